# Optimizing an MI355X kernel written in HIP

```python
import math
import jax, jax.numpy as jnp
from jax import lax
import numpy as np

D_MODEL = 1024
BATCH = 32
SEQ = 256
DEPTH = 1
DEC_BATCH = 2
DEC_SEQ = 4096
PAST_LEN = 256

GRID_W = 64
N_DIR = 2
N_DN_HEADS = 8
DN_HEAD_DIM = 128
D_DN = N_DN_HEADS * DN_HEAD_DIM
D_RG = 1024
N_RG_BLOCKS = 8
RG_BLOCK = D_RG // N_RG_BLOCKS
D_MIX = D_DN + D_RG
CONV_W = 4
CONV_PAD_L = 2
CONV_PAD_R = CONV_W - 1 - CONV_PAD_L
CHUNK = 64
RG_C = 8.0
EPS = 1e-6
OFF_Z = 3 * D_DN
OFF_B = 4 * D_DN
OFF_A = OFF_B + N_DIR * N_DN_HEADS
OFF_RX = OFF_A + N_DIR * N_DN_HEADS
OFF_RG = OFF_RX + D_RG
D_IN = OFF_RG + D_RG

kernel_name = 'hybrid_deltanet_rglru_diffusion_step'


def rmsnorm(x, w):
    xf = x.astype(jnp.float32)
    y = xf * lax.rsqrt(jnp.mean(xf * xf, axis=-1, keepdims=True) + EPS)
    return (y * w.astype(jnp.float32)).astype(x.dtype)


def l2norm(x):
    return x * lax.rsqrt(jnp.sum(x * x, axis=-1, keepdims=True) + EPS)


def short_conv(x, w):
    t = x.shape[1]
    xp = jnp.pad(x, ((0, 0), (CONV_PAD_L, CONV_PAD_R), (0, 0)))
    return sum(xp[:, j:j + t, :] * w[j] for j in range(CONV_W))


def grid_pos_embed(n_tok, dtype):
    rows = n_tok // GRID_W
    r = jnp.repeat(jnp.arange(rows, dtype=jnp.float32), GRID_W)
    col = jnp.tile(jnp.arange(GRID_W, dtype=jnp.float32), rows)
    quarter = D_MODEL // 4
    freqs = jnp.exp(-math.log(10000.0) * jnp.arange(quarter, dtype=jnp.float32) / quarter)
    ar = r[:, None] * freqs[None]
    ac = col[:, None] * freqs[None]
    pe = jnp.concatenate([jnp.sin(ar), jnp.cos(ar), jnp.sin(ac), jnp.cos(ac)], axis=-1)
    return pe.astype(dtype)


def gated_delta_chunked(q, k, v, g, beta, s0):
    b, t, h, dk = q.shape
    dv = v.shape[-1]
    n = t // CHUNK

    def chunks(a):
        return jnp.moveaxis(a.reshape((b, n, CHUNK, h) + a.shape[3:]), 3, 1)

    q = chunks(q) * (dk ** -0.5)
    k = chunks(k)
    v = chunks(v)
    beta = chunks(beta)
    g = jnp.cumsum(chunks(g), axis=-1)
    tril = jnp.tril(jnp.ones((CHUNK, CHUNK), dtype=bool))
    strict = jnp.tril(jnp.ones((CHUNK, CHUNK), dtype=bool), -1)
    decay = jnp.exp(jnp.where(tril, g[..., :, None] - g[..., None, :], -jnp.inf))
    kk = jnp.einsum('bhncd,bhnsd->bhncs', k * beta[..., None], k) * decay
    tmat = jnp.where(strict, kk, 0.0) + jnp.eye(CHUNK, dtype=jnp.float32)
    rhs = jnp.concatenate([v * beta[..., None], k * (beta * jnp.exp(g))[..., None]], axis=-1)
    sol = lax.linalg.triangular_solve(tmat, rhs, left_side=True, lower=True, unit_diagonal=True)
    u, w = sol[..., :dv], sol[..., dv:]
    attn = jnp.where(tril, jnp.einsum('bhncd,bhnsd->bhncs', q, k) * decay, 0.0)
    q_dec = q * jnp.exp(g)[..., None]
    k_dec = k * jnp.exp(g[..., -1:] - g)[..., None]
    g_last = jnp.exp(g[..., -1])

    def step(s, xs):
        u_i, w_i, attn_i, qd_i, kd_i, gl_i = xs
        v_new = u_i - jnp.einsum('bhcd,bhde->bhce', w_i, s)
        o = jnp.einsum('bhcd,bhde->bhce', qd_i, s) + jnp.einsum('bhcs,bhse->bhce', attn_i, v_new)
        s = s * gl_i[..., None, None] + jnp.einsum('bhcd,bhce->bhde', kd_i, v_new)
        return s, o

    xs = tuple(jnp.moveaxis(a, 2, 0) for a in (u, w, attn, q_dec, k_dec, g_last))
    s_fin, o = lax.scan(step, s0, xs)
    o = jnp.moveaxis(jnp.moveaxis(o, 0, 2), 1, 3).reshape(b, t, h, dv)
    return o, s_fin


def delta_branch(qkv, z, b_raw, a_raw, conv_w, a_log, dt_bias, norm_w, s0):
    bsz, t, _ = qkv.shape
    qkv = jax.nn.silu(short_conv(qkv, conv_w)).astype(jnp.float32)
    q, k, v = jnp.split(qkv.reshape(bsz, t, 3, N_DN_HEADS, DN_HEAD_DIM), 3, axis=2)
    q, k, v = l2norm(q[:, :, 0]), l2norm(k[:, :, 0]), v[:, :, 0]
    beta = jax.nn.sigmoid(b_raw.astype(jnp.float32))
    g = -jnp.exp(a_log) * jax.nn.softplus(a_raw.astype(jnp.float32) + dt_bias)
    s0 = s0.astype(jnp.float32)
    o_f, s_f = gated_delta_chunked(q, k, v, g[:, :, 0], beta[:, :, 0], s0[:, 0])
    flip = lambda a: jnp.flip(a, axis=1)
    o_b, s_b = gated_delta_chunked(flip(q), flip(k), flip(v), flip(g[:, :, 1]), flip(beta[:, :, 1]), s0[:, 1])
    o = rmsnorm(o_f + flip(o_b), norm_w) * jax.nn.silu(z.astype(jnp.float32).reshape(bsz, t, N_DN_HEADS, DN_HEAD_DIM))
    return o.reshape(bsz, t, D_DN), jnp.stack([s_f, s_b], axis=1)


def linear_scan(a, bx, h0):
    bx = bx.at[:, 0].add(a[:, 0] * h0)

    def comb(l, r):
        return l[0] * r[0], r[0] * l[1] + r[1]

    _, h = lax.associative_scan(comb, (a, bx), axis=1)
    return h


def rglru_branch(x, gate, conv_w, conv_b, w_r, b_r, w_i, b_i, lam, h0):
    bsz, t, _ = x.shape
    xf = (short_conv(x, conv_w) + conv_b).astype(jnp.float32)
    xb = xf.reshape(bsz, t, N_RG_BLOCKS, RG_BLOCK)
    r = jax.nn.sigmoid(jnp.einsum('btnk,dnkj->btdnj', xb, w_r).reshape(bsz, t, N_DIR, D_RG) + b_r)
    i = jax.nn.sigmoid(jnp.einsum('btnk,dnkj->btdnj', xb, w_i).reshape(bsz, t, N_DIR, D_RG) + b_i)
    log_a = -RG_C * r * jax.nn.softplus(-lam)
    a = jnp.exp(log_a)
    bx = jnp.sqrt(-jnp.expm1(2.0 * log_a)) * (i * xf[:, :, None, :])
    h0 = h0.astype(jnp.float32)
    h_f = linear_scan(a[:, :, 0], bx[:, :, 0], h0[:, 0])
    h_b = jnp.flip(linear_scan(jnp.flip(a[:, :, 1], 1), jnp.flip(bx[:, :, 1], 1), h0[:, 1]), 1)
    y = (h_f + h_b) * jax.nn.silu(gate.astype(jnp.float32))
    return y, jnp.stack([h_f[:, -1], h_b[:, 0]], axis=1)


def mixer_layer(x, mod, s_dn0, s_rg0, pre_w, post_w, w_in, w_out, dn_conv_w, dn_a_log, dn_dt_bias,
                dn_norm_w, rg_conv_w, rg_conv_b, rg_w_r, rg_b_r, rg_w_i, rg_b_i, rg_lam):
    bsz, t, _ = x.shape
    shift, scale, gate = jnp.split(mod[:, None, :].astype(x.dtype), 3, axis=-1)
    h = rmsnorm(x, pre_w) * (1 + scale) + shift
    proj = h @ w_in
    o_dn, s_dn = delta_branch(
        proj[..., :OFF_Z], proj[..., OFF_Z:OFF_B],
        proj[..., OFF_B:OFF_A].reshape(bsz, t, N_DIR, N_DN_HEADS),
        proj[..., OFF_A:OFF_RX].reshape(bsz, t, N_DIR, N_DN_HEADS),
        dn_conv_w, dn_a_log, dn_dt_bias, dn_norm_w, s_dn0)
    o_rg, s_rg = rglru_branch(proj[..., OFF_RX:OFF_RG], proj[..., OFF_RG:], rg_conv_w, rg_conv_b,
                              rg_w_r, rg_b_r, rg_w_i, rg_b_i, rg_lam, s_rg0)
    y = jnp.concatenate([o_dn, o_rg], axis=-1).astype(x.dtype) @ w_out
    return x + gate * rmsnorm(y, post_w), s_dn, s_rg


def setup_inputs(seed: int = 0) -> dict:
    key = jax.random.key(seed)
    ks = jax.random.split(key, 23)
    f32 = jnp.float32
    nrm = lambda k, shape, s: s * jax.random.normal(k, shape, f32)
    L = DEPTH
    dt = jnp.exp(jax.random.uniform(ks[14], (L, N_DIR, N_DN_HEADS), f32, math.log(1e-3), math.log(1e-1)))
    u = jax.random.uniform(ks[22], (L, N_DIR, D_RG), f32, 0.9, 0.999)
    log_sig = jnp.log(u) / RG_C
    return {
        'x_prompt': nrm(ks[0], (BATCH, SEQ, D_MODEL), 1.0),
        'x_sample': nrm(ks[1], (DEC_BATCH, DEC_SEQ, D_MODEL), 1.0),
        'state_delta': nrm(ks[2], (DEC_BATCH, L, N_DIR, N_DN_HEADS, DN_HEAD_DIM, DN_HEAD_DIM), 0.3),
        'state_rglru': nrm(ks[3], (DEC_BATCH, L, N_DIR, D_RG), 0.5),
        'c': nrm(ks[4], (DEC_BATCH, D_MODEL), 1.0),
        'c_ctx': nrm(ks[5], (D_MODEL,), 1.0),
        'ada_w': nrm(ks[6], (L, D_MODEL, 3 * D_MODEL), D_MODEL ** -0.5),
        'ada_b': nrm(ks[7], (L, 3 * D_MODEL), 0.02),
        'pre_norm_w': 1.0 + nrm(ks[8], (L, D_MODEL), 0.02),
        'post_norm_w': 1.0 + nrm(ks[9], (L, D_MODEL), 0.02),
        'w_in': nrm(ks[10], (L, D_MODEL, D_IN), D_MODEL ** -0.5),
        'w_out': nrm(ks[11], (L, D_MIX, D_MODEL), D_MIX ** -0.5),
        'dn_conv_w': nrm(ks[12], (L, CONV_W, 3 * D_DN), CONV_W ** -0.5),
        'dn_a_log': jnp.log(jax.random.uniform(ks[13], (L, N_DIR, N_DN_HEADS), f32, 1.0, 16.0)),
        'dn_dt_bias': dt + jnp.log(-jnp.expm1(-dt)),
        'dn_norm_w': 1.0 + nrm(ks[15], (L, DN_HEAD_DIM), 0.02),
        'rg_conv_w': nrm(ks[16], (L, CONV_W, D_RG), CONV_W ** -0.5),
        'rg_conv_b': nrm(ks[17], (L, D_RG), 0.01),
        'rg_w_r': nrm(ks[18], (L, N_DIR, N_RG_BLOCKS, RG_BLOCK, RG_BLOCK), RG_BLOCK ** -0.5),
        'rg_b_r': nrm(ks[19], (L, N_DIR, D_RG), 0.01),
        'rg_w_i': nrm(ks[20], (L, N_DIR, N_RG_BLOCKS, RG_BLOCK, RG_BLOCK), RG_BLOCK ** -0.5),
        'rg_b_i': nrm(ks[21], (L, N_DIR, D_RG), 0.01),
        'rg_lam': log_sig - jnp.log(-jnp.expm1(log_sig)),
    }


def reference(x_prompt, x_sample, state_delta, state_rglru, c, c_ctx, ada_w, ada_b, pre_norm_w,
              post_norm_w, w_in, w_out, dn_conv_w, dn_a_log, dn_dt_bias, dn_norm_w, rg_conv_w,
              rg_conv_b, rg_w_r, rg_b_r, rg_w_i, rg_b_i, rg_lam):
    xp = x_prompt
    xs = x_sample + grid_pos_embed(x_sample.shape[1], x_sample.dtype)[None]
    bp = x_prompt.shape[0]
    new_dn, new_rg = [], []
    for l in range(DEPTH):
        params = (pre_norm_w[l], post_norm_w[l], w_in[l], w_out[l], dn_conv_w[l], dn_a_log[l],
                  dn_dt_bias[l], dn_norm_w[l], rg_conv_w[l], rg_conv_b[l], rg_w_r[l], rg_b_r[l],
                  rg_w_i[l], rg_b_i[l], rg_lam[l])
        mod_ctx = jax.nn.silu(c_ctx[None]) @ ada_w[l] + ada_b[l]
        mod_lat = jax.nn.silu(c) @ ada_w[l] + ada_b[l]
        zero_dn = jnp.zeros((bp, N_DIR, N_DN_HEADS, DN_HEAD_DIM, DN_HEAD_DIM), jnp.float32)
        zero_rg = jnp.zeros((bp, N_DIR, D_RG), jnp.float32)
        xp, s_dn, s_rg = mixer_layer(xp, mod_ctx, zero_dn, zero_rg, *params)
        xs, _, _ = mixer_layer(xs, mod_lat, state_delta[:, l], state_rglru[:, l], *params)
        new_dn.append(s_dn.astype(x_prompt.dtype))
        new_rg.append(s_rg.astype(x_prompt.dtype))
    new_state_delta = jnp.stack(new_dn, axis=1)
    new_state_rglru = jnp.stack(new_rg, axis=1)
    return (xp, xs, new_state_delta, new_state_rglru)
```

```cpp
#include <hip/hip_runtime.h>
#include <cstdio>
#include <cstdint>

#define LAS __attribute__((address_space(3)))
typedef unsigned short bf16_t;
typedef short bf16x8 __attribute__((ext_vector_type(8)));
typedef float f32x4 __attribute__((ext_vector_type(4)));
typedef unsigned u32x4 __attribute__((ext_vector_type(4)));
typedef unsigned u32x2 __attribute__((ext_vector_type(2)));

#ifndef MK_SINGLE
#define MK_SINGLE 1
#endif

constexpr int NTOK = 16384, DM = 1024, NPROJ = 6144, DIN = 6176;
constexpr int NPH = 8;
constexpr int LDS_BYTES = 160 * 1024;
constexpr size_t OUT_YP = 0, OUT_YS = 8388608, OUT_SD = 16777216, OUT_SR = 25165824;
constexpr size_t WS_CTL = 0, WS_MODP = 16384, WS_PE = 606208, WS_BA = 737280, WS_GB = 2834432, WS_RGAGG = 4931584,
                 WS_WBAT = 9125888, WS_WOUTT = 9191424, WS_GT = 13385728, WS_WINT = 14434304, WS_TA = 27017216, WS_PROJ = 60571648;

struct Params {
    const float *x_prompt, *x_sample, *state_delta, *state_rglru, *c, *c_ctx, *ada_w, *ada_b, *pre_w, *post_w, *w_in, *w_out,
                *dn_conv_w, *dn_a_log, *dn_dt_bias, *dn_norm_w, *rg_conv_w, *rg_conv_b, *rg_w_r, *rg_b_r, *rg_w_i, *rg_b_i, *rg_lam;
    float* out; unsigned char* ws;
    int ph_lo, ph_hi;
};

__device__ __forceinline__ float bf2f(unsigned short b) { return __uint_as_float(((unsigned)b) << 16); }
__device__ __forceinline__ unsigned short f2bf(float f) { unsigned u = __float_as_uint(f); u += 0x7FFFu + ((u >> 16) & 1u); return (unsigned short)(u >> 16); }
__device__ __forceinline__ unsigned pk2(float lo, float hi) { return (unsigned)f2bf(lo) | ((unsigned)f2bf(hi) << 16); }
#ifndef SANITIZE
#define SANITIZE 0
#endif
#ifndef LIVE_MASK
#define LIVE_MASK 15
#endif
__device__ __forceinline__ float fin(float x) { return (SANITIZE && ((__float_as_uint(x) & 0x7f800000u) == 0x7f800000u)) ? 0.f : x; }
#define DG(F) ((unsigned*)((F).ws + WS_CTL))
__device__ __forceinline__ bool badv(float x, float lim) { return ((__float_as_uint(x) & 0x7f800000u) == 0x7f800000u) || fabsf(x) > lim; }
#ifndef DIAG
#define DIAG 0
#endif
#define CHK(F, k, bad) do { if (DIAG && (bad)) DG(F)[k] = 1u; } while (0)
__device__ __forceinline__ float sigm(float x) { return 1.f / (1.f + __expf(-x)); }
__device__ __forceinline__ float siluf_(float x) { return x / (1.f + __expf(-x)); }
__device__ __forceinline__ float softplusf_(float x) { return x > 20.f ? x : log1pf(__expf(x)); }
__device__ __forceinline__ void unpack8(const u32x4 v, float (&f)[8]) {
    f[0] = __uint_as_float(v.x << 16); f[1] = __uint_as_float(v.x & 0xffff0000u);
    f[2] = __uint_as_float(v.y << 16); f[3] = __uint_as_float(v.y & 0xffff0000u);
    f[4] = __uint_as_float(v.z << 16); f[5] = __uint_as_float(v.z & 0xffff0000u);
    f[6] = __uint_as_float(v.w << 16); f[7] = __uint_as_float(v.w & 0xffff0000u);
}
__device__ __forceinline__ u32x4 pack8(const float (&f)[8]) { u32x4 o; o.x = pk2(f[0], f[1]); o.y = pk2(f[2], f[3]); o.z = pk2(f[4], f[5]); o.w = pk2(f[6], f[7]); return o; }
__device__ __forceinline__ float wave_sum(float v) {
#pragma unroll
    for (int o = 1; o < 64; o <<= 1) v += __shfl_xor(v, o);
    return v;
}
#define MFMA16(a, b, c) __builtin_amdgcn_mfma_f32_16x16x32_bf16((a), (b), (c), 0, 0, 0)
#define LDS_WAIT() asm volatile("s_waitcnt lgkmcnt(0)" ::: "memory")
__device__ __forceinline__ bf16x8 ldfrag(const LAS unsigned char* base, int pitch, int row, int kb) { return *(const LAS bf16x8*)(base + row * pitch + kb); }

#define XB_TMO      128
#define XB_XCNT(j)  (256  + 64 * (j))
#define XB_XSUB(j)  (1280 + 64 * (j))
#define XB_XGEN(j)  (2304 + 64 * (j))
#define XB_TOP      3328
#define XB_TOPGEN   3392
#define XCD_BAR_WORDS 3456
#define XB_SPIN_CAP (1u << 18)
__device__ __forceinline__ unsigned xb_ld(unsigned* p)              { return __hip_atomic_load(p, __ATOMIC_RELAXED, __HIP_MEMORY_SCOPE_AGENT); }
__device__ __forceinline__ unsigned xb_add(unsigned* p, unsigned v) { return __hip_atomic_fetch_add(p, v, __ATOMIC_RELAXED, __HIP_MEMORY_SCOPE_AGENT); }
__device__ __forceinline__ unsigned xb_xcc_id() { return (unsigned)__builtin_amdgcn_s_getreg((3 << 11) | 20) & 0xFu; }
#define XB_SPIN(cond, bar) do { unsigned _sp = 0; while (cond) { __builtin_amdgcn_s_sleep(1); \
    if ((++_sp & 255u) == 0u) { if (xb_ld(&(bar)[XB_TMO])) break; if (_sp > XB_SPIN_CAP) { atomicAdd(&(bar)[XB_TMO], 1u); break; } } } } while (0)
struct XcdBarrier { unsigned* bar; unsigned x; volatile LAS unsigned* st; };
__device__ __forceinline__ XcdBarrier xcd_barrier_post(unsigned* bar, volatile LAS unsigned* st) {
    XcdBarrier b; b.bar = bar; b.x = xb_xcc_id(); b.st = st;
    if (threadIdx.x == 0) (void)xb_add(&bar[XB_XCNT(b.x)], 1u);
    return b;
}
__device__ __forceinline__ void xcd_barrier_complete(unsigned* bar, unsigned x, unsigned& nloc, unsigned& nx) {
    const unsigned G = gridDim.x * gridDim.y * gridDim.z;
    unsigned sum, cnt, mine, sp = 0u;
    for (;;) {
        sum = 0u; cnt = 0u; mine = 0u;
#pragma unroll
        for (unsigned j = 0; j < 16; ++j) { const unsigned c = xb_ld(&bar[XB_XCNT(j)]); sum += c; cnt += (c > 0u) ? 1u : 0u; mine = (j == x) ? c : mine; }
        if (sum == G) break;
        __builtin_amdgcn_s_sleep(1);
        if ((++sp & 255u) == 0u) { if (xb_ld(&bar[XB_TMO])) break; if (sp > XB_SPIN_CAP) { atomicAdd(&bar[XB_TMO], 1u); break; } }
    }
    nloc = mine > 0u ? mine : 1u; nx = cnt > 0u ? cnt : 1u;
}
__device__ __forceinline__ void xcd_barrier(const XcdBarrier& b) {
    asm volatile("s_waitcnt vmcnt(0)" ::: "memory");
    __syncthreads();
    if (threadIdx.x == 0) {
        unsigned* bar = b.bar;
        __builtin_amdgcn_s_waitcnt(0);
        unsigned nloc = b.st[0], nx = b.st[1];
        if (nloc == 0u) { xcd_barrier_complete(bar, b.x, nloc, nx); b.st[0] = nloc; b.st[1] = nx; }
        const unsigned old = xb_add(&bar[XB_XSUB(b.x)], 1u);
        const unsigned gen = old / nloc;
        if (old + 1u == (gen + 1u) * nloc) {
            __builtin_amdgcn_fence(__ATOMIC_RELEASE, "agent");
            asm volatile("s_waitcnt vmcnt(0)" ::: "memory");
            const unsigned og = xb_add(&bar[XB_TOP], 1u);
            const unsigned tg = og / nx;
            if (og + 1u == (tg + 1u) * nx) xb_add(&bar[XB_TOPGEN], 1u);
            else XB_SPIN(xb_ld(&bar[XB_TOPGEN]) == tg, bar);
            __builtin_amdgcn_fence(__ATOMIC_ACQUIRE, "agent");
            xb_add(&bar[XB_XGEN(b.x)], 1u);
            asm volatile("s_waitcnt vmcnt(0)" ::: "memory");
        } else {
            XB_SPIN(xb_ld(&bar[XB_XGEN(b.x)]) == gen, bar);
            __builtin_amdgcn_fence(__ATOMIC_ACQUIRE, "agent");
            asm volatile("s_waitcnt vmcnt(0)" ::: "memory");
        }
    }
    __syncthreads();
}

namespace pg8 {
constexpr int BM = 256, BK = 64, HALF = 128, HTB = HALF * BK * 2, STAGE_BYTES = 8 * HTB, NXCD = 8, WGM = 8;
__host__ __device__ __forceinline__ int lds_byte(int r, int c) { const int st = (r >> 4) * 2 + (c >> 5), rr = r & 15, cc = c & 31, ob = rr * 64 + cc * 2; return st * 1024 + (ob ^ (((ob >> 9) & 1) << 5)); }
__host__ __device__ __forceinline__ void stage_rc(int b, int& R, int& C) { const int st = b / 1024, sb = b % 1024, swz = sb ^ (((sb >> 9) & 1) << 5); R = (st >> 1) * 16 + swz / 64; C = (st & 1) * 32 + (swz % 64) / 2; }
__host__ __device__ __forceinline__ int perm32(int rho) { const int n = rho >> 4, i = rho & 15; return 8 * (i >> 2) + 4 * n + (i & 3); }
struct Unit { int pm, pn; };
struct Gemm { const bf16_t* A; const bf16_t* Bt; int M, N, K; };
struct StaticOrder {
    int nM, nN, nwg, G, c;
    __host__ __device__ void init(int M, int N, int G_, int c_) { nM = M / BM; nN = N / BM; nwg = nM * nN; G = G_; c = c_; }
    __host__ __device__ bool next(int i, Unit& u) const {
        const long L = (long)i * G + c; if (L >= nwg) return false;
        int wgid = (int)L; { const int q = nwg / NXCD, r = nwg % NXCD, xcd = wgid % NXCD, off = wgid / NXCD; wgid = (xcd < r ? xcd * (q + 1) : r * (q + 1) + (xcd - r) * q) + off; }
        const int nig = WGM * nN, gid = wgid / nig, fm = gid * WGM, gsz = (nM - fm) < WGM ? (nM - fm) : WGM;
        u.pm = fm + ((wgid % nig) % gsz); u.pn = (wgid % nig) / gsz; return true;
    }
};
__device__ __forceinline__ unsigned cvt_pk_bf16(float lo, float hi) { unsigned r; asm volatile("v_cvt_pk_bf16_f32 %0, %1, %2" : "=v"(r) : "v"(lo), "v"(hi)); return r; }
struct EpiF32 {
    static constexpr bool PERM = false;
    float* C; int ldc;
    __device__ __forceinline__ void operator()(const f32x4 (&acc)[2][2][4][2], const Unit& u, int wr, int wc, int fr, int fq) const {
        const int row0 = u.pm * BM + wr * 64 + fr, col0 = u.pn * BM + wc * 32 + 4 * fq;
#pragma unroll
        for (int ai = 0; ai < 2; ++ai)
#pragma unroll
            for (int m = 0; m < 4; ++m) { float* rowp = C + (size_t)(row0 + ai * HALF + m * 16) * ldc + col0;
#pragma unroll
                for (int bj = 0; bj < 2; ++bj)
#pragma unroll
                    for (int n = 0; n < 2; ++n) *(f32x4*)(rowp + bj * HALF + n * 16) = acc[ai][bj][m][n]; }
    }
};
struct EpiBf16 {
    static constexpr bool PERM = true;
    bf16_t* O; int ldc;
    __device__ __forceinline__ void operator()(const f32x4 (&acc)[2][2][4][2], const Unit& u, int wr, int wc, int fr, int fq) const {
        const int row0 = u.pm * BM + wr * 64 + fr; const int col0 = u.pn * BM + wc * 32 + 8 * fq;
#pragma unroll
        for (int ai = 0; ai < 2; ++ai)
#pragma unroll
            for (int m = 0; m < 4; ++m) { bf16_t* rowp = O + (size_t)(row0 + ai * HALF + m * 16) * ldc + col0;
#pragma unroll
                for (int bj = 0; bj < 2; ++bj) { const f32x4 v0 = acc[ai][bj][m][0], v1 = acc[ai][bj][m][1];
                    u32x4 w; w.x = cvt_pk_bf16(v0[0], v0[1]); w.y = cvt_pk_bf16(v0[2], v0[3]); w.z = cvt_pk_bf16(v1[0], v1[1]); w.w = cvt_pk_bf16(v1[2], v1[3]);
                    *(u32x4*)(rowp + bj * HALF) = w; } }
    }
};

template <class Epi, class Sched>
__device__ __forceinline__ void gemm_phase(LAS unsigned char* lds, const Gemm g, const Sched& S, const Epi& E) {
    const int tid = threadIdx.x, wid = __builtin_amdgcn_readfirstlane(tid >> 6), lane = tid & 63, wr = wid >> 2, wc = wid & 3, fr = lane & 15, fq = lane >> 4;
    const int K = g.K, nt = K / BK;
    unsigned voffA[2], voffB[2];
#pragma unroll
    for (int i = 0; i < 2; ++i) { int R, C; stage_rc(tid * 16 + i * 8192, R, C); const int Rb = Epi::PERM ? ((R & ~31) + perm32(R & 31)) : R;
        voffA[i] = (unsigned)(R * K + C) * 2u; voffB[i] = (unsigned)(Rb * K + C) * 2u; }
    const size_t kstep = (size_t)(BK * 2);
    const size_t hstep = (size_t)HALF * K * 2;
    const size_t tstep = 2 * hstep;
    const unsigned ldsw = (unsigned)wid * 1024u;
    const int aoff = lds_byte(wr * 64 + fr, fq * 8), boff = lds_byte(wc * 32 + fr, fq * 8);
#define PG8_SA(b, h) (((b) * 2 + (h)) * HTB)
#define PG8_SB(b, h) ((4 + (b) * 2 + (h)) * HTB)
#define PG8_STAGE(bufoff, gbase, voff) do { _Pragma("unroll") for (int _i = 0; _i < 2; ++_i) \
        __builtin_amdgcn_global_load_lds((const unsigned*)((const char*)(gbase) + (voff)[_i]), (LAS unsigned*)(lds + (bufoff) + ldsw + _i * 8192), 16, 0, 0); } while (0)
#define PG8_LDA(dst, b, h) do { _Pragma("unroll") for (int m = 0; m < 4; ++m) _Pragma("unroll") for (int k = 0; k < 2; ++k) dst[m][k] = *(const LAS bf16x8*)(lds + PG8_SA(b, h) + aoff + m * 2048 + k * 1024); } while (0)
#define PG8_LDB(dst, b, h) do { _Pragma("unroll") for (int n = 0; n < 2; ++n) _Pragma("unroll") for (int k = 0; k < 2; ++k) dst[n][k] = *(const LAS bf16x8*)(lds + PG8_SB(b, h) + boff + n * 2048 + k * 1024); } while (0)
#define PG8_MMA(ai, bj, At, Bt) do { __builtin_amdgcn_s_setprio(1); _Pragma("unroll") for (int m = 0; m < 4; ++m) _Pragma("unroll") for (int n = 0; n < 2; ++n) _Pragma("unroll") for (int k = 0; k < 2; ++k) \
        acc[ai][bj][m][n] = __builtin_amdgcn_mfma_f32_16x16x32_bf16(Bt[n][k], At[m][k], acc[ai][bj][m][n], 0, 0, 0); __builtin_amdgcn_s_setprio(0); } while (0)
#define PG8_WAIT_V(n) asm volatile("s_waitcnt vmcnt(" #n ")" ::: "memory")
#define PG8_WAIT_L(n) asm volatile("s_waitcnt lgkmcnt(" #n ")" ::: "memory")
#define PG8_BAR __builtin_amdgcn_s_barrier()
#define PG8_SCHED __builtin_amdgcn_sched_barrier(0)
    Unit cur, nxt; int ui = 0;
    if (!S.next(0, cur)) return;
    f32x4 acc[2][2][4][2];
#pragma unroll
    for (int a = 0; a < 2; ++a)
#pragma unroll
        for (int b = 0; b < 2; ++b)
#pragma unroll
            for (int m = 0; m < 4; ++m)
#pragma unroll
                for (int n = 0; n < 2; ++n) acc[a][b][m][n] = (f32x4){0.f, 0.f, 0.f, 0.f};
    bf16x8 At[4][2], B0[2][2], B1[2][2];
    const char* cA = (const char*)g.A + (size_t)cur.pm * tstep; const char* cB = (const char*)g.Bt + (size_t)cur.pn * tstep;
    PG8_STAGE(PG8_SB(0, 0), cB, voffB); PG8_STAGE(PG8_SA(0, 0), cA, voffA); PG8_STAGE(PG8_SB(0, 1), cB + hstep, voffB); PG8_STAGE(PG8_SA(0, 1), cA + hstep, voffA);
    if (wr == 1) PG8_BAR;
    PG8_WAIT_V(4); PG8_BAR;
    PG8_STAGE(PG8_SB(1, 0), cB + kstep, voffB); PG8_STAGE(PG8_SA(1, 0), cA + kstep, voffA); PG8_STAGE(PG8_SB(1, 1), cB + hstep + kstep, voffB);
    PG8_WAIT_V(6); PG8_BAR;
    for (;;) {
        const bool has_next = S.next(ui + 1, nxt);
        const char* nA = has_next ? (const char*)g.A + (size_t)nxt.pm * tstep : cA; const char* nB = has_next ? (const char*)g.Bt + (size_t)nxt.pn * tstep : cB;
        for (int t = 0; t < nt; t += 2) {
            const bool last = (t == nt - 2);
            const char* a1 = cA + (size_t)(t + 1) * kstep;
            const char* a2 = last ? nA : cA + (size_t)(t + 2) * kstep; const char* b2 = last ? nB : cB + (size_t)(t + 2) * kstep;
            const char* a3 = a2 + kstep; const char* b3 = b2 + kstep;
            PG8_LDB(B0, 0, 0); PG8_SCHED; PG8_LDA(At, 0, 0); PG8_STAGE(PG8_SA(1, 1), a1 + hstep, voffA);
            PG8_WAIT_L(8); PG8_BAR; PG8_WAIT_L(0); PG8_MMA(0, 0, At, B0); PG8_BAR; PG8_SCHED;
            PG8_LDB(B1, 0, 1); PG8_STAGE(PG8_SB(0, 0), b2, voffB);
            PG8_BAR; PG8_WAIT_L(0); PG8_MMA(0, 1, At, B1); PG8_BAR;
            PG8_LDA(At, 0, 1); PG8_STAGE(PG8_SA(0, 0), a2, voffA);
            PG8_BAR; PG8_WAIT_L(0); PG8_MMA(1, 0, At, B0); PG8_BAR; PG8_SCHED;
            PG8_STAGE(PG8_SB(0, 1), b2 + hstep, voffB);
            PG8_WAIT_V(6); PG8_BAR; PG8_MMA(1, 1, At, B1); PG8_BAR;
            PG8_LDB(B0, 1, 0); PG8_SCHED; PG8_LDA(At, 1, 0); PG8_STAGE(PG8_SA(0, 1), a2 + hstep, voffA);
            PG8_WAIT_L(8); PG8_BAR; PG8_WAIT_L(0); PG8_MMA(0, 0, At, B0); PG8_BAR; PG8_SCHED;
            PG8_LDB(B1, 1, 1); PG8_STAGE(PG8_SB(1, 0), b3, voffB);
            PG8_BAR; PG8_WAIT_L(0); PG8_MMA(0, 1, At, B1); PG8_BAR;
            PG8_LDA(At, 1, 1); PG8_STAGE(PG8_SA(1, 0), a3, voffA);
            PG8_BAR; PG8_WAIT_L(0); PG8_MMA(1, 0, At, B0); PG8_BAR; PG8_SCHED;
            PG8_STAGE(PG8_SB(1, 1), b3 + hstep, voffB);
            PG8_WAIT_V(6); PG8_BAR; PG8_MMA(1, 1, At, B1); PG8_BAR;
        }
        E(acc, cur, wr, wc, fr, fq);
        if (!has_next) break;
#pragma unroll
        for (int a = 0; a < 2; ++a)
#pragma unroll
            for (int b = 0; b < 2; ++b)
#pragma unroll
                for (int m = 0; m < 4; ++m)
#pragma unroll
                    for (int n = 0; n < 2; ++n) acc[a][b][m][n] = (f32x4){0.f, 0.f, 0.f, 0.f};
        cur = nxt; cA = nA; cB = nB; ++ui;
    }
    PG8_WAIT_V(0);
    if (wr == 0) PG8_BAR;
    PG8_BAR;
#undef PG8_SA
#undef PG8_SB
#undef PG8_STAGE
#undef PG8_LDA
#undef PG8_LDB
#undef PG8_MMA
#undef PG8_WAIT_V
#undef PG8_WAIT_L
#undef PG8_BAR
#undef PG8_SCHED
}
}

struct Frame {
    LAS unsigned char* lds;
    int tid, lane, wave, G, b;
    float* out; unsigned char* ws;
    __device__ __forceinline__ bf16_t* H() const { return (bf16_t*)out; }
    __device__ __forceinline__ bf16_t* Qc() const { return (bf16_t*)out; }
    __device__ __forceinline__ bf16_t* Kc() const { return (bf16_t*)(out + OUT_YS); }
    __device__ __forceinline__ bf16_t* MIX() const { return (bf16_t*)out; }
    __device__ __forceinline__ float* modp() const { return (float*)(ws + WS_MODP); }
    __device__ __forceinline__ float* pe() const { return (float*)(ws + WS_PE); }
    __device__ __forceinline__ float* BA() const { return (float*)(ws + WS_BA); }
    __device__ __forceinline__ float* GB() const { return (float*)(ws + WS_GB); }
    __device__ __forceinline__ float* RGAGG() const { return (float*)(ws + WS_RGAGG); }
    __device__ __forceinline__ bf16_t* WbaT() const { return (bf16_t*)(ws + WS_WBAT); }
    __device__ __forceinline__ bf16_t* WoutT() const { return (bf16_t*)(ws + WS_WOUTT); }
    __device__ __forceinline__ bf16_t* GT() const { return (bf16_t*)(ws + WS_GT); }
    __device__ __forceinline__ bf16_t* WinT() const { return (bf16_t*)(ws + WS_WINT); }
    __device__ __forceinline__ bf16_t* TA() const { return (bf16_t*)(ws + WS_TA); }
    __device__ __forceinline__ bf16_t* PROJ() const { return (bf16_t*)(ws + WS_PROJ); }
};
typedef const __attribute__((address_space(4))) Params CParams;

__device__ __forceinline__ int grp_of_block(int tb) { return tb < 128 ? 0 : (tb < 192 ? 1 : 2); }

__device__ __forceinline__ void transpose_item(const float* W, int N, int k0, int n0, bf16_t* WT0, int Kout, LAS float* scr, int lane) {
#pragma unroll 8
    for (int i = 0; i < 32; ++i) { const int kk = 2 * i + (lane >> 5); scr[kk * 33 + (lane & 31)] = W[(size_t)(k0 + kk) * N + n0 + (lane & 31)]; }
    LDS_WAIT();
    const int c = lane & 7;
#pragma unroll
    for (int j = 0; j < 4; ++j) { const int n = (lane >> 3) + 8 * j; const LAS float* s = scr + (8 * c) * 33 + n;
        u32x4 o; o.x = pk2(s[0 * 33], s[1 * 33]); o.y = pk2(s[2 * 33], s[3 * 33]); o.z = pk2(s[4 * 33], s[5 * 33]); o.w = pk2(s[6 * 33], s[7 * 33]);
        *(u32x4*)(WT0 + (size_t)n * Kout + k0 + 8 * c) = o; }
    LDS_WAIT();
}
__device__ __forceinline__ void phase0(CParams& p, Frame& F) {
    const int tid = F.tid, lane = F.lane;
    for (int it = F.b; it < 192; it += F.G) {
        const int jg = it % 12, ks = it / 12, j = jg * 256 + (tid & 255), half = tid >> 8, k0 = ks * 64 + half * 32;
        float s0 = 0.f, s1 = 0.f, s2 = 0.f;
#pragma unroll 8
        for (int k = 0; k < 32; ++k) { const int kk = k0 + k; const float w = p.ada_w[(size_t)kk * 3072 + j];
            s0 += siluf_(p.c_ctx[kk]) * w; s1 += siluf_(p.c[kk]) * w; s2 += siluf_(p.c[1024 + kk]) * w; }
        LAS float* red = (LAS float*)F.lds;
        if (half == 1) { red[tid - 256] = s0; red[256 + tid - 256] = s1; red[512 + tid - 256] = s2; }
        __syncthreads();
        if (half == 0) { F.modp()[(size_t)(ks * 3 + 0) * 3072 + j] = s0 + red[tid]; F.modp()[(size_t)(ks * 3 + 1) * 3072 + j] = s1 + red[256 + tid]; F.modp()[(size_t)(ks * 3 + 2) * 3072 + j] = s2 + red[512 + tid]; }
        __syncthreads();
    }
    LAS float* scr = (LAS float*)(F.lds + 4096 + F.wave * 8448);
    const int gw = F.b * 8 + F.wave, NGW = F.G * 8;
    constexpr int I_IN = 16 * 193, I_OUT = 32 * 32, I_G = 256, I_PE = 64;
    for (int it = gw; it < I_IN + I_OUT + I_G + I_PE; it += NGW) {
        int r = it;
        if (r < I_IN) { const int kb = r / 193, nb = r % 193, n0 = nb * 32;
            bf16_t* dst = n0 < 4096 ? F.WinT() + (size_t)n0 * 1024 : (n0 < 4128 ? F.WbaT() + (size_t)(n0 - 4096) * 1024 : F.WinT() + (size_t)(n0 - 32) * 1024);
            transpose_item(p.w_in, DIN, kb * 64, n0, dst, 1024, scr, lane); continue; }
        r -= I_IN;
        if (r < I_OUT) { const int kb = r / 32, nb = r % 32; transpose_item(p.w_out, 1024, kb * 64, nb * 32, F.WoutT() + (size_t)(nb * 32) * 2048, 2048, scr, lane); continue; }
        r -= I_OUT;
        if (r < I_G) { const int m = r >> 3, sub = r & 7, kb = sub >> 2, nb = sub & 3, g = m >> 4, dn = m & 15;
            const float* src = (g ? p.rg_w_i : p.rg_w_r) + (size_t)dn * 16384;
            transpose_item(src, 128, kb * 64, nb * 32, F.GT() + (size_t)m * 16384 + (size_t)(nb * 32) * 128, 128, scr, lane); continue; }
        r -= I_G;
        { const int v = r;
#pragma unroll
          for (int i = 0; i < 4; ++i) { const int idx = lane * 4 + i; const float f = expf(-9.210340371976184f * (float)idx / 256.f); const float a = (float)v * f;
              F.pe()[v * 256 + idx] = sinf(a); F.pe()[16384 + v * 256 + idx] = cosf(a); } }
    }
}

__device__ __forceinline__ float mod_val(CParams& p, const Frame& F, int grp, int j) {
    float s = p.ada_b[j];
#pragma unroll
    for (int ks = 0; ks < 16; ++ks) s += F.modp()[(size_t)(ks * 3 + grp) * 3072 + j];
    return s;
}

__device__ __forceinline__ void phase1(CParams& p, Frame& F) {
    LAS float* sc = (LAS float*)F.lds; LAS float* sh = sc + 1024;
    for (int tb = F.b; tb < 256; tb += F.G) {
        const int grp = grp_of_block(tb);
        for (int j = F.tid; j < 1024; j += 512) { sh[j] = mod_val(p, F, grp, j); sc[j] = p.pre_w[j] * (1.f + mod_val(p, F, grp, 1024 + j)); }
        __syncthreads();
        for (int i = 0; i < 8; ++i) {
            const int tok = tb * 64 + F.wave * 8 + i;
            const float* xr = tok < 8192 ? p.x_prompt + (size_t)tok * 1024 : p.x_sample + (size_t)(tok - 8192) * 1024;
            f32x4 v[4]; float ss = 0.f;
#pragma unroll
            for (int q = 0; q < 4; ++q) { v[q] = *(const f32x4*)(xr + F.lane * 4 + 256 * q);
                if (tok >= 8192) { const int pp = (tok - 8192) & 4095; const int vv = (q < 2) ? (pp >> 6) : (pp & 63);
                    const f32x4 e = *(const f32x4*)(F.pe() + ((q & 1) ? 16384 : 0) + vv * 256 + F.lane * 4); v[q] += e; }
                ss += (v[q][0] * v[q][0] + v[q][1] * v[q][1]) + (v[q][2] * v[q][2] + v[q][3] * v[q][3]); }
            const float rstd = rsqrtf(wave_sum(ss) * (1.f / 1024.f) + 1e-6f);
#pragma unroll
            for (int q = 0; q < 4; ++q) { const int j = F.lane * 4 + 256 * q; const f32x4 s4 = *(const LAS f32x4*)(sc + j), h4 = *(const LAS f32x4*)(sh + j);
                CHK(F, 1, badv(v[q][0] * rstd * s4[0] + h4[0], 100.f) || badv(v[q][3] * rstd * s4[3] + h4[3], 100.f));
                u32x2 o; o.x = pk2(v[q][0] * rstd * s4[0] + h4[0], v[q][1] * rstd * s4[1] + h4[1]); o.y = pk2(v[q][2] * rstd * s4[2] + h4[2], v[q][3] * rstd * s4[3] + h4[3]);
                *(u32x2*)(F.H() + (size_t)tok * 1024 + j) = o; }
        }
        __syncthreads();
    }
}

__device__ __forceinline__ void phase2(CParams& p, Frame& F) {
    { pg8::Gemm g{F.H(), F.WinT(), NTOK, NPROJ, 1024}; pg8::StaticOrder S; S.init(NTOK, NPROJ, F.G, F.b); pg8::EpiBf16 E{F.PROJ(), NPROJ};
      pg8::gemm_phase<pg8::EpiBf16, pg8::StaticOrder>(F.lds, g, S, E); }
    const int l15 = F.lane & 15, q4 = F.lane >> 4;
    for (int tb = F.b; tb < 256; tb += F.G) {
        const int mt = F.wave >> 1, nt = F.wave & 1;
        const bf16_t* ar = F.H() + (size_t)(tb * 64 + mt * 16 + l15) * 1024 + q4 * 8;
        const bf16_t* br = F.WbaT() + (size_t)(nt * 16 + l15) * 1024 + q4 * 8;
        f32x4 acc = {0.f, 0.f, 0.f, 0.f};
#pragma unroll 4
        for (int ks = 0; ks < 32; ++ks) { const bf16x8 a = *(const bf16x8*)(ar + ks * 32), b = *(const bf16x8*)(br + ks * 32); acc = MFMA16(a, b, acc); }
#pragma unroll
        for (int r = 0; r < 4; ++r) F.BA()[(size_t)(tb * 64 + mt * 16 + q4 * 4 + r) * 32 + nt * 16 + l15] = acc[r];
    }
}

__device__ __forceinline__ void p3_delta_item(CParams& p, Frame& F, int ci, int h) {
    const int tid = F.tid, lane = F.lane, wave = F.wave, q4 = lane >> 4, l15 = lane & 15;
    LAS unsigned char* Ks = F.lds; LAS unsigned char* Qs = F.lds + 17408;
    LAS float* gfv = (LAS float*)(F.lds + 34816);
    LAS unsigned char* DIR0 = F.lds + 35840;
    LAS unsigned char* ATo = F.lds + 137728;
#pragma unroll
    for (int i = 0; i < 5; ++i) { const int ch = tid + 512 * i; if (ch < 2304) { const int dd = ch >= 1152, cc = ch - dd * 1152; *(LAS u32x4*)(DIR0 + dd * 46848 + 18432 + cc * 16) = (u32x4){0u, 0u, 0u, 0u}; } }
    const int t0 = ci * 64;
    int seq_lo, seq_hi; if (ci < 128) { seq_lo = (ci >> 2) * 256; seq_hi = seq_lo + 256; } else { seq_lo = 8192 + ((ci - 128) >> 6) * 4096; seq_hi = seq_lo + 4096; }
    {
        const int tg = tid >> 5, part = (tid >> 4) & 1, sub = tid & 15, col = part * 1024 + h * 128 + sub * 8;
        float w[4][8];
#pragma unroll
        for (int j = 0; j < 4; ++j) { const f32x4 a = *(const f32x4*)(p.dn_conv_w + j * 3072 + col), b = *(const f32x4*)(p.dn_conv_w + j * 3072 + col + 4);
            w[j][0] = a[0]; w[j][1] = a[1]; w[j][2] = a[2]; w[j][3] = a[3]; w[j][4] = b[0]; w[j][5] = b[1]; w[j][6] = b[2]; w[j][7] = b[3]; }
        float acc[4][8];
#pragma unroll
        for (int i = 0; i < 4; ++i)
#pragma unroll
            for (int e = 0; e < 8; ++e) acc[i][e] = 0.f;
        const int tb = t0 + tg * 4 - 2;
#pragma unroll
        for (int r = 0; r < 7; ++r) { const int tok = tb + r; u32x4 v = {0u, 0u, 0u, 0u};
            if (tok >= seq_lo && tok < seq_hi) v = *(const u32x4*)(F.PROJ() + (size_t)tok * NPROJ + col);
            float x[8]; unpack8(v, x);
            CHK(F, 2, badv(x[0], 1000.f) || badv(x[3], 1000.f) || badv(x[7], 1000.f));
#pragma unroll
            for (int j = 0; j < 4; ++j) { const int i = r - j; if (i >= 0 && i < 4) {
#pragma unroll
                for (int e = 0; e < 8; ++e) acc[i][e] += w[j][e] * x[e]; } } }
#pragma unroll
        for (int i = 0; i < 4; ++i) { float ss = 0.f;
#pragma unroll
            for (int e = 0; e < 8; ++e) { acc[i][e] = siluf_(acc[i][e]); ss += acc[i][e] * acc[i][e]; }
            ss += __shfl_xor(ss, 1); ss += __shfl_xor(ss, 2); ss += __shfl_xor(ss, 4); ss += __shfl_xor(ss, 8);
            const float rs = rsqrtf(ss + 1e-6f) * (part == 0 ? 0.08838834764831845f : 1.f);
#pragma unroll
            for (int e = 0; e < 8; ++e) acc[i][e] *= rs;
            CHK(F, 4, badv(acc[i][0], 1.01f) || badv(acc[i][5], 1.01f) || badv(ss * rs * rs, part == 0 ? 0.0079f : 1.01f));
            const u32x4 o = pack8(acc[i]); const int c = tg * 4 + i;
            *(LAS u32x4*)((part ? Ks : Qs) + c * 272 + sub * 16) = o;
            *(u32x4*)((part ? F.Kc() : F.Qc()) + (size_t)(t0 + c) * 1024 + h * 128 + sub * 8) = o; }
    }
    if (wave == 0) {
        const float* ba = F.BA() + (size_t)(t0 + lane) * 32;
        const float bf_ = sigm(ba[h]), bb_ = sigm(ba[8 + h]);
        float s = -expf(p.dn_a_log[h]) * softplusf_(ba[16 + h] + p.dn_dt_bias[h]);
        float sb = -expf(p.dn_a_log[8 + h]) * softplusf_(ba[24 + h] + p.dn_dt_bias[8 + h]);
#pragma unroll
        for (int o = 1; o < 64; o <<= 1) { const float t = __shfl_up(s, o); if (lane >= o) s += t; }
#pragma unroll
        for (int o = 1; o < 64; o <<= 1) { const float t = __shfl_down(sb, o); if (lane + o < 64) sb += t; }
        CHK(F, 3, badv(ba[h], 1000.f) || badv(ba[24 + h], 1000.f));
        CHK(F, 8, badv(s, 1e4f) || badv(sb, 1e4f) || s > 0.f || sb > 0.f || bf_ < 0.f || bf_ > 1.f || bb_ < 0.f || bb_ > 1.f);
        gfv[lane] = s; gfv[64 + lane] = sb; gfv[128 + lane] = bf_; gfv[192 + lane] = bb_;
        float* gb = F.GB() + (size_t)(ci * 8 + h) * 256;
        gb[lane] = s; gb[64 + lane] = sb; gb[128 + lane] = bf_; gb[192 + lane] = bb_;
    }
    __syncthreads();
    const int d = wave >> 2, mt = wave & 3;
    LAS unsigned char* Db = DIR0 + d * 46848;
    LAS unsigned char* Brow = Db; LAS unsigned char* Btr = Db + 9216; LAS unsigned char* Xrow = Db + 18432; LAS unsigned char* Xtr = Db + 27648;
    LAS float* Dl = (LAS float*)(Db + 36864) + mt * 272; LAS unsigned char* M2t = Db + 41216; LAS unsigned char* Mts = Db + 43776 + mt * 768;
    const LAS unsigned char* Lrow = d == 0 ? Brow : Btr;
    const LAS float* gd = gfv + d * 64; const LAS float* bd = gfv + 128 + d * 64;
    {
        f32x4 kk[4], qk[4];
#pragma unroll
        for (int n = 0; n < 4; ++n) { kk[n] = (f32x4){0.f, 0.f, 0.f, 0.f}; qk[n] = (f32x4){0.f, 0.f, 0.f, 0.f}; }
#pragma unroll
        for (int ks = 0; ks < 4; ++ks) { const bf16x8 ak = ldfrag(Ks, 272, mt * 16 + l15, ks * 64 + q4 * 16), aq = ldfrag(Qs, 272, mt * 16 + l15, ks * 64 + q4 * 16);
#pragma unroll
            for (int n = 0; n < 4; ++n) { const bf16x8 bk = ldfrag(Ks, 272, n * 16 + l15, ks * 64 + q4 * 16); kk[n] = MFMA16(ak, bk, kk[n]); qk[n] = MFMA16(aq, bk, qk[n]); } }
#pragma unroll
        for (int n = 0; n < 4; ++n) { const int s = n * 16 + l15; float a4[4];
#pragma unroll
            for (int r = 0; r < 4; ++r) { const int c = mt * 16 + q4 * 4 + r;
                const float dec = __expf(fminf(gd[c] - gd[s], 0.f));
                const bool strict = d == 0 ? (c > s) : (c < s);
                const float a = strict ? bd[c] * kk[n][r] * dec : 0.f;
                a4[r] = a;
                ((LAS bf16_t*)Brow)[c * 72 + s] = f2bf(a);
                if (n == mt) { if (d == 0) Dl[(q4 * 4 + r) * 17 + l15] = a; else Dl[l15 * 17 + q4 * 4 + r] = a; }
                const bool incl = d == 0 ? (c >= s) : (c < s);
                if (incl) ((LAS bf16_t*)ATo)[c * 64 + s] = f2bf(qk[n][r] * dec); }
            u32x2 o; o.x = pk2(a4[0], a4[1]); o.y = pk2(a4[2], a4[3]);
            *(LAS u32x2*)(Btr + s * 144 + (mt * 16 + q4 * 4) * 2) = o; }
    }
    __syncthreads();
    if (lane < 16) {
        float x[16];
#pragma unroll
        for (int i = 0; i < 16; ++i) { float sv = (i == lane) ? 1.f : 0.f;
#pragma unroll
            for (int j = 0; j < i; ++j) sv -= Dl[i * 17 + j] * x[j];
            x[i] = sv; }
#pragma unroll
        for (int i = 0; i < 16; ++i) ((LAS bf16_t*)Xrow)[(mt * 16 + i) * 72 + mt * 16 + lane] = f2bf(x[i]);
        u32x4 o0, o1; o0.x = pk2(x[0], x[1]); o0.y = pk2(x[2], x[3]); o0.z = pk2(x[4], x[5]); o0.w = pk2(x[6], x[7]);
        o1.x = pk2(x[8], x[9]); o1.y = pk2(x[10], x[11]); o1.z = pk2(x[12], x[13]); o1.w = pk2(x[14], x[15]);
        *(LAS u32x4*)(Xtr + (mt * 16 + lane) * 144 + mt * 32) = o0; *(LAS u32x4*)(Xtr + (mt * 16 + lane) * 144 + mt * 32 + 16) = o1;
    }
    __syncthreads();
    const bf16x8 zero8 = {0, 0, 0, 0, 0, 0, 0, 0};
    const f32x4 zero4 = {0.f, 0.f, 0.f, 0.f};
    if (mt & 1) {
        const int I1 = mt, I0 = mt - 1;
        bf16x8 a = zero8, b = zero8;
        if (q4 < 2) { a = ldfrag(Lrow, 144, I1 * 16 + l15, I0 * 32 + q4 * 16); b = ldfrag(Xtr, 144, I0 * 16 + l15, I0 * 32 + q4 * 16); }
        const f32x4 M = MFMA16(a, b, zero4);
        { u32x2 o; o.x = pk2(M[0], M[1]); o.y = pk2(M[2], M[3]); *(LAS u32x2*)(Mts + l15 * 48 + q4 * 8) = o; }
        LDS_WAIT();
        bf16x8 a2 = zero8, b2 = zero8;
        if (q4 < 2) { a2 = ldfrag(Xrow, 144, I1 * 16 + l15, I1 * 32 + q4 * 16); b2 = *(const LAS bf16x8*)(Mts + l15 * 48 + q4 * 16); }
        const f32x4 X = MFMA16(a2, b2, zero4);
#pragma unroll
        for (int r = 0; r < 4; ++r) ((LAS bf16_t*)Xrow)[(I1 * 16 + q4 * 4 + r) * 72 + I0 * 16 + l15] = f2bf(-X[r]);
        u32x2 o; o.x = pk2(-X[0], -X[1]); o.y = pk2(-X[2], -X[3]);
        *(LAS u32x2*)(Xtr + (I0 * 16 + l15) * 144 + (I1 * 16 + q4 * 4) * 2) = o;
    }
    __syncthreads();
    {
        const int mi = mt >> 1, ni = mt & 1;
        const bf16x8 a = ldfrag(Lrow, 144, 32 + mi * 16 + l15, q4 * 16), b = ldfrag(Xtr, 144, ni * 16 + l15, q4 * 16);
        const f32x4 M2 = MFMA16(a, b, zero4);
        { u32x2 o; o.x = pk2(M2[0], M2[1]); o.y = pk2(M2[2], M2[3]); *(LAS u32x2*)(M2t + (ni * 16 + l15) * 80 + (mi * 16 + q4 * 4) * 2) = o; }
        __syncthreads();
        const bf16x8 a2 = ldfrag(Xrow, 144, 32 + mi * 16 + l15, 64 + q4 * 16), b2 = *(const LAS bf16x8*)(M2t + (ni * 16 + l15) * 80 + q4 * 16);
        const f32x4 X = MFMA16(a2, b2, zero4);
#pragma unroll
        for (int r = 0; r < 4; ++r) { CHK(F, 6, badv(X[r], 20.f)); ((LAS bf16_t*)Xrow)[(32 + mi * 16 + q4 * 4 + r) * 72 + ni * 16 + l15] = f2bf(-X[r]); }
        u32x2 o; o.x = pk2(-X[0], -X[1]); o.y = pk2(-X[2], -X[3]);
        *(LAS u32x2*)(Xtr + (ni * 16 + l15) * 144 + (32 + mi * 16 + q4 * 4) * 2) = o;
    }
    __syncthreads();
    { bf16_t* dst = F.TA() + (size_t)(ci * 8 + h) * 8192;
      const int c = tid >> 3, s0 = (tid & 7) * 8;
      const u32x4 lo = *(const LAS u32x4*)(DIR0 + 18432 + c * 144 + s0 * 2), up = *(const LAS u32x4*)(DIR0 + 46848 + 27648 + c * 144 + s0 * 2);
      unsigned wl[4] = {lo.x, lo.y, lo.z, lo.w}, wu[4] = {up.x, up.y, up.z, up.w}, wo[4];
#pragma unroll
      for (int i = 0; i < 4; ++i) { const int sa = s0 + 2 * i, sb2 = sa + 1;
          const unsigned mlo = (sa <= c ? 0x0000FFFFu : 0u) | (sb2 <= c ? 0xFFFF0000u : 0u);
          wo[i] = (wl[i] & mlo) | (wu[i] & ~mlo); }
      *(u32x4*)(dst + tid * 8) = (u32x4){wo[0], wo[1], wo[2], wo[3]};
      *(u32x4*)(dst + 4096 + tid * 8) = *(const LAS u32x4*)(ATo + tid * 16); }
    __syncthreads();
}

template <int PASS>
__device__ __forceinline__ void rg_item(CParams& p, Frame& F, int ci, int n) {
    const int tid = F.tid, lane = F.lane, wave = F.wave, q4 = lane >> 4, l15 = lane & 15;
    LAS unsigned char* xb = F.lds; LAS float* xf = (LAS float*)(F.lds + 17408); LAS float* Aa = (LAS float*)(F.lds + 50176);
    LAS float* Bx = (LAS float*)(F.lds + 82944); LAS float* Hs = (LAS float*)(F.lds + 115712); LAS float* h0 = (LAS float*)(F.lds + 148480);
    const int t0 = ci * 64;
    int seq_lo, seq_hi, c_lo, c_hi, seq; const bool samp = ci >= 128;
    if (!samp) { seq = ci >> 2; c_lo = seq * 4; c_hi = c_lo + 4; } else { seq = (ci - 128) >> 6; c_lo = 128 + seq * 64; c_hi = c_lo + 64; }
    seq_lo = c_lo * 64; seq_hi = c_hi * 64;
    {
        const int tg = tid >> 4, sub = tid & 15, ch = n * 128 + sub * 8, col = 4096 + ch;
        float w[4][8], acc[2][8];
#pragma unroll
        for (int j = 0; j < 4; ++j) { const f32x4 a = *(const f32x4*)(p.rg_conv_w + j * 1024 + ch), b = *(const f32x4*)(p.rg_conv_w + j * 1024 + ch + 4);
            w[j][0] = a[0]; w[j][1] = a[1]; w[j][2] = a[2]; w[j][3] = a[3]; w[j][4] = b[0]; w[j][5] = b[1]; w[j][6] = b[2]; w[j][7] = b[3]; }
        { const f32x4 a = *(const f32x4*)(p.rg_conv_b + ch), b = *(const f32x4*)(p.rg_conv_b + ch + 4);
#pragma unroll
          for (int i = 0; i < 2; ++i) { acc[i][0] = a[0]; acc[i][1] = a[1]; acc[i][2] = a[2]; acc[i][3] = a[3]; acc[i][4] = b[0]; acc[i][5] = b[1]; acc[i][6] = b[2]; acc[i][7] = b[3]; } }
        const int tb = t0 + tg * 2 - 2;
#pragma unroll
        for (int r = 0; r < 5; ++r) { const int tok = tb + r; u32x4 v = {0u, 0u, 0u, 0u};
            if (tok >= seq_lo && tok < seq_hi) v = *(const u32x4*)(F.PROJ() + (size_t)tok * NPROJ + col);
            float x[8]; unpack8(v, x);
#pragma unroll
            for (int j = 0; j < 4; ++j) { const int i = r - j; if (i >= 0 && i < 2) {
#pragma unroll
                for (int e = 0; e < 8; ++e) acc[i][e] += w[j][e] * x[e]; } } }
#pragma unroll
        for (int i = 0; i < 2; ++i) { const int c = tg * 2 + i;
            *(LAS u32x4*)(xb + c * 272 + sub * 16) = pack8(acc[i]);
            *(LAS f32x4*)(xf + c * 128 + sub * 8) = (f32x4){acc[i][0], acc[i][1], acc[i][2], acc[i][3]};
            *(LAS f32x4*)(xf + c * 128 + sub * 8 + 4) = (f32x4){acc[i][4], acc[i][5], acc[i][6], acc[i][7]}; }
    }
    if (PASS == 3 && tid < 256) {
        const int dd = tid >> 7, j = tid & 127, ch = n * 128 + j;
        float hh = samp ? p.state_rglru[(size_t)(seq * 2 + dd) * 1024 + ch] : 0.f;
        if (dd == 0) { for (int cc = c_lo; cc < ci; ++cc) { const float* ag = F.RGAGG() + (size_t)(cc * 2 + 0) * 2048; hh = ag[ch] * hh + ag[1024 + ch]; } }
        else { for (int cc = c_hi - 1; cc > ci; --cc) { const float* ag = F.RGAGG() + (size_t)(cc * 2 + 1) * 2048; hh = ag[ch] * hh + ag[1024 + ch]; } }
        h0[dd * 128 + j] = hh;
    }
    __syncthreads();
#pragma unroll 1
    for (int d = 0; d < 2; ++d) {
        {
            f32x4 ar[4], ai[4];
#pragma unroll
            for (int m = 0; m < 4; ++m) { ar[m] = (f32x4){0.f, 0.f, 0.f, 0.f}; ai[m] = (f32x4){0.f, 0.f, 0.f, 0.f}; }
            const bf16_t* gr = F.GT() + (size_t)((0 * 2 + d) * 8 + n) * 16384 + (size_t)(wave * 16 + l15) * 128 + q4 * 8;
            const bf16_t* gi = F.GT() + (size_t)((1 * 2 + d) * 8 + n) * 16384 + (size_t)(wave * 16 + l15) * 128 + q4 * 8;
#pragma unroll
            for (int ks = 0; ks < 4; ++ks) { const bf16x8 br = *(const bf16x8*)(gr + ks * 32), bi = *(const bf16x8*)(gi + ks * 32);
#pragma unroll
                for (int m = 0; m < 4; ++m) { const bf16x8 a = ldfrag(xb, 272, m * 16 + l15, ks * 64 + q4 * 16); ar[m] = MFMA16(a, br, ar[m]); ai[m] = MFMA16(a, bi, ai[m]); } }
            const int j = wave * 16 + l15, ch = n * 128 + j;
            const float br_ = p.rg_b_r[d * 1024 + ch], bi_ = p.rg_b_i[d * 1024 + ch], sp = softplusf_(-p.rg_lam[d * 1024 + ch]);
#pragma unroll
            for (int m = 0; m < 4; ++m)
#pragma unroll
                for (int r = 0; r < 4; ++r) { const int c = m * 16 + q4 * 4 + r;
                    const float rr = sigm(ar[m][r] + br_), ii = sigm(ai[m][r] + bi_);
                    const float la = -8.f * rr * sp; const float a = __expf(la);
                    const float bxv = sqrtf(-expm1f(2.f * la)) * (ii * xf[c * 128 + j]);
                    Aa[c * 128 + j] = a; Bx[c * 128 + j] = bxv; }
        }
        __syncthreads();
        if (tid < 128) {
            const int j = tid, ch = n * 128 + j;
            if (PASS == 1) {
                float A = 1.f, Bv = 0.f;
                if (d == 0) { for (int c = 0; c < 64; ++c) { const float a = Aa[c * 128 + j]; Bv = a * Bv + Bx[c * 128 + j]; A *= a; } }
                else { for (int c = 63; c >= 0; --c) { const float a = Aa[c * 128 + j]; Bv = a * Bv + Bx[c * 128 + j]; A *= a; } }
                float* ag = F.RGAGG() + (size_t)(ci * 2 + d) * 2048; ag[ch] = A; ag[1024 + ch] = Bv;
            } else {
                float hh = h0[d * 128 + j];
                if (d == 0) { for (int c = 0; c < 64; ++c) { hh = Aa[c * 128 + j] * hh + Bx[c * 128 + j]; Hs[c * 128 + j] = hh; }
                    if (!samp && ci == c_hi - 1) F.out[OUT_SR + (size_t)(seq * 2 + 0) * 1024 + ch] = (LIVE_MASK & 8) ? fin(hh) : 0.f; }
                else { for (int c = 63; c >= 0; --c) { hh = Aa[c * 128 + j] * hh + Bx[c * 128 + j]; Hs[c * 128 + j] += hh; }
                    if (!samp && ci == c_lo) F.out[OUT_SR + (size_t)(seq * 2 + 1) * 1024 + ch] = (LIVE_MASK & 8) ? fin(hh) : 0.f; }
            }
        }
        __syncthreads();
    }
    if (PASS == 3) {
#pragma unroll
        for (int i = 0; i < 2; ++i) { const int chunk = tid + 512 * i, c = chunk >> 4, cc = chunk & 15;
            const u32x4 gv = *(const u32x4*)(F.PROJ() + (size_t)(t0 + c) * NPROJ + 5120 + n * 128 + cc * 8);
            float g[8]; unpack8(gv, g);
            const f32x4 ha = *(const LAS f32x4*)(Hs + c * 128 + cc * 8), hb = *(const LAS f32x4*)(Hs + c * 128 + cc * 8 + 4);
            float o[8];
#pragma unroll
            for (int e = 0; e < 4; ++e) { o[e] = ha[e] * siluf_(g[e]); o[4 + e] = hb[e] * siluf_(g[4 + e]); }
            *(u32x4*)(F.MIX() + (size_t)(t0 + c) * 2048 + 1024 + n * 128 + cc * 8) = pack8(o); }
        __syncthreads();
    }
}

__device__ __forceinline__ void phase3(CParams& p, Frame& F) {
    for (int it = F.b; it < 2048; it += F.G) p3_delta_item(p, F, it >> 3, it & 7);
    for (int it = F.b; it < 2048; it += F.G) rg_item<1>(p, F, it >> 3, it & 7);
}

struct P4Pre { u32x4 k0, k1, q0, q1, ti, at; u32x2 v[4]; float g; };
__device__ __forceinline__ void p4_prefetch(const Frame& F, P4Pre& R, int ci, int h, int d, int sl, int seq_lo, int seq_hi) {
    const int tid = F.tid, t0 = ci * 64;
    { const int row = tid >> 4, cc = tid & 15;
      const size_t o0 = (size_t)(t0 + row) * 1024 + h * 128 + cc * 8, o1 = (size_t)(t0 + 32 + row) * 1024 + h * 128 + cc * 8;
      R.k0 = *(const u32x4*)(F.Kc() + o0); R.k1 = *(const u32x4*)(F.Kc() + o1); R.q0 = *(const u32x4*)(F.Qc() + o0); R.q1 = *(const u32x4*)(F.Qc() + o1); }
    { const bf16_t* ta = F.TA() + (size_t)(ci * 8 + h) * 8192; R.ti = *(const u32x4*)(ta + tid * 8); R.at = *(const u32x4*)(ta + 4096 + tid * 8); }
    { const int c = tid >> 3, e0 = (tid & 7) * 4;
#pragma unroll
      for (int j = 0; j < 4; ++j) { const int tok = t0 + c - 2 + j; u32x2 v = {0u, 0u};
          if (tok >= seq_lo && tok < seq_hi) v = *(const u32x2*)(F.PROJ() + (size_t)tok * NPROJ + 2048 + h * 128 + sl * 32 + e0);
          R.v[j] = v; } }
    R.g = 0.f;
    if (tid < 128) R.g = F.GB()[(size_t)(ci * 8 + h) * 256 + (tid >> 6) * 128 + d * 64 + (tid & 63)];
}
__device__ __forceinline__ u32x4 tri_mask(u32x4 v, int c, int s0, int d) {
    unsigned w[4] = {v.x, v.y, v.z, v.w};
#pragma unroll
    for (int i = 0; i < 4; ++i) { const int slo = s0 + 2 * i, shi = slo + 1;
        const bool klo = d == 0 ? (c >= slo) : (c <= slo), khi = d == 0 ? (c >= shi) : (c <= shi);
        w[i] &= (klo ? 0x0000FFFFu : 0u) | (khi ? 0xFFFF0000u : 0u); }
    return (u32x4){w[0], w[1], w[2], w[3]};
}
__device__ __forceinline__ void p4_item(CParams& p, Frame& F, int samp, int seq, int h, int d, int sl) {
    const int tid = F.tid, lane = F.lane, wave = F.wave, q4 = lane >> 4, l15 = lane & 15;
    LAS unsigned char* Ks = F.lds; LAS unsigned char* Qs = F.lds + 17408; LAS unsigned char* TIs = F.lds + 34816; LAS unsigned char* ATs = F.lds + 44032;
    LAS unsigned char* Sb = F.lds + 53248; LAS unsigned char* Rt = F.lds + 61952; LAS unsigned char* Vt1 = F.lds + 66560; LAS unsigned char* Vt2 = F.lds + 71168;
    LAS float* Vs = (LAS float*)(F.lds + 75776); LAS float* gv = (LAS float*)(F.lds + 83968); LAS float* bv = gv + 64;
    const int nch = samp ? 64 : 4, chunk0 = samp ? 128 + seq * 64 : seq * 4, seq_lo = chunk0 * 64, seq_hi = seq_lo + nch * 64;
    f32x4 S[2];
#pragma unroll
    for (int nt = 0; nt < 2; ++nt)
#pragma unroll
        for (int r = 0; r < 4; ++r)
            S[nt][r] = samp ? p.state_delta[(size_t)((seq * 2 + d) * 8 + h) * 16384 + (size_t)(wave * 16 + q4 * 4 + r) * 128 + sl * 32 + nt * 16 + l15] : 0.f;
#pragma unroll
    for (int nt = 0; nt < 2; ++nt) { u32x2 o; o.x = pk2(S[nt][0], S[nt][1]); o.y = pk2(S[nt][2], S[nt][3]); *(LAS u32x2*)(Sb + (nt * 16 + l15) * 272 + (wave * 16 + q4 * 4) * 2) = o; }
    float cw[4][4];
    { const int e0 = (tid & 7) * 4;
#pragma unroll
      for (int j = 0; j < 4; ++j) { const f32x4 a = *(const f32x4*)(p.dn_conv_w + j * 3072 + 2048 + h * 128 + sl * 32 + e0); cw[j][0] = a[0]; cw[j][1] = a[1]; cw[j][2] = a[2]; cw[j][3] = a[3]; } }
    P4Pre R;
    p4_prefetch(F, R, d == 0 ? chunk0 : chunk0 + nch - 1, h, d, sl, seq_lo, seq_hi);
#pragma unroll 1
    for (int step = 0; step < nch; ++step) {
        const int ci = d == 0 ? chunk0 + step : chunk0 + nch - 1 - step, t0 = ci * 64;
        { const int row = tid >> 4, cc = tid & 15;
          *(LAS u32x4*)(Ks + row * 272 + cc * 16) = R.k0; *(LAS u32x4*)(Ks + (32 + row) * 272 + cc * 16) = R.k1;
          *(LAS u32x4*)(Qs + row * 272 + cc * 16) = R.q0; *(LAS u32x4*)(Qs + (32 + row) * 272 + cc * 16) = R.q1; }
        { const int c = tid >> 3, s0 = (tid & 7) * 8;
          *(LAS u32x4*)(TIs + c * 144 + s0 * 2) = tri_mask(R.ti, c, s0, d); *(LAS u32x4*)(ATs + c * 144 + s0 * 2) = tri_mask(R.at, c, s0, d); }
        { const int c = tid >> 3, e0 = (tid & 7) * 4; float o[4] = {0.f, 0.f, 0.f, 0.f};
#pragma unroll
          for (int j = 0; j < 4; ++j) { const u32x2 v = R.v[j];
              o[0] += cw[j][0] * __uint_as_float(v.x << 16); o[1] += cw[j][1] * __uint_as_float(v.x & 0xffff0000u);
              o[2] += cw[j][2] * __uint_as_float(v.y << 16); o[3] += cw[j][3] * __uint_as_float(v.y & 0xffff0000u); }
          CHK(F, 9, badv(o[0], 1000.f) || badv(o[3], 1000.f));
          *(LAS f32x4*)(Vs + c * 32 + e0) = (f32x4){siluf_(o[0]), siluf_(o[1]), siluf_(o[2]), siluf_(o[3])}; }
        if (tid < 128) gv[tid] = R.g;
        if (step + 1 < nch) p4_prefetch(F, R, d == 0 ? ci + 1 : ci - 1, h, d, sl, seq_lo, seq_hi);
        __syncthreads();
        const int prod = wave >> 2, mt = wave & 3;
        f32x4 acc[2] = {(f32x4){0.f, 0.f, 0.f, 0.f}, (f32x4){0.f, 0.f, 0.f, 0.f}};
        { const LAS unsigned char* base = prod ? Qs : Ks;
#pragma unroll
          for (int ks = 0; ks < 4; ++ks) { const bf16x8 a = ldfrag(base, 272, mt * 16 + l15, ks * 64 + q4 * 16);
#pragma unroll
              for (int nt = 0; nt < 2; ++nt) { const bf16x8 b = ldfrag(Sb, 272, nt * 16 + l15, ks * 64 + q4 * 16); acc[nt] = MFMA16(a, b, acc[nt]); } } }
        if (prod == 0) {
#pragma unroll
            for (int nt = 0; nt < 2; ++nt) { const int e = nt * 16 + l15; float rv[4];
#pragma unroll
                for (int r = 0; r < 4; ++r) { const int c = mt * 16 + q4 * 4 + r; rv[r] = bv[c] * (Vs[c * 32 + e] - __expf(gv[c]) * acc[nt][r]); }
                u32x2 o; o.x = pk2(rv[0], rv[1]); o.y = pk2(rv[2], rv[3]); *(LAS u32x2*)(Rt + e * 144 + (mt * 16 + q4 * 4) * 2) = o; }
        } else {
#pragma unroll
            for (int nt = 0; nt < 2; ++nt)
#pragma unroll
                for (int r = 0; r < 4; ++r) { const int c = mt * 16 + q4 * 4 + r; acc[nt][r] *= __expf(gv[c]); }
        }
        __syncthreads();
        const float glast = d == 0 ? gv[63] : gv[0];
        { const int m3 = wave & 3, n3 = wave >> 2;
          f32x4 vn = {0.f, 0.f, 0.f, 0.f};
#pragma unroll
          for (int ks = 0; ks < 2; ++ks) { const bf16x8 a = ldfrag(TIs, 144, m3 * 16 + l15, ks * 64 + q4 * 16), b = ldfrag(Rt, 144, n3 * 16 + l15, ks * 64 + q4 * 16); vn = MFMA16(a, b, vn); }
          const int e = n3 * 16 + l15, c0 = m3 * 16 + q4 * 4;
          if (!samp) CHK(F, 10 + (step < 3 ? step : 3), badv(vn[0], 200.f) || badv(vn[3], 200.f));
          u32x2 o1, o2; o1.x = pk2(vn[0], vn[1]); o1.y = pk2(vn[2], vn[3]);
          o2.x = pk2(vn[0] * __expf(glast - gv[c0]), vn[1] * __expf(glast - gv[c0 + 1])); o2.y = pk2(vn[2] * __expf(glast - gv[c0 + 2]), vn[3] * __expf(glast - gv[c0 + 3]));
          *(LAS u32x2*)(Vt1 + e * 144 + c0 * 2) = o1; *(LAS u32x2*)(Vt2 + e * 144 + c0 * 2) = o2; }
        __syncthreads();
        if (prod == 1) {
#pragma unroll
            for (int ks = 0; ks < 2; ++ks) { const bf16x8 a = ldfrag(ATs, 144, mt * 16 + l15, ks * 64 + q4 * 16);
#pragma unroll
                for (int nt = 0; nt < 2; ++nt) { const bf16x8 b = ldfrag(Vt1, 144, nt * 16 + l15, ks * 64 + q4 * 16); acc[nt] = MFMA16(a, b, acc[nt]); } }
#pragma unroll
            for (int nt = 0; nt < 2; ++nt)
#pragma unroll
                for (int r = 0; r < 4; ++r) F.PROJ()[(size_t)(t0 + mt * 16 + q4 * 4 + r) * NPROJ + d * 1024 + h * 128 + sl * 32 + nt * 16 + l15] = f2bf(acc[nt][r]);
        }
        { const float gl = __expf(glast);
#pragma unroll
          for (int nt = 0; nt < 2; ++nt) S[nt] *= gl;
#pragma unroll
          for (int ks = 0; ks < 2; ++ks) { bf16x8 a;
#pragma unroll
              for (int j = 0; j < 8; ++j) a[j] = *(const LAS short*)(Ks + (ks * 32 + q4 * 8 + j) * 272 + (wave * 16 + l15) * 2);
#pragma unroll
              for (int nt = 0; nt < 2; ++nt) { const bf16x8 b = ldfrag(Vt2, 144, nt * 16 + l15, ks * 64 + q4 * 16); S[nt] = MFMA16(a, b, S[nt]); } }
#pragma unroll
          for (int nt = 0; nt < 2; ++nt) { u32x2 o; o.x = pk2(S[nt][0], S[nt][1]); o.y = pk2(S[nt][2], S[nt][3]); *(LAS u32x2*)(Sb + (nt * 16 + l15) * 272 + (wave * 16 + q4 * 4) * 2) = o; } }
        __syncthreads();
    }
    if (!samp) {
        CHK(F, 14, badv(S[0][0], 100.f) || badv(S[1][3], 100.f));
#pragma unroll
        for (int nt = 0; nt < 2; ++nt)
#pragma unroll
            for (int r = 0; r < 4; ++r)
                F.out[OUT_SD + (size_t)((seq * 2 + d) * 8 + h) * 16384 + (size_t)(wave * 16 + q4 * 4 + r) * 128 + sl * 32 + nt * 16 + l15] = (LIVE_MASK & 4) ? fin(S[nt][r]) : 0.f;
    }
}
__device__ __forceinline__ void p4_run(CParams& p, Frame& F, int item) {
    if (item < 128) { const int chain = item >> 2; p4_item(p, F, 1, chain >> 4, (chain >> 1) & 7, chain & 1, item & 3); }
    else { const int it = item - 128, chain = it >> 2; p4_item(p, F, 0, chain >> 4, (chain >> 1) & 7, chain & 1, it & 3); }
}
__device__ __forceinline__ void phase4(CParams& p, Frame& F) {
    if (F.G == 256) {
        if ((F.b & 1) == 0) p4_run(p, F, F.b >> 1);
        else { const int pb = F.b >> 1; for (int i = 0; i < 16; ++i) p4_run(p, F, 128 + pb * 16 + i); }
    } else {
        for (int it = F.b; it < 128 + 2048; it += F.G) p4_run(p, F, it);
    }
}

__device__ __forceinline__ void phase5(CParams& p, Frame& F) {
    const int lane = F.lane;
    float nw[16];
#pragma unroll
    for (int q = 0; q < 4; ++q) { const f32x4 a = *(const f32x4*)(p.dn_norm_w + (lane & 7) * 16 + q * 4); nw[q * 4] = a[0]; nw[q * 4 + 1] = a[1]; nw[q * 4 + 2] = a[2]; nw[q * 4 + 3] = a[3]; }
    for (int tok = F.b * 8 + F.wave; tok < NTOK; tok += F.G * 8) {
        const bf16_t* pr = F.PROJ() + (size_t)tok * NPROJ + lane * 16;
        float o[16], z[16]; float ss = 0.f;
#pragma unroll
        for (int hf = 0; hf < 2; ++hf) { const u32x4 a = *(const u32x4*)(pr + hf * 8), b = *(const u32x4*)(pr + 1024 + hf * 8), zz = *(const u32x4*)(pr + 3072 + hf * 8);
            float fa[8], fb[8], fz[8]; unpack8(a, fa); unpack8(b, fb); unpack8(zz, fz);
#pragma unroll
            for (int e = 0; e < 8; ++e) { o[hf * 8 + e] = fa[e] + fb[e]; z[hf * 8 + e] = fz[e]; ss += o[hf * 8 + e] * o[hf * 8 + e]; } }
        ss += __shfl_xor(ss, 1); ss += __shfl_xor(ss, 2); ss += __shfl_xor(ss, 4);
        const float rs = rsqrtf(ss * (1.f / 128.f) + 1e-6f);
#pragma unroll
        for (int hf = 0; hf < 2; ++hf) { float w[8];
#pragma unroll
            for (int e = 0; e < 8; ++e) w[e] = o[hf * 8 + e] * rs * nw[hf * 8 + e] * siluf_(z[hf * 8 + e]);
            *(u32x4*)(F.MIX() + (size_t)tok * 2048 + lane * 16 + hf * 8) = pack8(w); }
    }
    __syncthreads();
    for (int it = F.b; it < 2048; it += F.G) rg_item<3>(p, F, it >> 3, it & 7);
}

__device__ __forceinline__ void phase6(CParams& p, Frame& F) {
    pg8::Gemm g{F.MIX(), F.WoutT(), NTOK, 1024, 2048}; pg8::StaticOrder S; S.init(NTOK, 1024, F.G, F.b); pg8::EpiF32 E{(float*)F.PROJ(), 3072};
    pg8::gemm_phase<pg8::EpiF32, pg8::StaticOrder>(F.lds, g, S, E);
}

__device__ __forceinline__ void phase7(CParams& p, Frame& F) {
    LAS float* gt = (LAS float*)F.lds;
    for (int tb = F.b; tb < 256; tb += F.G) {
        const int grp = grp_of_block(tb);
        for (int j = F.tid; j < 1024; j += 512) gt[j] = mod_val(p, F, grp, 2048 + j) * p.post_w[j];
        __syncthreads();
        for (int i = 0; i < 8; ++i) {
            const int tok = tb * 64 + F.wave * 8 + i;
            const float* xr = tok < 8192 ? p.x_prompt + (size_t)tok * 1024 : p.x_sample + (size_t)(tok - 8192) * 1024;
            const float* yr = (const float*)F.PROJ() + (size_t)tok * 3072;
            f32x4 y[4]; float ss = 0.f;
#pragma unroll
            for (int q = 0; q < 4; ++q) { y[q] = *(const f32x4*)(yr + F.lane * 4 + 256 * q); ss += (y[q][0] * y[q][0] + y[q][1] * y[q][1]) + (y[q][2] * y[q][2] + y[q][3] * y[q][3]); }
            const float rstd = rsqrtf(wave_sum(ss) * (1.f / 1024.f) + 1e-6f);
#pragma unroll
            for (int q = 0; q < 4; ++q) { const int j = F.lane * 4 + 256 * q; f32x4 v = *(const f32x4*)(xr + j);
                if (tok >= 8192) { const int pp = (tok - 8192) & 4095; const int vv = (q < 2) ? (pp >> 6) : (pp & 63);
                    v += *(const f32x4*)(F.pe() + ((q & 1) ? 16384 : 0) + vv * 256 + F.lane * 4); }
                const f32x4 g4 = *(const LAS f32x4*)(gt + j);
                f32x4 ov = v + g4 * (y[q] * rstd); ov[0] = fin(ov[0]); ov[1] = fin(ov[1]); ov[2] = fin(ov[2]); ov[3] = fin(ov[3]); if (!(LIVE_MASK & 1)) ov = (f32x4){0.f, 0.f, 0.f, 0.f}; *(f32x4*)(F.out + (size_t)tok * 1024 + j) = ov; }
        }
        __syncthreads();
    }
}

__device__ __forceinline__ void phase8(CParams& p, Frame& F) {
    if (F.b == 0 && F.tid == 0) { int code = 0; for (int k = 31; k >= 1; --k) if (DG(F)[k]) code = k; F.out[OUT_SR] = 1000.f * (float)code + 500.f; }
}
extern __shared__ __attribute__((aligned(16))) unsigned char smem_raw[];
__global__ void __launch_bounds__(512) fwd_megakernel(Params p_unused) {
    CParams& p = *(CParams*)__builtin_amdgcn_kernarg_segment_ptr();
    Frame F;
    F.lds = (LAS unsigned char*)smem_raw;
    F.tid = threadIdx.x; F.lane = F.tid & 63; F.wave = __builtin_amdgcn_readfirstlane(F.tid >> 6); F.G = gridDim.x; F.b = blockIdx.x;
    F.out = p.out; F.ws = p.ws;
    volatile LAS unsigned* xbw = (volatile LAS unsigned*)(F.lds + LDS_BYTES - 16);
    const bool multi = (p.ph_hi - p.ph_lo) > 1;
    XcdBarrier xb; xb.bar = (unsigned*)(p.ws + WS_CTL); xb.x = 0; xb.st = xbw;
    if (multi) {
        if (F.tid == 0) { xbw[0] = 0u; xbw[1] = 0u; xbw[2] = 0u; xbw[3] = 0u; }
        __syncthreads();
        xb = xcd_barrier_post((unsigned*)(p.ws + WS_CTL), xbw);
    }
#ifndef PHMASK
#define PHMASK 511
#endif
    const int lo = p.ph_lo, hi = p.ph_hi;
#define RUN_PHASE(k, fn) do { if (lo <= (k) && (k) < hi) { if (PHMASK & (1 << (k))) fn(p, F); if ((k) + 1 < hi) xcd_barrier(xb); } } while (0)
    RUN_PHASE(0, phase0); RUN_PHASE(1, phase1); RUN_PHASE(2, phase2); RUN_PHASE(3, phase3);
    RUN_PHASE(4, phase4); RUN_PHASE(5, phase5); RUN_PHASE(6, phase6); RUN_PHASE(7, phase7); RUN_PHASE(8, phase8);
}

extern "C" void kernel_launch(void* const* d_in, const int* in_sizes, int n_in, void* d_out, int out_size, void* d_ws, size_t ws_size, hipStream_t stream) {
    static int grid = 0;
    if (grid == 0) {
        int dev = 0, cus = 0;
        if (hipGetDevice(&dev) != hipSuccess || hipDeviceGetAttribute(&cus, hipDeviceAttributeMultiprocessorCount, dev) != hipSuccess) { fprintf(stderr, "kernel_launch: device query failed\n"); grid = -1; return; }
        if (hipFuncSetAttribute((const void*)fwd_megakernel, hipFuncAttributeMaxDynamicSharedMemorySize, LDS_BYTES) != hipSuccess) { fprintf(stderr, "kernel_launch: hipFuncSetAttribute failed\n"); grid = -1; return; }
        int per_cu = 0;
        if (hipOccupancyMaxActiveBlocksPerMultiprocessor(&per_cu, (const void*)fwd_megakernel, 512, LDS_BYTES) != hipSuccess || per_cu < 1) { fprintf(stderr, "kernel_launch: occupancy query says %d blocks per CU\n", per_cu); (void)hipGetLastError(); }
        grid = cus;
    }
    if (grid < 0) return;
    Params p{};
    const float** pp = (const float**)&p;
    for (int i = 0; i < 23; ++i) pp[i] = (const float*)d_in[i];
    p.out = (float*)d_out; p.ws = (unsigned char*)d_ws;
    (void)hipMemsetAsync((char*)d_ws + WS_CTL, 0, 16384, stream);
#if MK_SINGLE
    p.ph_lo = 0; p.ph_hi = NPH;
    void* args[] = {&p};
    hipError_t e = hipLaunchCooperativeKernel((const void*)fwd_megakernel, dim3(grid), dim3(512), args, LDS_BYTES, stream);
    if (e != hipSuccess) fprintf(stderr, "cooperative launch failed: %s (grid %d)\n", hipGetErrorString(e), grid);
#else
    for (int ph = 0; ph < NPH; ++ph) {
        p.ph_lo = ph; p.ph_hi = ph + 1;
        hipLaunchKernelGGL(fwd_megakernel, dim3(grid), dim3(512), LDS_BYTES, stream, p);
    }
#endif
}
```

```cpp
#include <hip/hip_runtime.h>
#include <cstdio>
#include <cstdint>

#define LAS __attribute__((address_space(3)))
typedef unsigned short bf16_t;
typedef short bf16x8 __attribute__((ext_vector_type(8)));
typedef float f32x4 __attribute__((ext_vector_type(4)));
typedef unsigned u32x4 __attribute__((ext_vector_type(4)));
typedef unsigned u32x2 __attribute__((ext_vector_type(2)));

#ifndef MK_SINGLE
#define MK_SINGLE 1
#endif

constexpr int NTOK = 16384, DM = 1024, NPROJ = 6144, DIN = 6176;
constexpr int NPH = 8;
constexpr int LDS_BYTES = 160 * 1024;
constexpr size_t OUT_YP = 0, OUT_YS = 8388608, OUT_SD = 16777216, OUT_SR = 25165824;
constexpr size_t WS_CTL = 0, WS_MODP = 16384, WS_PE = 606208, WS_BA = 737280, WS_GB = 2834432, WS_RGAGG = 4931584,
                 WS_WBAT = 9125888, WS_WOUTT = 9191424, WS_GT = 13385728, WS_WINT = 14434304, WS_TA = 27017216, WS_PROJ = 60571648, WS_CARRY = 261898240;

struct Params {
    const float *x_prompt, *x_sample, *state_delta, *state_rglru, *c, *c_ctx, *ada_w, *ada_b, *pre_w, *post_w, *w_in, *w_out,
                *dn_conv_w, *dn_a_log, *dn_dt_bias, *dn_norm_w, *rg_conv_w, *rg_conv_b, *rg_w_r, *rg_b_r, *rg_w_i, *rg_b_i, *rg_lam;
    float* out; unsigned char* ws;
    int ph_lo, ph_hi;
};

__device__ __forceinline__ float bf2f(unsigned short b) { return __uint_as_float(((unsigned)b) << 16); }
__device__ __forceinline__ unsigned short f2bf(float f) { unsigned u = __float_as_uint(f); u += 0x7FFFu + ((u >> 16) & 1u); return (unsigned short)(u >> 16); }
__device__ __forceinline__ unsigned pk2(float lo, float hi) { return (unsigned)f2bf(lo) | ((unsigned)f2bf(hi) << 16); }
#ifndef SANITIZE
#define SANITIZE 0
#endif
#ifndef LIVE_MASK
#define LIVE_MASK 15
#endif
__device__ __forceinline__ float fin(float x) { return (SANITIZE && ((__float_as_uint(x) & 0x7f800000u) == 0x7f800000u)) ? 0.f : x; }
#define DG(F) ((unsigned*)((F).ws + WS_CTL))
__device__ __forceinline__ bool badv(float x, float lim) { return ((__float_as_uint(x) & 0x7f800000u) == 0x7f800000u) || fabsf(x) > lim; }
#ifndef DIAG
#define DIAG 0
#endif
#define CHK(F, k, bad) do { if (DIAG && (bad)) DG(F)[k] = 1u; } while (0)
__device__ __forceinline__ float sigm(float x) { return 1.f / (1.f + __expf(-x)); }
__device__ __forceinline__ float siluf_(float x) { return x / (1.f + __expf(-x)); }
__device__ __forceinline__ float softplusf_(float x) { return x > 20.f ? x : log1pf(__expf(x)); }
__device__ __forceinline__ void unpack8(const u32x4 v, float (&f)[8]) {
    f[0] = __uint_as_float(v.x << 16); f[1] = __uint_as_float(v.x & 0xffff0000u);
    f[2] = __uint_as_float(v.y << 16); f[3] = __uint_as_float(v.y & 0xffff0000u);
    f[4] = __uint_as_float(v.z << 16); f[5] = __uint_as_float(v.z & 0xffff0000u);
    f[6] = __uint_as_float(v.w << 16); f[7] = __uint_as_float(v.w & 0xffff0000u);
}
__device__ __forceinline__ u32x4 pack8(const float (&f)[8]) { u32x4 o; o.x = pk2(f[0], f[1]); o.y = pk2(f[2], f[3]); o.z = pk2(f[4], f[5]); o.w = pk2(f[6], f[7]); return o; }
__device__ __forceinline__ float wave_sum(float v) {
#pragma unroll
    for (int o = 1; o < 64; o <<= 1) v += __shfl_xor(v, o);
    return v;
}
#define MFMA16(a, b, c) __builtin_amdgcn_mfma_f32_16x16x32_bf16((a), (b), (c), 0, 0, 0)
#define LDS_WAIT() asm volatile("s_waitcnt lgkmcnt(0)" ::: "memory")
__device__ __forceinline__ bf16x8 ldfrag(const LAS unsigned char* base, int pitch, int row, int kb) { return *(const LAS bf16x8*)(base + row * pitch + kb); }

#define XB_TMO      128
#define XB_XCNT(j)  (256  + 64 * (j))
#define XB_XSUB(j)  (1280 + 64 * (j))
#define XB_XGEN(j)  (2304 + 64 * (j))
#define XB_TOP      3328
#define XB_TOPGEN   3392
#define XCD_BAR_WORDS 3456
#define XB_SPIN_CAP (1u << 18)
__device__ __forceinline__ unsigned xb_ld(unsigned* p)              { return __hip_atomic_load(p, __ATOMIC_RELAXED, __HIP_MEMORY_SCOPE_AGENT); }
__device__ __forceinline__ unsigned xb_add(unsigned* p, unsigned v) { return __hip_atomic_fetch_add(p, v, __ATOMIC_RELAXED, __HIP_MEMORY_SCOPE_AGENT); }
__device__ __forceinline__ unsigned xb_xcc_id() { return (unsigned)__builtin_amdgcn_s_getreg((3 << 11) | 20) & 0xFu; }
#define XB_SPIN(cond, bar) do { unsigned _sp = 0; while (cond) { __builtin_amdgcn_s_sleep(1); \
    if ((++_sp & 255u) == 0u) { if (xb_ld(&(bar)[XB_TMO])) break; if (_sp > XB_SPIN_CAP) { atomicAdd(&(bar)[XB_TMO], 1u); break; } } } } while (0)
struct XcdBarrier { unsigned* bar; unsigned x; volatile LAS unsigned* st; };
__device__ __forceinline__ XcdBarrier xcd_barrier_post(unsigned* bar, volatile LAS unsigned* st) {
    XcdBarrier b; b.bar = bar; b.x = xb_xcc_id(); b.st = st;
    if (threadIdx.x == 0) (void)xb_add(&bar[XB_XCNT(b.x)], 1u);
    return b;
}
__device__ __forceinline__ void xcd_barrier_complete(unsigned* bar, unsigned x, unsigned& nloc, unsigned& nx) {
    const unsigned G = gridDim.x * gridDim.y * gridDim.z;
    unsigned sum, cnt, mine, sp = 0u;
    for (;;) {
        sum = 0u; cnt = 0u; mine = 0u;
#pragma unroll
        for (unsigned j = 0; j < 16; ++j) { const unsigned c = xb_ld(&bar[XB_XCNT(j)]); sum += c; cnt += (c > 0u) ? 1u : 0u; mine = (j == x) ? c : mine; }
        if (sum == G) break;
        __builtin_amdgcn_s_sleep(1);
        if ((++sp & 255u) == 0u) { if (xb_ld(&bar[XB_TMO])) break; if (sp > XB_SPIN_CAP) { atomicAdd(&bar[XB_TMO], 1u); break; } }
    }
    nloc = mine > 0u ? mine : 1u; nx = cnt > 0u ? cnt : 1u;
}
__device__ __forceinline__ void xcd_barrier(const XcdBarrier& b) {
    asm volatile("s_waitcnt vmcnt(0)" ::: "memory");
    __syncthreads();
    if (threadIdx.x == 0) {
        unsigned* bar = b.bar;
        __builtin_amdgcn_s_waitcnt(0);
        unsigned nloc = b.st[0], nx = b.st[1];
        if (nloc == 0u) { xcd_barrier_complete(bar, b.x, nloc, nx); b.st[0] = nloc; b.st[1] = nx; }
        const unsigned old = xb_add(&bar[XB_XSUB(b.x)], 1u);
        const unsigned gen = old / nloc;
        if (old + 1u == (gen + 1u) * nloc) {
            __builtin_amdgcn_fence(__ATOMIC_RELEASE, "agent");
            asm volatile("s_waitcnt vmcnt(0)" ::: "memory");
            const unsigned og = xb_add(&bar[XB_TOP], 1u);
            const unsigned tg = og / nx;
            if (og + 1u == (tg + 1u) * nx) xb_add(&bar[XB_TOPGEN], 1u);
            else XB_SPIN(xb_ld(&bar[XB_TOPGEN]) == tg, bar);
            __builtin_amdgcn_fence(__ATOMIC_ACQUIRE, "agent");
            xb_add(&bar[XB_XGEN(b.x)], 1u);
            asm volatile("s_waitcnt vmcnt(0)" ::: "memory");
        } else {
            XB_SPIN(xb_ld(&bar[XB_XGEN(b.x)]) == gen, bar);
            __builtin_amdgcn_fence(__ATOMIC_ACQUIRE, "agent");
            asm volatile("s_waitcnt vmcnt(0)" ::: "memory");
        }
    }
    __syncthreads();
}

namespace pg8 {
constexpr int BM = 256, BK = 64, HALF = 128, HTB = HALF * BK * 2, STAGE_BYTES = 8 * HTB, NXCD = 8, WGM = 8;
__host__ __device__ __forceinline__ int lds_byte(int r, int c) { const int st = (r >> 4) * 2 + (c >> 5), rr = r & 15, cc = c & 31, ob = rr * 64 + cc * 2; return st * 1024 + (ob ^ (((ob >> 9) & 1) << 5)); }
__host__ __device__ __forceinline__ void stage_rc(int b, int& R, int& C) { const int st = b / 1024, sb = b % 1024, swz = sb ^ (((sb >> 9) & 1) << 5); R = (st >> 1) * 16 + swz / 64; C = (st & 1) * 32 + (swz % 64) / 2; }
__host__ __device__ __forceinline__ int perm32(int rho) { const int n = rho >> 4, i = rho & 15; return 8 * (i >> 2) + 4 * n + (i & 3); }
struct Unit { int pm, pn; };
struct Gemm { const bf16_t* A; const bf16_t* Bt; int M, N, K; };
struct StaticOrder {
    int nM, nN, nwg, G, c;
    __host__ __device__ void init(int M, int N, int G_, int c_) { nM = M / BM; nN = N / BM; nwg = nM * nN; G = G_; c = c_; }
    __host__ __device__ bool next(int i, Unit& u) const {
        const long L = (long)i * G + c; if (L >= nwg) return false;
        int wgid = (int)L; { const int q = nwg / NXCD, r = nwg % NXCD, xcd = wgid % NXCD, off = wgid / NXCD; wgid = (xcd < r ? xcd * (q + 1) : r * (q + 1) + (xcd - r) * q) + off; }
        const int nig = WGM * nN, gid = wgid / nig, fm = gid * WGM, gsz = (nM - fm) < WGM ? (nM - fm) : WGM;
        u.pm = fm + ((wgid % nig) % gsz); u.pn = (wgid % nig) / gsz; return true;
    }
};
__device__ __forceinline__ unsigned cvt_pk_bf16(float lo, float hi) { unsigned r; asm volatile("v_cvt_pk_bf16_f32 %0, %1, %2" : "=v"(r) : "v"(lo), "v"(hi)); return r; }
struct EpiF32 {
    static constexpr bool PERM = false;
    float* C; int ldc;
    __device__ __forceinline__ void operator()(const f32x4 (&acc)[2][2][4][2], const Unit& u, int wr, int wc, int fr, int fq) const {
        const int row0 = u.pm * BM + wr * 64 + fr, col0 = u.pn * BM + wc * 32 + 4 * fq;
#pragma unroll
        for (int ai = 0; ai < 2; ++ai)
#pragma unroll
            for (int m = 0; m < 4; ++m) { float* rowp = C + (size_t)(row0 + ai * HALF + m * 16) * ldc + col0;
#pragma unroll
                for (int bj = 0; bj < 2; ++bj)
#pragma unroll
                    for (int n = 0; n < 2; ++n) *(f32x4*)(rowp + bj * HALF + n * 16) = acc[ai][bj][m][n]; }
    }
};
struct EpiBf16 {
    static constexpr bool PERM = true;
    bf16_t* O; int ldc;
    __device__ __forceinline__ void operator()(const f32x4 (&acc)[2][2][4][2], const Unit& u, int wr, int wc, int fr, int fq) const {
        const int row0 = u.pm * BM + wr * 64 + fr; const int col0 = u.pn * BM + wc * 32 + 8 * fq;
#pragma unroll
        for (int ai = 0; ai < 2; ++ai)
#pragma unroll
            for (int m = 0; m < 4; ++m) { bf16_t* rowp = O + (size_t)(row0 + ai * HALF + m * 16) * ldc + col0;
#pragma unroll
                for (int bj = 0; bj < 2; ++bj) { const f32x4 v0 = acc[ai][bj][m][0], v1 = acc[ai][bj][m][1];
                    u32x4 w; w.x = cvt_pk_bf16(v0[0], v0[1]); w.y = cvt_pk_bf16(v0[2], v0[3]); w.z = cvt_pk_bf16(v1[0], v1[1]); w.w = cvt_pk_bf16(v1[2], v1[3]);
                    *(u32x4*)(rowp + bj * HALF) = w; } }
    }
};

template <class Epi, class Sched>
__device__ __forceinline__ void gemm_phase(LAS unsigned char* lds, const Gemm g, const Sched& S, const Epi& E) {
    const int tid = threadIdx.x, wid = __builtin_amdgcn_readfirstlane(tid >> 6), lane = tid & 63, wr = wid >> 2, wc = wid & 3, fr = lane & 15, fq = lane >> 4;
    const int K = g.K, nt = K / BK;
    unsigned voffA[2], voffB[2];
#pragma unroll
    for (int i = 0; i < 2; ++i) { int R, C; stage_rc(tid * 16 + i * 8192, R, C); const int Rb = Epi::PERM ? ((R & ~31) + perm32(R & 31)) : R;
        voffA[i] = (unsigned)(R * K + C) * 2u; voffB[i] = (unsigned)(Rb * K + C) * 2u; }
    const size_t kstep = (size_t)(BK * 2);
    const size_t hstep = (size_t)HALF * K * 2;
    const size_t tstep = 2 * hstep;
    const unsigned ldsw = (unsigned)wid * 1024u;
    const int aoff = lds_byte(wr * 64 + fr, fq * 8), boff = lds_byte(wc * 32 + fr, fq * 8);
#define PG8_SA(b, h) (((b) * 2 + (h)) * HTB)
#define PG8_SB(b, h) ((4 + (b) * 2 + (h)) * HTB)
#define PG8_STAGE(bufoff, gbase, voff) do { _Pragma("unroll") for (int _i = 0; _i < 2; ++_i) \
        __builtin_amdgcn_global_load_lds((const unsigned*)((const char*)(gbase) + (voff)[_i]), (LAS unsigned*)(lds + (bufoff) + ldsw + _i * 8192), 16, 0, 0); } while (0)
#define PG8_LDA(dst, b, h) do { _Pragma("unroll") for (int m = 0; m < 4; ++m) _Pragma("unroll") for (int k = 0; k < 2; ++k) dst[m][k] = *(const LAS bf16x8*)(lds + PG8_SA(b, h) + aoff + m * 2048 + k * 1024); } while (0)
#define PG8_LDB(dst, b, h) do { _Pragma("unroll") for (int n = 0; n < 2; ++n) _Pragma("unroll") for (int k = 0; k < 2; ++k) dst[n][k] = *(const LAS bf16x8*)(lds + PG8_SB(b, h) + boff + n * 2048 + k * 1024); } while (0)
#define PG8_MMA(ai, bj, At, Bt) do { __builtin_amdgcn_s_setprio(1); _Pragma("unroll") for (int m = 0; m < 4; ++m) _Pragma("unroll") for (int n = 0; n < 2; ++n) _Pragma("unroll") for (int k = 0; k < 2; ++k) \
        acc[ai][bj][m][n] = __builtin_amdgcn_mfma_f32_16x16x32_bf16(Bt[n][k], At[m][k], acc[ai][bj][m][n], 0, 0, 0); __builtin_amdgcn_s_setprio(0); } while (0)
#define PG8_WAIT_V(n) asm volatile("s_waitcnt vmcnt(" #n ")" ::: "memory")
#define PG8_WAIT_L(n) asm volatile("s_waitcnt lgkmcnt(" #n ")" ::: "memory")
#define PG8_BAR __builtin_amdgcn_s_barrier()
#define PG8_SCHED __builtin_amdgcn_sched_barrier(0)
    Unit cur, nxt; int ui = 0;
    if (!S.next(0, cur)) return;
    f32x4 acc[2][2][4][2];
#pragma unroll
    for (int a = 0; a < 2; ++a)
#pragma unroll
        for (int b = 0; b < 2; ++b)
#pragma unroll
            for (int m = 0; m < 4; ++m)
#pragma unroll
                for (int n = 0; n < 2; ++n) acc[a][b][m][n] = (f32x4){0.f, 0.f, 0.f, 0.f};
    bf16x8 At[4][2], B0[2][2], B1[2][2];
    const char* cA = (const char*)g.A + (size_t)cur.pm * tstep; const char* cB = (const char*)g.Bt + (size_t)cur.pn * tstep;
    PG8_STAGE(PG8_SB(0, 0), cB, voffB); PG8_STAGE(PG8_SA(0, 0), cA, voffA); PG8_STAGE(PG8_SB(0, 1), cB + hstep, voffB); PG8_STAGE(PG8_SA(0, 1), cA + hstep, voffA);
    if (wr == 1) PG8_BAR;
    PG8_WAIT_V(4); PG8_BAR;
    PG8_STAGE(PG8_SB(1, 0), cB + kstep, voffB); PG8_STAGE(PG8_SA(1, 0), cA + kstep, voffA); PG8_STAGE(PG8_SB(1, 1), cB + hstep + kstep, voffB);
    PG8_WAIT_V(6); PG8_BAR;
    for (;;) {
        const bool has_next = S.next(ui + 1, nxt);
        const char* nA = has_next ? (const char*)g.A + (size_t)nxt.pm * tstep : cA; const char* nB = has_next ? (const char*)g.Bt + (size_t)nxt.pn * tstep : cB;
        for (int t = 0; t < nt; t += 2) {
            const bool last = (t == nt - 2);
            const char* a1 = cA + (size_t)(t + 1) * kstep;
            const char* a2 = last ? nA : cA + (size_t)(t + 2) * kstep; const char* b2 = last ? nB : cB + (size_t)(t + 2) * kstep;
            const char* a3 = a2 + kstep; const char* b3 = b2 + kstep;
            PG8_LDB(B0, 0, 0); PG8_SCHED; PG8_LDA(At, 0, 0); PG8_STAGE(PG8_SA(1, 1), a1 + hstep, voffA);
            PG8_WAIT_L(8); PG8_BAR; PG8_WAIT_L(0); PG8_MMA(0, 0, At, B0); PG8_BAR; PG8_SCHED;
            PG8_LDB(B1, 0, 1); PG8_STAGE(PG8_SB(0, 0), b2, voffB);
            PG8_BAR; PG8_WAIT_L(0); PG8_MMA(0, 1, At, B1); PG8_BAR;
            PG8_LDA(At, 0, 1); PG8_STAGE(PG8_SA(0, 0), a2, voffA);
            PG8_BAR; PG8_WAIT_L(0); PG8_MMA(1, 0, At, B0); PG8_BAR; PG8_SCHED;
            PG8_STAGE(PG8_SB(0, 1), b2 + hstep, voffB);
            PG8_WAIT_V(6); PG8_BAR; PG8_MMA(1, 1, At, B1); PG8_BAR;
            PG8_LDB(B0, 1, 0); PG8_SCHED; PG8_LDA(At, 1, 0); PG8_STAGE(PG8_SA(0, 1), a2 + hstep, voffA);
            PG8_WAIT_L(8); PG8_BAR; PG8_WAIT_L(0); PG8_MMA(0, 0, At, B0); PG8_BAR; PG8_SCHED;
            PG8_LDB(B1, 1, 1); PG8_STAGE(PG8_SB(1, 0), b3, voffB);
            PG8_BAR; PG8_WAIT_L(0); PG8_MMA(0, 1, At, B1); PG8_BAR;
            PG8_LDA(At, 1, 1); PG8_STAGE(PG8_SA(1, 0), a3, voffA);
            PG8_BAR; PG8_WAIT_L(0); PG8_MMA(1, 0, At, B0); PG8_BAR; PG8_SCHED;
            PG8_STAGE(PG8_SB(1, 1), b3 + hstep, voffB);
            PG8_WAIT_V(6); PG8_BAR; PG8_MMA(1, 1, At, B1); PG8_BAR;
        }
        E(acc, cur, wr, wc, fr, fq);
        if (!has_next) break;
#pragma unroll
        for (int a = 0; a < 2; ++a)
#pragma unroll
            for (int b = 0; b < 2; ++b)
#pragma unroll
                for (int m = 0; m < 4; ++m)
#pragma unroll
                    for (int n = 0; n < 2; ++n) acc[a][b][m][n] = (f32x4){0.f, 0.f, 0.f, 0.f};
        cur = nxt; cA = nA; cB = nB; ++ui;
    }
    PG8_WAIT_V(0);
    if (wr == 0) PG8_BAR;
    PG8_BAR;
#undef PG8_SA
#undef PG8_SB
#undef PG8_STAGE
#undef PG8_LDA
#undef PG8_LDB
#undef PG8_MMA
#undef PG8_WAIT_V
#undef PG8_WAIT_L
#undef PG8_BAR
#undef PG8_SCHED
}
}

struct Frame {
    LAS unsigned char* lds;
    int tid, lane, wave, G, b;
    float* out; unsigned char* ws;
    __device__ __forceinline__ bf16_t* H() const { return (bf16_t*)out; }
    __device__ __forceinline__ bf16_t* Qc() const { return (bf16_t*)out; }
    __device__ __forceinline__ bf16_t* Kc() const { return (bf16_t*)(out + OUT_YS); }
    __device__ __forceinline__ bf16_t* MIX() const { return (bf16_t*)out; }
    __device__ __forceinline__ float* modp() const { return (float*)(ws + WS_MODP); }
    __device__ __forceinline__ float* pe() const { return (float*)(ws + WS_PE); }
    __device__ __forceinline__ float* BA() const { return (float*)(ws + WS_BA); }
    __device__ __forceinline__ float* GB() const { return (float*)(ws + WS_GB); }
    __device__ __forceinline__ float* RGAGG() const { return (float*)(ws + WS_RGAGG); }
    __device__ __forceinline__ bf16_t* WbaT() const { return (bf16_t*)(ws + WS_WBAT); }
    __device__ __forceinline__ bf16_t* WoutT() const { return (bf16_t*)(ws + WS_WOUTT); }
    __device__ __forceinline__ bf16_t* GT() const { return (bf16_t*)(ws + WS_GT); }
    __device__ __forceinline__ bf16_t* WinT() const { return (bf16_t*)(ws + WS_WINT); }
    __device__ __forceinline__ bf16_t* TA() const { return (bf16_t*)(ws + WS_TA); }
    __device__ __forceinline__ bf16_t* PROJ() const { return (bf16_t*)(ws + WS_PROJ); }
    __device__ __forceinline__ float* CARRY() const { return (float*)(ws + WS_CARRY); }
};
typedef const __attribute__((address_space(4))) Params CParams;

__device__ __forceinline__ int grp_of_block(int tb) { return tb < 128 ? 0 : (tb < 192 ? 1 : 2); }

__device__ __forceinline__ void transpose_item(const float* W, int N, int k0, int n0, bf16_t* WT0, int Kout, LAS float* scr, int lane) {
#pragma unroll 8
    for (int i = 0; i < 32; ++i) { const int kk = 2 * i + (lane >> 5); scr[kk * 33 + (lane & 31)] = W[(size_t)(k0 + kk) * N + n0 + (lane & 31)]; }
    LDS_WAIT();
    const int c = lane & 7;
#pragma unroll
    for (int j = 0; j < 4; ++j) { const int n = (lane >> 3) + 8 * j; const LAS float* s = scr + (8 * c) * 33 + n;
        u32x4 o; o.x = pk2(s[0 * 33], s[1 * 33]); o.y = pk2(s[2 * 33], s[3 * 33]); o.z = pk2(s[4 * 33], s[5 * 33]); o.w = pk2(s[6 * 33], s[7 * 33]);
        *(u32x4*)(WT0 + (size_t)n * Kout + k0 + 8 * c) = o; }
    LDS_WAIT();
}
__device__ __forceinline__ void phase0(CParams& p, Frame& F) {
    const int tid = F.tid, lane = F.lane;
    for (int it = F.b; it < 192; it += F.G) {
        const int jg = it % 12, ks = it / 12, j = jg * 256 + (tid & 255), half = tid >> 8, k0 = ks * 64 + half * 32;
        float s0 = 0.f, s1 = 0.f, s2 = 0.f;
#pragma unroll 8
        for (int k = 0; k < 32; ++k) { const int kk = k0 + k; const float w = p.ada_w[(size_t)kk * 3072 + j];
            s0 += siluf_(p.c_ctx[kk]) * w; s1 += siluf_(p.c[kk]) * w; s2 += siluf_(p.c[1024 + kk]) * w; }
        LAS float* red = (LAS float*)F.lds;
        if (half == 1) { red[tid - 256] = s0; red[256 + tid - 256] = s1; red[512 + tid - 256] = s2; }
        __syncthreads();
        if (half == 0) { F.modp()[(size_t)(ks * 3 + 0) * 3072 + j] = s0 + red[tid]; F.modp()[(size_t)(ks * 3 + 1) * 3072 + j] = s1 + red[256 + tid]; F.modp()[(size_t)(ks * 3 + 2) * 3072 + j] = s2 + red[512 + tid]; }
        __syncthreads();
    }
    LAS float* scr = (LAS float*)(F.lds + 4096 + F.wave * 8448);
    const int gw = F.b * 8 + F.wave, NGW = F.G * 8;
    constexpr int I_IN = 16 * 193, I_OUT = 32 * 32, I_G = 256, I_PE = 64;
    for (int it = gw; it < I_IN + I_OUT + I_G + I_PE; it += NGW) {
        int r = it;
        if (r < I_IN) { const int kb = r / 193, nb = r % 193, n0 = nb * 32;
            bf16_t* dst = n0 < 4096 ? F.WinT() + (size_t)n0 * 1024 : (n0 < 4128 ? F.WbaT() + (size_t)(n0 - 4096) * 1024 : F.WinT() + (size_t)(n0 - 32) * 1024);
            transpose_item(p.w_in, DIN, kb * 64, n0, dst, 1024, scr, lane); continue; }
        r -= I_IN;
        if (r < I_OUT) { const int kb = r / 32, nb = r % 32; transpose_item(p.w_out, 1024, kb * 64, nb * 32, F.WoutT() + (size_t)(nb * 32) * 2048, 2048, scr, lane); continue; }
        r -= I_OUT;
        if (r < I_G) { const int m = r >> 3, sub = r & 7, kb = sub >> 2, nb = sub & 3, g = m >> 4, dn = m & 15;
            const float* src = (g ? p.rg_w_i : p.rg_w_r) + (size_t)dn * 16384;
            transpose_item(src, 128, kb * 64, nb * 32, F.GT() + (size_t)m * 16384 + (size_t)(nb * 32) * 128, 128, scr, lane); continue; }
        r -= I_G;
        { const int v = r;
#pragma unroll
          for (int i = 0; i < 4; ++i) { const int idx = lane * 4 + i; const float f = expf(-9.210340371976184f * (float)idx / 256.f); const float a = (float)v * f;
              F.pe()[v * 256 + idx] = sinf(a); F.pe()[16384 + v * 256 + idx] = cosf(a); } }
    }
}

__device__ __forceinline__ float mod_val(CParams& p, const Frame& F, int grp, int j) {
    float s = p.ada_b[j];
#pragma unroll
    for (int ks = 0; ks < 16; ++ks) s += F.modp()[(size_t)(ks * 3 + grp) * 3072 + j];
    return s;
}

__device__ __forceinline__ void phase1(CParams& p, Frame& F) {
    LAS float* sc = (LAS float*)F.lds; LAS float* sh = sc + 1024;
    for (int tb = F.b; tb < 256; tb += F.G) {
        const int grp = grp_of_block(tb);
        for (int j = F.tid; j < 1024; j += 512) { sh[j] = mod_val(p, F, grp, j); sc[j] = p.pre_w[j] * (1.f + mod_val(p, F, grp, 1024 + j)); }
        __syncthreads();
        for (int i = 0; i < 8; ++i) {
            const int tok = tb * 64 + F.wave * 8 + i;
            const float* xr = tok < 8192 ? p.x_prompt + (size_t)tok * 1024 : p.x_sample + (size_t)(tok - 8192) * 1024;
            f32x4 v[4]; float ss = 0.f;
#pragma unroll
            for (int q = 0; q < 4; ++q) { v[q] = *(const f32x4*)(xr + F.lane * 4 + 256 * q);
                if (tok >= 8192) { const int pp = (tok - 8192) & 4095; const int vv = (q < 2) ? (pp >> 6) : (pp & 63);
                    const f32x4 e = *(const f32x4*)(F.pe() + ((q & 1) ? 16384 : 0) + vv * 256 + F.lane * 4); v[q] += e; }
                ss += (v[q][0] * v[q][0] + v[q][1] * v[q][1]) + (v[q][2] * v[q][2] + v[q][3] * v[q][3]); }
            const float rstd = rsqrtf(wave_sum(ss) * (1.f / 1024.f) + 1e-6f);
#pragma unroll
            for (int q = 0; q < 4; ++q) { const int j = F.lane * 4 + 256 * q; const f32x4 s4 = *(const LAS f32x4*)(sc + j), h4 = *(const LAS f32x4*)(sh + j);
                CHK(F, 1, badv(v[q][0] * rstd * s4[0] + h4[0], 100.f) || badv(v[q][3] * rstd * s4[3] + h4[3], 100.f));
                u32x2 o; o.x = pk2(v[q][0] * rstd * s4[0] + h4[0], v[q][1] * rstd * s4[1] + h4[1]); o.y = pk2(v[q][2] * rstd * s4[2] + h4[2], v[q][3] * rstd * s4[3] + h4[3]);
                *(u32x2*)(F.H() + (size_t)tok * 1024 + j) = o; }
        }
        __syncthreads();
    }
}

__device__ __forceinline__ void phase2(CParams& p, Frame& F) {
    { pg8::Gemm g{F.H(), F.WinT(), NTOK, NPROJ, 1024}; pg8::StaticOrder S; S.init(NTOK, NPROJ, F.G, F.b); pg8::EpiBf16 E{F.PROJ(), NPROJ};
      pg8::gemm_phase<pg8::EpiBf16, pg8::StaticOrder>(F.lds, g, S, E); }
    const int l15 = F.lane & 15, q4 = F.lane >> 4;
    for (int tb = F.b; tb < 256; tb += F.G) {
        const int mt = F.wave >> 1, nt = F.wave & 1;
        const bf16_t* ar = F.H() + (size_t)(tb * 64 + mt * 16 + l15) * 1024 + q4 * 8;
        const bf16_t* br = F.WbaT() + (size_t)(nt * 16 + l15) * 1024 + q4 * 8;
        f32x4 acc = {0.f, 0.f, 0.f, 0.f};
#pragma unroll 4
        for (int ks = 0; ks < 32; ++ks) { const bf16x8 a = *(const bf16x8*)(ar + ks * 32), b = *(const bf16x8*)(br + ks * 32); acc = MFMA16(a, b, acc); }
#pragma unroll
        for (int r = 0; r < 4; ++r) F.BA()[(size_t)(tb * 64 + mt * 16 + q4 * 4 + r) * 32 + nt * 16 + l15] = acc[r];
    }
}

__device__ __forceinline__ void p3_delta_item(CParams& p, Frame& F, int ci, int h) {
    const int tid = F.tid, lane = F.lane, wave = F.wave, q4 = lane >> 4, l15 = lane & 15;
    LAS unsigned char* Ks = F.lds; LAS unsigned char* Qs = F.lds + 17408;
    LAS float* gfv = (LAS float*)(F.lds + 34816);
    LAS unsigned char* DIR0 = F.lds + 35840;
    LAS unsigned char* ATo = F.lds + 137728;
#pragma unroll
    for (int i = 0; i < 5; ++i) { const int ch = tid + 512 * i; if (ch < 2304) { const int dd = ch >= 1152, cc = ch - dd * 1152; *(LAS u32x4*)(DIR0 + dd * 46848 + 18432 + cc * 16) = (u32x4){0u, 0u, 0u, 0u}; } }
    const int t0 = ci * 64;
    int seq_lo, seq_hi; if (ci < 128) { seq_lo = (ci >> 2) * 256; seq_hi = seq_lo + 256; } else { seq_lo = 8192 + ((ci - 128) >> 6) * 4096; seq_hi = seq_lo + 4096; }
    {
        const int tg = tid >> 5, part = (tid >> 4) & 1, sub = tid & 15, col = part * 1024 + h * 128 + sub * 8;
        float w[4][8];
#pragma unroll
        for (int j = 0; j < 4; ++j) { const f32x4 a = *(const f32x4*)(p.dn_conv_w + j * 3072 + col), b = *(const f32x4*)(p.dn_conv_w + j * 3072 + col + 4);
            w[j][0] = a[0]; w[j][1] = a[1]; w[j][2] = a[2]; w[j][3] = a[3]; w[j][4] = b[0]; w[j][5] = b[1]; w[j][6] = b[2]; w[j][7] = b[3]; }
        float acc[4][8];
#pragma unroll
        for (int i = 0; i < 4; ++i)
#pragma unroll
            for (int e = 0; e < 8; ++e) acc[i][e] = 0.f;
        const int tb = t0 + tg * 4 - 2;
#pragma unroll
        for (int r = 0; r < 7; ++r) { const int tok = tb + r; u32x4 v = {0u, 0u, 0u, 0u};
            if (tok >= seq_lo && tok < seq_hi) v = *(const u32x4*)(F.PROJ() + (size_t)tok * NPROJ + col);
            float x[8]; unpack8(v, x);
            CHK(F, 2, badv(x[0], 1000.f) || badv(x[3], 1000.f) || badv(x[7], 1000.f));
#pragma unroll
            for (int j = 0; j < 4; ++j) { const int i = r - j; if (i >= 0 && i < 4) {
#pragma unroll
                for (int e = 0; e < 8; ++e) acc[i][e] += w[j][e] * x[e]; } } }
#pragma unroll
        for (int i = 0; i < 4; ++i) { float ss = 0.f;
#pragma unroll
            for (int e = 0; e < 8; ++e) { acc[i][e] = siluf_(acc[i][e]); ss += acc[i][e] * acc[i][e]; }
            ss += __shfl_xor(ss, 1); ss += __shfl_xor(ss, 2); ss += __shfl_xor(ss, 4); ss += __shfl_xor(ss, 8);
            const float rs = rsqrtf(ss + 1e-6f) * (part == 0 ? 0.08838834764831845f : 1.f);
#pragma unroll
            for (int e = 0; e < 8; ++e) acc[i][e] *= rs;
            CHK(F, 4, badv(acc[i][0], 1.01f) || badv(acc[i][5], 1.01f) || badv(ss * rs * rs, part == 0 ? 0.0079f : 1.01f));
            const u32x4 o = pack8(acc[i]); const int c = tg * 4 + i;
            *(LAS u32x4*)((part ? Ks : Qs) + c * 272 + sub * 16) = o;
            *(u32x4*)((part ? F.Kc() : F.Qc()) + (size_t)(t0 + c) * 1024 + h * 128 + sub * 8) = o; }
    }
    if (wave == 0) {
        const float* ba = F.BA() + (size_t)(t0 + lane) * 32;
        const float bf_ = sigm(ba[h]), bb_ = sigm(ba[8 + h]);
        float s = -expf(p.dn_a_log[h]) * softplusf_(ba[16 + h] + p.dn_dt_bias[h]);
        float sb = -expf(p.dn_a_log[8 + h]) * softplusf_(ba[24 + h] + p.dn_dt_bias[8 + h]);
#pragma unroll
        for (int o = 1; o < 64; o <<= 1) { const float t = __shfl_up(s, o); if (lane >= o) s += t; }
#pragma unroll
        for (int o = 1; o < 64; o <<= 1) { const float t = __shfl_down(sb, o); if (lane + o < 64) sb += t; }
        CHK(F, 3, badv(ba[h], 1000.f) || badv(ba[24 + h], 1000.f));
        CHK(F, 8, badv(s, 1e4f) || badv(sb, 1e4f) || s > 0.f || sb > 0.f || bf_ < 0.f || bf_ > 1.f || bb_ < 0.f || bb_ > 1.f);
        gfv[lane] = s; gfv[64 + lane] = sb; gfv[128 + lane] = bf_; gfv[192 + lane] = bb_;
        float* gb = F.GB() + (size_t)(ci * 8 + h) * 256;
        gb[lane] = s; gb[64 + lane] = sb; gb[128 + lane] = bf_; gb[192 + lane] = bb_;
    }
    __syncthreads();
    const int d = wave >> 2, mt = wave & 3;
    LAS unsigned char* Db = DIR0 + d * 46848;
    LAS unsigned char* Brow = Db; LAS unsigned char* Btr = Db + 9216; LAS unsigned char* Xrow = Db + 18432; LAS unsigned char* Xtr = Db + 27648;
    LAS float* Dl = (LAS float*)(Db + 36864) + mt * 272; LAS unsigned char* M2t = Db + 41216; LAS unsigned char* Mts = Db + 43776 + mt * 768;
    const LAS unsigned char* Lrow = d == 0 ? Brow : Btr;
    const LAS float* gd = gfv + d * 64; const LAS float* bd = gfv + 128 + d * 64;
    {
        f32x4 kk[4], qk[4];
#pragma unroll
        for (int n = 0; n < 4; ++n) { kk[n] = (f32x4){0.f, 0.f, 0.f, 0.f}; qk[n] = (f32x4){0.f, 0.f, 0.f, 0.f}; }
#pragma unroll
        for (int ks = 0; ks < 4; ++ks) { const bf16x8 ak = ldfrag(Ks, 272, mt * 16 + l15, ks * 64 + q4 * 16), aq = ldfrag(Qs, 272, mt * 16 + l15, ks * 64 + q4 * 16);
#pragma unroll
            for (int n = 0; n < 4; ++n) { const bf16x8 bk = ldfrag(Ks, 272, n * 16 + l15, ks * 64 + q4 * 16); kk[n] = MFMA16(ak, bk, kk[n]); qk[n] = MFMA16(aq, bk, qk[n]); } }
#pragma unroll
        for (int n = 0; n < 4; ++n) { const int s = n * 16 + l15; float a4[4];
#pragma unroll
            for (int r = 0; r < 4; ++r) { const int c = mt * 16 + q4 * 4 + r;
                const float dec = __expf(fminf(gd[c] - gd[s], 0.f));
                const bool strict = d == 0 ? (c > s) : (c < s);
                const float a = strict ? bd[c] * kk[n][r] * dec : 0.f;
                a4[r] = a;
                ((LAS bf16_t*)Brow)[c * 72 + s] = f2bf(a);
                if (n == mt) { if (d == 0) Dl[(q4 * 4 + r) * 17 + l15] = a; else Dl[l15 * 17 + q4 * 4 + r] = a; }
                const bool incl = d == 0 ? (c >= s) : (c < s);
                if (incl) ((LAS bf16_t*)ATo)[c * 64 + s] = f2bf(qk[n][r] * dec); }
            u32x2 o; o.x = pk2(a4[0], a4[1]); o.y = pk2(a4[2], a4[3]);
            *(LAS u32x2*)(Btr + s * 144 + (mt * 16 + q4 * 4) * 2) = o; }
    }
    __syncthreads();
    if (lane < 16) {
        float x[16];
#pragma unroll
        for (int i = 0; i < 16; ++i) { float sv = (i == lane) ? 1.f : 0.f;
#pragma unroll
            for (int j = 0; j < i; ++j) sv -= Dl[i * 17 + j] * x[j];
            x[i] = sv; }
#pragma unroll
        for (int i = 0; i < 16; ++i) ((LAS bf16_t*)Xrow)[(mt * 16 + i) * 72 + mt * 16 + lane] = f2bf(x[i]);
        u32x4 o0, o1; o0.x = pk2(x[0], x[1]); o0.y = pk2(x[2], x[3]); o0.z = pk2(x[4], x[5]); o0.w = pk2(x[6], x[7]);
        o1.x = pk2(x[8], x[9]); o1.y = pk2(x[10], x[11]); o1.z = pk2(x[12], x[13]); o1.w = pk2(x[14], x[15]);
        *(LAS u32x4*)(Xtr + (mt * 16 + lane) * 144 + mt * 32) = o0; *(LAS u32x4*)(Xtr + (mt * 16 + lane) * 144 + mt * 32 + 16) = o1;
    }
    __syncthreads();
    const bf16x8 zero8 = {0, 0, 0, 0, 0, 0, 0, 0};
    const f32x4 zero4 = {0.f, 0.f, 0.f, 0.f};
    if (mt & 1) {
        const int I1 = mt, I0 = mt - 1;
        bf16x8 a = zero8, b = zero8;
        if (q4 < 2) { a = ldfrag(Lrow, 144, I1 * 16 + l15, I0 * 32 + q4 * 16); b = ldfrag(Xtr, 144, I0 * 16 + l15, I0 * 32 + q4 * 16); }
        const f32x4 M = MFMA16(a, b, zero4);
        { u32x2 o; o.x = pk2(M[0], M[1]); o.y = pk2(M[2], M[3]); *(LAS u32x2*)(Mts + l15 * 48 + q4 * 8) = o; }
        LDS_WAIT();
        bf16x8 a2 = zero8, b2 = zero8;
        if (q4 < 2) { a2 = ldfrag(Xrow, 144, I1 * 16 + l15, I1 * 32 + q4 * 16); b2 = *(const LAS bf16x8*)(Mts + l15 * 48 + q4 * 16); }
        const f32x4 X = MFMA16(a2, b2, zero4);
#pragma unroll
        for (int r = 0; r < 4; ++r) ((LAS bf16_t*)Xrow)[(I1 * 16 + q4 * 4 + r) * 72 + I0 * 16 + l15] = f2bf(-X[r]);
        u32x2 o; o.x = pk2(-X[0], -X[1]); o.y = pk2(-X[2], -X[3]);
        *(LAS u32x2*)(Xtr + (I0 * 16 + l15) * 144 + (I1 * 16 + q4 * 4) * 2) = o;
    }
    __syncthreads();
    {
        const int mi = mt >> 1, ni = mt & 1;
        const bf16x8 a = ldfrag(Lrow, 144, 32 + mi * 16 + l15, q4 * 16), b = ldfrag(Xtr, 144, ni * 16 + l15, q4 * 16);
        const f32x4 M2 = MFMA16(a, b, zero4);
        { u32x2 o; o.x = pk2(M2[0], M2[1]); o.y = pk2(M2[2], M2[3]); *(LAS u32x2*)(M2t + (ni * 16 + l15) * 80 + (mi * 16 + q4 * 4) * 2) = o; }
        __syncthreads();
        const bf16x8 a2 = ldfrag(Xrow, 144, 32 + mi * 16 + l15, 64 + q4 * 16), b2 = *(const LAS bf16x8*)(M2t + (ni * 16 + l15) * 80 + q4 * 16);
        const f32x4 X = MFMA16(a2, b2, zero4);
#pragma unroll
        for (int r = 0; r < 4; ++r) { CHK(F, 6, badv(X[r], 20.f)); ((LAS bf16_t*)Xrow)[(32 + mi * 16 + q4 * 4 + r) * 72 + ni * 16 + l15] = f2bf(-X[r]); }
        u32x2 o; o.x = pk2(-X[0], -X[1]); o.y = pk2(-X[2], -X[3]);
        *(LAS u32x2*)(Xtr + (ni * 16 + l15) * 144 + (32 + mi * 16 + q4 * 4) * 2) = o;
    }
    __syncthreads();
    { bf16_t* dst = F.TA() + (size_t)(ci * 8 + h) * 8192;
      const int c = tid >> 3, s0 = (tid & 7) * 8;
      const u32x4 lo = *(const LAS u32x4*)(DIR0 + 18432 + c * 144 + s0 * 2), up = *(const LAS u32x4*)(DIR0 + 46848 + 27648 + c * 144 + s0 * 2);
      unsigned wl[4] = {lo.x, lo.y, lo.z, lo.w}, wu[4] = {up.x, up.y, up.z, up.w}, wo[4];
#pragma unroll
      for (int i = 0; i < 4; ++i) { const int sa = s0 + 2 * i, sb2 = sa + 1;
          const unsigned mlo = (sa <= c ? 0x0000FFFFu : 0u) | (sb2 <= c ? 0xFFFF0000u : 0u);
          wo[i] = (wl[i] & mlo) | (wu[i] & ~mlo); }
      *(u32x4*)(dst + tid * 8) = (u32x4){wo[0], wo[1], wo[2], wo[3]};
      *(u32x4*)(dst + 4096 + tid * 8) = *(const LAS u32x4*)(ATo + tid * 16); }
    __syncthreads();
}

template <int PASS>
__device__ __forceinline__ void rg_item(CParams& p, Frame& F, int ci, int n) {
    const int tid = F.tid, lane = F.lane, wave = F.wave, q4 = lane >> 4, l15 = lane & 15;
    LAS unsigned char* xb = F.lds; LAS float* xf = (LAS float*)(F.lds + 17408); LAS float* Hs = (LAS float*)(F.lds + 50176);
    const int t0 = ci * 64;
    int seq_lo, seq_hi, c_lo, c_hi, seq; const bool samp = ci >= 128;
    if (!samp) { seq = ci >> 2; c_lo = seq * 4; c_hi = c_lo + 4; } else { seq = (ci - 128) >> 6; c_lo = 128 + seq * 64; c_hi = c_lo + 64; }
    seq_lo = c_lo * 64; seq_hi = c_hi * 64;
    {
        const int tg = tid >> 4, sub = tid & 15, ch = n * 128 + sub * 8, col = 4096 + ch;
        float w[4][8], acc[2][8];
#pragma unroll
        for (int j = 0; j < 4; ++j) { const f32x4 a = *(const f32x4*)(p.rg_conv_w + j * 1024 + ch), b = *(const f32x4*)(p.rg_conv_w + j * 1024 + ch + 4);
            w[j][0] = a[0]; w[j][1] = a[1]; w[j][2] = a[2]; w[j][3] = a[3]; w[j][4] = b[0]; w[j][5] = b[1]; w[j][6] = b[2]; w[j][7] = b[3]; }
        { const f32x4 a = *(const f32x4*)(p.rg_conv_b + ch), b = *(const f32x4*)(p.rg_conv_b + ch + 4);
#pragma unroll
          for (int i = 0; i < 2; ++i) { acc[i][0] = a[0]; acc[i][1] = a[1]; acc[i][2] = a[2]; acc[i][3] = a[3]; acc[i][4] = b[0]; acc[i][5] = b[1]; acc[i][6] = b[2]; acc[i][7] = b[3]; } }
        const int tb = t0 + tg * 2 - 2;
#pragma unroll
        for (int r = 0; r < 5; ++r) { const int tok = tb + r; u32x4 v = {0u, 0u, 0u, 0u};
            if (tok >= seq_lo && tok < seq_hi) v = *(const u32x4*)(F.PROJ() + (size_t)tok * NPROJ + col);
            float x[8]; unpack8(v, x);
#pragma unroll
            for (int j = 0; j < 4; ++j) { const int i = r - j; if (i >= 0 && i < 2) {
#pragma unroll
                for (int e = 0; e < 8; ++e) acc[i][e] += w[j][e] * x[e]; } } }
#pragma unroll
        for (int i = 0; i < 2; ++i) { const int c = tg * 2 + i;
            *(LAS u32x4*)(xb + c * 272 + sub * 16) = pack8(acc[i]);
            *(LAS f32x4*)(xf + c * 128 + sub * 8) = (f32x4){acc[i][0], acc[i][1], acc[i][2], acc[i][3]};
            *(LAS f32x4*)(xf + c * 128 + sub * 8 + 4) = (f32x4){acc[i][4], acc[i][5], acc[i][6], acc[i][7]}; }
    }
    __syncthreads();
    const int j = wave * 16 + l15, ch = n * 128 + j;
    f32x4 hs[4];
#pragma unroll
    for (int m = 0; m < 4; ++m) hs[m] = (f32x4){0.f, 0.f, 0.f, 0.f};
#pragma unroll
    for (int d = 0; d < 2; ++d) {
        f32x4 av[4], bxv[4];
        {
            f32x4 ar[4], ai[4];
#pragma unroll
            for (int m = 0; m < 4; ++m) { ar[m] = (f32x4){0.f, 0.f, 0.f, 0.f}; ai[m] = (f32x4){0.f, 0.f, 0.f, 0.f}; }
            const bf16_t* gr = F.GT() + (size_t)((0 * 2 + d) * 8 + n) * 16384 + (size_t)j * 128 + q4 * 8;
            const bf16_t* gi = F.GT() + (size_t)((1 * 2 + d) * 8 + n) * 16384 + (size_t)j * 128 + q4 * 8;
#pragma unroll
            for (int ks = 0; ks < 4; ++ks) { const bf16x8 br = *(const bf16x8*)(gr + ks * 32), bi = *(const bf16x8*)(gi + ks * 32);
#pragma unroll
                for (int m = 0; m < 4; ++m) { const bf16x8 a = ldfrag(xb, 272, m * 16 + l15, ks * 64 + q4 * 16); ar[m] = MFMA16(a, br, ar[m]); ai[m] = MFMA16(a, bi, ai[m]); } }
            const float br_ = p.rg_b_r[d * 1024 + ch], bi_ = p.rg_b_i[d * 1024 + ch], sp = softplusf_(-p.rg_lam[d * 1024 + ch]);
#pragma unroll
            for (int m = 0; m < 4; ++m)
#pragma unroll
                for (int r = 0; r < 4; ++r) { const int c = m * 16 + q4 * 4 + r;
                    const float rr = sigm(ar[m][r] + br_), ii = sigm(ai[m][r] + bi_);
                    const float la = -8.f * rr * sp, t2 = 2.f * la;
                    const float em = t2 > -0.02f ? t2 * (1.f + t2 * (0.5f + t2 * (0.16666667f + t2 * 0.041666667f))) : __expf(t2) - 1.f;
                    av[m][r] = __expf(la); bxv[m][r] = sqrtf(-em) * (ii * xf[c * 128 + j]); }
        }
        f32x4 Pa[4], Pb[4]; float Ap[4], Bp[4], Am[4], Bm[4];
#pragma unroll
        for (int m = 0; m < 4; ++m) {
            float pa, pb;
            if (d == 0) { pa = av[m][0]; pb = bxv[m][0]; Pa[m][0] = pa; Pb[m][0] = pb;
#pragma unroll
                for (int r = 1; r < 4; ++r) { pb = av[m][r] * pb + bxv[m][r]; pa = av[m][r] * pa; Pa[m][r] = pa; Pb[m][r] = pb; } }
            else { pa = av[m][3]; pb = bxv[m][3]; Pa[m][3] = pa; Pb[m][3] = pb;
#pragma unroll
                for (int r = 2; r >= 0; --r) { pb = av[m][r] * pb + bxv[m][r]; pa = av[m][r] * pa; Pa[m][r] = pa; Pb[m][r] = pb; } }
            float Ak[4], Bk[4];
#pragma unroll
            for (int k = 0; k < 4; ++k) { Ak[k] = __shfl(pa, l15 + 16 * k); Bk[k] = __shfl(pb, l15 + 16 * k); }
            float ap = 1.f, bp = 0.f, am = 1.f, bm = 0.f;
#pragma unroll
            for (int kk = 0; kk < 4; ++kk) { const int k = d == 0 ? kk : 3 - kk;
                const bool before = d == 0 ? (k < q4) : (k > q4);
                const float nb = Ak[k] * bp + Bk[k], na = Ak[k] * ap;
                bp = before ? nb : bp; ap = before ? na : ap;
                bm = Ak[k] * bm + Bk[k]; am = Ak[k] * am; }
            Ap[m] = ap; Bp[m] = bp; Am[m] = am; Bm[m] = bm;
        }
        if (PASS == 1) {
            float At = 1.f, Bt = 0.f;
#pragma unroll
            for (int mm = 0; mm < 4; ++mm) { const int m = d == 0 ? mm : 3 - mm; Bt = Am[m] * Bt + Bm[m]; At = Am[m] * At; }
            if (q4 == 0) { float* ag = F.RGAGG() + (size_t)(ci * 2 + d) * 2048; ag[ch] = At; ag[1024 + ch] = Bt; }
        } else {
            float hb = F.CARRY()[(size_t)(ci * 2 + d) * 1024 + ch];
#pragma unroll
            for (int mm = 0; mm < 4; ++mm) { const int m = d == 0 ? mm : 3 - mm;
                const float hin = Ap[m] * hb + Bp[m];
#pragma unroll
                for (int r = 0; r < 4; ++r) hs[m][r] += Pa[m][r] * hin + Pb[m][r];
                hb = Am[m] * hb + Bm[m]; }
            if (!samp && q4 == 0 && ci == (d == 0 ? c_hi - 1 : c_lo)) F.out[OUT_SR + (size_t)(seq * 2 + d) * 1024 + ch] = hb;
        }
    }
    if (PASS == 3) {
#pragma unroll
        for (int m = 0; m < 4; ++m)
#pragma unroll
            for (int r = 0; r < 4; ++r) Hs[(m * 16 + q4 * 4 + r) * 128 + j] = hs[m][r];
        __syncthreads();
#pragma unroll
        for (int i = 0; i < 2; ++i) { const int chunk = tid + 512 * i, c = chunk >> 4, cc = chunk & 15;
            const u32x4 gv = *(const u32x4*)(F.PROJ() + (size_t)(t0 + c) * NPROJ + 5120 + n * 128 + cc * 8);
            float g[8]; unpack8(gv, g);
            const f32x4 ha = *(const LAS f32x4*)(Hs + c * 128 + cc * 8), hb2 = *(const LAS f32x4*)(Hs + c * 128 + cc * 8 + 4);
            float o[8];
#pragma unroll
            for (int e = 0; e < 4; ++e) { o[e] = ha[e] * siluf_(g[e]); o[4 + e] = hb2[e] * siluf_(g[4 + e]); }
            *(u32x4*)(F.MIX() + (size_t)(t0 + c) * 2048 + 1024 + n * 128 + cc * 8) = pack8(o); }
    }
    __syncthreads();
}

__device__ __forceinline__ void rg_carry_scan(CParams& p, Frame& F) {
    const int tid = F.tid;
    int samp, seq, d, ch;
    if (tid < 256) { const int g = F.b * 256 + tid; if (g >= 65536) return; samp = 0; seq = g >> 11; d = (g >> 10) & 1; ch = g & 1023; }
    else if (tid < 272) { const int g = F.b * 16 + tid - 256; if (g >= 4096) return; samp = 1; seq = g >> 11; d = (g >> 10) & 1; ch = g & 1023; }
    else return;
    const int nch = samp ? 64 : 4, c_lo = samp ? 128 + seq * 64 : seq * 4;
    float h = samp ? p.state_rglru[(size_t)(seq * 2 + d) * 1024 + ch] : 0.f;
    for (int i0 = 0; i0 < nch; i0 += 4) {
        float A[4], B[4];
#pragma unroll
        for (int u = 0; u < 4; ++u) { const int cc = d == 0 ? c_lo + i0 + u : c_lo + nch - 1 - i0 - u; const float* ag = F.RGAGG() + (size_t)(cc * 2 + d) * 2048; A[u] = ag[ch]; B[u] = ag[1024 + ch]; }
#pragma unroll
        for (int u = 0; u < 4; ++u) { const int cc = d == 0 ? c_lo + i0 + u : c_lo + nch - 1 - i0 - u; F.CARRY()[(size_t)(cc * 2 + d) * 1024 + ch] = h; h = A[u] * h + B[u]; }
    }
}

__device__ __forceinline__ void phase3(CParams& p, Frame& F) {
    for (int it = F.b; it < 2048; it += F.G) p3_delta_item(p, F, it >> 3, it & 7);
    for (int it = F.b; it < 2048; it += F.G) rg_item<1>(p, F, it >> 3, it & 7);
}

struct P4Pre { u32x4 k0, k1, q0, q1, ti, at; u32x2 v[4]; float g; };
__device__ __forceinline__ void p4_prefetch(const Frame& F, P4Pre& R, int ci, int h, int d, int sl, int seq_lo, int seq_hi) {
    const int tid = F.tid, t0 = ci * 64;
    { const int row = tid >> 4, cc = tid & 15;
      const size_t o0 = (size_t)(t0 + row) * 1024 + h * 128 + cc * 8, o1 = (size_t)(t0 + 32 + row) * 1024 + h * 128 + cc * 8;
      R.k0 = *(const u32x4*)(F.Kc() + o0); R.k1 = *(const u32x4*)(F.Kc() + o1); R.q0 = *(const u32x4*)(F.Qc() + o0); R.q1 = *(const u32x4*)(F.Qc() + o1); }
    { const bf16_t* ta = F.TA() + (size_t)(ci * 8 + h) * 8192; R.ti = *(const u32x4*)(ta + tid * 8); R.at = *(const u32x4*)(ta + 4096 + tid * 8); }
    { const int c = tid >> 3, e0 = (tid & 7) * 4;
#pragma unroll
      for (int j = 0; j < 4; ++j) { const int tok = t0 + c - 2 + j; u32x2 v = {0u, 0u};
          if (tok >= seq_lo && tok < seq_hi) v = *(const u32x2*)(F.PROJ() + (size_t)tok * NPROJ + 2048 + h * 128 + sl * 32 + e0);
          R.v[j] = v; } }
    R.g = 0.f;
    if (tid < 128) R.g = F.GB()[(size_t)(ci * 8 + h) * 256 + (tid >> 6) * 128 + d * 64 + (tid & 63)];
}
__device__ __forceinline__ u32x4 tri_mask(u32x4 v, int c, int s0, int d) {
    unsigned w[4] = {v.x, v.y, v.z, v.w};
#pragma unroll
    for (int i = 0; i < 4; ++i) { const int slo = s0 + 2 * i, shi = slo + 1;
        const bool klo = d == 0 ? (c >= slo) : (c <= slo), khi = d == 0 ? (c >= shi) : (c <= shi);
        w[i] &= (klo ? 0x0000FFFFu : 0u) | (khi ? 0xFFFF0000u : 0u); }
    return (u32x4){w[0], w[1], w[2], w[3]};
}
__device__ __forceinline__ void p4_item(CParams& p, Frame& F, int samp, int seq, int h, int d, int sl) {
    const int tid = F.tid, lane = F.lane, wave = F.wave, q4 = lane >> 4, l15 = lane & 15;
    LAS unsigned char* Ks = F.lds; LAS unsigned char* Qs = F.lds + 17408; LAS unsigned char* TIs = F.lds + 34816; LAS unsigned char* ATs = F.lds + 44032;
    LAS unsigned char* Sb = F.lds + 53248; LAS unsigned char* Rt = F.lds + 61952; LAS unsigned char* Vt1 = F.lds + 66560; LAS unsigned char* Vt2 = F.lds + 71168;
    LAS float* Vs = (LAS float*)(F.lds + 75776); LAS float* gv = (LAS float*)(F.lds + 83968); LAS float* bv = gv + 64;
    const int nch = samp ? 64 : 4, chunk0 = samp ? 128 + seq * 64 : seq * 4, seq_lo = chunk0 * 64, seq_hi = seq_lo + nch * 64;
    f32x4 S[2];
#pragma unroll
    for (int nt = 0; nt < 2; ++nt)
#pragma unroll
        for (int r = 0; r < 4; ++r)
            S[nt][r] = samp ? p.state_delta[(size_t)((seq * 2 + d) * 8 + h) * 16384 + (size_t)(wave * 16 + q4 * 4 + r) * 128 + sl * 32 + nt * 16 + l15] : 0.f;
#pragma unroll
    for (int nt = 0; nt < 2; ++nt) { u32x2 o; o.x = pk2(S[nt][0], S[nt][1]); o.y = pk2(S[nt][2], S[nt][3]); *(LAS u32x2*)(Sb + (nt * 16 + l15) * 272 + (wave * 16 + q4 * 4) * 2) = o; }
    float cw[4][4];
    { const int e0 = (tid & 7) * 4;
#pragma unroll
      for (int j = 0; j < 4; ++j) { const f32x4 a = *(const f32x4*)(p.dn_conv_w + j * 3072 + 2048 + h * 128 + sl * 32 + e0); cw[j][0] = a[0]; cw[j][1] = a[1]; cw[j][2] = a[2]; cw[j][3] = a[3]; } }
    P4Pre R;
    p4_prefetch(F, R, d == 0 ? chunk0 : chunk0 + nch - 1, h, d, sl, seq_lo, seq_hi);
#pragma unroll 1
    for (int step = 0; step < nch; ++step) {
        const int ci = d == 0 ? chunk0 + step : chunk0 + nch - 1 - step, t0 = ci * 64;
        { const int row = tid >> 4, cc = tid & 15;
          *(LAS u32x4*)(Ks + row * 272 + cc * 16) = R.k0; *(LAS u32x4*)(Ks + (32 + row) * 272 + cc * 16) = R.k1;
          *(LAS u32x4*)(Qs + row * 272 + cc * 16) = R.q0; *(LAS u32x4*)(Qs + (32 + row) * 272 + cc * 16) = R.q1; }
        { const int c = tid >> 3, s0 = (tid & 7) * 8;
          *(LAS u32x4*)(TIs + c * 144 + s0 * 2) = tri_mask(R.ti, c, s0, d); *(LAS u32x4*)(ATs + c * 144 + s0 * 2) = tri_mask(R.at, c, s0, d); }
        { const int c = tid >> 3, e0 = (tid & 7) * 4; float o[4] = {0.f, 0.f, 0.f, 0.f};
#pragma unroll
          for (int j = 0; j < 4; ++j) { const u32x2 v = R.v[j];
              o[0] += cw[j][0] * __uint_as_float(v.x << 16); o[1] += cw[j][1] * __uint_as_float(v.x & 0xffff0000u);
              o[2] += cw[j][2] * __uint_as_float(v.y << 16); o[3] += cw[j][3] * __uint_as_float(v.y & 0xffff0000u); }
          CHK(F, 9, badv(o[0], 1000.f) || badv(o[3], 1000.f));
          *(LAS f32x4*)(Vs + c * 32 + e0) = (f32x4){siluf_(o[0]), siluf_(o[1]), siluf_(o[2]), siluf_(o[3])}; }
        if (tid < 128) gv[tid] = R.g;
        if (step + 1 < nch) p4_prefetch(F, R, d == 0 ? ci + 1 : ci - 1, h, d, sl, seq_lo, seq_hi);
        __syncthreads();
        const int prod = wave >> 2, mt = wave & 3;
        f32x4 acc[2] = {(f32x4){0.f, 0.f, 0.f, 0.f}, (f32x4){0.f, 0.f, 0.f, 0.f}};
        { const LAS unsigned char* base = prod ? Qs : Ks;
#pragma unroll
          for (int ks = 0; ks < 4; ++ks) { const bf16x8 a = ldfrag(base, 272, mt * 16 + l15, ks * 64 + q4 * 16);
#pragma unroll
              for (int nt = 0; nt < 2; ++nt) { const bf16x8 b = ldfrag(Sb, 272, nt * 16 + l15, ks * 64 + q4 * 16); acc[nt] = MFMA16(a, b, acc[nt]); } } }
        if (prod == 0) {
#pragma unroll
            for (int nt = 0; nt < 2; ++nt) { const int e = nt * 16 + l15; float rv[4];
#pragma unroll
                for (int r = 0; r < 4; ++r) { const int c = mt * 16 + q4 * 4 + r; rv[r] = bv[c] * (Vs[c * 32 + e] - __expf(gv[c]) * acc[nt][r]); }
                u32x2 o; o.x = pk2(rv[0], rv[1]); o.y = pk2(rv[2], rv[3]); *(LAS u32x2*)(Rt + e * 144 + (mt * 16 + q4 * 4) * 2) = o; }
        } else {
#pragma unroll
            for (int nt = 0; nt < 2; ++nt)
#pragma unroll
                for (int r = 0; r < 4; ++r) { const int c = mt * 16 + q4 * 4 + r; acc[nt][r] *= __expf(gv[c]); }
        }
        __syncthreads();
        const float glast = d == 0 ? gv[63] : gv[0];
        { const int m3 = wave & 3, n3 = wave >> 2;
          f32x4 vn = {0.f, 0.f, 0.f, 0.f};
#pragma unroll
          for (int ks = 0; ks < 2; ++ks) { const bf16x8 a = ldfrag(TIs, 144, m3 * 16 + l15, ks * 64 + q4 * 16), b = ldfrag(Rt, 144, n3 * 16 + l15, ks * 64 + q4 * 16); vn = MFMA16(a, b, vn); }
          const int e = n3 * 16 + l15, c0 = m3 * 16 + q4 * 4;
          if (!samp) CHK(F, 10 + (step < 3 ? step : 3), badv(vn[0], 200.f) || badv(vn[3], 200.f));
          u32x2 o1, o2; o1.x = pk2(vn[0], vn[1]); o1.y = pk2(vn[2], vn[3]);
          o2.x = pk2(vn[0] * __expf(glast - gv[c0]), vn[1] * __expf(glast - gv[c0 + 1])); o2.y = pk2(vn[2] * __expf(glast - gv[c0 + 2]), vn[3] * __expf(glast - gv[c0 + 3]));
          *(LAS u32x2*)(Vt1 + e * 144 + c0 * 2) = o1; *(LAS u32x2*)(Vt2 + e * 144 + c0 * 2) = o2; }
        __syncthreads();
        if (prod == 1) {
#pragma unroll
            for (int ks = 0; ks < 2; ++ks) { const bf16x8 a = ldfrag(ATs, 144, mt * 16 + l15, ks * 64 + q4 * 16);
#pragma unroll
                for (int nt = 0; nt < 2; ++nt) { const bf16x8 b = ldfrag(Vt1, 144, nt * 16 + l15, ks * 64 + q4 * 16); acc[nt] = MFMA16(a, b, acc[nt]); } }
#pragma unroll
            for (int nt = 0; nt < 2; ++nt)
#pragma unroll
                for (int r = 0; r < 4; ++r) F.PROJ()[(size_t)(t0 + mt * 16 + q4 * 4 + r) * NPROJ + d * 1024 + h * 128 + sl * 32 + nt * 16 + l15] = f2bf(acc[nt][r]);
        }
        { const float gl = __expf(glast);
#pragma unroll
          for (int nt = 0; nt < 2; ++nt) S[nt] *= gl;
#pragma unroll
          for (int ks = 0; ks < 2; ++ks) { bf16x8 a;
#pragma unroll
              for (int j = 0; j < 8; ++j) a[j] = *(const LAS short*)(Ks + (ks * 32 + q4 * 8 + j) * 272 + (wave * 16 + l15) * 2);
#pragma unroll
              for (int nt = 0; nt < 2; ++nt) { const bf16x8 b = ldfrag(Vt2, 144, nt * 16 + l15, ks * 64 + q4 * 16); S[nt] = MFMA16(a, b, S[nt]); } }
#pragma unroll
          for (int nt = 0; nt < 2; ++nt) { u32x2 o; o.x = pk2(S[nt][0], S[nt][1]); o.y = pk2(S[nt][2], S[nt][3]); *(LAS u32x2*)(Sb + (nt * 16 + l15) * 272 + (wave * 16 + q4 * 4) * 2) = o; } }
        __syncthreads();
    }
    if (!samp) {
        CHK(F, 14, badv(S[0][0], 100.f) || badv(S[1][3], 100.f));
#pragma unroll
        for (int nt = 0; nt < 2; ++nt)
#pragma unroll
            for (int r = 0; r < 4; ++r)
                F.out[OUT_SD + (size_t)((seq * 2 + d) * 8 + h) * 16384 + (size_t)(wave * 16 + q4 * 4 + r) * 128 + sl * 32 + nt * 16 + l15] = (LIVE_MASK & 4) ? fin(S[nt][r]) : 0.f;
    }
}
__device__ __forceinline__ void p4_run(CParams& p, Frame& F, int item) {
    if (item < 128) { const int chain = item >> 2; p4_item(p, F, 1, chain >> 4, (chain >> 1) & 7, chain & 1, item & 3); }
    else { const int it = item - 128, chain = it >> 2; p4_item(p, F, 0, chain >> 4, (chain >> 1) & 7, chain & 1, it & 3); }
}
__device__ __forceinline__ void phase4(CParams& p, Frame& F) {
    if (F.G == 256) rg_carry_scan(p, F);
    else if (F.b == 0) {
        for (int g = F.tid; g < 69632; g += 512) { int samp = g >= 65536, gg = samp ? g - 65536 : g, seq = gg >> 11, d = (gg >> 10) & 1, ch = gg & 1023;
            const int nch = samp ? 64 : 4, c_lo = samp ? 128 + seq * 64 : seq * 4; float h = samp ? p.state_rglru[(size_t)(seq * 2 + d) * 1024 + ch] : 0.f;
            for (int i = 0; i < nch; ++i) { const int cc = d == 0 ? c_lo + i : c_lo + nch - 1 - i; const float* ag = F.RGAGG() + (size_t)(cc * 2 + d) * 2048; F.CARRY()[(size_t)(cc * 2 + d) * 1024 + ch] = h; h = ag[ch] * h + ag[1024 + ch]; } } }
    __syncthreads();
    if (F.G == 256) {
        if ((F.b & 1) == 0) p4_run(p, F, F.b >> 1);
        else { const int pb = F.b >> 1; for (int i = 0; i < 16; ++i) p4_run(p, F, 128 + pb * 16 + i); }
    } else {
        for (int it = F.b; it < 128 + 2048; it += F.G) p4_run(p, F, it);
    }
}

__device__ __forceinline__ void phase5(CParams& p, Frame& F) {
    const int lane = F.lane;
    float nw[16];
#pragma unroll
    for (int q = 0; q < 4; ++q) { const f32x4 a = *(const f32x4*)(p.dn_norm_w + (lane & 7) * 16 + q * 4); nw[q * 4] = a[0]; nw[q * 4 + 1] = a[1]; nw[q * 4 + 2] = a[2]; nw[q * 4 + 3] = a[3]; }
    for (int tok = F.b * 8 + F.wave; tok < NTOK; tok += F.G * 8) {
        const bf16_t* pr = F.PROJ() + (size_t)tok * NPROJ + lane * 16;
        float o[16], z[16]; float ss = 0.f;
#pragma unroll
        for (int hf = 0; hf < 2; ++hf) { const u32x4 a = *(const u32x4*)(pr + hf * 8), b = *(const u32x4*)(pr + 1024 + hf * 8), zz = *(const u32x4*)(pr + 3072 + hf * 8);
            float fa[8], fb[8], fz[8]; unpack8(a, fa); unpack8(b, fb); unpack8(zz, fz);
#pragma unroll
            for (int e = 0; e < 8; ++e) { o[hf * 8 + e] = fa[e] + fb[e]; z[hf * 8 + e] = fz[e]; ss += o[hf * 8 + e] * o[hf * 8 + e]; } }
        ss += __shfl_xor(ss, 1); ss += __shfl_xor(ss, 2); ss += __shfl_xor(ss, 4);
        const float rs = rsqrtf(ss * (1.f / 128.f) + 1e-6f);
#pragma unroll
        for (int hf = 0; hf < 2; ++hf) { float w[8];
#pragma unroll
            for (int e = 0; e < 8; ++e) w[e] = o[hf * 8 + e] * rs * nw[hf * 8 + e] * siluf_(z[hf * 8 + e]);
            *(u32x4*)(F.MIX() + (size_t)tok * 2048 + lane * 16 + hf * 8) = pack8(w); }
    }
    __syncthreads();
    for (int it = F.b; it < 2048; it += F.G) rg_item<3>(p, F, it >> 3, it & 7);
}

__device__ __forceinline__ void phase6(CParams& p, Frame& F) {
    pg8::Gemm g{F.MIX(), F.WoutT(), NTOK, 1024, 2048}; pg8::StaticOrder S; S.init(NTOK, 1024, F.G, F.b); pg8::EpiF32 E{(float*)F.PROJ(), 3072};
    pg8::gemm_phase<pg8::EpiF32, pg8::StaticOrder>(F.lds, g, S, E);
}

__device__ __forceinline__ void phase7(CParams& p, Frame& F) {
    LAS float* gt = (LAS float*)F.lds;
    for (int tb = F.b; tb < 256; tb += F.G) {
        const int grp = grp_of_block(tb);
        for (int j = F.tid; j < 1024; j += 512) gt[j] = mod_val(p, F, grp, 2048 + j) * p.post_w[j];
        __syncthreads();
        for (int i = 0; i < 8; ++i) {
            const int tok = tb * 64 + F.wave * 8 + i;
            const float* xr = tok < 8192 ? p.x_prompt + (size_t)tok * 1024 : p.x_sample + (size_t)(tok - 8192) * 1024;
            const float* yr = (const float*)F.PROJ() + (size_t)tok * 3072;
            f32x4 y[4]; float ss = 0.f;
#pragma unroll
            for (int q = 0; q < 4; ++q) { y[q] = *(const f32x4*)(yr + F.lane * 4 + 256 * q); ss += (y[q][0] * y[q][0] + y[q][1] * y[q][1]) + (y[q][2] * y[q][2] + y[q][3] * y[q][3]); }
            const float rstd = rsqrtf(wave_sum(ss) * (1.f / 1024.f) + 1e-6f);
#pragma unroll
            for (int q = 0; q < 4; ++q) { const int j = F.lane * 4 + 256 * q; f32x4 v = *(const f32x4*)(xr + j);
                if (tok >= 8192) { const int pp = (tok - 8192) & 4095; const int vv = (q < 2) ? (pp >> 6) : (pp & 63);
                    v += *(const f32x4*)(F.pe() + ((q & 1) ? 16384 : 0) + vv * 256 + F.lane * 4); }
                const f32x4 g4 = *(const LAS f32x4*)(gt + j);
                f32x4 ov = v + g4 * (y[q] * rstd); ov[0] = fin(ov[0]); ov[1] = fin(ov[1]); ov[2] = fin(ov[2]); ov[3] = fin(ov[3]); if (!(LIVE_MASK & 1)) ov = (f32x4){0.f, 0.f, 0.f, 0.f}; *(f32x4*)(F.out + (size_t)tok * 1024 + j) = ov; }
        }
        __syncthreads();
    }
}

__device__ __forceinline__ void phase8(CParams& p, Frame& F) {
    if (F.b == 0 && F.tid == 0) { int code = 0; for (int k = 31; k >= 1; --k) if (DG(F)[k]) code = k; F.out[OUT_SR] = 1000.f * (float)code + 500.f; }
}
extern __shared__ __attribute__((aligned(16))) unsigned char smem_raw[];
__global__ void __launch_bounds__(512) fwd_megakernel(Params p_unused) {
    CParams& p = *(CParams*)__builtin_amdgcn_kernarg_segment_ptr();
    Frame F;
    F.lds = (LAS unsigned char*)smem_raw;
    F.tid = threadIdx.x; F.lane = F.tid & 63; F.wave = __builtin_amdgcn_readfirstlane(F.tid >> 6); F.G = gridDim.x; F.b = blockIdx.x;
    F.out = p.out; F.ws = p.ws;
    volatile LAS unsigned* xbw = (volatile LAS unsigned*)(F.lds + LDS_BYTES - 16);
    const bool multi = (p.ph_hi - p.ph_lo) > 1;
    XcdBarrier xb; xb.bar = (unsigned*)(p.ws + WS_CTL); xb.x = 0; xb.st = xbw;
    if (multi) {
        if (F.tid == 0) { xbw[0] = 0u; xbw[1] = 0u; xbw[2] = 0u; xbw[3] = 0u; }
        __syncthreads();
        xb = xcd_barrier_post((unsigned*)(p.ws + WS_CTL), xbw);
    }
#ifndef PHMASK
#define PHMASK 511
#endif
    const int lo = p.ph_lo, hi = p.ph_hi;
#ifndef REP_PHASE
#define REP_PHASE -1
#endif
#define RUN_PHASE(k, fn) do { if (lo <= (k) && (k) < hi) { if (PHMASK & (1 << (k))) fn(p, F); if ((k) == REP_PHASE) { __syncthreads(); fn(p, F); } if ((k) + 1 < hi) xcd_barrier(xb); } } while (0)
    RUN_PHASE(0, phase0); RUN_PHASE(1, phase1); RUN_PHASE(2, phase2); RUN_PHASE(3, phase3);
    RUN_PHASE(4, phase4); RUN_PHASE(5, phase5); RUN_PHASE(6, phase6); RUN_PHASE(7, phase7); RUN_PHASE(8, phase8);
}

extern "C" void kernel_launch(void* const* d_in, const int* in_sizes, int n_in, void* d_out, int out_size, void* d_ws, size_t ws_size, hipStream_t stream) {
    static int grid = 0;
    if (grid == 0) {
        int dev = 0, cus = 0;
        if (hipGetDevice(&dev) != hipSuccess || hipDeviceGetAttribute(&cus, hipDeviceAttributeMultiprocessorCount, dev) != hipSuccess) { fprintf(stderr, "kernel_launch: device query failed\n"); grid = -1; return; }
        if (hipFuncSetAttribute((const void*)fwd_megakernel, hipFuncAttributeMaxDynamicSharedMemorySize, LDS_BYTES) != hipSuccess) { fprintf(stderr, "kernel_launch: hipFuncSetAttribute failed\n"); grid = -1; return; }
        int per_cu = 0;
        if (hipOccupancyMaxActiveBlocksPerMultiprocessor(&per_cu, (const void*)fwd_megakernel, 512, LDS_BYTES) != hipSuccess || per_cu < 1) { fprintf(stderr, "kernel_launch: occupancy query says %d blocks per CU\n", per_cu); (void)hipGetLastError(); }
        grid = cus;
    }
    if (grid < 0) return;
    Params p{};
    const float** pp = (const float**)&p;
    for (int i = 0; i < 23; ++i) pp[i] = (const float*)d_in[i];
    p.out = (float*)d_out; p.ws = (unsigned char*)d_ws;
    (void)hipMemsetAsync((char*)d_ws + WS_CTL, 0, 16384, stream);
#if MK_SINGLE
    p.ph_lo = 0; p.ph_hi = NPH;
    void* args[] = {&p};
    hipError_t e = hipLaunchCooperativeKernel((const void*)fwd_megakernel, dim3(grid), dim3(512), args, LDS_BYTES, stream);
    if (e != hipSuccess) fprintf(stderr, "cooperative launch failed: %s (grid %d)\n", hipGetErrorString(e), grid);
#else
    for (int ph = 0; ph < NPH; ++ph) {
        p.ph_lo = ph; p.ph_hi = ph + 1;
        hipLaunchKernelGGL(fwd_megakernel, dim3(grid), dim3(512), LDS_BYTES, stream, p);
    }
#endif
}
```

```cpp
#include <hip/hip_runtime.h>
#include <cstdio>
#include <cstdint>

#define LAS __attribute__((address_space(3)))
typedef unsigned short bf16_t;
typedef short bf16x8 __attribute__((ext_vector_type(8)));
typedef float f32x4 __attribute__((ext_vector_type(4)));
typedef unsigned u32x4 __attribute__((ext_vector_type(4)));
typedef unsigned u32x2 __attribute__((ext_vector_type(2)));

#ifndef REP_PHASE
#define REP_PHASE -1
#endif
#ifndef MK_SINGLE
#define MK_SINGLE 1
#endif

constexpr int NTOK = 16384, DM = 1024, NPROJ = 6144, DIN = 6176;
constexpr int NPH = 8;
constexpr int LDS_BYTES = 160 * 1024;
constexpr size_t OUT_YP = 0, OUT_YS = 8388608, OUT_SD = 16777216, OUT_SR = 25165824;
constexpr size_t WS_CTL = 0, WS_MODP = 16384, WS_PE = 606208, WS_BA = 737280, WS_GB = 2834432, WS_RGAGG = 4931584,
                 WS_WBAT = 9125888, WS_WOUTT = 9191424, WS_GT = 13385728, WS_WINT = 14434304, WS_TA = 27017216, WS_PROJ = 60571648, WS_CARRY = 261898240;

struct Params {
    const float *x_prompt, *x_sample, *state_delta, *state_rglru, *c, *c_ctx, *ada_w, *ada_b, *pre_w, *post_w, *w_in, *w_out,
                *dn_conv_w, *dn_a_log, *dn_dt_bias, *dn_norm_w, *rg_conv_w, *rg_conv_b, *rg_w_r, *rg_b_r, *rg_w_i, *rg_b_i, *rg_lam;
    float* out; unsigned char* ws;
    int ph_lo, ph_hi;
};

__device__ __forceinline__ float bf2f(unsigned short b) { return __uint_as_float(((unsigned)b) << 16); }
__device__ __forceinline__ unsigned short f2bf(float f) { unsigned u = __float_as_uint(f); u += 0x7FFFu + ((u >> 16) & 1u); return (unsigned short)(u >> 16); }
__device__ __forceinline__ unsigned pk2(float lo, float hi) { return (unsigned)f2bf(lo) | ((unsigned)f2bf(hi) << 16); }
#ifndef SANITIZE
#define SANITIZE 0
#endif
#ifndef LIVE_MASK
#define LIVE_MASK 15
#endif
__device__ __forceinline__ float fin(float x) { return (SANITIZE && ((__float_as_uint(x) & 0x7f800000u) == 0x7f800000u)) ? 0.f : x; }
#define DG(F) ((unsigned*)((F).ws + WS_CTL))
__device__ __forceinline__ bool badv(float x, float lim) { return ((__float_as_uint(x) & 0x7f800000u) == 0x7f800000u) || fabsf(x) > lim; }
#ifndef DIAG
#define DIAG 0
#endif
#define CHK(F, k, bad) do { if (DIAG && (bad)) DG(F)[k] = 1u; } while (0)
__device__ __forceinline__ float sigm(float x) { return __builtin_amdgcn_rcpf(1.f + __expf(-x)); }
__device__ __forceinline__ float siluf_(float x) { return x * __builtin_amdgcn_rcpf(1.f + __expf(-x)); }
__device__ __forceinline__ float softplusf_(float x) { return x > 20.f ? x : log1pf(__expf(x)); }
__device__ __forceinline__ void unpack8(const u32x4 v, float (&f)[8]) {
    f[0] = __uint_as_float(v.x << 16); f[1] = __uint_as_float(v.x & 0xffff0000u);
    f[2] = __uint_as_float(v.y << 16); f[3] = __uint_as_float(v.y & 0xffff0000u);
    f[4] = __uint_as_float(v.z << 16); f[5] = __uint_as_float(v.z & 0xffff0000u);
    f[6] = __uint_as_float(v.w << 16); f[7] = __uint_as_float(v.w & 0xffff0000u);
}
__device__ __forceinline__ u32x4 pack8(const float (&f)[8]) { u32x4 o; o.x = pk2(f[0], f[1]); o.y = pk2(f[2], f[3]); o.z = pk2(f[4], f[5]); o.w = pk2(f[6], f[7]); return o; }
__device__ __forceinline__ float wave_sum(float v) {
#pragma unroll
    for (int o = 1; o < 64; o <<= 1) v += __shfl_xor(v, o);
    return v;
}
#define MFMA16(a, b, c) __builtin_amdgcn_mfma_f32_16x16x32_bf16((a), (b), (c), 0, 0, 0)
#define LDS_WAIT() asm volatile("s_waitcnt lgkmcnt(0)" ::: "memory")
__device__ __forceinline__ bf16x8 ldfrag(const LAS unsigned char* base, int pitch, int row, int kb) { return *(const LAS bf16x8*)(base + row * pitch + kb); }

#define XB_TMO      128
#define XB_XCNT(j)  (256  + 64 * (j))
#define XB_XSUB(j)  (1280 + 64 * (j))
#define XB_XGEN(j)  (2304 + 64 * (j))
#define XB_TOP      3328
#define XB_TOPGEN   3392
#define XCD_BAR_WORDS 3456
#define XB_SPIN_CAP (1u << 18)
__device__ __forceinline__ unsigned xb_ld(unsigned* p)              { return __hip_atomic_load(p, __ATOMIC_RELAXED, __HIP_MEMORY_SCOPE_AGENT); }
__device__ __forceinline__ unsigned xb_add(unsigned* p, unsigned v) { return __hip_atomic_fetch_add(p, v, __ATOMIC_RELAXED, __HIP_MEMORY_SCOPE_AGENT); }
__device__ __forceinline__ unsigned xb_xcc_id() { return (unsigned)__builtin_amdgcn_s_getreg((3 << 11) | 20) & 0xFu; }
#define XB_SPIN(cond, bar) do { unsigned _sp = 0; while (cond) { __builtin_amdgcn_s_sleep(1); \
    if ((++_sp & 255u) == 0u) { if (xb_ld(&(bar)[XB_TMO])) break; if (_sp > XB_SPIN_CAP) { atomicAdd(&(bar)[XB_TMO], 1u); break; } } } } while (0)
struct XcdBarrier { unsigned* bar; unsigned x; volatile LAS unsigned* st; };
__device__ __forceinline__ XcdBarrier xcd_barrier_post(unsigned* bar, volatile LAS unsigned* st) {
    XcdBarrier b; b.bar = bar; b.x = xb_xcc_id(); b.st = st;
    if (threadIdx.x == 0) (void)xb_add(&bar[XB_XCNT(b.x)], 1u);
    return b;
}
__device__ __forceinline__ void xcd_barrier_complete(unsigned* bar, unsigned x, unsigned& nloc, unsigned& nx) {
    const unsigned G = gridDim.x * gridDim.y * gridDim.z;
    unsigned sum, cnt, mine, sp = 0u;
    for (;;) {
        sum = 0u; cnt = 0u; mine = 0u;
#pragma unroll
        for (unsigned j = 0; j < 16; ++j) { const unsigned c = xb_ld(&bar[XB_XCNT(j)]); sum += c; cnt += (c > 0u) ? 1u : 0u; mine = (j == x) ? c : mine; }
        if (sum == G) break;
        __builtin_amdgcn_s_sleep(1);
        if ((++sp & 255u) == 0u) { if (xb_ld(&bar[XB_TMO])) break; if (sp > XB_SPIN_CAP) { atomicAdd(&bar[XB_TMO], 1u); break; } }
    }
    nloc = mine > 0u ? mine : 1u; nx = cnt > 0u ? cnt : 1u;
}
__device__ __forceinline__ void xcd_barrier(const XcdBarrier& b) {
    asm volatile("s_waitcnt vmcnt(0)" ::: "memory");
    __syncthreads();
    if (threadIdx.x == 0) {
        unsigned* bar = b.bar;
        __builtin_amdgcn_s_waitcnt(0);
        unsigned nloc = b.st[0], nx = b.st[1];
        if (nloc == 0u) { xcd_barrier_complete(bar, b.x, nloc, nx); b.st[0] = nloc; b.st[1] = nx; }
        const unsigned old = xb_add(&bar[XB_XSUB(b.x)], 1u);
        const unsigned gen = old / nloc;
        if (old + 1u == (gen + 1u) * nloc) {
            __builtin_amdgcn_fence(__ATOMIC_RELEASE, "agent");
            asm volatile("s_waitcnt vmcnt(0)" ::: "memory");
            const unsigned og = xb_add(&bar[XB_TOP], 1u);
            const unsigned tg = og / nx;
            if (og + 1u == (tg + 1u) * nx) xb_add(&bar[XB_TOPGEN], 1u);
            else XB_SPIN(xb_ld(&bar[XB_TOPGEN]) == tg, bar);
            __builtin_amdgcn_fence(__ATOMIC_ACQUIRE, "agent");
            xb_add(&bar[XB_XGEN(b.x)], 1u);
            asm volatile("s_waitcnt vmcnt(0)" ::: "memory");
        } else {
            XB_SPIN(xb_ld(&bar[XB_XGEN(b.x)]) == gen, bar);
            __builtin_amdgcn_fence(__ATOMIC_ACQUIRE, "agent");
            asm volatile("s_waitcnt vmcnt(0)" ::: "memory");
        }
    }
    __syncthreads();
}

namespace pg8 {
constexpr int BM = 256, BK = 64, HALF = 128, HTB = HALF * BK * 2, STAGE_BYTES = 8 * HTB, NXCD = 8, WGM = 8;
__host__ __device__ __forceinline__ int lds_byte(int r, int c) { const int st = (r >> 4) * 2 + (c >> 5), rr = r & 15, cc = c & 31, ob = rr * 64 + cc * 2; return st * 1024 + (ob ^ (((ob >> 9) & 1) << 5)); }
__host__ __device__ __forceinline__ void stage_rc(int b, int& R, int& C) { const int st = b / 1024, sb = b % 1024, swz = sb ^ (((sb >> 9) & 1) << 5); R = (st >> 1) * 16 + swz / 64; C = (st & 1) * 32 + (swz % 64) / 2; }
__host__ __device__ __forceinline__ int perm32(int rho) { const int n = rho >> 4, i = rho & 15; return 8 * (i >> 2) + 4 * n + (i & 3); }
struct Unit { int pm, pn; };
struct Gemm { const bf16_t* A; const bf16_t* Bt; int M, N, K; };
struct StaticOrder {
    int nM, nN, nwg, G, c;
    __host__ __device__ void init(int M, int N, int G_, int c_) { nM = M / BM; nN = N / BM; nwg = nM * nN; G = G_; c = c_; }
    __host__ __device__ bool next(int i, Unit& u) const {
        const long L = (long)i * G + c; if (L >= nwg) return false;
        int wgid = (int)L; { const int q = nwg / NXCD, r = nwg % NXCD, xcd = wgid % NXCD, off = wgid / NXCD; wgid = (xcd < r ? xcd * (q + 1) : r * (q + 1) + (xcd - r) * q) + off; }
        const int nig = WGM * nN, gid = wgid / nig, fm = gid * WGM, gsz = (nM - fm) < WGM ? (nM - fm) : WGM;
        u.pm = fm + ((wgid % nig) % gsz); u.pn = (wgid % nig) / gsz; return true;
    }
};
__device__ __forceinline__ unsigned cvt_pk_bf16(float lo, float hi) { unsigned r; asm volatile("v_cvt_pk_bf16_f32 %0, %1, %2" : "=v"(r) : "v"(lo), "v"(hi)); return r; }
struct EpiF32 {
    static constexpr bool PERM = false;
    float* C; int ldc;
    __device__ __forceinline__ void operator()(const f32x4 (&acc)[2][2][4][2], const Unit& u, int wr, int wc, int fr, int fq) const {
        const int row0 = u.pm * BM + wr * 64 + fr, col0 = u.pn * BM + wc * 32 + 4 * fq;
#pragma unroll
        for (int ai = 0; ai < 2; ++ai)
#pragma unroll
            for (int m = 0; m < 4; ++m) { float* rowp = C + (size_t)(row0 + ai * HALF + m * 16) * ldc + col0;
#pragma unroll
                for (int bj = 0; bj < 2; ++bj)
#pragma unroll
                    for (int n = 0; n < 2; ++n) *(f32x4*)(rowp + bj * HALF + n * 16) = acc[ai][bj][m][n]; }
    }
};
struct EpiBf16 {
    static constexpr bool PERM = true;
    bf16_t* O; int ldc;
    __device__ __forceinline__ void operator()(const f32x4 (&acc)[2][2][4][2], const Unit& u, int wr, int wc, int fr, int fq) const {
        const int row0 = u.pm * BM + wr * 64 + fr; const int col0 = u.pn * BM + wc * 32 + 8 * fq;
#pragma unroll
        for (int ai = 0; ai < 2; ++ai)
#pragma unroll
            for (int m = 0; m < 4; ++m) { bf16_t* rowp = O + (size_t)(row0 + ai * HALF + m * 16) * ldc + col0;
#pragma unroll
                for (int bj = 0; bj < 2; ++bj) { const f32x4 v0 = acc[ai][bj][m][0], v1 = acc[ai][bj][m][1];
                    u32x4 w; w.x = cvt_pk_bf16(v0[0], v0[1]); w.y = cvt_pk_bf16(v0[2], v0[3]); w.z = cvt_pk_bf16(v1[0], v1[1]); w.w = cvt_pk_bf16(v1[2], v1[3]);
                    *(u32x4*)(rowp + bj * HALF) = w; } }
    }
};

template <class Epi, class Sched>
__device__ __forceinline__ void gemm_phase(LAS unsigned char* lds, const Gemm g, const Sched& S, const Epi& E) {
    const int tid = threadIdx.x, wid = __builtin_amdgcn_readfirstlane(tid >> 6), lane = tid & 63, wr = wid >> 2, wc = wid & 3, fr = lane & 15, fq = lane >> 4;
    const int K = g.K, nt = K / BK;
    unsigned voffA[2], voffB[2];
#pragma unroll
    for (int i = 0; i < 2; ++i) { int R, C; stage_rc(tid * 16 + i * 8192, R, C); const int Rb = Epi::PERM ? ((R & ~31) + perm32(R & 31)) : R;
        voffA[i] = (unsigned)(R * K + C) * 2u; voffB[i] = (unsigned)(Rb * K + C) * 2u; }
    const size_t kstep = (size_t)(BK * 2);
    const size_t hstep = (size_t)HALF * K * 2;
    const size_t tstep = 2 * hstep;
    const unsigned ldsw = (unsigned)wid * 1024u;
    const int aoff = lds_byte(wr * 64 + fr, fq * 8), boff = lds_byte(wc * 32 + fr, fq * 8);
#define PG8_SA(b, h) (((b) * 2 + (h)) * HTB)
#define PG8_SB(b, h) ((4 + (b) * 2 + (h)) * HTB)
#define PG8_STAGE(bufoff, gbase, voff) do { _Pragma("unroll") for (int _i = 0; _i < 2; ++_i) \
        __builtin_amdgcn_global_load_lds((const unsigned*)((const char*)(gbase) + (voff)[_i]), (LAS unsigned*)(lds + (bufoff) + ldsw + _i * 8192), 16, 0, 0); } while (0)
#define PG8_LDA(dst, b, h) do { _Pragma("unroll") for (int m = 0; m < 4; ++m) _Pragma("unroll") for (int k = 0; k < 2; ++k) dst[m][k] = *(const LAS bf16x8*)(lds + PG8_SA(b, h) + aoff + m * 2048 + k * 1024); } while (0)
#define PG8_LDB(dst, b, h) do { _Pragma("unroll") for (int n = 0; n < 2; ++n) _Pragma("unroll") for (int k = 0; k < 2; ++k) dst[n][k] = *(const LAS bf16x8*)(lds + PG8_SB(b, h) + boff + n * 2048 + k * 1024); } while (0)
#define PG8_MMA(ai, bj, At, Bt) do { __builtin_amdgcn_s_setprio(1); _Pragma("unroll") for (int m = 0; m < 4; ++m) _Pragma("unroll") for (int n = 0; n < 2; ++n) _Pragma("unroll") for (int k = 0; k < 2; ++k) \
        acc[ai][bj][m][n] = __builtin_amdgcn_mfma_f32_16x16x32_bf16(Bt[n][k], At[m][k], acc[ai][bj][m][n], 0, 0, 0); __builtin_amdgcn_s_setprio(0); } while (0)
#define PG8_WAIT_V(n) asm volatile("s_waitcnt vmcnt(" #n ")" ::: "memory")
#define PG8_WAIT_L(n) asm volatile("s_waitcnt lgkmcnt(" #n ")" ::: "memory")
#define PG8_BAR __builtin_amdgcn_s_barrier()
#define PG8_SCHED __builtin_amdgcn_sched_barrier(0)
    Unit cur, nxt; int ui = 0;
    if (!S.next(0, cur)) return;
    f32x4 acc[2][2][4][2];
#pragma unroll
    for (int a = 0; a < 2; ++a)
#pragma unroll
        for (int b = 0; b < 2; ++b)
#pragma unroll
            for (int m = 0; m < 4; ++m)
#pragma unroll
                for (int n = 0; n < 2; ++n) acc[a][b][m][n] = (f32x4){0.f, 0.f, 0.f, 0.f};
    bf16x8 At[4][2], B0[2][2], B1[2][2];
    const char* cA = (const char*)g.A + (size_t)cur.pm * tstep; const char* cB = (const char*)g.Bt + (size_t)cur.pn * tstep;
    PG8_STAGE(PG8_SB(0, 0), cB, voffB); PG8_STAGE(PG8_SA(0, 0), cA, voffA); PG8_STAGE(PG8_SB(0, 1), cB + hstep, voffB); PG8_STAGE(PG8_SA(0, 1), cA + hstep, voffA);
    if (wr == 1) PG8_BAR;
    PG8_WAIT_V(4); PG8_BAR;
    PG8_STAGE(PG8_SB(1, 0), cB + kstep, voffB); PG8_STAGE(PG8_SA(1, 0), cA + kstep, voffA); PG8_STAGE(PG8_SB(1, 1), cB + hstep + kstep, voffB);
    PG8_WAIT_V(6); PG8_BAR;
    for (;;) {
        const bool has_next = S.next(ui + 1, nxt);
        const char* nA = has_next ? (const char*)g.A + (size_t)nxt.pm * tstep : cA; const char* nB = has_next ? (const char*)g.Bt + (size_t)nxt.pn * tstep : cB;
        for (int t = 0; t < nt; t += 2) {
            const bool last = (t == nt - 2);
            const char* a1 = cA + (size_t)(t + 1) * kstep;
            const char* a2 = last ? nA : cA + (size_t)(t + 2) * kstep; const char* b2 = last ? nB : cB + (size_t)(t + 2) * kstep;
            const char* a3 = a2 + kstep; const char* b3 = b2 + kstep;
            PG8_LDB(B0, 0, 0); PG8_SCHED; PG8_LDA(At, 0, 0); PG8_STAGE(PG8_SA(1, 1), a1 + hstep, voffA);
            PG8_WAIT_L(8); PG8_BAR; PG8_WAIT_L(0); PG8_MMA(0, 0, At, B0); PG8_BAR; PG8_SCHED;
            PG8_LDB(B1, 0, 1); PG8_STAGE(PG8_SB(0, 0), b2, voffB);
            PG8_BAR; PG8_WAIT_L(0); PG8_MMA(0, 1, At, B1); PG8_BAR;
            PG8_LDA(At, 0, 1); PG8_STAGE(PG8_SA(0, 0), a2, voffA);
            PG8_BAR; PG8_WAIT_L(0); PG8_MMA(1, 0, At, B0); PG8_BAR; PG8_SCHED;
            PG8_STAGE(PG8_SB(0, 1), b2 + hstep, voffB);
            PG8_WAIT_V(6); PG8_BAR; PG8_MMA(1, 1, At, B1); PG8_BAR;
            PG8_LDB(B0, 1, 0); PG8_SCHED; PG8_LDA(At, 1, 0); PG8_STAGE(PG8_SA(0, 1), a2 + hstep, voffA);
            PG8_WAIT_L(8); PG8_BAR; PG8_WAIT_L(0); PG8_MMA(0, 0, At, B0); PG8_BAR; PG8_SCHED;
            PG8_LDB(B1, 1, 1); PG8_STAGE(PG8_SB(1, 0), b3, voffB);
            PG8_BAR; PG8_WAIT_L(0); PG8_MMA(0, 1, At, B1); PG8_BAR;
            PG8_LDA(At, 1, 1); PG8_STAGE(PG8_SA(1, 0), a3, voffA);
            PG8_BAR; PG8_WAIT_L(0); PG8_MMA(1, 0, At, B0); PG8_BAR; PG8_SCHED;
            PG8_STAGE(PG8_SB(1, 1), b3 + hstep, voffB);
            PG8_WAIT_V(6); PG8_BAR; PG8_MMA(1, 1, At, B1); PG8_BAR;
        }
        E(acc, cur, wr, wc, fr, fq);
        if (!has_next) break;
#pragma unroll
        for (int a = 0; a < 2; ++a)
#pragma unroll
            for (int b = 0; b < 2; ++b)
#pragma unroll
                for (int m = 0; m < 4; ++m)
#pragma unroll
                    for (int n = 0; n < 2; ++n) acc[a][b][m][n] = (f32x4){0.f, 0.f, 0.f, 0.f};
        cur = nxt; cA = nA; cB = nB; ++ui;
    }
    PG8_WAIT_V(0);
    if (wr == 0) PG8_BAR;
    PG8_BAR;
#undef PG8_SA
#undef PG8_SB
#undef PG8_STAGE
#undef PG8_LDA
#undef PG8_LDB
#undef PG8_MMA
#undef PG8_WAIT_V
#undef PG8_WAIT_L
#undef PG8_BAR
#undef PG8_SCHED
}
}

struct Frame {
    LAS unsigned char* lds;
    int tid, lane, wave, G, b;
    float* out; unsigned char* ws;
    __device__ __forceinline__ bf16_t* H() const { return (bf16_t*)out; }
    __device__ __forceinline__ bf16_t* Qc() const { return (bf16_t*)out; }
    __device__ __forceinline__ bf16_t* Kc() const { return (bf16_t*)(out + OUT_YS); }
    __device__ __forceinline__ bf16_t* MIX() const { return (bf16_t*)out; }
    __device__ __forceinline__ float* modp() const { return (float*)(ws + WS_MODP); }
    __device__ __forceinline__ float* pe() const { return (float*)(ws + WS_PE); }
    __device__ __forceinline__ float* BA() const { return (float*)(ws + WS_BA); }
    __device__ __forceinline__ float* GB() const { return (float*)(ws + WS_GB); }
    __device__ __forceinline__ float* RGAGG() const { return (float*)(ws + WS_RGAGG); }
    __device__ __forceinline__ bf16_t* WbaT() const { return (bf16_t*)(ws + WS_WBAT); }
    __device__ __forceinline__ bf16_t* WoutT() const { return (bf16_t*)(ws + WS_WOUTT); }
    __device__ __forceinline__ bf16_t* GT() const { return (bf16_t*)(ws + WS_GT); }
    __device__ __forceinline__ bf16_t* WinT() const { return (bf16_t*)(ws + WS_WINT); }
    __device__ __forceinline__ bf16_t* TA() const { return (bf16_t*)(ws + WS_TA); }
    __device__ __forceinline__ bf16_t* PROJ() const { return (bf16_t*)(ws + WS_PROJ); }
    __device__ __forceinline__ float* CARRY() const { return (float*)(ws + WS_CARRY); }
};
typedef const __attribute__((address_space(4))) Params CParams;

__device__ __forceinline__ int grp_of_block(int tb) { return tb < 128 ? 0 : (tb < 192 ? 1 : 2); }

__device__ __forceinline__ void transpose_item(const float* W, int N, int k0, int n0, bf16_t* WT0, int Kout, LAS float* scr, int lane) {
#pragma unroll 8
    for (int i = 0; i < 32; ++i) { const int kk = 2 * i + (lane >> 5); scr[kk * 33 + (lane & 31)] = W[(size_t)(k0 + kk) * N + n0 + (lane & 31)]; }
    LDS_WAIT();
    const int c = lane & 7;
#pragma unroll
    for (int j = 0; j < 4; ++j) { const int n = (lane >> 3) + 8 * j; const LAS float* s = scr + (8 * c) * 33 + n;
        u32x4 o; o.x = pk2(s[0 * 33], s[1 * 33]); o.y = pk2(s[2 * 33], s[3 * 33]); o.z = pk2(s[4 * 33], s[5 * 33]); o.w = pk2(s[6 * 33], s[7 * 33]);
        *(u32x4*)(WT0 + (size_t)n * Kout + k0 + 8 * c) = o; }
    LDS_WAIT();
}
__device__ __forceinline__ void phase0(CParams& p, Frame& F) {
    const int tid = F.tid, lane = F.lane;
    for (int it = F.b; it < 192; it += F.G) {
        const int jg = it % 12, ks = it / 12, j = jg * 256 + (tid & 255), half = tid >> 8, k0 = ks * 64 + half * 32;
        float s0 = 0.f, s1 = 0.f, s2 = 0.f;
#pragma unroll 8
        for (int k = 0; k < 32; ++k) { const int kk = k0 + k; const float w = p.ada_w[(size_t)kk * 3072 + j];
            s0 += siluf_(p.c_ctx[kk]) * w; s1 += siluf_(p.c[kk]) * w; s2 += siluf_(p.c[1024 + kk]) * w; }
        LAS float* red = (LAS float*)F.lds;
        if (half == 1) { red[tid - 256] = s0; red[256 + tid - 256] = s1; red[512 + tid - 256] = s2; }
        __syncthreads();
        if (half == 0) { F.modp()[(size_t)(ks * 3 + 0) * 3072 + j] = s0 + red[tid]; F.modp()[(size_t)(ks * 3 + 1) * 3072 + j] = s1 + red[256 + tid]; F.modp()[(size_t)(ks * 3 + 2) * 3072 + j] = s2 + red[512 + tid]; }
        __syncthreads();
    }
    LAS float* scr = (LAS float*)(F.lds + 4096 + F.wave * 8448);
    const int gw = F.b * 8 + F.wave, NGW = F.G * 8;
    constexpr int I_IN = 16 * 193, I_OUT = 32 * 32, I_G = 256, I_PE = 64;
    for (int it = gw; it < I_IN + I_OUT + I_G + I_PE; it += NGW) {
        int r = it;
        if (r < I_IN) { const int kb = r / 193, nb = r % 193, n0 = nb * 32;
            bf16_t* dst = n0 < 4096 ? F.WinT() + (size_t)n0 * 1024 : (n0 < 4128 ? F.WbaT() + (size_t)(n0 - 4096) * 1024 : F.WinT() + (size_t)(n0 - 32) * 1024);
            transpose_item(p.w_in, DIN, kb * 64, n0, dst, 1024, scr, lane); continue; }
        r -= I_IN;
        if (r < I_OUT) { const int kb = r / 32, nb = r % 32; transpose_item(p.w_out, 1024, kb * 64, nb * 32, F.WoutT() + (size_t)(nb * 32) * 2048, 2048, scr, lane); continue; }
        r -= I_OUT;
        if (r < I_G) { const int m = r >> 3, sub = r & 7, kb = sub >> 2, nb = sub & 3, g = m >> 4, dn = m & 15;
            const float* src = (g ? p.rg_w_i : p.rg_w_r) + (size_t)dn * 16384;
            transpose_item(src, 128, kb * 64, nb * 32, F.GT() + (size_t)m * 16384 + (size_t)(nb * 32) * 128, 128, scr, lane); continue; }
        r -= I_G;
        { const int v = r;
#pragma unroll
          for (int i = 0; i < 4; ++i) { const int idx = lane * 4 + i; const float f = expf(-9.210340371976184f * (float)idx / 256.f); const float a = (float)v * f;
              F.pe()[v * 256 + idx] = sinf(a); F.pe()[16384 + v * 256 + idx] = cosf(a); } }
    }
}

__device__ __forceinline__ float mod_val(CParams& p, const Frame& F, int grp, int j) {
    float s = p.ada_b[j];
#pragma unroll
    for (int ks = 0; ks < 16; ++ks) s += F.modp()[(size_t)(ks * 3 + grp) * 3072 + j];
    return s;
}

__device__ __forceinline__ void phase1(CParams& p, Frame& F) {
    LAS float* sc = (LAS float*)F.lds; LAS float* sh = sc + 1024;
    for (int tb = F.b; tb < 256; tb += F.G) {
        const int grp = grp_of_block(tb);
        for (int j = F.tid; j < 1024; j += 512) { sh[j] = mod_val(p, F, grp, j); sc[j] = p.pre_w[j] * (1.f + mod_val(p, F, grp, 1024 + j)); }
        __syncthreads();
        for (int i = 0; i < 8; ++i) {
            const int tok = tb * 64 + F.wave * 8 + i;
            const float* xr = tok < 8192 ? p.x_prompt + (size_t)tok * 1024 : p.x_sample + (size_t)(tok - 8192) * 1024;
            f32x4 v[4]; float ss = 0.f;
#pragma unroll
            for (int q = 0; q < 4; ++q) { v[q] = *(const f32x4*)(xr + F.lane * 4 + 256 * q);
                if (tok >= 8192) { const int pp = (tok - 8192) & 4095; const int vv = (q < 2) ? (pp >> 6) : (pp & 63);
                    const f32x4 e = *(const f32x4*)(F.pe() + ((q & 1) ? 16384 : 0) + vv * 256 + F.lane * 4); v[q] += e; }
                ss += (v[q][0] * v[q][0] + v[q][1] * v[q][1]) + (v[q][2] * v[q][2] + v[q][3] * v[q][3]); }
            const float rstd = rsqrtf(wave_sum(ss) * (1.f / 1024.f) + 1e-6f);
#pragma unroll
            for (int q = 0; q < 4; ++q) { const int j = F.lane * 4 + 256 * q; const f32x4 s4 = *(const LAS f32x4*)(sc + j), h4 = *(const LAS f32x4*)(sh + j);
                CHK(F, 1, badv(v[q][0] * rstd * s4[0] + h4[0], 100.f) || badv(v[q][3] * rstd * s4[3] + h4[3], 100.f));
                u32x2 o; o.x = pk2(v[q][0] * rstd * s4[0] + h4[0], v[q][1] * rstd * s4[1] + h4[1]); o.y = pk2(v[q][2] * rstd * s4[2] + h4[2], v[q][3] * rstd * s4[3] + h4[3]);
                *(u32x2*)(F.H() + (size_t)tok * 1024 + j) = o; }
        }
        __syncthreads();
    }
}

__device__ __forceinline__ void phase2(CParams& p, Frame& F) {
    { pg8::Gemm g{F.H(), F.WinT(), NTOK, NPROJ, 1024}; pg8::StaticOrder S; S.init(NTOK, NPROJ, F.G, F.b); pg8::EpiBf16 E{F.PROJ(), NPROJ};
      pg8::gemm_phase<pg8::EpiBf16, pg8::StaticOrder>(F.lds, g, S, E); }
    const int l15 = F.lane & 15, q4 = F.lane >> 4;
    for (int tb = F.b; tb < 256; tb += F.G) {
        const int mt = F.wave >> 1, nt = F.wave & 1;
        const bf16_t* ar = F.H() + (size_t)(tb * 64 + mt * 16 + l15) * 1024 + q4 * 8;
        const bf16_t* br = F.WbaT() + (size_t)(nt * 16 + l15) * 1024 + q4 * 8;
        f32x4 acc = {0.f, 0.f, 0.f, 0.f};
#pragma unroll 4
        for (int ks = 0; ks < 32; ++ks) { const bf16x8 a = *(const bf16x8*)(ar + ks * 32), b = *(const bf16x8*)(br + ks * 32); acc = MFMA16(a, b, acc); }
#pragma unroll
        for (int r = 0; r < 4; ++r) F.BA()[(size_t)(tb * 64 + mt * 16 + q4 * 4 + r) * 32 + nt * 16 + l15] = acc[r];
    }
}

__device__ __forceinline__ void p3_delta_item(CParams& p, Frame& F, int ci, int h) {
    const int tid = F.tid, lane = F.lane, wave = F.wave, q4 = lane >> 4, l15 = lane & 15;
    LAS unsigned char* Ks = F.lds; LAS unsigned char* Qs = F.lds + 17408;
    LAS float* gfv = (LAS float*)(F.lds + 34816);
    LAS unsigned char* DIR0 = F.lds + 35840;
    LAS unsigned char* ATo = F.lds + 137728;
#pragma unroll
    for (int i = 0; i < 5; ++i) { const int ch = tid + 512 * i; if (ch < 2304) { const int dd = ch >= 1152, cc = ch - dd * 1152; *(LAS u32x4*)(DIR0 + dd * 46848 + 18432 + cc * 16) = (u32x4){0u, 0u, 0u, 0u}; } }
    const int t0 = ci * 64;
    int seq_lo, seq_hi; if (ci < 128) { seq_lo = (ci >> 2) * 256; seq_hi = seq_lo + 256; } else { seq_lo = 8192 + ((ci - 128) >> 6) * 4096; seq_hi = seq_lo + 4096; }
    {
        const int tg = tid >> 5, part = (tid >> 4) & 1, sub = tid & 15, col = part * 1024 + h * 128 + sub * 8;
        float w[4][8];
#pragma unroll
        for (int j = 0; j < 4; ++j) { const f32x4 a = *(const f32x4*)(p.dn_conv_w + j * 3072 + col), b = *(const f32x4*)(p.dn_conv_w + j * 3072 + col + 4);
            w[j][0] = a[0]; w[j][1] = a[1]; w[j][2] = a[2]; w[j][3] = a[3]; w[j][4] = b[0]; w[j][5] = b[1]; w[j][6] = b[2]; w[j][7] = b[3]; }
        float acc[4][8];
#pragma unroll
        for (int i = 0; i < 4; ++i)
#pragma unroll
            for (int e = 0; e < 8; ++e) acc[i][e] = 0.f;
        const int tb = t0 + tg * 4 - 2;
#pragma unroll
        for (int r = 0; r < 7; ++r) { const int tok = tb + r; u32x4 v = {0u, 0u, 0u, 0u};
            if (tok >= seq_lo && tok < seq_hi) v = *(const u32x4*)(F.PROJ() + (size_t)tok * NPROJ + col);
            float x[8]; unpack8(v, x);
            CHK(F, 2, badv(x[0], 1000.f) || badv(x[3], 1000.f) || badv(x[7], 1000.f));
#pragma unroll
            for (int j = 0; j < 4; ++j) { const int i = r - j; if (i >= 0 && i < 4) {
#pragma unroll
                for (int e = 0; e < 8; ++e) acc[i][e] += w[j][e] * x[e]; } } }
#pragma unroll
        for (int i = 0; i < 4; ++i) { float ss = 0.f;
#pragma unroll
            for (int e = 0; e < 8; ++e) { acc[i][e] = siluf_(acc[i][e]); ss += acc[i][e] * acc[i][e]; }
            ss += __shfl_xor(ss, 1); ss += __shfl_xor(ss, 2); ss += __shfl_xor(ss, 4); ss += __shfl_xor(ss, 8);
            const float rs = rsqrtf(ss + 1e-6f) * (part == 0 ? 0.08838834764831845f : 1.f);
#pragma unroll
            for (int e = 0; e < 8; ++e) acc[i][e] *= rs;
            CHK(F, 4, badv(acc[i][0], 1.01f) || badv(acc[i][5], 1.01f) || badv(ss * rs * rs, part == 0 ? 0.0079f : 1.01f));
            const u32x4 o = pack8(acc[i]); const int c = tg * 4 + i;
            *(LAS u32x4*)((part ? Ks : Qs) + c * 272 + sub * 16) = o;
            *(u32x4*)((part ? F.Kc() : F.Qc()) + (size_t)(t0 + c) * 1024 + h * 128 + sub * 8) = o; }
    }
    if (wave == 0) {
        const float* ba = F.BA() + (size_t)(t0 + lane) * 32;
        const float bf_ = sigm(ba[h]), bb_ = sigm(ba[8 + h]);
        float s = -expf(p.dn_a_log[h]) * softplusf_(ba[16 + h] + p.dn_dt_bias[h]);
        float sb = -expf(p.dn_a_log[8 + h]) * softplusf_(ba[24 + h] + p.dn_dt_bias[8 + h]);
#pragma unroll
        for (int o = 1; o < 64; o <<= 1) { const float t = __shfl_up(s, o); if (lane >= o) s += t; }
#pragma unroll
        for (int o = 1; o < 64; o <<= 1) { const float t = __shfl_down(sb, o); if (lane + o < 64) sb += t; }
        CHK(F, 3, badv(ba[h], 1000.f) || badv(ba[24 + h], 1000.f));
        CHK(F, 8, badv(s, 1e4f) || badv(sb, 1e4f) || s > 0.f || sb > 0.f || bf_ < 0.f || bf_ > 1.f || bb_ < 0.f || bb_ > 1.f);
        gfv[lane] = s; gfv[64 + lane] = sb; gfv[128 + lane] = bf_; gfv[192 + lane] = bb_;
        float* gb = F.GB() + (size_t)(ci * 8 + h) * 256;
        gb[lane] = s; gb[64 + lane] = sb; gb[128 + lane] = bf_; gb[192 + lane] = bb_;
    }
    __syncthreads();
    const int d = wave >> 2, mt = wave & 3;
    LAS unsigned char* Db = DIR0 + d * 46848;
    LAS unsigned char* Brow = Db; LAS unsigned char* Btr = Db + 9216; LAS unsigned char* Xrow = Db + 18432; LAS unsigned char* Xtr = Db + 27648;
    LAS float* Dl = (LAS float*)(Db + 36864) + mt * 272; LAS unsigned char* M2t = Db + 41216; LAS unsigned char* Mts = Db + 43776 + mt * 768;
    const LAS unsigned char* Lrow = d == 0 ? Brow : Btr;
    const LAS float* gd = gfv + d * 64; const LAS float* bd = gfv + 128 + d * 64;
    {
        f32x4 kk[4], qk[4];
#pragma unroll
        for (int n = 0; n < 4; ++n) { kk[n] = (f32x4){0.f, 0.f, 0.f, 0.f}; qk[n] = (f32x4){0.f, 0.f, 0.f, 0.f}; }
#pragma unroll
        for (int ks = 0; ks < 4; ++ks) { const bf16x8 ak = ldfrag(Ks, 272, mt * 16 + l15, ks * 64 + q4 * 16), aq = ldfrag(Qs, 272, mt * 16 + l15, ks * 64 + q4 * 16);
#pragma unroll
            for (int n = 0; n < 4; ++n) { const bf16x8 bk = ldfrag(Ks, 272, n * 16 + l15, ks * 64 + q4 * 16); kk[n] = MFMA16(ak, bk, kk[n]); qk[n] = MFMA16(aq, bk, qk[n]); } }
#pragma unroll
        for (int n = 0; n < 4; ++n) { const int s = n * 16 + l15; float a4[4];
#pragma unroll
            for (int r = 0; r < 4; ++r) { const int c = mt * 16 + q4 * 4 + r;
                const float dec = __expf(fminf(gd[c] - gd[s], 0.f));
                const bool strict = d == 0 ? (c > s) : (c < s);
                const float a = strict ? bd[c] * kk[n][r] * dec : 0.f;
                a4[r] = a;
                ((LAS bf16_t*)Brow)[c * 72 + s] = f2bf(a);
                if (n == mt) { if (d == 0) Dl[(q4 * 4 + r) * 17 + l15] = a; else Dl[l15 * 17 + q4 * 4 + r] = a; }
                const bool incl = d == 0 ? (c >= s) : (c < s);
                if (incl) ((LAS bf16_t*)ATo)[c * 64 + s] = f2bf(qk[n][r] * dec); }
            u32x2 o; o.x = pk2(a4[0], a4[1]); o.y = pk2(a4[2], a4[3]);
            *(LAS u32x2*)(Btr + s * 144 + (mt * 16 + q4 * 4) * 2) = o; }
    }
    __syncthreads();
    if (lane < 16) {
        float x[16];
#pragma unroll
        for (int i = 0; i < 16; ++i) { float sv = (i == lane) ? 1.f : 0.f;
#pragma unroll
            for (int j = 0; j < i; ++j) sv -= Dl[i * 17 + j] * x[j];
            x[i] = sv; }
#pragma unroll
        for (int i = 0; i < 16; ++i) ((LAS bf16_t*)Xrow)[(mt * 16 + i) * 72 + mt * 16 + lane] = f2bf(x[i]);
        u32x4 o0, o1; o0.x = pk2(x[0], x[1]); o0.y = pk2(x[2], x[3]); o0.z = pk2(x[4], x[5]); o0.w = pk2(x[6], x[7]);
        o1.x = pk2(x[8], x[9]); o1.y = pk2(x[10], x[11]); o1.z = pk2(x[12], x[13]); o1.w = pk2(x[14], x[15]);
        *(LAS u32x4*)(Xtr + (mt * 16 + lane) * 144 + mt * 32) = o0; *(LAS u32x4*)(Xtr + (mt * 16 + lane) * 144 + mt * 32 + 16) = o1;
    }
    __syncthreads();
    const bf16x8 zero8 = {0, 0, 0, 0, 0, 0, 0, 0};
    const f32x4 zero4 = {0.f, 0.f, 0.f, 0.f};
    if (mt & 1) {
        const int I1 = mt, I0 = mt - 1;
        bf16x8 a = zero8, b = zero8;
        if (q4 < 2) { a = ldfrag(Lrow, 144, I1 * 16 + l15, I0 * 32 + q4 * 16); b = ldfrag(Xtr, 144, I0 * 16 + l15, I0 * 32 + q4 * 16); }
        const f32x4 M = MFMA16(a, b, zero4);
        { u32x2 o; o.x = pk2(M[0], M[1]); o.y = pk2(M[2], M[3]); *(LAS u32x2*)(Mts + l15 * 48 + q4 * 8) = o; }
        LDS_WAIT();
        bf16x8 a2 = zero8, b2 = zero8;
        if (q4 < 2) { a2 = ldfrag(Xrow, 144, I1 * 16 + l15, I1 * 32 + q4 * 16); b2 = *(const LAS bf16x8*)(Mts + l15 * 48 + q4 * 16); }
        const f32x4 X = MFMA16(a2, b2, zero4);
#pragma unroll
        for (int r = 0; r < 4; ++r) ((LAS bf16_t*)Xrow)[(I1 * 16 + q4 * 4 + r) * 72 + I0 * 16 + l15] = f2bf(-X[r]);
        u32x2 o; o.x = pk2(-X[0], -X[1]); o.y = pk2(-X[2], -X[3]);
        *(LAS u32x2*)(Xtr + (I0 * 16 + l15) * 144 + (I1 * 16 + q4 * 4) * 2) = o;
    }
    __syncthreads();
    {
        const int mi = mt >> 1, ni = mt & 1;
        const bf16x8 a = ldfrag(Lrow, 144, 32 + mi * 16 + l15, q4 * 16), b = ldfrag(Xtr, 144, ni * 16 + l15, q4 * 16);
        const f32x4 M2 = MFMA16(a, b, zero4);
        { u32x2 o; o.x = pk2(M2[0], M2[1]); o.y = pk2(M2[2], M2[3]); *(LAS u32x2*)(M2t + (ni * 16 + l15) * 80 + (mi * 16 + q4 * 4) * 2) = o; }
        __syncthreads();
        const bf16x8 a2 = ldfrag(Xrow, 144, 32 + mi * 16 + l15, 64 + q4 * 16), b2 = *(const LAS bf16x8*)(M2t + (ni * 16 + l15) * 80 + q4 * 16);
        const f32x4 X = MFMA16(a2, b2, zero4);
#pragma unroll
        for (int r = 0; r < 4; ++r) { CHK(F, 6, badv(X[r], 20.f)); ((LAS bf16_t*)Xrow)[(32 + mi * 16 + q4 * 4 + r) * 72 + ni * 16 + l15] = f2bf(-X[r]); }
        u32x2 o; o.x = pk2(-X[0], -X[1]); o.y = pk2(-X[2], -X[3]);
        *(LAS u32x2*)(Xtr + (ni * 16 + l15) * 144 + (32 + mi * 16 + q4 * 4) * 2) = o;
    }
    __syncthreads();
    { bf16_t* dst = F.TA() + (size_t)(ci * 8 + h) * 8192;
      const int c = tid >> 3, s0 = (tid & 7) * 8;
      const u32x4 lo = *(const LAS u32x4*)(DIR0 + 18432 + c * 144 + s0 * 2), up = *(const LAS u32x4*)(DIR0 + 46848 + 27648 + c * 144 + s0 * 2);
      unsigned wl[4] = {lo.x, lo.y, lo.z, lo.w}, wu[4] = {up.x, up.y, up.z, up.w}, wo[4];
#pragma unroll
      for (int i = 0; i < 4; ++i) { const int sa = s0 + 2 * i, sb2 = sa + 1;
          const unsigned mlo = (sa <= c ? 0x0000FFFFu : 0u) | (sb2 <= c ? 0xFFFF0000u : 0u);
          wo[i] = (wl[i] & mlo) | (wu[i] & ~mlo); }
      *(u32x4*)(dst + tid * 8) = (u32x4){wo[0], wo[1], wo[2], wo[3]};
      *(u32x4*)(dst + 4096 + tid * 8) = *(const LAS u32x4*)(ATo + tid * 16); }
    __syncthreads();
}

struct RgW { bf16x8 g[2][2][4]; float br[2], bi[2], sp[2]; };
__device__ __forceinline__ void rg_load_w(CParams& p, const Frame& F, int n, RgW& W) {
    const int q4 = F.lane >> 4, j = F.wave * 16 + (F.lane & 15), ch = n * 128 + j;
#pragma unroll
    for (int d = 0; d < 2; ++d) {
#pragma unroll
        for (int g = 0; g < 2; ++g) { const bf16_t* gp = F.GT() + (size_t)((g * 2 + d) * 8 + n) * 16384 + (size_t)j * 128 + q4 * 8;
#pragma unroll
            for (int ks = 0; ks < 4; ++ks) W.g[d][g][ks] = *(const bf16x8*)(gp + ks * 32); }
        W.br[d] = p.rg_b_r[d * 1024 + ch]; W.bi[d] = p.rg_b_i[d * 1024 + ch]; W.sp[d] = softplusf_(-p.rg_lam[d * 1024 + ch]); }
}
template <int PASS>
__device__ __forceinline__ void rg_item(CParams& p, Frame& F, int ci, int n) {
    const int tid = F.tid, lane = F.lane, wave = F.wave, q4 = lane >> 4, l15 = lane & 15;
    LAS unsigned char* xb = F.lds; LAS float* xf = (LAS float*)(F.lds + 17408); LAS float* Hs = (LAS float*)(F.lds + 50176);
    const int t0 = ci * 64;
    int seq_lo, seq_hi, c_lo, c_hi, seq; const bool samp = ci >= 128;
    if (!samp) { seq = ci >> 2; c_lo = seq * 4; c_hi = c_lo + 4; } else { seq = (ci - 128) >> 6; c_lo = 128 + seq * 64; c_hi = c_lo + 64; }
    seq_lo = c_lo * 64; seq_hi = c_hi * 64;
    const int j = wave * 16 + l15, ch = n * 128 + j;
    bf16x8 wA[2][4], wB[2][4];
#pragma unroll
    for (int g = 0; g < 2; ++g) { const bf16_t* gp = F.GT() + (size_t)((g * 2 + 0) * 8 + n) * 16384 + (size_t)j * 128 + q4 * 8;
#pragma unroll
        for (int ks = 0; ks < 4; ++ks) wA[g][ks] = *(const bf16x8*)(gp + ks * 32); }
    {
        const int tg = tid >> 4, sub = tid & 15, ch = n * 128 + sub * 8, col = 4096 + ch;
        float w[4][8], acc[2][8];
#pragma unroll
        for (int j = 0; j < 4; ++j) { const f32x4 a = *(const f32x4*)(p.rg_conv_w + j * 1024 + ch), b = *(const f32x4*)(p.rg_conv_w + j * 1024 + ch + 4);
            w[j][0] = a[0]; w[j][1] = a[1]; w[j][2] = a[2]; w[j][3] = a[3]; w[j][4] = b[0]; w[j][5] = b[1]; w[j][6] = b[2]; w[j][7] = b[3]; }
        { const f32x4 a = *(const f32x4*)(p.rg_conv_b + ch), b = *(const f32x4*)(p.rg_conv_b + ch + 4);
#pragma unroll
          for (int i = 0; i < 2; ++i) { acc[i][0] = a[0]; acc[i][1] = a[1]; acc[i][2] = a[2]; acc[i][3] = a[3]; acc[i][4] = b[0]; acc[i][5] = b[1]; acc[i][6] = b[2]; acc[i][7] = b[3]; } }
        const int tb = t0 + tg * 2 - 2;
#pragma unroll
        for (int r = 0; r < 5; ++r) { const int tok = tb + r; u32x4 v = {0u, 0u, 0u, 0u};
            if (tok >= seq_lo && tok < seq_hi) v = *(const u32x4*)(F.PROJ() + (size_t)tok * NPROJ + col);
            float x[8]; unpack8(v, x);
#pragma unroll
            for (int j = 0; j < 4; ++j) { const int i = r - j; if (i >= 0 && i < 2) {
#pragma unroll
                for (int e = 0; e < 8; ++e) acc[i][e] += w[j][e] * x[e]; } } }
#pragma unroll
        for (int i = 0; i < 2; ++i) { const int c = tg * 2 + i;
            *(LAS u32x4*)(xb + c * 272 + sub * 16) = pack8(acc[i]);
            *(LAS f32x4*)(xf + c * 128 + sub * 8) = (f32x4){acc[i][0], acc[i][1], acc[i][2], acc[i][3]};
            *(LAS f32x4*)(xf + c * 128 + sub * 8 + 4) = (f32x4){acc[i][4], acc[i][5], acc[i][6], acc[i][7]}; }
    }
    __syncthreads();
    f32x4 hs[4];
#pragma unroll
    for (int m = 0; m < 4; ++m) hs[m] = (f32x4){0.f, 0.f, 0.f, 0.f};
#pragma unroll
    for (int d = 0; d < 2; ++d) {
        f32x4 av[4], bxv[4];
        {
            f32x4 ar[4], ai[4];
#pragma unroll
            for (int m = 0; m < 4; ++m) { ar[m] = (f32x4){0.f, 0.f, 0.f, 0.f}; ai[m] = (f32x4){0.f, 0.f, 0.f, 0.f}; }
#pragma unroll
            for (int ks = 0; ks < 4; ++ks) { const bf16x8 br = d == 0 ? wA[0][ks] : wB[0][ks], bi = d == 0 ? wA[1][ks] : wB[1][ks];
#pragma unroll
                for (int m = 0; m < 4; ++m) { const bf16x8 a = ldfrag(xb, 272, m * 16 + l15, ks * 64 + q4 * 16); ar[m] = MFMA16(a, br, ar[m]); ai[m] = MFMA16(a, bi, ai[m]); } }
            if (d == 0) {
#pragma unroll
                for (int g = 0; g < 2; ++g) { const bf16_t* gp = F.GT() + (size_t)((g * 2 + 1) * 8 + n) * 16384 + (size_t)j * 128 + q4 * 8;
#pragma unroll
                    for (int ks = 0; ks < 4; ++ks) wB[g][ks] = *(const bf16x8*)(gp + ks * 32); } }
            const float br_ = p.rg_b_r[d * 1024 + ch], bi_ = p.rg_b_i[d * 1024 + ch], sp = softplusf_(-p.rg_lam[d * 1024 + ch]);
#pragma unroll
            for (int m = 0; m < 4; ++m)
#pragma unroll
                for (int r = 0; r < 4; ++r) { const int c = m * 16 + q4 * 4 + r;
                    const float rr = sigm(ar[m][r] + br_), ii = sigm(ai[m][r] + bi_);
                    const float la = -8.f * rr * sp, t2 = 2.f * la;
                    const float em = t2 > -0.02f ? t2 * (1.f + t2 * (0.5f + t2 * (0.16666667f + t2 * 0.041666667f))) : __expf(t2) - 1.f;
                    av[m][r] = __expf(la); bxv[m][r] = __builtin_amdgcn_sqrtf(-em) * (ii * xf[c * 128 + j]); }
        }
        f32x4 Pa[4], Pb[4]; float Ap[4], Bp[4], Am[4], Bm[4];
#pragma unroll
        for (int m = 0; m < 4; ++m) {
            float pa, pb;
            if (d == 0) { pa = av[m][0]; pb = bxv[m][0]; Pa[m][0] = pa; Pb[m][0] = pb;
#pragma unroll
                for (int r = 1; r < 4; ++r) { pb = av[m][r] * pb + bxv[m][r]; pa = av[m][r] * pa; Pa[m][r] = pa; Pb[m][r] = pb; } }
            else { pa = av[m][3]; pb = bxv[m][3]; Pa[m][3] = pa; Pb[m][3] = pb;
#pragma unroll
                for (int r = 2; r >= 0; --r) { pb = av[m][r] * pb + bxv[m][r]; pa = av[m][r] * pa; Pa[m][r] = pa; Pb[m][r] = pb; } }
            float Ak[4], Bk[4];
#pragma unroll
            for (int k = 0; k < 4; ++k) { Ak[k] = __shfl(pa, l15 + 16 * k); Bk[k] = __shfl(pb, l15 + 16 * k); }
            float ap = 1.f, bp = 0.f, am = 1.f, bm = 0.f;
#pragma unroll
            for (int kk = 0; kk < 4; ++kk) { const int k = d == 0 ? kk : 3 - kk;
                const bool before = d == 0 ? (k < q4) : (k > q4);
                const float nb = Ak[k] * bp + Bk[k], na = Ak[k] * ap;
                bp = before ? nb : bp; ap = before ? na : ap;
                bm = Ak[k] * bm + Bk[k]; am = Ak[k] * am; }
            Ap[m] = ap; Bp[m] = bp; Am[m] = am; Bm[m] = bm;
        }
        if (PASS == 1) {
            float At = 1.f, Bt = 0.f;
#pragma unroll
            for (int mm = 0; mm < 4; ++mm) { const int m = d == 0 ? mm : 3 - mm; Bt = Am[m] * Bt + Bm[m]; At = Am[m] * At; }
            if (q4 == 0) { float* ag = F.RGAGG() + (size_t)(ci * 2 + d) * 2048; ag[ch] = At; ag[1024 + ch] = Bt; }
        } else {
            float hb = F.CARRY()[(size_t)(ci * 2 + d) * 1024 + ch];
#pragma unroll
            for (int mm = 0; mm < 4; ++mm) { const int m = d == 0 ? mm : 3 - mm;
                const float hin = Ap[m] * hb + Bp[m];
#pragma unroll
                for (int r = 0; r < 4; ++r) hs[m][r] += Pa[m][r] * hin + Pb[m][r];
                hb = Am[m] * hb + Bm[m]; }
            if (!samp && q4 == 0 && ci == (d == 0 ? c_hi - 1 : c_lo)) F.out[OUT_SR + (size_t)(seq * 2 + d) * 1024 + ch] = hb;
        }
    }
    if (PASS == 3) {
#pragma unroll
        for (int m = 0; m < 4; ++m)
#pragma unroll
            for (int r = 0; r < 4; ++r) Hs[(m * 16 + q4 * 4 + r) * 128 + j] = hs[m][r];
        __syncthreads();
#pragma unroll
        for (int i = 0; i < 2; ++i) { const int chunk = tid + 512 * i, c = chunk >> 4, cc = chunk & 15;
            const u32x4 gv = *(const u32x4*)(F.PROJ() + (size_t)(t0 + c) * NPROJ + 5120 + n * 128 + cc * 8);
            float g[8]; unpack8(gv, g);
            const f32x4 ha = *(const LAS f32x4*)(Hs + c * 128 + cc * 8), hb2 = *(const LAS f32x4*)(Hs + c * 128 + cc * 8 + 4);
            float o[8];
#pragma unroll
            for (int e = 0; e < 4; ++e) { o[e] = ha[e] * siluf_(g[e]); o[4 + e] = hb2[e] * siluf_(g[4 + e]); }
            *(u32x4*)(F.MIX() + (size_t)(t0 + c) * 2048 + 1024 + n * 128 + cc * 8) = pack8(o); }
    }
    __syncthreads();
}

__device__ __forceinline__ void rg_carry_scan(CParams& p, Frame& F) {
    const int tid = F.tid;
    int samp, seq, d, ch;
    if (tid < 256) { const int g = F.b * 256 + tid; if (g >= 65536) return; samp = 0; seq = g >> 11; d = (g >> 10) & 1; ch = g & 1023; }
    else if (tid < 272) { const int g = F.b * 16 + tid - 256; if (g >= 4096) return; samp = 1; seq = g >> 11; d = (g >> 10) & 1; ch = g & 1023; }
    else return;
    const int nch = samp ? 64 : 4, c_lo = samp ? 128 + seq * 64 : seq * 4;
    float h = samp ? p.state_rglru[(size_t)(seq * 2 + d) * 1024 + ch] : 0.f;
    for (int i0 = 0; i0 < nch; i0 += 4) {
        float A[4], B[4];
#pragma unroll
        for (int u = 0; u < 4; ++u) { const int cc = d == 0 ? c_lo + i0 + u : c_lo + nch - 1 - i0 - u; const float* ag = F.RGAGG() + (size_t)(cc * 2 + d) * 2048; A[u] = ag[ch]; B[u] = ag[1024 + ch]; }
#pragma unroll
        for (int u = 0; u < 4; ++u) { const int cc = d == 0 ? c_lo + i0 + u : c_lo + nch - 1 - i0 - u; F.CARRY()[(size_t)(cc * 2 + d) * 1024 + ch] = h; h = A[u] * h + B[u]; }
    }
}

__device__ __forceinline__ void phase3(CParams& p, Frame& F) {
    for (int rep = 0; rep < (REP_PHASE == 30 ? 2 : 1); ++rep)
    for (int it = F.b; it < 2048; it += F.G) p3_delta_item(p, F, it >> 3, it & 7);
    for (int rep = 0; rep < (REP_PHASE == 31 ? 2 : 1); ++rep) {
    for (int it = F.b; it < 2048; it += F.G) rg_item<1>(p, F, it >> 3, it & 7); }
}

struct P4Pre { u32x4 k0, k1, q0, q1, ti, at; u32x2 v[4]; float g; };
__device__ __forceinline__ void p4_prefetch(const Frame& F, P4Pre& R, int ci, int h, int d, int sl, int seq_lo, int seq_hi) {
    const int tid = F.tid, t0 = ci * 64;
    { const int row = tid >> 4, cc = tid & 15;
      const size_t o0 = (size_t)(t0 + row) * 1024 + h * 128 + cc * 8, o1 = (size_t)(t0 + 32 + row) * 1024 + h * 128 + cc * 8;
      R.k0 = *(const u32x4*)(F.Kc() + o0); R.k1 = *(const u32x4*)(F.Kc() + o1); R.q0 = *(const u32x4*)(F.Qc() + o0); R.q1 = *(const u32x4*)(F.Qc() + o1); }
    { const bf16_t* ta = F.TA() + (size_t)(ci * 8 + h) * 8192; R.ti = *(const u32x4*)(ta + tid * 8); R.at = *(const u32x4*)(ta + 4096 + tid * 8); }
    { const int c = tid >> 3, e0 = (tid & 7) * 4;
#pragma unroll
      for (int j = 0; j < 4; ++j) { const int tok = t0 + c - 2 + j; u32x2 v = {0u, 0u};
          if (tok >= seq_lo && tok < seq_hi) v = *(const u32x2*)(F.PROJ() + (size_t)tok * NPROJ + 2048 + h * 128 + sl * 32 + e0);
          R.v[j] = v; } }
    R.g = 0.f;
    if (tid < 128) R.g = F.GB()[(size_t)(ci * 8 + h) * 256 + (tid >> 6) * 128 + d * 64 + (tid & 63)];
}
__device__ __forceinline__ u32x4 tri_mask(u32x4 v, int c, int s0, int d) {
    unsigned w[4] = {v.x, v.y, v.z, v.w};
#pragma unroll
    for (int i = 0; i < 4; ++i) { const int slo = s0 + 2 * i, shi = slo + 1;
        const bool klo = d == 0 ? (c >= slo) : (c <= slo), khi = d == 0 ? (c >= shi) : (c <= shi);
        w[i] &= (klo ? 0x0000FFFFu : 0u) | (khi ? 0xFFFF0000u : 0u); }
    return (u32x4){w[0], w[1], w[2], w[3]};
}
__device__ __forceinline__ void p4_item(CParams& p, Frame& F, int samp, int seq, int h, int d, int sl) {
    const int tid = F.tid, lane = F.lane, wave = F.wave, q4 = lane >> 4, l15 = lane & 15;
    LAS unsigned char* Ks = F.lds; LAS unsigned char* Qs = F.lds + 17408; LAS unsigned char* TIs = F.lds + 34816; LAS unsigned char* ATs = F.lds + 44032;
    LAS unsigned char* Sb = F.lds + 53248; LAS unsigned char* Rt = F.lds + 61952; LAS unsigned char* Vt1 = F.lds + 66560; LAS unsigned char* Vt2 = F.lds + 71168;
    LAS float* Vs = (LAS float*)(F.lds + 75776); LAS float* gv = (LAS float*)(F.lds + 83968); LAS float* bv = gv + 64;
    const int nch = samp ? 64 : 4, chunk0 = samp ? 128 + seq * 64 : seq * 4, seq_lo = chunk0 * 64, seq_hi = seq_lo + nch * 64;
    f32x4 S[2];
#pragma unroll
    for (int nt = 0; nt < 2; ++nt)
#pragma unroll
        for (int r = 0; r < 4; ++r)
            S[nt][r] = samp ? p.state_delta[(size_t)((seq * 2 + d) * 8 + h) * 16384 + (size_t)(wave * 16 + q4 * 4 + r) * 128 + sl * 32 + nt * 16 + l15] : 0.f;
#pragma unroll
    for (int nt = 0; nt < 2; ++nt) { u32x2 o; o.x = pk2(S[nt][0], S[nt][1]); o.y = pk2(S[nt][2], S[nt][3]); *(LAS u32x2*)(Sb + (nt * 16 + l15) * 272 + (wave * 16 + q4 * 4) * 2) = o; }
    float cw[4][4];
    { const int e0 = (tid & 7) * 4;
#pragma unroll
      for (int j = 0; j < 4; ++j) { const f32x4 a = *(const f32x4*)(p.dn_conv_w + j * 3072 + 2048 + h * 128 + sl * 32 + e0); cw[j][0] = a[0]; cw[j][1] = a[1]; cw[j][2] = a[2]; cw[j][3] = a[3]; } }
    P4Pre R;
    p4_prefetch(F, R, d == 0 ? chunk0 : chunk0 + nch - 1, h, d, sl, seq_lo, seq_hi);
#pragma unroll 1
    for (int step = 0; step < nch; ++step) {
        const int ci = d == 0 ? chunk0 + step : chunk0 + nch - 1 - step, t0 = ci * 64;
        { const int row = tid >> 4, cc = tid & 15;
          *(LAS u32x4*)(Ks + row * 272 + cc * 16) = R.k0; *(LAS u32x4*)(Ks + (32 + row) * 272 + cc * 16) = R.k1;
          *(LAS u32x4*)(Qs + row * 272 + cc * 16) = R.q0; *(LAS u32x4*)(Qs + (32 + row) * 272 + cc * 16) = R.q1; }
        { const int c = tid >> 3, s0 = (tid & 7) * 8;
          *(LAS u32x4*)(TIs + c * 144 + s0 * 2) = tri_mask(R.ti, c, s0, d); *(LAS u32x4*)(ATs + c * 144 + s0 * 2) = tri_mask(R.at, c, s0, d); }
        { const int c = tid >> 3, e0 = (tid & 7) * 4; float o[4] = {0.f, 0.f, 0.f, 0.f};
#pragma unroll
          for (int j = 0; j < 4; ++j) { const u32x2 v = R.v[j];
              o[0] += cw[j][0] * __uint_as_float(v.x << 16); o[1] += cw[j][1] * __uint_as_float(v.x & 0xffff0000u);
              o[2] += cw[j][2] * __uint_as_float(v.y << 16); o[3] += cw[j][3] * __uint_as_float(v.y & 0xffff0000u); }
          CHK(F, 9, badv(o[0], 1000.f) || badv(o[3], 1000.f));
          *(LAS f32x4*)(Vs + c * 32 + e0) = (f32x4){siluf_(o[0]), siluf_(o[1]), siluf_(o[2]), siluf_(o[3])}; }
        if (tid < 128) gv[tid] = R.g;
        if (step + 1 < nch) p4_prefetch(F, R, d == 0 ? ci + 1 : ci - 1, h, d, sl, seq_lo, seq_hi);
        __syncthreads();
        const int prod = wave >> 2, mt = wave & 3;
        f32x4 acc[2] = {(f32x4){0.f, 0.f, 0.f, 0.f}, (f32x4){0.f, 0.f, 0.f, 0.f}};
        { const LAS unsigned char* base = prod ? Qs : Ks;
#pragma unroll
          for (int ks = 0; ks < 4; ++ks) { const bf16x8 a = ldfrag(base, 272, mt * 16 + l15, ks * 64 + q4 * 16);
#pragma unroll
              for (int nt = 0; nt < 2; ++nt) { const bf16x8 b = ldfrag(Sb, 272, nt * 16 + l15, ks * 64 + q4 * 16); acc[nt] = MFMA16(a, b, acc[nt]); } } }
        if (prod == 0) {
#pragma unroll
            for (int nt = 0; nt < 2; ++nt) { const int e = nt * 16 + l15; float rv[4];
#pragma unroll
                for (int r = 0; r < 4; ++r) { const int c = mt * 16 + q4 * 4 + r; rv[r] = bv[c] * (Vs[c * 32 + e] - __expf(gv[c]) * acc[nt][r]); }
                u32x2 o; o.x = pk2(rv[0], rv[1]); o.y = pk2(rv[2], rv[3]); *(LAS u32x2*)(Rt + e * 144 + (mt * 16 + q4 * 4) * 2) = o; }
        } else {
#pragma unroll
            for (int nt = 0; nt < 2; ++nt)
#pragma unroll
                for (int r = 0; r < 4; ++r) { const int c = mt * 16 + q4 * 4 + r; acc[nt][r] *= __expf(gv[c]); }
        }
        __syncthreads();
        const float glast = d == 0 ? gv[63] : gv[0];
        { const int m3 = wave & 3, n3 = wave >> 2;
          f32x4 vn = {0.f, 0.f, 0.f, 0.f};
#pragma unroll
          for (int ks = 0; ks < 2; ++ks) { const bf16x8 a = ldfrag(TIs, 144, m3 * 16 + l15, ks * 64 + q4 * 16), b = ldfrag(Rt, 144, n3 * 16 + l15, ks * 64 + q4 * 16); vn = MFMA16(a, b, vn); }
          const int e = n3 * 16 + l15, c0 = m3 * 16 + q4 * 4;
          if (!samp) CHK(F, 10 + (step < 3 ? step : 3), badv(vn[0], 200.f) || badv(vn[3], 200.f));
          u32x2 o1, o2; o1.x = pk2(vn[0], vn[1]); o1.y = pk2(vn[2], vn[3]);
          o2.x = pk2(vn[0] * __expf(glast - gv[c0]), vn[1] * __expf(glast - gv[c0 + 1])); o2.y = pk2(vn[2] * __expf(glast - gv[c0 + 2]), vn[3] * __expf(glast - gv[c0 + 3]));
          *(LAS u32x2*)(Vt1 + e * 144 + c0 * 2) = o1; *(LAS u32x2*)(Vt2 + e * 144 + c0 * 2) = o2; }
        __syncthreads();
        if (prod == 1) {
#pragma unroll
            for (int ks = 0; ks < 2; ++ks) { const bf16x8 a = ldfrag(ATs, 144, mt * 16 + l15, ks * 64 + q4 * 16);
#pragma unroll
                for (int nt = 0; nt < 2; ++nt) { const bf16x8 b = ldfrag(Vt1, 144, nt * 16 + l15, ks * 64 + q4 * 16); acc[nt] = MFMA16(a, b, acc[nt]); } }
#pragma unroll
            for (int nt = 0; nt < 2; ++nt)
#pragma unroll
                for (int r = 0; r < 4; ++r) F.PROJ()[(size_t)(t0 + mt * 16 + q4 * 4 + r) * NPROJ + d * 1024 + h * 128 + sl * 32 + nt * 16 + l15] = f2bf(acc[nt][r]);
        }
        { const float gl = __expf(glast);
#pragma unroll
          for (int nt = 0; nt < 2; ++nt) S[nt] *= gl;
#pragma unroll
          for (int ks = 0; ks < 2; ++ks) { bf16x8 a;
#pragma unroll
              for (int j = 0; j < 8; ++j) a[j] = *(const LAS short*)(Ks + (ks * 32 + q4 * 8 + j) * 272 + (wave * 16 + l15) * 2);
#pragma unroll
              for (int nt = 0; nt < 2; ++nt) { const bf16x8 b = ldfrag(Vt2, 144, nt * 16 + l15, ks * 64 + q4 * 16); S[nt] = MFMA16(a, b, S[nt]); } }
#pragma unroll
          for (int nt = 0; nt < 2; ++nt) { u32x2 o; o.x = pk2(S[nt][0], S[nt][1]); o.y = pk2(S[nt][2], S[nt][3]); *(LAS u32x2*)(Sb + (nt * 16 + l15) * 272 + (wave * 16 + q4 * 4) * 2) = o; } }
        __syncthreads();
    }
    if (!samp) {
        CHK(F, 14, badv(S[0][0], 100.f) || badv(S[1][3], 100.f));
#pragma unroll
        for (int nt = 0; nt < 2; ++nt)
#pragma unroll
            for (int r = 0; r < 4; ++r)
                F.out[OUT_SD + (size_t)((seq * 2 + d) * 8 + h) * 16384 + (size_t)(wave * 16 + q4 * 4 + r) * 128 + sl * 32 + nt * 16 + l15] = (LIVE_MASK & 4) ? fin(S[nt][r]) : 0.f;
    }
}
__device__ __forceinline__ void p4_run(CParams& p, Frame& F, int item) {
    if (item < 128) { const int chain = item >> 2; p4_item(p, F, 1, chain >> 4, (chain >> 1) & 7, chain & 1, item & 3); }
    else { const int it = item - 128, chain = it >> 2; p4_item(p, F, 0, chain >> 4, (chain >> 1) & 7, chain & 1, it & 3); }
}
__device__ __forceinline__ void phase4(CParams& p, Frame& F) {
    if (F.G == 256) rg_carry_scan(p, F);
    else if (F.b == 0) {
        for (int g = F.tid; g < 69632; g += 512) { int samp = g >= 65536, gg = samp ? g - 65536 : g, seq = gg >> 11, d = (gg >> 10) & 1, ch = gg & 1023;
            const int nch = samp ? 64 : 4, c_lo = samp ? 128 + seq * 64 : seq * 4; float h = samp ? p.state_rglru[(size_t)(seq * 2 + d) * 1024 + ch] : 0.f;
            for (int i = 0; i < nch; ++i) { const int cc = d == 0 ? c_lo + i : c_lo + nch - 1 - i; const float* ag = F.RGAGG() + (size_t)(cc * 2 + d) * 2048; F.CARRY()[(size_t)(cc * 2 + d) * 1024 + ch] = h; h = ag[ch] * h + ag[1024 + ch]; } } }
    __syncthreads();
    if (F.G == 256) {
        if ((F.b & 1) == 0) p4_run(p, F, F.b >> 1);
        else { const int pb = F.b >> 1; for (int i = 0; i < 16; ++i) p4_run(p, F, 128 + pb * 16 + i); }
    } else {
        for (int it = F.b; it < 128 + 2048; it += F.G) p4_run(p, F, it);
    }
}

__device__ __forceinline__ void phase5(CParams& p, Frame& F) {
    const int lane = F.lane;
    float nw[16];
#pragma unroll
    for (int q = 0; q < 4; ++q) { const f32x4 a = *(const f32x4*)(p.dn_norm_w + (lane & 7) * 16 + q * 4); nw[q * 4] = a[0]; nw[q * 4 + 1] = a[1]; nw[q * 4 + 2] = a[2]; nw[q * 4 + 3] = a[3]; }
    for (int tok = F.b * 8 + F.wave; tok < NTOK; tok += F.G * 8) {
        const bf16_t* pr = F.PROJ() + (size_t)tok * NPROJ + lane * 16;
        float o[16], z[16]; float ss = 0.f;
#pragma unroll
        for (int hf = 0; hf < 2; ++hf) { const u32x4 a = *(const u32x4*)(pr + hf * 8), b = *(const u32x4*)(pr + 1024 + hf * 8), zz = *(const u32x4*)(pr + 3072 + hf * 8);
            float fa[8], fb[8], fz[8]; unpack8(a, fa); unpack8(b, fb); unpack8(zz, fz);
#pragma unroll
            for (int e = 0; e < 8; ++e) { o[hf * 8 + e] = fa[e] + fb[e]; z[hf * 8 + e] = fz[e]; ss += o[hf * 8 + e] * o[hf * 8 + e]; } }
        ss += __shfl_xor(ss, 1); ss += __shfl_xor(ss, 2); ss += __shfl_xor(ss, 4);
        const float rs = rsqrtf(ss * (1.f / 128.f) + 1e-6f);
#pragma unroll
        for (int hf = 0; hf < 2; ++hf) { float w[8];
#pragma unroll
            for (int e = 0; e < 8; ++e) w[e] = o[hf * 8 + e] * rs * nw[hf * 8 + e] * siluf_(z[hf * 8 + e]);
            *(u32x4*)(F.MIX() + (size_t)tok * 2048 + lane * 16 + hf * 8) = pack8(w); }
    }
    __syncthreads();
    for (int it = F.b; it < 2048; it += F.G) rg_item<3>(p, F, it >> 3, it & 7);
}

__device__ __forceinline__ void phase6(CParams& p, Frame& F) {
    pg8::Gemm g{F.MIX(), F.WoutT(), NTOK, 1024, 2048}; pg8::StaticOrder S; S.init(NTOK, 1024, F.G, F.b); pg8::EpiF32 E{(float*)F.PROJ(), 3072};
    pg8::gemm_phase<pg8::EpiF32, pg8::StaticOrder>(F.lds, g, S, E);
}

__device__ __forceinline__ void phase7(CParams& p, Frame& F) {
    LAS float* gt = (LAS float*)F.lds;
    for (int tb = F.b; tb < 256; tb += F.G) {
        const int grp = grp_of_block(tb);
        for (int j = F.tid; j < 1024; j += 512) gt[j] = mod_val(p, F, grp, 2048 + j) * p.post_w[j];
        __syncthreads();
        for (int i = 0; i < 8; ++i) {
            const int tok = tb * 64 + F.wave * 8 + i;
            const float* xr = tok < 8192 ? p.x_prompt + (size_t)tok * 1024 : p.x_sample + (size_t)(tok - 8192) * 1024;
            const float* yr = (const float*)F.PROJ() + (size_t)tok * 3072;
            f32x4 y[4]; float ss = 0.f;
#pragma unroll
            for (int q = 0; q < 4; ++q) { y[q] = *(const f32x4*)(yr + F.lane * 4 + 256 * q); ss += (y[q][0] * y[q][0] + y[q][1] * y[q][1]) + (y[q][2] * y[q][2] + y[q][3] * y[q][3]); }
            const float rstd = rsqrtf(wave_sum(ss) * (1.f / 1024.f) + 1e-6f);
#pragma unroll
            for (int q = 0; q < 4; ++q) { const int j = F.lane * 4 + 256 * q; f32x4 v = *(const f32x4*)(xr + j);
                if (tok >= 8192) { const int pp = (tok - 8192) & 4095; const int vv = (q < 2) ? (pp >> 6) : (pp & 63);
                    v += *(const f32x4*)(F.pe() + ((q & 1) ? 16384 : 0) + vv * 256 + F.lane * 4); }
                const f32x4 g4 = *(const LAS f32x4*)(gt + j);
                f32x4 ov = v + g4 * (y[q] * rstd); ov[0] = fin(ov[0]); ov[1] = fin(ov[1]); ov[2] = fin(ov[2]); ov[3] = fin(ov[3]); if (!(LIVE_MASK & 1)) ov = (f32x4){0.f, 0.f, 0.f, 0.f}; *(f32x4*)(F.out + (size_t)tok * 1024 + j) = ov; }
        }
        __syncthreads();
    }
}

__device__ __forceinline__ void phase8(CParams& p, Frame& F) {
    if (F.b == 0 && F.tid == 0) { int code = 0; for (int k = 31; k >= 1; --k) if (DG(F)[k]) code = k; F.out[OUT_SR] = 1000.f * (float)code + 500.f; }
}
extern __shared__ __attribute__((aligned(16))) unsigned char smem_raw[];
__global__ void __launch_bounds__(512) fwd_megakernel(Params p_unused) {
    CParams& p = *(CParams*)__builtin_amdgcn_kernarg_segment_ptr();
    Frame F;
    F.lds = (LAS unsigned char*)smem_raw;
    F.tid = threadIdx.x; F.lane = F.tid & 63; F.wave = __builtin_amdgcn_readfirstlane(F.tid >> 6); F.G = gridDim.x; F.b = blockIdx.x;
    F.out = p.out; F.ws = p.ws;
    volatile LAS unsigned* xbw = (volatile LAS unsigned*)(F.lds + LDS_BYTES - 16);
    const bool multi = (p.ph_hi - p.ph_lo) > 1;
    XcdBarrier xb; xb.bar = (unsigned*)(p.ws + WS_CTL); xb.x = 0; xb.st = xbw;
    if (multi) {
        if (F.tid == 0) { xbw[0] = 0u; xbw[1] = 0u; xbw[2] = 0u; xbw[3] = 0u; }
        __syncthreads();
        xb = xcd_barrier_post((unsigned*)(p.ws + WS_CTL), xbw);
    }
#ifndef PHMASK
#define PHMASK 511
#endif
    const int lo = p.ph_lo, hi = p.ph_hi;
#ifndef REP_PHASE
#define REP_PHASE -1
#endif
#define RUN_PHASE(k, fn) do { if (lo <= (k) && (k) < hi) { if (PHMASK & (1 << (k))) fn(p, F); if ((k) == REP_PHASE) { __syncthreads(); fn(p, F); } if ((k) + 1 < hi) xcd_barrier(xb); } } while (0)
    RUN_PHASE(0, phase0); RUN_PHASE(1, phase1); RUN_PHASE(2, phase2); RUN_PHASE(3, phase3);
    RUN_PHASE(4, phase4); RUN_PHASE(5, phase5); RUN_PHASE(6, phase6); RUN_PHASE(7, phase7); RUN_PHASE(8, phase8);
}

extern "C" void kernel_launch(void* const* d_in, const int* in_sizes, int n_in, void* d_out, int out_size, void* d_ws, size_t ws_size, hipStream_t stream) {
    static int grid = 0;
    if (grid == 0) {
        int dev = 0, cus = 0;
        if (hipGetDevice(&dev) != hipSuccess || hipDeviceGetAttribute(&cus, hipDeviceAttributeMultiprocessorCount, dev) != hipSuccess) { fprintf(stderr, "kernel_launch: device query failed\n"); grid = -1; return; }
        if (hipFuncSetAttribute((const void*)fwd_megakernel, hipFuncAttributeMaxDynamicSharedMemorySize, LDS_BYTES) != hipSuccess) { fprintf(stderr, "kernel_launch: hipFuncSetAttribute failed\n"); grid = -1; return; }
        int per_cu = 0;
        if (hipOccupancyMaxActiveBlocksPerMultiprocessor(&per_cu, (const void*)fwd_megakernel, 512, LDS_BYTES) != hipSuccess || per_cu < 1) { fprintf(stderr, "kernel_launch: occupancy query says %d blocks per CU\n", per_cu); (void)hipGetLastError(); }
        grid = cus;
    }
    if (grid < 0) return;
    Params p{};
    const float** pp = (const float**)&p;
    for (int i = 0; i < 23; ++i) pp[i] = (const float*)d_in[i];
    p.out = (float*)d_out; p.ws = (unsigned char*)d_ws;
    (void)hipMemsetAsync((char*)d_ws + WS_CTL, 0, 16384, stream);
#if MK_SINGLE
    p.ph_lo = 0; p.ph_hi = NPH;
    void* args[] = {&p};
    hipError_t e = hipLaunchCooperativeKernel((const void*)fwd_megakernel, dim3(grid), dim3(512), args, LDS_BYTES, stream);
    if (e != hipSuccess) fprintf(stderr, "cooperative launch failed: %s (grid %d)\n", hipGetErrorString(e), grid);
#else
    for (int ph = 0; ph < NPH; ++ph) {
        p.ph_lo = ph; p.ph_hi = ph + 1;
        hipLaunchKernelGGL(fwd_megakernel, dim3(grid), dim3(512), LDS_BYTES, stream, p);
    }
#endif
}
```

```cpp
#include <hip/hip_runtime.h>
#include <cstdio>
#include <cstdint>

#define LAS __attribute__((address_space(3)))
typedef unsigned short bf16_t;
typedef short bf16x8 __attribute__((ext_vector_type(8)));
typedef float f32x4 __attribute__((ext_vector_type(4)));
typedef unsigned u32x4 __attribute__((ext_vector_type(4)));
typedef unsigned u32x2 __attribute__((ext_vector_type(2)));

#ifndef REP_PHASE
#define REP_PHASE -1
#endif
#ifndef MK_SINGLE
#define MK_SINGLE 1
#endif

constexpr int NTOK = 16384, DM = 1024, NPROJ = 6144, DIN = 6176;
constexpr int NPH = 8;
constexpr int LDS_BYTES = 160 * 1024;
constexpr size_t OUT_YP = 0, OUT_YS = 8388608, OUT_SD = 16777216, OUT_SR = 25165824;
constexpr size_t WS_CTL = 0, WS_MODP = 16384, WS_PE = 606208, WS_BA = 737280, WS_GB = 2834432, WS_RGAGG = 4931584,
                 WS_WBAT = 9125888, WS_WOUTT = 9191424, WS_GT = 13385728, WS_WINT = 14434304, WS_TA = 27017216, WS_PROJ = 60571648, WS_CARRY = 261898240;

struct Params {
    const float *x_prompt, *x_sample, *state_delta, *state_rglru, *c, *c_ctx, *ada_w, *ada_b, *pre_w, *post_w, *w_in, *w_out,
                *dn_conv_w, *dn_a_log, *dn_dt_bias, *dn_norm_w, *rg_conv_w, *rg_conv_b, *rg_w_r, *rg_b_r, *rg_w_i, *rg_b_i, *rg_lam;
    float* out; unsigned char* ws;
    int ph_lo, ph_hi;
};

__device__ __forceinline__ float bf2f(unsigned short b) { return __uint_as_float(((unsigned)b) << 16); }
typedef __bf16 bf2_t __attribute__((ext_vector_type(2)));
typedef float f2_t __attribute__((ext_vector_type(2)));
__device__ __forceinline__ unsigned pk2(float lo, float hi) { const f2_t v = {lo, hi}; return __builtin_bit_cast(unsigned, __builtin_convertvector(v, bf2_t)); }
__device__ __forceinline__ unsigned short f2bf(float f) { return (unsigned short)(pk2(f, f) & 0xffffu); }
#ifndef SANITIZE
#define SANITIZE 0
#endif
#ifndef LIVE_MASK
#define LIVE_MASK 15
#endif
__device__ __forceinline__ float fin(float x) { return (SANITIZE && ((__float_as_uint(x) & 0x7f800000u) == 0x7f800000u)) ? 0.f : x; }
#define DG(F) ((unsigned*)((F).ws + WS_CTL))
__device__ __forceinline__ bool badv(float x, float lim) { return ((__float_as_uint(x) & 0x7f800000u) == 0x7f800000u) || fabsf(x) > lim; }
#ifndef DIAG
#define DIAG 0
#endif
#define CHK(F, k, bad) do { if (DIAG && (bad)) DG(F)[k] = 1u; } while (0)
__device__ __forceinline__ float sigm(float x) { return __builtin_amdgcn_rcpf(1.f + __expf(-x)); }
__device__ __forceinline__ float siluf_(float x) { return x * __builtin_amdgcn_rcpf(1.f + __expf(-x)); }
__device__ __forceinline__ float softplusf_(float x) { return x > 20.f ? x : log1pf(__expf(x)); }
__device__ __forceinline__ void unpack8(const u32x4 v, float (&f)[8]) {
    f[0] = __uint_as_float(v.x << 16); f[1] = __uint_as_float(v.x & 0xffff0000u);
    f[2] = __uint_as_float(v.y << 16); f[3] = __uint_as_float(v.y & 0xffff0000u);
    f[4] = __uint_as_float(v.z << 16); f[5] = __uint_as_float(v.z & 0xffff0000u);
    f[6] = __uint_as_float(v.w << 16); f[7] = __uint_as_float(v.w & 0xffff0000u);
}
__device__ __forceinline__ u32x4 pack8(const float (&f)[8]) { u32x4 o; o.x = pk2(f[0], f[1]); o.y = pk2(f[2], f[3]); o.z = pk2(f[4], f[5]); o.w = pk2(f[6], f[7]); return o; }
__device__ __forceinline__ float wave_sum(float v) {
#pragma unroll
    for (int o = 1; o < 64; o <<= 1) v += __shfl_xor(v, o);
    return v;
}
#define MFMA16(a, b, c) __builtin_amdgcn_mfma_f32_16x16x32_bf16((a), (b), (c), 0, 0, 0)
#define LDS_WAIT() asm volatile("s_waitcnt lgkmcnt(0)" ::: "memory")
__device__ __forceinline__ bf16x8 ldfrag(const LAS unsigned char* base, int pitch, int row, int kb) { return *(const LAS bf16x8*)(base + row * pitch + kb); }

#define XB_TMO      128
#define XB_XCNT(j)  (256  + 64 * (j))
#define XB_XSUB(j)  (1280 + 64 * (j))
#define XB_XGEN(j)  (2304 + 64 * (j))
#define XB_TOP      3328
#define XB_TOPGEN   3392
#define XCD_BAR_WORDS 3456
#define XB_SPIN_CAP (1u << 18)
__device__ __forceinline__ unsigned xb_ld(unsigned* p)              { return __hip_atomic_load(p, __ATOMIC_RELAXED, __HIP_MEMORY_SCOPE_AGENT); }
__device__ __forceinline__ unsigned xb_add(unsigned* p, unsigned v) { return __hip_atomic_fetch_add(p, v, __ATOMIC_RELAXED, __HIP_MEMORY_SCOPE_AGENT); }
__device__ __forceinline__ unsigned xb_xcc_id() { return (unsigned)__builtin_amdgcn_s_getreg((3 << 11) | 20) & 0xFu; }
#define XB_SPIN(cond, bar) do { unsigned _sp = 0; while (cond) { __builtin_amdgcn_s_sleep(1); \
    if ((++_sp & 255u) == 0u) { if (xb_ld(&(bar)[XB_TMO])) break; if (_sp > XB_SPIN_CAP) { atomicAdd(&(bar)[XB_TMO], 1u); break; } } } } while (0)
struct XcdBarrier { unsigned* bar; unsigned x; volatile LAS unsigned* st; };
__device__ __forceinline__ XcdBarrier xcd_barrier_post(unsigned* bar, volatile LAS unsigned* st) {
    XcdBarrier b; b.bar = bar; b.x = xb_xcc_id(); b.st = st;
    if (threadIdx.x == 0) (void)xb_add(&bar[XB_XCNT(b.x)], 1u);
    return b;
}
__device__ __forceinline__ void xcd_barrier_complete(unsigned* bar, unsigned x, unsigned& nloc, unsigned& nx) {
    const unsigned G = gridDim.x * gridDim.y * gridDim.z;
    unsigned sum, cnt, mine, sp = 0u;
    for (;;) {
        sum = 0u; cnt = 0u; mine = 0u;
#pragma unroll
        for (unsigned j = 0; j < 16; ++j) { const unsigned c = xb_ld(&bar[XB_XCNT(j)]); sum += c; cnt += (c > 0u) ? 1u : 0u; mine = (j == x) ? c : mine; }
        if (sum == G) break;
        __builtin_amdgcn_s_sleep(1);
        if ((++sp & 255u) == 0u) { if (xb_ld(&bar[XB_TMO])) break; if (sp > XB_SPIN_CAP) { atomicAdd(&bar[XB_TMO], 1u); break; } }
    }
    nloc = mine > 0u ? mine : 1u; nx = cnt > 0u ? cnt : 1u;
}
__device__ __forceinline__ void xcd_barrier(const XcdBarrier& b) {
    asm volatile("s_waitcnt vmcnt(0)" ::: "memory");
    __syncthreads();
    if (threadIdx.x == 0) {
        unsigned* bar = b.bar;
        __builtin_amdgcn_s_waitcnt(0);
        unsigned nloc = b.st[0], nx = b.st[1];
        if (nloc == 0u) { xcd_barrier_complete(bar, b.x, nloc, nx); b.st[0] = nloc; b.st[1] = nx; }
        const unsigned old = xb_add(&bar[XB_XSUB(b.x)], 1u);
        const unsigned gen = old / nloc;
        if (old + 1u == (gen + 1u) * nloc) {
            __builtin_amdgcn_fence(__ATOMIC_RELEASE, "agent");
            asm volatile("s_waitcnt vmcnt(0)" ::: "memory");
            const unsigned og = xb_add(&bar[XB_TOP], 1u);
            const unsigned tg = og / nx;
            if (og + 1u == (tg + 1u) * nx) xb_add(&bar[XB_TOPGEN], 1u);
            else XB_SPIN(xb_ld(&bar[XB_TOPGEN]) == tg, bar);
            __builtin_amdgcn_fence(__ATOMIC_ACQUIRE, "agent");
            xb_add(&bar[XB_XGEN(b.x)], 1u);
            asm volatile("s_waitcnt vmcnt(0)" ::: "memory");
        } else {
            XB_SPIN(xb_ld(&bar[XB_XGEN(b.x)]) == gen, bar);
            __builtin_amdgcn_fence(__ATOMIC_ACQUIRE, "agent");
            asm volatile("s_waitcnt vmcnt(0)" ::: "memory");
        }
    }
    __syncthreads();
}

namespace pg8 {
constexpr int BM = 256, BK = 64, HALF = 128, HTB = HALF * BK * 2, STAGE_BYTES = 8 * HTB, NXCD = 8, WGM = 8;
__host__ __device__ __forceinline__ int lds_byte(int r, int c) { const int st = (r >> 4) * 2 + (c >> 5), rr = r & 15, cc = c & 31, ob = rr * 64 + cc * 2; return st * 1024 + (ob ^ (((ob >> 9) & 1) << 5)); }
__host__ __device__ __forceinline__ void stage_rc(int b, int& R, int& C) { const int st = b / 1024, sb = b % 1024, swz = sb ^ (((sb >> 9) & 1) << 5); R = (st >> 1) * 16 + swz / 64; C = (st & 1) * 32 + (swz % 64) / 2; }
__host__ __device__ __forceinline__ int perm32(int rho) { const int n = rho >> 4, i = rho & 15; return 8 * (i >> 2) + 4 * n + (i & 3); }
struct Unit { int pm, pn; };
struct Gemm { const bf16_t* A; const bf16_t* Bt; int M, N, K; };
struct StaticOrder {
    int nM, nN, nwg, G, c;
    __host__ __device__ void init(int M, int N, int G_, int c_) { nM = M / BM; nN = N / BM; nwg = nM * nN; G = G_; c = c_; }
    __host__ __device__ bool next(int i, Unit& u) const {
        const long L = (long)i * G + c; if (L >= nwg) return false;
        int wgid = (int)L; { const int q = nwg / NXCD, r = nwg % NXCD, xcd = wgid % NXCD, off = wgid / NXCD; wgid = (xcd < r ? xcd * (q + 1) : r * (q + 1) + (xcd - r) * q) + off; }
        const int nig = WGM * nN, gid = wgid / nig, fm = gid * WGM, gsz = (nM - fm) < WGM ? (nM - fm) : WGM;
        u.pm = fm + ((wgid % nig) % gsz); u.pn = (wgid % nig) / gsz; return true;
    }
};
__device__ __forceinline__ unsigned cvt_pk_bf16(float lo, float hi) { unsigned r; asm volatile("v_cvt_pk_bf16_f32 %0, %1, %2" : "=v"(r) : "v"(lo), "v"(hi)); return r; }
struct EpiF32 {
    static constexpr bool PERM = false;
    float* C; int ldc;
    __device__ __forceinline__ void operator()(const f32x4 (&acc)[2][2][4][2], const Unit& u, int wr, int wc, int fr, int fq) const {
        const int row0 = u.pm * BM + wr * 64 + fr, col0 = u.pn * BM + wc * 32 + 4 * fq;
#pragma unroll
        for (int ai = 0; ai < 2; ++ai)
#pragma unroll
            for (int m = 0; m < 4; ++m) { float* rowp = C + (size_t)(row0 + ai * HALF + m * 16) * ldc + col0;
#pragma unroll
                for (int bj = 0; bj < 2; ++bj)
#pragma unroll
                    for (int n = 0; n < 2; ++n) *(f32x4*)(rowp + bj * HALF + n * 16) = acc[ai][bj][m][n]; }
    }
};
struct EpiBf16 {
    static constexpr bool PERM = true;
    bf16_t* O; int ldc;
    __device__ __forceinline__ void operator()(const f32x4 (&acc)[2][2][4][2], const Unit& u, int wr, int wc, int fr, int fq) const {
        const int row0 = u.pm * BM + wr * 64 + fr; const int col0 = u.pn * BM + wc * 32 + 8 * fq;
#pragma unroll
        for (int ai = 0; ai < 2; ++ai)
#pragma unroll
            for (int m = 0; m < 4; ++m) { bf16_t* rowp = O + (size_t)(row0 + ai * HALF + m * 16) * ldc + col0;
#pragma unroll
                for (int bj = 0; bj < 2; ++bj) { const f32x4 v0 = acc[ai][bj][m][0], v1 = acc[ai][bj][m][1];
                    u32x4 w; w.x = cvt_pk_bf16(v0[0], v0[1]); w.y = cvt_pk_bf16(v0[2], v0[3]); w.z = cvt_pk_bf16(v1[0], v1[1]); w.w = cvt_pk_bf16(v1[2], v1[3]);
                    *(u32x4*)(rowp + bj * HALF) = w; } }
    }
};

template <class Epi, class Sched>
__device__ __forceinline__ void gemm_phase(LAS unsigned char* lds, const Gemm g, const Sched& S, const Epi& E) {
    const int tid = threadIdx.x, wid = __builtin_amdgcn_readfirstlane(tid >> 6), lane = tid & 63, wr = wid >> 2, wc = wid & 3, fr = lane & 15, fq = lane >> 4;
    const int K = g.K, nt = K / BK;
    unsigned voffA[2], voffB[2];
#pragma unroll
    for (int i = 0; i < 2; ++i) { int R, C; stage_rc(tid * 16 + i * 8192, R, C); const int Rb = Epi::PERM ? ((R & ~31) + perm32(R & 31)) : R;
        voffA[i] = (unsigned)(R * K + C) * 2u; voffB[i] = (unsigned)(Rb * K + C) * 2u; }
    const size_t kstep = (size_t)(BK * 2);
    const size_t hstep = (size_t)HALF * K * 2;
    const size_t tstep = 2 * hstep;
    const unsigned ldsw = (unsigned)wid * 1024u;
    const int aoff = lds_byte(wr * 64 + fr, fq * 8), boff = lds_byte(wc * 32 + fr, fq * 8);
#define PG8_SA(b, h) (((b) * 2 + (h)) * HTB)
#define PG8_SB(b, h) ((4 + (b) * 2 + (h)) * HTB)
#define PG8_STAGE(bufoff, gbase, voff) do { _Pragma("unroll") for (int _i = 0; _i < 2; ++_i) \
        __builtin_amdgcn_global_load_lds((const unsigned*)((const char*)(gbase) + (voff)[_i]), (LAS unsigned*)(lds + (bufoff) + ldsw + _i * 8192), 16, 0, 0); } while (0)
#define PG8_LDA(dst, b, h) do { _Pragma("unroll") for (int m = 0; m < 4; ++m) _Pragma("unroll") for (int k = 0; k < 2; ++k) dst[m][k] = *(const LAS bf16x8*)(lds + PG8_SA(b, h) + aoff + m * 2048 + k * 1024); } while (0)
#define PG8_LDB(dst, b, h) do { _Pragma("unroll") for (int n = 0; n < 2; ++n) _Pragma("unroll") for (int k = 0; k < 2; ++k) dst[n][k] = *(const LAS bf16x8*)(lds + PG8_SB(b, h) + boff + n * 2048 + k * 1024); } while (0)
#define PG8_MMA(ai, bj, At, Bt) do { __builtin_amdgcn_s_setprio(1); _Pragma("unroll") for (int m = 0; m < 4; ++m) _Pragma("unroll") for (int n = 0; n < 2; ++n) _Pragma("unroll") for (int k = 0; k < 2; ++k) \
        acc[ai][bj][m][n] = __builtin_amdgcn_mfma_f32_16x16x32_bf16(Bt[n][k], At[m][k], acc[ai][bj][m][n], 0, 0, 0); __builtin_amdgcn_s_setprio(0); } while (0)
#define PG8_WAIT_V(n) asm volatile("s_waitcnt vmcnt(" #n ")" ::: "memory")
#define PG8_WAIT_L(n) asm volatile("s_waitcnt lgkmcnt(" #n ")" ::: "memory")
#define PG8_BAR __builtin_amdgcn_s_barrier()
#define PG8_SCHED __builtin_amdgcn_sched_barrier(0)
    Unit cur, nxt; int ui = 0;
    if (!S.next(0, cur)) return;
    f32x4 acc[2][2][4][2];
#pragma unroll
    for (int a = 0; a < 2; ++a)
#pragma unroll
        for (int b = 0; b < 2; ++b)
#pragma unroll
            for (int m = 0; m < 4; ++m)
#pragma unroll
                for (int n = 0; n < 2; ++n) acc[a][b][m][n] = (f32x4){0.f, 0.f, 0.f, 0.f};
    bf16x8 At[4][2], B0[2][2], B1[2][2];
    const char* cA = (const char*)g.A + (size_t)cur.pm * tstep; const char* cB = (const char*)g.Bt + (size_t)cur.pn * tstep;
    PG8_STAGE(PG8_SB(0, 0), cB, voffB); PG8_STAGE(PG8_SA(0, 0), cA, voffA); PG8_STAGE(PG8_SB(0, 1), cB + hstep, voffB); PG8_STAGE(PG8_SA(0, 1), cA + hstep, voffA);
    if (wr == 1) PG8_BAR;
    PG8_WAIT_V(4); PG8_BAR;
    PG8_STAGE(PG8_SB(1, 0), cB + kstep, voffB); PG8_STAGE(PG8_SA(1, 0), cA + kstep, voffA); PG8_STAGE(PG8_SB(1, 1), cB + hstep + kstep, voffB);
    PG8_WAIT_V(6); PG8_BAR;
    for (;;) {
        const bool has_next = S.next(ui + 1, nxt);
        const char* nA = has_next ? (const char*)g.A + (size_t)nxt.pm * tstep : cA; const char* nB = has_next ? (const char*)g.Bt + (size_t)nxt.pn * tstep : cB;
        for (int t = 0; t < nt; t += 2) {
            const bool last = (t == nt - 2);
            const char* a1 = cA + (size_t)(t + 1) * kstep;
            const char* a2 = last ? nA : cA + (size_t)(t + 2) * kstep; const char* b2 = last ? nB : cB + (size_t)(t + 2) * kstep;
            const char* a3 = a2 + kstep; const char* b3 = b2 + kstep;
            PG8_LDB(B0, 0, 0); PG8_SCHED; PG8_LDA(At, 0, 0); PG8_STAGE(PG8_SA(1, 1), a1 + hstep, voffA);
            PG8_WAIT_L(8); PG8_BAR; PG8_WAIT_L(0); PG8_MMA(0, 0, At, B0); PG8_BAR; PG8_SCHED;
            PG8_LDB(B1, 0, 1); PG8_STAGE(PG8_SB(0, 0), b2, voffB);
            PG8_BAR; PG8_WAIT_L(0); PG8_MMA(0, 1, At, B1); PG8_BAR;
            PG8_LDA(At, 0, 1); PG8_STAGE(PG8_SA(0, 0), a2, voffA);
            PG8_BAR; PG8_WAIT_L(0); PG8_MMA(1, 0, At, B0); PG8_BAR; PG8_SCHED;
            PG8_STAGE(PG8_SB(0, 1), b2 + hstep, voffB);
            PG8_WAIT_V(6); PG8_BAR; PG8_MMA(1, 1, At, B1); PG8_BAR;
            PG8_LDB(B0, 1, 0); PG8_SCHED; PG8_LDA(At, 1, 0); PG8_STAGE(PG8_SA(0, 1), a2 + hstep, voffA);
            PG8_WAIT_L(8); PG8_BAR; PG8_WAIT_L(0); PG8_MMA(0, 0, At, B0); PG8_BAR; PG8_SCHED;
            PG8_LDB(B1, 1, 1); PG8_STAGE(PG8_SB(1, 0), b3, voffB);
            PG8_BAR; PG8_WAIT_L(0); PG8_MMA(0, 1, At, B1); PG8_BAR;
            PG8_LDA(At, 1, 1); PG8_STAGE(PG8_SA(1, 0), a3, voffA);
            PG8_BAR; PG8_WAIT_L(0); PG8_MMA(1, 0, At, B0); PG8_BAR; PG8_SCHED;
            PG8_STAGE(PG8_SB(1, 1), b3 + hstep, voffB);
            PG8_WAIT_V(6); PG8_BAR; PG8_MMA(1, 1, At, B1); PG8_BAR;
        }
        E(acc, cur, wr, wc, fr, fq);
        if (!has_next) break;
#pragma unroll
        for (int a = 0; a < 2; ++a)
#pragma unroll
            for (int b = 0; b < 2; ++b)
#pragma unroll
                for (int m = 0; m < 4; ++m)
#pragma unroll
                    for (int n = 0; n < 2; ++n) acc[a][b][m][n] = (f32x4){0.f, 0.f, 0.f, 0.f};
        cur = nxt; cA = nA; cB = nB; ++ui;
    }
    PG8_WAIT_V(0);
    if (wr == 0) PG8_BAR;
    PG8_BAR;
#undef PG8_SA
#undef PG8_SB
#undef PG8_STAGE
#undef PG8_LDA
#undef PG8_LDB
#undef PG8_MMA
#undef PG8_WAIT_V
#undef PG8_WAIT_L
#undef PG8_BAR
#undef PG8_SCHED
}
}

struct Frame {
    LAS unsigned char* lds;
    int tid, lane, wave, G, b;
    float* out; unsigned char* ws;
    __device__ __forceinline__ bf16_t* H() const { return (bf16_t*)out; }
    __device__ __forceinline__ bf16_t* Qc() const { return (bf16_t*)out; }
    __device__ __forceinline__ bf16_t* Kc() const { return (bf16_t*)(out + OUT_YS); }
    __device__ __forceinline__ bf16_t* MIX() const { return (bf16_t*)out; }
    __device__ __forceinline__ float* modp() const { return (float*)(ws + WS_MODP); }
    __device__ __forceinline__ float* pe() const { return (float*)(ws + WS_PE); }
    __device__ __forceinline__ float* BA() const { return (float*)(ws + WS_BA); }
    __device__ __forceinline__ float* GB() const { return (float*)(ws + WS_GB); }
    __device__ __forceinline__ float* RGAGG() const { return (float*)(ws + WS_RGAGG); }
    __device__ __forceinline__ bf16_t* WbaT() const { return (bf16_t*)(ws + WS_WBAT); }
    __device__ __forceinline__ bf16_t* WoutT() const { return (bf16_t*)(ws + WS_WOUTT); }
    __device__ __forceinline__ bf16_t* GT() const { return (bf16_t*)(ws + WS_GT); }
    __device__ __forceinline__ bf16_t* WinT() const { return (bf16_t*)(ws + WS_WINT); }
    __device__ __forceinline__ bf16_t* TA() const { return (bf16_t*)(ws + WS_TA); }
    __device__ __forceinline__ bf16_t* PROJ() const { return (bf16_t*)(ws + WS_PROJ); }
    __device__ __forceinline__ float* CARRY() const { return (float*)(ws + WS_CARRY); }
};
typedef const __attribute__((address_space(4))) Params CParams;

__device__ __forceinline__ int grp_of_block(int tb) { return tb < 128 ? 0 : (tb < 192 ? 1 : 2); }

__device__ __forceinline__ void transpose_item(const float* W, int N, int k0, int n0, bf16_t* WT0, int Kout, LAS float* scr, int lane) {
#pragma unroll 8
    for (int i = 0; i < 32; ++i) { const int kk = 2 * i + (lane >> 5); scr[kk * 33 + (lane & 31)] = W[(size_t)(k0 + kk) * N + n0 + (lane & 31)]; }
    LDS_WAIT();
    const int c = lane & 7;
#pragma unroll
    for (int j = 0; j < 4; ++j) { const int n = (lane >> 3) + 8 * j; const LAS float* s = scr + (8 * c) * 33 + n;
        u32x4 o; o.x = pk2(s[0 * 33], s[1 * 33]); o.y = pk2(s[2 * 33], s[3 * 33]); o.z = pk2(s[4 * 33], s[5 * 33]); o.w = pk2(s[6 * 33], s[7 * 33]);
        *(u32x4*)(WT0 + (size_t)n * Kout + k0 + 8 * c) = o; }
    LDS_WAIT();
}
__device__ __forceinline__ void phase0(CParams& p, Frame& F) {
    const int tid = F.tid, lane = F.lane;
    for (int it = F.b; it < 192; it += F.G) {
        const int jg = it % 12, ks = it / 12, j = jg * 256 + (tid & 255), half = tid >> 8, k0 = ks * 64 + half * 32;
        float s0 = 0.f, s1 = 0.f, s2 = 0.f;
#pragma unroll 8
        for (int k = 0; k < 32; ++k) { const int kk = k0 + k; const float w = p.ada_w[(size_t)kk * 3072 + j];
            s0 += siluf_(p.c_ctx[kk]) * w; s1 += siluf_(p.c[kk]) * w; s2 += siluf_(p.c[1024 + kk]) * w; }
        LAS float* red = (LAS float*)F.lds;
        if (half == 1) { red[tid - 256] = s0; red[256 + tid - 256] = s1; red[512 + tid - 256] = s2; }
        __syncthreads();
        if (half == 0) { F.modp()[(size_t)(ks * 3 + 0) * 3072 + j] = s0 + red[tid]; F.modp()[(size_t)(ks * 3 + 1) * 3072 + j] = s1 + red[256 + tid]; F.modp()[(size_t)(ks * 3 + 2) * 3072 + j] = s2 + red[512 + tid]; }
        __syncthreads();
    }
    LAS float* scr = (LAS float*)(F.lds + 4096 + F.wave * 8448);
    const int gw = F.b * 8 + F.wave, NGW = F.G * 8;
    constexpr int I_IN = 16 * 193, I_OUT = 32 * 32, I_G = 256, I_PE = 64;
    for (int it = gw; it < I_IN + I_OUT + I_G + I_PE; it += NGW) {
        int r = it;
        if (r < I_IN) { const int kb = r / 193, nb = r % 193, n0 = nb * 32;
            bf16_t* dst = n0 < 4096 ? F.WinT() + (size_t)n0 * 1024 : (n0 < 4128 ? F.WbaT() + (size_t)(n0 - 4096) * 1024 : F.WinT() + (size_t)(n0 - 32) * 1024);
            transpose_item(p.w_in, DIN, kb * 64, n0, dst, 1024, scr, lane); continue; }
        r -= I_IN;
        if (r < I_OUT) { const int kb = r / 32, nb = r % 32; transpose_item(p.w_out, 1024, kb * 64, nb * 32, F.WoutT() + (size_t)(nb * 32) * 2048, 2048, scr, lane); continue; }
        r -= I_OUT;
        if (r < I_G) { const int m = r >> 3, sub = r & 7, kb = sub >> 2, nb = sub & 3, g = m >> 4, dn = m & 15;
            const float* src = (g ? p.rg_w_i : p.rg_w_r) + (size_t)dn * 16384;
            transpose_item(src, 128, kb * 64, nb * 32, F.GT() + (size_t)m * 16384 + (size_t)(nb * 32) * 128, 128, scr, lane); continue; }
        r -= I_G;
        { const int v = r;
#pragma unroll
          for (int i = 0; i < 4; ++i) { const int idx = lane * 4 + i; const float f = expf(-9.210340371976184f * (float)idx / 256.f); const float a = (float)v * f;
              F.pe()[v * 256 + idx] = sinf(a); F.pe()[16384 + v * 256 + idx] = cosf(a); } }
    }
}

__device__ __forceinline__ float mod_val(CParams& p, const Frame& F, int grp, int j) {
    float s = p.ada_b[j];
#pragma unroll
    for (int ks = 0; ks < 16; ++ks) s += F.modp()[(size_t)(ks * 3 + grp) * 3072 + j];
    return s;
}

__device__ __forceinline__ void phase1(CParams& p, Frame& F) {
    LAS float* sc = (LAS float*)F.lds; LAS float* sh = sc + 1024;
    for (int tb = F.b; tb < 256; tb += F.G) {
        const int grp = grp_of_block(tb);
        for (int j = F.tid; j < 1024; j += 512) { sh[j] = mod_val(p, F, grp, j); sc[j] = p.pre_w[j] * (1.f + mod_val(p, F, grp, 1024 + j)); }
        __syncthreads();
#pragma unroll 2
        for (int i = 0; i < 8; ++i) {
            const int tok = tb * 64 + F.wave * 8 + i;
            const float* xr = tok < 8192 ? p.x_prompt + (size_t)tok * 1024 : p.x_sample + (size_t)(tok - 8192) * 1024;
            f32x4 v[4]; float ss = 0.f;
#pragma unroll
            for (int q = 0; q < 4; ++q) { v[q] = *(const f32x4*)(xr + F.lane * 4 + 256 * q);
                if (tok >= 8192) { const int pp = (tok - 8192) & 4095; const int vv = (q < 2) ? (pp >> 6) : (pp & 63);
                    const f32x4 e = *(const f32x4*)(F.pe() + ((q & 1) ? 16384 : 0) + vv * 256 + F.lane * 4); v[q] += e; }
                ss += (v[q][0] * v[q][0] + v[q][1] * v[q][1]) + (v[q][2] * v[q][2] + v[q][3] * v[q][3]); }
            const float rstd = rsqrtf(wave_sum(ss) * (1.f / 1024.f) + 1e-6f);
#pragma unroll
            for (int q = 0; q < 4; ++q) { const int j = F.lane * 4 + 256 * q; const f32x4 s4 = *(const LAS f32x4*)(sc + j), h4 = *(const LAS f32x4*)(sh + j);
                CHK(F, 1, badv(v[q][0] * rstd * s4[0] + h4[0], 100.f) || badv(v[q][3] * rstd * s4[3] + h4[3], 100.f));
                u32x2 o; o.x = pk2(v[q][0] * rstd * s4[0] + h4[0], v[q][1] * rstd * s4[1] + h4[1]); o.y = pk2(v[q][2] * rstd * s4[2] + h4[2], v[q][3] * rstd * s4[3] + h4[3]);
                *(u32x2*)(F.H() + (size_t)tok * 1024 + j) = o; }
        }
        __syncthreads();
    }
}

__device__ __forceinline__ void phase2(CParams& p, Frame& F) {
    { pg8::Gemm g{F.H(), F.WinT(), NTOK, NPROJ, 1024}; pg8::StaticOrder S; S.init(NTOK, NPROJ, F.G, F.b); pg8::EpiBf16 E{F.PROJ(), NPROJ};
      pg8::gemm_phase<pg8::EpiBf16, pg8::StaticOrder>(F.lds, g, S, E); }
    const int l15 = F.lane & 15, q4 = F.lane >> 4;
    for (int tb = F.b; tb < 256; tb += F.G) {
        const int mt = F.wave >> 1, nt = F.wave & 1;
        const bf16_t* ar = F.H() + (size_t)(tb * 64 + mt * 16 + l15) * 1024 + q4 * 8;
        const bf16_t* br = F.WbaT() + (size_t)(nt * 16 + l15) * 1024 + q4 * 8;
        f32x4 acc = {0.f, 0.f, 0.f, 0.f};
#pragma unroll 4
        for (int ks = 0; ks < 32; ++ks) { const bf16x8 a = *(const bf16x8*)(ar + ks * 32), b = *(const bf16x8*)(br + ks * 32); acc = MFMA16(a, b, acc); }
#pragma unroll
        for (int r = 0; r < 4; ++r) F.BA()[(size_t)(tb * 64 + mt * 16 + q4 * 4 + r) * 32 + nt * 16 + l15] = acc[r];
    }
}

__device__ __forceinline__ void p3_load_rows(const Frame& F, int ci, int h, u32x4 (&rows)[7]) {
    const int tid = F.tid, tg = tid >> 5, part = (tid >> 4) & 1, sub = tid & 15, col = part * 1024 + h * 128 + sub * 8, t0 = ci * 64;
    int seq_lo, seq_hi; if (ci < 128) { seq_lo = (ci >> 2) * 256; seq_hi = seq_lo + 256; } else { seq_lo = 8192 + ((ci - 128) >> 6) * 4096; seq_hi = seq_lo + 4096; }
    const int tb = t0 + tg * 4 - 2;
#pragma unroll
    for (int r = 0; r < 7; ++r) { const int tok = tb + r; u32x4 v = {0u, 0u, 0u, 0u};
        if (tok >= seq_lo && tok < seq_hi) v = *(const u32x4*)(F.PROJ() + (size_t)tok * NPROJ + col);
        rows[r] = v; }
}
__device__ __forceinline__ void p3_delta_item(CParams& p, Frame& F, int ci, int h, u32x4 (&rows)[7], int itn) {
    const int tid = F.tid, lane = F.lane, wave = F.wave, q4 = lane >> 4, l15 = lane & 15;
    LAS unsigned char* Ks = F.lds; LAS unsigned char* Qs = F.lds + 17408;
    LAS float* gfv = (LAS float*)(F.lds + 34816);
    LAS unsigned char* DIR0 = F.lds + 35840;
    LAS unsigned char* ATo = F.lds + 137728;
#pragma unroll
    for (int i = 0; i < 5; ++i) { const int ch = tid + 512 * i; if (ch < 2304) { const int dd = ch >= 1152, cc = ch - dd * 1152; *(LAS u32x4*)(DIR0 + dd * 46848 + 18432 + cc * 16) = (u32x4){0u, 0u, 0u, 0u}; } }
    const int t0 = ci * 64;
    int seq_lo, seq_hi; if (ci < 128) { seq_lo = (ci >> 2) * 256; seq_hi = seq_lo + 256; } else { seq_lo = 8192 + ((ci - 128) >> 6) * 4096; seq_hi = seq_lo + 4096; }
    {
        const int tg = tid >> 5, part = (tid >> 4) & 1, sub = tid & 15, col = part * 1024 + h * 128 + sub * 8;
        float w[4][8];
#pragma unroll
        for (int j = 0; j < 4; ++j) { const f32x4 a = *(const f32x4*)(p.dn_conv_w + j * 3072 + col), b = *(const f32x4*)(p.dn_conv_w + j * 3072 + col + 4);
            w[j][0] = a[0]; w[j][1] = a[1]; w[j][2] = a[2]; w[j][3] = a[3]; w[j][4] = b[0]; w[j][5] = b[1]; w[j][6] = b[2]; w[j][7] = b[3]; }
        float acc[4][8];
#pragma unroll
        for (int i = 0; i < 4; ++i)
#pragma unroll
            for (int e = 0; e < 8; ++e) acc[i][e] = 0.f;
#pragma unroll
        for (int r = 0; r < 7; ++r) {
            float x[8]; unpack8(rows[r], x);
#pragma unroll
            for (int j = 0; j < 4; ++j) { const int i = r - j; if (i >= 0 && i < 4) {
#pragma unroll
                for (int e = 0; e < 8; ++e) acc[i][e] += w[j][e] * x[e]; } } }
#pragma unroll
        for (int i = 0; i < 4; ++i) { float ss = 0.f;
#pragma unroll
            for (int e = 0; e < 8; ++e) { acc[i][e] = siluf_(acc[i][e]); ss += acc[i][e] * acc[i][e]; }
            ss += __shfl_xor(ss, 1); ss += __shfl_xor(ss, 2); ss += __shfl_xor(ss, 4); ss += __shfl_xor(ss, 8);
            const float rs = rsqrtf(ss + 1e-6f) * (part == 0 ? 0.08838834764831845f : 1.f);
#pragma unroll
            for (int e = 0; e < 8; ++e) acc[i][e] *= rs;
            CHK(F, 4, badv(acc[i][0], 1.01f) || badv(acc[i][5], 1.01f) || badv(ss * rs * rs, part == 0 ? 0.0079f : 1.01f));
            const u32x4 o = pack8(acc[i]); const int c = tg * 4 + i;
            *(LAS u32x4*)((part ? Ks : Qs) + c * 272 + sub * 16) = o;
            *(u32x4*)((part ? F.Kc() : F.Qc()) + (size_t)(t0 + c) * 1024 + h * 128 + sub * 8) = o; }
    }
    if (wave == 0) {
        const float* ba = F.BA() + (size_t)(t0 + lane) * 32;
        const float bf_ = sigm(ba[h]), bb_ = sigm(ba[8 + h]);
        float s = -expf(p.dn_a_log[h]) * softplusf_(ba[16 + h] + p.dn_dt_bias[h]);
        float sb = -expf(p.dn_a_log[8 + h]) * softplusf_(ba[24 + h] + p.dn_dt_bias[8 + h]);
#pragma unroll
        for (int o = 1; o < 64; o <<= 1) { const float t = __shfl_up(s, o); if (lane >= o) s += t; }
#pragma unroll
        for (int o = 1; o < 64; o <<= 1) { const float t = __shfl_down(sb, o); if (lane + o < 64) sb += t; }
        CHK(F, 3, badv(ba[h], 1000.f) || badv(ba[24 + h], 1000.f));
        CHK(F, 8, badv(s, 1e4f) || badv(sb, 1e4f) || s > 0.f || sb > 0.f || bf_ < 0.f || bf_ > 1.f || bb_ < 0.f || bb_ > 1.f);
        gfv[lane] = s; gfv[64 + lane] = sb; gfv[128 + lane] = bf_; gfv[192 + lane] = bb_;
        float* gb = F.GB() + (size_t)(ci * 8 + h) * 256;
        gb[lane] = s; gb[64 + lane] = sb; gb[128 + lane] = bf_; gb[192 + lane] = bb_;
    }
    __syncthreads();
    const int d = wave >> 2, mt = wave & 3;
    LAS unsigned char* Db = DIR0 + d * 46848;
    LAS unsigned char* Brow = Db; LAS unsigned char* Btr = Db + 9216; LAS unsigned char* Xrow = Db + 18432; LAS unsigned char* Xtr = Db + 27648;
    LAS float* Dl = (LAS float*)(Db + 36864) + mt * 272; LAS unsigned char* M2t = Db + 41216; LAS unsigned char* Mts = Db + 43776 + mt * 768;
    const LAS unsigned char* Lrow = d == 0 ? Brow : Btr;
    const LAS float* gd = gfv + d * 64; const LAS float* bd = gfv + 128 + d * 64;
    {
        f32x4 kk[4], qk[4];
#pragma unroll
        for (int n = 0; n < 4; ++n) { kk[n] = (f32x4){0.f, 0.f, 0.f, 0.f}; qk[n] = (f32x4){0.f, 0.f, 0.f, 0.f}; }
#pragma unroll
        for (int ks = 0; ks < 4; ++ks) { const bf16x8 ak = ldfrag(Ks, 272, mt * 16 + l15, ks * 64 + q4 * 16), aq = ldfrag(Qs, 272, mt * 16 + l15, ks * 64 + q4 * 16);
#pragma unroll
            for (int n = 0; n < 4; ++n) { const bf16x8 bk = ldfrag(Ks, 272, n * 16 + l15, ks * 64 + q4 * 16); kk[n] = MFMA16(ak, bk, kk[n]); qk[n] = MFMA16(aq, bk, qk[n]); } }
#pragma unroll
        for (int n = 0; n < 4; ++n) { const int s = n * 16 + l15; float a4[4];
#pragma unroll
            for (int r = 0; r < 4; ++r) { const int c = mt * 16 + q4 * 4 + r;
                const float dec = __expf(fminf(gd[c] - gd[s], 0.f));
                const bool strict = d == 0 ? (c > s) : (c < s);
                const float a = strict ? bd[c] * kk[n][r] * dec : 0.f;
                a4[r] = a;
                ((LAS bf16_t*)Brow)[c * 72 + s] = f2bf(a);
                if (n == mt) { if (d == 0) Dl[(q4 * 4 + r) * 17 + l15] = a; else Dl[l15 * 17 + q4 * 4 + r] = a; }
                const bool incl = d == 0 ? (c >= s) : (c < s);
                if (incl) ((LAS bf16_t*)ATo)[c * 64 + s] = f2bf(qk[n][r] * dec); }
            u32x2 o; o.x = pk2(a4[0], a4[1]); o.y = pk2(a4[2], a4[3]);
            *(LAS u32x2*)(Btr + s * 144 + (mt * 16 + q4 * 4) * 2) = o; }
    }
    __syncthreads();
    if (lane < 16) {
        float x[16];
#pragma unroll
        for (int i = 0; i < 16; ++i) { float sv = (i == lane) ? 1.f : 0.f;
#pragma unroll
            for (int j = 0; j < i; ++j) sv -= Dl[i * 17 + j] * x[j];
            x[i] = sv; }
#pragma unroll
        for (int i = 0; i < 16; ++i) ((LAS bf16_t*)Xrow)[(mt * 16 + i) * 72 + mt * 16 + lane] = f2bf(x[i]);
        u32x4 o0, o1; o0.x = pk2(x[0], x[1]); o0.y = pk2(x[2], x[3]); o0.z = pk2(x[4], x[5]); o0.w = pk2(x[6], x[7]);
        o1.x = pk2(x[8], x[9]); o1.y = pk2(x[10], x[11]); o1.z = pk2(x[12], x[13]); o1.w = pk2(x[14], x[15]);
        *(LAS u32x4*)(Xtr + (mt * 16 + lane) * 144 + mt * 32) = o0; *(LAS u32x4*)(Xtr + (mt * 16 + lane) * 144 + mt * 32 + 16) = o1;
    }
    __syncthreads();
    const bf16x8 zero8 = {0, 0, 0, 0, 0, 0, 0, 0};
    const f32x4 zero4 = {0.f, 0.f, 0.f, 0.f};
    if (mt & 1) {
        const int I1 = mt, I0 = mt - 1;
        bf16x8 a = zero8, b = zero8;
        if (q4 < 2) { a = ldfrag(Lrow, 144, I1 * 16 + l15, I0 * 32 + q4 * 16); b = ldfrag(Xtr, 144, I0 * 16 + l15, I0 * 32 + q4 * 16); }
        const f32x4 M = MFMA16(a, b, zero4);
        { u32x2 o; o.x = pk2(M[0], M[1]); o.y = pk2(M[2], M[3]); *(LAS u32x2*)(Mts + l15 * 48 + q4 * 8) = o; }
        LDS_WAIT();
        bf16x8 a2 = zero8, b2 = zero8;
        if (q4 < 2) { a2 = ldfrag(Xrow, 144, I1 * 16 + l15, I1 * 32 + q4 * 16); b2 = *(const LAS bf16x8*)(Mts + l15 * 48 + q4 * 16); }
        const f32x4 X = MFMA16(a2, b2, zero4);
#pragma unroll
        for (int r = 0; r < 4; ++r) ((LAS bf16_t*)Xrow)[(I1 * 16 + q4 * 4 + r) * 72 + I0 * 16 + l15] = f2bf(-X[r]);
        u32x2 o; o.x = pk2(-X[0], -X[1]); o.y = pk2(-X[2], -X[3]);
        *(LAS u32x2*)(Xtr + (I0 * 16 + l15) * 144 + (I1 * 16 + q4 * 4) * 2) = o;
    }
    __syncthreads();
    {
        const int mi = mt >> 1, ni = mt & 1;
        const bf16x8 a = ldfrag(Lrow, 144, 32 + mi * 16 + l15, q4 * 16), b = ldfrag(Xtr, 144, ni * 16 + l15, q4 * 16);
        const f32x4 M2 = MFMA16(a, b, zero4);
        { u32x2 o; o.x = pk2(M2[0], M2[1]); o.y = pk2(M2[2], M2[3]); *(LAS u32x2*)(M2t + (ni * 16 + l15) * 80 + (mi * 16 + q4 * 4) * 2) = o; }
        __syncthreads();
        const bf16x8 a2 = ldfrag(Xrow, 144, 32 + mi * 16 + l15, 64 + q4 * 16), b2 = *(const LAS bf16x8*)(M2t + (ni * 16 + l15) * 80 + q4 * 16);
        const f32x4 X = MFMA16(a2, b2, zero4);
#pragma unroll
        for (int r = 0; r < 4; ++r) { CHK(F, 6, badv(X[r], 20.f)); ((LAS bf16_t*)Xrow)[(32 + mi * 16 + q4 * 4 + r) * 72 + ni * 16 + l15] = f2bf(-X[r]); }
        u32x2 o; o.x = pk2(-X[0], -X[1]); o.y = pk2(-X[2], -X[3]);
        *(LAS u32x2*)(Xtr + (ni * 16 + l15) * 144 + (32 + mi * 16 + q4 * 4) * 2) = o;
    }
    __syncthreads();
    { bf16_t* dst = F.TA() + (size_t)(ci * 8 + h) * 8192;
      const int c = tid >> 3, s0 = (tid & 7) * 8;
      const u32x4 lo = *(const LAS u32x4*)(DIR0 + 18432 + c * 144 + s0 * 2), up = *(const LAS u32x4*)(DIR0 + 46848 + 27648 + c * 144 + s0 * 2);
      unsigned wl[4] = {lo.x, lo.y, lo.z, lo.w}, wu[4] = {up.x, up.y, up.z, up.w}, wo[4];
#pragma unroll
      for (int i = 0; i < 4; ++i) { const int sa = s0 + 2 * i, sb2 = sa + 1;
          const unsigned mlo = (sa <= c ? 0x0000FFFFu : 0u) | (sb2 <= c ? 0xFFFF0000u : 0u);
          wo[i] = (wl[i] & mlo) | (wu[i] & ~mlo); }
      *(u32x4*)(dst + tid * 8) = (u32x4){wo[0], wo[1], wo[2], wo[3]};
      *(u32x4*)(dst + 4096 + tid * 8) = *(const LAS u32x4*)(ATo + tid * 16); }
    __syncthreads();
}

struct RgW { bf16x8 g[2][2][4]; float br[2], bi[2], sp[2]; };
__device__ __forceinline__ void rg_load_w(CParams& p, const Frame& F, int n, RgW& W) {
    const int q4 = F.lane >> 4, j = F.wave * 16 + (F.lane & 15), ch = n * 128 + j;
#pragma unroll
    for (int d = 0; d < 2; ++d) {
#pragma unroll
        for (int g = 0; g < 2; ++g) { const bf16_t* gp = F.GT() + (size_t)((g * 2 + d) * 8 + n) * 16384 + (size_t)j * 128 + q4 * 8;
#pragma unroll
            for (int ks = 0; ks < 4; ++ks) W.g[d][g][ks] = *(const bf16x8*)(gp + ks * 32); }
        W.br[d] = p.rg_b_r[d * 1024 + ch]; W.bi[d] = p.rg_b_i[d * 1024 + ch]; W.sp[d] = softplusf_(-p.rg_lam[d * 1024 + ch]); }
}
__device__ __forceinline__ void rg_load_rows(const Frame& F, int ci, int n, u32x4 (&rows)[5]) {
    const int tid = F.tid, tg = tid >> 4, sub = tid & 15, col = 4096 + n * 128 + sub * 8, t0 = ci * 64;
    int c_lo, c_hi; if (ci < 128) { c_lo = (ci >> 2) * 4; c_hi = c_lo + 4; } else { c_lo = 128 + ((ci - 128) >> 6) * 64; c_hi = c_lo + 64; }
    const int tb = t0 + tg * 2 - 2;
#pragma unroll
    for (int r = 0; r < 5; ++r) { const int tok = tb + r; u32x4 v = {0u, 0u, 0u, 0u};
        if (tok >= c_lo * 64 && tok < c_hi * 64) v = *(const u32x4*)(F.PROJ() + (size_t)tok * NPROJ + col);
        rows[r] = v; }
}
template <int PASS>
__device__ __forceinline__ void rg_item(CParams& p, Frame& F, int ci, int n, u32x4 (&rows)[5], int itn) {
    const int tid = F.tid, lane = F.lane, wave = F.wave, q4 = lane >> 4, l15 = lane & 15;
    LAS unsigned char* xb = F.lds; LAS float* xf = (LAS float*)(F.lds + 17408); LAS float* Hs = (LAS float*)(F.lds + 50176);
    const int t0 = ci * 64;
    int seq_lo, seq_hi, c_lo, c_hi, seq; const bool samp = ci >= 128;
    if (!samp) { seq = ci >> 2; c_lo = seq * 4; c_hi = c_lo + 4; } else { seq = (ci - 128) >> 6; c_lo = 128 + seq * 64; c_hi = c_lo + 64; }
    seq_lo = c_lo * 64; seq_hi = c_hi * 64;
    const int j = wave * 16 + l15, ch = n * 128 + j;
    bf16x8 wA[2][4], wB[2][4];
#pragma unroll
    for (int g = 0; g < 2; ++g) { const bf16_t* gp = F.GT() + (size_t)((g * 2 + 0) * 8 + n) * 16384 + (size_t)j * 128 + q4 * 8;
#pragma unroll
        for (int ks = 0; ks < 4; ++ks) wA[g][ks] = *(const bf16x8*)(gp + ks * 32); }
    {
        const int tg = tid >> 4, sub = tid & 15, ch = n * 128 + sub * 8;
        float w[4][8], acc[2][8];
#pragma unroll
        for (int j = 0; j < 4; ++j) { const f32x4 a = *(const f32x4*)(p.rg_conv_w + j * 1024 + ch), b = *(const f32x4*)(p.rg_conv_w + j * 1024 + ch + 4);
            w[j][0] = a[0]; w[j][1] = a[1]; w[j][2] = a[2]; w[j][3] = a[3]; w[j][4] = b[0]; w[j][5] = b[1]; w[j][6] = b[2]; w[j][7] = b[3]; }
        { const f32x4 a = *(const f32x4*)(p.rg_conv_b + ch), b = *(const f32x4*)(p.rg_conv_b + ch + 4);
#pragma unroll
          for (int i = 0; i < 2; ++i) { acc[i][0] = a[0]; acc[i][1] = a[1]; acc[i][2] = a[2]; acc[i][3] = a[3]; acc[i][4] = b[0]; acc[i][5] = b[1]; acc[i][6] = b[2]; acc[i][7] = b[3]; } }
#pragma unroll
        for (int r = 0; r < 5; ++r) {
            float x[8]; unpack8(rows[r], x);
#pragma unroll
            for (int j = 0; j < 4; ++j) { const int i = r - j; if (i >= 0 && i < 2) {
#pragma unroll
                for (int e = 0; e < 8; ++e) acc[i][e] += w[j][e] * x[e]; } } }
#pragma unroll
        for (int i = 0; i < 2; ++i) { const int c = tg * 2 + i;
            *(LAS u32x4*)(xb + c * 272 + sub * 16) = pack8(acc[i]);
            *(LAS f32x4*)(xf + c * 128 + sub * 8) = (f32x4){acc[i][0], acc[i][1], acc[i][2], acc[i][3]};
            *(LAS f32x4*)(xf + c * 128 + sub * 8 + 4) = (f32x4){acc[i][4], acc[i][5], acc[i][6], acc[i][7]}; }
    }
    __syncthreads();
    f32x4 hs[4];
#pragma unroll
    for (int m = 0; m < 4; ++m) hs[m] = (f32x4){0.f, 0.f, 0.f, 0.f};
#pragma unroll
    for (int d = 0; d < 2; ++d) {
        f32x4 av[4], bxv[4];
        {
            f32x4 ar[4], ai[4];
#pragma unroll
            for (int m = 0; m < 4; ++m) { ar[m] = (f32x4){0.f, 0.f, 0.f, 0.f}; ai[m] = (f32x4){0.f, 0.f, 0.f, 0.f}; }
#pragma unroll
            for (int ks = 0; ks < 4; ++ks) { const bf16x8 br = d == 0 ? wA[0][ks] : wB[0][ks], bi = d == 0 ? wA[1][ks] : wB[1][ks];
#pragma unroll
                for (int m = 0; m < 4; ++m) { const bf16x8 a = ldfrag(xb, 272, m * 16 + l15, ks * 64 + q4 * 16); ar[m] = MFMA16(a, br, ar[m]); ai[m] = MFMA16(a, bi, ai[m]); } }
            if (d == 0) {
#pragma unroll
                for (int g = 0; g < 2; ++g) { const bf16_t* gp = F.GT() + (size_t)((g * 2 + 1) * 8 + n) * 16384 + (size_t)j * 128 + q4 * 8;
#pragma unroll
                    for (int ks = 0; ks < 4; ++ks) wB[g][ks] = *(const bf16x8*)(gp + ks * 32); } }
            const float L2E = 1.4426950408889634f;
            const float br_ = -L2E * p.rg_b_r[d * 1024 + ch], bi_ = -L2E * p.rg_b_i[d * 1024 + ch], sp = softplusf_(-p.rg_lam[d * 1024 + ch]);
            const float k2 = -16.f * sp, k2e = k2 * L2E, k1e = 0.5f * k2e;
#pragma unroll
            for (int m = 0; m < 4; ++m)
#pragma unroll
                for (int r = 0; r < 4; ++r) { const int c = m * 16 + q4 * 4 + r;
                    const float rr = __builtin_amdgcn_rcpf(1.f + __builtin_amdgcn_exp2f(fmaf(ar[m][r], -L2E, br_)));
                    const float ii = __builtin_amdgcn_rcpf(1.f + __builtin_amdgcn_exp2f(fmaf(ai[m][r], -L2E, bi_)));
                    const float t2 = k2 * rr;
                    const float ser = t2 * fmaf(t2, fmaf(t2, 0.16666667f, 0.5f), 1.f);
                    const float em = t2 > -0.01f ? ser : __builtin_amdgcn_exp2f(k2e * rr) - 1.f;
                    av[m][r] = __builtin_amdgcn_exp2f(k1e * rr); bxv[m][r] = __builtin_amdgcn_sqrtf(-em) * (ii * xf[c * 128 + j]); }
        }
        f32x4 Pa[4], Pb[4]; float Ap[4], Bp[4], Am[4], Bm[4];
#pragma unroll
        for (int m = 0; m < 4; ++m) {
            float pa, pb;
            if (d == 0) { pa = av[m][0]; pb = bxv[m][0]; Pa[m][0] = pa; Pb[m][0] = pb;
#pragma unroll
                for (int r = 1; r < 4; ++r) { pb = av[m][r] * pb + bxv[m][r]; pa = av[m][r] * pa; Pa[m][r] = pa; Pb[m][r] = pb; } }
            else { pa = av[m][3]; pb = bxv[m][3]; Pa[m][3] = pa; Pb[m][3] = pb;
#pragma unroll
                for (int r = 2; r >= 0; --r) { pb = av[m][r] * pb + bxv[m][r]; pa = av[m][r] * pa; Pa[m][r] = pa; Pb[m][r] = pb; } }
            float Ak[4], Bk[4];
#pragma unroll
            for (int k = 0; k < 4; ++k) { Ak[k] = __shfl(pa, l15 + 16 * k); Bk[k] = __shfl(pb, l15 + 16 * k); }
            float ap = 1.f, bp = 0.f, am = 1.f, bm = 0.f;
#pragma unroll
            for (int kk = 0; kk < 4; ++kk) { const int k = d == 0 ? kk : 3 - kk;
                const bool before = d == 0 ? (k < q4) : (k > q4);
                const float nb = Ak[k] * bp + Bk[k], na = Ak[k] * ap;
                bp = before ? nb : bp; ap = before ? na : ap;
                bm = Ak[k] * bm + Bk[k]; am = Ak[k] * am; }
            Ap[m] = ap; Bp[m] = bp; Am[m] = am; Bm[m] = bm;
        }
        if (PASS == 1) {
            float At = 1.f, Bt = 0.f;
#pragma unroll
            for (int mm = 0; mm < 4; ++mm) { const int m = d == 0 ? mm : 3 - mm; Bt = Am[m] * Bt + Bm[m]; At = Am[m] * At; }
            if (q4 == 0) { float* ag = F.RGAGG() + (size_t)(ci * 2 + d) * 2048; ag[ch] = At; ag[1024 + ch] = Bt; }
        } else {
            float hb = F.CARRY()[(size_t)(ci * 2 + d) * 1024 + ch];
#pragma unroll
            for (int mm = 0; mm < 4; ++mm) { const int m = d == 0 ? mm : 3 - mm;
                const float hin = Ap[m] * hb + Bp[m];
#pragma unroll
                for (int r = 0; r < 4; ++r) hs[m][r] += Pa[m][r] * hin + Pb[m][r];
                hb = Am[m] * hb + Bm[m]; }
            if (!samp && q4 == 0 && ci == (d == 0 ? c_hi - 1 : c_lo)) F.out[OUT_SR + (size_t)(seq * 2 + d) * 1024 + ch] = hb;
        }
    }
    if (PASS == 1 && itn < 2048) rg_load_rows(F, itn >> 3, itn & 7, rows);
    if (PASS == 3) {
#pragma unroll
        for (int m = 0; m < 4; ++m)
#pragma unroll
            for (int r = 0; r < 4; ++r) Hs[(m * 16 + q4 * 4 + r) * 128 + j] = hs[m][r];
        __syncthreads();
#pragma unroll
        for (int i = 0; i < 2; ++i) { const int chunk = tid + 512 * i, c = chunk >> 4, cc = chunk & 15;
            const u32x4 gv = *(const u32x4*)(F.PROJ() + (size_t)(t0 + c) * NPROJ + 5120 + n * 128 + cc * 8);
            float g[8]; unpack8(gv, g);
            const f32x4 ha = *(const LAS f32x4*)(Hs + c * 128 + cc * 8), hb2 = *(const LAS f32x4*)(Hs + c * 128 + cc * 8 + 4);
            float o[8];
#pragma unroll
            for (int e = 0; e < 4; ++e) { o[e] = ha[e] * siluf_(g[e]); o[4 + e] = hb2[e] * siluf_(g[4 + e]); }
            *(u32x4*)(F.MIX() + (size_t)(t0 + c) * 2048 + 1024 + n * 128 + cc * 8) = pack8(o); }
    }
    __syncthreads();
}

__device__ __forceinline__ void rg_carry_scan(CParams& p, Frame& F) {
    const int tid = F.tid;
    int samp, seq, d, ch;
    if (tid < 256) { const int g = F.b * 256 + tid; if (g >= 65536) return; samp = 0; seq = g >> 11; d = (g >> 10) & 1; ch = g & 1023; }
    else if (tid < 272) { const int g = F.b * 16 + tid - 256; if (g >= 4096) return; samp = 1; seq = g >> 11; d = (g >> 10) & 1; ch = g & 1023; }
    else return;
    const int nch = samp ? 64 : 4, c_lo = samp ? 128 + seq * 64 : seq * 4;
    float h = samp ? p.state_rglru[(size_t)(seq * 2 + d) * 1024 + ch] : 0.f;
    for (int i0 = 0; i0 < nch; i0 += 4) {
        float A[4], B[4];
#pragma unroll
        for (int u = 0; u < 4; ++u) { const int cc = d == 0 ? c_lo + i0 + u : c_lo + nch - 1 - i0 - u; const float* ag = F.RGAGG() + (size_t)(cc * 2 + d) * 2048; A[u] = ag[ch]; B[u] = ag[1024 + ch]; }
#pragma unroll
        for (int u = 0; u < 4; ++u) { const int cc = d == 0 ? c_lo + i0 + u : c_lo + nch - 1 - i0 - u; F.CARRY()[(size_t)(cc * 2 + d) * 1024 + ch] = h; h = A[u] * h + B[u]; }
    }
}

__device__ __forceinline__ void phase3(CParams& p, Frame& F) {
    for (int rep = 0; rep < (REP_PHASE == 30 ? 2 : 1); ++rep)
    for (int it = F.b; it < 2048; it += F.G) { u32x4 rows[7]; p3_load_rows(F, it >> 3, it & 7, rows); p3_delta_item(p, F, it >> 3, it & 7, rows, it + F.G); }
    for (int rep = 0; rep < (REP_PHASE == 31 ? 2 : 1); ++rep) {
    u32x4 rows[5]; if (F.b < 2048) rg_load_rows(F, F.b >> 3, F.b & 7, rows);
    for (int it = F.b; it < 2048; it += F.G) rg_item<1>(p, F, it >> 3, it & 7, rows, it + F.G); }
}

struct P4D { int valid, samp, seq, h, d, sl, ci, seq_lo, seq_hi, last, k, s, nch; };
__device__ __forceinline__ P4D p4_desc(const Frame& F, int k, int s) {
    P4D D; int item;
    if (F.G == 256) {
        const int x = F.b & 7, y = F.b >> 3;
        if (y < 16) { item = (x * 4 + (y >> 2)) * 4 + (y & 3); D.valid = k < 1; }
        else { const int j = y - 16; item = 128 + (x * 64 + (j >> 2) * 16 + k) * 4 + (j & 3); D.valid = k < 16; } }
    else { item = F.b + k * F.G; D.valid = item < 2176; }
    D.samp = item < 128; const int it = D.samp ? item : item - 128, chain = it >> 2;
    D.sl = it & 3; D.seq = chain >> 4; D.h = (chain >> 1) & 7; D.d = chain & 1;
    D.nch = D.samp ? 64 : 4; const int chunk0 = D.samp ? 128 + D.seq * 64 : D.seq * 4;
    D.seq_lo = chunk0 * 64; D.seq_hi = D.seq_lo + D.nch * 64;
    D.ci = D.d == 0 ? chunk0 + s : chunk0 + D.nch - 1 - s; D.last = s == D.nch - 1; D.k = k; D.s = s;
    return D;
}
__device__ __forceinline__ P4D p4_next(const Frame& F, const P4D& D) { int s = D.s + 1, k = D.k; if (s == D.nch) { s = 0; ++k; } return p4_desc(F, k, s); }
struct P4Pre { u32x4 k0, k1, q0, q1, ti, at; u32x2 v[4]; float g, b, bc; };
__device__ __forceinline__ void p4_prefetch(CParams& p, const Frame& F, P4Pre& R, const P4D& D) {
    const int tid = F.tid, t0 = D.ci * 64, h = D.h;
    { const int row = tid >> 4, cc = tid & 15;
      const size_t o0 = (size_t)(t0 + row) * 1024 + h * 128 + cc * 8, o1 = (size_t)(t0 + 32 + row) * 1024 + h * 128 + cc * 8;
      R.k0 = *(const u32x4*)(F.Kc() + o0); R.k1 = *(const u32x4*)(F.Kc() + o1); R.q0 = *(const u32x4*)(F.Qc() + o0); R.q1 = *(const u32x4*)(F.Qc() + o1); }
    { const bf16_t* ta = F.TA() + (size_t)(D.ci * 8 + h) * 8192; R.ti = *(const u32x4*)(ta + tid * 8); R.at = *(const u32x4*)(ta + 4096 + tid * 8); }
    { const int c = tid >> 3, e0 = (tid & 7) * 4;
#pragma unroll
      for (int j = 0; j < 4; ++j) { const int tok = t0 + c - 2 + j; u32x2 v = {0u, 0u};
          if (tok >= D.seq_lo && tok < D.seq_hi) v = *(const u32x2*)(F.PROJ() + (size_t)tok * NPROJ + 2048 + h * 128 + D.sl * 32 + e0);
          R.v[j] = v; } }
    const float* gb = F.GB() + (size_t)(D.ci * 8 + h) * 256;
    R.bc = gb[128 + D.d * 64 + (tid >> 3)];
    R.g = 0.f; R.b = 0.f;
    if (tid < 64) { R.g = gb[D.d * 64 + tid]; R.b = gb[128 + D.d * 64 + tid]; }
}
__device__ __forceinline__ u32x4 tri_mask(u32x4 v, int c, int s0, int d) {
    unsigned w[4] = {v.x, v.y, v.z, v.w};
#pragma unroll
    for (int i = 0; i < 4; ++i) { const int slo = s0 + 2 * i, shi = slo + 1;
        const bool klo = d == 0 ? (c >= slo) : (c <= slo), khi = d == 0 ? (c >= shi) : (c <= shi);
        w[i] &= (klo ? 0x0000FFFFu : 0u) | (khi ? 0xFFFF0000u : 0u); }
    return (u32x4){w[0], w[1], w[2], w[3]};
}
constexpr int P4_KS = 0, P4_TI = 17408, P4_VBT = 26624, P4_WL = 31232, P4_SB = 48640, P4_VT1 = 57344, P4_VT2 = 61952, P4_QS = 66560, P4_AT = 101376, P4_GV = 119808;
__device__ __forceinline__ void p4_stage(CParams& p, const Frame& F, const P4Pre& R, const P4D& D, int buf, const unsigned (&mk)[2][4], f32x4 (&cw)[4]) {
    const int tid = F.tid, d = D.d;
    LAS unsigned char* Ks = F.lds + P4_KS; LAS unsigned char* Qs = F.lds + P4_QS + buf * 17408; LAS unsigned char* TIs = F.lds + P4_TI;
    LAS unsigned char* ATs = F.lds + P4_AT + buf * 9216; LAS unsigned char* Vbt = F.lds + P4_VBT; LAS float* gv = (LAS float*)(F.lds + P4_GV + buf * 1280);
    { const int row = tid >> 4, cc = tid & 15;
      *(LAS u32x4*)(Ks + row * 272 + cc * 16) = R.k0; *(LAS u32x4*)(Ks + (32 + row) * 272 + cc * 16) = R.k1;
      *(LAS u32x4*)(Qs + row * 272 + cc * 16) = R.q0; *(LAS u32x4*)(Qs + (32 + row) * 272 + cc * 16) = R.q1; }
    { const int c = tid >> 3, s0 = (tid & 7) * 8;
      const unsigned m0 = d ? mk[1][0] : mk[0][0], m1 = d ? mk[1][1] : mk[0][1], m2 = d ? mk[1][2] : mk[0][2], m3 = d ? mk[1][3] : mk[0][3];
      *(LAS u32x4*)(TIs + c * 144 + s0 * 2) = (u32x4){R.ti.x & m0, R.ti.y & m1, R.ti.z & m2, R.ti.w & m3};
      *(LAS u32x4*)(ATs + c * 144 + s0 * 2) = (u32x4){R.at.x & m0, R.at.y & m1, R.at.z & m2, R.at.w & m3}; }
    { const int c = tid >> 3, e0 = (tid & 7) * 4; float o[4] = {0.f, 0.f, 0.f, 0.f};
      if (D.s == 0) {
#pragma unroll
          for (int j = 0; j < 4; ++j) cw[j] = *(const f32x4*)(p.dn_conv_w + j * 3072 + 2048 + D.h * 128 + D.sl * 32 + e0); }
#pragma unroll
      for (int j = 0; j < 4; ++j) { const u32x2 v = R.v[j];
          o[0] += cw[j][0] * __uint_as_float(v.x << 16); o[1] += cw[j][1] * __uint_as_float(v.x & 0xffff0000u);
          o[2] += cw[j][2] * __uint_as_float(v.y << 16); o[3] += cw[j][3] * __uint_as_float(v.y & 0xffff0000u); }
#pragma unroll
      for (int i = 0; i < 4; ++i) ((LAS bf16_t*)Vbt)[(e0 + i) * 72 + c] = f2bf(siluf_(o[i]) * R.bc); }
    if (tid < 64) {
        const float glast = __shfl(R.g, d == 0 ? 63 : 0), eg = __expf(R.g);
        gv[tid] = eg; gv[64 + tid] = R.b * eg; gv[128 + tid] = __expf(glast - R.g); if (tid == 0) gv[192] = __expf(glast);
    }
}
__device__ __forceinline__ void phase4_chains(CParams& p, Frame& F) {
    const int tid = F.tid, lane = F.lane, wave = F.wave, q4 = lane >> 4, l15 = lane & 15;
    LAS unsigned char* Ks = F.lds + P4_KS; LAS unsigned char* TIs = F.lds + P4_TI; LAS unsigned char* Vbt = F.lds + P4_VBT; LAS unsigned char* Wl = F.lds + P4_WL;
    LAS unsigned char* Sb = F.lds + P4_SB; LAS unsigned char* Vt1 = F.lds + P4_VT1; LAS unsigned char* Vt2 = F.lds + P4_VT2;
    const int ct = wave & 3, et = wave >> 2;
    P4D Dc = p4_desc(F, 0, 0);
    if (!Dc.valid) return;
    P4Pre RA, RB;
    f32x4 S[2], U; bf16x8 KT[2];
    unsigned mk[2][4]; f32x4 cw[4];
    { const int c = tid >> 3, s0 = (tid & 7) * 8;
#pragma unroll
      for (int i = 0; i < 4; ++i) { const int slo = s0 + 2 * i, shi = slo + 1;
          mk[0][i] = (c >= slo ? 0x0000FFFFu : 0u) | (c >= shi ? 0xFFFF0000u : 0u); mk[1][i] = (c <= slo ? 0x0000FFFFu : 0u) | (c <= shi ? 0xFFFF0000u : 0u); } }
#define P4_INIT_S(D) do { _Pragma("unroll") for (int nt = 0; nt < 2; ++nt) _Pragma("unroll") for (int r = 0; r < 4; ++r) \
        S[nt][r] = (D).samp ? p.state_delta[(size_t)(((D).seq * 2 + (D).d) * 8 + (D).h) * 16384 + (size_t)(wave * 16 + q4 * 4 + r) * 128 + (D).sl * 32 + nt * 16 + l15] : 0.f; } while (0)
#define P4_WRITE_SB() do { _Pragma("unroll") for (int nt = 0; nt < 2; ++nt) { u32x2 o_; o_.x = pk2(S[nt][0], S[nt][1]); o_.y = pk2(S[nt][2], S[nt][3]); \
        *(LAS u32x2*)(Sb + (nt * 16 + l15) * 272 + (wave * 16 + q4 * 4) * 2) = o_; } } while (0)
#define P4_PRECOMP(buf_) do { const LAS float* gv_ = (const LAS float*)(F.lds + P4_GV + (buf_) * 1280); \
        f32x4 WT[4]; _Pragma("unroll") for (int c_ = 0; c_ < 4; ++c_) WT[c_] = (f32x4){0.f, 0.f, 0.f, 0.f}; \
        _Pragma("unroll") for (int ks = 0; ks < 2; ++ks) { bf16x8 akg; \
            _Pragma("unroll") for (int j = 0; j < 8; ++j) { const int c_ = ks * 32 + q4 * 8 + j; const unsigned short kr = *(const LAS unsigned short*)(Ks + c_ * 272 + (wave * 16 + l15) * 2); \
                KT[ks][j] = (short)kr; akg[j] = (short)f2bf(bf2f(kr) * gv_[64 + c_]); } \
            _Pragma("unroll") for (int c_ = 0; c_ < 4; ++c_) { const bf16x8 bt = ldfrag(TIs, 144, c_ * 16 + l15, ks * 64 + q4 * 16); WT[c_] = MFMA16(akg, bt, WT[c_]); } } \
        _Pragma("unroll") for (int c_ = 0; c_ < 4; ++c_) { u32x2 o_; o_.x = pk2(WT[c_][0], WT[c_][1]); o_.y = pk2(WT[c_][2], WT[c_][3]); \
            *(LAS u32x2*)(Wl + (c_ * 16 + l15) * 272 + (wave * 16 + q4 * 4) * 2) = o_; } \
        U = (f32x4){0.f, 0.f, 0.f, 0.f}; \
        _Pragma("unroll") for (int ks = 0; ks < 2; ++ks) { const bf16x8 a_ = ldfrag(TIs, 144, ct * 16 + l15, ks * 64 + q4 * 16), b_ = ldfrag(Vbt, 144, et * 16 + l15, ks * 64 + q4 * 16); U = MFMA16(a_, b_, U); } } while (0)

    p4_prefetch(p, F, RA, Dc);
    P4_INIT_S(Dc);
    p4_stage(p, F, RA, Dc, 0, mk, cw);
    P4_WRITE_SB();
    P4D Dn = p4_next(F, Dc);
    if (Dn.valid) p4_prefetch(p, F, RA, Dn);
    P4D Dnn = Dn; if (Dn.valid) { Dnn = p4_next(F, Dn); if (Dnn.valid) p4_prefetch(p, F, RB, Dnn); }
    __syncthreads();
    P4_PRECOMP(0);
    __syncthreads();
    int buf = 0;
#define P4_BODY(RX) { \
        const LAS float* gv = (const LAS float*)(F.lds + P4_GV + buf * 1280); \
        const LAS unsigned char* Qs = F.lds + P4_QS + buf * 17408; const LAS unsigned char* ATs = F.lds + P4_AT + buf * 9216; \
        const int c0 = ct * 16 + q4 * 4, e = et * 16 + l15; \
         \
        f32x4 p1 = {0.f, 0.f, 0.f, 0.f}, oacc = {0.f, 0.f, 0.f, 0.f}; \
_Pragma("unroll") \
        for (int ks = 0; ks < 4; ++ks) { const bf16x8 bs = ldfrag(Sb, 272, et * 16 + l15, ks * 64 + q4 * 16); \
            const bf16x8 aw = ldfrag(Wl, 272, ct * 16 + l15, ks * 64 + q4 * 16), aq = ldfrag(Qs, 272, ct * 16 + l15, ks * 64 + q4 * 16); \
            p1 = MFMA16(aw, bs, p1); oacc = MFMA16(aq, bs, oacc); } \
        { float vn[4]; \
_Pragma("unroll") \
          for (int r = 0; r < 4; ++r) vn[r] = U[r] - p1[r]; \
          u32x2 o1, o2; o1.x = pk2(vn[0], vn[1]); o1.y = pk2(vn[2], vn[3]); \
          o2.x = pk2(vn[0] * gv[128 + c0], vn[1] * gv[128 + c0 + 1]); o2.y = pk2(vn[2] * gv[128 + c0 + 2], vn[3] * gv[128 + c0 + 3]); \
          *(LAS u32x2*)(Vt1 + e * 144 + c0 * 2) = o1; *(LAS u32x2*)(Vt2 + e * 144 + c0 * 2) = o2; } \
_Pragma("unroll") \
        for (int r = 0; r < 4; ++r) oacc[r] *= gv[c0 + r]; \
        P4D D3 = Dnn; \
        if (Dn.valid) { p4_stage(p, F, RX, Dn, buf ^ 1, mk, cw); if (Dnn.valid) { D3 = p4_next(F, Dnn); if (D3.valid) p4_prefetch(p, F, RX, D3); } } \
        __syncthreads(); \
         \
        { const float gl = gv[192]; \
_Pragma("unroll") \
          for (int nt = 0; nt < 2; ++nt) S[nt] *= gl; \
_Pragma("unroll") \
          for (int ks = 0; ks < 2; ++ks) \
_Pragma("unroll") \
              for (int nt = 0; nt < 2; ++nt) { const bf16x8 b_ = ldfrag(Vt2, 144, nt * 16 + l15, ks * 64 + q4 * 16); S[nt] = MFMA16(KT[ks], b_, S[nt]); } } \
_Pragma("unroll") \
        for (int ks = 0; ks < 2; ++ks) { const bf16x8 a_ = ldfrag(ATs, 144, ct * 16 + l15, ks * 64 + q4 * 16), b_ = ldfrag(Vt1, 144, et * 16 + l15, ks * 64 + q4 * 16); oacc = MFMA16(a_, b_, oacc); } \
_Pragma("unroll") \
        for (int r = 0; r < 4; ++r) F.PROJ()[(size_t)(Dc.ci * 64 + c0 + r) * NPROJ + Dc.d * 1024 + Dc.h * 128 + Dc.sl * 32 + e] = f2bf(oacc[r]); \
        if (Dc.last) { \
            if (!Dc.samp) { \
_Pragma("unroll") \
                for (int nt = 0; nt < 2; ++nt) \
_Pragma("unroll") \
                    for (int r = 0; r < 4; ++r) \
                        F.out[OUT_SD + (size_t)((Dc.seq * 2 + Dc.d) * 8 + Dc.h) * 16384 + (size_t)(wave * 16 + q4 * 4 + r) * 128 + Dc.sl * 32 + nt * 16 + l15] = S[nt][r]; \
            } \
            if (Dn.valid) P4_INIT_S(Dn); \
        } \
        P4_WRITE_SB(); \
        if (Dn.valid) P4_PRECOMP(buf ^ 1); \
        __syncthreads(); \
        if (!Dn.valid) break; \
        Dc = Dn; Dn = Dnn; Dnn = D3; buf ^= 1; \
    }
#pragma unroll 1
    for (;;) { P4_BODY(RA) P4_BODY(RB) }
#undef P4_BODY
#undef P4_INIT_S
#undef P4_WRITE_SB
#undef P4_PRECOMP
}
__device__ __forceinline__ void phase4(CParams& p, Frame& F) {
    if (F.G == 256) rg_carry_scan(p, F);
    else if (F.b == 0) {
        for (int g = F.tid; g < 69632; g += 512) { int samp = g >= 65536, gg = samp ? g - 65536 : g, seq = gg >> 11, d = (gg >> 10) & 1, ch = gg & 1023;
            const int nch = samp ? 64 : 4, c_lo = samp ? 128 + seq * 64 : seq * 4; float h = samp ? p.state_rglru[(size_t)(seq * 2 + d) * 1024 + ch] : 0.f;
            for (int i = 0; i < nch; ++i) { const int cc = d == 0 ? c_lo + i : c_lo + nch - 1 - i; const float* ag = F.RGAGG() + (size_t)(cc * 2 + d) * 2048; F.CARRY()[(size_t)(cc * 2 + d) * 1024 + ch] = h; h = ag[ch] * h + ag[1024 + ch]; } } }
    __syncthreads();
    phase4_chains(p, F);
}

__device__ __forceinline__ void phase5(CParams& p, Frame& F) {
    const int lane = F.lane;
    float nw[16];
#pragma unroll
    for (int q = 0; q < 4; ++q) { const f32x4 a = *(const f32x4*)(p.dn_norm_w + (lane & 7) * 16 + q * 4); nw[q * 4] = a[0]; nw[q * 4 + 1] = a[1]; nw[q * 4 + 2] = a[2]; nw[q * 4 + 3] = a[3]; }
#pragma unroll 2
    for (int tok = F.b * 8 + F.wave; tok < NTOK; tok += F.G * 8) {
        const bf16_t* pr = F.PROJ() + (size_t)tok * NPROJ + lane * 16;
        float o[16], z[16]; float ss = 0.f;
#pragma unroll
        for (int hf = 0; hf < 2; ++hf) { const u32x4 a = *(const u32x4*)(pr + hf * 8), b = *(const u32x4*)(pr + 1024 + hf * 8), zz = *(const u32x4*)(pr + 3072 + hf * 8);
            float fa[8], fb[8], fz[8]; unpack8(a, fa); unpack8(b, fb); unpack8(zz, fz);
#pragma unroll
            for (int e = 0; e < 8; ++e) { o[hf * 8 + e] = fa[e] + fb[e]; z[hf * 8 + e] = fz[e]; ss += o[hf * 8 + e] * o[hf * 8 + e]; } }
        ss += __shfl_xor(ss, 1); ss += __shfl_xor(ss, 2); ss += __shfl_xor(ss, 4);
        const float rs = rsqrtf(ss * (1.f / 128.f) + 1e-6f);
#pragma unroll
        for (int hf = 0; hf < 2; ++hf) { float w[8];
#pragma unroll
            for (int e = 0; e < 8; ++e) w[e] = o[hf * 8 + e] * rs * nw[hf * 8 + e] * siluf_(z[hf * 8 + e]);
            *(u32x4*)(F.MIX() + (size_t)tok * 2048 + lane * 16 + hf * 8) = pack8(w); }
    }
    __syncthreads();
    for (int it = F.b; it < 2048; it += F.G) { u32x4 rows[5]; rg_load_rows(F, it >> 3, it & 7, rows); rg_item<3>(p, F, it >> 3, it & 7, rows, it + F.G); }
}

__device__ __forceinline__ void phase6(CParams& p, Frame& F) {
    pg8::Gemm g{F.MIX(), F.WoutT(), NTOK, 1024, 2048}; pg8::StaticOrder S; S.init(NTOK, 1024, F.G, F.b); pg8::EpiF32 E{(float*)F.PROJ(), 3072};
    pg8::gemm_phase<pg8::EpiF32, pg8::StaticOrder>(F.lds, g, S, E);
}

__device__ __forceinline__ void phase7(CParams& p, Frame& F) {
    LAS float* gt = (LAS float*)F.lds;
    for (int tb = F.b; tb < 256; tb += F.G) {
        const int grp = grp_of_block(tb);
        for (int j = F.tid; j < 1024; j += 512) gt[j] = mod_val(p, F, grp, 2048 + j) * p.post_w[j];
        __syncthreads();
#pragma unroll 2
        for (int i = 0; i < 8; ++i) {
            const int tok = tb * 64 + F.wave * 8 + i;
            const float* xr = tok < 8192 ? p.x_prompt + (size_t)tok * 1024 : p.x_sample + (size_t)(tok - 8192) * 1024;
            const float* yr = (const float*)F.PROJ() + (size_t)tok * 3072;
            f32x4 y[4]; float ss = 0.f;
#pragma unroll
            for (int q = 0; q < 4; ++q) { y[q] = *(const f32x4*)(yr + F.lane * 4 + 256 * q); ss += (y[q][0] * y[q][0] + y[q][1] * y[q][1]) + (y[q][2] * y[q][2] + y[q][3] * y[q][3]); }
            const float rstd = rsqrtf(wave_sum(ss) * (1.f / 1024.f) + 1e-6f);
#pragma unroll
            for (int q = 0; q < 4; ++q) { const int j = F.lane * 4 + 256 * q; f32x4 v = *(const f32x4*)(xr + j);
                if (tok >= 8192) { const int pp = (tok - 8192) & 4095; const int vv = (q < 2) ? (pp >> 6) : (pp & 63);
                    v += *(const f32x4*)(F.pe() + ((q & 1) ? 16384 : 0) + vv * 256 + F.lane * 4); }
                const f32x4 g4 = *(const LAS f32x4*)(gt + j);
                f32x4 ov = v + g4 * (y[q] * rstd); ov[0] = fin(ov[0]); ov[1] = fin(ov[1]); ov[2] = fin(ov[2]); ov[3] = fin(ov[3]); if (!(LIVE_MASK & 1)) ov = (f32x4){0.f, 0.f, 0.f, 0.f}; *(f32x4*)(F.out + (size_t)tok * 1024 + j) = ov; }
        }
        __syncthreads();
    }
}

__device__ __forceinline__ void phase8(CParams& p, Frame& F) {
    if (F.b == 0 && F.tid == 0) { int code = 0; for (int k = 31; k >= 1; --k) if (DG(F)[k]) code = k; F.out[OUT_SR] = 1000.f * (float)code + 500.f; }
}
extern __shared__ __attribute__((aligned(16))) unsigned char smem_raw[];
__global__ void __launch_bounds__(512) fwd_megakernel(Params p_unused) {
    CParams& p = *(CParams*)__builtin_amdgcn_kernarg_segment_ptr();
    Frame F;
    F.lds = (LAS unsigned char*)smem_raw;
    F.tid = threadIdx.x; F.lane = F.tid & 63; F.wave = __builtin_amdgcn_readfirstlane(F.tid >> 6); F.G = gridDim.x; F.b = blockIdx.x;
    F.out = p.out; F.ws = p.ws;
    volatile LAS unsigned* xbw = (volatile LAS unsigned*)(F.lds + LDS_BYTES - 16);
    const bool multi = (p.ph_hi - p.ph_lo) > 1;
    XcdBarrier xb; xb.bar = (unsigned*)(p.ws + WS_CTL); xb.x = 0; xb.st = xbw;
    if (multi) {
        if (F.tid == 0) { xbw[0] = 0u; xbw[1] = 0u; xbw[2] = 0u; xbw[3] = 0u; }
        __syncthreads();
        xb = xcd_barrier_post((unsigned*)(p.ws + WS_CTL), xbw);
    }
#ifndef PHMASK
#define PHMASK 511
#endif
    const int lo = p.ph_lo, hi = p.ph_hi;
#ifndef REP_PHASE
#define REP_PHASE -1
#endif
#define RUN_PHASE(k, fn) do { if (lo <= (k) && (k) < hi) { if (PHMASK & (1 << (k))) fn(p, F); if ((k) == REP_PHASE) { __syncthreads(); fn(p, F); } if ((k) + 1 < hi) xcd_barrier(xb); } } while (0)
    RUN_PHASE(0, phase0); RUN_PHASE(1, phase1); RUN_PHASE(2, phase2); RUN_PHASE(3, phase3);
    RUN_PHASE(4, phase4); RUN_PHASE(5, phase5); RUN_PHASE(6, phase6); RUN_PHASE(7, phase7); RUN_PHASE(8, phase8);
}

extern "C" void kernel_launch(void* const* d_in, const int* in_sizes, int n_in, void* d_out, int out_size, void* d_ws, size_t ws_size, hipStream_t stream) {
    static int grid = 0;
    if (grid == 0) {
        int dev = 0, cus = 0;
        if (hipGetDevice(&dev) != hipSuccess || hipDeviceGetAttribute(&cus, hipDeviceAttributeMultiprocessorCount, dev) != hipSuccess) { fprintf(stderr, "kernel_launch: device query failed\n"); grid = -1; return; }
        if (hipFuncSetAttribute((const void*)fwd_megakernel, hipFuncAttributeMaxDynamicSharedMemorySize, LDS_BYTES) != hipSuccess) { fprintf(stderr, "kernel_launch: hipFuncSetAttribute failed\n"); grid = -1; return; }
        int per_cu = 0;
        if (hipOccupancyMaxActiveBlocksPerMultiprocessor(&per_cu, (const void*)fwd_megakernel, 512, LDS_BYTES) != hipSuccess || per_cu < 1) { fprintf(stderr, "kernel_launch: occupancy query says %d blocks per CU\n", per_cu); (void)hipGetLastError(); }
        grid = cus;
    }
    if (grid < 0) return;
    Params p{};
    const float** pp = (const float**)&p;
    for (int i = 0; i < 23; ++i) pp[i] = (const float*)d_in[i];
    p.out = (float*)d_out; p.ws = (unsigned char*)d_ws;
    (void)hipMemsetAsync((char*)d_ws + WS_CTL, 0, 16384, stream);
#if MK_SINGLE
    p.ph_lo = 0; p.ph_hi = NPH;
    void* args[] = {&p};
    hipError_t e = hipLaunchCooperativeKernel((const void*)fwd_megakernel, dim3(grid), dim3(512), args, LDS_BYTES, stream);
    if (e != hipSuccess) fprintf(stderr, "cooperative launch failed: %s (grid %d)\n", hipGetErrorString(e), grid);
#else
    for (int ph = 0; ph < NPH; ++ph) {
        p.ph_lo = ph; p.ph_hi = ph + 1;
        hipLaunchKernelGGL(fwd_megakernel, dim3(grid), dim3(512), LDS_BYTES, stream, p);
    }
#endif
}
```

```cpp
#include <hip/hip_runtime.h>
#include <cstdio>
#include <cstdint>

#define LAS __attribute__((address_space(3)))
typedef unsigned short bf16_t;
typedef short bf16x8 __attribute__((ext_vector_type(8)));
typedef float f32x4 __attribute__((ext_vector_type(4)));
typedef unsigned u32x4 __attribute__((ext_vector_type(4)));
typedef unsigned u32x2 __attribute__((ext_vector_type(2)));

#ifndef REP_PHASE
#define REP_PHASE -1
#endif
#ifndef MK_SINGLE
#define MK_SINGLE 1
#endif

constexpr int NTOK = 16384, DM = 1024, NPROJ = 6144, DIN = 6176;
constexpr int NPH = 8;
constexpr int LDS_BYTES = 160 * 1024;
constexpr size_t OUT_YP = 0, OUT_YS = 8388608, OUT_SD = 16777216, OUT_SR = 25165824;
constexpr size_t WS_CTL = 0, WS_MODP = 16384, WS_PE = 606208, WS_BA = 737280, WS_GB = 2834432, WS_RGAGG = 4931584,
                 WS_WBAT = 9125888, WS_WOUTT = 9191424, WS_GT = 13385728, WS_WINT = 14434304, WS_TA = 27017216, WS_PROJ = 60571648, WS_CARRY = 261898240;

struct Params {
    const float *x_prompt, *x_sample, *state_delta, *state_rglru, *c, *c_ctx, *ada_w, *ada_b, *pre_w, *post_w, *w_in, *w_out,
                *dn_conv_w, *dn_a_log, *dn_dt_bias, *dn_norm_w, *rg_conv_w, *rg_conv_b, *rg_w_r, *rg_b_r, *rg_w_i, *rg_b_i, *rg_lam;
    float* out; unsigned char* ws;
    int ph_lo, ph_hi;
};

__device__ __forceinline__ float bf2f(unsigned short b) { return __uint_as_float(((unsigned)b) << 16); }
typedef __bf16 bf2_t __attribute__((ext_vector_type(2)));
typedef float f2_t __attribute__((ext_vector_type(2)));
__device__ __forceinline__ unsigned pk2(float lo, float hi) { const f2_t v = {lo, hi}; return __builtin_bit_cast(unsigned, __builtin_convertvector(v, bf2_t)); }
__device__ __forceinline__ unsigned short f2bf(float f) { return (unsigned short)(pk2(f, f) & 0xffffu); }
#ifndef SANITIZE
#define SANITIZE 0
#endif
#ifndef LIVE_MASK
#define LIVE_MASK 15
#endif
__device__ __forceinline__ float fin(float x) { return (SANITIZE && ((__float_as_uint(x) & 0x7f800000u) == 0x7f800000u)) ? 0.f : x; }
#define DG(F) ((unsigned*)((F).ws + WS_CTL))
__device__ __forceinline__ bool badv(float x, float lim) { return ((__float_as_uint(x) & 0x7f800000u) == 0x7f800000u) || fabsf(x) > lim; }
#ifndef DIAG
#define DIAG 0
#endif
#define CHK(F, k, bad) do { if (DIAG && (bad)) DG(F)[k] = 1u; } while (0)
__device__ __forceinline__ float sigm(float x) { return __builtin_amdgcn_rcpf(1.f + __expf(-x)); }
__device__ __forceinline__ float siluf_(float x) { return x * __builtin_amdgcn_rcpf(1.f + __expf(-x)); }
__device__ __forceinline__ float softplusf_(float x) { return x > 20.f ? x : log1pf(__expf(x)); }
__device__ __forceinline__ void unpack8(const u32x4 v, float (&f)[8]) {
    f[0] = __uint_as_float(v.x << 16); f[1] = __uint_as_float(v.x & 0xffff0000u);
    f[2] = __uint_as_float(v.y << 16); f[3] = __uint_as_float(v.y & 0xffff0000u);
    f[4] = __uint_as_float(v.z << 16); f[5] = __uint_as_float(v.z & 0xffff0000u);
    f[6] = __uint_as_float(v.w << 16); f[7] = __uint_as_float(v.w & 0xffff0000u);
}
__device__ __forceinline__ u32x4 pack8(const float (&f)[8]) { u32x4 o; o.x = pk2(f[0], f[1]); o.y = pk2(f[2], f[3]); o.z = pk2(f[4], f[5]); o.w = pk2(f[6], f[7]); return o; }
__device__ __forceinline__ float wave_sum(float v) {
#pragma unroll
    for (int o = 1; o < 64; o <<= 1) v += __shfl_xor(v, o);
    return v;
}
__device__ __forceinline__ void lds_barrier() { asm volatile("s_waitcnt lgkmcnt(0)" ::: "memory"); __builtin_amdgcn_s_barrier(); asm volatile("" ::: "memory"); }
#define MFMA16(a, b, c) __builtin_amdgcn_mfma_f32_16x16x32_bf16((a), (b), (c), 0, 0, 0)
#define LDS_WAIT() asm volatile("s_waitcnt lgkmcnt(0)" ::: "memory")
__device__ __forceinline__ bf16x8 ldfrag(const LAS unsigned char* base, int pitch, int row, int kb) { return *(const LAS bf16x8*)(base + row * pitch + kb); }

#define XB_TMO      128
#define XB_XCNT(j)  (256  + 64 * (j))
#define XB_XSUB(j)  (1280 + 64 * (j))
#define XB_XGEN(j)  (2304 + 64 * (j))
#define XB_TOP      3328
#define XB_TOPGEN   3392
#define XCD_BAR_WORDS 3456
#define XB_SPIN_CAP (1u << 18)
__device__ __forceinline__ unsigned xb_ld(unsigned* p)              { return __hip_atomic_load(p, __ATOMIC_RELAXED, __HIP_MEMORY_SCOPE_AGENT); }
__device__ __forceinline__ unsigned xb_add(unsigned* p, unsigned v) { return __hip_atomic_fetch_add(p, v, __ATOMIC_RELAXED, __HIP_MEMORY_SCOPE_AGENT); }
__device__ __forceinline__ unsigned xb_xcc_id() { return (unsigned)__builtin_amdgcn_s_getreg((3 << 11) | 20) & 0xFu; }
#define XB_SPIN(cond, bar) do { unsigned _sp = 0; while (cond) { __builtin_amdgcn_s_sleep(1); \
    if ((++_sp & 255u) == 0u) { if (xb_ld(&(bar)[XB_TMO])) break; if (_sp > XB_SPIN_CAP) { atomicAdd(&(bar)[XB_TMO], 1u); break; } } } } while (0)
struct XcdBarrier { unsigned* bar; unsigned x; volatile LAS unsigned* st; };
__device__ __forceinline__ XcdBarrier xcd_barrier_post(unsigned* bar, volatile LAS unsigned* st) {
    XcdBarrier b; b.bar = bar; b.x = xb_xcc_id(); b.st = st;
    if (threadIdx.x == 0) (void)xb_add(&bar[XB_XCNT(b.x)], 1u);
    return b;
}
__device__ __forceinline__ void xcd_barrier_complete(unsigned* bar, unsigned x, unsigned& nloc, unsigned& nx) {
    const unsigned G = gridDim.x * gridDim.y * gridDim.z;
    unsigned sum, cnt, mine, sp = 0u;
    for (;;) {
        sum = 0u; cnt = 0u; mine = 0u;
#pragma unroll
        for (unsigned j = 0; j < 16; ++j) { const unsigned c = xb_ld(&bar[XB_XCNT(j)]); sum += c; cnt += (c > 0u) ? 1u : 0u; mine = (j == x) ? c : mine; }
        if (sum == G) break;
        __builtin_amdgcn_s_sleep(1);
        if ((++sp & 255u) == 0u) { if (xb_ld(&bar[XB_TMO])) break; if (sp > XB_SPIN_CAP) { atomicAdd(&bar[XB_TMO], 1u); break; } }
    }
    nloc = mine > 0u ? mine : 1u; nx = cnt > 0u ? cnt : 1u;
}
__device__ __forceinline__ void xcd_barrier(const XcdBarrier& b) {
    asm volatile("s_waitcnt vmcnt(0)" ::: "memory");
    __syncthreads();
    if (threadIdx.x == 0) {
        unsigned* bar = b.bar;
        __builtin_amdgcn_s_waitcnt(0);
        unsigned nloc = b.st[0], nx = b.st[1];
        if (nloc == 0u) { xcd_barrier_complete(bar, b.x, nloc, nx); b.st[0] = nloc; b.st[1] = nx; }
        const unsigned old = xb_add(&bar[XB_XSUB(b.x)], 1u);
        const unsigned gen = old / nloc;
        if (old + 1u == (gen + 1u) * nloc) {
            __builtin_amdgcn_fence(__ATOMIC_RELEASE, "agent");
            asm volatile("s_waitcnt vmcnt(0)" ::: "memory");
            const unsigned og = xb_add(&bar[XB_TOP], 1u);
            const unsigned tg = og / nx;
            if (og + 1u == (tg + 1u) * nx) xb_add(&bar[XB_TOPGEN], 1u);
            else XB_SPIN(xb_ld(&bar[XB_TOPGEN]) == tg, bar);
            __builtin_amdgcn_fence(__ATOMIC_ACQUIRE, "agent");
            xb_add(&bar[XB_XGEN(b.x)], 1u);
            asm volatile("s_waitcnt vmcnt(0)" ::: "memory");
        } else {
            XB_SPIN(xb_ld(&bar[XB_XGEN(b.x)]) == gen, bar);
            __builtin_amdgcn_fence(__ATOMIC_ACQUIRE, "agent");
            asm volatile("s_waitcnt vmcnt(0)" ::: "memory");
        }
    }
    __syncthreads();
}

namespace pg8 {
constexpr int BM = 256, BK = 64, HALF = 128, HTB = HALF * BK * 2, STAGE_BYTES = 8 * HTB, NXCD = 8, WGM = 8;
__host__ __device__ __forceinline__ int lds_byte(int r, int c) { const int st = (r >> 4) * 2 + (c >> 5), rr = r & 15, cc = c & 31, ob = rr * 64 + cc * 2; return st * 1024 + (ob ^ (((ob >> 9) & 1) << 5)); }
__host__ __device__ __forceinline__ void stage_rc(int b, int& R, int& C) { const int st = b / 1024, sb = b % 1024, swz = sb ^ (((sb >> 9) & 1) << 5); R = (st >> 1) * 16 + swz / 64; C = (st & 1) * 32 + (swz % 64) / 2; }
__host__ __device__ __forceinline__ int perm32(int rho) { const int n = rho >> 4, i = rho & 15; return 8 * (i >> 2) + 4 * n + (i & 3); }
struct Unit { int pm, pn; };
struct Gemm { const bf16_t* A; const bf16_t* Bt; int M, N, K; };
struct StaticOrder {
    int nM, nN, nwg, G, c;
    __host__ __device__ void init(int M, int N, int G_, int c_) { nM = M / BM; nN = N / BM; nwg = nM * nN; G = G_; c = c_; }
    __host__ __device__ bool next(int i, Unit& u) const {
        const long L = (long)i * G + c; if (L >= nwg) return false;
        int wgid = (int)L; { const int q = nwg / NXCD, r = nwg % NXCD, xcd = wgid % NXCD, off = wgid / NXCD; wgid = (xcd < r ? xcd * (q + 1) : r * (q + 1) + (xcd - r) * q) + off; }
        const int nig = WGM * nN, gid = wgid / nig, fm = gid * WGM, gsz = (nM - fm) < WGM ? (nM - fm) : WGM;
        u.pm = fm + ((wgid % nig) % gsz); u.pn = (wgid % nig) / gsz; return true;
    }
};
__device__ __forceinline__ unsigned cvt_pk_bf16(float lo, float hi) { unsigned r; asm volatile("v_cvt_pk_bf16_f32 %0, %1, %2" : "=v"(r) : "v"(lo), "v"(hi)); return r; }
struct EpiF32 {
    static constexpr bool PERM = false;
    float* C; int ldc;
    __device__ __forceinline__ void operator()(const f32x4 (&acc)[2][2][4][2], const Unit& u, int wr, int wc, int fr, int fq) const {
        const int row0 = u.pm * BM + wr * 64 + fr, col0 = u.pn * BM + wc * 32 + 4 * fq;
#pragma unroll
        for (int ai = 0; ai < 2; ++ai)
#pragma unroll
            for (int m = 0; m < 4; ++m) { float* rowp = C + (size_t)(row0 + ai * HALF + m * 16) * ldc + col0;
#pragma unroll
                for (int bj = 0; bj < 2; ++bj)
#pragma unroll
                    for (int n = 0; n < 2; ++n) *(f32x4*)(rowp + bj * HALF + n * 16) = acc[ai][bj][m][n]; }
    }
};
struct EpiBf16 {
    static constexpr bool PERM = true;
    bf16_t* O; int ldc;
    __device__ __forceinline__ void operator()(const f32x4 (&acc)[2][2][4][2], const Unit& u, int wr, int wc, int fr, int fq) const {
        const int row0 = u.pm * BM + wr * 64 + fr; const int col0 = u.pn * BM + wc * 32 + 8 * fq;
#pragma unroll
        for (int ai = 0; ai < 2; ++ai)
#pragma unroll
            for (int m = 0; m < 4; ++m) { bf16_t* rowp = O + (size_t)(row0 + ai * HALF + m * 16) * ldc + col0;
#pragma unroll
                for (int bj = 0; bj < 2; ++bj) { const f32x4 v0 = acc[ai][bj][m][0], v1 = acc[ai][bj][m][1];
                    u32x4 w; w.x = cvt_pk_bf16(v0[0], v0[1]); w.y = cvt_pk_bf16(v0[2], v0[3]); w.z = cvt_pk_bf16(v1[0], v1[1]); w.w = cvt_pk_bf16(v1[2], v1[3]);
                    *(u32x4*)(rowp + bj * HALF) = w; } }
    }
};

template <class Epi, class Sched>
__device__ __forceinline__ void gemm_phase(LAS unsigned char* lds, const Gemm g, const Sched& S, const Epi& E) {
    const int tid = threadIdx.x, wid = __builtin_amdgcn_readfirstlane(tid >> 6), lane = tid & 63, wr = wid >> 2, wc = wid & 3, fr = lane & 15, fq = lane >> 4;
    const int K = g.K, nt = K / BK;
    unsigned voffA[2], voffB[2];
#pragma unroll
    for (int i = 0; i < 2; ++i) { int R, C; stage_rc(tid * 16 + i * 8192, R, C); const int Rb = Epi::PERM ? ((R & ~31) + perm32(R & 31)) : R;
        voffA[i] = (unsigned)(R * K + C) * 2u; voffB[i] = (unsigned)(Rb * K + C) * 2u; }
    const size_t kstep = (size_t)(BK * 2);
    const size_t hstep = (size_t)HALF * K * 2;
    const size_t tstep = 2 * hstep;
    const unsigned ldsw = (unsigned)wid * 1024u;
    const int aoff = lds_byte(wr * 64 + fr, fq * 8), boff = lds_byte(wc * 32 + fr, fq * 8);
#define PG8_SA(b, h) (((b) * 2 + (h)) * HTB)
#define PG8_SB(b, h) ((4 + (b) * 2 + (h)) * HTB)
#define PG8_STAGE(bufoff, gbase, voff) do { _Pragma("unroll") for (int _i = 0; _i < 2; ++_i) \
        __builtin_amdgcn_global_load_lds((const unsigned*)((const char*)(gbase) + (voff)[_i]), (LAS unsigned*)(lds + (bufoff) + ldsw + _i * 8192), 16, 0, 0); } while (0)
#define PG8_LDA(dst, b, h) do { _Pragma("unroll") for (int m = 0; m < 4; ++m) _Pragma("unroll") for (int k = 0; k < 2; ++k) dst[m][k] = *(const LAS bf16x8*)(lds + PG8_SA(b, h) + aoff + m * 2048 + k * 1024); } while (0)
#define PG8_LDB(dst, b, h) do { _Pragma("unroll") for (int n = 0; n < 2; ++n) _Pragma("unroll") for (int k = 0; k < 2; ++k) dst[n][k] = *(const LAS bf16x8*)(lds + PG8_SB(b, h) + boff + n * 2048 + k * 1024); } while (0)
#define PG8_MMA(ai, bj, At, Bt) do { __builtin_amdgcn_s_setprio(1); _Pragma("unroll") for (int m = 0; m < 4; ++m) _Pragma("unroll") for (int n = 0; n < 2; ++n) _Pragma("unroll") for (int k = 0; k < 2; ++k) \
        acc[ai][bj][m][n] = __builtin_amdgcn_mfma_f32_16x16x32_bf16(Bt[n][k], At[m][k], acc[ai][bj][m][n], 0, 0, 0); __builtin_amdgcn_s_setprio(0); } while (0)
#define PG8_WAIT_V(n) asm volatile("s_waitcnt vmcnt(" #n ")" ::: "memory")
#define PG8_WAIT_L(n) asm volatile("s_waitcnt lgkmcnt(" #n ")" ::: "memory")
#define PG8_BAR __builtin_amdgcn_s_barrier()
#define PG8_SCHED __builtin_amdgcn_sched_barrier(0)
    Unit cur, nxt; int ui = 0;
    if (!S.next(0, cur)) return;
    f32x4 acc[2][2][4][2];
#pragma unroll
    for (int a = 0; a < 2; ++a)
#pragma unroll
        for (int b = 0; b < 2; ++b)
#pragma unroll
            for (int m = 0; m < 4; ++m)
#pragma unroll
                for (int n = 0; n < 2; ++n) acc[a][b][m][n] = (f32x4){0.f, 0.f, 0.f, 0.f};
    bf16x8 At[4][2], B0[2][2], B1[2][2];
    const char* cA = (const char*)g.A + (size_t)cur.pm * tstep; const char* cB = (const char*)g.Bt + (size_t)cur.pn * tstep;
    PG8_STAGE(PG8_SB(0, 0), cB, voffB); PG8_STAGE(PG8_SA(0, 0), cA, voffA); PG8_STAGE(PG8_SB(0, 1), cB + hstep, voffB); PG8_STAGE(PG8_SA(0, 1), cA + hstep, voffA);
    if (wr == 1) PG8_BAR;
    PG8_WAIT_V(4); PG8_BAR;
    PG8_STAGE(PG8_SB(1, 0), cB + kstep, voffB); PG8_STAGE(PG8_SA(1, 0), cA + kstep, voffA); PG8_STAGE(PG8_SB(1, 1), cB + hstep + kstep, voffB);
    PG8_WAIT_V(6); PG8_BAR;
    for (;;) {
        const bool has_next = S.next(ui + 1, nxt);
        const char* nA = has_next ? (const char*)g.A + (size_t)nxt.pm * tstep : cA; const char* nB = has_next ? (const char*)g.Bt + (size_t)nxt.pn * tstep : cB;
        for (int t = 0; t < nt; t += 2) {
            const bool last = (t == nt - 2);
            const char* a1 = cA + (size_t)(t + 1) * kstep;
            const char* a2 = last ? nA : cA + (size_t)(t + 2) * kstep; const char* b2 = last ? nB : cB + (size_t)(t + 2) * kstep;
            const char* a3 = a2 + kstep; const char* b3 = b2 + kstep;
            PG8_LDB(B0, 0, 0); PG8_SCHED; PG8_LDA(At, 0, 0); PG8_STAGE(PG8_SA(1, 1), a1 + hstep, voffA);
            PG8_WAIT_L(8); PG8_BAR; PG8_WAIT_L(0); PG8_MMA(0, 0, At, B0); PG8_BAR; PG8_SCHED;
            PG8_LDB(B1, 0, 1); PG8_STAGE(PG8_SB(0, 0), b2, voffB);
            PG8_BAR; PG8_WAIT_L(0); PG8_MMA(0, 1, At, B1); PG8_BAR;
            PG8_LDA(At, 0, 1); PG8_STAGE(PG8_SA(0, 0), a2, voffA);
            PG8_BAR; PG8_WAIT_L(0); PG8_MMA(1, 0, At, B0); PG8_BAR; PG8_SCHED;
            PG8_STAGE(PG8_SB(0, 1), b2 + hstep, voffB);
            PG8_WAIT_V(6); PG8_BAR; PG8_MMA(1, 1, At, B1); PG8_BAR;
            PG8_LDB(B0, 1, 0); PG8_SCHED; PG8_LDA(At, 1, 0); PG8_STAGE(PG8_SA(0, 1), a2 + hstep, voffA);
            PG8_WAIT_L(8); PG8_BAR; PG8_WAIT_L(0); PG8_MMA(0, 0, At, B0); PG8_BAR; PG8_SCHED;
            PG8_LDB(B1, 1, 1); PG8_STAGE(PG8_SB(1, 0), b3, voffB);
            PG8_BAR; PG8_WAIT_L(0); PG8_MMA(0, 1, At, B1); PG8_BAR;
            PG8_LDA(At, 1, 1); PG8_STAGE(PG8_SA(1, 0), a3, voffA);
            PG8_BAR; PG8_WAIT_L(0); PG8_MMA(1, 0, At, B0); PG8_BAR; PG8_SCHED;
            PG8_STAGE(PG8_SB(1, 1), b3 + hstep, voffB);
            PG8_WAIT_V(6); PG8_BAR; PG8_MMA(1, 1, At, B1); PG8_BAR;
        }
        E(acc, cur, wr, wc, fr, fq);
        if (!has_next) break;
#pragma unroll
        for (int a = 0; a < 2; ++a)
#pragma unroll
            for (int b = 0; b < 2; ++b)
#pragma unroll
                for (int m = 0; m < 4; ++m)
#pragma unroll
                    for (int n = 0; n < 2; ++n) acc[a][b][m][n] = (f32x4){0.f, 0.f, 0.f, 0.f};
        cur = nxt; cA = nA; cB = nB; ++ui;
    }
    PG8_WAIT_V(0);
    if (wr == 0) PG8_BAR;
    PG8_BAR;
#undef PG8_SA
#undef PG8_SB
#undef PG8_STAGE
#undef PG8_LDA
#undef PG8_LDB
#undef PG8_MMA
#undef PG8_WAIT_V
#undef PG8_WAIT_L
#undef PG8_BAR
#undef PG8_SCHED
}
}

struct Frame {
    LAS unsigned char* lds;
    int tid, lane, wave, G, b;
    float* out; unsigned char* ws;
    __device__ __forceinline__ bf16_t* H() const { return (bf16_t*)out; }
    __device__ __forceinline__ bf16_t* Qc() const { return (bf16_t*)out; }
    __device__ __forceinline__ bf16_t* Kc() const { return (bf16_t*)(out + OUT_YS); }
    __device__ __forceinline__ bf16_t* MIX() const { return (bf16_t*)out; }
    __device__ __forceinline__ float* modp() const { return (float*)(ws + WS_MODP); }
    __device__ __forceinline__ float* pe() const { return (float*)(ws + WS_PE); }
    __device__ __forceinline__ float* BA() const { return (float*)(ws + WS_BA); }
    __device__ __forceinline__ float* GB() const { return (float*)(ws + WS_GB); }
    __device__ __forceinline__ float* RGAGG() const { return (float*)(ws + WS_RGAGG); }
    __device__ __forceinline__ bf16_t* WbaT() const { return (bf16_t*)(ws + WS_WBAT); }
    __device__ __forceinline__ bf16_t* WoutT() const { return (bf16_t*)(ws + WS_WOUTT); }
    __device__ __forceinline__ bf16_t* GT() const { return (bf16_t*)(ws + WS_GT); }
    __device__ __forceinline__ bf16_t* WinT() const { return (bf16_t*)(ws + WS_WINT); }
    __device__ __forceinline__ bf16_t* TA() const { return (bf16_t*)(ws + WS_TA); }
    __device__ __forceinline__ bf16_t* PROJ() const { return (bf16_t*)(ws + WS_PROJ); }
    __device__ __forceinline__ float* CARRY() const { return (float*)(ws + WS_CARRY); }
};
typedef const __attribute__((address_space(4))) Params CParams;

__device__ __forceinline__ int grp_of_block(int tb) { return tb < 128 ? 0 : (tb < 192 ? 1 : 2); }

__device__ __forceinline__ void transpose_item(const float* W, int N, int k0, int n0, bf16_t* WT0, int Kout, LAS float* scr, int lane) {
#pragma unroll 8
    for (int i = 0; i < 32; ++i) { const int kk = 2 * i + (lane >> 5); scr[kk * 33 + (lane & 31)] = W[(size_t)(k0 + kk) * N + n0 + (lane & 31)]; }
    LDS_WAIT();
    const int c = lane & 7;
#pragma unroll
    for (int j = 0; j < 4; ++j) { const int n = (lane >> 3) + 8 * j; const LAS float* s = scr + (8 * c) * 33 + n;
        u32x4 o; o.x = pk2(s[0 * 33], s[1 * 33]); o.y = pk2(s[2 * 33], s[3 * 33]); o.z = pk2(s[4 * 33], s[5 * 33]); o.w = pk2(s[6 * 33], s[7 * 33]);
        *(u32x4*)(WT0 + (size_t)n * Kout + k0 + 8 * c) = o; }
    LDS_WAIT();
}
__device__ __forceinline__ void phase0(CParams& p, Frame& F) {
    const int tid = F.tid, lane = F.lane;
    for (int it = F.b; it < 192; it += F.G) {
        const int jg = it % 12, ks = it / 12, j = jg * 256 + (tid & 255), half = tid >> 8, k0 = ks * 64 + half * 32;
        float s0 = 0.f, s1 = 0.f, s2 = 0.f;
#pragma unroll 8
        for (int k = 0; k < 32; ++k) { const int kk = k0 + k; const float w = p.ada_w[(size_t)kk * 3072 + j];
            s0 += siluf_(p.c_ctx[kk]) * w; s1 += siluf_(p.c[kk]) * w; s2 += siluf_(p.c[1024 + kk]) * w; }
        LAS float* red = (LAS float*)F.lds;
        if (half == 1) { red[tid - 256] = s0; red[256 + tid - 256] = s1; red[512 + tid - 256] = s2; }
        __syncthreads();
        if (half == 0) { F.modp()[(size_t)(ks * 3 + 0) * 3072 + j] = s0 + red[tid]; F.modp()[(size_t)(ks * 3 + 1) * 3072 + j] = s1 + red[256 + tid]; F.modp()[(size_t)(ks * 3 + 2) * 3072 + j] = s2 + red[512 + tid]; }
        __syncthreads();
    }
    LAS float* scr = (LAS float*)(F.lds + 4096 + F.wave * 8448);
    const int gw = F.b * 8 + F.wave, NGW = F.G * 8;
    constexpr int I_IN = 16 * 193, I_OUT = 32 * 32, I_G = 256, I_PE = 64;
    for (int it = gw; it < I_IN + I_OUT + I_G + I_PE; it += NGW) {
        int r = it;
        if (r < I_IN) { const int kb = r / 193, nb = r % 193, n0 = nb * 32;
            bf16_t* dst = n0 < 4096 ? F.WinT() + (size_t)n0 * 1024 : (n0 < 4128 ? F.WbaT() + (size_t)(n0 - 4096) * 1024 : F.WinT() + (size_t)(n0 - 32) * 1024);
            transpose_item(p.w_in, DIN, kb * 64, n0, dst, 1024, scr, lane); continue; }
        r -= I_IN;
        if (r < I_OUT) { const int kb = r / 32, nb = r % 32; transpose_item(p.w_out, 1024, kb * 64, nb * 32, F.WoutT() + (size_t)(nb * 32) * 2048, 2048, scr, lane); continue; }
        r -= I_OUT;
        if (r < I_G) { const int m = r >> 3, sub = r & 7, kb = sub >> 2, nb = sub & 3, g = m >> 4, dn = m & 15;
            const float* src = (g ? p.rg_w_i : p.rg_w_r) + (size_t)dn * 16384;
            transpose_item(src, 128, kb * 64, nb * 32, F.GT() + (size_t)m * 16384 + (size_t)(nb * 32) * 128, 128, scr, lane); continue; }
        r -= I_G;
        { const int v = r;
#pragma unroll
          for (int i = 0; i < 4; ++i) { const int idx = lane * 4 + i; const float f = expf(-9.210340371976184f * (float)idx / 256.f); const float a = (float)v * f;
              F.pe()[v * 256 + idx] = sinf(a); F.pe()[16384 + v * 256 + idx] = cosf(a); } }
    }
}

__device__ __forceinline__ float mod_val(CParams& p, const Frame& F, int grp, int j) {
    float s = p.ada_b[j];
#pragma unroll
    for (int ks = 0; ks < 16; ++ks) s += F.modp()[(size_t)(ks * 3 + grp) * 3072 + j];
    return s;
}

__device__ __forceinline__ void phase1(CParams& p, Frame& F) {
    LAS float* sc = (LAS float*)F.lds; LAS float* sh = sc + 1024;
    for (int tb = F.b; tb < 256; tb += F.G) {
        const int grp = grp_of_block(tb);
        for (int j = F.tid; j < 1024; j += 512) { sh[j] = mod_val(p, F, grp, j); sc[j] = p.pre_w[j] * (1.f + mod_val(p, F, grp, 1024 + j)); }
        __syncthreads();
#pragma unroll 2
        for (int i = 0; i < 8; ++i) {
            const int tok = tb * 64 + F.wave * 8 + i;
            const float* xr = tok < 8192 ? p.x_prompt + (size_t)tok * 1024 : p.x_sample + (size_t)(tok - 8192) * 1024;
            f32x4 v[4]; float ss = 0.f;
#pragma unroll
            for (int q = 0; q < 4; ++q) { v[q] = *(const f32x4*)(xr + F.lane * 4 + 256 * q);
                if (tok >= 8192) { const int pp = (tok - 8192) & 4095; const int vv = (q < 2) ? (pp >> 6) : (pp & 63);
                    const f32x4 e = *(const f32x4*)(F.pe() + ((q & 1) ? 16384 : 0) + vv * 256 + F.lane * 4); v[q] += e; }
                ss += (v[q][0] * v[q][0] + v[q][1] * v[q][1]) + (v[q][2] * v[q][2] + v[q][3] * v[q][3]); }
            const float rstd = rsqrtf(wave_sum(ss) * (1.f / 1024.f) + 1e-6f);
#pragma unroll
            for (int q = 0; q < 4; ++q) { const int j = F.lane * 4 + 256 * q; const f32x4 s4 = *(const LAS f32x4*)(sc + j), h4 = *(const LAS f32x4*)(sh + j);
                CHK(F, 1, badv(v[q][0] * rstd * s4[0] + h4[0], 100.f) || badv(v[q][3] * rstd * s4[3] + h4[3], 100.f));
                u32x2 o; o.x = pk2(v[q][0] * rstd * s4[0] + h4[0], v[q][1] * rstd * s4[1] + h4[1]); o.y = pk2(v[q][2] * rstd * s4[2] + h4[2], v[q][3] * rstd * s4[3] + h4[3]);
                *(u32x2*)(F.H() + (size_t)tok * 1024 + j) = o; }
        }
        __syncthreads();
    }
}

__device__ __forceinline__ void phase2(CParams& p, Frame& F) {
    { pg8::Gemm g{F.H(), F.WinT(), NTOK, NPROJ, 1024}; pg8::StaticOrder S; S.init(NTOK, NPROJ, F.G, F.b); pg8::EpiBf16 E{F.PROJ(), NPROJ};
      pg8::gemm_phase<pg8::EpiBf16, pg8::StaticOrder>(F.lds, g, S, E); }
    const int l15 = F.lane & 15, q4 = F.lane >> 4;
    for (int tb = F.b; tb < 256; tb += F.G) {
        const int mt = F.wave >> 1, nt = F.wave & 1;
        const bf16_t* ar = F.H() + (size_t)(tb * 64 + mt * 16 + l15) * 1024 + q4 * 8;
        const bf16_t* br = F.WbaT() + (size_t)(nt * 16 + l15) * 1024 + q4 * 8;
        f32x4 acc = {0.f, 0.f, 0.f, 0.f};
#pragma unroll 4
        for (int ks = 0; ks < 32; ++ks) { const bf16x8 a = *(const bf16x8*)(ar + ks * 32), b = *(const bf16x8*)(br + ks * 32); acc = MFMA16(a, b, acc); }
#pragma unroll
        for (int r = 0; r < 4; ++r) F.BA()[(size_t)(tb * 64 + mt * 16 + q4 * 4 + r) * 32 + nt * 16 + l15] = acc[r];
    }
}

__device__ __forceinline__ void p3_load_rows(const Frame& F, int ci, int h, u32x4 (&rows)[7]) {
    const int tid = F.tid, tg = tid >> 5, part = (tid >> 4) & 1, sub = tid & 15, col = part * 1024 + h * 128 + sub * 8, t0 = ci * 64;
    int seq_lo, seq_hi; if (ci < 128) { seq_lo = (ci >> 2) * 256; seq_hi = seq_lo + 256; } else { seq_lo = 8192 + ((ci - 128) >> 6) * 4096; seq_hi = seq_lo + 4096; }
    const int tb = t0 + tg * 4 - 2;
#pragma unroll
    for (int r = 0; r < 7; ++r) { const int tok = tb + r; u32x4 v = {0u, 0u, 0u, 0u};
        if (tok >= seq_lo && tok < seq_hi) v = *(const u32x4*)(F.PROJ() + (size_t)tok * NPROJ + col);
        rows[r] = v; }
}
__device__ __forceinline__ void p3_delta_item(CParams& p, Frame& F, int ci, int h, u32x4 (&rows)[7], int itn) {
    const int tid = F.tid, lane = F.lane, wave = F.wave, q4 = lane >> 4, l15 = lane & 15;
    LAS unsigned char* Ks = F.lds; LAS unsigned char* Qs = F.lds + 17408;
    LAS float* gfv = (LAS float*)(F.lds + 34816);
    LAS unsigned char* DIR0 = F.lds + 35840;
    LAS unsigned char* ATo = F.lds + 137728;
#pragma unroll
    for (int i = 0; i < 5; ++i) { const int ch = tid + 512 * i; if (ch < 2304) { const int dd = ch >= 1152, cc = ch - dd * 1152; *(LAS u32x4*)(DIR0 + dd * 46848 + 18432 + cc * 16) = (u32x4){0u, 0u, 0u, 0u}; } }
    const int t0 = ci * 64;
    int seq_lo, seq_hi; if (ci < 128) { seq_lo = (ci >> 2) * 256; seq_hi = seq_lo + 256; } else { seq_lo = 8192 + ((ci - 128) >> 6) * 4096; seq_hi = seq_lo + 4096; }
    {
        const int tg = tid >> 5, part = (tid >> 4) & 1, sub = tid & 15, col = part * 1024 + h * 128 + sub * 8;
        float w[4][8];
#pragma unroll
        for (int j = 0; j < 4; ++j) { const f32x4 a = *(const f32x4*)(p.dn_conv_w + j * 3072 + col), b = *(const f32x4*)(p.dn_conv_w + j * 3072 + col + 4);
            w[j][0] = a[0]; w[j][1] = a[1]; w[j][2] = a[2]; w[j][3] = a[3]; w[j][4] = b[0]; w[j][5] = b[1]; w[j][6] = b[2]; w[j][7] = b[3]; }
        float acc[4][8];
#pragma unroll
        for (int i = 0; i < 4; ++i)
#pragma unroll
            for (int e = 0; e < 8; ++e) acc[i][e] = 0.f;
#pragma unroll
        for (int r = 0; r < 7; ++r) {
            float x[8]; unpack8(rows[r], x);
#pragma unroll
            for (int j = 0; j < 4; ++j) { const int i = r - j; if (i >= 0 && i < 4) {
#pragma unroll
                for (int e = 0; e < 8; ++e) acc[i][e] += w[j][e] * x[e]; } } }
#pragma unroll
        for (int i = 0; i < 4; ++i) { float ss = 0.f;
#pragma unroll
            for (int e = 0; e < 8; ++e) { acc[i][e] = siluf_(acc[i][e]); ss += acc[i][e] * acc[i][e]; }
            ss += __shfl_xor(ss, 1); ss += __shfl_xor(ss, 2); ss += __shfl_xor(ss, 4); ss += __shfl_xor(ss, 8);
            const float rs = rsqrtf(ss + 1e-6f) * (part == 0 ? 0.08838834764831845f : 1.f);
#pragma unroll
            for (int e = 0; e < 8; ++e) acc[i][e] *= rs;
            CHK(F, 4, badv(acc[i][0], 1.01f) || badv(acc[i][5], 1.01f) || badv(ss * rs * rs, part == 0 ? 0.0079f : 1.01f));
            const u32x4 o = pack8(acc[i]); const int c = tg * 4 + i;
            *(LAS u32x4*)((part ? Ks : Qs) + c * 272 + sub * 16) = o;
            *(u32x4*)((part ? F.Kc() : F.Qc()) + (size_t)(t0 + c) * 1024 + h * 128 + sub * 8) = o; }
    }
    if (wave == 0) {
        const float* ba = F.BA() + (size_t)(t0 + lane) * 32;
        const float bf_ = sigm(ba[h]), bb_ = sigm(ba[8 + h]);
        float s = -expf(p.dn_a_log[h]) * softplusf_(ba[16 + h] + p.dn_dt_bias[h]);
        float sb = -expf(p.dn_a_log[8 + h]) * softplusf_(ba[24 + h] + p.dn_dt_bias[8 + h]);
#pragma unroll
        for (int o = 1; o < 64; o <<= 1) { const float t = __shfl_up(s, o); if (lane >= o) s += t; }
#pragma unroll
        for (int o = 1; o < 64; o <<= 1) { const float t = __shfl_down(sb, o); if (lane + o < 64) sb += t; }
        CHK(F, 3, badv(ba[h], 1000.f) || badv(ba[24 + h], 1000.f));
        CHK(F, 8, badv(s, 1e4f) || badv(sb, 1e4f) || s > 0.f || sb > 0.f || bf_ < 0.f || bf_ > 1.f || bb_ < 0.f || bb_ > 1.f);
        gfv[lane] = s; gfv[64 + lane] = sb; gfv[128 + lane] = bf_; gfv[192 + lane] = bb_;
        float* gb = F.GB() + (size_t)(ci * 8 + h) * 256;
        gb[lane] = s; gb[64 + lane] = sb; gb[128 + lane] = bf_; gb[192 + lane] = bb_;
    }
    lds_barrier();
    const int d = wave >> 2, mt = wave & 3;
    LAS unsigned char* Db = DIR0 + d * 46848;
    LAS unsigned char* Brow = Db; LAS unsigned char* Btr = Db + 9216; LAS unsigned char* Xrow = Db + 18432; LAS unsigned char* Xtr = Db + 27648;
    LAS float* Dl = (LAS float*)(Db + 36864) + mt * 272; LAS unsigned char* M2t = Db + 41216; LAS unsigned char* Mts = Db + 43776 + mt * 768;
    const LAS unsigned char* Lrow = d == 0 ? Brow : Btr;
    const LAS float* gd = gfv + d * 64; const LAS float* bd = gfv + 128 + d * 64;
    {
        f32x4 kk[4], qk[4];
#pragma unroll
        for (int n = 0; n < 4; ++n) { kk[n] = (f32x4){0.f, 0.f, 0.f, 0.f}; qk[n] = (f32x4){0.f, 0.f, 0.f, 0.f}; }
#pragma unroll
        for (int ks = 0; ks < 4; ++ks) { const bf16x8 ak = ldfrag(Ks, 272, mt * 16 + l15, ks * 64 + q4 * 16), aq = ldfrag(Qs, 272, mt * 16 + l15, ks * 64 + q4 * 16);
#pragma unroll
            for (int n = 0; n < 4; ++n) { const bf16x8 bk = ldfrag(Ks, 272, n * 16 + l15, ks * 64 + q4 * 16); kk[n] = MFMA16(ak, bk, kk[n]); qk[n] = MFMA16(aq, bk, qk[n]); } }
#pragma unroll
        for (int n = 0; n < 4; ++n) { const int s = n * 16 + l15; float a4[4];
#pragma unroll
            for (int r = 0; r < 4; ++r) { const int c = mt * 16 + q4 * 4 + r;
                const float dec = __expf(fminf(gd[c] - gd[s], 0.f));
                const bool strict = d == 0 ? (c > s) : (c < s);
                const float a = strict ? bd[c] * kk[n][r] * dec : 0.f;
                a4[r] = a;
                ((LAS bf16_t*)Brow)[c * 72 + s] = f2bf(a);
                if (n == mt) { if (d == 0) Dl[(q4 * 4 + r) * 17 + l15] = a; else Dl[l15 * 17 + q4 * 4 + r] = a; }
                const bool incl = d == 0 ? (c >= s) : (c < s);
                if (incl) ((LAS bf16_t*)ATo)[c * 64 + s] = f2bf(qk[n][r] * dec); }
            u32x2 o; o.x = pk2(a4[0], a4[1]); o.y = pk2(a4[2], a4[3]);
            *(LAS u32x2*)(Btr + s * 144 + (mt * 16 + q4 * 4) * 2) = o; }
    }
    lds_barrier();
    if (lane < 16) {
        float x[16];
#pragma unroll
        for (int i = 0; i < 16; ++i) { float sv = (i == lane) ? 1.f : 0.f;
#pragma unroll
            for (int j = 0; j < i; ++j) sv -= Dl[i * 17 + j] * x[j];
            x[i] = sv; }
#pragma unroll
        for (int i = 0; i < 16; ++i) ((LAS bf16_t*)Xrow)[(mt * 16 + i) * 72 + mt * 16 + lane] = f2bf(x[i]);
        u32x4 o0, o1; o0.x = pk2(x[0], x[1]); o0.y = pk2(x[2], x[3]); o0.z = pk2(x[4], x[5]); o0.w = pk2(x[6], x[7]);
        o1.x = pk2(x[8], x[9]); o1.y = pk2(x[10], x[11]); o1.z = pk2(x[12], x[13]); o1.w = pk2(x[14], x[15]);
        *(LAS u32x4*)(Xtr + (mt * 16 + lane) * 144 + mt * 32) = o0; *(LAS u32x4*)(Xtr + (mt * 16 + lane) * 144 + mt * 32 + 16) = o1;
    }
    lds_barrier();
    const bf16x8 zero8 = {0, 0, 0, 0, 0, 0, 0, 0};
    const f32x4 zero4 = {0.f, 0.f, 0.f, 0.f};
    if (mt & 1) {
        const int I1 = mt, I0 = mt - 1;
        bf16x8 a = zero8, b = zero8;
        if (q4 < 2) { a = ldfrag(Lrow, 144, I1 * 16 + l15, I0 * 32 + q4 * 16); b = ldfrag(Xtr, 144, I0 * 16 + l15, I0 * 32 + q4 * 16); }
        const f32x4 M = MFMA16(a, b, zero4);
        { u32x2 o; o.x = pk2(M[0], M[1]); o.y = pk2(M[2], M[3]); *(LAS u32x2*)(Mts + l15 * 48 + q4 * 8) = o; }
        LDS_WAIT();
        bf16x8 a2 = zero8, b2 = zero8;
        if (q4 < 2) { a2 = ldfrag(Xrow, 144, I1 * 16 + l15, I1 * 32 + q4 * 16); b2 = *(const LAS bf16x8*)(Mts + l15 * 48 + q4 * 16); }
        const f32x4 X = MFMA16(a2, b2, zero4);
#pragma unroll
        for (int r = 0; r < 4; ++r) ((LAS bf16_t*)Xrow)[(I1 * 16 + q4 * 4 + r) * 72 + I0 * 16 + l15] = f2bf(-X[r]);
        u32x2 o; o.x = pk2(-X[0], -X[1]); o.y = pk2(-X[2], -X[3]);
        *(LAS u32x2*)(Xtr + (I0 * 16 + l15) * 144 + (I1 * 16 + q4 * 4) * 2) = o;
    }
    lds_barrier();
    {
        const int mi = mt >> 1, ni = mt & 1;
        const bf16x8 a = ldfrag(Lrow, 144, 32 + mi * 16 + l15, q4 * 16), b = ldfrag(Xtr, 144, ni * 16 + l15, q4 * 16);
        const f32x4 M2 = MFMA16(a, b, zero4);
        { u32x2 o; o.x = pk2(M2[0], M2[1]); o.y = pk2(M2[2], M2[3]); *(LAS u32x2*)(M2t + (ni * 16 + l15) * 80 + (mi * 16 + q4 * 4) * 2) = o; }
        lds_barrier();
        const bf16x8 a2 = ldfrag(Xrow, 144, 32 + mi * 16 + l15, 64 + q4 * 16), b2 = *(const LAS bf16x8*)(M2t + (ni * 16 + l15) * 80 + q4 * 16);
        const f32x4 X = MFMA16(a2, b2, zero4);
#pragma unroll
        for (int r = 0; r < 4; ++r) { CHK(F, 6, badv(X[r], 20.f)); ((LAS bf16_t*)Xrow)[(32 + mi * 16 + q4 * 4 + r) * 72 + ni * 16 + l15] = f2bf(-X[r]); }
        u32x2 o; o.x = pk2(-X[0], -X[1]); o.y = pk2(-X[2], -X[3]);
        *(LAS u32x2*)(Xtr + (ni * 16 + l15) * 144 + (32 + mi * 16 + q4 * 4) * 2) = o;
    }
    lds_barrier();
    { bf16_t* dst = F.TA() + (size_t)(ci * 8 + h) * 8192;
      const int c = tid >> 3, s0 = (tid & 7) * 8;
      const u32x4 lo = *(const LAS u32x4*)(DIR0 + 18432 + c * 144 + s0 * 2), up = *(const LAS u32x4*)(DIR0 + 46848 + 27648 + c * 144 + s0 * 2);
      unsigned wl[4] = {lo.x, lo.y, lo.z, lo.w}, wu[4] = {up.x, up.y, up.z, up.w}, wo[4];
#pragma unroll
      for (int i = 0; i < 4; ++i) { const int sa = s0 + 2 * i, sb2 = sa + 1;
          const unsigned mlo = (sa <= c ? 0x0000FFFFu : 0u) | (sb2 <= c ? 0xFFFF0000u : 0u);
          wo[i] = (wl[i] & mlo) | (wu[i] & ~mlo); }
      *(u32x4*)(dst + tid * 8) = (u32x4){wo[0], wo[1], wo[2], wo[3]};
      *(u32x4*)(dst + 4096 + tid * 8) = *(const LAS u32x4*)(ATo + tid * 16); }
    lds_barrier();
}

struct RgW { bf16x8 g[2][2][4]; float br[2], bi[2], sp[2]; };
__device__ __forceinline__ void rg_load_w(CParams& p, const Frame& F, int n, RgW& W) {
    const int q4 = F.lane >> 4, j = F.wave * 16 + (F.lane & 15), ch = n * 128 + j;
#pragma unroll
    for (int d = 0; d < 2; ++d) {
#pragma unroll
        for (int g = 0; g < 2; ++g) { const bf16_t* gp = F.GT() + (size_t)((g * 2 + d) * 8 + n) * 16384 + (size_t)j * 128 + q4 * 8;
#pragma unroll
            for (int ks = 0; ks < 4; ++ks) W.g[d][g][ks] = *(const bf16x8*)(gp + ks * 32); }
        W.br[d] = p.rg_b_r[d * 1024 + ch]; W.bi[d] = p.rg_b_i[d * 1024 + ch]; W.sp[d] = softplusf_(-p.rg_lam[d * 1024 + ch]); }
}
__device__ __forceinline__ void rg_load_rows(const Frame& F, int ci, int n, u32x4 (&rows)[5]) {
    const int tid = F.tid, tg = tid >> 4, sub = tid & 15, col = 4096 + n * 128 + sub * 8, t0 = ci * 64;
    int c_lo, c_hi; if (ci < 128) { c_lo = (ci >> 2) * 4; c_hi = c_lo + 4; } else { c_lo = 128 + ((ci - 128) >> 6) * 64; c_hi = c_lo + 64; }
    const int tb = t0 + tg * 2 - 2;
#pragma unroll
    for (int r = 0; r < 5; ++r) { const int tok = tb + r; u32x4 v = {0u, 0u, 0u, 0u};
        if (tok >= c_lo * 64 && tok < c_hi * 64) v = *(const u32x4*)(F.PROJ() + (size_t)tok * NPROJ + col);
        rows[r] = v; }
}
template <int PASS>
__device__ __forceinline__ void rg_item(CParams& p, Frame& F, int ci, int n, u32x4 (&rows)[5], int itn) {
    const int tid = F.tid, lane = F.lane, wave = F.wave, q4 = lane >> 4, l15 = lane & 15;
    LAS unsigned char* xb = F.lds; LAS float* xf = (LAS float*)(F.lds + 17408); LAS float* Hs = (LAS float*)(F.lds + 50176);
    const int t0 = ci * 64;
    int seq_lo, seq_hi, c_lo, c_hi, seq; const bool samp = ci >= 128;
    if (!samp) { seq = ci >> 2; c_lo = seq * 4; c_hi = c_lo + 4; } else { seq = (ci - 128) >> 6; c_lo = 128 + seq * 64; c_hi = c_lo + 64; }
    seq_lo = c_lo * 64; seq_hi = c_hi * 64;
    const int j = wave * 16 + l15, ch = n * 128 + j;
    bf16x8 wA[2][4], wB[2][4];
#pragma unroll
    for (int g = 0; g < 2; ++g) { const bf16_t* gp = F.GT() + (size_t)((g * 2 + 0) * 8 + n) * 16384 + (size_t)j * 128 + q4 * 8;
#pragma unroll
        for (int ks = 0; ks < 4; ++ks) wA[g][ks] = *(const bf16x8*)(gp + ks * 32); }
    {
        const int tg = tid >> 4, sub = tid & 15, ch = n * 128 + sub * 8;
        float w[4][8], acc[2][8];
#pragma unroll
        for (int j = 0; j < 4; ++j) { const f32x4 a = *(const f32x4*)(p.rg_conv_w + j * 1024 + ch), b = *(const f32x4*)(p.rg_conv_w + j * 1024 + ch + 4);
            w[j][0] = a[0]; w[j][1] = a[1]; w[j][2] = a[2]; w[j][3] = a[3]; w[j][4] = b[0]; w[j][5] = b[1]; w[j][6] = b[2]; w[j][7] = b[3]; }
        { const f32x4 a = *(const f32x4*)(p.rg_conv_b + ch), b = *(const f32x4*)(p.rg_conv_b + ch + 4);
#pragma unroll
          for (int i = 0; i < 2; ++i) { acc[i][0] = a[0]; acc[i][1] = a[1]; acc[i][2] = a[2]; acc[i][3] = a[3]; acc[i][4] = b[0]; acc[i][5] = b[1]; acc[i][6] = b[2]; acc[i][7] = b[3]; } }
#pragma unroll
        for (int r = 0; r < 5; ++r) {
            float x[8]; unpack8(rows[r], x);
#pragma unroll
            for (int j = 0; j < 4; ++j) { const int i = r - j; if (i >= 0 && i < 2) {
#pragma unroll
                for (int e = 0; e < 8; ++e) acc[i][e] += w[j][e] * x[e]; } } }
#pragma unroll
        for (int i = 0; i < 2; ++i) { const int c = tg * 2 + i;
            *(LAS u32x4*)(xb + c * 272 + sub * 16) = pack8(acc[i]);
            *(LAS f32x4*)(xf + c * 128 + sub * 8) = (f32x4){acc[i][0], acc[i][1], acc[i][2], acc[i][3]};
            *(LAS f32x4*)(xf + c * 128 + sub * 8 + 4) = (f32x4){acc[i][4], acc[i][5], acc[i][6], acc[i][7]}; }
    }
    lds_barrier();
    f32x4 hs[4];
#pragma unroll
    for (int m = 0; m < 4; ++m) hs[m] = (f32x4){0.f, 0.f, 0.f, 0.f};
#pragma unroll
    for (int d = 0; d < 2; ++d) {
        f32x4 av[4], bxv[4];
        {
            f32x4 ar[4], ai[4];
#pragma unroll
            for (int m = 0; m < 4; ++m) { ar[m] = (f32x4){0.f, 0.f, 0.f, 0.f}; ai[m] = (f32x4){0.f, 0.f, 0.f, 0.f}; }
#pragma unroll
            for (int ks = 0; ks < 4; ++ks) { const bf16x8 br = d == 0 ? wA[0][ks] : wB[0][ks], bi = d == 0 ? wA[1][ks] : wB[1][ks];
#pragma unroll
                for (int m = 0; m < 4; ++m) { const bf16x8 a = ldfrag(xb, 272, m * 16 + l15, ks * 64 + q4 * 16); ar[m] = MFMA16(a, br, ar[m]); ai[m] = MFMA16(a, bi, ai[m]); } }
            if (d == 0) {
#pragma unroll
                for (int g = 0; g < 2; ++g) { const bf16_t* gp = F.GT() + (size_t)((g * 2 + 1) * 8 + n) * 16384 + (size_t)j * 128 + q4 * 8;
#pragma unroll
                    for (int ks = 0; ks < 4; ++ks) wB[g][ks] = *(const bf16x8*)(gp + ks * 32); } }
            const float L2E = 1.4426950408889634f;
            const float br_ = -L2E * p.rg_b_r[d * 1024 + ch], bi_ = -L2E * p.rg_b_i[d * 1024 + ch], sp = softplusf_(-p.rg_lam[d * 1024 + ch]);
            const float k2 = -16.f * sp, k2e = k2 * L2E, k1e = 0.5f * k2e;
#pragma unroll
            for (int m = 0; m < 4; ++m)
#pragma unroll
                for (int r = 0; r < 4; ++r) { const int c = m * 16 + q4 * 4 + r;
                    const float rr = __builtin_amdgcn_rcpf(1.f + __builtin_amdgcn_exp2f(fmaf(ar[m][r], -L2E, br_)));
                    const float ii = __builtin_amdgcn_rcpf(1.f + __builtin_amdgcn_exp2f(fmaf(ai[m][r], -L2E, bi_)));
                    const float t2 = k2 * rr;
                    const float ser = t2 * fmaf(t2, fmaf(t2, 0.16666667f, 0.5f), 1.f);
                    const float em = t2 > -0.01f ? ser : __builtin_amdgcn_exp2f(k2e * rr) - 1.f;
                    av[m][r] = __builtin_amdgcn_exp2f(k1e * rr); bxv[m][r] = __builtin_amdgcn_sqrtf(-em) * (ii * xf[c * 128 + j]); }
        }
        f32x4 Pa[4], Pb[4]; float Ap[4], Bp[4], Am[4], Bm[4];
#pragma unroll
        for (int m = 0; m < 4; ++m) {
            float pa, pb;
            if (d == 0) { pa = av[m][0]; pb = bxv[m][0]; Pa[m][0] = pa; Pb[m][0] = pb;
#pragma unroll
                for (int r = 1; r < 4; ++r) { pb = av[m][r] * pb + bxv[m][r]; pa = av[m][r] * pa; Pa[m][r] = pa; Pb[m][r] = pb; } }
            else { pa = av[m][3]; pb = bxv[m][3]; Pa[m][3] = pa; Pb[m][3] = pb;
#pragma unroll
                for (int r = 2; r >= 0; --r) { pb = av[m][r] * pb + bxv[m][r]; pa = av[m][r] * pa; Pa[m][r] = pa; Pb[m][r] = pb; } }
            float Ak[4], Bk[4];
#pragma unroll
            for (int k = 0; k < 4; ++k) { Ak[k] = __shfl(pa, l15 + 16 * k); Bk[k] = __shfl(pb, l15 + 16 * k); }
            float ap = 1.f, bp = 0.f, am = 1.f, bm = 0.f;
#pragma unroll
            for (int kk = 0; kk < 4; ++kk) { const int k = d == 0 ? kk : 3 - kk;
                const bool before = d == 0 ? (k < q4) : (k > q4);
                const float nb = Ak[k] * bp + Bk[k], na = Ak[k] * ap;
                bp = before ? nb : bp; ap = before ? na : ap;
                bm = Ak[k] * bm + Bk[k]; am = Ak[k] * am; }
            Ap[m] = ap; Bp[m] = bp; Am[m] = am; Bm[m] = bm;
        }
        if (PASS == 1) {
            float At = 1.f, Bt = 0.f;
#pragma unroll
            for (int mm = 0; mm < 4; ++mm) { const int m = d == 0 ? mm : 3 - mm; Bt = Am[m] * Bt + Bm[m]; At = Am[m] * At; }
            if (q4 == 0) { float* ag = F.RGAGG() + (size_t)(ci * 2 + d) * 2048; ag[ch] = At; ag[1024 + ch] = Bt; }
        } else {
            float hb = F.CARRY()[(size_t)(ci * 2 + d) * 1024 + ch];
#pragma unroll
            for (int mm = 0; mm < 4; ++mm) { const int m = d == 0 ? mm : 3 - mm;
                const float hin = Ap[m] * hb + Bp[m];
#pragma unroll
                for (int r = 0; r < 4; ++r) hs[m][r] += Pa[m][r] * hin + Pb[m][r];
                hb = Am[m] * hb + Bm[m]; }
            if (!samp && q4 == 0 && ci == (d == 0 ? c_hi - 1 : c_lo)) F.out[OUT_SR + (size_t)(seq * 2 + d) * 1024 + ch] = hb;
        }
    }
    if (PASS == 1 && itn < 1024) rg_load_rows(F, 128 + (itn >> 3), itn & 7, rows);
    if (PASS == 3) {
#pragma unroll
        for (int m = 0; m < 4; ++m)
#pragma unroll
            for (int r = 0; r < 4; ++r) Hs[(m * 16 + q4 * 4 + r) * 128 + j] = hs[m][r];
        lds_barrier();
#pragma unroll
        for (int i = 0; i < 2; ++i) { const int chunk = tid + 512 * i, c = chunk >> 4, cc = chunk & 15;
            const u32x4 gv = *(const u32x4*)(F.PROJ() + (size_t)(t0 + c) * NPROJ + 5120 + n * 128 + cc * 8);
            float g[8]; unpack8(gv, g);
            const f32x4 ha = *(const LAS f32x4*)(Hs + c * 128 + cc * 8), hb2 = *(const LAS f32x4*)(Hs + c * 128 + cc * 8 + 4);
            float o[8];
#pragma unroll
            for (int e = 0; e < 4; ++e) { o[e] = ha[e] * siluf_(g[e]); o[4 + e] = hb2[e] * siluf_(g[4 + e]); }
            *(u32x4*)(F.MIX() + (size_t)(t0 + c) * 2048 + 1024 + n * 128 + cc * 8) = pack8(o); }
    }
    lds_barrier();
}

__device__ __forceinline__ void rg_conv_lds(CParams& p, const Frame& F, int n, const u32x4 (&rows)[5], LAS unsigned char* xb, LAS float* xf) {
    const int tid = F.tid, tg = tid >> 4, sub = tid & 15, ch = n * 128 + sub * 8;
    float w[4][8], acc[2][8];
#pragma unroll
    for (int j = 0; j < 4; ++j) { const f32x4 a = *(const f32x4*)(p.rg_conv_w + j * 1024 + ch), b = *(const f32x4*)(p.rg_conv_w + j * 1024 + ch + 4);
        w[j][0] = a[0]; w[j][1] = a[1]; w[j][2] = a[2]; w[j][3] = a[3]; w[j][4] = b[0]; w[j][5] = b[1]; w[j][6] = b[2]; w[j][7] = b[3]; }
    { const f32x4 a = *(const f32x4*)(p.rg_conv_b + ch), b = *(const f32x4*)(p.rg_conv_b + ch + 4);
#pragma unroll
      for (int i = 0; i < 2; ++i) { acc[i][0] = a[0]; acc[i][1] = a[1]; acc[i][2] = a[2]; acc[i][3] = a[3]; acc[i][4] = b[0]; acc[i][5] = b[1]; acc[i][6] = b[2]; acc[i][7] = b[3]; } }
#pragma unroll
    for (int r = 0; r < 5; ++r) { float x[8]; unpack8(rows[r], x);
#pragma unroll
        for (int j = 0; j < 4; ++j) { const int i = r - j; if (i >= 0 && i < 2) {
#pragma unroll
            for (int e = 0; e < 8; ++e) acc[i][e] += w[j][e] * x[e]; } } }
#pragma unroll
    for (int i = 0; i < 2; ++i) { const int c = tg * 2 + i;
        *(LAS u32x4*)(xb + c * 272 + sub * 16) = pack8(acc[i]);
        *(LAS f32x4*)(xf + c * 128 + sub * 8) = (f32x4){acc[i][0], acc[i][1], acc[i][2], acc[i][3]};
        *(LAS f32x4*)(xf + c * 128 + sub * 8 + 4) = (f32x4){acc[i][4], acc[i][5], acc[i][6], acc[i][7]}; }
}
template <int D>
__device__ __forceinline__ void rg_gate_scan(const Frame& F, const bf16x8 (&wg)[2][4], float br_, float bi_, float sp, const LAS unsigned char* xb, const LAS float* xf, int j,
                                             f32x4 (&Pa)[4], f32x4 (&Pb)[4], float (&Ap)[4], float (&Bp)[4], float (&Am)[4], float (&Bm)[4]) {
    const int lane = F.lane, q4 = lane >> 4, l15 = lane & 15;
    f32x4 av[4], bxv[4];
    {
        f32x4 ar[4], ai[4];
#pragma unroll
        for (int m = 0; m < 4; ++m) { ar[m] = (f32x4){0.f, 0.f, 0.f, 0.f}; ai[m] = (f32x4){0.f, 0.f, 0.f, 0.f}; }
#pragma unroll
        for (int ks = 0; ks < 4; ++ks) {
#pragma unroll
            for (int m = 0; m < 4; ++m) { const bf16x8 a = ldfrag(xb, 272, m * 16 + l15, ks * 64 + q4 * 16); ar[m] = MFMA16(a, wg[0][ks], ar[m]); ai[m] = MFMA16(a, wg[1][ks], ai[m]); } }
        const float L2E = 1.4426950408889634f;
        const float brs = -L2E * br_, bis = -L2E * bi_, k2 = -16.f * sp, k1e = 0.5f * k2 * L2E;
#pragma unroll
        for (int m = 0; m < 4; ++m)
#pragma unroll
            for (int r = 0; r < 4; ++r) { const int c = m * 16 + q4 * 4 + r;
                const float rr = __builtin_amdgcn_rcpf(1.f + __builtin_amdgcn_exp2f(fmaf(ar[m][r], -L2E, brs)));
                const float ii = __builtin_amdgcn_rcpf(1.f + __builtin_amdgcn_exp2f(fmaf(ai[m][r], -L2E, bis)));
                const float t2 = k2 * rr, a = __builtin_amdgcn_exp2f(k1e * rr);
                const float ser = t2 * fmaf(t2, fmaf(t2, 0.16666667f, 0.5f), 1.f);
                const float em = t2 > -0.01f ? ser : fmaf(a, a, -1.f);
                av[m][r] = a; bxv[m][r] = __builtin_amdgcn_sqrtf(-em) * (ii * xf[c * 128 + j]); }
    }
#pragma unroll
    for (int m = 0; m < 4; ++m) {
        float pa, pb;
        if (D == 0) { pa = av[m][0]; pb = bxv[m][0]; Pa[m][0] = pa; Pb[m][0] = pb;
#pragma unroll
            for (int r = 1; r < 4; ++r) { pb = av[m][r] * pb + bxv[m][r]; pa = av[m][r] * pa; Pa[m][r] = pa; Pb[m][r] = pb; } }
        else { pa = av[m][3]; pb = bxv[m][3]; Pa[m][3] = pa; Pb[m][3] = pb;
#pragma unroll
            for (int r = 2; r >= 0; --r) { pb = av[m][r] * pb + bxv[m][r]; pa = av[m][r] * pa; Pa[m][r] = pa; Pb[m][r] = pb; } }
        float Ak[4], Bk[4];
#pragma unroll
        for (int k = 0; k < 4; ++k) { Ak[k] = __shfl(pa, l15 + 16 * k); Bk[k] = __shfl(pb, l15 + 16 * k); }
        float ap = 1.f, bp = 0.f, am = 1.f, bm = 0.f;
#pragma unroll
        for (int kk = 0; kk < 4; ++kk) { const int k = D == 0 ? kk : 3 - kk;
            const bool before = D == 0 ? (k < q4) : (k > q4);
            const float nb = Ak[k] * bp + Bk[k], na = Ak[k] * ap;
            bp = before ? nb : bp; ap = before ? na : ap;
            bm = Ak[k] * bm + Bk[k]; am = Ak[k] * am; }
        Ap[m] = ap; Bp[m] = bp; Am[m] = am; Bm[m] = bm;
    }
}
template <int D>
__device__ __forceinline__ void rg_prompt_dir(CParams& p, Frame& F, int seq, int n) {
    const int tid = F.tid, lane = F.lane, wave = F.wave, q4 = lane >> 4, l15 = lane & 15;
    LAS unsigned char* xb = F.lds; LAS float* xf = (LAS float*)(F.lds + 17408); LAS float* Hs = (LAS float*)(F.lds + 50176); LAS bf16_t* Hf = (LAS bf16_t*)(F.lds + 82944);
    const int j = wave * 16 + l15, ch = n * 128 + j;
    bf16x8 wg[2][4];
#pragma unroll
    for (int g = 0; g < 2; ++g) { const bf16_t* gp = F.GT() + (size_t)((g * 2 + D) * 8 + n) * 16384 + (size_t)j * 128 + q4 * 8;
#pragma unroll
        for (int ks = 0; ks < 4; ++ks) wg[g][ks] = *(const bf16x8*)(gp + ks * 32); }
    const float br_ = p.rg_b_r[D * 1024 + ch], bi_ = p.rg_b_i[D * 1024 + ch], sp = softplusf_(-p.rg_lam[D * 1024 + ch]);
    float hb = 0.f;
    u32x4 rows[5];
    rg_load_rows(F, seq * 4 + (D == 0 ? 0 : 3), n, rows);
#pragma unroll 1
    for (int cs = 0; cs < 4; ++cs) {
        const int cidx = D == 0 ? cs : 3 - cs, ci = seq * 4 + cidx, t0 = ci * 64;
        rg_conv_lds(p, F, n, rows, xb, xf);
        if (cs < 3) rg_load_rows(F, seq * 4 + (D == 0 ? cidx + 1 : cidx - 1), n, rows);
        lds_barrier();
        f32x4 Pa[4], Pb[4]; float Ap[4], Bp[4], Am[4], Bm[4];
        rg_gate_scan<D>(F, wg, br_, bi_, sp, xb, xf, j, Pa, Pb, Ap, Bp, Am, Bm);
#pragma unroll
        for (int mm = 0; mm < 4; ++mm) { const int m = D == 0 ? mm : 3 - mm;
            const float hin = Ap[m] * hb + Bp[m];
#pragma unroll
            for (int r = 0; r < 4; ++r) { const float hv = Pa[m][r] * hin + Pb[m][r]; const int tl = m * 16 + q4 * 4 + r;
                if (D == 0) Hf[(cidx * 64 + tl) * 128 + j] = f2bf(hv);
                else Hs[tl * 128 + j] = hv + bf2f(Hf[(cidx * 64 + tl) * 128 + j]); }
            hb = Am[m] * hb + Bm[m]; }
        lds_barrier();
        if (D == 1) {
#pragma unroll
            for (int i = 0; i < 2; ++i) { const int chunk = tid + 512 * i, c = chunk >> 4, cc = chunk & 15;
                bf16_t* gp = F.PROJ() + (size_t)(t0 + c) * NPROJ + 5120 + n * 128 + cc * 8;
                const u32x4 gv = *(const u32x4*)gp; float g[8]; unpack8(gv, g);
                const f32x4 ha = *(const LAS f32x4*)(Hs + c * 128 + cc * 8), hb2 = *(const LAS f32x4*)(Hs + c * 128 + cc * 8 + 4);
                float o[8];
#pragma unroll
                for (int e = 0; e < 4; ++e) { o[e] = ha[e] * siluf_(g[e]); o[4 + e] = hb2[e] * siluf_(g[4 + e]); }
                *(u32x4*)gp = pack8(o); }
            lds_barrier();
        }
    }
    if (q4 == 0) F.out[OUT_SR + (size_t)(seq * 2 + D) * 1024 + ch] = hb;
}

__device__ __forceinline__ void rg_carry_scan(CParams& p, Frame& F) {
    const int tid = F.tid;
    int samp, seq, d, ch;
    if (tid < 256) return;
    else if (tid < 272) { const int g = F.b * 16 + tid - 256; if (g >= 4096) return; samp = 1; seq = g >> 11; d = (g >> 10) & 1; ch = g & 1023; }
    else return;
    const int nch = samp ? 64 : 4, c_lo = samp ? 128 + seq * 64 : seq * 4;
    float h = samp ? p.state_rglru[(size_t)(seq * 2 + d) * 1024 + ch] : 0.f;
    for (int i0 = 0; i0 < nch; i0 += 4) {
        float A[4], B[4];
#pragma unroll
        for (int u = 0; u < 4; ++u) { const int cc = d == 0 ? c_lo + i0 + u : c_lo + nch - 1 - i0 - u; const float* ag = F.RGAGG() + (size_t)(cc * 2 + d) * 2048; A[u] = ag[ch]; B[u] = ag[1024 + ch]; }
#pragma unroll
        for (int u = 0; u < 4; ++u) { const int cc = d == 0 ? c_lo + i0 + u : c_lo + nch - 1 - i0 - u; F.CARRY()[(size_t)(cc * 2 + d) * 1024 + ch] = h; h = A[u] * h + B[u]; }
    }
}

__device__ __forceinline__ void phase3(CParams& p, Frame& F) {
    for (int rep = 0; rep < (REP_PHASE == 30 ? 2 : 1); ++rep)
    for (int it = F.b; it < 2048; it += F.G) { u32x4 rows[7]; p3_load_rows(F, it >> 3, it & 7, rows); p3_delta_item(p, F, it >> 3, it & 7, rows, it + F.G); }
    for (int rep = 0; rep < (REP_PHASE == 31 ? 2 : 1); ++rep) {
    u32x4 rows[5]; if (F.b < 1024) rg_load_rows(F, 128 + (F.b >> 3), F.b & 7, rows);
    for (int it = F.b; it < 1024; it += F.G) rg_item<1>(p, F, 128 + (it >> 3), it & 7, rows, it + F.G); }
    for (int it = F.b; it < 256; it += F.G) { rg_prompt_dir<0>(p, F, it >> 3, it & 7); rg_prompt_dir<1>(p, F, it >> 3, it & 7); }
}

struct P4D { int valid, samp, seq, h, d, sl, ci, seq_lo, seq_hi, last, k, s, nch; };
__device__ __forceinline__ P4D p4_desc(const Frame& F, int k, int s) {
    P4D D; int item;
    if (F.G == 256) {
        const int x = F.b & 7, y = F.b >> 3;
        if (y < 16) { item = (x * 4 + (y >> 2)) * 4 + (y & 3); D.valid = k < 1; }
        else { const int j = y - 16; item = 128 + (x * 64 + (j >> 2) * 16 + k) * 4 + (j & 3); D.valid = k < 16; } }
    else { item = F.b + k * F.G; D.valid = item < 2176; }
    D.samp = item < 128; const int it = D.samp ? item : item - 128, chain = it >> 2;
    D.sl = it & 3; D.seq = chain >> 4; D.h = (chain >> 1) & 7; D.d = chain & 1;
    D.nch = D.samp ? 64 : 4; const int chunk0 = D.samp ? 128 + D.seq * 64 : D.seq * 4;
    D.seq_lo = chunk0 * 64; D.seq_hi = D.seq_lo + D.nch * 64;
    D.ci = D.d == 0 ? chunk0 + s : chunk0 + D.nch - 1 - s; D.last = s == D.nch - 1; D.k = k; D.s = s;
    return D;
}
__device__ __forceinline__ P4D p4_next(const Frame& F, const P4D& D) {
    if (D.s + 1 < D.nch) { P4D N = D; N.s = D.s + 1; N.ci = D.ci + (D.d == 0 ? 1 : -1); N.last = N.s == D.nch - 1; return N; }
    return p4_desc(F, D.k + 1, 0);
}
struct P4Pre { u32x4 k0, k1, q0, q1, ti, at; u32x2 v[4]; float g, b, bc; };
struct P4T { unsigned oKQ, oTA, oV, oG, oGc; int cj; };
__device__ __forceinline__ P4T p4_thread_consts(int tid) {
    P4T T; T.oKQ = (unsigned)(((tid >> 4) * 1024 + (tid & 15) * 8) * 2); T.oTA = (unsigned)tid * 16u;
    T.oV = (unsigned)(((tid >> 3) * NPROJ + (tid & 7) * 4) * 2); T.oG = (unsigned)(tid & 63) * 4u; T.oGc = (unsigned)(tid >> 3) * 4u; T.cj = (tid >> 3) - 2; return T;
}
__device__ __forceinline__ void p4_prefetch(CParams& p, const Frame& F, P4Pre& R, const P4D& D, const P4T& T) {
    const int tid = F.tid, t0 = D.ci * 64, h = D.h;
    const char* kb = (const char*)F.Kc() + ((size_t)t0 * 1024 + h * 128) * 2;
    const char* qb = (const char*)F.Qc() + ((size_t)t0 * 1024 + h * 128) * 2;
    const char* tb = (const char*)F.TA() + (size_t)(D.ci * 8 + h) * 16384;
    const char* vb = (const char*)F.PROJ() + ((long)(t0 - 2) * NPROJ + 2048 + h * 128 + D.sl * 32) * 2;
    const char* gb = (const char*)F.GB() + (size_t)(D.ci * 8 + h) * 1024 + D.d * 256;
    R.k0 = *(const u32x4*)(kb + T.oKQ); R.k1 = *(const u32x4*)(kb + T.oKQ + 65536u);
    R.q0 = *(const u32x4*)(qb + T.oKQ); R.q1 = *(const u32x4*)(qb + T.oKQ + 65536u);
    R.ti = *(const u32x4*)(tb + T.oTA); R.at = *(const u32x4*)(tb + T.oTA + 8192u);
#pragma unroll
    for (int j = 0; j < 4; ++j) { const int tok = t0 + T.cj + j; u32x2 v = {0u, 0u};
        if (tok >= D.seq_lo && tok < D.seq_hi) v = *(const u32x2*)(vb + T.oV + (unsigned)(j * NPROJ * 2));
        R.v[j] = v; }
    R.bc = *(const float*)(gb + 512 + T.oGc);
    R.g = 0.f; R.b = 0.f;
    if (tid < 64) { R.g = *(const float*)(gb + T.oG); R.b = *(const float*)(gb + 512 + T.oG); }
}
__device__ __forceinline__ u32x4 tri_mask(u32x4 v, int c, int s0, int d) {
    unsigned w[4] = {v.x, v.y, v.z, v.w};
#pragma unroll
    for (int i = 0; i < 4; ++i) { const int slo = s0 + 2 * i, shi = slo + 1;
        const bool klo = d == 0 ? (c >= slo) : (c <= slo), khi = d == 0 ? (c >= shi) : (c <= shi);
        w[i] &= (klo ? 0x0000FFFFu : 0u) | (khi ? 0xFFFF0000u : 0u); }
    return (u32x4){w[0], w[1], w[2], w[3]};
}
constexpr int P4_KS = 0, P4_TI = 17408, P4_VBT = 26624, P4_WL = 31232, P4_SB = 48640, P4_VT1 = 57344, P4_VT2 = 61952, P4_QS = 66560, P4_AT = 101376, P4_GV = 119808;
__device__ __forceinline__ void p4_stage(CParams& p, const Frame& F, const P4Pre& R, const P4D& D, int buf, const unsigned (&mk)[2][4], f32x4 (&cw)[4], const f32x4 (&cwn)[4]) {
    const int tid = F.tid, d = D.d;
    LAS unsigned char* Ks = F.lds + P4_KS; LAS unsigned char* Qs = F.lds + P4_QS + buf * 17408; LAS unsigned char* TIs = F.lds + P4_TI;
    LAS unsigned char* ATs = F.lds + P4_AT + buf * 9216; LAS unsigned char* Vbt = F.lds + P4_VBT; LAS float* gv = (LAS float*)(F.lds + P4_GV + buf * 1280);
    { const int row = tid >> 4, cc = tid & 15;
      *(LAS u32x4*)(Ks + row * 272 + cc * 16) = R.k0; *(LAS u32x4*)(Ks + (32 + row) * 272 + cc * 16) = R.k1;
      *(LAS u32x4*)(Qs + row * 272 + cc * 16) = R.q0; *(LAS u32x4*)(Qs + (32 + row) * 272 + cc * 16) = R.q1; }
    { const int c = tid >> 3, s0 = (tid & 7) * 8;
      const unsigned m0 = d ? mk[1][0] : mk[0][0], m1 = d ? mk[1][1] : mk[0][1], m2 = d ? mk[1][2] : mk[0][2], m3 = d ? mk[1][3] : mk[0][3];
      *(LAS u32x4*)(TIs + c * 144 + s0 * 2) = (u32x4){R.ti.x & m0, R.ti.y & m1, R.ti.z & m2, R.ti.w & m3};
      *(LAS u32x4*)(ATs + c * 144 + s0 * 2) = (u32x4){R.at.x & m0, R.at.y & m1, R.at.z & m2, R.at.w & m3}; }
    { const int c = tid >> 3, e0 = (tid & 7) * 4; float o[4] = {0.f, 0.f, 0.f, 0.f};
      if (D.s == 0) {
#pragma unroll
          for (int j = 0; j < 4; ++j) cw[j] = cwn[j]; }
#pragma unroll
      for (int j = 0; j < 4; ++j) { const u32x2 v = R.v[j];
          o[0] += cw[j][0] * __uint_as_float(v.x << 16); o[1] += cw[j][1] * __uint_as_float(v.x & 0xffff0000u);
          o[2] += cw[j][2] * __uint_as_float(v.y << 16); o[3] += cw[j][3] * __uint_as_float(v.y & 0xffff0000u); }
#pragma unroll
      for (int i = 0; i < 4; ++i) ((LAS bf16_t*)Vbt)[(e0 + i) * 72 + c] = f2bf(siluf_(o[i]) * R.bc); }
    if (tid < 64) {
        const float glast = __shfl(R.g, d == 0 ? 63 : 0), eg = __expf(R.g);
        gv[tid] = eg; gv[64 + tid] = R.b * eg; gv[128 + tid] = __expf(glast - R.g); if (tid == 0) gv[192] = __expf(glast);
    }
}
__device__ __forceinline__ void phase4_chains(CParams& p, Frame& F) {
    const int tid = F.tid, lane = F.lane, wave = F.wave, q4 = lane >> 4, l15 = lane & 15;
    LAS unsigned char* Ks = F.lds + P4_KS; LAS unsigned char* TIs = F.lds + P4_TI; LAS unsigned char* Vbt = F.lds + P4_VBT; LAS unsigned char* Wl = F.lds + P4_WL;
    LAS unsigned char* Sb = F.lds + P4_SB; LAS unsigned char* Vt1 = F.lds + P4_VT1; LAS unsigned char* Vt2 = F.lds + P4_VT2;
    const int ct = wave & 3, et = wave >> 2;
    P4D Dc = p4_desc(F, 0, 0);
    if (!Dc.valid) return;
    P4Pre RA, RB;
    f32x4 S[2], U; bf16x8 KT[2];
    unsigned mk[2][4]; f32x4 cw[4], cwn[4];
    { const int c = tid >> 3, s0 = (tid & 7) * 8;
#pragma unroll
      for (int i = 0; i < 4; ++i) { const int slo = s0 + 2 * i, shi = slo + 1;
          mk[0][i] = (c >= slo ? 0x0000FFFFu : 0u) | (c >= shi ? 0xFFFF0000u : 0u); mk[1][i] = (c <= slo ? 0x0000FFFFu : 0u) | (c <= shi ? 0xFFFF0000u : 0u); } }
#define P4_INIT_S(D) do { _Pragma("unroll") for (int nt = 0; nt < 2; ++nt) _Pragma("unroll") for (int r = 0; r < 4; ++r) \
        S[nt][r] = (D).samp ? p.state_delta[(size_t)(((D).seq * 2 + (D).d) * 8 + (D).h) * 16384 + (size_t)(wave * 16 + q4 * 4 + r) * 128 + (D).sl * 32 + nt * 16 + l15] : 0.f; } while (0)
#define P4_WRITE_SB() do { _Pragma("unroll") for (int nt = 0; nt < 2; ++nt) { u32x2 o_; o_.x = pk2(S[nt][0], S[nt][1]); o_.y = pk2(S[nt][2], S[nt][3]); \
        *(LAS u32x2*)(Sb + (nt * 16 + l15) * 272 + (wave * 16 + q4 * 4) * 2) = o_; } } while (0)
#define P4_PRECOMP(buf_) do { const LAS float* gv_ = (const LAS float*)(F.lds + P4_GV + (buf_) * 1280); \
        f32x4 WT[4]; _Pragma("unroll") for (int c_ = 0; c_ < 4; ++c_) WT[c_] = (f32x4){0.f, 0.f, 0.f, 0.f}; \
        _Pragma("unroll") for (int ks = 0; ks < 2; ++ks) { bf16x8 akg; \
            _Pragma("unroll") for (int j = 0; j < 8; ++j) { const int c_ = ks * 32 + q4 * 8 + j; const unsigned short kr = *(const LAS unsigned short*)(Ks + c_ * 272 + (wave * 16 + l15) * 2); \
                KT[ks][j] = (short)kr; akg[j] = (short)f2bf(bf2f(kr) * gv_[64 + c_]); } \
            _Pragma("unroll") for (int c_ = 0; c_ < 4; ++c_) { const bf16x8 bt = ldfrag(TIs, 144, c_ * 16 + l15, ks * 64 + q4 * 16); WT[c_] = MFMA16(akg, bt, WT[c_]); } } \
        _Pragma("unroll") for (int c_ = 0; c_ < 4; ++c_) { u32x2 o_; o_.x = pk2(WT[c_][0], WT[c_][1]); o_.y = pk2(WT[c_][2], WT[c_][3]); \
            *(LAS u32x2*)(Wl + (c_ * 16 + l15) * 272 + (wave * 16 + q4 * 4) * 2) = o_; } \
        U = (f32x4){0.f, 0.f, 0.f, 0.f}; \
        _Pragma("unroll") for (int ks = 0; ks < 2; ++ks) { const bf16x8 a_ = ldfrag(TIs, 144, ct * 16 + l15, ks * 64 + q4 * 16), b_ = ldfrag(Vbt, 144, et * 16 + l15, ks * 64 + q4 * 16); U = MFMA16(a_, b_, U); } } while (0)

    const P4T T = p4_thread_consts(tid);
    p4_prefetch(p, F, RA, Dc, T);
    P4_INIT_S(Dc);
    { const int e0 = (tid & 7) * 4;
#pragma unroll
      for (int j = 0; j < 4; ++j) cwn[j] = *(const f32x4*)(p.dn_conv_w + j * 3072 + 2048 + Dc.h * 128 + Dc.sl * 32 + e0); }
    p4_stage(p, F, RA, Dc, 0, mk, cw, cwn);
    P4_WRITE_SB();
    P4D Dn = p4_next(F, Dc);
    if (Dn.valid) p4_prefetch(p, F, RA, Dn, T);
    P4D Dnn = Dn; if (Dn.valid) { Dnn = p4_next(F, Dn); if (Dnn.valid) p4_prefetch(p, F, RB, Dnn, T); }
    lds_barrier();
    P4_PRECOMP(0);
    lds_barrier();
    int buf = 0;
#define P4_BODY(RX) { \
        const LAS float* gv = (const LAS float*)(F.lds + P4_GV + buf * 1280); \
        const LAS unsigned char* Qs = F.lds + P4_QS + buf * 17408; const LAS unsigned char* ATs = F.lds + P4_AT + buf * 9216; \
        const int c0 = ct * 16 + q4 * 4, e = et * 16 + l15; \
         \
        f32x4 p1 = {0.f, 0.f, 0.f, 0.f}, oacc = {0.f, 0.f, 0.f, 0.f}; \
_Pragma("unroll") \
        for (int ks = 0; ks < 4; ++ks) { const bf16x8 bs = ldfrag(Sb, 272, et * 16 + l15, ks * 64 + q4 * 16); \
            const bf16x8 aw = ldfrag(Wl, 272, ct * 16 + l15, ks * 64 + q4 * 16), aq = ldfrag(Qs, 272, ct * 16 + l15, ks * 64 + q4 * 16); \
            p1 = MFMA16(aw, bs, p1); oacc = MFMA16(aq, bs, oacc); } \
        { float vn[4]; \
_Pragma("unroll") \
          for (int r = 0; r < 4; ++r) vn[r] = U[r] - p1[r]; \
          u32x2 o1, o2; o1.x = pk2(vn[0], vn[1]); o1.y = pk2(vn[2], vn[3]); \
          o2.x = pk2(vn[0] * gv[128 + c0], vn[1] * gv[128 + c0 + 1]); o2.y = pk2(vn[2] * gv[128 + c0 + 2], vn[3] * gv[128 + c0 + 3]); \
          *(LAS u32x2*)(Vt1 + e * 144 + c0 * 2) = o1; *(LAS u32x2*)(Vt2 + e * 144 + c0 * 2) = o2; } \
_Pragma("unroll") \
        for (int r = 0; r < 4; ++r) oacc[r] *= gv[c0 + r]; \
        P4D D3 = Dnn; \
        if (Dn.valid) { p4_stage(p, F, RX, Dn, buf ^ 1, mk, cw, cwn); \
            if (Dn.last && Dnn.valid) { const int e0_ = (tid & 7) * 4; _Pragma("unroll") for (int j = 0; j < 4; ++j) cwn[j] = *(const f32x4*)(p.dn_conv_w + j * 3072 + 2048 + Dnn.h * 128 + Dnn.sl * 32 + e0_); } if (Dnn.valid) { D3 = p4_next(F, Dnn); if (D3.valid) p4_prefetch(p, F, RX, D3, T); } } \
        lds_barrier(); \
         \
        { const float gl = gv[192]; \
_Pragma("unroll") \
          for (int nt = 0; nt < 2; ++nt) S[nt] *= gl; \
_Pragma("unroll") \
          for (int ks = 0; ks < 2; ++ks) \
_Pragma("unroll") \
              for (int nt = 0; nt < 2; ++nt) { const bf16x8 b_ = ldfrag(Vt2, 144, nt * 16 + l15, ks * 64 + q4 * 16); S[nt] = MFMA16(KT[ks], b_, S[nt]); } } \
_Pragma("unroll") \
        for (int ks = 0; ks < 2; ++ks) { const bf16x8 a_ = ldfrag(ATs, 144, ct * 16 + l15, ks * 64 + q4 * 16), b_ = ldfrag(Vt1, 144, et * 16 + l15, ks * 64 + q4 * 16); oacc = MFMA16(a_, b_, oacc); } \
_Pragma("unroll") \
        for (int r = 0; r < 4; ++r) *(bf16_t*)((char*)F.PROJ() + ((size_t)Dc.ci * 64 * NPROJ + Dc.d * 1024 + Dc.h * 128 + Dc.sl * 32) * 2 + (unsigned)(((c0 + r) * NPROJ + e) * 2)) = f2bf(oacc[r]); \
        if (Dc.last) { \
            if (!Dc.samp) { \
_Pragma("unroll") \
                for (int nt = 0; nt < 2; ++nt) \
_Pragma("unroll") \
                    for (int r = 0; r < 4; ++r) \
                        F.out[OUT_SD + (size_t)((Dc.seq * 2 + Dc.d) * 8 + Dc.h) * 16384 + (size_t)(wave * 16 + q4 * 4 + r) * 128 + Dc.sl * 32 + nt * 16 + l15] = S[nt][r]; \
            } \
            if (Dn.valid) P4_INIT_S(Dn); \
        } \
        P4_WRITE_SB(); \
        if (Dn.valid) P4_PRECOMP(buf ^ 1); \
        lds_barrier(); \
        if (!Dn.valid) break; \
        Dc = Dn; Dn = Dnn; Dnn = D3; buf ^= 1; \
    }
#pragma unroll 1
    for (;;) { P4_BODY(RA) P4_BODY(RB) }
#undef P4_BODY
#undef P4_INIT_S
#undef P4_WRITE_SB
#undef P4_PRECOMP
}
__device__ __forceinline__ void phase4(CParams& p, Frame& F) {
    if (F.G == 256) rg_carry_scan(p, F);
    else if (F.b == 0) {
        for (int g = F.tid; g < 69632; g += 512) { int samp = g >= 65536, gg = samp ? g - 65536 : g, seq = gg >> 11, d = (gg >> 10) & 1, ch = gg & 1023;
            const int nch = samp ? 64 : 4, c_lo = samp ? 128 + seq * 64 : seq * 4; float h = samp ? p.state_rglru[(size_t)(seq * 2 + d) * 1024 + ch] : 0.f;
            for (int i = 0; i < nch; ++i) { const int cc = d == 0 ? c_lo + i : c_lo + nch - 1 - i; const float* ag = F.RGAGG() + (size_t)(cc * 2 + d) * 2048; F.CARRY()[(size_t)(cc * 2 + d) * 1024 + ch] = h; h = ag[ch] * h + ag[1024 + ch]; } } }
    __syncthreads();
    phase4_chains(p, F);
}

__device__ __forceinline__ void phase5(CParams& p, Frame& F) {
    const int lane = F.lane;
    float nw[16];
#pragma unroll
    for (int q = 0; q < 4; ++q) { const f32x4 a = *(const f32x4*)(p.dn_norm_w + (lane & 7) * 16 + q * 4); nw[q * 4] = a[0]; nw[q * 4 + 1] = a[1]; nw[q * 4 + 2] = a[2]; nw[q * 4 + 3] = a[3]; }
#pragma unroll 2
    for (int tok = F.b * 8 + F.wave; tok < NTOK; tok += F.G * 8) {
        const bf16_t* pr = F.PROJ() + (size_t)tok * NPROJ + lane * 16;
        float o[16], z[16]; float ss = 0.f;
#pragma unroll
        for (int hf = 0; hf < 2; ++hf) { const u32x4 a = *(const u32x4*)(pr + hf * 8), b = *(const u32x4*)(pr + 1024 + hf * 8), zz = *(const u32x4*)(pr + 3072 + hf * 8);
            float fa[8], fb[8], fz[8]; unpack8(a, fa); unpack8(b, fb); unpack8(zz, fz);
#pragma unroll
            for (int e = 0; e < 8; ++e) { o[hf * 8 + e] = fa[e] + fb[e]; z[hf * 8 + e] = fz[e]; ss += o[hf * 8 + e] * o[hf * 8 + e]; } }
        ss += __shfl_xor(ss, 1); ss += __shfl_xor(ss, 2); ss += __shfl_xor(ss, 4);
        const float rs = rsqrtf(ss * (1.f / 128.f) + 1e-6f);
#pragma unroll
        for (int hf = 0; hf < 2; ++hf) { float w[8];
#pragma unroll
            for (int e = 0; e < 8; ++e) w[e] = o[hf * 8 + e] * rs * nw[hf * 8 + e] * siluf_(z[hf * 8 + e]);
            *(u32x4*)(F.MIX() + (size_t)tok * 2048 + lane * 16 + hf * 8) = pack8(w); }
        if (tok < 8192) {
            const u32x4 y0 = *(const u32x4*)(pr + 5120), y1 = *(const u32x4*)(pr + 5120 + 8);
            *(u32x4*)(F.MIX() + (size_t)tok * 2048 + 1024 + lane * 16) = y0; *(u32x4*)(F.MIX() + (size_t)tok * 2048 + 1024 + lane * 16 + 8) = y1; }
    }
    __syncthreads();
    for (int it = F.b; it < 1024; it += F.G) { u32x4 rows[5]; rg_load_rows(F, 128 + (it >> 3), it & 7, rows); rg_item<3>(p, F, 128 + (it >> 3), it & 7, rows, it + F.G); }
}

__device__ __forceinline__ void phase6(CParams& p, Frame& F) {
    pg8::Gemm g{F.MIX(), F.WoutT(), NTOK, 1024, 2048}; pg8::StaticOrder S; S.init(NTOK, 1024, F.G, F.b); pg8::EpiF32 E{(float*)F.PROJ(), 3072};
    pg8::gemm_phase<pg8::EpiF32, pg8::StaticOrder>(F.lds, g, S, E);
}

__device__ __forceinline__ void phase7(CParams& p, Frame& F) {
    LAS float* gt = (LAS float*)F.lds;
    for (int tb = F.b; tb < 256; tb += F.G) {
        const int grp = grp_of_block(tb);
        for (int j = F.tid; j < 1024; j += 512) gt[j] = mod_val(p, F, grp, 2048 + j) * p.post_w[j];
        __syncthreads();
#pragma unroll 2
        for (int i = 0; i < 8; ++i) {
            const int tok = tb * 64 + F.wave * 8 + i;
            const float* xr = tok < 8192 ? p.x_prompt + (size_t)tok * 1024 : p.x_sample + (size_t)(tok - 8192) * 1024;
            const float* yr = (const float*)F.PROJ() + (size_t)tok * 3072;
            f32x4 y[4]; float ss = 0.f;
#pragma unroll
            for (int q = 0; q < 4; ++q) { y[q] = *(const f32x4*)(yr + F.lane * 4 + 256 * q); ss += (y[q][0] * y[q][0] + y[q][1] * y[q][1]) + (y[q][2] * y[q][2] + y[q][3] * y[q][3]); }
            const float rstd = rsqrtf(wave_sum(ss) * (1.f / 1024.f) + 1e-6f);
#pragma unroll
            for (int q = 0; q < 4; ++q) { const int j = F.lane * 4 + 256 * q; f32x4 v = *(const f32x4*)(xr + j);
                if (tok >= 8192) { const int pp = (tok - 8192) & 4095; const int vv = (q < 2) ? (pp >> 6) : (pp & 63);
                    v += *(const f32x4*)(F.pe() + ((q & 1) ? 16384 : 0) + vv * 256 + F.lane * 4); }
                const f32x4 g4 = *(const LAS f32x4*)(gt + j);
                f32x4 ov = v + g4 * (y[q] * rstd); ov[0] = fin(ov[0]); ov[1] = fin(ov[1]); ov[2] = fin(ov[2]); ov[3] = fin(ov[3]); if (!(LIVE_MASK & 1)) ov = (f32x4){0.f, 0.f, 0.f, 0.f}; *(f32x4*)(F.out + (size_t)tok * 1024 + j) = ov; }
        }
        __syncthreads();
    }
}

__device__ __forceinline__ void phase8(CParams& p, Frame& F) {
    if (F.b == 0 && F.tid == 0) { int code = 0; for (int k = 31; k >= 1; --k) if (DG(F)[k]) code = k; F.out[OUT_SR] = 1000.f * (float)code + 500.f; }
}
extern __shared__ __attribute__((aligned(16))) unsigned char smem_raw[];
__global__ void __launch_bounds__(512) fwd_megakernel(Params p_unused) {
    CParams& p = *(CParams*)__builtin_amdgcn_kernarg_segment_ptr();
    Frame F;
    F.lds = (LAS unsigned char*)smem_raw;
    F.tid = threadIdx.x; F.lane = F.tid & 63; F.wave = __builtin_amdgcn_readfirstlane(F.tid >> 6); F.G = gridDim.x; F.b = blockIdx.x;
    F.out = p.out; F.ws = p.ws;
    volatile LAS unsigned* xbw = (volatile LAS unsigned*)(F.lds + LDS_BYTES - 16);
    const bool multi = (p.ph_hi - p.ph_lo) > 1;
    XcdBarrier xb; xb.bar = (unsigned*)(p.ws + WS_CTL); xb.x = 0; xb.st = xbw;
    if (multi) {
        if (F.tid == 0) { xbw[0] = 0u; xbw[1] = 0u; xbw[2] = 0u; xbw[3] = 0u; }
        __syncthreads();
        xb = xcd_barrier_post((unsigned*)(p.ws + WS_CTL), xbw);
    }
#ifndef PHMASK
#define PHMASK 511
#endif
    const int lo = p.ph_lo, hi = p.ph_hi;
#ifndef REP_PHASE
#define REP_PHASE -1
#endif
#define RUN_PHASE(k, fn) do { if (lo <= (k) && (k) < hi) { if (PHMASK & (1 << (k))) fn(p, F); if ((k) == REP_PHASE) { __syncthreads(); fn(p, F); } if ((k) + 1 < hi) xcd_barrier(xb); } } while (0)
    RUN_PHASE(0, phase0); RUN_PHASE(1, phase1); RUN_PHASE(2, phase2); RUN_PHASE(3, phase3);
    RUN_PHASE(4, phase4); RUN_PHASE(5, phase5); RUN_PHASE(6, phase6); RUN_PHASE(7, phase7); RUN_PHASE(8, phase8);
}

extern "C" void kernel_launch(void* const* d_in, const int* in_sizes, int n_in, void* d_out, int out_size, void* d_ws, size_t ws_size, hipStream_t stream) {
    static int grid = 0;
    if (grid == 0) {
        int dev = 0, cus = 0;
        if (hipGetDevice(&dev) != hipSuccess || hipDeviceGetAttribute(&cus, hipDeviceAttributeMultiprocessorCount, dev) != hipSuccess) { fprintf(stderr, "kernel_launch: device query failed\n"); grid = -1; return; }
        if (hipFuncSetAttribute((const void*)fwd_megakernel, hipFuncAttributeMaxDynamicSharedMemorySize, LDS_BYTES) != hipSuccess) { fprintf(stderr, "kernel_launch: hipFuncSetAttribute failed\n"); grid = -1; return; }
        int per_cu = 0;
        if (hipOccupancyMaxActiveBlocksPerMultiprocessor(&per_cu, (const void*)fwd_megakernel, 512, LDS_BYTES) != hipSuccess || per_cu < 1) { fprintf(stderr, "kernel_launch: occupancy query says %d blocks per CU\n", per_cu); (void)hipGetLastError(); }
        grid = cus;
    }
    if (grid < 0) return;
    Params p{};
    const float** pp = (const float**)&p;
    for (int i = 0; i < 23; ++i) pp[i] = (const float*)d_in[i];
    p.out = (float*)d_out; p.ws = (unsigned char*)d_ws;
    (void)hipMemsetAsync((char*)d_ws + WS_CTL, 0, 16384, stream);
#if MK_SINGLE
    p.ph_lo = 0; p.ph_hi = NPH;
    void* args[] = {&p};
    hipError_t e = hipLaunchCooperativeKernel((const void*)fwd_megakernel, dim3(grid), dim3(512), args, LDS_BYTES, stream);
    if (e != hipSuccess) fprintf(stderr, "cooperative launch failed: %s (grid %d)\n", hipGetErrorString(e), grid);
#else
    for (int ph = 0; ph < NPH; ++ph) {
        p.ph_lo = ph; p.ph_hi = ph + 1;
        hipLaunchKernelGGL(fwd_megakernel, dim3(grid), dim3(512), LDS_BYTES, stream, p);
    }
#endif
}
```

```cpp
#include <hip/hip_runtime.h>
#include <cstdio>
#include <cstdint>

#define LAS __attribute__((address_space(3)))
typedef unsigned short bf16_t;
typedef short bf16x8 __attribute__((ext_vector_type(8)));
typedef float f32x4 __attribute__((ext_vector_type(4)));
typedef unsigned u32x4 __attribute__((ext_vector_type(4)));
typedef unsigned u32x2 __attribute__((ext_vector_type(2)));

#ifndef REP_PHASE
#define REP_PHASE -1
#endif
#ifndef MK_SINGLE
#define MK_SINGLE 1
#endif

constexpr int NTOK = 16384, DM = 1024, NPROJ = 6144, DIN = 6176;
constexpr int NPH = 8;
constexpr int LDS_BYTES = 160 * 1024;
constexpr size_t OUT_YP = 0, OUT_YS = 8388608, OUT_SD = 16777216, OUT_SR = 25165824;
constexpr size_t WS_CTL = 0, WS_MODP = 16384, WS_PE = 606208, WS_BA = 737280, WS_GB = 2834432, WS_RGAGG = 4931584,
                 WS_WBAT = 9125888, WS_WOUTT = 9191424, WS_GT = 13385728, WS_WINT = 14434304, WS_TA = 27017216, WS_PROJ = 60571648, WS_CARRY = 261898240;

struct Params {
    const float *x_prompt, *x_sample, *state_delta, *state_rglru, *c, *c_ctx, *ada_w, *ada_b, *pre_w, *post_w, *w_in, *w_out,
                *dn_conv_w, *dn_a_log, *dn_dt_bias, *dn_norm_w, *rg_conv_w, *rg_conv_b, *rg_w_r, *rg_b_r, *rg_w_i, *rg_b_i, *rg_lam;
    float* out; unsigned char* ws;
    int ph_lo, ph_hi;
};

__device__ __forceinline__ float bf2f(unsigned short b) { return __uint_as_float(((unsigned)b) << 16); }
typedef __bf16 bf2_t __attribute__((ext_vector_type(2)));
typedef float f2_t __attribute__((ext_vector_type(2)));
__device__ __forceinline__ unsigned pk2(float lo, float hi) { const f2_t v = {lo, hi}; return __builtin_bit_cast(unsigned, __builtin_convertvector(v, bf2_t)); }
__device__ __forceinline__ unsigned short f2bf(float f) { return (unsigned short)(pk2(f, f) & 0xffffu); }
#ifndef SANITIZE
#define SANITIZE 0
#endif
#ifndef LIVE_MASK
#define LIVE_MASK 15
#endif
__device__ __forceinline__ float fin(float x) { return (SANITIZE && ((__float_as_uint(x) & 0x7f800000u) == 0x7f800000u)) ? 0.f : x; }
#define DG(F) ((unsigned*)((F).ws + WS_CTL))
__device__ __forceinline__ bool badv(float x, float lim) { return ((__float_as_uint(x) & 0x7f800000u) == 0x7f800000u) || fabsf(x) > lim; }
#ifndef DIAG
#define DIAG 0
#endif
#define CHK(F, k, bad) do { if (DIAG && (bad)) DG(F)[k] = 1u; } while (0)
__device__ __forceinline__ float sigm(float x) { return __builtin_amdgcn_rcpf(1.f + __expf(-x)); }
__device__ __forceinline__ float siluf_(float x) { return x * __builtin_amdgcn_rcpf(1.f + __expf(-x)); }
__device__ __forceinline__ float softplusf_(float x) { return x > 20.f ? x : log1pf(__expf(x)); }
__device__ __forceinline__ void unpack8(const u32x4 v, float (&f)[8]) {
    f[0] = __uint_as_float(v.x << 16); f[1] = __uint_as_float(v.x & 0xffff0000u);
    f[2] = __uint_as_float(v.y << 16); f[3] = __uint_as_float(v.y & 0xffff0000u);
    f[4] = __uint_as_float(v.z << 16); f[5] = __uint_as_float(v.z & 0xffff0000u);
    f[6] = __uint_as_float(v.w << 16); f[7] = __uint_as_float(v.w & 0xffff0000u);
}
__device__ __forceinline__ u32x4 pack8(const float (&f)[8]) { u32x4 o; o.x = pk2(f[0], f[1]); o.y = pk2(f[2], f[3]); o.z = pk2(f[4], f[5]); o.w = pk2(f[6], f[7]); return o; }
__device__ __forceinline__ float wave_sum(float v) {
#pragma unroll
    for (int o = 1; o < 64; o <<= 1) v += __shfl_xor(v, o);
    return v;
}
__device__ __forceinline__ void lds_barrier() { asm volatile("s_waitcnt lgkmcnt(0)" ::: "memory"); __builtin_amdgcn_s_barrier(); asm volatile("" ::: "memory"); }
#define MFMA16(a, b, c) __builtin_amdgcn_mfma_f32_16x16x32_bf16((a), (b), (c), 0, 0, 0)
#define LDS_WAIT() asm volatile("s_waitcnt lgkmcnt(0)" ::: "memory")
__device__ __forceinline__ bf16x8 ldfrag(const LAS unsigned char* base, int pitch, int row, int kb) { return *(const LAS bf16x8*)(base + row * pitch + kb); }

#define XB_TMO      128
#define XB_XCNT(j)  (256  + 64 * (j))
#define XB_XSUB(j)  (1280 + 64 * (j))
#define XB_XGEN(j)  (2304 + 64 * (j))
#define XB_TOP      3328
#define XB_TOPGEN   3392
#define XCD_BAR_WORDS 3456
#define XB_SPIN_CAP (1u << 18)
__device__ __forceinline__ unsigned xb_ld(unsigned* p)              { return __hip_atomic_load(p, __ATOMIC_RELAXED, __HIP_MEMORY_SCOPE_AGENT); }
__device__ __forceinline__ unsigned xb_add(unsigned* p, unsigned v) { return __hip_atomic_fetch_add(p, v, __ATOMIC_RELAXED, __HIP_MEMORY_SCOPE_AGENT); }
__device__ __forceinline__ unsigned xb_xcc_id() { return (unsigned)__builtin_amdgcn_s_getreg((3 << 11) | 20) & 0xFu; }
#define XB_SPIN(cond, bar) do { unsigned _sp = 0; while (cond) { __builtin_amdgcn_s_sleep(1); \
    if ((++_sp & 255u) == 0u) { if (xb_ld(&(bar)[XB_TMO])) break; if (_sp > XB_SPIN_CAP) { atomicAdd(&(bar)[XB_TMO], 1u); break; } } } } while (0)
struct XcdBarrier { unsigned* bar; unsigned x; volatile LAS unsigned* st; };
__device__ __forceinline__ XcdBarrier xcd_barrier_post(unsigned* bar, volatile LAS unsigned* st) {
    XcdBarrier b; b.bar = bar; b.x = xb_xcc_id(); b.st = st;
    if (threadIdx.x == 0) (void)xb_add(&bar[XB_XCNT(b.x)], 1u);
    return b;
}
__device__ __forceinline__ void xcd_barrier_complete(unsigned* bar, unsigned x, unsigned& nloc, unsigned& nx) {
    const unsigned G = gridDim.x * gridDim.y * gridDim.z;
    unsigned sum, cnt, mine, sp = 0u;
    for (;;) {
        sum = 0u; cnt = 0u; mine = 0u;
#pragma unroll
        for (unsigned j = 0; j < 16; ++j) { const unsigned c = xb_ld(&bar[XB_XCNT(j)]); sum += c; cnt += (c > 0u) ? 1u : 0u; mine = (j == x) ? c : mine; }
        if (sum == G) break;
        __builtin_amdgcn_s_sleep(1);
        if ((++sp & 255u) == 0u) { if (xb_ld(&bar[XB_TMO])) break; if (sp > XB_SPIN_CAP) { atomicAdd(&bar[XB_TMO], 1u); break; } }
    }
    nloc = mine > 0u ? mine : 1u; nx = cnt > 0u ? cnt : 1u;
}
__device__ __forceinline__ void xcd_barrier(const XcdBarrier& b) {
    asm volatile("s_waitcnt vmcnt(0)" ::: "memory");
    __syncthreads();
    if (threadIdx.x == 0) {
        unsigned* bar = b.bar;
        __builtin_amdgcn_s_waitcnt(0);
        unsigned nloc = b.st[0], nx = b.st[1];
        if (nloc == 0u) { xcd_barrier_complete(bar, b.x, nloc, nx); b.st[0] = nloc; b.st[1] = nx; }
        const unsigned old = xb_add(&bar[XB_XSUB(b.x)], 1u);
        const unsigned gen = old / nloc;
        if (old + 1u == (gen + 1u) * nloc) {
            __builtin_amdgcn_fence(__ATOMIC_RELEASE, "agent");
            asm volatile("s_waitcnt vmcnt(0)" ::: "memory");
            const unsigned og = xb_add(&bar[XB_TOP], 1u);
            const unsigned tg = og / nx;
            if (og + 1u == (tg + 1u) * nx) xb_add(&bar[XB_TOPGEN], 1u);
            else XB_SPIN(xb_ld(&bar[XB_TOPGEN]) == tg, bar);
            __builtin_amdgcn_fence(__ATOMIC_ACQUIRE, "agent");
            xb_add(&bar[XB_XGEN(b.x)], 1u);
            asm volatile("s_waitcnt vmcnt(0)" ::: "memory");
        } else {
            XB_SPIN(xb_ld(&bar[XB_XGEN(b.x)]) == gen, bar);
            __builtin_amdgcn_fence(__ATOMIC_ACQUIRE, "agent");
            asm volatile("s_waitcnt vmcnt(0)" ::: "memory");
        }
    }
    __syncthreads();
}

namespace pg8 {
constexpr int BM = 256, BK = 64, HALF = 128, HTB = HALF * BK * 2, STAGE_BYTES = 8 * HTB, NXCD = 8, WGM = 8;
__host__ __device__ __forceinline__ int lds_byte(int r, int c) { const int st = (r >> 4) * 2 + (c >> 5), rr = r & 15, cc = c & 31, ob = rr * 64 + cc * 2; return st * 1024 + (ob ^ (((ob >> 9) & 1) << 5)); }
__host__ __device__ __forceinline__ void stage_rc(int b, int& R, int& C) { const int st = b / 1024, sb = b % 1024, swz = sb ^ (((sb >> 9) & 1) << 5); R = (st >> 1) * 16 + swz / 64; C = (st & 1) * 32 + (swz % 64) / 2; }
__host__ __device__ __forceinline__ int perm32(int rho) { const int n = rho >> 4, i = rho & 15; return 8 * (i >> 2) + 4 * n + (i & 3); }
struct Unit { int pm, pn; };
struct Gemm { const bf16_t* A; const bf16_t* Bt; int M, N, K; };
struct StaticOrder {
    int nM, nN, nwg, G, c;
    __host__ __device__ void init(int M, int N, int G_, int c_) { nM = M / BM; nN = N / BM; nwg = nM * nN; G = G_; c = c_; }
    __host__ __device__ bool next(int i, Unit& u) const {
        const long L = (long)i * G + c; if (L >= nwg) return false;
        int wgid = (int)L; { const int q = nwg / NXCD, r = nwg % NXCD, xcd = wgid % NXCD, off = wgid / NXCD; wgid = (xcd < r ? xcd * (q + 1) : r * (q + 1) + (xcd - r) * q) + off; }
        const int nig = WGM * nN, gid = wgid / nig, fm = gid * WGM, gsz = (nM - fm) < WGM ? (nM - fm) : WGM;
        u.pm = fm + ((wgid % nig) % gsz); u.pn = (wgid % nig) / gsz; return true;
    }
};
__device__ __forceinline__ unsigned cvt_pk_bf16(float lo, float hi) { unsigned r; asm volatile("v_cvt_pk_bf16_f32 %0, %1, %2" : "=v"(r) : "v"(lo), "v"(hi)); return r; }
struct EpiF32 {
    static constexpr bool PERM = false;
    float* C; int ldc;
    __device__ __forceinline__ void operator()(const f32x4 (&acc)[2][2][4][2], const Unit& u, int wr, int wc, int fr, int fq) const {
        const int row0 = u.pm * BM + wr * 64 + fr, col0 = u.pn * BM + wc * 32 + 4 * fq;
#pragma unroll
        for (int ai = 0; ai < 2; ++ai)
#pragma unroll
            for (int m = 0; m < 4; ++m) { float* rowp = C + (size_t)(row0 + ai * HALF + m * 16) * ldc + col0;
#pragma unroll
                for (int bj = 0; bj < 2; ++bj)
#pragma unroll
                    for (int n = 0; n < 2; ++n) *(f32x4*)(rowp + bj * HALF + n * 16) = acc[ai][bj][m][n]; }
    }
};
struct EpiBf16 {
    static constexpr bool PERM = true;
    bf16_t* O; int ldc;
    __device__ __forceinline__ void operator()(const f32x4 (&acc)[2][2][4][2], const Unit& u, int wr, int wc, int fr, int fq) const {
        const int row0 = u.pm * BM + wr * 64 + fr; const int col0 = u.pn * BM + wc * 32 + 8 * fq;
#pragma unroll
        for (int ai = 0; ai < 2; ++ai)
#pragma unroll
            for (int m = 0; m < 4; ++m) { bf16_t* rowp = O + (size_t)(row0 + ai * HALF + m * 16) * ldc + col0;
#pragma unroll
                for (int bj = 0; bj < 2; ++bj) { const f32x4 v0 = acc[ai][bj][m][0], v1 = acc[ai][bj][m][1];
                    u32x4 w; w.x = cvt_pk_bf16(v0[0], v0[1]); w.y = cvt_pk_bf16(v0[2], v0[3]); w.z = cvt_pk_bf16(v1[0], v1[1]); w.w = cvt_pk_bf16(v1[2], v1[3]);
                    *(u32x4*)(rowp + bj * HALF) = w; } }
    }
};

template <class Epi, class Sched>
__device__ __forceinline__ void gemm_phase(LAS unsigned char* lds, const Gemm g, const Sched& S, const Epi& E) {
    const int tid = threadIdx.x, wid = __builtin_amdgcn_readfirstlane(tid >> 6), lane = tid & 63, wr = wid >> 2, wc = wid & 3, fr = lane & 15, fq = lane >> 4;
    const int K = g.K, nt = K / BK;
    unsigned voffA[2], voffB[2];
#pragma unroll
    for (int i = 0; i < 2; ++i) { int R, C; stage_rc(tid * 16 + i * 8192, R, C); const int Rb = Epi::PERM ? ((R & ~31) + perm32(R & 31)) : R;
        voffA[i] = (unsigned)(R * K + C) * 2u; voffB[i] = (unsigned)(Rb * K + C) * 2u; }
    const size_t kstep = (size_t)(BK * 2);
    const size_t hstep = (size_t)HALF * K * 2;
    const size_t tstep = 2 * hstep;
    const unsigned ldsw = (unsigned)wid * 1024u;
    const int aoff = lds_byte(wr * 64 + fr, fq * 8), boff = lds_byte(wc * 32 + fr, fq * 8);
#define PG8_SA(b, h) (((b) * 2 + (h)) * HTB)
#define PG8_SB(b, h) ((4 + (b) * 2 + (h)) * HTB)
#define PG8_STAGE(bufoff, gbase, voff) do { _Pragma("unroll") for (int _i = 0; _i < 2; ++_i) \
        __builtin_amdgcn_global_load_lds((const unsigned*)((const char*)(gbase) + (voff)[_i]), (LAS unsigned*)(lds + (bufoff) + ldsw + _i * 8192), 16, 0, 0); } while (0)
#define PG8_LDA(dst, b, h) do { _Pragma("unroll") for (int m = 0; m < 4; ++m) _Pragma("unroll") for (int k = 0; k < 2; ++k) dst[m][k] = *(const LAS bf16x8*)(lds + PG8_SA(b, h) + aoff + m * 2048 + k * 1024); } while (0)
#define PG8_LDB(dst, b, h) do { _Pragma("unroll") for (int n = 0; n < 2; ++n) _Pragma("unroll") for (int k = 0; k < 2; ++k) dst[n][k] = *(const LAS bf16x8*)(lds + PG8_SB(b, h) + boff + n * 2048 + k * 1024); } while (0)
#define PG8_MMA(ai, bj, At, Bt) do { __builtin_amdgcn_s_setprio(1); _Pragma("unroll") for (int m = 0; m < 4; ++m) _Pragma("unroll") for (int n = 0; n < 2; ++n) _Pragma("unroll") for (int k = 0; k < 2; ++k) \
        acc[ai][bj][m][n] = __builtin_amdgcn_mfma_f32_16x16x32_bf16(Bt[n][k], At[m][k], acc[ai][bj][m][n], 0, 0, 0); __builtin_amdgcn_s_setprio(0); } while (0)
#define PG8_WAIT_V(n) asm volatile("s_waitcnt vmcnt(" #n ")" ::: "memory")
#define PG8_WAIT_L(n) asm volatile("s_waitcnt lgkmcnt(" #n ")" ::: "memory")
#define PG8_BAR __builtin_amdgcn_s_barrier()
#define PG8_SCHED __builtin_amdgcn_sched_barrier(0)
    Unit cur, nxt; int ui = 0;
    if (!S.next(0, cur)) return;
    f32x4 acc[2][2][4][2];
#pragma unroll
    for (int a = 0; a < 2; ++a)
#pragma unroll
        for (int b = 0; b < 2; ++b)
#pragma unroll
            for (int m = 0; m < 4; ++m)
#pragma unroll
                for (int n = 0; n < 2; ++n) acc[a][b][m][n] = (f32x4){0.f, 0.f, 0.f, 0.f};
    bf16x8 At[4][2], B0[2][2], B1[2][2];
    const char* cA = (const char*)g.A + (size_t)cur.pm * tstep; const char* cB = (const char*)g.Bt + (size_t)cur.pn * tstep;
    PG8_STAGE(PG8_SB(0, 0), cB, voffB); PG8_STAGE(PG8_SA(0, 0), cA, voffA); PG8_STAGE(PG8_SB(0, 1), cB + hstep, voffB); PG8_STAGE(PG8_SA(0, 1), cA + hstep, voffA);
    if (wr == 1) PG8_BAR;
    PG8_WAIT_V(4); PG8_BAR;
    PG8_STAGE(PG8_SB(1, 0), cB + kstep, voffB); PG8_STAGE(PG8_SA(1, 0), cA + kstep, voffA); PG8_STAGE(PG8_SB(1, 1), cB + hstep + kstep, voffB);
    PG8_WAIT_V(6); PG8_BAR;
    for (;;) {
        const bool has_next = S.next(ui + 1, nxt);
        const char* nA = has_next ? (const char*)g.A + (size_t)nxt.pm * tstep : cA; const char* nB = has_next ? (const char*)g.Bt + (size_t)nxt.pn * tstep : cB;
        for (int t = 0; t < nt; t += 2) {
            const bool last = (t == nt - 2);
            const char* a1 = cA + (size_t)(t + 1) * kstep;
            const char* a2 = last ? nA : cA + (size_t)(t + 2) * kstep; const char* b2 = last ? nB : cB + (size_t)(t + 2) * kstep;
            const char* a3 = a2 + kstep; const char* b3 = b2 + kstep;
            PG8_LDB(B0, 0, 0); PG8_SCHED; PG8_LDA(At, 0, 0); PG8_STAGE(PG8_SA(1, 1), a1 + hstep, voffA);
            PG8_WAIT_L(8); PG8_BAR; PG8_WAIT_L(0); PG8_MMA(0, 0, At, B0); PG8_BAR; PG8_SCHED;
            PG8_LDB(B1, 0, 1); PG8_STAGE(PG8_SB(0, 0), b2, voffB);
            PG8_BAR; PG8_WAIT_L(0); PG8_MMA(0, 1, At, B1); PG8_BAR;
            PG8_LDA(At, 0, 1); PG8_STAGE(PG8_SA(0, 0), a2, voffA);
            PG8_BAR; PG8_WAIT_L(0); PG8_MMA(1, 0, At, B0); PG8_BAR; PG8_SCHED;
            PG8_STAGE(PG8_SB(0, 1), b2 + hstep, voffB);
            PG8_WAIT_V(6); PG8_BAR; PG8_MMA(1, 1, At, B1); PG8_BAR;
            PG8_LDB(B0, 1, 0); PG8_SCHED; PG8_LDA(At, 1, 0); PG8_STAGE(PG8_SA(0, 1), a2 + hstep, voffA);
            PG8_WAIT_L(8); PG8_BAR; PG8_WAIT_L(0); PG8_MMA(0, 0, At, B0); PG8_BAR; PG8_SCHED;
            PG8_LDB(B1, 1, 1); PG8_STAGE(PG8_SB(1, 0), b3, voffB);
            PG8_BAR; PG8_WAIT_L(0); PG8_MMA(0, 1, At, B1); PG8_BAR;
            PG8_LDA(At, 1, 1); PG8_STAGE(PG8_SA(1, 0), a3, voffA);
            PG8_BAR; PG8_WAIT_L(0); PG8_MMA(1, 0, At, B0); PG8_BAR; PG8_SCHED;
            PG8_STAGE(PG8_SB(1, 1), b3 + hstep, voffB);
            PG8_WAIT_V(6); PG8_BAR; PG8_MMA(1, 1, At, B1); PG8_BAR;
        }
        E(acc, cur, wr, wc, fr, fq);
        if (!has_next) break;
#pragma unroll
        for (int a = 0; a < 2; ++a)
#pragma unroll
            for (int b = 0; b < 2; ++b)
#pragma unroll
                for (int m = 0; m < 4; ++m)
#pragma unroll
                    for (int n = 0; n < 2; ++n) acc[a][b][m][n] = (f32x4){0.f, 0.f, 0.f, 0.f};
        cur = nxt; cA = nA; cB = nB; ++ui;
    }
    PG8_WAIT_V(0);
    if (wr == 0) PG8_BAR;
    PG8_BAR;
#undef PG8_SA
#undef PG8_SB
#undef PG8_STAGE
#undef PG8_LDA
#undef PG8_LDB
#undef PG8_MMA
#undef PG8_WAIT_V
#undef PG8_WAIT_L
#undef PG8_BAR
#undef PG8_SCHED
}
}

struct Frame {
    LAS unsigned char* lds;
    int tid, lane, wave, G, b;
    float* out; unsigned char* ws;
    __device__ __forceinline__ bf16_t* H() const { return (bf16_t*)out; }
    __device__ __forceinline__ bf16_t* Qc() const { return (bf16_t*)out; }
    __device__ __forceinline__ bf16_t* Kc() const { return (bf16_t*)(out + OUT_YS); }
    __device__ __forceinline__ bf16_t* MIX() const { return (bf16_t*)out; }
    __device__ __forceinline__ float* modp() const { return (float*)(ws + WS_MODP); }
    __device__ __forceinline__ float* pe() const { return (float*)(ws + WS_PE); }
    __device__ __forceinline__ float* BA() const { return (float*)(ws + WS_BA); }
    __device__ __forceinline__ float* GB() const { return (float*)(ws + WS_GB); }
    __device__ __forceinline__ float* RGAGG() const { return (float*)(ws + WS_RGAGG); }
    __device__ __forceinline__ bf16_t* WbaT() const { return (bf16_t*)(ws + WS_WBAT); }
    __device__ __forceinline__ bf16_t* WoutT() const { return (bf16_t*)(ws + WS_WOUTT); }
    __device__ __forceinline__ bf16_t* GT() const { return (bf16_t*)(ws + WS_GT); }
    __device__ __forceinline__ bf16_t* WinT() const { return (bf16_t*)(ws + WS_WINT); }
    __device__ __forceinline__ bf16_t* TA() const { return (bf16_t*)(ws + WS_TA); }
    __device__ __forceinline__ bf16_t* PROJ() const { return (bf16_t*)(ws + WS_PROJ); }
    __device__ __forceinline__ float* CARRY() const { return (float*)(ws + WS_CARRY); }
};
typedef const __attribute__((address_space(4))) Params CParams;

__device__ __forceinline__ int grp_of_block(int tb) { return tb < 128 ? 0 : (tb < 192 ? 1 : 2); }

__device__ __forceinline__ void transpose_item(const float* W, int N, int k0, int n0, bf16_t* WT0, int Kout, LAS float* scr, int lane) {
#pragma unroll 8
    for (int i = 0; i < 32; ++i) { const int kk = 2 * i + (lane >> 5); scr[kk * 33 + (lane & 31)] = W[(size_t)(k0 + kk) * N + n0 + (lane & 31)]; }
    LDS_WAIT();
    const int c = lane & 7;
#pragma unroll
    for (int j = 0; j < 4; ++j) { const int n = (lane >> 3) + 8 * j; const LAS float* s = scr + (8 * c) * 33 + n;
        u32x4 o; o.x = pk2(s[0 * 33], s[1 * 33]); o.y = pk2(s[2 * 33], s[3 * 33]); o.z = pk2(s[4 * 33], s[5 * 33]); o.w = pk2(s[6 * 33], s[7 * 33]);
        *(u32x4*)(WT0 + (size_t)n * Kout + k0 + 8 * c) = o; }
    LDS_WAIT();
}
__device__ __forceinline__ void phase0(CParams& p, Frame& F) {
    const int tid = F.tid, lane = F.lane;
    for (int it = F.b; it < 192; it += F.G) {
        const int jg = it % 12, ks = it / 12, j = jg * 256 + (tid & 255), half = tid >> 8, k0 = ks * 64 + half * 32;
        float s0 = 0.f, s1 = 0.f, s2 = 0.f;
#pragma unroll 8
        for (int k = 0; k < 32; ++k) { const int kk = k0 + k; const float w = p.ada_w[(size_t)kk * 3072 + j];
            s0 += siluf_(p.c_ctx[kk]) * w; s1 += siluf_(p.c[kk]) * w; s2 += siluf_(p.c[1024 + kk]) * w; }
        LAS float* red = (LAS float*)F.lds;
        if (half == 1) { red[tid - 256] = s0; red[256 + tid - 256] = s1; red[512 + tid - 256] = s2; }
        __syncthreads();
        if (half == 0) { F.modp()[(size_t)(ks * 3 + 0) * 3072 + j] = s0 + red[tid]; F.modp()[(size_t)(ks * 3 + 1) * 3072 + j] = s1 + red[256 + tid]; F.modp()[(size_t)(ks * 3 + 2) * 3072 + j] = s2 + red[512 + tid]; }
        __syncthreads();
    }
    LAS float* scr = (LAS float*)(F.lds + 4096 + F.wave * 8448);
    const int gw = F.b * 8 + F.wave, NGW = F.G * 8;
    constexpr int I_IN = 16 * 193, I_OUT = 32 * 32, I_G = 256, I_PE = 64;
    for (int it = gw; it < I_IN + I_OUT + I_G + I_PE; it += NGW) {
        int r = it;
        if (r < I_IN) { const int kb = r / 193, nb = r % 193, n0 = nb * 32;
            bf16_t* dst = n0 < 4096 ? F.WinT() + (size_t)n0 * 1024 : (n0 < 4128 ? F.WbaT() + (size_t)(n0 - 4096) * 1024 : F.WinT() + (size_t)(n0 - 32) * 1024);
            transpose_item(p.w_in, DIN, kb * 64, n0, dst, 1024, scr, lane); continue; }
        r -= I_IN;
        if (r < I_OUT) { const int kb = r / 32, nb = r % 32; transpose_item(p.w_out, 1024, kb * 64, nb * 32, F.WoutT() + (size_t)(nb * 32) * 2048, 2048, scr, lane); continue; }
        r -= I_OUT;
        if (r < I_G) { const int m = r >> 3, sub = r & 7, kb = sub >> 2, nb = sub & 3, g = m >> 4, dn = m & 15;
            const float* src = (g ? p.rg_w_i : p.rg_w_r) + (size_t)dn * 16384;
            transpose_item(src, 128, kb * 64, nb * 32, F.GT() + (size_t)m * 16384 + (size_t)(nb * 32) * 128, 128, scr, lane); continue; }
        r -= I_G;
        { const int v = r;
#pragma unroll
          for (int i = 0; i < 4; ++i) { const int idx = lane * 4 + i; const float f = expf(-9.210340371976184f * (float)idx / 256.f); const float a = (float)v * f;
              F.pe()[v * 256 + idx] = sinf(a); F.pe()[16384 + v * 256 + idx] = cosf(a); } }
    }
}

__device__ __forceinline__ float mod_val(CParams& p, const Frame& F, int grp, int j) {
    float s = p.ada_b[j];
#pragma unroll
    for (int ks = 0; ks < 16; ++ks) s += F.modp()[(size_t)(ks * 3 + grp) * 3072 + j];
    return s;
}

__device__ __forceinline__ void phase1(CParams& p, Frame& F) {
    LAS float* sc = (LAS float*)F.lds; LAS float* sh = sc + 1024;
    for (int tb = F.b; tb < 256; tb += F.G) {
        const int grp = grp_of_block(tb);
        for (int j = F.tid; j < 1024; j += 512) { sh[j] = mod_val(p, F, grp, j); sc[j] = p.pre_w[j] * (1.f + mod_val(p, F, grp, 1024 + j)); }
        __syncthreads();
#pragma unroll 2
        for (int i = 0; i < 8; ++i) {
            const int tok = tb * 64 + F.wave * 8 + i;
            const float* xr = tok < 8192 ? p.x_prompt + (size_t)tok * 1024 : p.x_sample + (size_t)(tok - 8192) * 1024;
            f32x4 v[4]; float ss = 0.f;
#pragma unroll
            for (int q = 0; q < 4; ++q) { v[q] = *(const f32x4*)(xr + F.lane * 4 + 256 * q);
                if (tok >= 8192) { const int pp = (tok - 8192) & 4095; const int vv = (q < 2) ? (pp >> 6) : (pp & 63);
                    const f32x4 e = *(const f32x4*)(F.pe() + ((q & 1) ? 16384 : 0) + vv * 256 + F.lane * 4); v[q] += e; }
                ss += (v[q][0] * v[q][0] + v[q][1] * v[q][1]) + (v[q][2] * v[q][2] + v[q][3] * v[q][3]); }
            const float rstd = rsqrtf(wave_sum(ss) * (1.f / 1024.f) + 1e-6f);
#pragma unroll
            for (int q = 0; q < 4; ++q) { const int j = F.lane * 4 + 256 * q; const f32x4 s4 = *(const LAS f32x4*)(sc + j), h4 = *(const LAS f32x4*)(sh + j);
                CHK(F, 1, badv(v[q][0] * rstd * s4[0] + h4[0], 100.f) || badv(v[q][3] * rstd * s4[3] + h4[3], 100.f));
                u32x2 o; o.x = pk2(v[q][0] * rstd * s4[0] + h4[0], v[q][1] * rstd * s4[1] + h4[1]); o.y = pk2(v[q][2] * rstd * s4[2] + h4[2], v[q][3] * rstd * s4[3] + h4[3]);
                *(u32x2*)(F.H() + (size_t)tok * 1024 + j) = o; }
        }
        __syncthreads();
    }
}

__device__ __forceinline__ void phase2(CParams& p, Frame& F) {
    { pg8::Gemm g{F.H(), F.WinT(), NTOK, NPROJ, 1024}; pg8::StaticOrder S; S.init(NTOK, NPROJ, F.G, F.b); pg8::EpiBf16 E{F.PROJ(), NPROJ};
      pg8::gemm_phase<pg8::EpiBf16, pg8::StaticOrder>(F.lds, g, S, E); }
    const int l15 = F.lane & 15, q4 = F.lane >> 4;
    for (int tb = F.b; tb < 256; tb += F.G) {
        const int mt = F.wave >> 1, nt = F.wave & 1;
        const bf16_t* ar = F.H() + (size_t)(tb * 64 + mt * 16 + l15) * 1024 + q4 * 8;
        const bf16_t* br = F.WbaT() + (size_t)(nt * 16 + l15) * 1024 + q4 * 8;
        f32x4 acc = {0.f, 0.f, 0.f, 0.f};
#pragma unroll 16
        for (int ks = 0; ks < 32; ++ks) { const bf16x8 a = *(const bf16x8*)(ar + ks * 32), b = *(const bf16x8*)(br + ks * 32); acc = MFMA16(a, b, acc); }
#pragma unroll
        for (int r = 0; r < 4; ++r) F.BA()[(size_t)(tb * 64 + mt * 16 + q4 * 4 + r) * 32 + nt * 16 + l15] = acc[r];
    }
}

__device__ __forceinline__ void p3_load_rows(const Frame& F, int ci, int h, u32x4 (&rows)[7]) {
    const int tid = F.tid, tg = tid >> 5, part = (tid >> 4) & 1, sub = tid & 15, col = part * 1024 + h * 128 + sub * 8, t0 = ci * 64;
    int seq_lo, seq_hi; if (ci < 128) { seq_lo = (ci >> 2) * 256; seq_hi = seq_lo + 256; } else { seq_lo = 8192 + ((ci - 128) >> 6) * 4096; seq_hi = seq_lo + 4096; }
    const int tb = t0 + tg * 4 - 2;
#pragma unroll
    for (int r = 0; r < 7; ++r) { const int tok = tb + r; u32x4 v = {0u, 0u, 0u, 0u};
        if (tok >= seq_lo && tok < seq_hi) v = *(const u32x4*)(F.PROJ() + (size_t)tok * NPROJ + col);
        rows[r] = v; }
}
__device__ __forceinline__ void p3_delta_item(CParams& p, Frame& F, int ci, int h, u32x4 (&rows)[7], int itn) {
    const int tid = F.tid, lane = F.lane, wave = F.wave, q4 = lane >> 4, l15 = lane & 15;
    LAS unsigned char* Ks = F.lds; LAS unsigned char* Qs = F.lds + 17408;
    LAS float* gfv = (LAS float*)(F.lds + 34816);
    LAS unsigned char* DIR0 = F.lds + 35840;
    LAS unsigned char* ATo = F.lds + 137728;
#pragma unroll
    for (int i = 0; i < 5; ++i) { const int ch = tid + 512 * i; if (ch < 2304) { const int dd = ch >= 1152, cc = ch - dd * 1152; *(LAS u32x4*)(DIR0 + dd * 46848 + 18432 + cc * 16) = (u32x4){0u, 0u, 0u, 0u}; } }
    const int t0 = ci * 64;
    int seq_lo, seq_hi; if (ci < 128) { seq_lo = (ci >> 2) * 256; seq_hi = seq_lo + 256; } else { seq_lo = 8192 + ((ci - 128) >> 6) * 4096; seq_hi = seq_lo + 4096; }
    {
        const int tg = tid >> 5, part = (tid >> 4) & 1, sub = tid & 15, col = part * 1024 + h * 128 + sub * 8;
        float w[4][8];
#pragma unroll
        for (int j = 0; j < 4; ++j) { const f32x4 a = *(const f32x4*)(p.dn_conv_w + j * 3072 + col), b = *(const f32x4*)(p.dn_conv_w + j * 3072 + col + 4);
            w[j][0] = a[0]; w[j][1] = a[1]; w[j][2] = a[2]; w[j][3] = a[3]; w[j][4] = b[0]; w[j][5] = b[1]; w[j][6] = b[2]; w[j][7] = b[3]; }
        float acc[4][8];
#pragma unroll
        for (int i = 0; i < 4; ++i)
#pragma unroll
            for (int e = 0; e < 8; ++e) acc[i][e] = 0.f;
#pragma unroll
        for (int r = 0; r < 7; ++r) {
            float x[8]; unpack8(rows[r], x);
#pragma unroll
            for (int j = 0; j < 4; ++j) { const int i = r - j; if (i >= 0 && i < 4) {
#pragma unroll
                for (int e = 0; e < 8; ++e) acc[i][e] += w[j][e] * x[e]; } } }
#pragma unroll
        for (int i = 0; i < 4; ++i) { float ss = 0.f;
#pragma unroll
            for (int e = 0; e < 8; ++e) { acc[i][e] = siluf_(acc[i][e]); ss += acc[i][e] * acc[i][e]; }
            ss += __shfl_xor(ss, 1); ss += __shfl_xor(ss, 2); ss += __shfl_xor(ss, 4); ss += __shfl_xor(ss, 8);
            const float rs = rsqrtf(ss + 1e-6f) * (part == 0 ? 0.08838834764831845f : 1.f);
#pragma unroll
            for (int e = 0; e < 8; ++e) acc[i][e] *= rs;
            CHK(F, 4, badv(acc[i][0], 1.01f) || badv(acc[i][5], 1.01f) || badv(ss * rs * rs, part == 0 ? 0.0079f : 1.01f));
            const u32x4 o = pack8(acc[i]); const int c = tg * 4 + i;
            *(LAS u32x4*)((part ? Ks : Qs) + c * 272 + sub * 16) = o;
            *(u32x4*)((part ? F.Kc() : F.Qc()) + (size_t)(t0 + c) * 1024 + h * 128 + sub * 8) = o; }
    }
    if (wave == 0) {
        const float* ba = F.BA() + (size_t)(t0 + lane) * 32;
        const float bf_ = sigm(ba[h]), bb_ = sigm(ba[8 + h]);
        float s = -expf(p.dn_a_log[h]) * softplusf_(ba[16 + h] + p.dn_dt_bias[h]);
        float sb = -expf(p.dn_a_log[8 + h]) * softplusf_(ba[24 + h] + p.dn_dt_bias[8 + h]);
#pragma unroll
        for (int o = 1; o < 64; o <<= 1) { const float t = __shfl_up(s, o); if (lane >= o) s += t; }
#pragma unroll
        for (int o = 1; o < 64; o <<= 1) { const float t = __shfl_down(sb, o); if (lane + o < 64) sb += t; }
        CHK(F, 3, badv(ba[h], 1000.f) || badv(ba[24 + h], 1000.f));
        CHK(F, 8, badv(s, 1e4f) || badv(sb, 1e4f) || s > 0.f || sb > 0.f || bf_ < 0.f || bf_ > 1.f || bb_ < 0.f || bb_ > 1.f);
        gfv[lane] = s; gfv[64 + lane] = sb; gfv[128 + lane] = bf_; gfv[192 + lane] = bb_;
        float* gb = F.GB() + (size_t)(ci * 8 + h) * 256;
        gb[lane] = s; gb[64 + lane] = sb; gb[128 + lane] = bf_; gb[192 + lane] = bb_;
    }
    lds_barrier();
    const int d = wave >> 2, mt = wave & 3;
    LAS unsigned char* Db = DIR0 + d * 46848;
    LAS unsigned char* Brow = Db; LAS unsigned char* Btr = Db + 9216; LAS unsigned char* Xrow = Db + 18432; LAS unsigned char* Xtr = Db + 27648;
    LAS float* Dl = (LAS float*)(Db + 36864) + mt * 272; LAS unsigned char* M2t = Db + 41216; LAS unsigned char* Mts = Db + 43776 + mt * 768;
    const LAS unsigned char* Lrow = d == 0 ? Brow : Btr;
    const LAS float* gd = gfv + d * 64; const LAS float* bd = gfv + 128 + d * 64;
    {
        f32x4 kk[4], qk[4];
#pragma unroll
        for (int n = 0; n < 4; ++n) { kk[n] = (f32x4){0.f, 0.f, 0.f, 0.f}; qk[n] = (f32x4){0.f, 0.f, 0.f, 0.f}; }
#pragma unroll
        for (int ks = 0; ks < 4; ++ks) { const bf16x8 ak = ldfrag(Ks, 272, mt * 16 + l15, ks * 64 + q4 * 16), aq = ldfrag(Qs, 272, mt * 16 + l15, ks * 64 + q4 * 16);
#pragma unroll
            for (int n = 0; n < 4; ++n) { const bf16x8 bk = ldfrag(Ks, 272, n * 16 + l15, ks * 64 + q4 * 16); kk[n] = MFMA16(ak, bk, kk[n]); qk[n] = MFMA16(aq, bk, qk[n]); } }
#pragma unroll
        for (int n = 0; n < 4; ++n) { const int s = n * 16 + l15; float a4[4];
#pragma unroll
            for (int r = 0; r < 4; ++r) { const int c = mt * 16 + q4 * 4 + r;
                const float dec = __expf(fminf(gd[c] - gd[s], 0.f));
                const bool strict = d == 0 ? (c > s) : (c < s);
                const float a = strict ? bd[c] * kk[n][r] * dec : 0.f;
                a4[r] = a;
                ((LAS bf16_t*)Brow)[c * 72 + s] = f2bf(a);
                if (n == mt) { if (d == 0) Dl[(q4 * 4 + r) * 17 + l15] = a; else Dl[l15 * 17 + q4 * 4 + r] = a; }
                const bool incl = d == 0 ? (c >= s) : (c < s);
                if (incl) ((LAS bf16_t*)ATo)[c * 64 + s] = f2bf(qk[n][r] * dec); }
            u32x2 o; o.x = pk2(a4[0], a4[1]); o.y = pk2(a4[2], a4[3]);
            *(LAS u32x2*)(Btr + s * 144 + (mt * 16 + q4 * 4) * 2) = o; }
    }
    lds_barrier();
    if (lane < 16) {
        float x[16];
#pragma unroll
        for (int i = 0; i < 16; ++i) { float sv = (i == lane) ? 1.f : 0.f;
#pragma unroll
            for (int j = 0; j < i; ++j) sv -= Dl[i * 17 + j] * x[j];
            x[i] = sv; }
#pragma unroll
        for (int i = 0; i < 16; ++i) ((LAS bf16_t*)Xrow)[(mt * 16 + i) * 72 + mt * 16 + lane] = f2bf(x[i]);
        u32x4 o0, o1; o0.x = pk2(x[0], x[1]); o0.y = pk2(x[2], x[3]); o0.z = pk2(x[4], x[5]); o0.w = pk2(x[6], x[7]);
        o1.x = pk2(x[8], x[9]); o1.y = pk2(x[10], x[11]); o1.z = pk2(x[12], x[13]); o1.w = pk2(x[14], x[15]);
        *(LAS u32x4*)(Xtr + (mt * 16 + lane) * 144 + mt * 32) = o0; *(LAS u32x4*)(Xtr + (mt * 16 + lane) * 144 + mt * 32 + 16) = o1;
    }
    lds_barrier();
    const bf16x8 zero8 = {0, 0, 0, 0, 0, 0, 0, 0};
    const f32x4 zero4 = {0.f, 0.f, 0.f, 0.f};
    if (mt & 1) {
        const int I1 = mt, I0 = mt - 1;
        bf16x8 a = zero8, b = zero8;
        if (q4 < 2) { a = ldfrag(Lrow, 144, I1 * 16 + l15, I0 * 32 + q4 * 16); b = ldfrag(Xtr, 144, I0 * 16 + l15, I0 * 32 + q4 * 16); }
        const f32x4 M = MFMA16(a, b, zero4);
        { u32x2 o; o.x = pk2(M[0], M[1]); o.y = pk2(M[2], M[3]); *(LAS u32x2*)(Mts + l15 * 48 + q4 * 8) = o; }
        LDS_WAIT();
        bf16x8 a2 = zero8, b2 = zero8;
        if (q4 < 2) { a2 = ldfrag(Xrow, 144, I1 * 16 + l15, I1 * 32 + q4 * 16); b2 = *(const LAS bf16x8*)(Mts + l15 * 48 + q4 * 16); }
        const f32x4 X = MFMA16(a2, b2, zero4);
#pragma unroll
        for (int r = 0; r < 4; ++r) ((LAS bf16_t*)Xrow)[(I1 * 16 + q4 * 4 + r) * 72 + I0 * 16 + l15] = f2bf(-X[r]);
        u32x2 o; o.x = pk2(-X[0], -X[1]); o.y = pk2(-X[2], -X[3]);
        *(LAS u32x2*)(Xtr + (I0 * 16 + l15) * 144 + (I1 * 16 + q4 * 4) * 2) = o;
    }
    lds_barrier();
    {
        const int mi = mt >> 1, ni = mt & 1;
        const bf16x8 a = ldfrag(Lrow, 144, 32 + mi * 16 + l15, q4 * 16), b = ldfrag(Xtr, 144, ni * 16 + l15, q4 * 16);
        const f32x4 M2 = MFMA16(a, b, zero4);
        { u32x2 o; o.x = pk2(M2[0], M2[1]); o.y = pk2(M2[2], M2[3]); *(LAS u32x2*)(M2t + (ni * 16 + l15) * 80 + (mi * 16 + q4 * 4) * 2) = o; }
        lds_barrier();
        const bf16x8 a2 = ldfrag(Xrow, 144, 32 + mi * 16 + l15, 64 + q4 * 16), b2 = *(const LAS bf16x8*)(M2t + (ni * 16 + l15) * 80 + q4 * 16);
        const f32x4 X = MFMA16(a2, b2, zero4);
#pragma unroll
        for (int r = 0; r < 4; ++r) { CHK(F, 6, badv(X[r], 20.f)); ((LAS bf16_t*)Xrow)[(32 + mi * 16 + q4 * 4 + r) * 72 + ni * 16 + l15] = f2bf(-X[r]); }
        u32x2 o; o.x = pk2(-X[0], -X[1]); o.y = pk2(-X[2], -X[3]);
        *(LAS u32x2*)(Xtr + (ni * 16 + l15) * 144 + (32 + mi * 16 + q4 * 4) * 2) = o;
    }
    lds_barrier();
    { bf16_t* dst = F.TA() + (size_t)(ci * 8 + h) * 8192;
      const int c = tid >> 3, s0 = (tid & 7) * 8;
      const u32x4 lo = *(const LAS u32x4*)(DIR0 + 18432 + c * 144 + s0 * 2), up = *(const LAS u32x4*)(DIR0 + 46848 + 27648 + c * 144 + s0 * 2);
      unsigned wl[4] = {lo.x, lo.y, lo.z, lo.w}, wu[4] = {up.x, up.y, up.z, up.w}, wo[4];
#pragma unroll
      for (int i = 0; i < 4; ++i) { const int sa = s0 + 2 * i, sb2 = sa + 1;
          const unsigned mlo = (sa <= c ? 0x0000FFFFu : 0u) | (sb2 <= c ? 0xFFFF0000u : 0u);
          wo[i] = (wl[i] & mlo) | (wu[i] & ~mlo); }
      *(u32x4*)(dst + tid * 8) = (u32x4){wo[0], wo[1], wo[2], wo[3]};
      *(u32x4*)(dst + 4096 + tid * 8) = *(const LAS u32x4*)(ATo + tid * 16); }
    lds_barrier();
}

struct RgW { bf16x8 g[2][2][4]; float br[2], bi[2], sp[2]; };
__device__ __forceinline__ void rg_load_w(CParams& p, const Frame& F, int n, RgW& W) {
    const int q4 = F.lane >> 4, j = F.wave * 16 + (F.lane & 15), ch = n * 128 + j;
#pragma unroll
    for (int d = 0; d < 2; ++d) {
#pragma unroll
        for (int g = 0; g < 2; ++g) { const bf16_t* gp = F.GT() + (size_t)((g * 2 + d) * 8 + n) * 16384 + (size_t)j * 128 + q4 * 8;
#pragma unroll
            for (int ks = 0; ks < 4; ++ks) W.g[d][g][ks] = *(const bf16x8*)(gp + ks * 32); }
        W.br[d] = p.rg_b_r[d * 1024 + ch]; W.bi[d] = p.rg_b_i[d * 1024 + ch]; W.sp[d] = softplusf_(-p.rg_lam[d * 1024 + ch]); }
}
__device__ __forceinline__ void rg_load_rows(const Frame& F, int ci, int n, u32x4 (&rows)[5]) {
    const int tid = F.tid, tg = tid >> 4, sub = tid & 15, col = 4096 + n * 128 + sub * 8, t0 = ci * 64;
    int c_lo, c_hi; if (ci < 128) { c_lo = (ci >> 2) * 4; c_hi = c_lo + 4; } else { c_lo = 128 + ((ci - 128) >> 6) * 64; c_hi = c_lo + 64; }
    const int tb = t0 + tg * 2 - 2;
#pragma unroll
    for (int r = 0; r < 5; ++r) { const int tok = tb + r; u32x4 v = {0u, 0u, 0u, 0u};
        if (tok >= c_lo * 64 && tok < c_hi * 64) v = *(const u32x4*)(F.PROJ() + (size_t)tok * NPROJ + col);
        rows[r] = v; }
}
template <int PASS>
__device__ __forceinline__ void rg_item(CParams& p, Frame& F, int ci, int n, u32x4 (&rows)[5], int itn) {
    const int tid = F.tid, lane = F.lane, wave = F.wave, q4 = lane >> 4, l15 = lane & 15;
    LAS unsigned char* xb = F.lds; LAS float* xf = (LAS float*)(F.lds + 17408); LAS float* Hs = (LAS float*)(F.lds + 50176);
    const int t0 = ci * 64;
    int seq_lo, seq_hi, c_lo, c_hi, seq; const bool samp = ci >= 128;
    if (!samp) { seq = ci >> 2; c_lo = seq * 4; c_hi = c_lo + 4; } else { seq = (ci - 128) >> 6; c_lo = 128 + seq * 64; c_hi = c_lo + 64; }
    seq_lo = c_lo * 64; seq_hi = c_hi * 64;
    const int j = wave * 16 + l15, ch = n * 128 + j;
    bf16x8 wA[2][4], wB[2][4];
#pragma unroll
    for (int g = 0; g < 2; ++g) { const bf16_t* gp = F.GT() + (size_t)((g * 2 + 0) * 8 + n) * 16384 + (size_t)j * 128 + q4 * 8;
#pragma unroll
        for (int ks = 0; ks < 4; ++ks) wA[g][ks] = *(const bf16x8*)(gp + ks * 32); }
    {
        const int tg = tid >> 4, sub = tid & 15, ch = n * 128 + sub * 8;
        float w[4][8], acc[2][8];
#pragma unroll
        for (int j = 0; j < 4; ++j) { const f32x4 a = *(const f32x4*)(p.rg_conv_w + j * 1024 + ch), b = *(const f32x4*)(p.rg_conv_w + j * 1024 + ch + 4);
            w[j][0] = a[0]; w[j][1] = a[1]; w[j][2] = a[2]; w[j][3] = a[3]; w[j][4] = b[0]; w[j][5] = b[1]; w[j][6] = b[2]; w[j][7] = b[3]; }
        { const f32x4 a = *(const f32x4*)(p.rg_conv_b + ch), b = *(const f32x4*)(p.rg_conv_b + ch + 4);
#pragma unroll
          for (int i = 0; i < 2; ++i) { acc[i][0] = a[0]; acc[i][1] = a[1]; acc[i][2] = a[2]; acc[i][3] = a[3]; acc[i][4] = b[0]; acc[i][5] = b[1]; acc[i][6] = b[2]; acc[i][7] = b[3]; } }
#pragma unroll
        for (int r = 0; r < 5; ++r) {
            float x[8]; unpack8(rows[r], x);
#pragma unroll
            for (int j = 0; j < 4; ++j) { const int i = r - j; if (i >= 0 && i < 2) {
#pragma unroll
                for (int e = 0; e < 8; ++e) acc[i][e] += w[j][e] * x[e]; } } }
#pragma unroll
        for (int i = 0; i < 2; ++i) { const int c = tg * 2 + i;
            *(LAS u32x4*)(xb + c * 272 + sub * 16) = pack8(acc[i]);
            *(LAS f32x4*)(xf + c * 128 + sub * 8) = (f32x4){acc[i][0], acc[i][1], acc[i][2], acc[i][3]};
            *(LAS f32x4*)(xf + c * 128 + sub * 8 + 4) = (f32x4){acc[i][4], acc[i][5], acc[i][6], acc[i][7]}; }
    }
    lds_barrier();
    f32x4 hs[4];
#pragma unroll
    for (int m = 0; m < 4; ++m) hs[m] = (f32x4){0.f, 0.f, 0.f, 0.f};
#pragma unroll
    for (int d = 0; d < 2; ++d) {
        f32x4 av[4], bxv[4];
        {
            f32x4 ar[4], ai[4];
#pragma unroll
            for (int m = 0; m < 4; ++m) { ar[m] = (f32x4){0.f, 0.f, 0.f, 0.f}; ai[m] = (f32x4){0.f, 0.f, 0.f, 0.f}; }
#pragma unroll
            for (int ks = 0; ks < 4; ++ks) { const bf16x8 br = d == 0 ? wA[0][ks] : wB[0][ks], bi = d == 0 ? wA[1][ks] : wB[1][ks];
#pragma unroll
                for (int m = 0; m < 4; ++m) { const bf16x8 a = ldfrag(xb, 272, m * 16 + l15, ks * 64 + q4 * 16); ar[m] = MFMA16(a, br, ar[m]); ai[m] = MFMA16(a, bi, ai[m]); } }
            if (d == 0) {
#pragma unroll
                for (int g = 0; g < 2; ++g) { const bf16_t* gp = F.GT() + (size_t)((g * 2 + 1) * 8 + n) * 16384 + (size_t)j * 128 + q4 * 8;
#pragma unroll
                    for (int ks = 0; ks < 4; ++ks) wB[g][ks] = *(const bf16x8*)(gp + ks * 32); } }
            const float L2E = 1.4426950408889634f;
            const float br_ = -L2E * p.rg_b_r[d * 1024 + ch], bi_ = -L2E * p.rg_b_i[d * 1024 + ch], sp = softplusf_(-p.rg_lam[d * 1024 + ch]);
            const float k2 = -16.f * sp, k2e = k2 * L2E, k1e = 0.5f * k2e;
#pragma unroll
            for (int m = 0; m < 4; ++m)
#pragma unroll
                for (int r = 0; r < 4; ++r) { const int c = m * 16 + q4 * 4 + r;
                    const float rr = __builtin_amdgcn_rcpf(1.f + __builtin_amdgcn_exp2f(fmaf(ar[m][r], -L2E, br_)));
                    const float ii = __builtin_amdgcn_rcpf(1.f + __builtin_amdgcn_exp2f(fmaf(ai[m][r], -L2E, bi_)));
                    const float t2 = k2 * rr;
                    const float ser = t2 * fmaf(t2, fmaf(t2, 0.16666667f, 0.5f), 1.f);
                    const float a_ = __builtin_amdgcn_exp2f(k1e * rr);
                    const float em = t2 > -0.01f ? ser : fmaf(a_, a_, -1.f);
                    av[m][r] = a_; bxv[m][r] = __builtin_amdgcn_sqrtf(-em) * (ii * xf[c * 128 + j]); }
        }
        f32x4 Pa[4], Pb[4]; float Ap[4], Bp[4], Am[4], Bm[4];
#pragma unroll
        for (int m = 0; m < 4; ++m) {
            float pa, pb;
            if (d == 0) { pa = av[m][0]; pb = bxv[m][0]; Pa[m][0] = pa; Pb[m][0] = pb;
#pragma unroll
                for (int r = 1; r < 4; ++r) { pb = av[m][r] * pb + bxv[m][r]; pa = av[m][r] * pa; Pa[m][r] = pa; Pb[m][r] = pb; } }
            else { pa = av[m][3]; pb = bxv[m][3]; Pa[m][3] = pa; Pb[m][3] = pb;
#pragma unroll
                for (int r = 2; r >= 0; --r) { pb = av[m][r] * pb + bxv[m][r]; pa = av[m][r] * pa; Pa[m][r] = pa; Pb[m][r] = pb; } }
            float Ak[4], Bk[4];
#pragma unroll
            for (int k = 0; k < 4; ++k) { Ak[k] = __shfl(pa, l15 + 16 * k); Bk[k] = __shfl(pb, l15 + 16 * k); }
            float ap = 1.f, bp = 0.f, am = 1.f, bm = 0.f;
#pragma unroll
            for (int kk = 0; kk < 4; ++kk) { const int k = d == 0 ? kk : 3 - kk;
                const bool before = d == 0 ? (k < q4) : (k > q4);
                const float nb = Ak[k] * bp + Bk[k], na = Ak[k] * ap;
                bp = before ? nb : bp; ap = before ? na : ap;
                bm = Ak[k] * bm + Bk[k]; am = Ak[k] * am; }
            Ap[m] = ap; Bp[m] = bp; Am[m] = am; Bm[m] = bm;
        }
        if (PASS == 1) {
            float At = 1.f, Bt = 0.f;
#pragma unroll
            for (int mm = 0; mm < 4; ++mm) { const int m = d == 0 ? mm : 3 - mm; Bt = Am[m] * Bt + Bm[m]; At = Am[m] * At; }
            if (q4 == 0) { float* ag = F.RGAGG() + (size_t)(ci * 2 + d) * 2048; ag[ch] = At; ag[1024 + ch] = Bt; }
        } else {
            float hb = F.CARRY()[(size_t)(ci * 2 + d) * 1024 + ch];
#pragma unroll
            for (int mm = 0; mm < 4; ++mm) { const int m = d == 0 ? mm : 3 - mm;
                const float hin = Ap[m] * hb + Bp[m];
#pragma unroll
                for (int r = 0; r < 4; ++r) hs[m][r] += Pa[m][r] * hin + Pb[m][r];
                hb = Am[m] * hb + Bm[m]; }
            if (!samp && q4 == 0 && ci == (d == 0 ? c_hi - 1 : c_lo)) F.out[OUT_SR + (size_t)(seq * 2 + d) * 1024 + ch] = hb;
        }
    }
    if (PASS == 1 && itn < 1024) rg_load_rows(F, 128 + (itn >> 3), itn & 7, rows);
    if (PASS == 3) {
#pragma unroll
        for (int m = 0; m < 4; ++m)
#pragma unroll
            for (int r = 0; r < 4; ++r) Hs[(m * 16 + q4 * 4 + r) * 128 + j] = hs[m][r];
        lds_barrier();
#pragma unroll
        for (int i = 0; i < 2; ++i) { const int chunk = tid + 512 * i, c = chunk >> 4, cc = chunk & 15;
            const u32x4 gv = *(const u32x4*)(F.PROJ() + (size_t)(t0 + c) * NPROJ + 5120 + n * 128 + cc * 8);
            float g[8]; unpack8(gv, g);
            const f32x4 ha = *(const LAS f32x4*)(Hs + c * 128 + cc * 8), hb2 = *(const LAS f32x4*)(Hs + c * 128 + cc * 8 + 4);
            float o[8];
#pragma unroll
            for (int e = 0; e < 4; ++e) { o[e] = ha[e] * siluf_(g[e]); o[4 + e] = hb2[e] * siluf_(g[4 + e]); }
            *(u32x4*)(F.MIX() + (size_t)(t0 + c) * 2048 + 1024 + n * 128 + cc * 8) = pack8(o); }
    }
    lds_barrier();
}

__device__ __forceinline__ void rg_conv_lds(CParams& p, const Frame& F, int n, const u32x4 (&rows)[5], LAS unsigned char* xb, LAS float* xf) {
    const int tid = F.tid, tg = tid >> 4, sub = tid & 15, ch = n * 128 + sub * 8;
    float w[4][8], acc[2][8];
#pragma unroll
    for (int j = 0; j < 4; ++j) { const f32x4 a = *(const f32x4*)(p.rg_conv_w + j * 1024 + ch), b = *(const f32x4*)(p.rg_conv_w + j * 1024 + ch + 4);
        w[j][0] = a[0]; w[j][1] = a[1]; w[j][2] = a[2]; w[j][3] = a[3]; w[j][4] = b[0]; w[j][5] = b[1]; w[j][6] = b[2]; w[j][7] = b[3]; }
    { const f32x4 a = *(const f32x4*)(p.rg_conv_b + ch), b = *(const f32x4*)(p.rg_conv_b + ch + 4);
#pragma unroll
      for (int i = 0; i < 2; ++i) { acc[i][0] = a[0]; acc[i][1] = a[1]; acc[i][2] = a[2]; acc[i][3] = a[3]; acc[i][4] = b[0]; acc[i][5] = b[1]; acc[i][6] = b[2]; acc[i][7] = b[3]; } }
#pragma unroll
    for (int r = 0; r < 5; ++r) { float x[8]; unpack8(rows[r], x);
#pragma unroll
        for (int j = 0; j < 4; ++j) { const int i = r - j; if (i >= 0 && i < 2) {
#pragma unroll
            for (int e = 0; e < 8; ++e) acc[i][e] += w[j][e] * x[e]; } } }
#pragma unroll
    for (int i = 0; i < 2; ++i) { const int c = tg * 2 + i;
        *(LAS u32x4*)(xb + c * 272 + sub * 16) = pack8(acc[i]);
        *(LAS f32x4*)(xf + c * 128 + sub * 8) = (f32x4){acc[i][0], acc[i][1], acc[i][2], acc[i][3]};
        *(LAS f32x4*)(xf + c * 128 + sub * 8 + 4) = (f32x4){acc[i][4], acc[i][5], acc[i][6], acc[i][7]}; }
}
template <int D>
__device__ __forceinline__ void rg_gate_scan(const Frame& F, const bf16x8 (&wg)[2][4], float br_, float bi_, float sp, const LAS unsigned char* xb, const LAS float* xf, int j,
                                             f32x4 (&Pa)[4], f32x4 (&Pb)[4], float (&Ap)[4], float (&Bp)[4], float (&Am)[4], float (&Bm)[4]) {
    const int lane = F.lane, q4 = lane >> 4, l15 = lane & 15;
    f32x4 av[4], bxv[4];
    {
        f32x4 ar[4], ai[4];
#pragma unroll
        for (int m = 0; m < 4; ++m) { ar[m] = (f32x4){0.f, 0.f, 0.f, 0.f}; ai[m] = (f32x4){0.f, 0.f, 0.f, 0.f}; }
#pragma unroll
        for (int ks = 0; ks < 4; ++ks) {
#pragma unroll
            for (int m = 0; m < 4; ++m) { const bf16x8 a = ldfrag(xb, 272, m * 16 + l15, ks * 64 + q4 * 16); ar[m] = MFMA16(a, wg[0][ks], ar[m]); ai[m] = MFMA16(a, wg[1][ks], ai[m]); } }
        const float L2E = 1.4426950408889634f;
        const float brs = -L2E * br_, bis = -L2E * bi_, k2 = -16.f * sp, k1e = 0.5f * k2 * L2E;
#pragma unroll
        for (int m = 0; m < 4; ++m)
#pragma unroll
            for (int r = 0; r < 4; ++r) { const int c = m * 16 + q4 * 4 + r;
                const float rr = __builtin_amdgcn_rcpf(1.f + __builtin_amdgcn_exp2f(fmaf(ar[m][r], -L2E, brs)));
                const float ii = __builtin_amdgcn_rcpf(1.f + __builtin_amdgcn_exp2f(fmaf(ai[m][r], -L2E, bis)));
                const float t2 = k2 * rr, a = __builtin_amdgcn_exp2f(k1e * rr);
                const float ser = t2 * fmaf(t2, fmaf(t2, 0.16666667f, 0.5f), 1.f);
                const float em = t2 > -0.01f ? ser : fmaf(a, a, -1.f);
                av[m][r] = a; bxv[m][r] = __builtin_amdgcn_sqrtf(-em) * (ii * xf[c * 128 + j]); }
    }
#pragma unroll
    for (int m = 0; m < 4; ++m) {
        float pa, pb;
        if (D == 0) { pa = av[m][0]; pb = bxv[m][0]; Pa[m][0] = pa; Pb[m][0] = pb;
#pragma unroll
            for (int r = 1; r < 4; ++r) { pb = av[m][r] * pb + bxv[m][r]; pa = av[m][r] * pa; Pa[m][r] = pa; Pb[m][r] = pb; } }
        else { pa = av[m][3]; pb = bxv[m][3]; Pa[m][3] = pa; Pb[m][3] = pb;
#pragma unroll
            for (int r = 2; r >= 0; --r) { pb = av[m][r] * pb + bxv[m][r]; pa = av[m][r] * pa; Pa[m][r] = pa; Pb[m][r] = pb; } }
        float Ak[4], Bk[4];
#pragma unroll
        for (int k = 0; k < 4; ++k) { Ak[k] = __shfl(pa, l15 + 16 * k); Bk[k] = __shfl(pb, l15 + 16 * k); }
        float ap = 1.f, bp = 0.f, am = 1.f, bm = 0.f;
#pragma unroll
        for (int kk = 0; kk < 4; ++kk) { const int k = D == 0 ? kk : 3 - kk;
            const bool before = D == 0 ? (k < q4) : (k > q4);
            const float nb = Ak[k] * bp + Bk[k], na = Ak[k] * ap;
            bp = before ? nb : bp; ap = before ? na : ap;
            bm = Ak[k] * bm + Bk[k]; am = Ak[k] * am; }
        Ap[m] = ap; Bp[m] = bp; Am[m] = am; Bm[m] = bm;
    }
}
template <int D>
__device__ __forceinline__ void rg_prompt_dir(CParams& p, Frame& F, int seq, int n) {
    const int tid = F.tid, lane = F.lane, wave = F.wave, q4 = lane >> 4, l15 = lane & 15;
    LAS unsigned char* xb = F.lds; LAS float* xf = (LAS float*)(F.lds + 17408); LAS float* Hs = (LAS float*)(F.lds + 50176); LAS bf16_t* Hf = (LAS bf16_t*)(F.lds + 82944);
    const int j = wave * 16 + l15, ch = n * 128 + j;
    bf16x8 wg[2][4];
#pragma unroll
    for (int g = 0; g < 2; ++g) { const bf16_t* gp = F.GT() + (size_t)((g * 2 + D) * 8 + n) * 16384 + (size_t)j * 128 + q4 * 8;
#pragma unroll
        for (int ks = 0; ks < 4; ++ks) wg[g][ks] = *(const bf16x8*)(gp + ks * 32); }
    const float br_ = p.rg_b_r[D * 1024 + ch], bi_ = p.rg_b_i[D * 1024 + ch], sp = softplusf_(-p.rg_lam[D * 1024 + ch]);
    float hb = 0.f;
    u32x4 rows[5];
    rg_load_rows(F, seq * 4 + (D == 0 ? 0 : 3), n, rows);
#pragma unroll 1
    for (int cs = 0; cs < 4; ++cs) {
        const int cidx = D == 0 ? cs : 3 - cs, ci = seq * 4 + cidx, t0 = ci * 64;
        rg_conv_lds(p, F, n, rows, xb, xf);
        if (cs < 3) rg_load_rows(F, seq * 4 + (D == 0 ? cidx + 1 : cidx - 1), n, rows);
        lds_barrier();
        f32x4 Pa[4], Pb[4]; float Ap[4], Bp[4], Am[4], Bm[4];
        rg_gate_scan<D>(F, wg, br_, bi_, sp, xb, xf, j, Pa, Pb, Ap, Bp, Am, Bm);
#pragma unroll
        for (int mm = 0; mm < 4; ++mm) { const int m = D == 0 ? mm : 3 - mm;
            const float hin = Ap[m] * hb + Bp[m];
#pragma unroll
            for (int r = 0; r < 4; ++r) { const float hv = Pa[m][r] * hin + Pb[m][r]; const int tl = m * 16 + q4 * 4 + r;
                if (D == 0) Hf[(cidx * 64 + tl) * 128 + j] = f2bf(hv);
                else Hs[tl * 128 + j] = hv + bf2f(Hf[(cidx * 64 + tl) * 128 + j]); }
            hb = Am[m] * hb + Bm[m]; }
        lds_barrier();
        if (D == 1) {
#pragma unroll
            for (int i = 0; i < 2; ++i) { const int chunk = tid + 512 * i, c = chunk >> 4, cc = chunk & 15;
                bf16_t* gp = F.PROJ() + (size_t)(t0 + c) * NPROJ + 5120 + n * 128 + cc * 8;
                const u32x4 gv = *(const u32x4*)gp; float g[8]; unpack8(gv, g);
                const f32x4 ha = *(const LAS f32x4*)(Hs + c * 128 + cc * 8), hb2 = *(const LAS f32x4*)(Hs + c * 128 + cc * 8 + 4);
                float o[8];
#pragma unroll
                for (int e = 0; e < 4; ++e) { o[e] = ha[e] * siluf_(g[e]); o[4 + e] = hb2[e] * siluf_(g[4 + e]); }
                *(u32x4*)gp = pack8(o); }
            lds_barrier();
        }
    }
    if (q4 == 0) F.out[OUT_SR + (size_t)(seq * 2 + D) * 1024 + ch] = hb;
}

__device__ __forceinline__ void rg_carry_scan(CParams& p, Frame& F) {
    const int tid = F.tid;
    int samp, seq, d, ch;
    if (tid < 256) return;
    else if (tid < 272) { const int g = F.b * 16 + tid - 256; if (g >= 4096) return; samp = 1; seq = g >> 11; d = (g >> 10) & 1; ch = g & 1023; }
    else return;
    const int nch = samp ? 64 : 4, c_lo = samp ? 128 + seq * 64 : seq * 4;
    float h = samp ? p.state_rglru[(size_t)(seq * 2 + d) * 1024 + ch] : 0.f;
    for (int i0 = 0; i0 < nch; i0 += 4) {
        float A[4], B[4];
#pragma unroll
        for (int u = 0; u < 4; ++u) { const int cc = d == 0 ? c_lo + i0 + u : c_lo + nch - 1 - i0 - u; const float* ag = F.RGAGG() + (size_t)(cc * 2 + d) * 2048; A[u] = ag[ch]; B[u] = ag[1024 + ch]; }
#pragma unroll
        for (int u = 0; u < 4; ++u) { const int cc = d == 0 ? c_lo + i0 + u : c_lo + nch - 1 - i0 - u; F.CARRY()[(size_t)(cc * 2 + d) * 1024 + ch] = h; h = A[u] * h + B[u]; }
    }
}

__device__ __forceinline__ void phase3(CParams& p, Frame& F) {
    for (int rep = 0; rep < (REP_PHASE == 30 ? 2 : 1); ++rep)
    for (int it = F.b; it < 2048; it += F.G) { u32x4 rows[7]; p3_load_rows(F, it >> 3, it & 7, rows); p3_delta_item(p, F, it >> 3, it & 7, rows, it + F.G); }
    for (int rep = 0; rep < (REP_PHASE == 31 ? 2 : 1); ++rep) {
    u32x4 rows[5]; if (F.b < 1024) rg_load_rows(F, 128 + (F.b >> 3), F.b & 7, rows);
    for (int it = F.b; it < 1024; it += F.G) rg_item<1>(p, F, 128 + (it >> 3), it & 7, rows, it + F.G); }
    for (int it = F.b; it < 256; it += F.G) { rg_prompt_dir<0>(p, F, it >> 3, it & 7); rg_prompt_dir<1>(p, F, it >> 3, it & 7); }
}

struct P4D { int valid, samp, seq, h, d, sl, ci, seq_lo, seq_hi, last, k, s, nch; };
__device__ __forceinline__ P4D p4_desc(const Frame& F, int k, int s) {
    P4D D; int item;
    if (F.G == 256) {
        const int x = F.b & 7, y = F.b >> 3;
        if (y < 16) { item = (x * 4 + (y >> 2)) * 4 + (y & 3); D.valid = k < 1; }
        else { const int j = y - 16; item = 128 + (x * 64 + (j >> 2) * 16 + k) * 4 + (j & 3); D.valid = k < 16; } }
    else { item = F.b + k * F.G; D.valid = item < 2176; }
    D.samp = item < 128; const int it = D.samp ? item : item - 128, chain = it >> 2;
    D.sl = it & 3; D.seq = chain >> 4; D.h = (chain >> 1) & 7; D.d = chain & 1;
    D.nch = D.samp ? 64 : 4; const int chunk0 = D.samp ? 128 + D.seq * 64 : D.seq * 4;
    D.seq_lo = chunk0 * 64; D.seq_hi = D.seq_lo + D.nch * 64;
    D.ci = D.d == 0 ? chunk0 + s : chunk0 + D.nch - 1 - s; D.last = s == D.nch - 1; D.k = k; D.s = s;
    return D;
}
__device__ __forceinline__ P4D p4_next(const Frame& F, const P4D& D) {
    if (D.s + 1 < D.nch) { P4D N = D; N.s = D.s + 1; N.ci = D.ci + (D.d == 0 ? 1 : -1); N.last = N.s == D.nch - 1; return N; }
    return p4_desc(F, D.k + 1, 0);
}
struct P4Pre { u32x4 k0, k1, q0, q1, ti, at; u32x2 v[4]; float g, b, bc; };
struct P4T { unsigned oKQ, oTA, oV, oG, oGc; int cj; };
__device__ __forceinline__ P4T p4_thread_consts(int tid) {
    P4T T; T.oKQ = (unsigned)(((tid >> 4) * 1024 + (tid & 15) * 8) * 2); T.oTA = (unsigned)tid * 16u;
    T.oV = (unsigned)(((tid >> 3) * NPROJ + (tid & 7) * 4) * 2); T.oG = (unsigned)(tid & 63) * 4u; T.oGc = (unsigned)(tid >> 3) * 4u; T.cj = (tid >> 3) - 2; return T;
}
__device__ __forceinline__ void p4_prefetch(CParams& p, const Frame& F, P4Pre& R, const P4D& D, const P4T& T) {
    const int tid = F.tid, t0 = D.ci * 64, h = D.h;
    const char* kb = (const char*)F.Kc() + ((size_t)t0 * 1024 + h * 128) * 2;
    const char* qb = (const char*)F.Qc() + ((size_t)t0 * 1024 + h * 128) * 2;
    const char* tb = (const char*)F.TA() + (size_t)(D.ci * 8 + h) * 16384;
    const char* vb = (const char*)F.PROJ() + ((long)(t0 - 2) * NPROJ + 2048 + h * 128 + D.sl * 32) * 2;
    const char* gb = (const char*)F.GB() + (size_t)(D.ci * 8 + h) * 1024 + D.d * 256;
    R.k0 = *(const u32x4*)(kb + T.oKQ); R.k1 = *(const u32x4*)(kb + T.oKQ + 65536u);
    R.q0 = *(const u32x4*)(qb + T.oKQ); R.q1 = *(const u32x4*)(qb + T.oKQ + 65536u);
    R.ti = *(const u32x4*)(tb + T.oTA); R.at = *(const u32x4*)(tb + T.oTA + 8192u);
#pragma unroll
    for (int j = 0; j < 4; ++j) { const int tok = t0 + T.cj + j; u32x2 v = {0u, 0u};
        if (tok >= D.seq_lo && tok < D.seq_hi) v = *(const u32x2*)(vb + T.oV + (unsigned)(j * NPROJ * 2));
        R.v[j] = v; }
    R.bc = *(const float*)(gb + 512 + T.oGc);
    R.g = 0.f; R.b = 0.f;
    if (tid < 64) { R.g = *(const float*)(gb + T.oG); R.b = *(const float*)(gb + 512 + T.oG); }
}
__device__ __forceinline__ u32x4 tri_mask(u32x4 v, int c, int s0, int d) {
    unsigned w[4] = {v.x, v.y, v.z, v.w};
#pragma unroll
    for (int i = 0; i < 4; ++i) { const int slo = s0 + 2 * i, shi = slo + 1;
        const bool klo = d == 0 ? (c >= slo) : (c <= slo), khi = d == 0 ? (c >= shi) : (c <= shi);
        w[i] &= (klo ? 0x0000FFFFu : 0u) | (khi ? 0xFFFF0000u : 0u); }
    return (u32x4){w[0], w[1], w[2], w[3]};
}
constexpr int P4_KS = 0, P4_TI = 17408, P4_VBT = 26624, P4_WL = 31232, P4_SB = 48640, P4_VT1 = 57344, P4_VT2 = 61952, P4_QS = 66560, P4_AT = 101376, P4_GV = 119808;
__device__ __forceinline__ void p4_stage(CParams& p, const Frame& F, const P4Pre& R, const P4D& D, int buf, const unsigned (&mk)[2][4], f32x4 (&cw)[4], const f32x4 (&cwn)[4]) {
    const int tid = F.tid, d = D.d;
    LAS unsigned char* Ks = F.lds + P4_KS; LAS unsigned char* Qs = F.lds + P4_QS + buf * 17408; LAS unsigned char* TIs = F.lds + P4_TI;
    LAS unsigned char* ATs = F.lds + P4_AT + buf * 9216; LAS unsigned char* Vbt = F.lds + P4_VBT; LAS float* gv = (LAS float*)(F.lds + P4_GV + buf * 1280);
    { const int row = tid >> 4, cc = tid & 15;
      *(LAS u32x4*)(Ks + row * 272 + cc * 16) = R.k0; *(LAS u32x4*)(Ks + (32 + row) * 272 + cc * 16) = R.k1;
      *(LAS u32x4*)(Qs + row * 272 + cc * 16) = R.q0; *(LAS u32x4*)(Qs + (32 + row) * 272 + cc * 16) = R.q1; }
    { const int c = tid >> 3, s0 = (tid & 7) * 8;
      const unsigned m0 = d ? mk[1][0] : mk[0][0], m1 = d ? mk[1][1] : mk[0][1], m2 = d ? mk[1][2] : mk[0][2], m3 = d ? mk[1][3] : mk[0][3];
      *(LAS u32x4*)(TIs + c * 144 + s0 * 2) = (u32x4){R.ti.x & m0, R.ti.y & m1, R.ti.z & m2, R.ti.w & m3};
      *(LAS u32x4*)(ATs + c * 144 + s0 * 2) = (u32x4){R.at.x & m0, R.at.y & m1, R.at.z & m2, R.at.w & m3}; }
    { const int c = tid >> 3, e0 = (tid & 7) * 4; float o[4] = {0.f, 0.f, 0.f, 0.f};
      if (D.s == 0) {
#pragma unroll
          for (int j = 0; j < 4; ++j) cw[j] = cwn[j]; }
#pragma unroll
      for (int j = 0; j < 4; ++j) { const u32x2 v = R.v[j];
          o[0] += cw[j][0] * __uint_as_float(v.x << 16); o[1] += cw[j][1] * __uint_as_float(v.x & 0xffff0000u);
          o[2] += cw[j][2] * __uint_as_float(v.y << 16); o[3] += cw[j][3] * __uint_as_float(v.y & 0xffff0000u); }
#pragma unroll
      for (int i = 0; i < 4; ++i) ((LAS bf16_t*)Vbt)[(e0 + i) * 72 + c] = f2bf(siluf_(o[i]) * R.bc); }
    if (tid < 64) {
        const float glast = __shfl(R.g, d == 0 ? 63 : 0), eg = __expf(R.g);
        gv[tid] = eg; gv[64 + tid] = R.b * eg; gv[128 + tid] = __expf(glast - R.g); if (tid == 0) gv[192] = __expf(glast);
    }
}
__device__ __forceinline__ void phase4_chains(CParams& p, Frame& F) {
    const int tid = F.tid, lane = F.lane, wave = F.wave, q4 = lane >> 4, l15 = lane & 15;
    LAS unsigned char* Ks = F.lds + P4_KS; LAS unsigned char* TIs = F.lds + P4_TI; LAS unsigned char* Vbt = F.lds + P4_VBT; LAS unsigned char* Wl = F.lds + P4_WL;
    LAS unsigned char* Sb = F.lds + P4_SB; LAS unsigned char* Vt1 = F.lds + P4_VT1; LAS unsigned char* Vt2 = F.lds + P4_VT2;
    const int ct = wave & 3, et = wave >> 2;
    P4D Dc = p4_desc(F, 0, 0);
    if (!Dc.valid) return;
    P4Pre RA, RB;
    f32x4 S[2], U; bf16x8 KT[2];
    unsigned mk[2][4]; f32x4 cw[4], cwn[4];
    { const int c = tid >> 3, s0 = (tid & 7) * 8;
#pragma unroll
      for (int i = 0; i < 4; ++i) { const int slo = s0 + 2 * i, shi = slo + 1;
          mk[0][i] = (c >= slo ? 0x0000FFFFu : 0u) | (c >= shi ? 0xFFFF0000u : 0u); mk[1][i] = (c <= slo ? 0x0000FFFFu : 0u) | (c <= shi ? 0xFFFF0000u : 0u); } }
#define P4_INIT_S(D) do { _Pragma("unroll") for (int nt = 0; nt < 2; ++nt) _Pragma("unroll") for (int r = 0; r < 4; ++r) \
        S[nt][r] = (D).samp ? p.state_delta[(size_t)(((D).seq * 2 + (D).d) * 8 + (D).h) * 16384 + (size_t)(wave * 16 + q4 * 4 + r) * 128 + (D).sl * 32 + nt * 16 + l15] : 0.f; } while (0)
#define P4_WRITE_SB() do { _Pragma("unroll") for (int nt = 0; nt < 2; ++nt) { u32x2 o_; o_.x = pk2(S[nt][0], S[nt][1]); o_.y = pk2(S[nt][2], S[nt][3]); \
        *(LAS u32x2*)(Sb + (nt * 16 + l15) * 272 + (wave * 16 + q4 * 4) * 2) = o_; } } while (0)
#define P4_PRECOMP(buf_) do { const LAS float* gv_ = (const LAS float*)(F.lds + P4_GV + (buf_) * 1280); \
        f32x4 WT[4]; _Pragma("unroll") for (int c_ = 0; c_ < 4; ++c_) WT[c_] = (f32x4){0.f, 0.f, 0.f, 0.f}; \
        _Pragma("unroll") for (int ks = 0; ks < 2; ++ks) { bf16x8 akg; \
            _Pragma("unroll") for (int j = 0; j < 8; ++j) { const int c_ = ks * 32 + q4 * 8 + j; const unsigned short kr = *(const LAS unsigned short*)(Ks + c_ * 272 + (wave * 16 + l15) * 2); \
                KT[ks][j] = (short)kr; akg[j] = (short)f2bf(bf2f(kr) * gv_[64 + c_]); } \
            _Pragma("unroll") for (int c_ = 0; c_ < 4; ++c_) { const bf16x8 bt = ldfrag(TIs, 144, c_ * 16 + l15, ks * 64 + q4 * 16); WT[c_] = MFMA16(akg, bt, WT[c_]); } } \
        _Pragma("unroll") for (int c_ = 0; c_ < 4; ++c_) { u32x2 o_; o_.x = pk2(WT[c_][0], WT[c_][1]); o_.y = pk2(WT[c_][2], WT[c_][3]); \
            *(LAS u32x2*)(Wl + (c_ * 16 + l15) * 272 + (wave * 16 + q4 * 4) * 2) = o_; } \
        U = (f32x4){0.f, 0.f, 0.f, 0.f}; \
        _Pragma("unroll") for (int ks = 0; ks < 2; ++ks) { const bf16x8 a_ = ldfrag(TIs, 144, ct * 16 + l15, ks * 64 + q4 * 16), b_ = ldfrag(Vbt, 144, et * 16 + l15, ks * 64 + q4 * 16); U = MFMA16(a_, b_, U); } } while (0)

    const P4T T = p4_thread_consts(tid);
    p4_prefetch(p, F, RA, Dc, T);
    P4_INIT_S(Dc);
    { const int e0 = (tid & 7) * 4;
#pragma unroll
      for (int j = 0; j < 4; ++j) cwn[j] = *(const f32x4*)(p.dn_conv_w + j * 3072 + 2048 + Dc.h * 128 + Dc.sl * 32 + e0); }
    p4_stage(p, F, RA, Dc, 0, mk, cw, cwn);
    P4_WRITE_SB();
    P4D Dn = p4_next(F, Dc);
    if (Dn.valid) p4_prefetch(p, F, RA, Dn, T);
    P4D Dnn = Dn; if (Dn.valid) { Dnn = p4_next(F, Dn); if (Dnn.valid) p4_prefetch(p, F, RB, Dnn, T); }
    lds_barrier();
    P4_PRECOMP(0);
    lds_barrier();
    int buf = 0;
#define P4_BODY(RX) { \
        const LAS float* gv = (const LAS float*)(F.lds + P4_GV + buf * 1280); \
        const LAS unsigned char* Qs = F.lds + P4_QS + buf * 17408; const LAS unsigned char* ATs = F.lds + P4_AT + buf * 9216; \
        const int c0 = ct * 16 + q4 * 4, e = et * 16 + l15; \
         \
        f32x4 p1 = {0.f, 0.f, 0.f, 0.f}, oacc = {0.f, 0.f, 0.f, 0.f}; \
_Pragma("unroll") \
        for (int ks = 0; ks < 4; ++ks) { const bf16x8 bs = ldfrag(Sb, 272, et * 16 + l15, ks * 64 + q4 * 16); \
            const bf16x8 aw = ldfrag(Wl, 272, ct * 16 + l15, ks * 64 + q4 * 16), aq = ldfrag(Qs, 272, ct * 16 + l15, ks * 64 + q4 * 16); \
            p1 = MFMA16(aw, bs, p1); oacc = MFMA16(aq, bs, oacc); } \
        { float vn[4]; \
_Pragma("unroll") \
          for (int r = 0; r < 4; ++r) vn[r] = U[r] - p1[r]; \
          u32x2 o1, o2; o1.x = pk2(vn[0], vn[1]); o1.y = pk2(vn[2], vn[3]); \
          o2.x = pk2(vn[0] * gv[128 + c0], vn[1] * gv[128 + c0 + 1]); o2.y = pk2(vn[2] * gv[128 + c0 + 2], vn[3] * gv[128 + c0 + 3]); \
          *(LAS u32x2*)(Vt1 + e * 144 + c0 * 2) = o1; *(LAS u32x2*)(Vt2 + e * 144 + c0 * 2) = o2; } \
_Pragma("unroll") \
        for (int r = 0; r < 4; ++r) oacc[r] *= gv[c0 + r]; \
        P4D D3 = Dnn; \
        if (Dn.valid) { p4_stage(p, F, RX, Dn, buf ^ 1, mk, cw, cwn); \
            if (Dn.last && Dnn.valid) { const int e0_ = (tid & 7) * 4; _Pragma("unroll") for (int j = 0; j < 4; ++j) cwn[j] = *(const f32x4*)(p.dn_conv_w + j * 3072 + 2048 + Dnn.h * 128 + Dnn.sl * 32 + e0_); } if (Dnn.valid) { D3 = p4_next(F, Dnn); if (D3.valid) p4_prefetch(p, F, RX, D3, T); } } \
        lds_barrier(); \
         \
        { const float gl = gv[192]; \
_Pragma("unroll") \
          for (int nt = 0; nt < 2; ++nt) S[nt] *= gl; \
_Pragma("unroll") \
          for (int ks = 0; ks < 2; ++ks) \
_Pragma("unroll") \
              for (int nt = 0; nt < 2; ++nt) { const bf16x8 b_ = ldfrag(Vt2, 144, nt * 16 + l15, ks * 64 + q4 * 16); S[nt] = MFMA16(KT[ks], b_, S[nt]); } } \
_Pragma("unroll") \
        for (int ks = 0; ks < 2; ++ks) { const bf16x8 a_ = ldfrag(ATs, 144, ct * 16 + l15, ks * 64 + q4 * 16), b_ = ldfrag(Vt1, 144, et * 16 + l15, ks * 64 + q4 * 16); oacc = MFMA16(a_, b_, oacc); } \
_Pragma("unroll") \
        for (int r = 0; r < 4; ++r) *(bf16_t*)((char*)F.PROJ() + ((size_t)Dc.ci * 64 * NPROJ + Dc.d * 1024 + Dc.h * 128 + Dc.sl * 32) * 2 + (unsigned)(((c0 + r) * NPROJ + e) * 2)) = f2bf(oacc[r]); \
        if (Dc.last) { \
            if (!Dc.samp) { \
_Pragma("unroll") \
                for (int nt = 0; nt < 2; ++nt) \
_Pragma("unroll") \
                    for (int r = 0; r < 4; ++r) \
                        F.out[OUT_SD + (size_t)((Dc.seq * 2 + Dc.d) * 8 + Dc.h) * 16384 + (size_t)(wave * 16 + q4 * 4 + r) * 128 + Dc.sl * 32 + nt * 16 + l15] = S[nt][r]; \
            } \
            if (Dn.valid) P4_INIT_S(Dn); \
        } \
        P4_WRITE_SB(); \
        if (Dn.valid) P4_PRECOMP(buf ^ 1); \
        lds_barrier(); \
        if (!Dn.valid) break; \
        Dc = Dn; Dn = Dnn; Dnn = D3; buf ^= 1; \
    }
#pragma unroll 1
    for (;;) { P4_BODY(RA) P4_BODY(RB) }
#undef P4_BODY
#undef P4_INIT_S
#undef P4_WRITE_SB
#undef P4_PRECOMP
}
__device__ __forceinline__ void phase4(CParams& p, Frame& F) {
    if (F.G == 256) rg_carry_scan(p, F);
    else if (F.b == 0) {
        for (int g = F.tid; g < 69632; g += 512) { int samp = g >= 65536, gg = samp ? g - 65536 : g, seq = gg >> 11, d = (gg >> 10) & 1, ch = gg & 1023;
            const int nch = samp ? 64 : 4, c_lo = samp ? 128 + seq * 64 : seq * 4; float h = samp ? p.state_rglru[(size_t)(seq * 2 + d) * 1024 + ch] : 0.f;
            for (int i = 0; i < nch; ++i) { const int cc = d == 0 ? c_lo + i : c_lo + nch - 1 - i; const float* ag = F.RGAGG() + (size_t)(cc * 2 + d) * 2048; F.CARRY()[(size_t)(cc * 2 + d) * 1024 + ch] = h; h = ag[ch] * h + ag[1024 + ch]; } } }
    __syncthreads();
    phase4_chains(p, F);
}

__device__ __forceinline__ void phase5(CParams& p, Frame& F) {
    const int lane = F.lane;
    float nw[16];
#pragma unroll
    for (int q = 0; q < 4; ++q) { const f32x4 a = *(const f32x4*)(p.dn_norm_w + (lane & 7) * 16 + q * 4); nw[q * 4] = a[0]; nw[q * 4 + 1] = a[1]; nw[q * 4 + 2] = a[2]; nw[q * 4 + 3] = a[3]; }
#pragma unroll 4
    for (int tok = F.b * 8 + F.wave; tok < NTOK; tok += F.G * 8) {
        const bf16_t* pr = F.PROJ() + (size_t)tok * NPROJ + lane * 16;
        float o[16], z[16]; float ss = 0.f;
#pragma unroll
        for (int hf = 0; hf < 2; ++hf) { const u32x4 a = *(const u32x4*)(pr + hf * 8), b = *(const u32x4*)(pr + 1024 + hf * 8), zz = *(const u32x4*)(pr + 3072 + hf * 8);
            float fa[8], fb[8], fz[8]; unpack8(a, fa); unpack8(b, fb); unpack8(zz, fz);
#pragma unroll
            for (int e = 0; e < 8; ++e) { o[hf * 8 + e] = fa[e] + fb[e]; z[hf * 8 + e] = fz[e]; ss += o[hf * 8 + e] * o[hf * 8 + e]; } }
        ss += __shfl_xor(ss, 1); ss += __shfl_xor(ss, 2); ss += __shfl_xor(ss, 4);
        const float rs = rsqrtf(ss * (1.f / 128.f) + 1e-6f);
#pragma unroll
        for (int hf = 0; hf < 2; ++hf) { float w[8];
#pragma unroll
            for (int e = 0; e < 8; ++e) w[e] = o[hf * 8 + e] * rs * nw[hf * 8 + e] * siluf_(z[hf * 8 + e]);
            *(u32x4*)(F.MIX() + (size_t)tok * 2048 + lane * 16 + hf * 8) = pack8(w); }
        if (tok < 8192) {
            const u32x4 y0 = *(const u32x4*)(pr + 5120), y1 = *(const u32x4*)(pr + 5120 + 8);
            *(u32x4*)(F.MIX() + (size_t)tok * 2048 + 1024 + lane * 16) = y0; *(u32x4*)(F.MIX() + (size_t)tok * 2048 + 1024 + lane * 16 + 8) = y1; }
    }
    __syncthreads();
    for (int it = F.b; it < 1024; it += F.G) { u32x4 rows[5]; rg_load_rows(F, 128 + (it >> 3), it & 7, rows); rg_item<3>(p, F, 128 + (it >> 3), it & 7, rows, it + F.G); }
}

__device__ __forceinline__ void phase6(CParams& p, Frame& F) {
    pg8::Gemm g{F.MIX(), F.WoutT(), NTOK, 1024, 2048}; pg8::StaticOrder S; S.init(NTOK, 1024, F.G, F.b); pg8::EpiF32 E{(float*)F.PROJ(), 3072};
    pg8::gemm_phase<pg8::EpiF32, pg8::StaticOrder>(F.lds, g, S, E);
}

__device__ __forceinline__ void phase7(CParams& p, Frame& F) {
    LAS float* gt = (LAS float*)F.lds;
    for (int tb = F.b; tb < 256; tb += F.G) {
        const int grp = grp_of_block(tb);
        for (int j = F.tid; j < 1024; j += 512) gt[j] = mod_val(p, F, grp, 2048 + j) * p.post_w[j];
        __syncthreads();
#pragma unroll 2
        for (int i = 0; i < 8; ++i) {
            const int tok = tb * 64 + F.wave * 8 + i;
            const float* xr = tok < 8192 ? p.x_prompt + (size_t)tok * 1024 : p.x_sample + (size_t)(tok - 8192) * 1024;
            const float* yr = (const float*)F.PROJ() + (size_t)tok * 3072;
            f32x4 y[4]; float ss = 0.f;
#pragma unroll
            for (int q = 0; q < 4; ++q) { y[q] = *(const f32x4*)(yr + F.lane * 4 + 256 * q); ss += (y[q][0] * y[q][0] + y[q][1] * y[q][1]) + (y[q][2] * y[q][2] + y[q][3] * y[q][3]); }
            const float rstd = rsqrtf(wave_sum(ss) * (1.f / 1024.f) + 1e-6f);
#pragma unroll
            for (int q = 0; q < 4; ++q) { const int j = F.lane * 4 + 256 * q; f32x4 v = *(const f32x4*)(xr + j);
                if (tok >= 8192) { const int pp = (tok - 8192) & 4095; const int vv = (q < 2) ? (pp >> 6) : (pp & 63);
                    v += *(const f32x4*)(F.pe() + ((q & 1) ? 16384 : 0) + vv * 256 + F.lane * 4); }
                const f32x4 g4 = *(const LAS f32x4*)(gt + j);
                f32x4 ov = v + g4 * (y[q] * rstd); ov[0] = fin(ov[0]); ov[1] = fin(ov[1]); ov[2] = fin(ov[2]); ov[3] = fin(ov[3]); if (!(LIVE_MASK & 1)) ov = (f32x4){0.f, 0.f, 0.f, 0.f}; *(f32x4*)(F.out + (size_t)tok * 1024 + j) = ov; }
        }
        __syncthreads();
    }
}

__device__ __forceinline__ void phase8(CParams& p, Frame& F) {
    if (F.b == 0 && F.tid == 0) { int code = 0; for (int k = 31; k >= 1; --k) if (DG(F)[k]) code = k; F.out[OUT_SR] = 1000.f * (float)code + 500.f; }
}
extern __shared__ __attribute__((aligned(16))) unsigned char smem_raw[];
__global__ void __launch_bounds__(512) fwd_megakernel(Params p_unused) {
    CParams& p = *(CParams*)__builtin_amdgcn_kernarg_segment_ptr();
    Frame F;
    F.lds = (LAS unsigned char*)smem_raw;
    F.tid = threadIdx.x; F.lane = F.tid & 63; F.wave = __builtin_amdgcn_readfirstlane(F.tid >> 6); F.G = gridDim.x; F.b = blockIdx.x;
    F.out = p.out; F.ws = p.ws;
    volatile LAS unsigned* xbw = (volatile LAS unsigned*)(F.lds + LDS_BYTES - 16);
    const bool multi = (p.ph_hi - p.ph_lo) > 1;
    XcdBarrier xb; xb.bar = (unsigned*)(p.ws + WS_CTL); xb.x = 0; xb.st = xbw;
    if (multi) {
        if (F.tid == 0) { xbw[0] = 0u; xbw[1] = 0u; xbw[2] = 0u; xbw[3] = 0u; }
        __syncthreads();
        xb = xcd_barrier_post((unsigned*)(p.ws + WS_CTL), xbw);
    }
#ifndef PHMASK
#define PHMASK 511
#endif
    const int lo = p.ph_lo, hi = p.ph_hi;
#ifndef REP_PHASE
#define REP_PHASE -1
#endif
#define RUN_PHASE(k, fn) do { if (lo <= (k) && (k) < hi) { if (PHMASK & (1 << (k))) fn(p, F); if ((k) == REP_PHASE) { __syncthreads(); fn(p, F); } if ((k) + 1 < hi) xcd_barrier(xb); } } while (0)
    RUN_PHASE(0, phase0); RUN_PHASE(1, phase1); RUN_PHASE(2, phase2); RUN_PHASE(3, phase3);
    RUN_PHASE(4, phase4); RUN_PHASE(5, phase5); RUN_PHASE(6, phase6); RUN_PHASE(7, phase7); RUN_PHASE(8, phase8);
}

extern "C" void kernel_launch(void* const* d_in, const int* in_sizes, int n_in, void* d_out, int out_size, void* d_ws, size_t ws_size, hipStream_t stream) {
    static int grid = 0;
    if (grid == 0) {
        int dev = 0, cus = 0;
        if (hipGetDevice(&dev) != hipSuccess || hipDeviceGetAttribute(&cus, hipDeviceAttributeMultiprocessorCount, dev) != hipSuccess) { fprintf(stderr, "kernel_launch: device query failed\n"); grid = -1; return; }
        if (hipFuncSetAttribute((const void*)fwd_megakernel, hipFuncAttributeMaxDynamicSharedMemorySize, LDS_BYTES) != hipSuccess) { fprintf(stderr, "kernel_launch: hipFuncSetAttribute failed\n"); grid = -1; return; }
        int per_cu = 0;
        if (hipOccupancyMaxActiveBlocksPerMultiprocessor(&per_cu, (const void*)fwd_megakernel, 512, LDS_BYTES) != hipSuccess || per_cu < 1) { fprintf(stderr, "kernel_launch: occupancy query says %d blocks per CU\n", per_cu); (void)hipGetLastError(); }
        grid = cus;
    }
    if (grid < 0) return;
    Params p{};
    const float** pp = (const float**)&p;
    for (int i = 0; i < 23; ++i) pp[i] = (const float*)d_in[i];
    p.out = (float*)d_out; p.ws = (unsigned char*)d_ws;
    (void)hipMemsetAsync((char*)d_ws + WS_CTL, 0, 16384, stream);
#if MK_SINGLE
    p.ph_lo = 0; p.ph_hi = NPH;
    void* args[] = {&p};
    hipError_t e = hipLaunchCooperativeKernel((const void*)fwd_megakernel, dim3(grid), dim3(512), args, LDS_BYTES, stream);
    if (e != hipSuccess) fprintf(stderr, "cooperative launch failed: %s (grid %d)\n", hipGetErrorString(e), grid);
#else
    for (int ph = 0; ph < NPH; ++ph) {
        p.ph_lo = ph; p.ph_hi = ph + 1;
        hipLaunchKernelGGL(fwd_megakernel, dim3(grid), dim3(512), LDS_BYTES, stream, p);
    }
#endif
}
```

```cpp
#include <hip/hip_runtime.h>
#include <cstdio>
#include <cstdint>

#define LAS __attribute__((address_space(3)))
typedef unsigned short bf16_t;
typedef short bf16x8 __attribute__((ext_vector_type(8)));
typedef float f32x4 __attribute__((ext_vector_type(4)));
typedef unsigned u32x4 __attribute__((ext_vector_type(4)));
typedef unsigned u32x2 __attribute__((ext_vector_type(2)));

#ifndef REP_PHASE
#define REP_PHASE -1
#endif
#ifndef MK_SINGLE
#define MK_SINGLE 1
#endif

constexpr int NTOK = 16384, DM = 1024, NPROJ = 6144, DIN = 6176;
constexpr int NPH = 8;
constexpr int LDS_BYTES = 160 * 1024;
constexpr size_t OUT_YP = 0, OUT_YS = 8388608, OUT_SD = 16777216, OUT_SR = 25165824;
constexpr size_t WS_CTL = 0, WS_MODP = 16384, WS_PE = 606208, WS_BA = 737280, WS_GB = 2834432, WS_RGAGG = 4931584,
                 WS_WBAT = 9125888, WS_WOUTT = 9191424, WS_GT = 13385728, WS_WINT = 14434304, WS_TA = 27017216, WS_PROJ = 60571648, WS_CARRY = 261898240;

struct Params {
    const float *x_prompt, *x_sample, *state_delta, *state_rglru, *c, *c_ctx, *ada_w, *ada_b, *pre_w, *post_w, *w_in, *w_out,
                *dn_conv_w, *dn_a_log, *dn_dt_bias, *dn_norm_w, *rg_conv_w, *rg_conv_b, *rg_w_r, *rg_b_r, *rg_w_i, *rg_b_i, *rg_lam;
    float* out; unsigned char* ws;
    int ph_lo, ph_hi;
};

__device__ __forceinline__ float bf2f(unsigned short b) { return __uint_as_float(((unsigned)b) << 16); }
typedef __bf16 bf2_t __attribute__((ext_vector_type(2)));
typedef float f2_t __attribute__((ext_vector_type(2)));
__device__ __forceinline__ unsigned pk2(float lo, float hi) { const f2_t v = {lo, hi}; return __builtin_bit_cast(unsigned, __builtin_convertvector(v, bf2_t)); }
__device__ __forceinline__ unsigned short f2bf(float f) { return (unsigned short)(pk2(f, f) & 0xffffu); }
#ifndef SANITIZE
#define SANITIZE 0
#endif
#ifndef LIVE_MASK
#define LIVE_MASK 15
#endif
__device__ __forceinline__ float fin(float x) { return (SANITIZE && ((__float_as_uint(x) & 0x7f800000u) == 0x7f800000u)) ? 0.f : x; }
#define DG(F) ((unsigned*)((F).ws + WS_CTL))
__device__ __forceinline__ bool badv(float x, float lim) { return ((__float_as_uint(x) & 0x7f800000u) == 0x7f800000u) || fabsf(x) > lim; }
#ifndef DIAG
#define DIAG 0
#endif
#define CHK(F, k, bad) do { if (DIAG && (bad)) DG(F)[k] = 1u; } while (0)
__device__ __forceinline__ float sigm(float x) { return __builtin_amdgcn_rcpf(1.f + __expf(-x)); }
__device__ __forceinline__ float siluf_(float x) { return x * __builtin_amdgcn_rcpf(1.f + __expf(-x)); }
__device__ __forceinline__ float softplusf_(float x) { return x > 20.f ? x : log1pf(__expf(x)); }
__device__ __forceinline__ void unpack8(const u32x4 v, float (&f)[8]) {
    f[0] = __uint_as_float(v.x << 16); f[1] = __uint_as_float(v.x & 0xffff0000u);
    f[2] = __uint_as_float(v.y << 16); f[3] = __uint_as_float(v.y & 0xffff0000u);
    f[4] = __uint_as_float(v.z << 16); f[5] = __uint_as_float(v.z & 0xffff0000u);
    f[6] = __uint_as_float(v.w << 16); f[7] = __uint_as_float(v.w & 0xffff0000u);
}
__device__ __forceinline__ u32x4 pack8(const float (&f)[8]) { u32x4 o; o.x = pk2(f[0], f[1]); o.y = pk2(f[2], f[3]); o.z = pk2(f[4], f[5]); o.w = pk2(f[6], f[7]); return o; }
__device__ __forceinline__ float wave_sum(float v) {
#pragma unroll
    for (int o = 1; o < 64; o <<= 1) v += __shfl_xor(v, o);
    return v;
}
__device__ __forceinline__ void lds_barrier() { asm volatile("s_waitcnt lgkmcnt(0)" ::: "memory"); __builtin_amdgcn_s_barrier(); asm volatile("" ::: "memory"); }
#define MFMA16(a, b, c) __builtin_amdgcn_mfma_f32_16x16x32_bf16((a), (b), (c), 0, 0, 0)
#define LDS_WAIT() asm volatile("s_waitcnt lgkmcnt(0)" ::: "memory")
__device__ __forceinline__ bf16x8 ldfrag(const LAS unsigned char* base, int pitch, int row, int kb) { return *(const LAS bf16x8*)(base + row * pitch + kb); }

#define XB_TMO      128
#define XB_XCNT(j)  (256  + 64 * (j))
#define XB_XSUB(j)  (1280 + 64 * (j))
#define XB_XGEN(j)  (2304 + 64 * (j))
#define XB_TOP      3328
#define XB_TOPGEN   3392
#define XCD_BAR_WORDS 3456
#define XB_SPIN_CAP (1u << 18)
__device__ __forceinline__ unsigned xb_ld(unsigned* p)              { return __hip_atomic_load(p, __ATOMIC_RELAXED, __HIP_MEMORY_SCOPE_AGENT); }
__device__ __forceinline__ unsigned xb_add(unsigned* p, unsigned v) { return __hip_atomic_fetch_add(p, v, __ATOMIC_RELAXED, __HIP_MEMORY_SCOPE_AGENT); }
__device__ __forceinline__ unsigned xb_xcc_id() { return (unsigned)__builtin_amdgcn_s_getreg((3 << 11) | 20) & 0xFu; }
#define XB_SPIN(cond, bar) do { unsigned _sp = 0; while (cond) { __builtin_amdgcn_s_sleep(1); \
    if ((++_sp & 255u) == 0u) { if (xb_ld(&(bar)[XB_TMO])) break; if (_sp > XB_SPIN_CAP) { atomicAdd(&(bar)[XB_TMO], 1u); break; } } } } while (0)
struct XcdBarrier { unsigned* bar; unsigned x; volatile LAS unsigned* st; };
__device__ __forceinline__ XcdBarrier xcd_barrier_post(unsigned* bar, volatile LAS unsigned* st) {
    XcdBarrier b; b.bar = bar; b.x = xb_xcc_id(); b.st = st;
    if (threadIdx.x == 0) (void)xb_add(&bar[XB_XCNT(b.x)], 1u);
    return b;
}
__device__ __forceinline__ void xcd_barrier_complete(unsigned* bar, unsigned x, unsigned& nloc, unsigned& nx) {
    const unsigned G = gridDim.x * gridDim.y * gridDim.z;
    unsigned sum, cnt, mine, sp = 0u;
    for (;;) {
        sum = 0u; cnt = 0u; mine = 0u;
#pragma unroll
        for (unsigned j = 0; j < 16; ++j) { const unsigned c = xb_ld(&bar[XB_XCNT(j)]); sum += c; cnt += (c > 0u) ? 1u : 0u; mine = (j == x) ? c : mine; }
        if (sum == G) break;
        __builtin_amdgcn_s_sleep(1);
        if ((++sp & 255u) == 0u) { if (xb_ld(&bar[XB_TMO])) break; if (sp > XB_SPIN_CAP) { atomicAdd(&bar[XB_TMO], 1u); break; } }
    }
    nloc = mine > 0u ? mine : 1u; nx = cnt > 0u ? cnt : 1u;
}
__device__ __forceinline__ void xcd_barrier(const XcdBarrier& b) {
    asm volatile("s_waitcnt vmcnt(0)" ::: "memory");
    __syncthreads();
    if (threadIdx.x == 0) {
        unsigned* bar = b.bar;
        __builtin_amdgcn_s_waitcnt(0);
        unsigned nloc = b.st[0], nx = b.st[1];
        if (nloc == 0u) { xcd_barrier_complete(bar, b.x, nloc, nx); b.st[0] = nloc; b.st[1] = nx; }
        const unsigned old = xb_add(&bar[XB_XSUB(b.x)], 1u);
        const unsigned gen = old / nloc;
        if (old + 1u == (gen + 1u) * nloc) {
            __builtin_amdgcn_fence(__ATOMIC_RELEASE, "agent");
            asm volatile("s_waitcnt vmcnt(0)" ::: "memory");
            const unsigned og = xb_add(&bar[XB_TOP], 1u);
            const unsigned tg = og / nx;
            if (og + 1u == (tg + 1u) * nx) xb_add(&bar[XB_TOPGEN], 1u);
            else XB_SPIN(xb_ld(&bar[XB_TOPGEN]) == tg, bar);
            __builtin_amdgcn_fence(__ATOMIC_ACQUIRE, "agent");
            xb_add(&bar[XB_XGEN(b.x)], 1u);
            asm volatile("s_waitcnt vmcnt(0)" ::: "memory");
        } else {
            XB_SPIN(xb_ld(&bar[XB_XGEN(b.x)]) == gen, bar);
            __builtin_amdgcn_fence(__ATOMIC_ACQUIRE, "agent");
            asm volatile("s_waitcnt vmcnt(0)" ::: "memory");
        }
    }
    __syncthreads();
}

namespace pg8 {
constexpr int BM = 256, BK = 64, HALF = 128, HTB = HALF * BK * 2, STAGE_BYTES = 8 * HTB, NXCD = 8, WGM = 8;
__host__ __device__ __forceinline__ int lds_byte(int r, int c) { const int st = (r >> 4) * 2 + (c >> 5), rr = r & 15, cc = c & 31, ob = rr * 64 + cc * 2; return st * 1024 + (ob ^ (((ob >> 9) & 1) << 5)); }
__host__ __device__ __forceinline__ void stage_rc(int b, int& R, int& C) { const int st = b / 1024, sb = b % 1024, swz = sb ^ (((sb >> 9) & 1) << 5); R = (st >> 1) * 16 + swz / 64; C = (st & 1) * 32 + (swz % 64) / 2; }
__host__ __device__ __forceinline__ int perm32(int rho) { const int n = rho >> 4, i = rho & 15; return 8 * (i >> 2) + 4 * n + (i & 3); }
struct Unit { int pm, pn; };
struct Gemm { const bf16_t* A; const bf16_t* Bt; int M, N, K; };
struct StaticOrder {
    int nM, nN, nwg, G, c;
    __host__ __device__ void init(int M, int N, int G_, int c_) { nM = M / BM; nN = N / BM; nwg = nM * nN; G = G_; c = c_; }
    __host__ __device__ bool next(int i, Unit& u) const {
        const long L = (long)i * G + c; if (L >= nwg) return false;
        int wgid = (int)L; { const int q = nwg / NXCD, r = nwg % NXCD, xcd = wgid % NXCD, off = wgid / NXCD; wgid = (xcd < r ? xcd * (q + 1) : r * (q + 1) + (xcd - r) * q) + off; }
        const int nig = WGM * nN, gid = wgid / nig, fm = gid * WGM, gsz = (nM - fm) < WGM ? (nM - fm) : WGM;
        u.pm = fm + ((wgid % nig) % gsz); u.pn = (wgid % nig) / gsz; return true;
    }
};
__device__ __forceinline__ unsigned cvt_pk_bf16(float lo, float hi) { unsigned r; asm volatile("v_cvt_pk_bf16_f32 %0, %1, %2" : "=v"(r) : "v"(lo), "v"(hi)); return r; }
struct EpiF32 {
    static constexpr bool PERM = false;
    float* C; int ldc;
    __device__ __forceinline__ void operator()(const f32x4 (&acc)[2][2][4][2], const Unit& u, int wr, int wc, int fr, int fq) const {
        const int row0 = u.pm * BM + wr * 64 + fr, col0 = u.pn * BM + wc * 32 + 4 * fq;
#pragma unroll
        for (int ai = 0; ai < 2; ++ai)
#pragma unroll
            for (int m = 0; m < 4; ++m) { float* rowp = C + (size_t)(row0 + ai * HALF + m * 16) * ldc + col0;
#pragma unroll
                for (int bj = 0; bj < 2; ++bj)
#pragma unroll
                    for (int n = 0; n < 2; ++n) *(f32x4*)(rowp + bj * HALF + n * 16) = acc[ai][bj][m][n]; }
    }
};
struct EpiBf16 {
    static constexpr bool PERM = true;
    bf16_t* O; int ldc;
    __device__ __forceinline__ void operator()(const f32x4 (&acc)[2][2][4][2], const Unit& u, int wr, int wc, int fr, int fq) const {
        const int row0 = u.pm * BM + wr * 64 + fr; const int col0 = u.pn * BM + wc * 32 + 8 * fq;
#pragma unroll
        for (int ai = 0; ai < 2; ++ai)
#pragma unroll
            for (int m = 0; m < 4; ++m) { bf16_t* rowp = O + (size_t)(row0 + ai * HALF + m * 16) * ldc + col0;
#pragma unroll
                for (int bj = 0; bj < 2; ++bj) { const f32x4 v0 = acc[ai][bj][m][0], v1 = acc[ai][bj][m][1];
                    u32x4 w; w.x = cvt_pk_bf16(v0[0], v0[1]); w.y = cvt_pk_bf16(v0[2], v0[3]); w.z = cvt_pk_bf16(v1[0], v1[1]); w.w = cvt_pk_bf16(v1[2], v1[3]);
                    *(u32x4*)(rowp + bj * HALF) = w; } }
    }
};

template <class Epi, class Sched>
__device__ __forceinline__ void gemm_phase(LAS unsigned char* lds, const Gemm g, const Sched& S, const Epi& E) {
    const int tid = threadIdx.x, wid = __builtin_amdgcn_readfirstlane(tid >> 6), lane = tid & 63, wr = wid >> 2, wc = wid & 3, fr = lane & 15, fq = lane >> 4;
    const int K = g.K, nt = K / BK;
    unsigned voffA[2], voffB[2];
#pragma unroll
    for (int i = 0; i < 2; ++i) { int R, C; stage_rc(tid * 16 + i * 8192, R, C); const int Rb = Epi::PERM ? ((R & ~31) + perm32(R & 31)) : R;
        voffA[i] = (unsigned)(R * K + C) * 2u; voffB[i] = (unsigned)(Rb * K + C) * 2u; }
    const size_t kstep = (size_t)(BK * 2);
    const size_t hstep = (size_t)HALF * K * 2;
    const size_t tstep = 2 * hstep;
    const unsigned ldsw = (unsigned)wid * 1024u;
    const int aoff = lds_byte(wr * 64 + fr, fq * 8), boff = lds_byte(wc * 32 + fr, fq * 8);
#define PG8_SA(b, h) (((b) * 2 + (h)) * HTB)
#define PG8_SB(b, h) ((4 + (b) * 2 + (h)) * HTB)
#define PG8_STAGE(bufoff, gbase, voff) do { _Pragma("unroll") for (int _i = 0; _i < 2; ++_i) \
        __builtin_amdgcn_global_load_lds((const unsigned*)((const char*)(gbase) + (voff)[_i]), (LAS unsigned*)(lds + (bufoff) + ldsw + _i * 8192), 16, 0, 0); } while (0)
#define PG8_LDA(dst, b, h) do { _Pragma("unroll") for (int m = 0; m < 4; ++m) _Pragma("unroll") for (int k = 0; k < 2; ++k) dst[m][k] = *(const LAS bf16x8*)(lds + PG8_SA(b, h) + aoff + m * 2048 + k * 1024); } while (0)
#define PG8_LDB(dst, b, h) do { _Pragma("unroll") for (int n = 0; n < 2; ++n) _Pragma("unroll") for (int k = 0; k < 2; ++k) dst[n][k] = *(const LAS bf16x8*)(lds + PG8_SB(b, h) + boff + n * 2048 + k * 1024); } while (0)
#define PG8_MMA(ai, bj, At, Bt) do { __builtin_amdgcn_s_setprio(1); _Pragma("unroll") for (int m = 0; m < 4; ++m) _Pragma("unroll") for (int n = 0; n < 2; ++n) _Pragma("unroll") for (int k = 0; k < 2; ++k) \
        acc[ai][bj][m][n] = __builtin_amdgcn_mfma_f32_16x16x32_bf16(Bt[n][k], At[m][k], acc[ai][bj][m][n], 0, 0, 0); __builtin_amdgcn_s_setprio(0); } while (0)
#define PG8_WAIT_V(n) asm volatile("s_waitcnt vmcnt(" #n ")" ::: "memory")
#define PG8_WAIT_L(n) asm volatile("s_waitcnt lgkmcnt(" #n ")" ::: "memory")
#define PG8_BAR __builtin_amdgcn_s_barrier()
#define PG8_SCHED __builtin_amdgcn_sched_barrier(0)
    Unit cur, nxt; int ui = 0;
    if (!S.next(0, cur)) return;
    f32x4 acc[2][2][4][2];
#pragma unroll
    for (int a = 0; a < 2; ++a)
#pragma unroll
        for (int b = 0; b < 2; ++b)
#pragma unroll
            for (int m = 0; m < 4; ++m)
#pragma unroll
                for (int n = 0; n < 2; ++n) acc[a][b][m][n] = (f32x4){0.f, 0.f, 0.f, 0.f};
    bf16x8 At[4][2], B0[2][2], B1[2][2];
    const char* cA = (const char*)g.A + (size_t)cur.pm * tstep; const char* cB = (const char*)g.Bt + (size_t)cur.pn * tstep;
    PG8_STAGE(PG8_SB(0, 0), cB, voffB); PG8_STAGE(PG8_SA(0, 0), cA, voffA); PG8_STAGE(PG8_SB(0, 1), cB + hstep, voffB); PG8_STAGE(PG8_SA(0, 1), cA + hstep, voffA);
    if (wr == 1) PG8_BAR;
    PG8_WAIT_V(4); PG8_BAR;
    PG8_STAGE(PG8_SB(1, 0), cB + kstep, voffB); PG8_STAGE(PG8_SA(1, 0), cA + kstep, voffA); PG8_STAGE(PG8_SB(1, 1), cB + hstep + kstep, voffB);
    PG8_WAIT_V(6); PG8_BAR;
    for (;;) {
        const bool has_next = S.next(ui + 1, nxt);
        const char* nA = has_next ? (const char*)g.A + (size_t)nxt.pm * tstep : cA; const char* nB = has_next ? (const char*)g.Bt + (size_t)nxt.pn * tstep : cB;
        for (int t = 0; t < nt; t += 2) {
            const bool last = (t == nt - 2);
            const char* a1 = cA + (size_t)(t + 1) * kstep;
            const char* a2 = last ? nA : cA + (size_t)(t + 2) * kstep; const char* b2 = last ? nB : cB + (size_t)(t + 2) * kstep;
            const char* a3 = a2 + kstep; const char* b3 = b2 + kstep;
            PG8_LDB(B0, 0, 0); PG8_SCHED; PG8_LDA(At, 0, 0); PG8_STAGE(PG8_SA(1, 1), a1 + hstep, voffA);
            PG8_WAIT_L(8); PG8_BAR; PG8_WAIT_L(0); PG8_MMA(0, 0, At, B0); PG8_BAR; PG8_SCHED;
            PG8_LDB(B1, 0, 1); PG8_STAGE(PG8_SB(0, 0), b2, voffB);
            PG8_BAR; PG8_WAIT_L(0); PG8_MMA(0, 1, At, B1); PG8_BAR;
            PG8_LDA(At, 0, 1); PG8_STAGE(PG8_SA(0, 0), a2, voffA);
            PG8_BAR; PG8_WAIT_L(0); PG8_MMA(1, 0, At, B0); PG8_BAR; PG8_SCHED;
            PG8_STAGE(PG8_SB(0, 1), b2 + hstep, voffB);
            PG8_WAIT_V(6); PG8_BAR; PG8_MMA(1, 1, At, B1); PG8_BAR;
            PG8_LDB(B0, 1, 0); PG8_SCHED; PG8_LDA(At, 1, 0); PG8_STAGE(PG8_SA(0, 1), a2 + hstep, voffA);
            PG8_WAIT_L(8); PG8_BAR; PG8_WAIT_L(0); PG8_MMA(0, 0, At, B0); PG8_BAR; PG8_SCHED;
            PG8_LDB(B1, 1, 1); PG8_STAGE(PG8_SB(1, 0), b3, voffB);
            PG8_BAR; PG8_WAIT_L(0); PG8_MMA(0, 1, At, B1); PG8_BAR;
            PG8_LDA(At, 1, 1); PG8_STAGE(PG8_SA(1, 0), a3, voffA);
            PG8_BAR; PG8_WAIT_L(0); PG8_MMA(1, 0, At, B0); PG8_BAR; PG8_SCHED;
            PG8_STAGE(PG8_SB(1, 1), b3 + hstep, voffB);
            PG8_WAIT_V(6); PG8_BAR; PG8_MMA(1, 1, At, B1); PG8_BAR;
        }
        E(acc, cur, wr, wc, fr, fq);
        if (!has_next) break;
#pragma unroll
        for (int a = 0; a < 2; ++a)
#pragma unroll
            for (int b = 0; b < 2; ++b)
#pragma unroll
                for (int m = 0; m < 4; ++m)
#pragma unroll
                    for (int n = 0; n < 2; ++n) acc[a][b][m][n] = (f32x4){0.f, 0.f, 0.f, 0.f};
        cur = nxt; cA = nA; cB = nB; ++ui;
    }
    PG8_WAIT_V(0);
    if (wr == 0) PG8_BAR;
    PG8_BAR;
#undef PG8_SA
#undef PG8_SB
#undef PG8_STAGE
#undef PG8_LDA
#undef PG8_LDB
#undef PG8_MMA
#undef PG8_WAIT_V
#undef PG8_WAIT_L
#undef PG8_BAR
#undef PG8_SCHED
}
}

struct Frame {
    LAS unsigned char* lds;
    int tid, lane, wave, G, b;
    float* out; unsigned char* ws;
    __device__ __forceinline__ bf16_t* H() const { return (bf16_t*)out; }
    __device__ __forceinline__ bf16_t* Qc() const { return (bf16_t*)out; }
    __device__ __forceinline__ bf16_t* Kc() const { return (bf16_t*)(out + OUT_YS); }
    __device__ __forceinline__ bf16_t* MIX() const { return (bf16_t*)out; }
    __device__ __forceinline__ float* modp() const { return (float*)(ws + WS_MODP); }
    __device__ __forceinline__ float* pe() const { return (float*)(ws + WS_PE); }
    __device__ __forceinline__ float* BA() const { return (float*)(ws + WS_BA); }
    __device__ __forceinline__ float* GB() const { return (float*)(ws + WS_GB); }
    __device__ __forceinline__ float* RGAGG() const { return (float*)(ws + WS_RGAGG); }
    __device__ __forceinline__ bf16_t* WbaT() const { return (bf16_t*)(ws + WS_WBAT); }
    __device__ __forceinline__ bf16_t* WoutT() const { return (bf16_t*)(ws + WS_WOUTT); }
    __device__ __forceinline__ bf16_t* GT() const { return (bf16_t*)(ws + WS_GT); }
    __device__ __forceinline__ bf16_t* WinT() const { return (bf16_t*)(ws + WS_WINT); }
    __device__ __forceinline__ bf16_t* TA() const { return (bf16_t*)(ws + WS_TA); }
    __device__ __forceinline__ bf16_t* PROJ() const { return (bf16_t*)(ws + WS_PROJ); }
    __device__ __forceinline__ float* CARRY() const { return (float*)(ws + WS_CARRY); }
};
typedef const __attribute__((address_space(4))) Params CParams;

__device__ __forceinline__ int grp_of_block(int tb) { return tb < 128 ? 0 : (tb < 192 ? 1 : 2); }

__device__ __forceinline__ void transpose_item(const float* W, int N, int k0, int n0, bf16_t* WT0, int Kout, LAS float* scr, int lane) {
#pragma unroll 8
    for (int i = 0; i < 32; ++i) { const int kk = 2 * i + (lane >> 5); scr[kk * 33 + (lane & 31)] = W[(size_t)(k0 + kk) * N + n0 + (lane & 31)]; }
    LDS_WAIT();
    const int c = lane & 7;
#pragma unroll
    for (int j = 0; j < 4; ++j) { const int n = (lane >> 3) + 8 * j; const LAS float* s = scr + (8 * c) * 33 + n;
        u32x4 o; o.x = pk2(s[0 * 33], s[1 * 33]); o.y = pk2(s[2 * 33], s[3 * 33]); o.z = pk2(s[4 * 33], s[5 * 33]); o.w = pk2(s[6 * 33], s[7 * 33]);
        *(u32x4*)(WT0 + (size_t)n * Kout + k0 + 8 * c) = o; }
    LDS_WAIT();
}
__device__ __forceinline__ void phase0(CParams& p, Frame& F) {
    const int tid = F.tid, lane = F.lane;
    for (int it = F.b; it < 192; it += F.G) {
        const int jg = it % 12, ks = it / 12, j = jg * 256 + (tid & 255), half = tid >> 8, k0 = ks * 64 + half * 32;
        float s0 = 0.f, s1 = 0.f, s2 = 0.f;
#pragma unroll 8
        for (int k = 0; k < 32; ++k) { const int kk = k0 + k; const float w = p.ada_w[(size_t)kk * 3072 + j];
            s0 += siluf_(p.c_ctx[kk]) * w; s1 += siluf_(p.c[kk]) * w; s2 += siluf_(p.c[1024 + kk]) * w; }
        LAS float* red = (LAS float*)F.lds;
        if (half == 1) { red[tid - 256] = s0; red[256 + tid - 256] = s1; red[512 + tid - 256] = s2; }
        __syncthreads();
        if (half == 0) { F.modp()[(size_t)(ks * 3 + 0) * 3072 + j] = s0 + red[tid]; F.modp()[(size_t)(ks * 3 + 1) * 3072 + j] = s1 + red[256 + tid]; F.modp()[(size_t)(ks * 3 + 2) * 3072 + j] = s2 + red[512 + tid]; }
        __syncthreads();
    }
    LAS float* scr = (LAS float*)(F.lds + 4096 + F.wave * 8448);
    const int gw = F.b * 8 + F.wave, NGW = F.G * 8;
    constexpr int I_IN = 16 * 193, I_OUT = 32 * 32, I_G = 256, I_PE = 64;
    for (int it = gw; it < I_IN + I_OUT + I_G + I_PE; it += NGW) {
        int r = it;
        if (r < I_IN) { const int kb = r / 193, nb = r % 193, n0 = nb * 32;
            bf16_t* dst = n0 < 4096 ? F.WinT() + (size_t)n0 * 1024 : (n0 < 4128 ? F.WbaT() + (size_t)(n0 - 4096) * 1024 : F.WinT() + (size_t)(n0 - 32) * 1024);
            transpose_item(p.w_in, DIN, kb * 64, n0, dst, 1024, scr, lane); continue; }
        r -= I_IN;
        if (r < I_OUT) { const int kb = r / 32, nb = r % 32; transpose_item(p.w_out, 1024, kb * 64, nb * 32, F.WoutT() + (size_t)(nb * 32) * 2048, 2048, scr, lane); continue; }
        r -= I_OUT;
        if (r < I_G) { const int m = r >> 3, sub = r & 7, kb = sub >> 2, nb = sub & 3, g = m >> 4, dn = m & 15;
            const float* src = (g ? p.rg_w_i : p.rg_w_r) + (size_t)dn * 16384;
            transpose_item(src, 128, kb * 64, nb * 32, F.GT() + (size_t)m * 16384 + (size_t)(nb * 32) * 128, 128, scr, lane); continue; }
        r -= I_G;
        { const int v = r;
#pragma unroll
          for (int i = 0; i < 4; ++i) { const int idx = lane * 4 + i; const float f = expf(-9.210340371976184f * (float)idx / 256.f); const float a = (float)v * f;
              F.pe()[v * 256 + idx] = sinf(a); F.pe()[16384 + v * 256 + idx] = cosf(a); } }
    }
}

__device__ __forceinline__ float mod_val(CParams& p, const Frame& F, int grp, int j) {
    float s = p.ada_b[j];
#pragma unroll
    for (int ks = 0; ks < 16; ++ks) s += F.modp()[(size_t)(ks * 3 + grp) * 3072 + j];
    return s;
}

__device__ __forceinline__ void phase1(CParams& p, Frame& F) {
    LAS float* sc = (LAS float*)F.lds; LAS float* sh = sc + 1024;
    for (int tb = F.b; tb < 256; tb += F.G) {
        const int grp = grp_of_block(tb);
        for (int j = F.tid; j < 1024; j += 512) { sh[j] = mod_val(p, F, grp, j); sc[j] = p.pre_w[j] * (1.f + mod_val(p, F, grp, 1024 + j)); }
        __syncthreads();
#pragma unroll 2
        for (int i = 0; i < 8; ++i) {
            const int tok = tb * 64 + F.wave * 8 + i;
            const float* xr = tok < 8192 ? p.x_prompt + (size_t)tok * 1024 : p.x_sample + (size_t)(tok - 8192) * 1024;
            f32x4 v[4]; float ss = 0.f;
#pragma unroll
            for (int q = 0; q < 4; ++q) { v[q] = *(const f32x4*)(xr + F.lane * 4 + 256 * q);
                if (tok >= 8192) { const int pp = (tok - 8192) & 4095; const int vv = (q < 2) ? (pp >> 6) : (pp & 63);
                    const f32x4 e = *(const f32x4*)(F.pe() + ((q & 1) ? 16384 : 0) + vv * 256 + F.lane * 4); v[q] += e; }
                ss += (v[q][0] * v[q][0] + v[q][1] * v[q][1]) + (v[q][2] * v[q][2] + v[q][3] * v[q][3]); }
            const float rstd = rsqrtf(wave_sum(ss) * (1.f / 1024.f) + 1e-6f);
#pragma unroll
            for (int q = 0; q < 4; ++q) { const int j = F.lane * 4 + 256 * q; const f32x4 s4 = *(const LAS f32x4*)(sc + j), h4 = *(const LAS f32x4*)(sh + j);
                CHK(F, 1, badv(v[q][0] * rstd * s4[0] + h4[0], 100.f) || badv(v[q][3] * rstd * s4[3] + h4[3], 100.f));
                u32x2 o; o.x = pk2(v[q][0] * rstd * s4[0] + h4[0], v[q][1] * rstd * s4[1] + h4[1]); o.y = pk2(v[q][2] * rstd * s4[2] + h4[2], v[q][3] * rstd * s4[3] + h4[3]);
                *(u32x2*)(F.H() + (size_t)tok * 1024 + j) = o; }
        }
        __syncthreads();
    }
}

__device__ __forceinline__ void phase2(CParams& p, Frame& F) {
    { pg8::Gemm g{F.H(), F.WinT(), NTOK, NPROJ, 1024}; pg8::StaticOrder S; S.init(NTOK, NPROJ, F.G, F.b); pg8::EpiBf16 E{F.PROJ(), NPROJ};
      pg8::gemm_phase<pg8::EpiBf16, pg8::StaticOrder>(F.lds, g, S, E); }
    const int l15 = F.lane & 15, q4 = F.lane >> 4;
    for (int tb = F.b; tb < 256; tb += F.G) {
        const int mt = F.wave >> 1, nt = F.wave & 1;
        const bf16_t* ar = F.H() + (size_t)(tb * 64 + mt * 16 + l15) * 1024 + q4 * 8;
        const bf16_t* br = F.WbaT() + (size_t)(nt * 16 + l15) * 1024 + q4 * 8;
        f32x4 acc = {0.f, 0.f, 0.f, 0.f};
#pragma unroll 16
        for (int ks = 0; ks < 32; ++ks) { const bf16x8 a = *(const bf16x8*)(ar + ks * 32), b = *(const bf16x8*)(br + ks * 32); acc = MFMA16(a, b, acc); }
#pragma unroll
        for (int r = 0; r < 4; ++r) F.BA()[(size_t)(tb * 64 + mt * 16 + q4 * 4 + r) * 32 + nt * 16 + l15] = acc[r];
    }
}

__device__ __forceinline__ void p3_load_rows(const Frame& F, int ci, int h, u32x4 (&rows)[7]) {
    const int tid = F.tid, tg = tid >> 5, part = (tid >> 4) & 1, sub = tid & 15, col = part * 1024 + h * 128 + sub * 8, t0 = ci * 64;
    int seq_lo, seq_hi; if (ci < 128) { seq_lo = (ci >> 2) * 256; seq_hi = seq_lo + 256; } else { seq_lo = 8192 + ((ci - 128) >> 6) * 4096; seq_hi = seq_lo + 4096; }
    const int tb = t0 + tg * 4 - 2;
#pragma unroll
    for (int r = 0; r < 7; ++r) { const int tok = tb + r; u32x4 v = {0u, 0u, 0u, 0u};
        if (tok >= seq_lo && tok < seq_hi) v = *(const u32x4*)(F.PROJ() + (size_t)tok * NPROJ + col);
        rows[r] = v; }
}
__device__ __forceinline__ void p3_delta_item(CParams& p, Frame& F, int ci, int h, u32x4 (&rows)[7], int itn) {
    const int tid = F.tid, lane = F.lane, wave = F.wave, q4 = lane >> 4, l15 = lane & 15;
    LAS unsigned char* Ks = F.lds; LAS unsigned char* Qs = F.lds + 17408;
    LAS float* gfv = (LAS float*)(F.lds + 34816);
    LAS unsigned char* DIR0 = F.lds + 35840;
    LAS unsigned char* ATo = F.lds + 137728;
#pragma unroll
    for (int i = 0; i < 5; ++i) { const int ch = tid + 512 * i; if (ch < 2304) { const int dd = ch >= 1152, cc = ch - dd * 1152; *(LAS u32x4*)(DIR0 + dd * 46848 + 18432 + cc * 16) = (u32x4){0u, 0u, 0u, 0u}; } }
    const int t0 = ci * 64;
    int seq_lo, seq_hi; if (ci < 128) { seq_lo = (ci >> 2) * 256; seq_hi = seq_lo + 256; } else { seq_lo = 8192 + ((ci - 128) >> 6) * 4096; seq_hi = seq_lo + 4096; }
    {
        const int tg = tid >> 5, part = (tid >> 4) & 1, sub = tid & 15, col = part * 1024 + h * 128 + sub * 8;
        float w[4][8];
#pragma unroll
        for (int j = 0; j < 4; ++j) { const f32x4 a = *(const f32x4*)(p.dn_conv_w + j * 3072 + col), b = *(const f32x4*)(p.dn_conv_w + j * 3072 + col + 4);
            w[j][0] = a[0]; w[j][1] = a[1]; w[j][2] = a[2]; w[j][3] = a[3]; w[j][4] = b[0]; w[j][5] = b[1]; w[j][6] = b[2]; w[j][7] = b[3]; }
        float acc[4][8];
#pragma unroll
        for (int i = 0; i < 4; ++i)
#pragma unroll
            for (int e = 0; e < 8; ++e) acc[i][e] = 0.f;
#pragma unroll
        for (int r = 0; r < 7; ++r) {
            float x[8]; unpack8(rows[r], x);
#pragma unroll
            for (int j = 0; j < 4; ++j) { const int i = r - j; if (i >= 0 && i < 4) {
#pragma unroll
                for (int e = 0; e < 8; ++e) acc[i][e] += w[j][e] * x[e]; } } }
#pragma unroll
        for (int i = 0; i < 4; ++i) { float ss = 0.f;
#pragma unroll
            for (int e = 0; e < 8; ++e) { acc[i][e] = siluf_(acc[i][e]); ss += acc[i][e] * acc[i][e]; }
            ss += __shfl_xor(ss, 1); ss += __shfl_xor(ss, 2); ss += __shfl_xor(ss, 4); ss += __shfl_xor(ss, 8);
            const float rs = rsqrtf(ss + 1e-6f) * (part == 0 ? 0.08838834764831845f : 1.f);
#pragma unroll
            for (int e = 0; e < 8; ++e) acc[i][e] *= rs;
            CHK(F, 4, badv(acc[i][0], 1.01f) || badv(acc[i][5], 1.01f) || badv(ss * rs * rs, part == 0 ? 0.0079f : 1.01f));
            const u32x4 o = pack8(acc[i]); const int c = tg * 4 + i;
            *(LAS u32x4*)((part ? Ks : Qs) + c * 272 + sub * 16) = o;
            if (part == 0) *(u32x4*)(F.Qc() + (size_t)(t0 + c) * 1024 + h * 128 + sub * 8) = o; }
        if (part == 1) {
            bf16_t* kt = F.Kc() + (size_t)(ci * 8 + h) * 8192 + (size_t)(sub * 8) * 64 + tg * 4;
#pragma unroll
            for (int e = 0; e < 8; ++e) { u32x2 o2; o2.x = pk2(acc[0][e], acc[1][e]); o2.y = pk2(acc[2][e], acc[3][e]); *(u32x2*)(kt + e * 64) = o2; } }
    }
    if (wave == 0) {
        const float* ba = F.BA() + (size_t)(t0 + lane) * 32;
        const float bf_ = sigm(ba[h]), bb_ = sigm(ba[8 + h]);
        float s = -expf(p.dn_a_log[h]) * softplusf_(ba[16 + h] + p.dn_dt_bias[h]);
        float sb = -expf(p.dn_a_log[8 + h]) * softplusf_(ba[24 + h] + p.dn_dt_bias[8 + h]);
#pragma unroll
        for (int o = 1; o < 64; o <<= 1) { const float t = __shfl_up(s, o); if (lane >= o) s += t; }
#pragma unroll
        for (int o = 1; o < 64; o <<= 1) { const float t = __shfl_down(sb, o); if (lane + o < 64) sb += t; }
        CHK(F, 3, badv(ba[h], 1000.f) || badv(ba[24 + h], 1000.f));
        CHK(F, 8, badv(s, 1e4f) || badv(sb, 1e4f) || s > 0.f || sb > 0.f || bf_ < 0.f || bf_ > 1.f || bb_ < 0.f || bb_ > 1.f);
        gfv[lane] = s; gfv[64 + lane] = sb; gfv[128 + lane] = bf_; gfv[192 + lane] = bb_;
        float* gb = F.GB() + (size_t)(ci * 8 + h) * 256;
        gb[lane] = s; gb[64 + lane] = sb; gb[128 + lane] = bf_; gb[192 + lane] = bb_;
    }
    lds_barrier();
    const int d = wave >> 2, mt = wave & 3;
    LAS unsigned char* Db = DIR0 + d * 46848;
    LAS unsigned char* Brow = Db; LAS unsigned char* Btr = Db + 9216; LAS unsigned char* Xrow = Db + 18432; LAS unsigned char* Xtr = Db + 27648;
    LAS float* Dl = (LAS float*)(Db + 36864) + mt * 272; LAS unsigned char* M2t = Db + 41216; LAS unsigned char* Mts = Db + 43776 + mt * 768;
    const LAS unsigned char* Lrow = d == 0 ? Brow : Btr;
    const LAS float* gd = gfv + d * 64; const LAS float* bd = gfv + 128 + d * 64;
    {
        f32x4 kk[4], qk[4];
#pragma unroll
        for (int n = 0; n < 4; ++n) { kk[n] = (f32x4){0.f, 0.f, 0.f, 0.f}; qk[n] = (f32x4){0.f, 0.f, 0.f, 0.f}; }
#pragma unroll
        for (int ks = 0; ks < 4; ++ks) { const bf16x8 ak = ldfrag(Ks, 272, mt * 16 + l15, ks * 64 + q4 * 16), aq = ldfrag(Qs, 272, mt * 16 + l15, ks * 64 + q4 * 16);
#pragma unroll
            for (int n = 0; n < 4; ++n) { const bf16x8 bk = ldfrag(Ks, 272, n * 16 + l15, ks * 64 + q4 * 16); kk[n] = MFMA16(ak, bk, kk[n]); qk[n] = MFMA16(aq, bk, qk[n]); } }
#pragma unroll
        for (int n = 0; n < 4; ++n) { const int s = n * 16 + l15; float a4[4];
#pragma unroll
            for (int r = 0; r < 4; ++r) { const int c = mt * 16 + q4 * 4 + r;
                const float dec = __expf(fminf(gd[c] - gd[s], 0.f));
                const bool strict = d == 0 ? (c > s) : (c < s);
                const float a = strict ? bd[c] * kk[n][r] * dec : 0.f;
                a4[r] = a;
                ((LAS bf16_t*)Brow)[c * 72 + s] = f2bf(a);
                if (n == mt) { if (d == 0) Dl[(q4 * 4 + r) * 17 + l15] = a; else Dl[l15 * 17 + q4 * 4 + r] = a; }
                const bool incl = d == 0 ? (c >= s) : (c < s);
                if (incl) ((LAS bf16_t*)ATo)[c * 64 + s] = f2bf(qk[n][r] * dec); }
            u32x2 o; o.x = pk2(a4[0], a4[1]); o.y = pk2(a4[2], a4[3]);
            *(LAS u32x2*)(Btr + s * 144 + (mt * 16 + q4 * 4) * 2) = o; }
    }
    lds_barrier();
    if (lane < 16) {
        float x[16];
#pragma unroll
        for (int i = 0; i < 16; ++i) { float sv = (i == lane) ? 1.f : 0.f;
#pragma unroll
            for (int j = 0; j < i; ++j) sv -= Dl[i * 17 + j] * x[j];
            x[i] = sv; }
#pragma unroll
        for (int i = 0; i < 16; ++i) ((LAS bf16_t*)Xrow)[(mt * 16 + i) * 72 + mt * 16 + lane] = f2bf(x[i]);
        u32x4 o0, o1; o0.x = pk2(x[0], x[1]); o0.y = pk2(x[2], x[3]); o0.z = pk2(x[4], x[5]); o0.w = pk2(x[6], x[7]);
        o1.x = pk2(x[8], x[9]); o1.y = pk2(x[10], x[11]); o1.z = pk2(x[12], x[13]); o1.w = pk2(x[14], x[15]);
        *(LAS u32x4*)(Xtr + (mt * 16 + lane) * 144 + mt * 32) = o0; *(LAS u32x4*)(Xtr + (mt * 16 + lane) * 144 + mt * 32 + 16) = o1;
    }
    lds_barrier();
    const bf16x8 zero8 = {0, 0, 0, 0, 0, 0, 0, 0};
    const f32x4 zero4 = {0.f, 0.f, 0.f, 0.f};
    if (mt & 1) {
        const int I1 = mt, I0 = mt - 1;
        bf16x8 a = zero8, b = zero8;
        if (q4 < 2) { a = ldfrag(Lrow, 144, I1 * 16 + l15, I0 * 32 + q4 * 16); b = ldfrag(Xtr, 144, I0 * 16 + l15, I0 * 32 + q4 * 16); }
        const f32x4 M = MFMA16(a, b, zero4);
        { u32x2 o; o.x = pk2(M[0], M[1]); o.y = pk2(M[2], M[3]); *(LAS u32x2*)(Mts + l15 * 48 + q4 * 8) = o; }
        LDS_WAIT();
        bf16x8 a2 = zero8, b2 = zero8;
        if (q4 < 2) { a2 = ldfrag(Xrow, 144, I1 * 16 + l15, I1 * 32 + q4 * 16); b2 = *(const LAS bf16x8*)(Mts + l15 * 48 + q4 * 16); }
        const f32x4 X = MFMA16(a2, b2, zero4);
#pragma unroll
        for (int r = 0; r < 4; ++r) ((LAS bf16_t*)Xrow)[(I1 * 16 + q4 * 4 + r) * 72 + I0 * 16 + l15] = f2bf(-X[r]);
        u32x2 o; o.x = pk2(-X[0], -X[1]); o.y = pk2(-X[2], -X[3]);
        *(LAS u32x2*)(Xtr + (I0 * 16 + l15) * 144 + (I1 * 16 + q4 * 4) * 2) = o;
    }
    lds_barrier();
    {
        const int mi = mt >> 1, ni = mt & 1;
        const bf16x8 a = ldfrag(Lrow, 144, 32 + mi * 16 + l15, q4 * 16), b = ldfrag(Xtr, 144, ni * 16 + l15, q4 * 16);
        const f32x4 M2 = MFMA16(a, b, zero4);
        { u32x2 o; o.x = pk2(M2[0], M2[1]); o.y = pk2(M2[2], M2[3]); *(LAS u32x2*)(M2t + (ni * 16 + l15) * 80 + (mi * 16 + q4 * 4) * 2) = o; }
        lds_barrier();
        const bf16x8 a2 = ldfrag(Xrow, 144, 32 + mi * 16 + l15, 64 + q4 * 16), b2 = *(const LAS bf16x8*)(M2t + (ni * 16 + l15) * 80 + q4 * 16);
        const f32x4 X = MFMA16(a2, b2, zero4);
#pragma unroll
        for (int r = 0; r < 4; ++r) { CHK(F, 6, badv(X[r], 20.f)); ((LAS bf16_t*)Xrow)[(32 + mi * 16 + q4 * 4 + r) * 72 + ni * 16 + l15] = f2bf(-X[r]); }
        u32x2 o; o.x = pk2(-X[0], -X[1]); o.y = pk2(-X[2], -X[3]);
        *(LAS u32x2*)(Xtr + (ni * 16 + l15) * 144 + (32 + mi * 16 + q4 * 4) * 2) = o;
    }
    lds_barrier();
    { bf16_t* dst = F.TA() + (size_t)(ci * 8 + h) * 8192;
      const int c = tid >> 3, s0 = (tid & 7) * 8;
      const u32x4 lo = *(const LAS u32x4*)(DIR0 + 18432 + c * 144 + s0 * 2), up = *(const LAS u32x4*)(DIR0 + 46848 + 27648 + c * 144 + s0 * 2);
      unsigned wl[4] = {lo.x, lo.y, lo.z, lo.w}, wu[4] = {up.x, up.y, up.z, up.w}, wo[4];
#pragma unroll
      for (int i = 0; i < 4; ++i) { const int sa = s0 + 2 * i, sb2 = sa + 1;
          const unsigned mlo = (sa <= c ? 0x0000FFFFu : 0u) | (sb2 <= c ? 0xFFFF0000u : 0u);
          wo[i] = (wl[i] & mlo) | (wu[i] & ~mlo); }
      *(u32x4*)(dst + tid * 8) = (u32x4){wo[0], wo[1], wo[2], wo[3]};
      *(u32x4*)(dst + 4096 + tid * 8) = *(const LAS u32x4*)(ATo + tid * 16); }
    lds_barrier();
}

struct RgW { bf16x8 g[2][2][4]; float br[2], bi[2], sp[2]; };
__device__ __forceinline__ void rg_load_w(CParams& p, const Frame& F, int n, RgW& W) {
    const int q4 = F.lane >> 4, j = F.wave * 16 + (F.lane & 15), ch = n * 128 + j;
#pragma unroll
    for (int d = 0; d < 2; ++d) {
#pragma unroll
        for (int g = 0; g < 2; ++g) { const bf16_t* gp = F.GT() + (size_t)((g * 2 + d) * 8 + n) * 16384 + (size_t)j * 128 + q4 * 8;
#pragma unroll
            for (int ks = 0; ks < 4; ++ks) W.g[d][g][ks] = *(const bf16x8*)(gp + ks * 32); }
        W.br[d] = p.rg_b_r[d * 1024 + ch]; W.bi[d] = p.rg_b_i[d * 1024 + ch]; W.sp[d] = softplusf_(-p.rg_lam[d * 1024 + ch]); }
}
__device__ __forceinline__ void rg_load_rows(const Frame& F, int ci, int n, u32x4 (&rows)[5]) {
    const int tid = F.tid, tg = tid >> 4, sub = tid & 15, col = 4096 + n * 128 + sub * 8, t0 = ci * 64;
    int c_lo, c_hi; if (ci < 128) { c_lo = (ci >> 2) * 4; c_hi = c_lo + 4; } else { c_lo = 128 + ((ci - 128) >> 6) * 64; c_hi = c_lo + 64; }
    const int tb = t0 + tg * 2 - 2;
#pragma unroll
    for (int r = 0; r < 5; ++r) { const int tok = tb + r; u32x4 v = {0u, 0u, 0u, 0u};
        if (tok >= c_lo * 64 && tok < c_hi * 64) v = *(const u32x4*)(F.PROJ() + (size_t)tok * NPROJ + col);
        rows[r] = v; }
}
template <int PASS>
__device__ __forceinline__ void rg_item(CParams& p, Frame& F, int ci, int n, u32x4 (&rows)[5], int itn) {
    const int tid = F.tid, lane = F.lane, wave = F.wave, q4 = lane >> 4, l15 = lane & 15;
    LAS unsigned char* xb = F.lds; LAS float* xf = (LAS float*)(F.lds + 17408); LAS float* Hs = (LAS float*)(F.lds + 50176);
    const int t0 = ci * 64;
    int seq_lo, seq_hi, c_lo, c_hi, seq; const bool samp = ci >= 128;
    if (!samp) { seq = ci >> 2; c_lo = seq * 4; c_hi = c_lo + 4; } else { seq = (ci - 128) >> 6; c_lo = 128 + seq * 64; c_hi = c_lo + 64; }
    seq_lo = c_lo * 64; seq_hi = c_hi * 64;
    const int j = wave * 16 + l15, ch = n * 128 + j;
    bf16x8 wA[2][4], wB[2][4];
#pragma unroll
    for (int g = 0; g < 2; ++g) { const bf16_t* gp = F.GT() + (size_t)((g * 2 + 0) * 8 + n) * 16384 + (size_t)j * 128 + q4 * 8;
#pragma unroll
        for (int ks = 0; ks < 4; ++ks) wA[g][ks] = *(const bf16x8*)(gp + ks * 32); }
    {
        const int tg = tid >> 4, sub = tid & 15, ch = n * 128 + sub * 8;
        float w[4][8], acc[2][8];
#pragma unroll
        for (int j = 0; j < 4; ++j) { const f32x4 a = *(const f32x4*)(p.rg_conv_w + j * 1024 + ch), b = *(const f32x4*)(p.rg_conv_w + j * 1024 + ch + 4);
            w[j][0] = a[0]; w[j][1] = a[1]; w[j][2] = a[2]; w[j][3] = a[3]; w[j][4] = b[0]; w[j][5] = b[1]; w[j][6] = b[2]; w[j][7] = b[3]; }
        { const f32x4 a = *(const f32x4*)(p.rg_conv_b + ch), b = *(const f32x4*)(p.rg_conv_b + ch + 4);
#pragma unroll
          for (int i = 0; i < 2; ++i) { acc[i][0] = a[0]; acc[i][1] = a[1]; acc[i][2] = a[2]; acc[i][3] = a[3]; acc[i][4] = b[0]; acc[i][5] = b[1]; acc[i][6] = b[2]; acc[i][7] = b[3]; } }
#pragma unroll
        for (int r = 0; r < 5; ++r) {
            float x[8]; unpack8(rows[r], x);
#pragma unroll
            for (int j = 0; j < 4; ++j) { const int i = r - j; if (i >= 0 && i < 2) {
#pragma unroll
                for (int e = 0; e < 8; ++e) acc[i][e] += w[j][e] * x[e]; } } }
#pragma unroll
        for (int i = 0; i < 2; ++i) { const int c = tg * 2 + i;
            *(LAS u32x4*)(xb + c * 272 + sub * 16) = pack8(acc[i]);
            *(LAS f32x4*)(xf + c * 128 + sub * 8) = (f32x4){acc[i][0], acc[i][1], acc[i][2], acc[i][3]};
            *(LAS f32x4*)(xf + c * 128 + sub * 8 + 4) = (f32x4){acc[i][4], acc[i][5], acc[i][6], acc[i][7]}; }
    }
    lds_barrier();
    f32x4 hs[4];
#pragma unroll
    for (int m = 0; m < 4; ++m) hs[m] = (f32x4){0.f, 0.f, 0.f, 0.f};
#pragma unroll
    for (int d = 0; d < 2; ++d) {
        f32x4 av[4], bxv[4];
        {
            f32x4 ar[4], ai[4];
#pragma unroll
            for (int m = 0; m < 4; ++m) { ar[m] = (f32x4){0.f, 0.f, 0.f, 0.f}; ai[m] = (f32x4){0.f, 0.f, 0.f, 0.f}; }
#pragma unroll
            for (int ks = 0; ks < 4; ++ks) { const bf16x8 br = d == 0 ? wA[0][ks] : wB[0][ks], bi = d == 0 ? wA[1][ks] : wB[1][ks];
#pragma unroll
                for (int m = 0; m < 4; ++m) { const bf16x8 a = ldfrag(xb, 272, m * 16 + l15, ks * 64 + q4 * 16); ar[m] = MFMA16(a, br, ar[m]); ai[m] = MFMA16(a, bi, ai[m]); } }
            if (d == 0) {
#pragma unroll
                for (int g = 0; g < 2; ++g) { const bf16_t* gp = F.GT() + (size_t)((g * 2 + 1) * 8 + n) * 16384 + (size_t)j * 128 + q4 * 8;
#pragma unroll
                    for (int ks = 0; ks < 4; ++ks) wB[g][ks] = *(const bf16x8*)(gp + ks * 32); } }
            const float L2E = 1.4426950408889634f;
            const float br_ = -L2E * p.rg_b_r[d * 1024 + ch], bi_ = -L2E * p.rg_b_i[d * 1024 + ch], sp = softplusf_(-p.rg_lam[d * 1024 + ch]);
            const float k2 = -16.f * sp, k2e = k2 * L2E, k1e = 0.5f * k2e;
#pragma unroll
            for (int m = 0; m < 4; ++m)
#pragma unroll
                for (int r = 0; r < 4; ++r) { const int c = m * 16 + q4 * 4 + r;
                    const float rr = __builtin_amdgcn_rcpf(1.f + __builtin_amdgcn_exp2f(fmaf(ar[m][r], -L2E, br_)));
                    const float ii = __builtin_amdgcn_rcpf(1.f + __builtin_amdgcn_exp2f(fmaf(ai[m][r], -L2E, bi_)));
                    const float t2 = k2 * rr;
                    const float ser = t2 * fmaf(t2, fmaf(t2, 0.16666667f, 0.5f), 1.f);
                    const float a_ = __builtin_amdgcn_exp2f(k1e * rr);
                    const float em = t2 > -0.01f ? ser : fmaf(a_, a_, -1.f);
                    av[m][r] = a_; bxv[m][r] = __builtin_amdgcn_sqrtf(-em) * (ii * xf[c * 128 + j]); }
        }
        f32x4 Pa[4], Pb[4]; float Ap[4], Bp[4], Am[4], Bm[4];
#pragma unroll
        for (int m = 0; m < 4; ++m) {
            float pa, pb;
            if (d == 0) { pa = av[m][0]; pb = bxv[m][0]; Pa[m][0] = pa; Pb[m][0] = pb;
#pragma unroll
                for (int r = 1; r < 4; ++r) { pb = av[m][r] * pb + bxv[m][r]; pa = av[m][r] * pa; Pa[m][r] = pa; Pb[m][r] = pb; } }
            else { pa = av[m][3]; pb = bxv[m][3]; Pa[m][3] = pa; Pb[m][3] = pb;
#pragma unroll
                for (int r = 2; r >= 0; --r) { pb = av[m][r] * pb + bxv[m][r]; pa = av[m][r] * pa; Pa[m][r] = pa; Pb[m][r] = pb; } }
            float Ak[4], Bk[4];
#pragma unroll
            for (int k = 0; k < 4; ++k) { Ak[k] = __shfl(pa, l15 + 16 * k); Bk[k] = __shfl(pb, l15 + 16 * k); }
            float ap = 1.f, bp = 0.f, am = 1.f, bm = 0.f;
#pragma unroll
            for (int kk = 0; kk < 4; ++kk) { const int k = d == 0 ? kk : 3 - kk;
                const bool before = d == 0 ? (k < q4) : (k > q4);
                const float nb = Ak[k] * bp + Bk[k], na = Ak[k] * ap;
                bp = before ? nb : bp; ap = before ? na : ap;
                bm = Ak[k] * bm + Bk[k]; am = Ak[k] * am; }
            Ap[m] = ap; Bp[m] = bp; Am[m] = am; Bm[m] = bm;
        }
        if (PASS == 1) {
            float At = 1.f, Bt = 0.f;
#pragma unroll
            for (int mm = 0; mm < 4; ++mm) { const int m = d == 0 ? mm : 3 - mm; Bt = Am[m] * Bt + Bm[m]; At = Am[m] * At; }
            if (q4 == 0) { float* ag = F.RGAGG() + (size_t)(ci * 2 + d) * 2048; ag[ch] = At; ag[1024 + ch] = Bt; }
        } else {
            float hb = F.CARRY()[(size_t)(ci * 2 + d) * 1024 + ch];
#pragma unroll
            for (int mm = 0; mm < 4; ++mm) { const int m = d == 0 ? mm : 3 - mm;
                const float hin = Ap[m] * hb + Bp[m];
#pragma unroll
                for (int r = 0; r < 4; ++r) hs[m][r] += Pa[m][r] * hin + Pb[m][r];
                hb = Am[m] * hb + Bm[m]; }
            if (!samp && q4 == 0 && ci == (d == 0 ? c_hi - 1 : c_lo)) F.out[OUT_SR + (size_t)(seq * 2 + d) * 1024 + ch] = hb;
        }
    }
    if (PASS == 1 && itn < 1024) rg_load_rows(F, 128 + (itn >> 3), itn & 7, rows);
    if (PASS == 3) {
#pragma unroll
        for (int m = 0; m < 4; ++m)
#pragma unroll
            for (int r = 0; r < 4; ++r) Hs[(m * 16 + q4 * 4 + r) * 128 + j] = hs[m][r];
        lds_barrier();
#pragma unroll
        for (int i = 0; i < 2; ++i) { const int chunk = tid + 512 * i, c = chunk >> 4, cc = chunk & 15;
            const u32x4 gv = *(const u32x4*)(F.PROJ() + (size_t)(t0 + c) * NPROJ + 5120 + n * 128 + cc * 8);
            float g[8]; unpack8(gv, g);
            const f32x4 ha = *(const LAS f32x4*)(Hs + c * 128 + cc * 8), hb2 = *(const LAS f32x4*)(Hs + c * 128 + cc * 8 + 4);
            float o[8];
#pragma unroll
            for (int e = 0; e < 4; ++e) { o[e] = ha[e] * siluf_(g[e]); o[4 + e] = hb2[e] * siluf_(g[4 + e]); }
            *(u32x4*)(F.MIX() + (size_t)(t0 + c) * 2048 + 1024 + n * 128 + cc * 8) = pack8(o); }
    }
    lds_barrier();
}

__device__ __forceinline__ void rg_conv_lds(CParams& p, const Frame& F, int n, const u32x4 (&rows)[5], LAS unsigned char* xb, LAS float* xf) {
    const int tid = F.tid, tg = tid >> 4, sub = tid & 15, ch = n * 128 + sub * 8;
    float w[4][8], acc[2][8];
#pragma unroll
    for (int j = 0; j < 4; ++j) { const f32x4 a = *(const f32x4*)(p.rg_conv_w + j * 1024 + ch), b = *(const f32x4*)(p.rg_conv_w + j * 1024 + ch + 4);
        w[j][0] = a[0]; w[j][1] = a[1]; w[j][2] = a[2]; w[j][3] = a[3]; w[j][4] = b[0]; w[j][5] = b[1]; w[j][6] = b[2]; w[j][7] = b[3]; }
    { const f32x4 a = *(const f32x4*)(p.rg_conv_b + ch), b = *(const f32x4*)(p.rg_conv_b + ch + 4);
#pragma unroll
      for (int i = 0; i < 2; ++i) { acc[i][0] = a[0]; acc[i][1] = a[1]; acc[i][2] = a[2]; acc[i][3] = a[3]; acc[i][4] = b[0]; acc[i][5] = b[1]; acc[i][6] = b[2]; acc[i][7] = b[3]; } }
#pragma unroll
    for (int r = 0; r < 5; ++r) { float x[8]; unpack8(rows[r], x);
#pragma unroll
        for (int j = 0; j < 4; ++j) { const int i = r - j; if (i >= 0 && i < 2) {
#pragma unroll
            for (int e = 0; e < 8; ++e) acc[i][e] += w[j][e] * x[e]; } } }
#pragma unroll
    for (int i = 0; i < 2; ++i) { const int c = tg * 2 + i;
        *(LAS u32x4*)(xb + c * 272 + sub * 16) = pack8(acc[i]);
        *(LAS f32x4*)(xf + c * 128 + sub * 8) = (f32x4){acc[i][0], acc[i][1], acc[i][2], acc[i][3]};
        *(LAS f32x4*)(xf + c * 128 + sub * 8 + 4) = (f32x4){acc[i][4], acc[i][5], acc[i][6], acc[i][7]}; }
}
template <int D>
__device__ __forceinline__ void rg_gate_scan(const Frame& F, const bf16x8 (&wg)[2][4], float br_, float bi_, float sp, const LAS unsigned char* xb, const LAS float* xf, int j,
                                             f32x4 (&Pa)[4], f32x4 (&Pb)[4], float (&Ap)[4], float (&Bp)[4], float (&Am)[4], float (&Bm)[4]) {
    const int lane = F.lane, q4 = lane >> 4, l15 = lane & 15;
    f32x4 av[4], bxv[4];
    {
        f32x4 ar[4], ai[4];
#pragma unroll
        for (int m = 0; m < 4; ++m) { ar[m] = (f32x4){0.f, 0.f, 0.f, 0.f}; ai[m] = (f32x4){0.f, 0.f, 0.f, 0.f}; }
#pragma unroll
        for (int ks = 0; ks < 4; ++ks) {
#pragma unroll
            for (int m = 0; m < 4; ++m) { const bf16x8 a = ldfrag(xb, 272, m * 16 + l15, ks * 64 + q4 * 16); ar[m] = MFMA16(a, wg[0][ks], ar[m]); ai[m] = MFMA16(a, wg[1][ks], ai[m]); } }
        const float L2E = 1.4426950408889634f;
        const float brs = -L2E * br_, bis = -L2E * bi_, k2 = -16.f * sp, k1e = 0.5f * k2 * L2E;
#pragma unroll
        for (int m = 0; m < 4; ++m)
#pragma unroll
            for (int r = 0; r < 4; ++r) { const int c = m * 16 + q4 * 4 + r;
                const float rr = __builtin_amdgcn_rcpf(1.f + __builtin_amdgcn_exp2f(fmaf(ar[m][r], -L2E, brs)));
                const float ii = __builtin_amdgcn_rcpf(1.f + __builtin_amdgcn_exp2f(fmaf(ai[m][r], -L2E, bis)));
                const float t2 = k2 * rr, a = __builtin_amdgcn_exp2f(k1e * rr);
                const float ser = t2 * fmaf(t2, fmaf(t2, 0.16666667f, 0.5f), 1.f);
                const float em = t2 > -0.01f ? ser : fmaf(a, a, -1.f);
                av[m][r] = a; bxv[m][r] = __builtin_amdgcn_sqrtf(-em) * (ii * xf[c * 128 + j]); }
    }
#pragma unroll
    for (int m = 0; m < 4; ++m) {
        float pa, pb;
        if (D == 0) { pa = av[m][0]; pb = bxv[m][0]; Pa[m][0] = pa; Pb[m][0] = pb;
#pragma unroll
            for (int r = 1; r < 4; ++r) { pb = av[m][r] * pb + bxv[m][r]; pa = av[m][r] * pa; Pa[m][r] = pa; Pb[m][r] = pb; } }
        else { pa = av[m][3]; pb = bxv[m][3]; Pa[m][3] = pa; Pb[m][3] = pb;
#pragma unroll
            for (int r = 2; r >= 0; --r) { pb = av[m][r] * pb + bxv[m][r]; pa = av[m][r] * pa; Pa[m][r] = pa; Pb[m][r] = pb; } }
        float Ak[4], Bk[4];
#pragma unroll
        for (int k = 0; k < 4; ++k) { Ak[k] = __shfl(pa, l15 + 16 * k); Bk[k] = __shfl(pb, l15 + 16 * k); }
        float ap = 1.f, bp = 0.f, am = 1.f, bm = 0.f;
#pragma unroll
        for (int kk = 0; kk < 4; ++kk) { const int k = D == 0 ? kk : 3 - kk;
            const bool before = D == 0 ? (k < q4) : (k > q4);
            const float nb = Ak[k] * bp + Bk[k], na = Ak[k] * ap;
            bp = before ? nb : bp; ap = before ? na : ap;
            bm = Ak[k] * bm + Bk[k]; am = Ak[k] * am; }
        Ap[m] = ap; Bp[m] = bp; Am[m] = am; Bm[m] = bm;
    }
}
template <int D>
__device__ __forceinline__ void rg_prompt_dir(CParams& p, Frame& F, int seq, int n) {
    const int tid = F.tid, lane = F.lane, wave = F.wave, q4 = lane >> 4, l15 = lane & 15;
    LAS unsigned char* xb = F.lds; LAS float* xf = (LAS float*)(F.lds + 17408); LAS float* Hs = (LAS float*)(F.lds + 50176); LAS bf16_t* Hf = (LAS bf16_t*)(F.lds + 82944);
    const int j = wave * 16 + l15, ch = n * 128 + j;
    bf16x8 wg[2][4];
#pragma unroll
    for (int g = 0; g < 2; ++g) { const bf16_t* gp = F.GT() + (size_t)((g * 2 + D) * 8 + n) * 16384 + (size_t)j * 128 + q4 * 8;
#pragma unroll
        for (int ks = 0; ks < 4; ++ks) wg[g][ks] = *(const bf16x8*)(gp + ks * 32); }
    const float br_ = p.rg_b_r[D * 1024 + ch], bi_ = p.rg_b_i[D * 1024 + ch], sp = softplusf_(-p.rg_lam[D * 1024 + ch]);
    float hb = 0.f;
    u32x4 rows[5];
    rg_load_rows(F, seq * 4 + (D == 0 ? 0 : 3), n, rows);
#pragma unroll 1
    for (int cs = 0; cs < 4; ++cs) {
        const int cidx = D == 0 ? cs : 3 - cs, ci = seq * 4 + cidx, t0 = ci * 64;
        rg_conv_lds(p, F, n, rows, xb, xf);
        if (cs < 3) rg_load_rows(F, seq * 4 + (D == 0 ? cidx + 1 : cidx - 1), n, rows);
        lds_barrier();
        f32x4 Pa[4], Pb[4]; float Ap[4], Bp[4], Am[4], Bm[4];
        rg_gate_scan<D>(F, wg, br_, bi_, sp, xb, xf, j, Pa, Pb, Ap, Bp, Am, Bm);
#pragma unroll
        for (int mm = 0; mm < 4; ++mm) { const int m = D == 0 ? mm : 3 - mm;
            const float hin = Ap[m] * hb + Bp[m];
#pragma unroll
            for (int r = 0; r < 4; ++r) { const float hv = Pa[m][r] * hin + Pb[m][r]; const int tl = m * 16 + q4 * 4 + r;
                if (D == 0) Hf[(cidx * 64 + tl) * 128 + j] = f2bf(hv);
                else Hs[tl * 128 + j] = hv + bf2f(Hf[(cidx * 64 + tl) * 128 + j]); }
            hb = Am[m] * hb + Bm[m]; }
        lds_barrier();
        if (D == 1) {
#pragma unroll
            for (int i = 0; i < 2; ++i) { const int chunk = tid + 512 * i, c = chunk >> 4, cc = chunk & 15;
                bf16_t* gp = F.PROJ() + (size_t)(t0 + c) * NPROJ + 5120 + n * 128 + cc * 8;
                const u32x4 gv = *(const u32x4*)gp; float g[8]; unpack8(gv, g);
                const f32x4 ha = *(const LAS f32x4*)(Hs + c * 128 + cc * 8), hb2 = *(const LAS f32x4*)(Hs + c * 128 + cc * 8 + 4);
                float o[8];
#pragma unroll
                for (int e = 0; e < 4; ++e) { o[e] = ha[e] * siluf_(g[e]); o[4 + e] = hb2[e] * siluf_(g[4 + e]); }
                *(u32x4*)gp = pack8(o); }
            lds_barrier();
        }
    }
    if (q4 == 0) F.out[OUT_SR + (size_t)(seq * 2 + D) * 1024 + ch] = hb;
}

__device__ __forceinline__ void rg_carry_scan(CParams& p, Frame& F) {
    const int tid = F.tid;
    int samp, seq, d, ch;
    if (tid < 256) return;
    else if (tid < 272) { const int g = F.b * 16 + tid - 256; if (g >= 4096) return; samp = 1; seq = g >> 11; d = (g >> 10) & 1; ch = g & 1023; }
    else return;
    const int nch = samp ? 64 : 4, c_lo = samp ? 128 + seq * 64 : seq * 4;
    float h = samp ? p.state_rglru[(size_t)(seq * 2 + d) * 1024 + ch] : 0.f;
    for (int i0 = 0; i0 < nch; i0 += 4) {
        float A[4], B[4];
#pragma unroll
        for (int u = 0; u < 4; ++u) { const int cc = d == 0 ? c_lo + i0 + u : c_lo + nch - 1 - i0 - u; const float* ag = F.RGAGG() + (size_t)(cc * 2 + d) * 2048; A[u] = ag[ch]; B[u] = ag[1024 + ch]; }
#pragma unroll
        for (int u = 0; u < 4; ++u) { const int cc = d == 0 ? c_lo + i0 + u : c_lo + nch - 1 - i0 - u; F.CARRY()[(size_t)(cc * 2 + d) * 1024 + ch] = h; h = A[u] * h + B[u]; }
    }
}

__device__ __forceinline__ void phase3(CParams& p, Frame& F) {
    for (int rep = 0; rep < (REP_PHASE == 30 ? 2 : 1); ++rep)
    for (int it = F.b; it < 2048; it += F.G) { u32x4 rows[7]; p3_load_rows(F, it >> 3, it & 7, rows); p3_delta_item(p, F, it >> 3, it & 7, rows, it + F.G); }
    for (int rep = 0; rep < (REP_PHASE == 31 ? 2 : 1); ++rep) {
    u32x4 rows[5]; if (F.b < 1024) rg_load_rows(F, 128 + (F.b >> 3), F.b & 7, rows);
    for (int it = F.b; it < 1024; it += F.G) rg_item<1>(p, F, 128 + (it >> 3), it & 7, rows, it + F.G); }
    for (int it = F.b; it < 256; it += F.G) { rg_prompt_dir<0>(p, F, it >> 3, it & 7); rg_prompt_dir<1>(p, F, it >> 3, it & 7); }
}

struct P4D { int valid, samp, seq, h, d, sl, ci, seq_lo, seq_hi, last, k, s, nch; };
__device__ __forceinline__ P4D p4_desc(const Frame& F, int k, int s) {
    P4D D; int item;
    if (F.G == 256) {
        const int x = F.b & 7, y = F.b >> 3;
        if (y < 16) { item = (x * 4 + (y >> 2)) * 4 + (y & 3); D.valid = k < 1; }
        else { const int j = y - 16; item = 128 + (x * 64 + (j >> 2) * 16 + k) * 4 + (j & 3); D.valid = k < 16; } }
    else { item = F.b + k * F.G; D.valid = item < 2176; }
    D.samp = item < 128; const int it = D.samp ? item : item - 128, chain = it >> 2;
    D.sl = it & 3; D.seq = chain >> 4; D.h = (chain >> 1) & 7; D.d = chain & 1;
    D.nch = D.samp ? 64 : 4; const int chunk0 = D.samp ? 128 + D.seq * 64 : D.seq * 4;
    D.seq_lo = chunk0 * 64; D.seq_hi = D.seq_lo + D.nch * 64;
    D.ci = D.d == 0 ? chunk0 + s : chunk0 + D.nch - 1 - s; D.last = s == D.nch - 1; D.k = k; D.s = s;
    return D;
}
__device__ __forceinline__ P4D p4_next(const Frame& F, const P4D& D) {
    if (D.s + 1 < D.nch) { P4D N = D; N.s = D.s + 1; N.ci = D.ci + (D.d == 0 ? 1 : -1); N.last = N.s == D.nch - 1; return N; }
    return p4_desc(F, D.k + 1, 0);
}
struct P4Pre { u32x4 k0, k1, q0, q1, ti, at; u32x2 v[4]; float g, b, bc; };
struct P4T { unsigned oKQ, oTA, oV, oG, oGc; int cj; };
__device__ __forceinline__ P4T p4_thread_consts(int tid) {
    P4T T; T.oKQ = (unsigned)(((tid >> 4) * 1024 + (tid & 15) * 8) * 2); T.oTA = (unsigned)tid * 16u;
    T.oV = (unsigned)(((tid >> 3) * NPROJ + (tid & 7) * 4) * 2); T.oG = (unsigned)(tid & 63) * 4u; T.oGc = (unsigned)(tid >> 3) * 4u; T.cj = (tid >> 3) - 2; return T;
}
__device__ __forceinline__ void p4_prefetch(CParams& p, const Frame& F, P4Pre& R, const P4D& D, const P4T& T) {
    const int tid = F.tid, t0 = D.ci * 64, h = D.h;
    const char* kb = (const char*)F.Kc() + (size_t)(D.ci * 8 + h) * 16384;
    const char* qb = (const char*)F.Qc() + ((size_t)t0 * 1024 + h * 128) * 2;
    const char* tb = (const char*)F.TA() + (size_t)(D.ci * 8 + h) * 16384;
    const char* vb = (const char*)F.PROJ() + ((long)(t0 - 2) * NPROJ + 2048 + h * 128 + D.sl * 32) * 2;
    const char* gb = (const char*)F.GB() + (size_t)(D.ci * 8 + h) * 1024 + D.d * 256;
    R.k0 = *(const u32x4*)(kb + T.oTA); R.k1 = *(const u32x4*)(kb + T.oTA + 8192u);
    R.q0 = *(const u32x4*)(qb + T.oKQ); R.q1 = *(const u32x4*)(qb + T.oKQ + 65536u);
    R.ti = *(const u32x4*)(tb + T.oTA); R.at = *(const u32x4*)(tb + T.oTA + 8192u);
#pragma unroll
    for (int j = 0; j < 4; ++j) { const int tok = t0 + T.cj + j; u32x2 v = {0u, 0u};
        if (tok >= D.seq_lo && tok < D.seq_hi) v = *(const u32x2*)(vb + T.oV + (unsigned)(j * NPROJ * 2));
        R.v[j] = v; }
    R.bc = *(const float*)(gb + 512 + T.oGc);
    R.g = 0.f; R.b = 0.f;
    if (tid < 64) { R.g = *(const float*)(gb + T.oG); R.b = *(const float*)(gb + 512 + T.oG); }
}
__device__ __forceinline__ u32x4 tri_mask(u32x4 v, int c, int s0, int d) {
    unsigned w[4] = {v.x, v.y, v.z, v.w};
#pragma unroll
    for (int i = 0; i < 4; ++i) { const int slo = s0 + 2 * i, shi = slo + 1;
        const bool klo = d == 0 ? (c >= slo) : (c <= slo), khi = d == 0 ? (c >= shi) : (c <= shi);
        w[i] &= (klo ? 0x0000FFFFu : 0u) | (khi ? 0xFFFF0000u : 0u); }
    return (u32x4){w[0], w[1], w[2], w[3]};
}
constexpr int P4_KS = 0, P4_TI = 17408, P4_VBT = 26624, P4_WL = 31232, P4_SB = 48640, P4_VT1 = 57344, P4_VT2 = 61952, P4_QS = 66560, P4_AT = 101376, P4_GV = 119808, P4_KT = 122368;
__device__ __forceinline__ void p4_stage(CParams& p, const Frame& F, const P4Pre& R, const P4D& D, int buf, const unsigned (&mk)[2][4], f32x4 (&cw)[4], const f32x4 (&cwn)[4]) {
    const int tid = F.tid, d = D.d;
    LAS unsigned char* Ks = F.lds + P4_KS; LAS unsigned char* Qs = F.lds + P4_QS + buf * 17408; LAS unsigned char* TIs = F.lds + P4_TI;
    LAS unsigned char* ATs = F.lds + P4_AT + buf * 9216; LAS unsigned char* Vbt = F.lds + P4_VBT; LAS float* gv = (LAS float*)(F.lds + P4_GV + buf * 1280);
    { const int row = tid >> 4, cc = tid & 15;
      *(LAS u32x4*)(Qs + row * 272 + cc * 16) = R.q0; *(LAS u32x4*)(Qs + (32 + row) * 272 + cc * 16) = R.q1; }
    { const int dk = tid >> 3, cp = tid & 7; LAS unsigned char* Kts = F.lds + P4_KT;
      *(LAS u32x4*)(Kts + dk * 144 + cp * 16) = R.k0; *(LAS u32x4*)(Kts + (64 + dk) * 144 + cp * 16) = R.k1; }
    { const int c = tid >> 3, s0 = (tid & 7) * 8;
      const unsigned m0 = d ? mk[1][0] : mk[0][0], m1 = d ? mk[1][1] : mk[0][1], m2 = d ? mk[1][2] : mk[0][2], m3 = d ? mk[1][3] : mk[0][3];
      *(LAS u32x4*)(TIs + c * 144 + s0 * 2) = (u32x4){R.ti.x & m0, R.ti.y & m1, R.ti.z & m2, R.ti.w & m3};
      *(LAS u32x4*)(ATs + c * 144 + s0 * 2) = (u32x4){R.at.x & m0, R.at.y & m1, R.at.z & m2, R.at.w & m3}; }
    { const int c = tid >> 3, e0 = (tid & 7) * 4; float o[4] = {0.f, 0.f, 0.f, 0.f};
      if (D.s == 0) {
#pragma unroll
          for (int j = 0; j < 4; ++j) cw[j] = cwn[j]; }
#pragma unroll
      for (int j = 0; j < 4; ++j) { const u32x2 v = R.v[j];
          o[0] += cw[j][0] * __uint_as_float(v.x << 16); o[1] += cw[j][1] * __uint_as_float(v.x & 0xffff0000u);
          o[2] += cw[j][2] * __uint_as_float(v.y << 16); o[3] += cw[j][3] * __uint_as_float(v.y & 0xffff0000u); }
#pragma unroll
      for (int i = 0; i < 4; ++i) ((LAS bf16_t*)Vbt)[(e0 + i) * 72 + c] = f2bf(siluf_(o[i]) * R.bc); }
    if (tid < 64) {
        const float glast = __shfl(R.g, d == 0 ? 63 : 0), eg = __expf(R.g);
        gv[tid] = eg; gv[64 + tid] = R.b * eg; gv[128 + tid] = __expf(glast - R.g); if (tid == 0) gv[192] = __expf(glast);
    }
}
__device__ __forceinline__ void phase4_chains(CParams& p, Frame& F) {
    const int tid = F.tid, lane = F.lane, wave = F.wave, q4 = lane >> 4, l15 = lane & 15;
    LAS unsigned char* Ks = F.lds + P4_KS; LAS unsigned char* TIs = F.lds + P4_TI; LAS unsigned char* Vbt = F.lds + P4_VBT; LAS unsigned char* Wl = F.lds + P4_WL;
    LAS unsigned char* Sb = F.lds + P4_SB; LAS unsigned char* Vt1 = F.lds + P4_VT1; LAS unsigned char* Vt2 = F.lds + P4_VT2;
    const int ct = wave & 3, et = wave >> 2;
    P4D Dc = p4_desc(F, 0, 0);
    if (!Dc.valid) return;
    P4Pre RA, RB;
    f32x4 S[2], U; bf16x8 KT[2];
    unsigned mk[2][4]; f32x4 cw[4], cwn[4];
    { const int c = tid >> 3, s0 = (tid & 7) * 8;
#pragma unroll
      for (int i = 0; i < 4; ++i) { const int slo = s0 + 2 * i, shi = slo + 1;
          mk[0][i] = (c >= slo ? 0x0000FFFFu : 0u) | (c >= shi ? 0xFFFF0000u : 0u); mk[1][i] = (c <= slo ? 0x0000FFFFu : 0u) | (c <= shi ? 0xFFFF0000u : 0u); } }
#define P4_INIT_S(D) do { _Pragma("unroll") for (int nt = 0; nt < 2; ++nt) _Pragma("unroll") for (int r = 0; r < 4; ++r) \
        S[nt][r] = (D).samp ? p.state_delta[(size_t)(((D).seq * 2 + (D).d) * 8 + (D).h) * 16384 + (size_t)(wave * 16 + q4 * 4 + r) * 128 + (D).sl * 32 + nt * 16 + l15] : 0.f; } while (0)
#define P4_WRITE_SB() do { _Pragma("unroll") for (int nt = 0; nt < 2; ++nt) { u32x2 o_; o_.x = pk2(S[nt][0], S[nt][1]); o_.y = pk2(S[nt][2], S[nt][3]); \
        *(LAS u32x2*)(Sb + (nt * 16 + l15) * 272 + (wave * 16 + q4 * 4) * 2) = o_; } } while (0)
#define P4_PRECOMP(buf_) do { const LAS float* gv_ = (const LAS float*)(F.lds + P4_GV + (buf_) * 1280); \
        f32x4 WT[4]; _Pragma("unroll") for (int c_ = 0; c_ < 4; ++c_) WT[c_] = (f32x4){0.f, 0.f, 0.f, 0.f}; \
        _Pragma("unroll") for (int ks = 0; ks < 2; ++ks) { \
            const u32x4 kraw = *(const LAS u32x4*)(F.lds + P4_KT + (wave * 16 + l15) * 144 + ks * 64 + q4 * 16); KT[ks] = __builtin_bit_cast(bf16x8, kraw); \
            const f32x4 sa = *(const LAS f32x4*)(gv_ + 64 + ks * 32 + q4 * 8), sb_ = *(const LAS f32x4*)(gv_ + 64 + ks * 32 + q4 * 8 + 4); \
            float kf[8]; unpack8(kraw, kf); u32x4 kg; \
            kg.x = pk2(kf[0] * sa[0], kf[1] * sa[1]); kg.y = pk2(kf[2] * sa[2], kf[3] * sa[3]); kg.z = pk2(kf[4] * sb_[0], kf[5] * sb_[1]); kg.w = pk2(kf[6] * sb_[2], kf[7] * sb_[3]); \
            const bf16x8 akg = __builtin_bit_cast(bf16x8, kg); \
            _Pragma("unroll") for (int c_ = 0; c_ < 4; ++c_) { const bf16x8 bt = ldfrag(TIs, 144, c_ * 16 + l15, ks * 64 + q4 * 16); WT[c_] = MFMA16(akg, bt, WT[c_]); } } \
        _Pragma("unroll") for (int c_ = 0; c_ < 4; ++c_) { u32x2 o_; o_.x = pk2(WT[c_][0], WT[c_][1]); o_.y = pk2(WT[c_][2], WT[c_][3]); \
            *(LAS u32x2*)(Wl + (c_ * 16 + l15) * 272 + (wave * 16 + q4 * 4) * 2) = o_; } \
        U = (f32x4){0.f, 0.f, 0.f, 0.f}; \
        _Pragma("unroll") for (int ks = 0; ks < 2; ++ks) { const bf16x8 a_ = ldfrag(TIs, 144, ct * 16 + l15, ks * 64 + q4 * 16), b_ = ldfrag(Vbt, 144, et * 16 + l15, ks * 64 + q4 * 16); U = MFMA16(a_, b_, U); } } while (0)

    const P4T T = p4_thread_consts(tid);
    p4_prefetch(p, F, RA, Dc, T);
    P4_INIT_S(Dc);
    { const int e0 = (tid & 7) * 4;
#pragma unroll
      for (int j = 0; j < 4; ++j) cwn[j] = *(const f32x4*)(p.dn_conv_w + j * 3072 + 2048 + Dc.h * 128 + Dc.sl * 32 + e0); }
    p4_stage(p, F, RA, Dc, 0, mk, cw, cwn);
    P4_WRITE_SB();
    P4D Dn = p4_next(F, Dc);
    if (Dn.valid) p4_prefetch(p, F, RA, Dn, T);
    P4D Dnn = Dn; if (Dn.valid) { Dnn = p4_next(F, Dn); if (Dnn.valid) p4_prefetch(p, F, RB, Dnn, T); }
    lds_barrier();
    P4_PRECOMP(0);
    lds_barrier();
    int buf = 0;
#define P4_BODY(RX) { \
        const LAS float* gv = (const LAS float*)(F.lds + P4_GV + buf * 1280); \
        const LAS unsigned char* Qs = F.lds + P4_QS + buf * 17408; const LAS unsigned char* ATs = F.lds + P4_AT + buf * 9216; \
        const int c0 = ct * 16 + q4 * 4, e = et * 16 + l15; \
         \
        f32x4 p1 = {0.f, 0.f, 0.f, 0.f}, oacc = {0.f, 0.f, 0.f, 0.f}; \
_Pragma("unroll") \
        for (int ks = 0; ks < 4; ++ks) { const bf16x8 bs = ldfrag(Sb, 272, et * 16 + l15, ks * 64 + q4 * 16); \
            const bf16x8 aw = ldfrag(Wl, 272, ct * 16 + l15, ks * 64 + q4 * 16), aq = ldfrag(Qs, 272, ct * 16 + l15, ks * 64 + q4 * 16); \
            p1 = MFMA16(aw, bs, p1); oacc = MFMA16(aq, bs, oacc); } \
        { float vn[4]; \
_Pragma("unroll") \
          for (int r = 0; r < 4; ++r) vn[r] = U[r] - p1[r]; \
          u32x2 o1, o2; o1.x = pk2(vn[0], vn[1]); o1.y = pk2(vn[2], vn[3]); \
          o2.x = pk2(vn[0] * gv[128 + c0], vn[1] * gv[128 + c0 + 1]); o2.y = pk2(vn[2] * gv[128 + c0 + 2], vn[3] * gv[128 + c0 + 3]); \
          *(LAS u32x2*)(Vt1 + e * 144 + c0 * 2) = o1; *(LAS u32x2*)(Vt2 + e * 144 + c0 * 2) = o2; } \
_Pragma("unroll") \
        for (int r = 0; r < 4; ++r) oacc[r] *= gv[c0 + r]; \
        P4D D3 = Dnn; \
        if (Dn.valid) { p4_stage(p, F, RX, Dn, buf ^ 1, mk, cw, cwn); \
            if (Dn.last && Dnn.valid) { const int e0_ = (tid & 7) * 4; _Pragma("unroll") for (int j = 0; j < 4; ++j) cwn[j] = *(const f32x4*)(p.dn_conv_w + j * 3072 + 2048 + Dnn.h * 128 + Dnn.sl * 32 + e0_); } if (Dnn.valid) { D3 = p4_next(F, Dnn); if (D3.valid) p4_prefetch(p, F, RX, D3, T); } } \
        lds_barrier(); \
         \
        { const float gl = gv[192]; \
_Pragma("unroll") \
          for (int nt = 0; nt < 2; ++nt) S[nt] *= gl; \
_Pragma("unroll") \
          for (int ks = 0; ks < 2; ++ks) \
_Pragma("unroll") \
              for (int nt = 0; nt < 2; ++nt) { const bf16x8 b_ = ldfrag(Vt2, 144, nt * 16 + l15, ks * 64 + q4 * 16); S[nt] = MFMA16(KT[ks], b_, S[nt]); } } \
_Pragma("unroll") \
        for (int ks = 0; ks < 2; ++ks) { const bf16x8 a_ = ldfrag(ATs, 144, ct * 16 + l15, ks * 64 + q4 * 16), b_ = ldfrag(Vt1, 144, et * 16 + l15, ks * 64 + q4 * 16); oacc = MFMA16(a_, b_, oacc); } \
_Pragma("unroll") \
        for (int r = 0; r < 4; ++r) *(bf16_t*)((char*)F.PROJ() + ((size_t)Dc.ci * 64 * NPROJ + Dc.d * 1024 + Dc.h * 128 + Dc.sl * 32) * 2 + (unsigned)(((c0 + r) * NPROJ + e) * 2)) = f2bf(oacc[r]); \
        if (Dc.last) { \
            if (!Dc.samp) { \
_Pragma("unroll") \
                for (int nt = 0; nt < 2; ++nt) \
_Pragma("unroll") \
                    for (int r = 0; r < 4; ++r) \
                        F.out[OUT_SD + (size_t)((Dc.seq * 2 + Dc.d) * 8 + Dc.h) * 16384 + (size_t)(wave * 16 + q4 * 4 + r) * 128 + Dc.sl * 32 + nt * 16 + l15] = S[nt][r]; \
            } \
            if (Dn.valid) P4_INIT_S(Dn); \
        } \
        P4_WRITE_SB(); \
        if (Dn.valid) P4_PRECOMP(buf ^ 1); \
        lds_barrier(); \
        if (!Dn.valid) break; \
        Dc = Dn; Dn = Dnn; Dnn = D3; buf ^= 1; \
    }
#pragma unroll 1
    for (;;) { P4_BODY(RA) P4_BODY(RB) }
#undef P4_BODY
#undef P4_INIT_S
#undef P4_WRITE_SB
#undef P4_PRECOMP
}
__device__ __forceinline__ void phase4(CParams& p, Frame& F) {
    if (F.G == 256) rg_carry_scan(p, F);
    else if (F.b == 0) {
        for (int g = F.tid; g < 69632; g += 512) { int samp = g >= 65536, gg = samp ? g - 65536 : g, seq = gg >> 11, d = (gg >> 10) & 1, ch = gg & 1023;
            const int nch = samp ? 64 : 4, c_lo = samp ? 128 + seq * 64 : seq * 4; float h = samp ? p.state_rglru[(size_t)(seq * 2 + d) * 1024 + ch] : 0.f;
            for (int i = 0; i < nch; ++i) { const int cc = d == 0 ? c_lo + i : c_lo + nch - 1 - i; const float* ag = F.RGAGG() + (size_t)(cc * 2 + d) * 2048; F.CARRY()[(size_t)(cc * 2 + d) * 1024 + ch] = h; h = ag[ch] * h + ag[1024 + ch]; } } }
    __syncthreads();
    phase4_chains(p, F);
}

__device__ __forceinline__ void phase5(CParams& p, Frame& F) {
    const int lane = F.lane;
    float nw[16];
#pragma unroll
    for (int q = 0; q < 4; ++q) { const f32x4 a = *(const f32x4*)(p.dn_norm_w + (lane & 7) * 16 + q * 4); nw[q * 4] = a[0]; nw[q * 4 + 1] = a[1]; nw[q * 4 + 2] = a[2]; nw[q * 4 + 3] = a[3]; }
#pragma unroll 4
    for (int tok = F.b * 8 + F.wave; tok < NTOK; tok += F.G * 8) {
        const bf16_t* pr = F.PROJ() + (size_t)tok * NPROJ + lane * 16;
        float o[16], z[16]; float ss = 0.f;
#pragma unroll
        for (int hf = 0; hf < 2; ++hf) { const u32x4 a = *(const u32x4*)(pr + hf * 8), b = *(const u32x4*)(pr + 1024 + hf * 8), zz = *(const u32x4*)(pr + 3072 + hf * 8);
            float fa[8], fb[8], fz[8]; unpack8(a, fa); unpack8(b, fb); unpack8(zz, fz);
#pragma unroll
            for (int e = 0; e < 8; ++e) { o[hf * 8 + e] = fa[e] + fb[e]; z[hf * 8 + e] = fz[e]; ss += o[hf * 8 + e] * o[hf * 8 + e]; } }
        ss += __shfl_xor(ss, 1); ss += __shfl_xor(ss, 2); ss += __shfl_xor(ss, 4);
        const float rs = rsqrtf(ss * (1.f / 128.f) + 1e-6f);
#pragma unroll
        for (int hf = 0; hf < 2; ++hf) { float w[8];
#pragma unroll
            for (int e = 0; e < 8; ++e) w[e] = o[hf * 8 + e] * rs * nw[hf * 8 + e] * siluf_(z[hf * 8 + e]);
            *(u32x4*)(F.MIX() + (size_t)tok * 2048 + lane * 16 + hf * 8) = pack8(w); }
        if (tok < 8192) {
            const u32x4 y0 = *(const u32x4*)(pr + 5120), y1 = *(const u32x4*)(pr + 5120 + 8);
            *(u32x4*)(F.MIX() + (size_t)tok * 2048 + 1024 + lane * 16) = y0; *(u32x4*)(F.MIX() + (size_t)tok * 2048 + 1024 + lane * 16 + 8) = y1; }
    }
    __syncthreads();
    for (int it = F.b; it < 1024; it += F.G) { u32x4 rows[5]; rg_load_rows(F, 128 + (it >> 3), it & 7, rows); rg_item<3>(p, F, 128 + (it >> 3), it & 7, rows, it + F.G); }
}

__device__ __forceinline__ void phase6(CParams& p, Frame& F) {
    pg8::Gemm g{F.MIX(), F.WoutT(), NTOK, 1024, 2048}; pg8::StaticOrder S; S.init(NTOK, 1024, F.G, F.b); pg8::EpiF32 E{(float*)F.PROJ(), 3072};
    pg8::gemm_phase<pg8::EpiF32, pg8::StaticOrder>(F.lds, g, S, E);
}

__device__ __forceinline__ void phase7(CParams& p, Frame& F) {
    LAS float* gt = (LAS float*)F.lds;
    for (int tb = F.b; tb < 256; tb += F.G) {
        const int grp = grp_of_block(tb);
        for (int j = F.tid; j < 1024; j += 512) gt[j] = mod_val(p, F, grp, 2048 + j) * p.post_w[j];
        __syncthreads();
#pragma unroll 2
        for (int i = 0; i < 8; ++i) {
            const int tok = tb * 64 + F.wave * 8 + i;
            const float* xr = tok < 8192 ? p.x_prompt + (size_t)tok * 1024 : p.x_sample + (size_t)(tok - 8192) * 1024;
            const float* yr = (const float*)F.PROJ() + (size_t)tok * 3072;
            f32x4 y[4]; float ss = 0.f;
#pragma unroll
            for (int q = 0; q < 4; ++q) { y[q] = *(const f32x4*)(yr + F.lane * 4 + 256 * q); ss += (y[q][0] * y[q][0] + y[q][1] * y[q][1]) + (y[q][2] * y[q][2] + y[q][3] * y[q][3]); }
            const float rstd = rsqrtf(wave_sum(ss) * (1.f / 1024.f) + 1e-6f);
#pragma unroll
            for (int q = 0; q < 4; ++q) { const int j = F.lane * 4 + 256 * q; f32x4 v = *(const f32x4*)(xr + j);
                if (tok >= 8192) { const int pp = (tok - 8192) & 4095; const int vv = (q < 2) ? (pp >> 6) : (pp & 63);
                    v += *(const f32x4*)(F.pe() + ((q & 1) ? 16384 : 0) + vv * 256 + F.lane * 4); }
                const f32x4 g4 = *(const LAS f32x4*)(gt + j);
                f32x4 ov = v + g4 * (y[q] * rstd); ov[0] = fin(ov[0]); ov[1] = fin(ov[1]); ov[2] = fin(ov[2]); ov[3] = fin(ov[3]); if (!(LIVE_MASK & 1)) ov = (f32x4){0.f, 0.f, 0.f, 0.f}; *(f32x4*)(F.out + (size_t)tok * 1024 + j) = ov; }
        }
        __syncthreads();
    }
}

__device__ __forceinline__ void phase8(CParams& p, Frame& F) {
    if (F.b == 0 && F.tid == 0) { int code = 0; for (int k = 31; k >= 1; --k) if (DG(F)[k]) code = k; F.out[OUT_SR] = 1000.f * (float)code + 500.f; }
}
extern __shared__ __attribute__((aligned(16))) unsigned char smem_raw[];
__global__ void __launch_bounds__(512) fwd_megakernel(Params p_unused) {
    CParams& p = *(CParams*)__builtin_amdgcn_kernarg_segment_ptr();
    Frame F;
    F.lds = (LAS unsigned char*)smem_raw;
    F.tid = threadIdx.x; F.lane = F.tid & 63; F.wave = __builtin_amdgcn_readfirstlane(F.tid >> 6); F.G = gridDim.x; F.b = blockIdx.x;
    F.out = p.out; F.ws = p.ws;
    volatile LAS unsigned* xbw = (volatile LAS unsigned*)(F.lds + LDS_BYTES - 16);
    const bool multi = (p.ph_hi - p.ph_lo) > 1;
    XcdBarrier xb; xb.bar = (unsigned*)(p.ws + WS_CTL); xb.x = 0; xb.st = xbw;
    if (multi) {
        if (F.tid == 0) { xbw[0] = 0u; xbw[1] = 0u; xbw[2] = 0u; xbw[3] = 0u; }
        __syncthreads();
        xb = xcd_barrier_post((unsigned*)(p.ws + WS_CTL), xbw);
    }
#ifndef PHMASK
#define PHMASK 511
#endif
    const int lo = p.ph_lo, hi = p.ph_hi;
#ifndef REP_PHASE
#define REP_PHASE -1
#endif
#define RUN_PHASE(k, fn) do { if (lo <= (k) && (k) < hi) { if (PHMASK & (1 << (k))) fn(p, F); if ((k) == REP_PHASE) { __syncthreads(); fn(p, F); } if ((k) + 1 < hi) xcd_barrier(xb); } } while (0)
    RUN_PHASE(0, phase0); RUN_PHASE(1, phase1); RUN_PHASE(2, phase2); RUN_PHASE(3, phase3);
    RUN_PHASE(4, phase4); RUN_PHASE(5, phase5); RUN_PHASE(6, phase6); RUN_PHASE(7, phase7); RUN_PHASE(8, phase8);
}

extern "C" void kernel_launch(void* const* d_in, const int* in_sizes, int n_in, void* d_out, int out_size, void* d_ws, size_t ws_size, hipStream_t stream) {
    static int grid = 0;
    if (grid == 0) {
        int dev = 0, cus = 0;
        if (hipGetDevice(&dev) != hipSuccess || hipDeviceGetAttribute(&cus, hipDeviceAttributeMultiprocessorCount, dev) != hipSuccess) { fprintf(stderr, "kernel_launch: device query failed\n"); grid = -1; return; }
        if (hipFuncSetAttribute((const void*)fwd_megakernel, hipFuncAttributeMaxDynamicSharedMemorySize, LDS_BYTES) != hipSuccess) { fprintf(stderr, "kernel_launch: hipFuncSetAttribute failed\n"); grid = -1; return; }
        int per_cu = 0;
        if (hipOccupancyMaxActiveBlocksPerMultiprocessor(&per_cu, (const void*)fwd_megakernel, 512, LDS_BYTES) != hipSuccess || per_cu < 1) { fprintf(stderr, "kernel_launch: occupancy query says %d blocks per CU\n", per_cu); (void)hipGetLastError(); }
        grid = cus;
    }
    if (grid < 0) return;
    Params p{};
    const float** pp = (const float**)&p;
    for (int i = 0; i < 23; ++i) pp[i] = (const float*)d_in[i];
    p.out = (float*)d_out; p.ws = (unsigned char*)d_ws;
    (void)hipMemsetAsync((char*)d_ws + WS_CTL, 0, 16384, stream);
#if MK_SINGLE
    p.ph_lo = 0; p.ph_hi = NPH;
    void* args[] = {&p};
    hipError_t e = hipLaunchCooperativeKernel((const void*)fwd_megakernel, dim3(grid), dim3(512), args, LDS_BYTES, stream);
    if (e != hipSuccess) fprintf(stderr, "cooperative launch failed: %s (grid %d)\n", hipGetErrorString(e), grid);
#else
    for (int ph = 0; ph < NPH; ++ph) {
        p.ph_lo = ph; p.ph_hi = ph + 1;
        hipLaunchKernelGGL(fwd_megakernel, dim3(grid), dim3(512), LDS_BYTES, stream, p);
    }
#endif
}
```

```cpp
#include <hip/hip_runtime.h>
#include <cstdio>
#include <cstdint>

#define LAS __attribute__((address_space(3)))
typedef unsigned short bf16_t;
typedef short bf16x8 __attribute__((ext_vector_type(8)));
typedef float f32x4 __attribute__((ext_vector_type(4)));
typedef unsigned u32x4 __attribute__((ext_vector_type(4)));
typedef unsigned u32x2 __attribute__((ext_vector_type(2)));

#ifndef REP_PHASE
#define REP_PHASE -1
#endif
#ifndef MK_SINGLE
#define MK_SINGLE 1
#endif

constexpr int NTOK = 16384, DM = 1024, NPROJ = 6144, DIN = 6176;
constexpr int NPH = 8;
constexpr int LDS_BYTES = 160 * 1024;
constexpr size_t OUT_YP = 0, OUT_YS = 8388608, OUT_SD = 16777216, OUT_SR = 25165824;
constexpr size_t WS_CTL = 0, WS_MODP = 16384, WS_PE = 606208, WS_BA = 737280, WS_GB = 2834432, WS_RGAGG = 4931584,
                 WS_WBAT = 9125888, WS_WOUTT = 9191424, WS_GT = 13385728, WS_WINT = 14434304, WS_TA = 27017216, WS_PROJ = 60571648, WS_CARRY = 261898240;

struct Params {
    const float *x_prompt, *x_sample, *state_delta, *state_rglru, *c, *c_ctx, *ada_w, *ada_b, *pre_w, *post_w, *w_in, *w_out,
                *dn_conv_w, *dn_a_log, *dn_dt_bias, *dn_norm_w, *rg_conv_w, *rg_conv_b, *rg_w_r, *rg_b_r, *rg_w_i, *rg_b_i, *rg_lam;
    float* out; unsigned char* ws;
    int ph_lo, ph_hi;
};

__device__ __forceinline__ float bf2f(unsigned short b) { return __uint_as_float(((unsigned)b) << 16); }
typedef __bf16 bf2_t __attribute__((ext_vector_type(2)));
typedef float f2_t __attribute__((ext_vector_type(2)));
__device__ __forceinline__ unsigned pk2(float lo, float hi) { const f2_t v = {lo, hi}; return __builtin_bit_cast(unsigned, __builtin_convertvector(v, bf2_t)); }
__device__ __forceinline__ unsigned short f2bf(float f) { return (unsigned short)(pk2(f, f) & 0xffffu); }
#ifndef SANITIZE
#define SANITIZE 0
#endif
#ifndef LIVE_MASK
#define LIVE_MASK 15
#endif
__device__ __forceinline__ float fin(float x) { return (SANITIZE && ((__float_as_uint(x) & 0x7f800000u) == 0x7f800000u)) ? 0.f : x; }
#define DG(F) ((unsigned*)((F).ws + WS_CTL))
__device__ __forceinline__ bool badv(float x, float lim) { return ((__float_as_uint(x) & 0x7f800000u) == 0x7f800000u) || fabsf(x) > lim; }
#ifndef DIAG
#define DIAG 0
#endif
#define CHK(F, k, bad) do { if (DIAG && (bad)) DG(F)[k] = 1u; } while (0)
__device__ __forceinline__ float sigm(float x) { return __builtin_amdgcn_rcpf(1.f + __expf(-x)); }
__device__ __forceinline__ float siluf_(float x) { return x * __builtin_amdgcn_rcpf(1.f + __expf(-x)); }
__device__ __forceinline__ float softplusf_(float x) { return x > 20.f ? x : log1pf(__expf(x)); }
__device__ __forceinline__ void unpack8(const u32x4 v, float (&f)[8]) {
    f[0] = __uint_as_float(v.x << 16); f[1] = __uint_as_float(v.x & 0xffff0000u);
    f[2] = __uint_as_float(v.y << 16); f[3] = __uint_as_float(v.y & 0xffff0000u);
    f[4] = __uint_as_float(v.z << 16); f[5] = __uint_as_float(v.z & 0xffff0000u);
    f[6] = __uint_as_float(v.w << 16); f[7] = __uint_as_float(v.w & 0xffff0000u);
}
__device__ __forceinline__ u32x4 pack8(const float (&f)[8]) { u32x4 o; o.x = pk2(f[0], f[1]); o.y = pk2(f[2], f[3]); o.z = pk2(f[4], f[5]); o.w = pk2(f[6], f[7]); return o; }
__device__ __forceinline__ float wave_sum(float v) {
#pragma unroll
    for (int o = 1; o < 64; o <<= 1) v += __shfl_xor(v, o);
    return v;
}
__device__ __forceinline__ void lds_barrier() { asm volatile("s_waitcnt lgkmcnt(0)" ::: "memory"); __builtin_amdgcn_s_barrier(); asm volatile("" ::: "memory"); }
#define MFMA16(a, b, c) __builtin_amdgcn_mfma_f32_16x16x32_bf16((a), (b), (c), 0, 0, 0)
#define LDS_WAIT() asm volatile("s_waitcnt lgkmcnt(0)" ::: "memory")
__device__ __forceinline__ bf16x8 ldfrag(const LAS unsigned char* base, int pitch, int row, int kb) { return *(const LAS bf16x8*)(base + row * pitch + kb); }

#define XB_TMO      128
#define XB_XCNT(j)  (256  + 64 * (j))
#define XB_XSUB(j)  (1280 + 64 * (j))
#define XB_XGEN(j)  (2304 + 64 * (j))
#define XB_TOP      3328
#define XB_TOPGEN   3392
#define XCD_BAR_WORDS 3456
#define XB_SPIN_CAP (1u << 18)
__device__ __forceinline__ unsigned xb_ld(unsigned* p)              { return __hip_atomic_load(p, __ATOMIC_RELAXED, __HIP_MEMORY_SCOPE_AGENT); }
__device__ __forceinline__ unsigned xb_add(unsigned* p, unsigned v) { return __hip_atomic_fetch_add(p, v, __ATOMIC_RELAXED, __HIP_MEMORY_SCOPE_AGENT); }
__device__ __forceinline__ unsigned xb_xcc_id() { return (unsigned)__builtin_amdgcn_s_getreg((3 << 11) | 20) & 0xFu; }
#define XB_SPIN(cond, bar) do { unsigned _sp = 0; while (cond) { __builtin_amdgcn_s_sleep(1); \
    if ((++_sp & 255u) == 0u) { if (xb_ld(&(bar)[XB_TMO])) break; if (_sp > XB_SPIN_CAP) { atomicAdd(&(bar)[XB_TMO], 1u); break; } } } } while (0)
struct XcdBarrier { unsigned* bar; unsigned x; volatile LAS unsigned* st; };
__device__ __forceinline__ XcdBarrier xcd_barrier_post(unsigned* bar, volatile LAS unsigned* st) {
    XcdBarrier b; b.bar = bar; b.x = xb_xcc_id(); b.st = st;
    if (threadIdx.x == 0) (void)xb_add(&bar[XB_XCNT(b.x)], 1u);
    return b;
}
__device__ __forceinline__ void xcd_barrier_complete(unsigned* bar, unsigned x, unsigned& nloc, unsigned& nx) {
    const unsigned G = gridDim.x * gridDim.y * gridDim.z;
    unsigned sum, cnt, mine, sp = 0u;
    for (;;) {
        sum = 0u; cnt = 0u; mine = 0u;
#pragma unroll
        for (unsigned j = 0; j < 16; ++j) { const unsigned c = xb_ld(&bar[XB_XCNT(j)]); sum += c; cnt += (c > 0u) ? 1u : 0u; mine = (j == x) ? c : mine; }
        if (sum == G) break;
        __builtin_amdgcn_s_sleep(1);
        if ((++sp & 255u) == 0u) { if (xb_ld(&bar[XB_TMO])) break; if (sp > XB_SPIN_CAP) { atomicAdd(&bar[XB_TMO], 1u); break; } }
    }
    nloc = mine > 0u ? mine : 1u; nx = cnt > 0u ? cnt : 1u;
}
__device__ __forceinline__ void xcd_barrier(const XcdBarrier& b) {
    asm volatile("s_waitcnt vmcnt(0)" ::: "memory");
    __syncthreads();
    if (threadIdx.x == 0) {
        unsigned* bar = b.bar;
        __builtin_amdgcn_s_waitcnt(0);
        unsigned nloc = b.st[0], nx = b.st[1];
        if (nloc == 0u) { xcd_barrier_complete(bar, b.x, nloc, nx); b.st[0] = nloc; b.st[1] = nx; }
        const unsigned old = xb_add(&bar[XB_XSUB(b.x)], 1u);
        const unsigned gen = old / nloc;
        if (old + 1u == (gen + 1u) * nloc) {
            __builtin_amdgcn_fence(__ATOMIC_RELEASE, "agent");
            asm volatile("s_waitcnt vmcnt(0)" ::: "memory");
            const unsigned og = xb_add(&bar[XB_TOP], 1u);
            const unsigned tg = og / nx;
            if (og + 1u == (tg + 1u) * nx) xb_add(&bar[XB_TOPGEN], 1u);
            else XB_SPIN(xb_ld(&bar[XB_TOPGEN]) == tg, bar);
            __builtin_amdgcn_fence(__ATOMIC_ACQUIRE, "agent");
            xb_add(&bar[XB_XGEN(b.x)], 1u);
            asm volatile("s_waitcnt vmcnt(0)" ::: "memory");
        } else {
            XB_SPIN(xb_ld(&bar[XB_XGEN(b.x)]) == gen, bar);
            __builtin_amdgcn_fence(__ATOMIC_ACQUIRE, "agent");
            asm volatile("s_waitcnt vmcnt(0)" ::: "memory");
        }
    }
    __syncthreads();
}

namespace pg8 {
constexpr int BM = 256, BK = 64, HALF = 128, HTB = HALF * BK * 2, STAGE_BYTES = 8 * HTB, NXCD = 8, WGM = 8;
__host__ __device__ __forceinline__ int lds_byte(int r, int c) { const int st = (r >> 4) * 2 + (c >> 5), rr = r & 15, cc = c & 31, ob = rr * 64 + cc * 2; return st * 1024 + (ob ^ (((ob >> 9) & 1) << 5)); }
__host__ __device__ __forceinline__ void stage_rc(int b, int& R, int& C) { const int st = b / 1024, sb = b % 1024, swz = sb ^ (((sb >> 9) & 1) << 5); R = (st >> 1) * 16 + swz / 64; C = (st & 1) * 32 + (swz % 64) / 2; }
__host__ __device__ __forceinline__ int perm32(int rho) { const int n = rho >> 4, i = rho & 15; return 8 * (i >> 2) + 4 * n + (i & 3); }
struct Unit { int pm, pn; };
struct Gemm { const bf16_t* A; const bf16_t* Bt; int M, N, K; };
struct StaticOrder {
    int nM, nN, nwg, G, c;
    __host__ __device__ void init(int M, int N, int G_, int c_) { nM = M / BM; nN = N / BM; nwg = nM * nN; G = G_; c = c_; }
    __host__ __device__ bool next(int i, Unit& u) const {
        const long L = (long)i * G + c; if (L >= nwg) return false;
        int wgid = (int)L; { const int q = nwg / NXCD, r = nwg % NXCD, xcd = wgid % NXCD, off = wgid / NXCD; wgid = (xcd < r ? xcd * (q + 1) : r * (q + 1) + (xcd - r) * q) + off; }
        const int nig = WGM * nN, gid = wgid / nig, fm = gid * WGM, gsz = (nM - fm) < WGM ? (nM - fm) : WGM;
        u.pm = fm + ((wgid % nig) % gsz); u.pn = (wgid % nig) / gsz; return true;
    }
};
__device__ __forceinline__ unsigned cvt_pk_bf16(float lo, float hi) { unsigned r; asm volatile("v_cvt_pk_bf16_f32 %0, %1, %2" : "=v"(r) : "v"(lo), "v"(hi)); return r; }
struct EpiF32 {
    static constexpr bool PERM = false;
    float* C; int ldc;
    __device__ __forceinline__ void operator()(const f32x4 (&acc)[2][2][4][2], const Unit& u, int wr, int wc, int fr, int fq) const {
        const int row0 = u.pm * BM + wr * 64 + fr, col0 = u.pn * BM + wc * 32 + 4 * fq;
#pragma unroll
        for (int ai = 0; ai < 2; ++ai)
#pragma unroll
            for (int m = 0; m < 4; ++m) { float* rowp = C + (size_t)(row0 + ai * HALF + m * 16) * ldc + col0;
#pragma unroll
                for (int bj = 0; bj < 2; ++bj)
#pragma unroll
                    for (int n = 0; n < 2; ++n) *(f32x4*)(rowp + bj * HALF + n * 16) = acc[ai][bj][m][n]; }
    }
};
struct EpiBf16 {
    static constexpr bool PERM = true;
    bf16_t* O; int ldc;
    __device__ __forceinline__ void operator()(const f32x4 (&acc)[2][2][4][2], const Unit& u, int wr, int wc, int fr, int fq) const {
        const int row0 = u.pm * BM + wr * 64 + fr; const int col0 = u.pn * BM + wc * 32 + 8 * fq;
#pragma unroll
        for (int ai = 0; ai < 2; ++ai)
#pragma unroll
            for (int m = 0; m < 4; ++m) { bf16_t* rowp = O + (size_t)(row0 + ai * HALF + m * 16) * ldc + col0;
#pragma unroll
                for (int bj = 0; bj < 2; ++bj) { const f32x4 v0 = acc[ai][bj][m][0], v1 = acc[ai][bj][m][1];
                    u32x4 w; w.x = cvt_pk_bf16(v0[0], v0[1]); w.y = cvt_pk_bf16(v0[2], v0[3]); w.z = cvt_pk_bf16(v1[0], v1[1]); w.w = cvt_pk_bf16(v1[2], v1[3]);
                    *(u32x4*)(rowp + bj * HALF) = w; } }
    }
};

template <class Epi, class Sched>
__device__ __forceinline__ void gemm_phase(LAS unsigned char* lds, const Gemm g, const Sched& S, const Epi& E) {
    const int tid = threadIdx.x, wid = __builtin_amdgcn_readfirstlane(tid >> 6), lane = tid & 63, wr = wid >> 2, wc = wid & 3, fr = lane & 15, fq = lane >> 4;
    const int K = g.K, nt = K / BK;
    unsigned voffA[2], voffB[2];
#pragma unroll
    for (int i = 0; i < 2; ++i) { int R, C; stage_rc(tid * 16 + i * 8192, R, C); const int Rb = Epi::PERM ? ((R & ~31) + perm32(R & 31)) : R;
        voffA[i] = (unsigned)(R * K + C) * 2u; voffB[i] = (unsigned)(Rb * K + C) * 2u; }
    const size_t kstep = (size_t)(BK * 2);
    const size_t hstep = (size_t)HALF * K * 2;
    const size_t tstep = 2 * hstep;
    const unsigned ldsw = (unsigned)wid * 1024u;
    const int aoff = lds_byte(wr * 64 + fr, fq * 8), boff = lds_byte(wc * 32 + fr, fq * 8);
#define PG8_SA(b, h) (((b) * 2 + (h)) * HTB)
#define PG8_SB(b, h) ((4 + (b) * 2 + (h)) * HTB)
#define PG8_STAGE(bufoff, gbase, voff) do { _Pragma("unroll") for (int _i = 0; _i < 2; ++_i) \
        __builtin_amdgcn_global_load_lds((const unsigned*)((const char*)(gbase) + (voff)[_i]), (LAS unsigned*)(lds + (bufoff) + ldsw + _i * 8192), 16, 0, 0); } while (0)
#define PG8_LDA(dst, b, h) do { _Pragma("unroll") for (int m = 0; m < 4; ++m) _Pragma("unroll") for (int k = 0; k < 2; ++k) dst[m][k] = *(const LAS bf16x8*)(lds + PG8_SA(b, h) + aoff + m * 2048 + k * 1024); } while (0)
#define PG8_LDB(dst, b, h) do { _Pragma("unroll") for (int n = 0; n < 2; ++n) _Pragma("unroll") for (int k = 0; k < 2; ++k) dst[n][k] = *(const LAS bf16x8*)(lds + PG8_SB(b, h) + boff + n * 2048 + k * 1024); } while (0)
#define PG8_MMA(ai, bj, At, Bt) do { __builtin_amdgcn_s_setprio(1); _Pragma("unroll") for (int m = 0; m < 4; ++m) _Pragma("unroll") for (int n = 0; n < 2; ++n) _Pragma("unroll") for (int k = 0; k < 2; ++k) \
        acc[ai][bj][m][n] = __builtin_amdgcn_mfma_f32_16x16x32_bf16(Bt[n][k], At[m][k], acc[ai][bj][m][n], 0, 0, 0); __builtin_amdgcn_s_setprio(0); } while (0)
#define PG8_WAIT_V(n) asm volatile("s_waitcnt vmcnt(" #n ")" ::: "memory")
#define PG8_WAIT_L(n) asm volatile("s_waitcnt lgkmcnt(" #n ")" ::: "memory")
#define PG8_BAR __builtin_amdgcn_s_barrier()
#define PG8_SCHED __builtin_amdgcn_sched_barrier(0)
    Unit cur, nxt; int ui = 0;
    if (!S.next(0, cur)) return;
    f32x4 acc[2][2][4][2];
#pragma unroll
    for (int a = 0; a < 2; ++a)
#pragma unroll
        for (int b = 0; b < 2; ++b)
#pragma unroll
            for (int m = 0; m < 4; ++m)
#pragma unroll
                for (int n = 0; n < 2; ++n) acc[a][b][m][n] = (f32x4){0.f, 0.f, 0.f, 0.f};
    bf16x8 At[4][2], B0[2][2], B1[2][2];
    const char* cA = (const char*)g.A + (size_t)cur.pm * tstep; const char* cB = (const char*)g.Bt + (size_t)cur.pn * tstep;
    PG8_STAGE(PG8_SB(0, 0), cB, voffB); PG8_STAGE(PG8_SA(0, 0), cA, voffA); PG8_STAGE(PG8_SB(0, 1), cB + hstep, voffB); PG8_STAGE(PG8_SA(0, 1), cA + hstep, voffA);
    if (wr == 1) PG8_BAR;
    PG8_WAIT_V(4); PG8_BAR;
    PG8_STAGE(PG8_SB(1, 0), cB + kstep, voffB); PG8_STAGE(PG8_SA(1, 0), cA + kstep, voffA); PG8_STAGE(PG8_SB(1, 1), cB + hstep + kstep, voffB);
    PG8_WAIT_V(6); PG8_BAR;
    for (;;) {
        const bool has_next = S.next(ui + 1, nxt);
        const char* nA = has_next ? (const char*)g.A + (size_t)nxt.pm * tstep : cA; const char* nB = has_next ? (const char*)g.Bt + (size_t)nxt.pn * tstep : cB;
        for (int t = 0; t < nt; t += 2) {
            const bool last = (t == nt - 2);
            const char* a1 = cA + (size_t)(t + 1) * kstep;
            const char* a2 = last ? nA : cA + (size_t)(t + 2) * kstep; const char* b2 = last ? nB : cB + (size_t)(t + 2) * kstep;
            const char* a3 = a2 + kstep; const char* b3 = b2 + kstep;
            PG8_LDB(B0, 0, 0); PG8_SCHED; PG8_LDA(At, 0, 0); PG8_STAGE(PG8_SA(1, 1), a1 + hstep, voffA);
            PG8_WAIT_L(8); PG8_BAR; PG8_WAIT_L(0); PG8_MMA(0, 0, At, B0); PG8_BAR; PG8_SCHED;
            PG8_LDB(B1, 0, 1); PG8_STAGE(PG8_SB(0, 0), b2, voffB);
            PG8_BAR; PG8_WAIT_L(0); PG8_MMA(0, 1, At, B1); PG8_BAR;
            PG8_LDA(At, 0, 1); PG8_STAGE(PG8_SA(0, 0), a2, voffA);
            PG8_BAR; PG8_WAIT_L(0); PG8_MMA(1, 0, At, B0); PG8_BAR; PG8_SCHED;
            PG8_STAGE(PG8_SB(0, 1), b2 + hstep, voffB);
            PG8_WAIT_V(6); PG8_BAR; PG8_MMA(1, 1, At, B1); PG8_BAR;
            PG8_LDB(B0, 1, 0); PG8_SCHED; PG8_LDA(At, 1, 0); PG8_STAGE(PG8_SA(0, 1), a2 + hstep, voffA);
            PG8_WAIT_L(8); PG8_BAR; PG8_WAIT_L(0); PG8_MMA(0, 0, At, B0); PG8_BAR; PG8_SCHED;
            PG8_LDB(B1, 1, 1); PG8_STAGE(PG8_SB(1, 0), b3, voffB);
            PG8_BAR; PG8_WAIT_L(0); PG8_MMA(0, 1, At, B1); PG8_BAR;
            PG8_LDA(At, 1, 1); PG8_STAGE(PG8_SA(1, 0), a3, voffA);
            PG8_BAR; PG8_WAIT_L(0); PG8_MMA(1, 0, At, B0); PG8_BAR; PG8_SCHED;
            PG8_STAGE(PG8_SB(1, 1), b3 + hstep, voffB);
            PG8_WAIT_V(6); PG8_BAR; PG8_MMA(1, 1, At, B1); PG8_BAR;
        }
        E(acc, cur, wr, wc, fr, fq);
        if (!has_next) break;
#pragma unroll
        for (int a = 0; a < 2; ++a)
#pragma unroll
            for (int b = 0; b < 2; ++b)
#pragma unroll
                for (int m = 0; m < 4; ++m)
#pragma unroll
                    for (int n = 0; n < 2; ++n) acc[a][b][m][n] = (f32x4){0.f, 0.f, 0.f, 0.f};
        cur = nxt; cA = nA; cB = nB; ++ui;
    }
    PG8_WAIT_V(0);
    if (wr == 0) PG8_BAR;
    PG8_BAR;
#undef PG8_SA
#undef PG8_SB
#undef PG8_STAGE
#undef PG8_LDA
#undef PG8_LDB
#undef PG8_MMA
#undef PG8_WAIT_V
#undef PG8_WAIT_L
#undef PG8_BAR
#undef PG8_SCHED
}
}

struct Frame {
    LAS unsigned char* lds;
    int tid, lane, wave, G, b;
    float* out; unsigned char* ws;
    __device__ __forceinline__ bf16_t* H() const { return (bf16_t*)out; }
    __device__ __forceinline__ bf16_t* Qc() const { return (bf16_t*)out; }
    __device__ __forceinline__ bf16_t* Kc() const { return (bf16_t*)(out + OUT_YS); }
    __device__ __forceinline__ bf16_t* MIX() const { return (bf16_t*)out; }
    __device__ __forceinline__ float* modp() const { return (float*)(ws + WS_MODP); }
    __device__ __forceinline__ float* pe() const { return (float*)(ws + WS_PE); }
    __device__ __forceinline__ float* BA() const { return (float*)(ws + WS_BA); }
    __device__ __forceinline__ float* GB() const { return (float*)(ws + WS_GB); }
    __device__ __forceinline__ float* RGAGG() const { return (float*)(ws + WS_RGAGG); }
    __device__ __forceinline__ bf16_t* WbaT() const { return (bf16_t*)(ws + WS_WBAT); }
    __device__ __forceinline__ bf16_t* WoutT() const { return (bf16_t*)(ws + WS_WOUTT); }
    __device__ __forceinline__ bf16_t* GT() const { return (bf16_t*)(ws + WS_GT); }
    __device__ __forceinline__ bf16_t* WinT() const { return (bf16_t*)(ws + WS_WINT); }
    __device__ __forceinline__ bf16_t* TA() const { return (bf16_t*)(ws + WS_TA); }
    __device__ __forceinline__ bf16_t* PROJ() const { return (bf16_t*)(ws + WS_PROJ); }
    __device__ __forceinline__ float* CARRY() const { return (float*)(ws + WS_CARRY); }
};
typedef const __attribute__((address_space(4))) Params CParams;

__device__ __forceinline__ int grp_of_block(int tb) { return tb < 128 ? 0 : (tb < 192 ? 1 : 2); }

__device__ __forceinline__ void transpose_item(const float* W, int N, int k0, int n0, bf16_t* WT0, int Kout, LAS float* scr, int lane) {
#pragma unroll 8
    for (int i = 0; i < 32; ++i) { const int kk = 2 * i + (lane >> 5); scr[kk * 33 + (lane & 31)] = W[(size_t)(k0 + kk) * N + n0 + (lane & 31)]; }
    LDS_WAIT();
    const int c = lane & 7;
#pragma unroll
    for (int j = 0; j < 4; ++j) { const int n = (lane >> 3) + 8 * j; const LAS float* s = scr + (8 * c) * 33 + n;
        u32x4 o; o.x = pk2(s[0 * 33], s[1 * 33]); o.y = pk2(s[2 * 33], s[3 * 33]); o.z = pk2(s[4 * 33], s[5 * 33]); o.w = pk2(s[6 * 33], s[7 * 33]);
        *(u32x4*)(WT0 + (size_t)n * Kout + k0 + 8 * c) = o; }
    LDS_WAIT();
}
__device__ __forceinline__ void phase0(CParams& p, Frame& F) {
    const int tid = F.tid, lane = F.lane;
    for (int it = F.b; it < 192; it += F.G) {
        const int jg = it % 12, ks = it / 12, j = jg * 256 + (tid & 255), half = tid >> 8, k0 = ks * 64 + half * 32;
        float s0 = 0.f, s1 = 0.f, s2 = 0.f;
#pragma unroll 8
        for (int k = 0; k < 32; ++k) { const int kk = k0 + k; const float w = p.ada_w[(size_t)kk * 3072 + j];
            s0 += siluf_(p.c_ctx[kk]) * w; s1 += siluf_(p.c[kk]) * w; s2 += siluf_(p.c[1024 + kk]) * w; }
        LAS float* red = (LAS float*)F.lds;
        if (half == 1) { red[tid - 256] = s0; red[256 + tid - 256] = s1; red[512 + tid - 256] = s2; }
        __syncthreads();
        if (half == 0) { F.modp()[(size_t)(ks * 3 + 0) * 3072 + j] = s0 + red[tid]; F.modp()[(size_t)(ks * 3 + 1) * 3072 + j] = s1 + red[256 + tid]; F.modp()[(size_t)(ks * 3 + 2) * 3072 + j] = s2 + red[512 + tid]; }
        __syncthreads();
    }
    LAS float* scr = (LAS float*)(F.lds + 4096 + F.wave * 8448);
    const int gw = F.b * 8 + F.wave, NGW = F.G * 8;
    constexpr int I_IN = 16 * 193, I_OUT = 32 * 32, I_G = 256, I_PE = 64;
    for (int it = gw; it < I_IN + I_OUT + I_G + I_PE; it += NGW) {
        int r = it;
        if (r < I_IN) { const int kb = r / 193, nb = r % 193, n0 = nb * 32;
            bf16_t* dst = n0 < 4096 ? F.WinT() + (size_t)n0 * 1024 : (n0 < 4128 ? F.WbaT() + (size_t)(n0 - 4096) * 1024 : F.WinT() + (size_t)(n0 - 32) * 1024);
            transpose_item(p.w_in, DIN, kb * 64, n0, dst, 1024, scr, lane); continue; }
        r -= I_IN;
        if (r < I_OUT) { const int kb = r / 32, nb = r % 32; transpose_item(p.w_out, 1024, kb * 64, nb * 32, F.WoutT() + (size_t)(nb * 32) * 2048, 2048, scr, lane); continue; }
        r -= I_OUT;
        if (r < I_G) { const int m = r >> 3, sub = r & 7, kb = sub >> 2, nb = sub & 3, g = m >> 4, dn = m & 15;
            const float* src = (g ? p.rg_w_i : p.rg_w_r) + (size_t)dn * 16384;
            transpose_item(src, 128, kb * 64, nb * 32, F.GT() + (size_t)m * 16384 + (size_t)(nb * 32) * 128, 128, scr, lane); continue; }
        r -= I_G;
        { const int v = r;
#pragma unroll
          for (int i = 0; i < 4; ++i) { const int idx = lane * 4 + i; const float f = expf(-9.210340371976184f * (float)idx / 256.f); const float a = (float)v * f;
              F.pe()[v * 256 + idx] = sinf(a); F.pe()[16384 + v * 256 + idx] = cosf(a); } }
    }
}

__device__ __forceinline__ float mod_val(CParams& p, const Frame& F, int grp, int j) {
    float s = p.ada_b[j];
#pragma unroll
    for (int ks = 0; ks < 16; ++ks) s += F.modp()[(size_t)(ks * 3 + grp) * 3072 + j];
    return s;
}

__device__ __forceinline__ void phase1(CParams& p, Frame& F) {
    LAS float* sc = (LAS float*)F.lds; LAS float* sh = sc + 1024;
    for (int tb = F.b; tb < 256; tb += F.G) {
        const int grp = grp_of_block(tb);
        for (int j = F.tid; j < 1024; j += 512) { sh[j] = mod_val(p, F, grp, j); sc[j] = p.pre_w[j] * (1.f + mod_val(p, F, grp, 1024 + j)); }
        __syncthreads();
#pragma unroll 2
        for (int i = 0; i < 8; ++i) {
            const int tok = tb * 64 + F.wave * 8 + i;
            const float* xr = tok < 8192 ? p.x_prompt + (size_t)tok * 1024 : p.x_sample + (size_t)(tok - 8192) * 1024;
            f32x4 v[4]; float ss = 0.f;
#pragma unroll
            for (int q = 0; q < 4; ++q) { v[q] = *(const f32x4*)(xr + F.lane * 4 + 256 * q);
                if (tok >= 8192) { const int pp = (tok - 8192) & 4095; const int vv = (q < 2) ? (pp >> 6) : (pp & 63);
                    const f32x4 e = *(const f32x4*)(F.pe() + ((q & 1) ? 16384 : 0) + vv * 256 + F.lane * 4); v[q] += e; }
                ss += (v[q][0] * v[q][0] + v[q][1] * v[q][1]) + (v[q][2] * v[q][2] + v[q][3] * v[q][3]); }
            const float rstd = rsqrtf(wave_sum(ss) * (1.f / 1024.f) + 1e-6f);
#pragma unroll
            for (int q = 0; q < 4; ++q) { const int j = F.lane * 4 + 256 * q; const f32x4 s4 = *(const LAS f32x4*)(sc + j), h4 = *(const LAS f32x4*)(sh + j);
                CHK(F, 1, badv(v[q][0] * rstd * s4[0] + h4[0], 100.f) || badv(v[q][3] * rstd * s4[3] + h4[3], 100.f));
                u32x2 o; o.x = pk2(v[q][0] * rstd * s4[0] + h4[0], v[q][1] * rstd * s4[1] + h4[1]); o.y = pk2(v[q][2] * rstd * s4[2] + h4[2], v[q][3] * rstd * s4[3] + h4[3]);
                *(u32x2*)(F.H() + (size_t)tok * 1024 + j) = o; }
        }
        __syncthreads();
    }
}

__device__ __forceinline__ void phase2(CParams& p, Frame& F) {
    { pg8::Gemm g{F.H(), F.WinT(), NTOK, NPROJ, 1024}; pg8::StaticOrder S; S.init(NTOK, NPROJ, F.G, F.b); pg8::EpiBf16 E{F.PROJ(), NPROJ};
      pg8::gemm_phase<pg8::EpiBf16, pg8::StaticOrder>(F.lds, g, S, E); }
    const int l15 = F.lane & 15, q4 = F.lane >> 4;
    for (int tb = F.b; tb < 256; tb += F.G) {
        const int mt = F.wave >> 1, nt = F.wave & 1;
        const bf16_t* ar = F.H() + (size_t)(tb * 64 + mt * 16 + l15) * 1024 + q4 * 8;
        const bf16_t* br = F.WbaT() + (size_t)(nt * 16 + l15) * 1024 + q4 * 8;
        f32x4 acc = {0.f, 0.f, 0.f, 0.f};
#pragma unroll 16
        for (int ks = 0; ks < 32; ++ks) { const bf16x8 a = *(const bf16x8*)(ar + ks * 32), b = *(const bf16x8*)(br + ks * 32); acc = MFMA16(a, b, acc); }
#pragma unroll
        for (int r = 0; r < 4; ++r) F.BA()[(size_t)(tb * 64 + mt * 16 + q4 * 4 + r) * 32 + nt * 16 + l15] = acc[r];
    }
}

__device__ __forceinline__ void p3_load_rows(const Frame& F, int ci, int h, u32x4 (&rows)[7]) {
    const int tid = F.tid, tg = tid >> 5, part = (tid >> 4) & 1, sub = tid & 15, col = part * 1024 + h * 128 + sub * 8, t0 = ci * 64;
    int seq_lo, seq_hi; if (ci < 128) { seq_lo = (ci >> 2) * 256; seq_hi = seq_lo + 256; } else { seq_lo = 8192 + ((ci - 128) >> 6) * 4096; seq_hi = seq_lo + 4096; }
    const int tb = t0 + tg * 4 - 2;
#pragma unroll
    for (int r = 0; r < 7; ++r) { const int tok = tb + r; u32x4 v = {0u, 0u, 0u, 0u};
        if (tok >= seq_lo && tok < seq_hi) v = *(const u32x4*)(F.PROJ() + (size_t)tok * NPROJ + col);
        rows[r] = v; }
}
__device__ __forceinline__ void p3_delta_item(CParams& p, Frame& F, int ci, int h, u32x4 (&rows)[7], int itn) {
    const int tid = F.tid, lane = F.lane, wave = F.wave, q4 = lane >> 4, l15 = lane & 15;
    LAS unsigned char* Ks = F.lds; LAS unsigned char* Qs = F.lds + 17408;
    LAS float* gfv = (LAS float*)(F.lds + 34816);
    LAS unsigned char* DIR0 = F.lds + 35840;
    LAS unsigned char* ATo = F.lds + 137728;
#pragma unroll
    for (int i = 0; i < 5; ++i) { const int ch = tid + 512 * i; if (ch < 2304) { const int dd = ch >= 1152, cc = ch - dd * 1152; *(LAS u32x4*)(DIR0 + dd * 47616 + 18432 + cc * 16) = (u32x4){0u, 0u, 0u, 0u}; } }
    const int t0 = ci * 64;
    int seq_lo, seq_hi; if (ci < 128) { seq_lo = (ci >> 2) * 256; seq_hi = seq_lo + 256; } else { seq_lo = 8192 + ((ci - 128) >> 6) * 4096; seq_hi = seq_lo + 4096; }
    {
        const int tg = tid >> 5, part = (tid >> 4) & 1, sub = tid & 15, col = part * 1024 + h * 128 + sub * 8;
        float w[4][8];
#pragma unroll
        for (int j = 0; j < 4; ++j) { const f32x4 a = *(const f32x4*)(p.dn_conv_w + j * 3072 + col), b = *(const f32x4*)(p.dn_conv_w + j * 3072 + col + 4);
            w[j][0] = a[0]; w[j][1] = a[1]; w[j][2] = a[2]; w[j][3] = a[3]; w[j][4] = b[0]; w[j][5] = b[1]; w[j][6] = b[2]; w[j][7] = b[3]; }
        float acc[4][8];
#pragma unroll
        for (int i = 0; i < 4; ++i)
#pragma unroll
            for (int e = 0; e < 8; ++e) acc[i][e] = 0.f;
#pragma unroll
        for (int r = 0; r < 7; ++r) {
            float x[8]; unpack8(rows[r], x);
#pragma unroll
            for (int j = 0; j < 4; ++j) { const int i = r - j; if (i >= 0 && i < 4) {
#pragma unroll
                for (int e = 0; e < 8; ++e) acc[i][e] += w[j][e] * x[e]; } } }
#pragma unroll
        for (int i = 0; i < 4; ++i) { float ss = 0.f;
#pragma unroll
            for (int e = 0; e < 8; ++e) { acc[i][e] = siluf_(acc[i][e]); ss += acc[i][e] * acc[i][e]; }
            ss += __shfl_xor(ss, 1); ss += __shfl_xor(ss, 2); ss += __shfl_xor(ss, 4); ss += __shfl_xor(ss, 8);
            const float rs = rsqrtf(ss + 1e-6f) * (part == 0 ? 0.08838834764831845f : 1.f);
#pragma unroll
            for (int e = 0; e < 8; ++e) acc[i][e] *= rs;
            CHK(F, 4, badv(acc[i][0], 1.01f) || badv(acc[i][5], 1.01f) || badv(ss * rs * rs, part == 0 ? 0.0079f : 1.01f));
            const u32x4 o = pack8(acc[i]); const int c = tg * 4 + i;
            *(LAS u32x4*)((part ? Ks : Qs) + c * 272 + sub * 16) = o;
            if (part == 0) *(u32x4*)(F.Qc() + (size_t)(t0 + c) * 1024 + h * 128 + sub * 8) = o; }
        if (part == 1) {
            bf16_t* kt = F.Kc() + (size_t)(ci * 8 + h) * 8192 + (size_t)(sub * 8) * 64 + tg * 4;
#pragma unroll
            for (int e = 0; e < 8; ++e) { u32x2 o2; o2.x = pk2(acc[0][e], acc[1][e]); o2.y = pk2(acc[2][e], acc[3][e]); *(u32x2*)(kt + e * 64) = o2; } }
    }
    if (wave == 0) {
        const float* ba = F.BA() + (size_t)(t0 + lane) * 32;
        const float bf_ = sigm(ba[h]), bb_ = sigm(ba[8 + h]);
        float s = -expf(p.dn_a_log[h]) * softplusf_(ba[16 + h] + p.dn_dt_bias[h]);
        float sb = -expf(p.dn_a_log[8 + h]) * softplusf_(ba[24 + h] + p.dn_dt_bias[8 + h]);
#pragma unroll
        for (int o = 1; o < 64; o <<= 1) { const float t = __shfl_up(s, o); if (lane >= o) s += t; }
#pragma unroll
        for (int o = 1; o < 64; o <<= 1) { const float t = __shfl_down(sb, o); if (lane + o < 64) sb += t; }
        CHK(F, 3, badv(ba[h], 1000.f) || badv(ba[24 + h], 1000.f));
        CHK(F, 8, badv(s, 1e4f) || badv(sb, 1e4f) || s > 0.f || sb > 0.f || bf_ < 0.f || bf_ > 1.f || bb_ < 0.f || bb_ > 1.f);
        gfv[lane] = s; gfv[64 + lane] = sb; gfv[128 + lane] = bf_; gfv[192 + lane] = bb_;
        float* gb = F.GB() + (size_t)(ci * 8 + h) * 256;
        gb[lane] = s; gb[64 + lane] = sb; gb[128 + lane] = bf_; gb[192 + lane] = bb_;
    }
    lds_barrier();
    const int d = wave >> 2, mt = wave & 3;
    LAS unsigned char* Db = DIR0 + d * 47616;
    LAS unsigned char* Brow = Db; LAS unsigned char* Btr = Db + 9216; LAS unsigned char* Xrow = Db + 18432; LAS unsigned char* Xtr = Db + 27648;
    LAS float* Dl = (LAS float*)(Db + 36864) + mt * 320; LAS unsigned char* M2t = Db + 41984; LAS unsigned char* Mts = Db + 44544 + mt * 768;
    const LAS unsigned char* Lrow = d == 0 ? Brow : Btr;
    const LAS float* gd = gfv + d * 64; const LAS float* bd = gfv + 128 + d * 64;
    {
        f32x4 kk[4], qk[4];
#pragma unroll
        for (int n = 0; n < 4; ++n) { kk[n] = (f32x4){0.f, 0.f, 0.f, 0.f}; qk[n] = (f32x4){0.f, 0.f, 0.f, 0.f}; }
#pragma unroll
        for (int ks = 0; ks < 4; ++ks) { const bf16x8 ak = ldfrag(Ks, 272, mt * 16 + l15, ks * 64 + q4 * 16), aq = ldfrag(Qs, 272, mt * 16 + l15, ks * 64 + q4 * 16);
#pragma unroll
            for (int n = 0; n < 4; ++n) { const bf16x8 bk = ldfrag(Ks, 272, n * 16 + l15, ks * 64 + q4 * 16); kk[n] = MFMA16(ak, bk, kk[n]); qk[n] = MFMA16(aq, bk, qk[n]); } }
#pragma unroll
        for (int n = 0; n < 4; ++n) { const int s = n * 16 + l15; float a4[4];
#pragma unroll
            for (int r = 0; r < 4; ++r) { const int c = mt * 16 + q4 * 4 + r;
                const float dec = __expf(fminf(gd[c] - gd[s], 0.f));
                const bool strict = d == 0 ? (c > s) : (c < s);
                const float a = strict ? bd[c] * kk[n][r] * dec : 0.f;
                a4[r] = a;
                ((LAS bf16_t*)Brow)[c * 72 + s] = f2bf(a);
                if (n == mt) { if (d == 0) Dl[(q4 * 4 + r) * 20 + l15] = a; else Dl[l15 * 20 + q4 * 4 + r] = a; }
                const bool incl = d == 0 ? (c >= s) : (c < s);
                if (incl) ((LAS bf16_t*)ATo)[c * 64 + s] = f2bf(qk[n][r] * dec); }
            u32x2 o; o.x = pk2(a4[0], a4[1]); o.y = pk2(a4[2], a4[3]);
            *(LAS u32x2*)(Btr + s * 144 + (mt * 16 + q4 * 4) * 2) = o; }
    }
    lds_barrier();
    if (lane < 16) {
        float x[16];
#pragma unroll
        for (int i = 0; i < 16; ++i) { float sv = (i == lane) ? 1.f : 0.f;
            float drow[16];
#pragma unroll
            for (int q = 0; q < 4; ++q) if (4 * q < i) { const f32x4 t4 = *(const LAS f32x4*)(Dl + i * 20 + 4 * q); drow[4 * q] = t4[0]; drow[4 * q + 1] = t4[1]; drow[4 * q + 2] = t4[2]; drow[4 * q + 3] = t4[3]; }
#pragma unroll
            for (int j = 0; j < i; ++j) sv -= drow[j] * x[j];
            x[i] = sv; }
#pragma unroll
        for (int i = 0; i < 16; ++i) ((LAS bf16_t*)Xrow)[(mt * 16 + i) * 72 + mt * 16 + lane] = f2bf(x[i]);
        u32x4 o0, o1; o0.x = pk2(x[0], x[1]); o0.y = pk2(x[2], x[3]); o0.z = pk2(x[4], x[5]); o0.w = pk2(x[6], x[7]);
        o1.x = pk2(x[8], x[9]); o1.y = pk2(x[10], x[11]); o1.z = pk2(x[12], x[13]); o1.w = pk2(x[14], x[15]);
        *(LAS u32x4*)(Xtr + (mt * 16 + lane) * 144 + mt * 32) = o0; *(LAS u32x4*)(Xtr + (mt * 16 + lane) * 144 + mt * 32 + 16) = o1;
    }
    lds_barrier();
    const bf16x8 zero8 = {0, 0, 0, 0, 0, 0, 0, 0};
    const f32x4 zero4 = {0.f, 0.f, 0.f, 0.f};
    if (mt & 1) {
        const int I1 = mt, I0 = mt - 1;
        bf16x8 a = zero8, b = zero8;
        if (q4 < 2) { a = ldfrag(Lrow, 144, I1 * 16 + l15, I0 * 32 + q4 * 16); b = ldfrag(Xtr, 144, I0 * 16 + l15, I0 * 32 + q4 * 16); }
        const f32x4 M = MFMA16(a, b, zero4);
        { u32x2 o; o.x = pk2(M[0], M[1]); o.y = pk2(M[2], M[3]); *(LAS u32x2*)(Mts + l15 * 48 + q4 * 8) = o; }
        LDS_WAIT();
        bf16x8 a2 = zero8, b2 = zero8;
        if (q4 < 2) { a2 = ldfrag(Xrow, 144, I1 * 16 + l15, I1 * 32 + q4 * 16); b2 = *(const LAS bf16x8*)(Mts + l15 * 48 + q4 * 16); }
        const f32x4 X = MFMA16(a2, b2, zero4);
#pragma unroll
        for (int r = 0; r < 4; ++r) ((LAS bf16_t*)Xrow)[(I1 * 16 + q4 * 4 + r) * 72 + I0 * 16 + l15] = f2bf(-X[r]);
        u32x2 o; o.x = pk2(-X[0], -X[1]); o.y = pk2(-X[2], -X[3]);
        *(LAS u32x2*)(Xtr + (I0 * 16 + l15) * 144 + (I1 * 16 + q4 * 4) * 2) = o;
    }
    lds_barrier();
    {
        const int mi = mt >> 1, ni = mt & 1;
        const bf16x8 a = ldfrag(Lrow, 144, 32 + mi * 16 + l15, q4 * 16), b = ldfrag(Xtr, 144, ni * 16 + l15, q4 * 16);
        const f32x4 M2 = MFMA16(a, b, zero4);
        { u32x2 o; o.x = pk2(M2[0], M2[1]); o.y = pk2(M2[2], M2[3]); *(LAS u32x2*)(M2t + (ni * 16 + l15) * 80 + (mi * 16 + q4 * 4) * 2) = o; }
        lds_barrier();
        const bf16x8 a2 = ldfrag(Xrow, 144, 32 + mi * 16 + l15, 64 + q4 * 16), b2 = *(const LAS bf16x8*)(M2t + (ni * 16 + l15) * 80 + q4 * 16);
        const f32x4 X = MFMA16(a2, b2, zero4);
#pragma unroll
        for (int r = 0; r < 4; ++r) { CHK(F, 6, badv(X[r], 20.f)); ((LAS bf16_t*)Xrow)[(32 + mi * 16 + q4 * 4 + r) * 72 + ni * 16 + l15] = f2bf(-X[r]); }
        u32x2 o; o.x = pk2(-X[0], -X[1]); o.y = pk2(-X[2], -X[3]);
        *(LAS u32x2*)(Xtr + (ni * 16 + l15) * 144 + (32 + mi * 16 + q4 * 4) * 2) = o;
    }
    lds_barrier();
    { bf16_t* dst = F.TA() + (size_t)(ci * 8 + h) * 8192;
      const int c = tid >> 3, s0 = (tid & 7) * 8;
      const u32x4 lo = *(const LAS u32x4*)(DIR0 + 18432 + c * 144 + s0 * 2), up = *(const LAS u32x4*)(DIR0 + 47616 + 27648 + c * 144 + s0 * 2);
      unsigned wl[4] = {lo.x, lo.y, lo.z, lo.w}, wu[4] = {up.x, up.y, up.z, up.w}, wo[4];
#pragma unroll
      for (int i = 0; i < 4; ++i) { const int sa = s0 + 2 * i, sb2 = sa + 1;
          const unsigned mlo = (sa <= c ? 0x0000FFFFu : 0u) | (sb2 <= c ? 0xFFFF0000u : 0u);
          wo[i] = (wl[i] & mlo) | (wu[i] & ~mlo); }
      *(u32x4*)(dst + tid * 8) = (u32x4){wo[0], wo[1], wo[2], wo[3]};
      *(u32x4*)(dst + 4096 + tid * 8) = *(const LAS u32x4*)(ATo + tid * 16); }
    lds_barrier();
}

struct RgW { bf16x8 g[2][2][4]; float br[2], bi[2], sp[2]; };
__device__ __forceinline__ void rg_load_w(CParams& p, const Frame& F, int n, RgW& W) {
    const int q4 = F.lane >> 4, j = F.wave * 16 + (F.lane & 15), ch = n * 128 + j;
#pragma unroll
    for (int d = 0; d < 2; ++d) {
#pragma unroll
        for (int g = 0; g < 2; ++g) { const bf16_t* gp = F.GT() + (size_t)((g * 2 + d) * 8 + n) * 16384 + (size_t)j * 128 + q4 * 8;
#pragma unroll
            for (int ks = 0; ks < 4; ++ks) W.g[d][g][ks] = *(const bf16x8*)(gp + ks * 32); }
        W.br[d] = p.rg_b_r[d * 1024 + ch]; W.bi[d] = p.rg_b_i[d * 1024 + ch]; W.sp[d] = softplusf_(-p.rg_lam[d * 1024 + ch]); }
}
__device__ __forceinline__ void rg_load_rows(const Frame& F, int ci, int n, u32x4 (&rows)[5]) {
    const int tid = F.tid, tg = tid >> 4, sub = tid & 15, col = 4096 + n * 128 + sub * 8, t0 = ci * 64;
    int c_lo, c_hi; if (ci < 128) { c_lo = (ci >> 2) * 4; c_hi = c_lo + 4; } else { c_lo = 128 + ((ci - 128) >> 6) * 64; c_hi = c_lo + 64; }
    const int tb = t0 + tg * 2 - 2;
#pragma unroll
    for (int r = 0; r < 5; ++r) { const int tok = tb + r; u32x4 v = {0u, 0u, 0u, 0u};
        if (tok >= c_lo * 64 && tok < c_hi * 64) v = *(const u32x4*)(F.PROJ() + (size_t)tok * NPROJ + col);
        rows[r] = v; }
}
template <int PASS>
__device__ __forceinline__ void rg_item(CParams& p, Frame& F, int ci, int n, u32x4 (&rows)[5], int itn) {
    const int tid = F.tid, lane = F.lane, wave = F.wave, q4 = lane >> 4, l15 = lane & 15;
    LAS unsigned char* xb = F.lds; LAS float* xf = (LAS float*)(F.lds + 17408); LAS float* Hs = (LAS float*)(F.lds + 50176);
    const int t0 = ci * 64;
    int seq_lo, seq_hi, c_lo, c_hi, seq; const bool samp = ci >= 128;
    if (!samp) { seq = ci >> 2; c_lo = seq * 4; c_hi = c_lo + 4; } else { seq = (ci - 128) >> 6; c_lo = 128 + seq * 64; c_hi = c_lo + 64; }
    seq_lo = c_lo * 64; seq_hi = c_hi * 64;
    const int j = wave * 16 + l15, ch = n * 128 + j;
    bf16x8 wA[2][4], wB[2][4];
#pragma unroll
    for (int g = 0; g < 2; ++g) { const bf16_t* gp = F.GT() + (size_t)((g * 2 + 0) * 8 + n) * 16384 + (size_t)j * 128 + q4 * 8;
#pragma unroll
        for (int ks = 0; ks < 4; ++ks) wA[g][ks] = *(const bf16x8*)(gp + ks * 32); }
    {
        const int tg = tid >> 4, sub = tid & 15, ch = n * 128 + sub * 8;
        float w[4][8], acc[2][8];
#pragma unroll
        for (int j = 0; j < 4; ++j) { const f32x4 a = *(const f32x4*)(p.rg_conv_w + j * 1024 + ch), b = *(const f32x4*)(p.rg_conv_w + j * 1024 + ch + 4);
            w[j][0] = a[0]; w[j][1] = a[1]; w[j][2] = a[2]; w[j][3] = a[3]; w[j][4] = b[0]; w[j][5] = b[1]; w[j][6] = b[2]; w[j][7] = b[3]; }
        { const f32x4 a = *(const f32x4*)(p.rg_conv_b + ch), b = *(const f32x4*)(p.rg_conv_b + ch + 4);
#pragma unroll
          for (int i = 0; i < 2; ++i) { acc[i][0] = a[0]; acc[i][1] = a[1]; acc[i][2] = a[2]; acc[i][3] = a[3]; acc[i][4] = b[0]; acc[i][5] = b[1]; acc[i][6] = b[2]; acc[i][7] = b[3]; } }
#pragma unroll
        for (int r = 0; r < 5; ++r) {
            float x[8]; unpack8(rows[r], x);
#pragma unroll
            for (int j = 0; j < 4; ++j) { const int i = r - j; if (i >= 0 && i < 2) {
#pragma unroll
                for (int e = 0; e < 8; ++e) acc[i][e] += w[j][e] * x[e]; } } }
#pragma unroll
        for (int i = 0; i < 2; ++i) { const int c = tg * 2 + i;
            *(LAS u32x4*)(xb + c * 272 + sub * 16) = pack8(acc[i]);
            *(LAS f32x4*)(xf + c * 128 + sub * 8) = (f32x4){acc[i][0], acc[i][1], acc[i][2], acc[i][3]};
            *(LAS f32x4*)(xf + c * 128 + sub * 8 + 4) = (f32x4){acc[i][4], acc[i][5], acc[i][6], acc[i][7]}; }
    }
    lds_barrier();
    f32x4 hs[4];
#pragma unroll
    for (int m = 0; m < 4; ++m) hs[m] = (f32x4){0.f, 0.f, 0.f, 0.f};
#pragma unroll
    for (int d = 0; d < 2; ++d) {
        f32x4 av[4], bxv[4];
        {
            f32x4 ar[4], ai[4];
#pragma unroll
            for (int m = 0; m < 4; ++m) { ar[m] = (f32x4){0.f, 0.f, 0.f, 0.f}; ai[m] = (f32x4){0.f, 0.f, 0.f, 0.f}; }
#pragma unroll
            for (int ks = 0; ks < 4; ++ks) { const bf16x8 br = d == 0 ? wA[0][ks] : wB[0][ks], bi = d == 0 ? wA[1][ks] : wB[1][ks];
#pragma unroll
                for (int m = 0; m < 4; ++m) { const bf16x8 a = ldfrag(xb, 272, m * 16 + l15, ks * 64 + q4 * 16); ar[m] = MFMA16(a, br, ar[m]); ai[m] = MFMA16(a, bi, ai[m]); } }
            if (d == 0) {
#pragma unroll
                for (int g = 0; g < 2; ++g) { const bf16_t* gp = F.GT() + (size_t)((g * 2 + 1) * 8 + n) * 16384 + (size_t)j * 128 + q4 * 8;
#pragma unroll
                    for (int ks = 0; ks < 4; ++ks) wB[g][ks] = *(const bf16x8*)(gp + ks * 32); } }
            const float L2E = 1.4426950408889634f;
            const float br_ = -L2E * p.rg_b_r[d * 1024 + ch], bi_ = -L2E * p.rg_b_i[d * 1024 + ch], sp = softplusf_(-p.rg_lam[d * 1024 + ch]);
            const float k2 = -16.f * sp, k2e = k2 * L2E, k1e = 0.5f * k2e;
#pragma unroll
            for (int m = 0; m < 4; ++m)
#pragma unroll
                for (int r = 0; r < 4; ++r) { const int c = m * 16 + q4 * 4 + r;
                    const float rr = __builtin_amdgcn_rcpf(1.f + __builtin_amdgcn_exp2f(fmaf(ar[m][r], -L2E, br_)));
                    const float ii = __builtin_amdgcn_rcpf(1.f + __builtin_amdgcn_exp2f(fmaf(ai[m][r], -L2E, bi_)));
                    const float t2 = k2 * rr;
                    const float ser = t2 * fmaf(t2, fmaf(t2, 0.16666667f, 0.5f), 1.f);
                    const float a_ = __builtin_amdgcn_exp2f(k1e * rr);
                    const float em = t2 > -0.01f ? ser : fmaf(a_, a_, -1.f);
                    av[m][r] = a_; bxv[m][r] = __builtin_amdgcn_sqrtf(-em) * (ii * xf[c * 128 + j]); }
        }
        f32x4 Pa[4], Pb[4]; float Ap[4], Bp[4], Am[4], Bm[4];
#pragma unroll
        for (int m = 0; m < 4; ++m) {
            float pa, pb;
            if (d == 0) { pa = av[m][0]; pb = bxv[m][0]; Pa[m][0] = pa; Pb[m][0] = pb;
#pragma unroll
                for (int r = 1; r < 4; ++r) { pb = av[m][r] * pb + bxv[m][r]; pa = av[m][r] * pa; Pa[m][r] = pa; Pb[m][r] = pb; } }
            else { pa = av[m][3]; pb = bxv[m][3]; Pa[m][3] = pa; Pb[m][3] = pb;
#pragma unroll
                for (int r = 2; r >= 0; --r) { pb = av[m][r] * pb + bxv[m][r]; pa = av[m][r] * pa; Pa[m][r] = pa; Pb[m][r] = pb; } }
            float Ak[4], Bk[4];
#pragma unroll
            for (int k = 0; k < 4; ++k) { Ak[k] = __shfl(pa, l15 + 16 * k); Bk[k] = __shfl(pb, l15 + 16 * k); }
            float ap = 1.f, bp = 0.f, am = 1.f, bm = 0.f;
#pragma unroll
            for (int kk = 0; kk < 4; ++kk) { const int k = d == 0 ? kk : 3 - kk;
                const bool before = d == 0 ? (k < q4) : (k > q4);
                const float nb = Ak[k] * bp + Bk[k], na = Ak[k] * ap;
                bp = before ? nb : bp; ap = before ? na : ap;
                bm = Ak[k] * bm + Bk[k]; am = Ak[k] * am; }
            Ap[m] = ap; Bp[m] = bp; Am[m] = am; Bm[m] = bm;
        }
        if (PASS == 1) {
            float At = 1.f, Bt = 0.f;
#pragma unroll
            for (int mm = 0; mm < 4; ++mm) { const int m = d == 0 ? mm : 3 - mm; Bt = Am[m] * Bt + Bm[m]; At = Am[m] * At; }
            if (q4 == 0) { float* ag = F.RGAGG() + (size_t)(ci * 2 + d) * 2048; ag[ch] = At; ag[1024 + ch] = Bt; }
        } else {
            float hb = F.CARRY()[(size_t)(ci * 2 + d) * 1024 + ch];
#pragma unroll
            for (int mm = 0; mm < 4; ++mm) { const int m = d == 0 ? mm : 3 - mm;
                const float hin = Ap[m] * hb + Bp[m];
#pragma unroll
                for (int r = 0; r < 4; ++r) hs[m][r] += Pa[m][r] * hin + Pb[m][r];
                hb = Am[m] * hb + Bm[m]; }
            if (!samp && q4 == 0 && ci == (d == 0 ? c_hi - 1 : c_lo)) F.out[OUT_SR + (size_t)(seq * 2 + d) * 1024 + ch] = hb;
        }
    }
    if (PASS == 1 && itn < 1024) rg_load_rows(F, 128 + (itn >> 3), itn & 7, rows);
    if (PASS == 3) {
#pragma unroll
        for (int m = 0; m < 4; ++m)
#pragma unroll
            for (int r = 0; r < 4; ++r) Hs[(m * 16 + q4 * 4 + r) * 128 + j] = hs[m][r];
        lds_barrier();
#pragma unroll
        for (int i = 0; i < 2; ++i) { const int chunk = tid + 512 * i, c = chunk >> 4, cc = chunk & 15;
            const u32x4 gv = *(const u32x4*)(F.PROJ() + (size_t)(t0 + c) * NPROJ + 5120 + n * 128 + cc * 8);
            float g[8]; unpack8(gv, g);
            const f32x4 ha = *(const LAS f32x4*)(Hs + c * 128 + cc * 8), hb2 = *(const LAS f32x4*)(Hs + c * 128 + cc * 8 + 4);
            float o[8];
#pragma unroll
            for (int e = 0; e < 4; ++e) { o[e] = ha[e] * siluf_(g[e]); o[4 + e] = hb2[e] * siluf_(g[4 + e]); }
            *(u32x4*)(F.MIX() + (size_t)(t0 + c) * 2048 + 1024 + n * 128 + cc * 8) = pack8(o); }
    }
    lds_barrier();
}

__device__ __forceinline__ void rg_conv_lds(CParams& p, const Frame& F, int n, const u32x4 (&rows)[5], LAS unsigned char* xb, LAS float* xf) {
    const int tid = F.tid, tg = tid >> 4, sub = tid & 15, ch = n * 128 + sub * 8;
    float w[4][8], acc[2][8];
#pragma unroll
    for (int j = 0; j < 4; ++j) { const f32x4 a = *(const f32x4*)(p.rg_conv_w + j * 1024 + ch), b = *(const f32x4*)(p.rg_conv_w + j * 1024 + ch + 4);
        w[j][0] = a[0]; w[j][1] = a[1]; w[j][2] = a[2]; w[j][3] = a[3]; w[j][4] = b[0]; w[j][5] = b[1]; w[j][6] = b[2]; w[j][7] = b[3]; }
    { const f32x4 a = *(const f32x4*)(p.rg_conv_b + ch), b = *(const f32x4*)(p.rg_conv_b + ch + 4);
#pragma unroll
      for (int i = 0; i < 2; ++i) { acc[i][0] = a[0]; acc[i][1] = a[1]; acc[i][2] = a[2]; acc[i][3] = a[3]; acc[i][4] = b[0]; acc[i][5] = b[1]; acc[i][6] = b[2]; acc[i][7] = b[3]; } }
#pragma unroll
    for (int r = 0; r < 5; ++r) { float x[8]; unpack8(rows[r], x);
#pragma unroll
        for (int j = 0; j < 4; ++j) { const int i = r - j; if (i >= 0 && i < 2) {
#pragma unroll
            for (int e = 0; e < 8; ++e) acc[i][e] += w[j][e] * x[e]; } } }
#pragma unroll
    for (int i = 0; i < 2; ++i) { const int c = tg * 2 + i;
        *(LAS u32x4*)(xb + c * 272 + sub * 16) = pack8(acc[i]);
        *(LAS f32x4*)(xf + c * 128 + sub * 8) = (f32x4){acc[i][0], acc[i][1], acc[i][2], acc[i][3]};
        *(LAS f32x4*)(xf + c * 128 + sub * 8 + 4) = (f32x4){acc[i][4], acc[i][5], acc[i][6], acc[i][7]}; }
}
template <int D>
__device__ __forceinline__ void rg_gate_scan(const Frame& F, const bf16x8 (&wg)[2][4], float br_, float bi_, float sp, const LAS unsigned char* xb, const LAS float* xf, int j,
                                             f32x4 (&Pa)[4], f32x4 (&Pb)[4], float (&Ap)[4], float (&Bp)[4], float (&Am)[4], float (&Bm)[4]) {
    const int lane = F.lane, q4 = lane >> 4, l15 = lane & 15;
    f32x4 av[4], bxv[4];
    {
        f32x4 ar[4], ai[4];
#pragma unroll
        for (int m = 0; m < 4; ++m) { ar[m] = (f32x4){0.f, 0.f, 0.f, 0.f}; ai[m] = (f32x4){0.f, 0.f, 0.f, 0.f}; }
#pragma unroll
        for (int ks = 0; ks < 4; ++ks) {
#pragma unroll
            for (int m = 0; m < 4; ++m) { const bf16x8 a = ldfrag(xb, 272, m * 16 + l15, ks * 64 + q4 * 16); ar[m] = MFMA16(a, wg[0][ks], ar[m]); ai[m] = MFMA16(a, wg[1][ks], ai[m]); } }
        const float L2E = 1.4426950408889634f;
        const float brs = -L2E * br_, bis = -L2E * bi_, k2 = -16.f * sp, k1e = 0.5f * k2 * L2E;
#pragma unroll
        for (int m = 0; m < 4; ++m)
#pragma unroll
            for (int r = 0; r < 4; ++r) { const int c = m * 16 + q4 * 4 + r;
                const float rr = __builtin_amdgcn_rcpf(1.f + __builtin_amdgcn_exp2f(fmaf(ar[m][r], -L2E, brs)));
                const float ii = __builtin_amdgcn_rcpf(1.f + __builtin_amdgcn_exp2f(fmaf(ai[m][r], -L2E, bis)));
                const float t2 = k2 * rr, a = __builtin_amdgcn_exp2f(k1e * rr);
                const float ser = t2 * fmaf(t2, fmaf(t2, 0.16666667f, 0.5f), 1.f);
                const float em = t2 > -0.01f ? ser : fmaf(a, a, -1.f);
                av[m][r] = a; bxv[m][r] = __builtin_amdgcn_sqrtf(-em) * (ii * xf[c * 128 + j]); }
    }
#pragma unroll
    for (int m = 0; m < 4; ++m) {
        float pa, pb;
        if (D == 0) { pa = av[m][0]; pb = bxv[m][0]; Pa[m][0] = pa; Pb[m][0] = pb;
#pragma unroll
            for (int r = 1; r < 4; ++r) { pb = av[m][r] * pb + bxv[m][r]; pa = av[m][r] * pa; Pa[m][r] = pa; Pb[m][r] = pb; } }
        else { pa = av[m][3]; pb = bxv[m][3]; Pa[m][3] = pa; Pb[m][3] = pb;
#pragma unroll
            for (int r = 2; r >= 0; --r) { pb = av[m][r] * pb + bxv[m][r]; pa = av[m][r] * pa; Pa[m][r] = pa; Pb[m][r] = pb; } }
        float Ak[4], Bk[4];
#pragma unroll
        for (int k = 0; k < 4; ++k) { Ak[k] = __shfl(pa, l15 + 16 * k); Bk[k] = __shfl(pb, l15 + 16 * k); }
        float ap = 1.f, bp = 0.f, am = 1.f, bm = 0.f;
#pragma unroll
        for (int kk = 0; kk < 4; ++kk) { const int k = D == 0 ? kk : 3 - kk;
            const bool before = D == 0 ? (k < q4) : (k > q4);
            const float nb = Ak[k] * bp + Bk[k], na = Ak[k] * ap;
            bp = before ? nb : bp; ap = before ? na : ap;
            bm = Ak[k] * bm + Bk[k]; am = Ak[k] * am; }
        Ap[m] = ap; Bp[m] = bp; Am[m] = am; Bm[m] = bm;
    }
}
template <int D>
__device__ __forceinline__ void rg_prompt_dir(CParams& p, Frame& F, int seq, int n) {
    const int tid = F.tid, lane = F.lane, wave = F.wave, q4 = lane >> 4, l15 = lane & 15;
    LAS unsigned char* xb = F.lds; LAS float* xf = (LAS float*)(F.lds + 17408); LAS float* Hs = (LAS float*)(F.lds + 50176); LAS bf16_t* Hf = (LAS bf16_t*)(F.lds + 82944);
    const int j = wave * 16 + l15, ch = n * 128 + j;
    bf16x8 wg[2][4];
#pragma unroll
    for (int g = 0; g < 2; ++g) { const bf16_t* gp = F.GT() + (size_t)((g * 2 + D) * 8 + n) * 16384 + (size_t)j * 128 + q4 * 8;
#pragma unroll
        for (int ks = 0; ks < 4; ++ks) wg[g][ks] = *(const bf16x8*)(gp + ks * 32); }
    const float br_ = p.rg_b_r[D * 1024 + ch], bi_ = p.rg_b_i[D * 1024 + ch], sp = softplusf_(-p.rg_lam[D * 1024 + ch]);
    float hb = 0.f;
    u32x4 rows[5];
    rg_load_rows(F, seq * 4 + (D == 0 ? 0 : 3), n, rows);
#pragma unroll 1
    for (int cs = 0; cs < 4; ++cs) {
        const int cidx = D == 0 ? cs : 3 - cs, ci = seq * 4 + cidx, t0 = ci * 64;
        rg_conv_lds(p, F, n, rows, xb, xf);
        if (cs < 3) rg_load_rows(F, seq * 4 + (D == 0 ? cidx + 1 : cidx - 1), n, rows);
        lds_barrier();
        f32x4 Pa[4], Pb[4]; float Ap[4], Bp[4], Am[4], Bm[4];
        rg_gate_scan<D>(F, wg, br_, bi_, sp, xb, xf, j, Pa, Pb, Ap, Bp, Am, Bm);
#pragma unroll
        for (int mm = 0; mm < 4; ++mm) { const int m = D == 0 ? mm : 3 - mm;
            const float hin = Ap[m] * hb + Bp[m];
#pragma unroll
            for (int r = 0; r < 4; ++r) { const float hv = Pa[m][r] * hin + Pb[m][r]; const int tl = m * 16 + q4 * 4 + r;
                if (D == 0) Hf[(cidx * 64 + tl) * 128 + j] = f2bf(hv);
                else Hs[tl * 128 + j] = hv + bf2f(Hf[(cidx * 64 + tl) * 128 + j]); }
            hb = Am[m] * hb + Bm[m]; }
        lds_barrier();
        if (D == 1) {
#pragma unroll
            for (int i = 0; i < 2; ++i) { const int chunk = tid + 512 * i, c = chunk >> 4, cc = chunk & 15;
                bf16_t* gp = F.PROJ() + (size_t)(t0 + c) * NPROJ + 5120 + n * 128 + cc * 8;
                const u32x4 gv = *(const u32x4*)gp; float g[8]; unpack8(gv, g);
                const f32x4 ha = *(const LAS f32x4*)(Hs + c * 128 + cc * 8), hb2 = *(const LAS f32x4*)(Hs + c * 128 + cc * 8 + 4);
                float o[8];
#pragma unroll
                for (int e = 0; e < 4; ++e) { o[e] = ha[e] * siluf_(g[e]); o[4 + e] = hb2[e] * siluf_(g[4 + e]); }
                *(u32x4*)gp = pack8(o); }
            lds_barrier();
        }
    }
    if (q4 == 0) F.out[OUT_SR + (size_t)(seq * 2 + D) * 1024 + ch] = hb;
}

__device__ __forceinline__ void rg_carry_scan(CParams& p, Frame& F) {
    const int tid = F.tid;
    int samp, seq, d, ch;
    if (tid < 256) return;
    else if (tid < 272) { const int g = F.b * 16 + tid - 256; if (g >= 4096) return; samp = 1; seq = g >> 11; d = (g >> 10) & 1; ch = g & 1023; }
    else return;
    const int nch = samp ? 64 : 4, c_lo = samp ? 128 + seq * 64 : seq * 4;
    float h = samp ? p.state_rglru[(size_t)(seq * 2 + d) * 1024 + ch] : 0.f;
    for (int i0 = 0; i0 < nch; i0 += 4) {
        float A[4], B[4];
#pragma unroll
        for (int u = 0; u < 4; ++u) { const int cc = d == 0 ? c_lo + i0 + u : c_lo + nch - 1 - i0 - u; const float* ag = F.RGAGG() + (size_t)(cc * 2 + d) * 2048; A[u] = ag[ch]; B[u] = ag[1024 + ch]; }
#pragma unroll
        for (int u = 0; u < 4; ++u) { const int cc = d == 0 ? c_lo + i0 + u : c_lo + nch - 1 - i0 - u; F.CARRY()[(size_t)(cc * 2 + d) * 1024 + ch] = h; h = A[u] * h + B[u]; }
    }
}

__device__ __forceinline__ void phase3(CParams& p, Frame& F) {
    for (int rep = 0; rep < (REP_PHASE == 30 ? 2 : 1); ++rep)
    for (int it = F.b; it < 2048; it += F.G) { u32x4 rows[7]; p3_load_rows(F, it >> 3, it & 7, rows); p3_delta_item(p, F, it >> 3, it & 7, rows, it + F.G); }
    for (int rep = 0; rep < (REP_PHASE == 31 ? 2 : 1); ++rep) {
    u32x4 rows[5]; if (F.b < 1024) rg_load_rows(F, 128 + (F.b >> 3), F.b & 7, rows);
    for (int it = F.b; it < 1024; it += F.G) rg_item<1>(p, F, 128 + (it >> 3), it & 7, rows, it + F.G); }
    for (int it = F.b; it < 256; it += F.G) { rg_prompt_dir<0>(p, F, it >> 3, it & 7); rg_prompt_dir<1>(p, F, it >> 3, it & 7); }
}

struct P4D { int valid, samp, seq, h, d, sl, ci, seq_lo, seq_hi, last, k, s, nch; };
__device__ __forceinline__ P4D p4_desc(const Frame& F, int k, int s) {
    P4D D; int item;
    if (F.G == 256) {
        const int x = F.b & 7, y = F.b >> 3;
        if (y < 16) { item = (x * 4 + (y >> 2)) * 4 + (y & 3); D.valid = k < 1; }
        else { const int j = y - 16; item = 128 + (x * 64 + (j >> 2) * 16 + k) * 4 + (j & 3); D.valid = k < 16; } }
    else { item = F.b + k * F.G; D.valid = item < 2176; }
    D.samp = item < 128; const int it = D.samp ? item : item - 128, chain = it >> 2;
    D.sl = it & 3; D.seq = chain >> 4; D.h = (chain >> 1) & 7; D.d = chain & 1;
    D.nch = D.samp ? 64 : 4; const int chunk0 = D.samp ? 128 + D.seq * 64 : D.seq * 4;
    D.seq_lo = chunk0 * 64; D.seq_hi = D.seq_lo + D.nch * 64;
    D.ci = D.d == 0 ? chunk0 + s : chunk0 + D.nch - 1 - s; D.last = s == D.nch - 1; D.k = k; D.s = s;
    return D;
}
__device__ __forceinline__ P4D p4_next(const Frame& F, const P4D& D) {
    if (D.s + 1 < D.nch) { P4D N = D; N.s = D.s + 1; N.ci = D.ci + (D.d == 0 ? 1 : -1); N.last = N.s == D.nch - 1; return N; }
    return p4_desc(F, D.k + 1, 0);
}
struct P4Pre { u32x4 k0, k1, q0, q1, ti, at; u32x2 v[4]; float g, b, bc; };
struct P4T { unsigned oKQ, oTA, oV, oG, oGc; int cj; };
__device__ __forceinline__ P4T p4_thread_consts(int tid) {
    P4T T; T.oKQ = (unsigned)(((tid >> 4) * 1024 + (tid & 15) * 8) * 2); T.oTA = (unsigned)tid * 16u;
    T.oV = (unsigned)(((tid >> 3) * NPROJ + (tid & 7) * 4) * 2); T.oG = (unsigned)(tid & 63) * 4u; T.oGc = (unsigned)(tid >> 3) * 4u; T.cj = (tid >> 3) - 2; return T;
}
__device__ __forceinline__ void p4_prefetch(CParams& p, const Frame& F, P4Pre& R, const P4D& D, const P4T& T) {
    const int tid = F.tid, t0 = D.ci * 64, h = D.h;
    const char* kb = (const char*)F.Kc() + (size_t)(D.ci * 8 + h) * 16384;
    const char* qb = (const char*)F.Qc() + ((size_t)t0 * 1024 + h * 128) * 2;
    const char* tb = (const char*)F.TA() + (size_t)(D.ci * 8 + h) * 16384;
    const char* vb = (const char*)F.PROJ() + ((long)(t0 - 2) * NPROJ + 2048 + h * 128 + D.sl * 32) * 2;
    const char* gb = (const char*)F.GB() + (size_t)(D.ci * 8 + h) * 1024 + D.d * 256;
    R.k0 = *(const u32x4*)(kb + T.oTA); R.k1 = *(const u32x4*)(kb + T.oTA + 8192u);
    R.q0 = *(const u32x4*)(qb + T.oKQ); R.q1 = *(const u32x4*)(qb + T.oKQ + 65536u);
    R.ti = *(const u32x4*)(tb + T.oTA); R.at = *(const u32x4*)(tb + T.oTA + 8192u);
#pragma unroll
    for (int j = 0; j < 4; ++j) { const int tok = t0 + T.cj + j; u32x2 v = {0u, 0u};
        if (tok >= D.seq_lo && tok < D.seq_hi) v = *(const u32x2*)(vb + T.oV + (unsigned)(j * NPROJ * 2));
        R.v[j] = v; }
    R.bc = *(const float*)(gb + 512 + T.oGc);
    R.g = 0.f; R.b = 0.f;
    if (tid < 64) { R.g = *(const float*)(gb + T.oG); R.b = *(const float*)(gb + 512 + T.oG); }
}
__device__ __forceinline__ u32x4 tri_mask(u32x4 v, int c, int s0, int d) {
    unsigned w[4] = {v.x, v.y, v.z, v.w};
#pragma unroll
    for (int i = 0; i < 4; ++i) { const int slo = s0 + 2 * i, shi = slo + 1;
        const bool klo = d == 0 ? (c >= slo) : (c <= slo), khi = d == 0 ? (c >= shi) : (c <= shi);
        w[i] &= (klo ? 0x0000FFFFu : 0u) | (khi ? 0xFFFF0000u : 0u); }
    return (u32x4){w[0], w[1], w[2], w[3]};
}
constexpr int P4_KS = 0, P4_TI = 17408, P4_VBT = 26624, P4_WL = 31232, P4_SB = 48640, P4_VT1 = 57344, P4_VT2 = 61952, P4_QS = 66560, P4_AT = 101376, P4_GV = 119808, P4_KT = 122368;
__device__ __forceinline__ void p4_stage(CParams& p, const Frame& F, const P4Pre& R, const P4D& D, int buf, const unsigned (&mk)[2][4], f32x4 (&cw)[4], const f32x4 (&cwn)[4]) {
    const int tid = F.tid, d = D.d;
    LAS unsigned char* Ks = F.lds + P4_KS; LAS unsigned char* Qs = F.lds + P4_QS + buf * 17408; LAS unsigned char* TIs = F.lds + P4_TI;
    LAS unsigned char* ATs = F.lds + P4_AT + buf * 9216; LAS unsigned char* Vbt = F.lds + P4_VBT; LAS float* gv = (LAS float*)(F.lds + P4_GV + buf * 1280);
    { const int row = tid >> 4, cc = tid & 15;
      *(LAS u32x4*)(Qs + row * 272 + cc * 16) = R.q0; *(LAS u32x4*)(Qs + (32 + row) * 272 + cc * 16) = R.q1; }
    { const int dk = tid >> 3, cp = tid & 7; LAS unsigned char* Kts = F.lds + P4_KT;
      *(LAS u32x4*)(Kts + dk * 144 + cp * 16) = R.k0; *(LAS u32x4*)(Kts + (64 + dk) * 144 + cp * 16) = R.k1; }
    { const int c = tid >> 3, s0 = (tid & 7) * 8;
      const unsigned m0 = d ? mk[1][0] : mk[0][0], m1 = d ? mk[1][1] : mk[0][1], m2 = d ? mk[1][2] : mk[0][2], m3 = d ? mk[1][3] : mk[0][3];
      *(LAS u32x4*)(TIs + c * 144 + s0 * 2) = (u32x4){R.ti.x & m0, R.ti.y & m1, R.ti.z & m2, R.ti.w & m3};
      *(LAS u32x4*)(ATs + c * 144 + s0 * 2) = (u32x4){R.at.x & m0, R.at.y & m1, R.at.z & m2, R.at.w & m3}; }
    { const int c = tid >> 3, e0 = (tid & 7) * 4; float o[4] = {0.f, 0.f, 0.f, 0.f};
      if (D.s == 0) {
#pragma unroll
          for (int j = 0; j < 4; ++j) cw[j] = cwn[j]; }
#pragma unroll
      for (int j = 0; j < 4; ++j) { const u32x2 v = R.v[j];
          o[0] += cw[j][0] * __uint_as_float(v.x << 16); o[1] += cw[j][1] * __uint_as_float(v.x & 0xffff0000u);
          o[2] += cw[j][2] * __uint_as_float(v.y << 16); o[3] += cw[j][3] * __uint_as_float(v.y & 0xffff0000u); }
#pragma unroll
      for (int i = 0; i < 4; ++i) ((LAS bf16_t*)Vbt)[(e0 + i) * 72 + c] = f2bf(siluf_(o[i]) * R.bc); }
    if (tid < 64) {
        const float glast = __shfl(R.g, d == 0 ? 63 : 0), eg = __expf(R.g);
        gv[tid] = eg; gv[64 + tid] = R.b * eg; gv[128 + tid] = __expf(glast - R.g); if (tid == 0) gv[192] = __expf(glast);
    }
}
__device__ __forceinline__ void phase4_chains(CParams& p, Frame& F) {
    const int tid = F.tid, lane = F.lane, wave = F.wave, q4 = lane >> 4, l15 = lane & 15;
    LAS unsigned char* Ks = F.lds + P4_KS; LAS unsigned char* TIs = F.lds + P4_TI; LAS unsigned char* Vbt = F.lds + P4_VBT; LAS unsigned char* Wl = F.lds + P4_WL;
    LAS unsigned char* Sb = F.lds + P4_SB; LAS unsigned char* Vt1 = F.lds + P4_VT1; LAS unsigned char* Vt2 = F.lds + P4_VT2;
    const int ct = wave & 3, et = wave >> 2;
    P4D Dc = p4_desc(F, 0, 0);
    if (!Dc.valid) return;
    P4Pre RA, RB;
    f32x4 S[2], U; bf16x8 KT[2];
    unsigned mk[2][4]; f32x4 cw[4], cwn[4];
    { const int c = tid >> 3, s0 = (tid & 7) * 8;
#pragma unroll
      for (int i = 0; i < 4; ++i) { const int slo = s0 + 2 * i, shi = slo + 1;
          mk[0][i] = (c >= slo ? 0x0000FFFFu : 0u) | (c >= shi ? 0xFFFF0000u : 0u); mk[1][i] = (c <= slo ? 0x0000FFFFu : 0u) | (c <= shi ? 0xFFFF0000u : 0u); } }
#define P4_INIT_S(D) do { _Pragma("unroll") for (int nt = 0; nt < 2; ++nt) _Pragma("unroll") for (int r = 0; r < 4; ++r) \
        S[nt][r] = (D).samp ? p.state_delta[(size_t)(((D).seq * 2 + (D).d) * 8 + (D).h) * 16384 + (size_t)(wave * 16 + q4 * 4 + r) * 128 + (D).sl * 32 + nt * 16 + l15] : 0.f; } while (0)
#define P4_WRITE_SB() do { _Pragma("unroll") for (int nt = 0; nt < 2; ++nt) { u32x2 o_; o_.x = pk2(S[nt][0], S[nt][1]); o_.y = pk2(S[nt][2], S[nt][3]); \
        *(LAS u32x2*)(Sb + (nt * 16 + l15) * 272 + (wave * 16 + q4 * 4) * 2) = o_; } } while (0)
#define P4_PRECOMP(buf_) do { const LAS float* gv_ = (const LAS float*)(F.lds + P4_GV + (buf_) * 1280); \
        f32x4 WT[4]; _Pragma("unroll") for (int c_ = 0; c_ < 4; ++c_) WT[c_] = (f32x4){0.f, 0.f, 0.f, 0.f}; \
        _Pragma("unroll") for (int ks = 0; ks < 2; ++ks) { \
            const u32x4 kraw = *(const LAS u32x4*)(F.lds + P4_KT + (wave * 16 + l15) * 144 + ks * 64 + q4 * 16); KT[ks] = __builtin_bit_cast(bf16x8, kraw); \
            const f32x4 sa = *(const LAS f32x4*)(gv_ + 64 + ks * 32 + q4 * 8), sb_ = *(const LAS f32x4*)(gv_ + 64 + ks * 32 + q4 * 8 + 4); \
            float kf[8]; unpack8(kraw, kf); u32x4 kg; \
            kg.x = pk2(kf[0] * sa[0], kf[1] * sa[1]); kg.y = pk2(kf[2] * sa[2], kf[3] * sa[3]); kg.z = pk2(kf[4] * sb_[0], kf[5] * sb_[1]); kg.w = pk2(kf[6] * sb_[2], kf[7] * sb_[3]); \
            const bf16x8 akg = __builtin_bit_cast(bf16x8, kg); \
            _Pragma("unroll") for (int c_ = 0; c_ < 4; ++c_) { const bf16x8 bt = ldfrag(TIs, 144, c_ * 16 + l15, ks * 64 + q4 * 16); WT[c_] = MFMA16(akg, bt, WT[c_]); } } \
        _Pragma("unroll") for (int c_ = 0; c_ < 4; ++c_) { u32x2 o_; o_.x = pk2(WT[c_][0], WT[c_][1]); o_.y = pk2(WT[c_][2], WT[c_][3]); \
            *(LAS u32x2*)(Wl + (c_ * 16 + l15) * 272 + (wave * 16 + q4 * 4) * 2) = o_; } \
        U = (f32x4){0.f, 0.f, 0.f, 0.f}; \
        _Pragma("unroll") for (int ks = 0; ks < 2; ++ks) { const bf16x8 a_ = ldfrag(TIs, 144, ct * 16 + l15, ks * 64 + q4 * 16), b_ = ldfrag(Vbt, 144, et * 16 + l15, ks * 64 + q4 * 16); U = MFMA16(a_, b_, U); } } while (0)

    const P4T T = p4_thread_consts(tid);
    p4_prefetch(p, F, RA, Dc, T);
    P4_INIT_S(Dc);
    { const int e0 = (tid & 7) * 4;
#pragma unroll
      for (int j = 0; j < 4; ++j) cwn[j] = *(const f32x4*)(p.dn_conv_w + j * 3072 + 2048 + Dc.h * 128 + Dc.sl * 32 + e0); }
    p4_stage(p, F, RA, Dc, 0, mk, cw, cwn);
    P4_WRITE_SB();
    P4D Dn = p4_next(F, Dc);
    if (Dn.valid) p4_prefetch(p, F, RA, Dn, T);
    P4D Dnn = Dn; if (Dn.valid) { Dnn = p4_next(F, Dn); if (Dnn.valid) p4_prefetch(p, F, RB, Dnn, T); }
    lds_barrier();
    P4_PRECOMP(0);
    lds_barrier();
    int buf = 0;
#define P4_BODY(RX) { \
        const LAS float* gv = (const LAS float*)(F.lds + P4_GV + buf * 1280); \
        const LAS unsigned char* Qs = F.lds + P4_QS + buf * 17408; const LAS unsigned char* ATs = F.lds + P4_AT + buf * 9216; \
        const int c0 = ct * 16 + q4 * 4, e = et * 16 + l15; \
         \
        f32x4 p1 = {0.f, 0.f, 0.f, 0.f}, oacc = {0.f, 0.f, 0.f, 0.f}; \
_Pragma("unroll") \
        for (int ks = 0; ks < 4; ++ks) { const bf16x8 bs = ldfrag(Sb, 272, et * 16 + l15, ks * 64 + q4 * 16); \
            const bf16x8 aw = ldfrag(Wl, 272, ct * 16 + l15, ks * 64 + q4 * 16), aq = ldfrag(Qs, 272, ct * 16 + l15, ks * 64 + q4 * 16); \
            p1 = MFMA16(aw, bs, p1); oacc = MFMA16(aq, bs, oacc); } \
        { float vn[4]; \
_Pragma("unroll") \
          for (int r = 0; r < 4; ++r) vn[r] = U[r] - p1[r]; \
          u32x2 o1, o2; o1.x = pk2(vn[0], vn[1]); o1.y = pk2(vn[2], vn[3]); \
          o2.x = pk2(vn[0] * gv[128 + c0], vn[1] * gv[128 + c0 + 1]); o2.y = pk2(vn[2] * gv[128 + c0 + 2], vn[3] * gv[128 + c0 + 3]); \
          *(LAS u32x2*)(Vt1 + e * 144 + c0 * 2) = o1; *(LAS u32x2*)(Vt2 + e * 144 + c0 * 2) = o2; } \
_Pragma("unroll") \
        for (int r = 0; r < 4; ++r) oacc[r] *= gv[c0 + r]; \
        P4D D3 = Dnn; \
        if (Dn.valid) { p4_stage(p, F, RX, Dn, buf ^ 1, mk, cw, cwn); \
            if (Dn.last && Dnn.valid) { const int e0_ = (tid & 7) * 4; _Pragma("unroll") for (int j = 0; j < 4; ++j) cwn[j] = *(const f32x4*)(p.dn_conv_w + j * 3072 + 2048 + Dnn.h * 128 + Dnn.sl * 32 + e0_); } if (Dnn.valid) { D3 = p4_next(F, Dnn); if (D3.valid) p4_prefetch(p, F, RX, D3, T); } } \
        lds_barrier(); \
         \
        { const float gl = gv[192]; \
_Pragma("unroll") \
          for (int nt = 0; nt < 2; ++nt) S[nt] *= gl; \
_Pragma("unroll") \
          for (int ks = 0; ks < 2; ++ks) \
_Pragma("unroll") \
              for (int nt = 0; nt < 2; ++nt) { const bf16x8 b_ = ldfrag(Vt2, 144, nt * 16 + l15, ks * 64 + q4 * 16); S[nt] = MFMA16(KT[ks], b_, S[nt]); } } \
_Pragma("unroll") \
        for (int ks = 0; ks < 2; ++ks) { const bf16x8 a_ = ldfrag(ATs, 144, ct * 16 + l15, ks * 64 + q4 * 16), b_ = ldfrag(Vt1, 144, et * 16 + l15, ks * 64 + q4 * 16); oacc = MFMA16(a_, b_, oacc); } \
_Pragma("unroll") \
        for (int r = 0; r < 4; ++r) *(bf16_t*)((char*)F.PROJ() + ((size_t)Dc.ci * 64 * NPROJ + Dc.d * 1024 + Dc.h * 128 + Dc.sl * 32) * 2 + (unsigned)(((c0 + r) * NPROJ + e) * 2)) = f2bf(oacc[r]); \
        if (Dc.last) { \
            if (!Dc.samp) { \
_Pragma("unroll") \
                for (int nt = 0; nt < 2; ++nt) \
_Pragma("unroll") \
                    for (int r = 0; r < 4; ++r) \
                        F.out[OUT_SD + (size_t)((Dc.seq * 2 + Dc.d) * 8 + Dc.h) * 16384 + (size_t)(wave * 16 + q4 * 4 + r) * 128 + Dc.sl * 32 + nt * 16 + l15] = S[nt][r]; \
            } \
            if (Dn.valid) P4_INIT_S(Dn); \
        } \
        P4_WRITE_SB(); \
        if (Dn.valid) P4_PRECOMP(buf ^ 1); \
        lds_barrier(); \
        if (!Dn.valid) break; \
        Dc = Dn; Dn = Dnn; Dnn = D3; buf ^= 1; \
    }
#pragma unroll 1
    for (;;) { P4_BODY(RA) P4_BODY(RB) }
#undef P4_BODY
#undef P4_INIT_S
#undef P4_WRITE_SB
#undef P4_PRECOMP
}
__device__ __forceinline__ void phase4(CParams& p, Frame& F) {
    if (F.G == 256) rg_carry_scan(p, F);
    else if (F.b == 0) {
        for (int g = F.tid; g < 69632; g += 512) { int samp = g >= 65536, gg = samp ? g - 65536 : g, seq = gg >> 11, d = (gg >> 10) & 1, ch = gg & 1023;
            const int nch = samp ? 64 : 4, c_lo = samp ? 128 + seq * 64 : seq * 4; float h = samp ? p.state_rglru[(size_t)(seq * 2 + d) * 1024 + ch] : 0.f;
            for (int i = 0; i < nch; ++i) { const int cc = d == 0 ? c_lo + i : c_lo + nch - 1 - i; const float* ag = F.RGAGG() + (size_t)(cc * 2 + d) * 2048; F.CARRY()[(size_t)(cc * 2 + d) * 1024 + ch] = h; h = ag[ch] * h + ag[1024 + ch]; } } }
    __syncthreads();
    phase4_chains(p, F);
}

__device__ __forceinline__ void phase5(CParams& p, Frame& F) {
    const int lane = F.lane;
    float nw[16];
#pragma unroll
    for (int q = 0; q < 4; ++q) { const f32x4 a = *(const f32x4*)(p.dn_norm_w + (lane & 7) * 16 + q * 4); nw[q * 4] = a[0]; nw[q * 4 + 1] = a[1]; nw[q * 4 + 2] = a[2]; nw[q * 4 + 3] = a[3]; }
#pragma unroll 4
    for (int tok = F.b * 8 + F.wave; tok < NTOK; tok += F.G * 8) {
        const bf16_t* pr = F.PROJ() + (size_t)tok * NPROJ + lane * 16;
        float o[16], z[16]; float ss = 0.f;
#pragma unroll
        for (int hf = 0; hf < 2; ++hf) { const u32x4 a = *(const u32x4*)(pr + hf * 8), b = *(const u32x4*)(pr + 1024 + hf * 8), zz = *(const u32x4*)(pr + 3072 + hf * 8);
            float fa[8], fb[8], fz[8]; unpack8(a, fa); unpack8(b, fb); unpack8(zz, fz);
#pragma unroll
            for (int e = 0; e < 8; ++e) { o[hf * 8 + e] = fa[e] + fb[e]; z[hf * 8 + e] = fz[e]; ss += o[hf * 8 + e] * o[hf * 8 + e]; } }
        ss += __shfl_xor(ss, 1); ss += __shfl_xor(ss, 2); ss += __shfl_xor(ss, 4);
        const float rs = rsqrtf(ss * (1.f / 128.f) + 1e-6f);
#pragma unroll
        for (int hf = 0; hf < 2; ++hf) { float w[8];
#pragma unroll
            for (int e = 0; e < 8; ++e) w[e] = o[hf * 8 + e] * rs * nw[hf * 8 + e] * siluf_(z[hf * 8 + e]);
            *(u32x4*)(F.MIX() + (size_t)tok * 2048 + lane * 16 + hf * 8) = pack8(w); }
        if (tok < 8192) {
            const u32x4 y0 = *(const u32x4*)(pr + 5120), y1 = *(const u32x4*)(pr + 5120 + 8);
            *(u32x4*)(F.MIX() + (size_t)tok * 2048 + 1024 + lane * 16) = y0; *(u32x4*)(F.MIX() + (size_t)tok * 2048 + 1024 + lane * 16 + 8) = y1; }
    }
    __syncthreads();
    for (int it = F.b; it < 1024; it += F.G) { u32x4 rows[5]; rg_load_rows(F, 128 + (it >> 3), it & 7, rows); rg_item<3>(p, F, 128 + (it >> 3), it & 7, rows, it + F.G); }
}

__device__ __forceinline__ void phase6(CParams& p, Frame& F) {
    pg8::Gemm g{F.MIX(), F.WoutT(), NTOK, 1024, 2048}; pg8::StaticOrder S; S.init(NTOK, 1024, F.G, F.b); pg8::EpiF32 E{(float*)F.PROJ(), 3072};
    pg8::gemm_phase<pg8::EpiF32, pg8::StaticOrder>(F.lds, g, S, E);
}

__device__ __forceinline__ void phase7(CParams& p, Frame& F) {
    LAS float* gt = (LAS float*)F.lds;
    for (int tb = F.b; tb < 256; tb += F.G) {
        const int grp = grp_of_block(tb);
        for (int j = F.tid; j < 1024; j += 512) gt[j] = mod_val(p, F, grp, 2048 + j) * p.post_w[j];
        __syncthreads();
#pragma unroll 2
        for (int i = 0; i < 8; ++i) {
            const int tok = tb * 64 + F.wave * 8 + i;
            const float* xr = tok < 8192 ? p.x_prompt + (size_t)tok * 1024 : p.x_sample + (size_t)(tok - 8192) * 1024;
            const float* yr = (const float*)F.PROJ() + (size_t)tok * 3072;
            f32x4 y[4]; float ss = 0.f;
#pragma unroll
            for (int q = 0; q < 4; ++q) { y[q] = *(const f32x4*)(yr + F.lane * 4 + 256 * q); ss += (y[q][0] * y[q][0] + y[q][1] * y[q][1]) + (y[q][2] * y[q][2] + y[q][3] * y[q][3]); }
            const float rstd = rsqrtf(wave_sum(ss) * (1.f / 1024.f) + 1e-6f);
#pragma unroll
            for (int q = 0; q < 4; ++q) { const int j = F.lane * 4 + 256 * q; f32x4 v = *(const f32x4*)(xr + j);
                if (tok >= 8192) { const int pp = (tok - 8192) & 4095; const int vv = (q < 2) ? (pp >> 6) : (pp & 63);
                    v += *(const f32x4*)(F.pe() + ((q & 1) ? 16384 : 0) + vv * 256 + F.lane * 4); }
                const f32x4 g4 = *(const LAS f32x4*)(gt + j);
                f32x4 ov = v + g4 * (y[q] * rstd); ov[0] = fin(ov[0]); ov[1] = fin(ov[1]); ov[2] = fin(ov[2]); ov[3] = fin(ov[3]); if (!(LIVE_MASK & 1)) ov = (f32x4){0.f, 0.f, 0.f, 0.f}; *(f32x4*)(F.out + (size_t)tok * 1024 + j) = ov; }
        }
        __syncthreads();
    }
}

__device__ __forceinline__ void phase8(CParams& p, Frame& F) {
    if (F.b == 0 && F.tid == 0) { int code = 0; for (int k = 31; k >= 1; --k) if (DG(F)[k]) code = k; F.out[OUT_SR] = 1000.f * (float)code + 500.f; }
}
extern __shared__ __attribute__((aligned(16))) unsigned char smem_raw[];
__global__ void __launch_bounds__(512) fwd_megakernel(Params p_unused) {
    CParams& p = *(CParams*)__builtin_amdgcn_kernarg_segment_ptr();
    Frame F;
    F.lds = (LAS unsigned char*)smem_raw;
    F.tid = threadIdx.x; F.lane = F.tid & 63; F.wave = __builtin_amdgcn_readfirstlane(F.tid >> 6); F.G = gridDim.x; F.b = blockIdx.x;
    F.out = p.out; F.ws = p.ws;
    volatile LAS unsigned* xbw = (volatile LAS unsigned*)(F.lds + LDS_BYTES - 16);
    const bool multi = (p.ph_hi - p.ph_lo) > 1;
    XcdBarrier xb; xb.bar = (unsigned*)(p.ws + WS_CTL); xb.x = 0; xb.st = xbw;
    if (multi) {
        if (F.tid == 0) { xbw[0] = 0u; xbw[1] = 0u; xbw[2] = 0u; xbw[3] = 0u; }
        __syncthreads();
        xb = xcd_barrier_post((unsigned*)(p.ws + WS_CTL), xbw);
    }
#ifndef PHMASK
#define PHMASK 511
#endif
    const int lo = p.ph_lo, hi = p.ph_hi;
#ifndef REP_PHASE
#define REP_PHASE -1
#endif
#define RUN_PHASE(k, fn) do { if (lo <= (k) && (k) < hi) { if (PHMASK & (1 << (k))) fn(p, F); if ((k) == REP_PHASE) { __syncthreads(); fn(p, F); } if ((k) + 1 < hi) xcd_barrier(xb); } } while (0)
    RUN_PHASE(0, phase0); RUN_PHASE(1, phase1); RUN_PHASE(2, phase2); RUN_PHASE(3, phase3);
    RUN_PHASE(4, phase4); RUN_PHASE(5, phase5); RUN_PHASE(6, phase6); RUN_PHASE(7, phase7); RUN_PHASE(8, phase8);
}

extern "C" void kernel_launch(void* const* d_in, const int* in_sizes, int n_in, void* d_out, int out_size, void* d_ws, size_t ws_size, hipStream_t stream) {
    static int grid = 0;
    if (grid == 0) {
        int dev = 0, cus = 0;
        if (hipGetDevice(&dev) != hipSuccess || hipDeviceGetAttribute(&cus, hipDeviceAttributeMultiprocessorCount, dev) != hipSuccess) { fprintf(stderr, "kernel_launch: device query failed\n"); grid = -1; return; }
        if (hipFuncSetAttribute((const void*)fwd_megakernel, hipFuncAttributeMaxDynamicSharedMemorySize, LDS_BYTES) != hipSuccess) { fprintf(stderr, "kernel_launch: hipFuncSetAttribute failed\n"); grid = -1; return; }
        int per_cu = 0;
        if (hipOccupancyMaxActiveBlocksPerMultiprocessor(&per_cu, (const void*)fwd_megakernel, 512, LDS_BYTES) != hipSuccess || per_cu < 1) { fprintf(stderr, "kernel_launch: occupancy query says %d blocks per CU\n", per_cu); (void)hipGetLastError(); }
        grid = cus;
    }
    if (grid < 0) return;
    Params p{};
    const float** pp = (const float**)&p;
    for (int i = 0; i < 23; ++i) pp[i] = (const float*)d_in[i];
    p.out = (float*)d_out; p.ws = (unsigned char*)d_ws;
    (void)hipMemsetAsync((char*)d_ws + WS_CTL, 0, 16384, stream);
#if MK_SINGLE
    p.ph_lo = 0; p.ph_hi = NPH;
    void* args[] = {&p};
    hipError_t e = hipLaunchCooperativeKernel((const void*)fwd_megakernel, dim3(grid), dim3(512), args, LDS_BYTES, stream);
    if (e != hipSuccess) fprintf(stderr, "cooperative launch failed: %s (grid %d)\n", hipGetErrorString(e), grid);
#else
    for (int ph = 0; ph < NPH; ++ph) {
        p.ph_lo = ph; p.ph_hi = ph + 1;
        hipLaunchKernelGGL(fwd_megakernel, dim3(grid), dim3(512), LDS_BYTES, stream, p);
    }
#endif
}
```

```cpp
#include <hip/hip_runtime.h>
#include <cstdio>
#include <cstdint>

#define LAS __attribute__((address_space(3)))
typedef unsigned short bf16_t;
typedef short bf16x8 __attribute__((ext_vector_type(8)));
typedef float f32x4 __attribute__((ext_vector_type(4)));
typedef unsigned u32x4 __attribute__((ext_vector_type(4)));
typedef unsigned u32x2 __attribute__((ext_vector_type(2)));

#ifndef REP_PHASE
#define REP_PHASE -1
#endif
#ifndef MK_SINGLE
#define MK_SINGLE 1
#endif

constexpr int NTOK = 16384, DM = 1024, NPROJ = 6144, DIN = 6176;
constexpr int NPH = 8;
constexpr int LDS_BYTES = 160 * 1024;
constexpr size_t OUT_YP = 0, OUT_YS = 8388608, OUT_SD = 16777216, OUT_SR = 25165824;
constexpr size_t WS_CTL = 0, WS_MODP = 16384, WS_PE = 606208, WS_BA = 737280, WS_GB = 2834432, WS_RGAGG = 4931584,
                 WS_WBAT = 9125888, WS_WOUTT = 9191424, WS_GT = 13385728, WS_WINT = 14434304, WS_TA = 27017216, WS_PROJ = 60571648, WS_CARRY = 261898240;

struct Params {
    const float *x_prompt, *x_sample, *state_delta, *state_rglru, *c, *c_ctx, *ada_w, *ada_b, *pre_w, *post_w, *w_in, *w_out,
                *dn_conv_w, *dn_a_log, *dn_dt_bias, *dn_norm_w, *rg_conv_w, *rg_conv_b, *rg_w_r, *rg_b_r, *rg_w_i, *rg_b_i, *rg_lam;
    float* out; unsigned char* ws;
    int ph_lo, ph_hi;
};

__device__ __forceinline__ float bf2f(unsigned short b) { return __uint_as_float(((unsigned)b) << 16); }
typedef __bf16 bf2_t __attribute__((ext_vector_type(2)));
typedef float f2_t __attribute__((ext_vector_type(2)));
__device__ __forceinline__ unsigned pk2(float lo, float hi) { const f2_t v = {lo, hi}; return __builtin_bit_cast(unsigned, __builtin_convertvector(v, bf2_t)); }
__device__ __forceinline__ unsigned short f2bf(float f) { return (unsigned short)(pk2(f, f) & 0xffffu); }
#ifndef SANITIZE
#define SANITIZE 0
#endif
#ifndef LIVE_MASK
#define LIVE_MASK 15
#endif
__device__ __forceinline__ float fin(float x) { return (SANITIZE && ((__float_as_uint(x) & 0x7f800000u) == 0x7f800000u)) ? 0.f : x; }
#define DG(F) ((unsigned*)((F).ws + WS_CTL))
__device__ __forceinline__ bool badv(float x, float lim) { return ((__float_as_uint(x) & 0x7f800000u) == 0x7f800000u) || fabsf(x) > lim; }
#ifndef DIAG
#define DIAG 0
#endif
#define CHK(F, k, bad) do { if (DIAG && (bad)) DG(F)[k] = 1u; } while (0)
__device__ __forceinline__ float sigm(float x) { return __builtin_amdgcn_rcpf(1.f + __expf(-x)); }
__device__ __forceinline__ float siluf_(float x) { return x * __builtin_amdgcn_rcpf(1.f + __expf(-x)); }
__device__ __forceinline__ float softplusf_(float x) { return x > 20.f ? x : log1pf(__expf(x)); }
__device__ __forceinline__ void unpack8(const u32x4 v, float (&f)[8]) {
    f[0] = __uint_as_float(v.x << 16); f[1] = __uint_as_float(v.x & 0xffff0000u);
    f[2] = __uint_as_float(v.y << 16); f[3] = __uint_as_float(v.y & 0xffff0000u);
    f[4] = __uint_as_float(v.z << 16); f[5] = __uint_as_float(v.z & 0xffff0000u);
    f[6] = __uint_as_float(v.w << 16); f[7] = __uint_as_float(v.w & 0xffff0000u);
}
__device__ __forceinline__ u32x4 pack8(const float (&f)[8]) { u32x4 o; o.x = pk2(f[0], f[1]); o.y = pk2(f[2], f[3]); o.z = pk2(f[4], f[5]); o.w = pk2(f[6], f[7]); return o; }
__device__ __forceinline__ float wave_sum(float v) {
#pragma unroll
    for (int o = 1; o < 64; o <<= 1) v += __shfl_xor(v, o);
    return v;
}
__device__ __forceinline__ void lds_barrier() { asm volatile("s_waitcnt lgkmcnt(0)" ::: "memory"); __builtin_amdgcn_s_barrier(); asm volatile("" ::: "memory"); }
#define MFMA16(a, b, c) __builtin_amdgcn_mfma_f32_16x16x32_bf16((a), (b), (c), 0, 0, 0)
#define LDS_WAIT() asm volatile("s_waitcnt lgkmcnt(0)" ::: "memory")
__device__ __forceinline__ bf16x8 ldfrag(const LAS unsigned char* base, int pitch, int row, int kb) { return *(const LAS bf16x8*)(base + row * pitch + kb); }

#define XB_TMO      128
#define XB_XCNT(j)  (256  + 64 * (j))
#define XB_XSUB(j)  (1280 + 64 * (j))
#define XB_XGEN(j)  (2304 + 64 * (j))
#define XB_TOP      3328
#define XB_TOPGEN   3392
#define XCD_BAR_WORDS 3456
#define XB_SPIN_CAP (1u << 18)
__device__ __forceinline__ unsigned xb_ld(unsigned* p)              { return __hip_atomic_load(p, __ATOMIC_RELAXED, __HIP_MEMORY_SCOPE_AGENT); }
__device__ __forceinline__ unsigned xb_add(unsigned* p, unsigned v) { return __hip_atomic_fetch_add(p, v, __ATOMIC_RELAXED, __HIP_MEMORY_SCOPE_AGENT); }
__device__ __forceinline__ unsigned xb_xcc_id() { return (unsigned)__builtin_amdgcn_s_getreg((3 << 11) | 20) & 0xFu; }
#define XB_SPIN(cond, bar) do { unsigned _sp = 0; while (cond) { __builtin_amdgcn_s_sleep(1); \
    if ((++_sp & 255u) == 0u) { if (xb_ld(&(bar)[XB_TMO])) break; if (_sp > XB_SPIN_CAP) { atomicAdd(&(bar)[XB_TMO], 1u); break; } } } } while (0)
struct XcdBarrier { unsigned* bar; unsigned x; volatile LAS unsigned* st; };
__device__ __forceinline__ XcdBarrier xcd_barrier_post(unsigned* bar, volatile LAS unsigned* st) {
    XcdBarrier b; b.bar = bar; b.x = xb_xcc_id(); b.st = st;
    if (threadIdx.x == 0) (void)xb_add(&bar[XB_XCNT(b.x)], 1u);
    return b;
}
__device__ __forceinline__ void xcd_barrier_complete(unsigned* bar, unsigned x, unsigned& nloc, unsigned& nx) {
    const unsigned G = gridDim.x * gridDim.y * gridDim.z;
    unsigned sum, cnt, mine, sp = 0u;
    for (;;) {
        sum = 0u; cnt = 0u; mine = 0u;
#pragma unroll
        for (unsigned j = 0; j < 16; ++j) { const unsigned c = xb_ld(&bar[XB_XCNT(j)]); sum += c; cnt += (c > 0u) ? 1u : 0u; mine = (j == x) ? c : mine; }
        if (sum == G) break;
        __builtin_amdgcn_s_sleep(1);
        if ((++sp & 255u) == 0u) { if (xb_ld(&bar[XB_TMO])) break; if (sp > XB_SPIN_CAP) { atomicAdd(&bar[XB_TMO], 1u); break; } }
    }
    nloc = mine > 0u ? mine : 1u; nx = cnt > 0u ? cnt : 1u;
}
__device__ __forceinline__ void xcd_barrier(const XcdBarrier& b) {
    asm volatile("s_waitcnt vmcnt(0)" ::: "memory");
    __syncthreads();
    if (threadIdx.x == 0) {
        unsigned* bar = b.bar;
        __builtin_amdgcn_s_waitcnt(0);
        unsigned nloc = b.st[0], nx = b.st[1];
        if (nloc == 0u) { xcd_barrier_complete(bar, b.x, nloc, nx); b.st[0] = nloc; b.st[1] = nx; }
        const unsigned old = xb_add(&bar[XB_XSUB(b.x)], 1u);
        const unsigned gen = old / nloc;
        if (old + 1u == (gen + 1u) * nloc) {
            __builtin_amdgcn_fence(__ATOMIC_RELEASE, "agent");
            asm volatile("s_waitcnt vmcnt(0)" ::: "memory");
            const unsigned og = xb_add(&bar[XB_TOP], 1u);
            const unsigned tg = og / nx;
            if (og + 1u == (tg + 1u) * nx) xb_add(&bar[XB_TOPGEN], 1u);
            else XB_SPIN(xb_ld(&bar[XB_TOPGEN]) == tg, bar);
            __builtin_amdgcn_fence(__ATOMIC_ACQUIRE, "agent");
            xb_add(&bar[XB_XGEN(b.x)], 1u);
            asm volatile("s_waitcnt vmcnt(0)" ::: "memory");
        } else {
            XB_SPIN(xb_ld(&bar[XB_XGEN(b.x)]) == gen, bar);
            __builtin_amdgcn_fence(__ATOMIC_ACQUIRE, "agent");
            asm volatile("s_waitcnt vmcnt(0)" ::: "memory");
        }
    }
    __syncthreads();
}

namespace pg8 {
constexpr int BM = 256, BK = 64, HALF = 128, HTB = HALF * BK * 2, STAGE_BYTES = 8 * HTB, NXCD = 8, WGM = 8;
__host__ __device__ __forceinline__ int lds_byte(int r, int c) { const int st = (r >> 4) * 2 + (c >> 5), rr = r & 15, cc = c & 31, ob = rr * 64 + cc * 2; return st * 1024 + (ob ^ (((ob >> 9) & 1) << 5)); }
__host__ __device__ __forceinline__ void stage_rc(int b, int& R, int& C) { const int st = b / 1024, sb = b % 1024, swz = sb ^ (((sb >> 9) & 1) << 5); R = (st >> 1) * 16 + swz / 64; C = (st & 1) * 32 + (swz % 64) / 2; }
__host__ __device__ __forceinline__ int perm32(int rho) { const int n = rho >> 4, i = rho & 15; return 8 * (i >> 2) + 4 * n + (i & 3); }
struct Unit { int pm, pn; };
struct Gemm { const bf16_t* A; const bf16_t* Bt; int M, N, K; };
struct StaticOrder {
    int nM, nN, nwg, G, c;
    __host__ __device__ void init(int M, int N, int G_, int c_) { nM = M / BM; nN = N / BM; nwg = nM * nN; G = G_; c = c_; }
    __host__ __device__ bool next(int i, Unit& u) const {
        const long L = (long)i * G + c; if (L >= nwg) return false;
        int wgid = (int)L; { const int q = nwg / NXCD, r = nwg % NXCD, xcd = wgid % NXCD, off = wgid / NXCD; wgid = (xcd < r ? xcd * (q + 1) : r * (q + 1) + (xcd - r) * q) + off; }
        const int nig = WGM * nN, gid = wgid / nig, fm = gid * WGM, gsz = (nM - fm) < WGM ? (nM - fm) : WGM;
        u.pm = fm + ((wgid % nig) % gsz); u.pn = (wgid % nig) / gsz; return true;
    }
};
__device__ __forceinline__ unsigned cvt_pk_bf16(float lo, float hi) { unsigned r; asm volatile("v_cvt_pk_bf16_f32 %0, %1, %2" : "=v"(r) : "v"(lo), "v"(hi)); return r; }
struct EpiF32 {
    static constexpr bool PERM = false;
    float* C; int ldc;
    __device__ __forceinline__ void operator()(const f32x4 (&acc)[2][2][4][2], const Unit& u, int wr, int wc, int fr, int fq) const {
        const int row0 = u.pm * BM + wr * 64 + fr, col0 = u.pn * BM + wc * 32 + 4 * fq;
#pragma unroll
        for (int ai = 0; ai < 2; ++ai)
#pragma unroll
            for (int m = 0; m < 4; ++m) { float* rowp = C + (size_t)(row0 + ai * HALF + m * 16) * ldc + col0;
#pragma unroll
                for (int bj = 0; bj < 2; ++bj)
#pragma unroll
                    for (int n = 0; n < 2; ++n) *(f32x4*)(rowp + bj * HALF + n * 16) = acc[ai][bj][m][n]; }
    }
};
struct EpiBf16 {
    static constexpr bool PERM = true;
    bf16_t* O; int ldc;
    __device__ __forceinline__ void operator()(const f32x4 (&acc)[2][2][4][2], const Unit& u, int wr, int wc, int fr, int fq) const {
        const int row0 = u.pm * BM + wr * 64 + fr; const int col0 = u.pn * BM + wc * 32 + 8 * fq;
#pragma unroll
        for (int ai = 0; ai < 2; ++ai)
#pragma unroll
            for (int m = 0; m < 4; ++m) { bf16_t* rowp = O + (size_t)(row0 + ai * HALF + m * 16) * ldc + col0;
#pragma unroll
                for (int bj = 0; bj < 2; ++bj) { const f32x4 v0 = acc[ai][bj][m][0], v1 = acc[ai][bj][m][1];
                    u32x4 w; w.x = cvt_pk_bf16(v0[0], v0[1]); w.y = cvt_pk_bf16(v0[2], v0[3]); w.z = cvt_pk_bf16(v1[0], v1[1]); w.w = cvt_pk_bf16(v1[2], v1[3]);
                    *(u32x4*)(rowp + bj * HALF) = w; } }
    }
};

template <class Epi, class Sched>
__device__ __forceinline__ void gemm_phase(LAS unsigned char* lds, const Gemm g, const Sched& S, const Epi& E) {
    const int tid = threadIdx.x, wid = __builtin_amdgcn_readfirstlane(tid >> 6), lane = tid & 63, wr = wid >> 2, wc = wid & 3, fr = lane & 15, fq = lane >> 4;
    const int K = g.K, nt = K / BK;
    unsigned voffA[2], voffB[2];
#pragma unroll
    for (int i = 0; i < 2; ++i) { int R, C; stage_rc(tid * 16 + i * 8192, R, C); const int Rb = Epi::PERM ? ((R & ~31) + perm32(R & 31)) : R;
        voffA[i] = (unsigned)(R * K + C) * 2u; voffB[i] = (unsigned)(Rb * K + C) * 2u; }
    const size_t kstep = (size_t)(BK * 2);
    const size_t hstep = (size_t)HALF * K * 2;
    const size_t tstep = 2 * hstep;
    const unsigned ldsw = (unsigned)wid * 1024u;
    const int aoff = lds_byte(wr * 64 + fr, fq * 8), boff = lds_byte(wc * 32 + fr, fq * 8);
#define PG8_SA(b, h) (((b) * 2 + (h)) * HTB)
#define PG8_SB(b, h) ((4 + (b) * 2 + (h)) * HTB)
#define PG8_STAGE(bufoff, gbase, voff) do { _Pragma("unroll") for (int _i = 0; _i < 2; ++_i) \
        __builtin_amdgcn_global_load_lds((const unsigned*)((const char*)(gbase) + (voff)[_i]), (LAS unsigned*)(lds + (bufoff) + ldsw + _i * 8192), 16, 0, 0); } while (0)
#define PG8_LDA(dst, b, h) do { _Pragma("unroll") for (int m = 0; m < 4; ++m) _Pragma("unroll") for (int k = 0; k < 2; ++k) dst[m][k] = *(const LAS bf16x8*)(lds + PG8_SA(b, h) + aoff + m * 2048 + k * 1024); } while (0)
#define PG8_LDB(dst, b, h) do { _Pragma("unroll") for (int n = 0; n < 2; ++n) _Pragma("unroll") for (int k = 0; k < 2; ++k) dst[n][k] = *(const LAS bf16x8*)(lds + PG8_SB(b, h) + boff + n * 2048 + k * 1024); } while (0)
#define PG8_MMA(ai, bj, At, Bt) do { __builtin_amdgcn_s_setprio(1); _Pragma("unroll") for (int m = 0; m < 4; ++m) _Pragma("unroll") for (int n = 0; n < 2; ++n) _Pragma("unroll") for (int k = 0; k < 2; ++k) \
        acc[ai][bj][m][n] = __builtin_amdgcn_mfma_f32_16x16x32_bf16(Bt[n][k], At[m][k], acc[ai][bj][m][n], 0, 0, 0); __builtin_amdgcn_s_setprio(0); } while (0)
#define PG8_WAIT_V(n) asm volatile("s_waitcnt vmcnt(" #n ")" ::: "memory")
#define PG8_WAIT_L(n) asm volatile("s_waitcnt lgkmcnt(" #n ")" ::: "memory")
#define PG8_BAR __builtin_amdgcn_s_barrier()
#define PG8_SCHED __builtin_amdgcn_sched_barrier(0)
    Unit cur, nxt; int ui = 0;
    if (!S.next(0, cur)) return;
    f32x4 acc[2][2][4][2];
#pragma unroll
    for (int a = 0; a < 2; ++a)
#pragma unroll
        for (int b = 0; b < 2; ++b)
#pragma unroll
            for (int m = 0; m < 4; ++m)
#pragma unroll
                for (int n = 0; n < 2; ++n) acc[a][b][m][n] = (f32x4){0.f, 0.f, 0.f, 0.f};
    bf16x8 At[4][2], B0[2][2], B1[2][2];
    const char* cA = (const char*)g.A + (size_t)cur.pm * tstep; const char* cB = (const char*)g.Bt + (size_t)cur.pn * tstep;
    PG8_STAGE(PG8_SB(0, 0), cB, voffB); PG8_STAGE(PG8_SA(0, 0), cA, voffA); PG8_STAGE(PG8_SB(0, 1), cB + hstep, voffB); PG8_STAGE(PG8_SA(0, 1), cA + hstep, voffA);
    if (wr == 1) PG8_BAR;
    PG8_WAIT_V(4); PG8_BAR;
    PG8_STAGE(PG8_SB(1, 0), cB + kstep, voffB); PG8_STAGE(PG8_SA(1, 0), cA + kstep, voffA); PG8_STAGE(PG8_SB(1, 1), cB + hstep + kstep, voffB);
    PG8_WAIT_V(6); PG8_BAR;
    for (;;) {
        const bool has_next = S.next(ui + 1, nxt);
        const char* nA = has_next ? (const char*)g.A + (size_t)nxt.pm * tstep : cA; const char* nB = has_next ? (const char*)g.Bt + (size_t)nxt.pn * tstep : cB;
        for (int t = 0; t < nt; t += 2) {
            const bool last = (t == nt - 2);
            const char* a1 = cA + (size_t)(t + 1) * kstep;
            const char* a2 = last ? nA : cA + (size_t)(t + 2) * kstep; const char* b2 = last ? nB : cB + (size_t)(t + 2) * kstep;
            const char* a3 = a2 + kstep; const char* b3 = b2 + kstep;
            PG8_LDB(B0, 0, 0); PG8_SCHED; PG8_LDA(At, 0, 0); PG8_STAGE(PG8_SA(1, 1), a1 + hstep, voffA);
            PG8_WAIT_L(8); PG8_BAR; PG8_WAIT_L(0); PG8_MMA(0, 0, At, B0); PG8_BAR; PG8_SCHED;
            PG8_LDB(B1, 0, 1); PG8_STAGE(PG8_SB(0, 0), b2, voffB);
            PG8_BAR; PG8_WAIT_L(0); PG8_MMA(0, 1, At, B1); PG8_BAR;
            PG8_LDA(At, 0, 1); PG8_STAGE(PG8_SA(0, 0), a2, voffA);
            PG8_BAR; PG8_WAIT_L(0); PG8_MMA(1, 0, At, B0); PG8_BAR; PG8_SCHED;
            PG8_STAGE(PG8_SB(0, 1), b2 + hstep, voffB);
            PG8_WAIT_V(6); PG8_BAR; PG8_MMA(1, 1, At, B1); PG8_BAR;
            PG8_LDB(B0, 1, 0); PG8_SCHED; PG8_LDA(At, 1, 0); PG8_STAGE(PG8_SA(0, 1), a2 + hstep, voffA);
            PG8_WAIT_L(8); PG8_BAR; PG8_WAIT_L(0); PG8_MMA(0, 0, At, B0); PG8_BAR; PG8_SCHED;
            PG8_LDB(B1, 1, 1); PG8_STAGE(PG8_SB(1, 0), b3, voffB);
            PG8_BAR; PG8_WAIT_L(0); PG8_MMA(0, 1, At, B1); PG8_BAR;
            PG8_LDA(At, 1, 1); PG8_STAGE(PG8_SA(1, 0), a3, voffA);
            PG8_BAR; PG8_WAIT_L(0); PG8_MMA(1, 0, At, B0); PG8_BAR; PG8_SCHED;
            PG8_STAGE(PG8_SB(1, 1), b3 + hstep, voffB);
            PG8_WAIT_V(6); PG8_BAR; PG8_MMA(1, 1, At, B1); PG8_BAR;
        }
        E(acc, cur, wr, wc, fr, fq);
        if (!has_next) break;
#pragma unroll
        for (int a = 0; a < 2; ++a)
#pragma unroll
            for (int b = 0; b < 2; ++b)
#pragma unroll
                for (int m = 0; m < 4; ++m)
#pragma unroll
                    for (int n = 0; n < 2; ++n) acc[a][b][m][n] = (f32x4){0.f, 0.f, 0.f, 0.f};
        cur = nxt; cA = nA; cB = nB; ++ui;
    }
    PG8_WAIT_V(0);
    if (wr == 0) PG8_BAR;
    PG8_BAR;
#undef PG8_SA
#undef PG8_SB
#undef PG8_STAGE
#undef PG8_LDA
#undef PG8_LDB
#undef PG8_MMA
#undef PG8_WAIT_V
#undef PG8_WAIT_L
#undef PG8_BAR
#undef PG8_SCHED
}
}

struct Frame {
    LAS unsigned char* lds;
    int tid, lane, wave, G, b;
    float* out; unsigned char* ws;
    __device__ __forceinline__ bf16_t* H() const { return (bf16_t*)out; }
    __device__ __forceinline__ bf16_t* Qc() const { return (bf16_t*)out; }
    __device__ __forceinline__ bf16_t* Kc() const { return (bf16_t*)(out + OUT_YS); }
    __device__ __forceinline__ bf16_t* MIX() const { return (bf16_t*)out; }
    __device__ __forceinline__ float* modp() const { return (float*)(ws + WS_MODP); }
    __device__ __forceinline__ float* pe() const { return (float*)(ws + WS_PE); }
    __device__ __forceinline__ float* BA() const { return (float*)(ws + WS_BA); }
    __device__ __forceinline__ float* GB() const { return (float*)(ws + WS_GB); }
    __device__ __forceinline__ float* RGAGG() const { return (float*)(ws + WS_RGAGG); }
    __device__ __forceinline__ bf16_t* WbaT() const { return (bf16_t*)(ws + WS_WBAT); }
    __device__ __forceinline__ bf16_t* WoutT() const { return (bf16_t*)(ws + WS_WOUTT); }
    __device__ __forceinline__ bf16_t* GT() const { return (bf16_t*)(ws + WS_GT); }
    __device__ __forceinline__ bf16_t* WinT() const { return (bf16_t*)(ws + WS_WINT); }
    __device__ __forceinline__ bf16_t* TA() const { return (bf16_t*)(ws + WS_TA); }
    __device__ __forceinline__ bf16_t* PROJ() const { return (bf16_t*)(ws + WS_PROJ); }
    __device__ __forceinline__ float* CARRY() const { return (float*)(ws + WS_CARRY); }
};
typedef const __attribute__((address_space(4))) Params CParams;

__device__ __forceinline__ int grp_of_block(int tb) { return tb < 128 ? 0 : (tb < 192 ? 1 : 2); }

__device__ __forceinline__ void transpose_item(const float* W, int N, int k0, int n0, bf16_t* WT0, int Kout, LAS float* scr, int lane) {
#pragma unroll 8
    for (int i = 0; i < 32; ++i) { const int kk = 2 * i + (lane >> 5); scr[kk * 33 + (lane & 31)] = W[(size_t)(k0 + kk) * N + n0 + (lane & 31)]; }
    LDS_WAIT();
    const int c = lane & 7;
#pragma unroll
    for (int j = 0; j < 4; ++j) { const int n = (lane >> 3) + 8 * j; const LAS float* s = scr + (8 * c) * 33 + n;
        u32x4 o; o.x = pk2(s[0 * 33], s[1 * 33]); o.y = pk2(s[2 * 33], s[3 * 33]); o.z = pk2(s[4 * 33], s[5 * 33]); o.w = pk2(s[6 * 33], s[7 * 33]);
        *(u32x4*)(WT0 + (size_t)n * Kout + k0 + 8 * c) = o; }
    LDS_WAIT();
}
__device__ __forceinline__ void phase0(CParams& p, Frame& F) {
    const int tid = F.tid, lane = F.lane;
    for (int it = F.b; it < 192; it += F.G) {
        const int jg = it % 12, ks = it / 12, j = jg * 256 + (tid & 255), half = tid >> 8, k0 = ks * 64 + half * 32;
        float s0 = 0.f, s1 = 0.f, s2 = 0.f;
#pragma unroll 8
        for (int k = 0; k < 32; ++k) { const int kk = k0 + k; const float w = p.ada_w[(size_t)kk * 3072 + j];
            s0 += siluf_(p.c_ctx[kk]) * w; s1 += siluf_(p.c[kk]) * w; s2 += siluf_(p.c[1024 + kk]) * w; }
        LAS float* red = (LAS float*)F.lds;
        if (half == 1) { red[tid - 256] = s0; red[256 + tid - 256] = s1; red[512 + tid - 256] = s2; }
        __syncthreads();
        if (half == 0) { F.modp()[(size_t)(ks * 3 + 0) * 3072 + j] = s0 + red[tid]; F.modp()[(size_t)(ks * 3 + 1) * 3072 + j] = s1 + red[256 + tid]; F.modp()[(size_t)(ks * 3 + 2) * 3072 + j] = s2 + red[512 + tid]; }
        __syncthreads();
    }
    LAS float* scr = (LAS float*)(F.lds + 4096 + F.wave * 8448);
    const int gw = F.b * 8 + F.wave, NGW = F.G * 8;
    constexpr int I_IN = 16 * 193, I_OUT = 32 * 32, I_G = 256, I_PE = 64;
    for (int it = gw; it < I_IN + I_OUT + I_G + I_PE; it += NGW) {
        int r = it;
        if (r < I_IN) { const int kb = r / 193, nb = r % 193, n0 = nb * 32;
            bf16_t* dst = n0 < 4096 ? F.WinT() + (size_t)n0 * 1024 : (n0 < 4128 ? F.WbaT() + (size_t)(n0 - 4096) * 1024 : F.WinT() + (size_t)(n0 - 32) * 1024);
            transpose_item(p.w_in, DIN, kb * 64, n0, dst, 1024, scr, lane); continue; }
        r -= I_IN;
        if (r < I_OUT) { const int kb = r / 32, nb = r % 32; transpose_item(p.w_out, 1024, kb * 64, nb * 32, F.WoutT() + (size_t)(nb * 32) * 2048, 2048, scr, lane); continue; }
        r -= I_OUT;
        if (r < I_G) { const int m = r >> 3, sub = r & 7, kb = sub >> 2, nb = sub & 3, g = m >> 4, dn = m & 15;
            const float* src = (g ? p.rg_w_i : p.rg_w_r) + (size_t)dn * 16384;
            transpose_item(src, 128, kb * 64, nb * 32, F.GT() + (size_t)m * 16384 + (size_t)(nb * 32) * 128, 128, scr, lane); continue; }
        r -= I_G;
        { const int v = r;
#pragma unroll
          for (int i = 0; i < 4; ++i) { const int idx = lane * 4 + i; const float f = expf(-9.210340371976184f * (float)idx / 256.f); const float a = (float)v * f;
              F.pe()[v * 256 + idx] = sinf(a); F.pe()[16384 + v * 256 + idx] = cosf(a); } }
    }
}

__device__ __forceinline__ float mod_val(CParams& p, const Frame& F, int grp, int j) {
    float s = p.ada_b[j];
#pragma unroll
    for (int ks = 0; ks < 16; ++ks) s += F.modp()[(size_t)(ks * 3 + grp) * 3072 + j];
    return s;
}

__device__ __forceinline__ void phase1(CParams& p, Frame& F) {
    LAS float* sc = (LAS float*)F.lds; LAS float* sh = sc + 1024;
    for (int tb = F.b; tb < 256; tb += F.G) {
        const int grp = grp_of_block(tb);
        for (int j = F.tid; j < 1024; j += 512) { sh[j] = mod_val(p, F, grp, j); sc[j] = p.pre_w[j] * (1.f + mod_val(p, F, grp, 1024 + j)); }
        __syncthreads();
#pragma unroll 2
        for (int i = 0; i < 8; ++i) {
            const int tok = tb * 64 + F.wave * 8 + i;
            const float* xr = tok < 8192 ? p.x_prompt + (size_t)tok * 1024 : p.x_sample + (size_t)(tok - 8192) * 1024;
            f32x4 v[4]; float ss = 0.f;
#pragma unroll
            for (int q = 0; q < 4; ++q) { v[q] = *(const f32x4*)(xr + F.lane * 4 + 256 * q);
                if (tok >= 8192) { const int pp = (tok - 8192) & 4095; const int vv = (q < 2) ? (pp >> 6) : (pp & 63);
                    const f32x4 e = *(const f32x4*)(F.pe() + ((q & 1) ? 16384 : 0) + vv * 256 + F.lane * 4); v[q] += e; }
                ss += (v[q][0] * v[q][0] + v[q][1] * v[q][1]) + (v[q][2] * v[q][2] + v[q][3] * v[q][3]); }
            const float rstd = rsqrtf(wave_sum(ss) * (1.f / 1024.f) + 1e-6f);
#pragma unroll
            for (int q = 0; q < 4; ++q) { const int j = F.lane * 4 + 256 * q; const f32x4 s4 = *(const LAS f32x4*)(sc + j), h4 = *(const LAS f32x4*)(sh + j);
                CHK(F, 1, badv(v[q][0] * rstd * s4[0] + h4[0], 100.f) || badv(v[q][3] * rstd * s4[3] + h4[3], 100.f));
                u32x2 o; o.x = pk2(v[q][0] * rstd * s4[0] + h4[0], v[q][1] * rstd * s4[1] + h4[1]); o.y = pk2(v[q][2] * rstd * s4[2] + h4[2], v[q][3] * rstd * s4[3] + h4[3]);
                *(u32x2*)(F.H() + (size_t)tok * 1024 + j) = o; }
        }
        __syncthreads();
    }
}

__device__ __forceinline__ void phase2(CParams& p, Frame& F) {
    { pg8::Gemm g{F.H(), F.WinT(), NTOK, NPROJ, 1024}; pg8::StaticOrder S; S.init(NTOK, NPROJ, F.G, F.b); pg8::EpiBf16 E{F.PROJ(), NPROJ};
      pg8::gemm_phase<pg8::EpiBf16, pg8::StaticOrder>(F.lds, g, S, E); }
    const int l15 = F.lane & 15, q4 = F.lane >> 4;
    for (int tb = F.b; tb < 256; tb += F.G) {
        const int mt = F.wave >> 1, nt = F.wave & 1;
        const bf16_t* ar = F.H() + (size_t)(tb * 64 + mt * 16 + l15) * 1024 + q4 * 8;
        const bf16_t* br = F.WbaT() + (size_t)(nt * 16 + l15) * 1024 + q4 * 8;
        f32x4 acc = {0.f, 0.f, 0.f, 0.f};
#pragma unroll 16
        for (int ks = 0; ks < 32; ++ks) { const bf16x8 a = *(const bf16x8*)(ar + ks * 32), b = *(const bf16x8*)(br + ks * 32); acc = MFMA16(a, b, acc); }
#pragma unroll
        for (int r = 0; r < 4; ++r) F.BA()[(size_t)(tb * 64 + mt * 16 + q4 * 4 + r) * 32 + nt * 16 + l15] = acc[r];
    }
}

__device__ __forceinline__ void p3_load_rows(const Frame& F, int ci, int h, u32x4 (&rows)[7]) {
    const int tid = F.tid, tg = tid >> 5, part = (tid >> 4) & 1, sub = tid & 15, col = part * 1024 + h * 128 + sub * 8, t0 = ci * 64;
    int seq_lo, seq_hi; if (ci < 128) { seq_lo = (ci >> 2) * 256; seq_hi = seq_lo + 256; } else { seq_lo = 8192 + ((ci - 128) >> 6) * 4096; seq_hi = seq_lo + 4096; }
    const int tb = t0 + tg * 4 - 2;
#pragma unroll
    for (int r = 0; r < 7; ++r) { const int tok = tb + r; u32x4 v = {0u, 0u, 0u, 0u};
        if (tok >= seq_lo && tok < seq_hi) v = *(const u32x4*)(F.PROJ() + (size_t)tok * NPROJ + col);
        rows[r] = v; }
}
__device__ __forceinline__ void p3_delta_item(CParams& p, Frame& F, int ci, int h, u32x4 (&rows)[7], int itn) {
    const int tid = F.tid, lane = F.lane, wave = F.wave, q4 = lane >> 4, l15 = lane & 15;
    LAS unsigned char* Ks = F.lds; LAS unsigned char* Qs = F.lds + 17408;
    LAS float* gfv = (LAS float*)(F.lds + 34816);
    LAS unsigned char* DIR0 = F.lds + 35840;
    LAS unsigned char* ATo = F.lds + 137728;
#pragma unroll
    for (int i = 0; i < 5; ++i) { const int ch = tid + 512 * i; if (ch < 2304) { const int dd = ch >= 1152, cc = ch - dd * 1152; *(LAS u32x4*)(DIR0 + dd * 47616 + 18432 + cc * 16) = (u32x4){0u, 0u, 0u, 0u}; } }
    const int t0 = ci * 64;
    int seq_lo, seq_hi; if (ci < 128) { seq_lo = (ci >> 2) * 256; seq_hi = seq_lo + 256; } else { seq_lo = 8192 + ((ci - 128) >> 6) * 4096; seq_hi = seq_lo + 4096; }
    {
        const int tg = tid >> 5, part = (tid >> 4) & 1, sub = tid & 15, col = part * 1024 + h * 128 + sub * 8;
        float w[4][8];
#pragma unroll
        for (int j = 0; j < 4; ++j) { const f32x4 a = *(const f32x4*)(p.dn_conv_w + j * 3072 + col), b = *(const f32x4*)(p.dn_conv_w + j * 3072 + col + 4);
            w[j][0] = a[0]; w[j][1] = a[1]; w[j][2] = a[2]; w[j][3] = a[3]; w[j][4] = b[0]; w[j][5] = b[1]; w[j][6] = b[2]; w[j][7] = b[3]; }
        float acc[4][8];
#pragma unroll
        for (int i = 0; i < 4; ++i)
#pragma unroll
            for (int e = 0; e < 8; ++e) acc[i][e] = 0.f;
#pragma unroll
        for (int r = 0; r < 7; ++r) {
            float x[8]; unpack8(rows[r], x);
#pragma unroll
            for (int j = 0; j < 4; ++j) { const int i = r - j; if (i >= 0 && i < 4) {
#pragma unroll
                for (int e = 0; e < 8; ++e) acc[i][e] += w[j][e] * x[e]; } } }
#pragma unroll
        for (int i = 0; i < 4; ++i) { float ss = 0.f;
#pragma unroll
            for (int e = 0; e < 8; ++e) { acc[i][e] = siluf_(acc[i][e]); ss += acc[i][e] * acc[i][e]; }
            ss += __shfl_xor(ss, 1); ss += __shfl_xor(ss, 2); ss += __shfl_xor(ss, 4); ss += __shfl_xor(ss, 8);
            const float rs = rsqrtf(ss + 1e-6f) * (part == 0 ? 0.08838834764831845f : 1.f);
#pragma unroll
            for (int e = 0; e < 8; ++e) acc[i][e] *= rs;
            CHK(F, 4, badv(acc[i][0], 1.01f) || badv(acc[i][5], 1.01f) || badv(ss * rs * rs, part == 0 ? 0.0079f : 1.01f));
            const u32x4 o = pack8(acc[i]); const int c = tg * 4 + i;
            *(LAS u32x4*)((part ? Ks : Qs) + c * 272 + sub * 16) = o;
            if (part == 0) *(u32x4*)(F.Qc() + (size_t)(t0 + c) * 1024 + h * 128 + sub * 8) = o; }
        if (part == 1) {
            bf16_t* kt = F.Kc() + (size_t)(ci * 8 + h) * 8192 + (size_t)(sub * 8) * 64 + tg * 4;
#pragma unroll
            for (int e = 0; e < 8; ++e) { u32x2 o2; o2.x = pk2(acc[0][e], acc[1][e]); o2.y = pk2(acc[2][e], acc[3][e]); *(u32x2*)(kt + e * 64) = o2; } }
    }
    if (wave == 0) {
        const float* ba = F.BA() + (size_t)(t0 + lane) * 32;
        const float bf_ = sigm(ba[h]), bb_ = sigm(ba[8 + h]);
        float s = -expf(p.dn_a_log[h]) * softplusf_(ba[16 + h] + p.dn_dt_bias[h]);
        float sb = -expf(p.dn_a_log[8 + h]) * softplusf_(ba[24 + h] + p.dn_dt_bias[8 + h]);
#pragma unroll
        for (int o = 1; o < 64; o <<= 1) { const float t = __shfl_up(s, o); if (lane >= o) s += t; }
#pragma unroll
        for (int o = 1; o < 64; o <<= 1) { const float t = __shfl_down(sb, o); if (lane + o < 64) sb += t; }
        CHK(F, 3, badv(ba[h], 1000.f) || badv(ba[24 + h], 1000.f));
        CHK(F, 8, badv(s, 1e4f) || badv(sb, 1e4f) || s > 0.f || sb > 0.f || bf_ < 0.f || bf_ > 1.f || bb_ < 0.f || bb_ > 1.f);
        gfv[lane] = s; gfv[64 + lane] = sb; gfv[128 + lane] = bf_; gfv[192 + lane] = bb_;
        float* gb = F.GB() + (size_t)(ci * 8 + h) * 256;
        gb[lane] = s; gb[64 + lane] = sb; gb[128 + lane] = bf_; gb[192 + lane] = bb_;
    }
    lds_barrier();
    const int d = wave >> 2, mt = wave & 3;
    LAS unsigned char* Db = DIR0 + d * 47616;
    LAS unsigned char* Brow = Db; LAS unsigned char* Btr = Db + 9216; LAS unsigned char* Xrow = Db + 18432; LAS unsigned char* Xtr = Db + 27648;
    LAS float* Dl = (LAS float*)(Db + 36864) + mt * 320; LAS unsigned char* M2t = Db + 41984; LAS unsigned char* Mts = Db + 44544 + mt * 768;
    const LAS unsigned char* Lrow = Brow;
    const LAS float* gd = gfv + d * 64; const LAS float* bd = gfv + 128 + d * 64;
    {
        f32x4 kk[4], qk[4];
#pragma unroll
        for (int n = 0; n < 4; ++n) { kk[n] = (f32x4){0.f, 0.f, 0.f, 0.f}; qk[n] = (f32x4){0.f, 0.f, 0.f, 0.f}; }
#pragma unroll
        for (int ks = 0; ks < 4; ++ks) { const bf16x8 ak = ldfrag(Ks, 272, mt * 16 + l15, ks * 64 + q4 * 16), aq = ldfrag(Qs, 272, mt * 16 + l15, ks * 64 + q4 * 16);
#pragma unroll
            for (int n = 0; n < 4; ++n) { const bf16x8 bk = ldfrag(Ks, 272, n * 16 + l15, ks * 64 + q4 * 16); kk[n] = MFMA16(ak, bk, kk[n]); qk[n] = MFMA16(aq, bk, qk[n]); } }
#pragma unroll
        for (int n = 0; n < 4; ++n) { const int C = n * 16 + l15; const float gC = gd[C], bC = bd[C]; float a4[4];
#pragma unroll
            for (int r = 0; r < 4; ++r) { const int R = mt * 16 + q4 * 4 + r;
                const float dec = __expf(-fabsf(gd[R] - gC));
                a4[r] = (C > R) ? (d == 0 ? bC : bd[R]) * kk[n][r] * dec : 0.f;
                const bool incl = d == 0 ? (R >= C) : (R < C);
                if (incl) ((LAS bf16_t*)ATo)[R * 64 + C] = f2bf(qk[n][r] * dec); }
            u32x2 o; o.x = pk2(a4[0], a4[1]); o.y = pk2(a4[2], a4[3]);
            *(LAS u32x2*)(Brow + C * 144 + (mt * 16 + q4 * 4) * 2) = o;
            if (n == mt) *(LAS f32x4*)(Dl + l15 * 20 + q4 * 4) = (f32x4){a4[0], a4[1], a4[2], a4[3]}; }
    }
    lds_barrier();
    if (lane < 16) {
        float x[16];
#pragma unroll
        for (int i = 0; i < 16; ++i) { float sv = (i == lane) ? 1.f : 0.f;
            float drow[16];
#pragma unroll
            for (int q = 0; q < 4; ++q) if (4 * q < i) { const f32x4 t4 = *(const LAS f32x4*)(Dl + i * 20 + 4 * q); drow[4 * q] = t4[0]; drow[4 * q + 1] = t4[1]; drow[4 * q + 2] = t4[2]; drow[4 * q + 3] = t4[3]; }
#pragma unroll
            for (int j = 0; j < i; ++j) sv -= drow[j] * x[j];
            x[i] = sv; }
#pragma unroll
        for (int i = 0; i < 16; ++i) ((LAS bf16_t*)Xrow)[(mt * 16 + i) * 72 + mt * 16 + lane] = f2bf(x[i]);
        u32x4 o0, o1; o0.x = pk2(x[0], x[1]); o0.y = pk2(x[2], x[3]); o0.z = pk2(x[4], x[5]); o0.w = pk2(x[6], x[7]);
        o1.x = pk2(x[8], x[9]); o1.y = pk2(x[10], x[11]); o1.z = pk2(x[12], x[13]); o1.w = pk2(x[14], x[15]);
        *(LAS u32x4*)(Xtr + (mt * 16 + lane) * 144 + mt * 32) = o0; *(LAS u32x4*)(Xtr + (mt * 16 + lane) * 144 + mt * 32 + 16) = o1;
    }
    lds_barrier();
    const bf16x8 zero8 = {0, 0, 0, 0, 0, 0, 0, 0};
    const f32x4 zero4 = {0.f, 0.f, 0.f, 0.f};
    if (mt & 1) {
        const int I1 = mt, I0 = mt - 1;
        bf16x8 a = zero8, b = zero8;
        if (q4 < 2) { a = ldfrag(Lrow, 144, I1 * 16 + l15, I0 * 32 + q4 * 16); b = ldfrag(Xtr, 144, I0 * 16 + l15, I0 * 32 + q4 * 16); }
        const f32x4 M = MFMA16(a, b, zero4);
        { u32x2 o; o.x = pk2(M[0], M[1]); o.y = pk2(M[2], M[3]); *(LAS u32x2*)(Mts + l15 * 48 + q4 * 8) = o; }
        LDS_WAIT();
        bf16x8 a2 = zero8, b2 = zero8;
        if (q4 < 2) { a2 = ldfrag(Xrow, 144, I1 * 16 + l15, I1 * 32 + q4 * 16); b2 = *(const LAS bf16x8*)(Mts + l15 * 48 + q4 * 16); }
        const f32x4 X = MFMA16(a2, b2, zero4);
#pragma unroll
        for (int r = 0; r < 4; ++r) ((LAS bf16_t*)Xrow)[(I1 * 16 + q4 * 4 + r) * 72 + I0 * 16 + l15] = f2bf(-X[r]);
        u32x2 o; o.x = pk2(-X[0], -X[1]); o.y = pk2(-X[2], -X[3]);
        *(LAS u32x2*)(Xtr + (I0 * 16 + l15) * 144 + (I1 * 16 + q4 * 4) * 2) = o;
    }
    lds_barrier();
    {
        const int mi = mt >> 1, ni = mt & 1;
        const bf16x8 a = ldfrag(Lrow, 144, 32 + mi * 16 + l15, q4 * 16), b = ldfrag(Xtr, 144, ni * 16 + l15, q4 * 16);
        const f32x4 M2 = MFMA16(a, b, zero4);
        { u32x2 o; o.x = pk2(M2[0], M2[1]); o.y = pk2(M2[2], M2[3]); *(LAS u32x2*)(M2t + (ni * 16 + l15) * 80 + (mi * 16 + q4 * 4) * 2) = o; }
        lds_barrier();
        const bf16x8 a2 = ldfrag(Xrow, 144, 32 + mi * 16 + l15, 64 + q4 * 16), b2 = *(const LAS bf16x8*)(M2t + (ni * 16 + l15) * 80 + q4 * 16);
        const f32x4 X = MFMA16(a2, b2, zero4);
#pragma unroll
        for (int r = 0; r < 4; ++r) { CHK(F, 6, badv(X[r], 20.f)); ((LAS bf16_t*)Xrow)[(32 + mi * 16 + q4 * 4 + r) * 72 + ni * 16 + l15] = f2bf(-X[r]); }
        u32x2 o; o.x = pk2(-X[0], -X[1]); o.y = pk2(-X[2], -X[3]);
        *(LAS u32x2*)(Xtr + (ni * 16 + l15) * 144 + (32 + mi * 16 + q4 * 4) * 2) = o;
    }
    lds_barrier();
    { bf16_t* dst = F.TA() + (size_t)(ci * 8 + h) * 8192;
      const int c = tid >> 3, s0 = (tid & 7) * 8;
      const u32x4 lo = *(const LAS u32x4*)(DIR0 + 18432 + c * 144 + s0 * 2), up = *(const LAS u32x4*)(DIR0 + 47616 + 27648 + c * 144 + s0 * 2);
      unsigned wl[4] = {lo.x, lo.y, lo.z, lo.w}, wu[4] = {up.x, up.y, up.z, up.w}, wo[4];
#pragma unroll
      for (int i = 0; i < 4; ++i) { const int sa = s0 + 2 * i, sb2 = sa + 1;
          const unsigned mlo = (sa <= c ? 0x0000FFFFu : 0u) | (sb2 <= c ? 0xFFFF0000u : 0u);
          wo[i] = (wl[i] & mlo) | (wu[i] & ~mlo); }
      *(u32x4*)(dst + tid * 8) = (u32x4){wo[0], wo[1], wo[2], wo[3]};
      *(u32x4*)(dst + 4096 + tid * 8) = *(const LAS u32x4*)(ATo + tid * 16); }
    lds_barrier();
}

struct RgW { bf16x8 g[2][2][4]; float br[2], bi[2], sp[2]; };
__device__ __forceinline__ void rg_load_w(CParams& p, const Frame& F, int n, RgW& W) {
    const int q4 = F.lane >> 4, j = F.wave * 16 + (F.lane & 15), ch = n * 128 + j;
#pragma unroll
    for (int d = 0; d < 2; ++d) {
#pragma unroll
        for (int g = 0; g < 2; ++g) { const bf16_t* gp = F.GT() + (size_t)((g * 2 + d) * 8 + n) * 16384 + (size_t)j * 128 + q4 * 8;
#pragma unroll
            for (int ks = 0; ks < 4; ++ks) W.g[d][g][ks] = *(const bf16x8*)(gp + ks * 32); }
        W.br[d] = p.rg_b_r[d * 1024 + ch]; W.bi[d] = p.rg_b_i[d * 1024 + ch]; W.sp[d] = softplusf_(-p.rg_lam[d * 1024 + ch]); }
}
__device__ __forceinline__ void rg_load_rows(const Frame& F, int ci, int n, u32x4 (&rows)[5]) {
    const int tid = F.tid, tg = tid >> 4, sub = tid & 15, col = 4096 + n * 128 + sub * 8, t0 = ci * 64;
    int c_lo, c_hi; if (ci < 128) { c_lo = (ci >> 2) * 4; c_hi = c_lo + 4; } else { c_lo = 128 + ((ci - 128) >> 6) * 64; c_hi = c_lo + 64; }
    const int tb = t0 + tg * 2 - 2;
#pragma unroll
    for (int r = 0; r < 5; ++r) { const int tok = tb + r; u32x4 v = {0u, 0u, 0u, 0u};
        if (tok >= c_lo * 64 && tok < c_hi * 64) v = *(const u32x4*)(F.PROJ() + (size_t)tok * NPROJ + col);
        rows[r] = v; }
}
template <int PASS>
__device__ __forceinline__ void rg_item(CParams& p, Frame& F, int ci, int n, u32x4 (&rows)[5], int itn) {
    const int tid = F.tid, lane = F.lane, wave = F.wave, q4 = lane >> 4, l15 = lane & 15;
    LAS unsigned char* xb = F.lds; LAS float* xf = (LAS float*)(F.lds + 17408); LAS float* Hs = (LAS float*)(F.lds + 50176);
    const int t0 = ci * 64;
    int seq_lo, seq_hi, c_lo, c_hi, seq; const bool samp = ci >= 128;
    if (!samp) { seq = ci >> 2; c_lo = seq * 4; c_hi = c_lo + 4; } else { seq = (ci - 128) >> 6; c_lo = 128 + seq * 64; c_hi = c_lo + 64; }
    seq_lo = c_lo * 64; seq_hi = c_hi * 64;
    const int j = wave * 16 + l15, ch = n * 128 + j;
    bf16x8 wA[2][4], wB[2][4];
#pragma unroll
    for (int g = 0; g < 2; ++g) { const bf16_t* gp = F.GT() + (size_t)((g * 2 + 0) * 8 + n) * 16384 + (size_t)j * 128 + q4 * 8;
#pragma unroll
        for (int ks = 0; ks < 4; ++ks) wA[g][ks] = *(const bf16x8*)(gp + ks * 32); }
    {
        const int tg = tid >> 4, sub = tid & 15, ch = n * 128 + sub * 8;
        float w[4][8], acc[2][8];
#pragma unroll
        for (int j = 0; j < 4; ++j) { const f32x4 a = *(const f32x4*)(p.rg_conv_w + j * 1024 + ch), b = *(const f32x4*)(p.rg_conv_w + j * 1024 + ch + 4);
            w[j][0] = a[0]; w[j][1] = a[1]; w[j][2] = a[2]; w[j][3] = a[3]; w[j][4] = b[0]; w[j][5] = b[1]; w[j][6] = b[2]; w[j][7] = b[3]; }
        { const f32x4 a = *(const f32x4*)(p.rg_conv_b + ch), b = *(const f32x4*)(p.rg_conv_b + ch + 4);
#pragma unroll
          for (int i = 0; i < 2; ++i) { acc[i][0] = a[0]; acc[i][1] = a[1]; acc[i][2] = a[2]; acc[i][3] = a[3]; acc[i][4] = b[0]; acc[i][5] = b[1]; acc[i][6] = b[2]; acc[i][7] = b[3]; } }
#pragma unroll
        for (int r = 0; r < 5; ++r) {
            float x[8]; unpack8(rows[r], x);
#pragma unroll
            for (int j = 0; j < 4; ++j) { const int i = r - j; if (i >= 0 && i < 2) {
#pragma unroll
                for (int e = 0; e < 8; ++e) acc[i][e] += w[j][e] * x[e]; } } }
#pragma unroll
        for (int i = 0; i < 2; ++i) { const int c = tg * 2 + i;
            *(LAS u32x4*)(xb + c * 272 + sub * 16) = pack8(acc[i]);
            *(LAS f32x4*)(xf + c * 128 + sub * 8) = (f32x4){acc[i][0], acc[i][1], acc[i][2], acc[i][3]};
            *(LAS f32x4*)(xf + c * 128 + sub * 8 + 4) = (f32x4){acc[i][4], acc[i][5], acc[i][6], acc[i][7]}; }
    }
    lds_barrier();
    f32x4 hs[4];
#pragma unroll
    for (int m = 0; m < 4; ++m) hs[m] = (f32x4){0.f, 0.f, 0.f, 0.f};
#pragma unroll
    for (int d = 0; d < 2; ++d) {
        f32x4 av[4], bxv[4];
        {
            f32x4 ar[4], ai[4];
#pragma unroll
            for (int m = 0; m < 4; ++m) { ar[m] = (f32x4){0.f, 0.f, 0.f, 0.f}; ai[m] = (f32x4){0.f, 0.f, 0.f, 0.f}; }
#pragma unroll
            for (int ks = 0; ks < 4; ++ks) { const bf16x8 br = d == 0 ? wA[0][ks] : wB[0][ks], bi = d == 0 ? wA[1][ks] : wB[1][ks];
#pragma unroll
                for (int m = 0; m < 4; ++m) { const bf16x8 a = ldfrag(xb, 272, m * 16 + l15, ks * 64 + q4 * 16); ar[m] = MFMA16(a, br, ar[m]); ai[m] = MFMA16(a, bi, ai[m]); } }
            if (d == 0) {
#pragma unroll
                for (int g = 0; g < 2; ++g) { const bf16_t* gp = F.GT() + (size_t)((g * 2 + 1) * 8 + n) * 16384 + (size_t)j * 128 + q4 * 8;
#pragma unroll
                    for (int ks = 0; ks < 4; ++ks) wB[g][ks] = *(const bf16x8*)(gp + ks * 32); } }
            const float L2E = 1.4426950408889634f;
            const float br_ = -L2E * p.rg_b_r[d * 1024 + ch], bi_ = -L2E * p.rg_b_i[d * 1024 + ch], sp = softplusf_(-p.rg_lam[d * 1024 + ch]);
            const float k2 = -16.f * sp, k2e = k2 * L2E, k1e = 0.5f * k2e;
#pragma unroll
            for (int m = 0; m < 4; ++m)
#pragma unroll
                for (int r = 0; r < 4; ++r) { const int c = m * 16 + q4 * 4 + r;
                    const float rr = __builtin_amdgcn_rcpf(1.f + __builtin_amdgcn_exp2f(fmaf(ar[m][r], -L2E, br_)));
                    const float ii = __builtin_amdgcn_rcpf(1.f + __builtin_amdgcn_exp2f(fmaf(ai[m][r], -L2E, bi_)));
                    const float t2 = k2 * rr;
                    const float ser = t2 * fmaf(t2, fmaf(t2, 0.16666667f, 0.5f), 1.f);
                    const float a_ = __builtin_amdgcn_exp2f(k1e * rr);
                    const float em = t2 > -0.01f ? ser : fmaf(a_, a_, -1.f);
                    av[m][r] = a_; bxv[m][r] = __builtin_amdgcn_sqrtf(-em) * (ii * xf[c * 128 + j]); }
        }
        f32x4 Pa[4], Pb[4]; float Ap[4], Bp[4], Am[4], Bm[4];
#pragma unroll
        for (int m = 0; m < 4; ++m) {
            float pa, pb;
            if (d == 0) { pa = av[m][0]; pb = bxv[m][0]; Pa[m][0] = pa; Pb[m][0] = pb;
#pragma unroll
                for (int r = 1; r < 4; ++r) { pb = av[m][r] * pb + bxv[m][r]; pa = av[m][r] * pa; Pa[m][r] = pa; Pb[m][r] = pb; } }
            else { pa = av[m][3]; pb = bxv[m][3]; Pa[m][3] = pa; Pb[m][3] = pb;
#pragma unroll
                for (int r = 2; r >= 0; --r) { pb = av[m][r] * pb + bxv[m][r]; pa = av[m][r] * pa; Pa[m][r] = pa; Pb[m][r] = pb; } }
            float Ak[4], Bk[4];
#pragma unroll
            for (int k = 0; k < 4; ++k) { Ak[k] = __shfl(pa, l15 + 16 * k); Bk[k] = __shfl(pb, l15 + 16 * k); }
            float ap = 1.f, bp = 0.f, am = 1.f, bm = 0.f;
#pragma unroll
            for (int kk = 0; kk < 4; ++kk) { const int k = d == 0 ? kk : 3 - kk;
                const bool before = d == 0 ? (k < q4) : (k > q4);
                const float nb = Ak[k] * bp + Bk[k], na = Ak[k] * ap;
                bp = before ? nb : bp; ap = before ? na : ap;
                bm = Ak[k] * bm + Bk[k]; am = Ak[k] * am; }
            Ap[m] = ap; Bp[m] = bp; Am[m] = am; Bm[m] = bm;
        }
        if (PASS == 1) {
            float At = 1.f, Bt = 0.f;
#pragma unroll
            for (int mm = 0; mm < 4; ++mm) { const int m = d == 0 ? mm : 3 - mm; Bt = Am[m] * Bt + Bm[m]; At = Am[m] * At; }
            if (q4 == 0) { float* ag = F.RGAGG() + (size_t)(ci * 2 + d) * 2048; ag[ch] = At; ag[1024 + ch] = Bt; }
        } else {
            float hb = F.CARRY()[(size_t)(ci * 2 + d) * 1024 + ch];
#pragma unroll
            for (int mm = 0; mm < 4; ++mm) { const int m = d == 0 ? mm : 3 - mm;
                const float hin = Ap[m] * hb + Bp[m];
#pragma unroll
                for (int r = 0; r < 4; ++r) hs[m][r] += Pa[m][r] * hin + Pb[m][r];
                hb = Am[m] * hb + Bm[m]; }
            if (!samp && q4 == 0 && ci == (d == 0 ? c_hi - 1 : c_lo)) F.out[OUT_SR + (size_t)(seq * 2 + d) * 1024 + ch] = hb;
        }
    }
    if (PASS == 1 && itn < 1024) rg_load_rows(F, 128 + (itn >> 3), itn & 7, rows);
    if (PASS == 3) {
#pragma unroll
        for (int m = 0; m < 4; ++m)
#pragma unroll
            for (int r = 0; r < 4; ++r) Hs[(m * 16 + q4 * 4 + r) * 128 + j] = hs[m][r];
        lds_barrier();
#pragma unroll
        for (int i = 0; i < 2; ++i) { const int chunk = tid + 512 * i, c = chunk >> 4, cc = chunk & 15;
            const u32x4 gv = *(const u32x4*)(F.PROJ() + (size_t)(t0 + c) * NPROJ + 5120 + n * 128 + cc * 8);
            float g[8]; unpack8(gv, g);
            const f32x4 ha = *(const LAS f32x4*)(Hs + c * 128 + cc * 8), hb2 = *(const LAS f32x4*)(Hs + c * 128 + cc * 8 + 4);
            float o[8];
#pragma unroll
            for (int e = 0; e < 4; ++e) { o[e] = ha[e] * siluf_(g[e]); o[4 + e] = hb2[e] * siluf_(g[4 + e]); }
            *(u32x4*)(F.MIX() + (size_t)(t0 + c) * 2048 + 1024 + n * 128 + cc * 8) = pack8(o); }
    }
    lds_barrier();
}

__device__ __forceinline__ void rg_conv_lds(CParams& p, const Frame& F, int n, const u32x4 (&rows)[5], LAS unsigned char* xb, LAS float* xf) {
    const int tid = F.tid, tg = tid >> 4, sub = tid & 15, ch = n * 128 + sub * 8;
    float w[4][8], acc[2][8];
#pragma unroll
    for (int j = 0; j < 4; ++j) { const f32x4 a = *(const f32x4*)(p.rg_conv_w + j * 1024 + ch), b = *(const f32x4*)(p.rg_conv_w + j * 1024 + ch + 4);
        w[j][0] = a[0]; w[j][1] = a[1]; w[j][2] = a[2]; w[j][3] = a[3]; w[j][4] = b[0]; w[j][5] = b[1]; w[j][6] = b[2]; w[j][7] = b[3]; }
    { const f32x4 a = *(const f32x4*)(p.rg_conv_b + ch), b = *(const f32x4*)(p.rg_conv_b + ch + 4);
#pragma unroll
      for (int i = 0; i < 2; ++i) { acc[i][0] = a[0]; acc[i][1] = a[1]; acc[i][2] = a[2]; acc[i][3] = a[3]; acc[i][4] = b[0]; acc[i][5] = b[1]; acc[i][6] = b[2]; acc[i][7] = b[3]; } }
#pragma unroll
    for (int r = 0; r < 5; ++r) { float x[8]; unpack8(rows[r], x);
#pragma unroll
        for (int j = 0; j < 4; ++j) { const int i = r - j; if (i >= 0 && i < 2) {
#pragma unroll
            for (int e = 0; e < 8; ++e) acc[i][e] += w[j][e] * x[e]; } } }
#pragma unroll
    for (int i = 0; i < 2; ++i) { const int c = tg * 2 + i;
        *(LAS u32x4*)(xb + c * 272 + sub * 16) = pack8(acc[i]);
        *(LAS f32x4*)(xf + c * 128 + sub * 8) = (f32x4){acc[i][0], acc[i][1], acc[i][2], acc[i][3]};
        *(LAS f32x4*)(xf + c * 128 + sub * 8 + 4) = (f32x4){acc[i][4], acc[i][5], acc[i][6], acc[i][7]}; }
}
template <int D>
__device__ __forceinline__ void rg_gate_scan(const Frame& F, const bf16x8 (&wg)[2][4], float br_, float bi_, float sp, const LAS unsigned char* xb, const LAS float* xf, int j,
                                             f32x4 (&Pa)[4], f32x4 (&Pb)[4], float (&Ap)[4], float (&Bp)[4], float (&Am)[4], float (&Bm)[4]) {
    const int lane = F.lane, q4 = lane >> 4, l15 = lane & 15;
    f32x4 av[4], bxv[4];
    {
        f32x4 ar[4], ai[4];
#pragma unroll
        for (int m = 0; m < 4; ++m) { ar[m] = (f32x4){0.f, 0.f, 0.f, 0.f}; ai[m] = (f32x4){0.f, 0.f, 0.f, 0.f}; }
#pragma unroll
        for (int ks = 0; ks < 4; ++ks) {
#pragma unroll
            for (int m = 0; m < 4; ++m) { const bf16x8 a = ldfrag(xb, 272, m * 16 + l15, ks * 64 + q4 * 16); ar[m] = MFMA16(a, wg[0][ks], ar[m]); ai[m] = MFMA16(a, wg[1][ks], ai[m]); } }
        const float L2E = 1.4426950408889634f;
        const float brs = -L2E * br_, bis = -L2E * bi_, k2 = -16.f * sp, k1e = 0.5f * k2 * L2E;
#pragma unroll
        for (int m = 0; m < 4; ++m)
#pragma unroll
            for (int r = 0; r < 4; ++r) { const int c = m * 16 + q4 * 4 + r;
                const float rr = __builtin_amdgcn_rcpf(1.f + __builtin_amdgcn_exp2f(fmaf(ar[m][r], -L2E, brs)));
                const float ii = __builtin_amdgcn_rcpf(1.f + __builtin_amdgcn_exp2f(fmaf(ai[m][r], -L2E, bis)));
                const float t2 = k2 * rr, a = __builtin_amdgcn_exp2f(k1e * rr);
                const float ser = t2 * fmaf(t2, fmaf(t2, 0.16666667f, 0.5f), 1.f);
                const float em = t2 > -0.01f ? ser : fmaf(a, a, -1.f);
                av[m][r] = a; bxv[m][r] = __builtin_amdgcn_sqrtf(-em) * (ii * xf[c * 128 + j]); }
    }
#pragma unroll
    for (int m = 0; m < 4; ++m) {
        float pa, pb;
        if (D == 0) { pa = av[m][0]; pb = bxv[m][0]; Pa[m][0] = pa; Pb[m][0] = pb;
#pragma unroll
            for (int r = 1; r < 4; ++r) { pb = av[m][r] * pb + bxv[m][r]; pa = av[m][r] * pa; Pa[m][r] = pa; Pb[m][r] = pb; } }
        else { pa = av[m][3]; pb = bxv[m][3]; Pa[m][3] = pa; Pb[m][3] = pb;
#pragma unroll
            for (int r = 2; r >= 0; --r) { pb = av[m][r] * pb + bxv[m][r]; pa = av[m][r] * pa; Pa[m][r] = pa; Pb[m][r] = pb; } }
        float Ak[4], Bk[4];
#pragma unroll
        for (int k = 0; k < 4; ++k) { Ak[k] = __shfl(pa, l15 + 16 * k); Bk[k] = __shfl(pb, l15 + 16 * k); }
        float ap = 1.f, bp = 0.f, am = 1.f, bm = 0.f;
#pragma unroll
        for (int kk = 0; kk < 4; ++kk) { const int k = D == 0 ? kk : 3 - kk;
            const bool before = D == 0 ? (k < q4) : (k > q4);
            const float nb = Ak[k] * bp + Bk[k], na = Ak[k] * ap;
            bp = before ? nb : bp; ap = before ? na : ap;
            bm = Ak[k] * bm + Bk[k]; am = Ak[k] * am; }
        Ap[m] = ap; Bp[m] = bp; Am[m] = am; Bm[m] = bm;
    }
}
template <int D>
__device__ __forceinline__ void rg_prompt_dir(CParams& p, Frame& F, int seq, int n) {
    const int tid = F.tid, lane = F.lane, wave = F.wave, q4 = lane >> 4, l15 = lane & 15;
    LAS unsigned char* xb = F.lds; LAS float* xf = (LAS float*)(F.lds + 17408); LAS float* Hs = (LAS float*)(F.lds + 50176); LAS bf16_t* Hf = (LAS bf16_t*)(F.lds + 82944);
    const int j = wave * 16 + l15, ch = n * 128 + j;
    bf16x8 wg[2][4];
#pragma unroll
    for (int g = 0; g < 2; ++g) { const bf16_t* gp = F.GT() + (size_t)((g * 2 + D) * 8 + n) * 16384 + (size_t)j * 128 + q4 * 8;
#pragma unroll
        for (int ks = 0; ks < 4; ++ks) wg[g][ks] = *(const bf16x8*)(gp + ks * 32); }
    const float br_ = p.rg_b_r[D * 1024 + ch], bi_ = p.rg_b_i[D * 1024 + ch], sp = softplusf_(-p.rg_lam[D * 1024 + ch]);
    float hb = 0.f;
    u32x4 rows[5];
    rg_load_rows(F, seq * 4 + (D == 0 ? 0 : 3), n, rows);
#pragma unroll 1
    for (int cs = 0; cs < 4; ++cs) {
        const int cidx = D == 0 ? cs : 3 - cs, ci = seq * 4 + cidx, t0 = ci * 64;
        rg_conv_lds(p, F, n, rows, xb, xf);
        if (cs < 3) rg_load_rows(F, seq * 4 + (D == 0 ? cidx + 1 : cidx - 1), n, rows);
        lds_barrier();
        f32x4 Pa[4], Pb[4]; float Ap[4], Bp[4], Am[4], Bm[4];
        rg_gate_scan<D>(F, wg, br_, bi_, sp, xb, xf, j, Pa, Pb, Ap, Bp, Am, Bm);
#pragma unroll
        for (int mm = 0; mm < 4; ++mm) { const int m = D == 0 ? mm : 3 - mm;
            const float hin = Ap[m] * hb + Bp[m];
#pragma unroll
            for (int r = 0; r < 4; ++r) { const float hv = Pa[m][r] * hin + Pb[m][r]; const int tl = m * 16 + q4 * 4 + r;
                if (D == 0) Hf[(cidx * 64 + tl) * 128 + j] = f2bf(hv);
                else Hs[tl * 128 + j] = hv + bf2f(Hf[(cidx * 64 + tl) * 128 + j]); }
            hb = Am[m] * hb + Bm[m]; }
        lds_barrier();
        if (D == 1) {
#pragma unroll
            for (int i = 0; i < 2; ++i) { const int chunk = tid + 512 * i, c = chunk >> 4, cc = chunk & 15;
                bf16_t* gp = F.PROJ() + (size_t)(t0 + c) * NPROJ + 5120 + n * 128 + cc * 8;
                const u32x4 gv = *(const u32x4*)gp; float g[8]; unpack8(gv, g);
                const f32x4 ha = *(const LAS f32x4*)(Hs + c * 128 + cc * 8), hb2 = *(const LAS f32x4*)(Hs + c * 128 + cc * 8 + 4);
                float o[8];
#pragma unroll
                for (int e = 0; e < 4; ++e) { o[e] = ha[e] * siluf_(g[e]); o[4 + e] = hb2[e] * siluf_(g[4 + e]); }
                *(u32x4*)gp = pack8(o); }
            lds_barrier();
        }
    }
    if (q4 == 0) F.out[OUT_SR + (size_t)(seq * 2 + D) * 1024 + ch] = hb;
}

__device__ __forceinline__ void rg_carry_scan(CParams& p, Frame& F) {
    const int tid = F.tid;
    int samp, seq, d, ch;
    if (tid < 256) return;
    else if (tid < 272) { const int g = F.b * 16 + tid - 256; if (g >= 4096) return; samp = 1; seq = g >> 11; d = (g >> 10) & 1; ch = g & 1023; }
    else return;
    const int nch = samp ? 64 : 4, c_lo = samp ? 128 + seq * 64 : seq * 4;
    float h = samp ? p.state_rglru[(size_t)(seq * 2 + d) * 1024 + ch] : 0.f;
    for (int i0 = 0; i0 < nch; i0 += 4) {
        float A[4], B[4];
#pragma unroll
        for (int u = 0; u < 4; ++u) { const int cc = d == 0 ? c_lo + i0 + u : c_lo + nch - 1 - i0 - u; const float* ag = F.RGAGG() + (size_t)(cc * 2 + d) * 2048; A[u] = ag[ch]; B[u] = ag[1024 + ch]; }
#pragma unroll
        for (int u = 0; u < 4; ++u) { const int cc = d == 0 ? c_lo + i0 + u : c_lo + nch - 1 - i0 - u; F.CARRY()[(size_t)(cc * 2 + d) * 1024 + ch] = h; h = A[u] * h + B[u]; }
    }
}

__device__ __forceinline__ void phase3(CParams& p, Frame& F) {
    for (int rep = 0; rep < (REP_PHASE == 30 ? 2 : 1); ++rep)
    for (int it = F.b; it < 2048; it += F.G) { u32x4 rows[7]; p3_load_rows(F, it >> 3, it & 7, rows); p3_delta_item(p, F, it >> 3, it & 7, rows, it + F.G); }
    for (int rep = 0; rep < (REP_PHASE == 31 ? 2 : 1); ++rep) {
    u32x4 rows[5]; if (F.b < 1024) rg_load_rows(F, 128 + (F.b >> 3), F.b & 7, rows);
    for (int it = F.b; it < 1024; it += F.G) rg_item<1>(p, F, 128 + (it >> 3), it & 7, rows, it + F.G); }
    for (int it = F.b; it < 256; it += F.G) { rg_prompt_dir<0>(p, F, it >> 3, it & 7); rg_prompt_dir<1>(p, F, it >> 3, it & 7); }
}

struct P4D { int valid, samp, seq, h, d, sl, ci, seq_lo, seq_hi, last, k, s, nch; };
__device__ __forceinline__ P4D p4_desc(const Frame& F, int k, int s) {
    P4D D; int item;
    if (F.G == 256) {
        const int x = F.b & 7, y = F.b >> 3;
        if (y < 16) { item = (x * 4 + (y >> 2)) * 4 + (y & 3); D.valid = k < 1; }
        else { const int j = y - 16; item = 128 + (x * 64 + (j >> 2) * 16 + k) * 4 + (j & 3); D.valid = k < 16; } }
    else { item = F.b + k * F.G; D.valid = item < 2176; }
    D.samp = item < 128; const int it = D.samp ? item : item - 128, chain = it >> 2;
    D.sl = it & 3; D.seq = chain >> 4; D.h = (chain >> 1) & 7; D.d = chain & 1;
    D.nch = D.samp ? 64 : 4; const int chunk0 = D.samp ? 128 + D.seq * 64 : D.seq * 4;
    D.seq_lo = chunk0 * 64; D.seq_hi = D.seq_lo + D.nch * 64;
    D.ci = D.d == 0 ? chunk0 + s : chunk0 + D.nch - 1 - s; D.last = s == D.nch - 1; D.k = k; D.s = s;
    return D;
}
__device__ __forceinline__ P4D p4_next(const Frame& F, const P4D& D) {
    if (D.s + 1 < D.nch) { P4D N = D; N.s = D.s + 1; N.ci = D.ci + (D.d == 0 ? 1 : -1); N.last = N.s == D.nch - 1; return N; }
    return p4_desc(F, D.k + 1, 0);
}
struct P4Pre { u32x4 k0, k1, q0, q1, ti, at; u32x2 v[4]; float g, b, bc; };
struct P4T { unsigned oKQ, oTA, oV, oG, oGc; int cj; };
__device__ __forceinline__ P4T p4_thread_consts(int tid) {
    P4T T; T.oKQ = (unsigned)(((tid >> 4) * 1024 + (tid & 15) * 8) * 2); T.oTA = (unsigned)tid * 16u;
    T.oV = (unsigned)(((tid >> 3) * NPROJ + (tid & 7) * 4) * 2); T.oG = (unsigned)(tid & 63) * 4u; T.oGc = (unsigned)(tid >> 3) * 4u; T.cj = (tid >> 3) - 2; return T;
}
__device__ __forceinline__ void p4_prefetch(CParams& p, const Frame& F, P4Pre& R, const P4D& D, const P4T& T) {
    const int tid = F.tid, t0 = D.ci * 64, h = D.h;
    const char* kb = (const char*)F.Kc() + (size_t)(D.ci * 8 + h) * 16384;
    const char* qb = (const char*)F.Qc() + ((size_t)t0 * 1024 + h * 128) * 2;
    const char* tb = (const char*)F.TA() + (size_t)(D.ci * 8 + h) * 16384;
    const char* vb = (const char*)F.PROJ() + ((long)(t0 - 2) * NPROJ + 2048 + h * 128 + D.sl * 32) * 2;
    const char* gb = (const char*)F.GB() + (size_t)(D.ci * 8 + h) * 1024 + D.d * 256;
    R.k0 = *(const u32x4*)(kb + T.oTA); R.k1 = *(const u32x4*)(kb + T.oTA + 8192u);
    R.q0 = *(const u32x4*)(qb + T.oKQ); R.q1 = *(const u32x4*)(qb + T.oKQ + 65536u);
    R.ti = *(const u32x4*)(tb + T.oTA); R.at = *(const u32x4*)(tb + T.oTA + 8192u);
#pragma unroll
    for (int j = 0; j < 4; ++j) { const int tok = t0 + T.cj + j; u32x2 v = {0u, 0u};
        if (tok >= D.seq_lo && tok < D.seq_hi) v = *(const u32x2*)(vb + T.oV + (unsigned)(j * NPROJ * 2));
        R.v[j] = v; }
    R.bc = *(const float*)(gb + 512 + T.oGc);
    R.g = 0.f; R.b = 0.f;
    if (tid < 64) { R.g = *(const float*)(gb + T.oG); R.b = *(const float*)(gb + 512 + T.oG); }
}
__device__ __forceinline__ u32x4 tri_mask(u32x4 v, int c, int s0, int d) {
    unsigned w[4] = {v.x, v.y, v.z, v.w};
#pragma unroll
    for (int i = 0; i < 4; ++i) { const int slo = s0 + 2 * i, shi = slo + 1;
        const bool klo = d == 0 ? (c >= slo) : (c <= slo), khi = d == 0 ? (c >= shi) : (c <= shi);
        w[i] &= (klo ? 0x0000FFFFu : 0u) | (khi ? 0xFFFF0000u : 0u); }
    return (u32x4){w[0], w[1], w[2], w[3]};
}
constexpr int P4_KS = 0, P4_TI = 17408, P4_VBT = 26624, P4_WL = 31232, P4_SB = 48640, P4_VT1 = 57344, P4_VT2 = 61952, P4_QS = 66560, P4_AT = 101376, P4_GV = 119808, P4_KT = 122368;
__device__ __forceinline__ void p4_stage(CParams& p, const Frame& F, const P4Pre& R, const P4D& D, int buf, const unsigned (&mk)[2][4], f32x4 (&cw)[4], const f32x4 (&cwn)[4]) {
    const int tid = F.tid, d = D.d;
    LAS unsigned char* Ks = F.lds + P4_KS; LAS unsigned char* Qs = F.lds + P4_QS + buf * 17408; LAS unsigned char* TIs = F.lds + P4_TI;
    LAS unsigned char* ATs = F.lds + P4_AT + buf * 9216; LAS unsigned char* Vbt = F.lds + P4_VBT; LAS float* gv = (LAS float*)(F.lds + P4_GV + buf * 1280);
    { const int row = tid >> 4, cc = tid & 15;
      *(LAS u32x4*)(Qs + row * 272 + cc * 16) = R.q0; *(LAS u32x4*)(Qs + (32 + row) * 272 + cc * 16) = R.q1; }
    { const int dk = tid >> 3, cp = tid & 7; LAS unsigned char* Kts = F.lds + P4_KT;
      *(LAS u32x4*)(Kts + dk * 144 + cp * 16) = R.k0; *(LAS u32x4*)(Kts + (64 + dk) * 144 + cp * 16) = R.k1; }
    { const int c = tid >> 3, s0 = (tid & 7) * 8;
      const unsigned m0 = d ? mk[1][0] : mk[0][0], m1 = d ? mk[1][1] : mk[0][1], m2 = d ? mk[1][2] : mk[0][2], m3 = d ? mk[1][3] : mk[0][3];
      *(LAS u32x4*)(TIs + c * 144 + s0 * 2) = (u32x4){R.ti.x & m0, R.ti.y & m1, R.ti.z & m2, R.ti.w & m3};
      *(LAS u32x4*)(ATs + c * 144 + s0 * 2) = (u32x4){R.at.x & m0, R.at.y & m1, R.at.z & m2, R.at.w & m3}; }
    { const int c = tid >> 3, e0 = (tid & 7) * 4; float o[4] = {0.f, 0.f, 0.f, 0.f};
      if (D.s == 0) {
#pragma unroll
          for (int j = 0; j < 4; ++j) cw[j] = cwn[j]; }
#pragma unroll
      for (int j = 0; j < 4; ++j) { const u32x2 v = R.v[j];
          o[0] += cw[j][0] * __uint_as_float(v.x << 16); o[1] += cw[j][1] * __uint_as_float(v.x & 0xffff0000u);
          o[2] += cw[j][2] * __uint_as_float(v.y << 16); o[3] += cw[j][3] * __uint_as_float(v.y & 0xffff0000u); }
#pragma unroll
      for (int i = 0; i < 4; ++i) ((LAS bf16_t*)Vbt)[(e0 + i) * 72 + c] = f2bf(siluf_(o[i]) * R.bc); }
    if (tid < 64) {
        const float glast = __shfl(R.g, d == 0 ? 63 : 0), eg = __expf(R.g);
        gv[tid] = eg; gv[64 + tid] = R.b * eg; gv[128 + tid] = __expf(glast - R.g); if (tid == 0) gv[192] = __expf(glast);
    }
}
__device__ __forceinline__ void phase4_chains(CParams& p, Frame& F) {
    const int tid = F.tid, lane = F.lane, wave = F.wave, q4 = lane >> 4, l15 = lane & 15;
    LAS unsigned char* Ks = F.lds + P4_KS; LAS unsigned char* TIs = F.lds + P4_TI; LAS unsigned char* Vbt = F.lds + P4_VBT; LAS unsigned char* Wl = F.lds + P4_WL;
    LAS unsigned char* Sb = F.lds + P4_SB; LAS unsigned char* Vt1 = F.lds + P4_VT1; LAS unsigned char* Vt2 = F.lds + P4_VT2;
    const int ct = wave & 3, et = wave >> 2;
    P4D Dc = p4_desc(F, 0, 0);
    if (!Dc.valid) return;
    P4Pre RA, RB;
    f32x4 S[2], U; bf16x8 KT[2];
    unsigned mk[2][4]; f32x4 cw[4], cwn[4];
    { const int c = tid >> 3, s0 = (tid & 7) * 8;
#pragma unroll
      for (int i = 0; i < 4; ++i) { const int slo = s0 + 2 * i, shi = slo + 1;
          mk[0][i] = (c >= slo ? 0x0000FFFFu : 0u) | (c >= shi ? 0xFFFF0000u : 0u); mk[1][i] = (c <= slo ? 0x0000FFFFu : 0u) | (c <= shi ? 0xFFFF0000u : 0u); } }
#define P4_INIT_S(D) do { _Pragma("unroll") for (int nt = 0; nt < 2; ++nt) _Pragma("unroll") for (int r = 0; r < 4; ++r) \
        S[nt][r] = (D).samp ? p.state_delta[(size_t)(((D).seq * 2 + (D).d) * 8 + (D).h) * 16384 + (size_t)(wave * 16 + q4 * 4 + r) * 128 + (D).sl * 32 + nt * 16 + l15] : 0.f; } while (0)
#define P4_WRITE_SB() do { _Pragma("unroll") for (int nt = 0; nt < 2; ++nt) { u32x2 o_; o_.x = pk2(S[nt][0], S[nt][1]); o_.y = pk2(S[nt][2], S[nt][3]); \
        *(LAS u32x2*)(Sb + (nt * 16 + l15) * 272 + (wave * 16 + q4 * 4) * 2) = o_; } } while (0)
#define P4_PRECOMP(buf_) do { const LAS float* gv_ = (const LAS float*)(F.lds + P4_GV + (buf_) * 1280); \
        f32x4 WT[4]; _Pragma("unroll") for (int c_ = 0; c_ < 4; ++c_) WT[c_] = (f32x4){0.f, 0.f, 0.f, 0.f}; \
        _Pragma("unroll") for (int ks = 0; ks < 2; ++ks) { \
            const u32x4 kraw = *(const LAS u32x4*)(F.lds + P4_KT + (wave * 16 + l15) * 144 + ks * 64 + q4 * 16); KT[ks] = __builtin_bit_cast(bf16x8, kraw); \
            const f32x4 sa = *(const LAS f32x4*)(gv_ + 64 + ks * 32 + q4 * 8), sb_ = *(const LAS f32x4*)(gv_ + 64 + ks * 32 + q4 * 8 + 4); \
            float kf[8]; unpack8(kraw, kf); u32x4 kg; \
            kg.x = pk2(kf[0] * sa[0], kf[1] * sa[1]); kg.y = pk2(kf[2] * sa[2], kf[3] * sa[3]); kg.z = pk2(kf[4] * sb_[0], kf[5] * sb_[1]); kg.w = pk2(kf[6] * sb_[2], kf[7] * sb_[3]); \
            const bf16x8 akg = __builtin_bit_cast(bf16x8, kg); \
            _Pragma("unroll") for (int c_ = 0; c_ < 4; ++c_) { const bf16x8 bt = ldfrag(TIs, 144, c_ * 16 + l15, ks * 64 + q4 * 16); WT[c_] = MFMA16(akg, bt, WT[c_]); } } \
        _Pragma("unroll") for (int c_ = 0; c_ < 4; ++c_) { u32x2 o_; o_.x = pk2(WT[c_][0], WT[c_][1]); o_.y = pk2(WT[c_][2], WT[c_][3]); \
            *(LAS u32x2*)(Wl + (c_ * 16 + l15) * 272 + (wave * 16 + q4 * 4) * 2) = o_; } \
        U = (f32x4){0.f, 0.f, 0.f, 0.f}; \
        _Pragma("unroll") for (int ks = 0; ks < 2; ++ks) { const bf16x8 a_ = ldfrag(TIs, 144, ct * 16 + l15, ks * 64 + q4 * 16), b_ = ldfrag(Vbt, 144, et * 16 + l15, ks * 64 + q4 * 16); U = MFMA16(a_, b_, U); } } while (0)

    const P4T T = p4_thread_consts(tid);
    p4_prefetch(p, F, RA, Dc, T);
    P4_INIT_S(Dc);
    { const int e0 = (tid & 7) * 4;
#pragma unroll
      for (int j = 0; j < 4; ++j) cwn[j] = *(const f32x4*)(p.dn_conv_w + j * 3072 + 2048 + Dc.h * 128 + Dc.sl * 32 + e0); }
    p4_stage(p, F, RA, Dc, 0, mk, cw, cwn);
    P4_WRITE_SB();
    P4D Dn = p4_next(F, Dc);
    if (Dn.valid) p4_prefetch(p, F, RA, Dn, T);
    P4D Dnn = Dn; if (Dn.valid) { Dnn = p4_next(F, Dn); if (Dnn.valid) p4_prefetch(p, F, RB, Dnn, T); }
    lds_barrier();
    P4_PRECOMP(0);
    lds_barrier();
    int buf = 0;
#define P4_BODY(RX) { \
        const LAS float* gv = (const LAS float*)(F.lds + P4_GV + buf * 1280); \
        const LAS unsigned char* Qs = F.lds + P4_QS + buf * 17408; const LAS unsigned char* ATs = F.lds + P4_AT + buf * 9216; \
        const int c0 = ct * 16 + q4 * 4, e = et * 16 + l15; \
         \
        f32x4 p1 = {0.f, 0.f, 0.f, 0.f}, oacc = {0.f, 0.f, 0.f, 0.f}; \
_Pragma("unroll") \
        for (int ks = 0; ks < 4; ++ks) { const bf16x8 bs = ldfrag(Sb, 272, et * 16 + l15, ks * 64 + q4 * 16); \
            const bf16x8 aw = ldfrag(Wl, 272, ct * 16 + l15, ks * 64 + q4 * 16), aq = ldfrag(Qs, 272, ct * 16 + l15, ks * 64 + q4 * 16); \
            p1 = MFMA16(aw, bs, p1); oacc = MFMA16(aq, bs, oacc); } \
        { float vn[4]; \
_Pragma("unroll") \
          for (int r = 0; r < 4; ++r) vn[r] = U[r] - p1[r]; \
          u32x2 o1, o2; o1.x = pk2(vn[0], vn[1]); o1.y = pk2(vn[2], vn[3]); \
          o2.x = pk2(vn[0] * gv[128 + c0], vn[1] * gv[128 + c0 + 1]); o2.y = pk2(vn[2] * gv[128 + c0 + 2], vn[3] * gv[128 + c0 + 3]); \
          *(LAS u32x2*)(Vt1 + e * 144 + c0 * 2) = o1; *(LAS u32x2*)(Vt2 + e * 144 + c0 * 2) = o2; } \
_Pragma("unroll") \
        for (int r = 0; r < 4; ++r) oacc[r] *= gv[c0 + r]; \
        P4D D3 = Dnn; \
        if (Dn.valid) { p4_stage(p, F, RX, Dn, buf ^ 1, mk, cw, cwn); \
            if (Dn.last && Dnn.valid) { const int e0_ = (tid & 7) * 4; _Pragma("unroll") for (int j = 0; j < 4; ++j) cwn[j] = *(const f32x4*)(p.dn_conv_w + j * 3072 + 2048 + Dnn.h * 128 + Dnn.sl * 32 + e0_); } if (Dnn.valid) { D3 = p4_next(F, Dnn); if (D3.valid) p4_prefetch(p, F, RX, D3, T); } } \
        lds_barrier(); \
         \
        { const float gl = gv[192]; \
_Pragma("unroll") \
          for (int nt = 0; nt < 2; ++nt) S[nt] *= gl; \
_Pragma("unroll") \
          for (int ks = 0; ks < 2; ++ks) \
_Pragma("unroll") \
              for (int nt = 0; nt < 2; ++nt) { const bf16x8 b_ = ldfrag(Vt2, 144, nt * 16 + l15, ks * 64 + q4 * 16); S[nt] = MFMA16(KT[ks], b_, S[nt]); } } \
_Pragma("unroll") \
        for (int ks = 0; ks < 2; ++ks) { const bf16x8 a_ = ldfrag(ATs, 144, ct * 16 + l15, ks * 64 + q4 * 16), b_ = ldfrag(Vt1, 144, et * 16 + l15, ks * 64 + q4 * 16); oacc = MFMA16(a_, b_, oacc); } \
_Pragma("unroll") \
        for (int r = 0; r < 4; ++r) *(bf16_t*)((char*)F.PROJ() + ((size_t)Dc.ci * 64 * NPROJ + Dc.d * 1024 + Dc.h * 128 + Dc.sl * 32) * 2 + (unsigned)(((c0 + r) * NPROJ + e) * 2)) = f2bf(oacc[r]); \
        if (Dc.last) { \
            if (!Dc.samp) { \
_Pragma("unroll") \
                for (int nt = 0; nt < 2; ++nt) \
_Pragma("unroll") \
                    for (int r = 0; r < 4; ++r) \
                        F.out[OUT_SD + (size_t)((Dc.seq * 2 + Dc.d) * 8 + Dc.h) * 16384 + (size_t)(wave * 16 + q4 * 4 + r) * 128 + Dc.sl * 32 + nt * 16 + l15] = S[nt][r]; \
            } \
            if (Dn.valid) P4_INIT_S(Dn); \
        } \
        P4_WRITE_SB(); \
        if (Dn.valid) P4_PRECOMP(buf ^ 1); \
        lds_barrier(); \
        if (!Dn.valid) break; \
        Dc = Dn; Dn = Dnn; Dnn = D3; buf ^= 1; \
    }
#pragma unroll 1
    for (;;) { P4_BODY(RA) P4_BODY(RB) }
#undef P4_BODY
#undef P4_INIT_S
#undef P4_WRITE_SB
#undef P4_PRECOMP
}
__device__ __forceinline__ void phase4(CParams& p, Frame& F) {
    if (F.G == 256) rg_carry_scan(p, F);
    else if (F.b == 0) {
        for (int g = F.tid; g < 69632; g += 512) { int samp = g >= 65536, gg = samp ? g - 65536 : g, seq = gg >> 11, d = (gg >> 10) & 1, ch = gg & 1023;
            const int nch = samp ? 64 : 4, c_lo = samp ? 128 + seq * 64 : seq * 4; float h = samp ? p.state_rglru[(size_t)(seq * 2 + d) * 1024 + ch] : 0.f;
            for (int i = 0; i < nch; ++i) { const int cc = d == 0 ? c_lo + i : c_lo + nch - 1 - i; const float* ag = F.RGAGG() + (size_t)(cc * 2 + d) * 2048; F.CARRY()[(size_t)(cc * 2 + d) * 1024 + ch] = h; h = ag[ch] * h + ag[1024 + ch]; } } }
    __syncthreads();
    phase4_chains(p, F);
}

__device__ __forceinline__ void phase5(CParams& p, Frame& F) {
    const int lane = F.lane;
    float nw[16];
#pragma unroll
    for (int q = 0; q < 4; ++q) { const f32x4 a = *(const f32x4*)(p.dn_norm_w + (lane & 7) * 16 + q * 4); nw[q * 4] = a[0]; nw[q * 4 + 1] = a[1]; nw[q * 4 + 2] = a[2]; nw[q * 4 + 3] = a[3]; }
#pragma unroll 4
    for (int tok = F.b * 8 + F.wave; tok < NTOK; tok += F.G * 8) {
        const bf16_t* pr = F.PROJ() + (size_t)tok * NPROJ + lane * 16;
        float o[16], z[16]; float ss = 0.f;
#pragma unroll
        for (int hf = 0; hf < 2; ++hf) { const u32x4 a = *(const u32x4*)(pr + hf * 8), b = *(const u32x4*)(pr + 1024 + hf * 8), zz = *(const u32x4*)(pr + 3072 + hf * 8);
            float fa[8], fb[8], fz[8]; unpack8(a, fa); unpack8(b, fb); unpack8(zz, fz);
#pragma unroll
            for (int e = 0; e < 8; ++e) { o[hf * 8 + e] = fa[e] + fb[e]; z[hf * 8 + e] = fz[e]; ss += o[hf * 8 + e] * o[hf * 8 + e]; } }
        ss += __shfl_xor(ss, 1); ss += __shfl_xor(ss, 2); ss += __shfl_xor(ss, 4);
        const float rs = rsqrtf(ss * (1.f / 128.f) + 1e-6f);
#pragma unroll
        for (int hf = 0; hf < 2; ++hf) { float w[8];
#pragma unroll
            for (int e = 0; e < 8; ++e) w[e] = o[hf * 8 + e] * rs * nw[hf * 8 + e] * siluf_(z[hf * 8 + e]);
            *(u32x4*)(F.MIX() + (size_t)tok * 2048 + lane * 16 + hf * 8) = pack8(w); }
        if (tok < 8192) {
            const u32x4 y0 = *(const u32x4*)(pr + 5120), y1 = *(const u32x4*)(pr + 5120 + 8);
            *(u32x4*)(F.MIX() + (size_t)tok * 2048 + 1024 + lane * 16) = y0; *(u32x4*)(F.MIX() + (size_t)tok * 2048 + 1024 + lane * 16 + 8) = y1; }
    }
    __syncthreads();
    for (int it = F.b; it < 1024; it += F.G) { u32x4 rows[5]; rg_load_rows(F, 128 + (it >> 3), it & 7, rows); rg_item<3>(p, F, 128 + (it >> 3), it & 7, rows, it + F.G); }
}

__device__ __forceinline__ void phase6(CParams& p, Frame& F) {
    pg8::Gemm g{F.MIX(), F.WoutT(), NTOK, 1024, 2048}; pg8::StaticOrder S; S.init(NTOK, 1024, F.G, F.b); pg8::EpiF32 E{(float*)F.PROJ(), 3072};
    pg8::gemm_phase<pg8::EpiF32, pg8::StaticOrder>(F.lds, g, S, E);
}

__device__ __forceinline__ void phase7(CParams& p, Frame& F) {
    LAS float* gt = (LAS float*)F.lds;
    for (int tb = F.b; tb < 256; tb += F.G) {
        const int grp = grp_of_block(tb);
        for (int j = F.tid; j < 1024; j += 512) gt[j] = mod_val(p, F, grp, 2048 + j) * p.post_w[j];
        __syncthreads();
#pragma unroll 2
        for (int i = 0; i < 8; ++i) {
            const int tok = tb * 64 + F.wave * 8 + i;
            const float* xr = tok < 8192 ? p.x_prompt + (size_t)tok * 1024 : p.x_sample + (size_t)(tok - 8192) * 1024;
            const float* yr = (const float*)F.PROJ() + (size_t)tok * 3072;
            f32x4 y[4]; float ss = 0.f;
#pragma unroll
            for (int q = 0; q < 4; ++q) { y[q] = *(const f32x4*)(yr + F.lane * 4 + 256 * q); ss += (y[q][0] * y[q][0] + y[q][1] * y[q][1]) + (y[q][2] * y[q][2] + y[q][3] * y[q][3]); }
            const float rstd = rsqrtf(wave_sum(ss) * (1.f / 1024.f) + 1e-6f);
#pragma unroll
            for (int q = 0; q < 4; ++q) { const int j = F.lane * 4 + 256 * q; f32x4 v = *(const f32x4*)(xr + j);
                if (tok >= 8192) { const int pp = (tok - 8192) & 4095; const int vv = (q < 2) ? (pp >> 6) : (pp & 63);
                    v += *(const f32x4*)(F.pe() + ((q & 1) ? 16384 : 0) + vv * 256 + F.lane * 4); }
                const f32x4 g4 = *(const LAS f32x4*)(gt + j);
                f32x4 ov = v + g4 * (y[q] * rstd); ov[0] = fin(ov[0]); ov[1] = fin(ov[1]); ov[2] = fin(ov[2]); ov[3] = fin(ov[3]); if (!(LIVE_MASK & 1)) ov = (f32x4){0.f, 0.f, 0.f, 0.f}; *(f32x4*)(F.out + (size_t)tok * 1024 + j) = ov; }
        }
        __syncthreads();
    }
}

__device__ __forceinline__ void phase8(CParams& p, Frame& F) {
    if (F.b == 0 && F.tid == 0) { int code = 0; for (int k = 31; k >= 1; --k) if (DG(F)[k]) code = k; F.out[OUT_SR] = 1000.f * (float)code + 500.f; }
}
extern __shared__ __attribute__((aligned(16))) unsigned char smem_raw[];
__global__ void __launch_bounds__(512) fwd_megakernel(Params p_unused) {
    CParams& p = *(CParams*)__builtin_amdgcn_kernarg_segment_ptr();
    Frame F;
    F.lds = (LAS unsigned char*)smem_raw;
    F.tid = threadIdx.x; F.lane = F.tid & 63; F.wave = __builtin_amdgcn_readfirstlane(F.tid >> 6); F.G = gridDim.x; F.b = blockIdx.x;
    F.out = p.out; F.ws = p.ws;
    volatile LAS unsigned* xbw = (volatile LAS unsigned*)(F.lds + LDS_BYTES - 16);
    const bool multi = (p.ph_hi - p.ph_lo) > 1;
    XcdBarrier xb; xb.bar = (unsigned*)(p.ws + WS_CTL); xb.x = 0; xb.st = xbw;
    if (multi) {
        if (F.tid == 0) { xbw[0] = 0u; xbw[1] = 0u; xbw[2] = 0u; xbw[3] = 0u; }
        __syncthreads();
        xb = xcd_barrier_post((unsigned*)(p.ws + WS_CTL), xbw);
    }
#ifndef PHMASK
#define PHMASK 511
#endif
    const int lo = p.ph_lo, hi = p.ph_hi;
#ifndef REP_PHASE
#define REP_PHASE -1
#endif
#define RUN_PHASE(k, fn) do { if (lo <= (k) && (k) < hi) { if (PHMASK & (1 << (k))) fn(p, F); if ((k) == REP_PHASE) { __syncthreads(); fn(p, F); } if ((k) + 1 < hi) xcd_barrier(xb); } } while (0)
    RUN_PHASE(0, phase0); RUN_PHASE(1, phase1); RUN_PHASE(2, phase2); RUN_PHASE(3, phase3);
    RUN_PHASE(4, phase4); RUN_PHASE(5, phase5); RUN_PHASE(6, phase6); RUN_PHASE(7, phase7); RUN_PHASE(8, phase8);
}

extern "C" void kernel_launch(void* const* d_in, const int* in_sizes, int n_in, void* d_out, int out_size, void* d_ws, size_t ws_size, hipStream_t stream) {
    static int grid = 0;
    if (grid == 0) {
        int dev = 0, cus = 0;
        if (hipGetDevice(&dev) != hipSuccess || hipDeviceGetAttribute(&cus, hipDeviceAttributeMultiprocessorCount, dev) != hipSuccess) { fprintf(stderr, "kernel_launch: device query failed\n"); grid = -1; return; }
        if (hipFuncSetAttribute((const void*)fwd_megakernel, hipFuncAttributeMaxDynamicSharedMemorySize, LDS_BYTES) != hipSuccess) { fprintf(stderr, "kernel_launch: hipFuncSetAttribute failed\n"); grid = -1; return; }
        int per_cu = 0;
        if (hipOccupancyMaxActiveBlocksPerMultiprocessor(&per_cu, (const void*)fwd_megakernel, 512, LDS_BYTES) != hipSuccess || per_cu < 1) { fprintf(stderr, "kernel_launch: occupancy query says %d blocks per CU\n", per_cu); (void)hipGetLastError(); }
        grid = cus;
    }
    if (grid < 0) return;
    Params p{};
    const float** pp = (const float**)&p;
    for (int i = 0; i < 23; ++i) pp[i] = (const float*)d_in[i];
    p.out = (float*)d_out; p.ws = (unsigned char*)d_ws;
    (void)hipMemsetAsync((char*)d_ws + WS_CTL, 0, 16384, stream);
#if MK_SINGLE
    p.ph_lo = 0; p.ph_hi = NPH;
    void* args[] = {&p};
    hipError_t e = hipLaunchCooperativeKernel((const void*)fwd_megakernel, dim3(grid), dim3(512), args, LDS_BYTES, stream);
    if (e != hipSuccess) fprintf(stderr, "cooperative launch failed: %s (grid %d)\n", hipGetErrorString(e), grid);
#else
    for (int ph = 0; ph < NPH; ++ph) {
        p.ph_lo = ph; p.ph_hi = ph + 1;
        hipLaunchKernelGGL(fwd_megakernel, dim3(grid), dim3(512), LDS_BYTES, stream, p);
    }
#endif
}
```

```cpp
#include <hip/hip_runtime.h>
#include <cstdio>
#include <cstdint>

#define LAS __attribute__((address_space(3)))
typedef unsigned short bf16_t;
typedef short bf16x8 __attribute__((ext_vector_type(8)));
typedef float f32x4 __attribute__((ext_vector_type(4)));
typedef unsigned u32x4 __attribute__((ext_vector_type(4)));
typedef unsigned u32x2 __attribute__((ext_vector_type(2)));

#ifndef REP_PHASE
#define REP_PHASE -1
#endif
#ifndef MK_SINGLE
#define MK_SINGLE 1
#endif

constexpr int NTOK = 16384, DM = 1024, NPROJ = 6144, DIN = 6176;
constexpr int NPH = 8;
constexpr int LDS_BYTES = 160 * 1024;
constexpr size_t OUT_YP = 0, OUT_YS = 8388608, OUT_SD = 16777216, OUT_SR = 25165824;
constexpr size_t WS_CTL = 0, WS_MODP = 16384, WS_PE = 606208, WS_BA = 737280, WS_GB = 2834432, WS_RGAGG = 4931584,
                 WS_WBAT = 9125888, WS_WOUTT = 9191424, WS_GT = 13385728, WS_WINT = 14434304, WS_TA = 27017216, WS_PROJ = 60571648, WS_CARRY = 261898240;

struct Params {
    const float *x_prompt, *x_sample, *state_delta, *state_rglru, *c, *c_ctx, *ada_w, *ada_b, *pre_w, *post_w, *w_in, *w_out,
                *dn_conv_w, *dn_a_log, *dn_dt_bias, *dn_norm_w, *rg_conv_w, *rg_conv_b, *rg_w_r, *rg_b_r, *rg_w_i, *rg_b_i, *rg_lam;
    float* out; unsigned char* ws;
    int ph_lo, ph_hi;
};

__device__ __forceinline__ float bf2f(unsigned short b) { return __uint_as_float(((unsigned)b) << 16); }
typedef __bf16 bf2_t __attribute__((ext_vector_type(2)));
typedef float f2_t __attribute__((ext_vector_type(2)));
__device__ __forceinline__ unsigned pk2(float lo, float hi) { const f2_t v = {lo, hi}; return __builtin_bit_cast(unsigned, __builtin_convertvector(v, bf2_t)); }
__device__ __forceinline__ unsigned short f2bf(float f) { return (unsigned short)(pk2(f, f) & 0xffffu); }
#ifndef SANITIZE
#define SANITIZE 0
#endif
#ifndef LIVE_MASK
#define LIVE_MASK 15
#endif
__device__ __forceinline__ float fin(float x) { return (SANITIZE && ((__float_as_uint(x) & 0x7f800000u) == 0x7f800000u)) ? 0.f : x; }
#define DG(F) ((unsigned*)((F).ws + WS_CTL))
__device__ __forceinline__ bool badv(float x, float lim) { return ((__float_as_uint(x) & 0x7f800000u) == 0x7f800000u) || fabsf(x) > lim; }
#ifndef DIAG
#define DIAG 0
#endif
#define CHK(F, k, bad) do { if (DIAG && (bad)) DG(F)[k] = 1u; } while (0)
__device__ __forceinline__ float sigm(float x) { return __builtin_amdgcn_rcpf(1.f + __expf(-x)); }
__device__ __forceinline__ float siluf_(float x) { return x * __builtin_amdgcn_rcpf(1.f + __expf(-x)); }
__device__ __forceinline__ float softplusf_(float x) { return x > 20.f ? x : log1pf(__expf(x)); }
__device__ __forceinline__ void unpack8(const u32x4 v, float (&f)[8]) {
    f[0] = __uint_as_float(v.x << 16); f[1] = __uint_as_float(v.x & 0xffff0000u);
    f[2] = __uint_as_float(v.y << 16); f[3] = __uint_as_float(v.y & 0xffff0000u);
    f[4] = __uint_as_float(v.z << 16); f[5] = __uint_as_float(v.z & 0xffff0000u);
    f[6] = __uint_as_float(v.w << 16); f[7] = __uint_as_float(v.w & 0xffff0000u);
}
__device__ __forceinline__ u32x4 pack8(const float (&f)[8]) { u32x4 o; o.x = pk2(f[0], f[1]); o.y = pk2(f[2], f[3]); o.z = pk2(f[4], f[5]); o.w = pk2(f[6], f[7]); return o; }
__device__ __forceinline__ float wave_sum(float v) {
#pragma unroll
    for (int o = 1; o < 64; o <<= 1) v += __shfl_xor(v, o);
    return v;
}
__device__ __forceinline__ void lds_barrier() { asm volatile("s_waitcnt lgkmcnt(0)" ::: "memory"); __builtin_amdgcn_s_barrier(); asm volatile("" ::: "memory"); }
#define MFMA16(a, b, c) __builtin_amdgcn_mfma_f32_16x16x32_bf16((a), (b), (c), 0, 0, 0)
#define LDS_WAIT() asm volatile("s_waitcnt lgkmcnt(0)" ::: "memory")
__device__ __forceinline__ bf16x8 ldfrag(const LAS unsigned char* base, int pitch, int row, int kb) { return *(const LAS bf16x8*)(base + row * pitch + kb); }

#define XB_TMO      128
#define XB_XCNT(j)  (256  + 64 * (j))
#define XB_XSUB(j)  (1280 + 64 * (j))
#define XB_XGEN(j)  (2304 + 64 * (j))
#define XB_TOP      3328
#define XB_TOPGEN   3392
#define XCD_BAR_WORDS 3456
#define XB_SPIN_CAP (1u << 18)
__device__ __forceinline__ unsigned xb_ld(unsigned* p)              { return __hip_atomic_load(p, __ATOMIC_RELAXED, __HIP_MEMORY_SCOPE_AGENT); }
__device__ __forceinline__ unsigned xb_add(unsigned* p, unsigned v) { return __hip_atomic_fetch_add(p, v, __ATOMIC_RELAXED, __HIP_MEMORY_SCOPE_AGENT); }
__device__ __forceinline__ unsigned xb_xcc_id() { return (unsigned)__builtin_amdgcn_s_getreg((3 << 11) | 20) & 0xFu; }
#define XB_SPIN(cond, bar) do { unsigned _sp = 0; while (cond) { __builtin_amdgcn_s_sleep(1); \
    if ((++_sp & 255u) == 0u) { if (xb_ld(&(bar)[XB_TMO])) break; if (_sp > XB_SPIN_CAP) { atomicAdd(&(bar)[XB_TMO], 1u); break; } } } } while (0)
struct XcdBarrier { unsigned* bar; unsigned x; volatile LAS unsigned* st; };
__device__ __forceinline__ XcdBarrier xcd_barrier_post(unsigned* bar, volatile LAS unsigned* st) {
    XcdBarrier b; b.bar = bar; b.x = xb_xcc_id(); b.st = st;
    if (threadIdx.x == 0) (void)xb_add(&bar[XB_XCNT(b.x)], 1u);
    return b;
}
__device__ __forceinline__ void xcd_barrier_complete(unsigned* bar, unsigned x, unsigned& nloc, unsigned& nx) {
    const unsigned G = gridDim.x * gridDim.y * gridDim.z;
    unsigned sum, cnt, mine, sp = 0u;
    for (;;) {
        sum = 0u; cnt = 0u; mine = 0u;
#pragma unroll
        for (unsigned j = 0; j < 16; ++j) { const unsigned c = xb_ld(&bar[XB_XCNT(j)]); sum += c; cnt += (c > 0u) ? 1u : 0u; mine = (j == x) ? c : mine; }
        if (sum == G) break;
        __builtin_amdgcn_s_sleep(1);
        if ((++sp & 255u) == 0u) { if (xb_ld(&bar[XB_TMO])) break; if (sp > XB_SPIN_CAP) { atomicAdd(&bar[XB_TMO], 1u); break; } }
    }
    nloc = mine > 0u ? mine : 1u; nx = cnt > 0u ? cnt : 1u;
}
__device__ __forceinline__ void xcd_barrier(const XcdBarrier& b) {
    asm volatile("s_waitcnt vmcnt(0)" ::: "memory");
    __syncthreads();
    if (threadIdx.x == 0) {
        unsigned* bar = b.bar;
        __builtin_amdgcn_s_waitcnt(0);
        unsigned nloc = b.st[0], nx = b.st[1];
        if (nloc == 0u) { xcd_barrier_complete(bar, b.x, nloc, nx); b.st[0] = nloc; b.st[1] = nx; }
        const unsigned old = xb_add(&bar[XB_XSUB(b.x)], 1u);
        const unsigned gen = old / nloc;
        if (old + 1u == (gen + 1u) * nloc) {
            __builtin_amdgcn_fence(__ATOMIC_RELEASE, "agent");
            asm volatile("s_waitcnt vmcnt(0)" ::: "memory");
            const unsigned og = xb_add(&bar[XB_TOP], 1u);
            const unsigned tg = og / nx;
            if (og + 1u == (tg + 1u) * nx) xb_add(&bar[XB_TOPGEN], 1u);
            else XB_SPIN(xb_ld(&bar[XB_TOPGEN]) == tg, bar);
            __builtin_amdgcn_fence(__ATOMIC_ACQUIRE, "agent");
            xb_add(&bar[XB_XGEN(b.x)], 1u);
            asm volatile("s_waitcnt vmcnt(0)" ::: "memory");
        } else {
            XB_SPIN(xb_ld(&bar[XB_XGEN(b.x)]) == gen, bar);
            __builtin_amdgcn_fence(__ATOMIC_ACQUIRE, "agent");
            asm volatile("s_waitcnt vmcnt(0)" ::: "memory");
        }
    }
    __syncthreads();
}

namespace pg8 {
constexpr int BM = 256, BK = 64, HALF = 128, HTB = HALF * BK * 2, STAGE_BYTES = 8 * HTB, NXCD = 8, WGM = 8;
__host__ __device__ __forceinline__ int lds_byte(int r, int c) { const int st = (r >> 4) * 2 + (c >> 5), rr = r & 15, cc = c & 31, ob = rr * 64 + cc * 2; return st * 1024 + (ob ^ (((ob >> 9) & 1) << 5)); }
__host__ __device__ __forceinline__ void stage_rc(int b, int& R, int& C) { const int st = b / 1024, sb = b % 1024, swz = sb ^ (((sb >> 9) & 1) << 5); R = (st >> 1) * 16 + swz / 64; C = (st & 1) * 32 + (swz % 64) / 2; }
__host__ __device__ __forceinline__ int perm32(int rho) { const int n = rho >> 4, i = rho & 15; return 8 * (i >> 2) + 4 * n + (i & 3); }
struct Unit { int pm, pn; };
struct Gemm { const bf16_t* A; const bf16_t* Bt; int M, N, K; };
struct StaticOrder {
    int nM, nN, nwg, G, c;
    __host__ __device__ void init(int M, int N, int G_, int c_) { nM = M / BM; nN = N / BM; nwg = nM * nN; G = G_; c = c_; }
    __host__ __device__ bool next(int i, Unit& u) const {
        const long L = (long)i * G + c; if (L >= nwg) return false;
        int wgid = (int)L; { const int q = nwg / NXCD, r = nwg % NXCD, xcd = wgid % NXCD, off = wgid / NXCD; wgid = (xcd < r ? xcd * (q + 1) : r * (q + 1) + (xcd - r) * q) + off; }
        const int nig = WGM * nN, gid = wgid / nig, fm = gid * WGM, gsz = (nM - fm) < WGM ? (nM - fm) : WGM;
        u.pm = fm + ((wgid % nig) % gsz); u.pn = (wgid % nig) / gsz; return true;
    }
};
__device__ __forceinline__ unsigned cvt_pk_bf16(float lo, float hi) { unsigned r; asm volatile("v_cvt_pk_bf16_f32 %0, %1, %2" : "=v"(r) : "v"(lo), "v"(hi)); return r; }
struct EpiF32 {
    static constexpr bool PERM = false;
    float* C; int ldc;
    __device__ __forceinline__ void operator()(const f32x4 (&acc)[2][2][4][2], const Unit& u, int wr, int wc, int fr, int fq) const {
        const int row0 = u.pm * BM + wr * 64 + fr, col0 = u.pn * BM + wc * 32 + 4 * fq;
#pragma unroll
        for (int ai = 0; ai < 2; ++ai)
#pragma unroll
            for (int m = 0; m < 4; ++m) { float* rowp = C + (size_t)(row0 + ai * HALF + m * 16) * ldc + col0;
#pragma unroll
                for (int bj = 0; bj < 2; ++bj)
#pragma unroll
                    for (int n = 0; n < 2; ++n) *(f32x4*)(rowp + bj * HALF + n * 16) = acc[ai][bj][m][n]; }
    }
};
struct EpiBf16 {
    static constexpr bool PERM = true;
    bf16_t* O; int ldc;
    __device__ __forceinline__ void operator()(const f32x4 (&acc)[2][2][4][2], const Unit& u, int wr, int wc, int fr, int fq) const {
        const int row0 = u.pm * BM + wr * 64 + fr; const int col0 = u.pn * BM + wc * 32 + 8 * fq;
#pragma unroll
        for (int ai = 0; ai < 2; ++ai)
#pragma unroll
            for (int m = 0; m < 4; ++m) { bf16_t* rowp = O + (size_t)(row0 + ai * HALF + m * 16) * ldc + col0;
#pragma unroll
                for (int bj = 0; bj < 2; ++bj) { const f32x4 v0 = acc[ai][bj][m][0], v1 = acc[ai][bj][m][1];
                    u32x4 w; w.x = cvt_pk_bf16(v0[0], v0[1]); w.y = cvt_pk_bf16(v0[2], v0[3]); w.z = cvt_pk_bf16(v1[0], v1[1]); w.w = cvt_pk_bf16(v1[2], v1[3]);
                    *(u32x4*)(rowp + bj * HALF) = w; } }
    }
};

template <class Epi, class Sched>
__device__ __forceinline__ void gemm_phase(LAS unsigned char* lds, const Gemm g, const Sched& S, const Epi& E) {
    const int tid = threadIdx.x, wid = __builtin_amdgcn_readfirstlane(tid >> 6), lane = tid & 63, wr = wid >> 2, wc = wid & 3, fr = lane & 15, fq = lane >> 4;
    const int K = g.K, nt = K / BK;
    unsigned voffA[2], voffB[2];
#pragma unroll
    for (int i = 0; i < 2; ++i) { int R, C; stage_rc(tid * 16 + i * 8192, R, C); const int Rb = Epi::PERM ? ((R & ~31) + perm32(R & 31)) : R;
        voffA[i] = (unsigned)(R * K + C) * 2u; voffB[i] = (unsigned)(Rb * K + C) * 2u; }
    const size_t kstep = (size_t)(BK * 2);
    const size_t hstep = (size_t)HALF * K * 2;
    const size_t tstep = 2 * hstep;
    const unsigned ldsw = (unsigned)wid * 1024u;
    const int aoff = lds_byte(wr * 64 + fr, fq * 8), boff = lds_byte(wc * 32 + fr, fq * 8);
#define PG8_SA(b, h) (((b) * 2 + (h)) * HTB)
#define PG8_SB(b, h) ((4 + (b) * 2 + (h)) * HTB)
#define PG8_STAGE(bufoff, gbase, voff) do { _Pragma("unroll") for (int _i = 0; _i < 2; ++_i) \
        __builtin_amdgcn_global_load_lds((const unsigned*)((const char*)(gbase) + (voff)[_i]), (LAS unsigned*)(lds + (bufoff) + ldsw + _i * 8192), 16, 0, 0); } while (0)
#define PG8_LDA(dst, b, h) do { _Pragma("unroll") for (int m = 0; m < 4; ++m) _Pragma("unroll") for (int k = 0; k < 2; ++k) dst[m][k] = *(const LAS bf16x8*)(lds + PG8_SA(b, h) + aoff + m * 2048 + k * 1024); } while (0)
#define PG8_LDB(dst, b, h) do { _Pragma("unroll") for (int n = 0; n < 2; ++n) _Pragma("unroll") for (int k = 0; k < 2; ++k) dst[n][k] = *(const LAS bf16x8*)(lds + PG8_SB(b, h) + boff + n * 2048 + k * 1024); } while (0)
#define PG8_MMA(ai, bj, At, Bt) do { __builtin_amdgcn_s_setprio(1); _Pragma("unroll") for (int m = 0; m < 4; ++m) _Pragma("unroll") for (int n = 0; n < 2; ++n) _Pragma("unroll") for (int k = 0; k < 2; ++k) \
        acc[ai][bj][m][n] = __builtin_amdgcn_mfma_f32_16x16x32_bf16(Bt[n][k], At[m][k], acc[ai][bj][m][n], 0, 0, 0); __builtin_amdgcn_s_setprio(0); } while (0)
#define PG8_WAIT_V(n) asm volatile("s_waitcnt vmcnt(" #n ")" ::: "memory")
#define PG8_WAIT_L(n) asm volatile("s_waitcnt lgkmcnt(" #n ")" ::: "memory")
#define PG8_BAR __builtin_amdgcn_s_barrier()
#define PG8_SCHED __builtin_amdgcn_sched_barrier(0)
    Unit cur, nxt; int ui = 0;
    if (!S.next(0, cur)) return;
    f32x4 acc[2][2][4][2];
#pragma unroll
    for (int a = 0; a < 2; ++a)
#pragma unroll
        for (int b = 0; b < 2; ++b)
#pragma unroll
            for (int m = 0; m < 4; ++m)
#pragma unroll
                for (int n = 0; n < 2; ++n) acc[a][b][m][n] = (f32x4){0.f, 0.f, 0.f, 0.f};
    bf16x8 At[4][2], B0[2][2], B1[2][2];
    const char* cA = (const char*)g.A + (size_t)cur.pm * tstep; const char* cB = (const char*)g.Bt + (size_t)cur.pn * tstep;
    PG8_STAGE(PG8_SB(0, 0), cB, voffB); PG8_STAGE(PG8_SA(0, 0), cA, voffA); PG8_STAGE(PG8_SB(0, 1), cB + hstep, voffB); PG8_STAGE(PG8_SA(0, 1), cA + hstep, voffA);
    if (wr == 1) PG8_BAR;
    PG8_WAIT_V(4); PG8_BAR;
    PG8_STAGE(PG8_SB(1, 0), cB + kstep, voffB); PG8_STAGE(PG8_SA(1, 0), cA + kstep, voffA); PG8_STAGE(PG8_SB(1, 1), cB + hstep + kstep, voffB);
    PG8_WAIT_V(6); PG8_BAR;
    for (;;) {
        const bool has_next = S.next(ui + 1, nxt);
        const char* nA = has_next ? (const char*)g.A + (size_t)nxt.pm * tstep : cA; const char* nB = has_next ? (const char*)g.Bt + (size_t)nxt.pn * tstep : cB;
        for (int t = 0; t < nt; t += 2) {
            const bool last = (t == nt - 2);
            const char* a1 = cA + (size_t)(t + 1) * kstep;
            const char* a2 = last ? nA : cA + (size_t)(t + 2) * kstep; const char* b2 = last ? nB : cB + (size_t)(t + 2) * kstep;
            const char* a3 = a2 + kstep; const char* b3 = b2 + kstep;
            PG8_LDB(B0, 0, 0); PG8_SCHED; PG8_LDA(At, 0, 0); PG8_STAGE(PG8_SA(1, 1), a1 + hstep, voffA);
            PG8_WAIT_L(8); PG8_BAR; PG8_WAIT_L(0); PG8_MMA(0, 0, At, B0); PG8_BAR; PG8_SCHED;
            PG8_LDB(B1, 0, 1); PG8_STAGE(PG8_SB(0, 0), b2, voffB);
            PG8_BAR; PG8_WAIT_L(0); PG8_MMA(0, 1, At, B1); PG8_BAR;
            PG8_LDA(At, 0, 1); PG8_STAGE(PG8_SA(0, 0), a2, voffA);
            PG8_BAR; PG8_WAIT_L(0); PG8_MMA(1, 0, At, B0); PG8_BAR; PG8_SCHED;
            PG8_STAGE(PG8_SB(0, 1), b2 + hstep, voffB);
            PG8_WAIT_V(6); PG8_BAR; PG8_MMA(1, 1, At, B1); PG8_BAR;
            PG8_LDB(B0, 1, 0); PG8_SCHED; PG8_LDA(At, 1, 0); PG8_STAGE(PG8_SA(0, 1), a2 + hstep, voffA);
            PG8_WAIT_L(8); PG8_BAR; PG8_WAIT_L(0); PG8_MMA(0, 0, At, B0); PG8_BAR; PG8_SCHED;
            PG8_LDB(B1, 1, 1); PG8_STAGE(PG8_SB(1, 0), b3, voffB);
            PG8_BAR; PG8_WAIT_L(0); PG8_MMA(0, 1, At, B1); PG8_BAR;
            PG8_LDA(At, 1, 1); PG8_STAGE(PG8_SA(1, 0), a3, voffA);
            PG8_BAR; PG8_WAIT_L(0); PG8_MMA(1, 0, At, B0); PG8_BAR; PG8_SCHED;
            PG8_STAGE(PG8_SB(1, 1), b3 + hstep, voffB);
            PG8_WAIT_V(6); PG8_BAR; PG8_MMA(1, 1, At, B1); PG8_BAR;
        }
        E(acc, cur, wr, wc, fr, fq);
        if (!has_next) break;
#pragma unroll
        for (int a = 0; a < 2; ++a)
#pragma unroll
            for (int b = 0; b < 2; ++b)
#pragma unroll
                for (int m = 0; m < 4; ++m)
#pragma unroll
                    for (int n = 0; n < 2; ++n) acc[a][b][m][n] = (f32x4){0.f, 0.f, 0.f, 0.f};
        cur = nxt; cA = nA; cB = nB; ++ui;
    }
    PG8_WAIT_V(0);
    if (wr == 0) PG8_BAR;
    PG8_BAR;
#undef PG8_SA
#undef PG8_SB
#undef PG8_STAGE
#undef PG8_LDA
#undef PG8_LDB
#undef PG8_MMA
#undef PG8_WAIT_V
#undef PG8_WAIT_L
#undef PG8_BAR
#undef PG8_SCHED
}
}

struct Frame {
    LAS unsigned char* lds;
    int tid, lane, wave, G, b;
    float* out; unsigned char* ws;
    __device__ __forceinline__ bf16_t* H() const { return (bf16_t*)out; }
    __device__ __forceinline__ bf16_t* Qc() const { return (bf16_t*)out; }
    __device__ __forceinline__ bf16_t* Kc() const { return (bf16_t*)(out + OUT_YS); }
    __device__ __forceinline__ bf16_t* MIX() const { return (bf16_t*)out; }
    __device__ __forceinline__ float* modp() const { return (float*)(ws + WS_MODP); }
    __device__ __forceinline__ float* pe() const { return (float*)(ws + WS_PE); }
    __device__ __forceinline__ float* BA() const { return (float*)(ws + WS_BA); }
    __device__ __forceinline__ float* GB() const { return (float*)(ws + WS_GB); }
    __device__ __forceinline__ float* RGAGG() const { return (float*)(ws + WS_RGAGG); }
    __device__ __forceinline__ bf16_t* WbaT() const { return (bf16_t*)(ws + WS_WBAT); }
    __device__ __forceinline__ bf16_t* WoutT() const { return (bf16_t*)(ws + WS_WOUTT); }
    __device__ __forceinline__ bf16_t* GT() const { return (bf16_t*)(ws + WS_GT); }
    __device__ __forceinline__ bf16_t* WinT() const { return (bf16_t*)(ws + WS_WINT); }
    __device__ __forceinline__ bf16_t* TA() const { return (bf16_t*)(ws + WS_TA); }
    __device__ __forceinline__ bf16_t* PROJ() const { return (bf16_t*)(ws + WS_PROJ); }
    __device__ __forceinline__ float* CARRY() const { return (float*)(ws + WS_CARRY); }
};
typedef const __attribute__((address_space(4))) Params CParams;

__device__ __forceinline__ int grp_of_block(int tb) { return tb < 128 ? 0 : (tb < 192 ? 1 : 2); }

__device__ __forceinline__ void transpose_item(const float* W, int N, int k0, int n0, bf16_t* WT0, int Kout, LAS float* scr, int lane) {
#pragma unroll 8
    for (int i = 0; i < 32; ++i) { const int kk = 2 * i + (lane >> 5); scr[kk * 33 + (lane & 31)] = W[(size_t)(k0 + kk) * N + n0 + (lane & 31)]; }
    LDS_WAIT();
    const int c = lane & 7;
#pragma unroll
    for (int j = 0; j < 4; ++j) { const int n = (lane >> 3) + 8 * j; const LAS float* s = scr + (8 * c) * 33 + n;
        u32x4 o; o.x = pk2(s[0 * 33], s[1 * 33]); o.y = pk2(s[2 * 33], s[3 * 33]); o.z = pk2(s[4 * 33], s[5 * 33]); o.w = pk2(s[6 * 33], s[7 * 33]);
        *(u32x4*)(WT0 + (size_t)n * Kout + k0 + 8 * c) = o; }
    LDS_WAIT();
}
__device__ __forceinline__ void phase0(CParams& p, Frame& F) {
    const int tid = F.tid, lane = F.lane;
    for (int it = F.b; it < 192; it += F.G) {
        const int jg = it % 12, ks = it / 12, j = jg * 256 + (tid & 255), half = tid >> 8, k0 = ks * 64 + half * 32;
        float s0 = 0.f, s1 = 0.f, s2 = 0.f;
#pragma unroll 8
        for (int k = 0; k < 32; ++k) { const int kk = k0 + k; const float w = p.ada_w[(size_t)kk * 3072 + j];
            s0 += siluf_(p.c_ctx[kk]) * w; s1 += siluf_(p.c[kk]) * w; s2 += siluf_(p.c[1024 + kk]) * w; }
        LAS float* red = (LAS float*)F.lds;
        if (half == 1) { red[tid - 256] = s0; red[256 + tid - 256] = s1; red[512 + tid - 256] = s2; }
        __syncthreads();
        if (half == 0) { F.modp()[(size_t)(ks * 3 + 0) * 3072 + j] = s0 + red[tid]; F.modp()[(size_t)(ks * 3 + 1) * 3072 + j] = s1 + red[256 + tid]; F.modp()[(size_t)(ks * 3 + 2) * 3072 + j] = s2 + red[512 + tid]; }
        __syncthreads();
    }
    LAS float* scr = (LAS float*)(F.lds + 4096 + F.wave * 8448);
    const int gw = F.b * 8 + F.wave, NGW = F.G * 8;
    constexpr int I_IN = 16 * 193, I_OUT = 32 * 32, I_G = 256, I_PE = 64;
    for (int it = gw; it < I_IN + I_OUT + I_G + I_PE; it += NGW) {
        int r = it;
        if (r < I_IN) { const int kb = r / 193, nb = r % 193, n0 = nb * 32;
            bf16_t* dst = n0 < 4096 ? F.WinT() + (size_t)n0 * 1024 : (n0 < 4128 ? F.WbaT() + (size_t)(n0 - 4096) * 1024 : F.WinT() + (size_t)(n0 - 32) * 1024);
            transpose_item(p.w_in, DIN, kb * 64, n0, dst, 1024, scr, lane); continue; }
        r -= I_IN;
        if (r < I_OUT) { const int kb = r / 32, nb = r % 32; transpose_item(p.w_out, 1024, kb * 64, nb * 32, F.WoutT() + (size_t)(nb * 32) * 2048, 2048, scr, lane); continue; }
        r -= I_OUT;
        if (r < I_G) { const int m = r >> 3, sub = r & 7, kb = sub >> 2, nb = sub & 3, g = m >> 4, dn = m & 15;
            const float* src = (g ? p.rg_w_i : p.rg_w_r) + (size_t)dn * 16384;
            transpose_item(src, 128, kb * 64, nb * 32, F.GT() + (size_t)m * 16384 + (size_t)(nb * 32) * 128, 128, scr, lane); continue; }
        r -= I_G;
        { const int v = r;
#pragma unroll
          for (int i = 0; i < 4; ++i) { const int idx = lane * 4 + i; const float f = expf(-9.210340371976184f * (float)idx / 256.f); const float a = (float)v * f;
              F.pe()[v * 256 + idx] = sinf(a); F.pe()[16384 + v * 256 + idx] = cosf(a); } }
    }
}

__device__ __forceinline__ float mod_val(CParams& p, const Frame& F, int grp, int j) {
    float s = p.ada_b[j];
#pragma unroll
    for (int ks = 0; ks < 16; ++ks) s += F.modp()[(size_t)(ks * 3 + grp) * 3072 + j];
    return s;
}

__device__ __forceinline__ void phase1(CParams& p, Frame& F) {
    LAS float* sc = (LAS float*)F.lds; LAS float* sh = sc + 1024;
    for (int tb = F.b; tb < 256; tb += F.G) {
        const int grp = grp_of_block(tb);
        for (int j = F.tid; j < 1024; j += 512) { sh[j] = mod_val(p, F, grp, j); sc[j] = p.pre_w[j] * (1.f + mod_val(p, F, grp, 1024 + j)); }
        __syncthreads();
#pragma unroll 2
        for (int i = 0; i < 8; ++i) {
            const int tok = tb * 64 + F.wave * 8 + i;
            const float* xr = tok < 8192 ? p.x_prompt + (size_t)tok * 1024 : p.x_sample + (size_t)(tok - 8192) * 1024;
            f32x4 v[4]; float ss = 0.f;
#pragma unroll
            for (int q = 0; q < 4; ++q) { v[q] = *(const f32x4*)(xr + F.lane * 4 + 256 * q);
                if (tok >= 8192) { const int pp = (tok - 8192) & 4095; const int vv = (q < 2) ? (pp >> 6) : (pp & 63);
                    const f32x4 e = *(const f32x4*)(F.pe() + ((q & 1) ? 16384 : 0) + vv * 256 + F.lane * 4); v[q] += e; }
                ss += (v[q][0] * v[q][0] + v[q][1] * v[q][1]) + (v[q][2] * v[q][2] + v[q][3] * v[q][3]); }
            const float rstd = rsqrtf(wave_sum(ss) * (1.f / 1024.f) + 1e-6f);
#pragma unroll
            for (int q = 0; q < 4; ++q) { const int j = F.lane * 4 + 256 * q; const f32x4 s4 = *(const LAS f32x4*)(sc + j), h4 = *(const LAS f32x4*)(sh + j);
                CHK(F, 1, badv(v[q][0] * rstd * s4[0] + h4[0], 100.f) || badv(v[q][3] * rstd * s4[3] + h4[3], 100.f));
                u32x2 o; o.x = pk2(v[q][0] * rstd * s4[0] + h4[0], v[q][1] * rstd * s4[1] + h4[1]); o.y = pk2(v[q][2] * rstd * s4[2] + h4[2], v[q][3] * rstd * s4[3] + h4[3]);
                *(u32x2*)(F.H() + (size_t)tok * 1024 + j) = o; }
        }
        __syncthreads();
    }
}

__device__ __forceinline__ void phase2(CParams& p, Frame& F) {
    { pg8::Gemm g{F.H(), F.WinT(), NTOK, NPROJ, 1024}; pg8::StaticOrder S; S.init(NTOK, NPROJ, F.G, F.b); pg8::EpiBf16 E{F.PROJ(), NPROJ};
      pg8::gemm_phase<pg8::EpiBf16, pg8::StaticOrder>(F.lds, g, S, E); }
    const int l15 = F.lane & 15, q4 = F.lane >> 4;
    for (int tb = F.b; tb < 256; tb += F.G) {
        const int mt = F.wave >> 1, nt = F.wave & 1;
        const bf16_t* ar = F.H() + (size_t)(tb * 64 + mt * 16 + l15) * 1024 + q4 * 8;
        const bf16_t* br = F.WbaT() + (size_t)(nt * 16 + l15) * 1024 + q4 * 8;
        f32x4 acc = {0.f, 0.f, 0.f, 0.f};
#pragma unroll 16
        for (int ks = 0; ks < 32; ++ks) { const bf16x8 a = *(const bf16x8*)(ar + ks * 32), b = *(const bf16x8*)(br + ks * 32); acc = MFMA16(a, b, acc); }
#pragma unroll
        for (int r = 0; r < 4; ++r) F.BA()[(size_t)(tb * 64 + mt * 16 + q4 * 4 + r) * 32 + nt * 16 + l15] = acc[r];
    }
}

__device__ __forceinline__ void p3_load_rows(const Frame& F, int ci, int h, u32x4 (&rows)[7]) {
    const int tid = F.tid, tg = tid >> 5, part = (tid >> 4) & 1, sub = tid & 15, col = part * 1024 + h * 128 + sub * 8, t0 = ci * 64;
    int seq_lo, seq_hi; if (ci < 128) { seq_lo = (ci >> 2) * 256; seq_hi = seq_lo + 256; } else { seq_lo = 8192 + ((ci - 128) >> 6) * 4096; seq_hi = seq_lo + 4096; }
    const int tb = t0 + tg * 4 - 2;
#pragma unroll
    for (int r = 0; r < 7; ++r) { const int tok = tb + r; u32x4 v = {0u, 0u, 0u, 0u};
        if (tok >= seq_lo && tok < seq_hi) v = *(const u32x4*)(F.PROJ() + (size_t)tok * NPROJ + col);
        rows[r] = v; }
}
__device__ __forceinline__ void p3_delta_item(CParams& p, Frame& F, int ci, int h, u32x4 (&rows)[7], int itn) {
    const int tid = F.tid, lane = F.lane, wave = F.wave, q4 = lane >> 4, l15 = lane & 15;
    LAS unsigned char* Ks = F.lds; LAS unsigned char* Qs = F.lds + 17408;
    LAS float* gfv = (LAS float*)(F.lds + 34816);
    LAS unsigned char* DIR0 = F.lds + 35840;
    LAS unsigned char* ATo = F.lds + 137728;
#pragma unroll
    for (int i = 0; i < 5; ++i) { const int ch = tid + 512 * i; if (ch < 2304) { const int dd = ch >= 1152, cc = ch - dd * 1152; *(LAS u32x4*)(DIR0 + dd * 47616 + 18432 + cc * 16) = (u32x4){0u, 0u, 0u, 0u}; } }
    const int t0 = ci * 64;
    int seq_lo, seq_hi; if (ci < 128) { seq_lo = (ci >> 2) * 256; seq_hi = seq_lo + 256; } else { seq_lo = 8192 + ((ci - 128) >> 6) * 4096; seq_hi = seq_lo + 4096; }
    {
        const int tg = tid >> 5, part = (tid >> 4) & 1, sub = tid & 15, col = part * 1024 + h * 128 + sub * 8;
        float w[4][8];
#pragma unroll
        for (int j = 0; j < 4; ++j) { const f32x4 a = *(const f32x4*)(p.dn_conv_w + j * 3072 + col), b = *(const f32x4*)(p.dn_conv_w + j * 3072 + col + 4);
            w[j][0] = a[0]; w[j][1] = a[1]; w[j][2] = a[2]; w[j][3] = a[3]; w[j][4] = b[0]; w[j][5] = b[1]; w[j][6] = b[2]; w[j][7] = b[3]; }
        float acc[4][8];
#pragma unroll
        for (int i = 0; i < 4; ++i)
#pragma unroll
            for (int e = 0; e < 8; ++e) acc[i][e] = 0.f;
#pragma unroll
        for (int r = 0; r < 7; ++r) {
            float x[8]; unpack8(rows[r], x);
#pragma unroll
            for (int j = 0; j < 4; ++j) { const int i = r - j; if (i >= 0 && i < 4) {
#pragma unroll
                for (int e = 0; e < 8; ++e) acc[i][e] += w[j][e] * x[e]; } } }
#pragma unroll
        for (int i = 0; i < 4; ++i) { float ss = 0.f;
#pragma unroll
            for (int e = 0; e < 8; ++e) { acc[i][e] = siluf_(acc[i][e]); ss += acc[i][e] * acc[i][e]; }
            ss += __shfl_xor(ss, 1); ss += __shfl_xor(ss, 2); ss += __shfl_xor(ss, 4); ss += __shfl_xor(ss, 8);
            const float rs = rsqrtf(ss + 1e-6f) * (part == 0 ? 0.08838834764831845f : 1.f);
#pragma unroll
            for (int e = 0; e < 8; ++e) acc[i][e] *= rs;
            CHK(F, 4, badv(acc[i][0], 1.01f) || badv(acc[i][5], 1.01f) || badv(ss * rs * rs, part == 0 ? 0.0079f : 1.01f));
            const u32x4 o = pack8(acc[i]); const int c = tg * 4 + i;
            *(LAS u32x4*)((part ? Ks : Qs) + c * 272 + sub * 16) = o;
            if (part == 0) *(u32x4*)(F.Qc() + (size_t)(t0 + c) * 1024 + h * 128 + sub * 8) = o; }
        if (part == 1) {
            bf16_t* kt = F.Kc() + (size_t)(ci * 8 + h) * 8192 + (size_t)(sub * 8) * 64 + tg * 4;
#pragma unroll
            for (int e = 0; e < 8; ++e) { u32x2 o2; o2.x = pk2(acc[0][e], acc[1][e]); o2.y = pk2(acc[2][e], acc[3][e]); *(u32x2*)(kt + e * 64) = o2; } }
    }
    if (wave == 0) {
        const float* ba = F.BA() + (size_t)(t0 + lane) * 32;
        const float bf_ = sigm(ba[h]), bb_ = sigm(ba[8 + h]);
        float s = -expf(p.dn_a_log[h]) * softplusf_(ba[16 + h] + p.dn_dt_bias[h]);
        float sb = -expf(p.dn_a_log[8 + h]) * softplusf_(ba[24 + h] + p.dn_dt_bias[8 + h]);
#pragma unroll
        for (int o = 1; o < 64; o <<= 1) { const float t = __shfl_up(s, o); if (lane >= o) s += t; }
#pragma unroll
        for (int o = 1; o < 64; o <<= 1) { const float t = __shfl_down(sb, o); if (lane + o < 64) sb += t; }
        CHK(F, 3, badv(ba[h], 1000.f) || badv(ba[24 + h], 1000.f));
        CHK(F, 8, badv(s, 1e4f) || badv(sb, 1e4f) || s > 0.f || sb > 0.f || bf_ < 0.f || bf_ > 1.f || bb_ < 0.f || bb_ > 1.f);
        gfv[lane] = s; gfv[64 + lane] = sb; gfv[128 + lane] = bf_; gfv[192 + lane] = bb_;
        float* gb = F.GB() + (size_t)(ci * 8 + h) * 256;
        gb[lane] = s; gb[64 + lane] = sb; gb[128 + lane] = bf_; gb[192 + lane] = bb_;
    }
    lds_barrier();
    const int d = wave >> 2, mt = wave & 3;
    LAS unsigned char* Db = DIR0 + d * 47616;
    LAS unsigned char* Brow = Db; LAS unsigned char* Btr = Db + 9216; LAS unsigned char* Xrow = Db + 18432; LAS unsigned char* Xtr = Db + 27648;
    LAS float* Dl = (LAS float*)(Db + 36864) + mt * 320; LAS unsigned char* M2t = Db + 41984; LAS unsigned char* Mts = Db + 44544 + mt * 768;
    const LAS unsigned char* Lrow = Brow;
    const LAS float* gd = gfv + d * 64; const LAS float* bd = gfv + 128 + d * 64;
    {
        f32x4 kk[4], qk[4];
#pragma unroll
        for (int n = 0; n < 4; ++n) { kk[n] = (f32x4){0.f, 0.f, 0.f, 0.f}; qk[n] = (f32x4){0.f, 0.f, 0.f, 0.f}; }
#pragma unroll
        for (int ks = 0; ks < 4; ++ks) { const bf16x8 ak = ldfrag(Ks, 272, mt * 16 + l15, ks * 64 + q4 * 16), aq = ldfrag(Qs, 272, mt * 16 + l15, ks * 64 + q4 * 16);
#pragma unroll
            for (int n = 0; n < 4; ++n) { const bf16x8 bk = ldfrag(Ks, 272, n * 16 + l15, ks * 64 + q4 * 16); kk[n] = MFMA16(ak, bk, kk[n]); qk[n] = MFMA16(aq, bk, qk[n]); } }
#pragma unroll
        for (int n = 0; n < 4; ++n) { const int C = n * 16 + l15; const float gC = gd[C], bC = bd[C]; float a4[4];
#pragma unroll
            for (int r = 0; r < 4; ++r) { const int R = mt * 16 + q4 * 4 + r;
                const float dec = __expf(-fabsf(gd[R] - gC));
                a4[r] = (C > R) ? (d == 0 ? bC : bd[R]) * kk[n][r] * dec : 0.f;
                const bool incl = d == 0 ? (R >= C) : (R < C);
                if (incl) ((LAS bf16_t*)ATo)[R * 64 + C] = f2bf(qk[n][r] * dec); }
            u32x2 o; o.x = pk2(a4[0], a4[1]); o.y = pk2(a4[2], a4[3]);
            *(LAS u32x2*)(Brow + C * 144 + (mt * 16 + q4 * 4) * 2) = o;
            if (n == mt) *(LAS f32x4*)(Dl + l15 * 20 + q4 * 4) = (f32x4){a4[0], a4[1], a4[2], a4[3]}; }
    }
    lds_barrier();
    if (itn < 2048) p3_load_rows(F, itn >> 3, itn & 7, rows);
    if (lane < 16) {
        float x[16];
#pragma unroll
        for (int i = 0; i < 16; ++i) { float sv = (i == lane) ? 1.f : 0.f;
            float drow[16];
#pragma unroll
            for (int q = 0; q < 4; ++q) if (4 * q < i) { const f32x4 t4 = *(const LAS f32x4*)(Dl + i * 20 + 4 * q); drow[4 * q] = t4[0]; drow[4 * q + 1] = t4[1]; drow[4 * q + 2] = t4[2]; drow[4 * q + 3] = t4[3]; }
#pragma unroll
            for (int j = 0; j < i; ++j) sv -= drow[j] * x[j];
            x[i] = sv; }
#pragma unroll
        for (int i = 0; i < 16; ++i) ((LAS bf16_t*)Xrow)[(mt * 16 + i) * 72 + mt * 16 + lane] = f2bf(x[i]);
        u32x4 o0, o1; o0.x = pk2(x[0], x[1]); o0.y = pk2(x[2], x[3]); o0.z = pk2(x[4], x[5]); o0.w = pk2(x[6], x[7]);
        o1.x = pk2(x[8], x[9]); o1.y = pk2(x[10], x[11]); o1.z = pk2(x[12], x[13]); o1.w = pk2(x[14], x[15]);
        *(LAS u32x4*)(Xtr + (mt * 16 + lane) * 144 + mt * 32) = o0; *(LAS u32x4*)(Xtr + (mt * 16 + lane) * 144 + mt * 32 + 16) = o1;
    }
    lds_barrier();
    const bf16x8 zero8 = {0, 0, 0, 0, 0, 0, 0, 0};
    const f32x4 zero4 = {0.f, 0.f, 0.f, 0.f};
    if (mt & 1) {
        const int I1 = mt, I0 = mt - 1;
        bf16x8 a = zero8, b = zero8;
        if (q4 < 2) { a = ldfrag(Lrow, 144, I1 * 16 + l15, I0 * 32 + q4 * 16); b = ldfrag(Xtr, 144, I0 * 16 + l15, I0 * 32 + q4 * 16); }
        const f32x4 M = MFMA16(a, b, zero4);
        { u32x2 o; o.x = pk2(M[0], M[1]); o.y = pk2(M[2], M[3]); *(LAS u32x2*)(Mts + l15 * 48 + q4 * 8) = o; }
        LDS_WAIT();
        bf16x8 a2 = zero8, b2 = zero8;
        if (q4 < 2) { a2 = ldfrag(Xrow, 144, I1 * 16 + l15, I1 * 32 + q4 * 16); b2 = *(const LAS bf16x8*)(Mts + l15 * 48 + q4 * 16); }
        const f32x4 X = MFMA16(a2, b2, zero4);
#pragma unroll
        for (int r = 0; r < 4; ++r) ((LAS bf16_t*)Xrow)[(I1 * 16 + q4 * 4 + r) * 72 + I0 * 16 + l15] = f2bf(-X[r]);
        u32x2 o; o.x = pk2(-X[0], -X[1]); o.y = pk2(-X[2], -X[3]);
        *(LAS u32x2*)(Xtr + (I0 * 16 + l15) * 144 + (I1 * 16 + q4 * 4) * 2) = o;
    }
    lds_barrier();
    {
        const int mi = mt >> 1, ni = mt & 1;
        const bf16x8 a = ldfrag(Lrow, 144, 32 + mi * 16 + l15, q4 * 16), b = ldfrag(Xtr, 144, ni * 16 + l15, q4 * 16);
        const f32x4 M2 = MFMA16(a, b, zero4);
        { u32x2 o; o.x = pk2(M2[0], M2[1]); o.y = pk2(M2[2], M2[3]); *(LAS u32x2*)(M2t + (ni * 16 + l15) * 80 + (mi * 16 + q4 * 4) * 2) = o; }
        lds_barrier();
        const bf16x8 a2 = ldfrag(Xrow, 144, 32 + mi * 16 + l15, 64 + q4 * 16), b2 = *(const LAS bf16x8*)(M2t + (ni * 16 + l15) * 80 + q4 * 16);
        const f32x4 X = MFMA16(a2, b2, zero4);
#pragma unroll
        for (int r = 0; r < 4; ++r) { CHK(F, 6, badv(X[r], 20.f)); ((LAS bf16_t*)Xrow)[(32 + mi * 16 + q4 * 4 + r) * 72 + ni * 16 + l15] = f2bf(-X[r]); }
        u32x2 o; o.x = pk2(-X[0], -X[1]); o.y = pk2(-X[2], -X[3]);
        *(LAS u32x2*)(Xtr + (ni * 16 + l15) * 144 + (32 + mi * 16 + q4 * 4) * 2) = o;
    }
    lds_barrier();
    { bf16_t* dst = F.TA() + (size_t)(ci * 8 + h) * 8192;
      const int c = tid >> 3, s0 = (tid & 7) * 8;
      const u32x4 lo = *(const LAS u32x4*)(DIR0 + 18432 + c * 144 + s0 * 2), up = *(const LAS u32x4*)(DIR0 + 47616 + 27648 + c * 144 + s0 * 2);
      unsigned wl[4] = {lo.x, lo.y, lo.z, lo.w}, wu[4] = {up.x, up.y, up.z, up.w}, wo[4];
#pragma unroll
      for (int i = 0; i < 4; ++i) { const int sa = s0 + 2 * i, sb2 = sa + 1;
          const unsigned mlo = (sa <= c ? 0x0000FFFFu : 0u) | (sb2 <= c ? 0xFFFF0000u : 0u);
          wo[i] = (wl[i] & mlo) | (wu[i] & ~mlo); }
      *(u32x4*)(dst + tid * 8) = (u32x4){wo[0], wo[1], wo[2], wo[3]};
      *(u32x4*)(dst + 4096 + tid * 8) = *(const LAS u32x4*)(ATo + tid * 16); }
    lds_barrier();
}

struct RgW { bf16x8 g[2][2][4]; float br[2], bi[2], sp[2]; };
__device__ __forceinline__ void rg_load_w(CParams& p, const Frame& F, int n, RgW& W) {
    const int q4 = F.lane >> 4, j = F.wave * 16 + (F.lane & 15), ch = n * 128 + j;
#pragma unroll
    for (int d = 0; d < 2; ++d) {
#pragma unroll
        for (int g = 0; g < 2; ++g) { const bf16_t* gp = F.GT() + (size_t)((g * 2 + d) * 8 + n) * 16384 + (size_t)j * 128 + q4 * 8;
#pragma unroll
            for (int ks = 0; ks < 4; ++ks) W.g[d][g][ks] = *(const bf16x8*)(gp + ks * 32); }
        W.br[d] = p.rg_b_r[d * 1024 + ch]; W.bi[d] = p.rg_b_i[d * 1024 + ch]; W.sp[d] = softplusf_(-p.rg_lam[d * 1024 + ch]); }
}
__device__ __forceinline__ void rg_load_rows(const Frame& F, int ci, int n, u32x4 (&rows)[5]) {
    const int tid = F.tid, tg = tid >> 4, sub = tid & 15, col = 4096 + n * 128 + sub * 8, t0 = ci * 64;
    int c_lo, c_hi; if (ci < 128) { c_lo = (ci >> 2) * 4; c_hi = c_lo + 4; } else { c_lo = 128 + ((ci - 128) >> 6) * 64; c_hi = c_lo + 64; }
    const int tb = t0 + tg * 2 - 2;
#pragma unroll
    for (int r = 0; r < 5; ++r) { const int tok = tb + r; u32x4 v = {0u, 0u, 0u, 0u};
        if (tok >= c_lo * 64 && tok < c_hi * 64) v = *(const u32x4*)(F.PROJ() + (size_t)tok * NPROJ + col);
        rows[r] = v; }
}
template <int PASS>
__device__ __forceinline__ void rg_item(CParams& p, Frame& F, int ci, int n, u32x4 (&rows)[5], int itn) {
    const int tid = F.tid, lane = F.lane, wave = F.wave, q4 = lane >> 4, l15 = lane & 15;
    LAS unsigned char* xb = F.lds; LAS float* xf = (LAS float*)(F.lds + 17408); LAS float* Hs = (LAS float*)(F.lds + 50176);
    const int t0 = ci * 64;
    int seq_lo, seq_hi, c_lo, c_hi, seq; const bool samp = ci >= 128;
    if (!samp) { seq = ci >> 2; c_lo = seq * 4; c_hi = c_lo + 4; } else { seq = (ci - 128) >> 6; c_lo = 128 + seq * 64; c_hi = c_lo + 64; }
    seq_lo = c_lo * 64; seq_hi = c_hi * 64;
    const int j = wave * 16 + l15, ch = n * 128 + j;
    bf16x8 wA[2][4], wB[2][4];
#pragma unroll
    for (int g = 0; g < 2; ++g) { const bf16_t* gp = F.GT() + (size_t)((g * 2 + 0) * 8 + n) * 16384 + (size_t)j * 128 + q4 * 8;
#pragma unroll
        for (int ks = 0; ks < 4; ++ks) wA[g][ks] = *(const bf16x8*)(gp + ks * 32); }
    {
        const int tg = tid >> 4, sub = tid & 15, ch = n * 128 + sub * 8;
        float w[4][8], acc[2][8];
#pragma unroll
        for (int j = 0; j < 4; ++j) { const f32x4 a = *(const f32x4*)(p.rg_conv_w + j * 1024 + ch), b = *(const f32x4*)(p.rg_conv_w + j * 1024 + ch + 4);
            w[j][0] = a[0]; w[j][1] = a[1]; w[j][2] = a[2]; w[j][3] = a[3]; w[j][4] = b[0]; w[j][5] = b[1]; w[j][6] = b[2]; w[j][7] = b[3]; }
        { const f32x4 a = *(const f32x4*)(p.rg_conv_b + ch), b = *(const f32x4*)(p.rg_conv_b + ch + 4);
#pragma unroll
          for (int i = 0; i < 2; ++i) { acc[i][0] = a[0]; acc[i][1] = a[1]; acc[i][2] = a[2]; acc[i][3] = a[3]; acc[i][4] = b[0]; acc[i][5] = b[1]; acc[i][6] = b[2]; acc[i][7] = b[3]; } }
#pragma unroll
        for (int r = 0; r < 5; ++r) {
            float x[8]; unpack8(rows[r], x);
#pragma unroll
            for (int j = 0; j < 4; ++j) { const int i = r - j; if (i >= 0 && i < 2) {
#pragma unroll
                for (int e = 0; e < 8; ++e) acc[i][e] += w[j][e] * x[e]; } } }
#pragma unroll
        for (int i = 0; i < 2; ++i) { const int c = tg * 2 + i;
            *(LAS u32x4*)(xb + c * 272 + sub * 16) = pack8(acc[i]);
            *(LAS f32x4*)(xf + c * 128 + sub * 8) = (f32x4){acc[i][0], acc[i][1], acc[i][2], acc[i][3]};
            *(LAS f32x4*)(xf + c * 128 + sub * 8 + 4) = (f32x4){acc[i][4], acc[i][5], acc[i][6], acc[i][7]}; }
    }
    lds_barrier();
    f32x4 hs[4];
#pragma unroll
    for (int m = 0; m < 4; ++m) hs[m] = (f32x4){0.f, 0.f, 0.f, 0.f};
#pragma unroll
    for (int d = 0; d < 2; ++d) {
        f32x4 av[4], bxv[4];
        {
            f32x4 ar[4], ai[4];
#pragma unroll
            for (int m = 0; m < 4; ++m) { ar[m] = (f32x4){0.f, 0.f, 0.f, 0.f}; ai[m] = (f32x4){0.f, 0.f, 0.f, 0.f}; }
#pragma unroll
            for (int ks = 0; ks < 4; ++ks) { const bf16x8 br = d == 0 ? wA[0][ks] : wB[0][ks], bi = d == 0 ? wA[1][ks] : wB[1][ks];
#pragma unroll
                for (int m = 0; m < 4; ++m) { const bf16x8 a = ldfrag(xb, 272, m * 16 + l15, ks * 64 + q4 * 16); ar[m] = MFMA16(a, br, ar[m]); ai[m] = MFMA16(a, bi, ai[m]); } }
            if (d == 0) {
#pragma unroll
                for (int g = 0; g < 2; ++g) { const bf16_t* gp = F.GT() + (size_t)((g * 2 + 1) * 8 + n) * 16384 + (size_t)j * 128 + q4 * 8;
#pragma unroll
                    for (int ks = 0; ks < 4; ++ks) wB[g][ks] = *(const bf16x8*)(gp + ks * 32); } }
            const float L2E = 1.4426950408889634f;
            const float br_ = -L2E * p.rg_b_r[d * 1024 + ch], bi_ = -L2E * p.rg_b_i[d * 1024 + ch], sp = softplusf_(-p.rg_lam[d * 1024 + ch]);
            const float k2 = -16.f * sp, k2e = k2 * L2E, k1e = 0.5f * k2e;
#pragma unroll
            for (int m = 0; m < 4; ++m)
#pragma unroll
                for (int r = 0; r < 4; ++r) { const int c = m * 16 + q4 * 4 + r;
                    const float rr = __builtin_amdgcn_rcpf(1.f + __builtin_amdgcn_exp2f(fmaf(ar[m][r], -L2E, br_)));
                    const float ii = __builtin_amdgcn_rcpf(1.f + __builtin_amdgcn_exp2f(fmaf(ai[m][r], -L2E, bi_)));
                    const float t2 = k2 * rr;
                    const float ser = t2 * fmaf(t2, fmaf(t2, 0.16666667f, 0.5f), 1.f);
                    const float a_ = __builtin_amdgcn_exp2f(k1e * rr);
                    const float em = t2 > -0.01f ? ser : fmaf(a_, a_, -1.f);
                    av[m][r] = a_; bxv[m][r] = __builtin_amdgcn_sqrtf(-em) * (ii * xf[c * 128 + j]); }
        }
        f32x4 Pa[4], Pb[4]; float Ap[4], Bp[4], Am[4], Bm[4];
#pragma unroll
        for (int m = 0; m < 4; ++m) {
            float pa, pb;
            if (d == 0) { pa = av[m][0]; pb = bxv[m][0]; Pa[m][0] = pa; Pb[m][0] = pb;
#pragma unroll
                for (int r = 1; r < 4; ++r) { pb = av[m][r] * pb + bxv[m][r]; pa = av[m][r] * pa; Pa[m][r] = pa; Pb[m][r] = pb; } }
            else { pa = av[m][3]; pb = bxv[m][3]; Pa[m][3] = pa; Pb[m][3] = pb;
#pragma unroll
                for (int r = 2; r >= 0; --r) { pb = av[m][r] * pb + bxv[m][r]; pa = av[m][r] * pa; Pa[m][r] = pa; Pb[m][r] = pb; } }
            float Ak[4], Bk[4];
#pragma unroll
            for (int k = 0; k < 4; ++k) { Ak[k] = __shfl(pa, l15 + 16 * k); Bk[k] = __shfl(pb, l15 + 16 * k); }
            float ap = 1.f, bp = 0.f, am = 1.f, bm = 0.f;
#pragma unroll
            for (int kk = 0; kk < 4; ++kk) { const int k = d == 0 ? kk : 3 - kk;
                const bool before = d == 0 ? (k < q4) : (k > q4);
                const float nb = Ak[k] * bp + Bk[k], na = Ak[k] * ap;
                bp = before ? nb : bp; ap = before ? na : ap;
                bm = Ak[k] * bm + Bk[k]; am = Ak[k] * am; }
            Ap[m] = ap; Bp[m] = bp; Am[m] = am; Bm[m] = bm;
        }
        if (PASS == 1) {
            float At = 1.f, Bt = 0.f;
#pragma unroll
            for (int mm = 0; mm < 4; ++mm) { const int m = d == 0 ? mm : 3 - mm; Bt = Am[m] * Bt + Bm[m]; At = Am[m] * At; }
            if (q4 == 0) { float* ag = F.RGAGG() + (size_t)(ci * 2 + d) * 2048; ag[ch] = At; ag[1024 + ch] = Bt; }
        } else {
            float hb = F.CARRY()[(size_t)(ci * 2 + d) * 1024 + ch];
#pragma unroll
            for (int mm = 0; mm < 4; ++mm) { const int m = d == 0 ? mm : 3 - mm;
                const float hin = Ap[m] * hb + Bp[m];
#pragma unroll
                for (int r = 0; r < 4; ++r) hs[m][r] += Pa[m][r] * hin + Pb[m][r];
                hb = Am[m] * hb + Bm[m]; }
            if (!samp && q4 == 0 && ci == (d == 0 ? c_hi - 1 : c_lo)) F.out[OUT_SR + (size_t)(seq * 2 + d) * 1024 + ch] = hb;
        }
    }
    if (PASS == 1 && itn < 1024) rg_load_rows(F, 128 + (itn >> 3), itn & 7, rows);
    if (PASS == 3) {
#pragma unroll
        for (int m = 0; m < 4; ++m)
#pragma unroll
            for (int r = 0; r < 4; ++r) Hs[(m * 16 + q4 * 4 + r) * 128 + j] = hs[m][r];
        lds_barrier();
#pragma unroll
        for (int i = 0; i < 2; ++i) { const int chunk = tid + 512 * i, c = chunk >> 4, cc = chunk & 15;
            const u32x4 gv = *(const u32x4*)(F.PROJ() + (size_t)(t0 + c) * NPROJ + 5120 + n * 128 + cc * 8);
            float g[8]; unpack8(gv, g);
            const f32x4 ha = *(const LAS f32x4*)(Hs + c * 128 + cc * 8), hb2 = *(const LAS f32x4*)(Hs + c * 128 + cc * 8 + 4);
            float o[8];
#pragma unroll
            for (int e = 0; e < 4; ++e) { o[e] = ha[e] * siluf_(g[e]); o[4 + e] = hb2[e] * siluf_(g[4 + e]); }
            *(u32x4*)(F.MIX() + (size_t)(t0 + c) * 2048 + 1024 + n * 128 + cc * 8) = pack8(o); }
    }
    lds_barrier();
}

__device__ __forceinline__ void rg_conv_lds(CParams& p, const Frame& F, int n, const u32x4 (&rows)[5], LAS unsigned char* xb, LAS float* xf) {
    const int tid = F.tid, tg = tid >> 4, sub = tid & 15, ch = n * 128 + sub * 8;
    float w[4][8], acc[2][8];
#pragma unroll
    for (int j = 0; j < 4; ++j) { const f32x4 a = *(const f32x4*)(p.rg_conv_w + j * 1024 + ch), b = *(const f32x4*)(p.rg_conv_w + j * 1024 + ch + 4);
        w[j][0] = a[0]; w[j][1] = a[1]; w[j][2] = a[2]; w[j][3] = a[3]; w[j][4] = b[0]; w[j][5] = b[1]; w[j][6] = b[2]; w[j][7] = b[3]; }
    { const f32x4 a = *(const f32x4*)(p.rg_conv_b + ch), b = *(const f32x4*)(p.rg_conv_b + ch + 4);
#pragma unroll
      for (int i = 0; i < 2; ++i) { acc[i][0] = a[0]; acc[i][1] = a[1]; acc[i][2] = a[2]; acc[i][3] = a[3]; acc[i][4] = b[0]; acc[i][5] = b[1]; acc[i][6] = b[2]; acc[i][7] = b[3]; } }
#pragma unroll
    for (int r = 0; r < 5; ++r) { float x[8]; unpack8(rows[r], x);
#pragma unroll
        for (int j = 0; j < 4; ++j) { const int i = r - j; if (i >= 0 && i < 2) {
#pragma unroll
            for (int e = 0; e < 8; ++e) acc[i][e] += w[j][e] * x[e]; } } }
#pragma unroll
    for (int i = 0; i < 2; ++i) { const int c = tg * 2 + i;
        *(LAS u32x4*)(xb + c * 272 + sub * 16) = pack8(acc[i]);
        *(LAS f32x4*)(xf + c * 128 + sub * 8) = (f32x4){acc[i][0], acc[i][1], acc[i][2], acc[i][3]};
        *(LAS f32x4*)(xf + c * 128 + sub * 8 + 4) = (f32x4){acc[i][4], acc[i][5], acc[i][6], acc[i][7]}; }
}
template <int D>
__device__ __forceinline__ void rg_gate_scan(const Frame& F, const bf16x8 (&wg)[2][4], float br_, float bi_, float sp, const LAS unsigned char* xb, const LAS float* xf, int j,
                                             f32x4 (&Pa)[4], f32x4 (&Pb)[4], float (&Ap)[4], float (&Bp)[4], float (&Am)[4], float (&Bm)[4]) {
    const int lane = F.lane, q4 = lane >> 4, l15 = lane & 15;
    f32x4 av[4], bxv[4];
    {
        f32x4 ar[4], ai[4];
#pragma unroll
        for (int m = 0; m < 4; ++m) { ar[m] = (f32x4){0.f, 0.f, 0.f, 0.f}; ai[m] = (f32x4){0.f, 0.f, 0.f, 0.f}; }
#pragma unroll
        for (int ks = 0; ks < 4; ++ks) {
#pragma unroll
            for (int m = 0; m < 4; ++m) { const bf16x8 a = ldfrag(xb, 272, m * 16 + l15, ks * 64 + q4 * 16); ar[m] = MFMA16(a, wg[0][ks], ar[m]); ai[m] = MFMA16(a, wg[1][ks], ai[m]); } }
        const float L2E = 1.4426950408889634f;
        const float brs = -L2E * br_, bis = -L2E * bi_, k2 = -16.f * sp, k1e = 0.5f * k2 * L2E;
#pragma unroll
        for (int m = 0; m < 4; ++m)
#pragma unroll
            for (int r = 0; r < 4; ++r) { const int c = m * 16 + q4 * 4 + r;
                const float rr = __builtin_amdgcn_rcpf(1.f + __builtin_amdgcn_exp2f(fmaf(ar[m][r], -L2E, brs)));
                const float ii = __builtin_amdgcn_rcpf(1.f + __builtin_amdgcn_exp2f(fmaf(ai[m][r], -L2E, bis)));
                const float t2 = k2 * rr, a = __builtin_amdgcn_exp2f(k1e * rr);
                const float ser = t2 * fmaf(t2, fmaf(t2, 0.16666667f, 0.5f), 1.f);
                const float em = t2 > -0.01f ? ser : fmaf(a, a, -1.f);
                av[m][r] = a; bxv[m][r] = __builtin_amdgcn_sqrtf(-em) * (ii * xf[c * 128 + j]); }
    }
#pragma unroll
    for (int m = 0; m < 4; ++m) {
        float pa, pb;
        if (D == 0) { pa = av[m][0]; pb = bxv[m][0]; Pa[m][0] = pa; Pb[m][0] = pb;
#pragma unroll
            for (int r = 1; r < 4; ++r) { pb = av[m][r] * pb + bxv[m][r]; pa = av[m][r] * pa; Pa[m][r] = pa; Pb[m][r] = pb; } }
        else { pa = av[m][3]; pb = bxv[m][3]; Pa[m][3] = pa; Pb[m][3] = pb;
#pragma unroll
            for (int r = 2; r >= 0; --r) { pb = av[m][r] * pb + bxv[m][r]; pa = av[m][r] * pa; Pa[m][r] = pa; Pb[m][r] = pb; } }
        float Ak[4], Bk[4];
#pragma unroll
        for (int k = 0; k < 4; ++k) { Ak[k] = __shfl(pa, l15 + 16 * k); Bk[k] = __shfl(pb, l15 + 16 * k); }
        float ap = 1.f, bp = 0.f, am = 1.f, bm = 0.f;
#pragma unroll
        for (int kk = 0; kk < 4; ++kk) { const int k = D == 0 ? kk : 3 - kk;
            const bool before = D == 0 ? (k < q4) : (k > q4);
            const float nb = Ak[k] * bp + Bk[k], na = Ak[k] * ap;
            bp = before ? nb : bp; ap = before ? na : ap;
            bm = Ak[k] * bm + Bk[k]; am = Ak[k] * am; }
        Ap[m] = ap; Bp[m] = bp; Am[m] = am; Bm[m] = bm;
    }
}
template <int D>
__device__ __forceinline__ void rg_prompt_dir(CParams& p, Frame& F, int seq, int n) {
    const int tid = F.tid, lane = F.lane, wave = F.wave, q4 = lane >> 4, l15 = lane & 15;
    LAS unsigned char* xb = F.lds; LAS float* xf = (LAS float*)(F.lds + 17408); LAS float* Hs = (LAS float*)(F.lds + 50176); LAS bf16_t* Hf = (LAS bf16_t*)(F.lds + 82944);
    const int j = wave * 16 + l15, ch = n * 128 + j;
    bf16x8 wg[2][4];
#pragma unroll
    for (int g = 0; g < 2; ++g) { const bf16_t* gp = F.GT() + (size_t)((g * 2 + D) * 8 + n) * 16384 + (size_t)j * 128 + q4 * 8;
#pragma unroll
        for (int ks = 0; ks < 4; ++ks) wg[g][ks] = *(const bf16x8*)(gp + ks * 32); }
    const float br_ = p.rg_b_r[D * 1024 + ch], bi_ = p.rg_b_i[D * 1024 + ch], sp = softplusf_(-p.rg_lam[D * 1024 + ch]);
    float hb = 0.f;
    u32x4 rows[5];
    rg_load_rows(F, seq * 4 + (D == 0 ? 0 : 3), n, rows);
#pragma unroll 1
    for (int cs = 0; cs < 4; ++cs) {
        const int cidx = D == 0 ? cs : 3 - cs, ci = seq * 4 + cidx, t0 = ci * 64;
        rg_conv_lds(p, F, n, rows, xb, xf);
        if (cs < 3) rg_load_rows(F, seq * 4 + (D == 0 ? cidx + 1 : cidx - 1), n, rows);
        lds_barrier();
        f32x4 Pa[4], Pb[4]; float Ap[4], Bp[4], Am[4], Bm[4];
        rg_gate_scan<D>(F, wg, br_, bi_, sp, xb, xf, j, Pa, Pb, Ap, Bp, Am, Bm);
#pragma unroll
        for (int mm = 0; mm < 4; ++mm) { const int m = D == 0 ? mm : 3 - mm;
            const float hin = Ap[m] * hb + Bp[m];
#pragma unroll
            for (int r = 0; r < 4; ++r) { const float hv = Pa[m][r] * hin + Pb[m][r]; const int tl = m * 16 + q4 * 4 + r;
                if (D == 0) Hf[(cidx * 64 + tl) * 128 + j] = f2bf(hv);
                else Hs[tl * 128 + j] = hv + bf2f(Hf[(cidx * 64 + tl) * 128 + j]); }
            hb = Am[m] * hb + Bm[m]; }
        lds_barrier();
        if (D == 1) {
#pragma unroll
            for (int i = 0; i < 2; ++i) { const int chunk = tid + 512 * i, c = chunk >> 4, cc = chunk & 15;
                bf16_t* gp = F.PROJ() + (size_t)(t0 + c) * NPROJ + 5120 + n * 128 + cc * 8;
                const u32x4 gv = *(const u32x4*)gp; float g[8]; unpack8(gv, g);
                const f32x4 ha = *(const LAS f32x4*)(Hs + c * 128 + cc * 8), hb2 = *(const LAS f32x4*)(Hs + c * 128 + cc * 8 + 4);
                float o[8];
#pragma unroll
                for (int e = 0; e < 4; ++e) { o[e] = ha[e] * siluf_(g[e]); o[4 + e] = hb2[e] * siluf_(g[4 + e]); }
                *(u32x4*)gp = pack8(o); }
            lds_barrier();
        }
    }
    if (q4 == 0) F.out[OUT_SR + (size_t)(seq * 2 + D) * 1024 + ch] = hb;
}

__device__ __forceinline__ void rg_carry_scan(CParams& p, Frame& F) {
    const int tid = F.tid;
    int samp, seq, d, ch;
    if (tid < 256) return;
    else if (tid < 272) { const int g = F.b * 16 + tid - 256; if (g >= 4096) return; samp = 1; seq = g >> 11; d = (g >> 10) & 1; ch = g & 1023; }
    else return;
    const int nch = samp ? 64 : 4, c_lo = samp ? 128 + seq * 64 : seq * 4;
    float h = samp ? p.state_rglru[(size_t)(seq * 2 + d) * 1024 + ch] : 0.f;
    for (int i0 = 0; i0 < nch; i0 += 4) {
        float A[4], B[4];
#pragma unroll
        for (int u = 0; u < 4; ++u) { const int cc = d == 0 ? c_lo + i0 + u : c_lo + nch - 1 - i0 - u; const float* ag = F.RGAGG() + (size_t)(cc * 2 + d) * 2048; A[u] = ag[ch]; B[u] = ag[1024 + ch]; }
#pragma unroll
        for (int u = 0; u < 4; ++u) { const int cc = d == 0 ? c_lo + i0 + u : c_lo + nch - 1 - i0 - u; F.CARRY()[(size_t)(cc * 2 + d) * 1024 + ch] = h; h = A[u] * h + B[u]; }
    }
}

__device__ __forceinline__ void phase3(CParams& p, Frame& F) {
    for (int rep = 0; rep < (REP_PHASE == 30 ? 2 : 1); ++rep)
    { u32x4 rows[7]; if (F.b < 2048) p3_load_rows(F, F.b >> 3, F.b & 7, rows);
      for (int it = F.b; it < 2048; it += F.G) p3_delta_item(p, F, it >> 3, it & 7, rows, it + F.G); }
    for (int rep = 0; rep < (REP_PHASE == 31 ? 2 : 1); ++rep) {
    u32x4 rows[5]; if (F.b < 1024) rg_load_rows(F, 128 + (F.b >> 3), F.b & 7, rows);
    for (int it = F.b; it < 1024; it += F.G) rg_item<1>(p, F, 128 + (it >> 3), it & 7, rows, it + F.G); }
    for (int it = F.b; it < 256; it += F.G) { rg_prompt_dir<0>(p, F, it >> 3, it & 7); rg_prompt_dir<1>(p, F, it >> 3, it & 7); }
}

struct P4D { int valid, samp, seq, h, d, sl, ci, seq_lo, seq_hi, last, k, s, nch; };
__device__ __forceinline__ P4D p4_desc(const Frame& F, int k, int s) {
    P4D D; int item;
    if (F.G == 256) {
        const int x = F.b & 7, y = F.b >> 3;
        if (y < 16) { item = (x * 4 + (y >> 2)) * 4 + (y & 3); D.valid = k < 1; }
        else { const int j = y - 16; item = 128 + (x * 64 + (j >> 2) * 16 + k) * 4 + (j & 3); D.valid = k < 16; } }
    else { item = F.b + k * F.G; D.valid = item < 2176; }
    D.samp = item < 128; const int it = D.samp ? item : item - 128, chain = it >> 2;
    D.sl = it & 3; D.seq = chain >> 4; D.h = (chain >> 1) & 7; D.d = chain & 1;
    D.nch = D.samp ? 64 : 4; const int chunk0 = D.samp ? 128 + D.seq * 64 : D.seq * 4;
    D.seq_lo = chunk0 * 64; D.seq_hi = D.seq_lo + D.nch * 64;
    D.ci = D.d == 0 ? chunk0 + s : chunk0 + D.nch - 1 - s; D.last = s == D.nch - 1; D.k = k; D.s = s;
    return D;
}
__device__ __forceinline__ P4D p4_next(const Frame& F, const P4D& D) {
    if (D.s + 1 < D.nch) { P4D N = D; N.s = D.s + 1; N.ci = D.ci + (D.d == 0 ? 1 : -1); N.last = N.s == D.nch - 1; return N; }
    return p4_desc(F, D.k + 1, 0);
}
struct P4Pre { u32x4 k0, k1, q0, q1, ti, at; u32x2 v[4]; float g, b, bc; };
struct P4T { unsigned oKQ, oTA, oV, oG, oGc; int cj; };
__device__ __forceinline__ P4T p4_thread_consts(int tid) {
    P4T T; T.oKQ = (unsigned)(((tid >> 4) * 1024 + (tid & 15) * 8) * 2); T.oTA = (unsigned)tid * 16u;
    T.oV = (unsigned)(((tid >> 3) * NPROJ + (tid & 7) * 4) * 2); T.oG = (unsigned)(tid & 63) * 4u; T.oGc = (unsigned)(tid >> 3) * 4u; T.cj = (tid >> 3) - 2; return T;
}
__device__ __forceinline__ void p4_prefetch(CParams& p, const Frame& F, P4Pre& R, const P4D& D, const P4T& T) {
    const int tid = F.tid, t0 = D.ci * 64, h = D.h;
    const char* kb = (const char*)F.Kc() + (size_t)(D.ci * 8 + h) * 16384;
    const char* qb = (const char*)F.Qc() + ((size_t)t0 * 1024 + h * 128) * 2;
    const char* tb = (const char*)F.TA() + (size_t)(D.ci * 8 + h) * 16384;
    const char* vb = (const char*)F.PROJ() + ((long)(t0 - 2) * NPROJ + 2048 + h * 128 + D.sl * 32) * 2;
    const char* gb = (const char*)F.GB() + (size_t)(D.ci * 8 + h) * 1024 + D.d * 256;
    R.k0 = *(const u32x4*)(kb + T.oTA); R.k1 = *(const u32x4*)(kb + T.oTA + 8192u);
    R.q0 = *(const u32x4*)(qb + T.oKQ); R.q1 = *(const u32x4*)(qb + T.oKQ + 65536u);
    R.ti = *(const u32x4*)(tb + T.oTA); R.at = *(const u32x4*)(tb + T.oTA + 8192u);
#pragma unroll
    for (int j = 0; j < 4; ++j) { const int tok = t0 + T.cj + j; u32x2 v = {0u, 0u};
        if (tok >= D.seq_lo && tok < D.seq_hi) v = *(const u32x2*)(vb + T.oV + (unsigned)(j * NPROJ * 2));
        R.v[j] = v; }
    R.bc = *(const float*)(gb + 512 + T.oGc);
    R.g = 0.f; R.b = 0.f;
    if (tid < 64) { R.g = *(const float*)(gb + T.oG); R.b = *(const float*)(gb + 512 + T.oG); }
}
__device__ __forceinline__ u32x4 tri_mask(u32x4 v, int c, int s0, int d) {
    unsigned w[4] = {v.x, v.y, v.z, v.w};
#pragma unroll
    for (int i = 0; i < 4; ++i) { const int slo = s0 + 2 * i, shi = slo + 1;
        const bool klo = d == 0 ? (c >= slo) : (c <= slo), khi = d == 0 ? (c >= shi) : (c <= shi);
        w[i] &= (klo ? 0x0000FFFFu : 0u) | (khi ? 0xFFFF0000u : 0u); }
    return (u32x4){w[0], w[1], w[2], w[3]};
}
constexpr int P4_KS = 0, P4_TI = 17408, P4_VBT = 26624, P4_WL = 31232, P4_SB = 48640, P4_VT1 = 57344, P4_VT2 = 61952, P4_QS = 66560, P4_AT = 101376, P4_GV = 119808, P4_KT = 122368;
__device__ __forceinline__ void p4_stage(CParams& p, const Frame& F, const P4Pre& R, const P4D& D, int buf, const unsigned (&mk)[2][4], f32x4 (&cw)[4], const f32x4 (&cwn)[4]) {
    const int tid = F.tid, d = D.d;
    LAS unsigned char* Ks = F.lds + P4_KS; LAS unsigned char* Qs = F.lds + P4_QS + buf * 17408; LAS unsigned char* TIs = F.lds + P4_TI;
    LAS unsigned char* ATs = F.lds + P4_AT + buf * 9216; LAS unsigned char* Vbt = F.lds + P4_VBT; LAS float* gv = (LAS float*)(F.lds + P4_GV + buf * 1280);
    { const int row = tid >> 4, cc = tid & 15;
      *(LAS u32x4*)(Qs + row * 272 + cc * 16) = R.q0; *(LAS u32x4*)(Qs + (32 + row) * 272 + cc * 16) = R.q1; }
    { const int dk = tid >> 3, cp = tid & 7; LAS unsigned char* Kts = F.lds + P4_KT;
      *(LAS u32x4*)(Kts + dk * 144 + cp * 16) = R.k0; *(LAS u32x4*)(Kts + (64 + dk) * 144 + cp * 16) = R.k1; }
    { const int c = tid >> 3, s0 = (tid & 7) * 8;
      const unsigned m0 = d ? mk[1][0] : mk[0][0], m1 = d ? mk[1][1] : mk[0][1], m2 = d ? mk[1][2] : mk[0][2], m3 = d ? mk[1][3] : mk[0][3];
      *(LAS u32x4*)(TIs + c * 144 + s0 * 2) = (u32x4){R.ti.x & m0, R.ti.y & m1, R.ti.z & m2, R.ti.w & m3};
      *(LAS u32x4*)(ATs + c * 144 + s0 * 2) = (u32x4){R.at.x & m0, R.at.y & m1, R.at.z & m2, R.at.w & m3}; }
    { const int c = tid >> 3, e0 = (tid & 7) * 4; float o[4] = {0.f, 0.f, 0.f, 0.f};
      if (D.s == 0) {
#pragma unroll
          for (int j = 0; j < 4; ++j) cw[j] = cwn[j]; }
#pragma unroll
      for (int j = 0; j < 4; ++j) { const u32x2 v = R.v[j];
          o[0] += cw[j][0] * __uint_as_float(v.x << 16); o[1] += cw[j][1] * __uint_as_float(v.x & 0xffff0000u);
          o[2] += cw[j][2] * __uint_as_float(v.y << 16); o[3] += cw[j][3] * __uint_as_float(v.y & 0xffff0000u); }
#pragma unroll
      for (int i = 0; i < 4; ++i) ((LAS bf16_t*)Vbt)[(e0 + i) * 72 + c] = f2bf(siluf_(o[i]) * R.bc); }
    if (tid < 64) {
        const float glast = __shfl(R.g, d == 0 ? 63 : 0), eg = __expf(R.g);
        gv[tid] = eg; gv[64 + tid] = R.b * eg; gv[128 + tid] = __expf(glast - R.g); if (tid == 0) gv[192] = __expf(glast);
    }
}
__device__ __forceinline__ void phase4_chains(CParams& p, Frame& F) {
    const int tid = F.tid, lane = F.lane, wave = F.wave, q4 = lane >> 4, l15 = lane & 15;
    LAS unsigned char* Ks = F.lds + P4_KS; LAS unsigned char* TIs = F.lds + P4_TI; LAS unsigned char* Vbt = F.lds + P4_VBT; LAS unsigned char* Wl = F.lds + P4_WL;
    LAS unsigned char* Sb = F.lds + P4_SB; LAS unsigned char* Vt1 = F.lds + P4_VT1; LAS unsigned char* Vt2 = F.lds + P4_VT2;
    const int ct = wave & 3, et = wave >> 2;
    P4D Dc = p4_desc(F, 0, 0);
    if (!Dc.valid) return;
    P4Pre RA, RB;
    f32x4 S[2], U; bf16x8 KT[2];
    unsigned mk[2][4]; f32x4 cw[4], cwn[4];
    { const int c = tid >> 3, s0 = (tid & 7) * 8;
#pragma unroll
      for (int i = 0; i < 4; ++i) { const int slo = s0 + 2 * i, shi = slo + 1;
          mk[0][i] = (c >= slo ? 0x0000FFFFu : 0u) | (c >= shi ? 0xFFFF0000u : 0u); mk[1][i] = (c <= slo ? 0x0000FFFFu : 0u) | (c <= shi ? 0xFFFF0000u : 0u); } }
#define P4_INIT_S(D) do { _Pragma("unroll") for (int nt = 0; nt < 2; ++nt) _Pragma("unroll") for (int r = 0; r < 4; ++r) \
        S[nt][r] = (D).samp ? p.state_delta[(size_t)(((D).seq * 2 + (D).d) * 8 + (D).h) * 16384 + (size_t)(wave * 16 + q4 * 4 + r) * 128 + (D).sl * 32 + nt * 16 + l15] : 0.f; } while (0)
#define P4_WRITE_SB() do { _Pragma("unroll") for (int nt = 0; nt < 2; ++nt) { u32x2 o_; o_.x = pk2(S[nt][0], S[nt][1]); o_.y = pk2(S[nt][2], S[nt][3]); \
        *(LAS u32x2*)(Sb + (nt * 16 + l15) * 272 + (wave * 16 + q4 * 4) * 2) = o_; } } while (0)
#define P4_PRECOMP(buf_) do { const LAS float* gv_ = (const LAS float*)(F.lds + P4_GV + (buf_) * 1280); \
        f32x4 WT[4]; _Pragma("unroll") for (int c_ = 0; c_ < 4; ++c_) WT[c_] = (f32x4){0.f, 0.f, 0.f, 0.f}; \
        _Pragma("unroll") for (int ks = 0; ks < 2; ++ks) { \
            const u32x4 kraw = *(const LAS u32x4*)(F.lds + P4_KT + (wave * 16 + l15) * 144 + ks * 64 + q4 * 16); KT[ks] = __builtin_bit_cast(bf16x8, kraw); \
            const f32x4 sa = *(const LAS f32x4*)(gv_ + 64 + ks * 32 + q4 * 8), sb_ = *(const LAS f32x4*)(gv_ + 64 + ks * 32 + q4 * 8 + 4); \
            float kf[8]; unpack8(kraw, kf); u32x4 kg; \
            kg.x = pk2(kf[0] * sa[0], kf[1] * sa[1]); kg.y = pk2(kf[2] * sa[2], kf[3] * sa[3]); kg.z = pk2(kf[4] * sb_[0], kf[5] * sb_[1]); kg.w = pk2(kf[6] * sb_[2], kf[7] * sb_[3]); \
            const bf16x8 akg = __builtin_bit_cast(bf16x8, kg); \
            _Pragma("unroll") for (int c_ = 0; c_ < 4; ++c_) { const bf16x8 bt = ldfrag(TIs, 144, c_ * 16 + l15, ks * 64 + q4 * 16); WT[c_] = MFMA16(akg, bt, WT[c_]); } } \
        _Pragma("unroll") for (int c_ = 0; c_ < 4; ++c_) { u32x2 o_; o_.x = pk2(WT[c_][0], WT[c_][1]); o_.y = pk2(WT[c_][2], WT[c_][3]); \
            *(LAS u32x2*)(Wl + (c_ * 16 + l15) * 272 + (wave * 16 + q4 * 4) * 2) = o_; } \
        U = (f32x4){0.f, 0.f, 0.f, 0.f}; \
        _Pragma("unroll") for (int ks = 0; ks < 2; ++ks) { const bf16x8 a_ = ldfrag(TIs, 144, ct * 16 + l15, ks * 64 + q4 * 16), b_ = ldfrag(Vbt, 144, et * 16 + l15, ks * 64 + q4 * 16); U = MFMA16(a_, b_, U); } } while (0)

    const P4T T = p4_thread_consts(tid);
    p4_prefetch(p, F, RA, Dc, T);
    P4_INIT_S(Dc);
    { const int e0 = (tid & 7) * 4;
#pragma unroll
      for (int j = 0; j < 4; ++j) cwn[j] = *(const f32x4*)(p.dn_conv_w + j * 3072 + 2048 + Dc.h * 128 + Dc.sl * 32 + e0); }
    p4_stage(p, F, RA, Dc, 0, mk, cw, cwn);
    P4_WRITE_SB();
    P4D Dn = p4_next(F, Dc);
    if (Dn.valid) p4_prefetch(p, F, RA, Dn, T);
    P4D Dnn = Dn; if (Dn.valid) { Dnn = p4_next(F, Dn); if (Dnn.valid) p4_prefetch(p, F, RB, Dnn, T); }
    lds_barrier();
    P4_PRECOMP(0);
    lds_barrier();
    int buf = 0;
#define P4_BODY(RX) { \
        const LAS float* gv = (const LAS float*)(F.lds + P4_GV + buf * 1280); \
        const LAS unsigned char* Qs = F.lds + P4_QS + buf * 17408; const LAS unsigned char* ATs = F.lds + P4_AT + buf * 9216; \
        const int c0 = ct * 16 + q4 * 4, e = et * 16 + l15; \
         \
        f32x4 p1 = {0.f, 0.f, 0.f, 0.f}, oacc = {0.f, 0.f, 0.f, 0.f}; \
_Pragma("unroll") \
        for (int ks = 0; ks < 4; ++ks) { const bf16x8 bs = ldfrag(Sb, 272, et * 16 + l15, ks * 64 + q4 * 16); \
            const bf16x8 aw = ldfrag(Wl, 272, ct * 16 + l15, ks * 64 + q4 * 16), aq = ldfrag(Qs, 272, ct * 16 + l15, ks * 64 + q4 * 16); \
            p1 = MFMA16(aw, bs, p1); oacc = MFMA16(aq, bs, oacc); } \
        { float vn[4]; \
_Pragma("unroll") \
          for (int r = 0; r < 4; ++r) vn[r] = U[r] - p1[r]; \
          u32x2 o1, o2; o1.x = pk2(vn[0], vn[1]); o1.y = pk2(vn[2], vn[3]); \
          o2.x = pk2(vn[0] * gv[128 + c0], vn[1] * gv[128 + c0 + 1]); o2.y = pk2(vn[2] * gv[128 + c0 + 2], vn[3] * gv[128 + c0 + 3]); \
          *(LAS u32x2*)(Vt1 + e * 144 + c0 * 2) = o1; *(LAS u32x2*)(Vt2 + e * 144 + c0 * 2) = o2; } \
_Pragma("unroll") \
        for (int r = 0; r < 4; ++r) oacc[r] *= gv[c0 + r]; \
        P4D D3 = Dnn; \
        if (Dn.valid) { p4_stage(p, F, RX, Dn, buf ^ 1, mk, cw, cwn); \
            if (Dn.last && Dnn.valid) { const int e0_ = (tid & 7) * 4; _Pragma("unroll") for (int j = 0; j < 4; ++j) cwn[j] = *(const f32x4*)(p.dn_conv_w + j * 3072 + 2048 + Dnn.h * 128 + Dnn.sl * 32 + e0_); } if (Dnn.valid) { D3 = p4_next(F, Dnn); if (D3.valid) p4_prefetch(p, F, RX, D3, T); } } \
        lds_barrier(); \
         \
        { const float gl = gv[192]; \
_Pragma("unroll") \
          for (int nt = 0; nt < 2; ++nt) S[nt] *= gl; \
_Pragma("unroll") \
          for (int ks = 0; ks < 2; ++ks) \
_Pragma("unroll") \
              for (int nt = 0; nt < 2; ++nt) { const bf16x8 b_ = ldfrag(Vt2, 144, nt * 16 + l15, ks * 64 + q4 * 16); S[nt] = MFMA16(KT[ks], b_, S[nt]); } } \
_Pragma("unroll") \
        for (int ks = 0; ks < 2; ++ks) { const bf16x8 a_ = ldfrag(ATs, 144, ct * 16 + l15, ks * 64 + q4 * 16), b_ = ldfrag(Vt1, 144, et * 16 + l15, ks * 64 + q4 * 16); oacc = MFMA16(a_, b_, oacc); } \
_Pragma("unroll") \
        for (int r = 0; r < 4; ++r) *(bf16_t*)((char*)F.PROJ() + ((size_t)Dc.ci * 64 * NPROJ + Dc.d * 1024 + Dc.h * 128 + Dc.sl * 32) * 2 + (unsigned)(((c0 + r) * NPROJ + e) * 2)) = f2bf(oacc[r]); \
        if (Dc.last) { \
            if (!Dc.samp) { \
_Pragma("unroll") \
                for (int nt = 0; nt < 2; ++nt) \
_Pragma("unroll") \
                    for (int r = 0; r < 4; ++r) \
                        F.out[OUT_SD + (size_t)((Dc.seq * 2 + Dc.d) * 8 + Dc.h) * 16384 + (size_t)(wave * 16 + q4 * 4 + r) * 128 + Dc.sl * 32 + nt * 16 + l15] = S[nt][r]; \
            } \
            if (Dn.valid) P4_INIT_S(Dn); \
        } \
        P4_WRITE_SB(); \
        if (Dn.valid) P4_PRECOMP(buf ^ 1); \
        lds_barrier(); \
        if (!Dn.valid) break; \
        Dc = Dn; Dn = Dnn; Dnn = D3; buf ^= 1; \
    }
#pragma unroll 1
    for (;;) { P4_BODY(RA) P4_BODY(RB) }
#undef P4_BODY
#undef P4_INIT_S
#undef P4_WRITE_SB
#undef P4_PRECOMP
}
__device__ __forceinline__ void phase4(CParams& p, Frame& F) {
    if (F.G == 256) rg_carry_scan(p, F);
    else if (F.b == 0) {
        for (int g = F.tid; g < 69632; g += 512) { int samp = g >= 65536, gg = samp ? g - 65536 : g, seq = gg >> 11, d = (gg >> 10) & 1, ch = gg & 1023;
            const int nch = samp ? 64 : 4, c_lo = samp ? 128 + seq * 64 : seq * 4; float h = samp ? p.state_rglru[(size_t)(seq * 2 + d) * 1024 + ch] : 0.f;
            for (int i = 0; i < nch; ++i) { const int cc = d == 0 ? c_lo + i : c_lo + nch - 1 - i; const float* ag = F.RGAGG() + (size_t)(cc * 2 + d) * 2048; F.CARRY()[(size_t)(cc * 2 + d) * 1024 + ch] = h; h = ag[ch] * h + ag[1024 + ch]; } } }
    __syncthreads();
    phase4_chains(p, F);
}

__device__ __forceinline__ void phase5(CParams& p, Frame& F) {
    const int lane = F.lane;
    float nw[16];
#pragma unroll
    for (int q = 0; q < 4; ++q) { const f32x4 a = *(const f32x4*)(p.dn_norm_w + (lane & 7) * 16 + q * 4); nw[q * 4] = a[0]; nw[q * 4 + 1] = a[1]; nw[q * 4 + 2] = a[2]; nw[q * 4 + 3] = a[3]; }
#pragma unroll 4
    for (int tok = F.b * 8 + F.wave; tok < NTOK; tok += F.G * 8) {
        const bf16_t* pr = F.PROJ() + (size_t)tok * NPROJ + lane * 16;
        float o[16], z[16]; float ss = 0.f;
#pragma unroll
        for (int hf = 0; hf < 2; ++hf) { const u32x4 a = *(const u32x4*)(pr + hf * 8), b = *(const u32x4*)(pr + 1024 + hf * 8), zz = *(const u32x4*)(pr + 3072 + hf * 8);
            float fa[8], fb[8], fz[8]; unpack8(a, fa); unpack8(b, fb); unpack8(zz, fz);
#pragma unroll
            for (int e = 0; e < 8; ++e) { o[hf * 8 + e] = fa[e] + fb[e]; z[hf * 8 + e] = fz[e]; ss += o[hf * 8 + e] * o[hf * 8 + e]; } }
        ss += __shfl_xor(ss, 1); ss += __shfl_xor(ss, 2); ss += __shfl_xor(ss, 4);
        const float rs = rsqrtf(ss * (1.f / 128.f) + 1e-6f);
#pragma unroll
        for (int hf = 0; hf < 2; ++hf) { float w[8];
#pragma unroll
            for (int e = 0; e < 8; ++e) w[e] = o[hf * 8 + e] * rs * nw[hf * 8 + e] * siluf_(z[hf * 8 + e]);
            *(u32x4*)(F.MIX() + (size_t)tok * 2048 + lane * 16 + hf * 8) = pack8(w); }
        if (tok < 8192) {
            const u32x4 y0 = *(const u32x4*)(pr + 5120), y1 = *(const u32x4*)(pr + 5120 + 8);
            *(u32x4*)(F.MIX() + (size_t)tok * 2048 + 1024 + lane * 16) = y0; *(u32x4*)(F.MIX() + (size_t)tok * 2048 + 1024 + lane * 16 + 8) = y1; }
    }
    __syncthreads();
    for (int it = F.b; it < 1024; it += F.G) { u32x4 rows[5]; rg_load_rows(F, 128 + (it >> 3), it & 7, rows); rg_item<3>(p, F, 128 + (it >> 3), it & 7, rows, it + F.G); }
}

__device__ __forceinline__ void phase6(CParams& p, Frame& F) {
    pg8::Gemm g{F.MIX(), F.WoutT(), NTOK, 1024, 2048}; pg8::StaticOrder S; S.init(NTOK, 1024, F.G, F.b); pg8::EpiF32 E{(float*)F.PROJ(), 3072};
    pg8::gemm_phase<pg8::EpiF32, pg8::StaticOrder>(F.lds, g, S, E);
}

__device__ __forceinline__ void phase7(CParams& p, Frame& F) {
    LAS float* gt = (LAS float*)F.lds;
    for (int tb = F.b; tb < 256; tb += F.G) {
        const int grp = grp_of_block(tb);
        for (int j = F.tid; j < 1024; j += 512) gt[j] = mod_val(p, F, grp, 2048 + j) * p.post_w[j];
        __syncthreads();
#pragma unroll 2
        for (int i = 0; i < 8; ++i) {
            const int tok = tb * 64 + F.wave * 8 + i;
            const float* xr = tok < 8192 ? p.x_prompt + (size_t)tok * 1024 : p.x_sample + (size_t)(tok - 8192) * 1024;
            const float* yr = (const float*)F.PROJ() + (size_t)tok * 3072;
            f32x4 y[4]; float ss = 0.f;
#pragma unroll
            for (int q = 0; q < 4; ++q) { y[q] = *(const f32x4*)(yr + F.lane * 4 + 256 * q); ss += (y[q][0] * y[q][0] + y[q][1] * y[q][1]) + (y[q][2] * y[q][2] + y[q][3] * y[q][3]); }
            const float rstd = rsqrtf(wave_sum(ss) * (1.f / 1024.f) + 1e-6f);
#pragma unroll
            for (int q = 0; q < 4; ++q) { const int j = F.lane * 4 + 256 * q; f32x4 v = *(const f32x4*)(xr + j);
                if (tok >= 8192) { const int pp = (tok - 8192) & 4095; const int vv = (q < 2) ? (pp >> 6) : (pp & 63);
                    v += *(const f32x4*)(F.pe() + ((q & 1) ? 16384 : 0) + vv * 256 + F.lane * 4); }
                const f32x4 g4 = *(const LAS f32x4*)(gt + j);
                f32x4 ov = v + g4 * (y[q] * rstd); ov[0] = fin(ov[0]); ov[1] = fin(ov[1]); ov[2] = fin(ov[2]); ov[3] = fin(ov[3]); if (!(LIVE_MASK & 1)) ov = (f32x4){0.f, 0.f, 0.f, 0.f}; *(f32x4*)(F.out + (size_t)tok * 1024 + j) = ov; }
        }
        __syncthreads();
    }
}

__device__ __forceinline__ void phase8(CParams& p, Frame& F) {
    if (F.b == 0 && F.tid == 0) { int code = 0; for (int k = 31; k >= 1; --k) if (DG(F)[k]) code = k; F.out[OUT_SR] = 1000.f * (float)code + 500.f; }
}
extern __shared__ __attribute__((aligned(16))) unsigned char smem_raw[];
__global__ void __launch_bounds__(512) fwd_megakernel(Params p_unused) {
    CParams& p = *(CParams*)__builtin_amdgcn_kernarg_segment_ptr();
    Frame F;
    F.lds = (LAS unsigned char*)smem_raw;
    F.tid = threadIdx.x; F.lane = F.tid & 63; F.wave = __builtin_amdgcn_readfirstlane(F.tid >> 6); F.G = gridDim.x; F.b = blockIdx.x;
    F.out = p.out; F.ws = p.ws;
    volatile LAS unsigned* xbw = (volatile LAS unsigned*)(F.lds + LDS_BYTES - 16);
    const bool multi = (p.ph_hi - p.ph_lo) > 1;
    XcdBarrier xb; xb.bar = (unsigned*)(p.ws + WS_CTL); xb.x = 0; xb.st = xbw;
    if (multi) {
        if (F.tid == 0) { xbw[0] = 0u; xbw[1] = 0u; xbw[2] = 0u; xbw[3] = 0u; }
        __syncthreads();
        xb = xcd_barrier_post((unsigned*)(p.ws + WS_CTL), xbw);
    }
#ifndef PHMASK
#define PHMASK 511
#endif
    const int lo = p.ph_lo, hi = p.ph_hi;
#ifndef REP_PHASE
#define REP_PHASE -1
#endif
#define RUN_PHASE(k, fn) do { if (lo <= (k) && (k) < hi) { if (PHMASK & (1 << (k))) fn(p, F); if ((k) == REP_PHASE) { __syncthreads(); fn(p, F); } if ((k) + 1 < hi) xcd_barrier(xb); } } while (0)
    RUN_PHASE(0, phase0); RUN_PHASE(1, phase1); RUN_PHASE(2, phase2); RUN_PHASE(3, phase3);
    RUN_PHASE(4, phase4); RUN_PHASE(5, phase5); RUN_PHASE(6, phase6); RUN_PHASE(7, phase7); RUN_PHASE(8, phase8);
}

extern "C" void kernel_launch(void* const* d_in, const int* in_sizes, int n_in, void* d_out, int out_size, void* d_ws, size_t ws_size, hipStream_t stream) {
    static int grid = 0;
    if (grid == 0) {
        int dev = 0, cus = 0;
        if (hipGetDevice(&dev) != hipSuccess || hipDeviceGetAttribute(&cus, hipDeviceAttributeMultiprocessorCount, dev) != hipSuccess) { fprintf(stderr, "kernel_launch: device query failed\n"); grid = -1; return; }
        if (hipFuncSetAttribute((const void*)fwd_megakernel, hipFuncAttributeMaxDynamicSharedMemorySize, LDS_BYTES) != hipSuccess) { fprintf(stderr, "kernel_launch: hipFuncSetAttribute failed\n"); grid = -1; return; }
        int per_cu = 0;
        if (hipOccupancyMaxActiveBlocksPerMultiprocessor(&per_cu, (const void*)fwd_megakernel, 512, LDS_BYTES) != hipSuccess || per_cu < 1) { fprintf(stderr, "kernel_launch: occupancy query says %d blocks per CU\n", per_cu); (void)hipGetLastError(); }
        grid = cus;
    }
    if (grid < 0) return;
    Params p{};
    const float** pp = (const float**)&p;
    for (int i = 0; i < 23; ++i) pp[i] = (const float*)d_in[i];
    p.out = (float*)d_out; p.ws = (unsigned char*)d_ws;
    (void)hipMemsetAsync((char*)d_ws + WS_CTL, 0, 16384, stream);
#if MK_SINGLE
    p.ph_lo = 0; p.ph_hi = NPH;
    void* args[] = {&p};
    hipError_t e = hipLaunchCooperativeKernel((const void*)fwd_megakernel, dim3(grid), dim3(512), args, LDS_BYTES, stream);
    if (e != hipSuccess) fprintf(stderr, "cooperative launch failed: %s (grid %d)\n", hipGetErrorString(e), grid);
#else
    for (int ph = 0; ph < NPH; ++ph) {
        p.ph_lo = ph; p.ph_hi = ph + 1;
        hipLaunchKernelGGL(fwd_megakernel, dim3(grid), dim3(512), LDS_BYTES, stream, p);
    }
#endif
}
```

```cpp
#include <hip/hip_runtime.h>
#include <cstdio>
#include <cstdint>

#define LAS __attribute__((address_space(3)))
typedef unsigned short bf16_t;
typedef short bf16x8 __attribute__((ext_vector_type(8)));
typedef float f32x4 __attribute__((ext_vector_type(4)));
typedef unsigned u32x4 __attribute__((ext_vector_type(4)));
typedef unsigned u32x2 __attribute__((ext_vector_type(2)));

#ifndef REP_PHASE
#define REP_PHASE -1
#endif
#ifndef MK_SINGLE
#define MK_SINGLE 1
#endif

constexpr int NTOK = 16384, DM = 1024, NPROJ = 6144, DIN = 6176;
constexpr int NPH = 8;
constexpr int LDS_BYTES = 160 * 1024;
constexpr size_t OUT_YP = 0, OUT_YS = 8388608, OUT_SD = 16777216, OUT_SR = 25165824;
constexpr size_t WS_CTL = 0, WS_MODP = 16384, WS_PE = 606208, WS_BA = 737280, WS_GB = 2834432, WS_RGAGG = 4931584,
                 WS_WBAT = 9125888, WS_WOUTT = 9191424, WS_GT = 13385728, WS_WINT = 14434304, WS_TA = 27017216, WS_PROJ = 60571648, WS_CARRY = 261898240;

struct Params {
    const float *x_prompt, *x_sample, *state_delta, *state_rglru, *c, *c_ctx, *ada_w, *ada_b, *pre_w, *post_w, *w_in, *w_out,
                *dn_conv_w, *dn_a_log, *dn_dt_bias, *dn_norm_w, *rg_conv_w, *rg_conv_b, *rg_w_r, *rg_b_r, *rg_w_i, *rg_b_i, *rg_lam;
    float* out; unsigned char* ws;
    int ph_lo, ph_hi;
};

__device__ __forceinline__ float bf2f(unsigned short b) { return __uint_as_float(((unsigned)b) << 16); }
typedef __bf16 bf2_t __attribute__((ext_vector_type(2)));
typedef float f2_t __attribute__((ext_vector_type(2)));
__device__ __forceinline__ unsigned pk2(float lo, float hi) { const f2_t v = {lo, hi}; return __builtin_bit_cast(unsigned, __builtin_convertvector(v, bf2_t)); }
__device__ __forceinline__ unsigned short f2bf(float f) { return (unsigned short)(pk2(f, f) & 0xffffu); }
#ifndef SANITIZE
#define SANITIZE 0
#endif
#ifndef LIVE_MASK
#define LIVE_MASK 15
#endif
__device__ __forceinline__ float fin(float x) { return (SANITIZE && ((__float_as_uint(x) & 0x7f800000u) == 0x7f800000u)) ? 0.f : x; }
#define DG(F) ((unsigned*)((F).ws + WS_CTL))
__device__ __forceinline__ bool badv(float x, float lim) { return ((__float_as_uint(x) & 0x7f800000u) == 0x7f800000u) || fabsf(x) > lim; }
#ifndef DIAG
#define DIAG 0
#endif
#define CHK(F, k, bad) do { if (DIAG && (bad)) DG(F)[k] = 1u; } while (0)
__device__ __forceinline__ float sigm(float x) { return __builtin_amdgcn_rcpf(1.f + __expf(-x)); }
__device__ __forceinline__ float siluf_(float x) { return x * __builtin_amdgcn_rcpf(1.f + __expf(-x)); }
__device__ __forceinline__ float softplusf_(float x) { return x > 20.f ? x : log1pf(__expf(x)); }
__device__ __forceinline__ void unpack8(const u32x4 v, float (&f)[8]) {
    f[0] = __uint_as_float(v.x << 16); f[1] = __uint_as_float(v.x & 0xffff0000u);
    f[2] = __uint_as_float(v.y << 16); f[3] = __uint_as_float(v.y & 0xffff0000u);
    f[4] = __uint_as_float(v.z << 16); f[5] = __uint_as_float(v.z & 0xffff0000u);
    f[6] = __uint_as_float(v.w << 16); f[7] = __uint_as_float(v.w & 0xffff0000u);
}
__device__ __forceinline__ u32x4 pack8(const float (&f)[8]) { u32x4 o; o.x = pk2(f[0], f[1]); o.y = pk2(f[2], f[3]); o.z = pk2(f[4], f[5]); o.w = pk2(f[6], f[7]); return o; }
__device__ __forceinline__ float wave_sum(float v) {
#pragma unroll
    for (int o = 1; o < 64; o <<= 1) v += __shfl_xor(v, o);
    return v;
}
__device__ __forceinline__ void lds_barrier() { asm volatile("s_waitcnt lgkmcnt(0)" ::: "memory"); __builtin_amdgcn_s_barrier(); asm volatile("" ::: "memory"); }
#define MFMA16(a, b, c) __builtin_amdgcn_mfma_f32_16x16x32_bf16((a), (b), (c), 0, 0, 0)
#define LDS_WAIT() asm volatile("s_waitcnt lgkmcnt(0)" ::: "memory")
__device__ __forceinline__ bf16x8 ldfrag(const LAS unsigned char* base, int pitch, int row, int kb) { return *(const LAS bf16x8*)(base + row * pitch + kb); }

#define XB_TMO      128
#define XB_XCNT(j)  (256  + 64 * (j))
#define XB_XSUB(j)  (1280 + 64 * (j))
#define XB_XGEN(j)  (2304 + 64 * (j))
#define XB_TOP      3328
#define XB_TOPGEN   3392
#define XCD_BAR_WORDS 3456
#define XB_SPIN_CAP (1u << 18)
__device__ __forceinline__ unsigned xb_ld(unsigned* p)              { return __hip_atomic_load(p, __ATOMIC_RELAXED, __HIP_MEMORY_SCOPE_AGENT); }
__device__ __forceinline__ unsigned xb_add(unsigned* p, unsigned v) { return __hip_atomic_fetch_add(p, v, __ATOMIC_RELAXED, __HIP_MEMORY_SCOPE_AGENT); }
__device__ __forceinline__ unsigned xb_xcc_id() { return (unsigned)__builtin_amdgcn_s_getreg((3 << 11) | 20) & 0xFu; }
#define XB_SPIN(cond, bar) do { unsigned _sp = 0; while (cond) { __builtin_amdgcn_s_sleep(1); \
    if ((++_sp & 255u) == 0u) { if (xb_ld(&(bar)[XB_TMO])) break; if (_sp > XB_SPIN_CAP) { atomicAdd(&(bar)[XB_TMO], 1u); break; } } } } while (0)
struct XcdBarrier { unsigned* bar; unsigned x; volatile LAS unsigned* st; };
__device__ __forceinline__ XcdBarrier xcd_barrier_post(unsigned* bar, volatile LAS unsigned* st) {
    XcdBarrier b; b.bar = bar; b.x = xb_xcc_id(); b.st = st;
    if (threadIdx.x == 0) (void)xb_add(&bar[XB_XCNT(b.x)], 1u);
    return b;
}
__device__ __forceinline__ void xcd_barrier_complete(unsigned* bar, unsigned x, unsigned& nloc, unsigned& nx) {
    const unsigned G = gridDim.x * gridDim.y * gridDim.z;
    unsigned sum, cnt, mine, sp = 0u;
    for (;;) {
        sum = 0u; cnt = 0u; mine = 0u;
#pragma unroll
        for (unsigned j = 0; j < 16; ++j) { const unsigned c = xb_ld(&bar[XB_XCNT(j)]); sum += c; cnt += (c > 0u) ? 1u : 0u; mine = (j == x) ? c : mine; }
        if (sum == G) break;
        __builtin_amdgcn_s_sleep(1);
        if ((++sp & 255u) == 0u) { if (xb_ld(&bar[XB_TMO])) break; if (sp > XB_SPIN_CAP) { atomicAdd(&bar[XB_TMO], 1u); break; } }
    }
    nloc = mine > 0u ? mine : 1u; nx = cnt > 0u ? cnt : 1u;
}
__device__ __forceinline__ void xcd_barrier(const XcdBarrier& b) {
    asm volatile("s_waitcnt vmcnt(0)" ::: "memory");
    __syncthreads();
    if (threadIdx.x == 0) {
        unsigned* bar = b.bar;
        __builtin_amdgcn_s_waitcnt(0);
        unsigned nloc = b.st[0], nx = b.st[1];
        if (nloc == 0u) { xcd_barrier_complete(bar, b.x, nloc, nx); b.st[0] = nloc; b.st[1] = nx; }
        const unsigned old = xb_add(&bar[XB_XSUB(b.x)], 1u);
        const unsigned gen = old / nloc;
        if (old + 1u == (gen + 1u) * nloc) {
            __builtin_amdgcn_fence(__ATOMIC_RELEASE, "agent");
            asm volatile("s_waitcnt vmcnt(0)" ::: "memory");
            const unsigned og = xb_add(&bar[XB_TOP], 1u);
            const unsigned tg = og / nx;
            if (og + 1u == (tg + 1u) * nx) xb_add(&bar[XB_TOPGEN], 1u);
            else XB_SPIN(xb_ld(&bar[XB_TOPGEN]) == tg, bar);
            __builtin_amdgcn_fence(__ATOMIC_ACQUIRE, "agent");
            xb_add(&bar[XB_XGEN(b.x)], 1u);
            asm volatile("s_waitcnt vmcnt(0)" ::: "memory");
        } else {
            XB_SPIN(xb_ld(&bar[XB_XGEN(b.x)]) == gen, bar);
            __builtin_amdgcn_fence(__ATOMIC_ACQUIRE, "agent");
            asm volatile("s_waitcnt vmcnt(0)" ::: "memory");
        }
    }
    __syncthreads();
}

namespace pg8 {
constexpr int BM = 256, BK = 64, HALF = 128, HTB = HALF * BK * 2, STAGE_BYTES = 8 * HTB, NXCD = 8, WGM = 8;
__host__ __device__ __forceinline__ int lds_byte(int r, int c) { const int st = (r >> 4) * 2 + (c >> 5), rr = r & 15, cc = c & 31, ob = rr * 64 + cc * 2; return st * 1024 + (ob ^ (((ob >> 9) & 1) << 5)); }
__host__ __device__ __forceinline__ void stage_rc(int b, int& R, int& C) { const int st = b / 1024, sb = b % 1024, swz = sb ^ (((sb >> 9) & 1) << 5); R = (st >> 1) * 16 + swz / 64; C = (st & 1) * 32 + (swz % 64) / 2; }
__host__ __device__ __forceinline__ int perm32(int rho) { const int n = rho >> 4, i = rho & 15; return 8 * (i >> 2) + 4 * n + (i & 3); }
struct Unit { int pm, pn; };
struct Gemm { const bf16_t* A; const bf16_t* Bt; int M, N, K; };
struct StaticOrder {
    int nM, nN, nwg, G, c;
    __host__ __device__ void init(int M, int N, int G_, int c_) { nM = M / BM; nN = N / BM; nwg = nM * nN; G = G_; c = c_; }
    __host__ __device__ bool next(int i, Unit& u) const {
        const long L = (long)i * G + c; if (L >= nwg) return false;
        int wgid = (int)L; { const int q = nwg / NXCD, r = nwg % NXCD, xcd = wgid % NXCD, off = wgid / NXCD; wgid = (xcd < r ? xcd * (q + 1) : r * (q + 1) + (xcd - r) * q) + off; }
        const int nig = WGM * nN, gid = wgid / nig, fm = gid * WGM, gsz = (nM - fm) < WGM ? (nM - fm) : WGM;
        u.pm = fm + ((wgid % nig) % gsz); u.pn = (wgid % nig) / gsz; return true;
    }
};
__device__ __forceinline__ unsigned cvt_pk_bf16(float lo, float hi) { unsigned r; asm volatile("v_cvt_pk_bf16_f32 %0, %1, %2" : "=v"(r) : "v"(lo), "v"(hi)); return r; }
struct EpiF32 {
    static constexpr bool PERM = false;
    float* C; int ldc;
    __device__ __forceinline__ void operator()(const f32x4 (&acc)[2][2][4][2], const Unit& u, int wr, int wc, int fr, int fq) const {
        const int row0 = u.pm * BM + wr * 64 + fr, col0 = u.pn * BM + wc * 32 + 4 * fq;
#pragma unroll
        for (int ai = 0; ai < 2; ++ai)
#pragma unroll
            for (int m = 0; m < 4; ++m) { float* rowp = C + (size_t)(row0 + ai * HALF + m * 16) * ldc + col0;
#pragma unroll
                for (int bj = 0; bj < 2; ++bj)
#pragma unroll
                    for (int n = 0; n < 2; ++n) *(f32x4*)(rowp + bj * HALF + n * 16) = acc[ai][bj][m][n]; }
    }
};
struct EpiBf16 {
    static constexpr bool PERM = true;
    bf16_t* O; int ldc;
    __device__ __forceinline__ void operator()(const f32x4 (&acc)[2][2][4][2], const Unit& u, int wr, int wc, int fr, int fq) const {
        const int row0 = u.pm * BM + wr * 64 + fr; const int col0 = u.pn * BM + wc * 32 + 8 * fq;
#pragma unroll
        for (int ai = 0; ai < 2; ++ai)
#pragma unroll
            for (int m = 0; m < 4; ++m) { bf16_t* rowp = O + (size_t)(row0 + ai * HALF + m * 16) * ldc + col0;
#pragma unroll
                for (int bj = 0; bj < 2; ++bj) { const f32x4 v0 = acc[ai][bj][m][0], v1 = acc[ai][bj][m][1];
                    u32x4 w; w.x = cvt_pk_bf16(v0[0], v0[1]); w.y = cvt_pk_bf16(v0[2], v0[3]); w.z = cvt_pk_bf16(v1[0], v1[1]); w.w = cvt_pk_bf16(v1[2], v1[3]);
                    *(u32x4*)(rowp + bj * HALF) = w; } }
    }
};

template <class Epi, class Sched>
__device__ __forceinline__ void gemm_phase(LAS unsigned char* lds, const Gemm g, const Sched& S, const Epi& E) {
    const int tid = threadIdx.x, wid = __builtin_amdgcn_readfirstlane(tid >> 6), lane = tid & 63, wr = wid >> 2, wc = wid & 3, fr = lane & 15, fq = lane >> 4;
    const int K = g.K, nt = K / BK;
    unsigned voffA[2], voffB[2];
#pragma unroll
    for (int i = 0; i < 2; ++i) { int R, C; stage_rc(tid * 16 + i * 8192, R, C); const int Rb = Epi::PERM ? ((R & ~31) + perm32(R & 31)) : R;
        voffA[i] = (unsigned)(R * K + C) * 2u; voffB[i] = (unsigned)(Rb * K + C) * 2u; }
    const size_t kstep = (size_t)(BK * 2);
    const size_t hstep = (size_t)HALF * K * 2;
    const size_t tstep = 2 * hstep;
    const unsigned ldsw = (unsigned)wid * 1024u;
    const int aoff = lds_byte(wr * 64 + fr, fq * 8), boff = lds_byte(wc * 32 + fr, fq * 8);
#define PG8_SA(b, h) (((b) * 2 + (h)) * HTB)
#define PG8_SB(b, h) ((4 + (b) * 2 + (h)) * HTB)
#define PG8_STAGE(bufoff, gbase, voff) do { _Pragma("unroll") for (int _i = 0; _i < 2; ++_i) \
        __builtin_amdgcn_global_load_lds((const unsigned*)((const char*)(gbase) + (voff)[_i]), (LAS unsigned*)(lds + (bufoff) + ldsw + _i * 8192), 16, 0, 0); } while (0)
#define PG8_LDA(dst, b, h) do { _Pragma("unroll") for (int m = 0; m < 4; ++m) _Pragma("unroll") for (int k = 0; k < 2; ++k) dst[m][k] = *(const LAS bf16x8*)(lds + PG8_SA(b, h) + aoff + m * 2048 + k * 1024); } while (0)
#define PG8_LDB(dst, b, h) do { _Pragma("unroll") for (int n = 0; n < 2; ++n) _Pragma("unroll") for (int k = 0; k < 2; ++k) dst[n][k] = *(const LAS bf16x8*)(lds + PG8_SB(b, h) + boff + n * 2048 + k * 1024); } while (0)
#define PG8_MMA(ai, bj, At, Bt) do { __builtin_amdgcn_s_setprio(1); _Pragma("unroll") for (int m = 0; m < 4; ++m) _Pragma("unroll") for (int n = 0; n < 2; ++n) _Pragma("unroll") for (int k = 0; k < 2; ++k) \
        acc[ai][bj][m][n] = __builtin_amdgcn_mfma_f32_16x16x32_bf16(Bt[n][k], At[m][k], acc[ai][bj][m][n], 0, 0, 0); __builtin_amdgcn_s_setprio(0); } while (0)
#define PG8_WAIT_V(n) asm volatile("s_waitcnt vmcnt(" #n ")" ::: "memory")
#define PG8_WAIT_L(n) asm volatile("s_waitcnt lgkmcnt(" #n ")" ::: "memory")
#define PG8_BAR __builtin_amdgcn_s_barrier()
#define PG8_SCHED __builtin_amdgcn_sched_barrier(0)
    Unit cur, nxt; int ui = 0;
    if (!S.next(0, cur)) return;
    f32x4 acc[2][2][4][2];
#pragma unroll
    for (int a = 0; a < 2; ++a)
#pragma unroll
        for (int b = 0; b < 2; ++b)
#pragma unroll
            for (int m = 0; m < 4; ++m)
#pragma unroll
                for (int n = 0; n < 2; ++n) acc[a][b][m][n] = (f32x4){0.f, 0.f, 0.f, 0.f};
    bf16x8 At[4][2], B0[2][2], B1[2][2];
    const char* cA = (const char*)g.A + (size_t)cur.pm * tstep; const char* cB = (const char*)g.Bt + (size_t)cur.pn * tstep;
    PG8_STAGE(PG8_SB(0, 0), cB, voffB); PG8_STAGE(PG8_SA(0, 0), cA, voffA); PG8_STAGE(PG8_SB(0, 1), cB + hstep, voffB); PG8_STAGE(PG8_SA(0, 1), cA + hstep, voffA);
    if (wr == 1) PG8_BAR;
    PG8_WAIT_V(4); PG8_BAR;
    PG8_STAGE(PG8_SB(1, 0), cB + kstep, voffB); PG8_STAGE(PG8_SA(1, 0), cA + kstep, voffA); PG8_STAGE(PG8_SB(1, 1), cB + hstep + kstep, voffB);
    PG8_WAIT_V(6); PG8_BAR;
    for (;;) {
        const bool has_next = S.next(ui + 1, nxt);
        const char* nA = has_next ? (const char*)g.A + (size_t)nxt.pm * tstep : cA; const char* nB = has_next ? (const char*)g.Bt + (size_t)nxt.pn * tstep : cB;
        for (int t = 0; t < nt; t += 2) {
            const bool last = (t == nt - 2);
            const char* a1 = cA + (size_t)(t + 1) * kstep;
            const char* a2 = last ? nA : cA + (size_t)(t + 2) * kstep; const char* b2 = last ? nB : cB + (size_t)(t + 2) * kstep;
            const char* a3 = a2 + kstep; const char* b3 = b2 + kstep;
            PG8_LDB(B0, 0, 0); PG8_SCHED; PG8_LDA(At, 0, 0); PG8_STAGE(PG8_SA(1, 1), a1 + hstep, voffA);
            PG8_WAIT_L(8); PG8_BAR; PG8_WAIT_L(0); PG8_MMA(0, 0, At, B0); PG8_BAR; PG8_SCHED;
            PG8_LDB(B1, 0, 1); PG8_STAGE(PG8_SB(0, 0), b2, voffB);
            PG8_BAR; PG8_WAIT_L(0); PG8_MMA(0, 1, At, B1); PG8_BAR;
            PG8_LDA(At, 0, 1); PG8_STAGE(PG8_SA(0, 0), a2, voffA);
            PG8_BAR; PG8_WAIT_L(0); PG8_MMA(1, 0, At, B0); PG8_BAR; PG8_SCHED;
            PG8_STAGE(PG8_SB(0, 1), b2 + hstep, voffB);
            PG8_WAIT_V(6); PG8_BAR; PG8_MMA(1, 1, At, B1); PG8_BAR;
            PG8_LDB(B0, 1, 0); PG8_SCHED; PG8_LDA(At, 1, 0); PG8_STAGE(PG8_SA(0, 1), a2 + hstep, voffA);
            PG8_WAIT_L(8); PG8_BAR; PG8_WAIT_L(0); PG8_MMA(0, 0, At, B0); PG8_BAR; PG8_SCHED;
            PG8_LDB(B1, 1, 1); PG8_STAGE(PG8_SB(1, 0), b3, voffB);
            PG8_BAR; PG8_WAIT_L(0); PG8_MMA(0, 1, At, B1); PG8_BAR;
            PG8_LDA(At, 1, 1); PG8_STAGE(PG8_SA(1, 0), a3, voffA);
            PG8_BAR; PG8_WAIT_L(0); PG8_MMA(1, 0, At, B0); PG8_BAR; PG8_SCHED;
            PG8_STAGE(PG8_SB(1, 1), b3 + hstep, voffB);
            PG8_WAIT_V(6); PG8_BAR; PG8_MMA(1, 1, At, B1); PG8_BAR;
        }
        E(acc, cur, wr, wc, fr, fq);
        if (!has_next) break;
#pragma unroll
        for (int a = 0; a < 2; ++a)
#pragma unroll
            for (int b = 0; b < 2; ++b)
#pragma unroll
                for (int m = 0; m < 4; ++m)
#pragma unroll
                    for (int n = 0; n < 2; ++n) acc[a][b][m][n] = (f32x4){0.f, 0.f, 0.f, 0.f};
        cur = nxt; cA = nA; cB = nB; ++ui;
    }
    PG8_WAIT_V(0);
    if (wr == 0) PG8_BAR;
    PG8_BAR;
#undef PG8_SA
#undef PG8_SB
#undef PG8_STAGE
#undef PG8_LDA
#undef PG8_LDB
#undef PG8_MMA
#undef PG8_WAIT_V
#undef PG8_WAIT_L
#undef PG8_BAR
#undef PG8_SCHED
}
}

struct Frame {
    LAS unsigned char* lds;
    int tid, lane, wave, G, b;
    float* out; unsigned char* ws;
    __device__ __forceinline__ bf16_t* H() const { return (bf16_t*)out; }
    __device__ __forceinline__ bf16_t* Qc() const { return (bf16_t*)out; }
    __device__ __forceinline__ bf16_t* Kc() const { return (bf16_t*)(out + OUT_YS); }
    __device__ __forceinline__ bf16_t* MIX() const { return (bf16_t*)out; }
    __device__ __forceinline__ float* modp() const { return (float*)(ws + WS_MODP); }
    __device__ __forceinline__ float* pe() const { return (float*)(ws + WS_PE); }
    __device__ __forceinline__ float* BA() const { return (float*)(ws + WS_BA); }
    __device__ __forceinline__ float* GB() const { return (float*)(ws + WS_GB); }
    __device__ __forceinline__ float* RGAGG() const { return (float*)(ws + WS_RGAGG); }
    __device__ __forceinline__ bf16_t* WbaT() const { return (bf16_t*)(ws + WS_WBAT); }
    __device__ __forceinline__ bf16_t* WoutT() const { return (bf16_t*)(ws + WS_WOUTT); }
    __device__ __forceinline__ bf16_t* GT() const { return (bf16_t*)(ws + WS_GT); }
    __device__ __forceinline__ bf16_t* WinT() const { return (bf16_t*)(ws + WS_WINT); }
    __device__ __forceinline__ bf16_t* TA() const { return (bf16_t*)(ws + WS_TA); }
    __device__ __forceinline__ bf16_t* PROJ() const { return (bf16_t*)(ws + WS_PROJ); }
    __device__ __forceinline__ float* CARRY() const { return (float*)(ws + WS_CARRY); }
};
typedef const __attribute__((address_space(4))) Params CParams;

__device__ __forceinline__ int grp_of_block(int tb) { return tb < 128 ? 0 : (tb < 192 ? 1 : 2); }

__device__ __forceinline__ void transpose_item(const float* W, int N, int k0, int n0, bf16_t* WT0, int Kout, LAS float* scr, int lane) {
#pragma unroll 8
    for (int i = 0; i < 32; ++i) { const int kk = 2 * i + (lane >> 5); scr[kk * 33 + (lane & 31)] = W[(size_t)(k0 + kk) * N + n0 + (lane & 31)]; }
    LDS_WAIT();
    const int c = lane & 7;
#pragma unroll
    for (int j = 0; j < 4; ++j) { const int n = (lane >> 3) + 8 * j; const LAS float* s = scr + (8 * c) * 33 + n;
        u32x4 o; o.x = pk2(s[0 * 33], s[1 * 33]); o.y = pk2(s[2 * 33], s[3 * 33]); o.z = pk2(s[4 * 33], s[5 * 33]); o.w = pk2(s[6 * 33], s[7 * 33]);
        *(u32x4*)(WT0 + (size_t)n * Kout + k0 + 8 * c) = o; }
    LDS_WAIT();
}
struct P0Item { const float* W; bf16_t* dst; int N, k0, n0, Kout, kind; };
__device__ __forceinline__ P0Item p0_decode(CParams& p, const Frame& F, int it) {
    constexpr int I_IN = 16 * 193, I_OUT = 32 * 32, I_G = 256;
    P0Item D; D.kind = 0; int r = it;
    if (r < I_IN) { const int kb = r / 193, nb = r % 193, n0 = nb * 32;
        D.dst = n0 < 4096 ? F.WinT() + (size_t)n0 * 1024 : (n0 < 4128 ? F.WbaT() + (size_t)(n0 - 4096) * 1024 : F.WinT() + (size_t)(n0 - 32) * 1024);
        D.W = p.w_in; D.N = DIN; D.k0 = kb * 64; D.n0 = n0; D.Kout = 1024; return D; }
    r -= I_IN;
    if (r < I_OUT) { const int kb = r / 32, nb = r % 32; D.W = p.w_out; D.N = 1024; D.k0 = kb * 64; D.n0 = nb * 32; D.dst = F.WoutT() + (size_t)(nb * 32) * 2048; D.Kout = 2048; return D; }
    r -= I_OUT;
    if (r < I_G) { const int m = r >> 3, sub = r & 7, kb = sub >> 2, nb = sub & 3, g = m >> 4, dn = m & 15;
        D.W = (g ? p.rg_w_i : p.rg_w_r) + (size_t)dn * 16384; D.N = 128; D.k0 = kb * 64; D.n0 = nb * 32; D.dst = F.GT() + (size_t)m * 16384 + (size_t)(nb * 32) * 128; D.Kout = 128; return D; }
    r -= I_G;
    D.kind = 1; D.k0 = r; D.W = p.w_in; D.dst = F.WinT(); D.N = 0; D.n0 = 0; D.Kout = 0; return D;
}
__device__ __forceinline__ void p0_load(const P0Item& D, float (&v)[32], int lane) {
#pragma unroll
    for (int i = 0; i < 32; ++i) { const int kk = 2 * i + (lane >> 5); v[i] = D.W[(size_t)(D.k0 + kk) * D.N + D.n0 + (lane & 31)]; }
}
__device__ __forceinline__ void p0_store(const P0Item& D, const float (&v)[32], LAS float* scr, int lane) {
#pragma unroll
    for (int i = 0; i < 32; ++i) { const int kk = 2 * i + (lane >> 5); scr[kk * 33 + (lane & 31)] = v[i]; }
    LDS_WAIT();
    const int c = lane & 7;
#pragma unroll
    for (int j = 0; j < 4; ++j) { const int n = (lane >> 3) + 8 * j; const LAS float* s = scr + (8 * c) * 33 + n;
        u32x4 o; o.x = pk2(s[0 * 33], s[1 * 33]); o.y = pk2(s[2 * 33], s[3 * 33]); o.z = pk2(s[4 * 33], s[5 * 33]); o.w = pk2(s[6 * 33], s[7 * 33]);
        *(u32x4*)(D.dst + (size_t)n * D.Kout + D.k0 + 8 * c) = o; }
    LDS_WAIT();
}
__device__ __forceinline__ void phase0(CParams& p, Frame& F) {
    const int tid = F.tid, lane = F.lane;
    for (int it = F.b; it < 192; it += F.G) {
        const int jg = it % 12, ks = it / 12, j = jg * 256 + (tid & 255), half = tid >> 8, k0 = ks * 64 + half * 32;
        float s0 = 0.f, s1 = 0.f, s2 = 0.f;
#pragma unroll 8
        for (int k = 0; k < 32; ++k) { const int kk = k0 + k; const float w = p.ada_w[(size_t)kk * 3072 + j];
            s0 += siluf_(p.c_ctx[kk]) * w; s1 += siluf_(p.c[kk]) * w; s2 += siluf_(p.c[1024 + kk]) * w; }
        LAS float* red = (LAS float*)F.lds;
        if (half == 1) { red[tid - 256] = s0; red[256 + tid - 256] = s1; red[512 + tid - 256] = s2; }
        __syncthreads();
        if (half == 0) { F.modp()[(size_t)(ks * 3 + 0) * 3072 + j] = s0 + red[tid]; F.modp()[(size_t)(ks * 3 + 1) * 3072 + j] = s1 + red[256 + tid]; F.modp()[(size_t)(ks * 3 + 2) * 3072 + j] = s2 + red[512 + tid]; }
        __syncthreads();
    }
    LAS float* scr = (LAS float*)(F.lds + 4096 + F.wave * 8448);
    const int gw = F.b * 8 + F.wave, NGW = F.G * 8;
    constexpr int I_IN = 16 * 193, I_OUT = 32 * 32, I_G = 256, I_PE = 64, I_ALL = I_IN + I_OUT + I_G + I_PE;
    P0Item D = p0_decode(p, F, gw), Dn = D; float v[32], vn[32];
    if (gw < I_ALL && D.kind == 0) p0_load(D, v, lane);
    for (int it = gw; it < I_ALL; it += NGW) {
        const int itn = it + NGW;
        if (itn < I_ALL) { Dn = p0_decode(p, F, itn); if (Dn.kind == 0) p0_load(Dn, vn, lane); }
        if (D.kind == 0) p0_store(D, v, scr, lane);
        else { const int pv = D.k0;
#pragma unroll
            for (int i = 0; i < 4; ++i) { const int idx = lane * 4 + i; const float f = expf(-9.210340371976184f * (float)idx / 256.f); const float a = (float)pv * f;
                F.pe()[pv * 256 + idx] = sinf(a); F.pe()[16384 + pv * 256 + idx] = cosf(a); } }
        D = Dn;
#pragma unroll
        for (int i = 0; i < 32; ++i) v[i] = vn[i];
    }
}

__device__ __forceinline__ float mod_val(CParams& p, const Frame& F, int grp, int j) {
    float s = p.ada_b[j];
#pragma unroll
    for (int ks = 0; ks < 16; ++ks) s += F.modp()[(size_t)(ks * 3 + grp) * 3072 + j];
    return s;
}

__device__ __forceinline__ void phase1(CParams& p, Frame& F) {
    LAS float* sc = (LAS float*)F.lds; LAS float* sh = sc + 1024;
    for (int tb = F.b; tb < 256; tb += F.G) {
        const int grp = grp_of_block(tb);
        for (int j = F.tid; j < 1024; j += 512) { sh[j] = mod_val(p, F, grp, j); sc[j] = p.pre_w[j] * (1.f + mod_val(p, F, grp, 1024 + j)); }
        __syncthreads();
#pragma unroll 2
        for (int i = 0; i < 8; ++i) {
            const int tok = tb * 64 + F.wave * 8 + i;
            const float* xr = tok < 8192 ? p.x_prompt + (size_t)tok * 1024 : p.x_sample + (size_t)(tok - 8192) * 1024;
            f32x4 v[4]; float ss = 0.f;
#pragma unroll
            for (int q = 0; q < 4; ++q) { v[q] = *(const f32x4*)(xr + F.lane * 4 + 256 * q);
                if (tok >= 8192) { const int pp = (tok - 8192) & 4095; const int vv = (q < 2) ? (pp >> 6) : (pp & 63);
                    const f32x4 e = *(const f32x4*)(F.pe() + ((q & 1) ? 16384 : 0) + vv * 256 + F.lane * 4); v[q] += e; }
                ss += (v[q][0] * v[q][0] + v[q][1] * v[q][1]) + (v[q][2] * v[q][2] + v[q][3] * v[q][3]); }
            const float rstd = rsqrtf(wave_sum(ss) * (1.f / 1024.f) + 1e-6f);
#pragma unroll
            for (int q = 0; q < 4; ++q) { const int j = F.lane * 4 + 256 * q; const f32x4 s4 = *(const LAS f32x4*)(sc + j), h4 = *(const LAS f32x4*)(sh + j);
                CHK(F, 1, badv(v[q][0] * rstd * s4[0] + h4[0], 100.f) || badv(v[q][3] * rstd * s4[3] + h4[3], 100.f));
                u32x2 o; o.x = pk2(v[q][0] * rstd * s4[0] + h4[0], v[q][1] * rstd * s4[1] + h4[1]); o.y = pk2(v[q][2] * rstd * s4[2] + h4[2], v[q][3] * rstd * s4[3] + h4[3]);
                *(u32x2*)(F.H() + (size_t)tok * 1024 + j) = o; }
        }
        __syncthreads();
    }
}

__device__ __forceinline__ void phase2(CParams& p, Frame& F) {
    { pg8::Gemm g{F.H(), F.WinT(), NTOK, NPROJ, 1024}; pg8::StaticOrder S; S.init(NTOK, NPROJ, F.G, F.b); pg8::EpiBf16 E{F.PROJ(), NPROJ};
      pg8::gemm_phase<pg8::EpiBf16, pg8::StaticOrder>(F.lds, g, S, E); }
    const int l15 = F.lane & 15, q4 = F.lane >> 4;
    for (int tb = F.b; tb < 256; tb += F.G) {
        const int mt = F.wave >> 1, nt = F.wave & 1;
        const bf16_t* ar = F.H() + (size_t)(tb * 64 + mt * 16 + l15) * 1024 + q4 * 8;
        const bf16_t* br = F.WbaT() + (size_t)(nt * 16 + l15) * 1024 + q4 * 8;
        f32x4 acc = {0.f, 0.f, 0.f, 0.f};
#pragma unroll 16
        for (int ks = 0; ks < 32; ++ks) { const bf16x8 a = *(const bf16x8*)(ar + ks * 32), b = *(const bf16x8*)(br + ks * 32); acc = MFMA16(a, b, acc); }
#pragma unroll
        for (int r = 0; r < 4; ++r) F.BA()[(size_t)(tb * 64 + mt * 16 + q4 * 4 + r) * 32 + nt * 16 + l15] = acc[r];
    }
}

__device__ __forceinline__ void p3_load_rows(const Frame& F, int ci, int h, u32x4 (&rows)[7]) {
    const int tid = F.tid, tg = tid >> 5, part = (tid >> 4) & 1, sub = tid & 15, col = part * 1024 + h * 128 + sub * 8, t0 = ci * 64;
    int seq_lo, seq_hi; if (ci < 128) { seq_lo = (ci >> 2) * 256; seq_hi = seq_lo + 256; } else { seq_lo = 8192 + ((ci - 128) >> 6) * 4096; seq_hi = seq_lo + 4096; }
    const int tb = t0 + tg * 4 - 2;
#pragma unroll
    for (int r = 0; r < 7; ++r) { const int tok = tb + r; u32x4 v = {0u, 0u, 0u, 0u};
        if (tok >= seq_lo && tok < seq_hi) v = *(const u32x4*)(F.PROJ() + (size_t)tok * NPROJ + col);
        rows[r] = v; }
}
__device__ __forceinline__ void p3_delta_item(CParams& p, Frame& F, int ci, int h, u32x4 (&rows)[7], int itn) {
    const int tid = F.tid, lane = F.lane, wave = F.wave, q4 = lane >> 4, l15 = lane & 15;
    LAS unsigned char* Ks = F.lds; LAS unsigned char* Qs = F.lds + 17408;
    LAS float* gfv = (LAS float*)(F.lds + 34816);
    LAS unsigned char* DIR0 = F.lds + 35840;
    LAS unsigned char* ATo = F.lds + 137728;
#pragma unroll
    for (int i = 0; i < 5; ++i) { const int ch = tid + 512 * i; if (ch < 2304) { const int dd = ch >= 1152, cc = ch - dd * 1152; *(LAS u32x4*)(DIR0 + dd * 47616 + 18432 + cc * 16) = (u32x4){0u, 0u, 0u, 0u}; } }
    const int t0 = ci * 64;
    int seq_lo, seq_hi; if (ci < 128) { seq_lo = (ci >> 2) * 256; seq_hi = seq_lo + 256; } else { seq_lo = 8192 + ((ci - 128) >> 6) * 4096; seq_hi = seq_lo + 4096; }
    {
        const int tg = tid >> 5, part = (tid >> 4) & 1, sub = tid & 15, col = part * 1024 + h * 128 + sub * 8;
        float w[4][8];
#pragma unroll
        for (int j = 0; j < 4; ++j) { const f32x4 a = *(const f32x4*)(p.dn_conv_w + j * 3072 + col), b = *(const f32x4*)(p.dn_conv_w + j * 3072 + col + 4);
            w[j][0] = a[0]; w[j][1] = a[1]; w[j][2] = a[2]; w[j][3] = a[3]; w[j][4] = b[0]; w[j][5] = b[1]; w[j][6] = b[2]; w[j][7] = b[3]; }
        float acc[4][8];
#pragma unroll
        for (int i = 0; i < 4; ++i)
#pragma unroll
            for (int e = 0; e < 8; ++e) acc[i][e] = 0.f;
#pragma unroll
        for (int r = 0; r < 7; ++r) {
            float x[8]; unpack8(rows[r], x);
#pragma unroll
            for (int j = 0; j < 4; ++j) { const int i = r - j; if (i >= 0 && i < 4) {
#pragma unroll
                for (int e = 0; e < 8; ++e) acc[i][e] += w[j][e] * x[e]; } } }
#pragma unroll
        for (int i = 0; i < 4; ++i) { float ss = 0.f;
#pragma unroll
            for (int e = 0; e < 8; ++e) { acc[i][e] = siluf_(acc[i][e]); ss += acc[i][e] * acc[i][e]; }
            ss += __shfl_xor(ss, 1); ss += __shfl_xor(ss, 2); ss += __shfl_xor(ss, 4); ss += __shfl_xor(ss, 8);
            const float rs = rsqrtf(ss + 1e-6f) * (part == 0 ? 0.08838834764831845f : 1.f);
#pragma unroll
            for (int e = 0; e < 8; ++e) acc[i][e] *= rs;
            CHK(F, 4, badv(acc[i][0], 1.01f) || badv(acc[i][5], 1.01f) || badv(ss * rs * rs, part == 0 ? 0.0079f : 1.01f));
            const u32x4 o = pack8(acc[i]); const int c = tg * 4 + i;
            *(LAS u32x4*)((part ? Ks : Qs) + c * 272 + sub * 16) = o;
            if (part == 0) *(u32x4*)(F.Qc() + (size_t)(t0 + c) * 1024 + h * 128 + sub * 8) = o; }
        if (part == 1) {
            bf16_t* kt = F.Kc() + (size_t)(ci * 8 + h) * 8192 + (size_t)(sub * 8) * 64 + tg * 4;
#pragma unroll
            for (int e = 0; e < 8; ++e) { u32x2 o2; o2.x = pk2(acc[0][e], acc[1][e]); o2.y = pk2(acc[2][e], acc[3][e]); *(u32x2*)(kt + e * 64) = o2; } }
    }
    if (wave == 0) {
        const float* ba = F.BA() + (size_t)(t0 + lane) * 32;
        const float bf_ = sigm(ba[h]), bb_ = sigm(ba[8 + h]);
        float s = -expf(p.dn_a_log[h]) * softplusf_(ba[16 + h] + p.dn_dt_bias[h]);
        float sb = -expf(p.dn_a_log[8 + h]) * softplusf_(ba[24 + h] + p.dn_dt_bias[8 + h]);
#pragma unroll
        for (int o = 1; o < 64; o <<= 1) { const float t = __shfl_up(s, o); if (lane >= o) s += t; }
#pragma unroll
        for (int o = 1; o < 64; o <<= 1) { const float t = __shfl_down(sb, o); if (lane + o < 64) sb += t; }
        CHK(F, 3, badv(ba[h], 1000.f) || badv(ba[24 + h], 1000.f));
        CHK(F, 8, badv(s, 1e4f) || badv(sb, 1e4f) || s > 0.f || sb > 0.f || bf_ < 0.f || bf_ > 1.f || bb_ < 0.f || bb_ > 1.f);
        gfv[lane] = s; gfv[64 + lane] = sb; gfv[128 + lane] = bf_; gfv[192 + lane] = bb_;
        float* gb = F.GB() + (size_t)(ci * 8 + h) * 256;
        gb[lane] = s; gb[64 + lane] = sb; gb[128 + lane] = bf_; gb[192 + lane] = bb_;
    }
    lds_barrier();
    const int d = wave >> 2, mt = wave & 3;
    LAS unsigned char* Db = DIR0 + d * 47616;
    LAS unsigned char* Brow = Db; LAS unsigned char* Btr = Db + 9216; LAS unsigned char* Xrow = Db + 18432; LAS unsigned char* Xtr = Db + 27648;
    LAS float* Dl = (LAS float*)(Db + 36864) + mt * 320; LAS unsigned char* M2t = Db + 41984; LAS unsigned char* Mts = Db + 44544 + mt * 768;
    const LAS unsigned char* Lrow = Brow;
    const LAS float* gd = gfv + d * 64; const LAS float* bd = gfv + 128 + d * 64;
    {
        f32x4 kk[4], qk[4];
#pragma unroll
        for (int n = 0; n < 4; ++n) { kk[n] = (f32x4){0.f, 0.f, 0.f, 0.f}; qk[n] = (f32x4){0.f, 0.f, 0.f, 0.f}; }
#pragma unroll
        for (int ks = 0; ks < 4; ++ks) { const bf16x8 ak = ldfrag(Ks, 272, mt * 16 + l15, ks * 64 + q4 * 16), aq = ldfrag(Qs, 272, mt * 16 + l15, ks * 64 + q4 * 16);
#pragma unroll
            for (int n = 0; n < 4; ++n) { const bf16x8 bk = ldfrag(Ks, 272, n * 16 + l15, ks * 64 + q4 * 16); kk[n] = MFMA16(ak, bk, kk[n]); qk[n] = MFMA16(aq, bk, qk[n]); } }
#pragma unroll
        for (int n = 0; n < 4; ++n) { const int C = n * 16 + l15; const float gC = gd[C], bC = bd[C]; float a4[4];
#pragma unroll
            for (int r = 0; r < 4; ++r) { const int R = mt * 16 + q4 * 4 + r;
                const float dec = __expf(-fabsf(gd[R] - gC));
                a4[r] = (C > R) ? (d == 0 ? bC : bd[R]) * kk[n][r] * dec : 0.f;
                const bool incl = d == 0 ? (R >= C) : (R < C);
                if (incl) ((LAS bf16_t*)ATo)[R * 64 + C] = f2bf(qk[n][r] * dec); }
            u32x2 o; o.x = pk2(a4[0], a4[1]); o.y = pk2(a4[2], a4[3]);
            *(LAS u32x2*)(Brow + C * 144 + (mt * 16 + q4 * 4) * 2) = o;
            if (n == mt) *(LAS f32x4*)(Dl + l15 * 20 + q4 * 4) = (f32x4){a4[0], a4[1], a4[2], a4[3]}; }
    }
    lds_barrier();
    if (itn < 2048) p3_load_rows(F, itn >> 3, itn & 7, rows);
    if (lane < 16) {
        float x[16];
#pragma unroll
        for (int i = 0; i < 16; ++i) { float sv = (i == lane) ? 1.f : 0.f;
            float drow[16];
#pragma unroll
            for (int q = 0; q < 4; ++q) if (4 * q < i) { const f32x4 t4 = *(const LAS f32x4*)(Dl + i * 20 + 4 * q); drow[4 * q] = t4[0]; drow[4 * q + 1] = t4[1]; drow[4 * q + 2] = t4[2]; drow[4 * q + 3] = t4[3]; }
#pragma unroll
            for (int j = 0; j < i; ++j) sv -= drow[j] * x[j];
            x[i] = sv; }
#pragma unroll
        for (int i = 0; i < 16; ++i) ((LAS bf16_t*)Xrow)[(mt * 16 + i) * 72 + mt * 16 + lane] = f2bf(x[i]);
        u32x4 o0, o1; o0.x = pk2(x[0], x[1]); o0.y = pk2(x[2], x[3]); o0.z = pk2(x[4], x[5]); o0.w = pk2(x[6], x[7]);
        o1.x = pk2(x[8], x[9]); o1.y = pk2(x[10], x[11]); o1.z = pk2(x[12], x[13]); o1.w = pk2(x[14], x[15]);
        *(LAS u32x4*)(Xtr + (mt * 16 + lane) * 144 + mt * 32) = o0; *(LAS u32x4*)(Xtr + (mt * 16 + lane) * 144 + mt * 32 + 16) = o1;
    }
    lds_barrier();
    const bf16x8 zero8 = {0, 0, 0, 0, 0, 0, 0, 0};
    const f32x4 zero4 = {0.f, 0.f, 0.f, 0.f};
    if (mt & 1) {
        const int I1 = mt, I0 = mt - 1;
        bf16x8 a = zero8, b = zero8;
        if (q4 < 2) { a = ldfrag(Lrow, 144, I1 * 16 + l15, I0 * 32 + q4 * 16); b = ldfrag(Xtr, 144, I0 * 16 + l15, I0 * 32 + q4 * 16); }
        const f32x4 M = MFMA16(a, b, zero4);
        { u32x2 o; o.x = pk2(M[0], M[1]); o.y = pk2(M[2], M[3]); *(LAS u32x2*)(Mts + l15 * 48 + q4 * 8) = o; }
        LDS_WAIT();
        bf16x8 a2 = zero8, b2 = zero8;
        if (q4 < 2) { a2 = ldfrag(Xrow, 144, I1 * 16 + l15, I1 * 32 + q4 * 16); b2 = *(const LAS bf16x8*)(Mts + l15 * 48 + q4 * 16); }
        const f32x4 X = MFMA16(a2, b2, zero4);
#pragma unroll
        for (int r = 0; r < 4; ++r) ((LAS bf16_t*)Xrow)[(I1 * 16 + q4 * 4 + r) * 72 + I0 * 16 + l15] = f2bf(-X[r]);
        u32x2 o; o.x = pk2(-X[0], -X[1]); o.y = pk2(-X[2], -X[3]);
        *(LAS u32x2*)(Xtr + (I0 * 16 + l15) * 144 + (I1 * 16 + q4 * 4) * 2) = o;
    }
    lds_barrier();
    {
        const int mi = mt >> 1, ni = mt & 1;
        const bf16x8 a = ldfrag(Lrow, 144, 32 + mi * 16 + l15, q4 * 16), b = ldfrag(Xtr, 144, ni * 16 + l15, q4 * 16);
        const f32x4 M2 = MFMA16(a, b, zero4);
        { u32x2 o; o.x = pk2(M2[0], M2[1]); o.y = pk2(M2[2], M2[3]); *(LAS u32x2*)(M2t + (ni * 16 + l15) * 80 + (mi * 16 + q4 * 4) * 2) = o; }
        lds_barrier();
        const bf16x8 a2 = ldfrag(Xrow, 144, 32 + mi * 16 + l15, 64 + q4 * 16), b2 = *(const LAS bf16x8*)(M2t + (ni * 16 + l15) * 80 + q4 * 16);
        const f32x4 X = MFMA16(a2, b2, zero4);
#pragma unroll
        for (int r = 0; r < 4; ++r) { CHK(F, 6, badv(X[r], 20.f)); ((LAS bf16_t*)Xrow)[(32 + mi * 16 + q4 * 4 + r) * 72 + ni * 16 + l15] = f2bf(-X[r]); }
        u32x2 o; o.x = pk2(-X[0], -X[1]); o.y = pk2(-X[2], -X[3]);
        *(LAS u32x2*)(Xtr + (ni * 16 + l15) * 144 + (32 + mi * 16 + q4 * 4) * 2) = o;
    }
    lds_barrier();
    { bf16_t* dst = F.TA() + (size_t)(ci * 8 + h) * 8192;
      const int c = tid >> 3, s0 = (tid & 7) * 8;
      const u32x4 lo = *(const LAS u32x4*)(DIR0 + 18432 + c * 144 + s0 * 2), up = *(const LAS u32x4*)(DIR0 + 47616 + 27648 + c * 144 + s0 * 2);
      unsigned wl[4] = {lo.x, lo.y, lo.z, lo.w}, wu[4] = {up.x, up.y, up.z, up.w}, wo[4];
#pragma unroll
      for (int i = 0; i < 4; ++i) { const int sa = s0 + 2 * i, sb2 = sa + 1;
          const unsigned mlo = (sa <= c ? 0x0000FFFFu : 0u) | (sb2 <= c ? 0xFFFF0000u : 0u);
          wo[i] = (wl[i] & mlo) | (wu[i] & ~mlo); }
      *(u32x4*)(dst + tid * 8) = (u32x4){wo[0], wo[1], wo[2], wo[3]};
      *(u32x4*)(dst + 4096 + tid * 8) = *(const LAS u32x4*)(ATo + tid * 16); }
    lds_barrier();
}

struct RgW { bf16x8 g[2][2][4]; float br[2], bi[2], sp[2]; };
__device__ __forceinline__ void rg_load_w(CParams& p, const Frame& F, int n, RgW& W) {
    const int q4 = F.lane >> 4, j = F.wave * 16 + (F.lane & 15), ch = n * 128 + j;
#pragma unroll
    for (int d = 0; d < 2; ++d) {
#pragma unroll
        for (int g = 0; g < 2; ++g) { const bf16_t* gp = F.GT() + (size_t)((g * 2 + d) * 8 + n) * 16384 + (size_t)j * 128 + q4 * 8;
#pragma unroll
            for (int ks = 0; ks < 4; ++ks) W.g[d][g][ks] = *(const bf16x8*)(gp + ks * 32); }
        W.br[d] = p.rg_b_r[d * 1024 + ch]; W.bi[d] = p.rg_b_i[d * 1024 + ch]; W.sp[d] = softplusf_(-p.rg_lam[d * 1024 + ch]); }
}
__device__ __forceinline__ void rg_load_rows(const Frame& F, int ci, int n, u32x4 (&rows)[5]) {
    const int tid = F.tid, tg = tid >> 4, sub = tid & 15, col = 4096 + n * 128 + sub * 8, t0 = ci * 64;
    int c_lo, c_hi; if (ci < 128) { c_lo = (ci >> 2) * 4; c_hi = c_lo + 4; } else { c_lo = 128 + ((ci - 128) >> 6) * 64; c_hi = c_lo + 64; }
    const int tb = t0 + tg * 2 - 2;
#pragma unroll
    for (int r = 0; r < 5; ++r) { const int tok = tb + r; u32x4 v = {0u, 0u, 0u, 0u};
        if (tok >= c_lo * 64 && tok < c_hi * 64) v = *(const u32x4*)(F.PROJ() + (size_t)tok * NPROJ + col);
        rows[r] = v; }
}
template <int PASS>
__device__ __forceinline__ void rg_item(CParams& p, Frame& F, int ci, int n, u32x4 (&rows)[5], int itn) {
    const int tid = F.tid, lane = F.lane, wave = F.wave, q4 = lane >> 4, l15 = lane & 15;
    LAS unsigned char* xb = F.lds; LAS float* xf = (LAS float*)(F.lds + 17408); LAS float* Hs = (LAS float*)(F.lds + 50176);
    const int t0 = ci * 64;
    int seq_lo, seq_hi, c_lo, c_hi, seq; const bool samp = ci >= 128;
    if (!samp) { seq = ci >> 2; c_lo = seq * 4; c_hi = c_lo + 4; } else { seq = (ci - 128) >> 6; c_lo = 128 + seq * 64; c_hi = c_lo + 64; }
    seq_lo = c_lo * 64; seq_hi = c_hi * 64;
    const int j = wave * 16 + l15, ch = n * 128 + j;
    bf16x8 wA[2][4], wB[2][4];
#pragma unroll
    for (int g = 0; g < 2; ++g) { const bf16_t* gp = F.GT() + (size_t)((g * 2 + 0) * 8 + n) * 16384 + (size_t)j * 128 + q4 * 8;
#pragma unroll
        for (int ks = 0; ks < 4; ++ks) wA[g][ks] = *(const bf16x8*)(gp + ks * 32); }
    {
        const int tg = tid >> 4, sub = tid & 15, ch = n * 128 + sub * 8;
        float w[4][8], acc[2][8];
#pragma unroll
        for (int j = 0; j < 4; ++j) { const f32x4 a = *(const f32x4*)(p.rg_conv_w + j * 1024 + ch), b = *(const f32x4*)(p.rg_conv_w + j * 1024 + ch + 4);
            w[j][0] = a[0]; w[j][1] = a[1]; w[j][2] = a[2]; w[j][3] = a[3]; w[j][4] = b[0]; w[j][5] = b[1]; w[j][6] = b[2]; w[j][7] = b[3]; }
        { const f32x4 a = *(const f32x4*)(p.rg_conv_b + ch), b = *(const f32x4*)(p.rg_conv_b + ch + 4);
#pragma unroll
          for (int i = 0; i < 2; ++i) { acc[i][0] = a[0]; acc[i][1] = a[1]; acc[i][2] = a[2]; acc[i][3] = a[3]; acc[i][4] = b[0]; acc[i][5] = b[1]; acc[i][6] = b[2]; acc[i][7] = b[3]; } }
#pragma unroll
        for (int r = 0; r < 5; ++r) {
            float x[8]; unpack8(rows[r], x);
#pragma unroll
            for (int j = 0; j < 4; ++j) { const int i = r - j; if (i >= 0 && i < 2) {
#pragma unroll
                for (int e = 0; e < 8; ++e) acc[i][e] += w[j][e] * x[e]; } } }
#pragma unroll
        for (int i = 0; i < 2; ++i) { const int c = tg * 2 + i;
            *(LAS u32x4*)(xb + c * 272 + sub * 16) = pack8(acc[i]);
            *(LAS f32x4*)(xf + c * 128 + sub * 8) = (f32x4){acc[i][0], acc[i][1], acc[i][2], acc[i][3]};
            *(LAS f32x4*)(xf + c * 128 + sub * 8 + 4) = (f32x4){acc[i][4], acc[i][5], acc[i][6], acc[i][7]}; }
    }
    lds_barrier();
    f32x4 hs[4];
#pragma unroll
    for (int m = 0; m < 4; ++m) hs[m] = (f32x4){0.f, 0.f, 0.f, 0.f};
#pragma unroll
    for (int d = 0; d < 2; ++d) {
        f32x4 av[4], bxv[4];
        {
            f32x4 ar[4], ai[4];
#pragma unroll
            for (int m = 0; m < 4; ++m) { ar[m] = (f32x4){0.f, 0.f, 0.f, 0.f}; ai[m] = (f32x4){0.f, 0.f, 0.f, 0.f}; }
#pragma unroll
            for (int ks = 0; ks < 4; ++ks) { const bf16x8 br = d == 0 ? wA[0][ks] : wB[0][ks], bi = d == 0 ? wA[1][ks] : wB[1][ks];
#pragma unroll
                for (int m = 0; m < 4; ++m) { const bf16x8 a = ldfrag(xb, 272, m * 16 + l15, ks * 64 + q4 * 16); ar[m] = MFMA16(a, br, ar[m]); ai[m] = MFMA16(a, bi, ai[m]); } }
            if (d == 0) {
#pragma unroll
                for (int g = 0; g < 2; ++g) { const bf16_t* gp = F.GT() + (size_t)((g * 2 + 1) * 8 + n) * 16384 + (size_t)j * 128 + q4 * 8;
#pragma unroll
                    for (int ks = 0; ks < 4; ++ks) wB[g][ks] = *(const bf16x8*)(gp + ks * 32); } }
            const float L2E = 1.4426950408889634f;
            const float br_ = -L2E * p.rg_b_r[d * 1024 + ch], bi_ = -L2E * p.rg_b_i[d * 1024 + ch], sp = softplusf_(-p.rg_lam[d * 1024 + ch]);
            const float k2 = -16.f * sp, k2e = k2 * L2E, k1e = 0.5f * k2e;
#pragma unroll
            for (int m = 0; m < 4; ++m)
#pragma unroll
                for (int r = 0; r < 4; ++r) { const int c = m * 16 + q4 * 4 + r;
                    const float rr = __builtin_amdgcn_rcpf(1.f + __builtin_amdgcn_exp2f(fmaf(ar[m][r], -L2E, br_)));
                    const float ii = __builtin_amdgcn_rcpf(1.f + __builtin_amdgcn_exp2f(fmaf(ai[m][r], -L2E, bi_)));
                    const float t2 = k2 * rr;
                    const float ser = t2 * fmaf(t2, fmaf(t2, 0.16666667f, 0.5f), 1.f);
                    const float a_ = __builtin_amdgcn_exp2f(k1e * rr);
                    const float em = t2 > -0.01f ? ser : fmaf(a_, a_, -1.f);
                    av[m][r] = a_; bxv[m][r] = __builtin_amdgcn_sqrtf(-em) * (ii * xf[c * 128 + j]); }
        }
        f32x4 Pa[4], Pb[4]; float Ap[4], Bp[4], Am[4], Bm[4];
#pragma unroll
        for (int m = 0; m < 4; ++m) {
            float pa, pb;
            if (d == 0) { pa = av[m][0]; pb = bxv[m][0]; Pa[m][0] = pa; Pb[m][0] = pb;
#pragma unroll
                for (int r = 1; r < 4; ++r) { pb = av[m][r] * pb + bxv[m][r]; pa = av[m][r] * pa; Pa[m][r] = pa; Pb[m][r] = pb; } }
            else { pa = av[m][3]; pb = bxv[m][3]; Pa[m][3] = pa; Pb[m][3] = pb;
#pragma unroll
                for (int r = 2; r >= 0; --r) { pb = av[m][r] * pb + bxv[m][r]; pa = av[m][r] * pa; Pa[m][r] = pa; Pb[m][r] = pb; } }
            float Ak[4], Bk[4];
#pragma unroll
            for (int k = 0; k < 4; ++k) { Ak[k] = __shfl(pa, l15 + 16 * k); Bk[k] = __shfl(pb, l15 + 16 * k); }
            float ap = 1.f, bp = 0.f, am = 1.f, bm = 0.f;
#pragma unroll
            for (int kk = 0; kk < 4; ++kk) { const int k = d == 0 ? kk : 3 - kk;
                const bool before = d == 0 ? (k < q4) : (k > q4);
                const float nb = Ak[k] * bp + Bk[k], na = Ak[k] * ap;
                bp = before ? nb : bp; ap = before ? na : ap;
                bm = Ak[k] * bm + Bk[k]; am = Ak[k] * am; }
            Ap[m] = ap; Bp[m] = bp; Am[m] = am; Bm[m] = bm;
        }
        if (PASS == 1) {
            float At = 1.f, Bt = 0.f;
#pragma unroll
            for (int mm = 0; mm < 4; ++mm) { const int m = d == 0 ? mm : 3 - mm; Bt = Am[m] * Bt + Bm[m]; At = Am[m] * At; }
            if (q4 == 0) { float* ag = F.RGAGG() + (size_t)(ci * 2 + d) * 2048; ag[ch] = At; ag[1024 + ch] = Bt; }
        } else {
            float hb = F.CARRY()[(size_t)(ci * 2 + d) * 1024 + ch];
#pragma unroll
            for (int mm = 0; mm < 4; ++mm) { const int m = d == 0 ? mm : 3 - mm;
                const float hin = Ap[m] * hb + Bp[m];
#pragma unroll
                for (int r = 0; r < 4; ++r) hs[m][r] += Pa[m][r] * hin + Pb[m][r];
                hb = Am[m] * hb + Bm[m]; }
            if (!samp && q4 == 0 && ci == (d == 0 ? c_hi - 1 : c_lo)) F.out[OUT_SR + (size_t)(seq * 2 + d) * 1024 + ch] = hb;
        }
    }
    if (PASS == 1 && itn < 1024) rg_load_rows(F, 128 + (itn >> 3), itn & 7, rows);
    if (PASS == 3) {
#pragma unroll
        for (int m = 0; m < 4; ++m)
#pragma unroll
            for (int r = 0; r < 4; ++r) Hs[(m * 16 + q4 * 4 + r) * 128 + j] = hs[m][r];
        lds_barrier();
#pragma unroll
        for (int i = 0; i < 2; ++i) { const int chunk = tid + 512 * i, c = chunk >> 4, cc = chunk & 15;
            const u32x4 gv = *(const u32x4*)(F.PROJ() + (size_t)(t0 + c) * NPROJ + 5120 + n * 128 + cc * 8);
            float g[8]; unpack8(gv, g);
            const f32x4 ha = *(const LAS f32x4*)(Hs + c * 128 + cc * 8), hb2 = *(const LAS f32x4*)(Hs + c * 128 + cc * 8 + 4);
            float o[8];
#pragma unroll
            for (int e = 0; e < 4; ++e) { o[e] = ha[e] * siluf_(g[e]); o[4 + e] = hb2[e] * siluf_(g[4 + e]); }
            *(u32x4*)(F.MIX() + (size_t)(t0 + c) * 2048 + 1024 + n * 128 + cc * 8) = pack8(o); }
    }
    lds_barrier();
}

__device__ __forceinline__ void rg_conv_lds(CParams& p, const Frame& F, int n, const u32x4 (&rows)[5], LAS unsigned char* xb, LAS float* xf) {
    const int tid = F.tid, tg = tid >> 4, sub = tid & 15, ch = n * 128 + sub * 8;
    float w[4][8], acc[2][8];
#pragma unroll
    for (int j = 0; j < 4; ++j) { const f32x4 a = *(const f32x4*)(p.rg_conv_w + j * 1024 + ch), b = *(const f32x4*)(p.rg_conv_w + j * 1024 + ch + 4);
        w[j][0] = a[0]; w[j][1] = a[1]; w[j][2] = a[2]; w[j][3] = a[3]; w[j][4] = b[0]; w[j][5] = b[1]; w[j][6] = b[2]; w[j][7] = b[3]; }
    { const f32x4 a = *(const f32x4*)(p.rg_conv_b + ch), b = *(const f32x4*)(p.rg_conv_b + ch + 4);
#pragma unroll
      for (int i = 0; i < 2; ++i) { acc[i][0] = a[0]; acc[i][1] = a[1]; acc[i][2] = a[2]; acc[i][3] = a[3]; acc[i][4] = b[0]; acc[i][5] = b[1]; acc[i][6] = b[2]; acc[i][7] = b[3]; } }
#pragma unroll
    for (int r = 0; r < 5; ++r) { float x[8]; unpack8(rows[r], x);
#pragma unroll
        for (int j = 0; j < 4; ++j) { const int i = r - j; if (i >= 0 && i < 2) {
#pragma unroll
            for (int e = 0; e < 8; ++e) acc[i][e] += w[j][e] * x[e]; } } }
#pragma unroll
    for (int i = 0; i < 2; ++i) { const int c = tg * 2 + i;
        *(LAS u32x4*)(xb + c * 272 + sub * 16) = pack8(acc[i]);
        *(LAS f32x4*)(xf + c * 128 + sub * 8) = (f32x4){acc[i][0], acc[i][1], acc[i][2], acc[i][3]};
        *(LAS f32x4*)(xf + c * 128 + sub * 8 + 4) = (f32x4){acc[i][4], acc[i][5], acc[i][6], acc[i][7]}; }
}
template <int D>
__device__ __forceinline__ void rg_gate_scan(const Frame& F, const bf16x8 (&wg)[2][4], float br_, float bi_, float sp, const LAS unsigned char* xb, const LAS float* xf, int j,
                                             f32x4 (&Pa)[4], f32x4 (&Pb)[4], float (&Ap)[4], float (&Bp)[4], float (&Am)[4], float (&Bm)[4]) {
    const int lane = F.lane, q4 = lane >> 4, l15 = lane & 15;
    f32x4 av[4], bxv[4];
    {
        f32x4 ar[4], ai[4];
#pragma unroll
        for (int m = 0; m < 4; ++m) { ar[m] = (f32x4){0.f, 0.f, 0.f, 0.f}; ai[m] = (f32x4){0.f, 0.f, 0.f, 0.f}; }
#pragma unroll
        for (int ks = 0; ks < 4; ++ks) {
#pragma unroll
            for (int m = 0; m < 4; ++m) { const bf16x8 a = ldfrag(xb, 272, m * 16 + l15, ks * 64 + q4 * 16); ar[m] = MFMA16(a, wg[0][ks], ar[m]); ai[m] = MFMA16(a, wg[1][ks], ai[m]); } }
        const float L2E = 1.4426950408889634f;
        const float brs = -L2E * br_, bis = -L2E * bi_, k2 = -16.f * sp, k1e = 0.5f * k2 * L2E;
#pragma unroll
        for (int m = 0; m < 4; ++m)
#pragma unroll
            for (int r = 0; r < 4; ++r) { const int c = m * 16 + q4 * 4 + r;
                const float rr = __builtin_amdgcn_rcpf(1.f + __builtin_amdgcn_exp2f(fmaf(ar[m][r], -L2E, brs)));
                const float ii = __builtin_amdgcn_rcpf(1.f + __builtin_amdgcn_exp2f(fmaf(ai[m][r], -L2E, bis)));
                const float t2 = k2 * rr, a = __builtin_amdgcn_exp2f(k1e * rr);
                const float ser = t2 * fmaf(t2, fmaf(t2, 0.16666667f, 0.5f), 1.f);
                const float em = t2 > -0.01f ? ser : fmaf(a, a, -1.f);
                av[m][r] = a; bxv[m][r] = __builtin_amdgcn_sqrtf(-em) * (ii * xf[c * 128 + j]); }
    }
#pragma unroll
    for (int m = 0; m < 4; ++m) {
        float pa, pb;
        if (D == 0) { pa = av[m][0]; pb = bxv[m][0]; Pa[m][0] = pa; Pb[m][0] = pb;
#pragma unroll
            for (int r = 1; r < 4; ++r) { pb = av[m][r] * pb + bxv[m][r]; pa = av[m][r] * pa; Pa[m][r] = pa; Pb[m][r] = pb; } }
        else { pa = av[m][3]; pb = bxv[m][3]; Pa[m][3] = pa; Pb[m][3] = pb;
#pragma unroll
            for (int r = 2; r >= 0; --r) { pb = av[m][r] * pb + bxv[m][r]; pa = av[m][r] * pa; Pa[m][r] = pa; Pb[m][r] = pb; } }
        float Ak[4], Bk[4];
#pragma unroll
        for (int k = 0; k < 4; ++k) { Ak[k] = __shfl(pa, l15 + 16 * k); Bk[k] = __shfl(pb, l15 + 16 * k); }
        float ap = 1.f, bp = 0.f, am = 1.f, bm = 0.f;
#pragma unroll
        for (int kk = 0; kk < 4; ++kk) { const int k = D == 0 ? kk : 3 - kk;
            const bool before = D == 0 ? (k < q4) : (k > q4);
            const float nb = Ak[k] * bp + Bk[k], na = Ak[k] * ap;
            bp = before ? nb : bp; ap = before ? na : ap;
            bm = Ak[k] * bm + Bk[k]; am = Ak[k] * am; }
        Ap[m] = ap; Bp[m] = bp; Am[m] = am; Bm[m] = bm;
    }
}
template <int D>
__device__ __forceinline__ void rg_prompt_dir(CParams& p, Frame& F, int seq, int n) {
    const int tid = F.tid, lane = F.lane, wave = F.wave, q4 = lane >> 4, l15 = lane & 15;
    LAS unsigned char* xb = F.lds; LAS float* xf = (LAS float*)(F.lds + 17408); LAS float* Hs = (LAS float*)(F.lds + 50176); LAS bf16_t* Hf = (LAS bf16_t*)(F.lds + 82944);
    const int j = wave * 16 + l15, ch = n * 128 + j;
    bf16x8 wg[2][4];
#pragma unroll
    for (int g = 0; g < 2; ++g) { const bf16_t* gp = F.GT() + (size_t)((g * 2 + D) * 8 + n) * 16384 + (size_t)j * 128 + q4 * 8;
#pragma unroll
        for (int ks = 0; ks < 4; ++ks) wg[g][ks] = *(const bf16x8*)(gp + ks * 32); }
    const float br_ = p.rg_b_r[D * 1024 + ch], bi_ = p.rg_b_i[D * 1024 + ch], sp = softplusf_(-p.rg_lam[D * 1024 + ch]);
    float hb = 0.f;
    u32x4 rows[5];
    rg_load_rows(F, seq * 4 + (D == 0 ? 0 : 3), n, rows);
#pragma unroll 1
    for (int cs = 0; cs < 4; ++cs) {
        const int cidx = D == 0 ? cs : 3 - cs, ci = seq * 4 + cidx, t0 = ci * 64;
        rg_conv_lds(p, F, n, rows, xb, xf);
        if (cs < 3) rg_load_rows(F, seq * 4 + (D == 0 ? cidx + 1 : cidx - 1), n, rows);
        lds_barrier();
        f32x4 Pa[4], Pb[4]; float Ap[4], Bp[4], Am[4], Bm[4];
        rg_gate_scan<D>(F, wg, br_, bi_, sp, xb, xf, j, Pa, Pb, Ap, Bp, Am, Bm);
#pragma unroll
        for (int mm = 0; mm < 4; ++mm) { const int m = D == 0 ? mm : 3 - mm;
            const float hin = Ap[m] * hb + Bp[m];
#pragma unroll
            for (int r = 0; r < 4; ++r) { const float hv = Pa[m][r] * hin + Pb[m][r]; const int tl = m * 16 + q4 * 4 + r;
                if (D == 0) Hf[(cidx * 64 + tl) * 128 + j] = f2bf(hv);
                else Hs[tl * 128 + j] = hv + bf2f(Hf[(cidx * 64 + tl) * 128 + j]); }
            hb = Am[m] * hb + Bm[m]; }
        lds_barrier();
        if (D == 1) {
#pragma unroll
            for (int i = 0; i < 2; ++i) { const int chunk = tid + 512 * i, c = chunk >> 4, cc = chunk & 15;
                bf16_t* gp = F.PROJ() + (size_t)(t0 + c) * NPROJ + 5120 + n * 128 + cc * 8;
                const u32x4 gv = *(const u32x4*)gp; float g[8]; unpack8(gv, g);
                const f32x4 ha = *(const LAS f32x4*)(Hs + c * 128 + cc * 8), hb2 = *(const LAS f32x4*)(Hs + c * 128 + cc * 8 + 4);
                float o[8];
#pragma unroll
                for (int e = 0; e < 4; ++e) { o[e] = ha[e] * siluf_(g[e]); o[4 + e] = hb2[e] * siluf_(g[4 + e]); }
                *(u32x4*)gp = pack8(o); }
            lds_barrier();
        }
    }
    if (q4 == 0) F.out[OUT_SR + (size_t)(seq * 2 + D) * 1024 + ch] = hb;
}

__device__ __forceinline__ void rg_carry_scan(CParams& p, Frame& F) {
    const int tid = F.tid;
    if (tid < 256 || tid >= 272) return;
    const int g = F.b * 16 + tid - 256; if (g >= 4096) return;
    const int seq = g >> 11, d = (g >> 10) & 1, ch = g & 1023, c_lo = 128 + seq * 64;
    const float* ag0 = F.RGAGG() + (size_t)d * 2048 + ch;
    float h = p.state_rglru[(size_t)(seq * 2 + d) * 1024 + ch];
    float* cr0 = F.CARRY() + (size_t)d * 1024 + ch;
#pragma unroll 1
    for (int u0 = 0; u0 < 64; u0 += 32) {
        float A[32], B[32];
#pragma unroll
        for (int u = 0; u < 32; ++u) { const int cc = d == 0 ? c_lo + u0 + u : c_lo + 63 - u0 - u; A[u] = ag0[(size_t)cc * 4096]; B[u] = ag0[(size_t)cc * 4096 + 1024]; }
#pragma unroll
        for (int u = 0; u < 32; ++u) { const int cc = d == 0 ? c_lo + u0 + u : c_lo + 63 - u0 - u; cr0[(size_t)cc * 2048] = h; h = A[u] * h + B[u]; }
    }
}

__device__ __forceinline__ void phase3(CParams& p, Frame& F) {
    for (int rep = 0; rep < (REP_PHASE == 30 ? 2 : 1); ++rep)
    { u32x4 rows[7]; if (F.b < 2048) p3_load_rows(F, F.b >> 3, F.b & 7, rows);
      for (int it = F.b; it < 2048; it += F.G) p3_delta_item(p, F, it >> 3, it & 7, rows, it + F.G); }
    for (int rep = 0; rep < (REP_PHASE == 31 ? 2 : 1); ++rep) {
    u32x4 rows[5]; if (F.b < 1024) rg_load_rows(F, 128 + (F.b >> 3), F.b & 7, rows);
    for (int it = F.b; it < 1024; it += F.G) rg_item<1>(p, F, 128 + (it >> 3), it & 7, rows, it + F.G); }
    for (int it = F.b; it < 256; it += F.G) { rg_prompt_dir<0>(p, F, it >> 3, it & 7); rg_prompt_dir<1>(p, F, it >> 3, it & 7); }
}

struct P4D { int valid, samp, seq, h, d, sl, ci, seq_lo, seq_hi, last, k, s, nch; };
__device__ __forceinline__ P4D p4_desc(const Frame& F, int k, int s) {
    P4D D; int item;
    if (F.G == 256) {
        const int x = F.b & 7, y = F.b >> 3;
        if (y < 16) { item = (x * 4 + (y >> 2)) * 4 + (y & 3); D.valid = k < 1; }
        else { const int j = y - 16; item = 128 + (x * 64 + (j >> 2) * 16 + k) * 4 + (j & 3); D.valid = k < 16; } }
    else { item = F.b + k * F.G; D.valid = item < 2176; }
    D.samp = item < 128; const int it = D.samp ? item : item - 128, chain = it >> 2;
    D.sl = it & 3; D.seq = chain >> 4; D.h = (chain >> 1) & 7; D.d = chain & 1;
    D.nch = D.samp ? 64 : 4; const int chunk0 = D.samp ? 128 + D.seq * 64 : D.seq * 4;
    D.seq_lo = chunk0 * 64; D.seq_hi = D.seq_lo + D.nch * 64;
    D.ci = D.d == 0 ? chunk0 + s : chunk0 + D.nch - 1 - s; D.last = s == D.nch - 1; D.k = k; D.s = s;
    return D;
}
__device__ __forceinline__ P4D p4_next(const Frame& F, const P4D& D) {
    if (D.s + 1 < D.nch) { P4D N = D; N.s = D.s + 1; N.ci = D.ci + (D.d == 0 ? 1 : -1); N.last = N.s == D.nch - 1; return N; }
    return p4_desc(F, D.k + 1, 0);
}
struct P4Pre { u32x4 k0, k1, q0, q1, ti, at; u32x2 v[4]; float g, b, bc; };
struct P4T { unsigned oKQ, oTA, oV, oG, oGc; int cj; };
__device__ __forceinline__ P4T p4_thread_consts(int tid) {
    P4T T; T.oKQ = (unsigned)(((tid >> 4) * 1024 + (tid & 15) * 8) * 2); T.oTA = (unsigned)tid * 16u;
    T.oV = (unsigned)(((tid >> 3) * NPROJ + (tid & 7) * 4) * 2); T.oG = (unsigned)(tid & 63) * 4u; T.oGc = (unsigned)(tid >> 3) * 4u; T.cj = (tid >> 3) - 2; return T;
}
__device__ __forceinline__ void p4_prefetch(CParams& p, const Frame& F, P4Pre& R, const P4D& D, const P4T& T) {
    const int tid = F.tid, t0 = D.ci * 64, h = D.h;
    const char* kb = (const char*)F.Kc() + (size_t)(D.ci * 8 + h) * 16384;
    const char* qb = (const char*)F.Qc() + ((size_t)t0 * 1024 + h * 128) * 2;
    const char* tb = (const char*)F.TA() + (size_t)(D.ci * 8 + h) * 16384;
    const char* vb = (const char*)F.PROJ() + ((long)(t0 - 2) * NPROJ + 2048 + h * 128 + D.sl * 32) * 2;
    const char* gb = (const char*)F.GB() + (size_t)(D.ci * 8 + h) * 1024 + D.d * 256;
    R.k0 = *(const u32x4*)(kb + T.oTA); R.k1 = *(const u32x4*)(kb + T.oTA + 8192u);
    R.q0 = *(const u32x4*)(qb + T.oKQ); R.q1 = *(const u32x4*)(qb + T.oKQ + 65536u);
    R.ti = *(const u32x4*)(tb + T.oTA); R.at = *(const u32x4*)(tb + T.oTA + 8192u);
#pragma unroll
    for (int j = 0; j < 4; ++j) { const int tok = t0 + T.cj + j; u32x2 v = {0u, 0u};
        if (tok >= D.seq_lo && tok < D.seq_hi) v = *(const u32x2*)(vb + T.oV + (unsigned)(j * NPROJ * 2));
        R.v[j] = v; }
    R.bc = *(const float*)(gb + 512 + T.oGc);
    R.g = 0.f; R.b = 0.f;
    if (tid < 64) { R.g = *(const float*)(gb + T.oG); R.b = *(const float*)(gb + 512 + T.oG); }
}
__device__ __forceinline__ u32x4 tri_mask(u32x4 v, int c, int s0, int d) {
    unsigned w[4] = {v.x, v.y, v.z, v.w};
#pragma unroll
    for (int i = 0; i < 4; ++i) { const int slo = s0 + 2 * i, shi = slo + 1;
        const bool klo = d == 0 ? (c >= slo) : (c <= slo), khi = d == 0 ? (c >= shi) : (c <= shi);
        w[i] &= (klo ? 0x0000FFFFu : 0u) | (khi ? 0xFFFF0000u : 0u); }
    return (u32x4){w[0], w[1], w[2], w[3]};
}
constexpr int P4_KS = 0, P4_TI = 17408, P4_VBT = 26624, P4_WL = 31232, P4_SB = 48640, P4_VT1 = 57344, P4_VT2 = 61952, P4_QS = 66560, P4_AT = 101376, P4_GV = 119808, P4_KT = 122368;
__device__ __forceinline__ void p4_stage(CParams& p, const Frame& F, const P4Pre& R, const P4D& D, int buf, const unsigned (&mk)[2][4], f32x4 (&cw)[4], const f32x4 (&cwn)[4]) {
    const int tid = F.tid, d = D.d;
    LAS unsigned char* Ks = F.lds + P4_KS; LAS unsigned char* Qs = F.lds + P4_QS + buf * 17408; LAS unsigned char* TIs = F.lds + P4_TI;
    LAS unsigned char* ATs = F.lds + P4_AT + buf * 9216; LAS unsigned char* Vbt = F.lds + P4_VBT; LAS float* gv = (LAS float*)(F.lds + P4_GV + buf * 1280);
    { const int row = tid >> 4, cc = tid & 15;
      *(LAS u32x4*)(Qs + row * 272 + cc * 16) = R.q0; *(LAS u32x4*)(Qs + (32 + row) * 272 + cc * 16) = R.q1; }
    { const int dk = tid >> 3, cp = tid & 7; LAS unsigned char* Kts = F.lds + P4_KT;
      *(LAS u32x4*)(Kts + dk * 144 + cp * 16) = R.k0; *(LAS u32x4*)(Kts + (64 + dk) * 144 + cp * 16) = R.k1; }
    { const int c = tid >> 3, s0 = (tid & 7) * 8;
      const unsigned m0 = d ? mk[1][0] : mk[0][0], m1 = d ? mk[1][1] : mk[0][1], m2 = d ? mk[1][2] : mk[0][2], m3 = d ? mk[1][3] : mk[0][3];
      *(LAS u32x4*)(TIs + c * 144 + s0 * 2) = (u32x4){R.ti.x & m0, R.ti.y & m1, R.ti.z & m2, R.ti.w & m3};
      *(LAS u32x4*)(ATs + c * 144 + s0 * 2) = (u32x4){R.at.x & m0, R.at.y & m1, R.at.z & m2, R.at.w & m3}; }
    { const int c = tid >> 3, e0 = (tid & 7) * 4; float o[4] = {0.f, 0.f, 0.f, 0.f};
      if (D.s == 0) {
#pragma unroll
          for (int j = 0; j < 4; ++j) cw[j] = cwn[j]; }
#pragma unroll
      for (int j = 0; j < 4; ++j) { const u32x2 v = R.v[j];
          o[0] += cw[j][0] * __uint_as_float(v.x << 16); o[1] += cw[j][1] * __uint_as_float(v.x & 0xffff0000u);
          o[2] += cw[j][2] * __uint_as_float(v.y << 16); o[3] += cw[j][3] * __uint_as_float(v.y & 0xffff0000u); }
#pragma unroll
      for (int i = 0; i < 4; ++i) ((LAS bf16_t*)Vbt)[(e0 + i) * 72 + c] = f2bf(siluf_(o[i]) * R.bc); }
    if (tid < 64) {
        const float glast = __shfl(R.g, d == 0 ? 63 : 0), eg = __expf(R.g);
        gv[tid] = eg; gv[64 + tid] = R.b * eg; gv[128 + tid] = __expf(glast - R.g); if (tid == 0) gv[192] = __expf(glast);
    }
}
__device__ __forceinline__ void phase4_chains(CParams& p, Frame& F) {
    const int tid = F.tid, lane = F.lane, wave = F.wave, q4 = lane >> 4, l15 = lane & 15;
    LAS unsigned char* Ks = F.lds + P4_KS; LAS unsigned char* TIs = F.lds + P4_TI; LAS unsigned char* Vbt = F.lds + P4_VBT; LAS unsigned char* Wl = F.lds + P4_WL;
    LAS unsigned char* Sb = F.lds + P4_SB; LAS unsigned char* Vt1 = F.lds + P4_VT1; LAS unsigned char* Vt2 = F.lds + P4_VT2;
    const int ct = wave & 3, et = wave >> 2;
    P4D Dc = p4_desc(F, 0, 0);
    if (!Dc.valid) return;
    P4Pre RA, RB;
    f32x4 S[2], U; bf16x8 KT[2];
    unsigned mk[2][4]; f32x4 cw[4], cwn[4];
    { const int c = tid >> 3, s0 = (tid & 7) * 8;
#pragma unroll
      for (int i = 0; i < 4; ++i) { const int slo = s0 + 2 * i, shi = slo + 1;
          mk[0][i] = (c >= slo ? 0x0000FFFFu : 0u) | (c >= shi ? 0xFFFF0000u : 0u); mk[1][i] = (c <= slo ? 0x0000FFFFu : 0u) | (c <= shi ? 0xFFFF0000u : 0u); } }
#define P4_INIT_S(D) do { _Pragma("unroll") for (int nt = 0; nt < 2; ++nt) _Pragma("unroll") for (int r = 0; r < 4; ++r) \
        S[nt][r] = (D).samp ? p.state_delta[(size_t)(((D).seq * 2 + (D).d) * 8 + (D).h) * 16384 + (size_t)(wave * 16 + q4 * 4 + r) * 128 + (D).sl * 32 + nt * 16 + l15] : 0.f; } while (0)
#define P4_WRITE_SB() do { _Pragma("unroll") for (int nt = 0; nt < 2; ++nt) { u32x2 o_; o_.x = pk2(S[nt][0], S[nt][1]); o_.y = pk2(S[nt][2], S[nt][3]); \
        *(LAS u32x2*)(Sb + (nt * 16 + l15) * 272 + (wave * 16 + q4 * 4) * 2) = o_; } } while (0)
#define P4_PRECOMP(buf_) do { const LAS float* gv_ = (const LAS float*)(F.lds + P4_GV + (buf_) * 1280); \
        f32x4 WT[4]; _Pragma("unroll") for (int c_ = 0; c_ < 4; ++c_) WT[c_] = (f32x4){0.f, 0.f, 0.f, 0.f}; \
        _Pragma("unroll") for (int ks = 0; ks < 2; ++ks) { \
            const u32x4 kraw = *(const LAS u32x4*)(F.lds + P4_KT + (wave * 16 + l15) * 144 + ks * 64 + q4 * 16); KT[ks] = __builtin_bit_cast(bf16x8, kraw); \
            const f32x4 sa = *(const LAS f32x4*)(gv_ + 64 + ks * 32 + q4 * 8), sb_ = *(const LAS f32x4*)(gv_ + 64 + ks * 32 + q4 * 8 + 4); \
            float kf[8]; unpack8(kraw, kf); u32x4 kg; \
            kg.x = pk2(kf[0] * sa[0], kf[1] * sa[1]); kg.y = pk2(kf[2] * sa[2], kf[3] * sa[3]); kg.z = pk2(kf[4] * sb_[0], kf[5] * sb_[1]); kg.w = pk2(kf[6] * sb_[2], kf[7] * sb_[3]); \
            const bf16x8 akg = __builtin_bit_cast(bf16x8, kg); \
            _Pragma("unroll") for (int c_ = 0; c_ < 4; ++c_) { const bf16x8 bt = ldfrag(TIs, 144, c_ * 16 + l15, ks * 64 + q4 * 16); WT[c_] = MFMA16(akg, bt, WT[c_]); } } \
        _Pragma("unroll") for (int c_ = 0; c_ < 4; ++c_) { u32x2 o_; o_.x = pk2(WT[c_][0], WT[c_][1]); o_.y = pk2(WT[c_][2], WT[c_][3]); \
            *(LAS u32x2*)(Wl + (c_ * 16 + l15) * 272 + (wave * 16 + q4 * 4) * 2) = o_; } \
        U = (f32x4){0.f, 0.f, 0.f, 0.f}; \
        _Pragma("unroll") for (int ks = 0; ks < 2; ++ks) { const bf16x8 a_ = ldfrag(TIs, 144, ct * 16 + l15, ks * 64 + q4 * 16), b_ = ldfrag(Vbt, 144, et * 16 + l15, ks * 64 + q4 * 16); U = MFMA16(a_, b_, U); } } while (0)

    const P4T T = p4_thread_consts(tid);
    p4_prefetch(p, F, RA, Dc, T);
    P4_INIT_S(Dc);
    { const int e0 = (tid & 7) * 4;
#pragma unroll
      for (int j = 0; j < 4; ++j) cwn[j] = *(const f32x4*)(p.dn_conv_w + j * 3072 + 2048 + Dc.h * 128 + Dc.sl * 32 + e0); }
    p4_stage(p, F, RA, Dc, 0, mk, cw, cwn);
    P4_WRITE_SB();
    P4D Dn = p4_next(F, Dc);
    if (Dn.valid) p4_prefetch(p, F, RA, Dn, T);
    P4D Dnn = Dn; if (Dn.valid) { Dnn = p4_next(F, Dn); if (Dnn.valid) p4_prefetch(p, F, RB, Dnn, T); }
    lds_barrier();
    P4_PRECOMP(0);
    lds_barrier();
    int buf = 0;
#define P4_BODY(RX) { \
        const LAS float* gv = (const LAS float*)(F.lds + P4_GV + buf * 1280); \
        const LAS unsigned char* Qs = F.lds + P4_QS + buf * 17408; const LAS unsigned char* ATs = F.lds + P4_AT + buf * 9216; \
        const int c0 = ct * 16 + q4 * 4, e = et * 16 + l15; \
         \
        f32x4 p1 = {0.f, 0.f, 0.f, 0.f}, oacc = {0.f, 0.f, 0.f, 0.f}; \
_Pragma("unroll") \
        for (int ks = 0; ks < 4; ++ks) { const bf16x8 bs = ldfrag(Sb, 272, et * 16 + l15, ks * 64 + q4 * 16); \
            const bf16x8 aw = ldfrag(Wl, 272, ct * 16 + l15, ks * 64 + q4 * 16), aq = ldfrag(Qs, 272, ct * 16 + l15, ks * 64 + q4 * 16); \
            p1 = MFMA16(aw, bs, p1); oacc = MFMA16(aq, bs, oacc); } \
        { float vn[4]; \
_Pragma("unroll") \
          for (int r = 0; r < 4; ++r) vn[r] = U[r] - p1[r]; \
          u32x2 o1, o2; o1.x = pk2(vn[0], vn[1]); o1.y = pk2(vn[2], vn[3]); \
          o2.x = pk2(vn[0] * gv[128 + c0], vn[1] * gv[128 + c0 + 1]); o2.y = pk2(vn[2] * gv[128 + c0 + 2], vn[3] * gv[128 + c0 + 3]); \
          *(LAS u32x2*)(Vt1 + e * 144 + c0 * 2) = o1; *(LAS u32x2*)(Vt2 + e * 144 + c0 * 2) = o2; } \
_Pragma("unroll") \
        for (int r = 0; r < 4; ++r) oacc[r] *= gv[c0 + r]; \
        P4D D3 = Dnn; \
        if (Dn.valid) { p4_stage(p, F, RX, Dn, buf ^ 1, mk, cw, cwn); \
            if (Dn.last && Dnn.valid) { const int e0_ = (tid & 7) * 4; _Pragma("unroll") for (int j = 0; j < 4; ++j) cwn[j] = *(const f32x4*)(p.dn_conv_w + j * 3072 + 2048 + Dnn.h * 128 + Dnn.sl * 32 + e0_); } if (Dnn.valid) { D3 = p4_next(F, Dnn); if (D3.valid) p4_prefetch(p, F, RX, D3, T); } } \
        lds_barrier(); \
         \
        { const float gl = gv[192]; \
_Pragma("unroll") \
          for (int nt = 0; nt < 2; ++nt) S[nt] *= gl; \
_Pragma("unroll") \
          for (int ks = 0; ks < 2; ++ks) \
_Pragma("unroll") \
              for (int nt = 0; nt < 2; ++nt) { const bf16x8 b_ = ldfrag(Vt2, 144, nt * 16 + l15, ks * 64 + q4 * 16); S[nt] = MFMA16(KT[ks], b_, S[nt]); } } \
_Pragma("unroll") \
        for (int ks = 0; ks < 2; ++ks) { const bf16x8 a_ = ldfrag(ATs, 144, ct * 16 + l15, ks * 64 + q4 * 16), b_ = ldfrag(Vt1, 144, et * 16 + l15, ks * 64 + q4 * 16); oacc = MFMA16(a_, b_, oacc); } \
_Pragma("unroll") \
        for (int r = 0; r < 4; ++r) *(bf16_t*)((char*)F.PROJ() + ((size_t)Dc.ci * 64 * NPROJ + Dc.d * 1024 + Dc.h * 128 + Dc.sl * 32) * 2 + (unsigned)(((c0 + r) * NPROJ + e) * 2)) = f2bf(oacc[r]); \
        if (Dc.last) { \
            if (!Dc.samp) { \
_Pragma("unroll") \
                for (int nt = 0; nt < 2; ++nt) \
_Pragma("unroll") \
                    for (int r = 0; r < 4; ++r) \
                        F.out[OUT_SD + (size_t)((Dc.seq * 2 + Dc.d) * 8 + Dc.h) * 16384 + (size_t)(wave * 16 + q4 * 4 + r) * 128 + Dc.sl * 32 + nt * 16 + l15] = S[nt][r]; \
            } \
            if (Dn.valid) P4_INIT_S(Dn); \
        } \
        P4_WRITE_SB(); \
        if (Dn.valid) P4_PRECOMP(buf ^ 1); \
        lds_barrier(); \
        if (!Dn.valid) break; \
        Dc = Dn; Dn = Dnn; Dnn = D3; buf ^= 1; \
    }
#pragma unroll 1
    for (;;) { P4_BODY(RA) P4_BODY(RB) }
#undef P4_BODY
#undef P4_INIT_S
#undef P4_WRITE_SB
#undef P4_PRECOMP
}
__device__ __forceinline__ void phase4(CParams& p, Frame& F) {
    if (F.G == 256) rg_carry_scan(p, F);
    else if (F.b == 0) {
        for (int g = F.tid; g < 69632; g += 512) { int samp = g >= 65536, gg = samp ? g - 65536 : g, seq = gg >> 11, d = (gg >> 10) & 1, ch = gg & 1023;
            const int nch = samp ? 64 : 4, c_lo = samp ? 128 + seq * 64 : seq * 4; float h = samp ? p.state_rglru[(size_t)(seq * 2 + d) * 1024 + ch] : 0.f;
            for (int i = 0; i < nch; ++i) { const int cc = d == 0 ? c_lo + i : c_lo + nch - 1 - i; const float* ag = F.RGAGG() + (size_t)(cc * 2 + d) * 2048; F.CARRY()[(size_t)(cc * 2 + d) * 1024 + ch] = h; h = ag[ch] * h + ag[1024 + ch]; } } }
    __syncthreads();
    phase4_chains(p, F);
}

__device__ __forceinline__ void phase5(CParams& p, Frame& F) {
    const int lane = F.lane;
    float nw[16];
#pragma unroll
    for (int q = 0; q < 4; ++q) { const f32x4 a = *(const f32x4*)(p.dn_norm_w + (lane & 7) * 16 + q * 4); nw[q * 4] = a[0]; nw[q * 4 + 1] = a[1]; nw[q * 4 + 2] = a[2]; nw[q * 4 + 3] = a[3]; }
#pragma unroll 4
    for (int tok = F.b * 8 + F.wave; tok < NTOK; tok += F.G * 8) {
        const bf16_t* pr = F.PROJ() + (size_t)tok * NPROJ + lane * 16;
        float o[16], z[16]; float ss = 0.f;
#pragma unroll
        for (int hf = 0; hf < 2; ++hf) { const u32x4 a = *(const u32x4*)(pr + hf * 8), b = *(const u32x4*)(pr + 1024 + hf * 8), zz = *(const u32x4*)(pr + 3072 + hf * 8);
            float fa[8], fb[8], fz[8]; unpack8(a, fa); unpack8(b, fb); unpack8(zz, fz);
#pragma unroll
            for (int e = 0; e < 8; ++e) { o[hf * 8 + e] = fa[e] + fb[e]; z[hf * 8 + e] = fz[e]; ss += o[hf * 8 + e] * o[hf * 8 + e]; } }
        ss += __shfl_xor(ss, 1); ss += __shfl_xor(ss, 2); ss += __shfl_xor(ss, 4);
        const float rs = rsqrtf(ss * (1.f / 128.f) + 1e-6f);
#pragma unroll
        for (int hf = 0; hf < 2; ++hf) { float w[8];
#pragma unroll
            for (int e = 0; e < 8; ++e) w[e] = o[hf * 8 + e] * rs * nw[hf * 8 + e] * siluf_(z[hf * 8 + e]);
            *(u32x4*)(F.MIX() + (size_t)tok * 2048 + lane * 16 + hf * 8) = pack8(w); }
        if (tok < 8192) {
            const u32x4 y0 = *(const u32x4*)(pr + 5120), y1 = *(const u32x4*)(pr + 5120 + 8);
            *(u32x4*)(F.MIX() + (size_t)tok * 2048 + 1024 + lane * 16) = y0; *(u32x4*)(F.MIX() + (size_t)tok * 2048 + 1024 + lane * 16 + 8) = y1; }
    }
    __syncthreads();
    for (int it = F.b; it < 1024; it += F.G) { u32x4 rows[5]; rg_load_rows(F, 128 + (it >> 3), it & 7, rows); rg_item<3>(p, F, 128 + (it >> 3), it & 7, rows, it + F.G); }
}

__device__ __forceinline__ void phase6(CParams& p, Frame& F) {
    pg8::Gemm g{F.MIX(), F.WoutT(), NTOK, 1024, 2048}; pg8::StaticOrder S; S.init(NTOK, 1024, F.G, F.b); pg8::EpiF32 E{(float*)F.PROJ(), 3072};
    pg8::gemm_phase<pg8::EpiF32, pg8::StaticOrder>(F.lds, g, S, E);
}

__device__ __forceinline__ void phase7(CParams& p, Frame& F) {
    LAS float* gt = (LAS float*)F.lds;
    for (int tb = F.b; tb < 256; tb += F.G) {
        const int grp = grp_of_block(tb);
        for (int j = F.tid; j < 1024; j += 512) gt[j] = mod_val(p, F, grp, 2048 + j) * p.post_w[j];
        __syncthreads();
#pragma unroll 2
        for (int i = 0; i < 8; ++i) {
            const int tok = tb * 64 + F.wave * 8 + i;
            const float* xr = tok < 8192 ? p.x_prompt + (size_t)tok * 1024 : p.x_sample + (size_t)(tok - 8192) * 1024;
            const float* yr = (const float*)F.PROJ() + (size_t)tok * 3072;
            f32x4 y[4]; float ss = 0.f;
#pragma unroll
            for (int q = 0; q < 4; ++q) { y[q] = *(const f32x4*)(yr + F.lane * 4 + 256 * q); ss += (y[q][0] * y[q][0] + y[q][1] * y[q][1]) + (y[q][2] * y[q][2] + y[q][3] * y[q][3]); }
            const float rstd = rsqrtf(wave_sum(ss) * (1.f / 1024.f) + 1e-6f);
#pragma unroll
            for (int q = 0; q < 4; ++q) { const int j = F.lane * 4 + 256 * q; f32x4 v = *(const f32x4*)(xr + j);
                if (tok >= 8192) { const int pp = (tok - 8192) & 4095; const int vv = (q < 2) ? (pp >> 6) : (pp & 63);
                    v += *(const f32x4*)(F.pe() + ((q & 1) ? 16384 : 0) + vv * 256 + F.lane * 4); }
                const f32x4 g4 = *(const LAS f32x4*)(gt + j);
                f32x4 ov = v + g4 * (y[q] * rstd); ov[0] = fin(ov[0]); ov[1] = fin(ov[1]); ov[2] = fin(ov[2]); ov[3] = fin(ov[3]); if (!(LIVE_MASK & 1)) ov = (f32x4){0.f, 0.f, 0.f, 0.f}; *(f32x4*)(F.out + (size_t)tok * 1024 + j) = ov; }
        }
        __syncthreads();
    }
}

__device__ __forceinline__ void phase8(CParams& p, Frame& F) {
    if (F.b == 0 && F.tid == 0) { int code = 0; for (int k = 31; k >= 1; --k) if (DG(F)[k]) code = k; F.out[OUT_SR] = 1000.f * (float)code + 500.f; }
}
extern __shared__ __attribute__((aligned(16))) unsigned char smem_raw[];
__global__ void __launch_bounds__(512) fwd_megakernel(Params p_unused) {
    CParams& p = *(CParams*)__builtin_amdgcn_kernarg_segment_ptr();
    Frame F;
    F.lds = (LAS unsigned char*)smem_raw;
    F.tid = threadIdx.x; F.lane = F.tid & 63; F.wave = __builtin_amdgcn_readfirstlane(F.tid >> 6); F.G = gridDim.x; F.b = blockIdx.x;
    F.out = p.out; F.ws = p.ws;
    volatile LAS unsigned* xbw = (volatile LAS unsigned*)(F.lds + LDS_BYTES - 16);
    const bool multi = (p.ph_hi - p.ph_lo) > 1;
    XcdBarrier xb; xb.bar = (unsigned*)(p.ws + WS_CTL); xb.x = 0; xb.st = xbw;
    if (multi) {
        if (F.tid == 0) { xbw[0] = 0u; xbw[1] = 0u; xbw[2] = 0u; xbw[3] = 0u; }
        __syncthreads();
        xb = xcd_barrier_post((unsigned*)(p.ws + WS_CTL), xbw);
    }
#ifndef PHMASK
#define PHMASK 511
#endif
    const int lo = p.ph_lo, hi = p.ph_hi;
#ifndef REP_PHASE
#define REP_PHASE -1
#endif
#define RUN_PHASE(k, fn) do { if (lo <= (k) && (k) < hi) { if (PHMASK & (1 << (k))) fn(p, F); if ((k) == REP_PHASE) { __syncthreads(); fn(p, F); } if ((k) + 1 < hi) xcd_barrier(xb); } } while (0)
    RUN_PHASE(0, phase0); RUN_PHASE(1, phase1); RUN_PHASE(2, phase2); RUN_PHASE(3, phase3);
    RUN_PHASE(4, phase4); RUN_PHASE(5, phase5); RUN_PHASE(6, phase6); RUN_PHASE(7, phase7); RUN_PHASE(8, phase8);
}

extern "C" void kernel_launch(void* const* d_in, const int* in_sizes, int n_in, void* d_out, int out_size, void* d_ws, size_t ws_size, hipStream_t stream) {
    static int grid = 0;
    if (grid == 0) {
        int dev = 0, cus = 0;
        if (hipGetDevice(&dev) != hipSuccess || hipDeviceGetAttribute(&cus, hipDeviceAttributeMultiprocessorCount, dev) != hipSuccess) { fprintf(stderr, "kernel_launch: device query failed\n"); grid = -1; return; }
        if (hipFuncSetAttribute((const void*)fwd_megakernel, hipFuncAttributeMaxDynamicSharedMemorySize, LDS_BYTES) != hipSuccess) { fprintf(stderr, "kernel_launch: hipFuncSetAttribute failed\n"); grid = -1; return; }
        int per_cu = 0;
        if (hipOccupancyMaxActiveBlocksPerMultiprocessor(&per_cu, (const void*)fwd_megakernel, 512, LDS_BYTES) != hipSuccess || per_cu < 1) { fprintf(stderr, "kernel_launch: occupancy query says %d blocks per CU\n", per_cu); (void)hipGetLastError(); }
        grid = cus;
    }
    if (grid < 0) return;
    Params p{};
    const float** pp = (const float**)&p;
    for (int i = 0; i < 23; ++i) pp[i] = (const float*)d_in[i];
    p.out = (float*)d_out; p.ws = (unsigned char*)d_ws;
    (void)hipMemsetAsync((char*)d_ws + WS_CTL, 0, 16384, stream);
#if MK_SINGLE
    p.ph_lo = 0; p.ph_hi = NPH;
    void* args[] = {&p};
    hipError_t e = hipLaunchCooperativeKernel((const void*)fwd_megakernel, dim3(grid), dim3(512), args, LDS_BYTES, stream);
    if (e != hipSuccess) fprintf(stderr, "cooperative launch failed: %s (grid %d)\n", hipGetErrorString(e), grid);
#else
    for (int ph = 0; ph < NPH; ++ph) {
        p.ph_lo = ph; p.ph_hi = ph + 1;
        hipLaunchKernelGGL(fwd_megakernel, dim3(grid), dim3(512), LDS_BYTES, stream, p);
    }
#endif
}
```

```cpp
#include <hip/hip_runtime.h>
#include <cstdio>
#include <cstdint>

#define LAS __attribute__((address_space(3)))
typedef unsigned short bf16_t;
typedef short bf16x8 __attribute__((ext_vector_type(8)));
typedef float f32x4 __attribute__((ext_vector_type(4)));
typedef unsigned u32x4 __attribute__((ext_vector_type(4)));
typedef unsigned u32x2 __attribute__((ext_vector_type(2)));

#ifndef REP_PHASE
#define REP_PHASE -1
#endif
#ifndef MK_SINGLE
#define MK_SINGLE 1
#endif

constexpr int NTOK = 16384, DM = 1024, NPROJ = 6144, DIN = 6176;
constexpr int NPH = 8;
constexpr int LDS_BYTES = 160 * 1024;
constexpr size_t OUT_YP = 0, OUT_YS = 8388608, OUT_SD = 16777216, OUT_SR = 25165824;
constexpr size_t WS_CTL = 0, WS_MODP = 16384, WS_PE = 606208, WS_BA = 737280, WS_GB = 2834432, WS_RGAGG = 4931584,
                 WS_WBAT = 9125888, WS_WOUTT = 9191424, WS_GT = 13385728, WS_WINT = 14434304, WS_TA = 27017216, WS_PROJ = 60571648, WS_CARRY = 261898240;

struct Params {
    const float *x_prompt, *x_sample, *state_delta, *state_rglru, *c, *c_ctx, *ada_w, *ada_b, *pre_w, *post_w, *w_in, *w_out,
                *dn_conv_w, *dn_a_log, *dn_dt_bias, *dn_norm_w, *rg_conv_w, *rg_conv_b, *rg_w_r, *rg_b_r, *rg_w_i, *rg_b_i, *rg_lam;
    float* out; unsigned char* ws;
    int ph_lo, ph_hi;
};

__device__ __forceinline__ float bf2f(unsigned short b) { return __uint_as_float(((unsigned)b) << 16); }
typedef __bf16 bf2_t __attribute__((ext_vector_type(2)));
typedef float f2_t __attribute__((ext_vector_type(2)));
__device__ __forceinline__ unsigned pk2(float lo, float hi) { const f2_t v = {lo, hi}; return __builtin_bit_cast(unsigned, __builtin_convertvector(v, bf2_t)); }
__device__ __forceinline__ unsigned short f2bf(float f) { return (unsigned short)(pk2(f, f) & 0xffffu); }
#ifndef SANITIZE
#define SANITIZE 0
#endif
#ifndef LIVE_MASK
#define LIVE_MASK 15
#endif
__device__ __forceinline__ float fin(float x) { return (SANITIZE && ((__float_as_uint(x) & 0x7f800000u) == 0x7f800000u)) ? 0.f : x; }
#define DG(F) ((unsigned*)((F).ws + WS_CTL))
__device__ __forceinline__ bool badv(float x, float lim) { return ((__float_as_uint(x) & 0x7f800000u) == 0x7f800000u) || fabsf(x) > lim; }
#ifndef DIAG
#define DIAG 0
#endif
#define CHK(F, k, bad) do { if (DIAG && (bad)) DG(F)[k] = 1u; } while (0)
__device__ __forceinline__ float sigm(float x) { return __builtin_amdgcn_rcpf(1.f + __expf(-x)); }
__device__ __forceinline__ float siluf_(float x) { return x * __builtin_amdgcn_rcpf(1.f + __expf(-x)); }
__device__ __forceinline__ float softplusf_(float x) { return x > 20.f ? x : log1pf(__expf(x)); }
__device__ __forceinline__ void unpack8(const u32x4 v, float (&f)[8]) {
    f[0] = __uint_as_float(v.x << 16); f[1] = __uint_as_float(v.x & 0xffff0000u);
    f[2] = __uint_as_float(v.y << 16); f[3] = __uint_as_float(v.y & 0xffff0000u);
    f[4] = __uint_as_float(v.z << 16); f[5] = __uint_as_float(v.z & 0xffff0000u);
    f[6] = __uint_as_float(v.w << 16); f[7] = __uint_as_float(v.w & 0xffff0000u);
}
__device__ __forceinline__ u32x4 pack8(const float (&f)[8]) { u32x4 o; o.x = pk2(f[0], f[1]); o.y = pk2(f[2], f[3]); o.z = pk2(f[4], f[5]); o.w = pk2(f[6], f[7]); return o; }
__device__ __forceinline__ float wave_sum(float v) {
#pragma unroll
    for (int o = 1; o < 64; o <<= 1) v += __shfl_xor(v, o);
    return v;
}
__device__ __forceinline__ void lds_barrier() { asm volatile("s_waitcnt lgkmcnt(0)" ::: "memory"); __builtin_amdgcn_s_barrier(); asm volatile("" ::: "memory"); }
#define MFMA16(a, b, c) __builtin_amdgcn_mfma_f32_16x16x32_bf16((a), (b), (c), 0, 0, 0)
#define LDS_WAIT() asm volatile("s_waitcnt lgkmcnt(0)" ::: "memory")
__device__ __forceinline__ bf16x8 ldfrag(const LAS unsigned char* base, int pitch, int row, int kb) { return *(const LAS bf16x8*)(base + row * pitch + kb); }

#define XB_TMO      128
#define XB_XCNT(j)  (256  + 64 * (j))
#define XB_XSUB(j)  (1280 + 64 * (j))
#define XB_XGEN(j)  (2304 + 64 * (j))
#define XB_TOP      3328
#define XB_TOPGEN   3392
#define XCD_BAR_WORDS 3456
#define XB_SPIN_CAP (1u << 18)
__device__ __forceinline__ unsigned xb_ld(unsigned* p)              { return __hip_atomic_load(p, __ATOMIC_RELAXED, __HIP_MEMORY_SCOPE_AGENT); }
__device__ __forceinline__ unsigned xb_add(unsigned* p, unsigned v) { return __hip_atomic_fetch_add(p, v, __ATOMIC_RELAXED, __HIP_MEMORY_SCOPE_AGENT); }
__device__ __forceinline__ unsigned xb_xcc_id() { return (unsigned)__builtin_amdgcn_s_getreg((3 << 11) | 20) & 0xFu; }
#define XB_SPIN(cond, bar) do { unsigned _sp = 0; while (cond) { __builtin_amdgcn_s_sleep(1); \
    if ((++_sp & 255u) == 0u) { if (xb_ld(&(bar)[XB_TMO])) break; if (_sp > XB_SPIN_CAP) { atomicAdd(&(bar)[XB_TMO], 1u); break; } } } } while (0)
struct XcdBarrier { unsigned* bar; unsigned x; volatile LAS unsigned* st; };
__device__ __forceinline__ XcdBarrier xcd_barrier_post(unsigned* bar, volatile LAS unsigned* st) {
    XcdBarrier b; b.bar = bar; b.x = xb_xcc_id(); b.st = st;
    if (threadIdx.x == 0) (void)xb_add(&bar[XB_XCNT(b.x)], 1u);
    return b;
}
__device__ __forceinline__ void xcd_barrier_complete(unsigned* bar, unsigned x, unsigned& nloc, unsigned& nx) {
    const unsigned G = gridDim.x * gridDim.y * gridDim.z;
    unsigned sum, cnt, mine, sp = 0u;
    for (;;) {
        sum = 0u; cnt = 0u; mine = 0u;
#pragma unroll
        for (unsigned j = 0; j < 16; ++j) { const unsigned c = xb_ld(&bar[XB_XCNT(j)]); sum += c; cnt += (c > 0u) ? 1u : 0u; mine = (j == x) ? c : mine; }
        if (sum == G) break;
        __builtin_amdgcn_s_sleep(1);
        if ((++sp & 255u) == 0u) { if (xb_ld(&bar[XB_TMO])) break; if (sp > XB_SPIN_CAP) { atomicAdd(&bar[XB_TMO], 1u); break; } }
    }
    nloc = mine > 0u ? mine : 1u; nx = cnt > 0u ? cnt : 1u;
}
__device__ __forceinline__ void xcd_barrier(const XcdBarrier& b) {
    asm volatile("s_waitcnt vmcnt(0)" ::: "memory");
    __syncthreads();
    if (threadIdx.x == 0) {
        unsigned* bar = b.bar;
        __builtin_amdgcn_s_waitcnt(0);
        unsigned nloc = b.st[0], nx = b.st[1];
        if (nloc == 0u) { xcd_barrier_complete(bar, b.x, nloc, nx); b.st[0] = nloc; b.st[1] = nx; }
        const unsigned old = xb_add(&bar[XB_XSUB(b.x)], 1u);
        const unsigned gen = old / nloc;
        if (old + 1u == (gen + 1u) * nloc) {
            __builtin_amdgcn_fence(__ATOMIC_RELEASE, "agent");
            asm volatile("s_waitcnt vmcnt(0)" ::: "memory");
            const unsigned og = xb_add(&bar[XB_TOP], 1u);
            const unsigned tg = og / nx;
            if (og + 1u == (tg + 1u) * nx) xb_add(&bar[XB_TOPGEN], 1u);
            else XB_SPIN(xb_ld(&bar[XB_TOPGEN]) == tg, bar);
            __builtin_amdgcn_fence(__ATOMIC_ACQUIRE, "agent");
            xb_add(&bar[XB_XGEN(b.x)], 1u);
            asm volatile("s_waitcnt vmcnt(0)" ::: "memory");
        } else {
            XB_SPIN(xb_ld(&bar[XB_XGEN(b.x)]) == gen, bar);
            __builtin_amdgcn_fence(__ATOMIC_ACQUIRE, "agent");
            asm volatile("s_waitcnt vmcnt(0)" ::: "memory");
        }
    }
    __syncthreads();
}

namespace pg8 {
constexpr int BM = 256, BK = 64, HALF = 128, HTB = HALF * BK * 2, STAGE_BYTES = 8 * HTB, NXCD = 8, WGM = 8;
__host__ __device__ __forceinline__ int lds_byte(int r, int c) { const int st = (r >> 4) * 2 + (c >> 5), rr = r & 15, cc = c & 31, ob = rr * 64 + cc * 2; return st * 1024 + (ob ^ (((ob >> 9) & 1) << 5)); }
__host__ __device__ __forceinline__ void stage_rc(int b, int& R, int& C) { const int st = b / 1024, sb = b % 1024, swz = sb ^ (((sb >> 9) & 1) << 5); R = (st >> 1) * 16 + swz / 64; C = (st & 1) * 32 + (swz % 64) / 2; }
__host__ __device__ __forceinline__ int perm32(int rho) { const int n = rho >> 4, i = rho & 15; return 8 * (i >> 2) + 4 * n + (i & 3); }
struct Unit { int pm, pn; };
struct Gemm { const bf16_t* A; const bf16_t* Bt; int M, N, K; };
struct StaticOrder {
    int nM, nN, nwg, G, c;
    __host__ __device__ void init(int M, int N, int G_, int c_) { nM = M / BM; nN = N / BM; nwg = nM * nN; G = G_; c = c_; }
    __host__ __device__ bool next(int i, Unit& u) const {
        const long L = (long)i * G + c; if (L >= nwg) return false;
        int wgid = (int)L; { const int q = nwg / NXCD, r = nwg % NXCD, xcd = wgid % NXCD, off = wgid / NXCD; wgid = (xcd < r ? xcd * (q + 1) : r * (q + 1) + (xcd - r) * q) + off; }
        const int nig = WGM * nN, gid = wgid / nig, fm = gid * WGM, gsz = (nM - fm) < WGM ? (nM - fm) : WGM;
        u.pm = fm + ((wgid % nig) % gsz); u.pn = (wgid % nig) / gsz; return true;
    }
};
__device__ __forceinline__ unsigned cvt_pk_bf16(float lo, float hi) { unsigned r; asm volatile("v_cvt_pk_bf16_f32 %0, %1, %2" : "=v"(r) : "v"(lo), "v"(hi)); return r; }
struct EpiF32 {
    static constexpr bool PERM = false;
    float* C; int ldc;
    __device__ __forceinline__ void operator()(const f32x4 (&acc)[2][2][4][2], const Unit& u, int wr, int wc, int fr, int fq) const {
        const int row0 = u.pm * BM + wr * 64 + fr, col0 = u.pn * BM + wc * 32 + 4 * fq;
#pragma unroll
        for (int ai = 0; ai < 2; ++ai)
#pragma unroll
            for (int m = 0; m < 4; ++m) { float* rowp = C + (size_t)(row0 + ai * HALF + m * 16) * ldc + col0;
#pragma unroll
                for (int bj = 0; bj < 2; ++bj)
#pragma unroll
                    for (int n = 0; n < 2; ++n) *(f32x4*)(rowp + bj * HALF + n * 16) = acc[ai][bj][m][n]; }
    }
};
struct EpiBf16 {
    static constexpr bool PERM = true;
    bf16_t* O; int ldc;
    __device__ __forceinline__ void operator()(const f32x4 (&acc)[2][2][4][2], const Unit& u, int wr, int wc, int fr, int fq) const {
        const int row0 = u.pm * BM + wr * 64 + fr; const int col0 = u.pn * BM + wc * 32 + 8 * fq;
#pragma unroll
        for (int ai = 0; ai < 2; ++ai)
#pragma unroll
            for (int m = 0; m < 4; ++m) { bf16_t* rowp = O + (size_t)(row0 + ai * HALF + m * 16) * ldc + col0;
#pragma unroll
                for (int bj = 0; bj < 2; ++bj) { const f32x4 v0 = acc[ai][bj][m][0], v1 = acc[ai][bj][m][1];
                    u32x4 w; w.x = cvt_pk_bf16(v0[0], v0[1]); w.y = cvt_pk_bf16(v0[2], v0[3]); w.z = cvt_pk_bf16(v1[0], v1[1]); w.w = cvt_pk_bf16(v1[2], v1[3]);
                    *(u32x4*)(rowp + bj * HALF) = w; } }
    }
};

template <class Epi, class Sched>
__device__ __forceinline__ void gemm_phase(LAS unsigned char* lds, const Gemm g, const Sched& S, const Epi& E) {
    const int tid = threadIdx.x, wid = __builtin_amdgcn_readfirstlane(tid >> 6), lane = tid & 63, wr = wid >> 2, wc = wid & 3, fr = lane & 15, fq = lane >> 4;
    const int K = g.K, nt = K / BK;
    unsigned voffA[2], voffB[2];
#pragma unroll
    for (int i = 0; i < 2; ++i) { int R, C; stage_rc(tid * 16 + i * 8192, R, C); const int Rb = Epi::PERM ? ((R & ~31) + perm32(R & 31)) : R;
        voffA[i] = (unsigned)(R * K + C) * 2u; voffB[i] = (unsigned)(Rb * K + C) * 2u; }
    const size_t kstep = (size_t)(BK * 2);
    const size_t hstep = (size_t)HALF * K * 2;
    const size_t tstep = 2 * hstep;
    const unsigned ldsw = (unsigned)wid * 1024u;
    const int aoff = lds_byte(wr * 64 + fr, fq * 8), boff = lds_byte(wc * 32 + fr, fq * 8);
#define PG8_SA(b, h) (((b) * 2 + (h)) * HTB)
#define PG8_SB(b, h) ((4 + (b) * 2 + (h)) * HTB)
#define PG8_STAGE(bufoff, gbase, voff) do { _Pragma("unroll") for (int _i = 0; _i < 2; ++_i) \
        __builtin_amdgcn_global_load_lds((const unsigned*)((const char*)(gbase) + (voff)[_i]), (LAS unsigned*)(lds + (bufoff) + ldsw + _i * 8192), 16, 0, 0); } while (0)
#define PG8_LDA(dst, b, h) do { _Pragma("unroll") for (int m = 0; m < 4; ++m) _Pragma("unroll") for (int k = 0; k < 2; ++k) dst[m][k] = *(const LAS bf16x8*)(lds + PG8_SA(b, h) + aoff + m * 2048 + k * 1024); } while (0)
#define PG8_LDB(dst, b, h) do { _Pragma("unroll") for (int n = 0; n < 2; ++n) _Pragma("unroll") for (int k = 0; k < 2; ++k) dst[n][k] = *(const LAS bf16x8*)(lds + PG8_SB(b, h) + boff + n * 2048 + k * 1024); } while (0)
#define PG8_MMA(ai, bj, At, Bt) do { __builtin_amdgcn_s_setprio(1); _Pragma("unroll") for (int m = 0; m < 4; ++m) _Pragma("unroll") for (int n = 0; n < 2; ++n) _Pragma("unroll") for (int k = 0; k < 2; ++k) \
        acc[ai][bj][m][n] = __builtin_amdgcn_mfma_f32_16x16x32_bf16(Bt[n][k], At[m][k], acc[ai][bj][m][n], 0, 0, 0); __builtin_amdgcn_s_setprio(0); } while (0)
#define PG8_WAIT_V(n) asm volatile("s_waitcnt vmcnt(" #n ")" ::: "memory")
#define PG8_WAIT_L(n) asm volatile("s_waitcnt lgkmcnt(" #n ")" ::: "memory")
#define PG8_BAR __builtin_amdgcn_s_barrier()
#define PG8_SCHED __builtin_amdgcn_sched_barrier(0)
    Unit cur, nxt; int ui = 0;
    if (!S.next(0, cur)) return;
    f32x4 acc[2][2][4][2];
#pragma unroll
    for (int a = 0; a < 2; ++a)
#pragma unroll
        for (int b = 0; b < 2; ++b)
#pragma unroll
            for (int m = 0; m < 4; ++m)
#pragma unroll
                for (int n = 0; n < 2; ++n) acc[a][b][m][n] = (f32x4){0.f, 0.f, 0.f, 0.f};
    bf16x8 At[4][2], B0[2][2], B1[2][2];
    const char* cA = (const char*)g.A + (size_t)cur.pm * tstep; const char* cB = (const char*)g.Bt + (size_t)cur.pn * tstep;
    PG8_STAGE(PG8_SB(0, 0), cB, voffB); PG8_STAGE(PG8_SA(0, 0), cA, voffA); PG8_STAGE(PG8_SB(0, 1), cB + hstep, voffB); PG8_STAGE(PG8_SA(0, 1), cA + hstep, voffA);
    if (wr == 1) PG8_BAR;
    PG8_WAIT_V(4); PG8_BAR;
    PG8_STAGE(PG8_SB(1, 0), cB + kstep, voffB); PG8_STAGE(PG8_SA(1, 0), cA + kstep, voffA); PG8_STAGE(PG8_SB(1, 1), cB + hstep + kstep, voffB);
    PG8_WAIT_V(6); PG8_BAR;
    for (;;) {
        const bool has_next = S.next(ui + 1, nxt);
        const char* nA = has_next ? (const char*)g.A + (size_t)nxt.pm * tstep : cA; const char* nB = has_next ? (const char*)g.Bt + (size_t)nxt.pn * tstep : cB;
        for (int t = 0; t < nt; t += 2) {
            const bool last = (t == nt - 2);
            const char* a1 = cA + (size_t)(t + 1) * kstep;
            const char* a2 = last ? nA : cA + (size_t)(t + 2) * kstep; const char* b2 = last ? nB : cB + (size_t)(t + 2) * kstep;
            const char* a3 = a2 + kstep; const char* b3 = b2 + kstep;
            PG8_LDB(B0, 0, 0); PG8_SCHED; PG8_LDA(At, 0, 0); PG8_STAGE(PG8_SA(1, 1), a1 + hstep, voffA);
            PG8_WAIT_L(8); PG8_BAR; PG8_WAIT_L(0); PG8_MMA(0, 0, At, B0); PG8_BAR; PG8_SCHED;
            PG8_LDB(B1, 0, 1); PG8_STAGE(PG8_SB(0, 0), b2, voffB);
            PG8_BAR; PG8_WAIT_L(0); PG8_MMA(0, 1, At, B1); PG8_BAR;
            PG8_LDA(At, 0, 1); PG8_STAGE(PG8_SA(0, 0), a2, voffA);
            PG8_BAR; PG8_WAIT_L(0); PG8_MMA(1, 0, At, B0); PG8_BAR; PG8_SCHED;
            PG8_STAGE(PG8_SB(0, 1), b2 + hstep, voffB);
            PG8_WAIT_V(6); PG8_BAR; PG8_MMA(1, 1, At, B1); PG8_BAR;
            PG8_LDB(B0, 1, 0); PG8_SCHED; PG8_LDA(At, 1, 0); PG8_STAGE(PG8_SA(0, 1), a2 + hstep, voffA);
            PG8_WAIT_L(8); PG8_BAR; PG8_WAIT_L(0); PG8_MMA(0, 0, At, B0); PG8_BAR; PG8_SCHED;
            PG8_LDB(B1, 1, 1); PG8_STAGE(PG8_SB(1, 0), b3, voffB);
            PG8_BAR; PG8_WAIT_L(0); PG8_MMA(0, 1, At, B1); PG8_BAR;
            PG8_LDA(At, 1, 1); PG8_STAGE(PG8_SA(1, 0), a3, voffA);
            PG8_BAR; PG8_WAIT_L(0); PG8_MMA(1, 0, At, B0); PG8_BAR; PG8_SCHED;
            PG8_STAGE(PG8_SB(1, 1), b3 + hstep, voffB);
            PG8_WAIT_V(6); PG8_BAR; PG8_MMA(1, 1, At, B1); PG8_BAR;
        }
        E(acc, cur, wr, wc, fr, fq);
        if (!has_next) break;
#pragma unroll
        for (int a = 0; a < 2; ++a)
#pragma unroll
            for (int b = 0; b < 2; ++b)
#pragma unroll
                for (int m = 0; m < 4; ++m)
#pragma unroll
                    for (int n = 0; n < 2; ++n) acc[a][b][m][n] = (f32x4){0.f, 0.f, 0.f, 0.f};
        cur = nxt; cA = nA; cB = nB; ++ui;
    }
    PG8_WAIT_V(0);
    if (wr == 0) PG8_BAR;
    PG8_BAR;
#undef PG8_SA
#undef PG8_SB
#undef PG8_STAGE
#undef PG8_LDA
#undef PG8_LDB
#undef PG8_MMA
#undef PG8_WAIT_V
#undef PG8_WAIT_L
#undef PG8_BAR
#undef PG8_SCHED
}
}

struct Frame {
    LAS unsigned char* lds;
    int tid, lane, wave, G, b;
    float* out; unsigned char* ws;
    __device__ __forceinline__ bf16_t* H() const { return (bf16_t*)out; }
    __device__ __forceinline__ bf16_t* Qc() const { return (bf16_t*)out; }
    __device__ __forceinline__ bf16_t* Kc() const { return (bf16_t*)(out + OUT_YS); }
    __device__ __forceinline__ bf16_t* MIX() const { return (bf16_t*)out; }
    __device__ __forceinline__ float* modp() const { return (float*)(ws + WS_MODP); }
    __device__ __forceinline__ float* pe() const { return (float*)(ws + WS_PE); }
    __device__ __forceinline__ float* BA() const { return (float*)(ws + WS_BA); }
    __device__ __forceinline__ float* GB() const { return (float*)(ws + WS_GB); }
    __device__ __forceinline__ float* RGAGG() const { return (float*)(ws + WS_RGAGG); }
    __device__ __forceinline__ bf16_t* WbaT() const { return (bf16_t*)(ws + WS_WBAT); }
    __device__ __forceinline__ bf16_t* WoutT() const { return (bf16_t*)(ws + WS_WOUTT); }
    __device__ __forceinline__ bf16_t* GT() const { return (bf16_t*)(ws + WS_GT); }
    __device__ __forceinline__ bf16_t* WinT() const { return (bf16_t*)(ws + WS_WINT); }
    __device__ __forceinline__ bf16_t* TA() const { return (bf16_t*)(ws + WS_TA); }
    __device__ __forceinline__ bf16_t* PROJ() const { return (bf16_t*)(ws + WS_PROJ); }
    __device__ __forceinline__ float* CARRY() const { return (float*)(ws + WS_CARRY); }
};
typedef const __attribute__((address_space(4))) Params CParams;

__device__ __forceinline__ int grp_of_block(int tb) { return tb < 128 ? 0 : (tb < 192 ? 1 : 2); }

__device__ __forceinline__ void transpose_item(const float* W, int N, int k0, int n0, bf16_t* WT0, int Kout, LAS float* scr, int lane) {
#pragma unroll 8
    for (int i = 0; i < 32; ++i) { const int kk = 2 * i + (lane >> 5); scr[kk * 33 + (lane & 31)] = W[(size_t)(k0 + kk) * N + n0 + (lane & 31)]; }
    LDS_WAIT();
    const int c = lane & 7;
#pragma unroll
    for (int j = 0; j < 4; ++j) { const int n = (lane >> 3) + 8 * j; const LAS float* s = scr + (8 * c) * 33 + n;
        u32x4 o; o.x = pk2(s[0 * 33], s[1 * 33]); o.y = pk2(s[2 * 33], s[3 * 33]); o.z = pk2(s[4 * 33], s[5 * 33]); o.w = pk2(s[6 * 33], s[7 * 33]);
        *(u32x4*)(WT0 + (size_t)n * Kout + k0 + 8 * c) = o; }
    LDS_WAIT();
}
struct P0Item { const float* W; bf16_t* dst; int N, k0, n0, Kout, kind; };
__device__ __forceinline__ P0Item p0_decode(CParams& p, const Frame& F, int it) {
    constexpr int I_IN = 16 * 193, I_OUT = 32 * 32, I_G = 256;
    P0Item D; D.kind = 0; int r = it;
    if (r < I_IN) { const int kb = r / 193, nb = r % 193, n0 = nb * 32;
        D.dst = n0 < 4096 ? F.WinT() + (size_t)n0 * 1024 : (n0 < 4128 ? F.WbaT() + (size_t)(n0 - 4096) * 1024 : F.WinT() + (size_t)(n0 - 32) * 1024);
        D.W = p.w_in; D.N = DIN; D.k0 = kb * 64; D.n0 = n0; D.Kout = 1024; return D; }
    r -= I_IN;
    if (r < I_OUT) { const int kb = r / 32, nb = r % 32; D.W = p.w_out; D.N = 1024; D.k0 = kb * 64; D.n0 = nb * 32; D.dst = F.WoutT() + (size_t)(nb * 32) * 2048; D.Kout = 2048; return D; }
    r -= I_OUT;
    if (r < I_G) { const int m = r >> 3, sub = r & 7, kb = sub >> 2, nb = sub & 3, g = m >> 4, dn = m & 15;
        D.W = (g ? p.rg_w_i : p.rg_w_r) + (size_t)dn * 16384; D.N = 128; D.k0 = kb * 64; D.n0 = nb * 32; D.dst = F.GT() + (size_t)m * 16384 + (size_t)(nb * 32) * 128; D.Kout = 128; return D; }
    r -= I_G;
    D.kind = 1; D.k0 = r; D.W = p.w_in; D.dst = F.WinT(); D.N = 0; D.n0 = 0; D.Kout = 0; return D;
}
__device__ __forceinline__ void p0_load(const P0Item& D, float (&v)[32], int lane) {
#pragma unroll
    for (int i = 0; i < 32; ++i) { const int kk = 2 * i + (lane >> 5); v[i] = D.W[(size_t)(D.k0 + kk) * D.N + D.n0 + (lane & 31)]; }
}
__device__ __forceinline__ void p0_store(const P0Item& D, const float (&v)[32], LAS float* scr, int lane) {
#pragma unroll
    for (int i = 0; i < 32; ++i) { const int kk = 2 * i + (lane >> 5); scr[kk * 33 + (lane & 31)] = v[i]; }
    LDS_WAIT();
    const int c = lane & 7;
#pragma unroll
    for (int j = 0; j < 4; ++j) { const int n = (lane >> 3) + 8 * j; const LAS float* s = scr + (8 * c) * 33 + n;
        u32x4 o; o.x = pk2(s[0 * 33], s[1 * 33]); o.y = pk2(s[2 * 33], s[3 * 33]); o.z = pk2(s[4 * 33], s[5 * 33]); o.w = pk2(s[6 * 33], s[7 * 33]);
        *(u32x4*)(D.dst + (size_t)n * D.Kout + D.k0 + 8 * c) = o; }
    LDS_WAIT();
}
__device__ __forceinline__ void phase0(CParams& p, Frame& F) {
    const int tid = F.tid, lane = F.lane;
    for (int it = F.b; it < 192; it += F.G) {
        const int jg = it % 12, ks = it / 12, j = jg * 256 + (tid & 255), half = tid >> 8, k0 = ks * 64 + half * 32;
        float s0 = 0.f, s1 = 0.f, s2 = 0.f;
#pragma unroll 8
        for (int k = 0; k < 32; ++k) { const int kk = k0 + k; const float w = p.ada_w[(size_t)kk * 3072 + j];
            s0 += siluf_(p.c_ctx[kk]) * w; s1 += siluf_(p.c[kk]) * w; s2 += siluf_(p.c[1024 + kk]) * w; }
        LAS float* red = (LAS float*)F.lds;
        if (half == 1) { red[tid - 256] = s0; red[256 + tid - 256] = s1; red[512 + tid - 256] = s2; }
        __syncthreads();
        if (half == 0) { F.modp()[(size_t)(ks * 3 + 0) * 3072 + j] = s0 + red[tid]; F.modp()[(size_t)(ks * 3 + 1) * 3072 + j] = s1 + red[256 + tid]; F.modp()[(size_t)(ks * 3 + 2) * 3072 + j] = s2 + red[512 + tid]; }
        __syncthreads();
    }
    LAS float* scr = (LAS float*)(F.lds + 4096 + F.wave * 8448);
    const int gw = F.b * 8 + F.wave, NGW = F.G * 8;
    constexpr int I_IN = 16 * 193, I_OUT = 32 * 32, I_G = 256, I_PE = 64, I_ALL = I_IN + I_OUT + I_G + I_PE;
    P0Item D = p0_decode(p, F, gw), Dn = D; float v[32], vn[32];
    if (gw < I_ALL && D.kind == 0) p0_load(D, v, lane);
    for (int it = gw; it < I_ALL; it += NGW) {
        const int itn = it + NGW;
        if (itn < I_ALL) { Dn = p0_decode(p, F, itn); if (Dn.kind == 0) p0_load(Dn, vn, lane); }
        if (D.kind == 0) p0_store(D, v, scr, lane);
        else { const int pv = D.k0;
#pragma unroll
            for (int i = 0; i < 4; ++i) { const int idx = lane * 4 + i; const float f = expf(-9.210340371976184f * (float)idx / 256.f); const float a = (float)pv * f;
                F.pe()[pv * 256 + idx] = sinf(a); F.pe()[16384 + pv * 256 + idx] = cosf(a); } }
        D = Dn;
#pragma unroll
        for (int i = 0; i < 32; ++i) v[i] = vn[i];
    }
}

__device__ __forceinline__ float mod_val(CParams& p, const Frame& F, int grp, int j) {
    float s = p.ada_b[j];
#pragma unroll
    for (int ks = 0; ks < 16; ++ks) s += F.modp()[(size_t)(ks * 3 + grp) * 3072 + j];
    return s;
}

__device__ __forceinline__ void phase1(CParams& p, Frame& F) {
    LAS float* sc = (LAS float*)F.lds; LAS float* sh = sc + 1024;
    for (int tb = F.b; tb < 256; tb += F.G) {
        const int grp = grp_of_block(tb);
        for (int j = F.tid; j < 1024; j += 512) { sh[j] = mod_val(p, F, grp, j); sc[j] = p.pre_w[j] * (1.f + mod_val(p, F, grp, 1024 + j)); }
        __syncthreads();
#pragma unroll 2
        for (int i = 0; i < 8; ++i) {
            const int tok = tb * 64 + F.wave * 8 + i;
            const float* xr = tok < 8192 ? p.x_prompt + (size_t)tok * 1024 : p.x_sample + (size_t)(tok - 8192) * 1024;
            f32x4 v[4]; float ss = 0.f;
#pragma unroll
            for (int q = 0; q < 4; ++q) { v[q] = *(const f32x4*)(xr + F.lane * 4 + 256 * q);
                if (tok >= 8192) { const int pp = (tok - 8192) & 4095; const int vv = (q < 2) ? (pp >> 6) : (pp & 63);
                    const f32x4 e = *(const f32x4*)(F.pe() + ((q & 1) ? 16384 : 0) + vv * 256 + F.lane * 4); v[q] += e; }
                ss += (v[q][0] * v[q][0] + v[q][1] * v[q][1]) + (v[q][2] * v[q][2] + v[q][3] * v[q][3]); }
            const float rstd = rsqrtf(wave_sum(ss) * (1.f / 1024.f) + 1e-6f);
#pragma unroll
            for (int q = 0; q < 4; ++q) { const int j = F.lane * 4 + 256 * q; const f32x4 s4 = *(const LAS f32x4*)(sc + j), h4 = *(const LAS f32x4*)(sh + j);
                CHK(F, 1, badv(v[q][0] * rstd * s4[0] + h4[0], 100.f) || badv(v[q][3] * rstd * s4[3] + h4[3], 100.f));
                u32x2 o; o.x = pk2(v[q][0] * rstd * s4[0] + h4[0], v[q][1] * rstd * s4[1] + h4[1]); o.y = pk2(v[q][2] * rstd * s4[2] + h4[2], v[q][3] * rstd * s4[3] + h4[3]);
                *(u32x2*)(F.H() + (size_t)tok * 1024 + j) = o; }
        }
        __syncthreads();
    }
}

__device__ __forceinline__ void phase2(CParams& p, Frame& F) {
    { pg8::Gemm g{F.H(), F.WinT(), NTOK, NPROJ, 1024}; pg8::StaticOrder S; S.init(NTOK, NPROJ, F.G, F.b); pg8::EpiBf16 E{F.PROJ(), NPROJ};
      pg8::gemm_phase<pg8::EpiBf16, pg8::StaticOrder>(F.lds, g, S, E); }
    const int l15 = F.lane & 15, q4 = F.lane >> 4;
    for (int tb = F.b; tb < 256; tb += F.G) {
        const int mt = F.wave >> 1, nt = F.wave & 1;
        const bf16_t* ar = F.H() + (size_t)(tb * 64 + mt * 16 + l15) * 1024 + q4 * 8;
        const bf16_t* br = F.WbaT() + (size_t)(nt * 16 + l15) * 1024 + q4 * 8;
        f32x4 acc = {0.f, 0.f, 0.f, 0.f};
#pragma unroll 16
        for (int ks = 0; ks < 32; ++ks) { const bf16x8 a = *(const bf16x8*)(ar + ks * 32), b = *(const bf16x8*)(br + ks * 32); acc = MFMA16(a, b, acc); }
#pragma unroll
        for (int r = 0; r < 4; ++r) F.BA()[(size_t)(tb * 64 + mt * 16 + q4 * 4 + r) * 32 + nt * 16 + l15] = acc[r];
    }
}

__device__ __forceinline__ void p3_load_rows(const Frame& F, int ci, int h, u32x4 (&rows)[7]) {
    const int tid = F.tid, tg = tid >> 5, part = (tid >> 4) & 1, sub = tid & 15, col = part * 1024 + h * 128 + sub * 8, t0 = ci * 64;
    int seq_lo, seq_hi; if (ci < 128) { seq_lo = (ci >> 2) * 256; seq_hi = seq_lo + 256; } else { seq_lo = 8192 + ((ci - 128) >> 6) * 4096; seq_hi = seq_lo + 4096; }
    const int tb = t0 + tg * 4 - 2;
#pragma unroll
    for (int r = 0; r < 7; ++r) { const int tok = tb + r; u32x4 v = {0u, 0u, 0u, 0u};
        if (tok >= seq_lo && tok < seq_hi) v = *(const u32x4*)(F.PROJ() + (size_t)tok * NPROJ + col);
        rows[r] = v; }
}
__device__ __forceinline__ void p3_delta_item(CParams& p, Frame& F, int ci, int h, u32x4 (&rows)[7], int itn) {
    const int tid = F.tid, lane = F.lane, wave = F.wave, q4 = lane >> 4, l15 = lane & 15;
    LAS unsigned char* Ks = F.lds; LAS unsigned char* Qs = F.lds + 17408;
    LAS float* gfv = (LAS float*)(F.lds + 34816);
    LAS unsigned char* DIR0 = F.lds + 35840;
    LAS unsigned char* ATo = F.lds + 137728;
#pragma unroll
    for (int i = 0; i < 5; ++i) { const int ch = tid + 512 * i; if (ch < 2304) { const int dd = ch >= 1152, cc = ch - dd * 1152; *(LAS u32x4*)(DIR0 + dd * 47616 + 18432 + cc * 16) = (u32x4){0u, 0u, 0u, 0u}; } }
    const int t0 = ci * 64;
    int seq_lo, seq_hi; if (ci < 128) { seq_lo = (ci >> 2) * 256; seq_hi = seq_lo + 256; } else { seq_lo = 8192 + ((ci - 128) >> 6) * 4096; seq_hi = seq_lo + 4096; }
    {
        const int tg = tid >> 5, part = (tid >> 4) & 1, sub = tid & 15, col = part * 1024 + h * 128 + sub * 8;
        float w[4][8];
#pragma unroll
        for (int j = 0; j < 4; ++j) { const f32x4 a = *(const f32x4*)(p.dn_conv_w + j * 3072 + col), b = *(const f32x4*)(p.dn_conv_w + j * 3072 + col + 4);
            w[j][0] = a[0]; w[j][1] = a[1]; w[j][2] = a[2]; w[j][3] = a[3]; w[j][4] = b[0]; w[j][5] = b[1]; w[j][6] = b[2]; w[j][7] = b[3]; }
        float acc[4][8];
#pragma unroll
        for (int i = 0; i < 4; ++i)
#pragma unroll
            for (int e = 0; e < 8; ++e) acc[i][e] = 0.f;
#pragma unroll
        for (int r = 0; r < 7; ++r) {
            float x[8]; unpack8(rows[r], x);
#pragma unroll
            for (int j = 0; j < 4; ++j) { const int i = r - j; if (i >= 0 && i < 4) {
#pragma unroll
                for (int e = 0; e < 8; ++e) acc[i][e] += w[j][e] * x[e]; } } }
#pragma unroll
        for (int i = 0; i < 4; ++i) { float ss = 0.f;
#pragma unroll
            for (int e = 0; e < 8; ++e) { acc[i][e] = siluf_(acc[i][e]); ss += acc[i][e] * acc[i][e]; }
            ss += __shfl_xor(ss, 1); ss += __shfl_xor(ss, 2); ss += __shfl_xor(ss, 4); ss += __shfl_xor(ss, 8);
            const float rs = rsqrtf(ss + 1e-6f) * (part == 0 ? 0.08838834764831845f : 1.f);
#pragma unroll
            for (int e = 0; e < 8; ++e) acc[i][e] *= rs;
            CHK(F, 4, badv(acc[i][0], 1.01f) || badv(acc[i][5], 1.01f) || badv(ss * rs * rs, part == 0 ? 0.0079f : 1.01f));
            const u32x4 o = pack8(acc[i]); const int c = tg * 4 + i;
            *(LAS u32x4*)((part ? Ks : Qs) + c * 272 + sub * 16) = o;
            if (part == 0) *(u32x4*)(F.Qc() + (size_t)(t0 + c) * 1024 + h * 128 + sub * 8) = o; }
        if (part == 1) {
            bf16_t* kt = F.Kc() + (size_t)(ci * 8 + h) * 8192 + (size_t)(sub * 8) * 64 + tg * 4;
#pragma unroll
            for (int e = 0; e < 8; ++e) { u32x2 o2; o2.x = pk2(acc[0][e], acc[1][e]); o2.y = pk2(acc[2][e], acc[3][e]); *(u32x2*)(kt + e * 64) = o2; } }
    }
    if (wave == 0) {
        const float* ba = F.BA() + (size_t)(t0 + lane) * 32;
        const float bf_ = sigm(ba[h]), bb_ = sigm(ba[8 + h]);
        float s = -expf(p.dn_a_log[h]) * softplusf_(ba[16 + h] + p.dn_dt_bias[h]);
        float sb = -expf(p.dn_a_log[8 + h]) * softplusf_(ba[24 + h] + p.dn_dt_bias[8 + h]);
#pragma unroll
        for (int o = 1; o < 64; o <<= 1) { const float t = __shfl_up(s, o); if (lane >= o) s += t; }
#pragma unroll
        for (int o = 1; o < 64; o <<= 1) { const float t = __shfl_down(sb, o); if (lane + o < 64) sb += t; }
        CHK(F, 3, badv(ba[h], 1000.f) || badv(ba[24 + h], 1000.f));
        CHK(F, 8, badv(s, 1e4f) || badv(sb, 1e4f) || s > 0.f || sb > 0.f || bf_ < 0.f || bf_ > 1.f || bb_ < 0.f || bb_ > 1.f);
        gfv[lane] = s; gfv[64 + lane] = sb; gfv[128 + lane] = bf_; gfv[192 + lane] = bb_;
        float* gb = F.GB() + (size_t)(ci * 8 + h) * 256;
        gb[lane] = s; gb[64 + lane] = sb; gb[128 + lane] = bf_; gb[192 + lane] = bb_;
    }
    lds_barrier();
    const int d = wave >> 2, mt = wave & 3;
    LAS unsigned char* Db = DIR0 + d * 47616;
    LAS unsigned char* Brow = Db; LAS unsigned char* Btr = Db + 9216; LAS unsigned char* Xrow = Db + 18432; LAS unsigned char* Xtr = Db + 27648;
    LAS float* Dl = (LAS float*)(Db + 36864) + mt * 320; LAS unsigned char* M2t = Db + 41984; LAS unsigned char* Mts = Db + 44544 + mt * 768;
    const LAS unsigned char* Lrow = Brow;
    const LAS float* gd = gfv + d * 64; const LAS float* bd = gfv + 128 + d * 64;
    {
        f32x4 kk[4], qk[4];
#pragma unroll
        for (int n = 0; n < 4; ++n) { kk[n] = (f32x4){0.f, 0.f, 0.f, 0.f}; qk[n] = (f32x4){0.f, 0.f, 0.f, 0.f}; }
#pragma unroll
        for (int ks = 0; ks < 4; ++ks) { const bf16x8 ak = ldfrag(Ks, 272, mt * 16 + l15, ks * 64 + q4 * 16), aq = ldfrag(Qs, 272, mt * 16 + l15, ks * 64 + q4 * 16);
#pragma unroll
            for (int n = 0; n < 4; ++n) { const bf16x8 bk = ldfrag(Ks, 272, n * 16 + l15, ks * 64 + q4 * 16); kk[n] = MFMA16(ak, bk, kk[n]); qk[n] = MFMA16(aq, bk, qk[n]); } }
#pragma unroll
        for (int n = 0; n < 4; ++n) { const int C = n * 16 + l15; const float gC = gd[C], bC = bd[C]; float a4[4];
#pragma unroll
            for (int r = 0; r < 4; ++r) { const int R = mt * 16 + q4 * 4 + r;
                const float dec = __expf(-fabsf(gd[R] - gC));
                a4[r] = (C > R) ? (d == 0 ? bC : bd[R]) * kk[n][r] * dec : 0.f;
                const bool incl = d == 0 ? (R >= C) : (R < C);
                if (incl) ((LAS bf16_t*)ATo)[R * 64 + C] = f2bf(qk[n][r] * dec); }
            u32x2 o; o.x = pk2(a4[0], a4[1]); o.y = pk2(a4[2], a4[3]);
            *(LAS u32x2*)(Brow + C * 144 + (mt * 16 + q4 * 4) * 2) = o;
            if (n == mt) *(LAS f32x4*)(Dl + l15 * 20 + q4 * 4) = (f32x4){a4[0], a4[1], a4[2], a4[3]}; }
    }
    lds_barrier();
    if (itn < 2048) p3_load_rows(F, itn >> 3, itn & 7, rows);
    if (lane < 16) {
        float x[16];
#pragma unroll
        for (int i = 0; i < 16; ++i) { float sv = (i == lane) ? 1.f : 0.f;
            float drow[16];
#pragma unroll
            for (int q = 0; q < 4; ++q) if (4 * q < i) { const f32x4 t4 = *(const LAS f32x4*)(Dl + i * 20 + 4 * q); drow[4 * q] = t4[0]; drow[4 * q + 1] = t4[1]; drow[4 * q + 2] = t4[2]; drow[4 * q + 3] = t4[3]; }
#pragma unroll
            for (int j = 0; j < i; ++j) sv -= drow[j] * x[j];
            x[i] = sv; }
#pragma unroll
        for (int i = 0; i < 16; ++i) ((LAS bf16_t*)Xrow)[(mt * 16 + i) * 72 + mt * 16 + lane] = f2bf(x[i]);
        u32x4 o0, o1; o0.x = pk2(x[0], x[1]); o0.y = pk2(x[2], x[3]); o0.z = pk2(x[4], x[5]); o0.w = pk2(x[6], x[7]);
        o1.x = pk2(x[8], x[9]); o1.y = pk2(x[10], x[11]); o1.z = pk2(x[12], x[13]); o1.w = pk2(x[14], x[15]);
        *(LAS u32x4*)(Xtr + (mt * 16 + lane) * 144 + mt * 32) = o0; *(LAS u32x4*)(Xtr + (mt * 16 + lane) * 144 + mt * 32 + 16) = o1;
    }
    lds_barrier();
    const bf16x8 zero8 = {0, 0, 0, 0, 0, 0, 0, 0};
    const f32x4 zero4 = {0.f, 0.f, 0.f, 0.f};
    if (mt & 1) {
        const int I1 = mt, I0 = mt - 1;
        bf16x8 a = zero8, b = zero8;
        if (q4 < 2) { a = ldfrag(Lrow, 144, I1 * 16 + l15, I0 * 32 + q4 * 16); b = ldfrag(Xtr, 144, I0 * 16 + l15, I0 * 32 + q4 * 16); }
        const f32x4 M = MFMA16(a, b, zero4);
        { u32x2 o; o.x = pk2(M[0], M[1]); o.y = pk2(M[2], M[3]); *(LAS u32x2*)(Mts + l15 * 48 + q4 * 8) = o; }
        LDS_WAIT();
        bf16x8 a2 = zero8, b2 = zero8;
        if (q4 < 2) { a2 = ldfrag(Xrow, 144, I1 * 16 + l15, I1 * 32 + q4 * 16); b2 = *(const LAS bf16x8*)(Mts + l15 * 48 + q4 * 16); }
        const f32x4 X = MFMA16(a2, b2, zero4);
#pragma unroll
        for (int r = 0; r < 4; ++r) ((LAS bf16_t*)Xrow)[(I1 * 16 + q4 * 4 + r) * 72 + I0 * 16 + l15] = f2bf(-X[r]);
        u32x2 o; o.x = pk2(-X[0], -X[1]); o.y = pk2(-X[2], -X[3]);
        *(LAS u32x2*)(Xtr + (I0 * 16 + l15) * 144 + (I1 * 16 + q4 * 4) * 2) = o;
    }
    lds_barrier();
    {
        const int mi = mt >> 1, ni = mt & 1;
        const bf16x8 a = ldfrag(Lrow, 144, 32 + mi * 16 + l15, q4 * 16), b = ldfrag(Xtr, 144, ni * 16 + l15, q4 * 16);
        const f32x4 M2 = MFMA16(a, b, zero4);
        { u32x2 o; o.x = pk2(M2[0], M2[1]); o.y = pk2(M2[2], M2[3]); *(LAS u32x2*)(M2t + (ni * 16 + l15) * 80 + (mi * 16 + q4 * 4) * 2) = o; }
        lds_barrier();
        const bf16x8 a2 = ldfrag(Xrow, 144, 32 + mi * 16 + l15, 64 + q4 * 16), b2 = *(const LAS bf16x8*)(M2t + (ni * 16 + l15) * 80 + q4 * 16);
        const f32x4 X = MFMA16(a2, b2, zero4);
#pragma unroll
        for (int r = 0; r < 4; ++r) { CHK(F, 6, badv(X[r], 20.f)); ((LAS bf16_t*)Xrow)[(32 + mi * 16 + q4 * 4 + r) * 72 + ni * 16 + l15] = f2bf(-X[r]); }
        u32x2 o; o.x = pk2(-X[0], -X[1]); o.y = pk2(-X[2], -X[3]);
        *(LAS u32x2*)(Xtr + (ni * 16 + l15) * 144 + (32 + mi * 16 + q4 * 4) * 2) = o;
    }
    lds_barrier();
    { bf16_t* dst = F.TA() + (size_t)(ci * 8 + h) * 8192;
      const int c = tid >> 3, s0 = (tid & 7) * 8;
      const u32x4 lo = *(const LAS u32x4*)(DIR0 + 18432 + c * 144 + s0 * 2), up = *(const LAS u32x4*)(DIR0 + 47616 + 27648 + c * 144 + s0 * 2);
      unsigned wl[4] = {lo.x, lo.y, lo.z, lo.w}, wu[4] = {up.x, up.y, up.z, up.w}, wo[4];
#pragma unroll
      for (int i = 0; i < 4; ++i) { const int sa = s0 + 2 * i, sb2 = sa + 1;
          const unsigned mlo = (sa <= c ? 0x0000FFFFu : 0u) | (sb2 <= c ? 0xFFFF0000u : 0u);
          wo[i] = (wl[i] & mlo) | (wu[i] & ~mlo); }
      *(u32x4*)(dst + tid * 8) = (u32x4){wo[0], wo[1], wo[2], wo[3]};
      *(u32x4*)(dst + 4096 + tid * 8) = *(const LAS u32x4*)(ATo + tid * 16); }
    lds_barrier();
}

struct RgW { bf16x8 g[2][2][4]; float br[2], bi[2], sp[2]; };
__device__ __forceinline__ void rg_load_w(CParams& p, const Frame& F, int n, RgW& W) {
    const int q4 = F.lane >> 4, j = F.wave * 16 + (F.lane & 15), ch = n * 128 + j;
#pragma unroll
    for (int d = 0; d < 2; ++d) {
#pragma unroll
        for (int g = 0; g < 2; ++g) { const bf16_t* gp = F.GT() + (size_t)((g * 2 + d) * 8 + n) * 16384 + (size_t)j * 128 + q4 * 8;
#pragma unroll
            for (int ks = 0; ks < 4; ++ks) W.g[d][g][ks] = *(const bf16x8*)(gp + ks * 32); }
        W.br[d] = p.rg_b_r[d * 1024 + ch]; W.bi[d] = p.rg_b_i[d * 1024 + ch]; W.sp[d] = softplusf_(-p.rg_lam[d * 1024 + ch]); }
}
__device__ __forceinline__ void rg_load_rows(const Frame& F, int ci, int n, u32x4 (&rows)[5]) {
    const int tid = F.tid, tg = tid >> 4, sub = tid & 15, col = 4096 + n * 128 + sub * 8, t0 = ci * 64;
    int c_lo, c_hi; if (ci < 128) { c_lo = (ci >> 2) * 4; c_hi = c_lo + 4; } else { c_lo = 128 + ((ci - 128) >> 6) * 64; c_hi = c_lo + 64; }
    const int tb = t0 + tg * 2 - 2;
#pragma unroll
    for (int r = 0; r < 5; ++r) { const int tok = tb + r; u32x4 v = {0u, 0u, 0u, 0u};
        if (tok >= c_lo * 64 && tok < c_hi * 64) v = *(const u32x4*)(F.PROJ() + (size_t)tok * NPROJ + col);
        rows[r] = v; }
}
template <int PASS>
__device__ __forceinline__ void rg_item(CParams& p, Frame& F, int ci, int n, u32x4 (&rows)[5], int itn) {
    const int tid = F.tid, lane = F.lane, wave = F.wave, q4 = lane >> 4, l15 = lane & 15;
    LAS unsigned char* xb = F.lds; LAS float* xf = (LAS float*)(F.lds + 17408); LAS float* Hs = (LAS float*)(F.lds + 50176);
    const int t0 = ci * 64;
    int seq_lo, seq_hi, c_lo, c_hi, seq; const bool samp = ci >= 128;
    if (!samp) { seq = ci >> 2; c_lo = seq * 4; c_hi = c_lo + 4; } else { seq = (ci - 128) >> 6; c_lo = 128 + seq * 64; c_hi = c_lo + 64; }
    seq_lo = c_lo * 64; seq_hi = c_hi * 64;
    const int j = wave * 16 + l15, ch = n * 128 + j;
    bf16x8 wA[2][4], wB[2][4];
#pragma unroll
    for (int g = 0; g < 2; ++g) { const bf16_t* gp = F.GT() + (size_t)((g * 2 + 0) * 8 + n) * 16384 + (size_t)j * 128 + q4 * 8;
#pragma unroll
        for (int ks = 0; ks < 4; ++ks) wA[g][ks] = *(const bf16x8*)(gp + ks * 32); }
    {
        const int tg = tid >> 4, sub = tid & 15, ch = n * 128 + sub * 8;
        float w[4][8], acc[2][8];
#pragma unroll
        for (int j = 0; j < 4; ++j) { const f32x4 a = *(const f32x4*)(p.rg_conv_w + j * 1024 + ch), b = *(const f32x4*)(p.rg_conv_w + j * 1024 + ch + 4);
            w[j][0] = a[0]; w[j][1] = a[1]; w[j][2] = a[2]; w[j][3] = a[3]; w[j][4] = b[0]; w[j][5] = b[1]; w[j][6] = b[2]; w[j][7] = b[3]; }
        { const f32x4 a = *(const f32x4*)(p.rg_conv_b + ch), b = *(const f32x4*)(p.rg_conv_b + ch + 4);
#pragma unroll
          for (int i = 0; i < 2; ++i) { acc[i][0] = a[0]; acc[i][1] = a[1]; acc[i][2] = a[2]; acc[i][3] = a[3]; acc[i][4] = b[0]; acc[i][5] = b[1]; acc[i][6] = b[2]; acc[i][7] = b[3]; } }
#pragma unroll
        for (int r = 0; r < 5; ++r) {
            float x[8]; unpack8(rows[r], x);
#pragma unroll
            for (int j = 0; j < 4; ++j) { const int i = r - j; if (i >= 0 && i < 2) {
#pragma unroll
                for (int e = 0; e < 8; ++e) acc[i][e] += w[j][e] * x[e]; } } }
#pragma unroll
        for (int i = 0; i < 2; ++i) { const int c = tg * 2 + i;
            *(LAS u32x4*)(xb + c * 272 + sub * 16) = pack8(acc[i]);
            *(LAS f32x4*)(xf + c * 128 + sub * 8) = (f32x4){acc[i][0], acc[i][1], acc[i][2], acc[i][3]};
            *(LAS f32x4*)(xf + c * 128 + sub * 8 + 4) = (f32x4){acc[i][4], acc[i][5], acc[i][6], acc[i][7]}; }
    }
    lds_barrier();
    f32x4 hs[4];
#pragma unroll
    for (int m = 0; m < 4; ++m) hs[m] = (f32x4){0.f, 0.f, 0.f, 0.f};
#pragma unroll
    for (int d = 0; d < 2; ++d) {
        f32x4 av[4], bxv[4];
        {
            f32x4 ar[4], ai[4];
#pragma unroll
            for (int m = 0; m < 4; ++m) { ar[m] = (f32x4){0.f, 0.f, 0.f, 0.f}; ai[m] = (f32x4){0.f, 0.f, 0.f, 0.f}; }
#pragma unroll
            for (int ks = 0; ks < 4; ++ks) { const bf16x8 br = d == 0 ? wA[0][ks] : wB[0][ks], bi = d == 0 ? wA[1][ks] : wB[1][ks];
#pragma unroll
                for (int m = 0; m < 4; ++m) { const bf16x8 a = ldfrag(xb, 272, m * 16 + l15, ks * 64 + q4 * 16); ar[m] = MFMA16(a, br, ar[m]); ai[m] = MFMA16(a, bi, ai[m]); } }
            if (d == 0) {
#pragma unroll
                for (int g = 0; g < 2; ++g) { const bf16_t* gp = F.GT() + (size_t)((g * 2 + 1) * 8 + n) * 16384 + (size_t)j * 128 + q4 * 8;
#pragma unroll
                    for (int ks = 0; ks < 4; ++ks) wB[g][ks] = *(const bf16x8*)(gp + ks * 32); } }
            const float L2E = 1.4426950408889634f;
            const float br_ = -L2E * p.rg_b_r[d * 1024 + ch], bi_ = -L2E * p.rg_b_i[d * 1024 + ch], sp = softplusf_(-p.rg_lam[d * 1024 + ch]);
            const float k2 = -16.f * sp, k2e = k2 * L2E, k1e = 0.5f * k2e;
#pragma unroll
            for (int m = 0; m < 4; ++m)
#pragma unroll
                for (int r = 0; r < 4; ++r) { const int c = m * 16 + q4 * 4 + r;
                    const float rr = __builtin_amdgcn_rcpf(1.f + __builtin_amdgcn_exp2f(fmaf(ar[m][r], -L2E, br_)));
                    const float ii = __builtin_amdgcn_rcpf(1.f + __builtin_amdgcn_exp2f(fmaf(ai[m][r], -L2E, bi_)));
                    const float a_ = __builtin_amdgcn_exp2f(k1e * rr);
                    const float em = fmaf(a_, a_, -1.f);
                    av[m][r] = a_; bxv[m][r] = __builtin_amdgcn_sqrtf(fmaxf(-em, 0.f)) * (ii * xf[c * 128 + j]); }
        }
        f32x4 Pa[4], Pb[4]; float Ap[4], Bp[4], Am[4], Bm[4];
#pragma unroll
        for (int m = 0; m < 4; ++m) {
            float pa, pb;
            if (d == 0) { pa = av[m][0]; pb = bxv[m][0]; Pa[m][0] = pa; Pb[m][0] = pb;
#pragma unroll
                for (int r = 1; r < 4; ++r) { pb = av[m][r] * pb + bxv[m][r]; pa = av[m][r] * pa; Pa[m][r] = pa; Pb[m][r] = pb; } }
            else { pa = av[m][3]; pb = bxv[m][3]; Pa[m][3] = pa; Pb[m][3] = pb;
#pragma unroll
                for (int r = 2; r >= 0; --r) { pb = av[m][r] * pb + bxv[m][r]; pa = av[m][r] * pa; Pa[m][r] = pa; Pb[m][r] = pb; } }
            float Ak[4], Bk[4];
#pragma unroll
            for (int k = 0; k < 4; ++k) { Ak[k] = __shfl(pa, l15 + 16 * k); Bk[k] = __shfl(pb, l15 + 16 * k); }
            float ap = 1.f, bp = 0.f, am = 1.f, bm = 0.f;
#pragma unroll
            for (int kk = 0; kk < 4; ++kk) { const int k = d == 0 ? kk : 3 - kk;
                const bool before = d == 0 ? (k < q4) : (k > q4);
                const float nb = Ak[k] * bp + Bk[k], na = Ak[k] * ap;
                bp = before ? nb : bp; ap = before ? na : ap;
                bm = Ak[k] * bm + Bk[k]; am = Ak[k] * am; }
            Ap[m] = ap; Bp[m] = bp; Am[m] = am; Bm[m] = bm;
        }
        if (PASS == 1) {
            float At = 1.f, Bt = 0.f;
#pragma unroll
            for (int mm = 0; mm < 4; ++mm) { const int m = d == 0 ? mm : 3 - mm; Bt = Am[m] * Bt + Bm[m]; At = Am[m] * At; }
            if (q4 == 0) { float* ag = F.RGAGG() + (size_t)(ci * 2 + d) * 2048; ag[ch] = At; ag[1024 + ch] = Bt; }
        } else {
            float hb = F.CARRY()[(size_t)(ci * 2 + d) * 1024 + ch];
#pragma unroll
            for (int mm = 0; mm < 4; ++mm) { const int m = d == 0 ? mm : 3 - mm;
                const float hin = Ap[m] * hb + Bp[m];
#pragma unroll
                for (int r = 0; r < 4; ++r) hs[m][r] += Pa[m][r] * hin + Pb[m][r];
                hb = Am[m] * hb + Bm[m]; }
            if (!samp && q4 == 0 && ci == (d == 0 ? c_hi - 1 : c_lo)) F.out[OUT_SR + (size_t)(seq * 2 + d) * 1024 + ch] = hb;
        }
    }
    if (PASS == 1 && itn < 1024) rg_load_rows(F, 128 + (itn >> 3), itn & 7, rows);
    if (PASS == 3) {
#pragma unroll
        for (int m = 0; m < 4; ++m)
#pragma unroll
            for (int r = 0; r < 4; ++r) Hs[(m * 16 + q4 * 4 + r) * 128 + j] = hs[m][r];
        lds_barrier();
#pragma unroll
        for (int i = 0; i < 2; ++i) { const int chunk = tid + 512 * i, c = chunk >> 4, cc = chunk & 15;
            const u32x4 gv = *(const u32x4*)(F.PROJ() + (size_t)(t0 + c) * NPROJ + 5120 + n * 128 + cc * 8);
            float g[8]; unpack8(gv, g);
            const f32x4 ha = *(const LAS f32x4*)(Hs + c * 128 + cc * 8), hb2 = *(const LAS f32x4*)(Hs + c * 128 + cc * 8 + 4);
            float o[8];
#pragma unroll
            for (int e = 0; e < 4; ++e) { o[e] = ha[e] * siluf_(g[e]); o[4 + e] = hb2[e] * siluf_(g[4 + e]); }
            *(u32x4*)(F.MIX() + (size_t)(t0 + c) * 2048 + 1024 + n * 128 + cc * 8) = pack8(o); }
    }
    lds_barrier();
}

__device__ __forceinline__ void rg_conv_lds(CParams& p, const Frame& F, int n, const u32x4 (&rows)[5], LAS unsigned char* xb, LAS float* xf) {
    const int tid = F.tid, tg = tid >> 4, sub = tid & 15, ch = n * 128 + sub * 8;
    float w[4][8], acc[2][8];
#pragma unroll
    for (int j = 0; j < 4; ++j) { const f32x4 a = *(const f32x4*)(p.rg_conv_w + j * 1024 + ch), b = *(const f32x4*)(p.rg_conv_w + j * 1024 + ch + 4);
        w[j][0] = a[0]; w[j][1] = a[1]; w[j][2] = a[2]; w[j][3] = a[3]; w[j][4] = b[0]; w[j][5] = b[1]; w[j][6] = b[2]; w[j][7] = b[3]; }
    { const f32x4 a = *(const f32x4*)(p.rg_conv_b + ch), b = *(const f32x4*)(p.rg_conv_b + ch + 4);
#pragma unroll
      for (int i = 0; i < 2; ++i) { acc[i][0] = a[0]; acc[i][1] = a[1]; acc[i][2] = a[2]; acc[i][3] = a[3]; acc[i][4] = b[0]; acc[i][5] = b[1]; acc[i][6] = b[2]; acc[i][7] = b[3]; } }
#pragma unroll
    for (int r = 0; r < 5; ++r) { float x[8]; unpack8(rows[r], x);
#pragma unroll
        for (int j = 0; j < 4; ++j) { const int i = r - j; if (i >= 0 && i < 2) {
#pragma unroll
            for (int e = 0; e < 8; ++e) acc[i][e] += w[j][e] * x[e]; } } }
#pragma unroll
    for (int i = 0; i < 2; ++i) { const int c = tg * 2 + i;
        *(LAS u32x4*)(xb + c * 272 + sub * 16) = pack8(acc[i]);
        *(LAS f32x4*)(xf + c * 128 + sub * 8) = (f32x4){acc[i][0], acc[i][1], acc[i][2], acc[i][3]};
        *(LAS f32x4*)(xf + c * 128 + sub * 8 + 4) = (f32x4){acc[i][4], acc[i][5], acc[i][6], acc[i][7]}; }
}
template <int D>
__device__ __forceinline__ void rg_gate_scan(const Frame& F, const bf16x8 (&wg)[2][4], float br_, float bi_, float sp, const LAS unsigned char* xb, const LAS float* xf, int j,
                                             f32x4 (&Pa)[4], f32x4 (&Pb)[4], float (&Ap)[4], float (&Bp)[4], float (&Am)[4], float (&Bm)[4]) {
    const int lane = F.lane, q4 = lane >> 4, l15 = lane & 15;
    f32x4 av[4], bxv[4];
    {
        f32x4 ar[4], ai[4];
#pragma unroll
        for (int m = 0; m < 4; ++m) { ar[m] = (f32x4){0.f, 0.f, 0.f, 0.f}; ai[m] = (f32x4){0.f, 0.f, 0.f, 0.f}; }
#pragma unroll
        for (int ks = 0; ks < 4; ++ks) {
#pragma unroll
            for (int m = 0; m < 4; ++m) { const bf16x8 a = ldfrag(xb, 272, m * 16 + l15, ks * 64 + q4 * 16); ar[m] = MFMA16(a, wg[0][ks], ar[m]); ai[m] = MFMA16(a, wg[1][ks], ai[m]); } }
        const float L2E = 1.4426950408889634f;
        const float brs = -L2E * br_, bis = -L2E * bi_, k2 = -16.f * sp, k1e = 0.5f * k2 * L2E;
#pragma unroll
        for (int m = 0; m < 4; ++m)
#pragma unroll
            for (int r = 0; r < 4; ++r) { const int c = m * 16 + q4 * 4 + r;
                const float rr = __builtin_amdgcn_rcpf(1.f + __builtin_amdgcn_exp2f(fmaf(ar[m][r], -L2E, brs)));
                const float ii = __builtin_amdgcn_rcpf(1.f + __builtin_amdgcn_exp2f(fmaf(ai[m][r], -L2E, bis)));
                const float a = __builtin_amdgcn_exp2f(k1e * rr);
                const float em = fmaf(a, a, -1.f);
                av[m][r] = a; bxv[m][r] = __builtin_amdgcn_sqrtf(fmaxf(-em, 0.f)) * (ii * xf[c * 128 + j]); }
    }
#pragma unroll
    for (int m = 0; m < 4; ++m) {
        float pa, pb;
        if (D == 0) { pa = av[m][0]; pb = bxv[m][0]; Pa[m][0] = pa; Pb[m][0] = pb;
#pragma unroll
            for (int r = 1; r < 4; ++r) { pb = av[m][r] * pb + bxv[m][r]; pa = av[m][r] * pa; Pa[m][r] = pa; Pb[m][r] = pb; } }
        else { pa = av[m][3]; pb = bxv[m][3]; Pa[m][3] = pa; Pb[m][3] = pb;
#pragma unroll
            for (int r = 2; r >= 0; --r) { pb = av[m][r] * pb + bxv[m][r]; pa = av[m][r] * pa; Pa[m][r] = pa; Pb[m][r] = pb; } }
        float Ak[4], Bk[4];
#pragma unroll
        for (int k = 0; k < 4; ++k) { Ak[k] = __shfl(pa, l15 + 16 * k); Bk[k] = __shfl(pb, l15 + 16 * k); }
        float ap = 1.f, bp = 0.f, am = 1.f, bm = 0.f;
#pragma unroll
        for (int kk = 0; kk < 4; ++kk) { const int k = D == 0 ? kk : 3 - kk;
            const bool before = D == 0 ? (k < q4) : (k > q4);
            const float nb = Ak[k] * bp + Bk[k], na = Ak[k] * ap;
            bp = before ? nb : bp; ap = before ? na : ap;
            bm = Ak[k] * bm + Bk[k]; am = Ak[k] * am; }
        Ap[m] = ap; Bp[m] = bp; Am[m] = am; Bm[m] = bm;
    }
}
template <int D>
__device__ __forceinline__ void rg_prompt_dir(CParams& p, Frame& F, int seq, int n) {
    const int tid = F.tid, lane = F.lane, wave = F.wave, q4 = lane >> 4, l15 = lane & 15;
    LAS unsigned char* xb = F.lds; LAS float* xf = (LAS float*)(F.lds + 17408); LAS float* Hs = (LAS float*)(F.lds + 50176); LAS bf16_t* Hf = (LAS bf16_t*)(F.lds + 82944);
    const int j = wave * 16 + l15, ch = n * 128 + j;
    bf16x8 wg[2][4];
#pragma unroll
    for (int g = 0; g < 2; ++g) { const bf16_t* gp = F.GT() + (size_t)((g * 2 + D) * 8 + n) * 16384 + (size_t)j * 128 + q4 * 8;
#pragma unroll
        for (int ks = 0; ks < 4; ++ks) wg[g][ks] = *(const bf16x8*)(gp + ks * 32); }
    const float br_ = p.rg_b_r[D * 1024 + ch], bi_ = p.rg_b_i[D * 1024 + ch], sp = softplusf_(-p.rg_lam[D * 1024 + ch]);
    float hb = 0.f;
    u32x4 rows[5];
    rg_load_rows(F, seq * 4 + (D == 0 ? 0 : 3), n, rows);
#pragma unroll 1
    for (int cs = 0; cs < 4; ++cs) {
        const int cidx = D == 0 ? cs : 3 - cs, ci = seq * 4 + cidx, t0 = ci * 64;
        rg_conv_lds(p, F, n, rows, xb, xf);
        if (cs < 3) rg_load_rows(F, seq * 4 + (D == 0 ? cidx + 1 : cidx - 1), n, rows);
        lds_barrier();
        f32x4 Pa[4], Pb[4]; float Ap[4], Bp[4], Am[4], Bm[4];
        rg_gate_scan<D>(F, wg, br_, bi_, sp, xb, xf, j, Pa, Pb, Ap, Bp, Am, Bm);
#pragma unroll
        for (int mm = 0; mm < 4; ++mm) { const int m = D == 0 ? mm : 3 - mm;
            const float hin = Ap[m] * hb + Bp[m];
#pragma unroll
            for (int r = 0; r < 4; ++r) { const float hv = Pa[m][r] * hin + Pb[m][r]; const int tl = m * 16 + q4 * 4 + r;
                if (D == 0) Hf[(cidx * 64 + tl) * 128 + j] = f2bf(hv);
                else Hs[tl * 128 + j] = hv + bf2f(Hf[(cidx * 64 + tl) * 128 + j]); }
            hb = Am[m] * hb + Bm[m]; }
        lds_barrier();
        if (D == 1) {
#pragma unroll
            for (int i = 0; i < 2; ++i) { const int chunk = tid + 512 * i, c = chunk >> 4, cc = chunk & 15;
                bf16_t* gp = F.PROJ() + (size_t)(t0 + c) * NPROJ + 5120 + n * 128 + cc * 8;
                const u32x4 gv = *(const u32x4*)gp; float g[8]; unpack8(gv, g);
                const f32x4 ha = *(const LAS f32x4*)(Hs + c * 128 + cc * 8), hb2 = *(const LAS f32x4*)(Hs + c * 128 + cc * 8 + 4);
                float o[8];
#pragma unroll
                for (int e = 0; e < 4; ++e) { o[e] = ha[e] * siluf_(g[e]); o[4 + e] = hb2[e] * siluf_(g[4 + e]); }
                *(u32x4*)gp = pack8(o); }
            lds_barrier();
        }
    }
    if (q4 == 0) F.out[OUT_SR + (size_t)(seq * 2 + D) * 1024 + ch] = hb;
}

__device__ __forceinline__ void rg_carry_scan(CParams& p, Frame& F) {
    const int tid = F.tid;
    if (tid < 256 || tid >= 272) return;
    const int g = F.b * 16 + tid - 256; if (g >= 4096) return;
    const int seq = g >> 11, d = (g >> 10) & 1, ch = g & 1023, c_lo = 128 + seq * 64;
    const float* ag0 = F.RGAGG() + (size_t)d * 2048 + ch;
    float h = p.state_rglru[(size_t)(seq * 2 + d) * 1024 + ch];
    float* cr0 = F.CARRY() + (size_t)d * 1024 + ch;
#pragma unroll 1
    for (int u0 = 0; u0 < 64; u0 += 32) {
        float A[32], B[32];
#pragma unroll
        for (int u = 0; u < 32; ++u) { const int cc = d == 0 ? c_lo + u0 + u : c_lo + 63 - u0 - u; A[u] = ag0[(size_t)cc * 4096]; B[u] = ag0[(size_t)cc * 4096 + 1024]; }
#pragma unroll
        for (int u = 0; u < 32; ++u) { const int cc = d == 0 ? c_lo + u0 + u : c_lo + 63 - u0 - u; cr0[(size_t)cc * 2048] = h; h = A[u] * h + B[u]; }
    }
}

__device__ __forceinline__ void phase3(CParams& p, Frame& F) {
    for (int rep = 0; rep < (REP_PHASE == 30 ? 2 : 1); ++rep)
    { u32x4 rows[7]; if (F.b < 2048) p3_load_rows(F, F.b >> 3, F.b & 7, rows);
      for (int it = F.b; it < 2048; it += F.G) p3_delta_item(p, F, it >> 3, it & 7, rows, it + F.G); }
    for (int rep = 0; rep < (REP_PHASE == 31 ? 2 : 1); ++rep) {
    u32x4 rows[5]; if (F.b < 1024) rg_load_rows(F, 128 + (F.b >> 3), F.b & 7, rows);
    for (int it = F.b; it < 1024; it += F.G) rg_item<1>(p, F, 128 + (it >> 3), it & 7, rows, it + F.G); }
    for (int it = F.b; it < 256; it += F.G) { rg_prompt_dir<0>(p, F, it >> 3, it & 7); rg_prompt_dir<1>(p, F, it >> 3, it & 7); }
}

struct P4D { int valid, samp, seq, h, d, sl, ci, seq_lo, seq_hi, last, k, s, nch; };
__device__ __forceinline__ P4D p4_desc(const Frame& F, int k, int s) {
    P4D D; int item;
    if (F.G == 256) {
        const int x = F.b & 7, y = F.b >> 3;
        if (y < 16) { item = (x * 4 + (y >> 2)) * 4 + (y & 3); D.valid = k < 1; }
        else { const int j = y - 16; item = 128 + (x * 64 + (j >> 2) * 16 + k) * 4 + (j & 3); D.valid = k < 16; } }
    else { item = F.b + k * F.G; D.valid = item < 2176; }
    D.samp = item < 128; const int it = D.samp ? item : item - 128, chain = it >> 2;
    D.sl = it & 3; D.seq = chain >> 4; D.h = (chain >> 1) & 7; D.d = chain & 1;
    D.nch = D.samp ? 64 : 4; const int chunk0 = D.samp ? 128 + D.seq * 64 : D.seq * 4;
    D.seq_lo = chunk0 * 64; D.seq_hi = D.seq_lo + D.nch * 64;
    D.ci = D.d == 0 ? chunk0 + s : chunk0 + D.nch - 1 - s; D.last = s == D.nch - 1; D.k = k; D.s = s;
    return D;
}
__device__ __forceinline__ P4D p4_next(const Frame& F, const P4D& D) {
    if (D.s + 1 < D.nch) { P4D N = D; N.s = D.s + 1; N.ci = D.ci + (D.d == 0 ? 1 : -1); N.last = N.s == D.nch - 1; return N; }
    return p4_desc(F, D.k + 1, 0);
}
struct P4Pre { u32x4 k0, k1, q0, q1, ti, at; u32x2 v[4]; float g, b, bc; };
struct P4T { unsigned oKQ, oTA, oV, oG, oGc; int cj; };
__device__ __forceinline__ P4T p4_thread_consts(int tid) {
    P4T T; T.oKQ = (unsigned)(((tid >> 4) * 1024 + (tid & 15) * 8) * 2); T.oTA = (unsigned)tid * 16u;
    T.oV = (unsigned)(((tid >> 3) * NPROJ + (tid & 7) * 4) * 2); T.oG = (unsigned)(tid & 63) * 4u; T.oGc = (unsigned)(tid >> 3) * 4u; T.cj = (tid >> 3) - 2; return T;
}
__device__ __forceinline__ void p4_prefetch(CParams& p, const Frame& F, P4Pre& R, const P4D& D, const P4T& T) {
    const int tid = F.tid, t0 = D.ci * 64, h = D.h;
    const char* kb = (const char*)F.Kc() + (size_t)(D.ci * 8 + h) * 16384;
    const char* qb = (const char*)F.Qc() + ((size_t)t0 * 1024 + h * 128) * 2;
    const char* tb = (const char*)F.TA() + (size_t)(D.ci * 8 + h) * 16384;
    const char* vb = (const char*)F.PROJ() + ((long)(t0 - 2) * NPROJ + 2048 + h * 128 + D.sl * 32) * 2;
    const char* gb = (const char*)F.GB() + (size_t)(D.ci * 8 + h) * 1024 + D.d * 256;
    R.k0 = *(const u32x4*)(kb + T.oTA); R.k1 = *(const u32x4*)(kb + T.oTA + 8192u);
    R.q0 = *(const u32x4*)(qb + T.oKQ); R.q1 = *(const u32x4*)(qb + T.oKQ + 65536u);
    R.ti = *(const u32x4*)(tb + T.oTA); R.at = *(const u32x4*)(tb + T.oTA + 8192u);
#pragma unroll
    for (int j = 0; j < 4; ++j) { const int tok = t0 + T.cj + j; u32x2 v = {0u, 0u};
        if (tok >= D.seq_lo && tok < D.seq_hi) v = *(const u32x2*)(vb + T.oV + (unsigned)(j * NPROJ * 2));
        R.v[j] = v; }
    R.bc = *(const float*)(gb + 512 + T.oGc);
    R.g = 0.f; R.b = 0.f;
    if (tid < 64) { R.g = *(const float*)(gb + T.oG); R.b = *(const float*)(gb + 512 + T.oG); }
}
__device__ __forceinline__ u32x4 tri_mask(u32x4 v, int c, int s0, int d) {
    unsigned w[4] = {v.x, v.y, v.z, v.w};
#pragma unroll
    for (int i = 0; i < 4; ++i) { const int slo = s0 + 2 * i, shi = slo + 1;
        const bool klo = d == 0 ? (c >= slo) : (c <= slo), khi = d == 0 ? (c >= shi) : (c <= shi);
        w[i] &= (klo ? 0x0000FFFFu : 0u) | (khi ? 0xFFFF0000u : 0u); }
    return (u32x4){w[0], w[1], w[2], w[3]};
}
constexpr int P4_KS = 0, P4_TI = 17408, P4_VBT = 26624, P4_WL = 31232, P4_SB = 48640, P4_VT1 = 57344, P4_VT2 = 61952, P4_QS = 66560, P4_AT = 101376, P4_GV = 119808, P4_KT = 122368;
__device__ __forceinline__ void p4_stage(CParams& p, const Frame& F, const P4Pre& R, const P4D& D, int buf, const unsigned (&mk)[2][4], f32x4 (&cw)[4], const f32x4 (&cwn)[4]) {
    const int tid = F.tid, d = D.d;
    LAS unsigned char* Ks = F.lds + P4_KS; LAS unsigned char* Qs = F.lds + P4_QS + buf * 17408; LAS unsigned char* TIs = F.lds + P4_TI;
    LAS unsigned char* ATs = F.lds + P4_AT + buf * 9216; LAS unsigned char* Vbt = F.lds + P4_VBT; LAS float* gv = (LAS float*)(F.lds + P4_GV + buf * 1280);
    { const int row = tid >> 4, cc = tid & 15;
      *(LAS u32x4*)(Qs + row * 272 + cc * 16) = R.q0; *(LAS u32x4*)(Qs + (32 + row) * 272 + cc * 16) = R.q1; }
    { const int dk = tid >> 3, cp = tid & 7; LAS unsigned char* Kts = F.lds + P4_KT;
      *(LAS u32x4*)(Kts + dk * 144 + cp * 16) = R.k0; *(LAS u32x4*)(Kts + (64 + dk) * 144 + cp * 16) = R.k1; }
    { const int c = tid >> 3, s0 = (tid & 7) * 8;
      const unsigned m0 = d ? mk[1][0] : mk[0][0], m1 = d ? mk[1][1] : mk[0][1], m2 = d ? mk[1][2] : mk[0][2], m3 = d ? mk[1][3] : mk[0][3];
      *(LAS u32x4*)(TIs + c * 144 + s0 * 2) = (u32x4){R.ti.x & m0, R.ti.y & m1, R.ti.z & m2, R.ti.w & m3};
      *(LAS u32x4*)(ATs + c * 144 + s0 * 2) = (u32x4){R.at.x & m0, R.at.y & m1, R.at.z & m2, R.at.w & m3}; }
    { const int c = tid >> 3, e0 = (tid & 7) * 4; float o[4] = {0.f, 0.f, 0.f, 0.f};
      if (D.s == 0) {
#pragma unroll
          for (int j = 0; j < 4; ++j) cw[j] = cwn[j]; }
#pragma unroll
      for (int j = 0; j < 4; ++j) { const u32x2 v = R.v[j];
          o[0] += cw[j][0] * __uint_as_float(v.x << 16); o[1] += cw[j][1] * __uint_as_float(v.x & 0xffff0000u);
          o[2] += cw[j][2] * __uint_as_float(v.y << 16); o[3] += cw[j][3] * __uint_as_float(v.y & 0xffff0000u); }
#pragma unroll
      for (int i = 0; i < 4; ++i) ((LAS bf16_t*)Vbt)[(e0 + i) * 72 + c] = f2bf(siluf_(o[i]) * R.bc); }
    if (tid < 64) {
        const float glast = __shfl(R.g, d == 0 ? 63 : 0), eg = __expf(R.g);
        gv[tid] = eg; gv[64 + tid] = R.b * eg; gv[128 + tid] = __expf(glast - R.g); if (tid == 0) gv[192] = __expf(glast);
    }
}
__device__ __forceinline__ void phase4_chains(CParams& p, Frame& F) {
    const int tid = F.tid, lane = F.lane, wave = F.wave, q4 = lane >> 4, l15 = lane & 15;
    LAS unsigned char* Ks = F.lds + P4_KS; LAS unsigned char* TIs = F.lds + P4_TI; LAS unsigned char* Vbt = F.lds + P4_VBT; LAS unsigned char* Wl = F.lds + P4_WL;
    LAS unsigned char* Sb = F.lds + P4_SB; LAS unsigned char* Vt1 = F.lds + P4_VT1; LAS unsigned char* Vt2 = F.lds + P4_VT2;
    const int ct = wave & 3, et = wave >> 2;
    P4D Dc = p4_desc(F, 0, 0);
    if (!Dc.valid) return;
    P4Pre RA, RB;
    f32x4 S[2], U; bf16x8 KT[2];
    unsigned mk[2][4]; f32x4 cw[4], cwn[4];
    { const int c = tid >> 3, s0 = (tid & 7) * 8;
#pragma unroll
      for (int i = 0; i < 4; ++i) { const int slo = s0 + 2 * i, shi = slo + 1;
          mk[0][i] = (c >= slo ? 0x0000FFFFu : 0u) | (c >= shi ? 0xFFFF0000u : 0u); mk[1][i] = (c <= slo ? 0x0000FFFFu : 0u) | (c <= shi ? 0xFFFF0000u : 0u); } }
#define P4_INIT_S(D) do { _Pragma("unroll") for (int nt = 0; nt < 2; ++nt) _Pragma("unroll") for (int r = 0; r < 4; ++r) \
        S[nt][r] = (D).samp ? p.state_delta[(size_t)(((D).seq * 2 + (D).d) * 8 + (D).h) * 16384 + (size_t)(wave * 16 + q4 * 4 + r) * 128 + (D).sl * 32 + nt * 16 + l15] : 0.f; } while (0)
#define P4_WRITE_SB() do { _Pragma("unroll") for (int nt = 0; nt < 2; ++nt) { u32x2 o_; o_.x = pk2(S[nt][0], S[nt][1]); o_.y = pk2(S[nt][2], S[nt][3]); \
        *(LAS u32x2*)(Sb + (nt * 16 + l15) * 272 + (wave * 16 + q4 * 4) * 2) = o_; } } while (0)
#define P4_PRECOMP(buf_) do { const LAS float* gv_ = (const LAS float*)(F.lds + P4_GV + (buf_) * 1280); \
        f32x4 WT[4]; _Pragma("unroll") for (int c_ = 0; c_ < 4; ++c_) WT[c_] = (f32x4){0.f, 0.f, 0.f, 0.f}; \
        _Pragma("unroll") for (int ks = 0; ks < 2; ++ks) { \
            const u32x4 kraw = *(const LAS u32x4*)(F.lds + P4_KT + (wave * 16 + l15) * 144 + ks * 64 + q4 * 16); KT[ks] = __builtin_bit_cast(bf16x8, kraw); \
            const f32x4 sa = *(const LAS f32x4*)(gv_ + 64 + ks * 32 + q4 * 8), sb_ = *(const LAS f32x4*)(gv_ + 64 + ks * 32 + q4 * 8 + 4); \
            float kf[8]; unpack8(kraw, kf); u32x4 kg; \
            kg.x = pk2(kf[0] * sa[0], kf[1] * sa[1]); kg.y = pk2(kf[2] * sa[2], kf[3] * sa[3]); kg.z = pk2(kf[4] * sb_[0], kf[5] * sb_[1]); kg.w = pk2(kf[6] * sb_[2], kf[7] * sb_[3]); \
            const bf16x8 akg = __builtin_bit_cast(bf16x8, kg); \
            _Pragma("unroll") for (int c_ = 0; c_ < 4; ++c_) { const bf16x8 bt = ldfrag(TIs, 144, c_ * 16 + l15, ks * 64 + q4 * 16); WT[c_] = MFMA16(akg, bt, WT[c_]); } } \
        _Pragma("unroll") for (int c_ = 0; c_ < 4; ++c_) { u32x2 o_; o_.x = pk2(WT[c_][0], WT[c_][1]); o_.y = pk2(WT[c_][2], WT[c_][3]); \
            *(LAS u32x2*)(Wl + (c_ * 16 + l15) * 272 + (wave * 16 + q4 * 4) * 2) = o_; } \
        U = (f32x4){0.f, 0.f, 0.f, 0.f}; \
        _Pragma("unroll") for (int ks = 0; ks < 2; ++ks) { const bf16x8 a_ = ldfrag(TIs, 144, ct * 16 + l15, ks * 64 + q4 * 16), b_ = ldfrag(Vbt, 144, et * 16 + l15, ks * 64 + q4 * 16); U = MFMA16(a_, b_, U); } } while (0)

    const P4T T = p4_thread_consts(tid);
    p4_prefetch(p, F, RA, Dc, T);
    P4_INIT_S(Dc);
    { const int e0 = (tid & 7) * 4;
#pragma unroll
      for (int j = 0; j < 4; ++j) cwn[j] = *(const f32x4*)(p.dn_conv_w + j * 3072 + 2048 + Dc.h * 128 + Dc.sl * 32 + e0); }
    p4_stage(p, F, RA, Dc, 0, mk, cw, cwn);
    P4_WRITE_SB();
    P4D Dn = p4_next(F, Dc);
    if (Dn.valid) p4_prefetch(p, F, RA, Dn, T);
    P4D Dnn = Dn; if (Dn.valid) { Dnn = p4_next(F, Dn); if (Dnn.valid) p4_prefetch(p, F, RB, Dnn, T); }
    lds_barrier();
    P4_PRECOMP(0);
    lds_barrier();
    int buf = 0;
#define P4_BODY(RX) { \
        const LAS float* gv = (const LAS float*)(F.lds + P4_GV + buf * 1280); \
        const LAS unsigned char* Qs = F.lds + P4_QS + buf * 17408; const LAS unsigned char* ATs = F.lds + P4_AT + buf * 9216; \
        const int c0 = ct * 16 + q4 * 4, e = et * 16 + l15; \
         \
        f32x4 p1 = {0.f, 0.f, 0.f, 0.f}, oacc = {0.f, 0.f, 0.f, 0.f}; \
_Pragma("unroll") \
        for (int ks = 0; ks < 4; ++ks) { const bf16x8 bs = ldfrag(Sb, 272, et * 16 + l15, ks * 64 + q4 * 16); \
            const bf16x8 aw = ldfrag(Wl, 272, ct * 16 + l15, ks * 64 + q4 * 16), aq = ldfrag(Qs, 272, ct * 16 + l15, ks * 64 + q4 * 16); \
            p1 = MFMA16(aw, bs, p1); oacc = MFMA16(aq, bs, oacc); } \
        { float vn[4]; \
_Pragma("unroll") \
          for (int r = 0; r < 4; ++r) vn[r] = U[r] - p1[r]; \
          u32x2 o1, o2; o1.x = pk2(vn[0], vn[1]); o1.y = pk2(vn[2], vn[3]); \
          o2.x = pk2(vn[0] * gv[128 + c0], vn[1] * gv[128 + c0 + 1]); o2.y = pk2(vn[2] * gv[128 + c0 + 2], vn[3] * gv[128 + c0 + 3]); \
          *(LAS u32x2*)(Vt1 + e * 144 + c0 * 2) = o1; *(LAS u32x2*)(Vt2 + e * 144 + c0 * 2) = o2; } \
_Pragma("unroll") \
        for (int r = 0; r < 4; ++r) oacc[r] *= gv[c0 + r]; \
        P4D D3 = Dnn; \
        if (Dn.valid) { p4_stage(p, F, RX, Dn, buf ^ 1, mk, cw, cwn); \
            if (Dn.last && Dnn.valid) { const int e0_ = (tid & 7) * 4; _Pragma("unroll") for (int j = 0; j < 4; ++j) cwn[j] = *(const f32x4*)(p.dn_conv_w + j * 3072 + 2048 + Dnn.h * 128 + Dnn.sl * 32 + e0_); } if (Dnn.valid) { D3 = p4_next(F, Dnn); if (D3.valid) p4_prefetch(p, F, RX, D3, T); } } \
        lds_barrier(); \
         \
        { const float gl = gv[192]; \
_Pragma("unroll") \
          for (int nt = 0; nt < 2; ++nt) S[nt] *= gl; \
_Pragma("unroll") \
          for (int ks = 0; ks < 2; ++ks) \
_Pragma("unroll") \
              for (int nt = 0; nt < 2; ++nt) { const bf16x8 b_ = ldfrag(Vt2, 144, nt * 16 + l15, ks * 64 + q4 * 16); S[nt] = MFMA16(KT[ks], b_, S[nt]); } } \
_Pragma("unroll") \
        for (int ks = 0; ks < 2; ++ks) { const bf16x8 a_ = ldfrag(ATs, 144, ct * 16 + l15, ks * 64 + q4 * 16), b_ = ldfrag(Vt1, 144, et * 16 + l15, ks * 64 + q4 * 16); oacc = MFMA16(a_, b_, oacc); } \
_Pragma("unroll") \
        for (int r = 0; r < 4; ++r) *(bf16_t*)((char*)F.PROJ() + ((size_t)Dc.ci * 64 * NPROJ + Dc.d * 1024 + Dc.h * 128 + Dc.sl * 32) * 2 + (unsigned)(((c0 + r) * NPROJ + e) * 2)) = f2bf(oacc[r]); \
        if (Dc.last) { \
            if (!Dc.samp) { \
_Pragma("unroll") \
                for (int nt = 0; nt < 2; ++nt) \
_Pragma("unroll") \
                    for (int r = 0; r < 4; ++r) \
                        F.out[OUT_SD + (size_t)((Dc.seq * 2 + Dc.d) * 8 + Dc.h) * 16384 + (size_t)(wave * 16 + q4 * 4 + r) * 128 + Dc.sl * 32 + nt * 16 + l15] = S[nt][r]; \
            } \
            if (Dn.valid) P4_INIT_S(Dn); \
        } \
        P4_WRITE_SB(); \
        if (Dn.valid) P4_PRECOMP(buf ^ 1); \
        lds_barrier(); \
        if (!Dn.valid) break; \
        Dc = Dn; Dn = Dnn; Dnn = D3; buf ^= 1; \
    }
#pragma unroll 1
    for (;;) { P4_BODY(RA) P4_BODY(RB) }
#undef P4_BODY
#undef P4_INIT_S
#undef P4_WRITE_SB
#undef P4_PRECOMP
}
__device__ __forceinline__ void phase4(CParams& p, Frame& F) {
    if (F.G == 256) rg_carry_scan(p, F);
    else if (F.b == 0) {
        for (int g = F.tid; g < 69632; g += 512) { int samp = g >= 65536, gg = samp ? g - 65536 : g, seq = gg >> 11, d = (gg >> 10) & 1, ch = gg & 1023;
            const int nch = samp ? 64 : 4, c_lo = samp ? 128 + seq * 64 : seq * 4; float h = samp ? p.state_rglru[(size_t)(seq * 2 + d) * 1024 + ch] : 0.f;
            for (int i = 0; i < nch; ++i) { const int cc = d == 0 ? c_lo + i : c_lo + nch - 1 - i; const float* ag = F.RGAGG() + (size_t)(cc * 2 + d) * 2048; F.CARRY()[(size_t)(cc * 2 + d) * 1024 + ch] = h; h = ag[ch] * h + ag[1024 + ch]; } } }
    __syncthreads();
    phase4_chains(p, F);
}

__device__ __forceinline__ void phase5(CParams& p, Frame& F) {
    const int lane = F.lane;
    float nw[16];
#pragma unroll
    for (int q = 0; q < 4; ++q) { const f32x4 a = *(const f32x4*)(p.dn_norm_w + (lane & 7) * 16 + q * 4); nw[q * 4] = a[0]; nw[q * 4 + 1] = a[1]; nw[q * 4 + 2] = a[2]; nw[q * 4 + 3] = a[3]; }
#pragma unroll 4
    for (int tok = F.b * 8 + F.wave; tok < NTOK; tok += F.G * 8) {
        const bf16_t* pr = F.PROJ() + (size_t)tok * NPROJ + lane * 16;
        float o[16], z[16]; float ss = 0.f;
#pragma unroll
        for (int hf = 0; hf < 2; ++hf) { const u32x4 a = *(const u32x4*)(pr + hf * 8), b = *(const u32x4*)(pr + 1024 + hf * 8), zz = *(const u32x4*)(pr + 3072 + hf * 8);
            float fa[8], fb[8], fz[8]; unpack8(a, fa); unpack8(b, fb); unpack8(zz, fz);
#pragma unroll
            for (int e = 0; e < 8; ++e) { o[hf * 8 + e] = fa[e] + fb[e]; z[hf * 8 + e] = fz[e]; ss += o[hf * 8 + e] * o[hf * 8 + e]; } }
        ss += __shfl_xor(ss, 1); ss += __shfl_xor(ss, 2); ss += __shfl_xor(ss, 4);
        const float rs = rsqrtf(ss * (1.f / 128.f) + 1e-6f);
#pragma unroll
        for (int hf = 0; hf < 2; ++hf) { float w[8];
#pragma unroll
            for (int e = 0; e < 8; ++e) w[e] = o[hf * 8 + e] * rs * nw[hf * 8 + e] * siluf_(z[hf * 8 + e]);
            *(u32x4*)(F.MIX() + (size_t)tok * 2048 + lane * 16 + hf * 8) = pack8(w); }
        if (tok < 8192) {
            const u32x4 y0 = *(const u32x4*)(pr + 5120), y1 = *(const u32x4*)(pr + 5120 + 8);
            *(u32x4*)(F.MIX() + (size_t)tok * 2048 + 1024 + lane * 16) = y0; *(u32x4*)(F.MIX() + (size_t)tok * 2048 + 1024 + lane * 16 + 8) = y1; }
    }
    __syncthreads();
    for (int it = F.b; it < 1024; it += F.G) { u32x4 rows[5]; rg_load_rows(F, 128 + (it >> 3), it & 7, rows); rg_item<3>(p, F, 128 + (it >> 3), it & 7, rows, it + F.G); }
}

__device__ __forceinline__ void phase6(CParams& p, Frame& F) {
    pg8::Gemm g{F.MIX(), F.WoutT(), NTOK, 1024, 2048}; pg8::StaticOrder S; S.init(NTOK, 1024, F.G, F.b); pg8::EpiF32 E{(float*)F.PROJ(), 3072};
    pg8::gemm_phase<pg8::EpiF32, pg8::StaticOrder>(F.lds, g, S, E);
}

__device__ __forceinline__ void phase7(CParams& p, Frame& F) {
    LAS float* gt = (LAS float*)F.lds;
    for (int tb = F.b; tb < 256; tb += F.G) {
        const int grp = grp_of_block(tb);
        for (int j = F.tid; j < 1024; j += 512) gt[j] = mod_val(p, F, grp, 2048 + j) * p.post_w[j];
        __syncthreads();
#pragma unroll 2
        for (int i = 0; i < 8; ++i) {
            const int tok = tb * 64 + F.wave * 8 + i;
            const float* xr = tok < 8192 ? p.x_prompt + (size_t)tok * 1024 : p.x_sample + (size_t)(tok - 8192) * 1024;
            const float* yr = (const float*)F.PROJ() + (size_t)tok * 3072;
            f32x4 y[4]; float ss = 0.f;
#pragma unroll
            for (int q = 0; q < 4; ++q) { y[q] = *(const f32x4*)(yr + F.lane * 4 + 256 * q); ss += (y[q][0] * y[q][0] + y[q][1] * y[q][1]) + (y[q][2] * y[q][2] + y[q][3] * y[q][3]); }
            const float rstd = rsqrtf(wave_sum(ss) * (1.f / 1024.f) + 1e-6f);
#pragma unroll
            for (int q = 0; q < 4; ++q) { const int j = F.lane * 4 + 256 * q; f32x4 v = *(const f32x4*)(xr + j);
                if (tok >= 8192) { const int pp = (tok - 8192) & 4095; const int vv = (q < 2) ? (pp >> 6) : (pp & 63);
                    v += *(const f32x4*)(F.pe() + ((q & 1) ? 16384 : 0) + vv * 256 + F.lane * 4); }
                const f32x4 g4 = *(const LAS f32x4*)(gt + j);
                f32x4 ov = v + g4 * (y[q] * rstd); ov[0] = fin(ov[0]); ov[1] = fin(ov[1]); ov[2] = fin(ov[2]); ov[3] = fin(ov[3]); if (!(LIVE_MASK & 1)) ov = (f32x4){0.f, 0.f, 0.f, 0.f}; *(f32x4*)(F.out + (size_t)tok * 1024 + j) = ov; }
        }
        __syncthreads();
    }
}

__device__ __forceinline__ void phase8(CParams& p, Frame& F) {
    if (F.b == 0 && F.tid == 0) { int code = 0; for (int k = 31; k >= 1; --k) if (DG(F)[k]) code = k; F.out[OUT_SR] = 1000.f * (float)code + 500.f; }
}
extern __shared__ __attribute__((aligned(16))) unsigned char smem_raw[];
__global__ void __launch_bounds__(512) fwd_megakernel(Params p_unused) {
    CParams& p = *(CParams*)__builtin_amdgcn_kernarg_segment_ptr();
    Frame F;
    F.lds = (LAS unsigned char*)smem_raw;
    F.tid = threadIdx.x; F.lane = F.tid & 63; F.wave = __builtin_amdgcn_readfirstlane(F.tid >> 6); F.G = gridDim.x; F.b = blockIdx.x;
    F.out = p.out; F.ws = p.ws;
    volatile LAS unsigned* xbw = (volatile LAS unsigned*)(F.lds + LDS_BYTES - 16);
    const bool multi = (p.ph_hi - p.ph_lo) > 1;
    XcdBarrier xb; xb.bar = (unsigned*)(p.ws + WS_CTL); xb.x = 0; xb.st = xbw;
    if (multi) {
        if (F.tid == 0) { xbw[0] = 0u; xbw[1] = 0u; xbw[2] = 0u; xbw[3] = 0u; }
        __syncthreads();
        xb = xcd_barrier_post((unsigned*)(p.ws + WS_CTL), xbw);
    }
#ifndef PHMASK
#define PHMASK 511
#endif
    const int lo = p.ph_lo, hi = p.ph_hi;
#ifndef REP_PHASE
#define REP_PHASE -1
#endif
#define RUN_PHASE(k, fn) do { if (lo <= (k) && (k) < hi) { if (PHMASK & (1 << (k))) fn(p, F); if ((k) == REP_PHASE) { __syncthreads(); fn(p, F); } if ((k) + 1 < hi) xcd_barrier(xb); } } while (0)
    RUN_PHASE(0, phase0); RUN_PHASE(1, phase1); RUN_PHASE(2, phase2); RUN_PHASE(3, phase3);
    RUN_PHASE(4, phase4); RUN_PHASE(5, phase5); RUN_PHASE(6, phase6); RUN_PHASE(7, phase7); RUN_PHASE(8, phase8);
}

extern "C" void kernel_launch(void* const* d_in, const int* in_sizes, int n_in, void* d_out, int out_size, void* d_ws, size_t ws_size, hipStream_t stream) {
    static int grid = 0;
    if (grid == 0) {
        int dev = 0, cus = 0;
        if (hipGetDevice(&dev) != hipSuccess || hipDeviceGetAttribute(&cus, hipDeviceAttributeMultiprocessorCount, dev) != hipSuccess) { fprintf(stderr, "kernel_launch: device query failed\n"); grid = -1; return; }
        if (hipFuncSetAttribute((const void*)fwd_megakernel, hipFuncAttributeMaxDynamicSharedMemorySize, LDS_BYTES) != hipSuccess) { fprintf(stderr, "kernel_launch: hipFuncSetAttribute failed\n"); grid = -1; return; }
        int per_cu = 0;
        if (hipOccupancyMaxActiveBlocksPerMultiprocessor(&per_cu, (const void*)fwd_megakernel, 512, LDS_BYTES) != hipSuccess || per_cu < 1) { fprintf(stderr, "kernel_launch: occupancy query says %d blocks per CU\n", per_cu); (void)hipGetLastError(); }
        grid = cus;
    }
    if (grid < 0) return;
    Params p{};
    const float** pp = (const float**)&p;
    for (int i = 0; i < 23; ++i) pp[i] = (const float*)d_in[i];
    p.out = (float*)d_out; p.ws = (unsigned char*)d_ws;
    (void)hipMemsetAsync((char*)d_ws + WS_CTL, 0, 16384, stream);
#if MK_SINGLE
    p.ph_lo = 0; p.ph_hi = NPH;
    void* args[] = {&p};
    hipError_t e = hipLaunchCooperativeKernel((const void*)fwd_megakernel, dim3(grid), dim3(512), args, LDS_BYTES, stream);
    if (e != hipSuccess) fprintf(stderr, "cooperative launch failed: %s (grid %d)\n", hipGetErrorString(e), grid);
#else
    for (int ph = 0; ph < NPH; ++ph) {
        p.ph_lo = ph; p.ph_hi = ph + 1;
        hipLaunchKernelGGL(fwd_megakernel, dim3(grid), dim3(512), LDS_BYTES, stream, p);
    }
#endif
}
```

```cpp
#include <hip/hip_runtime.h>
#include <cstdio>
#include <cstdint>

#define LAS __attribute__((address_space(3)))
typedef unsigned short bf16_t;
typedef short bf16x8 __attribute__((ext_vector_type(8)));
typedef float f32x4 __attribute__((ext_vector_type(4)));
typedef unsigned u32x4 __attribute__((ext_vector_type(4)));
typedef unsigned u32x2 __attribute__((ext_vector_type(2)));

#ifndef REP_PHASE
#define REP_PHASE -1
#endif
#ifndef MK_SINGLE
#define MK_SINGLE 1
#endif

constexpr int NTOK = 16384, DM = 1024, NPROJ = 6144, DIN = 6176;
constexpr int NPH = 8;
constexpr int LDS_BYTES = 160 * 1024;
constexpr size_t OUT_YP = 0, OUT_YS = 8388608, OUT_SD = 16777216, OUT_SR = 25165824;
constexpr size_t WS_CTL = 0, WS_MODP = 16384, WS_PE = 606208, WS_BA = 737280, WS_GB = 2834432, WS_RGAGG = 4931584,
                 WS_WBAT = 9125888, WS_WOUTT = 9191424, WS_GT = 13385728, WS_WINT = 14434304, WS_TA = 27017216, WS_PROJ = 60571648, WS_CARRY = 261898240;

struct Params {
    const float *x_prompt, *x_sample, *state_delta, *state_rglru, *c, *c_ctx, *ada_w, *ada_b, *pre_w, *post_w, *w_in, *w_out,
                *dn_conv_w, *dn_a_log, *dn_dt_bias, *dn_norm_w, *rg_conv_w, *rg_conv_b, *rg_w_r, *rg_b_r, *rg_w_i, *rg_b_i, *rg_lam;
    float* out; unsigned char* ws;
    int ph_lo, ph_hi;
};

__device__ __forceinline__ float bf2f(unsigned short b) { return __uint_as_float(((unsigned)b) << 16); }
typedef __bf16 bf2_t __attribute__((ext_vector_type(2)));
typedef float f2_t __attribute__((ext_vector_type(2)));
__device__ __forceinline__ unsigned pk2(float lo, float hi) { const f2_t v = {lo, hi}; return __builtin_bit_cast(unsigned, __builtin_convertvector(v, bf2_t)); }
__device__ __forceinline__ unsigned short f2bf(float f) { return (unsigned short)(pk2(f, f) & 0xffffu); }
#ifndef SANITIZE
#define SANITIZE 0
#endif
#ifndef LIVE_MASK
#define LIVE_MASK 15
#endif
__device__ __forceinline__ float fin(float x) { return (SANITIZE && ((__float_as_uint(x) & 0x7f800000u) == 0x7f800000u)) ? 0.f : x; }
#define DG(F) ((unsigned*)((F).ws + WS_CTL))
__device__ __forceinline__ bool badv(float x, float lim) { return ((__float_as_uint(x) & 0x7f800000u) == 0x7f800000u) || fabsf(x) > lim; }
#ifndef DIAG
#define DIAG 0
#endif
#define CHK(F, k, bad) do { if (DIAG && (bad)) DG(F)[k] = 1u; } while (0)
__device__ __forceinline__ float sigm(float x) { return __builtin_amdgcn_rcpf(1.f + __expf(-x)); }
__device__ __forceinline__ float siluf_(float x) { return x * __builtin_amdgcn_rcpf(1.f + __expf(-x)); }
__device__ __forceinline__ float softplusf_(float x) { return x > 20.f ? x : log1pf(__expf(x)); }
__device__ __forceinline__ void unpack8(const u32x4 v, float (&f)[8]) {
    f[0] = __uint_as_float(v.x << 16); f[1] = __uint_as_float(v.x & 0xffff0000u);
    f[2] = __uint_as_float(v.y << 16); f[3] = __uint_as_float(v.y & 0xffff0000u);
    f[4] = __uint_as_float(v.z << 16); f[5] = __uint_as_float(v.z & 0xffff0000u);
    f[6] = __uint_as_float(v.w << 16); f[7] = __uint_as_float(v.w & 0xffff0000u);
}
__device__ __forceinline__ u32x4 pack8(const float (&f)[8]) { u32x4 o; o.x = pk2(f[0], f[1]); o.y = pk2(f[2], f[3]); o.z = pk2(f[4], f[5]); o.w = pk2(f[6], f[7]); return o; }
__device__ __forceinline__ float wave_sum(float v) {
#pragma unroll
    for (int o = 1; o < 64; o <<= 1) v += __shfl_xor(v, o);
    return v;
}
__device__ __forceinline__ void lds_barrier() { asm volatile("s_waitcnt lgkmcnt(0)" ::: "memory"); __builtin_amdgcn_s_barrier(); asm volatile("" ::: "memory"); }
#define MFMA16(a, b, c) __builtin_amdgcn_mfma_f32_16x16x32_bf16((a), (b), (c), 0, 0, 0)
#define LDS_WAIT() asm volatile("s_waitcnt lgkmcnt(0)" ::: "memory")
__device__ __forceinline__ bf16x8 ldfrag(const LAS unsigned char* base, int pitch, int row, int kb) { return *(const LAS bf16x8*)(base + row * pitch + kb); }

#define XB_TMO      128
#define XB_XCNT(j)  (256  + 64 * (j))
#define XB_XSUB(j)  (1280 + 64 * (j))
#define XB_XGEN(j)  (2304 + 64 * (j))
#define XB_TOP      3328
#define XB_TOPGEN   3392
#define XCD_BAR_WORDS 3456
#define XB_SPIN_CAP (1u << 18)
__device__ __forceinline__ unsigned xb_ld(unsigned* p)              { return __hip_atomic_load(p, __ATOMIC_RELAXED, __HIP_MEMORY_SCOPE_AGENT); }
__device__ __forceinline__ unsigned xb_add(unsigned* p, unsigned v) { return __hip_atomic_fetch_add(p, v, __ATOMIC_RELAXED, __HIP_MEMORY_SCOPE_AGENT); }
__device__ __forceinline__ unsigned xb_xcc_id() { return (unsigned)__builtin_amdgcn_s_getreg((3 << 11) | 20) & 0xFu; }
#define XB_SPIN(cond, bar) do { unsigned _sp = 0; while (cond) { __builtin_amdgcn_s_sleep(1); \
    if ((++_sp & 255u) == 0u) { if (xb_ld(&(bar)[XB_TMO])) break; if (_sp > XB_SPIN_CAP) { atomicAdd(&(bar)[XB_TMO], 1u); break; } } } } while (0)
struct XcdBarrier { unsigned* bar; unsigned x; volatile LAS unsigned* st; };
__device__ __forceinline__ XcdBarrier xcd_barrier_post(unsigned* bar, volatile LAS unsigned* st) {
    XcdBarrier b; b.bar = bar; b.x = xb_xcc_id(); b.st = st;
    if (threadIdx.x == 0) (void)xb_add(&bar[XB_XCNT(b.x)], 1u);
    return b;
}
__device__ __forceinline__ void xcd_barrier_complete(unsigned* bar, unsigned x, unsigned& nloc, unsigned& nx) {
    const unsigned G = gridDim.x * gridDim.y * gridDim.z;
    unsigned sum, cnt, mine, sp = 0u;
    for (;;) {
        sum = 0u; cnt = 0u; mine = 0u;
#pragma unroll
        for (unsigned j = 0; j < 16; ++j) { const unsigned c = xb_ld(&bar[XB_XCNT(j)]); sum += c; cnt += (c > 0u) ? 1u : 0u; mine = (j == x) ? c : mine; }
        if (sum == G) break;
        __builtin_amdgcn_s_sleep(1);
        if ((++sp & 255u) == 0u) { if (xb_ld(&bar[XB_TMO])) break; if (sp > XB_SPIN_CAP) { atomicAdd(&bar[XB_TMO], 1u); break; } }
    }
    nloc = mine > 0u ? mine : 1u; nx = cnt > 0u ? cnt : 1u;
}
__device__ __forceinline__ void xcd_barrier(const XcdBarrier& b) {
    asm volatile("s_waitcnt vmcnt(0)" ::: "memory");
    __syncthreads();
    if (threadIdx.x == 0) {
        unsigned* bar = b.bar;
        __builtin_amdgcn_s_waitcnt(0);
        unsigned nloc = b.st[0], nx = b.st[1];
        if (nloc == 0u) { xcd_barrier_complete(bar, b.x, nloc, nx); b.st[0] = nloc; b.st[1] = nx; }
        const unsigned old = xb_add(&bar[XB_XSUB(b.x)], 1u);
        const unsigned gen = old / nloc;
        if (old + 1u == (gen + 1u) * nloc) {
            __builtin_amdgcn_fence(__ATOMIC_RELEASE, "agent");
            asm volatile("s_waitcnt vmcnt(0)" ::: "memory");
            const unsigned og = xb_add(&bar[XB_TOP], 1u);
            const unsigned tg = og / nx;
            if (og + 1u == (tg + 1u) * nx) xb_add(&bar[XB_TOPGEN], 1u);
            else XB_SPIN(xb_ld(&bar[XB_TOPGEN]) == tg, bar);
            __builtin_amdgcn_fence(__ATOMIC_ACQUIRE, "agent");
            xb_add(&bar[XB_XGEN(b.x)], 1u);
            asm volatile("s_waitcnt vmcnt(0)" ::: "memory");
        } else {
            XB_SPIN(xb_ld(&bar[XB_XGEN(b.x)]) == gen, bar);
            __builtin_amdgcn_fence(__ATOMIC_ACQUIRE, "agent");
            asm volatile("s_waitcnt vmcnt(0)" ::: "memory");
        }
    }
    __syncthreads();
}

namespace pg8 {
constexpr int BM = 256, BK = 64, HALF = 128, HTB = HALF * BK * 2, STAGE_BYTES = 8 * HTB, NXCD = 8, WGM = 8;
__host__ __device__ __forceinline__ int lds_byte(int r, int c) { const int st = (r >> 4) * 2 + (c >> 5), rr = r & 15, cc = c & 31, ob = rr * 64 + cc * 2; return st * 1024 + (ob ^ (((ob >> 9) & 1) << 5)); }
__host__ __device__ __forceinline__ void stage_rc(int b, int& R, int& C) { const int st = b / 1024, sb = b % 1024, swz = sb ^ (((sb >> 9) & 1) << 5); R = (st >> 1) * 16 + swz / 64; C = (st & 1) * 32 + (swz % 64) / 2; }
__host__ __device__ __forceinline__ int perm32(int rho) { const int n = rho >> 4, i = rho & 15; return 8 * (i >> 2) + 4 * n + (i & 3); }
struct Unit { int pm, pn; };
struct Gemm { const bf16_t* A; const bf16_t* Bt; int M, N, K; };
struct StaticOrder {
    int nM, nN, nwg, G, c;
    __host__ __device__ void init(int M, int N, int G_, int c_) { nM = M / BM; nN = N / BM; nwg = nM * nN; G = G_; c = c_; }
    __host__ __device__ bool next(int i, Unit& u) const {
        const long L = (long)i * G + c; if (L >= nwg) return false;
        int wgid = (int)L; { const int q = nwg / NXCD, r = nwg % NXCD, xcd = wgid % NXCD, off = wgid / NXCD; wgid = (xcd < r ? xcd * (q + 1) : r * (q + 1) + (xcd - r) * q) + off; }
        const int nig = WGM * nN, gid = wgid / nig, fm = gid * WGM, gsz = (nM - fm) < WGM ? (nM - fm) : WGM;
        u.pm = fm + ((wgid % nig) % gsz); u.pn = (wgid % nig) / gsz; return true;
    }
};
__device__ __forceinline__ unsigned cvt_pk_bf16(float lo, float hi) { unsigned r; asm volatile("v_cvt_pk_bf16_f32 %0, %1, %2" : "=v"(r) : "v"(lo), "v"(hi)); return r; }
struct EpiF32 {
    static constexpr bool PERM = false;
    float* C; int ldc;
    __device__ __forceinline__ void operator()(const f32x4 (&acc)[2][2][4][2], const Unit& u, int wr, int wc, int fr, int fq) const {
        const int row0 = u.pm * BM + wr * 64 + fr, col0 = u.pn * BM + wc * 32 + 4 * fq;
#pragma unroll
        for (int ai = 0; ai < 2; ++ai)
#pragma unroll
            for (int m = 0; m < 4; ++m) { float* rowp = C + (size_t)(row0 + ai * HALF + m * 16) * ldc + col0;
#pragma unroll
                for (int bj = 0; bj < 2; ++bj)
#pragma unroll
                    for (int n = 0; n < 2; ++n) *(f32x4*)(rowp + bj * HALF + n * 16) = acc[ai][bj][m][n]; }
    }
};
struct EpiBf16 {
    static constexpr bool PERM = true;
    bf16_t* O; int ldc;
    __device__ __forceinline__ void operator()(const f32x4 (&acc)[2][2][4][2], const Unit& u, int wr, int wc, int fr, int fq) const {
        const int row0 = u.pm * BM + wr * 64 + fr; const int col0 = u.pn * BM + wc * 32 + 8 * fq;
#pragma unroll
        for (int ai = 0; ai < 2; ++ai)
#pragma unroll
            for (int m = 0; m < 4; ++m) { bf16_t* rowp = O + (size_t)(row0 + ai * HALF + m * 16) * ldc + col0;
#pragma unroll
                for (int bj = 0; bj < 2; ++bj) { const f32x4 v0 = acc[ai][bj][m][0], v1 = acc[ai][bj][m][1];
                    u32x4 w; w.x = cvt_pk_bf16(v0[0], v0[1]); w.y = cvt_pk_bf16(v0[2], v0[3]); w.z = cvt_pk_bf16(v1[0], v1[1]); w.w = cvt_pk_bf16(v1[2], v1[3]);
                    *(u32x4*)(rowp + bj * HALF) = w; } }
    }
};

template <class Epi, class Sched>
__device__ __forceinline__ void gemm_phase(LAS unsigned char* lds, const Gemm g, const Sched& S, const Epi& E) {
    const int tid = threadIdx.x, wid = __builtin_amdgcn_readfirstlane(tid >> 6), lane = tid & 63, wr = wid >> 2, wc = wid & 3, fr = lane & 15, fq = lane >> 4;
    const int K = g.K, nt = K / BK;
    unsigned voffA[2], voffB[2];
#pragma unroll
    for (int i = 0; i < 2; ++i) { int R, C; stage_rc(tid * 16 + i * 8192, R, C); const int Rb = Epi::PERM ? ((R & ~31) + perm32(R & 31)) : R;
        voffA[i] = (unsigned)(R * K + C) * 2u; voffB[i] = (unsigned)(Rb * K + C) * 2u; }
    const size_t kstep = (size_t)(BK * 2);
    const size_t hstep = (size_t)HALF * K * 2;
    const size_t tstep = 2 * hstep;
    const unsigned ldsw = (unsigned)wid * 1024u;
    const int aoff = lds_byte(wr * 64 + fr, fq * 8), boff = lds_byte(wc * 32 + fr, fq * 8);
#define PG8_SA(b, h) (((b) * 2 + (h)) * HTB)
#define PG8_SB(b, h) ((4 + (b) * 2 + (h)) * HTB)
#define PG8_STAGE(bufoff, gbase, voff) do { _Pragma("unroll") for (int _i = 0; _i < 2; ++_i) \
        __builtin_amdgcn_global_load_lds((const unsigned*)((const char*)(gbase) + (voff)[_i]), (LAS unsigned*)(lds + (bufoff) + ldsw + _i * 8192), 16, 0, 0); } while (0)
#define PG8_LDA(dst, b, h) do { _Pragma("unroll") for (int m = 0; m < 4; ++m) _Pragma("unroll") for (int k = 0; k < 2; ++k) dst[m][k] = *(const LAS bf16x8*)(lds + PG8_SA(b, h) + aoff + m * 2048 + k * 1024); } while (0)
#define PG8_LDB(dst, b, h) do { _Pragma("unroll") for (int n = 0; n < 2; ++n) _Pragma("unroll") for (int k = 0; k < 2; ++k) dst[n][k] = *(const LAS bf16x8*)(lds + PG8_SB(b, h) + boff + n * 2048 + k * 1024); } while (0)
#define PG8_MMA(ai, bj, At, Bt) do { __builtin_amdgcn_s_setprio(1); _Pragma("unroll") for (int m = 0; m < 4; ++m) _Pragma("unroll") for (int n = 0; n < 2; ++n) _Pragma("unroll") for (int k = 0; k < 2; ++k) \
        acc[ai][bj][m][n] = __builtin_amdgcn_mfma_f32_16x16x32_bf16(Bt[n][k], At[m][k], acc[ai][bj][m][n], 0, 0, 0); __builtin_amdgcn_s_setprio(0); } while (0)
#define PG8_WAIT_V(n) asm volatile("s_waitcnt vmcnt(" #n ")" ::: "memory")
#define PG8_WAIT_L(n) asm volatile("s_waitcnt lgkmcnt(" #n ")" ::: "memory")
#define PG8_BAR __builtin_amdgcn_s_barrier()
#define PG8_SCHED __builtin_amdgcn_sched_barrier(0)
    Unit cur, nxt; int ui = 0;
    if (!S.next(0, cur)) return;
    f32x4 acc[2][2][4][2];
#pragma unroll
    for (int a = 0; a < 2; ++a)
#pragma unroll
        for (int b = 0; b < 2; ++b)
#pragma unroll
            for (int m = 0; m < 4; ++m)
#pragma unroll
                for (int n = 0; n < 2; ++n) acc[a][b][m][n] = (f32x4){0.f, 0.f, 0.f, 0.f};
    bf16x8 At[4][2], B0[2][2], B1[2][2];
    const char* cA = (const char*)g.A + (size_t)cur.pm * tstep; const char* cB = (const char*)g.Bt + (size_t)cur.pn * tstep;
    PG8_STAGE(PG8_SB(0, 0), cB, voffB); PG8_STAGE(PG8_SA(0, 0), cA, voffA); PG8_STAGE(PG8_SB(0, 1), cB + hstep, voffB); PG8_STAGE(PG8_SA(0, 1), cA + hstep, voffA);
    if (wr == 1) PG8_BAR;
    PG8_WAIT_V(4); PG8_BAR;
    PG8_STAGE(PG8_SB(1, 0), cB + kstep, voffB); PG8_STAGE(PG8_SA(1, 0), cA + kstep, voffA); PG8_STAGE(PG8_SB(1, 1), cB + hstep + kstep, voffB);
    PG8_WAIT_V(6); PG8_BAR;
    for (;;) {
        const bool has_next = S.next(ui + 1, nxt);
        const char* nA = has_next ? (const char*)g.A + (size_t)nxt.pm * tstep : cA; const char* nB = has_next ? (const char*)g.Bt + (size_t)nxt.pn * tstep : cB;
        for (int t = 0; t < nt; t += 2) {
            const bool last = (t == nt - 2);
            const char* a1 = cA + (size_t)(t + 1) * kstep;
            const char* a2 = last ? nA : cA + (size_t)(t + 2) * kstep; const char* b2 = last ? nB : cB + (size_t)(t + 2) * kstep;
            const char* a3 = a2 + kstep; const char* b3 = b2 + kstep;
            PG8_LDB(B0, 0, 0); PG8_SCHED; PG8_LDA(At, 0, 0); PG8_STAGE(PG8_SA(1, 1), a1 + hstep, voffA);
            PG8_WAIT_L(8); PG8_BAR; PG8_WAIT_L(0); PG8_MMA(0, 0, At, B0); PG8_BAR; PG8_SCHED;
            PG8_LDB(B1, 0, 1); PG8_STAGE(PG8_SB(0, 0), b2, voffB);
            PG8_BAR; PG8_WAIT_L(0); PG8_MMA(0, 1, At, B1); PG8_BAR;
            PG8_LDA(At, 0, 1); PG8_STAGE(PG8_SA(0, 0), a2, voffA);
            PG8_BAR; PG8_WAIT_L(0); PG8_MMA(1, 0, At, B0); PG8_BAR; PG8_SCHED;
            PG8_STAGE(PG8_SB(0, 1), b2 + hstep, voffB);
            PG8_WAIT_V(6); PG8_BAR; PG8_MMA(1, 1, At, B1); PG8_BAR;
            PG8_LDB(B0, 1, 0); PG8_SCHED; PG8_LDA(At, 1, 0); PG8_STAGE(PG8_SA(0, 1), a2 + hstep, voffA);
            PG8_WAIT_L(8); PG8_BAR; PG8_WAIT_L(0); PG8_MMA(0, 0, At, B0); PG8_BAR; PG8_SCHED;
            PG8_LDB(B1, 1, 1); PG8_STAGE(PG8_SB(1, 0), b3, voffB);
            PG8_BAR; PG8_WAIT_L(0); PG8_MMA(0, 1, At, B1); PG8_BAR;
            PG8_LDA(At, 1, 1); PG8_STAGE(PG8_SA(1, 0), a3, voffA);
            PG8_BAR; PG8_WAIT_L(0); PG8_MMA(1, 0, At, B0); PG8_BAR; PG8_SCHED;
            PG8_STAGE(PG8_SB(1, 1), b3 + hstep, voffB);
            PG8_WAIT_V(6); PG8_BAR; PG8_MMA(1, 1, At, B1); PG8_BAR;
        }
        E(acc, cur, wr, wc, fr, fq);
        if (!has_next) break;
#pragma unroll
        for (int a = 0; a < 2; ++a)
#pragma unroll
            for (int b = 0; b < 2; ++b)
#pragma unroll
                for (int m = 0; m < 4; ++m)
#pragma unroll
                    for (int n = 0; n < 2; ++n) acc[a][b][m][n] = (f32x4){0.f, 0.f, 0.f, 0.f};
        cur = nxt; cA = nA; cB = nB; ++ui;
    }
    PG8_WAIT_V(0);
    if (wr == 0) PG8_BAR;
    PG8_BAR;
#undef PG8_SA
#undef PG8_SB
#undef PG8_STAGE
#undef PG8_LDA
#undef PG8_LDB
#undef PG8_MMA
#undef PG8_WAIT_V
#undef PG8_WAIT_L
#undef PG8_BAR
#undef PG8_SCHED
}
}

struct Frame {
    LAS unsigned char* lds;
    int tid, lane, wave, G, b;
    float* out; unsigned char* ws;
    __device__ __forceinline__ bf16_t* H() const { return (bf16_t*)out; }
    __device__ __forceinline__ bf16_t* Qc() const { return (bf16_t*)out; }
    __device__ __forceinline__ bf16_t* Kc() const { return (bf16_t*)(out + OUT_YS); }
    __device__ __forceinline__ bf16_t* MIX() const { return (bf16_t*)out; }
    __device__ __forceinline__ float* modp() const { return (float*)(ws + WS_MODP); }
    __device__ __forceinline__ float* pe() const { return (float*)(ws + WS_PE); }
    __device__ __forceinline__ float* BA() const { return (float*)(ws + WS_BA); }
    __device__ __forceinline__ float* GB() const { return (float*)(ws + WS_GB); }
    __device__ __forceinline__ float* RGAGG() const { return (float*)(ws + WS_RGAGG); }
    __device__ __forceinline__ bf16_t* WbaT() const { return (bf16_t*)(ws + WS_WBAT); }
    __device__ __forceinline__ bf16_t* WoutT() const { return (bf16_t*)(ws + WS_WOUTT); }
    __device__ __forceinline__ bf16_t* GT() const { return (bf16_t*)(ws + WS_GT); }
    __device__ __forceinline__ bf16_t* WinT() const { return (bf16_t*)(ws + WS_WINT); }
    __device__ __forceinline__ bf16_t* TA() const { return (bf16_t*)(ws + WS_TA); }
    __device__ __forceinline__ bf16_t* PROJ() const { return (bf16_t*)(ws + WS_PROJ); }
    __device__ __forceinline__ float* CARRY() const { return (float*)(ws + WS_CARRY); }
};
typedef const __attribute__((address_space(4))) Params CParams;

__device__ __forceinline__ int grp_of_block(int tb) { return tb < 128 ? 0 : (tb < 192 ? 1 : 2); }

__device__ __forceinline__ void transpose_item(const float* W, int N, int k0, int n0, bf16_t* WT0, int Kout, LAS float* scr, int lane) {
#pragma unroll 8
    for (int i = 0; i < 32; ++i) { const int kk = 2 * i + (lane >> 5); scr[kk * 33 + (lane & 31)] = W[(size_t)(k0 + kk) * N + n0 + (lane & 31)]; }
    LDS_WAIT();
    const int c = lane & 7;
#pragma unroll
    for (int j = 0; j < 4; ++j) { const int n = (lane >> 3) + 8 * j; const LAS float* s = scr + (8 * c) * 33 + n;
        u32x4 o; o.x = pk2(s[0 * 33], s[1 * 33]); o.y = pk2(s[2 * 33], s[3 * 33]); o.z = pk2(s[4 * 33], s[5 * 33]); o.w = pk2(s[6 * 33], s[7 * 33]);
        *(u32x4*)(WT0 + (size_t)n * Kout + k0 + 8 * c) = o; }
    LDS_WAIT();
}
struct P0Item { const float* W; bf16_t* dst; int N, k0, n0, Kout, kind; };
__device__ __forceinline__ P0Item p0_decode(CParams& p, const Frame& F, int it) {
    constexpr int I_IN = 16 * 193, I_OUT = 32 * 32, I_G = 256;
    P0Item D; D.kind = 0; int r = it;
    if (r < I_IN) { const int kb = r / 193, nb = r % 193, n0 = nb * 32;
        D.dst = n0 < 4096 ? F.WinT() + (size_t)n0 * 1024 : (n0 < 4128 ? F.WbaT() + (size_t)(n0 - 4096) * 1024 : F.WinT() + (size_t)(n0 - 32) * 1024);
        D.W = p.w_in; D.N = DIN; D.k0 = kb * 64; D.n0 = n0; D.Kout = 1024; return D; }
    r -= I_IN;
    if (r < I_OUT) { const int kb = r / 32, nb = r % 32; D.W = p.w_out; D.N = 1024; D.k0 = kb * 64; D.n0 = nb * 32; D.dst = F.WoutT() + (size_t)(nb * 32) * 2048; D.Kout = 2048; return D; }
    r -= I_OUT;
    if (r < I_G) { const int m = r >> 3, sub = r & 7, kb = sub >> 2, nb = sub & 3, g = m >> 4, dn = m & 15;
        D.W = (g ? p.rg_w_i : p.rg_w_r) + (size_t)dn * 16384; D.N = 128; D.k0 = kb * 64; D.n0 = nb * 32; D.dst = F.GT() + (size_t)m * 16384 + (size_t)(nb * 32) * 128; D.Kout = 128; return D; }
    r -= I_G;
    D.kind = 1; D.k0 = r; D.W = p.w_in; D.dst = F.WinT(); D.N = 0; D.n0 = 0; D.Kout = 0; return D;
}
__device__ __forceinline__ void p0_load(const P0Item& D, float (&v)[32], int lane) {
#pragma unroll
    for (int i = 0; i < 32; ++i) { const int kk = 2 * i + (lane >> 5); v[i] = D.W[(size_t)(D.k0 + kk) * D.N + D.n0 + (lane & 31)]; }
}
__device__ __forceinline__ void p0_store(const P0Item& D, const float (&v)[32], LAS float* scr, int lane) {
#pragma unroll
    for (int i = 0; i < 32; ++i) { const int kk = 2 * i + (lane >> 5); scr[kk * 33 + (lane & 31)] = v[i]; }
    LDS_WAIT();
    const int c = lane & 7;
#pragma unroll
    for (int j = 0; j < 4; ++j) { const int n = (lane >> 3) + 8 * j; const LAS float* s = scr + (8 * c) * 33 + n;
        u32x4 o; o.x = pk2(s[0 * 33], s[1 * 33]); o.y = pk2(s[2 * 33], s[3 * 33]); o.z = pk2(s[4 * 33], s[5 * 33]); o.w = pk2(s[6 * 33], s[7 * 33]);
        *(u32x4*)(D.dst + (size_t)n * D.Kout + D.k0 + 8 * c) = o; }
    LDS_WAIT();
}
__device__ __forceinline__ void phase0(CParams& p, Frame& F) {
    const int tid = F.tid, lane = F.lane;
    for (int it = F.b; it < 192; it += F.G) {
        const int jg = it % 12, ks = it / 12, j = jg * 256 + (tid & 255), half = tid >> 8, k0 = ks * 64 + half * 32;
        float s0 = 0.f, s1 = 0.f, s2 = 0.f;
#pragma unroll 8
        for (int k = 0; k < 32; ++k) { const int kk = k0 + k; const float w = p.ada_w[(size_t)kk * 3072 + j];
            s0 += siluf_(p.c_ctx[kk]) * w; s1 += siluf_(p.c[kk]) * w; s2 += siluf_(p.c[1024 + kk]) * w; }
        LAS float* red = (LAS float*)F.lds;
        if (half == 1) { red[tid - 256] = s0; red[256 + tid - 256] = s1; red[512 + tid - 256] = s2; }
        __syncthreads();
        if (half == 0) { F.modp()[(size_t)(ks * 3 + 0) * 3072 + j] = s0 + red[tid]; F.modp()[(size_t)(ks * 3 + 1) * 3072 + j] = s1 + red[256 + tid]; F.modp()[(size_t)(ks * 3 + 2) * 3072 + j] = s2 + red[512 + tid]; }
        __syncthreads();
    }
    LAS float* scr = (LAS float*)(F.lds + 4096 + F.wave * 8448);
    const int gw = F.b * 8 + F.wave, NGW = F.G * 8;
    constexpr int I_IN = 16 * 193, I_OUT = 32 * 32, I_G = 256, I_PE = 64, I_ALL = I_IN + I_OUT + I_G + I_PE;
    P0Item D = p0_decode(p, F, gw), Dn = D; float v[32], vn[32];
    if (gw < I_ALL && D.kind == 0) p0_load(D, v, lane);
    for (int it = gw; it < I_ALL; it += NGW) {
        const int itn = it + NGW;
        if (itn < I_ALL) { Dn = p0_decode(p, F, itn); if (Dn.kind == 0) p0_load(Dn, vn, lane); }
        if (D.kind == 0) p0_store(D, v, scr, lane);
        else { const int pv = D.k0;
#pragma unroll
            for (int i = 0; i < 4; ++i) { const int idx = lane * 4 + i; const float f = expf(-9.210340371976184f * (float)idx / 256.f); const float a = (float)pv * f;
                F.pe()[pv * 256 + idx] = sinf(a); F.pe()[16384 + pv * 256 + idx] = cosf(a); } }
        D = Dn;
#pragma unroll
        for (int i = 0; i < 32; ++i) v[i] = vn[i];
    }
}

__device__ __forceinline__ float mod_val(CParams& p, const Frame& F, int grp, int j) {
    float s = p.ada_b[j];
#pragma unroll
    for (int ks = 0; ks < 16; ++ks) s += F.modp()[(size_t)(ks * 3 + grp) * 3072 + j];
    return s;
}

__device__ __forceinline__ void phase1(CParams& p, Frame& F) {
    LAS float* sc = (LAS float*)F.lds; LAS float* sh = sc + 1024;
    for (int tb = F.b; tb < 256; tb += F.G) {
        const int grp = grp_of_block(tb);
        for (int j = F.tid; j < 1024; j += 512) { sh[j] = mod_val(p, F, grp, j); sc[j] = p.pre_w[j] * (1.f + mod_val(p, F, grp, 1024 + j)); }
        __syncthreads();
#pragma unroll 2
        for (int i = 0; i < 8; ++i) {
            const int tok = tb * 64 + F.wave * 8 + i;
            const float* xr = tok < 8192 ? p.x_prompt + (size_t)tok * 1024 : p.x_sample + (size_t)(tok - 8192) * 1024;
            f32x4 v[4]; float ss = 0.f;
#pragma unroll
            for (int q = 0; q < 4; ++q) { v[q] = *(const f32x4*)(xr + F.lane * 4 + 256 * q);
                if (tok >= 8192) { const int pp = (tok - 8192) & 4095; const int vv = (q < 2) ? (pp >> 6) : (pp & 63);
                    const f32x4 e = *(const f32x4*)(F.pe() + ((q & 1) ? 16384 : 0) + vv * 256 + F.lane * 4); v[q] += e; }
                ss += (v[q][0] * v[q][0] + v[q][1] * v[q][1]) + (v[q][2] * v[q][2] + v[q][3] * v[q][3]); }
            const float rstd = rsqrtf(wave_sum(ss) * (1.f / 1024.f) + 1e-6f);
#pragma unroll
            for (int q = 0; q < 4; ++q) { const int j = F.lane * 4 + 256 * q; const f32x4 s4 = *(const LAS f32x4*)(sc + j), h4 = *(const LAS f32x4*)(sh + j);
                CHK(F, 1, badv(v[q][0] * rstd * s4[0] + h4[0], 100.f) || badv(v[q][3] * rstd * s4[3] + h4[3], 100.f));
                u32x2 o; o.x = pk2(v[q][0] * rstd * s4[0] + h4[0], v[q][1] * rstd * s4[1] + h4[1]); o.y = pk2(v[q][2] * rstd * s4[2] + h4[2], v[q][3] * rstd * s4[3] + h4[3]);
                *(u32x2*)(F.H() + (size_t)tok * 1024 + j) = o; }
        }
        __syncthreads();
    }
}

__device__ __forceinline__ void phase2(CParams& p, Frame& F) {
    { pg8::Gemm g{F.H(), F.WinT(), NTOK, NPROJ, 1024}; pg8::StaticOrder S; S.init(NTOK, NPROJ, F.G, F.b); pg8::EpiBf16 E{F.PROJ(), NPROJ};
      pg8::gemm_phase<pg8::EpiBf16, pg8::StaticOrder>(F.lds, g, S, E); }
    const int l15 = F.lane & 15, q4 = F.lane >> 4;
    for (int tb = F.b; tb < 256; tb += F.G) {
        const int mt = F.wave >> 1, nt = F.wave & 1;
        const bf16_t* ar = F.H() + (size_t)(tb * 64 + mt * 16 + l15) * 1024 + q4 * 8;
        const bf16_t* br = F.WbaT() + (size_t)(nt * 16 + l15) * 1024 + q4 * 8;
        f32x4 acc = {0.f, 0.f, 0.f, 0.f};
#pragma unroll 16
        for (int ks = 0; ks < 32; ++ks) { const bf16x8 a = *(const bf16x8*)(ar + ks * 32), b = *(const bf16x8*)(br + ks * 32); acc = MFMA16(a, b, acc); }
#pragma unroll
        for (int r = 0; r < 4; ++r) F.BA()[(size_t)(tb * 64 + mt * 16 + q4 * 4 + r) * 32 + nt * 16 + l15] = acc[r];
    }
}

__device__ __forceinline__ void p3_load_rows(const Frame& F, int ci, int h, u32x4 (&rows)[7]) {
    const int tid = F.tid, tg = tid >> 5, part = (tid >> 4) & 1, sub = tid & 15, col = part * 1024 + h * 128 + sub * 8, t0 = ci * 64;
    int seq_lo, seq_hi; if (ci < 128) { seq_lo = (ci >> 2) * 256; seq_hi = seq_lo + 256; } else { seq_lo = 8192 + ((ci - 128) >> 6) * 4096; seq_hi = seq_lo + 4096; }
    const int tb = t0 + tg * 4 - 2;
#pragma unroll
    for (int r = 0; r < 7; ++r) { const int tok = tb + r; u32x4 v = {0u, 0u, 0u, 0u};
        if (tok >= seq_lo && tok < seq_hi) v = *(const u32x4*)(F.PROJ() + (size_t)tok * NPROJ + col);
        rows[r] = v; }
}
__device__ __forceinline__ void p3_delta_item(CParams& p, Frame& F, int ci, int h, u32x4 (&rows)[7], int itn) {
    const int tid = F.tid, lane = F.lane, wave = F.wave, q4 = lane >> 4, l15 = lane & 15;
    LAS unsigned char* Ks = F.lds; LAS unsigned char* Qs = F.lds + 17408;
    LAS float* gfv = (LAS float*)(F.lds + 34816);
    LAS unsigned char* DIR0 = F.lds + 35840;
    LAS unsigned char* ATo = F.lds + 137728;
#pragma unroll
    for (int i = 0; i < 5; ++i) { const int ch = tid + 512 * i; if (ch < 2304) { const int dd = ch >= 1152, cc = ch - dd * 1152; *(LAS u32x4*)(DIR0 + dd * 47616 + 18432 + cc * 16) = (u32x4){0u, 0u, 0u, 0u}; } }
    const int t0 = ci * 64;
    int seq_lo, seq_hi; if (ci < 128) { seq_lo = (ci >> 2) * 256; seq_hi = seq_lo + 256; } else { seq_lo = 8192 + ((ci - 128) >> 6) * 4096; seq_hi = seq_lo + 4096; }
    {
        const int tg = tid >> 5, part = (tid >> 4) & 1, sub = tid & 15, col = part * 1024 + h * 128 + sub * 8;
        float w[4][8];
#pragma unroll
        for (int j = 0; j < 4; ++j) { const f32x4 a = *(const f32x4*)(p.dn_conv_w + j * 3072 + col), b = *(const f32x4*)(p.dn_conv_w + j * 3072 + col + 4);
            w[j][0] = a[0]; w[j][1] = a[1]; w[j][2] = a[2]; w[j][3] = a[3]; w[j][4] = b[0]; w[j][5] = b[1]; w[j][6] = b[2]; w[j][7] = b[3]; }
        float acc[4][8];
#pragma unroll
        for (int i = 0; i < 4; ++i)
#pragma unroll
            for (int e = 0; e < 8; ++e) acc[i][e] = 0.f;
#pragma unroll
        for (int r = 0; r < 7; ++r) {
            float x[8]; unpack8(rows[r], x);
#pragma unroll
            for (int j = 0; j < 4; ++j) { const int i = r - j; if (i >= 0 && i < 4) {
#pragma unroll
                for (int e = 0; e < 8; ++e) acc[i][e] += w[j][e] * x[e]; } } }
#pragma unroll
        for (int i = 0; i < 4; ++i) { float ss = 0.f;
#pragma unroll
            for (int e = 0; e < 8; ++e) { acc[i][e] = siluf_(acc[i][e]); ss += acc[i][e] * acc[i][e]; }
            ss += __shfl_xor(ss, 1); ss += __shfl_xor(ss, 2); ss += __shfl_xor(ss, 4); ss += __shfl_xor(ss, 8);
            const float rs = rsqrtf(ss + 1e-6f) * (part == 0 ? 0.08838834764831845f : 1.f);
#pragma unroll
            for (int e = 0; e < 8; ++e) acc[i][e] *= rs;
            CHK(F, 4, badv(acc[i][0], 1.01f) || badv(acc[i][5], 1.01f) || badv(ss * rs * rs, part == 0 ? 0.0079f : 1.01f));
            const u32x4 o = pack8(acc[i]); const int c = tg * 4 + i;
            *(LAS u32x4*)((part ? Ks : Qs) + c * 272 + sub * 16) = o;
            if (part == 0) *(u32x4*)(F.Qc() + (size_t)(t0 + c) * 1024 + h * 128 + sub * 8) = o; }
        if (part == 1) {
            bf16_t* kt = F.Kc() + (size_t)(ci * 8 + h) * 8192 + (size_t)(sub * 8) * 64 + tg * 4;
#pragma unroll
            for (int e = 0; e < 8; ++e) { u32x2 o2; o2.x = pk2(acc[0][e], acc[1][e]); o2.y = pk2(acc[2][e], acc[3][e]); *(u32x2*)(kt + e * 64) = o2; } }
    }
    if (wave == 0) {
        const float* ba = F.BA() + (size_t)(t0 + lane) * 32;
        const float bf_ = sigm(ba[h]), bb_ = sigm(ba[8 + h]);
        float s = -expf(p.dn_a_log[h]) * softplusf_(ba[16 + h] + p.dn_dt_bias[h]);
        float sb = -expf(p.dn_a_log[8 + h]) * softplusf_(ba[24 + h] + p.dn_dt_bias[8 + h]);
#pragma unroll
        for (int o = 1; o < 64; o <<= 1) { const float t = __shfl_up(s, o); if (lane >= o) s += t; }
#pragma unroll
        for (int o = 1; o < 64; o <<= 1) { const float t = __shfl_down(sb, o); if (lane + o < 64) sb += t; }
        CHK(F, 3, badv(ba[h], 1000.f) || badv(ba[24 + h], 1000.f));
        CHK(F, 8, badv(s, 1e4f) || badv(sb, 1e4f) || s > 0.f || sb > 0.f || bf_ < 0.f || bf_ > 1.f || bb_ < 0.f || bb_ > 1.f);
        gfv[lane] = s; gfv[64 + lane] = sb; gfv[128 + lane] = bf_; gfv[192 + lane] = bb_;
        float* gb = F.GB() + (size_t)(ci * 8 + h) * 256;
        gb[lane] = s; gb[64 + lane] = sb; gb[128 + lane] = bf_; gb[192 + lane] = bb_;
    }
    lds_barrier();
    const int d = wave >> 2, mt = wave & 3;
    LAS unsigned char* Db = DIR0 + d * 47616;
    LAS unsigned char* Brow = Db; LAS unsigned char* Btr = Db + 9216; LAS unsigned char* Xrow = Db + 18432; LAS unsigned char* Xtr = Db + 27648;
    LAS float* Dl = (LAS float*)(Db + 36864) + mt * 320; LAS unsigned char* M2t = Db + 41984; LAS unsigned char* Mts = Db + 44544 + mt * 768;
    const LAS unsigned char* Lrow = Brow;
    const LAS float* gd = gfv + d * 64; const LAS float* bd = gfv + 128 + d * 64;
    {
        f32x4 kk[4], qk[4];
#pragma unroll
        for (int n = 0; n < 4; ++n) { kk[n] = (f32x4){0.f, 0.f, 0.f, 0.f}; qk[n] = (f32x4){0.f, 0.f, 0.f, 0.f}; }
#pragma unroll
        for (int ks = 0; ks < 4; ++ks) { const bf16x8 ak = ldfrag(Ks, 272, mt * 16 + l15, ks * 64 + q4 * 16), aq = ldfrag(Qs, 272, mt * 16 + l15, ks * 64 + q4 * 16);
#pragma unroll
            for (int n = 0; n < 4; ++n) { const bf16x8 bk = ldfrag(Ks, 272, n * 16 + l15, ks * 64 + q4 * 16); kk[n] = MFMA16(ak, bk, kk[n]); qk[n] = MFMA16(aq, bk, qk[n]); } }
#pragma unroll
        for (int n = 0; n < 4; ++n) { const int C = n * 16 + l15; const float gC = gd[C], bC = bd[C]; float a4[4];
#pragma unroll
            for (int r = 0; r < 4; ++r) { const int R = mt * 16 + q4 * 4 + r;
                const float dec = __expf(-fabsf(gd[R] - gC));
                a4[r] = (C > R) ? (d == 0 ? bC : bd[R]) * kk[n][r] * dec : 0.f;
                const bool incl = d == 0 ? (R >= C) : (R < C);
                if (incl) ((LAS bf16_t*)ATo)[R * 64 + C] = f2bf(qk[n][r] * dec); }
            u32x2 o; o.x = pk2(a4[0], a4[1]); o.y = pk2(a4[2], a4[3]);
            *(LAS u32x2*)(Brow + C * 144 + (mt * 16 + q4 * 4) * 2) = o;
            if (n == mt) *(LAS f32x4*)(Dl + l15 * 20 + q4 * 4) = (f32x4){a4[0], a4[1], a4[2], a4[3]}; }
    }
    lds_barrier();
    if (itn < 2048) p3_load_rows(F, itn >> 3, itn & 7, rows);
    if (lane < 16) {
        float x[16];
#pragma unroll
        for (int i = 0; i < 16; ++i) { float sv = (i == lane) ? 1.f : 0.f;
            float drow[16];
#pragma unroll
            for (int q = 0; q < 4; ++q) if (4 * q < i) { const f32x4 t4 = *(const LAS f32x4*)(Dl + i * 20 + 4 * q); drow[4 * q] = t4[0]; drow[4 * q + 1] = t4[1]; drow[4 * q + 2] = t4[2]; drow[4 * q + 3] = t4[3]; }
#pragma unroll
            for (int j = 0; j < i; ++j) sv -= drow[j] * x[j];
            x[i] = sv; }
#pragma unroll
        for (int i = 0; i < 16; ++i) ((LAS bf16_t*)Xrow)[(mt * 16 + i) * 72 + mt * 16 + lane] = f2bf(x[i]);
        u32x4 o0, o1; o0.x = pk2(x[0], x[1]); o0.y = pk2(x[2], x[3]); o0.z = pk2(x[4], x[5]); o0.w = pk2(x[6], x[7]);
        o1.x = pk2(x[8], x[9]); o1.y = pk2(x[10], x[11]); o1.z = pk2(x[12], x[13]); o1.w = pk2(x[14], x[15]);
        *(LAS u32x4*)(Xtr + (mt * 16 + lane) * 144 + mt * 32) = o0; *(LAS u32x4*)(Xtr + (mt * 16 + lane) * 144 + mt * 32 + 16) = o1;
    }
    lds_barrier();
    const bf16x8 zero8 = {0, 0, 0, 0, 0, 0, 0, 0};
    const f32x4 zero4 = {0.f, 0.f, 0.f, 0.f};
    if (mt & 1) {
        const int I1 = mt, I0 = mt - 1;
        bf16x8 a = zero8, b = zero8;
        if (q4 < 2) { a = ldfrag(Lrow, 144, I1 * 16 + l15, I0 * 32 + q4 * 16); b = ldfrag(Xtr, 144, I0 * 16 + l15, I0 * 32 + q4 * 16); }
        const f32x4 M = MFMA16(a, b, zero4);
        { u32x2 o; o.x = pk2(M[0], M[1]); o.y = pk2(M[2], M[3]); *(LAS u32x2*)(Mts + l15 * 48 + q4 * 8) = o; }
        LDS_WAIT();
        bf16x8 a2 = zero8, b2 = zero8;
        if (q4 < 2) { a2 = ldfrag(Xrow, 144, I1 * 16 + l15, I1 * 32 + q4 * 16); b2 = *(const LAS bf16x8*)(Mts + l15 * 48 + q4 * 16); }
        const f32x4 X = MFMA16(a2, b2, zero4);
#pragma unroll
        for (int r = 0; r < 4; ++r) ((LAS bf16_t*)Xrow)[(I1 * 16 + q4 * 4 + r) * 72 + I0 * 16 + l15] = f2bf(-X[r]);
        u32x2 o; o.x = pk2(-X[0], -X[1]); o.y = pk2(-X[2], -X[3]);
        *(LAS u32x2*)(Xtr + (I0 * 16 + l15) * 144 + (I1 * 16 + q4 * 4) * 2) = o;
    }
    lds_barrier();
    {
        const int mi = mt >> 1, ni = mt & 1;
        const bf16x8 a = ldfrag(Lrow, 144, 32 + mi * 16 + l15, q4 * 16), b = ldfrag(Xtr, 144, ni * 16 + l15, q4 * 16);
        const f32x4 M2 = MFMA16(a, b, zero4);
        { u32x2 o; o.x = pk2(M2[0], M2[1]); o.y = pk2(M2[2], M2[3]); *(LAS u32x2*)(M2t + (ni * 16 + l15) * 80 + (mi * 16 + q4 * 4) * 2) = o; }
        lds_barrier();
        const bf16x8 a2 = ldfrag(Xrow, 144, 32 + mi * 16 + l15, 64 + q4 * 16), b2 = *(const LAS bf16x8*)(M2t + (ni * 16 + l15) * 80 + q4 * 16);
        const f32x4 X = MFMA16(a2, b2, zero4);
#pragma unroll
        for (int r = 0; r < 4; ++r) { CHK(F, 6, badv(X[r], 20.f)); ((LAS bf16_t*)Xrow)[(32 + mi * 16 + q4 * 4 + r) * 72 + ni * 16 + l15] = f2bf(-X[r]); }
        u32x2 o; o.x = pk2(-X[0], -X[1]); o.y = pk2(-X[2], -X[3]);
        *(LAS u32x2*)(Xtr + (ni * 16 + l15) * 144 + (32 + mi * 16 + q4 * 4) * 2) = o;
    }
    lds_barrier();
    { bf16_t* dst = F.TA() + (size_t)(ci * 8 + h) * 8192;
      const int c = tid >> 3, s0 = (tid & 7) * 8;
      const u32x4 lo = *(const LAS u32x4*)(DIR0 + 18432 + c * 144 + s0 * 2), up = *(const LAS u32x4*)(DIR0 + 47616 + 27648 + c * 144 + s0 * 2);
      unsigned wl[4] = {lo.x, lo.y, lo.z, lo.w}, wu[4] = {up.x, up.y, up.z, up.w}, wo[4];
#pragma unroll
      for (int i = 0; i < 4; ++i) { const int sa = s0 + 2 * i, sb2 = sa + 1;
          const unsigned mlo = (sa <= c ? 0x0000FFFFu : 0u) | (sb2 <= c ? 0xFFFF0000u : 0u);
          wo[i] = (wl[i] & mlo) | (wu[i] & ~mlo); }
      *(u32x4*)(dst + tid * 8) = (u32x4){wo[0], wo[1], wo[2], wo[3]};
      *(u32x4*)(dst + 4096 + tid * 8) = *(const LAS u32x4*)(ATo + tid * 16); }
    lds_barrier();
}

struct RgW { bf16x8 g[2][2][4]; float br[2], bi[2], sp[2]; };
__device__ __forceinline__ void rg_load_w(CParams& p, const Frame& F, int n, RgW& W) {
    const int q4 = F.lane >> 4, j = F.wave * 16 + (F.lane & 15), ch = n * 128 + j;
#pragma unroll
    for (int d = 0; d < 2; ++d) {
#pragma unroll
        for (int g = 0; g < 2; ++g) { const bf16_t* gp = F.GT() + (size_t)((g * 2 + d) * 8 + n) * 16384 + (size_t)j * 128 + q4 * 8;
#pragma unroll
            for (int ks = 0; ks < 4; ++ks) W.g[d][g][ks] = *(const bf16x8*)(gp + ks * 32); }
        W.br[d] = p.rg_b_r[d * 1024 + ch]; W.bi[d] = p.rg_b_i[d * 1024 + ch]; W.sp[d] = softplusf_(-p.rg_lam[d * 1024 + ch]); }
}
__device__ __forceinline__ void rg_load_rows(const Frame& F, int ci, int n, u32x4 (&rows)[5]) {
    const int tid = F.tid, tg = tid >> 4, sub = tid & 15, col = 4096 + n * 128 + sub * 8, t0 = ci * 64;
    int c_lo, c_hi; if (ci < 128) { c_lo = (ci >> 2) * 4; c_hi = c_lo + 4; } else { c_lo = 128 + ((ci - 128) >> 6) * 64; c_hi = c_lo + 64; }
    const int tb = t0 + tg * 2 - 2;
#pragma unroll
    for (int r = 0; r < 5; ++r) { const int tok = tb + r; u32x4 v = {0u, 0u, 0u, 0u};
        if (tok >= c_lo * 64 && tok < c_hi * 64) v = *(const u32x4*)(F.PROJ() + (size_t)tok * NPROJ + col);
        rows[r] = v; }
}
template <int PASS>
__device__ __forceinline__ void rg_item(CParams& p, Frame& F, int ci, int n, u32x4 (&rows)[5], int itn) {
    const int tid = F.tid, lane = F.lane, wave = F.wave, q4 = lane >> 4, l15 = lane & 15;
    LAS unsigned char* xb = F.lds; LAS float* xf = (LAS float*)(F.lds + 17408); LAS float* Hs = (LAS float*)(F.lds + 50176);
    const int t0 = ci * 64;
    int seq_lo, seq_hi, c_lo, c_hi, seq; const bool samp = ci >= 128;
    if (!samp) { seq = ci >> 2; c_lo = seq * 4; c_hi = c_lo + 4; } else { seq = (ci - 128) >> 6; c_lo = 128 + seq * 64; c_hi = c_lo + 64; }
    seq_lo = c_lo * 64; seq_hi = c_hi * 64;
    const int j = wave * 16 + l15, ch = n * 128 + j;
    bf16x8 wA[2][4], wB[2][4];
#pragma unroll
    for (int g = 0; g < 2; ++g) { const bf16_t* gp = F.GT() + (size_t)((g * 2 + 0) * 8 + n) * 16384 + (size_t)j * 128 + q4 * 8;
#pragma unroll
        for (int ks = 0; ks < 4; ++ks) wA[g][ks] = *(const bf16x8*)(gp + ks * 32); }
    {
        const int tg = tid >> 4, sub = tid & 15, ch = n * 128 + sub * 8;
        float w[4][8], acc[2][8];
#pragma unroll
        for (int j = 0; j < 4; ++j) { const f32x4 a = *(const f32x4*)(p.rg_conv_w + j * 1024 + ch), b = *(const f32x4*)(p.rg_conv_w + j * 1024 + ch + 4);
            w[j][0] = a[0]; w[j][1] = a[1]; w[j][2] = a[2]; w[j][3] = a[3]; w[j][4] = b[0]; w[j][5] = b[1]; w[j][6] = b[2]; w[j][7] = b[3]; }
        { const f32x4 a = *(const f32x4*)(p.rg_conv_b + ch), b = *(const f32x4*)(p.rg_conv_b + ch + 4);
#pragma unroll
          for (int i = 0; i < 2; ++i) { acc[i][0] = a[0]; acc[i][1] = a[1]; acc[i][2] = a[2]; acc[i][3] = a[3]; acc[i][4] = b[0]; acc[i][5] = b[1]; acc[i][6] = b[2]; acc[i][7] = b[3]; } }
#pragma unroll
        for (int r = 0; r < 5; ++r) {
            float x[8]; unpack8(rows[r], x);
#pragma unroll
            for (int j = 0; j < 4; ++j) { const int i = r - j; if (i >= 0 && i < 2) {
#pragma unroll
                for (int e = 0; e < 8; ++e) acc[i][e] += w[j][e] * x[e]; } } }
#pragma unroll
        for (int i = 0; i < 2; ++i) { const int c = tg * 2 + i;
            *(LAS u32x4*)(xb + c * 272 + sub * 16) = pack8(acc[i]);
            *(LAS f32x4*)(xf + c * 128 + sub * 8) = (f32x4){acc[i][0], acc[i][1], acc[i][2], acc[i][3]};
            *(LAS f32x4*)(xf + c * 128 + sub * 8 + 4) = (f32x4){acc[i][4], acc[i][5], acc[i][6], acc[i][7]}; }
    }
    lds_barrier();
    f32x4 hs[4];
#pragma unroll
    for (int m = 0; m < 4; ++m) hs[m] = (f32x4){0.f, 0.f, 0.f, 0.f};
#pragma unroll
    for (int d = 0; d < 2; ++d) {
        f32x4 av[4], bxv[4];
        {
            f32x4 ar[4], ai[4];
#pragma unroll
            for (int m = 0; m < 4; ++m) { ar[m] = (f32x4){0.f, 0.f, 0.f, 0.f}; ai[m] = (f32x4){0.f, 0.f, 0.f, 0.f}; }
#pragma unroll
            for (int ks = 0; ks < 4; ++ks) { const bf16x8 br = d == 0 ? wA[0][ks] : wB[0][ks], bi = d == 0 ? wA[1][ks] : wB[1][ks];
#pragma unroll
                for (int m = 0; m < 4; ++m) { const bf16x8 a = ldfrag(xb, 272, m * 16 + l15, ks * 64 + q4 * 16); ar[m] = MFMA16(a, br, ar[m]); ai[m] = MFMA16(a, bi, ai[m]); } }
            if (d == 0) {
#pragma unroll
                for (int g = 0; g < 2; ++g) { const bf16_t* gp = F.GT() + (size_t)((g * 2 + 1) * 8 + n) * 16384 + (size_t)j * 128 + q4 * 8;
#pragma unroll
                    for (int ks = 0; ks < 4; ++ks) wB[g][ks] = *(const bf16x8*)(gp + ks * 32); } }
            const float L2E = 1.4426950408889634f;
            const float br_ = -L2E * p.rg_b_r[d * 1024 + ch], bi_ = -L2E * p.rg_b_i[d * 1024 + ch], sp = softplusf_(-p.rg_lam[d * 1024 + ch]);
            const float k2 = -16.f * sp, k2e = k2 * L2E, k1e = 0.5f * k2e;
#pragma unroll
            for (int m = 0; m < 4; ++m)
#pragma unroll
                for (int r = 0; r < 4; ++r) { const int c = m * 16 + q4 * 4 + r;
                    const float rr = __builtin_amdgcn_rcpf(1.f + __builtin_amdgcn_exp2f(fmaf(ar[m][r], -L2E, br_)));
                    const float ii = __builtin_amdgcn_rcpf(1.f + __builtin_amdgcn_exp2f(fmaf(ai[m][r], -L2E, bi_)));
                    const float a_ = __builtin_amdgcn_exp2f(k1e * rr);
                    const float em = fmaf(a_, a_, -1.f);
                    av[m][r] = a_; bxv[m][r] = __builtin_amdgcn_sqrtf(fmaxf(-em, 0.f)) * (ii * xf[c * 128 + j]); }
        }
        f32x4 Pa[4], Pb[4]; float Ap[4], Bp[4], Am[4], Bm[4];
#pragma unroll
        for (int m = 0; m < 4; ++m) {
            float pa, pb;
            if (d == 0) { pa = av[m][0]; pb = bxv[m][0]; Pa[m][0] = pa; Pb[m][0] = pb;
#pragma unroll
                for (int r = 1; r < 4; ++r) { pb = av[m][r] * pb + bxv[m][r]; pa = av[m][r] * pa; Pa[m][r] = pa; Pb[m][r] = pb; } }
            else { pa = av[m][3]; pb = bxv[m][3]; Pa[m][3] = pa; Pb[m][3] = pb;
#pragma unroll
                for (int r = 2; r >= 0; --r) { pb = av[m][r] * pb + bxv[m][r]; pa = av[m][r] * pa; Pa[m][r] = pa; Pb[m][r] = pb; } }
            float Ak[4], Bk[4];
#pragma unroll
            for (int k = 0; k < 4; ++k) { Ak[k] = __shfl(pa, l15 + 16 * k); Bk[k] = __shfl(pb, l15 + 16 * k); }
            float ap = 1.f, bp = 0.f, am = 1.f, bm = 0.f;
#pragma unroll
            for (int kk = 0; kk < 4; ++kk) { const int k = d == 0 ? kk : 3 - kk;
                const bool before = d == 0 ? (k < q4) : (k > q4);
                const float nb = Ak[k] * bp + Bk[k], na = Ak[k] * ap;
                bp = before ? nb : bp; ap = before ? na : ap;
                bm = Ak[k] * bm + Bk[k]; am = Ak[k] * am; }
            Ap[m] = ap; Bp[m] = bp; Am[m] = am; Bm[m] = bm;
        }
        if (PASS == 1) {
            float At = 1.f, Bt = 0.f;
#pragma unroll
            for (int mm = 0; mm < 4; ++mm) { const int m = d == 0 ? mm : 3 - mm; Bt = Am[m] * Bt + Bm[m]; At = Am[m] * At; }
            if (q4 == 0) { float* ag = F.RGAGG() + (size_t)(ci * 2 + d) * 2048; ag[ch] = At; ag[1024 + ch] = Bt; }
        } else {
            float hb = F.CARRY()[(size_t)(ci * 2 + d) * 1024 + ch];
#pragma unroll
            for (int mm = 0; mm < 4; ++mm) { const int m = d == 0 ? mm : 3 - mm;
                const float hin = Ap[m] * hb + Bp[m];
#pragma unroll
                for (int r = 0; r < 4; ++r) hs[m][r] += Pa[m][r] * hin + Pb[m][r];
                hb = Am[m] * hb + Bm[m]; }
            if (!samp && q4 == 0 && ci == (d == 0 ? c_hi - 1 : c_lo)) F.out[OUT_SR + (size_t)(seq * 2 + d) * 1024 + ch] = hb;
        }
    }
    if (PASS == 1 && itn < 1024) rg_load_rows(F, 128 + (itn >> 3), itn & 7, rows);
    if (PASS == 3) {
#pragma unroll
        for (int m = 0; m < 4; ++m)
#pragma unroll
            for (int r = 0; r < 4; ++r) Hs[(m * 16 + q4 * 4 + r) * 128 + j] = hs[m][r];
        lds_barrier();
#pragma unroll
        for (int i = 0; i < 2; ++i) { const int chunk = tid + 512 * i, c = chunk >> 4, cc = chunk & 15;
            const u32x4 gv = *(const u32x4*)(F.PROJ() + (size_t)(t0 + c) * NPROJ + 5120 + n * 128 + cc * 8);
            float g[8]; unpack8(gv, g);
            const f32x4 ha = *(const LAS f32x4*)(Hs + c * 128 + cc * 8), hb2 = *(const LAS f32x4*)(Hs + c * 128 + cc * 8 + 4);
            float o[8];
#pragma unroll
            for (int e = 0; e < 4; ++e) { o[e] = ha[e] * siluf_(g[e]); o[4 + e] = hb2[e] * siluf_(g[4 + e]); }
            *(u32x4*)(F.MIX() + (size_t)(t0 + c) * 2048 + 1024 + n * 128 + cc * 8) = pack8(o); }
    }
    lds_barrier();
}

__device__ __forceinline__ void rg_conv_lds(CParams& p, const Frame& F, int n, const u32x4 (&rows)[5], LAS unsigned char* xb, LAS float* xf) {
    const int tid = F.tid, tg = tid >> 4, sub = tid & 15, ch = n * 128 + sub * 8;
    float w[4][8], acc[2][8];
#pragma unroll
    for (int j = 0; j < 4; ++j) { const f32x4 a = *(const f32x4*)(p.rg_conv_w + j * 1024 + ch), b = *(const f32x4*)(p.rg_conv_w + j * 1024 + ch + 4);
        w[j][0] = a[0]; w[j][1] = a[1]; w[j][2] = a[2]; w[j][3] = a[3]; w[j][4] = b[0]; w[j][5] = b[1]; w[j][6] = b[2]; w[j][7] = b[3]; }
    { const f32x4 a = *(const f32x4*)(p.rg_conv_b + ch), b = *(const f32x4*)(p.rg_conv_b + ch + 4);
#pragma unroll
      for (int i = 0; i < 2; ++i) { acc[i][0] = a[0]; acc[i][1] = a[1]; acc[i][2] = a[2]; acc[i][3] = a[3]; acc[i][4] = b[0]; acc[i][5] = b[1]; acc[i][6] = b[2]; acc[i][7] = b[3]; } }
#pragma unroll
    for (int r = 0; r < 5; ++r) { float x[8]; unpack8(rows[r], x);
#pragma unroll
        for (int j = 0; j < 4; ++j) { const int i = r - j; if (i >= 0 && i < 2) {
#pragma unroll
            for (int e = 0; e < 8; ++e) acc[i][e] += w[j][e] * x[e]; } } }
#pragma unroll
    for (int i = 0; i < 2; ++i) { const int c = tg * 2 + i;
        *(LAS u32x4*)(xb + c * 272 + sub * 16) = pack8(acc[i]);
        *(LAS f32x4*)(xf + c * 128 + sub * 8) = (f32x4){acc[i][0], acc[i][1], acc[i][2], acc[i][3]};
        *(LAS f32x4*)(xf + c * 128 + sub * 8 + 4) = (f32x4){acc[i][4], acc[i][5], acc[i][6], acc[i][7]}; }
}
template <int D>
__device__ __forceinline__ void rg_gate_scan(const Frame& F, const bf16x8 (&wg)[2][4], float br_, float bi_, float sp, const LAS unsigned char* xb, const LAS float* xf, int j,
                                             f32x4 (&Pa)[4], f32x4 (&Pb)[4], float (&Ap)[4], float (&Bp)[4], float (&Am)[4], float (&Bm)[4]) {
    const int lane = F.lane, q4 = lane >> 4, l15 = lane & 15;
    f32x4 av[4], bxv[4];
    {
        f32x4 ar[4], ai[4];
#pragma unroll
        for (int m = 0; m < 4; ++m) { ar[m] = (f32x4){0.f, 0.f, 0.f, 0.f}; ai[m] = (f32x4){0.f, 0.f, 0.f, 0.f}; }
#pragma unroll
        for (int ks = 0; ks < 4; ++ks) {
#pragma unroll
            for (int m = 0; m < 4; ++m) { const bf16x8 a = ldfrag(xb, 272, m * 16 + l15, ks * 64 + q4 * 16); ar[m] = MFMA16(a, wg[0][ks], ar[m]); ai[m] = MFMA16(a, wg[1][ks], ai[m]); } }
        const float L2E = 1.4426950408889634f;
        const float brs = -L2E * br_, bis = -L2E * bi_, k2 = -16.f * sp, k1e = 0.5f * k2 * L2E;
#pragma unroll
        for (int m = 0; m < 4; ++m)
#pragma unroll
            for (int r = 0; r < 4; ++r) { const int c = m * 16 + q4 * 4 + r;
                const float rr = __builtin_amdgcn_rcpf(1.f + __builtin_amdgcn_exp2f(fmaf(ar[m][r], -L2E, brs)));
                const float ii = __builtin_amdgcn_rcpf(1.f + __builtin_amdgcn_exp2f(fmaf(ai[m][r], -L2E, bis)));
                const float a = __builtin_amdgcn_exp2f(k1e * rr);
                const float em = fmaf(a, a, -1.f);
                av[m][r] = a; bxv[m][r] = __builtin_amdgcn_sqrtf(fmaxf(-em, 0.f)) * (ii * xf[c * 128 + j]); }
    }
#pragma unroll
    for (int m = 0; m < 4; ++m) {
        float pa, pb;
        if (D == 0) { pa = av[m][0]; pb = bxv[m][0]; Pa[m][0] = pa; Pb[m][0] = pb;
#pragma unroll
            for (int r = 1; r < 4; ++r) { pb = av[m][r] * pb + bxv[m][r]; pa = av[m][r] * pa; Pa[m][r] = pa; Pb[m][r] = pb; } }
        else { pa = av[m][3]; pb = bxv[m][3]; Pa[m][3] = pa; Pb[m][3] = pb;
#pragma unroll
            for (int r = 2; r >= 0; --r) { pb = av[m][r] * pb + bxv[m][r]; pa = av[m][r] * pa; Pa[m][r] = pa; Pb[m][r] = pb; } }
        float Ak[4], Bk[4];
#pragma unroll
        for (int k = 0; k < 4; ++k) { Ak[k] = __shfl(pa, l15 + 16 * k); Bk[k] = __shfl(pb, l15 + 16 * k); }
        float ap = 1.f, bp = 0.f, am = 1.f, bm = 0.f;
#pragma unroll
        for (int kk = 0; kk < 4; ++kk) { const int k = D == 0 ? kk : 3 - kk;
            const bool before = D == 0 ? (k < q4) : (k > q4);
            const float nb = Ak[k] * bp + Bk[k], na = Ak[k] * ap;
            bp = before ? nb : bp; ap = before ? na : ap;
            bm = Ak[k] * bm + Bk[k]; am = Ak[k] * am; }
        Ap[m] = ap; Bp[m] = bp; Am[m] = am; Bm[m] = bm;
    }
}
template <int D>
__device__ __forceinline__ void rg_prompt_dir(CParams& p, Frame& F, int seq, int n) {
    const int tid = F.tid, lane = F.lane, wave = F.wave, q4 = lane >> 4, l15 = lane & 15;
    LAS unsigned char* xb = F.lds; LAS float* xf = (LAS float*)(F.lds + 17408); LAS float* Hs = (LAS float*)(F.lds + 50176); LAS bf16_t* Hf = (LAS bf16_t*)(F.lds + 82944);
    const int j = wave * 16 + l15, ch = n * 128 + j;
    bf16x8 wg[2][4];
#pragma unroll
    for (int g = 0; g < 2; ++g) { const bf16_t* gp = F.GT() + (size_t)((g * 2 + D) * 8 + n) * 16384 + (size_t)j * 128 + q4 * 8;
#pragma unroll
        for (int ks = 0; ks < 4; ++ks) wg[g][ks] = *(const bf16x8*)(gp + ks * 32); }
    const float br_ = p.rg_b_r[D * 1024 + ch], bi_ = p.rg_b_i[D * 1024 + ch], sp = softplusf_(-p.rg_lam[D * 1024 + ch]);
    float hb = 0.f;
    u32x4 rows[5];
    rg_load_rows(F, seq * 4 + (D == 0 ? 0 : 3), n, rows);
#pragma unroll 1
    for (int cs = 0; cs < 4; ++cs) {
        const int cidx = D == 0 ? cs : 3 - cs, ci = seq * 4 + cidx, t0 = ci * 64;
        rg_conv_lds(p, F, n, rows, xb, xf);
        if (cs < 3) rg_load_rows(F, seq * 4 + (D == 0 ? cidx + 1 : cidx - 1), n, rows);
        lds_barrier();
        f32x4 Pa[4], Pb[4]; float Ap[4], Bp[4], Am[4], Bm[4];
        rg_gate_scan<D>(F, wg, br_, bi_, sp, xb, xf, j, Pa, Pb, Ap, Bp, Am, Bm);
#pragma unroll
        for (int mm = 0; mm < 4; ++mm) { const int m = D == 0 ? mm : 3 - mm;
            const float hin = Ap[m] * hb + Bp[m];
#pragma unroll
            for (int r = 0; r < 4; ++r) { const float hv = Pa[m][r] * hin + Pb[m][r]; const int tl = m * 16 + q4 * 4 + r;
                if (D == 0) Hf[(cidx * 64 + tl) * 128 + j] = f2bf(hv);
                else Hs[tl * 128 + j] = hv + bf2f(Hf[(cidx * 64 + tl) * 128 + j]); }
            hb = Am[m] * hb + Bm[m]; }
        lds_barrier();
        if (D == 1) {
#pragma unroll
            for (int i = 0; i < 2; ++i) { const int chunk = tid + 512 * i, c = chunk >> 4, cc = chunk & 15;
                bf16_t* gp = F.PROJ() + (size_t)(t0 + c) * NPROJ + 5120 + n * 128 + cc * 8;
                const u32x4 gv = *(const u32x4*)gp; float g[8]; unpack8(gv, g);
                const f32x4 ha = *(const LAS f32x4*)(Hs + c * 128 + cc * 8), hb2 = *(const LAS f32x4*)(Hs + c * 128 + cc * 8 + 4);
                float o[8];
#pragma unroll
                for (int e = 0; e < 4; ++e) { o[e] = ha[e] * siluf_(g[e]); o[4 + e] = hb2[e] * siluf_(g[4 + e]); }
                *(u32x4*)gp = pack8(o); }
            lds_barrier();
        }
    }
    if (q4 == 0) F.out[OUT_SR + (size_t)(seq * 2 + D) * 1024 + ch] = hb;
}

__device__ __forceinline__ void rg_carry_scan(CParams& p, Frame& F) {
    const int tid = F.tid;
    if (tid < 256 || tid >= 272) return;
    const int g = F.b * 16 + tid - 256; if (g >= 4096) return;
    const int seq = g >> 11, d = (g >> 10) & 1, ch = g & 1023, c_lo = 128 + seq * 64;
    const float* ag0 = F.RGAGG() + (size_t)d * 2048 + ch;
    float h = p.state_rglru[(size_t)(seq * 2 + d) * 1024 + ch];
    float* cr0 = F.CARRY() + (size_t)d * 1024 + ch;
#pragma unroll 1
    for (int u0 = 0; u0 < 64; u0 += 32) {
        float A[32], B[32];
#pragma unroll
        for (int u = 0; u < 32; ++u) { const int cc = d == 0 ? c_lo + u0 + u : c_lo + 63 - u0 - u; A[u] = ag0[(size_t)cc * 4096]; B[u] = ag0[(size_t)cc * 4096 + 1024]; }
#pragma unroll
        for (int u = 0; u < 32; ++u) { const int cc = d == 0 ? c_lo + u0 + u : c_lo + 63 - u0 - u; cr0[(size_t)cc * 2048] = h; h = A[u] * h + B[u]; }
    }
}

__device__ __forceinline__ void phase3(CParams& p, Frame& F) {
    for (int rep = 0; rep < (REP_PHASE == 30 ? 2 : 1); ++rep)
    { u32x4 rows[7]; if (F.b < 2048) p3_load_rows(F, F.b >> 3, F.b & 7, rows);
      for (int it = F.b; it < 2048; it += F.G) p3_delta_item(p, F, it >> 3, it & 7, rows, it + F.G); }
    for (int rep = 0; rep < (REP_PHASE == 31 ? 2 : 1); ++rep) {
    u32x4 rows[5]; if (F.b < 1024) rg_load_rows(F, 128 + (F.b >> 3), F.b & 7, rows);
    for (int it = F.b; it < 1024; it += F.G) rg_item<1>(p, F, 128 + (it >> 3), it & 7, rows, it + F.G); }
    for (int it = F.b; it < 256; it += F.G) { rg_prompt_dir<0>(p, F, it >> 3, it & 7); rg_prompt_dir<1>(p, F, it >> 3, it & 7); }
}

struct P4D { int valid, samp, seq, h, d, sl, ci, seq_lo, seq_hi, last, k, s, nch; };
__device__ __forceinline__ P4D p4_desc(const Frame& F, int k, int s) {
    P4D D; int item;
    if (F.G == 256) {
        const int x = F.b & 7, y = F.b >> 3;
        if (y < 16) { item = (x * 4 + (y >> 2)) * 4 + (y & 3); D.valid = k < 1; }
        else { const int j = y - 16; item = 128 + (x * 64 + (j >> 2) * 16 + k) * 4 + (j & 3); D.valid = k < 16; } }
    else { item = F.b + k * F.G; D.valid = item < 2176; }
    D.samp = item < 128; const int it = D.samp ? item : item - 128, chain = it >> 2;
    D.sl = it & 3; D.seq = chain >> 4; D.h = (chain >> 1) & 7; D.d = chain & 1;
    D.nch = D.samp ? 64 : 4; const int chunk0 = D.samp ? 128 + D.seq * 64 : D.seq * 4;
    D.seq_lo = chunk0 * 64; D.seq_hi = D.seq_lo + D.nch * 64;
    D.ci = D.d == 0 ? chunk0 + s : chunk0 + D.nch - 1 - s; D.last = s == D.nch - 1; D.k = k; D.s = s;
    return D;
}
__device__ __forceinline__ P4D p4_next(const Frame& F, const P4D& D) {
    if (D.s + 1 < D.nch) { P4D N = D; N.s = D.s + 1; N.ci = D.ci + (D.d == 0 ? 1 : -1); N.last = N.s == D.nch - 1; return N; }
    return p4_desc(F, D.k + 1, 0);
}
struct P4Pre { u32x4 k0, k1, q0, q1, ti, at; u32x2 v[4]; float g, b, bc; };
struct P4T { unsigned oKQ, oTA, oV, oG, oGc; int cj; };
__device__ __forceinline__ P4T p4_thread_consts(int tid) {
    P4T T; T.oKQ = (unsigned)(((tid >> 4) * 1024 + (tid & 15) * 8) * 2); T.oTA = (unsigned)tid * 16u;
    T.oV = (unsigned)(((tid >> 3) * NPROJ + (tid & 7) * 4) * 2); T.oG = (unsigned)(tid & 63) * 4u; T.oGc = (unsigned)(tid >> 3) * 4u; T.cj = (tid >> 3) - 2; return T;
}
__device__ __forceinline__ void p4_prefetch(CParams& p, const Frame& F, P4Pre& R, const P4D& D, const P4T& T) {
    const int tid = F.tid, t0 = D.ci * 64, h = D.h;
    const char* kb = (const char*)F.Kc() + (size_t)(D.ci * 8 + h) * 16384;
    const char* qb = (const char*)F.Qc() + ((size_t)t0 * 1024 + h * 128) * 2;
    const char* tb = (const char*)F.TA() + (size_t)(D.ci * 8 + h) * 16384;
    const char* vb = (const char*)F.PROJ() + ((long)(t0 - 2) * NPROJ + 2048 + h * 128 + D.sl * 32) * 2;
    const char* gb = (const char*)F.GB() + (size_t)(D.ci * 8 + h) * 1024 + D.d * 256;
    R.k0 = *(const u32x4*)(kb + T.oTA); R.k1 = *(const u32x4*)(kb + T.oTA + 8192u);
    R.q0 = *(const u32x4*)(qb + T.oKQ); R.q1 = *(const u32x4*)(qb + T.oKQ + 65536u);
    R.ti = *(const u32x4*)(tb + T.oTA); R.at = *(const u32x4*)(tb + T.oTA + 8192u);
#pragma unroll
    for (int j = 0; j < 4; ++j) { const int tok = t0 + T.cj + j; u32x2 v = {0u, 0u};
        if (tok >= D.seq_lo && tok < D.seq_hi) v = *(const u32x2*)(vb + T.oV + (unsigned)(j * NPROJ * 2));
        R.v[j] = v; }
    R.bc = *(const float*)(gb + 512 + T.oGc);
    R.g = 0.f; R.b = 0.f;
    if (tid < 64) { R.g = *(const float*)(gb + T.oG); R.b = *(const float*)(gb + 512 + T.oG); }
}
__device__ __forceinline__ u32x4 tri_mask(u32x4 v, int c, int s0, int d) {
    unsigned w[4] = {v.x, v.y, v.z, v.w};
#pragma unroll
    for (int i = 0; i < 4; ++i) { const int slo = s0 + 2 * i, shi = slo + 1;
        const bool klo = d == 0 ? (c >= slo) : (c <= slo), khi = d == 0 ? (c >= shi) : (c <= shi);
        w[i] &= (klo ? 0x0000FFFFu : 0u) | (khi ? 0xFFFF0000u : 0u); }
    return (u32x4){w[0], w[1], w[2], w[3]};
}
constexpr int P4_KS = 0, P4_TI = 17408, P4_VBT = 26624, P4_WL = 31232, P4_SB = 48640, P4_VT1 = 57344, P4_VT2 = 61952, P4_QS = 66560, P4_AT = 101376, P4_GV = 119808, P4_KT = 122368;
__device__ __forceinline__ void p4_stage(CParams& p, const Frame& F, const P4Pre& R, const P4D& D, int buf, const unsigned (&mk)[2][4], f32x4 (&cw)[4], const f32x4 (&cwn)[4]) {
    const int tid = F.tid, d = D.d;
    LAS unsigned char* Ks = F.lds + P4_KS; LAS unsigned char* Qs = F.lds + P4_QS + buf * 17408; LAS unsigned char* TIs = F.lds + P4_TI;
    LAS unsigned char* ATs = F.lds + P4_AT + buf * 9216; LAS unsigned char* Vbt = F.lds + P4_VBT; LAS float* gv = (LAS float*)(F.lds + P4_GV + buf * 1280);
    { const int row = tid >> 4, cc = tid & 15;
      *(LAS u32x4*)(Qs + row * 272 + cc * 16) = R.q0; *(LAS u32x4*)(Qs + (32 + row) * 272 + cc * 16) = R.q1; }
    { const int dk = tid >> 3, cp = tid & 7; LAS unsigned char* Kts = F.lds + P4_KT;
      *(LAS u32x4*)(Kts + dk * 144 + cp * 16) = R.k0; *(LAS u32x4*)(Kts + (64 + dk) * 144 + cp * 16) = R.k1; }
    { const int c = tid >> 3, s0 = (tid & 7) * 8;
      const unsigned m0 = d ? mk[1][0] : mk[0][0], m1 = d ? mk[1][1] : mk[0][1], m2 = d ? mk[1][2] : mk[0][2], m3 = d ? mk[1][3] : mk[0][3];
      *(LAS u32x4*)(TIs + c * 144 + s0 * 2) = (u32x4){R.ti.x & m0, R.ti.y & m1, R.ti.z & m2, R.ti.w & m3};
      *(LAS u32x4*)(ATs + c * 144 + s0 * 2) = (u32x4){R.at.x & m0, R.at.y & m1, R.at.z & m2, R.at.w & m3}; }
    { const int c = tid >> 3, e0 = (tid & 7) * 4; float o[4] = {0.f, 0.f, 0.f, 0.f};
      if (D.s == 0) {
#pragma unroll
          for (int j = 0; j < 4; ++j) cw[j] = cwn[j]; }
#pragma unroll
      for (int j = 0; j < 4; ++j) { const u32x2 v = R.v[j];
          o[0] += cw[j][0] * __uint_as_float(v.x << 16); o[1] += cw[j][1] * __uint_as_float(v.x & 0xffff0000u);
          o[2] += cw[j][2] * __uint_as_float(v.y << 16); o[3] += cw[j][3] * __uint_as_float(v.y & 0xffff0000u); }
#pragma unroll
      for (int i = 0; i < 4; ++i) ((LAS bf16_t*)Vbt)[(e0 + i) * 72 + c] = f2bf(siluf_(o[i]) * R.bc); }
    if (tid < 64) {
        const float glast = __shfl(R.g, d == 0 ? 63 : 0), eg = __expf(R.g);
        gv[tid] = eg; gv[64 + tid] = R.b * eg; gv[128 + tid] = __expf(glast - R.g); if (tid == 0) gv[192] = __expf(glast);
    }
}
__device__ __forceinline__ void phase4_chains(CParams& p, Frame& F) {
    const int tid = F.tid, lane = F.lane, wave = F.wave, q4 = lane >> 4, l15 = lane & 15;
    LAS unsigned char* Ks = F.lds + P4_KS; LAS unsigned char* TIs = F.lds + P4_TI; LAS unsigned char* Vbt = F.lds + P4_VBT; LAS unsigned char* Wl = F.lds + P4_WL;
    LAS unsigned char* Sb = F.lds + P4_SB; LAS unsigned char* Vt1 = F.lds + P4_VT1; LAS unsigned char* Vt2 = F.lds + P4_VT2;
    const int ct = wave & 3, et = wave >> 2;
    P4D Dc = p4_desc(F, 0, 0);
    if (!Dc.valid) return;
    P4Pre RA, RB;
    f32x4 S[2], U; bf16x8 KT[2];
    unsigned mk[2][4]; f32x4 cw[4], cwn[4];
    { const int c = tid >> 3, s0 = (tid & 7) * 8;
#pragma unroll
      for (int i = 0; i < 4; ++i) { const int slo = s0 + 2 * i, shi = slo + 1;
          mk[0][i] = (c >= slo ? 0x0000FFFFu : 0u) | (c >= shi ? 0xFFFF0000u : 0u); mk[1][i] = (c <= slo ? 0x0000FFFFu : 0u) | (c <= shi ? 0xFFFF0000u : 0u); } }
#define P4_INIT_S(D) do { _Pragma("unroll") for (int nt = 0; nt < 2; ++nt) _Pragma("unroll") for (int r = 0; r < 4; ++r) \
        S[nt][r] = (D).samp ? p.state_delta[(size_t)(((D).seq * 2 + (D).d) * 8 + (D).h) * 16384 + (size_t)(wave * 16 + q4 * 4 + r) * 128 + (D).sl * 32 + nt * 16 + l15] : 0.f; } while (0)
#define P4_WRITE_SB() do { _Pragma("unroll") for (int nt = 0; nt < 2; ++nt) { u32x2 o_; o_.x = pk2(S[nt][0], S[nt][1]); o_.y = pk2(S[nt][2], S[nt][3]); \
        *(LAS u32x2*)(Sb + (nt * 16 + l15) * 272 + (wave * 16 + q4 * 4) * 2) = o_; } } while (0)
#define P4_PRECOMP(buf_) do { const LAS float* gv_ = (const LAS float*)(F.lds + P4_GV + (buf_) * 1280); \
        f32x4 WT[4]; _Pragma("unroll") for (int c_ = 0; c_ < 4; ++c_) WT[c_] = (f32x4){0.f, 0.f, 0.f, 0.f}; \
        _Pragma("unroll") for (int ks = 0; ks < 2; ++ks) { \
            const u32x4 kraw = *(const LAS u32x4*)(F.lds + P4_KT + (wave * 16 + l15) * 144 + ks * 64 + q4 * 16); KT[ks] = __builtin_bit_cast(bf16x8, kraw); \
            const f32x4 sa = *(const LAS f32x4*)(gv_ + 64 + ks * 32 + q4 * 8), sb_ = *(const LAS f32x4*)(gv_ + 64 + ks * 32 + q4 * 8 + 4); \
            float kf[8]; unpack8(kraw, kf); u32x4 kg; \
            kg.x = pk2(kf[0] * sa[0], kf[1] * sa[1]); kg.y = pk2(kf[2] * sa[2], kf[3] * sa[3]); kg.z = pk2(kf[4] * sb_[0], kf[5] * sb_[1]); kg.w = pk2(kf[6] * sb_[2], kf[7] * sb_[3]); \
            const bf16x8 akg = __builtin_bit_cast(bf16x8, kg); \
            _Pragma("unroll") for (int c_ = 0; c_ < 4; ++c_) { const bf16x8 bt = ldfrag(TIs, 144, c_ * 16 + l15, ks * 64 + q4 * 16); WT[c_] = MFMA16(akg, bt, WT[c_]); } } \
        _Pragma("unroll") for (int c_ = 0; c_ < 4; ++c_) { u32x2 o_; o_.x = pk2(WT[c_][0], WT[c_][1]); o_.y = pk2(WT[c_][2], WT[c_][3]); \
            *(LAS u32x2*)(Wl + (c_ * 16 + l15) * 272 + (wave * 16 + q4 * 4) * 2) = o_; } \
        U = (f32x4){0.f, 0.f, 0.f, 0.f}; \
        _Pragma("unroll") for (int ks = 0; ks < 2; ++ks) { const bf16x8 a_ = ldfrag(TIs, 144, ct * 16 + l15, ks * 64 + q4 * 16), b_ = ldfrag(Vbt, 144, et * 16 + l15, ks * 64 + q4 * 16); U = MFMA16(a_, b_, U); } } while (0)

    const P4T T = p4_thread_consts(tid);
    p4_prefetch(p, F, RA, Dc, T);
    P4_INIT_S(Dc);
    { const int e0 = (tid & 7) * 4;
#pragma unroll
      for (int j = 0; j < 4; ++j) cwn[j] = *(const f32x4*)(p.dn_conv_w + j * 3072 + 2048 + Dc.h * 128 + Dc.sl * 32 + e0); }
    p4_stage(p, F, RA, Dc, 0, mk, cw, cwn);
    P4_WRITE_SB();
    P4D Dn = p4_next(F, Dc);
    if (Dn.valid) p4_prefetch(p, F, RA, Dn, T);
    P4D Dnn = Dn; if (Dn.valid) { Dnn = p4_next(F, Dn); if (Dnn.valid) p4_prefetch(p, F, RB, Dnn, T); }
    lds_barrier();
    P4_PRECOMP(0);
    lds_barrier();
    int buf = 0;
#define P4_BODY(RX) { \
        const LAS float* gv = (const LAS float*)(F.lds + P4_GV + buf * 1280); \
        const LAS unsigned char* Qs = F.lds + P4_QS + buf * 17408; const LAS unsigned char* ATs = F.lds + P4_AT + buf * 9216; \
        const int c0 = ct * 16 + q4 * 4, e = et * 16 + l15; \
         \
        f32x4 p1 = {0.f, 0.f, 0.f, 0.f}, oacc = {0.f, 0.f, 0.f, 0.f}; \
_Pragma("unroll") \
        for (int ks = 0; ks < 4; ++ks) { const bf16x8 bs = ldfrag(Sb, 272, et * 16 + l15, ks * 64 + q4 * 16); \
            const bf16x8 aw = ldfrag(Wl, 272, ct * 16 + l15, ks * 64 + q4 * 16), aq = ldfrag(Qs, 272, ct * 16 + l15, ks * 64 + q4 * 16); \
            p1 = MFMA16(aw, bs, p1); oacc = MFMA16(aq, bs, oacc); } \
        { float vn[4]; \
_Pragma("unroll") \
          for (int r = 0; r < 4; ++r) vn[r] = U[r] - p1[r]; \
          u32x2 o1, o2; o1.x = pk2(vn[0], vn[1]); o1.y = pk2(vn[2], vn[3]); \
          o2.x = pk2(vn[0] * gv[128 + c0], vn[1] * gv[128 + c0 + 1]); o2.y = pk2(vn[2] * gv[128 + c0 + 2], vn[3] * gv[128 + c0 + 3]); \
          *(LAS u32x2*)(Vt1 + e * 144 + c0 * 2) = o1; *(LAS u32x2*)(Vt2 + e * 144 + c0 * 2) = o2; } \
_Pragma("unroll") \
        for (int r = 0; r < 4; ++r) oacc[r] *= gv[c0 + r]; \
        P4D D3 = Dnn; \
        if (Dn.valid) { p4_stage(p, F, RX, Dn, buf ^ 1, mk, cw, cwn); \
            if (Dn.last && Dnn.valid) { const int e0_ = (tid & 7) * 4; _Pragma("unroll") for (int j = 0; j < 4; ++j) cwn[j] = *(const f32x4*)(p.dn_conv_w + j * 3072 + 2048 + Dnn.h * 128 + Dnn.sl * 32 + e0_); } if (Dnn.valid) { D3 = p4_next(F, Dnn); if (D3.valid) p4_prefetch(p, F, RX, D3, T); } } \
        lds_barrier(); \
         \
        { const float gl = gv[192]; \
_Pragma("unroll") \
          for (int nt = 0; nt < 2; ++nt) S[nt] *= gl; \
_Pragma("unroll") \
          for (int ks = 0; ks < 2; ++ks) \
_Pragma("unroll") \
              for (int nt = 0; nt < 2; ++nt) { const bf16x8 b_ = ldfrag(Vt2, 144, nt * 16 + l15, ks * 64 + q4 * 16); S[nt] = MFMA16(KT[ks], b_, S[nt]); } } \
_Pragma("unroll") \
        for (int ks = 0; ks < 2; ++ks) { const bf16x8 a_ = ldfrag(ATs, 144, ct * 16 + l15, ks * 64 + q4 * 16), b_ = ldfrag(Vt1, 144, et * 16 + l15, ks * 64 + q4 * 16); oacc = MFMA16(a_, b_, oacc); } \
_Pragma("unroll") \
        for (int r = 0; r < 4; ++r) *(bf16_t*)((char*)F.PROJ() + ((size_t)Dc.ci * 64 * NPROJ + Dc.d * 1024 + Dc.h * 128 + Dc.sl * 32) * 2 + (unsigned)(((c0 + r) * NPROJ + e) * 2)) = f2bf(oacc[r]); \
        if (Dc.last) { \
            if (!Dc.samp) { \
_Pragma("unroll") \
                for (int nt = 0; nt < 2; ++nt) \
_Pragma("unroll") \
                    for (int r = 0; r < 4; ++r) \
                        F.out[OUT_SD + (size_t)((Dc.seq * 2 + Dc.d) * 8 + Dc.h) * 16384 + (size_t)(wave * 16 + q4 * 4 + r) * 128 + Dc.sl * 32 + nt * 16 + l15] = S[nt][r]; \
            } \
            if (Dn.valid) P4_INIT_S(Dn); \
        } \
        P4_WRITE_SB(); \
        if (Dn.valid) P4_PRECOMP(buf ^ 1); \
        lds_barrier(); \
        if (!Dn.valid) break; \
        Dc = Dn; Dn = Dnn; Dnn = D3; buf ^= 1; \
    }
#pragma unroll 1
    for (;;) { P4_BODY(RA) P4_BODY(RB) }
#undef P4_BODY
#undef P4_INIT_S
#undef P4_WRITE_SB
#undef P4_PRECOMP
}
__device__ __forceinline__ void phase4(CParams& p, Frame& F) {
    if (F.G == 256) rg_carry_scan(p, F);
    else if (F.b == 0) {
        for (int g = F.tid; g < 69632; g += 512) { int samp = g >= 65536, gg = samp ? g - 65536 : g, seq = gg >> 11, d = (gg >> 10) & 1, ch = gg & 1023;
            const int nch = samp ? 64 : 4, c_lo = samp ? 128 + seq * 64 : seq * 4; float h = samp ? p.state_rglru[(size_t)(seq * 2 + d) * 1024 + ch] : 0.f;
            for (int i = 0; i < nch; ++i) { const int cc = d == 0 ? c_lo + i : c_lo + nch - 1 - i; const float* ag = F.RGAGG() + (size_t)(cc * 2 + d) * 2048; F.CARRY()[(size_t)(cc * 2 + d) * 1024 + ch] = h; h = ag[ch] * h + ag[1024 + ch]; } } }
    __syncthreads();
    phase4_chains(p, F);
}

__device__ __forceinline__ void phase5(CParams& p, Frame& F) {
    const int lane = F.lane;
    float nw[16];
#pragma unroll
    for (int q = 0; q < 4; ++q) { const f32x4 a = *(const f32x4*)(p.dn_norm_w + (lane & 7) * 16 + q * 4); nw[q * 4] = a[0]; nw[q * 4 + 1] = a[1]; nw[q * 4 + 2] = a[2]; nw[q * 4 + 3] = a[3]; }
#pragma unroll 4
    for (int tok = F.b * 8 + F.wave; tok < NTOK; tok += F.G * 8) {
        const bf16_t* pr = F.PROJ() + (size_t)tok * NPROJ + lane * 16;
        float o[16], z[16]; float ss = 0.f;
#pragma unroll
        for (int hf = 0; hf < 2; ++hf) { const u32x4 a = *(const u32x4*)(pr + hf * 8), b = *(const u32x4*)(pr + 1024 + hf * 8), zz = *(const u32x4*)(pr + 3072 + hf * 8);
            float fa[8], fb[8], fz[8]; unpack8(a, fa); unpack8(b, fb); unpack8(zz, fz);
#pragma unroll
            for (int e = 0; e < 8; ++e) { o[hf * 8 + e] = fa[e] + fb[e]; z[hf * 8 + e] = fz[e]; ss += o[hf * 8 + e] * o[hf * 8 + e]; } }
        ss += __shfl_xor(ss, 1); ss += __shfl_xor(ss, 2); ss += __shfl_xor(ss, 4);
        const float rs = rsqrtf(ss * (1.f / 128.f) + 1e-6f);
#pragma unroll
        for (int hf = 0; hf < 2; ++hf) { float w[8];
#pragma unroll
            for (int e = 0; e < 8; ++e) w[e] = o[hf * 8 + e] * rs * nw[hf * 8 + e] * siluf_(z[hf * 8 + e]);
            *(u32x4*)(F.MIX() + (size_t)tok * 2048 + lane * 16 + hf * 8) = pack8(w); }
        if (tok < 8192) {
            const u32x4 y0 = *(const u32x4*)(pr + 5120), y1 = *(const u32x4*)(pr + 5120 + 8);
            *(u32x4*)(F.MIX() + (size_t)tok * 2048 + 1024 + lane * 16) = y0; *(u32x4*)(F.MIX() + (size_t)tok * 2048 + 1024 + lane * 16 + 8) = y1; }
    }
    __syncthreads();
    for (int it = F.b; it < 1024; it += F.G) { u32x4 rows[5]; rg_load_rows(F, 128 + (it >> 3), it & 7, rows); rg_item<3>(p, F, 128 + (it >> 3), it & 7, rows, it + F.G); }
}

__device__ __forceinline__ void phase6(CParams& p, Frame& F) {
    pg8::Gemm g{F.MIX(), F.WoutT(), NTOK, 1024, 2048}; pg8::StaticOrder S; S.init(NTOK, 1024, F.G, F.b); pg8::EpiBf16 E{F.PROJ(), NPROJ};
    pg8::gemm_phase<pg8::EpiBf16, pg8::StaticOrder>(F.lds, g, S, E);
}

__device__ __forceinline__ void phase7(CParams& p, Frame& F) {
    LAS float* gt = (LAS float*)F.lds;
    for (int tb = F.b; tb < 256; tb += F.G) {
        const int grp = grp_of_block(tb);
        for (int j = F.tid; j < 1024; j += 512) gt[j] = mod_val(p, F, grp, 2048 + j) * p.post_w[j];
        __syncthreads();
#pragma unroll 2
        for (int i = 0; i < 8; ++i) {
            const int tok = tb * 64 + F.wave * 8 + i;
            const float* xr = tok < 8192 ? p.x_prompt + (size_t)tok * 1024 : p.x_sample + (size_t)(tok - 8192) * 1024;
            const bf16_t* yr = F.PROJ() + (size_t)tok * NPROJ;
            f32x4 y[4]; float ss = 0.f;
#pragma unroll
            for (int q = 0; q < 4; ++q) { const u32x2 yb = *(const u32x2*)(yr + F.lane * 4 + 256 * q);
                y[q] = (f32x4){__uint_as_float(yb.x << 16), __uint_as_float(yb.x & 0xffff0000u), __uint_as_float(yb.y << 16), __uint_as_float(yb.y & 0xffff0000u)}; ss += (y[q][0] * y[q][0] + y[q][1] * y[q][1]) + (y[q][2] * y[q][2] + y[q][3] * y[q][3]); }
            const float rstd = rsqrtf(wave_sum(ss) * (1.f / 1024.f) + 1e-6f);
#pragma unroll
            for (int q = 0; q < 4; ++q) { const int j = F.lane * 4 + 256 * q; f32x4 v = *(const f32x4*)(xr + j);
                if (tok >= 8192) { const int pp = (tok - 8192) & 4095; const int vv = (q < 2) ? (pp >> 6) : (pp & 63);
                    v += *(const f32x4*)(F.pe() + ((q & 1) ? 16384 : 0) + vv * 256 + F.lane * 4); }
                const f32x4 g4 = *(const LAS f32x4*)(gt + j);
                f32x4 ov = v + g4 * (y[q] * rstd); ov[0] = fin(ov[0]); ov[1] = fin(ov[1]); ov[2] = fin(ov[2]); ov[3] = fin(ov[3]); if (!(LIVE_MASK & 1)) ov = (f32x4){0.f, 0.f, 0.f, 0.f}; *(f32x4*)(F.out + (size_t)tok * 1024 + j) = ov; }
        }
        __syncthreads();
    }
}

__device__ __forceinline__ void phase8(CParams& p, Frame& F) {
    if (F.b == 0 && F.tid == 0) { int code = 0; for (int k = 31; k >= 1; --k) if (DG(F)[k]) code = k; F.out[OUT_SR] = 1000.f * (float)code + 500.f; }
}
extern __shared__ __attribute__((aligned(16))) unsigned char smem_raw[];
__global__ void __launch_bounds__(512) fwd_megakernel(Params p_unused) {
    CParams& p = *(CParams*)__builtin_amdgcn_kernarg_segment_ptr();
    Frame F;
    F.lds = (LAS unsigned char*)smem_raw;
    F.tid = threadIdx.x; F.lane = F.tid & 63; F.wave = __builtin_amdgcn_readfirstlane(F.tid >> 6); F.G = gridDim.x; F.b = blockIdx.x;
    F.out = p.out; F.ws = p.ws;
    volatile LAS unsigned* xbw = (volatile LAS unsigned*)(F.lds + LDS_BYTES - 16);
    const bool multi = (p.ph_hi - p.ph_lo) > 1;
    XcdBarrier xb; xb.bar = (unsigned*)(p.ws + WS_CTL); xb.x = 0; xb.st = xbw;
    if (multi) {
        if (F.tid == 0) { xbw[0] = 0u; xbw[1] = 0u; xbw[2] = 0u; xbw[3] = 0u; }
        __syncthreads();
        xb = xcd_barrier_post((unsigned*)(p.ws + WS_CTL), xbw);
    }
#ifndef PHMASK
#define PHMASK 511
#endif
    const int lo = p.ph_lo, hi = p.ph_hi;
#ifndef REP_PHASE
#define REP_PHASE -1
#endif
#define RUN_PHASE(k, fn) do { if (lo <= (k) && (k) < hi) { if (PHMASK & (1 << (k))) fn(p, F); if ((k) == REP_PHASE) { __syncthreads(); fn(p, F); } if ((k) + 1 < hi) xcd_barrier(xb); } } while (0)
    RUN_PHASE(0, phase0); RUN_PHASE(1, phase1); RUN_PHASE(2, phase2); RUN_PHASE(3, phase3);
    RUN_PHASE(4, phase4); RUN_PHASE(5, phase5); RUN_PHASE(6, phase6); RUN_PHASE(7, phase7); RUN_PHASE(8, phase8);
}

extern "C" void kernel_launch(void* const* d_in, const int* in_sizes, int n_in, void* d_out, int out_size, void* d_ws, size_t ws_size, hipStream_t stream) {
    static int grid = 0;
    if (grid == 0) {
        int dev = 0, cus = 0;
        if (hipGetDevice(&dev) != hipSuccess || hipDeviceGetAttribute(&cus, hipDeviceAttributeMultiprocessorCount, dev) != hipSuccess) { fprintf(stderr, "kernel_launch: device query failed\n"); grid = -1; return; }
        if (hipFuncSetAttribute((const void*)fwd_megakernel, hipFuncAttributeMaxDynamicSharedMemorySize, LDS_BYTES) != hipSuccess) { fprintf(stderr, "kernel_launch: hipFuncSetAttribute failed\n"); grid = -1; return; }
        int per_cu = 0;
        if (hipOccupancyMaxActiveBlocksPerMultiprocessor(&per_cu, (const void*)fwd_megakernel, 512, LDS_BYTES) != hipSuccess || per_cu < 1) { fprintf(stderr, "kernel_launch: occupancy query says %d blocks per CU\n", per_cu); (void)hipGetLastError(); }
        grid = cus;
    }
    if (grid < 0) return;
    Params p{};
    const float** pp = (const float**)&p;
    for (int i = 0; i < 23; ++i) pp[i] = (const float*)d_in[i];
    p.out = (float*)d_out; p.ws = (unsigned char*)d_ws;
    (void)hipMemsetAsync((char*)d_ws + WS_CTL, 0, 16384, stream);
#if MK_SINGLE
    p.ph_lo = 0; p.ph_hi = NPH;
    void* args[] = {&p};
    hipError_t e = hipLaunchCooperativeKernel((const void*)fwd_megakernel, dim3(grid), dim3(512), args, LDS_BYTES, stream);
    if (e != hipSuccess) fprintf(stderr, "cooperative launch failed: %s (grid %d)\n", hipGetErrorString(e), grid);
#else
    for (int ph = 0; ph < NPH; ++ph) {
        p.ph_lo = ph; p.ph_hi = ph + 1;
        hipLaunchKernelGGL(fwd_megakernel, dim3(grid), dim3(512), LDS_BYTES, stream, p);
    }
#endif
}
```

```cpp
#include <hip/hip_runtime.h>
#include <cstdio>
#include <cstdint>

#define LAS __attribute__((address_space(3)))
typedef unsigned short bf16_t;
typedef short bf16x8 __attribute__((ext_vector_type(8)));
typedef float f32x4 __attribute__((ext_vector_type(4)));
typedef unsigned u32x4 __attribute__((ext_vector_type(4)));
typedef unsigned u32x2 __attribute__((ext_vector_type(2)));

#ifndef REP_PHASE
#define REP_PHASE -1
#endif
#ifndef MK_SINGLE
#define MK_SINGLE 1
#endif

constexpr int NTOK = 16384, DM = 1024, NPROJ = 6144, DIN = 6176;
constexpr int NPH = 8;
constexpr int LDS_BYTES = 160 * 1024;
constexpr size_t OUT_YP = 0, OUT_YS = 8388608, OUT_SD = 16777216, OUT_SR = 25165824;
constexpr size_t WS_CTL = 0, WS_MODP = 16384, WS_PE = 606208, WS_BA = 737280, WS_GB = 2834432, WS_RGAGG = 4931584,
                 WS_WBAT = 9125888, WS_WOUTT = 9191424, WS_GT = 13385728, WS_WINT = 14434304, WS_TA = 27017216, WS_PROJ = 60571648, WS_CARRY = 261898240;

struct Params {
    const float *x_prompt, *x_sample, *state_delta, *state_rglru, *c, *c_ctx, *ada_w, *ada_b, *pre_w, *post_w, *w_in, *w_out,
                *dn_conv_w, *dn_a_log, *dn_dt_bias, *dn_norm_w, *rg_conv_w, *rg_conv_b, *rg_w_r, *rg_b_r, *rg_w_i, *rg_b_i, *rg_lam;
    float* out; unsigned char* ws;
    int ph_lo, ph_hi;
};

__device__ __forceinline__ float bf2f(unsigned short b) { return __uint_as_float(((unsigned)b) << 16); }
typedef __bf16 bf2_t __attribute__((ext_vector_type(2)));
typedef float f2_t __attribute__((ext_vector_type(2)));
__device__ __forceinline__ unsigned pk2(float lo, float hi) { const f2_t v = {lo, hi}; return __builtin_bit_cast(unsigned, __builtin_convertvector(v, bf2_t)); }
__device__ __forceinline__ unsigned short f2bf(float f) { return (unsigned short)(pk2(f, f) & 0xffffu); }
#ifndef SANITIZE
#define SANITIZE 0
#endif
#ifndef LIVE_MASK
#define LIVE_MASK 15
#endif
__device__ __forceinline__ float fin(float x) { return (SANITIZE && ((__float_as_uint(x) & 0x7f800000u) == 0x7f800000u)) ? 0.f : x; }
#define DG(F) ((unsigned*)((F).ws + WS_CTL))
__device__ __forceinline__ bool badv(float x, float lim) { return ((__float_as_uint(x) & 0x7f800000u) == 0x7f800000u) || fabsf(x) > lim; }
#ifndef DIAG
#define DIAG 0
#endif
#define CHK(F, k, bad) do { if (DIAG && (bad)) DG(F)[k] = 1u; } while (0)
__device__ __forceinline__ float sigm(float x) { return __builtin_amdgcn_rcpf(1.f + __expf(-x)); }
__device__ __forceinline__ float siluf_(float x) { return x * __builtin_amdgcn_rcpf(1.f + __expf(-x)); }
__device__ __forceinline__ float softplusf_(float x) { return x > 20.f ? x : log1pf(__expf(x)); }
__device__ __forceinline__ void unpack8(const u32x4 v, float (&f)[8]) {
    f[0] = __uint_as_float(v.x << 16); f[1] = __uint_as_float(v.x & 0xffff0000u);
    f[2] = __uint_as_float(v.y << 16); f[3] = __uint_as_float(v.y & 0xffff0000u);
    f[4] = __uint_as_float(v.z << 16); f[5] = __uint_as_float(v.z & 0xffff0000u);
    f[6] = __uint_as_float(v.w << 16); f[7] = __uint_as_float(v.w & 0xffff0000u);
}
__device__ __forceinline__ u32x4 pack8(const float (&f)[8]) { u32x4 o; o.x = pk2(f[0], f[1]); o.y = pk2(f[2], f[3]); o.z = pk2(f[4], f[5]); o.w = pk2(f[6], f[7]); return o; }
__device__ __forceinline__ float wave_sum(float v) {
#pragma unroll
    for (int o = 1; o < 64; o <<= 1) v += __shfl_xor(v, o);
    return v;
}
__device__ __forceinline__ void lds_barrier() { asm volatile("s_waitcnt lgkmcnt(0)" ::: "memory"); __builtin_amdgcn_s_barrier(); asm volatile("" ::: "memory"); }
#define MFMA16(a, b, c) __builtin_amdgcn_mfma_f32_16x16x32_bf16((a), (b), (c), 0, 0, 0)
#define LDS_WAIT() asm volatile("s_waitcnt lgkmcnt(0)" ::: "memory")
__device__ __forceinline__ bf16x8 ldfrag(const LAS unsigned char* base, int pitch, int row, int kb) { return *(const LAS bf16x8*)(base + row * pitch + kb); }

#define XB_TMO      128
#define XB_XCNT(j)  (256  + 64 * (j))
#define XB_XSUB(j)  (1280 + 64 * (j))
#define XB_XGEN(j)  (2304 + 64 * (j))
#define XB_TOP      3328
#define XB_TOPGEN   3392
#define XCD_BAR_WORDS 3456
#define XB_SPIN_CAP (1u << 18)
__device__ __forceinline__ unsigned xb_ld(unsigned* p)              { return __hip_atomic_load(p, __ATOMIC_RELAXED, __HIP_MEMORY_SCOPE_AGENT); }
__device__ __forceinline__ unsigned xb_add(unsigned* p, unsigned v) { return __hip_atomic_fetch_add(p, v, __ATOMIC_RELAXED, __HIP_MEMORY_SCOPE_AGENT); }
__device__ __forceinline__ unsigned xb_xcc_id() { return (unsigned)__builtin_amdgcn_s_getreg((3 << 11) | 20) & 0xFu; }
#define XB_SPIN(cond, bar) do { unsigned _sp = 0; while (cond) { __builtin_amdgcn_s_sleep(1); \
    if ((++_sp & 255u) == 0u) { if (xb_ld(&(bar)[XB_TMO])) break; if (_sp > XB_SPIN_CAP) { atomicAdd(&(bar)[XB_TMO], 1u); break; } } } } while (0)
struct XcdBarrier { unsigned* bar; unsigned x; volatile LAS unsigned* st; };
__device__ __forceinline__ XcdBarrier xcd_barrier_post(unsigned* bar, volatile LAS unsigned* st) {
    XcdBarrier b; b.bar = bar; b.x = xb_xcc_id(); b.st = st;
    if (threadIdx.x == 0) (void)xb_add(&bar[XB_XCNT(b.x)], 1u);
    return b;
}
__device__ __forceinline__ void xcd_barrier_complete(unsigned* bar, unsigned x, unsigned& nloc, unsigned& nx) {
    const unsigned G = gridDim.x * gridDim.y * gridDim.z;
    unsigned sum, cnt, mine, sp = 0u;
    for (;;) {
        sum = 0u; cnt = 0u; mine = 0u;
#pragma unroll
        for (unsigned j = 0; j < 16; ++j) { const unsigned c = xb_ld(&bar[XB_XCNT(j)]); sum += c; cnt += (c > 0u) ? 1u : 0u; mine = (j == x) ? c : mine; }
        if (sum == G) break;
        __builtin_amdgcn_s_sleep(1);
        if ((++sp & 255u) == 0u) { if (xb_ld(&bar[XB_TMO])) break; if (sp > XB_SPIN_CAP) { atomicAdd(&bar[XB_TMO], 1u); break; } }
    }
    nloc = mine > 0u ? mine : 1u; nx = cnt > 0u ? cnt : 1u;
}
__device__ __forceinline__ void xcd_barrier(const XcdBarrier& b) {
    asm volatile("s_waitcnt vmcnt(0)" ::: "memory");
    __syncthreads();
    if (threadIdx.x == 0) {
        unsigned* bar = b.bar;
        __builtin_amdgcn_s_waitcnt(0);
        unsigned nloc = b.st[0], nx = b.st[1];
        if (nloc == 0u) { xcd_barrier_complete(bar, b.x, nloc, nx); b.st[0] = nloc; b.st[1] = nx; }
        const unsigned old = xb_add(&bar[XB_XSUB(b.x)], 1u);
        const unsigned gen = old / nloc;
        if (old + 1u == (gen + 1u) * nloc) {
            __builtin_amdgcn_fence(__ATOMIC_RELEASE, "agent");
            asm volatile("s_waitcnt vmcnt(0)" ::: "memory");
            const unsigned og = xb_add(&bar[XB_TOP], 1u);
            const unsigned tg = og / nx;
            if (og + 1u == (tg + 1u) * nx) xb_add(&bar[XB_TOPGEN], 1u);
            else XB_SPIN(xb_ld(&bar[XB_TOPGEN]) == tg, bar);
            __builtin_amdgcn_fence(__ATOMIC_ACQUIRE, "agent");
            xb_add(&bar[XB_XGEN(b.x)], 1u);
            asm volatile("s_waitcnt vmcnt(0)" ::: "memory");
        } else {
            XB_SPIN(xb_ld(&bar[XB_XGEN(b.x)]) == gen, bar);
            __builtin_amdgcn_fence(__ATOMIC_ACQUIRE, "agent");
            asm volatile("s_waitcnt vmcnt(0)" ::: "memory");
        }
    }
    __syncthreads();
}

namespace pg8 {
constexpr int BM = 256, BK = 64, HALF = 128, HTB = HALF * BK * 2, STAGE_BYTES = 8 * HTB, NXCD = 8, WGM = 8;
__host__ __device__ __forceinline__ int lds_byte(int r, int c) { const int st = (r >> 4) * 2 + (c >> 5), rr = r & 15, cc = c & 31, ob = rr * 64 + cc * 2; return st * 1024 + (ob ^ (((ob >> 9) & 1) << 5)); }
__host__ __device__ __forceinline__ void stage_rc(int b, int& R, int& C) { const int st = b / 1024, sb = b % 1024, swz = sb ^ (((sb >> 9) & 1) << 5); R = (st >> 1) * 16 + swz / 64; C = (st & 1) * 32 + (swz % 64) / 2; }
__host__ __device__ __forceinline__ int perm32(int rho) { const int n = rho >> 4, i = rho & 15; return 8 * (i >> 2) + 4 * n + (i & 3); }
struct Unit { int pm, pn; };
struct Gemm { const bf16_t* A; const bf16_t* Bt; int M, N, K; };
struct StaticOrder {
    int nM, nN, nwg, G, c;
    __host__ __device__ void init(int M, int N, int G_, int c_) { nM = M / BM; nN = N / BM; nwg = nM * nN; G = G_; c = c_; }
    __host__ __device__ bool next(int i, Unit& u) const {
        const long L = (long)i * G + c; if (L >= nwg) return false;
        int wgid = (int)L; { const int q = nwg / NXCD, r = nwg % NXCD, xcd = wgid % NXCD, off = wgid / NXCD; wgid = (xcd < r ? xcd * (q + 1) : r * (q + 1) + (xcd - r) * q) + off; }
        const int nig = WGM * nN, gid = wgid / nig, fm = gid * WGM, gsz = (nM - fm) < WGM ? (nM - fm) : WGM;
        u.pm = fm + ((wgid % nig) % gsz); u.pn = (wgid % nig) / gsz; return true;
    }
};
__device__ __forceinline__ unsigned cvt_pk_bf16(float lo, float hi) { unsigned r; asm volatile("v_cvt_pk_bf16_f32 %0, %1, %2" : "=v"(r) : "v"(lo), "v"(hi)); return r; }
struct EpiF32 {
    static constexpr bool PERM = false;
    float* C; int ldc;
    __device__ __forceinline__ void operator()(const f32x4 (&acc)[2][2][4][2], const Unit& u, int wr, int wc, int fr, int fq) const {
        const int row0 = u.pm * BM + wr * 64 + fr, col0 = u.pn * BM + wc * 32 + 4 * fq;
#pragma unroll
        for (int ai = 0; ai < 2; ++ai)
#pragma unroll
            for (int m = 0; m < 4; ++m) { float* rowp = C + (size_t)(row0 + ai * HALF + m * 16) * ldc + col0;
#pragma unroll
                for (int bj = 0; bj < 2; ++bj)
#pragma unroll
                    for (int n = 0; n < 2; ++n) *(f32x4*)(rowp + bj * HALF + n * 16) = acc[ai][bj][m][n]; }
    }
};
struct EpiBf16 {
    static constexpr bool PERM = true;
    bf16_t* O; int ldc;
    __device__ __forceinline__ void operator()(const f32x4 (&acc)[2][2][4][2], const Unit& u, int wr, int wc, int fr, int fq) const {
        const int row0 = u.pm * BM + wr * 64 + fr; const int col0 = u.pn * BM + wc * 32 + 8 * fq;
#pragma unroll
        for (int ai = 0; ai < 2; ++ai)
#pragma unroll
            for (int m = 0; m < 4; ++m) { bf16_t* rowp = O + (size_t)(row0 + ai * HALF + m * 16) * ldc + col0;
#pragma unroll
                for (int bj = 0; bj < 2; ++bj) { const f32x4 v0 = acc[ai][bj][m][0], v1 = acc[ai][bj][m][1];
                    u32x4 w; w.x = cvt_pk_bf16(v0[0], v0[1]); w.y = cvt_pk_bf16(v0[2], v0[3]); w.z = cvt_pk_bf16(v1[0], v1[1]); w.w = cvt_pk_bf16(v1[2], v1[3]);
                    *(u32x4*)(rowp + bj * HALF) = w; } }
    }
};

template <class Epi, class Sched>
__device__ __forceinline__ void gemm_phase(LAS unsigned char* lds, const Gemm g, const Sched& S, const Epi& E) {
    const int tid = threadIdx.x, wid = __builtin_amdgcn_readfirstlane(tid >> 6), lane = tid & 63, wr = wid >> 2, wc = wid & 3, fr = lane & 15, fq = lane >> 4;
    const int K = g.K, nt = K / BK;
    unsigned voffA[2], voffB[2];
#pragma unroll
    for (int i = 0; i < 2; ++i) { int R, C; stage_rc(tid * 16 + i * 8192, R, C); const int Rb = Epi::PERM ? ((R & ~31) + perm32(R & 31)) : R;
        voffA[i] = (unsigned)(R * K + C) * 2u; voffB[i] = (unsigned)(Rb * K + C) * 2u; }
    const size_t kstep = (size_t)(BK * 2);
    const size_t hstep = (size_t)HALF * K * 2;
    const size_t tstep = 2 * hstep;
    const unsigned ldsw = (unsigned)wid * 1024u;
    const int aoff = lds_byte(wr * 64 + fr, fq * 8), boff = lds_byte(wc * 32 + fr, fq * 8);
#define PG8_SA(b, h) (((b) * 2 + (h)) * HTB)
#define PG8_SB(b, h) ((4 + (b) * 2 + (h)) * HTB)
#define PG8_STAGE(bufoff, gbase, voff) do { _Pragma("unroll") for (int _i = 0; _i < 2; ++_i) \
        __builtin_amdgcn_global_load_lds((const unsigned*)((const char*)(gbase) + (voff)[_i]), (LAS unsigned*)(lds + (bufoff) + ldsw + _i * 8192), 16, 0, 0); } while (0)
#define PG8_LDA(dst, b, h) do { _Pragma("unroll") for (int m = 0; m < 4; ++m) _Pragma("unroll") for (int k = 0; k < 2; ++k) dst[m][k] = *(const LAS bf16x8*)(lds + PG8_SA(b, h) + aoff + m * 2048 + k * 1024); } while (0)
#define PG8_LDB(dst, b, h) do { _Pragma("unroll") for (int n = 0; n < 2; ++n) _Pragma("unroll") for (int k = 0; k < 2; ++k) dst[n][k] = *(const LAS bf16x8*)(lds + PG8_SB(b, h) + boff + n * 2048 + k * 1024); } while (0)
#define PG8_MMA(ai, bj, At, Bt) do { __builtin_amdgcn_s_setprio(1); _Pragma("unroll") for (int m = 0; m < 4; ++m) _Pragma("unroll") for (int n = 0; n < 2; ++n) _Pragma("unroll") for (int k = 0; k < 2; ++k) \
        acc[ai][bj][m][n] = __builtin_amdgcn_mfma_f32_16x16x32_bf16(Bt[n][k], At[m][k], acc[ai][bj][m][n], 0, 0, 0); __builtin_amdgcn_s_setprio(0); } while (0)
#define PG8_WAIT_V(n) asm volatile("s_waitcnt vmcnt(" #n ")" ::: "memory")
#define PG8_WAIT_L(n) asm volatile("s_waitcnt lgkmcnt(" #n ")" ::: "memory")
#define PG8_BAR __builtin_amdgcn_s_barrier()
#define PG8_SCHED __builtin_amdgcn_sched_barrier(0)
    Unit cur, nxt; int ui = 0;
    if (!S.next(0, cur)) return;
    f32x4 acc[2][2][4][2];
#pragma unroll
    for (int a = 0; a < 2; ++a)
#pragma unroll
        for (int b = 0; b < 2; ++b)
#pragma unroll
            for (int m = 0; m < 4; ++m)
#pragma unroll
                for (int n = 0; n < 2; ++n) acc[a][b][m][n] = (f32x4){0.f, 0.f, 0.f, 0.f};
    bf16x8 At[4][2], B0[2][2], B1[2][2];
    const char* cA = (const char*)g.A + (size_t)cur.pm * tstep; const char* cB = (const char*)g.Bt + (size_t)cur.pn * tstep;
    PG8_STAGE(PG8_SB(0, 0), cB, voffB); PG8_STAGE(PG8_SA(0, 0), cA, voffA); PG8_STAGE(PG8_SB(0, 1), cB + hstep, voffB); PG8_STAGE(PG8_SA(0, 1), cA + hstep, voffA);
    if (wr == 1) PG8_BAR;
    PG8_WAIT_V(4); PG8_BAR;
    PG8_STAGE(PG8_SB(1, 0), cB + kstep, voffB); PG8_STAGE(PG8_SA(1, 0), cA + kstep, voffA); PG8_STAGE(PG8_SB(1, 1), cB + hstep + kstep, voffB);
    PG8_WAIT_V(6); PG8_BAR;
    for (;;) {
        const bool has_next = S.next(ui + 1, nxt);
        const char* nA = has_next ? (const char*)g.A + (size_t)nxt.pm * tstep : cA; const char* nB = has_next ? (const char*)g.Bt + (size_t)nxt.pn * tstep : cB;
        for (int t = 0; t < nt; t += 2) {
            const bool last = (t == nt - 2);
            const char* a1 = cA + (size_t)(t + 1) * kstep;
            const char* a2 = last ? nA : cA + (size_t)(t + 2) * kstep; const char* b2 = last ? nB : cB + (size_t)(t + 2) * kstep;
            const char* a3 = a2 + kstep; const char* b3 = b2 + kstep;
            PG8_LDB(B0, 0, 0); PG8_SCHED; PG8_LDA(At, 0, 0); PG8_STAGE(PG8_SA(1, 1), a1 + hstep, voffA);
            PG8_WAIT_L(8); PG8_BAR; PG8_WAIT_L(0); PG8_MMA(0, 0, At, B0); PG8_BAR; PG8_SCHED;
            PG8_LDB(B1, 0, 1); PG8_STAGE(PG8_SB(0, 0), b2, voffB);
            PG8_BAR; PG8_WAIT_L(0); PG8_MMA(0, 1, At, B1); PG8_BAR;
            PG8_LDA(At, 0, 1); PG8_STAGE(PG8_SA(0, 0), a2, voffA);
            PG8_BAR; PG8_WAIT_L(0); PG8_MMA(1, 0, At, B0); PG8_BAR; PG8_SCHED;
            PG8_STAGE(PG8_SB(0, 1), b2 + hstep, voffB);
            PG8_WAIT_V(6); PG8_BAR; PG8_MMA(1, 1, At, B1); PG8_BAR;
            PG8_LDB(B0, 1, 0); PG8_SCHED; PG8_LDA(At, 1, 0); PG8_STAGE(PG8_SA(0, 1), a2 + hstep, voffA);
            PG8_WAIT_L(8); PG8_BAR; PG8_WAIT_L(0); PG8_MMA(0, 0, At, B0); PG8_BAR; PG8_SCHED;
            PG8_LDB(B1, 1, 1); PG8_STAGE(PG8_SB(1, 0), b3, voffB);
            PG8_BAR; PG8_WAIT_L(0); PG8_MMA(0, 1, At, B1); PG8_BAR;
            PG8_LDA(At, 1, 1); PG8_STAGE(PG8_SA(1, 0), a3, voffA);
            PG8_BAR; PG8_WAIT_L(0); PG8_MMA(1, 0, At, B0); PG8_BAR; PG8_SCHED;
            PG8_STAGE(PG8_SB(1, 1), b3 + hstep, voffB);
            PG8_WAIT_V(6); PG8_BAR; PG8_MMA(1, 1, At, B1); PG8_BAR;
        }
        E(acc, cur, wr, wc, fr, fq);
        if (!has_next) break;
#pragma unroll
        for (int a = 0; a < 2; ++a)
#pragma unroll
            for (int b = 0; b < 2; ++b)
#pragma unroll
                for (int m = 0; m < 4; ++m)
#pragma unroll
                    for (int n = 0; n < 2; ++n) acc[a][b][m][n] = (f32x4){0.f, 0.f, 0.f, 0.f};
        cur = nxt; cA = nA; cB = nB; ++ui;
    }
    PG8_WAIT_V(0);
    if (wr == 0) PG8_BAR;
    PG8_BAR;
#undef PG8_SA
#undef PG8_SB
#undef PG8_STAGE
#undef PG8_LDA
#undef PG8_LDB
#undef PG8_MMA
#undef PG8_WAIT_V
#undef PG8_WAIT_L
#undef PG8_BAR
#undef PG8_SCHED
}
}

struct Frame {
    LAS unsigned char* lds;
    int tid, lane, wave, G, b;
    float* out; unsigned char* ws;
    __device__ __forceinline__ bf16_t* H() const { return (bf16_t*)out; }
    __device__ __forceinline__ bf16_t* Qc() const { return (bf16_t*)out; }
    __device__ __forceinline__ bf16_t* Kc() const { return (bf16_t*)(out + OUT_YS); }
    __device__ __forceinline__ bf16_t* MIX() const { return (bf16_t*)out; }
    __device__ __forceinline__ float* modp() const { return (float*)(ws + WS_MODP); }
    __device__ __forceinline__ float* pe() const { return (float*)(ws + WS_PE); }
    __device__ __forceinline__ float* BA() const { return (float*)(ws + WS_BA); }
    __device__ __forceinline__ float* GB() const { return (float*)(ws + WS_GB); }
    __device__ __forceinline__ float* RGAGG() const { return (float*)(ws + WS_RGAGG); }
    __device__ __forceinline__ bf16_t* WbaT() const { return (bf16_t*)(ws + WS_WBAT); }
    __device__ __forceinline__ bf16_t* WoutT() const { return (bf16_t*)(ws + WS_WOUTT); }
    __device__ __forceinline__ bf16_t* GT() const { return (bf16_t*)(ws + WS_GT); }
    __device__ __forceinline__ bf16_t* WinT() const { return (bf16_t*)(ws + WS_WINT); }
    __device__ __forceinline__ bf16_t* TA() const { return (bf16_t*)(ws + WS_TA); }
    __device__ __forceinline__ bf16_t* PROJ() const { return (bf16_t*)(ws + WS_PROJ); }
    __device__ __forceinline__ float* CARRY() const { return (float*)(ws + WS_CARRY); }
};
typedef const __attribute__((address_space(4))) Params CParams;

__device__ __forceinline__ int grp_of_block(int tb) { return tb < 128 ? 0 : (tb < 192 ? 1 : 2); }

__device__ __forceinline__ void transpose_item(const float* W, int N, int k0, int n0, bf16_t* WT0, int Kout, LAS float* scr, int lane) {
#pragma unroll 8
    for (int i = 0; i < 32; ++i) { const int kk = 2 * i + (lane >> 5); scr[kk * 33 + (lane & 31)] = W[(size_t)(k0 + kk) * N + n0 + (lane & 31)]; }
    LDS_WAIT();
    const int c = lane & 7;
#pragma unroll
    for (int j = 0; j < 4; ++j) { const int n = (lane >> 3) + 8 * j; const LAS float* s = scr + (8 * c) * 33 + n;
        u32x4 o; o.x = pk2(s[0 * 33], s[1 * 33]); o.y = pk2(s[2 * 33], s[3 * 33]); o.z = pk2(s[4 * 33], s[5 * 33]); o.w = pk2(s[6 * 33], s[7 * 33]);
        *(u32x4*)(WT0 + (size_t)n * Kout + k0 + 8 * c) = o; }
    LDS_WAIT();
}
struct P0Item { const float* W; bf16_t* dst; int N, k0, n0, Kout, kind; };
__device__ __forceinline__ P0Item p0_decode(CParams& p, const Frame& F, int it) {
    constexpr int I_IN = 16 * 193, I_OUT = 32 * 32, I_G = 256;
    P0Item D; D.kind = 0; int r = it;
    if (r < I_IN) { const int kb = r / 193, nb = r % 193, n0 = nb * 32;
        D.dst = n0 < 4096 ? F.WinT() + (size_t)n0 * 1024 : (n0 < 4128 ? F.WbaT() + (size_t)(n0 - 4096) * 1024 : F.WinT() + (size_t)(n0 - 32) * 1024);
        D.W = p.w_in; D.N = DIN; D.k0 = kb * 64; D.n0 = n0; D.Kout = 1024; return D; }
    r -= I_IN;
    if (r < I_OUT) { const int kb = r / 32, nb = r % 32; D.W = p.w_out; D.N = 1024; D.k0 = kb * 64; D.n0 = nb * 32; D.dst = F.WoutT() + (size_t)(nb * 32) * 2048; D.Kout = 2048; return D; }
    r -= I_OUT;
    if (r < I_G) { const int m = r >> 3, sub = r & 7, kb = sub >> 2, nb = sub & 3, g = m >> 4, dn = m & 15;
        D.W = (g ? p.rg_w_i : p.rg_w_r) + (size_t)dn * 16384; D.N = 128; D.k0 = kb * 64; D.n0 = nb * 32; D.dst = F.GT() + (size_t)m * 16384 + (size_t)(nb * 32) * 128; D.Kout = 128; return D; }
    r -= I_G;
    D.kind = 1; D.k0 = r; D.W = p.w_in; D.dst = F.WinT(); D.N = 0; D.n0 = 0; D.Kout = 0; return D;
}
__device__ __forceinline__ void p0_load(const P0Item& D, float (&v)[32], int lane) {
#pragma unroll
    for (int i = 0; i < 32; ++i) { const int kk = 2 * i + (lane >> 5); v[i] = __builtin_nontemporal_load(D.W + (size_t)(D.k0 + kk) * D.N + D.n0 + (lane & 31)); }
}
__device__ __forceinline__ void p0_store(const P0Item& D, const float (&v)[32], LAS float* scr, int lane) {
#pragma unroll
    for (int i = 0; i < 32; ++i) { const int kk = 2 * i + (lane >> 5); scr[kk * 33 + (lane & 31)] = v[i]; }
    LDS_WAIT();
    const int c = lane & 7;
#pragma unroll
    for (int j = 0; j < 4; ++j) { const int n = (lane >> 3) + 8 * j; const LAS float* s = scr + (8 * c) * 33 + n;
        u32x4 o; o.x = pk2(s[0 * 33], s[1 * 33]); o.y = pk2(s[2 * 33], s[3 * 33]); o.z = pk2(s[4 * 33], s[5 * 33]); o.w = pk2(s[6 * 33], s[7 * 33]);
        *(u32x4*)(D.dst + (size_t)n * D.Kout + D.k0 + 8 * c) = o; }
    LDS_WAIT();
}
__device__ __forceinline__ void phase0(CParams& p, Frame& F) {
    const int tid = F.tid, lane = F.lane;
    for (int it = F.b; it < 192; it += F.G) {
        const int jg = it % 12, ks = it / 12, j = jg * 256 + (tid & 255), half = tid >> 8, k0 = ks * 64 + half * 32;
        float s0 = 0.f, s1 = 0.f, s2 = 0.f;
#pragma unroll 8
        for (int k = 0; k < 32; ++k) { const int kk = k0 + k; const float w = __builtin_nontemporal_load(p.ada_w + (size_t)kk * 3072 + j);
            s0 += siluf_(p.c_ctx[kk]) * w; s1 += siluf_(p.c[kk]) * w; s2 += siluf_(p.c[1024 + kk]) * w; }
        LAS float* red = (LAS float*)F.lds;
        if (half == 1) { red[tid - 256] = s0; red[256 + tid - 256] = s1; red[512 + tid - 256] = s2; }
        __syncthreads();
        if (half == 0) { F.modp()[(size_t)(ks * 3 + 0) * 3072 + j] = s0 + red[tid]; F.modp()[(size_t)(ks * 3 + 1) * 3072 + j] = s1 + red[256 + tid]; F.modp()[(size_t)(ks * 3 + 2) * 3072 + j] = s2 + red[512 + tid]; }
        __syncthreads();
    }
    LAS float* scr = (LAS float*)(F.lds + 4096 + F.wave * 8448);
    const int gw = F.b * 8 + F.wave, NGW = F.G * 8;
    constexpr int I_IN = 16 * 193, I_OUT = 32 * 32, I_G = 256, I_PE = 64, I_ALL = I_IN + I_OUT + I_G + I_PE;
    P0Item D = p0_decode(p, F, gw), Dn = D; float v[32], vn[32];
    if (gw < I_ALL && D.kind == 0) p0_load(D, v, lane);
    for (int it = gw; it < I_ALL; it += NGW) {
        const int itn = it + NGW;
        if (itn < I_ALL) { Dn = p0_decode(p, F, itn); if (Dn.kind == 0) p0_load(Dn, vn, lane); }
        if (D.kind == 0) p0_store(D, v, scr, lane);
        else { const int pv = D.k0;
#pragma unroll
            for (int i = 0; i < 4; ++i) { const int idx = lane * 4 + i; const float f = expf(-9.210340371976184f * (float)idx / 256.f); const float a = (float)pv * f;
                F.pe()[pv * 256 + idx] = sinf(a); F.pe()[16384 + pv * 256 + idx] = cosf(a); } }
        D = Dn;
#pragma unroll
        for (int i = 0; i < 32; ++i) v[i] = vn[i];
    }
}

__device__ __forceinline__ float mod_val(CParams& p, const Frame& F, int grp, int j) {
    float s = p.ada_b[j];
#pragma unroll
    for (int ks = 0; ks < 16; ++ks) s += F.modp()[(size_t)(ks * 3 + grp) * 3072 + j];
    return s;
}

__device__ __forceinline__ void phase1(CParams& p, Frame& F) {
    LAS float* sc = (LAS float*)F.lds; LAS float* sh = sc + 1024;
    for (int tb = F.b; tb < 256; tb += F.G) {
        const int grp = grp_of_block(tb);
        for (int j = F.tid; j < 1024; j += 512) { sh[j] = mod_val(p, F, grp, j); sc[j] = p.pre_w[j] * (1.f + mod_val(p, F, grp, 1024 + j)); }
        __syncthreads();
#pragma unroll 2
        for (int i = 0; i < 8; ++i) {
            const int tok = tb * 64 + F.wave * 8 + i;
            const float* xr = tok < 8192 ? p.x_prompt + (size_t)tok * 1024 : p.x_sample + (size_t)(tok - 8192) * 1024;
            f32x4 v[4]; float ss = 0.f;
#pragma unroll
            for (int q = 0; q < 4; ++q) { v[q] = __builtin_nontemporal_load((const f32x4*)(xr + F.lane * 4 + 256 * q));
                if (tok >= 8192) { const int pp = (tok - 8192) & 4095; const int vv = (q < 2) ? (pp >> 6) : (pp & 63);
                    const f32x4 e = *(const f32x4*)(F.pe() + ((q & 1) ? 16384 : 0) + vv * 256 + F.lane * 4); v[q] += e; }
                ss += (v[q][0] * v[q][0] + v[q][1] * v[q][1]) + (v[q][2] * v[q][2] + v[q][3] * v[q][3]); }
            const float rstd = rsqrtf(wave_sum(ss) * (1.f / 1024.f) + 1e-6f);
#pragma unroll
            for (int q = 0; q < 4; ++q) { const int j = F.lane * 4 + 256 * q; const f32x4 s4 = *(const LAS f32x4*)(sc + j), h4 = *(const LAS f32x4*)(sh + j);
                CHK(F, 1, badv(v[q][0] * rstd * s4[0] + h4[0], 100.f) || badv(v[q][3] * rstd * s4[3] + h4[3], 100.f));
                u32x2 o; o.x = pk2(v[q][0] * rstd * s4[0] + h4[0], v[q][1] * rstd * s4[1] + h4[1]); o.y = pk2(v[q][2] * rstd * s4[2] + h4[2], v[q][3] * rstd * s4[3] + h4[3]);
                *(u32x2*)(F.H() + (size_t)tok * 1024 + j) = o; }
        }
        __syncthreads();
    }
}

__device__ __forceinline__ void phase2(CParams& p, Frame& F) {
    { pg8::Gemm g{F.H(), F.WinT(), NTOK, NPROJ, 1024}; pg8::StaticOrder S; S.init(NTOK, NPROJ, F.G, F.b); pg8::EpiBf16 E{F.PROJ(), NPROJ};
      pg8::gemm_phase<pg8::EpiBf16, pg8::StaticOrder>(F.lds, g, S, E); }
    const int l15 = F.lane & 15, q4 = F.lane >> 4;
    for (int tb = F.b; tb < 256; tb += F.G) {
        const int mt = F.wave >> 1, nt = F.wave & 1;
        const bf16_t* ar = F.H() + (size_t)(tb * 64 + mt * 16 + l15) * 1024 + q4 * 8;
        const bf16_t* br = F.WbaT() + (size_t)(nt * 16 + l15) * 1024 + q4 * 8;
        f32x4 acc = {0.f, 0.f, 0.f, 0.f};
#pragma unroll 16
        for (int ks = 0; ks < 32; ++ks) { const bf16x8 a = *(const bf16x8*)(ar + ks * 32), b = *(const bf16x8*)(br + ks * 32); acc = MFMA16(a, b, acc); }
#pragma unroll
        for (int r = 0; r < 4; ++r) F.BA()[(size_t)(tb * 64 + mt * 16 + q4 * 4 + r) * 32 + nt * 16 + l15] = acc[r];
    }
}

__device__ __forceinline__ void p3_load_rows(const Frame& F, int ci, int h, u32x4 (&rows)[7]) {
    const int tid = F.tid, tg = tid >> 5, part = (tid >> 4) & 1, sub = tid & 15, col = part * 1024 + h * 128 + sub * 8, t0 = ci * 64;
    int seq_lo, seq_hi; if (ci < 128) { seq_lo = (ci >> 2) * 256; seq_hi = seq_lo + 256; } else { seq_lo = 8192 + ((ci - 128) >> 6) * 4096; seq_hi = seq_lo + 4096; }
    const int tb = t0 + tg * 4 - 2;
#pragma unroll
    for (int r = 0; r < 7; ++r) { const int tok = tb + r; u32x4 v = {0u, 0u, 0u, 0u};
        if (tok >= seq_lo && tok < seq_hi) v = *(const u32x4*)(F.PROJ() + (size_t)tok * NPROJ + col);
        rows[r] = v; }
}
__device__ __forceinline__ void p3_delta_item(CParams& p, Frame& F, int ci, int h, u32x4 (&rows)[7], int itn) {
    const int tid = F.tid, lane = F.lane, wave = F.wave, q4 = lane >> 4, l15 = lane & 15;
    LAS unsigned char* Ks = F.lds; LAS unsigned char* Qs = F.lds + 17408;
    LAS float* gfv = (LAS float*)(F.lds + 34816);
    LAS unsigned char* DIR0 = F.lds + 35840;
    LAS unsigned char* ATo = F.lds + 137728;
#pragma unroll
    for (int i = 0; i < 5; ++i) { const int ch = tid + 512 * i; if (ch < 2304) { const int dd = ch >= 1152, cc = ch - dd * 1152; *(LAS u32x4*)(DIR0 + dd * 47616 + 18432 + cc * 16) = (u32x4){0u, 0u, 0u, 0u}; } }
    const int t0 = ci * 64;
    int seq_lo, seq_hi; if (ci < 128) { seq_lo = (ci >> 2) * 256; seq_hi = seq_lo + 256; } else { seq_lo = 8192 + ((ci - 128) >> 6) * 4096; seq_hi = seq_lo + 4096; }
    {
        const int tg = tid >> 5, part = (tid >> 4) & 1, sub = tid & 15, col = part * 1024 + h * 128 + sub * 8;
        float w[4][8];
#pragma unroll
        for (int j = 0; j < 4; ++j) { const f32x4 a = *(const f32x4*)(p.dn_conv_w + j * 3072 + col), b = *(const f32x4*)(p.dn_conv_w + j * 3072 + col + 4);
            w[j][0] = a[0]; w[j][1] = a[1]; w[j][2] = a[2]; w[j][3] = a[3]; w[j][4] = b[0]; w[j][5] = b[1]; w[j][6] = b[2]; w[j][7] = b[3]; }
        float acc[4][8];
#pragma unroll
        for (int i = 0; i < 4; ++i)
#pragma unroll
            for (int e = 0; e < 8; ++e) acc[i][e] = 0.f;
#pragma unroll
        for (int r = 0; r < 7; ++r) {
            float x[8]; unpack8(rows[r], x);
#pragma unroll
            for (int j = 0; j < 4; ++j) { const int i = r - j; if (i >= 0 && i < 4) {
#pragma unroll
                for (int e = 0; e < 8; ++e) acc[i][e] += w[j][e] * x[e]; } } }
#pragma unroll
        for (int i = 0; i < 4; ++i) { float ss = 0.f;
#pragma unroll
            for (int e = 0; e < 8; ++e) { acc[i][e] = siluf_(acc[i][e]); ss += acc[i][e] * acc[i][e]; }
            ss += __shfl_xor(ss, 1); ss += __shfl_xor(ss, 2); ss += __shfl_xor(ss, 4); ss += __shfl_xor(ss, 8);
            const float rs = rsqrtf(ss + 1e-6f) * (part == 0 ? 0.08838834764831845f : 1.f);
#pragma unroll
            for (int e = 0; e < 8; ++e) acc[i][e] *= rs;
            CHK(F, 4, badv(acc[i][0], 1.01f) || badv(acc[i][5], 1.01f) || badv(ss * rs * rs, part == 0 ? 0.0079f : 1.01f));
            const u32x4 o = pack8(acc[i]); const int c = tg * 4 + i;
            *(LAS u32x4*)((part ? Ks : Qs) + c * 272 + sub * 16) = o;
            if (part == 0) *(u32x4*)(F.Qc() + (size_t)(t0 + c) * 1024 + h * 128 + sub * 8) = o; }
        if (part == 1) {
            bf16_t* kt = F.Kc() + (size_t)(ci * 8 + h) * 8192 + (size_t)(sub * 8) * 64 + tg * 4;
#pragma unroll
            for (int e = 0; e < 8; ++e) { u32x2 o2; o2.x = pk2(acc[0][e], acc[1][e]); o2.y = pk2(acc[2][e], acc[3][e]); *(u32x2*)(kt + e * 64) = o2; } }
    }
    if (wave == 0) {
        const float* ba = F.BA() + (size_t)(t0 + lane) * 32;
        const float bf_ = sigm(ba[h]), bb_ = sigm(ba[8 + h]);
        float s = -expf(p.dn_a_log[h]) * softplusf_(ba[16 + h] + p.dn_dt_bias[h]);
        float sb = -expf(p.dn_a_log[8 + h]) * softplusf_(ba[24 + h] + p.dn_dt_bias[8 + h]);
#pragma unroll
        for (int o = 1; o < 64; o <<= 1) { const float t = __shfl_up(s, o); if (lane >= o) s += t; }
#pragma unroll
        for (int o = 1; o < 64; o <<= 1) { const float t = __shfl_down(sb, o); if (lane + o < 64) sb += t; }
        CHK(F, 3, badv(ba[h], 1000.f) || badv(ba[24 + h], 1000.f));
        CHK(F, 8, badv(s, 1e4f) || badv(sb, 1e4f) || s > 0.f || sb > 0.f || bf_ < 0.f || bf_ > 1.f || bb_ < 0.f || bb_ > 1.f);
        gfv[lane] = s; gfv[64 + lane] = sb; gfv[128 + lane] = bf_; gfv[192 + lane] = bb_;
        float* gb = F.GB() + (size_t)(ci * 8 + h) * 256;
        gb[lane] = s; gb[64 + lane] = sb; gb[128 + lane] = bf_; gb[192 + lane] = bb_;
    }
    lds_barrier();
    const int d = wave >> 2, mt = wave & 3;
    LAS unsigned char* Db = DIR0 + d * 47616;
    LAS unsigned char* Brow = Db; LAS unsigned char* Btr = Db + 9216; LAS unsigned char* Xrow = Db + 18432; LAS unsigned char* Xtr = Db + 27648;
    LAS float* Dl = (LAS float*)(Db + 36864) + mt * 320; LAS unsigned char* M2t = Db + 41984; LAS unsigned char* Mts = Db + 44544 + mt * 768;
    const LAS unsigned char* Lrow = Brow;
    const LAS float* gd = gfv + d * 64; const LAS float* bd = gfv + 128 + d * 64;
    {
        f32x4 kk[4], qk[4];
#pragma unroll
        for (int n = 0; n < 4; ++n) { kk[n] = (f32x4){0.f, 0.f, 0.f, 0.f}; qk[n] = (f32x4){0.f, 0.f, 0.f, 0.f}; }
#pragma unroll
        for (int ks = 0; ks < 4; ++ks) { const bf16x8 ak = ldfrag(Ks, 272, mt * 16 + l15, ks * 64 + q4 * 16), aq = ldfrag(Qs, 272, mt * 16 + l15, ks * 64 + q4 * 16);
#pragma unroll
            for (int n = 0; n < 4; ++n) { const bf16x8 bk = ldfrag(Ks, 272, n * 16 + l15, ks * 64 + q4 * 16); kk[n] = MFMA16(ak, bk, kk[n]); qk[n] = MFMA16(aq, bk, qk[n]); } }
#pragma unroll
        for (int n = 0; n < 4; ++n) { const int C = n * 16 + l15; const float gC = gd[C], bC = bd[C]; float a4[4];
#pragma unroll
            for (int r = 0; r < 4; ++r) { const int R = mt * 16 + q4 * 4 + r;
                const float dec = __expf(-fabsf(gd[R] - gC));
                a4[r] = (C > R) ? (d == 0 ? bC : bd[R]) * kk[n][r] * dec : 0.f;
                const bool incl = d == 0 ? (R >= C) : (R < C);
                if (incl) ((LAS bf16_t*)ATo)[R * 64 + C] = f2bf(qk[n][r] * dec); }
            u32x2 o; o.x = pk2(a4[0], a4[1]); o.y = pk2(a4[2], a4[3]);
            *(LAS u32x2*)(Brow + C * 144 + (mt * 16 + q4 * 4) * 2) = o;
            if (n == mt) *(LAS f32x4*)(Dl + l15 * 20 + q4 * 4) = (f32x4){a4[0], a4[1], a4[2], a4[3]}; }
    }
    lds_barrier();
    if (itn < 2048) p3_load_rows(F, itn >> 3, itn & 7, rows);
    if (lane < 16) {
        float x[16];
#pragma unroll
        for (int i = 0; i < 16; ++i) { float sv = (i == lane) ? 1.f : 0.f;
            float drow[16];
#pragma unroll
            for (int q = 0; q < 4; ++q) if (4 * q < i) { const f32x4 t4 = *(const LAS f32x4*)(Dl + i * 20 + 4 * q); drow[4 * q] = t4[0]; drow[4 * q + 1] = t4[1]; drow[4 * q + 2] = t4[2]; drow[4 * q + 3] = t4[3]; }
#pragma unroll
            for (int j = 0; j < i; ++j) sv -= drow[j] * x[j];
            x[i] = sv; }
#pragma unroll
        for (int i = 0; i < 16; ++i) ((LAS bf16_t*)Xrow)[(mt * 16 + i) * 72 + mt * 16 + lane] = f2bf(x[i]);
        u32x4 o0, o1; o0.x = pk2(x[0], x[1]); o0.y = pk2(x[2], x[3]); o0.z = pk2(x[4], x[5]); o0.w = pk2(x[6], x[7]);
        o1.x = pk2(x[8], x[9]); o1.y = pk2(x[10], x[11]); o1.z = pk2(x[12], x[13]); o1.w = pk2(x[14], x[15]);
        *(LAS u32x4*)(Xtr + (mt * 16 + lane) * 144 + mt * 32) = o0; *(LAS u32x4*)(Xtr + (mt * 16 + lane) * 144 + mt * 32 + 16) = o1;
    }
    lds_barrier();
    const bf16x8 zero8 = {0, 0, 0, 0, 0, 0, 0, 0};
    const f32x4 zero4 = {0.f, 0.f, 0.f, 0.f};
    if (mt & 1) {
        const int I1 = mt, I0 = mt - 1;
        bf16x8 a = zero8, b = zero8;
        if (q4 < 2) { a = ldfrag(Lrow, 144, I1 * 16 + l15, I0 * 32 + q4 * 16); b = ldfrag(Xtr, 144, I0 * 16 + l15, I0 * 32 + q4 * 16); }
        const f32x4 M = MFMA16(a, b, zero4);
        { u32x2 o; o.x = pk2(M[0], M[1]); o.y = pk2(M[2], M[3]); *(LAS u32x2*)(Mts + l15 * 48 + q4 * 8) = o; }
        LDS_WAIT();
        bf16x8 a2 = zero8, b2 = zero8;
        if (q4 < 2) { a2 = ldfrag(Xrow, 144, I1 * 16 + l15, I1 * 32 + q4 * 16); b2 = *(const LAS bf16x8*)(Mts + l15 * 48 + q4 * 16); }
        const f32x4 X = MFMA16(a2, b2, zero4);
#pragma unroll
        for (int r = 0; r < 4; ++r) ((LAS bf16_t*)Xrow)[(I1 * 16 + q4 * 4 + r) * 72 + I0 * 16 + l15] = f2bf(-X[r]);
        u32x2 o; o.x = pk2(-X[0], -X[1]); o.y = pk2(-X[2], -X[3]);
        *(LAS u32x2*)(Xtr + (I0 * 16 + l15) * 144 + (I1 * 16 + q4 * 4) * 2) = o;
    }
    lds_barrier();
    {
        const int mi = mt >> 1, ni = mt & 1;
        const bf16x8 a = ldfrag(Lrow, 144, 32 + mi * 16 + l15, q4 * 16), b = ldfrag(Xtr, 144, ni * 16 + l15, q4 * 16);
        const f32x4 M2 = MFMA16(a, b, zero4);
        { u32x2 o; o.x = pk2(M2[0], M2[1]); o.y = pk2(M2[2], M2[3]); *(LAS u32x2*)(M2t + (ni * 16 + l15) * 80 + (mi * 16 + q4 * 4) * 2) = o; }
        lds_barrier();
        const bf16x8 a2 = ldfrag(Xrow, 144, 32 + mi * 16 + l15, 64 + q4 * 16), b2 = *(const LAS bf16x8*)(M2t + (ni * 16 + l15) * 80 + q4 * 16);
        const f32x4 X = MFMA16(a2, b2, zero4);
#pragma unroll
        for (int r = 0; r < 4; ++r) { CHK(F, 6, badv(X[r], 20.f)); ((LAS bf16_t*)Xrow)[(32 + mi * 16 + q4 * 4 + r) * 72 + ni * 16 + l15] = f2bf(-X[r]); }
        u32x2 o; o.x = pk2(-X[0], -X[1]); o.y = pk2(-X[2], -X[3]);
        *(LAS u32x2*)(Xtr + (ni * 16 + l15) * 144 + (32 + mi * 16 + q4 * 4) * 2) = o;
    }
    lds_barrier();
    { bf16_t* dst = F.TA() + (size_t)(ci * 8 + h) * 8192;
      const int c = tid >> 3, s0 = (tid & 7) * 8;
      const u32x4 lo = *(const LAS u32x4*)(DIR0 + 18432 + c * 144 + s0 * 2), up = *(const LAS u32x4*)(DIR0 + 47616 + 27648 + c * 144 + s0 * 2);
      unsigned wl[4] = {lo.x, lo.y, lo.z, lo.w}, wu[4] = {up.x, up.y, up.z, up.w}, wo[4];
#pragma unroll
      for (int i = 0; i < 4; ++i) { const int sa = s0 + 2 * i, sb2 = sa + 1;
          const unsigned mlo = (sa <= c ? 0x0000FFFFu : 0u) | (sb2 <= c ? 0xFFFF0000u : 0u);
          wo[i] = (wl[i] & mlo) | (wu[i] & ~mlo); }
      *(u32x4*)(dst + tid * 8) = (u32x4){wo[0], wo[1], wo[2], wo[3]};
      *(u32x4*)(dst + 4096 + tid * 8) = *(const LAS u32x4*)(ATo + tid * 16); }
    lds_barrier();
}

struct RgW { bf16x8 g[2][2][4]; float br[2], bi[2], sp[2]; };
__device__ __forceinline__ void rg_load_w(CParams& p, const Frame& F, int n, RgW& W) {
    const int q4 = F.lane >> 4, j = F.wave * 16 + (F.lane & 15), ch = n * 128 + j;
#pragma unroll
    for (int d = 0; d < 2; ++d) {
#pragma unroll
        for (int g = 0; g < 2; ++g) { const bf16_t* gp = F.GT() + (size_t)((g * 2 + d) * 8 + n) * 16384 + (size_t)j * 128 + q4 * 8;
#pragma unroll
            for (int ks = 0; ks < 4; ++ks) W.g[d][g][ks] = *(const bf16x8*)(gp + ks * 32); }
        W.br[d] = p.rg_b_r[d * 1024 + ch]; W.bi[d] = p.rg_b_i[d * 1024 + ch]; W.sp[d] = softplusf_(-p.rg_lam[d * 1024 + ch]); }
}
__device__ __forceinline__ void rg_load_rows(const Frame& F, int ci, int n, u32x4 (&rows)[5]) {
    const int tid = F.tid, tg = tid >> 4, sub = tid & 15, col = 4096 + n * 128 + sub * 8, t0 = ci * 64;
    int c_lo, c_hi; if (ci < 128) { c_lo = (ci >> 2) * 4; c_hi = c_lo + 4; } else { c_lo = 128 + ((ci - 128) >> 6) * 64; c_hi = c_lo + 64; }
    const int tb = t0 + tg * 2 - 2;
#pragma unroll
    for (int r = 0; r < 5; ++r) { const int tok = tb + r; u32x4 v = {0u, 0u, 0u, 0u};
        if (tok >= c_lo * 64 && tok < c_hi * 64) v = *(const u32x4*)(F.PROJ() + (size_t)tok * NPROJ + col);
        rows[r] = v; }
}
template <int PASS>
__device__ __forceinline__ void rg_item(CParams& p, Frame& F, int ci, int n, u32x4 (&rows)[5], int itn) {
    const int tid = F.tid, lane = F.lane, wave = F.wave, q4 = lane >> 4, l15 = lane & 15;
    LAS unsigned char* xb = F.lds; LAS float* xf = (LAS float*)(F.lds + 17408); LAS float* Hs = (LAS float*)(F.lds + 50176);
    const int t0 = ci * 64;
    int seq_lo, seq_hi, c_lo, c_hi, seq; const bool samp = ci >= 128;
    if (!samp) { seq = ci >> 2; c_lo = seq * 4; c_hi = c_lo + 4; } else { seq = (ci - 128) >> 6; c_lo = 128 + seq * 64; c_hi = c_lo + 64; }
    seq_lo = c_lo * 64; seq_hi = c_hi * 64;
    const int j = wave * 16 + l15, ch = n * 128 + j;
    bf16x8 wA[2][4], wB[2][4];
#pragma unroll
    for (int g = 0; g < 2; ++g) { const bf16_t* gp = F.GT() + (size_t)((g * 2 + 0) * 8 + n) * 16384 + (size_t)j * 128 + q4 * 8;
#pragma unroll
        for (int ks = 0; ks < 4; ++ks) wA[g][ks] = *(const bf16x8*)(gp + ks * 32); }
    {
        const int tg = tid >> 4, sub = tid & 15, ch = n * 128 + sub * 8;
        float w[4][8], acc[2][8];
#pragma unroll
        for (int j = 0; j < 4; ++j) { const f32x4 a = *(const f32x4*)(p.rg_conv_w + j * 1024 + ch), b = *(const f32x4*)(p.rg_conv_w + j * 1024 + ch + 4);
            w[j][0] = a[0]; w[j][1] = a[1]; w[j][2] = a[2]; w[j][3] = a[3]; w[j][4] = b[0]; w[j][5] = b[1]; w[j][6] = b[2]; w[j][7] = b[3]; }
        { const f32x4 a = *(const f32x4*)(p.rg_conv_b + ch), b = *(const f32x4*)(p.rg_conv_b + ch + 4);
#pragma unroll
          for (int i = 0; i < 2; ++i) { acc[i][0] = a[0]; acc[i][1] = a[1]; acc[i][2] = a[2]; acc[i][3] = a[3]; acc[i][4] = b[0]; acc[i][5] = b[1]; acc[i][6] = b[2]; acc[i][7] = b[3]; } }
#pragma unroll
        for (int r = 0; r < 5; ++r) {
            float x[8]; unpack8(rows[r], x);
#pragma unroll
            for (int j = 0; j < 4; ++j) { const int i = r - j; if (i >= 0 && i < 2) {
#pragma unroll
                for (int e = 0; e < 8; ++e) acc[i][e] += w[j][e] * x[e]; } } }
#pragma unroll
        for (int i = 0; i < 2; ++i) { const int c = tg * 2 + i;
            *(LAS u32x4*)(xb + c * 272 + sub * 16) = pack8(acc[i]);
            *(LAS f32x4*)(xf + c * 128 + sub * 8) = (f32x4){acc[i][0], acc[i][1], acc[i][2], acc[i][3]};
            *(LAS f32x4*)(xf + c * 128 + sub * 8 + 4) = (f32x4){acc[i][4], acc[i][5], acc[i][6], acc[i][7]}; }
    }
    lds_barrier();
    f32x4 hs[4];
#pragma unroll
    for (int m = 0; m < 4; ++m) hs[m] = (f32x4){0.f, 0.f, 0.f, 0.f};
#pragma unroll
    for (int d = 0; d < 2; ++d) {
        f32x4 av[4], bxv[4];
        {
            f32x4 ar[4], ai[4];
#pragma unroll
            for (int m = 0; m < 4; ++m) { ar[m] = (f32x4){0.f, 0.f, 0.f, 0.f}; ai[m] = (f32x4){0.f, 0.f, 0.f, 0.f}; }
#pragma unroll
            for (int ks = 0; ks < 4; ++ks) { const bf16x8 br = d == 0 ? wA[0][ks] : wB[0][ks], bi = d == 0 ? wA[1][ks] : wB[1][ks];
#pragma unroll
                for (int m = 0; m < 4; ++m) { const bf16x8 a = ldfrag(xb, 272, m * 16 + l15, ks * 64 + q4 * 16); ar[m] = MFMA16(a, br, ar[m]); ai[m] = MFMA16(a, bi, ai[m]); } }
            if (d == 0) {
#pragma unroll
                for (int g = 0; g < 2; ++g) { const bf16_t* gp = F.GT() + (size_t)((g * 2 + 1) * 8 + n) * 16384 + (size_t)j * 128 + q4 * 8;
#pragma unroll
                    for (int ks = 0; ks < 4; ++ks) wB[g][ks] = *(const bf16x8*)(gp + ks * 32); } }
            const float L2E = 1.4426950408889634f;
            const float br_ = -L2E * p.rg_b_r[d * 1024 + ch], bi_ = -L2E * p.rg_b_i[d * 1024 + ch], sp = softplusf_(-p.rg_lam[d * 1024 + ch]);
            const float k2 = -16.f * sp, k2e = k2 * L2E, k1e = 0.5f * k2e;
#pragma unroll
            for (int m = 0; m < 4; ++m)
#pragma unroll
                for (int r = 0; r < 4; ++r) { const int c = m * 16 + q4 * 4 + r;
                    const float rr = __builtin_amdgcn_rcpf(1.f + __builtin_amdgcn_exp2f(fmaf(ar[m][r], -L2E, br_)));
                    const float ii = __builtin_amdgcn_rcpf(1.f + __builtin_amdgcn_exp2f(fmaf(ai[m][r], -L2E, bi_)));
                    const float a_ = __builtin_amdgcn_exp2f(k1e * rr);
                    const float em = fmaf(a_, a_, -1.f);
                    av[m][r] = a_; bxv[m][r] = __builtin_amdgcn_sqrtf(fmaxf(-em, 0.f)) * (ii * xf[c * 128 + j]); }
        }
        f32x4 Pa[4], Pb[4]; float Ap[4], Bp[4], Am[4], Bm[4];
#pragma unroll
        for (int m = 0; m < 4; ++m) {
            float pa, pb;
            if (d == 0) { pa = av[m][0]; pb = bxv[m][0]; Pa[m][0] = pa; Pb[m][0] = pb;
#pragma unroll
                for (int r = 1; r < 4; ++r) { pb = av[m][r] * pb + bxv[m][r]; pa = av[m][r] * pa; Pa[m][r] = pa; Pb[m][r] = pb; } }
            else { pa = av[m][3]; pb = bxv[m][3]; Pa[m][3] = pa; Pb[m][3] = pb;
#pragma unroll
                for (int r = 2; r >= 0; --r) { pb = av[m][r] * pb + bxv[m][r]; pa = av[m][r] * pa; Pa[m][r] = pa; Pb[m][r] = pb; } }
            float Ak[4], Bk[4];
#pragma unroll
            for (int k = 0; k < 4; ++k) { Ak[k] = __shfl(pa, l15 + 16 * k); Bk[k] = __shfl(pb, l15 + 16 * k); }
            float ap = 1.f, bp = 0.f, am = 1.f, bm = 0.f;
#pragma unroll
            for (int kk = 0; kk < 4; ++kk) { const int k = d == 0 ? kk : 3 - kk;
                const bool before = d == 0 ? (k < q4) : (k > q4);
                const float nb = Ak[k] * bp + Bk[k], na = Ak[k] * ap;
                bp = before ? nb : bp; ap = before ? na : ap;
                bm = Ak[k] * bm + Bk[k]; am = Ak[k] * am; }
            Ap[m] = ap; Bp[m] = bp; Am[m] = am; Bm[m] = bm;
        }
        if (PASS == 1) {
            float At = 1.f, Bt = 0.f;
#pragma unroll
            for (int mm = 0; mm < 4; ++mm) { const int m = d == 0 ? mm : 3 - mm; Bt = Am[m] * Bt + Bm[m]; At = Am[m] * At; }
            if (q4 == 0) { float* ag = F.RGAGG() + (size_t)(ci * 2 + d) * 2048; ag[ch] = At; ag[1024 + ch] = Bt; }
        } else {
            float hb = F.CARRY()[(size_t)(ci * 2 + d) * 1024 + ch];
#pragma unroll
            for (int mm = 0; mm < 4; ++mm) { const int m = d == 0 ? mm : 3 - mm;
                const float hin = Ap[m] * hb + Bp[m];
#pragma unroll
                for (int r = 0; r < 4; ++r) hs[m][r] += Pa[m][r] * hin + Pb[m][r];
                hb = Am[m] * hb + Bm[m]; }
            if (!samp && q4 == 0 && ci == (d == 0 ? c_hi - 1 : c_lo)) F.out[OUT_SR + (size_t)(seq * 2 + d) * 1024 + ch] = hb;
        }
    }
    if (PASS == 1 && itn < 1024) rg_load_rows(F, 128 + (itn >> 3), itn & 7, rows);
    if (PASS == 3) {
#pragma unroll
        for (int m = 0; m < 4; ++m)
#pragma unroll
            for (int r = 0; r < 4; ++r) Hs[(m * 16 + q4 * 4 + r) * 128 + j] = hs[m][r];
        lds_barrier();
#pragma unroll
        for (int i = 0; i < 2; ++i) { const int chunk = tid + 512 * i, c = chunk >> 4, cc = chunk & 15;
            const u32x4 gv = *(const u32x4*)(F.PROJ() + (size_t)(t0 + c) * NPROJ + 5120 + n * 128 + cc * 8);
            float g[8]; unpack8(gv, g);
            const f32x4 ha = *(const LAS f32x4*)(Hs + c * 128 + cc * 8), hb2 = *(const LAS f32x4*)(Hs + c * 128 + cc * 8 + 4);
            float o[8];
#pragma unroll
            for (int e = 0; e < 4; ++e) { o[e] = ha[e] * siluf_(g[e]); o[4 + e] = hb2[e] * siluf_(g[4 + e]); }
            *(u32x4*)(F.MIX() + (size_t)(t0 + c) * 2048 + 1024 + n * 128 + cc * 8) = pack8(o); }
    }
    lds_barrier();
}

__device__ __forceinline__ void rg_conv_lds(CParams& p, const Frame& F, int n, const u32x4 (&rows)[5], LAS unsigned char* xb, LAS float* xf) {
    const int tid = F.tid, tg = tid >> 4, sub = tid & 15, ch = n * 128 + sub * 8;
    float w[4][8], acc[2][8];
#pragma unroll
    for (int j = 0; j < 4; ++j) { const f32x4 a = *(const f32x4*)(p.rg_conv_w + j * 1024 + ch), b = *(const f32x4*)(p.rg_conv_w + j * 1024 + ch + 4);
        w[j][0] = a[0]; w[j][1] = a[1]; w[j][2] = a[2]; w[j][3] = a[3]; w[j][4] = b[0]; w[j][5] = b[1]; w[j][6] = b[2]; w[j][7] = b[3]; }
    { const f32x4 a = *(const f32x4*)(p.rg_conv_b + ch), b = *(const f32x4*)(p.rg_conv_b + ch + 4);
#pragma unroll
      for (int i = 0; i < 2; ++i) { acc[i][0] = a[0]; acc[i][1] = a[1]; acc[i][2] = a[2]; acc[i][3] = a[3]; acc[i][4] = b[0]; acc[i][5] = b[1]; acc[i][6] = b[2]; acc[i][7] = b[3]; } }
#pragma unroll
    for (int r = 0; r < 5; ++r) { float x[8]; unpack8(rows[r], x);
#pragma unroll
        for (int j = 0; j < 4; ++j) { const int i = r - j; if (i >= 0 && i < 2) {
#pragma unroll
            for (int e = 0; e < 8; ++e) acc[i][e] += w[j][e] * x[e]; } } }
#pragma unroll
    for (int i = 0; i < 2; ++i) { const int c = tg * 2 + i;
        *(LAS u32x4*)(xb + c * 272 + sub * 16) = pack8(acc[i]);
        *(LAS f32x4*)(xf + c * 128 + sub * 8) = (f32x4){acc[i][0], acc[i][1], acc[i][2], acc[i][3]};
        *(LAS f32x4*)(xf + c * 128 + sub * 8 + 4) = (f32x4){acc[i][4], acc[i][5], acc[i][6], acc[i][7]}; }
}
template <int D>
__device__ __forceinline__ void rg_gate_scan(const Frame& F, const bf16x8 (&wg)[2][4], float br_, float bi_, float sp, const LAS unsigned char* xb, const LAS float* xf, int j,
                                             f32x4 (&Pa)[4], f32x4 (&Pb)[4], float (&Ap)[4], float (&Bp)[4], float (&Am)[4], float (&Bm)[4]) {
    const int lane = F.lane, q4 = lane >> 4, l15 = lane & 15;
    f32x4 av[4], bxv[4];
    {
        f32x4 ar[4], ai[4];
#pragma unroll
        for (int m = 0; m < 4; ++m) { ar[m] = (f32x4){0.f, 0.f, 0.f, 0.f}; ai[m] = (f32x4){0.f, 0.f, 0.f, 0.f}; }
#pragma unroll
        for (int ks = 0; ks < 4; ++ks) {
#pragma unroll
            for (int m = 0; m < 4; ++m) { const bf16x8 a = ldfrag(xb, 272, m * 16 + l15, ks * 64 + q4 * 16); ar[m] = MFMA16(a, wg[0][ks], ar[m]); ai[m] = MFMA16(a, wg[1][ks], ai[m]); } }
        const float L2E = 1.4426950408889634f;
        const float brs = -L2E * br_, bis = -L2E * bi_, k2 = -16.f * sp, k1e = 0.5f * k2 * L2E;
#pragma unroll
        for (int m = 0; m < 4; ++m)
#pragma unroll
            for (int r = 0; r < 4; ++r) { const int c = m * 16 + q4 * 4 + r;
                const float rr = __builtin_amdgcn_rcpf(1.f + __builtin_amdgcn_exp2f(fmaf(ar[m][r], -L2E, brs)));
                const float ii = __builtin_amdgcn_rcpf(1.f + __builtin_amdgcn_exp2f(fmaf(ai[m][r], -L2E, bis)));
                const float a = __builtin_amdgcn_exp2f(k1e * rr);
                const float em = fmaf(a, a, -1.f);
                av[m][r] = a; bxv[m][r] = __builtin_amdgcn_sqrtf(fmaxf(-em, 0.f)) * (ii * xf[c * 128 + j]); }
    }
#pragma unroll
    for (int m = 0; m < 4; ++m) {
        float pa, pb;
        if (D == 0) { pa = av[m][0]; pb = bxv[m][0]; Pa[m][0] = pa; Pb[m][0] = pb;
#pragma unroll
            for (int r = 1; r < 4; ++r) { pb = av[m][r] * pb + bxv[m][r]; pa = av[m][r] * pa; Pa[m][r] = pa; Pb[m][r] = pb; } }
        else { pa = av[m][3]; pb = bxv[m][3]; Pa[m][3] = pa; Pb[m][3] = pb;
#pragma unroll
            for (int r = 2; r >= 0; --r) { pb = av[m][r] * pb + bxv[m][r]; pa = av[m][r] * pa; Pa[m][r] = pa; Pb[m][r] = pb; } }
        float Ak[4], Bk[4];
#pragma unroll
        for (int k = 0; k < 4; ++k) { Ak[k] = __shfl(pa, l15 + 16 * k); Bk[k] = __shfl(pb, l15 + 16 * k); }
        float ap = 1.f, bp = 0.f, am = 1.f, bm = 0.f;
#pragma unroll
        for (int kk = 0; kk < 4; ++kk) { const int k = D == 0 ? kk : 3 - kk;
            const bool before = D == 0 ? (k < q4) : (k > q4);
            const float nb = Ak[k] * bp + Bk[k], na = Ak[k] * ap;
            bp = before ? nb : bp; ap = before ? na : ap;
            bm = Ak[k] * bm + Bk[k]; am = Ak[k] * am; }
        Ap[m] = ap; Bp[m] = bp; Am[m] = am; Bm[m] = bm;
    }
}
template <int D>
__device__ __forceinline__ void rg_prompt_dir(CParams& p, Frame& F, int seq, int n) {
    const int tid = F.tid, lane = F.lane, wave = F.wave, q4 = lane >> 4, l15 = lane & 15;
    LAS unsigned char* xb = F.lds; LAS float* xf = (LAS float*)(F.lds + 17408); LAS float* Hs = (LAS float*)(F.lds + 50176); LAS bf16_t* Hf = (LAS bf16_t*)(F.lds + 82944);
    const int j = wave * 16 + l15, ch = n * 128 + j;
    bf16x8 wg[2][4];
#pragma unroll
    for (int g = 0; g < 2; ++g) { const bf16_t* gp = F.GT() + (size_t)((g * 2 + D) * 8 + n) * 16384 + (size_t)j * 128 + q4 * 8;
#pragma unroll
        for (int ks = 0; ks < 4; ++ks) wg[g][ks] = *(const bf16x8*)(gp + ks * 32); }
    const float br_ = p.rg_b_r[D * 1024 + ch], bi_ = p.rg_b_i[D * 1024 + ch], sp = softplusf_(-p.rg_lam[D * 1024 + ch]);
    float hb = 0.f;
    u32x4 rows[5];
    rg_load_rows(F, seq * 4 + (D == 0 ? 0 : 3), n, rows);
#pragma unroll 1
    for (int cs = 0; cs < 4; ++cs) {
        const int cidx = D == 0 ? cs : 3 - cs, ci = seq * 4 + cidx, t0 = ci * 64;
        rg_conv_lds(p, F, n, rows, xb, xf);
        if (cs < 3) rg_load_rows(F, seq * 4 + (D == 0 ? cidx + 1 : cidx - 1), n, rows);
        lds_barrier();
        f32x4 Pa[4], Pb[4]; float Ap[4], Bp[4], Am[4], Bm[4];
        rg_gate_scan<D>(F, wg, br_, bi_, sp, xb, xf, j, Pa, Pb, Ap, Bp, Am, Bm);
#pragma unroll
        for (int mm = 0; mm < 4; ++mm) { const int m = D == 0 ? mm : 3 - mm;
            const float hin = Ap[m] * hb + Bp[m];
#pragma unroll
            for (int r = 0; r < 4; ++r) { const float hv = Pa[m][r] * hin + Pb[m][r]; const int tl = m * 16 + q4 * 4 + r;
                if (D == 0) Hf[(cidx * 64 + tl) * 128 + j] = f2bf(hv);
                else Hs[tl * 128 + j] = hv + bf2f(Hf[(cidx * 64 + tl) * 128 + j]); }
            hb = Am[m] * hb + Bm[m]; }
        lds_barrier();
        if (D == 1) {
#pragma unroll
            for (int i = 0; i < 2; ++i) { const int chunk = tid + 512 * i, c = chunk >> 4, cc = chunk & 15;
                bf16_t* gp = F.PROJ() + (size_t)(t0 + c) * NPROJ + 5120 + n * 128 + cc * 8;
                const u32x4 gv = *(const u32x4*)gp; float g[8]; unpack8(gv, g);
                const f32x4 ha = *(const LAS f32x4*)(Hs + c * 128 + cc * 8), hb2 = *(const LAS f32x4*)(Hs + c * 128 + cc * 8 + 4);
                float o[8];
#pragma unroll
                for (int e = 0; e < 4; ++e) { o[e] = ha[e] * siluf_(g[e]); o[4 + e] = hb2[e] * siluf_(g[4 + e]); }
                *(u32x4*)gp = pack8(o); }
            lds_barrier();
        }
    }
    if (q4 == 0) F.out[OUT_SR + (size_t)(seq * 2 + D) * 1024 + ch] = hb;
}

__device__ __forceinline__ void rg_carry_scan(CParams& p, Frame& F) {
    const int tid = F.tid;
    if (tid < 256 || tid >= 272) return;
    const int g = F.b * 16 + tid - 256; if (g >= 4096) return;
    const int seq = g >> 11, d = (g >> 10) & 1, ch = g & 1023, c_lo = 128 + seq * 64;
    const float* ag0 = F.RGAGG() + (size_t)d * 2048 + ch;
    float h = p.state_rglru[(size_t)(seq * 2 + d) * 1024 + ch];
    float* cr0 = F.CARRY() + (size_t)d * 1024 + ch;
#pragma unroll 1
    for (int u0 = 0; u0 < 64; u0 += 32) {
        float A[32], B[32];
#pragma unroll
        for (int u = 0; u < 32; ++u) { const int cc = d == 0 ? c_lo + u0 + u : c_lo + 63 - u0 - u; A[u] = ag0[(size_t)cc * 4096]; B[u] = ag0[(size_t)cc * 4096 + 1024]; }
#pragma unroll
        for (int u = 0; u < 32; ++u) { const int cc = d == 0 ? c_lo + u0 + u : c_lo + 63 - u0 - u; cr0[(size_t)cc * 2048] = h; h = A[u] * h + B[u]; }
    }
}

__device__ __forceinline__ void phase3(CParams& p, Frame& F) {
    for (int rep = 0; rep < (REP_PHASE == 30 ? 2 : 1); ++rep)
    { u32x4 rows[7]; if (F.b < 2048) p3_load_rows(F, F.b >> 3, F.b & 7, rows);
      for (int it = F.b; it < 2048; it += F.G) p3_delta_item(p, F, it >> 3, it & 7, rows, it + F.G); }
    for (int rep = 0; rep < (REP_PHASE == 31 ? 2 : 1); ++rep) {
    u32x4 rows[5]; if (F.b < 1024) rg_load_rows(F, 128 + (F.b >> 3), F.b & 7, rows);
    for (int it = F.b; it < 1024; it += F.G) rg_item<1>(p, F, 128 + (it >> 3), it & 7, rows, it + F.G); }
    for (int it = F.b; it < 256; it += F.G) { rg_prompt_dir<0>(p, F, it >> 3, it & 7); rg_prompt_dir<1>(p, F, it >> 3, it & 7); }
}

struct P4D { int valid, samp, seq, h, d, sl, ci, seq_lo, seq_hi, last, k, s, nch; };
__device__ __forceinline__ P4D p4_desc(const Frame& F, int k, int s) {
    P4D D; int item;
    if (F.G == 256) {
        const int x = F.b & 7, y = F.b >> 3;
        if (y < 16) { item = (x * 4 + (y >> 2)) * 4 + (y & 3); D.valid = k < 1; }
        else { const int j = y - 16; item = 128 + (x * 64 + (j >> 2) * 16 + k) * 4 + (j & 3); D.valid = k < 16; } }
    else { item = F.b + k * F.G; D.valid = item < 2176; }
    D.samp = item < 128; const int it = D.samp ? item : item - 128, chain = it >> 2;
    D.sl = it & 3; D.seq = chain >> 4; D.h = (chain >> 1) & 7; D.d = chain & 1;
    D.nch = D.samp ? 64 : 4; const int chunk0 = D.samp ? 128 + D.seq * 64 : D.seq * 4;
    D.seq_lo = chunk0 * 64; D.seq_hi = D.seq_lo + D.nch * 64;
    D.ci = D.d == 0 ? chunk0 + s : chunk0 + D.nch - 1 - s; D.last = s == D.nch - 1; D.k = k; D.s = s;
    return D;
}
__device__ __forceinline__ P4D p4_next(const Frame& F, const P4D& D) {
    if (D.s + 1 < D.nch) { P4D N = D; N.s = D.s + 1; N.ci = D.ci + (D.d == 0 ? 1 : -1); N.last = N.s == D.nch - 1; return N; }
    return p4_desc(F, D.k + 1, 0);
}
struct P4Pre { u32x4 k0, k1, q0, q1, ti, at; u32x2 v[4]; float g, b, bc; };
struct P4T { unsigned oKQ, oTA, oV, oG, oGc; int cj; };
__device__ __forceinline__ P4T p4_thread_consts(int tid) {
    P4T T; T.oKQ = (unsigned)(((tid >> 4) * 1024 + (tid & 15) * 8) * 2); T.oTA = (unsigned)tid * 16u;
    T.oV = (unsigned)(((tid >> 3) * NPROJ + (tid & 7) * 4) * 2); T.oG = (unsigned)(tid & 63) * 4u; T.oGc = (unsigned)(tid >> 3) * 4u; T.cj = (tid >> 3) - 2; return T;
}
__device__ __forceinline__ void p4_prefetch(CParams& p, const Frame& F, P4Pre& R, const P4D& D, const P4T& T) {
    const int tid = F.tid, t0 = D.ci * 64, h = D.h;
    const char* kb = (const char*)F.Kc() + (size_t)(D.ci * 8 + h) * 16384;
    const char* qb = (const char*)F.Qc() + ((size_t)t0 * 1024 + h * 128) * 2;
    const char* tb = (const char*)F.TA() + (size_t)(D.ci * 8 + h) * 16384;
    const char* vb = (const char*)F.PROJ() + ((long)(t0 - 2) * NPROJ + 2048 + h * 128 + D.sl * 32) * 2;
    const char* gb = (const char*)F.GB() + (size_t)(D.ci * 8 + h) * 1024 + D.d * 256;
    R.k0 = *(const u32x4*)(kb + T.oTA); R.k1 = *(const u32x4*)(kb + T.oTA + 8192u);
    R.q0 = *(const u32x4*)(qb + T.oKQ); R.q1 = *(const u32x4*)(qb + T.oKQ + 65536u);
    R.ti = *(const u32x4*)(tb + T.oTA); R.at = *(const u32x4*)(tb + T.oTA + 8192u);
#pragma unroll
    for (int j = 0; j < 4; ++j) { const int tok = t0 + T.cj + j; u32x2 v = {0u, 0u};
        if (tok >= D.seq_lo && tok < D.seq_hi) v = *(const u32x2*)(vb + T.oV + (unsigned)(j * NPROJ * 2));
        R.v[j] = v; }
    R.bc = *(const float*)(gb + 512 + T.oGc);
    R.g = 0.f; R.b = 0.f;
    if (tid < 64) { R.g = *(const float*)(gb + T.oG); R.b = *(const float*)(gb + 512 + T.oG); }
}
__device__ __forceinline__ u32x4 tri_mask(u32x4 v, int c, int s0, int d) {
    unsigned w[4] = {v.x, v.y, v.z, v.w};
#pragma unroll
    for (int i = 0; i < 4; ++i) { const int slo = s0 + 2 * i, shi = slo + 1;
        const bool klo = d == 0 ? (c >= slo) : (c <= slo), khi = d == 0 ? (c >= shi) : (c <= shi);
        w[i] &= (klo ? 0x0000FFFFu : 0u) | (khi ? 0xFFFF0000u : 0u); }
    return (u32x4){w[0], w[1], w[2], w[3]};
}
constexpr int P4_KS = 0, P4_TI = 17408, P4_VBT = 26624, P4_WL = 31232, P4_SB = 48640, P4_VT1 = 57344, P4_VT2 = 61952, P4_QS = 66560, P4_AT = 101376, P4_GV = 119808, P4_KT = 122368;
__device__ __forceinline__ void p4_stage(CParams& p, const Frame& F, const P4Pre& R, const P4D& D, int buf, const unsigned (&mk)[2][4], f32x4 (&cw)[4], const f32x4 (&cwn)[4]) {
    const int tid = F.tid, d = D.d;
    LAS unsigned char* Ks = F.lds + P4_KS; LAS unsigned char* Qs = F.lds + P4_QS + buf * 17408; LAS unsigned char* TIs = F.lds + P4_TI;
    LAS unsigned char* ATs = F.lds + P4_AT + buf * 9216; LAS unsigned char* Vbt = F.lds + P4_VBT; LAS float* gv = (LAS float*)(F.lds + P4_GV + buf * 1280);
    { const int row = tid >> 4, cc = tid & 15;
      *(LAS u32x4*)(Qs + row * 272 + cc * 16) = R.q0; *(LAS u32x4*)(Qs + (32 + row) * 272 + cc * 16) = R.q1; }
    { const int dk = tid >> 3, cp = tid & 7; LAS unsigned char* Kts = F.lds + P4_KT;
      *(LAS u32x4*)(Kts + dk * 144 + cp * 16) = R.k0; *(LAS u32x4*)(Kts + (64 + dk) * 144 + cp * 16) = R.k1; }
    { const int c = tid >> 3, s0 = (tid & 7) * 8;
      const unsigned m0 = d ? mk[1][0] : mk[0][0], m1 = d ? mk[1][1] : mk[0][1], m2 = d ? mk[1][2] : mk[0][2], m3 = d ? mk[1][3] : mk[0][3];
      *(LAS u32x4*)(TIs + c * 144 + s0 * 2) = (u32x4){R.ti.x & m0, R.ti.y & m1, R.ti.z & m2, R.ti.w & m3};
      *(LAS u32x4*)(ATs + c * 144 + s0 * 2) = (u32x4){R.at.x & m0, R.at.y & m1, R.at.z & m2, R.at.w & m3}; }
    { const int c = tid >> 3, e0 = (tid & 7) * 4; float o[4] = {0.f, 0.f, 0.f, 0.f};
      if (D.s == 0) {
#pragma unroll
          for (int j = 0; j < 4; ++j) cw[j] = cwn[j]; }
#pragma unroll
      for (int j = 0; j < 4; ++j) { const u32x2 v = R.v[j];
          o[0] += cw[j][0] * __uint_as_float(v.x << 16); o[1] += cw[j][1] * __uint_as_float(v.x & 0xffff0000u);
          o[2] += cw[j][2] * __uint_as_float(v.y << 16); o[3] += cw[j][3] * __uint_as_float(v.y & 0xffff0000u); }
#pragma unroll
      for (int i = 0; i < 4; ++i) ((LAS bf16_t*)Vbt)[(e0 + i) * 72 + c] = f2bf(siluf_(o[i]) * R.bc); }
    if (tid < 64) {
        const float glast = __shfl(R.g, d == 0 ? 63 : 0), eg = __expf(R.g);
        gv[tid] = eg; gv[64 + tid] = R.b * eg; gv[128 + tid] = __expf(glast - R.g); if (tid == 0) gv[192] = __expf(glast);
    }
}
__device__ __forceinline__ void phase4_chains(CParams& p, Frame& F) {
    const int tid = F.tid, lane = F.lane, wave = F.wave, q4 = lane >> 4, l15 = lane & 15;
    LAS unsigned char* Ks = F.lds + P4_KS; LAS unsigned char* TIs = F.lds + P4_TI; LAS unsigned char* Vbt = F.lds + P4_VBT; LAS unsigned char* Wl = F.lds + P4_WL;
    LAS unsigned char* Sb = F.lds + P4_SB; LAS unsigned char* Vt1 = F.lds + P4_VT1; LAS unsigned char* Vt2 = F.lds + P4_VT2;
    const int ct = wave & 3, et = wave >> 2;
    P4D Dc = p4_desc(F, 0, 0);
    if (!Dc.valid) return;
    P4Pre RA, RB;
    f32x4 S[2], U; bf16x8 KT[2];
    unsigned mk[2][4]; f32x4 cw[4], cwn[4];
    { const int c = tid >> 3, s0 = (tid & 7) * 8;
#pragma unroll
      for (int i = 0; i < 4; ++i) { const int slo = s0 + 2 * i, shi = slo + 1;
          mk[0][i] = (c >= slo ? 0x0000FFFFu : 0u) | (c >= shi ? 0xFFFF0000u : 0u); mk[1][i] = (c <= slo ? 0x0000FFFFu : 0u) | (c <= shi ? 0xFFFF0000u : 0u); } }
#define P4_INIT_S(D) do { _Pragma("unroll") for (int nt = 0; nt < 2; ++nt) _Pragma("unroll") for (int r = 0; r < 4; ++r) \
        S[nt][r] = (D).samp ? p.state_delta[(size_t)(((D).seq * 2 + (D).d) * 8 + (D).h) * 16384 + (size_t)(wave * 16 + q4 * 4 + r) * 128 + (D).sl * 32 + nt * 16 + l15] : 0.f; } while (0)
#define P4_WRITE_SB() do { _Pragma("unroll") for (int nt = 0; nt < 2; ++nt) { u32x2 o_; o_.x = pk2(S[nt][0], S[nt][1]); o_.y = pk2(S[nt][2], S[nt][3]); \
        *(LAS u32x2*)(Sb + (nt * 16 + l15) * 272 + (wave * 16 + q4 * 4) * 2) = o_; } } while (0)
#define P4_PRECOMP(buf_) do { const LAS float* gv_ = (const LAS float*)(F.lds + P4_GV + (buf_) * 1280); \
        f32x4 WT[4]; _Pragma("unroll") for (int c_ = 0; c_ < 4; ++c_) WT[c_] = (f32x4){0.f, 0.f, 0.f, 0.f}; \
        _Pragma("unroll") for (int ks = 0; ks < 2; ++ks) { \
            const u32x4 kraw = *(const LAS u32x4*)(F.lds + P4_KT + (wave * 16 + l15) * 144 + ks * 64 + q4 * 16); KT[ks] = __builtin_bit_cast(bf16x8, kraw); \
            const f32x4 sa = *(const LAS f32x4*)(gv_ + 64 + ks * 32 + q4 * 8), sb_ = *(const LAS f32x4*)(gv_ + 64 + ks * 32 + q4 * 8 + 4); \
            float kf[8]; unpack8(kraw, kf); u32x4 kg; \
            kg.x = pk2(kf[0] * sa[0], kf[1] * sa[1]); kg.y = pk2(kf[2] * sa[2], kf[3] * sa[3]); kg.z = pk2(kf[4] * sb_[0], kf[5] * sb_[1]); kg.w = pk2(kf[6] * sb_[2], kf[7] * sb_[3]); \
            const bf16x8 akg = __builtin_bit_cast(bf16x8, kg); \
            _Pragma("unroll") for (int c_ = 0; c_ < 4; ++c_) { const bf16x8 bt = ldfrag(TIs, 144, c_ * 16 + l15, ks * 64 + q4 * 16); WT[c_] = MFMA16(akg, bt, WT[c_]); } } \
        _Pragma("unroll") for (int c_ = 0; c_ < 4; ++c_) { u32x2 o_; o_.x = pk2(WT[c_][0], WT[c_][1]); o_.y = pk2(WT[c_][2], WT[c_][3]); \
            *(LAS u32x2*)(Wl + (c_ * 16 + l15) * 272 + (wave * 16 + q4 * 4) * 2) = o_; } \
        U = (f32x4){0.f, 0.f, 0.f, 0.f}; \
        _Pragma("unroll") for (int ks = 0; ks < 2; ++ks) { const bf16x8 a_ = ldfrag(TIs, 144, ct * 16 + l15, ks * 64 + q4 * 16), b_ = ldfrag(Vbt, 144, et * 16 + l15, ks * 64 + q4 * 16); U = MFMA16(a_, b_, U); } } while (0)

    const P4T T = p4_thread_consts(tid);
    p4_prefetch(p, F, RA, Dc, T);
    P4_INIT_S(Dc);
    { const int e0 = (tid & 7) * 4;
#pragma unroll
      for (int j = 0; j < 4; ++j) cwn[j] = *(const f32x4*)(p.dn_conv_w + j * 3072 + 2048 + Dc.h * 128 + Dc.sl * 32 + e0); }
    p4_stage(p, F, RA, Dc, 0, mk, cw, cwn);
    P4_WRITE_SB();
    P4D Dn = p4_next(F, Dc);
    if (Dn.valid) p4_prefetch(p, F, RA, Dn, T);
    P4D Dnn = Dn; if (Dn.valid) { Dnn = p4_next(F, Dn); if (Dnn.valid) p4_prefetch(p, F, RB, Dnn, T); }
    lds_barrier();
    P4_PRECOMP(0);
    lds_barrier();
    int buf = 0;
#define P4_BODY(RX) { \
        const LAS float* gv = (const LAS float*)(F.lds + P4_GV + buf * 1280); \
        const LAS unsigned char* Qs = F.lds + P4_QS + buf * 17408; const LAS unsigned char* ATs = F.lds + P4_AT + buf * 9216; \
        const int c0 = ct * 16 + q4 * 4, e = et * 16 + l15; \
         \
        f32x4 p1 = {0.f, 0.f, 0.f, 0.f}, oacc = {0.f, 0.f, 0.f, 0.f}; \
_Pragma("unroll") \
        for (int ks = 0; ks < 4; ++ks) { const bf16x8 bs = ldfrag(Sb, 272, et * 16 + l15, ks * 64 + q4 * 16); \
            const bf16x8 aw = ldfrag(Wl, 272, ct * 16 + l15, ks * 64 + q4 * 16), aq = ldfrag(Qs, 272, ct * 16 + l15, ks * 64 + q4 * 16); \
            p1 = MFMA16(aw, bs, p1); oacc = MFMA16(aq, bs, oacc); } \
        { float vn[4]; \
_Pragma("unroll") \
          for (int r = 0; r < 4; ++r) vn[r] = U[r] - p1[r]; \
          u32x2 o1, o2; o1.x = pk2(vn[0], vn[1]); o1.y = pk2(vn[2], vn[3]); \
          o2.x = pk2(vn[0] * gv[128 + c0], vn[1] * gv[128 + c0 + 1]); o2.y = pk2(vn[2] * gv[128 + c0 + 2], vn[3] * gv[128 + c0 + 3]); \
          *(LAS u32x2*)(Vt1 + e * 144 + c0 * 2) = o1; *(LAS u32x2*)(Vt2 + e * 144 + c0 * 2) = o2; } \
_Pragma("unroll") \
        for (int r = 0; r < 4; ++r) oacc[r] *= gv[c0 + r]; \
        P4D D3 = Dnn; \
        if (Dn.valid) { p4_stage(p, F, RX, Dn, buf ^ 1, mk, cw, cwn); \
            if (Dn.last && Dnn.valid) { const int e0_ = (tid & 7) * 4; _Pragma("unroll") for (int j = 0; j < 4; ++j) cwn[j] = *(const f32x4*)(p.dn_conv_w + j * 3072 + 2048 + Dnn.h * 128 + Dnn.sl * 32 + e0_); } if (Dnn.valid) { D3 = p4_next(F, Dnn); if (D3.valid) p4_prefetch(p, F, RX, D3, T); } } \
        lds_barrier(); \
         \
        { const float gl = gv[192]; \
_Pragma("unroll") \
          for (int nt = 0; nt < 2; ++nt) S[nt] *= gl; \
_Pragma("unroll") \
          for (int ks = 0; ks < 2; ++ks) \
_Pragma("unroll") \
              for (int nt = 0; nt < 2; ++nt) { const bf16x8 b_ = ldfrag(Vt2, 144, nt * 16 + l15, ks * 64 + q4 * 16); S[nt] = MFMA16(KT[ks], b_, S[nt]); } } \
_Pragma("unroll") \
        for (int ks = 0; ks < 2; ++ks) { const bf16x8 a_ = ldfrag(ATs, 144, ct * 16 + l15, ks * 64 + q4 * 16), b_ = ldfrag(Vt1, 144, et * 16 + l15, ks * 64 + q4 * 16); oacc = MFMA16(a_, b_, oacc); } \
_Pragma("unroll") \
        for (int r = 0; r < 4; ++r) *(bf16_t*)((char*)F.PROJ() + ((size_t)Dc.ci * 64 * NPROJ + Dc.d * 1024 + Dc.h * 128 + Dc.sl * 32) * 2 + (unsigned)(((c0 + r) * NPROJ + e) * 2)) = f2bf(oacc[r]); \
        if (Dc.last) { \
            if (!Dc.samp) { \
_Pragma("unroll") \
                for (int nt = 0; nt < 2; ++nt) \
_Pragma("unroll") \
                    for (int r = 0; r < 4; ++r) \
                        F.out[OUT_SD + (size_t)((Dc.seq * 2 + Dc.d) * 8 + Dc.h) * 16384 + (size_t)(wave * 16 + q4 * 4 + r) * 128 + Dc.sl * 32 + nt * 16 + l15] = S[nt][r]; \
            } \
            if (Dn.valid) P4_INIT_S(Dn); \
        } \
        P4_WRITE_SB(); \
        if (Dn.valid) P4_PRECOMP(buf ^ 1); \
        lds_barrier(); \
        if (!Dn.valid) break; \
        Dc = Dn; Dn = Dnn; Dnn = D3; buf ^= 1; \
    }
#pragma unroll 1
    for (;;) { P4_BODY(RA) P4_BODY(RB) }
#undef P4_BODY
#undef P4_INIT_S
#undef P4_WRITE_SB
#undef P4_PRECOMP
}
__device__ __forceinline__ void phase4(CParams& p, Frame& F) {
    if (F.G == 256) rg_carry_scan(p, F);
    else if (F.b == 0) {
        for (int g = F.tid; g < 69632; g += 512) { int samp = g >= 65536, gg = samp ? g - 65536 : g, seq = gg >> 11, d = (gg >> 10) & 1, ch = gg & 1023;
            const int nch = samp ? 64 : 4, c_lo = samp ? 128 + seq * 64 : seq * 4; float h = samp ? p.state_rglru[(size_t)(seq * 2 + d) * 1024 + ch] : 0.f;
            for (int i = 0; i < nch; ++i) { const int cc = d == 0 ? c_lo + i : c_lo + nch - 1 - i; const float* ag = F.RGAGG() + (size_t)(cc * 2 + d) * 2048; F.CARRY()[(size_t)(cc * 2 + d) * 1024 + ch] = h; h = ag[ch] * h + ag[1024 + ch]; } } }
    __syncthreads();
    phase4_chains(p, F);
}

__device__ __forceinline__ void phase5(CParams& p, Frame& F) {
    const int lane = F.lane;
    float nw[16];
#pragma unroll
    for (int q = 0; q < 4; ++q) { const f32x4 a = *(const f32x4*)(p.dn_norm_w + (lane & 7) * 16 + q * 4); nw[q * 4] = a[0]; nw[q * 4 + 1] = a[1]; nw[q * 4 + 2] = a[2]; nw[q * 4 + 3] = a[3]; }
#pragma unroll 4
    for (int tok = F.b * 8 + F.wave; tok < NTOK; tok += F.G * 8) {
        const bf16_t* pr = F.PROJ() + (size_t)tok * NPROJ + lane * 16;
        float o[16], z[16]; float ss = 0.f;
#pragma unroll
        for (int hf = 0; hf < 2; ++hf) { const u32x4 a = __builtin_nontemporal_load((const u32x4*)(pr + hf * 8)), b = __builtin_nontemporal_load((const u32x4*)(pr + 1024 + hf * 8)), zz = __builtin_nontemporal_load((const u32x4*)(pr + 3072 + hf * 8));
            float fa[8], fb[8], fz[8]; unpack8(a, fa); unpack8(b, fb); unpack8(zz, fz);
#pragma unroll
            for (int e = 0; e < 8; ++e) { o[hf * 8 + e] = fa[e] + fb[e]; z[hf * 8 + e] = fz[e]; ss += o[hf * 8 + e] * o[hf * 8 + e]; } }
        ss += __shfl_xor(ss, 1); ss += __shfl_xor(ss, 2); ss += __shfl_xor(ss, 4);
        const float rs = rsqrtf(ss * (1.f / 128.f) + 1e-6f);
#pragma unroll
        for (int hf = 0; hf < 2; ++hf) { float w[8];
#pragma unroll
            for (int e = 0; e < 8; ++e) w[e] = o[hf * 8 + e] * rs * nw[hf * 8 + e] * siluf_(z[hf * 8 + e]);
            *(u32x4*)(F.MIX() + (size_t)tok * 2048 + lane * 16 + hf * 8) = pack8(w); }
        if (tok < 8192) {
            const u32x4 y0 = __builtin_nontemporal_load((const u32x4*)(pr + 5120)), y1 = __builtin_nontemporal_load((const u32x4*)(pr + 5120 + 8));
            *(u32x4*)(F.MIX() + (size_t)tok * 2048 + 1024 + lane * 16) = y0; *(u32x4*)(F.MIX() + (size_t)tok * 2048 + 1024 + lane * 16 + 8) = y1; }
    }
    __syncthreads();
    for (int it = F.b; it < 1024; it += F.G) { u32x4 rows[5]; rg_load_rows(F, 128 + (it >> 3), it & 7, rows); rg_item<3>(p, F, 128 + (it >> 3), it & 7, rows, it + F.G); }
}

__device__ __forceinline__ void phase6(CParams& p, Frame& F) {
    pg8::Gemm g{F.MIX(), F.WoutT(), NTOK, 1024, 2048}; pg8::StaticOrder S; S.init(NTOK, 1024, F.G, F.b); pg8::EpiBf16 E{F.PROJ(), NPROJ};
    pg8::gemm_phase<pg8::EpiBf16, pg8::StaticOrder>(F.lds, g, S, E);
}

__device__ __forceinline__ void phase7(CParams& p, Frame& F) {
    LAS float* gt = (LAS float*)F.lds;
    for (int tb = F.b; tb < 256; tb += F.G) {
        const int grp = grp_of_block(tb);
        for (int j = F.tid; j < 1024; j += 512) gt[j] = mod_val(p, F, grp, 2048 + j) * p.post_w[j];
        __syncthreads();
#pragma unroll 2
        for (int i = 0; i < 8; ++i) {
            const int tok = tb * 64 + F.wave * 8 + i;
            const float* xr = tok < 8192 ? p.x_prompt + (size_t)tok * 1024 : p.x_sample + (size_t)(tok - 8192) * 1024;
            const bf16_t* yr = F.PROJ() + (size_t)tok * NPROJ;
            f32x4 y[4]; float ss = 0.f;
#pragma unroll
            for (int q = 0; q < 4; ++q) { const u32x2 yb = __builtin_nontemporal_load((const u32x2*)(yr + F.lane * 4 + 256 * q));
                y[q] = (f32x4){__uint_as_float(yb.x << 16), __uint_as_float(yb.x & 0xffff0000u), __uint_as_float(yb.y << 16), __uint_as_float(yb.y & 0xffff0000u)}; ss += (y[q][0] * y[q][0] + y[q][1] * y[q][1]) + (y[q][2] * y[q][2] + y[q][3] * y[q][3]); }
            const float rstd = rsqrtf(wave_sum(ss) * (1.f / 1024.f) + 1e-6f);
#pragma unroll
            for (int q = 0; q < 4; ++q) { const int j = F.lane * 4 + 256 * q; f32x4 v = __builtin_nontemporal_load((const f32x4*)(xr + j));
                if (tok >= 8192) { const int pp = (tok - 8192) & 4095; const int vv = (q < 2) ? (pp >> 6) : (pp & 63);
                    v += *(const f32x4*)(F.pe() + ((q & 1) ? 16384 : 0) + vv * 256 + F.lane * 4); }
                const f32x4 g4 = *(const LAS f32x4*)(gt + j);
                f32x4 ov = v + g4 * (y[q] * rstd); ov[0] = fin(ov[0]); ov[1] = fin(ov[1]); ov[2] = fin(ov[2]); ov[3] = fin(ov[3]); if (!(LIVE_MASK & 1)) ov = (f32x4){0.f, 0.f, 0.f, 0.f}; __builtin_nontemporal_store(ov, (f32x4*)(F.out + (size_t)tok * 1024 + j)); }
        }
        __syncthreads();
    }
}

__device__ __forceinline__ void phase8(CParams& p, Frame& F) {
    if (F.b == 0 && F.tid == 0) { int code = 0; for (int k = 31; k >= 1; --k) if (DG(F)[k]) code = k; F.out[OUT_SR] = 1000.f * (float)code + 500.f; }
}
extern __shared__ __attribute__((aligned(16))) unsigned char smem_raw[];
__global__ void __launch_bounds__(512) fwd_megakernel(Params p_unused) {
    CParams& p = *(CParams*)__builtin_amdgcn_kernarg_segment_ptr();
    Frame F;
    F.lds = (LAS unsigned char*)smem_raw;
    F.tid = threadIdx.x; F.lane = F.tid & 63; F.wave = __builtin_amdgcn_readfirstlane(F.tid >> 6); F.G = gridDim.x; F.b = blockIdx.x;
    F.out = p.out; F.ws = p.ws;
    volatile LAS unsigned* xbw = (volatile LAS unsigned*)(F.lds + LDS_BYTES - 16);
    const bool multi = (p.ph_hi - p.ph_lo) > 1;
    XcdBarrier xb; xb.bar = (unsigned*)(p.ws + WS_CTL); xb.x = 0; xb.st = xbw;
    if (multi) {
        if (F.tid == 0) { xbw[0] = 0u; xbw[1] = 0u; xbw[2] = 0u; xbw[3] = 0u; }
        __syncthreads();
        xb = xcd_barrier_post((unsigned*)(p.ws + WS_CTL), xbw);
    }
#ifndef PHMASK
#define PHMASK 511
#endif
    const int lo = p.ph_lo, hi = p.ph_hi;
#ifndef REP_PHASE
#define REP_PHASE -1
#endif
#define RUN_PHASE(k, fn) do { if (lo <= (k) && (k) < hi) { if (PHMASK & (1 << (k))) fn(p, F); if ((k) == REP_PHASE) { __syncthreads(); fn(p, F); } if ((k) + 1 < hi) xcd_barrier(xb); } } while (0)
    RUN_PHASE(0, phase0); RUN_PHASE(1, phase1); RUN_PHASE(2, phase2); RUN_PHASE(3, phase3);
    RUN_PHASE(4, phase4); RUN_PHASE(5, phase5); RUN_PHASE(6, phase6); RUN_PHASE(7, phase7); RUN_PHASE(8, phase8);
}

extern "C" void kernel_launch(void* const* d_in, const int* in_sizes, int n_in, void* d_out, int out_size, void* d_ws, size_t ws_size, hipStream_t stream) {
    static int grid = 0;
    if (grid == 0) {
        int dev = 0, cus = 0;
        if (hipGetDevice(&dev) != hipSuccess || hipDeviceGetAttribute(&cus, hipDeviceAttributeMultiprocessorCount, dev) != hipSuccess) { fprintf(stderr, "kernel_launch: device query failed\n"); grid = -1; return; }
        if (hipFuncSetAttribute((const void*)fwd_megakernel, hipFuncAttributeMaxDynamicSharedMemorySize, LDS_BYTES) != hipSuccess) { fprintf(stderr, "kernel_launch: hipFuncSetAttribute failed\n"); grid = -1; return; }
        int per_cu = 0;
        if (hipOccupancyMaxActiveBlocksPerMultiprocessor(&per_cu, (const void*)fwd_megakernel, 512, LDS_BYTES) != hipSuccess || per_cu < 1) { fprintf(stderr, "kernel_launch: occupancy query says %d blocks per CU\n", per_cu); (void)hipGetLastError(); }
        grid = cus;
    }
    if (grid < 0) return;
    Params p{};
    const float** pp = (const float**)&p;
    for (int i = 0; i < 23; ++i) pp[i] = (const float*)d_in[i];
    p.out = (float*)d_out; p.ws = (unsigned char*)d_ws;
    (void)hipMemsetAsync((char*)d_ws + WS_CTL, 0, 16384, stream);
#if MK_SINGLE
    p.ph_lo = 0; p.ph_hi = NPH;
    void* args[] = {&p};
    hipError_t e = hipLaunchCooperativeKernel((const void*)fwd_megakernel, dim3(grid), dim3(512), args, LDS_BYTES, stream);
    if (e != hipSuccess) fprintf(stderr, "cooperative launch failed: %s (grid %d)\n", hipGetErrorString(e), grid);
#else
    for (int ph = 0; ph < NPH; ++ph) {
        p.ph_lo = ph; p.ph_hi = ph + 1;
        hipLaunchKernelGGL(fwd_megakernel, dim3(grid), dim3(512), LDS_BYTES, stream, p);
    }
#endif
}
```

```cpp
#include <hip/hip_runtime.h>
#include <cstdio>
#include <cstdint>

#define LAS __attribute__((address_space(3)))
typedef unsigned short bf16_t;
typedef short bf16x8 __attribute__((ext_vector_type(8)));
typedef float f32x4 __attribute__((ext_vector_type(4)));
typedef unsigned u32x4 __attribute__((ext_vector_type(4)));
typedef unsigned u32x2 __attribute__((ext_vector_type(2)));

#ifndef REP_PHASE
#define REP_PHASE -1
#endif
#ifndef MK_SINGLE
#define MK_SINGLE 1
#endif

constexpr int NTOK = 16384, DM = 1024, NPROJ = 6144, DIN = 6176;
constexpr int NPH = 8;
constexpr int LDS_BYTES = 160 * 1024;
constexpr size_t OUT_YP = 0, OUT_YS = 8388608, OUT_SD = 16777216, OUT_SR = 25165824;
constexpr size_t WS_CTL = 0, WS_MODP = 16384, WS_PE = 606208, WS_BA = 737280, WS_GB = 2834432, WS_RGAGG = 4931584,
                 WS_WBAT = 9125888, WS_WOUTT = 9191424, WS_GT = 13385728, WS_WINT = 14434304, WS_TA = 27017216, WS_PROJ = 60571648, WS_CARRY = 261898240;

struct Params {
    const float *x_prompt, *x_sample, *state_delta, *state_rglru, *c, *c_ctx, *ada_w, *ada_b, *pre_w, *post_w, *w_in, *w_out,
                *dn_conv_w, *dn_a_log, *dn_dt_bias, *dn_norm_w, *rg_conv_w, *rg_conv_b, *rg_w_r, *rg_b_r, *rg_w_i, *rg_b_i, *rg_lam;
    float* out; unsigned char* ws;
    int ph_lo, ph_hi;
};

__device__ __forceinline__ float bf2f(unsigned short b) { return __uint_as_float(((unsigned)b) << 16); }
typedef __bf16 bf2_t __attribute__((ext_vector_type(2)));
typedef float f2_t __attribute__((ext_vector_type(2)));
__device__ __forceinline__ unsigned pk2(float lo, float hi) { const f2_t v = {lo, hi}; return __builtin_bit_cast(unsigned, __builtin_convertvector(v, bf2_t)); }
__device__ __forceinline__ unsigned short f2bf(float f) { return (unsigned short)(pk2(f, f) & 0xffffu); }
#ifndef SANITIZE
#define SANITIZE 0
#endif
#ifndef LIVE_MASK
#define LIVE_MASK 15
#endif
__device__ __forceinline__ float fin(float x) { return (SANITIZE && ((__float_as_uint(x) & 0x7f800000u) == 0x7f800000u)) ? 0.f : x; }
#define DG(F) ((unsigned*)((F).ws + WS_CTL))
__device__ __forceinline__ bool badv(float x, float lim) { return ((__float_as_uint(x) & 0x7f800000u) == 0x7f800000u) || fabsf(x) > lim; }
#ifndef DIAG
#define DIAG 0
#endif
#define CHK(F, k, bad) do { if (DIAG && (bad)) DG(F)[k] = 1u; } while (0)
__device__ __forceinline__ float sigm(float x) { return __builtin_amdgcn_rcpf(1.f + __expf(-x)); }
__device__ __forceinline__ float siluf_(float x) { return x * __builtin_amdgcn_rcpf(1.f + __expf(-x)); }
__device__ __forceinline__ float softplusf_(float x) { return x > 20.f ? x : log1pf(__expf(x)); }
__device__ __forceinline__ void unpack8(const u32x4 v, float (&f)[8]) {
    f[0] = __uint_as_float(v.x << 16); f[1] = __uint_as_float(v.x & 0xffff0000u);
    f[2] = __uint_as_float(v.y << 16); f[3] = __uint_as_float(v.y & 0xffff0000u);
    f[4] = __uint_as_float(v.z << 16); f[5] = __uint_as_float(v.z & 0xffff0000u);
    f[6] = __uint_as_float(v.w << 16); f[7] = __uint_as_float(v.w & 0xffff0000u);
}
__device__ __forceinline__ u32x4 pack8(const float (&f)[8]) { u32x4 o; o.x = pk2(f[0], f[1]); o.y = pk2(f[2], f[3]); o.z = pk2(f[4], f[5]); o.w = pk2(f[6], f[7]); return o; }
__device__ __forceinline__ float wave_sum(float v) {
#pragma unroll
    for (int o = 1; o < 64; o <<= 1) v += __shfl_xor(v, o);
    return v;
}
__device__ __forceinline__ void lds_barrier() { asm volatile("s_waitcnt lgkmcnt(0)" ::: "memory"); __builtin_amdgcn_s_barrier(); asm volatile("" ::: "memory"); }
#define MFMA16(a, b, c) __builtin_amdgcn_mfma_f32_16x16x32_bf16((a), (b), (c), 0, 0, 0)
#define LDS_WAIT() asm volatile("s_waitcnt lgkmcnt(0)" ::: "memory")
__device__ __forceinline__ bf16x8 ldfrag(const LAS unsigned char* base, int pitch, int row, int kb) { return *(const LAS bf16x8*)(base + row * pitch + kb); }

#define XB_TMO      128
#define XB_XCNT(j)  (256  + 64 * (j))
#define XB_XSUB(j)  (1280 + 64 * (j))
#define XB_XGEN(j)  (2304 + 64 * (j))
#define XB_TOP      3328
#define XB_TOPGEN   3392
#define XCD_BAR_WORDS 3456
#define XB_SPIN_CAP (1u << 18)
__device__ __forceinline__ unsigned xb_ld(unsigned* p)              { return __hip_atomic_load(p, __ATOMIC_RELAXED, __HIP_MEMORY_SCOPE_AGENT); }
__device__ __forceinline__ unsigned xb_add(unsigned* p, unsigned v) { return __hip_atomic_fetch_add(p, v, __ATOMIC_RELAXED, __HIP_MEMORY_SCOPE_AGENT); }
__device__ __forceinline__ unsigned xb_xcc_id() { return (unsigned)__builtin_amdgcn_s_getreg((3 << 11) | 20) & 0xFu; }
#define XB_SPIN(cond, bar) do { unsigned _sp = 0; while (cond) { __builtin_amdgcn_s_sleep(1); \
    if ((++_sp & 255u) == 0u) { if (xb_ld(&(bar)[XB_TMO])) break; if (_sp > XB_SPIN_CAP) { atomicAdd(&(bar)[XB_TMO], 1u); break; } } } } while (0)
struct XcdBarrier { unsigned* bar; unsigned x; volatile LAS unsigned* st; };
__device__ __forceinline__ XcdBarrier xcd_barrier_post(unsigned* bar, volatile LAS unsigned* st) {
    XcdBarrier b; b.bar = bar; b.x = xb_xcc_id(); b.st = st;
    if (threadIdx.x == 0) (void)xb_add(&bar[XB_XCNT(b.x)], 1u);
    return b;
}
__device__ __forceinline__ void xcd_barrier_complete(unsigned* bar, unsigned x, unsigned& nloc, unsigned& nx) {
    const unsigned G = gridDim.x * gridDim.y * gridDim.z;
    unsigned sum, cnt, mine, sp = 0u;
    for (;;) {
        sum = 0u; cnt = 0u; mine = 0u;
#pragma unroll
        for (unsigned j = 0; j < 16; ++j) { const unsigned c = xb_ld(&bar[XB_XCNT(j)]); sum += c; cnt += (c > 0u) ? 1u : 0u; mine = (j == x) ? c : mine; }
        if (sum == G) break;
        __builtin_amdgcn_s_sleep(1);
        if ((++sp & 255u) == 0u) { if (xb_ld(&bar[XB_TMO])) break; if (sp > XB_SPIN_CAP) { atomicAdd(&bar[XB_TMO], 1u); break; } }
    }
    nloc = mine > 0u ? mine : 1u; nx = cnt > 0u ? cnt : 1u;
}
__device__ __forceinline__ void xcd_barrier(const XcdBarrier& b) {
    asm volatile("s_waitcnt vmcnt(0)" ::: "memory");
    __syncthreads();
    if (threadIdx.x == 0) {
        unsigned* bar = b.bar;
        __builtin_amdgcn_s_waitcnt(0);
        unsigned nloc = b.st[0], nx = b.st[1];
        if (nloc == 0u) { xcd_barrier_complete(bar, b.x, nloc, nx); b.st[0] = nloc; b.st[1] = nx; }
        const unsigned old = xb_add(&bar[XB_XSUB(b.x)], 1u);
        const unsigned gen = old / nloc;
        if (old + 1u == (gen + 1u) * nloc) {
            __builtin_amdgcn_fence(__ATOMIC_RELEASE, "agent");
            asm volatile("s_waitcnt vmcnt(0)" ::: "memory");
            const unsigned og = xb_add(&bar[XB_TOP], 1u);
            const unsigned tg = og / nx;
            if (og + 1u == (tg + 1u) * nx) xb_add(&bar[XB_TOPGEN], 1u);
            else XB_SPIN(xb_ld(&bar[XB_TOPGEN]) == tg, bar);
            __builtin_amdgcn_fence(__ATOMIC_ACQUIRE, "agent");
            xb_add(&bar[XB_XGEN(b.x)], 1u);
            asm volatile("s_waitcnt vmcnt(0)" ::: "memory");
        } else {
            XB_SPIN(xb_ld(&bar[XB_XGEN(b.x)]) == gen, bar);
            __builtin_amdgcn_fence(__ATOMIC_ACQUIRE, "agent");
            asm volatile("s_waitcnt vmcnt(0)" ::: "memory");
        }
    }
    __syncthreads();
}

namespace pg8 {
constexpr int BM = 256, BK = 64, HALF = 128, HTB = HALF * BK * 2, STAGE_BYTES = 8 * HTB, NXCD = 8, WGM = 8;
__host__ __device__ __forceinline__ int lds_byte(int r, int c) { const int st = (r >> 4) * 2 + (c >> 5), rr = r & 15, cc = c & 31, ob = rr * 64 + cc * 2; return st * 1024 + (ob ^ (((ob >> 9) & 1) << 5)); }
__host__ __device__ __forceinline__ void stage_rc(int b, int& R, int& C) { const int st = b / 1024, sb = b % 1024, swz = sb ^ (((sb >> 9) & 1) << 5); R = (st >> 1) * 16 + swz / 64; C = (st & 1) * 32 + (swz % 64) / 2; }
__host__ __device__ __forceinline__ int perm32(int rho) { const int n = rho >> 4, i = rho & 15; return 8 * (i >> 2) + 4 * n + (i & 3); }
struct Unit { int pm, pn; };
struct Gemm { const bf16_t* A; const bf16_t* Bt; int M, N, K; };
struct StaticOrder {
    int nM, nN, nwg, G, c;
    __host__ __device__ void init(int M, int N, int G_, int c_) { nM = M / BM; nN = N / BM; nwg = nM * nN; G = G_; c = c_; }
    __host__ __device__ bool next(int i, Unit& u) const {
        const long L = (long)i * G + c; if (L >= nwg) return false;
        int wgid = (int)L; { const int q = nwg / NXCD, r = nwg % NXCD, xcd = wgid % NXCD, off = wgid / NXCD; wgid = (xcd < r ? xcd * (q + 1) : r * (q + 1) + (xcd - r) * q) + off; }
        const int nig = WGM * nN, gid = wgid / nig, fm = gid * WGM, gsz = (nM - fm) < WGM ? (nM - fm) : WGM;
        u.pm = fm + ((wgid % nig) % gsz); u.pn = (wgid % nig) / gsz; return true;
    }
};
__device__ __forceinline__ unsigned cvt_pk_bf16(float lo, float hi) { unsigned r; asm volatile("v_cvt_pk_bf16_f32 %0, %1, %2" : "=v"(r) : "v"(lo), "v"(hi)); return r; }
struct EpiF32 {
    static constexpr bool PERM = false;
    float* C; int ldc;
    __device__ __forceinline__ void operator()(const f32x4 (&acc)[2][2][4][2], const Unit& u, int wr, int wc, int fr, int fq) const {
        const int row0 = u.pm * BM + wr * 64 + fr, col0 = u.pn * BM + wc * 32 + 4 * fq;
#pragma unroll
        for (int ai = 0; ai < 2; ++ai)
#pragma unroll
            for (int m = 0; m < 4; ++m) { float* rowp = C + (size_t)(row0 + ai * HALF + m * 16) * ldc + col0;
#pragma unroll
                for (int bj = 0; bj < 2; ++bj)
#pragma unroll
                    for (int n = 0; n < 2; ++n) *(f32x4*)(rowp + bj * HALF + n * 16) = acc[ai][bj][m][n]; }
    }
};
struct EpiBf16 {
    static constexpr bool PERM = true;
    bf16_t* O; int ldc;
    __device__ __forceinline__ void operator()(const f32x4 (&acc)[2][2][4][2], const Unit& u, int wr, int wc, int fr, int fq) const {
        const int row0 = u.pm * BM + wr * 64 + fr; const int col0 = u.pn * BM + wc * 32 + 8 * fq;
#pragma unroll
        for (int ai = 0; ai < 2; ++ai)
#pragma unroll
            for (int m = 0; m < 4; ++m) { bf16_t* rowp = O + (size_t)(row0 + ai * HALF + m * 16) * ldc + col0;
#pragma unroll
                for (int bj = 0; bj < 2; ++bj) { const f32x4 v0 = acc[ai][bj][m][0], v1 = acc[ai][bj][m][1];
                    u32x4 w; w.x = cvt_pk_bf16(v0[0], v0[1]); w.y = cvt_pk_bf16(v0[2], v0[3]); w.z = cvt_pk_bf16(v1[0], v1[1]); w.w = cvt_pk_bf16(v1[2], v1[3]);
                    *(u32x4*)(rowp + bj * HALF) = w; } }
    }
};

template <class Epi, class Sched>
__device__ __forceinline__ void gemm_phase(LAS unsigned char* lds, const Gemm g, const Sched& S, const Epi& E) {
    const int tid = threadIdx.x, wid = __builtin_amdgcn_readfirstlane(tid >> 6), lane = tid & 63, wr = wid >> 2, wc = wid & 3, fr = lane & 15, fq = lane >> 4;
    const int K = g.K, nt = K / BK;
    unsigned voffA[2], voffB[2];
#pragma unroll
    for (int i = 0; i < 2; ++i) { int R, C; stage_rc(tid * 16 + i * 8192, R, C); const int Rb = Epi::PERM ? ((R & ~31) + perm32(R & 31)) : R;
        voffA[i] = (unsigned)(R * K + C) * 2u; voffB[i] = (unsigned)(Rb * K + C) * 2u; }
    const size_t kstep = (size_t)(BK * 2);
    const size_t hstep = (size_t)HALF * K * 2;
    const size_t tstep = 2 * hstep;
    const unsigned ldsw = (unsigned)wid * 1024u;
    const int aoff = lds_byte(wr * 64 + fr, fq * 8), boff = lds_byte(wc * 32 + fr, fq * 8);
#define PG8_SA(b, h) (((b) * 2 + (h)) * HTB)
#define PG8_SB(b, h) ((4 + (b) * 2 + (h)) * HTB)
#define PG8_STAGE(bufoff, gbase, voff) do { _Pragma("unroll") for (int _i = 0; _i < 2; ++_i) \
        __builtin_amdgcn_global_load_lds((const unsigned*)((const char*)(gbase) + (voff)[_i]), (LAS unsigned*)(lds + (bufoff) + ldsw + _i * 8192), 16, 0, 0); } while (0)
#define PG8_LDA(dst, b, h) do { _Pragma("unroll") for (int m = 0; m < 4; ++m) _Pragma("unroll") for (int k = 0; k < 2; ++k) dst[m][k] = *(const LAS bf16x8*)(lds + PG8_SA(b, h) + aoff + m * 2048 + k * 1024); } while (0)
#define PG8_LDB(dst, b, h) do { _Pragma("unroll") for (int n = 0; n < 2; ++n) _Pragma("unroll") for (int k = 0; k < 2; ++k) dst[n][k] = *(const LAS bf16x8*)(lds + PG8_SB(b, h) + boff + n * 2048 + k * 1024); } while (0)
#define PG8_MMA(ai, bj, At, Bt) do { __builtin_amdgcn_s_setprio(1); _Pragma("unroll") for (int m = 0; m < 4; ++m) _Pragma("unroll") for (int n = 0; n < 2; ++n) _Pragma("unroll") for (int k = 0; k < 2; ++k) \
        acc[ai][bj][m][n] = __builtin_amdgcn_mfma_f32_16x16x32_bf16(Bt[n][k], At[m][k], acc[ai][bj][m][n], 0, 0, 0); __builtin_amdgcn_s_setprio(0); } while (0)
#define PG8_WAIT_V(n) asm volatile("s_waitcnt vmcnt(" #n ")" ::: "memory")
#define PG8_WAIT_L(n) asm volatile("s_waitcnt lgkmcnt(" #n ")" ::: "memory")
#define PG8_BAR __builtin_amdgcn_s_barrier()
#define PG8_SCHED __builtin_amdgcn_sched_barrier(0)
    Unit cur, nxt; int ui = 0;
    if (!S.next(0, cur)) return;
    f32x4 acc[2][2][4][2];
#pragma unroll
    for (int a = 0; a < 2; ++a)
#pragma unroll
        for (int b = 0; b < 2; ++b)
#pragma unroll
            for (int m = 0; m < 4; ++m)
#pragma unroll
                for (int n = 0; n < 2; ++n) acc[a][b][m][n] = (f32x4){0.f, 0.f, 0.f, 0.f};
    bf16x8 At[4][2], B0[2][2], B1[2][2];
    const char* cA = (const char*)g.A + (size_t)cur.pm * tstep; const char* cB = (const char*)g.Bt + (size_t)cur.pn * tstep;
    PG8_STAGE(PG8_SB(0, 0), cB, voffB); PG8_STAGE(PG8_SA(0, 0), cA, voffA); PG8_STAGE(PG8_SB(0, 1), cB + hstep, voffB); PG8_STAGE(PG8_SA(0, 1), cA + hstep, voffA);
    if (wr == 1) PG8_BAR;
    PG8_WAIT_V(4); PG8_BAR;
    PG8_STAGE(PG8_SB(1, 0), cB + kstep, voffB); PG8_STAGE(PG8_SA(1, 0), cA + kstep, voffA); PG8_STAGE(PG8_SB(1, 1), cB + hstep + kstep, voffB);
    PG8_WAIT_V(6); PG8_BAR;
    for (;;) {
        const bool has_next = S.next(ui + 1, nxt);
        const char* nA = has_next ? (const char*)g.A + (size_t)nxt.pm * tstep : cA; const char* nB = has_next ? (const char*)g.Bt + (size_t)nxt.pn * tstep : cB;
        for (int t = 0; t < nt; t += 2) {
            const bool last = (t == nt - 2);
            const char* a1 = cA + (size_t)(t + 1) * kstep;
            const char* a2 = last ? nA : cA + (size_t)(t + 2) * kstep; const char* b2 = last ? nB : cB + (size_t)(t + 2) * kstep;
            const char* a3 = a2 + kstep; const char* b3 = b2 + kstep;
            PG8_LDB(B0, 0, 0); PG8_SCHED; PG8_LDA(At, 0, 0); PG8_STAGE(PG8_SA(1, 1), a1 + hstep, voffA);
            PG8_WAIT_L(8); PG8_BAR; PG8_WAIT_L(0); PG8_MMA(0, 0, At, B0); PG8_BAR; PG8_SCHED;
            PG8_LDB(B1, 0, 1); PG8_STAGE(PG8_SB(0, 0), b2, voffB);
            PG8_BAR; PG8_WAIT_L(0); PG8_MMA(0, 1, At, B1); PG8_BAR;
            PG8_LDA(At, 0, 1); PG8_STAGE(PG8_SA(0, 0), a2, voffA);
            PG8_BAR; PG8_WAIT_L(0); PG8_MMA(1, 0, At, B0); PG8_BAR; PG8_SCHED;
            PG8_STAGE(PG8_SB(0, 1), b2 + hstep, voffB);
            PG8_WAIT_V(6); PG8_BAR; PG8_MMA(1, 1, At, B1); PG8_BAR;
            PG8_LDB(B0, 1, 0); PG8_SCHED; PG8_LDA(At, 1, 0); PG8_STAGE(PG8_SA(0, 1), a2 + hstep, voffA);
            PG8_WAIT_L(8); PG8_BAR; PG8_WAIT_L(0); PG8_MMA(0, 0, At, B0); PG8_BAR; PG8_SCHED;
            PG8_LDB(B1, 1, 1); PG8_STAGE(PG8_SB(1, 0), b3, voffB);
            PG8_BAR; PG8_WAIT_L(0); PG8_MMA(0, 1, At, B1); PG8_BAR;
            PG8_LDA(At, 1, 1); PG8_STAGE(PG8_SA(1, 0), a3, voffA);
            PG8_BAR; PG8_WAIT_L(0); PG8_MMA(1, 0, At, B0); PG8_BAR; PG8_SCHED;
            PG8_STAGE(PG8_SB(1, 1), b3 + hstep, voffB);
            PG8_WAIT_V(6); PG8_BAR; PG8_MMA(1, 1, At, B1); PG8_BAR;
        }
        E(acc, cur, wr, wc, fr, fq);
        if (!has_next) break;
#pragma unroll
        for (int a = 0; a < 2; ++a)
#pragma unroll
            for (int b = 0; b < 2; ++b)
#pragma unroll
                for (int m = 0; m < 4; ++m)
#pragma unroll
                    for (int n = 0; n < 2; ++n) acc[a][b][m][n] = (f32x4){0.f, 0.f, 0.f, 0.f};
        cur = nxt; cA = nA; cB = nB; ++ui;
    }
    PG8_WAIT_V(0);
    if (wr == 0) PG8_BAR;
    PG8_BAR;
#undef PG8_SA
#undef PG8_SB
#undef PG8_STAGE
#undef PG8_LDA
#undef PG8_LDB
#undef PG8_MMA
#undef PG8_WAIT_V
#undef PG8_WAIT_L
#undef PG8_BAR
#undef PG8_SCHED
}
}

struct Frame {
    LAS unsigned char* lds;
    int tid, lane, wave, G, b;
    float* out; unsigned char* ws;
    __device__ __forceinline__ bf16_t* H() const { return (bf16_t*)out; }
    __device__ __forceinline__ bf16_t* Qc() const { return (bf16_t*)out; }
    __device__ __forceinline__ bf16_t* Kc() const { return (bf16_t*)(out + OUT_YS); }
    __device__ __forceinline__ bf16_t* MIX() const { return (bf16_t*)out; }
    __device__ __forceinline__ float* modp() const { return (float*)(ws + WS_MODP); }
    __device__ __forceinline__ float* pe() const { return (float*)(ws + WS_PE); }
    __device__ __forceinline__ float* BA() const { return (float*)(ws + WS_BA); }
    __device__ __forceinline__ float* GB() const { return (float*)(ws + WS_GB); }
    __device__ __forceinline__ float* RGAGG() const { return (float*)(ws + WS_RGAGG); }
    __device__ __forceinline__ bf16_t* WbaT() const { return (bf16_t*)(ws + WS_WBAT); }
    __device__ __forceinline__ bf16_t* WoutT() const { return (bf16_t*)(ws + WS_WOUTT); }
    __device__ __forceinline__ bf16_t* GT() const { return (bf16_t*)(ws + WS_GT); }
    __device__ __forceinline__ bf16_t* WinT() const { return (bf16_t*)(ws + WS_WINT); }
    __device__ __forceinline__ bf16_t* TA() const { return (bf16_t*)(ws + WS_TA); }
    __device__ __forceinline__ bf16_t* PROJ() const { return (bf16_t*)(ws + WS_PROJ); }
    __device__ __forceinline__ float* CARRY() const { return (float*)(ws + WS_CARRY); }
};
typedef const __attribute__((address_space(4))) Params CParams;

__device__ __forceinline__ int grp_of_block(int tb) { return tb < 128 ? 0 : (tb < 192 ? 1 : 2); }

__device__ __forceinline__ void transpose_item(const float* W, int N, int k0, int n0, bf16_t* WT0, int Kout, LAS float* scr, int lane) {
#pragma unroll 8
    for (int i = 0; i < 32; ++i) { const int kk = 2 * i + (lane >> 5); scr[kk * 33 + (lane & 31)] = W[(size_t)(k0 + kk) * N + n0 + (lane & 31)]; }
    LDS_WAIT();
    const int c = lane & 7;
#pragma unroll
    for (int j = 0; j < 4; ++j) { const int n = (lane >> 3) + 8 * j; const LAS float* s = scr + (8 * c) * 33 + n;
        u32x4 o; o.x = pk2(s[0 * 33], s[1 * 33]); o.y = pk2(s[2 * 33], s[3 * 33]); o.z = pk2(s[4 * 33], s[5 * 33]); o.w = pk2(s[6 * 33], s[7 * 33]);
        *(u32x4*)(WT0 + (size_t)n * Kout + k0 + 8 * c) = o; }
    LDS_WAIT();
}
struct P0Item { const float* W; bf16_t* dst; int N, k0, n0, Kout, kind; };
__device__ __forceinline__ P0Item p0_decode(CParams& p, const Frame& F, int it) {
    constexpr int I_IN = 16 * 193, I_OUT = 32 * 32, I_G = 256;
    P0Item D; D.kind = 0; int r = it;
    if (r < I_IN) { const int kb = r / 193, nb = r % 193, n0 = nb * 32;
        D.dst = n0 < 4096 ? F.WinT() + (size_t)n0 * 1024 : (n0 < 4128 ? F.WbaT() + (size_t)(n0 - 4096) * 1024 : F.WinT() + (size_t)(n0 - 32) * 1024);
        D.W = p.w_in; D.N = DIN; D.k0 = kb * 64; D.n0 = n0; D.Kout = 1024; return D; }
    r -= I_IN;
    if (r < I_OUT) { const int kb = r / 32, nb = r % 32; D.W = p.w_out; D.N = 1024; D.k0 = kb * 64; D.n0 = nb * 32; D.dst = F.WoutT() + (size_t)(nb * 32) * 2048; D.Kout = 2048; return D; }
    r -= I_OUT;
    if (r < I_G) { const int m = r >> 3, sub = r & 7, kb = sub >> 2, nb = sub & 3, g = m >> 4, dn = m & 15;
        D.W = (g ? p.rg_w_i : p.rg_w_r) + (size_t)dn * 16384; D.N = 128; D.k0 = kb * 64; D.n0 = nb * 32; D.dst = F.GT() + (size_t)m * 16384 + (size_t)(nb * 32) * 128; D.Kout = 128; return D; }
    r -= I_G;
    D.kind = 1; D.k0 = r; D.W = p.w_in; D.dst = F.WinT(); D.N = 0; D.n0 = 0; D.Kout = 0; return D;
}
__device__ __forceinline__ void p0_load(const P0Item& D, float (&v)[32], int lane) {
#pragma unroll
    for (int i = 0; i < 32; ++i) { const int kk = 2 * i + (lane >> 5); v[i] = __builtin_nontemporal_load(D.W + (size_t)(D.k0 + kk) * D.N + D.n0 + (lane & 31)); }
}
__device__ __forceinline__ void p0_store(const P0Item& D, const float (&v)[32], LAS float* scr, int lane) {
#pragma unroll
    for (int i = 0; i < 32; ++i) { const int kk = 2 * i + (lane >> 5); scr[kk * 33 + (lane & 31)] = v[i]; }
    LDS_WAIT();
    const int c = lane & 7;
#pragma unroll
    for (int j = 0; j < 4; ++j) { const int n = (lane >> 3) + 8 * j; const LAS float* s = scr + (8 * c) * 33 + n;
        u32x4 o; o.x = pk2(s[0 * 33], s[1 * 33]); o.y = pk2(s[2 * 33], s[3 * 33]); o.z = pk2(s[4 * 33], s[5 * 33]); o.w = pk2(s[6 * 33], s[7 * 33]);
        *(u32x4*)(D.dst + (size_t)n * D.Kout + D.k0 + 8 * c) = o; }
    LDS_WAIT();
}
__device__ __forceinline__ void phase0(CParams& p, Frame& F) {
    const int tid = F.tid, lane = F.lane;
    for (int it = F.b; it < 192; it += F.G) {
        const int jg = it % 12, ks = it / 12, j = jg * 256 + (tid & 255), half = tid >> 8, k0 = ks * 64 + half * 32;
        float s0 = 0.f, s1 = 0.f, s2 = 0.f;
#pragma unroll 8
        for (int k = 0; k < 32; ++k) { const int kk = k0 + k; const float w = __builtin_nontemporal_load(p.ada_w + (size_t)kk * 3072 + j);
            s0 += siluf_(p.c_ctx[kk]) * w; s1 += siluf_(p.c[kk]) * w; s2 += siluf_(p.c[1024 + kk]) * w; }
        LAS float* red = (LAS float*)F.lds;
        if (half == 1) { red[tid - 256] = s0; red[256 + tid - 256] = s1; red[512 + tid - 256] = s2; }
        __syncthreads();
        if (half == 0) { F.modp()[(size_t)(ks * 3 + 0) * 3072 + j] = s0 + red[tid]; F.modp()[(size_t)(ks * 3 + 1) * 3072 + j] = s1 + red[256 + tid]; F.modp()[(size_t)(ks * 3 + 2) * 3072 + j] = s2 + red[512 + tid]; }
        __syncthreads();
    }
    LAS float* scr = (LAS float*)(F.lds + 4096 + F.wave * 8448);
    const int gw = F.b * 8 + F.wave, NGW = F.G * 8;
    constexpr int I_IN = 16 * 193, I_OUT = 32 * 32, I_G = 256, I_PE = 64, I_ALL = I_IN + I_OUT + I_G + I_PE;
    P0Item D = p0_decode(p, F, gw), Dn = D; float v[32], vn[32];
    if (gw < I_ALL && D.kind == 0) p0_load(D, v, lane);
    for (int it = gw; it < I_ALL; it += NGW) {
        const int itn = it + NGW;
        if (itn < I_ALL) { Dn = p0_decode(p, F, itn); if (Dn.kind == 0) p0_load(Dn, vn, lane); }
        if (D.kind == 0) p0_store(D, v, scr, lane);
        else { const int pv = D.k0;
#pragma unroll
            for (int i = 0; i < 4; ++i) { const int idx = lane * 4 + i; const float f = expf(-9.210340371976184f * (float)idx / 256.f); const float a = (float)pv * f;
                F.pe()[pv * 256 + idx] = sinf(a); F.pe()[16384 + pv * 256 + idx] = cosf(a); } }
        D = Dn;
#pragma unroll
        for (int i = 0; i < 32; ++i) v[i] = vn[i];
    }
}

__device__ __forceinline__ float mod_val(CParams& p, const Frame& F, int grp, int j) {
    float s = p.ada_b[j];
#pragma unroll
    for (int ks = 0; ks < 16; ++ks) s += F.modp()[(size_t)(ks * 3 + grp) * 3072 + j];
    return s;
}

__device__ __forceinline__ void phase1(CParams& p, Frame& F) {
    LAS float* sc = (LAS float*)F.lds; LAS float* sh = sc + 1024;
    for (int tb = F.b; tb < 256; tb += F.G) {
        const int grp = grp_of_block(tb);
        for (int j = F.tid; j < 1024; j += 512) { sh[j] = mod_val(p, F, grp, j); sc[j] = p.pre_w[j] * (1.f + mod_val(p, F, grp, 1024 + j)); }
        __syncthreads();
#pragma unroll 2
        for (int i = 0; i < 8; ++i) {
            const int tok = tb * 64 + F.wave * 8 + i;
            const float* xr = tok < 8192 ? p.x_prompt + (size_t)tok * 1024 : p.x_sample + (size_t)(tok - 8192) * 1024;
            f32x4 v[4]; float ss = 0.f;
#pragma unroll
            for (int q = 0; q < 4; ++q) { v[q] = __builtin_nontemporal_load((const f32x4*)(xr + F.lane * 4 + 256 * q));
                if (tok >= 8192) { const int pp = (tok - 8192) & 4095; const int vv = (q < 2) ? (pp >> 6) : (pp & 63);
                    const f32x4 e = *(const f32x4*)(F.pe() + ((q & 1) ? 16384 : 0) + vv * 256 + F.lane * 4); v[q] += e; }
                ss += (v[q][0] * v[q][0] + v[q][1] * v[q][1]) + (v[q][2] * v[q][2] + v[q][3] * v[q][3]); }
            const float rstd = rsqrtf(wave_sum(ss) * (1.f / 1024.f) + 1e-6f);
#pragma unroll
            for (int q = 0; q < 4; ++q) { const int j = F.lane * 4 + 256 * q; const f32x4 s4 = *(const LAS f32x4*)(sc + j), h4 = *(const LAS f32x4*)(sh + j);
                CHK(F, 1, badv(v[q][0] * rstd * s4[0] + h4[0], 100.f) || badv(v[q][3] * rstd * s4[3] + h4[3], 100.f));
                u32x2 o; o.x = pk2(v[q][0] * rstd * s4[0] + h4[0], v[q][1] * rstd * s4[1] + h4[1]); o.y = pk2(v[q][2] * rstd * s4[2] + h4[2], v[q][3] * rstd * s4[3] + h4[3]);
                *(u32x2*)(F.H() + (size_t)tok * 1024 + j) = o; }
        }
        __syncthreads();
    }
}

__device__ __forceinline__ void phase2(CParams& p, Frame& F) {
    { pg8::Gemm g{F.H(), F.WinT(), NTOK, NPROJ, 1024}; pg8::StaticOrder S; S.init(NTOK, NPROJ, F.G, F.b); pg8::EpiBf16 E{F.PROJ(), NPROJ};
      pg8::gemm_phase<pg8::EpiBf16, pg8::StaticOrder>(F.lds, g, S, E); }
    const int l15 = F.lane & 15, q4 = F.lane >> 4;
    for (int tb = F.b; tb < 256; tb += F.G) {
        const int mt = F.wave >> 1, nt = F.wave & 1;
        const bf16_t* ar = F.H() + (size_t)(tb * 64 + mt * 16 + l15) * 1024 + q4 * 8;
        const bf16_t* br = F.WbaT() + (size_t)(nt * 16 + l15) * 1024 + q4 * 8;
        f32x4 acc = {0.f, 0.f, 0.f, 0.f};
#pragma unroll 16
        for (int ks = 0; ks < 32; ++ks) { const bf16x8 a = *(const bf16x8*)(ar + ks * 32), b = *(const bf16x8*)(br + ks * 32); acc = MFMA16(a, b, acc); }
#pragma unroll
        for (int r = 0; r < 4; ++r) F.BA()[(size_t)(tb * 64 + mt * 16 + q4 * 4 + r) * 32 + nt * 16 + l15] = acc[r];
    }
}

__device__ __forceinline__ void p3_load_rows(const Frame& F, int ci, int h, u32x4 (&rows)[7]) {
    const int tid = F.tid, tg = tid >> 5, part = (tid >> 4) & 1, sub = tid & 15, col = part * 1024 + h * 128 + sub * 8, t0 = ci * 64;
    int seq_lo, seq_hi; if (ci < 128) { seq_lo = (ci >> 2) * 256; seq_hi = seq_lo + 256; } else { seq_lo = 8192 + ((ci - 128) >> 6) * 4096; seq_hi = seq_lo + 4096; }
    const int tb = t0 + tg * 4 - 2;
#pragma unroll
    for (int r = 0; r < 7; ++r) { const int tok = tb + r; u32x4 v = {0u, 0u, 0u, 0u};
        if (tok >= seq_lo && tok < seq_hi) v = *(const u32x4*)(F.PROJ() + (size_t)tok * NPROJ + col);
        rows[r] = v; }
}
__device__ __forceinline__ void p3_delta_item(CParams& p, Frame& F, int ci, int h, u32x4 (&rows)[7], int itn) {
    const int tid = F.tid, lane = F.lane, wave = F.wave, q4 = lane >> 4, l15 = lane & 15;
    LAS unsigned char* Ks = F.lds; LAS unsigned char* Qs = F.lds + 17408;
    LAS float* gfv = (LAS float*)(F.lds + 34816);
    LAS unsigned char* DIR0 = F.lds + 35840;
    LAS unsigned char* ATo = F.lds + 137728;
#pragma unroll
    for (int i = 0; i < 5; ++i) { const int ch = tid + 512 * i; if (ch < 2304) { const int dd = ch >= 1152, cc = ch - dd * 1152; *(LAS u32x4*)(DIR0 + dd * 47616 + 18432 + cc * 16) = (u32x4){0u, 0u, 0u, 0u}; } }
    const int t0 = ci * 64;
    int seq_lo, seq_hi; if (ci < 128) { seq_lo = (ci >> 2) * 256; seq_hi = seq_lo + 256; } else { seq_lo = 8192 + ((ci - 128) >> 6) * 4096; seq_hi = seq_lo + 4096; }
    {
        const int tg = tid >> 5, part = (tid >> 4) & 1, sub = tid & 15, col = part * 1024 + h * 128 + sub * 8;
        float w[4][8];
#pragma unroll
        for (int j = 0; j < 4; ++j) { const f32x4 a = *(const f32x4*)(p.dn_conv_w + j * 3072 + col), b = *(const f32x4*)(p.dn_conv_w + j * 3072 + col + 4);
            w[j][0] = a[0]; w[j][1] = a[1]; w[j][2] = a[2]; w[j][3] = a[3]; w[j][4] = b[0]; w[j][5] = b[1]; w[j][6] = b[2]; w[j][7] = b[3]; }
        float acc[4][8];
#pragma unroll
        for (int i = 0; i < 4; ++i)
#pragma unroll
            for (int e = 0; e < 8; ++e) acc[i][e] = 0.f;
#pragma unroll
        for (int r = 0; r < 7; ++r) {
            float x[8]; unpack8(rows[r], x);
#pragma unroll
            for (int j = 0; j < 4; ++j) { const int i = r - j; if (i >= 0 && i < 4) {
#pragma unroll
                for (int e = 0; e < 8; ++e) acc[i][e] += w[j][e] * x[e]; } } }
#pragma unroll
        for (int i = 0; i < 4; ++i) { float ss = 0.f;
#pragma unroll
            for (int e = 0; e < 8; ++e) { acc[i][e] = siluf_(acc[i][e]); ss += acc[i][e] * acc[i][e]; }
            ss += __shfl_xor(ss, 1); ss += __shfl_xor(ss, 2); ss += __shfl_xor(ss, 4); ss += __shfl_xor(ss, 8);
            const float rs = rsqrtf(ss + 1e-6f) * (part == 0 ? 0.08838834764831845f : 1.f);
#pragma unroll
            for (int e = 0; e < 8; ++e) acc[i][e] *= rs;
            CHK(F, 4, badv(acc[i][0], 1.01f) || badv(acc[i][5], 1.01f) || badv(ss * rs * rs, part == 0 ? 0.0079f : 1.01f));
            const u32x4 o = pack8(acc[i]); const int c = tg * 4 + i;
            *(LAS u32x4*)((part ? Ks : Qs) + c * 272 + sub * 16) = o;
            if (part == 0) *(u32x4*)(F.Qc() + (size_t)(t0 + c) * 1024 + h * 128 + sub * 8) = o; }
        if (part == 1) {
            bf16_t* kt = F.Kc() + (size_t)(ci * 8 + h) * 8192 + (size_t)(sub * 8) * 64 + tg * 4;
#pragma unroll
            for (int e = 0; e < 8; ++e) { u32x2 o2; o2.x = pk2(acc[0][e], acc[1][e]); o2.y = pk2(acc[2][e], acc[3][e]); *(u32x2*)(kt + e * 64) = o2; } }
    }
    if (wave == 0) {
        const float* ba = F.BA() + (size_t)(t0 + lane) * 32;
        const float bf_ = sigm(ba[h]), bb_ = sigm(ba[8 + h]);
        float s = -expf(p.dn_a_log[h]) * softplusf_(ba[16 + h] + p.dn_dt_bias[h]);
        float sb = -expf(p.dn_a_log[8 + h]) * softplusf_(ba[24 + h] + p.dn_dt_bias[8 + h]);
#pragma unroll
        for (int o = 1; o < 64; o <<= 1) { const float t = __shfl_up(s, o); if (lane >= o) s += t; }
#pragma unroll
        for (int o = 1; o < 64; o <<= 1) { const float t = __shfl_down(sb, o); if (lane + o < 64) sb += t; }
        CHK(F, 3, badv(ba[h], 1000.f) || badv(ba[24 + h], 1000.f));
        CHK(F, 8, badv(s, 1e4f) || badv(sb, 1e4f) || s > 0.f || sb > 0.f || bf_ < 0.f || bf_ > 1.f || bb_ < 0.f || bb_ > 1.f);
        gfv[lane] = s; gfv[64 + lane] = sb; gfv[128 + lane] = bf_; gfv[192 + lane] = bb_;
        float* gb = F.GB() + (size_t)(ci * 8 + h) * 256;
        gb[lane] = s; gb[64 + lane] = sb; gb[128 + lane] = bf_; gb[192 + lane] = bb_;
    }
    lds_barrier();
    const int d = wave >> 2, mt = wave & 3;
    LAS unsigned char* Db = DIR0 + d * 47616;
    LAS unsigned char* Brow = Db; LAS unsigned char* Btr = Db + 9216; LAS unsigned char* Xrow = Db + 18432; LAS unsigned char* Xtr = Db + 27648;
    LAS float* Dl = (LAS float*)(Db + 36864) + mt * 320; LAS unsigned char* M2t = Db + 41984; LAS unsigned char* Mts = Db + 44544 + mt * 768;
    const LAS unsigned char* Lrow = Brow;
    const LAS float* gd = gfv + d * 64; const LAS float* bd = gfv + 128 + d * 64;
    {
        f32x4 kk[4], qk[4];
#pragma unroll
        for (int n = 0; n < 4; ++n) { kk[n] = (f32x4){0.f, 0.f, 0.f, 0.f}; qk[n] = (f32x4){0.f, 0.f, 0.f, 0.f}; }
#pragma unroll
        for (int ks = 0; ks < 4; ++ks) { const bf16x8 ak = ldfrag(Ks, 272, mt * 16 + l15, ks * 64 + q4 * 16), aq = ldfrag(Qs, 272, mt * 16 + l15, ks * 64 + q4 * 16);
#pragma unroll
            for (int n = 0; n < 4; ++n) { const bf16x8 bk = ldfrag(Ks, 272, n * 16 + l15, ks * 64 + q4 * 16); kk[n] = MFMA16(ak, bk, kk[n]); qk[n] = MFMA16(aq, bk, qk[n]); } }
#pragma unroll
        for (int n = 0; n < 4; ++n) { const int C = n * 16 + l15; const float gC = gd[C], bC = bd[C]; float a4[4];
#pragma unroll
            for (int r = 0; r < 4; ++r) { const int R = mt * 16 + q4 * 4 + r;
                const float dec = __expf(-fabsf(gd[R] - gC));
                a4[r] = (C > R) ? (d == 0 ? bC : bd[R]) * kk[n][r] * dec : 0.f;
                const bool incl = d == 0 ? (R >= C) : (R < C);
                if (incl) ((LAS bf16_t*)ATo)[R * 64 + C] = f2bf(qk[n][r] * dec); }
            u32x2 o; o.x = pk2(a4[0], a4[1]); o.y = pk2(a4[2], a4[3]);
            *(LAS u32x2*)(Brow + C * 144 + (mt * 16 + q4 * 4) * 2) = o;
            if (n == mt) *(LAS f32x4*)(Dl + l15 * 20 + q4 * 4) = (f32x4){a4[0], a4[1], a4[2], a4[3]}; }
    }
    lds_barrier();
    if (itn < 2048) p3_load_rows(F, itn >> 3, itn & 7, rows);
    if (lane < 16) {
        float x[16];
#pragma unroll
        for (int i = 0; i < 16; ++i) { float sv = (i == lane) ? 1.f : 0.f;
            float drow[16];
#pragma unroll
            for (int q = 0; q < 4; ++q) if (4 * q < i) { const f32x4 t4 = *(const LAS f32x4*)(Dl + i * 20 + 4 * q); drow[4 * q] = t4[0]; drow[4 * q + 1] = t4[1]; drow[4 * q + 2] = t4[2]; drow[4 * q + 3] = t4[3]; }
#pragma unroll
            for (int j = 0; j < i; ++j) sv -= drow[j] * x[j];
            x[i] = sv; }
#pragma unroll
        for (int i = 0; i < 16; ++i) ((LAS bf16_t*)Xrow)[(mt * 16 + i) * 72 + mt * 16 + lane] = f2bf(x[i]);
        u32x4 o0, o1; o0.x = pk2(x[0], x[1]); o0.y = pk2(x[2], x[3]); o0.z = pk2(x[4], x[5]); o0.w = pk2(x[6], x[7]);
        o1.x = pk2(x[8], x[9]); o1.y = pk2(x[10], x[11]); o1.z = pk2(x[12], x[13]); o1.w = pk2(x[14], x[15]);
        *(LAS u32x4*)(Xtr + (mt * 16 + lane) * 144 + mt * 32) = o0; *(LAS u32x4*)(Xtr + (mt * 16 + lane) * 144 + mt * 32 + 16) = o1;
    }
    lds_barrier();
    const bf16x8 zero8 = {0, 0, 0, 0, 0, 0, 0, 0};
    const f32x4 zero4 = {0.f, 0.f, 0.f, 0.f};
    if (mt & 1) {
        const int I1 = mt, I0 = mt - 1;
        bf16x8 a = zero8, b = zero8;
        if (q4 < 2) { a = ldfrag(Lrow, 144, I1 * 16 + l15, I0 * 32 + q4 * 16); b = ldfrag(Xtr, 144, I0 * 16 + l15, I0 * 32 + q4 * 16); }
        const f32x4 M = MFMA16(a, b, zero4);
        { u32x2 o; o.x = pk2(M[0], M[1]); o.y = pk2(M[2], M[3]); *(LAS u32x2*)(Mts + l15 * 48 + q4 * 8) = o; }
        LDS_WAIT();
        bf16x8 a2 = zero8, b2 = zero8;
        if (q4 < 2) { a2 = ldfrag(Xrow, 144, I1 * 16 + l15, I1 * 32 + q4 * 16); b2 = *(const LAS bf16x8*)(Mts + l15 * 48 + q4 * 16); }
        const f32x4 X = MFMA16(a2, b2, zero4);
#pragma unroll
        for (int r = 0; r < 4; ++r) ((LAS bf16_t*)Xrow)[(I1 * 16 + q4 * 4 + r) * 72 + I0 * 16 + l15] = f2bf(-X[r]);
        u32x2 o; o.x = pk2(-X[0], -X[1]); o.y = pk2(-X[2], -X[3]);
        *(LAS u32x2*)(Xtr + (I0 * 16 + l15) * 144 + (I1 * 16 + q4 * 4) * 2) = o;
    }
    lds_barrier();
    {
        const int mi = mt >> 1, ni = mt & 1;
        const bf16x8 a = ldfrag(Lrow, 144, 32 + mi * 16 + l15, q4 * 16), b = ldfrag(Xtr, 144, ni * 16 + l15, q4 * 16);
        const f32x4 M2 = MFMA16(a, b, zero4);
        { u32x2 o; o.x = pk2(M2[0], M2[1]); o.y = pk2(M2[2], M2[3]); *(LAS u32x2*)(M2t + (ni * 16 + l15) * 80 + (mi * 16 + q4 * 4) * 2) = o; }
        lds_barrier();
        const bf16x8 a2 = ldfrag(Xrow, 144, 32 + mi * 16 + l15, 64 + q4 * 16), b2 = *(const LAS bf16x8*)(M2t + (ni * 16 + l15) * 80 + q4 * 16);
        const f32x4 X = MFMA16(a2, b2, zero4);
#pragma unroll
        for (int r = 0; r < 4; ++r) { CHK(F, 6, badv(X[r], 20.f)); ((LAS bf16_t*)Xrow)[(32 + mi * 16 + q4 * 4 + r) * 72 + ni * 16 + l15] = f2bf(-X[r]); }
        u32x2 o; o.x = pk2(-X[0], -X[1]); o.y = pk2(-X[2], -X[3]);
        *(LAS u32x2*)(Xtr + (ni * 16 + l15) * 144 + (32 + mi * 16 + q4 * 4) * 2) = o;
    }
    lds_barrier();
    { bf16_t* dst = F.TA() + (size_t)(ci * 8 + h) * 8192;
      const int c = tid >> 3, s0 = (tid & 7) * 8;
      const u32x4 lo = *(const LAS u32x4*)(DIR0 + 18432 + c * 144 + s0 * 2), up = *(const LAS u32x4*)(DIR0 + 47616 + 27648 + c * 144 + s0 * 2);
      unsigned wl[4] = {lo.x, lo.y, lo.z, lo.w}, wu[4] = {up.x, up.y, up.z, up.w}, wo[4];
#pragma unroll
      for (int i = 0; i < 4; ++i) { const int sa = s0 + 2 * i, sb2 = sa + 1;
          const unsigned mlo = (sa <= c ? 0x0000FFFFu : 0u) | (sb2 <= c ? 0xFFFF0000u : 0u);
          wo[i] = (wl[i] & mlo) | (wu[i] & ~mlo); }
      *(u32x4*)(dst + tid * 8) = (u32x4){wo[0], wo[1], wo[2], wo[3]};
      *(u32x4*)(dst + 4096 + tid * 8) = *(const LAS u32x4*)(ATo + tid * 16); }
    lds_barrier();
}

struct RgW { bf16x8 g[2][2][4]; float br[2], bi[2], sp[2]; };
__device__ __forceinline__ void rg_load_w(CParams& p, const Frame& F, int n, RgW& W) {
    const int q4 = F.lane >> 4, j = F.wave * 16 + (F.lane & 15), ch = n * 128 + j;
#pragma unroll
    for (int d = 0; d < 2; ++d) {
#pragma unroll
        for (int g = 0; g < 2; ++g) { const bf16_t* gp = F.GT() + (size_t)((g * 2 + d) * 8 + n) * 16384 + (size_t)j * 128 + q4 * 8;
#pragma unroll
            for (int ks = 0; ks < 4; ++ks) W.g[d][g][ks] = *(const bf16x8*)(gp + ks * 32); }
        W.br[d] = p.rg_b_r[d * 1024 + ch]; W.bi[d] = p.rg_b_i[d * 1024 + ch]; W.sp[d] = softplusf_(-p.rg_lam[d * 1024 + ch]); }
}
__device__ __forceinline__ void rg_load_rows(const Frame& F, int ci, int n, u32x4 (&rows)[5]) {
    const int tid = F.tid, tg = tid >> 4, sub = tid & 15, col = 4096 + n * 128 + sub * 8, t0 = ci * 64;
    int c_lo, c_hi; if (ci < 128) { c_lo = (ci >> 2) * 4; c_hi = c_lo + 4; } else { c_lo = 128 + ((ci - 128) >> 6) * 64; c_hi = c_lo + 64; }
    const int tb = t0 + tg * 2 - 2;
#pragma unroll
    for (int r = 0; r < 5; ++r) { const int tok = tb + r; u32x4 v = {0u, 0u, 0u, 0u};
        if (tok >= c_lo * 64 && tok < c_hi * 64) v = *(const u32x4*)(F.PROJ() + (size_t)tok * NPROJ + col);
        rows[r] = v; }
}
template <int PASS>
__device__ __forceinline__ void rg_item(CParams& p, Frame& F, int ci, int n, u32x4 (&rows)[5], int itn) {
    const int tid = F.tid, lane = F.lane, wave = F.wave, q4 = lane >> 4, l15 = lane & 15;
    LAS unsigned char* xb = F.lds; LAS float* xf = (LAS float*)(F.lds + 17408); LAS float* Hs = (LAS float*)(F.lds + 50176);
    const int t0 = ci * 64;
    int seq_lo, seq_hi, c_lo, c_hi, seq; const bool samp = ci >= 128;
    if (!samp) { seq = ci >> 2; c_lo = seq * 4; c_hi = c_lo + 4; } else { seq = (ci - 128) >> 6; c_lo = 128 + seq * 64; c_hi = c_lo + 64; }
    seq_lo = c_lo * 64; seq_hi = c_hi * 64;
    const int j = wave * 16 + l15, ch = n * 128 + j;
    bf16x8 wA[2][4], wB[2][4];
#pragma unroll
    for (int g = 0; g < 2; ++g) { const bf16_t* gp = F.GT() + (size_t)((g * 2 + 0) * 8 + n) * 16384 + (size_t)j * 128 + q4 * 8;
#pragma unroll
        for (int ks = 0; ks < 4; ++ks) wA[g][ks] = *(const bf16x8*)(gp + ks * 32); }
    {
        const int tg = tid >> 4, sub = tid & 15, ch = n * 128 + sub * 8;
        float w[4][8], acc[2][8];
#pragma unroll
        for (int j = 0; j < 4; ++j) { const f32x4 a = *(const f32x4*)(p.rg_conv_w + j * 1024 + ch), b = *(const f32x4*)(p.rg_conv_w + j * 1024 + ch + 4);
            w[j][0] = a[0]; w[j][1] = a[1]; w[j][2] = a[2]; w[j][3] = a[3]; w[j][4] = b[0]; w[j][5] = b[1]; w[j][6] = b[2]; w[j][7] = b[3]; }
        { const f32x4 a = *(const f32x4*)(p.rg_conv_b + ch), b = *(const f32x4*)(p.rg_conv_b + ch + 4);
#pragma unroll
          for (int i = 0; i < 2; ++i) { acc[i][0] = a[0]; acc[i][1] = a[1]; acc[i][2] = a[2]; acc[i][3] = a[3]; acc[i][4] = b[0]; acc[i][5] = b[1]; acc[i][6] = b[2]; acc[i][7] = b[3]; } }
#pragma unroll
        for (int r = 0; r < 5; ++r) {
            float x[8]; unpack8(rows[r], x);
#pragma unroll
            for (int j = 0; j < 4; ++j) { const int i = r - j; if (i >= 0 && i < 2) {
#pragma unroll
                for (int e = 0; e < 8; ++e) acc[i][e] += w[j][e] * x[e]; } } }
#pragma unroll
        for (int i = 0; i < 2; ++i) { const int c = tg * 2 + i;
            *(LAS u32x4*)(xb + c * 272 + sub * 16) = pack8(acc[i]);
            *(LAS f32x4*)(xf + c * 128 + sub * 8) = (f32x4){acc[i][0], acc[i][1], acc[i][2], acc[i][3]};
            *(LAS f32x4*)(xf + c * 128 + sub * 8 + 4) = (f32x4){acc[i][4], acc[i][5], acc[i][6], acc[i][7]}; }
    }
    lds_barrier();
    f32x4 hs[4];
#pragma unroll
    for (int m = 0; m < 4; ++m) hs[m] = (f32x4){0.f, 0.f, 0.f, 0.f};
#pragma unroll
    for (int d = 0; d < 2; ++d) {
        f32x4 av[4], bxv[4];
        {
            f32x4 ar[4], ai[4];
#pragma unroll
            for (int m = 0; m < 4; ++m) { ar[m] = (f32x4){0.f, 0.f, 0.f, 0.f}; ai[m] = (f32x4){0.f, 0.f, 0.f, 0.f}; }
#pragma unroll
            for (int ks = 0; ks < 4; ++ks) { const bf16x8 br = d == 0 ? wA[0][ks] : wB[0][ks], bi = d == 0 ? wA[1][ks] : wB[1][ks];
#pragma unroll
                for (int m = 0; m < 4; ++m) { const bf16x8 a = ldfrag(xb, 272, m * 16 + l15, ks * 64 + q4 * 16); ar[m] = MFMA16(a, br, ar[m]); ai[m] = MFMA16(a, bi, ai[m]); } }
            if (d == 0) {
#pragma unroll
                for (int g = 0; g < 2; ++g) { const bf16_t* gp = F.GT() + (size_t)((g * 2 + 1) * 8 + n) * 16384 + (size_t)j * 128 + q4 * 8;
#pragma unroll
                    for (int ks = 0; ks < 4; ++ks) wB[g][ks] = *(const bf16x8*)(gp + ks * 32); } }
            const float L2E = 1.4426950408889634f;
            const float br_ = -L2E * p.rg_b_r[d * 1024 + ch], bi_ = -L2E * p.rg_b_i[d * 1024 + ch], sp = softplusf_(-p.rg_lam[d * 1024 + ch]);
            const float k2 = -16.f * sp, k2e = k2 * L2E, k1e = 0.5f * k2e;
#pragma unroll
            for (int m = 0; m < 4; ++m)
#pragma unroll
                for (int r = 0; r < 4; ++r) { const int c = m * 16 + q4 * 4 + r;
                    const float rr = __builtin_amdgcn_rcpf(1.f + __builtin_amdgcn_exp2f(fmaf(ar[m][r], -L2E, br_)));
                    const float ii = __builtin_amdgcn_rcpf(1.f + __builtin_amdgcn_exp2f(fmaf(ai[m][r], -L2E, bi_)));
                    const float a_ = __builtin_amdgcn_exp2f(k1e * rr);
                    const float em = fmaf(a_, a_, -1.f);
                    av[m][r] = a_; bxv[m][r] = __builtin_amdgcn_sqrtf(fmaxf(-em, 0.f)) * (ii * xf[c * 128 + j]); }
        }
        f32x4 Pa[4], Pb[4]; float Ap[4], Bp[4], Am[4], Bm[4];
#pragma unroll
        for (int m = 0; m < 4; ++m) {
            float pa, pb;
            if (d == 0) { pa = av[m][0]; pb = bxv[m][0]; Pa[m][0] = pa; Pb[m][0] = pb;
#pragma unroll
                for (int r = 1; r < 4; ++r) { pb = av[m][r] * pb + bxv[m][r]; pa = av[m][r] * pa; Pa[m][r] = pa; Pb[m][r] = pb; } }
            else { pa = av[m][3]; pb = bxv[m][3]; Pa[m][3] = pa; Pb[m][3] = pb;
#pragma unroll
                for (int r = 2; r >= 0; --r) { pb = av[m][r] * pb + bxv[m][r]; pa = av[m][r] * pa; Pa[m][r] = pa; Pb[m][r] = pb; } }
            float Ak[4], Bk[4];
#pragma unroll
            for (int k = 0; k < 4; ++k) { Ak[k] = __shfl(pa, l15 + 16 * k); Bk[k] = __shfl(pb, l15 + 16 * k); }
            float ap = 1.f, bp = 0.f, am = 1.f, bm = 0.f;
#pragma unroll
            for (int kk = 0; kk < 4; ++kk) { const int k = d == 0 ? kk : 3 - kk;
                const bool before = d == 0 ? (k < q4) : (k > q4);
                const float nb = Ak[k] * bp + Bk[k], na = Ak[k] * ap;
                bp = before ? nb : bp; ap = before ? na : ap;
                bm = Ak[k] * bm + Bk[k]; am = Ak[k] * am; }
            Ap[m] = ap; Bp[m] = bp; Am[m] = am; Bm[m] = bm;
        }
        if (PASS == 1) {
            float At = 1.f, Bt = 0.f;
#pragma unroll
            for (int mm = 0; mm < 4; ++mm) { const int m = d == 0 ? mm : 3 - mm; Bt = Am[m] * Bt + Bm[m]; At = Am[m] * At; }
            if (q4 == 0) { float* ag = F.RGAGG() + (size_t)(ci * 2 + d) * 2048; ag[ch] = At; ag[1024 + ch] = Bt; }
        } else {
            float hb = F.CARRY()[(size_t)(ci * 2 + d) * 1024 + ch];
#pragma unroll
            for (int mm = 0; mm < 4; ++mm) { const int m = d == 0 ? mm : 3 - mm;
                const float hin = Ap[m] * hb + Bp[m];
#pragma unroll
                for (int r = 0; r < 4; ++r) hs[m][r] += Pa[m][r] * hin + Pb[m][r];
                hb = Am[m] * hb + Bm[m]; }
            if (!samp && q4 == 0 && ci == (d == 0 ? c_hi - 1 : c_lo)) F.out[OUT_SR + (size_t)(seq * 2 + d) * 1024 + ch] = hb;
        }
    }
    if (PASS == 1 && itn < 1024) rg_load_rows(F, 128 + (itn >> 3), itn & 7, rows);
    if (PASS == 3) {
#pragma unroll
        for (int m = 0; m < 4; ++m)
#pragma unroll
            for (int r = 0; r < 4; ++r) Hs[(m * 16 + q4 * 4 + r) * 128 + j] = hs[m][r];
        lds_barrier();
#pragma unroll
        for (int i = 0; i < 2; ++i) { const int chunk = tid + 512 * i, c = chunk >> 4, cc = chunk & 15;
            const u32x4 gv = *(const u32x4*)(F.PROJ() + (size_t)(t0 + c) * NPROJ + 5120 + n * 128 + cc * 8);
            float g[8]; unpack8(gv, g);
            const f32x4 ha = *(const LAS f32x4*)(Hs + c * 128 + cc * 8), hb2 = *(const LAS f32x4*)(Hs + c * 128 + cc * 8 + 4);
            float o[8];
#pragma unroll
            for (int e = 0; e < 4; ++e) { o[e] = ha[e] * siluf_(g[e]); o[4 + e] = hb2[e] * siluf_(g[4 + e]); }
            *(u32x4*)(F.MIX() + (size_t)(t0 + c) * 2048 + 1024 + n * 128 + cc * 8) = pack8(o); }
    }
    lds_barrier();
}

__device__ __forceinline__ void rg_conv_lds(CParams& p, const Frame& F, int n, const u32x4 (&rows)[5], LAS unsigned char* xb, LAS float* xf) {
    const int tid = F.tid, tg = tid >> 4, sub = tid & 15, ch = n * 128 + sub * 8;
    float w[4][8], acc[2][8];
#pragma unroll
    for (int j = 0; j < 4; ++j) { const f32x4 a = *(const f32x4*)(p.rg_conv_w + j * 1024 + ch), b = *(const f32x4*)(p.rg_conv_w + j * 1024 + ch + 4);
        w[j][0] = a[0]; w[j][1] = a[1]; w[j][2] = a[2]; w[j][3] = a[3]; w[j][4] = b[0]; w[j][5] = b[1]; w[j][6] = b[2]; w[j][7] = b[3]; }
    { const f32x4 a = *(const f32x4*)(p.rg_conv_b + ch), b = *(const f32x4*)(p.rg_conv_b + ch + 4);
#pragma unroll
      for (int i = 0; i < 2; ++i) { acc[i][0] = a[0]; acc[i][1] = a[1]; acc[i][2] = a[2]; acc[i][3] = a[3]; acc[i][4] = b[0]; acc[i][5] = b[1]; acc[i][6] = b[2]; acc[i][7] = b[3]; } }
#pragma unroll
    for (int r = 0; r < 5; ++r) { float x[8]; unpack8(rows[r], x);
#pragma unroll
        for (int j = 0; j < 4; ++j) { const int i = r - j; if (i >= 0 && i < 2) {
#pragma unroll
            for (int e = 0; e < 8; ++e) acc[i][e] += w[j][e] * x[e]; } } }
#pragma unroll
    for (int i = 0; i < 2; ++i) { const int c = tg * 2 + i;
        *(LAS u32x4*)(xb + c * 272 + sub * 16) = pack8(acc[i]);
        *(LAS f32x4*)(xf + c * 128 + sub * 8) = (f32x4){acc[i][0], acc[i][1], acc[i][2], acc[i][3]};
        *(LAS f32x4*)(xf + c * 128 + sub * 8 + 4) = (f32x4){acc[i][4], acc[i][5], acc[i][6], acc[i][7]}; }
}
template <int D>
__device__ __forceinline__ void rg_gate_scan(const Frame& F, const bf16x8 (&wg)[2][4], float br_, float bi_, float sp, const LAS unsigned char* xb, const LAS float* xf, int j,
                                             f32x4 (&Pa)[4], f32x4 (&Pb)[4], float (&Ap)[4], float (&Bp)[4], float (&Am)[4], float (&Bm)[4]) {
    const int lane = F.lane, q4 = lane >> 4, l15 = lane & 15;
    f32x4 av[4], bxv[4];
    {
        f32x4 ar[4], ai[4];
#pragma unroll
        for (int m = 0; m < 4; ++m) { ar[m] = (f32x4){0.f, 0.f, 0.f, 0.f}; ai[m] = (f32x4){0.f, 0.f, 0.f, 0.f}; }
#pragma unroll
        for (int ks = 0; ks < 4; ++ks) {
#pragma unroll
            for (int m = 0; m < 4; ++m) { const bf16x8 a = ldfrag(xb, 272, m * 16 + l15, ks * 64 + q4 * 16); ar[m] = MFMA16(a, wg[0][ks], ar[m]); ai[m] = MFMA16(a, wg[1][ks], ai[m]); } }
        const float L2E = 1.4426950408889634f;
        const float brs = -L2E * br_, bis = -L2E * bi_, k2 = -16.f * sp, k1e = 0.5f * k2 * L2E;
#pragma unroll
        for (int m = 0; m < 4; ++m)
#pragma unroll
            for (int r = 0; r < 4; ++r) { const int c = m * 16 + q4 * 4 + r;
                const float rr = __builtin_amdgcn_rcpf(1.f + __builtin_amdgcn_exp2f(fmaf(ar[m][r], -L2E, brs)));
                const float ii = __builtin_amdgcn_rcpf(1.f + __builtin_amdgcn_exp2f(fmaf(ai[m][r], -L2E, bis)));
                const float a = __builtin_amdgcn_exp2f(k1e * rr);
                const float em = fmaf(a, a, -1.f);
                av[m][r] = a; bxv[m][r] = __builtin_amdgcn_sqrtf(fmaxf(-em, 0.f)) * (ii * xf[c * 128 + j]); }
    }
#pragma unroll
    for (int m = 0; m < 4; ++m) {
        float pa, pb;
        if (D == 0) { pa = av[m][0]; pb = bxv[m][0]; Pa[m][0] = pa; Pb[m][0] = pb;
#pragma unroll
            for (int r = 1; r < 4; ++r) { pb = av[m][r] * pb + bxv[m][r]; pa = av[m][r] * pa; Pa[m][r] = pa; Pb[m][r] = pb; } }
        else { pa = av[m][3]; pb = bxv[m][3]; Pa[m][3] = pa; Pb[m][3] = pb;
#pragma unroll
            for (int r = 2; r >= 0; --r) { pb = av[m][r] * pb + bxv[m][r]; pa = av[m][r] * pa; Pa[m][r] = pa; Pb[m][r] = pb; } }
        float Ak[4], Bk[4];
#pragma unroll
        for (int k = 0; k < 4; ++k) { Ak[k] = __shfl(pa, l15 + 16 * k); Bk[k] = __shfl(pb, l15 + 16 * k); }
        float ap = 1.f, bp = 0.f, am = 1.f, bm = 0.f;
#pragma unroll
        for (int kk = 0; kk < 4; ++kk) { const int k = D == 0 ? kk : 3 - kk;
            const bool before = D == 0 ? (k < q4) : (k > q4);
            const float nb = Ak[k] * bp + Bk[k], na = Ak[k] * ap;
            bp = before ? nb : bp; ap = before ? na : ap;
            bm = Ak[k] * bm + Bk[k]; am = Ak[k] * am; }
        Ap[m] = ap; Bp[m] = bp; Am[m] = am; Bm[m] = bm;
    }
}
template <int D>
__device__ __forceinline__ void rg_prompt_dir(CParams& p, Frame& F, int seq, int n) {
    const int tid = F.tid, lane = F.lane, wave = F.wave, q4 = lane >> 4, l15 = lane & 15;
    LAS unsigned char* xb = F.lds; LAS float* xf = (LAS float*)(F.lds + 17408); LAS float* Hs = (LAS float*)(F.lds + 50176); LAS bf16_t* Hf = (LAS bf16_t*)(F.lds + 82944);
    const int j = wave * 16 + l15, ch = n * 128 + j;
    bf16x8 wg[2][4];
#pragma unroll
    for (int g = 0; g < 2; ++g) { const bf16_t* gp = F.GT() + (size_t)((g * 2 + D) * 8 + n) * 16384 + (size_t)j * 128 + q4 * 8;
#pragma unroll
        for (int ks = 0; ks < 4; ++ks) wg[g][ks] = *(const bf16x8*)(gp + ks * 32); }
    const float br_ = p.rg_b_r[D * 1024 + ch], bi_ = p.rg_b_i[D * 1024 + ch], sp = softplusf_(-p.rg_lam[D * 1024 + ch]);
    float hb = 0.f;
    u32x4 rows[5];
    rg_load_rows(F, seq * 4 + (D == 0 ? 0 : 3), n, rows);
#pragma unroll 1
    for (int cs = 0; cs < 4; ++cs) {
        const int cidx = D == 0 ? cs : 3 - cs, ci = seq * 4 + cidx, t0 = ci * 64;
        rg_conv_lds(p, F, n, rows, xb, xf);
        if (cs < 3) rg_load_rows(F, seq * 4 + (D == 0 ? cidx + 1 : cidx - 1), n, rows);
        lds_barrier();
        f32x4 Pa[4], Pb[4]; float Ap[4], Bp[4], Am[4], Bm[4];
        rg_gate_scan<D>(F, wg, br_, bi_, sp, xb, xf, j, Pa, Pb, Ap, Bp, Am, Bm);
#pragma unroll
        for (int mm = 0; mm < 4; ++mm) { const int m = D == 0 ? mm : 3 - mm;
            const float hin = Ap[m] * hb + Bp[m];
#pragma unroll
            for (int r = 0; r < 4; ++r) { const float hv = Pa[m][r] * hin + Pb[m][r]; const int tl = m * 16 + q4 * 4 + r;
                if (D == 0) Hf[(cidx * 64 + tl) * 128 + j] = f2bf(hv);
                else Hs[tl * 128 + j] = hv + bf2f(Hf[(cidx * 64 + tl) * 128 + j]); }
            hb = Am[m] * hb + Bm[m]; }
        lds_barrier();
        if (D == 1) {
#pragma unroll
            for (int i = 0; i < 2; ++i) { const int chunk = tid + 512 * i, c = chunk >> 4, cc = chunk & 15;
                const u32x4 gv = __builtin_nontemporal_load((const u32x4*)(F.PROJ() + (size_t)(t0 + c) * NPROJ + 5120 + n * 128 + cc * 8)); float g[8]; unpack8(gv, g);
                const f32x4 ha = *(const LAS f32x4*)(Hs + c * 128 + cc * 8), hb2 = *(const LAS f32x4*)(Hs + c * 128 + cc * 8 + 4);
                float o[8];
#pragma unroll
                for (int e = 0; e < 4; ++e) { o[e] = ha[e] * siluf_(g[e]); o[4 + e] = hb2[e] * siluf_(g[4 + e]); }
                *(u32x4*)(F.MIX() + (size_t)(t0 + c) * 2048 + 1024 + n * 128 + cc * 8) = pack8(o); }
            lds_barrier();
        }
    }
    if (q4 == 0) F.out[OUT_SR + (size_t)(seq * 2 + D) * 1024 + ch] = hb;
}

__device__ __forceinline__ void rg_carry_scan(CParams& p, Frame& F) {
    const int tid = F.tid;
    if (tid < 256 || tid >= 272) return;
    const int g = F.b * 16 + tid - 256; if (g >= 4096) return;
    const int seq = g >> 11, d = (g >> 10) & 1, ch = g & 1023, c_lo = 128 + seq * 64;
    const float* ag0 = F.RGAGG() + (size_t)d * 2048 + ch;
    float h = p.state_rglru[(size_t)(seq * 2 + d) * 1024 + ch];
    float* cr0 = F.CARRY() + (size_t)d * 1024 + ch;
#pragma unroll 1
    for (int u0 = 0; u0 < 64; u0 += 32) {
        float A[32], B[32];
#pragma unroll
        for (int u = 0; u < 32; ++u) { const int cc = d == 0 ? c_lo + u0 + u : c_lo + 63 - u0 - u; A[u] = ag0[(size_t)cc * 4096]; B[u] = ag0[(size_t)cc * 4096 + 1024]; }
#pragma unroll
        for (int u = 0; u < 32; ++u) { const int cc = d == 0 ? c_lo + u0 + u : c_lo + 63 - u0 - u; cr0[(size_t)cc * 2048] = h; h = A[u] * h + B[u]; }
    }
}

__device__ __forceinline__ void phase3(CParams& p, Frame& F) {
    for (int rep = 0; rep < (REP_PHASE == 30 ? 2 : 1); ++rep)
    { u32x4 rows[7]; if (F.b < 2048) p3_load_rows(F, F.b >> 3, F.b & 7, rows);
      for (int it = F.b; it < 2048; it += F.G) p3_delta_item(p, F, it >> 3, it & 7, rows, it + F.G); }
    for (int rep = 0; rep < (REP_PHASE == 31 ? 2 : 1); ++rep) {
    u32x4 rows[5]; if (F.b < 1024) rg_load_rows(F, 128 + (F.b >> 3), F.b & 7, rows);
    for (int it = F.b; it < 1024; it += F.G) rg_item<1>(p, F, 128 + (it >> 3), it & 7, rows, it + F.G); }
}

struct P4D { int valid, samp, seq, h, d, sl, ci, seq_lo, seq_hi, last, k, s, nch; };
__device__ __forceinline__ P4D p4_desc(const Frame& F, int k, int s) {
    P4D D; int item;
    if (F.G == 256) {
        const int x = F.b & 7, y = F.b >> 3;
        if (y < 16) { item = (x * 4 + (y >> 2)) * 4 + (y & 3); D.valid = k < 1; }
        else { const int j = y - 16; item = 128 + (x * 64 + (j >> 2) * 16 + k) * 4 + (j & 3); D.valid = k < 16; } }
    else { item = F.b + k * F.G; D.valid = item < 2176; }
    D.samp = item < 128; const int it = D.samp ? item : item - 128, chain = it >> 2;
    D.sl = it & 3; D.seq = chain >> 4; D.h = (chain >> 1) & 7; D.d = chain & 1;
    D.nch = D.samp ? 64 : 4; const int chunk0 = D.samp ? 128 + D.seq * 64 : D.seq * 4;
    D.seq_lo = chunk0 * 64; D.seq_hi = D.seq_lo + D.nch * 64;
    D.ci = D.d == 0 ? chunk0 + s : chunk0 + D.nch - 1 - s; D.last = s == D.nch - 1; D.k = k; D.s = s;
    return D;
}
__device__ __forceinline__ P4D p4_next(const Frame& F, const P4D& D) {
    if (D.s + 1 < D.nch) { P4D N = D; N.s = D.s + 1; N.ci = D.ci + (D.d == 0 ? 1 : -1); N.last = N.s == D.nch - 1; return N; }
    return p4_desc(F, D.k + 1, 0);
}
struct P4Pre { u32x4 k0, k1, q0, q1, ti, at; u32x2 v[4]; float g, b, bc; };
struct P4T { unsigned oKQ, oTA, oV, oG, oGc; int cj; };
__device__ __forceinline__ P4T p4_thread_consts(int tid) {
    P4T T; T.oKQ = (unsigned)(((tid >> 4) * 1024 + (tid & 15) * 8) * 2); T.oTA = (unsigned)tid * 16u;
    T.oV = (unsigned)(((tid >> 3) * NPROJ + (tid & 7) * 4) * 2); T.oG = (unsigned)(tid & 63) * 4u; T.oGc = (unsigned)(tid >> 3) * 4u; T.cj = (tid >> 3) - 2; return T;
}
__device__ __forceinline__ void p4_prefetch(CParams& p, const Frame& F, P4Pre& R, const P4D& D, const P4T& T) {
    const int tid = F.tid, t0 = D.ci * 64, h = D.h;
    const char* kb = (const char*)F.Kc() + (size_t)(D.ci * 8 + h) * 16384;
    const char* qb = (const char*)F.Qc() + ((size_t)t0 * 1024 + h * 128) * 2;
    const char* tb = (const char*)F.TA() + (size_t)(D.ci * 8 + h) * 16384;
    const char* vb = (const char*)F.PROJ() + ((long)(t0 - 2) * NPROJ + 2048 + h * 128 + D.sl * 32) * 2;
    const char* gb = (const char*)F.GB() + (size_t)(D.ci * 8 + h) * 1024 + D.d * 256;
    R.k0 = *(const u32x4*)(kb + T.oTA); R.k1 = *(const u32x4*)(kb + T.oTA + 8192u);
    R.q0 = *(const u32x4*)(qb + T.oKQ); R.q1 = *(const u32x4*)(qb + T.oKQ + 65536u);
    R.ti = *(const u32x4*)(tb + T.oTA); R.at = *(const u32x4*)(tb + T.oTA + 8192u);
#pragma unroll
    for (int j = 0; j < 4; ++j) { const int tok = t0 + T.cj + j; u32x2 v = {0u, 0u};
        if (tok >= D.seq_lo && tok < D.seq_hi) v = *(const u32x2*)(vb + T.oV + (unsigned)(j * NPROJ * 2));
        R.v[j] = v; }
    R.bc = *(const float*)(gb + 512 + T.oGc);
    R.g = 0.f; R.b = 0.f;
    if (tid < 64) { R.g = *(const float*)(gb + T.oG); R.b = *(const float*)(gb + 512 + T.oG); }
}
__device__ __forceinline__ u32x4 tri_mask(u32x4 v, int c, int s0, int d) {
    unsigned w[4] = {v.x, v.y, v.z, v.w};
#pragma unroll
    for (int i = 0; i < 4; ++i) { const int slo = s0 + 2 * i, shi = slo + 1;
        const bool klo = d == 0 ? (c >= slo) : (c <= slo), khi = d == 0 ? (c >= shi) : (c <= shi);
        w[i] &= (klo ? 0x0000FFFFu : 0u) | (khi ? 0xFFFF0000u : 0u); }
    return (u32x4){w[0], w[1], w[2], w[3]};
}
constexpr int P4_KS = 0, P4_TI = 17408, P4_VBT = 26624, P4_WL = 31232, P4_SB = 48640, P4_VT1 = 57344, P4_VT2 = 61952, P4_QS = 66560, P4_AT = 101376, P4_GV = 119808, P4_KT = 122368;
__device__ __forceinline__ void p4_stage(CParams& p, const Frame& F, const P4Pre& R, const P4D& D, int buf, const unsigned (&mk)[2][4], f32x4 (&cw)[4], const f32x4 (&cwn)[4]) {
    const int tid = F.tid, d = D.d;
    LAS unsigned char* Ks = F.lds + P4_KS; LAS unsigned char* Qs = F.lds + P4_QS + buf * 17408; LAS unsigned char* TIs = F.lds + P4_TI;
    LAS unsigned char* ATs = F.lds + P4_AT + buf * 9216; LAS unsigned char* Vbt = F.lds + P4_VBT; LAS float* gv = (LAS float*)(F.lds + P4_GV + buf * 1280);
    { const int row = tid >> 4, cc = tid & 15;
      *(LAS u32x4*)(Qs + row * 272 + cc * 16) = R.q0; *(LAS u32x4*)(Qs + (32 + row) * 272 + cc * 16) = R.q1; }
    { const int dk = tid >> 3, cp = tid & 7; LAS unsigned char* Kts = F.lds + P4_KT;
      *(LAS u32x4*)(Kts + dk * 144 + cp * 16) = R.k0; *(LAS u32x4*)(Kts + (64 + dk) * 144 + cp * 16) = R.k1; }
    { const int c = tid >> 3, s0 = (tid & 7) * 8;
      const unsigned m0 = d ? mk[1][0] : mk[0][0], m1 = d ? mk[1][1] : mk[0][1], m2 = d ? mk[1][2] : mk[0][2], m3 = d ? mk[1][3] : mk[0][3];
      *(LAS u32x4*)(TIs + c * 144 + s0 * 2) = (u32x4){R.ti.x & m0, R.ti.y & m1, R.ti.z & m2, R.ti.w & m3};
      *(LAS u32x4*)(ATs + c * 144 + s0 * 2) = (u32x4){R.at.x & m0, R.at.y & m1, R.at.z & m2, R.at.w & m3}; }
    { const int c = tid >> 3, e0 = (tid & 7) * 4; float o[4] = {0.f, 0.f, 0.f, 0.f};
      if (D.s == 0) {
#pragma unroll
          for (int j = 0; j < 4; ++j) cw[j] = cwn[j]; }
#pragma unroll
      for (int j = 0; j < 4; ++j) { const u32x2 v = R.v[j];
          o[0] += cw[j][0] * __uint_as_float(v.x << 16); o[1] += cw[j][1] * __uint_as_float(v.x & 0xffff0000u);
          o[2] += cw[j][2] * __uint_as_float(v.y << 16); o[3] += cw[j][3] * __uint_as_float(v.y & 0xffff0000u); }
#pragma unroll
      for (int i = 0; i < 4; ++i) ((LAS bf16_t*)Vbt)[(e0 + i) * 72 + c] = f2bf(siluf_(o[i]) * R.bc); }
    if (tid < 64) {
        const float glast = __shfl(R.g, d == 0 ? 63 : 0), eg = __expf(R.g);
        gv[tid] = eg; gv[64 + tid] = R.b * eg; gv[128 + tid] = __expf(glast - R.g); if (tid == 0) gv[192] = __expf(glast);
    }
}
__device__ __forceinline__ void phase4_chains(CParams& p, Frame& F) {
    const int tid = F.tid, lane = F.lane, wave = F.wave, q4 = lane >> 4, l15 = lane & 15;
    LAS unsigned char* Ks = F.lds + P4_KS; LAS unsigned char* TIs = F.lds + P4_TI; LAS unsigned char* Vbt = F.lds + P4_VBT; LAS unsigned char* Wl = F.lds + P4_WL;
    LAS unsigned char* Sb = F.lds + P4_SB; LAS unsigned char* Vt1 = F.lds + P4_VT1; LAS unsigned char* Vt2 = F.lds + P4_VT2;
    const int ct = wave & 3, et = wave >> 2;
    P4D Dc = p4_desc(F, 0, 0);
    if (!Dc.valid) return;
    P4Pre RA, RB;
    f32x4 S[2], U; bf16x8 KT[2];
    unsigned mk[2][4]; f32x4 cw[4], cwn[4];
    { const int c = tid >> 3, s0 = (tid & 7) * 8;
#pragma unroll
      for (int i = 0; i < 4; ++i) { const int slo = s0 + 2 * i, shi = slo + 1;
          mk[0][i] = (c >= slo ? 0x0000FFFFu : 0u) | (c >= shi ? 0xFFFF0000u : 0u); mk[1][i] = (c <= slo ? 0x0000FFFFu : 0u) | (c <= shi ? 0xFFFF0000u : 0u); } }
#define P4_INIT_S(D) do { _Pragma("unroll") for (int nt = 0; nt < 2; ++nt) _Pragma("unroll") for (int r = 0; r < 4; ++r) \
        S[nt][r] = (D).samp ? p.state_delta[(size_t)(((D).seq * 2 + (D).d) * 8 + (D).h) * 16384 + (size_t)(wave * 16 + q4 * 4 + r) * 128 + (D).sl * 32 + nt * 16 + l15] : 0.f; } while (0)
#define P4_WRITE_SB() do { _Pragma("unroll") for (int nt = 0; nt < 2; ++nt) { u32x2 o_; o_.x = pk2(S[nt][0], S[nt][1]); o_.y = pk2(S[nt][2], S[nt][3]); \
        *(LAS u32x2*)(Sb + (nt * 16 + l15) * 272 + (wave * 16 + q4 * 4) * 2) = o_; } } while (0)
#define P4_PRECOMP(buf_) do { const LAS float* gv_ = (const LAS float*)(F.lds + P4_GV + (buf_) * 1280); \
        f32x4 WT[4]; _Pragma("unroll") for (int c_ = 0; c_ < 4; ++c_) WT[c_] = (f32x4){0.f, 0.f, 0.f, 0.f}; \
        _Pragma("unroll") for (int ks = 0; ks < 2; ++ks) { \
            const u32x4 kraw = *(const LAS u32x4*)(F.lds + P4_KT + (wave * 16 + l15) * 144 + ks * 64 + q4 * 16); KT[ks] = __builtin_bit_cast(bf16x8, kraw); \
            const f32x4 sa = *(const LAS f32x4*)(gv_ + 64 + ks * 32 + q4 * 8), sb_ = *(const LAS f32x4*)(gv_ + 64 + ks * 32 + q4 * 8 + 4); \
            float kf[8]; unpack8(kraw, kf); u32x4 kg; \
            kg.x = pk2(kf[0] * sa[0], kf[1] * sa[1]); kg.y = pk2(kf[2] * sa[2], kf[3] * sa[3]); kg.z = pk2(kf[4] * sb_[0], kf[5] * sb_[1]); kg.w = pk2(kf[6] * sb_[2], kf[7] * sb_[3]); \
            const bf16x8 akg = __builtin_bit_cast(bf16x8, kg); \
            _Pragma("unroll") for (int c_ = 0; c_ < 4; ++c_) { const bf16x8 bt = ldfrag(TIs, 144, c_ * 16 + l15, ks * 64 + q4 * 16); WT[c_] = MFMA16(akg, bt, WT[c_]); } } \
        _Pragma("unroll") for (int c_ = 0; c_ < 4; ++c_) { u32x2 o_; o_.x = pk2(WT[c_][0], WT[c_][1]); o_.y = pk2(WT[c_][2], WT[c_][3]); \
            *(LAS u32x2*)(Wl + (c_ * 16 + l15) * 272 + (wave * 16 + q4 * 4) * 2) = o_; } \
        U = (f32x4){0.f, 0.f, 0.f, 0.f}; \
        _Pragma("unroll") for (int ks = 0; ks < 2; ++ks) { const bf16x8 a_ = ldfrag(TIs, 144, ct * 16 + l15, ks * 64 + q4 * 16), b_ = ldfrag(Vbt, 144, et * 16 + l15, ks * 64 + q4 * 16); U = MFMA16(a_, b_, U); } } while (0)

    const P4T T = p4_thread_consts(tid);
    p4_prefetch(p, F, RA, Dc, T);
    P4_INIT_S(Dc);
    { const int e0 = (tid & 7) * 4;
#pragma unroll
      for (int j = 0; j < 4; ++j) cwn[j] = *(const f32x4*)(p.dn_conv_w + j * 3072 + 2048 + Dc.h * 128 + Dc.sl * 32 + e0); }
    p4_stage(p, F, RA, Dc, 0, mk, cw, cwn);
    P4_WRITE_SB();
    P4D Dn = p4_next(F, Dc);
    if (Dn.valid) p4_prefetch(p, F, RA, Dn, T);
    P4D Dnn = Dn; if (Dn.valid) { Dnn = p4_next(F, Dn); if (Dnn.valid) p4_prefetch(p, F, RB, Dnn, T); }
    lds_barrier();
    P4_PRECOMP(0);
    lds_barrier();
    int buf = 0;
#define P4_BODY(RX) { \
        const LAS float* gv = (const LAS float*)(F.lds + P4_GV + buf * 1280); \
        const LAS unsigned char* Qs = F.lds + P4_QS + buf * 17408; const LAS unsigned char* ATs = F.lds + P4_AT + buf * 9216; \
        const int c0 = ct * 16 + q4 * 4, e = et * 16 + l15; \
         \
        f32x4 p1 = {0.f, 0.f, 0.f, 0.f}, oacc = {0.f, 0.f, 0.f, 0.f}; \
_Pragma("unroll") \
        for (int ks = 0; ks < 4; ++ks) { const bf16x8 bs = ldfrag(Sb, 272, et * 16 + l15, ks * 64 + q4 * 16); \
            const bf16x8 aw = ldfrag(Wl, 272, ct * 16 + l15, ks * 64 + q4 * 16), aq = ldfrag(Qs, 272, ct * 16 + l15, ks * 64 + q4 * 16); \
            p1 = MFMA16(aw, bs, p1); oacc = MFMA16(aq, bs, oacc); } \
        { float vn[4]; \
_Pragma("unroll") \
          for (int r = 0; r < 4; ++r) vn[r] = U[r] - p1[r]; \
          u32x2 o1, o2; o1.x = pk2(vn[0], vn[1]); o1.y = pk2(vn[2], vn[3]); \
          o2.x = pk2(vn[0] * gv[128 + c0], vn[1] * gv[128 + c0 + 1]); o2.y = pk2(vn[2] * gv[128 + c0 + 2], vn[3] * gv[128 + c0 + 3]); \
          *(LAS u32x2*)(Vt1 + e * 144 + c0 * 2) = o1; *(LAS u32x2*)(Vt2 + e * 144 + c0 * 2) = o2; } \
_Pragma("unroll") \
        for (int r = 0; r < 4; ++r) oacc[r] *= gv[c0 + r]; \
        P4D D3 = Dnn; \
        if (Dn.valid) { p4_stage(p, F, RX, Dn, buf ^ 1, mk, cw, cwn); \
            if (Dn.last && Dnn.valid) { const int e0_ = (tid & 7) * 4; _Pragma("unroll") for (int j = 0; j < 4; ++j) cwn[j] = *(const f32x4*)(p.dn_conv_w + j * 3072 + 2048 + Dnn.h * 128 + Dnn.sl * 32 + e0_); } if (Dnn.valid) { D3 = p4_next(F, Dnn); if (D3.valid) p4_prefetch(p, F, RX, D3, T); } } \
        lds_barrier(); \
         \
        { const float gl = gv[192]; \
_Pragma("unroll") \
          for (int nt = 0; nt < 2; ++nt) S[nt] *= gl; \
_Pragma("unroll") \
          for (int ks = 0; ks < 2; ++ks) \
_Pragma("unroll") \
              for (int nt = 0; nt < 2; ++nt) { const bf16x8 b_ = ldfrag(Vt2, 144, nt * 16 + l15, ks * 64 + q4 * 16); S[nt] = MFMA16(KT[ks], b_, S[nt]); } } \
_Pragma("unroll") \
        for (int ks = 0; ks < 2; ++ks) { const bf16x8 a_ = ldfrag(ATs, 144, ct * 16 + l15, ks * 64 + q4 * 16), b_ = ldfrag(Vt1, 144, et * 16 + l15, ks * 64 + q4 * 16); oacc = MFMA16(a_, b_, oacc); } \
_Pragma("unroll") \
        for (int r = 0; r < 4; ++r) *(bf16_t*)((char*)F.PROJ() + ((size_t)Dc.ci * 64 * NPROJ + Dc.d * 1024 + Dc.h * 128 + Dc.sl * 32) * 2 + (unsigned)(((c0 + r) * NPROJ + e) * 2)) = f2bf(oacc[r]); \
        if (Dc.last) { \
            if (!Dc.samp) { \
_Pragma("unroll") \
                for (int nt = 0; nt < 2; ++nt) \
_Pragma("unroll") \
                    for (int r = 0; r < 4; ++r) \
                        F.out[OUT_SD + (size_t)((Dc.seq * 2 + Dc.d) * 8 + Dc.h) * 16384 + (size_t)(wave * 16 + q4 * 4 + r) * 128 + Dc.sl * 32 + nt * 16 + l15] = S[nt][r]; \
            } \
            if (Dn.valid) P4_INIT_S(Dn); \
        } \
        P4_WRITE_SB(); \
        if (Dn.valid) P4_PRECOMP(buf ^ 1); \
        lds_barrier(); \
        if (!Dn.valid) break; \
        Dc = Dn; Dn = Dnn; Dnn = D3; buf ^= 1; \
    }
#pragma unroll 1
    for (;;) { P4_BODY(RA) P4_BODY(RB) }
#undef P4_BODY
#undef P4_INIT_S
#undef P4_WRITE_SB
#undef P4_PRECOMP
}
__device__ __forceinline__ void phase4(CParams& p, Frame& F) {
    if (F.G == 256) rg_carry_scan(p, F);
    else if (F.b == 0) {
        for (int g = F.tid; g < 69632; g += 512) { int samp = g >= 65536, gg = samp ? g - 65536 : g, seq = gg >> 11, d = (gg >> 10) & 1, ch = gg & 1023;
            const int nch = samp ? 64 : 4, c_lo = samp ? 128 + seq * 64 : seq * 4; float h = samp ? p.state_rglru[(size_t)(seq * 2 + d) * 1024 + ch] : 0.f;
            for (int i = 0; i < nch; ++i) { const int cc = d == 0 ? c_lo + i : c_lo + nch - 1 - i; const float* ag = F.RGAGG() + (size_t)(cc * 2 + d) * 2048; F.CARRY()[(size_t)(cc * 2 + d) * 1024 + ch] = h; h = ag[ch] * h + ag[1024 + ch]; } } }
    __syncthreads();
    phase4_chains(p, F);
}

__device__ __forceinline__ void phase5(CParams& p, Frame& F) {
    const int lane = F.lane;
    float nw[16];
#pragma unroll
    for (int q = 0; q < 4; ++q) { const f32x4 a = *(const f32x4*)(p.dn_norm_w + (lane & 7) * 16 + q * 4); nw[q * 4] = a[0]; nw[q * 4 + 1] = a[1]; nw[q * 4 + 2] = a[2]; nw[q * 4 + 3] = a[3]; }
#pragma unroll 4
    for (int tok = F.b * 8 + F.wave; tok < NTOK; tok += F.G * 8) {
        const bf16_t* pr = F.PROJ() + (size_t)tok * NPROJ + lane * 16;
        float o[16], z[16]; float ss = 0.f;
#pragma unroll
        for (int hf = 0; hf < 2; ++hf) { const u32x4 a = __builtin_nontemporal_load((const u32x4*)(pr + hf * 8)), b = __builtin_nontemporal_load((const u32x4*)(pr + 1024 + hf * 8)), zz = __builtin_nontemporal_load((const u32x4*)(pr + 3072 + hf * 8));
            float fa[8], fb[8], fz[8]; unpack8(a, fa); unpack8(b, fb); unpack8(zz, fz);
#pragma unroll
            for (int e = 0; e < 8; ++e) { o[hf * 8 + e] = fa[e] + fb[e]; z[hf * 8 + e] = fz[e]; ss += o[hf * 8 + e] * o[hf * 8 + e]; } }
        ss += __shfl_xor(ss, 1); ss += __shfl_xor(ss, 2); ss += __shfl_xor(ss, 4);
        const float rs = rsqrtf(ss * (1.f / 128.f) + 1e-6f);
#pragma unroll
        for (int hf = 0; hf < 2; ++hf) { float w[8];
#pragma unroll
            for (int e = 0; e < 8; ++e) w[e] = o[hf * 8 + e] * rs * nw[hf * 8 + e] * siluf_(z[hf * 8 + e]);
            *(u32x4*)(F.MIX() + (size_t)tok * 2048 + lane * 16 + hf * 8) = pack8(w); }
    }
    __syncthreads();
    for (int it = F.b; it < 1024; it += F.G) { u32x4 rows[5]; rg_load_rows(F, 128 + (it >> 3), it & 7, rows); rg_item<3>(p, F, 128 + (it >> 3), it & 7, rows, it + F.G); }
    for (int it = F.b; it < 256; it += F.G) { rg_prompt_dir<0>(p, F, it >> 3, it & 7); rg_prompt_dir<1>(p, F, it >> 3, it & 7); }

}

__device__ __forceinline__ void phase6(CParams& p, Frame& F) {
    pg8::Gemm g{F.MIX(), F.WoutT(), NTOK, 1024, 2048}; pg8::StaticOrder S; S.init(NTOK, 1024, F.G, F.b); pg8::EpiBf16 E{F.PROJ(), NPROJ};
    pg8::gemm_phase<pg8::EpiBf16, pg8::StaticOrder>(F.lds, g, S, E);
}

__device__ __forceinline__ void phase7(CParams& p, Frame& F) {
    LAS float* gt = (LAS float*)F.lds;
    for (int tb = F.b; tb < 256; tb += F.G) {
        const int grp = grp_of_block(tb);
        for (int j = F.tid; j < 1024; j += 512) gt[j] = mod_val(p, F, grp, 2048 + j) * p.post_w[j];
        __syncthreads();
#pragma unroll 2
        for (int i = 0; i < 8; ++i) {
            const int tok = tb * 64 + F.wave * 8 + i;
            const float* xr = tok < 8192 ? p.x_prompt + (size_t)tok * 1024 : p.x_sample + (size_t)(tok - 8192) * 1024;
            const bf16_t* yr = F.PROJ() + (size_t)tok * NPROJ;
            f32x4 y[4]; float ss = 0.f;
#pragma unroll
            for (int q = 0; q < 4; ++q) { const u32x2 yb = __builtin_nontemporal_load((const u32x2*)(yr + F.lane * 4 + 256 * q));
                y[q] = (f32x4){__uint_as_float(yb.x << 16), __uint_as_float(yb.x & 0xffff0000u), __uint_as_float(yb.y << 16), __uint_as_float(yb.y & 0xffff0000u)}; ss += (y[q][0] * y[q][0] + y[q][1] * y[q][1]) + (y[q][2] * y[q][2] + y[q][3] * y[q][3]); }
            const float rstd = rsqrtf(wave_sum(ss) * (1.f / 1024.f) + 1e-6f);
#pragma unroll
            for (int q = 0; q < 4; ++q) { const int j = F.lane * 4 + 256 * q; f32x4 v = __builtin_nontemporal_load((const f32x4*)(xr + j));
                if (tok >= 8192) { const int pp = (tok - 8192) & 4095; const int vv = (q < 2) ? (pp >> 6) : (pp & 63);
                    v += *(const f32x4*)(F.pe() + ((q & 1) ? 16384 : 0) + vv * 256 + F.lane * 4); }
                const f32x4 g4 = *(const LAS f32x4*)(gt + j);
                f32x4 ov = v + g4 * (y[q] * rstd); ov[0] = fin(ov[0]); ov[1] = fin(ov[1]); ov[2] = fin(ov[2]); ov[3] = fin(ov[3]); if (!(LIVE_MASK & 1)) ov = (f32x4){0.f, 0.f, 0.f, 0.f}; __builtin_nontemporal_store(ov, (f32x4*)(F.out + (size_t)tok * 1024 + j)); }
        }
        __syncthreads();
    }
}

__device__ __forceinline__ void phase8(CParams& p, Frame& F) {
    if (F.b == 0 && F.tid == 0) { int code = 0; for (int k = 31; k >= 1; --k) if (DG(F)[k]) code = k; F.out[OUT_SR] = 1000.f * (float)code + 500.f; }
}
extern __shared__ __attribute__((aligned(16))) unsigned char smem_raw[];
__global__ void __launch_bounds__(512) fwd_megakernel(Params p_unused) {
    CParams& p = *(CParams*)__builtin_amdgcn_kernarg_segment_ptr();
    Frame F;
    F.lds = (LAS unsigned char*)smem_raw;
    F.tid = threadIdx.x; F.lane = F.tid & 63; F.wave = __builtin_amdgcn_readfirstlane(F.tid >> 6); F.G = gridDim.x; F.b = blockIdx.x;
    F.out = p.out; F.ws = p.ws;
    volatile LAS unsigned* xbw = (volatile LAS unsigned*)(F.lds + LDS_BYTES - 16);
    const bool multi = (p.ph_hi - p.ph_lo) > 1;
    XcdBarrier xb; xb.bar = (unsigned*)(p.ws + WS_CTL); xb.x = 0; xb.st = xbw;
    if (multi) {
        if (F.tid == 0) { xbw[0] = 0u; xbw[1] = 0u; xbw[2] = 0u; xbw[3] = 0u; }
        __syncthreads();
        xb = xcd_barrier_post((unsigned*)(p.ws + WS_CTL), xbw);
    }
#ifndef PHMASK
#define PHMASK 511
#endif
    const int lo = p.ph_lo, hi = p.ph_hi;
#ifndef REP_PHASE
#define REP_PHASE -1
#endif
#define RUN_PHASE(k, fn) do { if (lo <= (k) && (k) < hi) { if (PHMASK & (1 << (k))) fn(p, F); if ((k) == REP_PHASE) { __syncthreads(); fn(p, F); } if ((k) + 1 < hi) xcd_barrier(xb); } } while (0)
    RUN_PHASE(0, phase0); RUN_PHASE(1, phase1); RUN_PHASE(2, phase2); RUN_PHASE(3, phase3);
    RUN_PHASE(4, phase4); RUN_PHASE(5, phase5); RUN_PHASE(6, phase6); RUN_PHASE(7, phase7); RUN_PHASE(8, phase8);
}

extern "C" void kernel_launch(void* const* d_in, const int* in_sizes, int n_in, void* d_out, int out_size, void* d_ws, size_t ws_size, hipStream_t stream) {
    static int grid = 0;
    if (grid == 0) {
        int dev = 0, cus = 0;
        if (hipGetDevice(&dev) != hipSuccess || hipDeviceGetAttribute(&cus, hipDeviceAttributeMultiprocessorCount, dev) != hipSuccess) { fprintf(stderr, "kernel_launch: device query failed\n"); grid = -1; return; }
        if (hipFuncSetAttribute((const void*)fwd_megakernel, hipFuncAttributeMaxDynamicSharedMemorySize, LDS_BYTES) != hipSuccess) { fprintf(stderr, "kernel_launch: hipFuncSetAttribute failed\n"); grid = -1; return; }
        int per_cu = 0;
        if (hipOccupancyMaxActiveBlocksPerMultiprocessor(&per_cu, (const void*)fwd_megakernel, 512, LDS_BYTES) != hipSuccess || per_cu < 1) { fprintf(stderr, "kernel_launch: occupancy query says %d blocks per CU\n", per_cu); (void)hipGetLastError(); }
        grid = cus;
    }
    if (grid < 0) return;
    Params p{};
    const float** pp = (const float**)&p;
    for (int i = 0; i < 23; ++i) pp[i] = (const float*)d_in[i];
    p.out = (float*)d_out; p.ws = (unsigned char*)d_ws;
    (void)hipMemsetAsync((char*)d_ws + WS_CTL, 0, 16384, stream);
#if MK_SINGLE
    p.ph_lo = 0; p.ph_hi = NPH;
    void* args[] = {&p};
    hipError_t e = hipLaunchCooperativeKernel((const void*)fwd_megakernel, dim3(grid), dim3(512), args, LDS_BYTES, stream);
    if (e != hipSuccess) fprintf(stderr, "cooperative launch failed: %s (grid %d)\n", hipGetErrorString(e), grid);
#else
    for (int ph = 0; ph < NPH; ++ph) {
        p.ph_lo = ph; p.ph_hi = ph + 1;
        hipLaunchKernelGGL(fwd_megakernel, dim3(grid), dim3(512), LDS_BYTES, stream, p);
    }
#endif
}
```

```cpp
#include <hip/hip_runtime.h>
#include <cstdio>
#include <cstdint>

#define LAS __attribute__((address_space(3)))
typedef unsigned short bf16_t;
typedef short bf16x8 __attribute__((ext_vector_type(8)));
typedef float f32x4 __attribute__((ext_vector_type(4)));
typedef unsigned u32x4 __attribute__((ext_vector_type(4)));
typedef unsigned u32x2 __attribute__((ext_vector_type(2)));

#ifndef REP_PHASE
#define REP_PHASE -1
#endif
#ifndef MK_SINGLE
#define MK_SINGLE 1
#endif

constexpr int NTOK = 16384, DM = 1024, NPROJ = 6144, DIN = 6176;
constexpr int NPH = 8;
constexpr int LDS_BYTES = 160 * 1024;
constexpr size_t OUT_YP = 0, OUT_YS = 8388608, OUT_SD = 16777216, OUT_SR = 25165824;
constexpr size_t WS_CTL = 0, WS_MODP = 16384, WS_PE = 606208, WS_BA = 737280, WS_GB = 2834432, WS_RGAGG = 4931584,
                 WS_WBAT = 9125888, WS_WOUTT = 9191424, WS_GT = 13385728, WS_WINT = 14434304, WS_TA = 27017216, WS_PROJ = 60571648, WS_CARRY = 261898240;

struct Params {
    const float *x_prompt, *x_sample, *state_delta, *state_rglru, *c, *c_ctx, *ada_w, *ada_b, *pre_w, *post_w, *w_in, *w_out,
                *dn_conv_w, *dn_a_log, *dn_dt_bias, *dn_norm_w, *rg_conv_w, *rg_conv_b, *rg_w_r, *rg_b_r, *rg_w_i, *rg_b_i, *rg_lam;
    float* out; unsigned char* ws;
    int ph_lo, ph_hi;
};

__device__ __forceinline__ float bf2f(unsigned short b) { return __uint_as_float(((unsigned)b) << 16); }
typedef __bf16 bf2_t __attribute__((ext_vector_type(2)));
typedef float f2_t __attribute__((ext_vector_type(2)));
__device__ __forceinline__ unsigned pk2(float lo, float hi) { const f2_t v = {lo, hi}; return __builtin_bit_cast(unsigned, __builtin_convertvector(v, bf2_t)); }
__device__ __forceinline__ unsigned short f2bf(float f) { return (unsigned short)(pk2(f, f) & 0xffffu); }
#ifndef SANITIZE
#define SANITIZE 0
#endif
#ifndef LIVE_MASK
#define LIVE_MASK 15
#endif
__device__ __forceinline__ float fin(float x) { return (SANITIZE && ((__float_as_uint(x) & 0x7f800000u) == 0x7f800000u)) ? 0.f : x; }
#define DG(F) ((unsigned*)((F).ws + WS_CTL))
__device__ __forceinline__ bool badv(float x, float lim) { return ((__float_as_uint(x) & 0x7f800000u) == 0x7f800000u) || fabsf(x) > lim; }
#ifndef DIAG
#define DIAG 0
#endif
#define CHK(F, k, bad) do { if (DIAG && (bad)) DG(F)[k] = 1u; } while (0)
__device__ __forceinline__ float sigm(float x) { return __builtin_amdgcn_rcpf(1.f + __expf(-x)); }
__device__ __forceinline__ float siluf_(float x) { return x * __builtin_amdgcn_rcpf(1.f + __expf(-x)); }
__device__ __forceinline__ float softplusf_(float x) { return x > 20.f ? x : log1pf(__expf(x)); }
__device__ __forceinline__ void unpack8(const u32x4 v, float (&f)[8]) {
    f[0] = __uint_as_float(v.x << 16); f[1] = __uint_as_float(v.x & 0xffff0000u);
    f[2] = __uint_as_float(v.y << 16); f[3] = __uint_as_float(v.y & 0xffff0000u);
    f[4] = __uint_as_float(v.z << 16); f[5] = __uint_as_float(v.z & 0xffff0000u);
    f[6] = __uint_as_float(v.w << 16); f[7] = __uint_as_float(v.w & 0xffff0000u);
}
__device__ __forceinline__ u32x4 pack8(const float (&f)[8]) { u32x4 o; o.x = pk2(f[0], f[1]); o.y = pk2(f[2], f[3]); o.z = pk2(f[4], f[5]); o.w = pk2(f[6], f[7]); return o; }
__device__ __forceinline__ float wave_sum(float v) {
#pragma unroll
    for (int o = 1; o < 64; o <<= 1) v += __shfl_xor(v, o);
    return v;
}
__device__ __forceinline__ void lds_barrier() { asm volatile("s_waitcnt lgkmcnt(0)" ::: "memory"); __builtin_amdgcn_s_barrier(); asm volatile("" ::: "memory"); }
#define MFMA16(a, b, c) __builtin_amdgcn_mfma_f32_16x16x32_bf16((a), (b), (c), 0, 0, 0)
#define LDS_WAIT() asm volatile("s_waitcnt lgkmcnt(0)" ::: "memory")
__device__ __forceinline__ bf16x8 ldfrag(const LAS unsigned char* base, int pitch, int row, int kb) { return *(const LAS bf16x8*)(base + row * pitch + kb); }

#define XB_TMO      128
#define XB_XCNT(j)  (256  + 64 * (j))
#define XB_XSUB(j)  (1280 + 64 * (j))
#define XB_XGEN(j)  (2304 + 64 * (j))
#define XB_TOP      3328
#define XB_TOPGEN   3392
#define XCD_BAR_WORDS 3456
#define XB_SPIN_CAP (1u << 18)
__device__ __forceinline__ unsigned xb_ld(unsigned* p)              { return __hip_atomic_load(p, __ATOMIC_RELAXED, __HIP_MEMORY_SCOPE_AGENT); }
__device__ __forceinline__ unsigned xb_add(unsigned* p, unsigned v) { return __hip_atomic_fetch_add(p, v, __ATOMIC_RELAXED, __HIP_MEMORY_SCOPE_AGENT); }
__device__ __forceinline__ unsigned xb_xcc_id() { return (unsigned)__builtin_amdgcn_s_getreg((3 << 11) | 20) & 0xFu; }
#define XB_SPIN(cond, bar) do { unsigned _sp = 0; while (cond) { __builtin_amdgcn_s_sleep(1); \
    if ((++_sp & 255u) == 0u) { if (xb_ld(&(bar)[XB_TMO])) break; if (_sp > XB_SPIN_CAP) { atomicAdd(&(bar)[XB_TMO], 1u); break; } } } } while (0)
struct XcdBarrier { unsigned* bar; unsigned x; volatile LAS unsigned* st; };
__device__ __forceinline__ XcdBarrier xcd_barrier_post(unsigned* bar, volatile LAS unsigned* st) {
    XcdBarrier b; b.bar = bar; b.x = xb_xcc_id(); b.st = st;
    if (threadIdx.x == 0) (void)xb_add(&bar[XB_XCNT(b.x)], 1u);
    return b;
}
__device__ __forceinline__ void xcd_barrier_complete(unsigned* bar, unsigned x, unsigned& nloc, unsigned& nx) {
    const unsigned G = gridDim.x * gridDim.y * gridDim.z;
    unsigned sum, cnt, mine, sp = 0u;
    for (;;) {
        sum = 0u; cnt = 0u; mine = 0u;
#pragma unroll
        for (unsigned j = 0; j < 16; ++j) { const unsigned c = xb_ld(&bar[XB_XCNT(j)]); sum += c; cnt += (c > 0u) ? 1u : 0u; mine = (j == x) ? c : mine; }
        if (sum == G) break;
        __builtin_amdgcn_s_sleep(1);
        if ((++sp & 255u) == 0u) { if (xb_ld(&bar[XB_TMO])) break; if (sp > XB_SPIN_CAP) { atomicAdd(&bar[XB_TMO], 1u); break; } }
    }
    nloc = mine > 0u ? mine : 1u; nx = cnt > 0u ? cnt : 1u;
}
__device__ __forceinline__ void xcd_barrier(const XcdBarrier& b) {
    asm volatile("s_waitcnt vmcnt(0)" ::: "memory");
    __syncthreads();
    if (threadIdx.x == 0) {
        unsigned* bar = b.bar;
        __builtin_amdgcn_s_waitcnt(0);
        unsigned nloc = b.st[0], nx = b.st[1];
        if (nloc == 0u) { xcd_barrier_complete(bar, b.x, nloc, nx); b.st[0] = nloc; b.st[1] = nx; }
        const unsigned old = xb_add(&bar[XB_XSUB(b.x)], 1u);
        const unsigned gen = old / nloc;
        if (old + 1u == (gen + 1u) * nloc) {
            __builtin_amdgcn_fence(__ATOMIC_RELEASE, "agent");
            asm volatile("s_waitcnt vmcnt(0)" ::: "memory");
            const unsigned og = xb_add(&bar[XB_TOP], 1u);
            const unsigned tg = og / nx;
            if (og + 1u == (tg + 1u) * nx) xb_add(&bar[XB_TOPGEN], 1u);
            else XB_SPIN(xb_ld(&bar[XB_TOPGEN]) == tg, bar);
            __builtin_amdgcn_fence(__ATOMIC_ACQUIRE, "agent");
            xb_add(&bar[XB_XGEN(b.x)], 1u);
            asm volatile("s_waitcnt vmcnt(0)" ::: "memory");
        } else {
            XB_SPIN(xb_ld(&bar[XB_XGEN(b.x)]) == gen, bar);
            __builtin_amdgcn_fence(__ATOMIC_ACQUIRE, "agent");
            asm volatile("s_waitcnt vmcnt(0)" ::: "memory");
        }
    }
    __syncthreads();
}

namespace pg8 {
constexpr int BM = 256, BK = 64, HALF = 128, HTB = HALF * BK * 2, STAGE_BYTES = 8 * HTB, NXCD = 8, WGM = 8;
__host__ __device__ __forceinline__ int lds_byte(int r, int c) { const int st = (r >> 4) * 2 + (c >> 5), rr = r & 15, cc = c & 31, ob = rr * 64 + cc * 2; return st * 1024 + (ob ^ (((ob >> 9) & 1) << 5)); }
__host__ __device__ __forceinline__ void stage_rc(int b, int& R, int& C) { const int st = b / 1024, sb = b % 1024, swz = sb ^ (((sb >> 9) & 1) << 5); R = (st >> 1) * 16 + swz / 64; C = (st & 1) * 32 + (swz % 64) / 2; }
__host__ __device__ __forceinline__ int perm32(int rho) { const int n = rho >> 4, i = rho & 15; return 8 * (i >> 2) + 4 * n + (i & 3); }
struct Unit { int pm, pn; };
struct Gemm { const bf16_t* A; const bf16_t* Bt; int M, N, K; };
struct StaticOrder {
    int nM, nN, nwg, G, c;
    __host__ __device__ void init(int M, int N, int G_, int c_) { nM = M / BM; nN = N / BM; nwg = nM * nN; G = G_; c = c_; }
    __host__ __device__ bool next(int i, Unit& u) const {
        const long L = (long)i * G + c; if (L >= nwg) return false;
        int wgid = (int)L; { const int q = nwg / NXCD, r = nwg % NXCD, xcd = wgid % NXCD, off = wgid / NXCD; wgid = (xcd < r ? xcd * (q + 1) : r * (q + 1) + (xcd - r) * q) + off; }
        const int nig = WGM * nN, gid = wgid / nig, fm = gid * WGM, gsz = (nM - fm) < WGM ? (nM - fm) : WGM;
        u.pm = fm + ((wgid % nig) % gsz); u.pn = (wgid % nig) / gsz; return true;
    }
};
__device__ __forceinline__ unsigned cvt_pk_bf16(float lo, float hi) { unsigned r; asm volatile("v_cvt_pk_bf16_f32 %0, %1, %2" : "=v"(r) : "v"(lo), "v"(hi)); return r; }
struct EpiF32 {
    static constexpr bool PERM = false;
    float* C; int ldc;
    __device__ __forceinline__ void operator()(const f32x4 (&acc)[2][2][4][2], const Unit& u, int wr, int wc, int fr, int fq) const {
        const int row0 = u.pm * BM + wr * 64 + fr, col0 = u.pn * BM + wc * 32 + 4 * fq;
#pragma unroll
        for (int ai = 0; ai < 2; ++ai)
#pragma unroll
            for (int m = 0; m < 4; ++m) { float* rowp = C + (size_t)(row0 + ai * HALF + m * 16) * ldc + col0;
#pragma unroll
                for (int bj = 0; bj < 2; ++bj)
#pragma unroll
                    for (int n = 0; n < 2; ++n) *(f32x4*)(rowp + bj * HALF + n * 16) = acc[ai][bj][m][n]; }
    }
};
struct EpiBf16 {
    static constexpr bool PERM = true;
    bf16_t* O; int ldc;
    __device__ __forceinline__ void operator()(const f32x4 (&acc)[2][2][4][2], const Unit& u, int wr, int wc, int fr, int fq) const {
        const int row0 = u.pm * BM + wr * 64 + fr; const int col0 = u.pn * BM + wc * 32 + 8 * fq;
#pragma unroll
        for (int ai = 0; ai < 2; ++ai)
#pragma unroll
            for (int m = 0; m < 4; ++m) { bf16_t* rowp = O + (size_t)(row0 + ai * HALF + m * 16) * ldc + col0;
#pragma unroll
                for (int bj = 0; bj < 2; ++bj) { const f32x4 v0 = acc[ai][bj][m][0], v1 = acc[ai][bj][m][1];
                    u32x4 w; w.x = cvt_pk_bf16(v0[0], v0[1]); w.y = cvt_pk_bf16(v0[2], v0[3]); w.z = cvt_pk_bf16(v1[0], v1[1]); w.w = cvt_pk_bf16(v1[2], v1[3]);
                    *(u32x4*)(rowp + bj * HALF) = w; } }
    }
};

template <class Epi, class Sched>
__device__ __forceinline__ void gemm_phase(LAS unsigned char* lds, const Gemm g, const Sched& S, const Epi& E) {
    const int tid = threadIdx.x, wid = __builtin_amdgcn_readfirstlane(tid >> 6), lane = tid & 63, wr = wid >> 2, wc = wid & 3, fr = lane & 15, fq = lane >> 4;
    const int K = g.K, nt = K / BK;
    unsigned voffA[2], voffB[2];
#pragma unroll
    for (int i = 0; i < 2; ++i) { int R, C; stage_rc(tid * 16 + i * 8192, R, C); const int Rb = Epi::PERM ? ((R & ~31) + perm32(R & 31)) : R;
        voffA[i] = (unsigned)(R * K + C) * 2u; voffB[i] = (unsigned)(Rb * K + C) * 2u; }
    const size_t kstep = (size_t)(BK * 2);
    const size_t hstep = (size_t)HALF * K * 2;
    const size_t tstep = 2 * hstep;
    const unsigned ldsw = (unsigned)wid * 1024u;
    const int aoff = lds_byte(wr * 64 + fr, fq * 8), boff = lds_byte(wc * 32 + fr, fq * 8);
#define PG8_SA(b, h) (((b) * 2 + (h)) * HTB)
#define PG8_SB(b, h) ((4 + (b) * 2 + (h)) * HTB)
#define PG8_STAGE(bufoff, gbase, voff) do { _Pragma("unroll") for (int _i = 0; _i < 2; ++_i) \
        __builtin_amdgcn_global_load_lds((const unsigned*)((const char*)(gbase) + (voff)[_i]), (LAS unsigned*)(lds + (bufoff) + ldsw + _i * 8192), 16, 0, 0); } while (0)
#define PG8_LDA(dst, b, h) do { _Pragma("unroll") for (int m = 0; m < 4; ++m) _Pragma("unroll") for (int k = 0; k < 2; ++k) dst[m][k] = *(const LAS bf16x8*)(lds + PG8_SA(b, h) + aoff + m * 2048 + k * 1024); } while (0)
#define PG8_LDB(dst, b, h) do { _Pragma("unroll") for (int n = 0; n < 2; ++n) _Pragma("unroll") for (int k = 0; k < 2; ++k) dst[n][k] = *(const LAS bf16x8*)(lds + PG8_SB(b, h) + boff + n * 2048 + k * 1024); } while (0)
#define PG8_MMA(ai, bj, At, Bt) do { __builtin_amdgcn_s_setprio(1); _Pragma("unroll") for (int m = 0; m < 4; ++m) _Pragma("unroll") for (int n = 0; n < 2; ++n) _Pragma("unroll") for (int k = 0; k < 2; ++k) \
        acc[ai][bj][m][n] = __builtin_amdgcn_mfma_f32_16x16x32_bf16(Bt[n][k], At[m][k], acc[ai][bj][m][n], 0, 0, 0); __builtin_amdgcn_s_setprio(0); } while (0)
#define PG8_WAIT_V(n) asm volatile("s_waitcnt vmcnt(" #n ")" ::: "memory")
#define PG8_WAIT_L(n) asm volatile("s_waitcnt lgkmcnt(" #n ")" ::: "memory")
#define PG8_BAR __builtin_amdgcn_s_barrier()
#define PG8_SCHED __builtin_amdgcn_sched_barrier(0)
    Unit cur, nxt; int ui = 0;
    if (!S.next(0, cur)) return;
    f32x4 acc[2][2][4][2];
#pragma unroll
    for (int a = 0; a < 2; ++a)
#pragma unroll
        for (int b = 0; b < 2; ++b)
#pragma unroll
            for (int m = 0; m < 4; ++m)
#pragma unroll
                for (int n = 0; n < 2; ++n) acc[a][b][m][n] = (f32x4){0.f, 0.f, 0.f, 0.f};
    bf16x8 At[4][2], B0[2][2], B1[2][2];
    const char* cA = (const char*)g.A + (size_t)cur.pm * tstep; const char* cB = (const char*)g.Bt + (size_t)cur.pn * tstep;
    PG8_STAGE(PG8_SB(0, 0), cB, voffB); PG8_STAGE(PG8_SA(0, 0), cA, voffA); PG8_STAGE(PG8_SB(0, 1), cB + hstep, voffB); PG8_STAGE(PG8_SA(0, 1), cA + hstep, voffA);
    if (wr == 1) PG8_BAR;
    PG8_WAIT_V(4); PG8_BAR;
    PG8_STAGE(PG8_SB(1, 0), cB + kstep, voffB); PG8_STAGE(PG8_SA(1, 0), cA + kstep, voffA); PG8_STAGE(PG8_SB(1, 1), cB + hstep + kstep, voffB);
    PG8_WAIT_V(6); PG8_BAR;
    for (;;) {
        const bool has_next = S.next(ui + 1, nxt);
        const char* nA = has_next ? (const char*)g.A + (size_t)nxt.pm * tstep : cA; const char* nB = has_next ? (const char*)g.Bt + (size_t)nxt.pn * tstep : cB;
        for (int t = 0; t < nt; t += 2) {
            const bool last = (t == nt - 2);
            const char* a1 = cA + (size_t)(t + 1) * kstep;
            const char* a2 = last ? nA : cA + (size_t)(t + 2) * kstep; const char* b2 = last ? nB : cB + (size_t)(t + 2) * kstep;
            const char* a3 = a2 + kstep; const char* b3 = b2 + kstep;
            PG8_LDB(B0, 0, 0); PG8_SCHED; PG8_LDA(At, 0, 0); PG8_STAGE(PG8_SA(1, 1), a1 + hstep, voffA);
            PG8_WAIT_L(8); PG8_BAR; PG8_WAIT_L(0); PG8_MMA(0, 0, At, B0); PG8_BAR; PG8_SCHED;
            PG8_LDB(B1, 0, 1); PG8_STAGE(PG8_SB(0, 0), b2, voffB);
            PG8_BAR; PG8_WAIT_L(0); PG8_MMA(0, 1, At, B1); PG8_BAR;
            PG8_LDA(At, 0, 1); PG8_STAGE(PG8_SA(0, 0), a2, voffA);
            PG8_BAR; PG8_WAIT_L(0); PG8_MMA(1, 0, At, B0); PG8_BAR; PG8_SCHED;
            PG8_STAGE(PG8_SB(0, 1), b2 + hstep, voffB);
            PG8_WAIT_V(6); PG8_BAR; PG8_MMA(1, 1, At, B1); PG8_BAR;
            PG8_LDB(B0, 1, 0); PG8_SCHED; PG8_LDA(At, 1, 0); PG8_STAGE(PG8_SA(0, 1), a2 + hstep, voffA);
            PG8_WAIT_L(8); PG8_BAR; PG8_WAIT_L(0); PG8_MMA(0, 0, At, B0); PG8_BAR; PG8_SCHED;
            PG8_LDB(B1, 1, 1); PG8_STAGE(PG8_SB(1, 0), b3, voffB);
            PG8_BAR; PG8_WAIT_L(0); PG8_MMA(0, 1, At, B1); PG8_BAR;
            PG8_LDA(At, 1, 1); PG8_STAGE(PG8_SA(1, 0), a3, voffA);
            PG8_BAR; PG8_WAIT_L(0); PG8_MMA(1, 0, At, B0); PG8_BAR; PG8_SCHED;
            PG8_STAGE(PG8_SB(1, 1), b3 + hstep, voffB);
            PG8_WAIT_V(6); PG8_BAR; PG8_MMA(1, 1, At, B1); PG8_BAR;
        }
        E(acc, cur, wr, wc, fr, fq);
        if (!has_next) break;
#pragma unroll
        for (int a = 0; a < 2; ++a)
#pragma unroll
            for (int b = 0; b < 2; ++b)
#pragma unroll
                for (int m = 0; m < 4; ++m)
#pragma unroll
                    for (int n = 0; n < 2; ++n) acc[a][b][m][n] = (f32x4){0.f, 0.f, 0.f, 0.f};
        cur = nxt; cA = nA; cB = nB; ++ui;
    }
    PG8_WAIT_V(0);
    if (wr == 0) PG8_BAR;
    PG8_BAR;
#undef PG8_SA
#undef PG8_SB
#undef PG8_STAGE
#undef PG8_LDA
#undef PG8_LDB
#undef PG8_MMA
#undef PG8_WAIT_V
#undef PG8_WAIT_L
#undef PG8_BAR
#undef PG8_SCHED
}
}

struct Frame {
    LAS unsigned char* lds;
    int tid, lane, wave, G, b;
    float* out; unsigned char* ws;
    __device__ __forceinline__ bf16_t* H() const { return (bf16_t*)out; }
    __device__ __forceinline__ bf16_t* Qc() const { return (bf16_t*)out; }
    __device__ __forceinline__ bf16_t* Kc() const { return (bf16_t*)(out + OUT_YS); }
    __device__ __forceinline__ bf16_t* MIX() const { return (bf16_t*)out; }
    __device__ __forceinline__ float* modp() const { return (float*)(ws + WS_MODP); }
    __device__ __forceinline__ float* pe() const { return (float*)(ws + WS_PE); }
    __device__ __forceinline__ float* BA() const { return (float*)(ws + WS_BA); }
    __device__ __forceinline__ float* GB() const { return (float*)(ws + WS_GB); }
    __device__ __forceinline__ float* RGAGG() const { return (float*)(ws + WS_RGAGG); }
    __device__ __forceinline__ bf16_t* WbaT() const { return (bf16_t*)(ws + WS_WBAT); }
    __device__ __forceinline__ bf16_t* WoutT() const { return (bf16_t*)(ws + WS_WOUTT); }
    __device__ __forceinline__ bf16_t* GT() const { return (bf16_t*)(ws + WS_GT); }
    __device__ __forceinline__ bf16_t* WinT() const { return (bf16_t*)(ws + WS_WINT); }
    __device__ __forceinline__ bf16_t* TA() const { return (bf16_t*)(ws + WS_TA); }
    __device__ __forceinline__ bf16_t* PROJ() const { return (bf16_t*)(ws + WS_PROJ); }
    __device__ __forceinline__ float* CARRY() const { return (float*)(ws + WS_CARRY); }
};
typedef const __attribute__((address_space(4))) Params CParams;

__device__ __forceinline__ int grp_of_block(int tb) { return tb < 128 ? 0 : (tb < 192 ? 1 : 2); }

__device__ __forceinline__ void transpose_item(const float* W, int N, int k0, int n0, bf16_t* WT0, int Kout, LAS float* scr, int lane) {
#pragma unroll 8
    for (int i = 0; i < 32; ++i) { const int kk = 2 * i + (lane >> 5); scr[kk * 33 + (lane & 31)] = W[(size_t)(k0 + kk) * N + n0 + (lane & 31)]; }
    LDS_WAIT();
    const int c = lane & 7;
#pragma unroll
    for (int j = 0; j < 4; ++j) { const int n = (lane >> 3) + 8 * j; const LAS float* s = scr + (8 * c) * 33 + n;
        u32x4 o; o.x = pk2(s[0 * 33], s[1 * 33]); o.y = pk2(s[2 * 33], s[3 * 33]); o.z = pk2(s[4 * 33], s[5 * 33]); o.w = pk2(s[6 * 33], s[7 * 33]);
        *(u32x4*)(WT0 + (size_t)n * Kout + k0 + 8 * c) = o; }
    LDS_WAIT();
}
struct P0Item { const float* W; bf16_t* dst; int N, k0, n0, Kout, kind; };
__device__ __forceinline__ P0Item p0_decode(CParams& p, const Frame& F, int it) {
    constexpr int I_IN = 16 * 193, I_OUT = 32 * 32, I_G = 256;
    P0Item D; D.kind = 0; int r = it;
    if (r < I_IN) { const int kb = r / 193, nb = r % 193, n0 = nb * 32;
        D.dst = n0 < 4096 ? F.WinT() + (size_t)n0 * 1024 : (n0 < 4128 ? F.WbaT() + (size_t)(n0 - 4096) * 1024 : F.WinT() + (size_t)(n0 - 32) * 1024);
        D.W = p.w_in; D.N = DIN; D.k0 = kb * 64; D.n0 = n0; D.Kout = 1024; return D; }
    r -= I_IN;
    if (r < I_OUT) { const int kb = r / 32, nb = r % 32; D.W = p.w_out; D.N = 1024; D.k0 = kb * 64; D.n0 = nb * 32; D.dst = F.WoutT() + (size_t)(nb * 32) * 2048; D.Kout = 2048; return D; }
    r -= I_OUT;
    if (r < I_G) { const int m = r >> 3, sub = r & 7, kb = sub >> 2, nb = sub & 3, g = m >> 4, dn = m & 15;
        D.W = (g ? p.rg_w_i : p.rg_w_r) + (size_t)dn * 16384; D.N = 128; D.k0 = kb * 64; D.n0 = nb * 32; D.dst = F.GT() + (size_t)m * 16384 + (size_t)(nb * 32) * 128; D.Kout = 128; return D; }
    r -= I_G;
    D.kind = 1; D.k0 = r; D.W = p.w_in; D.dst = F.WinT(); D.N = 0; D.n0 = 0; D.Kout = 0; return D;
}
__device__ __forceinline__ void p0_load(const P0Item& D, float (&v)[32], int lane) {
#pragma unroll
    for (int i = 0; i < 32; ++i) { const int kk = 2 * i + (lane >> 5); v[i] = __builtin_nontemporal_load(D.W + (size_t)(D.k0 + kk) * D.N + D.n0 + (lane & 31)); }
}
__device__ __forceinline__ void p0_store(const P0Item& D, const float (&v)[32], LAS float* scr, int lane) {
#pragma unroll
    for (int i = 0; i < 32; ++i) { const int kk = 2 * i + (lane >> 5); scr[kk * 33 + (lane & 31)] = v[i]; }
    LDS_WAIT();
    const int c = lane & 7;
#pragma unroll
    for (int j = 0; j < 4; ++j) { const int n = (lane >> 3) + 8 * j; const LAS float* s = scr + (8 * c) * 33 + n;
        u32x4 o; o.x = pk2(s[0 * 33], s[1 * 33]); o.y = pk2(s[2 * 33], s[3 * 33]); o.z = pk2(s[4 * 33], s[5 * 33]); o.w = pk2(s[6 * 33], s[7 * 33]);
        *(u32x4*)(D.dst + (size_t)n * D.Kout + D.k0 + 8 * c) = o; }
    LDS_WAIT();
}
__device__ __forceinline__ void phase0(CParams& p, Frame& F) {
    const int tid = F.tid, lane = F.lane;
    for (int it = F.b; it < 192; it += F.G) {
        const int jg = it % 12, ks = it / 12, j = jg * 256 + (tid & 255), half = tid >> 8, k0 = ks * 64 + half * 32;
        float s0 = 0.f, s1 = 0.f, s2 = 0.f;
#pragma unroll 8
        for (int k = 0; k < 32; ++k) { const int kk = k0 + k; const float w = __builtin_nontemporal_load(p.ada_w + (size_t)kk * 3072 + j);
            s0 += siluf_(p.c_ctx[kk]) * w; s1 += siluf_(p.c[kk]) * w; s2 += siluf_(p.c[1024 + kk]) * w; }
        LAS float* red = (LAS float*)F.lds;
        if (half == 1) { red[tid - 256] = s0; red[256 + tid - 256] = s1; red[512 + tid - 256] = s2; }
        __syncthreads();
        if (half == 0) { F.modp()[(size_t)(ks * 3 + 0) * 3072 + j] = s0 + red[tid]; F.modp()[(size_t)(ks * 3 + 1) * 3072 + j] = s1 + red[256 + tid]; F.modp()[(size_t)(ks * 3 + 2) * 3072 + j] = s2 + red[512 + tid]; }
        __syncthreads();
    }
    LAS float* scr = (LAS float*)(F.lds + 4096 + F.wave * 8448);
    const int gw = F.b * 8 + F.wave, NGW = F.G * 8;
    constexpr int I_IN = 16 * 193, I_OUT = 32 * 32, I_G = 256, I_PE = 64, I_ALL = I_IN + I_OUT + I_G + I_PE;
    P0Item D = p0_decode(p, F, gw), Dn = D; float v[32], vn[32];
    if (gw < I_ALL && D.kind == 0) p0_load(D, v, lane);
    for (int it = gw; it < I_ALL; it += NGW) {
        const int itn = it + NGW;
        if (itn < I_ALL) { Dn = p0_decode(p, F, itn); if (Dn.kind == 0) p0_load(Dn, vn, lane); }
        if (D.kind == 0) p0_store(D, v, scr, lane);
        else { const int pv = D.k0;
#pragma unroll
            for (int i = 0; i < 4; ++i) { const int idx = lane * 4 + i; const float f = expf(-9.210340371976184f * (float)idx / 256.f); const float a = (float)pv * f;
                F.pe()[pv * 256 + idx] = sinf(a); F.pe()[16384 + pv * 256 + idx] = cosf(a); } }
        D = Dn;
#pragma unroll
        for (int i = 0; i < 32; ++i) v[i] = vn[i];
    }
}

__device__ __forceinline__ float mod_val(CParams& p, const Frame& F, int grp, int j) {
    float s = p.ada_b[j];
#pragma unroll
    for (int ks = 0; ks < 16; ++ks) s += F.modp()[(size_t)(ks * 3 + grp) * 3072 + j];
    return s;
}

__device__ __forceinline__ void phase1(CParams& p, Frame& F) {
    LAS float* sc = (LAS float*)F.lds; LAS float* sh = sc + 1024;
    for (int tb = F.b; tb < 256; tb += F.G) {
        const int grp = grp_of_block(tb);
        for (int j = F.tid; j < 1024; j += 512) { sh[j] = mod_val(p, F, grp, j); sc[j] = p.pre_w[j] * (1.f + mod_val(p, F, grp, 1024 + j)); }
        __syncthreads();
#pragma unroll 2
        for (int i = 0; i < 8; ++i) {
            const int tok = tb * 64 + F.wave * 8 + i;
            const float* xr = tok < 8192 ? p.x_prompt + (size_t)tok * 1024 : p.x_sample + (size_t)(tok - 8192) * 1024;
            f32x4 v[4]; float ss = 0.f;
#pragma unroll
            for (int q = 0; q < 4; ++q) { v[q] = __builtin_nontemporal_load((const f32x4*)(xr + F.lane * 4 + 256 * q));
                if (tok >= 8192) { const int pp = (tok - 8192) & 4095; const int vv = (q < 2) ? (pp >> 6) : (pp & 63);
                    const f32x4 e = *(const f32x4*)(F.pe() + ((q & 1) ? 16384 : 0) + vv * 256 + F.lane * 4); v[q] += e; }
                ss += (v[q][0] * v[q][0] + v[q][1] * v[q][1]) + (v[q][2] * v[q][2] + v[q][3] * v[q][3]); }
            const float rstd = rsqrtf(wave_sum(ss) * (1.f / 1024.f) + 1e-6f);
#pragma unroll
            for (int q = 0; q < 4; ++q) { const int j = F.lane * 4 + 256 * q; const f32x4 s4 = *(const LAS f32x4*)(sc + j), h4 = *(const LAS f32x4*)(sh + j);
                CHK(F, 1, badv(v[q][0] * rstd * s4[0] + h4[0], 100.f) || badv(v[q][3] * rstd * s4[3] + h4[3], 100.f));
                u32x2 o; o.x = pk2(v[q][0] * rstd * s4[0] + h4[0], v[q][1] * rstd * s4[1] + h4[1]); o.y = pk2(v[q][2] * rstd * s4[2] + h4[2], v[q][3] * rstd * s4[3] + h4[3]);
                *(u32x2*)(F.H() + (size_t)tok * 1024 + j) = o; }
        }
        __syncthreads();
    }
}

__device__ __forceinline__ void phase2(CParams& p, Frame& F) {
    { pg8::Gemm g{F.H(), F.WinT(), NTOK, NPROJ, 1024}; pg8::StaticOrder S; S.init(NTOK, NPROJ, F.G, F.b); pg8::EpiBf16 E{F.PROJ(), NPROJ};
      pg8::gemm_phase<pg8::EpiBf16, pg8::StaticOrder>(F.lds, g, S, E); }
    const int l15 = F.lane & 15, q4 = F.lane >> 4;
    for (int tb = F.b; tb < 256; tb += F.G) {
        const int mt = F.wave >> 1, nt = F.wave & 1;
        const bf16_t* ar = F.H() + (size_t)(tb * 64 + mt * 16 + l15) * 1024 + q4 * 8;
        const bf16_t* br = F.WbaT() + (size_t)(nt * 16 + l15) * 1024 + q4 * 8;
        f32x4 acc = {0.f, 0.f, 0.f, 0.f};
#pragma unroll 16
        for (int ks = 0; ks < 32; ++ks) { const bf16x8 a = *(const bf16x8*)(ar + ks * 32), b = *(const bf16x8*)(br + ks * 32); acc = MFMA16(a, b, acc); }
#pragma unroll
        for (int r = 0; r < 4; ++r) F.BA()[(size_t)(tb * 64 + mt * 16 + q4 * 4 + r) * 32 + nt * 16 + l15] = acc[r];
    }
}

__device__ __forceinline__ void p3_load_rows(const Frame& F, int ci, int h, u32x4 (&rows)[7]) {
    const int tid = F.tid, tg = tid >> 5, part = (tid >> 4) & 1, sub = tid & 15, col = part * 1024 + h * 128 + sub * 8, t0 = ci * 64;
    int seq_lo, seq_hi; if (ci < 128) { seq_lo = (ci >> 2) * 256; seq_hi = seq_lo + 256; } else { seq_lo = 8192 + ((ci - 128) >> 6) * 4096; seq_hi = seq_lo + 4096; }
    const int tb = t0 + tg * 4 - 2;
#pragma unroll
    for (int r = 0; r < 7; ++r) { const int tok = tb + r; u32x4 v = {0u, 0u, 0u, 0u};
        if (tok >= seq_lo && tok < seq_hi) v = *(const u32x4*)(F.PROJ() + (size_t)tok * NPROJ + col);
        rows[r] = v; }
}
__device__ __forceinline__ void p3_delta_item(CParams& p, Frame& F, int ci, int h, u32x4 (&rows)[7], int itn) {
    const int tid = F.tid, lane = F.lane, wave = F.wave, q4 = lane >> 4, l15 = lane & 15;
    LAS unsigned char* Ks = F.lds; LAS unsigned char* Qs = F.lds + 17408;
    LAS float* gfv = (LAS float*)(F.lds + 34816);
    LAS unsigned char* DIR0 = F.lds + 35840;
    LAS unsigned char* ATo = F.lds + 137728;
#pragma unroll
    for (int i = 0; i < 5; ++i) { const int ch = tid + 512 * i; if (ch < 2304) { const int dd = ch >= 1152, cc = ch - dd * 1152; *(LAS u32x4*)(DIR0 + dd * 47616 + 18432 + cc * 16) = (u32x4){0u, 0u, 0u, 0u}; } }
    const int t0 = ci * 64;
    int seq_lo, seq_hi; if (ci < 128) { seq_lo = (ci >> 2) * 256; seq_hi = seq_lo + 256; } else { seq_lo = 8192 + ((ci - 128) >> 6) * 4096; seq_hi = seq_lo + 4096; }
    {
        const int tg = tid >> 5, part = (tid >> 4) & 1, sub = tid & 15, col = part * 1024 + h * 128 + sub * 8;
        float w[4][8];
#pragma unroll
        for (int j = 0; j < 4; ++j) { const f32x4 a = *(const f32x4*)(p.dn_conv_w + j * 3072 + col), b = *(const f32x4*)(p.dn_conv_w + j * 3072 + col + 4);
            w[j][0] = a[0]; w[j][1] = a[1]; w[j][2] = a[2]; w[j][3] = a[3]; w[j][4] = b[0]; w[j][5] = b[1]; w[j][6] = b[2]; w[j][7] = b[3]; }
        float acc[4][8];
#pragma unroll
        for (int i = 0; i < 4; ++i)
#pragma unroll
            for (int e = 0; e < 8; ++e) acc[i][e] = 0.f;
#pragma unroll
        for (int r = 0; r < 7; ++r) {
            float x[8]; unpack8(rows[r], x);
#pragma unroll
            for (int j = 0; j < 4; ++j) { const int i = r - j; if (i >= 0 && i < 4) {
#pragma unroll
                for (int e = 0; e < 8; ++e) acc[i][e] += w[j][e] * x[e]; } } }
#pragma unroll
        for (int i = 0; i < 4; ++i) { float ss = 0.f;
#pragma unroll
            for (int e = 0; e < 8; ++e) { acc[i][e] = siluf_(acc[i][e]); ss += acc[i][e] * acc[i][e]; }
            ss += __shfl_xor(ss, 1); ss += __shfl_xor(ss, 2); ss += __shfl_xor(ss, 4); ss += __shfl_xor(ss, 8);
            const float rs = rsqrtf(ss + 1e-6f) * (part == 0 ? 0.08838834764831845f : 1.f);
#pragma unroll
            for (int e = 0; e < 8; ++e) acc[i][e] *= rs;
            CHK(F, 4, badv(acc[i][0], 1.01f) || badv(acc[i][5], 1.01f) || badv(ss * rs * rs, part == 0 ? 0.0079f : 1.01f));
            const u32x4 o = pack8(acc[i]); const int c = tg * 4 + i;
            *(LAS u32x4*)((part ? Ks : Qs) + c * 272 + sub * 16) = o;
            if (part == 0) *(u32x4*)(F.Qc() + (size_t)(t0 + c) * 1024 + h * 128 + sub * 8) = o; }
        if (part == 1) {
            bf16_t* kt = F.Kc() + (size_t)(ci * 8 + h) * 8192 + (size_t)(sub * 8) * 64 + tg * 4;
#pragma unroll
            for (int e = 0; e < 8; ++e) { u32x2 o2; o2.x = pk2(acc[0][e], acc[1][e]); o2.y = pk2(acc[2][e], acc[3][e]); *(u32x2*)(kt + e * 64) = o2; } }
    }
    if (wave == 0) {
        const float* ba = F.BA() + (size_t)(t0 + lane) * 32;
        const float bf_ = sigm(ba[h]), bb_ = sigm(ba[8 + h]);
        float s = -expf(p.dn_a_log[h]) * softplusf_(ba[16 + h] + p.dn_dt_bias[h]);
        float sb = -expf(p.dn_a_log[8 + h]) * softplusf_(ba[24 + h] + p.dn_dt_bias[8 + h]);
#pragma unroll
        for (int o = 1; o < 64; o <<= 1) { const float t = __shfl_up(s, o); if (lane >= o) s += t; }
#pragma unroll
        for (int o = 1; o < 64; o <<= 1) { const float t = __shfl_down(sb, o); if (lane + o < 64) sb += t; }
        CHK(F, 3, badv(ba[h], 1000.f) || badv(ba[24 + h], 1000.f));
        CHK(F, 8, badv(s, 1e4f) || badv(sb, 1e4f) || s > 0.f || sb > 0.f || bf_ < 0.f || bf_ > 1.f || bb_ < 0.f || bb_ > 1.f);
        gfv[lane] = s; gfv[64 + lane] = sb; gfv[128 + lane] = bf_; gfv[192 + lane] = bb_;
        float* gb = F.GB() + (size_t)(ci * 8 + h) * 256;
        gb[lane] = s; gb[64 + lane] = sb; gb[128 + lane] = bf_; gb[192 + lane] = bb_;
    }
    lds_barrier();
    const int d = wave >> 2, mt = wave & 3;
    LAS unsigned char* Db = DIR0 + d * 47616;
    LAS unsigned char* Brow = Db; LAS unsigned char* Btr = Db + 9216; LAS unsigned char* Xrow = Db + 18432; LAS unsigned char* Xtr = Db + 27648;
    LAS float* Dl = (LAS float*)(Db + 36864) + mt * 320; LAS unsigned char* M2t = Db + 41984; LAS unsigned char* Mts = Db + 44544 + mt * 768;
    const LAS unsigned char* Lrow = Brow;
    const LAS float* gd = gfv + d * 64; const LAS float* bd = gfv + 128 + d * 64;
    {
        f32x4 kk[4], qk[4];
#pragma unroll
        for (int n = 0; n < 4; ++n) { kk[n] = (f32x4){0.f, 0.f, 0.f, 0.f}; qk[n] = (f32x4){0.f, 0.f, 0.f, 0.f}; }
#pragma unroll
        for (int ks = 0; ks < 4; ++ks) { const bf16x8 ak = ldfrag(Ks, 272, mt * 16 + l15, ks * 64 + q4 * 16), aq = ldfrag(Qs, 272, mt * 16 + l15, ks * 64 + q4 * 16);
#pragma unroll
            for (int n = 0; n < 4; ++n) { const bf16x8 bk = ldfrag(Ks, 272, n * 16 + l15, ks * 64 + q4 * 16); kk[n] = MFMA16(ak, bk, kk[n]); qk[n] = MFMA16(aq, bk, qk[n]); } }
#pragma unroll
        for (int n = 0; n < 4; ++n) { const int C = n * 16 + l15; const float gC = gd[C], bC = bd[C]; float a4[4];
#pragma unroll
            for (int r = 0; r < 4; ++r) { const int R = mt * 16 + q4 * 4 + r;
                const float dec = __expf(-fabsf(gd[R] - gC));
                a4[r] = (C > R) ? (d == 0 ? bC : bd[R]) * kk[n][r] * dec : 0.f;
                const bool incl = d == 0 ? (R >= C) : (R < C);
                if (incl) ((LAS bf16_t*)ATo)[R * 64 + C] = f2bf(qk[n][r] * dec); }
            u32x2 o; o.x = pk2(a4[0], a4[1]); o.y = pk2(a4[2], a4[3]);
            *(LAS u32x2*)(Brow + C * 144 + (mt * 16 + q4 * 4) * 2) = o;
            if (n == mt) *(LAS f32x4*)(Dl + l15 * 20 + q4 * 4) = (f32x4){a4[0], a4[1], a4[2], a4[3]}; }
    }
    lds_barrier();
    if (itn < 2048) p3_load_rows(F, itn >> 3, itn & 7, rows);
    if (lane < 16) {
        float x[16];
#pragma unroll
        for (int i = 0; i < 16; ++i) { float sv = (i == lane) ? 1.f : 0.f;
            float drow[16];
#pragma unroll
            for (int q = 0; q < 4; ++q) if (4 * q < i) { const f32x4 t4 = *(const LAS f32x4*)(Dl + i * 20 + 4 * q); drow[4 * q] = t4[0]; drow[4 * q + 1] = t4[1]; drow[4 * q + 2] = t4[2]; drow[4 * q + 3] = t4[3]; }
#pragma unroll
            for (int j = 0; j < i; ++j) sv -= drow[j] * x[j];
            x[i] = sv; }
#pragma unroll
        for (int i = 0; i < 16; ++i) ((LAS bf16_t*)Xrow)[(mt * 16 + i) * 72 + mt * 16 + lane] = f2bf(x[i]);
        u32x4 o0, o1; o0.x = pk2(x[0], x[1]); o0.y = pk2(x[2], x[3]); o0.z = pk2(x[4], x[5]); o0.w = pk2(x[6], x[7]);
        o1.x = pk2(x[8], x[9]); o1.y = pk2(x[10], x[11]); o1.z = pk2(x[12], x[13]); o1.w = pk2(x[14], x[15]);
        *(LAS u32x4*)(Xtr + (mt * 16 + lane) * 144 + mt * 32) = o0; *(LAS u32x4*)(Xtr + (mt * 16 + lane) * 144 + mt * 32 + 16) = o1;
    }
    lds_barrier();
    const bf16x8 zero8 = {0, 0, 0, 0, 0, 0, 0, 0};
    const f32x4 zero4 = {0.f, 0.f, 0.f, 0.f};
    if (mt & 1) {
        const int I1 = mt, I0 = mt - 1;
        bf16x8 a = zero8, b = zero8;
        if (q4 < 2) { a = ldfrag(Lrow, 144, I1 * 16 + l15, I0 * 32 + q4 * 16); b = ldfrag(Xtr, 144, I0 * 16 + l15, I0 * 32 + q4 * 16); }
        const f32x4 M = MFMA16(a, b, zero4);
        { u32x2 o; o.x = pk2(M[0], M[1]); o.y = pk2(M[2], M[3]); *(LAS u32x2*)(Mts + l15 * 48 + q4 * 8) = o; }
        LDS_WAIT();
        bf16x8 a2 = zero8, b2 = zero8;
        if (q4 < 2) { a2 = ldfrag(Xrow, 144, I1 * 16 + l15, I1 * 32 + q4 * 16); b2 = *(const LAS bf16x8*)(Mts + l15 * 48 + q4 * 16); }
        const f32x4 X = MFMA16(a2, b2, zero4);
#pragma unroll
        for (int r = 0; r < 4; ++r) ((LAS bf16_t*)Xrow)[(I1 * 16 + q4 * 4 + r) * 72 + I0 * 16 + l15] = f2bf(-X[r]);
        u32x2 o; o.x = pk2(-X[0], -X[1]); o.y = pk2(-X[2], -X[3]);
        *(LAS u32x2*)(Xtr + (I0 * 16 + l15) * 144 + (I1 * 16 + q4 * 4) * 2) = o;
    }
    lds_barrier();
    {
        const int mi = mt >> 1, ni = mt & 1;
        const bf16x8 a = ldfrag(Lrow, 144, 32 + mi * 16 + l15, q4 * 16), b = ldfrag(Xtr, 144, ni * 16 + l15, q4 * 16);
        const f32x4 M2 = MFMA16(a, b, zero4);
        { u32x2 o; o.x = pk2(M2[0], M2[1]); o.y = pk2(M2[2], M2[3]); *(LAS u32x2*)(M2t + (ni * 16 + l15) * 80 + (mi * 16 + q4 * 4) * 2) = o; }
        lds_barrier();
        const bf16x8 a2 = ldfrag(Xrow, 144, 32 + mi * 16 + l15, 64 + q4 * 16), b2 = *(const LAS bf16x8*)(M2t + (ni * 16 + l15) * 80 + q4 * 16);
        const f32x4 X = MFMA16(a2, b2, zero4);
#pragma unroll
        for (int r = 0; r < 4; ++r) { CHK(F, 6, badv(X[r], 20.f)); ((LAS bf16_t*)Xrow)[(32 + mi * 16 + q4 * 4 + r) * 72 + ni * 16 + l15] = f2bf(-X[r]); }
        u32x2 o; o.x = pk2(-X[0], -X[1]); o.y = pk2(-X[2], -X[3]);
        *(LAS u32x2*)(Xtr + (ni * 16 + l15) * 144 + (32 + mi * 16 + q4 * 4) * 2) = o;
    }
    lds_barrier();
    { bf16_t* dst = F.TA() + (size_t)(ci * 8 + h) * 8192;
      const int c = tid >> 3, s0 = (tid & 7) * 8;
      const u32x4 lo = *(const LAS u32x4*)(DIR0 + 18432 + c * 144 + s0 * 2), up = *(const LAS u32x4*)(DIR0 + 47616 + 27648 + c * 144 + s0 * 2);
      unsigned wl[4] = {lo.x, lo.y, lo.z, lo.w}, wu[4] = {up.x, up.y, up.z, up.w}, wo[4];
#pragma unroll
      for (int i = 0; i < 4; ++i) { const int sa = s0 + 2 * i, sb2 = sa + 1;
          const unsigned mlo = (sa <= c ? 0x0000FFFFu : 0u) | (sb2 <= c ? 0xFFFF0000u : 0u);
          wo[i] = (wl[i] & mlo) | (wu[i] & ~mlo); }
      *(u32x4*)(dst + tid * 8) = (u32x4){wo[0], wo[1], wo[2], wo[3]};
      *(u32x4*)(dst + 4096 + tid * 8) = *(const LAS u32x4*)(ATo + tid * 16); }
    lds_barrier();
}

struct RgW { bf16x8 g[2][2][4]; float br[2], bi[2], sp[2]; };
__device__ __forceinline__ void rg_load_w(CParams& p, const Frame& F, int n, RgW& W) {
    const int q4 = F.lane >> 4, j = F.wave * 16 + (F.lane & 15), ch = n * 128 + j;
#pragma unroll
    for (int d = 0; d < 2; ++d) {
#pragma unroll
        for (int g = 0; g < 2; ++g) { const bf16_t* gp = F.GT() + (size_t)((g * 2 + d) * 8 + n) * 16384 + (size_t)j * 128 + q4 * 8;
#pragma unroll
            for (int ks = 0; ks < 4; ++ks) W.g[d][g][ks] = *(const bf16x8*)(gp + ks * 32); }
        W.br[d] = p.rg_b_r[d * 1024 + ch]; W.bi[d] = p.rg_b_i[d * 1024 + ch]; W.sp[d] = softplusf_(-p.rg_lam[d * 1024 + ch]); }
}
__device__ __forceinline__ void rg_load_rows(const Frame& F, int ci, int n, u32x4 (&rows)[5]) {
    const int tid = F.tid, tg = tid >> 4, sub = tid & 15, col = 4096 + n * 128 + sub * 8, t0 = ci * 64;
    int c_lo, c_hi; if (ci < 128) { c_lo = (ci >> 2) * 4; c_hi = c_lo + 4; } else { c_lo = 128 + ((ci - 128) >> 6) * 64; c_hi = c_lo + 64; }
    const int tb = t0 + tg * 2 - 2;
#pragma unroll
    for (int r = 0; r < 5; ++r) { const int tok = tb + r; u32x4 v = {0u, 0u, 0u, 0u};
        if (tok >= c_lo * 64 && tok < c_hi * 64) v = *(const u32x4*)(F.PROJ() + (size_t)tok * NPROJ + col);
        rows[r] = v; }
}
template <int PASS>
__device__ __forceinline__ void rg_item(CParams& p, Frame& F, int ci, int n, u32x4 (&rows)[5], int itn) {
    const int tid = F.tid, lane = F.lane, wave = F.wave, q4 = lane >> 4, l15 = lane & 15;
    LAS unsigned char* xb = F.lds; LAS float* xf = (LAS float*)(F.lds + 17408); LAS float* Hs = (LAS float*)(F.lds + 50176);
    const int t0 = ci * 64;
    int seq_lo, seq_hi, c_lo, c_hi, seq; const bool samp = ci >= 128;
    if (!samp) { seq = ci >> 2; c_lo = seq * 4; c_hi = c_lo + 4; } else { seq = (ci - 128) >> 6; c_lo = 128 + seq * 64; c_hi = c_lo + 64; }
    seq_lo = c_lo * 64; seq_hi = c_hi * 64;
    const int j = wave * 16 + l15, ch = n * 128 + j;
    bf16x8 wA[2][4], wB[2][4];
#pragma unroll
    for (int g = 0; g < 2; ++g) { const bf16_t* gp = F.GT() + (size_t)((g * 2 + 0) * 8 + n) * 16384 + (size_t)j * 128 + q4 * 8;
#pragma unroll
        for (int ks = 0; ks < 4; ++ks) wA[g][ks] = *(const bf16x8*)(gp + ks * 32); }
    {
        const int tg = tid >> 4, sub = tid & 15, ch = n * 128 + sub * 8;
        float w[4][8], acc[2][8];
#pragma unroll
        for (int j = 0; j < 4; ++j) { const f32x4 a = *(const f32x4*)(p.rg_conv_w + j * 1024 + ch), b = *(const f32x4*)(p.rg_conv_w + j * 1024 + ch + 4);
            w[j][0] = a[0]; w[j][1] = a[1]; w[j][2] = a[2]; w[j][3] = a[3]; w[j][4] = b[0]; w[j][5] = b[1]; w[j][6] = b[2]; w[j][7] = b[3]; }
        { const f32x4 a = *(const f32x4*)(p.rg_conv_b + ch), b = *(const f32x4*)(p.rg_conv_b + ch + 4);
#pragma unroll
          for (int i = 0; i < 2; ++i) { acc[i][0] = a[0]; acc[i][1] = a[1]; acc[i][2] = a[2]; acc[i][3] = a[3]; acc[i][4] = b[0]; acc[i][5] = b[1]; acc[i][6] = b[2]; acc[i][7] = b[3]; } }
#pragma unroll
        for (int r = 0; r < 5; ++r) {
            float x[8]; unpack8(rows[r], x);
#pragma unroll
            for (int j = 0; j < 4; ++j) { const int i = r - j; if (i >= 0 && i < 2) {
#pragma unroll
                for (int e = 0; e < 8; ++e) acc[i][e] += w[j][e] * x[e]; } } }
#pragma unroll
        for (int i = 0; i < 2; ++i) { const int c = tg * 2 + i;
            *(LAS u32x4*)(xb + c * 272 + sub * 16) = pack8(acc[i]);
            *(LAS f32x4*)(xf + c * 128 + sub * 8) = (f32x4){acc[i][0], acc[i][1], acc[i][2], acc[i][3]};
            *(LAS f32x4*)(xf + c * 128 + sub * 8 + 4) = (f32x4){acc[i][4], acc[i][5], acc[i][6], acc[i][7]}; }
    }
    lds_barrier();
    f32x4 hs[4];
#pragma unroll
    for (int m = 0; m < 4; ++m) hs[m] = (f32x4){0.f, 0.f, 0.f, 0.f};
#pragma unroll
    for (int d = 0; d < 2; ++d) {
        f32x4 av[4], bxv[4];
        {
            f32x4 ar[4], ai[4];
#pragma unroll
            for (int m = 0; m < 4; ++m) { ar[m] = (f32x4){0.f, 0.f, 0.f, 0.f}; ai[m] = (f32x4){0.f, 0.f, 0.f, 0.f}; }
#pragma unroll
            for (int ks = 0; ks < 4; ++ks) { const bf16x8 br = d == 0 ? wA[0][ks] : wB[0][ks], bi = d == 0 ? wA[1][ks] : wB[1][ks];
#pragma unroll
                for (int m = 0; m < 4; ++m) { const bf16x8 a = ldfrag(xb, 272, m * 16 + l15, ks * 64 + q4 * 16); ar[m] = MFMA16(a, br, ar[m]); ai[m] = MFMA16(a, bi, ai[m]); } }
            if (d == 0) {
#pragma unroll
                for (int g = 0; g < 2; ++g) { const bf16_t* gp = F.GT() + (size_t)((g * 2 + 1) * 8 + n) * 16384 + (size_t)j * 128 + q4 * 8;
#pragma unroll
                    for (int ks = 0; ks < 4; ++ks) wB[g][ks] = *(const bf16x8*)(gp + ks * 32); } }
            const float L2E = 1.4426950408889634f;
            const float br_ = -L2E * p.rg_b_r[d * 1024 + ch], bi_ = -L2E * p.rg_b_i[d * 1024 + ch], sp = softplusf_(-p.rg_lam[d * 1024 + ch]);
            const float k2 = -16.f * sp, k2e = k2 * L2E, k1e = 0.5f * k2e;
#pragma unroll
            for (int m = 0; m < 4; ++m)
#pragma unroll
                for (int r = 0; r < 4; ++r) { const int c = m * 16 + q4 * 4 + r;
                    const float rr = __builtin_amdgcn_rcpf(1.f + __builtin_amdgcn_exp2f(fmaf(ar[m][r], -L2E, br_)));
                    const float ii = __builtin_amdgcn_rcpf(1.f + __builtin_amdgcn_exp2f(fmaf(ai[m][r], -L2E, bi_)));
                    const float a_ = __builtin_amdgcn_exp2f(k1e * rr);
                    const float em = fmaf(a_, a_, -1.f);
                    av[m][r] = a_; bxv[m][r] = __builtin_amdgcn_sqrtf(fmaxf(-em, 0.f)) * (ii * xf[c * 128 + j]); }
        }
        f32x4 Pa[4], Pb[4]; float Ap[4], Bp[4], Am[4], Bm[4];
#pragma unroll
        for (int m = 0; m < 4; ++m) {
            float pa, pb;
            if (d == 0) { pa = av[m][0]; pb = bxv[m][0]; Pa[m][0] = pa; Pb[m][0] = pb;
#pragma unroll
                for (int r = 1; r < 4; ++r) { pb = av[m][r] * pb + bxv[m][r]; pa = av[m][r] * pa; Pa[m][r] = pa; Pb[m][r] = pb; } }
            else { pa = av[m][3]; pb = bxv[m][3]; Pa[m][3] = pa; Pb[m][3] = pb;
#pragma unroll
                for (int r = 2; r >= 0; --r) { pb = av[m][r] * pb + bxv[m][r]; pa = av[m][r] * pa; Pa[m][r] = pa; Pb[m][r] = pb; } }
            float Ak[4], Bk[4];
#pragma unroll
            for (int k = 0; k < 4; ++k) { Ak[k] = __shfl(pa, l15 + 16 * k); Bk[k] = __shfl(pb, l15 + 16 * k); }
            float ap = 1.f, bp = 0.f, am = 1.f, bm = 0.f;
#pragma unroll
            for (int kk = 0; kk < 4; ++kk) { const int k = d == 0 ? kk : 3 - kk;
                const bool before = d == 0 ? (k < q4) : (k > q4);
                const float nb = Ak[k] * bp + Bk[k], na = Ak[k] * ap;
                bp = before ? nb : bp; ap = before ? na : ap;
                bm = Ak[k] * bm + Bk[k]; am = Ak[k] * am; }
            Ap[m] = ap; Bp[m] = bp; Am[m] = am; Bm[m] = bm;
        }
        if (PASS == 1) {
            float At = 1.f, Bt = 0.f;
#pragma unroll
            for (int mm = 0; mm < 4; ++mm) { const int m = d == 0 ? mm : 3 - mm; Bt = Am[m] * Bt + Bm[m]; At = Am[m] * At; }
            if (q4 == 0) { float* ag = F.RGAGG() + (size_t)(ci * 2 + d) * 2048; ag[ch] = At; ag[1024 + ch] = Bt; }
        } else {
            float hb = F.CARRY()[(size_t)(ci * 2 + d) * 1024 + ch];
#pragma unroll
            for (int mm = 0; mm < 4; ++mm) { const int m = d == 0 ? mm : 3 - mm;
                const float hin = Ap[m] * hb + Bp[m];
#pragma unroll
                for (int r = 0; r < 4; ++r) hs[m][r] += Pa[m][r] * hin + Pb[m][r];
                hb = Am[m] * hb + Bm[m]; }
            if (!samp && q4 == 0 && ci == (d == 0 ? c_hi - 1 : c_lo)) F.out[OUT_SR + (size_t)(seq * 2 + d) * 1024 + ch] = hb;
        }
    }
    if (PASS == 1 && itn < 1024) rg_load_rows(F, 128 + (itn >> 3), itn & 7, rows);
    if (PASS == 3) {
#pragma unroll
        for (int m = 0; m < 4; ++m)
#pragma unroll
            for (int r = 0; r < 4; ++r) Hs[(m * 16 + q4 * 4 + r) * 128 + j] = hs[m][r];
        lds_barrier();
#pragma unroll
        for (int i = 0; i < 2; ++i) { const int chunk = tid + 512 * i, c = chunk >> 4, cc = chunk & 15;
            const u32x4 gv = *(const u32x4*)(F.PROJ() + (size_t)(t0 + c) * NPROJ + 5120 + n * 128 + cc * 8);
            float g[8]; unpack8(gv, g);
            const f32x4 ha = *(const LAS f32x4*)(Hs + c * 128 + cc * 8), hb2 = *(const LAS f32x4*)(Hs + c * 128 + cc * 8 + 4);
            float o[8];
#pragma unroll
            for (int e = 0; e < 4; ++e) { o[e] = ha[e] * siluf_(g[e]); o[4 + e] = hb2[e] * siluf_(g[4 + e]); }
            *(u32x4*)(F.MIX() + (size_t)(t0 + c) * 2048 + 1024 + n * 128 + cc * 8) = pack8(o); }
    }
    lds_barrier();
}

__device__ __forceinline__ void rg_conv_lds(CParams& p, const Frame& F, int n, const u32x4 (&rows)[5], LAS unsigned char* xb, LAS float* xf) {
    const int tid = F.tid, tg = tid >> 4, sub = tid & 15, ch = n * 128 + sub * 8;
    float w[4][8], acc[2][8];
#pragma unroll
    for (int j = 0; j < 4; ++j) { const f32x4 a = *(const f32x4*)(p.rg_conv_w + j * 1024 + ch), b = *(const f32x4*)(p.rg_conv_w + j * 1024 + ch + 4);
        w[j][0] = a[0]; w[j][1] = a[1]; w[j][2] = a[2]; w[j][3] = a[3]; w[j][4] = b[0]; w[j][5] = b[1]; w[j][6] = b[2]; w[j][7] = b[3]; }
    { const f32x4 a = *(const f32x4*)(p.rg_conv_b + ch), b = *(const f32x4*)(p.rg_conv_b + ch + 4);
#pragma unroll
      for (int i = 0; i < 2; ++i) { acc[i][0] = a[0]; acc[i][1] = a[1]; acc[i][2] = a[2]; acc[i][3] = a[3]; acc[i][4] = b[0]; acc[i][5] = b[1]; acc[i][6] = b[2]; acc[i][7] = b[3]; } }
#pragma unroll
    for (int r = 0; r < 5; ++r) { float x[8]; unpack8(rows[r], x);
#pragma unroll
        for (int j = 0; j < 4; ++j) { const int i = r - j; if (i >= 0 && i < 2) {
#pragma unroll
            for (int e = 0; e < 8; ++e) acc[i][e] += w[j][e] * x[e]; } } }
#pragma unroll
    for (int i = 0; i < 2; ++i) { const int c = tg * 2 + i;
        *(LAS u32x4*)(xb + c * 272 + sub * 16) = pack8(acc[i]);
        *(LAS f32x4*)(xf + c * 128 + sub * 8) = (f32x4){acc[i][0], acc[i][1], acc[i][2], acc[i][3]};
        *(LAS f32x4*)(xf + c * 128 + sub * 8 + 4) = (f32x4){acc[i][4], acc[i][5], acc[i][6], acc[i][7]}; }
}
template <int D>
__device__ __forceinline__ void rg_gate_scan(const Frame& F, const bf16x8 (&wg)[2][4], float br_, float bi_, float sp, const LAS unsigned char* xb, const LAS float* xf, int j,
                                             f32x4 (&Pa)[4], f32x4 (&Pb)[4], float (&Ap)[4], float (&Bp)[4], float (&Am)[4], float (&Bm)[4]) {
    const int lane = F.lane, q4 = lane >> 4, l15 = lane & 15;
    f32x4 av[4], bxv[4];
    {
        f32x4 ar[4], ai[4];
#pragma unroll
        for (int m = 0; m < 4; ++m) { ar[m] = (f32x4){0.f, 0.f, 0.f, 0.f}; ai[m] = (f32x4){0.f, 0.f, 0.f, 0.f}; }
#pragma unroll
        for (int ks = 0; ks < 4; ++ks) {
#pragma unroll
            for (int m = 0; m < 4; ++m) { const bf16x8 a = ldfrag(xb, 272, m * 16 + l15, ks * 64 + q4 * 16); ar[m] = MFMA16(a, wg[0][ks], ar[m]); ai[m] = MFMA16(a, wg[1][ks], ai[m]); } }
        const float L2E = 1.4426950408889634f;
        const float brs = -L2E * br_, bis = -L2E * bi_, k2 = -16.f * sp, k1e = 0.5f * k2 * L2E;
#pragma unroll
        for (int m = 0; m < 4; ++m)
#pragma unroll
            for (int r = 0; r < 4; ++r) { const int c = m * 16 + q4 * 4 + r;
                const float rr = __builtin_amdgcn_rcpf(1.f + __builtin_amdgcn_exp2f(fmaf(ar[m][r], -L2E, brs)));
                const float ii = __builtin_amdgcn_rcpf(1.f + __builtin_amdgcn_exp2f(fmaf(ai[m][r], -L2E, bis)));
                const float a = __builtin_amdgcn_exp2f(k1e * rr);
                const float em = fmaf(a, a, -1.f);
                av[m][r] = a; bxv[m][r] = __builtin_amdgcn_sqrtf(fmaxf(-em, 0.f)) * (ii * xf[c * 128 + j]); }
    }
#pragma unroll
    for (int m = 0; m < 4; ++m) {
        float pa, pb;
        if (D == 0) { pa = av[m][0]; pb = bxv[m][0]; Pa[m][0] = pa; Pb[m][0] = pb;
#pragma unroll
            for (int r = 1; r < 4; ++r) { pb = av[m][r] * pb + bxv[m][r]; pa = av[m][r] * pa; Pa[m][r] = pa; Pb[m][r] = pb; } }
        else { pa = av[m][3]; pb = bxv[m][3]; Pa[m][3] = pa; Pb[m][3] = pb;
#pragma unroll
            for (int r = 2; r >= 0; --r) { pb = av[m][r] * pb + bxv[m][r]; pa = av[m][r] * pa; Pa[m][r] = pa; Pb[m][r] = pb; } }
        float Ak[4], Bk[4];
#pragma unroll
        for (int k = 0; k < 4; ++k) { Ak[k] = __shfl(pa, l15 + 16 * k); Bk[k] = __shfl(pb, l15 + 16 * k); }
        float ap = 1.f, bp = 0.f, am = 1.f, bm = 0.f;
#pragma unroll
        for (int kk = 0; kk < 4; ++kk) { const int k = D == 0 ? kk : 3 - kk;
            const bool before = D == 0 ? (k < q4) : (k > q4);
            const float nb = Ak[k] * bp + Bk[k], na = Ak[k] * ap;
            bp = before ? nb : bp; ap = before ? na : ap;
            bm = Ak[k] * bm + Bk[k]; am = Ak[k] * am; }
        Ap[m] = ap; Bp[m] = bp; Am[m] = am; Bm[m] = bm;
    }
}
template <int D>
__device__ __forceinline__ void rg_prompt_dir(CParams& p, Frame& F, int seq, int n) {
    const int tid = F.tid, lane = F.lane, wave = F.wave, q4 = lane >> 4, l15 = lane & 15;
    LAS unsigned char* xb = F.lds; LAS float* xf = (LAS float*)(F.lds + 17408); LAS float* Hs = (LAS float*)(F.lds + 50176); LAS bf16_t* Hf = (LAS bf16_t*)(F.lds + 82944);
    const int j = wave * 16 + l15, ch = n * 128 + j;
    bf16x8 wg[2][4];
#pragma unroll
    for (int g = 0; g < 2; ++g) { const bf16_t* gp = F.GT() + (size_t)((g * 2 + D) * 8 + n) * 16384 + (size_t)j * 128 + q4 * 8;
#pragma unroll
        for (int ks = 0; ks < 4; ++ks) wg[g][ks] = *(const bf16x8*)(gp + ks * 32); }
    const float br_ = p.rg_b_r[D * 1024 + ch], bi_ = p.rg_b_i[D * 1024 + ch], sp = softplusf_(-p.rg_lam[D * 1024 + ch]);
    float hb = 0.f;
    u32x4 rows[5];
    rg_load_rows(F, seq * 4 + (D == 0 ? 0 : 3), n, rows);
#pragma unroll 1
    for (int cs = 0; cs < 4; ++cs) {
        const int cidx = D == 0 ? cs : 3 - cs, ci = seq * 4 + cidx, t0 = ci * 64;
        rg_conv_lds(p, F, n, rows, xb, xf);
        if (cs < 3) rg_load_rows(F, seq * 4 + (D == 0 ? cidx + 1 : cidx - 1), n, rows);
        lds_barrier();
        f32x4 Pa[4], Pb[4]; float Ap[4], Bp[4], Am[4], Bm[4];
        rg_gate_scan<D>(F, wg, br_, bi_, sp, xb, xf, j, Pa, Pb, Ap, Bp, Am, Bm);
#pragma unroll
        for (int mm = 0; mm < 4; ++mm) { const int m = D == 0 ? mm : 3 - mm;
            const float hin = Ap[m] * hb + Bp[m];
#pragma unroll
            for (int r = 0; r < 4; ++r) { const float hv = Pa[m][r] * hin + Pb[m][r]; const int tl = m * 16 + q4 * 4 + r;
                if (D == 0) Hf[(cidx * 64 + tl) * 128 + j] = f2bf(hv);
                else Hs[tl * 128 + j] = hv + bf2f(Hf[(cidx * 64 + tl) * 128 + j]); }
            hb = Am[m] * hb + Bm[m]; }
        lds_barrier();
        if (D == 1) {
#pragma unroll
            for (int i = 0; i < 2; ++i) { const int chunk = tid + 512 * i, c = chunk >> 4, cc = chunk & 15;
                const u32x4 gv = __builtin_nontemporal_load((const u32x4*)(F.PROJ() + (size_t)(t0 + c) * NPROJ + 5120 + n * 128 + cc * 8)); float g[8]; unpack8(gv, g);
                const f32x4 ha = *(const LAS f32x4*)(Hs + c * 128 + cc * 8), hb2 = *(const LAS f32x4*)(Hs + c * 128 + cc * 8 + 4);
                float o[8];
#pragma unroll
                for (int e = 0; e < 4; ++e) { o[e] = ha[e] * siluf_(g[e]); o[4 + e] = hb2[e] * siluf_(g[4 + e]); }
                *(u32x4*)(F.MIX() + (size_t)(t0 + c) * 2048 + 1024 + n * 128 + cc * 8) = pack8(o); }
            lds_barrier();
        }
    }
    if (q4 == 0) F.out[OUT_SR + (size_t)(seq * 2 + D) * 1024 + ch] = hb;
}

__device__ __forceinline__ void rg_carry_scan(CParams& p, Frame& F) {
    const int tid = F.tid;
    if (tid < 256 || tid >= 272) return;
    const int g = F.b * 16 + tid - 256; if (g >= 4096) return;
    const int seq = g >> 11, d = (g >> 10) & 1, ch = g & 1023, c_lo = 128 + seq * 64;
    const float* ag0 = F.RGAGG() + (size_t)d * 2048 + ch;
    float h = p.state_rglru[(size_t)(seq * 2 + d) * 1024 + ch];
    float* cr0 = F.CARRY() + (size_t)d * 1024 + ch;
#pragma unroll 1
    for (int u0 = 0; u0 < 64; u0 += 32) {
        float A[32], B[32];
#pragma unroll
        for (int u = 0; u < 32; ++u) { const int cc = d == 0 ? c_lo + u0 + u : c_lo + 63 - u0 - u; A[u] = ag0[(size_t)cc * 4096]; B[u] = ag0[(size_t)cc * 4096 + 1024]; }
#pragma unroll
        for (int u = 0; u < 32; ++u) { const int cc = d == 0 ? c_lo + u0 + u : c_lo + 63 - u0 - u; cr0[(size_t)cc * 2048] = h; h = A[u] * h + B[u]; }
    }
}

__device__ __forceinline__ void phase3(CParams& p, Frame& F) {
    for (int rep = 0; rep < (REP_PHASE == 30 ? 2 : 1); ++rep)
    { u32x4 rows[7]; if (F.b < 2048) p3_load_rows(F, F.b >> 3, F.b & 7, rows);
      for (int it = F.b; it < 2048; it += F.G) p3_delta_item(p, F, it >> 3, it & 7, rows, it + F.G); }
    for (int rep = 0; rep < (REP_PHASE == 31 ? 2 : 1); ++rep) {
    u32x4 rows[5]; if (F.b < 1024) rg_load_rows(F, 128 + (F.b >> 3), F.b & 7, rows);
    for (int it = F.b; it < 1024; it += F.G) rg_item<1>(p, F, 128 + (it >> 3), it & 7, rows, it + F.G); }
}

struct P4D { int valid, samp, seq, h, d, sl, ci, seq_lo, seq_hi, last, k, s, nch; };
__device__ __forceinline__ P4D p4_desc(const Frame& F, int k, int s) {
    P4D D; int item;
    if (F.G == 256) {
        const int x = F.b & 7, y = F.b >> 3;
        if (y < 16) { item = (x * 4 + (y >> 2)) * 4 + (y & 3); D.valid = k < 1; }
        else { const int j = y - 16; item = 128 + (x * 64 + (j >> 2) * 16 + k) * 4 + (j & 3); D.valid = k < 16; } }
    else { item = F.b + k * F.G; D.valid = item < 2176; }
    D.samp = item < 128; const int it = D.samp ? item : item - 128, chain = it >> 2;
    D.sl = it & 3; D.seq = chain >> 4; D.h = (chain >> 1) & 7; D.d = chain & 1;
    D.nch = D.samp ? 64 : 4; const int chunk0 = D.samp ? 128 + D.seq * 64 : D.seq * 4;
    D.seq_lo = chunk0 * 64; D.seq_hi = D.seq_lo + D.nch * 64;
    D.ci = D.d == 0 ? chunk0 + s : chunk0 + D.nch - 1 - s; D.last = s == D.nch - 1; D.k = k; D.s = s;
    return D;
}
__device__ __forceinline__ P4D p4_next(const Frame& F, const P4D& D) {
    if (D.s + 1 < D.nch) { P4D N = D; N.s = D.s + 1; N.ci = D.ci + (D.d == 0 ? 1 : -1); N.last = N.s == D.nch - 1; return N; }
    return p4_desc(F, D.k + 1, 0);
}
struct P4Pre { u32x4 k0, k1, q0, q1, ti, at; u32x2 v[4]; float g, b, bc; };
struct P4T { unsigned oKQ, oTA, oV, oG, oGc; int cj; };
__device__ __forceinline__ P4T p4_thread_consts(int tid) {
    P4T T; T.oKQ = (unsigned)(((tid >> 4) * 1024 + (tid & 15) * 8) * 2); T.oTA = (unsigned)tid * 16u;
    T.oV = (unsigned)(((tid >> 3) * NPROJ + (tid & 7) * 4) * 2); T.oG = (unsigned)(tid & 63) * 4u; T.oGc = (unsigned)(tid >> 3) * 4u; T.cj = (tid >> 3) - 2; return T;
}
__device__ __forceinline__ void p4_prefetch(CParams& p, const Frame& F, P4Pre& R, const P4D& D, const P4T& T) {
    const int tid = F.tid, t0 = D.ci * 64, h = D.h;
    const char* kb = (const char*)F.Kc() + (size_t)(D.ci * 8 + h) * 16384;
    const char* qb = (const char*)F.Qc() + ((size_t)t0 * 1024 + h * 128) * 2;
    const char* tb = (const char*)F.TA() + (size_t)(D.ci * 8 + h) * 16384;
    const char* vb = (const char*)F.PROJ() + ((long)(t0 - 2) * NPROJ + 2048 + h * 128 + D.sl * 32) * 2;
    const char* gb = (const char*)F.GB() + (size_t)(D.ci * 8 + h) * 1024 + D.d * 256;
    R.k0 = *(const u32x4*)(kb + T.oTA); R.k1 = *(const u32x4*)(kb + T.oTA + 8192u);
    R.q0 = *(const u32x4*)(qb + T.oKQ); R.q1 = *(const u32x4*)(qb + T.oKQ + 65536u);
    R.ti = *(const u32x4*)(tb + T.oTA); R.at = *(const u32x4*)(tb + T.oTA + 8192u);
#pragma unroll
    for (int j = 0; j < 4; ++j) { const int tok = t0 + T.cj + j; u32x2 v = {0u, 0u};
        if (tok >= D.seq_lo && tok < D.seq_hi) v = *(const u32x2*)(vb + T.oV + (unsigned)(j * NPROJ * 2));
        R.v[j] = v; }
    R.bc = *(const float*)(gb + 512 + T.oGc);
    R.g = 0.f; R.b = 0.f;
    if (tid < 64) { R.g = *(const float*)(gb + T.oG); R.b = *(const float*)(gb + 512 + T.oG); }
}
__device__ __forceinline__ u32x4 tri_mask(u32x4 v, int c, int s0, int d) {
    unsigned w[4] = {v.x, v.y, v.z, v.w};
#pragma unroll
    for (int i = 0; i < 4; ++i) { const int slo = s0 + 2 * i, shi = slo + 1;
        const bool klo = d == 0 ? (c >= slo) : (c <= slo), khi = d == 0 ? (c >= shi) : (c <= shi);
        w[i] &= (klo ? 0x0000FFFFu : 0u) | (khi ? 0xFFFF0000u : 0u); }
    return (u32x4){w[0], w[1], w[2], w[3]};
}
constexpr int P4_KS = 0, P4_TI = 17408, P4_VBT = 26624, P4_WL = 31232, P4_SB = 48640, P4_VT1 = 57344, P4_VT2 = 61952, P4_QS = 66560, P4_AT = 101376, P4_GV = 119808, P4_KT = 122368;
__device__ __forceinline__ void p4_stage(CParams& p, const Frame& F, const P4Pre& R, const P4D& D, int buf, const unsigned (&mk)[2][4], f32x4 (&cw)[4], const f32x4 (&cwn)[4]) {
    const int tid = F.tid, d = D.d;
    LAS unsigned char* Ks = F.lds + P4_KS; LAS unsigned char* Qs = F.lds + P4_QS + buf * 17408; LAS unsigned char* TIs = F.lds + P4_TI;
    LAS unsigned char* ATs = F.lds + P4_AT + buf * 9216; LAS unsigned char* Vbt = F.lds + P4_VBT; LAS float* gv = (LAS float*)(F.lds + P4_GV + buf * 1280);
    { const int row = tid >> 4, cc = tid & 15;
      *(LAS u32x4*)(Qs + row * 272 + cc * 16) = R.q0; *(LAS u32x4*)(Qs + (32 + row) * 272 + cc * 16) = R.q1; }
    { const int dk = tid >> 3, cp = tid & 7; LAS unsigned char* Kts = F.lds + P4_KT;
      *(LAS u32x4*)(Kts + dk * 144 + cp * 16) = R.k0; *(LAS u32x4*)(Kts + (64 + dk) * 144 + cp * 16) = R.k1; }
    { const int c = tid >> 3, s0 = (tid & 7) * 8;
      const unsigned m0 = d ? mk[1][0] : mk[0][0], m1 = d ? mk[1][1] : mk[0][1], m2 = d ? mk[1][2] : mk[0][2], m3 = d ? mk[1][3] : mk[0][3];
      *(LAS u32x4*)(TIs + c * 144 + s0 * 2) = (u32x4){R.ti.x & m0, R.ti.y & m1, R.ti.z & m2, R.ti.w & m3};
      *(LAS u32x4*)(ATs + c * 144 + s0 * 2) = (u32x4){R.at.x & m0, R.at.y & m1, R.at.z & m2, R.at.w & m3}; }
    { const int c = tid >> 3, e0 = (tid & 7) * 4; float o[4] = {0.f, 0.f, 0.f, 0.f};
      if (D.s == 0) {
#pragma unroll
          for (int j = 0; j < 4; ++j) cw[j] = cwn[j]; }
#pragma unroll
      for (int j = 0; j < 4; ++j) { const u32x2 v = R.v[j];
          o[0] += cw[j][0] * __uint_as_float(v.x << 16); o[1] += cw[j][1] * __uint_as_float(v.x & 0xffff0000u);
          o[2] += cw[j][2] * __uint_as_float(v.y << 16); o[3] += cw[j][3] * __uint_as_float(v.y & 0xffff0000u); }
#pragma unroll
      for (int i = 0; i < 4; ++i) ((LAS bf16_t*)Vbt)[(e0 + i) * 72 + c] = f2bf(siluf_(o[i]) * R.bc); }
    if (tid < 64) {
        const float glast = __shfl(R.g, d == 0 ? 63 : 0), eg = __expf(R.g);
        gv[tid] = eg; gv[64 + tid] = R.b * eg; gv[128 + tid] = __expf(glast - R.g); if (tid == 0) gv[192] = __expf(glast);
    }
}
__device__ __forceinline__ void phase4_chains(CParams& p, Frame& F) {
    const int tid = F.tid, lane = F.lane, wave = F.wave, q4 = lane >> 4, l15 = lane & 15;
    LAS unsigned char* Ks = F.lds + P4_KS; LAS unsigned char* TIs = F.lds + P4_TI; LAS unsigned char* Vbt = F.lds + P4_VBT; LAS unsigned char* Wl = F.lds + P4_WL;
    LAS unsigned char* Sb = F.lds + P4_SB; LAS unsigned char* Vt1 = F.lds + P4_VT1; LAS unsigned char* Vt2 = F.lds + P4_VT2;
    const int ct = wave & 3, et = wave >> 2;
    P4D Dc = p4_desc(F, 0, 0);
    if (!Dc.valid) return;
    P4Pre RA, RB;
    f32x4 S[2], U; bf16x8 KT[2];
    unsigned mk[2][4]; f32x4 cw[4], cwn[4];
    { const int c = tid >> 3, s0 = (tid & 7) * 8;
#pragma unroll
      for (int i = 0; i < 4; ++i) { const int slo = s0 + 2 * i, shi = slo + 1;
          mk[0][i] = (c >= slo ? 0x0000FFFFu : 0u) | (c >= shi ? 0xFFFF0000u : 0u); mk[1][i] = (c <= slo ? 0x0000FFFFu : 0u) | (c <= shi ? 0xFFFF0000u : 0u); } }
#define P4_INIT_S(D) do { _Pragma("unroll") for (int nt = 0; nt < 2; ++nt) _Pragma("unroll") for (int r = 0; r < 4; ++r) \
        S[nt][r] = (D).samp ? p.state_delta[(size_t)(((D).seq * 2 + (D).d) * 8 + (D).h) * 16384 + (size_t)(wave * 16 + q4 * 4 + r) * 128 + (D).sl * 32 + nt * 16 + l15] : 0.f; } while (0)
#define P4_WRITE_SB() do { _Pragma("unroll") for (int nt = 0; nt < 2; ++nt) { u32x2 o_; o_.x = pk2(S[nt][0], S[nt][1]); o_.y = pk2(S[nt][2], S[nt][3]); \
        *(LAS u32x2*)(Sb + (nt * 16 + l15) * 272 + (wave * 16 + q4 * 4) * 2) = o_; } } while (0)
#define P4_PRECOMP(buf_) do { const LAS float* gv_ = (const LAS float*)(F.lds + P4_GV + (buf_) * 1280); \
        f32x4 WT[4]; _Pragma("unroll") for (int c_ = 0; c_ < 4; ++c_) WT[c_] = (f32x4){0.f, 0.f, 0.f, 0.f}; \
        _Pragma("unroll") for (int ks = 0; ks < 2; ++ks) { \
            const u32x4 kraw = *(const LAS u32x4*)(F.lds + P4_KT + (wave * 16 + l15) * 144 + ks * 64 + q4 * 16); KT[ks] = __builtin_bit_cast(bf16x8, kraw); \
            const f32x4 sa = *(const LAS f32x4*)(gv_ + 64 + ks * 32 + q4 * 8), sb_ = *(const LAS f32x4*)(gv_ + 64 + ks * 32 + q4 * 8 + 4); \
            float kf[8]; unpack8(kraw, kf); u32x4 kg; \
            kg.x = pk2(kf[0] * sa[0], kf[1] * sa[1]); kg.y = pk2(kf[2] * sa[2], kf[3] * sa[3]); kg.z = pk2(kf[4] * sb_[0], kf[5] * sb_[1]); kg.w = pk2(kf[6] * sb_[2], kf[7] * sb_[3]); \
            const bf16x8 akg = __builtin_bit_cast(bf16x8, kg); \
            _Pragma("unroll") for (int c_ = 0; c_ < 4; ++c_) { const bf16x8 bt = ldfrag(TIs, 144, c_ * 16 + l15, ks * 64 + q4 * 16); WT[c_] = MFMA16(akg, bt, WT[c_]); } } \
        _Pragma("unroll") for (int c_ = 0; c_ < 4; ++c_) { u32x2 o_; o_.x = pk2(WT[c_][0], WT[c_][1]); o_.y = pk2(WT[c_][2], WT[c_][3]); \
            *(LAS u32x2*)(Wl + (c_ * 16 + l15) * 272 + (wave * 16 + q4 * 4) * 2) = o_; } \
        U = (f32x4){0.f, 0.f, 0.f, 0.f}; \
        _Pragma("unroll") for (int ks = 0; ks < 2; ++ks) { const bf16x8 a_ = ldfrag(TIs, 144, ct * 16 + l15, ks * 64 + q4 * 16), b_ = ldfrag(Vbt, 144, et * 16 + l15, ks * 64 + q4 * 16); U = MFMA16(a_, b_, U); } } while (0)

    const P4T T = p4_thread_consts(tid);
    p4_prefetch(p, F, RA, Dc, T);
    P4_INIT_S(Dc);
    { const int e0 = (tid & 7) * 4;
#pragma unroll
      for (int j = 0; j < 4; ++j) cwn[j] = *(const f32x4*)(p.dn_conv_w + j * 3072 + 2048 + Dc.h * 128 + Dc.sl * 32 + e0); }
    p4_stage(p, F, RA, Dc, 0, mk, cw, cwn);
    P4_WRITE_SB();
    P4D Dn = p4_next(F, Dc);
    if (Dn.valid) p4_prefetch(p, F, RA, Dn, T);
    P4D Dnn = Dn; if (Dn.valid) { Dnn = p4_next(F, Dn); if (Dnn.valid) p4_prefetch(p, F, RB, Dnn, T); }
    lds_barrier();
    P4_PRECOMP(0);
    lds_barrier();
    int buf = 0;
#define P4_BODY(RX) { \
        const LAS float* gv = (const LAS float*)(F.lds + P4_GV + buf * 1280); \
        const LAS unsigned char* Qs = F.lds + P4_QS + buf * 17408; const LAS unsigned char* ATs = F.lds + P4_AT + buf * 9216; \
        const int c0 = ct * 16 + q4 * 4, e = et * 16 + l15; \
         \
        f32x4 p1 = {0.f, 0.f, 0.f, 0.f}, oacc = {0.f, 0.f, 0.f, 0.f}; \
_Pragma("unroll") \
        for (int ks = 0; ks < 4; ++ks) { const bf16x8 bs = ldfrag(Sb, 272, et * 16 + l15, ks * 64 + q4 * 16); \
            const bf16x8 aw = ldfrag(Wl, 272, ct * 16 + l15, ks * 64 + q4 * 16), aq = ldfrag(Qs, 272, ct * 16 + l15, ks * 64 + q4 * 16); \
            p1 = MFMA16(aw, bs, p1); oacc = MFMA16(aq, bs, oacc); } \
        { float vn[4]; \
_Pragma("unroll") \
          for (int r = 0; r < 4; ++r) vn[r] = U[r] - p1[r]; \
          u32x2 o1, o2; o1.x = pk2(vn[0], vn[1]); o1.y = pk2(vn[2], vn[3]); \
          o2.x = pk2(vn[0] * gv[128 + c0], vn[1] * gv[128 + c0 + 1]); o2.y = pk2(vn[2] * gv[128 + c0 + 2], vn[3] * gv[128 + c0 + 3]); \
          *(LAS u32x2*)(Vt1 + e * 144 + c0 * 2) = o1; *(LAS u32x2*)(Vt2 + e * 144 + c0 * 2) = o2; } \
_Pragma("unroll") \
        for (int r = 0; r < 4; ++r) oacc[r] *= gv[c0 + r]; \
        P4D D3 = Dnn; \
        if (Dn.valid) { p4_stage(p, F, RX, Dn, buf ^ 1, mk, cw, cwn); \
            if (Dn.last && Dnn.valid) { const int e0_ = (tid & 7) * 4; _Pragma("unroll") for (int j = 0; j < 4; ++j) cwn[j] = *(const f32x4*)(p.dn_conv_w + j * 3072 + 2048 + Dnn.h * 128 + Dnn.sl * 32 + e0_); } if (Dnn.valid) { D3 = p4_next(F, Dnn); if (D3.valid) p4_prefetch(p, F, RX, D3, T); } } \
        lds_barrier(); \
         \
        { const float gl = gv[192]; \
_Pragma("unroll") \
          for (int nt = 0; nt < 2; ++nt) S[nt] *= gl; \
_Pragma("unroll") \
          for (int ks = 0; ks < 2; ++ks) \
_Pragma("unroll") \
              for (int nt = 0; nt < 2; ++nt) { const bf16x8 b_ = ldfrag(Vt2, 144, nt * 16 + l15, ks * 64 + q4 * 16); S[nt] = MFMA16(KT[ks], b_, S[nt]); } } \
_Pragma("unroll") \
        for (int ks = 0; ks < 2; ++ks) { const bf16x8 a_ = ldfrag(ATs, 144, ct * 16 + l15, ks * 64 + q4 * 16), b_ = ldfrag(Vt1, 144, et * 16 + l15, ks * 64 + q4 * 16); oacc = MFMA16(a_, b_, oacc); } \
_Pragma("unroll") \
        for (int r = 0; r < 4; ++r) *(bf16_t*)((char*)F.PROJ() + ((size_t)Dc.ci * 64 * NPROJ + Dc.d * 1024 + Dc.h * 128 + Dc.sl * 32) * 2 + (unsigned)(((c0 + r) * NPROJ + e) * 2)) = f2bf(oacc[r]); \
        if (Dc.last) { \
            if (!Dc.samp) { \
_Pragma("unroll") \
                for (int nt = 0; nt < 2; ++nt) \
_Pragma("unroll") \
                    for (int r = 0; r < 4; ++r) \
                        F.out[OUT_SD + (size_t)((Dc.seq * 2 + Dc.d) * 8 + Dc.h) * 16384 + (size_t)(wave * 16 + q4 * 4 + r) * 128 + Dc.sl * 32 + nt * 16 + l15] = S[nt][r]; \
            } \
            if (Dn.valid) P4_INIT_S(Dn); \
        } \
        P4_WRITE_SB(); \
        if (Dn.valid) P4_PRECOMP(buf ^ 1); \
        lds_barrier(); \
        if (!Dn.valid) break; \
        Dc = Dn; Dn = Dnn; Dnn = D3; buf ^= 1; \
    }
#pragma unroll 1
    for (;;) { P4_BODY(RA) P4_BODY(RB) }
#undef P4_BODY
#undef P4_INIT_S
#undef P4_WRITE_SB
#undef P4_PRECOMP
}
__device__ __forceinline__ void phase4(CParams& p, Frame& F) {
    if (F.G == 256) rg_carry_scan(p, F);
    else if (F.b == 0) {
        for (int g = F.tid; g < 69632; g += 512) { int samp = g >= 65536, gg = samp ? g - 65536 : g, seq = gg >> 11, d = (gg >> 10) & 1, ch = gg & 1023;
            const int nch = samp ? 64 : 4, c_lo = samp ? 128 + seq * 64 : seq * 4; float h = samp ? p.state_rglru[(size_t)(seq * 2 + d) * 1024 + ch] : 0.f;
            for (int i = 0; i < nch; ++i) { const int cc = d == 0 ? c_lo + i : c_lo + nch - 1 - i; const float* ag = F.RGAGG() + (size_t)(cc * 2 + d) * 2048; F.CARRY()[(size_t)(cc * 2 + d) * 1024 + ch] = h; h = ag[ch] * h + ag[1024 + ch]; } } }
    __syncthreads();
    phase4_chains(p, F);
}

__device__ __forceinline__ void phase5(CParams& p, Frame& F) {
    const int lane = F.lane;
    float nw[16];
#pragma unroll
    for (int q = 0; q < 4; ++q) { const f32x4 a = *(const f32x4*)(p.dn_norm_w + (lane & 7) * 16 + q * 4); nw[q * 4] = a[0]; nw[q * 4 + 1] = a[1]; nw[q * 4 + 2] = a[2]; nw[q * 4 + 3] = a[3]; }
#pragma unroll 4
    for (int tok = F.b * 8 + F.wave; tok < NTOK; tok += F.G * 8) {
        const bf16_t* pr = F.PROJ() + (size_t)tok * NPROJ + lane * 16;
        float o[16], z[16]; float ss = 0.f;
#pragma unroll
        for (int hf = 0; hf < 2; ++hf) { const u32x4 a = __builtin_nontemporal_load((const u32x4*)(pr + hf * 8)), b = __builtin_nontemporal_load((const u32x4*)(pr + 1024 + hf * 8)), zz = __builtin_nontemporal_load((const u32x4*)(pr + 3072 + hf * 8));
            float fa[8], fb[8], fz[8]; unpack8(a, fa); unpack8(b, fb); unpack8(zz, fz);
#pragma unroll
            for (int e = 0; e < 8; ++e) { o[hf * 8 + e] = fa[e] + fb[e]; z[hf * 8 + e] = fz[e]; ss += o[hf * 8 + e] * o[hf * 8 + e]; } }
        ss += __shfl_xor(ss, 1); ss += __shfl_xor(ss, 2); ss += __shfl_xor(ss, 4);
        const float rs = rsqrtf(ss * (1.f / 128.f) + 1e-6f);
#pragma unroll
        for (int hf = 0; hf < 2; ++hf) { float w[8];
#pragma unroll
            for (int e = 0; e < 8; ++e) w[e] = o[hf * 8 + e] * rs * nw[hf * 8 + e] * siluf_(z[hf * 8 + e]);
            *(u32x4*)(F.MIX() + (size_t)tok * 2048 + lane * 16 + hf * 8) = pack8(w); }
    }
    __syncthreads();
    for (int it = F.b; it < 1024; it += F.G) { u32x4 rows[5]; rg_load_rows(F, 128 + (it >> 3), it & 7, rows); rg_item<3>(p, F, 128 + (it >> 3), it & 7, rows, it + F.G); }
    for (int it = F.b; it < 256; it += F.G) { rg_prompt_dir<0>(p, F, it >> 3, it & 7); rg_prompt_dir<1>(p, F, it >> 3, it & 7); }

}

__device__ __forceinline__ void phase6(CParams& p, Frame& F) {
    pg8::Gemm g{F.MIX(), F.WoutT(), NTOK, 1024, 2048}; pg8::StaticOrder S; S.init(NTOK, 1024, F.G, F.b); pg8::EpiBf16 E{F.PROJ(), NPROJ};
    pg8::gemm_phase<pg8::EpiBf16, pg8::StaticOrder>(F.lds, g, S, E);
}

__device__ __forceinline__ void phase7(CParams& p, Frame& F) {
    LAS float* gt = (LAS float*)F.lds;
    for (int tb = F.b; tb < 256; tb += F.G) {
        const int grp = grp_of_block(tb);
        for (int j = F.tid; j < 1024; j += 512) gt[j] = mod_val(p, F, grp, 2048 + j) * p.post_w[j];
        __syncthreads();
#pragma unroll 2
        for (int i = 0; i < 8; ++i) {
            const int tok = tb * 64 + F.wave * 8 + i;
            const float* xr = tok < 8192 ? p.x_prompt + (size_t)tok * 1024 : p.x_sample + (size_t)(tok - 8192) * 1024;
            const bf16_t* yr = F.PROJ() + (size_t)tok * NPROJ;
            f32x4 y[4], xv[4]; float ss = 0.f;
#pragma unroll
            for (int q = 0; q < 4; ++q) xv[q] = __builtin_nontemporal_load((const f32x4*)(xr + F.lane * 4 + 256 * q));
#pragma unroll
            for (int q = 0; q < 4; ++q) { const u32x2 yb = __builtin_nontemporal_load((const u32x2*)(yr + F.lane * 4 + 256 * q));
                y[q] = (f32x4){__uint_as_float(yb.x << 16), __uint_as_float(yb.x & 0xffff0000u), __uint_as_float(yb.y << 16), __uint_as_float(yb.y & 0xffff0000u)}; ss += (y[q][0] * y[q][0] + y[q][1] * y[q][1]) + (y[q][2] * y[q][2] + y[q][3] * y[q][3]); }
            const float rstd = rsqrtf(wave_sum(ss) * (1.f / 1024.f) + 1e-6f);
#pragma unroll
            for (int q = 0; q < 4; ++q) { const int j = F.lane * 4 + 256 * q; f32x4 v = xv[q];
                if (tok >= 8192) { const int pp = (tok - 8192) & 4095; const int vv = (q < 2) ? (pp >> 6) : (pp & 63);
                    v += *(const f32x4*)(F.pe() + ((q & 1) ? 16384 : 0) + vv * 256 + F.lane * 4); }
                const f32x4 g4 = *(const LAS f32x4*)(gt + j);
                f32x4 ov = v + g4 * (y[q] * rstd); ov[0] = fin(ov[0]); ov[1] = fin(ov[1]); ov[2] = fin(ov[2]); ov[3] = fin(ov[3]); if (!(LIVE_MASK & 1)) ov = (f32x4){0.f, 0.f, 0.f, 0.f}; __builtin_nontemporal_store(ov, (f32x4*)(F.out + (size_t)tok * 1024 + j)); }
        }
        __syncthreads();
    }
}

__device__ __forceinline__ void phase8(CParams& p, Frame& F) {
    if (F.b == 0 && F.tid == 0) { int code = 0; for (int k = 31; k >= 1; --k) if (DG(F)[k]) code = k; F.out[OUT_SR] = 1000.f * (float)code + 500.f; }
}
extern __shared__ __attribute__((aligned(16))) unsigned char smem_raw[];
__global__ void __launch_bounds__(512) fwd_megakernel(Params p_unused) {
    CParams& p = *(CParams*)__builtin_amdgcn_kernarg_segment_ptr();
    Frame F;
    F.lds = (LAS unsigned char*)smem_raw;
    F.tid = threadIdx.x; F.lane = F.tid & 63; F.wave = __builtin_amdgcn_readfirstlane(F.tid >> 6); F.G = gridDim.x; F.b = blockIdx.x;
    F.out = p.out; F.ws = p.ws;
    volatile LAS unsigned* xbw = (volatile LAS unsigned*)(F.lds + LDS_BYTES - 16);
    const bool multi = (p.ph_hi - p.ph_lo) > 1;
    XcdBarrier xb; xb.bar = (unsigned*)(p.ws + WS_CTL); xb.x = 0; xb.st = xbw;
    if (multi) {
        if (F.tid == 0) { xbw[0] = 0u; xbw[1] = 0u; xbw[2] = 0u; xbw[3] = 0u; }
        __syncthreads();
        xb = xcd_barrier_post((unsigned*)(p.ws + WS_CTL), xbw);
    }
#ifndef PHMASK
#define PHMASK 511
#endif
    const int lo = p.ph_lo, hi = p.ph_hi;
#ifndef REP_PHASE
#define REP_PHASE -1
#endif
#define RUN_PHASE(k, fn) do { if (lo <= (k) && (k) < hi) { if (PHMASK & (1 << (k))) fn(p, F); if ((k) == REP_PHASE) { __syncthreads(); fn(p, F); } if ((k) + 1 < hi) xcd_barrier(xb); } } while (0)
    RUN_PHASE(0, phase0); RUN_PHASE(1, phase1); RUN_PHASE(2, phase2); RUN_PHASE(3, phase3);
    RUN_PHASE(4, phase4); RUN_PHASE(5, phase5); RUN_PHASE(6, phase6); RUN_PHASE(7, phase7); RUN_PHASE(8, phase8);
}

extern "C" void kernel_launch(void* const* d_in, const int* in_sizes, int n_in, void* d_out, int out_size, void* d_ws, size_t ws_size, hipStream_t stream) {
    static int grid = 0;
    if (grid == 0) {
        int dev = 0, cus = 0;
        if (hipGetDevice(&dev) != hipSuccess || hipDeviceGetAttribute(&cus, hipDeviceAttributeMultiprocessorCount, dev) != hipSuccess) { fprintf(stderr, "kernel_launch: device query failed\n"); grid = -1; return; }
        if (hipFuncSetAttribute((const void*)fwd_megakernel, hipFuncAttributeMaxDynamicSharedMemorySize, LDS_BYTES) != hipSuccess) { fprintf(stderr, "kernel_launch: hipFuncSetAttribute failed\n"); grid = -1; return; }
        int per_cu = 0;
        if (hipOccupancyMaxActiveBlocksPerMultiprocessor(&per_cu, (const void*)fwd_megakernel, 512, LDS_BYTES) != hipSuccess || per_cu < 1) { fprintf(stderr, "kernel_launch: occupancy query says %d blocks per CU\n", per_cu); (void)hipGetLastError(); }
        grid = cus;
    }
    if (grid < 0) return;
    Params p{};
    const float** pp = (const float**)&p;
    for (int i = 0; i < 23; ++i) pp[i] = (const float*)d_in[i];
    p.out = (float*)d_out; p.ws = (unsigned char*)d_ws;
    (void)hipMemsetAsync((char*)d_ws + WS_CTL, 0, 16384, stream);
#if MK_SINGLE
    p.ph_lo = 0; p.ph_hi = NPH;
    void* args[] = {&p};
    hipError_t e = hipLaunchCooperativeKernel((const void*)fwd_megakernel, dim3(grid), dim3(512), args, LDS_BYTES, stream);
    if (e != hipSuccess) fprintf(stderr, "cooperative launch failed: %s (grid %d)\n", hipGetErrorString(e), grid);
#else
    for (int ph = 0; ph < NPH; ++ph) {
        p.ph_lo = ph; p.ph_hi = ph + 1;
        hipLaunchKernelGGL(fwd_megakernel, dim3(grid), dim3(512), LDS_BYTES, stream, p);
    }
#endif
}
```

```cpp
#include <hip/hip_runtime.h>
#include <cstdio>
#include <cstdint>

#define LAS __attribute__((address_space(3)))
typedef unsigned short bf16_t;
typedef short bf16x8 __attribute__((ext_vector_type(8)));
typedef float f32x4 __attribute__((ext_vector_type(4)));
typedef unsigned u32x4 __attribute__((ext_vector_type(4)));
typedef unsigned u32x2 __attribute__((ext_vector_type(2)));

#ifndef REP_PHASE
#define REP_PHASE -1
#endif
#ifndef MK_SINGLE
#define MK_SINGLE 1
#endif

constexpr int NTOK = 16384, DM = 1024, NPROJ = 6144, DIN = 6176;
constexpr int NPH = 8;
constexpr int LDS_BYTES = 160 * 1024;
constexpr size_t OUT_YP = 0, OUT_YS = 8388608, OUT_SD = 16777216, OUT_SR = 25165824;
constexpr size_t WS_CTL = 0, WS_MODP = 16384, WS_PE = 606208, WS_BA = 737280, WS_GB = 2834432, WS_RGAGG = 4931584,
                 WS_WBAT = 9125888, WS_WOUTT = 9191424, WS_GT = 13385728, WS_WINT = 14434304, WS_TA = 27017216, WS_PROJ = 60571648, WS_CARRY = 261898240;

struct Params {
    const float *x_prompt, *x_sample, *state_delta, *state_rglru, *c, *c_ctx, *ada_w, *ada_b, *pre_w, *post_w, *w_in, *w_out,
                *dn_conv_w, *dn_a_log, *dn_dt_bias, *dn_norm_w, *rg_conv_w, *rg_conv_b, *rg_w_r, *rg_b_r, *rg_w_i, *rg_b_i, *rg_lam;
    float* out; unsigned char* ws;
    int ph_lo, ph_hi;
};

__device__ __forceinline__ float bf2f(unsigned short b) { return __uint_as_float(((unsigned)b) << 16); }
typedef __bf16 bf2_t __attribute__((ext_vector_type(2)));
typedef float f2_t __attribute__((ext_vector_type(2)));
__device__ __forceinline__ unsigned pk2(float lo, float hi) { const f2_t v = {lo, hi}; return __builtin_bit_cast(unsigned, __builtin_convertvector(v, bf2_t)); }
__device__ __forceinline__ unsigned short f2bf(float f) { return (unsigned short)(pk2(f, f) & 0xffffu); }
#ifndef SANITIZE
#define SANITIZE 0
#endif
#ifndef LIVE_MASK
#define LIVE_MASK 15
#endif
__device__ __forceinline__ float fin(float x) { return (SANITIZE && ((__float_as_uint(x) & 0x7f800000u) == 0x7f800000u)) ? 0.f : x; }
#define DG(F) ((unsigned*)((F).ws + WS_CTL))
__device__ __forceinline__ bool badv(float x, float lim) { return ((__float_as_uint(x) & 0x7f800000u) == 0x7f800000u) || fabsf(x) > lim; }
#ifndef DIAG
#define DIAG 0
#endif
#define CHK(F, k, bad) do { if (DIAG && (bad)) DG(F)[k] = 1u; } while (0)
__device__ __forceinline__ float sigm(float x) { return __builtin_amdgcn_rcpf(1.f + __expf(-x)); }
__device__ __forceinline__ float siluf_(float x) { return x * __builtin_amdgcn_rcpf(1.f + __expf(-x)); }
__device__ __forceinline__ float softplusf_(float x) { return x > 20.f ? x : log1pf(__expf(x)); }
__device__ __forceinline__ void unpack8(const u32x4 v, float (&f)[8]) {
    f[0] = __uint_as_float(v.x << 16); f[1] = __uint_as_float(v.x & 0xffff0000u);
    f[2] = __uint_as_float(v.y << 16); f[3] = __uint_as_float(v.y & 0xffff0000u);
    f[4] = __uint_as_float(v.z << 16); f[5] = __uint_as_float(v.z & 0xffff0000u);
    f[6] = __uint_as_float(v.w << 16); f[7] = __uint_as_float(v.w & 0xffff0000u);
}
__device__ __forceinline__ u32x4 pack8(const float (&f)[8]) { u32x4 o; o.x = pk2(f[0], f[1]); o.y = pk2(f[2], f[3]); o.z = pk2(f[4], f[5]); o.w = pk2(f[6], f[7]); return o; }
__device__ __forceinline__ float wave_sum(float v) {
#pragma unroll
    for (int o = 1; o < 64; o <<= 1) v += __shfl_xor(v, o);
    return v;
}
__device__ __forceinline__ void lds_barrier() { asm volatile("s_waitcnt lgkmcnt(0)" ::: "memory"); __builtin_amdgcn_s_barrier(); asm volatile("" ::: "memory"); }
#define MFMA16(a, b, c) __builtin_amdgcn_mfma_f32_16x16x32_bf16((a), (b), (c), 0, 0, 0)
#define LDS_WAIT() asm volatile("s_waitcnt lgkmcnt(0)" ::: "memory")
__device__ __forceinline__ bf16x8 ldfrag(const LAS unsigned char* base, int pitch, int row, int kb) { return *(const LAS bf16x8*)(base + row * pitch + kb); }

#define XB_TMO      128
#define XB_XCNT(j)  (256  + 64 * (j))
#define XB_XSUB(j)  (1280 + 64 * (j))
#define XB_XGEN(j)  (2304 + 64 * (j))
#define XB_TOP      3328
#define XB_TOPGEN   3392
#define XCD_BAR_WORDS 3456
#define XB_SPIN_CAP (1u << 18)
__device__ __forceinline__ unsigned xb_ld(unsigned* p)              { return __hip_atomic_load(p, __ATOMIC_RELAXED, __HIP_MEMORY_SCOPE_AGENT); }
__device__ __forceinline__ unsigned xb_add(unsigned* p, unsigned v) { return __hip_atomic_fetch_add(p, v, __ATOMIC_RELAXED, __HIP_MEMORY_SCOPE_AGENT); }
__device__ __forceinline__ unsigned xb_xcc_id() { return (unsigned)__builtin_amdgcn_s_getreg((3 << 11) | 20) & 0xFu; }
#define XB_SPIN(cond, bar) do { unsigned _sp = 0; while (cond) { __builtin_amdgcn_s_sleep(1); \
    if ((++_sp & 255u) == 0u) { if (xb_ld(&(bar)[XB_TMO])) break; if (_sp > XB_SPIN_CAP) { atomicAdd(&(bar)[XB_TMO], 1u); break; } } } } while (0)
struct XcdBarrier { unsigned* bar; unsigned x; volatile LAS unsigned* st; };
__device__ __forceinline__ XcdBarrier xcd_barrier_post(unsigned* bar, volatile LAS unsigned* st) {
    XcdBarrier b; b.bar = bar; b.x = xb_xcc_id(); b.st = st;
    if (threadIdx.x == 0) (void)xb_add(&bar[XB_XCNT(b.x)], 1u);
    return b;
}
__device__ __forceinline__ void xcd_barrier_complete(unsigned* bar, unsigned x, unsigned& nloc, unsigned& nx) {
    const unsigned G = gridDim.x * gridDim.y * gridDim.z;
    unsigned sum, cnt, mine, sp = 0u;
    for (;;) {
        sum = 0u; cnt = 0u; mine = 0u;
#pragma unroll
        for (unsigned j = 0; j < 16; ++j) { const unsigned c = xb_ld(&bar[XB_XCNT(j)]); sum += c; cnt += (c > 0u) ? 1u : 0u; mine = (j == x) ? c : mine; }
        if (sum == G) break;
        __builtin_amdgcn_s_sleep(1);
        if ((++sp & 255u) == 0u) { if (xb_ld(&bar[XB_TMO])) break; if (sp > XB_SPIN_CAP) { atomicAdd(&bar[XB_TMO], 1u); break; } }
    }
    nloc = mine > 0u ? mine : 1u; nx = cnt > 0u ? cnt : 1u;
}
__device__ __forceinline__ void xcd_barrier(const XcdBarrier& b) {
    asm volatile("s_waitcnt vmcnt(0)" ::: "memory");
    __syncthreads();
    if (threadIdx.x == 0) {
        unsigned* bar = b.bar;
        __builtin_amdgcn_s_waitcnt(0);
        unsigned nloc = b.st[0], nx = b.st[1];
        if (nloc == 0u) { xcd_barrier_complete(bar, b.x, nloc, nx); b.st[0] = nloc; b.st[1] = nx; }
        const unsigned old = xb_add(&bar[XB_XSUB(b.x)], 1u);
        const unsigned gen = old / nloc;
        if (old + 1u == (gen + 1u) * nloc) {
            __builtin_amdgcn_fence(__ATOMIC_RELEASE, "agent");
            asm volatile("s_waitcnt vmcnt(0)" ::: "memory");
            const unsigned og = xb_add(&bar[XB_TOP], 1u);
            const unsigned tg = og / nx;
            if (og + 1u == (tg + 1u) * nx) xb_add(&bar[XB_TOPGEN], 1u);
            else XB_SPIN(xb_ld(&bar[XB_TOPGEN]) == tg, bar);
            __builtin_amdgcn_fence(__ATOMIC_ACQUIRE, "agent");
            xb_add(&bar[XB_XGEN(b.x)], 1u);
            asm volatile("s_waitcnt vmcnt(0)" ::: "memory");
        } else {
            XB_SPIN(xb_ld(&bar[XB_XGEN(b.x)]) == gen, bar);
            __builtin_amdgcn_fence(__ATOMIC_ACQUIRE, "agent");
            asm volatile("s_waitcnt vmcnt(0)" ::: "memory");
        }
    }
    __syncthreads();
}

namespace pg8 {
constexpr int BM = 256, BK = 64, HALF = 128, HTB = HALF * BK * 2, STAGE_BYTES = 8 * HTB, NXCD = 8, WGM = 8;
__host__ __device__ __forceinline__ int lds_byte(int r, int c) { const int st = (r >> 4) * 2 + (c >> 5), rr = r & 15, cc = c & 31, ob = rr * 64 + cc * 2; return st * 1024 + (ob ^ (((ob >> 9) & 1) << 5)); }
__host__ __device__ __forceinline__ void stage_rc(int b, int& R, int& C) { const int st = b / 1024, sb = b % 1024, swz = sb ^ (((sb >> 9) & 1) << 5); R = (st >> 1) * 16 + swz / 64; C = (st & 1) * 32 + (swz % 64) / 2; }
__host__ __device__ __forceinline__ int perm32(int rho) { const int n = rho >> 4, i = rho & 15; return 8 * (i >> 2) + 4 * n + (i & 3); }
struct Unit { int pm, pn; };
struct Gemm { const bf16_t* A; const bf16_t* Bt; int M, N, K; };
struct StaticOrder {
    int nM, nN, nwg, G, c, colperm;
    __host__ __device__ void init(int M, int N, int G_, int c_, int colperm_ = 0) { nM = M / BM; nN = N / BM; nwg = nM * nN; G = G_; c = c_; colperm = colperm_; }
    __host__ __device__ bool next(int i, Unit& u) const {
        const long L = (long)i * G + c; if (L >= nwg) return false;
        int wgid = (int)L; { const int q = nwg / NXCD, r = nwg % NXCD, xcd = wgid % NXCD, off = wgid / NXCD; wgid = (xcd < r ? xcd * (q + 1) : r * (q + 1) + (xcd - r) * q) + off; }
        const int nig = WGM * nN, gid = wgid / nig, fm = gid * WGM, gsz = (nM - fm) < WGM ? (nM - fm) : WGM;
        u.pm = fm + ((wgid % nig) % gsz); u.pn = (wgid % nig) / gsz;
        if (colperm) u.pn = (int)((0x014253u >> (4 * (u.pn >> 2))) & 15u) * 4 + (u.pn & 3);
        return true;
    }
};
__device__ __forceinline__ unsigned cvt_pk_bf16(float lo, float hi) { unsigned r; asm volatile("v_cvt_pk_bf16_f32 %0, %1, %2" : "=v"(r) : "v"(lo), "v"(hi)); return r; }
struct EpiF32 {
    static constexpr bool PERM = false;
    float* C; int ldc;
    __device__ __forceinline__ void operator()(const f32x4 (&acc)[2][2][4][2], const Unit& u, int wr, int wc, int fr, int fq) const {
        const int row0 = u.pm * BM + wr * 64 + fr, col0 = u.pn * BM + wc * 32 + 4 * fq;
#pragma unroll
        for (int ai = 0; ai < 2; ++ai)
#pragma unroll
            for (int m = 0; m < 4; ++m) { float* rowp = C + (size_t)(row0 + ai * HALF + m * 16) * ldc + col0;
#pragma unroll
                for (int bj = 0; bj < 2; ++bj)
#pragma unroll
                    for (int n = 0; n < 2; ++n) *(f32x4*)(rowp + bj * HALF + n * 16) = acc[ai][bj][m][n]; }
    }
};
struct EpiBf16 {
    static constexpr bool PERM = true;
    bf16_t* O; int ldc;
    __device__ __forceinline__ void operator()(const f32x4 (&acc)[2][2][4][2], const Unit& u, int wr, int wc, int fr, int fq) const {
        const int row0 = u.pm * BM + wr * 64 + fr; const int col0 = u.pn * BM + wc * 32 + 8 * fq;
#pragma unroll
        for (int ai = 0; ai < 2; ++ai)
#pragma unroll
            for (int m = 0; m < 4; ++m) { bf16_t* rowp = O + (size_t)(row0 + ai * HALF + m * 16) * ldc + col0;
#pragma unroll
                for (int bj = 0; bj < 2; ++bj) { const f32x4 v0 = acc[ai][bj][m][0], v1 = acc[ai][bj][m][1];
                    u32x4 w; w.x = cvt_pk_bf16(v0[0], v0[1]); w.y = cvt_pk_bf16(v0[2], v0[3]); w.z = cvt_pk_bf16(v1[0], v1[1]); w.w = cvt_pk_bf16(v1[2], v1[3]);
                    *(u32x4*)(rowp + bj * HALF) = w; } }
    }
};

template <class Epi, class Sched>
__device__ __forceinline__ void gemm_phase(LAS unsigned char* lds, const Gemm g, const Sched& S, const Epi& E) {
    const int tid = threadIdx.x, wid = __builtin_amdgcn_readfirstlane(tid >> 6), lane = tid & 63, wr = wid >> 2, wc = wid & 3, fr = lane & 15, fq = lane >> 4;
    const int K = g.K, nt = K / BK;
    unsigned voffA[2], voffB[2];
#pragma unroll
    for (int i = 0; i < 2; ++i) { int R, C; stage_rc(tid * 16 + i * 8192, R, C); const int Rb = Epi::PERM ? ((R & ~31) + perm32(R & 31)) : R;
        voffA[i] = (unsigned)(R * K + C) * 2u; voffB[i] = (unsigned)(Rb * K + C) * 2u; }
    const size_t kstep = (size_t)(BK * 2);
    const size_t hstep = (size_t)HALF * K * 2;
    const size_t tstep = 2 * hstep;
    const unsigned ldsw = (unsigned)wid * 1024u;
    const int aoff = lds_byte(wr * 64 + fr, fq * 8), boff = lds_byte(wc * 32 + fr, fq * 8);
#define PG8_SA(b, h) (((b) * 2 + (h)) * HTB)
#define PG8_SB(b, h) ((4 + (b) * 2 + (h)) * HTB)
#define PG8_STAGE(bufoff, gbase, voff) do { _Pragma("unroll") for (int _i = 0; _i < 2; ++_i) \
        __builtin_amdgcn_global_load_lds((const unsigned*)((const char*)(gbase) + (voff)[_i]), (LAS unsigned*)(lds + (bufoff) + ldsw + _i * 8192), 16, 0, 0); } while (0)
#define PG8_LDA(dst, b, h) do { _Pragma("unroll") for (int m = 0; m < 4; ++m) _Pragma("unroll") for (int k = 0; k < 2; ++k) dst[m][k] = *(const LAS bf16x8*)(lds + PG8_SA(b, h) + aoff + m * 2048 + k * 1024); } while (0)
#define PG8_LDB(dst, b, h) do { _Pragma("unroll") for (int n = 0; n < 2; ++n) _Pragma("unroll") for (int k = 0; k < 2; ++k) dst[n][k] = *(const LAS bf16x8*)(lds + PG8_SB(b, h) + boff + n * 2048 + k * 1024); } while (0)
#define PG8_MMA(ai, bj, At, Bt) do { __builtin_amdgcn_s_setprio(1); _Pragma("unroll") for (int m = 0; m < 4; ++m) _Pragma("unroll") for (int n = 0; n < 2; ++n) _Pragma("unroll") for (int k = 0; k < 2; ++k) \
        acc[ai][bj][m][n] = __builtin_amdgcn_mfma_f32_16x16x32_bf16(Bt[n][k], At[m][k], acc[ai][bj][m][n], 0, 0, 0); __builtin_amdgcn_s_setprio(0); } while (0)
#define PG8_WAIT_V(n) asm volatile("s_waitcnt vmcnt(" #n ")" ::: "memory")
#define PG8_WAIT_L(n) asm volatile("s_waitcnt lgkmcnt(" #n ")" ::: "memory")
#define PG8_BAR __builtin_amdgcn_s_barrier()
#define PG8_SCHED __builtin_amdgcn_sched_barrier(0)
    Unit cur, nxt; int ui = 0;
    if (!S.next(0, cur)) return;
    f32x4 acc[2][2][4][2];
#pragma unroll
    for (int a = 0; a < 2; ++a)
#pragma unroll
        for (int b = 0; b < 2; ++b)
#pragma unroll
            for (int m = 0; m < 4; ++m)
#pragma unroll
                for (int n = 0; n < 2; ++n) acc[a][b][m][n] = (f32x4){0.f, 0.f, 0.f, 0.f};
    bf16x8 At[4][2], B0[2][2], B1[2][2];
    const char* cA = (const char*)g.A + (size_t)cur.pm * tstep; const char* cB = (const char*)g.Bt + (size_t)cur.pn * tstep;
    PG8_STAGE(PG8_SB(0, 0), cB, voffB); PG8_STAGE(PG8_SA(0, 0), cA, voffA); PG8_STAGE(PG8_SB(0, 1), cB + hstep, voffB); PG8_STAGE(PG8_SA(0, 1), cA + hstep, voffA);
    if (wr == 1) PG8_BAR;
    PG8_WAIT_V(4); PG8_BAR;
    PG8_STAGE(PG8_SB(1, 0), cB + kstep, voffB); PG8_STAGE(PG8_SA(1, 0), cA + kstep, voffA); PG8_STAGE(PG8_SB(1, 1), cB + hstep + kstep, voffB);
    PG8_WAIT_V(6); PG8_BAR;
    for (;;) {
        const bool has_next = S.next(ui + 1, nxt);
        const char* nA = has_next ? (const char*)g.A + (size_t)nxt.pm * tstep : cA; const char* nB = has_next ? (const char*)g.Bt + (size_t)nxt.pn * tstep : cB;
        for (int t = 0; t < nt; t += 2) {
            const bool last = (t == nt - 2);
            const char* a1 = cA + (size_t)(t + 1) * kstep;
            const char* a2 = last ? nA : cA + (size_t)(t + 2) * kstep; const char* b2 = last ? nB : cB + (size_t)(t + 2) * kstep;
            const char* a3 = a2 + kstep; const char* b3 = b2 + kstep;
            PG8_LDB(B0, 0, 0); PG8_SCHED; PG8_LDA(At, 0, 0); PG8_STAGE(PG8_SA(1, 1), a1 + hstep, voffA);
            PG8_WAIT_L(8); PG8_BAR; PG8_WAIT_L(0); PG8_MMA(0, 0, At, B0); PG8_BAR; PG8_SCHED;
            PG8_LDB(B1, 0, 1); PG8_STAGE(PG8_SB(0, 0), b2, voffB);
            PG8_BAR; PG8_WAIT_L(0); PG8_MMA(0, 1, At, B1); PG8_BAR;
            PG8_LDA(At, 0, 1); PG8_STAGE(PG8_SA(0, 0), a2, voffA);
            PG8_BAR; PG8_WAIT_L(0); PG8_MMA(1, 0, At, B0); PG8_BAR; PG8_SCHED;
            PG8_STAGE(PG8_SB(0, 1), b2 + hstep, voffB);
            PG8_WAIT_V(6); PG8_BAR; PG8_MMA(1, 1, At, B1); PG8_BAR;
            PG8_LDB(B0, 1, 0); PG8_SCHED; PG8_LDA(At, 1, 0); PG8_STAGE(PG8_SA(0, 1), a2 + hstep, voffA);
            PG8_WAIT_L(8); PG8_BAR; PG8_WAIT_L(0); PG8_MMA(0, 0, At, B0); PG8_BAR; PG8_SCHED;
            PG8_LDB(B1, 1, 1); PG8_STAGE(PG8_SB(1, 0), b3, voffB);
            PG8_BAR; PG8_WAIT_L(0); PG8_MMA(0, 1, At, B1); PG8_BAR;
            PG8_LDA(At, 1, 1); PG8_STAGE(PG8_SA(1, 0), a3, voffA);
            PG8_BAR; PG8_WAIT_L(0); PG8_MMA(1, 0, At, B0); PG8_BAR; PG8_SCHED;
            PG8_STAGE(PG8_SB(1, 1), b3 + hstep, voffB);
            PG8_WAIT_V(6); PG8_BAR; PG8_MMA(1, 1, At, B1); PG8_BAR;
        }
        E(acc, cur, wr, wc, fr, fq);
        if (!has_next) break;
#pragma unroll
        for (int a = 0; a < 2; ++a)
#pragma unroll
            for (int b = 0; b < 2; ++b)
#pragma unroll
                for (int m = 0; m < 4; ++m)
#pragma unroll
                    for (int n = 0; n < 2; ++n) acc[a][b][m][n] = (f32x4){0.f, 0.f, 0.f, 0.f};
        cur = nxt; cA = nA; cB = nB; ++ui;
    }
    PG8_WAIT_V(0);
    if (wr == 0) PG8_BAR;
    PG8_BAR;
#undef PG8_SA
#undef PG8_SB
#undef PG8_STAGE
#undef PG8_LDA
#undef PG8_LDB
#undef PG8_MMA
#undef PG8_WAIT_V
#undef PG8_WAIT_L
#undef PG8_BAR
#undef PG8_SCHED
}
}

struct Frame {
    LAS unsigned char* lds;
    int tid, lane, wave, G, b;
    float* out; unsigned char* ws;
    __device__ __forceinline__ bf16_t* H() const { return (bf16_t*)out; }
    __device__ __forceinline__ bf16_t* Qc() const { return (bf16_t*)out; }
    __device__ __forceinline__ bf16_t* Kc() const { return (bf16_t*)(out + OUT_YS); }
    __device__ __forceinline__ bf16_t* MIX() const { return (bf16_t*)out; }
    __device__ __forceinline__ float* modp() const { return (float*)(ws + WS_MODP); }
    __device__ __forceinline__ float* pe() const { return (float*)(ws + WS_PE); }
    __device__ __forceinline__ float* BA() const { return (float*)(ws + WS_BA); }
    __device__ __forceinline__ float* GB() const { return (float*)(ws + WS_GB); }
    __device__ __forceinline__ float* RGAGG() const { return (float*)(ws + WS_RGAGG); }
    __device__ __forceinline__ bf16_t* WbaT() const { return (bf16_t*)(ws + WS_WBAT); }
    __device__ __forceinline__ bf16_t* WoutT() const { return (bf16_t*)(ws + WS_WOUTT); }
    __device__ __forceinline__ bf16_t* GT() const { return (bf16_t*)(ws + WS_GT); }
    __device__ __forceinline__ bf16_t* WinT() const { return (bf16_t*)(ws + WS_WINT); }
    __device__ __forceinline__ bf16_t* TA() const { return (bf16_t*)(ws + WS_TA); }
    __device__ __forceinline__ bf16_t* PROJ() const { return (bf16_t*)(ws + WS_PROJ); }
    __device__ __forceinline__ float* CARRY() const { return (float*)(ws + WS_CARRY); }
};
typedef const __attribute__((address_space(4))) Params CParams;

__device__ __forceinline__ int grp_of_block(int tb) { return tb < 128 ? 0 : (tb < 192 ? 1 : 2); }

__device__ __forceinline__ void transpose_item(const float* W, int N, int k0, int n0, bf16_t* WT0, int Kout, LAS float* scr, int lane) {
#pragma unroll 8
    for (int i = 0; i < 32; ++i) { const int kk = 2 * i + (lane >> 5); scr[kk * 33 + (lane & 31)] = W[(size_t)(k0 + kk) * N + n0 + (lane & 31)]; }
    LDS_WAIT();
    const int c = lane & 7;
#pragma unroll
    for (int j = 0; j < 4; ++j) { const int n = (lane >> 3) + 8 * j; const LAS float* s = scr + (8 * c) * 33 + n;
        u32x4 o; o.x = pk2(s[0 * 33], s[1 * 33]); o.y = pk2(s[2 * 33], s[3 * 33]); o.z = pk2(s[4 * 33], s[5 * 33]); o.w = pk2(s[6 * 33], s[7 * 33]);
        *(u32x4*)(WT0 + (size_t)n * Kout + k0 + 8 * c) = o; }
    LDS_WAIT();
}
struct P0Item { const float* W; bf16_t* dst; int N, k0, n0, Kout, kind; };
__device__ __forceinline__ P0Item p0_decode(CParams& p, const Frame& F, int it) {
    constexpr int I_IN = 16 * 193, I_OUT = 32 * 32, I_G = 256;
    P0Item D; D.kind = 0; int r = it;
    if (r < I_IN) { const int kb = r / 193, nb = r % 193, n0 = nb * 32;
        D.dst = n0 < 4096 ? F.WinT() + (size_t)n0 * 1024 : (n0 < 4128 ? F.WbaT() + (size_t)(n0 - 4096) * 1024 : F.WinT() + (size_t)(n0 - 32) * 1024);
        D.W = p.w_in; D.N = DIN; D.k0 = kb * 64; D.n0 = n0; D.Kout = 1024; return D; }
    r -= I_IN;
    if (r < I_OUT) { const int kb = r / 32, nb = r % 32; D.W = p.w_out; D.N = 1024; D.k0 = kb * 64; D.n0 = nb * 32; D.dst = F.WoutT() + (size_t)(nb * 32) * 2048; D.Kout = 2048; return D; }
    r -= I_OUT;
    if (r < I_G) { const int m = r >> 3, sub = r & 7, kb = sub >> 2, nb = sub & 3, g = m >> 4, dn = m & 15;
        D.W = (g ? p.rg_w_i : p.rg_w_r) + (size_t)dn * 16384; D.N = 128; D.k0 = kb * 64; D.n0 = nb * 32; D.dst = F.GT() + (size_t)m * 16384 + (size_t)(nb * 32) * 128; D.Kout = 128; return D; }
    r -= I_G;
    D.kind = 1; D.k0 = r; D.W = p.w_in; D.dst = F.WinT(); D.N = 0; D.n0 = 0; D.Kout = 0; return D;
}
__device__ __forceinline__ void p0_load(const P0Item& D, float (&v)[32], int lane) {
#pragma unroll
    for (int i = 0; i < 32; ++i) { const int kk = 2 * i + (lane >> 5); v[i] = __builtin_nontemporal_load(D.W + (size_t)(D.k0 + kk) * D.N + D.n0 + (lane & 31)); }
}
__device__ __forceinline__ void p0_store(const P0Item& D, const float (&v)[32], LAS float* scr, int lane) {
#pragma unroll
    for (int i = 0; i < 32; ++i) { const int kk = 2 * i + (lane >> 5); scr[kk * 33 + (lane & 31)] = v[i]; }
    LDS_WAIT();
    const int c = lane & 7;
#pragma unroll
    for (int j = 0; j < 4; ++j) { const int n = (lane >> 3) + 8 * j; const LAS float* s = scr + (8 * c) * 33 + n;
        u32x4 o; o.x = pk2(s[0 * 33], s[1 * 33]); o.y = pk2(s[2 * 33], s[3 * 33]); o.z = pk2(s[4 * 33], s[5 * 33]); o.w = pk2(s[6 * 33], s[7 * 33]);
        *(u32x4*)(D.dst + (size_t)n * D.Kout + D.k0 + 8 * c) = o; }
    LDS_WAIT();
}
__device__ __forceinline__ void phase0(CParams& p, Frame& F) {
    const int tid = F.tid, lane = F.lane;
    for (int it = F.b; it < 192; it += F.G) {
        const int jg = it % 12, ks = it / 12, j = jg * 256 + (tid & 255), half = tid >> 8, k0 = ks * 64 + half * 32;
        float s0 = 0.f, s1 = 0.f, s2 = 0.f;
#pragma unroll 8
        for (int k = 0; k < 32; ++k) { const int kk = k0 + k; const float w = __builtin_nontemporal_load(p.ada_w + (size_t)kk * 3072 + j);
            s0 += siluf_(p.c_ctx[kk]) * w; s1 += siluf_(p.c[kk]) * w; s2 += siluf_(p.c[1024 + kk]) * w; }
        LAS float* red = (LAS float*)F.lds;
        if (half == 1) { red[tid - 256] = s0; red[256 + tid - 256] = s1; red[512 + tid - 256] = s2; }
        __syncthreads();
        if (half == 0) { F.modp()[(size_t)(ks * 3 + 0) * 3072 + j] = s0 + red[tid]; F.modp()[(size_t)(ks * 3 + 1) * 3072 + j] = s1 + red[256 + tid]; F.modp()[(size_t)(ks * 3 + 2) * 3072 + j] = s2 + red[512 + tid]; }
        __syncthreads();
    }
    LAS float* scr = (LAS float*)(F.lds + 4096 + F.wave * 8448);
    const int gw = F.b * 8 + F.wave, NGW = F.G * 8;
    constexpr int I_IN = 16 * 193, I_OUT = 32 * 32, I_G = 256, I_PE = 64, I_ALL = I_IN + I_OUT + I_G + I_PE;
    P0Item D = p0_decode(p, F, gw), Dn = D; float v[32], vn[32];
    if (gw < I_ALL && D.kind == 0) p0_load(D, v, lane);
    for (int it = gw; it < I_ALL; it += NGW) {
        const int itn = it + NGW;
        if (itn < I_ALL) { Dn = p0_decode(p, F, itn); if (Dn.kind == 0) p0_load(Dn, vn, lane); }
        if (D.kind == 0) p0_store(D, v, scr, lane);
        else { const int pv = D.k0;
#pragma unroll
            for (int i = 0; i < 4; ++i) { const int idx = lane * 4 + i; const float f = expf(-9.210340371976184f * (float)idx / 256.f); const float a = (float)pv * f;
                F.pe()[pv * 256 + idx] = sinf(a); F.pe()[16384 + pv * 256 + idx] = cosf(a); } }
        D = Dn;
#pragma unroll
        for (int i = 0; i < 32; ++i) v[i] = vn[i];
    }
}

__device__ __forceinline__ float mod_val(CParams& p, const Frame& F, int grp, int j) {
    float s = p.ada_b[j];
#pragma unroll
    for (int ks = 0; ks < 16; ++ks) s += F.modp()[(size_t)(ks * 3 + grp) * 3072 + j];
    return s;
}

__device__ __forceinline__ void phase1(CParams& p, Frame& F) {
    LAS float* sc = (LAS float*)F.lds; LAS float* sh = sc + 1024;
    for (int tb = F.b; tb < 256; tb += F.G) {
        const int grp = grp_of_block(tb);
        for (int j = F.tid; j < 1024; j += 512) { sh[j] = mod_val(p, F, grp, j); sc[j] = p.pre_w[j] * (1.f + mod_val(p, F, grp, 1024 + j)); }
        __syncthreads();
#pragma unroll 2
        for (int i = 0; i < 8; ++i) {
            const int tok = tb * 64 + F.wave * 8 + i;
            const float* xr = tok < 8192 ? p.x_prompt + (size_t)tok * 1024 : p.x_sample + (size_t)(tok - 8192) * 1024;
            f32x4 v[4]; float ss = 0.f;
#pragma unroll
            for (int q = 0; q < 4; ++q) { v[q] = __builtin_nontemporal_load((const f32x4*)(xr + F.lane * 4 + 256 * q));
                if (tok >= 8192) { const int pp = (tok - 8192) & 4095; const int vv = (q < 2) ? (pp >> 6) : (pp & 63);
                    const f32x4 e = *(const f32x4*)(F.pe() + ((q & 1) ? 16384 : 0) + vv * 256 + F.lane * 4); v[q] += e; }
                ss += (v[q][0] * v[q][0] + v[q][1] * v[q][1]) + (v[q][2] * v[q][2] + v[q][3] * v[q][3]); }
            const float rstd = rsqrtf(wave_sum(ss) * (1.f / 1024.f) + 1e-6f);
#pragma unroll
            for (int q = 0; q < 4; ++q) { const int j = F.lane * 4 + 256 * q; const f32x4 s4 = *(const LAS f32x4*)(sc + j), h4 = *(const LAS f32x4*)(sh + j);
                CHK(F, 1, badv(v[q][0] * rstd * s4[0] + h4[0], 100.f) || badv(v[q][3] * rstd * s4[3] + h4[3], 100.f));
                u32x2 o; o.x = pk2(v[q][0] * rstd * s4[0] + h4[0], v[q][1] * rstd * s4[1] + h4[1]); o.y = pk2(v[q][2] * rstd * s4[2] + h4[2], v[q][3] * rstd * s4[3] + h4[3]);
                *(u32x2*)(F.H() + (size_t)tok * 1024 + j) = o; }
        }
        __syncthreads();
    }
}

__device__ __forceinline__ void phase2(CParams& p, Frame& F) {
    { pg8::Gemm g{F.H(), F.WinT(), NTOK, NPROJ, 1024}; pg8::StaticOrder S; S.init(NTOK, NPROJ, F.G, F.b, 1); pg8::EpiBf16 E{F.PROJ(), NPROJ};
      pg8::gemm_phase<pg8::EpiBf16, pg8::StaticOrder>(F.lds, g, S, E); }
    const int l15 = F.lane & 15, q4 = F.lane >> 4;
    for (int tb = F.b; tb < 256; tb += F.G) {
        const int mt = F.wave >> 1, nt = F.wave & 1;
        const bf16_t* ar = F.H() + (size_t)(tb * 64 + mt * 16 + l15) * 1024 + q4 * 8;
        const bf16_t* br = F.WbaT() + (size_t)(nt * 16 + l15) * 1024 + q4 * 8;
        f32x4 acc = {0.f, 0.f, 0.f, 0.f};
#pragma unroll 16
        for (int ks = 0; ks < 32; ++ks) { const bf16x8 a = *(const bf16x8*)(ar + ks * 32), b = *(const bf16x8*)(br + ks * 32); acc = MFMA16(a, b, acc); }
#pragma unroll
        for (int r = 0; r < 4; ++r) F.BA()[(size_t)(tb * 64 + mt * 16 + q4 * 4 + r) * 32 + nt * 16 + l15] = acc[r];
    }
}

__device__ __forceinline__ void p3_load_rows(const Frame& F, int ci, int h, u32x4 (&rows)[7]) {
    const int tid = F.tid, tg = tid >> 5, part = (tid >> 4) & 1, sub = tid & 15, col = part * 1024 + h * 128 + sub * 8, t0 = ci * 64;
    int seq_lo, seq_hi; if (ci < 128) { seq_lo = (ci >> 2) * 256; seq_hi = seq_lo + 256; } else { seq_lo = 8192 + ((ci - 128) >> 6) * 4096; seq_hi = seq_lo + 4096; }
    const int tb = t0 + tg * 4 - 2;
#pragma unroll
    for (int r = 0; r < 7; ++r) { const int tok = tb + r; u32x4 v = {0u, 0u, 0u, 0u};
        if (tok >= seq_lo && tok < seq_hi) v = *(const u32x4*)(F.PROJ() + (size_t)tok * NPROJ + col);
        rows[r] = v; }
}
__device__ __forceinline__ void p3_delta_item(CParams& p, Frame& F, int ci, int h, u32x4 (&rows)[7], int itn) {
    const int tid = F.tid, lane = F.lane, wave = F.wave, q4 = lane >> 4, l15 = lane & 15;
    LAS unsigned char* Ks = F.lds; LAS unsigned char* Qs = F.lds + 17408;
    LAS float* gfv = (LAS float*)(F.lds + 34816);
    LAS unsigned char* DIR0 = F.lds + 35840;
    LAS unsigned char* ATo = F.lds + 137728;
#pragma unroll
    for (int i = 0; i < 5; ++i) { const int ch = tid + 512 * i; if (ch < 2304) { const int dd = ch >= 1152, cc = ch - dd * 1152; *(LAS u32x4*)(DIR0 + dd * 47616 + 18432 + cc * 16) = (u32x4){0u, 0u, 0u, 0u}; } }
    const int t0 = ci * 64;
    int seq_lo, seq_hi; if (ci < 128) { seq_lo = (ci >> 2) * 256; seq_hi = seq_lo + 256; } else { seq_lo = 8192 + ((ci - 128) >> 6) * 4096; seq_hi = seq_lo + 4096; }
    {
        const int tg = tid >> 5, part = (tid >> 4) & 1, sub = tid & 15, col = part * 1024 + h * 128 + sub * 8;
        float w[4][8];
#pragma unroll
        for (int j = 0; j < 4; ++j) { const f32x4 a = *(const f32x4*)(p.dn_conv_w + j * 3072 + col), b = *(const f32x4*)(p.dn_conv_w + j * 3072 + col + 4);
            w[j][0] = a[0]; w[j][1] = a[1]; w[j][2] = a[2]; w[j][3] = a[3]; w[j][4] = b[0]; w[j][5] = b[1]; w[j][6] = b[2]; w[j][7] = b[3]; }
        float acc[4][8];
#pragma unroll
        for (int i = 0; i < 4; ++i)
#pragma unroll
            for (int e = 0; e < 8; ++e) acc[i][e] = 0.f;
#pragma unroll
        for (int r = 0; r < 7; ++r) {
            float x[8]; unpack8(rows[r], x);
#pragma unroll
            for (int j = 0; j < 4; ++j) { const int i = r - j; if (i >= 0 && i < 4) {
#pragma unroll
                for (int e = 0; e < 8; ++e) acc[i][e] += w[j][e] * x[e]; } } }
#pragma unroll
        for (int i = 0; i < 4; ++i) { float ss = 0.f;
#pragma unroll
            for (int e = 0; e < 8; ++e) { acc[i][e] = siluf_(acc[i][e]); ss += acc[i][e] * acc[i][e]; }
            ss += __shfl_xor(ss, 1); ss += __shfl_xor(ss, 2); ss += __shfl_xor(ss, 4); ss += __shfl_xor(ss, 8);
            const float rs = rsqrtf(ss + 1e-6f) * (part == 0 ? 0.08838834764831845f : 1.f);
#pragma unroll
            for (int e = 0; e < 8; ++e) acc[i][e] *= rs;
            CHK(F, 4, badv(acc[i][0], 1.01f) || badv(acc[i][5], 1.01f) || badv(ss * rs * rs, part == 0 ? 0.0079f : 1.01f));
            const u32x4 o = pack8(acc[i]); const int c = tg * 4 + i;
            *(LAS u32x4*)((part ? Ks : Qs) + c * 272 + sub * 16) = o;
            if (part == 0) *(u32x4*)(F.Qc() + (size_t)(t0 + c) * 1024 + h * 128 + sub * 8) = o; }
        if (part == 1) {
            bf16_t* kt = F.Kc() + (size_t)(ci * 8 + h) * 8192 + (size_t)(sub * 8) * 64 + tg * 4;
#pragma unroll
            for (int e = 0; e < 8; ++e) { u32x2 o2; o2.x = pk2(acc[0][e], acc[1][e]); o2.y = pk2(acc[2][e], acc[3][e]); *(u32x2*)(kt + e * 64) = o2; } }
    }
    if (wave == 0) {
        const float* ba = F.BA() + (size_t)(t0 + lane) * 32;
        const float bf_ = sigm(ba[h]), bb_ = sigm(ba[8 + h]);
        float s = -expf(p.dn_a_log[h]) * softplusf_(ba[16 + h] + p.dn_dt_bias[h]);
        float sb = -expf(p.dn_a_log[8 + h]) * softplusf_(ba[24 + h] + p.dn_dt_bias[8 + h]);
#pragma unroll
        for (int o = 1; o < 64; o <<= 1) { const float t = __shfl_up(s, o); if (lane >= o) s += t; }
#pragma unroll
        for (int o = 1; o < 64; o <<= 1) { const float t = __shfl_down(sb, o); if (lane + o < 64) sb += t; }
        CHK(F, 3, badv(ba[h], 1000.f) || badv(ba[24 + h], 1000.f));
        CHK(F, 8, badv(s, 1e4f) || badv(sb, 1e4f) || s > 0.f || sb > 0.f || bf_ < 0.f || bf_ > 1.f || bb_ < 0.f || bb_ > 1.f);
        gfv[lane] = s; gfv[64 + lane] = sb; gfv[128 + lane] = bf_; gfv[192 + lane] = bb_;
        float* gb = F.GB() + (size_t)(ci * 8 + h) * 256;
        gb[lane] = s; gb[64 + lane] = sb; gb[128 + lane] = bf_; gb[192 + lane] = bb_;
    }
    lds_barrier();
    const int d = wave >> 2, mt = wave & 3;
    LAS unsigned char* Db = DIR0 + d * 47616;
    LAS unsigned char* Brow = Db; LAS unsigned char* Btr = Db + 9216; LAS unsigned char* Xrow = Db + 18432; LAS unsigned char* Xtr = Db + 27648;
    LAS float* Dl = (LAS float*)(Db + 36864) + mt * 320; LAS unsigned char* M2t = Db + 41984; LAS unsigned char* Mts = Db + 44544 + mt * 768;
    const LAS unsigned char* Lrow = Brow;
    const LAS float* gd = gfv + d * 64; const LAS float* bd = gfv + 128 + d * 64;
    {
        f32x4 kk[4], qk[4];
#pragma unroll
        for (int n = 0; n < 4; ++n) { kk[n] = (f32x4){0.f, 0.f, 0.f, 0.f}; qk[n] = (f32x4){0.f, 0.f, 0.f, 0.f}; }
#pragma unroll
        for (int ks = 0; ks < 4; ++ks) { const bf16x8 ak = ldfrag(Ks, 272, mt * 16 + l15, ks * 64 + q4 * 16), aq = ldfrag(Qs, 272, mt * 16 + l15, ks * 64 + q4 * 16);
#pragma unroll
            for (int n = 0; n < 4; ++n) { const bf16x8 bk = ldfrag(Ks, 272, n * 16 + l15, ks * 64 + q4 * 16); kk[n] = MFMA16(ak, bk, kk[n]); qk[n] = MFMA16(aq, bk, qk[n]); } }
#pragma unroll
        for (int n = 0; n < 4; ++n) { const int C = n * 16 + l15; const float gC = gd[C], bC = bd[C]; float a4[4];
#pragma unroll
            for (int r = 0; r < 4; ++r) { const int R = mt * 16 + q4 * 4 + r;
                const float dec = __expf(-fabsf(gd[R] - gC));
                a4[r] = (C > R) ? (d == 0 ? bC : bd[R]) * kk[n][r] * dec : 0.f;
                const bool incl = d == 0 ? (R >= C) : (R < C);
                if (incl) ((LAS bf16_t*)ATo)[R * 64 + C] = f2bf(qk[n][r] * dec); }
            u32x2 o; o.x = pk2(a4[0], a4[1]); o.y = pk2(a4[2], a4[3]);
            *(LAS u32x2*)(Brow + C * 144 + (mt * 16 + q4 * 4) * 2) = o;
            if (n == mt) *(LAS f32x4*)(Dl + l15 * 20 + q4 * 4) = (f32x4){a4[0], a4[1], a4[2], a4[3]}; }
    }
    lds_barrier();
    if (itn < 2048) p3_load_rows(F, itn >> 3, itn & 7, rows);
    if (lane < 16) {
        float x[16];
#pragma unroll
        for (int i = 0; i < 16; ++i) { float sv = (i == lane) ? 1.f : 0.f;
            float drow[16];
#pragma unroll
            for (int q = 0; q < 4; ++q) if (4 * q < i) { const f32x4 t4 = *(const LAS f32x4*)(Dl + i * 20 + 4 * q); drow[4 * q] = t4[0]; drow[4 * q + 1] = t4[1]; drow[4 * q + 2] = t4[2]; drow[4 * q + 3] = t4[3]; }
#pragma unroll
            for (int j = 0; j < i; ++j) sv -= drow[j] * x[j];
            x[i] = sv; }
#pragma unroll
        for (int i = 0; i < 16; ++i) ((LAS bf16_t*)Xrow)[(mt * 16 + i) * 72 + mt * 16 + lane] = f2bf(x[i]);
        u32x4 o0, o1; o0.x = pk2(x[0], x[1]); o0.y = pk2(x[2], x[3]); o0.z = pk2(x[4], x[5]); o0.w = pk2(x[6], x[7]);
        o1.x = pk2(x[8], x[9]); o1.y = pk2(x[10], x[11]); o1.z = pk2(x[12], x[13]); o1.w = pk2(x[14], x[15]);
        *(LAS u32x4*)(Xtr + (mt * 16 + lane) * 144 + mt * 32) = o0; *(LAS u32x4*)(Xtr + (mt * 16 + lane) * 144 + mt * 32 + 16) = o1;
    }
    lds_barrier();
    const bf16x8 zero8 = {0, 0, 0, 0, 0, 0, 0, 0};
    const f32x4 zero4 = {0.f, 0.f, 0.f, 0.f};
    if (mt & 1) {
        const int I1 = mt, I0 = mt - 1;
        bf16x8 a = zero8, b = zero8;
        if (q4 < 2) { a = ldfrag(Lrow, 144, I1 * 16 + l15, I0 * 32 + q4 * 16); b = ldfrag(Xtr, 144, I0 * 16 + l15, I0 * 32 + q4 * 16); }
        const f32x4 M = MFMA16(a, b, zero4);
        { u32x2 o; o.x = pk2(M[0], M[1]); o.y = pk2(M[2], M[3]); *(LAS u32x2*)(Mts + l15 * 48 + q4 * 8) = o; }
        LDS_WAIT();
        bf16x8 a2 = zero8, b2 = zero8;
        if (q4 < 2) { a2 = ldfrag(Xrow, 144, I1 * 16 + l15, I1 * 32 + q4 * 16); b2 = *(const LAS bf16x8*)(Mts + l15 * 48 + q4 * 16); }
        const f32x4 X = MFMA16(a2, b2, zero4);
#pragma unroll
        for (int r = 0; r < 4; ++r) ((LAS bf16_t*)Xrow)[(I1 * 16 + q4 * 4 + r) * 72 + I0 * 16 + l15] = f2bf(-X[r]);
        u32x2 o; o.x = pk2(-X[0], -X[1]); o.y = pk2(-X[2], -X[3]);
        *(LAS u32x2*)(Xtr + (I0 * 16 + l15) * 144 + (I1 * 16 + q4 * 4) * 2) = o;
    }
    lds_barrier();
    {
        const int mi = mt >> 1, ni = mt & 1;
        const bf16x8 a = ldfrag(Lrow, 144, 32 + mi * 16 + l15, q4 * 16), b = ldfrag(Xtr, 144, ni * 16 + l15, q4 * 16);
        const f32x4 M2 = MFMA16(a, b, zero4);
        { u32x2 o; o.x = pk2(M2[0], M2[1]); o.y = pk2(M2[2], M2[3]); *(LAS u32x2*)(M2t + (ni * 16 + l15) * 80 + (mi * 16 + q4 * 4) * 2) = o; }
        lds_barrier();
        const bf16x8 a2 = ldfrag(Xrow, 144, 32 + mi * 16 + l15, 64 + q4 * 16), b2 = *(const LAS bf16x8*)(M2t + (ni * 16 + l15) * 80 + q4 * 16);
        const f32x4 X = MFMA16(a2, b2, zero4);
#pragma unroll
        for (int r = 0; r < 4; ++r) { CHK(F, 6, badv(X[r], 20.f)); ((LAS bf16_t*)Xrow)[(32 + mi * 16 + q4 * 4 + r) * 72 + ni * 16 + l15] = f2bf(-X[r]); }
        u32x2 o; o.x = pk2(-X[0], -X[1]); o.y = pk2(-X[2], -X[3]);
        *(LAS u32x2*)(Xtr + (ni * 16 + l15) * 144 + (32 + mi * 16 + q4 * 4) * 2) = o;
    }
    lds_barrier();
    { bf16_t* dst = F.TA() + (size_t)(ci * 8 + h) * 8192;
      const int c = tid >> 3, s0 = (tid & 7) * 8;
      const u32x4 lo = *(const LAS u32x4*)(DIR0 + 18432 + c * 144 + s0 * 2), up = *(const LAS u32x4*)(DIR0 + 47616 + 27648 + c * 144 + s0 * 2);
      unsigned wl[4] = {lo.x, lo.y, lo.z, lo.w}, wu[4] = {up.x, up.y, up.z, up.w}, wo[4];
#pragma unroll
      for (int i = 0; i < 4; ++i) { const int sa = s0 + 2 * i, sb2 = sa + 1;
          const unsigned mlo = (sa <= c ? 0x0000FFFFu : 0u) | (sb2 <= c ? 0xFFFF0000u : 0u);
          wo[i] = (wl[i] & mlo) | (wu[i] & ~mlo); }
      *(u32x4*)(dst + tid * 8) = (u32x4){wo[0], wo[1], wo[2], wo[3]};
      *(u32x4*)(dst + 4096 + tid * 8) = *(const LAS u32x4*)(ATo + tid * 16); }
    lds_barrier();
}

struct RgW { bf16x8 g[2][2][4]; float br[2], bi[2], sp[2]; };
__device__ __forceinline__ void rg_load_w(CParams& p, const Frame& F, int n, RgW& W) {
    const int q4 = F.lane >> 4, j = F.wave * 16 + (F.lane & 15), ch = n * 128 + j;
#pragma unroll
    for (int d = 0; d < 2; ++d) {
#pragma unroll
        for (int g = 0; g < 2; ++g) { const bf16_t* gp = F.GT() + (size_t)((g * 2 + d) * 8 + n) * 16384 + (size_t)j * 128 + q4 * 8;
#pragma unroll
            for (int ks = 0; ks < 4; ++ks) W.g[d][g][ks] = *(const bf16x8*)(gp + ks * 32); }
        W.br[d] = p.rg_b_r[d * 1024 + ch]; W.bi[d] = p.rg_b_i[d * 1024 + ch]; W.sp[d] = softplusf_(-p.rg_lam[d * 1024 + ch]); }
}
__device__ __forceinline__ void rg_load_rows(const Frame& F, int ci, int n, u32x4 (&rows)[5]) {
    const int tid = F.tid, tg = tid >> 4, sub = tid & 15, col = 4096 + n * 128 + sub * 8, t0 = ci * 64;
    int c_lo, c_hi; if (ci < 128) { c_lo = (ci >> 2) * 4; c_hi = c_lo + 4; } else { c_lo = 128 + ((ci - 128) >> 6) * 64; c_hi = c_lo + 64; }
    const int tb = t0 + tg * 2 - 2;
#pragma unroll
    for (int r = 0; r < 5; ++r) { const int tok = tb + r; u32x4 v = {0u, 0u, 0u, 0u};
        if (tok >= c_lo * 64 && tok < c_hi * 64) v = *(const u32x4*)(F.PROJ() + (size_t)tok * NPROJ + col);
        rows[r] = v; }
}
template <int PASS>
__device__ __forceinline__ void rg_item(CParams& p, Frame& F, int ci, int n, u32x4 (&rows)[5], int itn) {
    const int tid = F.tid, lane = F.lane, wave = F.wave, q4 = lane >> 4, l15 = lane & 15;
    LAS unsigned char* xb = F.lds; LAS float* xf = (LAS float*)(F.lds + 17408); LAS float* Hs = (LAS float*)(F.lds + 50176);
    const int t0 = ci * 64;
    int seq_lo, seq_hi, c_lo, c_hi, seq; const bool samp = ci >= 128;
    if (!samp) { seq = ci >> 2; c_lo = seq * 4; c_hi = c_lo + 4; } else { seq = (ci - 128) >> 6; c_lo = 128 + seq * 64; c_hi = c_lo + 64; }
    seq_lo = c_lo * 64; seq_hi = c_hi * 64;
    const int j = wave * 16 + l15, ch = n * 128 + j;
    bf16x8 wA[2][4], wB[2][4];
#pragma unroll
    for (int g = 0; g < 2; ++g) { const bf16_t* gp = F.GT() + (size_t)((g * 2 + 0) * 8 + n) * 16384 + (size_t)j * 128 + q4 * 8;
#pragma unroll
        for (int ks = 0; ks < 4; ++ks) wA[g][ks] = *(const bf16x8*)(gp + ks * 32); }
    {
        const int tg = tid >> 4, sub = tid & 15, ch = n * 128 + sub * 8;
        float w[4][8], acc[2][8];
#pragma unroll
        for (int j = 0; j < 4; ++j) { const f32x4 a = *(const f32x4*)(p.rg_conv_w + j * 1024 + ch), b = *(const f32x4*)(p.rg_conv_w + j * 1024 + ch + 4);
            w[j][0] = a[0]; w[j][1] = a[1]; w[j][2] = a[2]; w[j][3] = a[3]; w[j][4] = b[0]; w[j][5] = b[1]; w[j][6] = b[2]; w[j][7] = b[3]; }
        { const f32x4 a = *(const f32x4*)(p.rg_conv_b + ch), b = *(const f32x4*)(p.rg_conv_b + ch + 4);
#pragma unroll
          for (int i = 0; i < 2; ++i) { acc[i][0] = a[0]; acc[i][1] = a[1]; acc[i][2] = a[2]; acc[i][3] = a[3]; acc[i][4] = b[0]; acc[i][5] = b[1]; acc[i][6] = b[2]; acc[i][7] = b[3]; } }
#pragma unroll
        for (int r = 0; r < 5; ++r) {
            float x[8]; unpack8(rows[r], x);
#pragma unroll
            for (int j = 0; j < 4; ++j) { const int i = r - j; if (i >= 0 && i < 2) {
#pragma unroll
                for (int e = 0; e < 8; ++e) acc[i][e] += w[j][e] * x[e]; } } }
#pragma unroll
        for (int i = 0; i < 2; ++i) { const int c = tg * 2 + i;
            *(LAS u32x4*)(xb + c * 272 + sub * 16) = pack8(acc[i]);
            *(LAS f32x4*)(xf + c * 128 + sub * 8) = (f32x4){acc[i][0], acc[i][1], acc[i][2], acc[i][3]};
            *(LAS f32x4*)(xf + c * 128 + sub * 8 + 4) = (f32x4){acc[i][4], acc[i][5], acc[i][6], acc[i][7]}; }
    }
    lds_barrier();
    f32x4 hs[4];
#pragma unroll
    for (int m = 0; m < 4; ++m) hs[m] = (f32x4){0.f, 0.f, 0.f, 0.f};
#pragma unroll
    for (int d = 0; d < 2; ++d) {
        f32x4 av[4], bxv[4];
        {
            f32x4 ar[4], ai[4];
#pragma unroll
            for (int m = 0; m < 4; ++m) { ar[m] = (f32x4){0.f, 0.f, 0.f, 0.f}; ai[m] = (f32x4){0.f, 0.f, 0.f, 0.f}; }
#pragma unroll
            for (int ks = 0; ks < 4; ++ks) { const bf16x8 br = d == 0 ? wA[0][ks] : wB[0][ks], bi = d == 0 ? wA[1][ks] : wB[1][ks];
#pragma unroll
                for (int m = 0; m < 4; ++m) { const bf16x8 a = ldfrag(xb, 272, m * 16 + l15, ks * 64 + q4 * 16); ar[m] = MFMA16(a, br, ar[m]); ai[m] = MFMA16(a, bi, ai[m]); } }
            if (d == 0) {
#pragma unroll
                for (int g = 0; g < 2; ++g) { const bf16_t* gp = F.GT() + (size_t)((g * 2 + 1) * 8 + n) * 16384 + (size_t)j * 128 + q4 * 8;
#pragma unroll
                    for (int ks = 0; ks < 4; ++ks) wB[g][ks] = *(const bf16x8*)(gp + ks * 32); } }
            const float L2E = 1.4426950408889634f;
            const float br_ = -L2E * p.rg_b_r[d * 1024 + ch], bi_ = -L2E * p.rg_b_i[d * 1024 + ch], sp = softplusf_(-p.rg_lam[d * 1024 + ch]);
            const float k2 = -16.f * sp, k2e = k2 * L2E, k1e = 0.5f * k2e;
#pragma unroll
            for (int m = 0; m < 4; ++m)
#pragma unroll
                for (int r = 0; r < 4; ++r) { const int c = m * 16 + q4 * 4 + r;
                    const float rr = __builtin_amdgcn_rcpf(1.f + __builtin_amdgcn_exp2f(fmaf(ar[m][r], -L2E, br_)));
                    const float ii = __builtin_amdgcn_rcpf(1.f + __builtin_amdgcn_exp2f(fmaf(ai[m][r], -L2E, bi_)));
                    const float a_ = __builtin_amdgcn_exp2f(k1e * rr);
                    const float em = fmaf(a_, a_, -1.f);
                    av[m][r] = a_; bxv[m][r] = __builtin_amdgcn_sqrtf(fmaxf(-em, 0.f)) * (ii * xf[c * 128 + j]); }
        }
        f32x4 Pa[4], Pb[4]; float Ap[4], Bp[4], Am[4], Bm[4];
#pragma unroll
        for (int m = 0; m < 4; ++m) {
            float pa, pb;
            if (d == 0) { pa = av[m][0]; pb = bxv[m][0]; Pa[m][0] = pa; Pb[m][0] = pb;
#pragma unroll
                for (int r = 1; r < 4; ++r) { pb = av[m][r] * pb + bxv[m][r]; pa = av[m][r] * pa; Pa[m][r] = pa; Pb[m][r] = pb; } }
            else { pa = av[m][3]; pb = bxv[m][3]; Pa[m][3] = pa; Pb[m][3] = pb;
#pragma unroll
                for (int r = 2; r >= 0; --r) { pb = av[m][r] * pb + bxv[m][r]; pa = av[m][r] * pa; Pa[m][r] = pa; Pb[m][r] = pb; } }
            float Ak[4], Bk[4];
#pragma unroll
            for (int k = 0; k < 4; ++k) { Ak[k] = __shfl(pa, l15 + 16 * k); Bk[k] = __shfl(pb, l15 + 16 * k); }
            float ap = 1.f, bp = 0.f, am = 1.f, bm = 0.f;
#pragma unroll
            for (int kk = 0; kk < 4; ++kk) { const int k = d == 0 ? kk : 3 - kk;
                const bool before = d == 0 ? (k < q4) : (k > q4);
                const float nb = Ak[k] * bp + Bk[k], na = Ak[k] * ap;
                bp = before ? nb : bp; ap = before ? na : ap;
                bm = Ak[k] * bm + Bk[k]; am = Ak[k] * am; }
            Ap[m] = ap; Bp[m] = bp; Am[m] = am; Bm[m] = bm;
        }
        if (PASS == 1) {
            float At = 1.f, Bt = 0.f;
#pragma unroll
            for (int mm = 0; mm < 4; ++mm) { const int m = d == 0 ? mm : 3 - mm; Bt = Am[m] * Bt + Bm[m]; At = Am[m] * At; }
            if (q4 == 0) { float* ag = F.RGAGG() + (size_t)(ci * 2 + d) * 2048; ag[ch] = At; ag[1024 + ch] = Bt; }
        } else {
            float hb = F.CARRY()[(size_t)(ci * 2 + d) * 1024 + ch];
#pragma unroll
            for (int mm = 0; mm < 4; ++mm) { const int m = d == 0 ? mm : 3 - mm;
                const float hin = Ap[m] * hb + Bp[m];
#pragma unroll
                for (int r = 0; r < 4; ++r) hs[m][r] += Pa[m][r] * hin + Pb[m][r];
                hb = Am[m] * hb + Bm[m]; }
            if (!samp && q4 == 0 && ci == (d == 0 ? c_hi - 1 : c_lo)) F.out[OUT_SR + (size_t)(seq * 2 + d) * 1024 + ch] = hb;
        }
    }
    if (PASS == 1 && itn < 1024) rg_load_rows(F, 128 + (itn >> 3), itn & 7, rows);
    if (PASS == 3) {
#pragma unroll
        for (int m = 0; m < 4; ++m)
#pragma unroll
            for (int r = 0; r < 4; ++r) Hs[(m * 16 + q4 * 4 + r) * 128 + j] = hs[m][r];
        lds_barrier();
#pragma unroll
        for (int i = 0; i < 2; ++i) { const int chunk = tid + 512 * i, c = chunk >> 4, cc = chunk & 15;
            const u32x4 gv = *(const u32x4*)(F.PROJ() + (size_t)(t0 + c) * NPROJ + 5120 + n * 128 + cc * 8);
            float g[8]; unpack8(gv, g);
            const f32x4 ha = *(const LAS f32x4*)(Hs + c * 128 + cc * 8), hb2 = *(const LAS f32x4*)(Hs + c * 128 + cc * 8 + 4);
            float o[8];
#pragma unroll
            for (int e = 0; e < 4; ++e) { o[e] = ha[e] * siluf_(g[e]); o[4 + e] = hb2[e] * siluf_(g[4 + e]); }
            *(u32x4*)(F.MIX() + (size_t)(t0 + c) * 2048 + 1024 + n * 128 + cc * 8) = pack8(o); }
    }
    lds_barrier();
}

__device__ __forceinline__ void rg_conv_lds(CParams& p, const Frame& F, int n, const u32x4 (&rows)[5], LAS unsigned char* xb, LAS float* xf) {
    const int tid = F.tid, tg = tid >> 4, sub = tid & 15, ch = n * 128 + sub * 8;
    float w[4][8], acc[2][8];
#pragma unroll
    for (int j = 0; j < 4; ++j) { const f32x4 a = *(const f32x4*)(p.rg_conv_w + j * 1024 + ch), b = *(const f32x4*)(p.rg_conv_w + j * 1024 + ch + 4);
        w[j][0] = a[0]; w[j][1] = a[1]; w[j][2] = a[2]; w[j][3] = a[3]; w[j][4] = b[0]; w[j][5] = b[1]; w[j][6] = b[2]; w[j][7] = b[3]; }
    { const f32x4 a = *(const f32x4*)(p.rg_conv_b + ch), b = *(const f32x4*)(p.rg_conv_b + ch + 4);
#pragma unroll
      for (int i = 0; i < 2; ++i) { acc[i][0] = a[0]; acc[i][1] = a[1]; acc[i][2] = a[2]; acc[i][3] = a[3]; acc[i][4] = b[0]; acc[i][5] = b[1]; acc[i][6] = b[2]; acc[i][7] = b[3]; } }
#pragma unroll
    for (int r = 0; r < 5; ++r) { float x[8]; unpack8(rows[r], x);
#pragma unroll
        for (int j = 0; j < 4; ++j) { const int i = r - j; if (i >= 0 && i < 2) {
#pragma unroll
            for (int e = 0; e < 8; ++e) acc[i][e] += w[j][e] * x[e]; } } }
#pragma unroll
    for (int i = 0; i < 2; ++i) { const int c = tg * 2 + i;
        *(LAS u32x4*)(xb + c * 272 + sub * 16) = pack8(acc[i]);
        *(LAS f32x4*)(xf + c * 128 + sub * 8) = (f32x4){acc[i][0], acc[i][1], acc[i][2], acc[i][3]};
        *(LAS f32x4*)(xf + c * 128 + sub * 8 + 4) = (f32x4){acc[i][4], acc[i][5], acc[i][6], acc[i][7]}; }
}
template <int D>
__device__ __forceinline__ void rg_gate_scan(const Frame& F, const bf16x8 (&wg)[2][4], float br_, float bi_, float sp, const LAS unsigned char* xb, const LAS float* xf, int j,
                                             f32x4 (&Pa)[4], f32x4 (&Pb)[4], float (&Ap)[4], float (&Bp)[4], float (&Am)[4], float (&Bm)[4]) {
    const int lane = F.lane, q4 = lane >> 4, l15 = lane & 15;
    f32x4 av[4], bxv[4];
    {
        f32x4 ar[4], ai[4];
#pragma unroll
        for (int m = 0; m < 4; ++m) { ar[m] = (f32x4){0.f, 0.f, 0.f, 0.f}; ai[m] = (f32x4){0.f, 0.f, 0.f, 0.f}; }
#pragma unroll
        for (int ks = 0; ks < 4; ++ks) {
#pragma unroll
            for (int m = 0; m < 4; ++m) { const bf16x8 a = ldfrag(xb, 272, m * 16 + l15, ks * 64 + q4 * 16); ar[m] = MFMA16(a, wg[0][ks], ar[m]); ai[m] = MFMA16(a, wg[1][ks], ai[m]); } }
        const float L2E = 1.4426950408889634f;
        const float brs = -L2E * br_, bis = -L2E * bi_, k2 = -16.f * sp, k1e = 0.5f * k2 * L2E;
#pragma unroll
        for (int m = 0; m < 4; ++m)
#pragma unroll
            for (int r = 0; r < 4; ++r) { const int c = m * 16 + q4 * 4 + r;
                const float rr = __builtin_amdgcn_rcpf(1.f + __builtin_amdgcn_exp2f(fmaf(ar[m][r], -L2E, brs)));
                const float ii = __builtin_amdgcn_rcpf(1.f + __builtin_amdgcn_exp2f(fmaf(ai[m][r], -L2E, bis)));
                const float a = __builtin_amdgcn_exp2f(k1e * rr);
                const float em = fmaf(a, a, -1.f);
                av[m][r] = a; bxv[m][r] = __builtin_amdgcn_sqrtf(fmaxf(-em, 0.f)) * (ii * xf[c * 128 + j]); }
    }
#pragma unroll
    for (int m = 0; m < 4; ++m) {
        float pa, pb;
        if (D == 0) { pa = av[m][0]; pb = bxv[m][0]; Pa[m][0] = pa; Pb[m][0] = pb;
#pragma unroll
            for (int r = 1; r < 4; ++r) { pb = av[m][r] * pb + bxv[m][r]; pa = av[m][r] * pa; Pa[m][r] = pa; Pb[m][r] = pb; } }
        else { pa = av[m][3]; pb = bxv[m][3]; Pa[m][3] = pa; Pb[m][3] = pb;
#pragma unroll
            for (int r = 2; r >= 0; --r) { pb = av[m][r] * pb + bxv[m][r]; pa = av[m][r] * pa; Pa[m][r] = pa; Pb[m][r] = pb; } }
        float Ak[4], Bk[4];
#pragma unroll
        for (int k = 0; k < 4; ++k) { Ak[k] = __shfl(pa, l15 + 16 * k); Bk[k] = __shfl(pb, l15 + 16 * k); }
        float ap = 1.f, bp = 0.f, am = 1.f, bm = 0.f;
#pragma unroll
        for (int kk = 0; kk < 4; ++kk) { const int k = D == 0 ? kk : 3 - kk;
            const bool before = D == 0 ? (k < q4) : (k > q4);
            const float nb = Ak[k] * bp + Bk[k], na = Ak[k] * ap;
            bp = before ? nb : bp; ap = before ? na : ap;
            bm = Ak[k] * bm + Bk[k]; am = Ak[k] * am; }
        Ap[m] = ap; Bp[m] = bp; Am[m] = am; Bm[m] = bm;
    }
}
template <int D>
__device__ __forceinline__ void rg_prompt_dir(CParams& p, Frame& F, int seq, int n) {
    const int tid = F.tid, lane = F.lane, wave = F.wave, q4 = lane >> 4, l15 = lane & 15;
    LAS unsigned char* xb = F.lds; LAS float* xf = (LAS float*)(F.lds + 17408); LAS float* Hs = (LAS float*)(F.lds + 50176); LAS bf16_t* Hf = (LAS bf16_t*)(F.lds + 82944);
    const int j = wave * 16 + l15, ch = n * 128 + j;
    bf16x8 wg[2][4];
#pragma unroll
    for (int g = 0; g < 2; ++g) { const bf16_t* gp = F.GT() + (size_t)((g * 2 + D) * 8 + n) * 16384 + (size_t)j * 128 + q4 * 8;
#pragma unroll
        for (int ks = 0; ks < 4; ++ks) wg[g][ks] = *(const bf16x8*)(gp + ks * 32); }
    const float br_ = p.rg_b_r[D * 1024 + ch], bi_ = p.rg_b_i[D * 1024 + ch], sp = softplusf_(-p.rg_lam[D * 1024 + ch]);
    float hb = 0.f;
    u32x4 rows[5];
    rg_load_rows(F, seq * 4 + (D == 0 ? 0 : 3), n, rows);
#pragma unroll 1
    for (int cs = 0; cs < 4; ++cs) {
        const int cidx = D == 0 ? cs : 3 - cs, ci = seq * 4 + cidx, t0 = ci * 64;
        rg_conv_lds(p, F, n, rows, xb, xf);
        if (cs < 3) rg_load_rows(F, seq * 4 + (D == 0 ? cidx + 1 : cidx - 1), n, rows);
        lds_barrier();
        f32x4 Pa[4], Pb[4]; float Ap[4], Bp[4], Am[4], Bm[4];
        rg_gate_scan<D>(F, wg, br_, bi_, sp, xb, xf, j, Pa, Pb, Ap, Bp, Am, Bm);
#pragma unroll
        for (int mm = 0; mm < 4; ++mm) { const int m = D == 0 ? mm : 3 - mm;
            const float hin = Ap[m] * hb + Bp[m];
#pragma unroll
            for (int r = 0; r < 4; ++r) { const float hv = Pa[m][r] * hin + Pb[m][r]; const int tl = m * 16 + q4 * 4 + r;
                if (D == 0) Hf[(cidx * 64 + tl) * 128 + j] = f2bf(hv);
                else Hs[tl * 128 + j] = hv + bf2f(Hf[(cidx * 64 + tl) * 128 + j]); }
            hb = Am[m] * hb + Bm[m]; }
        lds_barrier();
        if (D == 1) {
#pragma unroll
            for (int i = 0; i < 2; ++i) { const int chunk = tid + 512 * i, c = chunk >> 4, cc = chunk & 15;
                const u32x4 gv = __builtin_nontemporal_load((const u32x4*)(F.PROJ() + (size_t)(t0 + c) * NPROJ + 5120 + n * 128 + cc * 8)); float g[8]; unpack8(gv, g);
                const f32x4 ha = *(const LAS f32x4*)(Hs + c * 128 + cc * 8), hb2 = *(const LAS f32x4*)(Hs + c * 128 + cc * 8 + 4);
                float o[8];
#pragma unroll
                for (int e = 0; e < 4; ++e) { o[e] = ha[e] * siluf_(g[e]); o[4 + e] = hb2[e] * siluf_(g[4 + e]); }
                *(u32x4*)(F.MIX() + (size_t)(t0 + c) * 2048 + 1024 + n * 128 + cc * 8) = pack8(o); }
            lds_barrier();
        }
    }
    if (q4 == 0) F.out[OUT_SR + (size_t)(seq * 2 + D) * 1024 + ch] = hb;
}

__device__ __forceinline__ void rg_carry_scan(CParams& p, Frame& F) {
    const int tid = F.tid;
    if (tid < 256 || tid >= 272) return;
    const int g = F.b * 16 + tid - 256; if (g >= 4096) return;
    const int seq = g >> 11, d = (g >> 10) & 1, ch = g & 1023, c_lo = 128 + seq * 64;
    const float* ag0 = F.RGAGG() + (size_t)d * 2048 + ch;
    float h = p.state_rglru[(size_t)(seq * 2 + d) * 1024 + ch];
    float* cr0 = F.CARRY() + (size_t)d * 1024 + ch;
#pragma unroll 1
    for (int u0 = 0; u0 < 64; u0 += 32) {
        float A[32], B[32];
#pragma unroll
        for (int u = 0; u < 32; ++u) { const int cc = d == 0 ? c_lo + u0 + u : c_lo + 63 - u0 - u; A[u] = ag0[(size_t)cc * 4096]; B[u] = ag0[(size_t)cc * 4096 + 1024]; }
#pragma unroll
        for (int u = 0; u < 32; ++u) { const int cc = d == 0 ? c_lo + u0 + u : c_lo + 63 - u0 - u; cr0[(size_t)cc * 2048] = h; h = A[u] * h + B[u]; }
    }
}

__device__ __forceinline__ void phase3(CParams& p, Frame& F) {
    for (int rep = 0; rep < (REP_PHASE == 30 ? 2 : 1); ++rep)
    { u32x4 rows[7]; if (F.b < 2048) p3_load_rows(F, F.b >> 3, F.b & 7, rows);
      for (int it = F.b; it < 2048; it += F.G) p3_delta_item(p, F, it >> 3, it & 7, rows, it + F.G); }
    for (int rep = 0; rep < (REP_PHASE == 31 ? 2 : 1); ++rep) {
    u32x4 rows[5]; if (F.b < 1024) rg_load_rows(F, 128 + (F.b >> 3), F.b & 7, rows);
    for (int it = F.b; it < 1024; it += F.G) rg_item<1>(p, F, 128 + (it >> 3), it & 7, rows, it + F.G); }
}

struct P4D { int valid, samp, seq, h, d, sl, ci, seq_lo, seq_hi, last, k, s, nch; };
__device__ __forceinline__ P4D p4_desc(const Frame& F, int k, int s) {
    P4D D; int item;
    if (F.G == 256) {
        const int x = F.b & 7, y = F.b >> 3;
        if (y < 16) { item = (x * 4 + (y >> 2)) * 4 + (y & 3); D.valid = k < 1; }
        else { const int j = y - 16; item = 128 + (x * 64 + (j >> 2) * 16 + k) * 4 + (j & 3); D.valid = k < 16; } }
    else { item = F.b + k * F.G; D.valid = item < 2176; }
    D.samp = item < 128; const int it = D.samp ? item : item - 128, chain = it >> 2;
    D.sl = it & 3; D.seq = chain >> 4; D.h = (chain >> 1) & 7; D.d = chain & 1;
    D.nch = D.samp ? 64 : 4; const int chunk0 = D.samp ? 128 + D.seq * 64 : D.seq * 4;
    D.seq_lo = chunk0 * 64; D.seq_hi = D.seq_lo + D.nch * 64;
    D.ci = D.d == 0 ? chunk0 + s : chunk0 + D.nch - 1 - s; D.last = s == D.nch - 1; D.k = k; D.s = s;
    return D;
}
__device__ __forceinline__ P4D p4_next(const Frame& F, const P4D& D) {
    if (D.s + 1 < D.nch) { P4D N = D; N.s = D.s + 1; N.ci = D.ci + (D.d == 0 ? 1 : -1); N.last = N.s == D.nch - 1; return N; }
    return p4_desc(F, D.k + 1, 0);
}
struct P4Pre { u32x4 k0, k1, q0, q1, ti, at; u32x2 v[4]; float g, b, bc; };
struct P4T { unsigned oKQ, oTA, oV, oG, oGc; int cj; };
__device__ __forceinline__ P4T p4_thread_consts(int tid) {
    P4T T; T.oKQ = (unsigned)(((tid >> 4) * 1024 + (tid & 15) * 8) * 2); T.oTA = (unsigned)tid * 16u;
    T.oV = (unsigned)(((tid >> 3) * NPROJ + (tid & 7) * 4) * 2); T.oG = (unsigned)(tid & 63) * 4u; T.oGc = (unsigned)(tid >> 3) * 4u; T.cj = (tid >> 3) - 2; return T;
}
__device__ __forceinline__ void p4_prefetch(CParams& p, const Frame& F, P4Pre& R, const P4D& D, const P4T& T) {
    const int tid = F.tid, t0 = D.ci * 64, h = D.h;
    const char* kb = (const char*)F.Kc() + (size_t)(D.ci * 8 + h) * 16384;
    const char* qb = (const char*)F.Qc() + ((size_t)t0 * 1024 + h * 128) * 2;
    const char* tb = (const char*)F.TA() + (size_t)(D.ci * 8 + h) * 16384;
    const char* vb = (const char*)F.PROJ() + ((long)(t0 - 2) * NPROJ + 2048 + h * 128 + D.sl * 32) * 2;
    const char* gb = (const char*)F.GB() + (size_t)(D.ci * 8 + h) * 1024 + D.d * 256;
    R.k0 = *(const u32x4*)(kb + T.oTA); R.k1 = *(const u32x4*)(kb + T.oTA + 8192u);
    R.q0 = *(const u32x4*)(qb + T.oKQ); R.q1 = *(const u32x4*)(qb + T.oKQ + 65536u);
    R.ti = *(const u32x4*)(tb + T.oTA); R.at = *(const u32x4*)(tb + T.oTA + 8192u);
#pragma unroll
    for (int j = 0; j < 4; ++j) { const int tok = t0 + T.cj + j; u32x2 v = {0u, 0u};
        if (tok >= D.seq_lo && tok < D.seq_hi) v = *(const u32x2*)(vb + T.oV + (unsigned)(j * NPROJ * 2));
        R.v[j] = v; }
    R.bc = *(const float*)(gb + 512 + T.oGc);
    R.g = 0.f; R.b = 0.f;
    if (tid < 64) { R.g = *(const float*)(gb + T.oG); R.b = *(const float*)(gb + 512 + T.oG); }
}
__device__ __forceinline__ u32x4 tri_mask(u32x4 v, int c, int s0, int d) {
    unsigned w[4] = {v.x, v.y, v.z, v.w};
#pragma unroll
    for (int i = 0; i < 4; ++i) { const int slo = s0 + 2 * i, shi = slo + 1;
        const bool klo = d == 0 ? (c >= slo) : (c <= slo), khi = d == 0 ? (c >= shi) : (c <= shi);
        w[i] &= (klo ? 0x0000FFFFu : 0u) | (khi ? 0xFFFF0000u : 0u); }
    return (u32x4){w[0], w[1], w[2], w[3]};
}
constexpr int P4_KS = 0, P4_TI = 17408, P4_VBT = 26624, P4_WL = 31232, P4_SB = 48640, P4_VT1 = 57344, P4_VT2 = 61952, P4_QS = 66560, P4_AT = 101376, P4_GV = 119808, P4_KT = 122368;
__device__ __forceinline__ void p4_stage(CParams& p, const Frame& F, const P4Pre& R, const P4D& D, int buf, const unsigned (&mk)[2][4], f32x4 (&cw)[4], const f32x4 (&cwn)[4]) {
    const int tid = F.tid, d = D.d;
    LAS unsigned char* Ks = F.lds + P4_KS; LAS unsigned char* Qs = F.lds + P4_QS + buf * 17408; LAS unsigned char* TIs = F.lds + P4_TI;
    LAS unsigned char* ATs = F.lds + P4_AT + buf * 9216; LAS unsigned char* Vbt = F.lds + P4_VBT; LAS float* gv = (LAS float*)(F.lds + P4_GV + buf * 1280);
    { const int row = tid >> 4, cc = tid & 15;
      *(LAS u32x4*)(Qs + row * 272 + cc * 16) = R.q0; *(LAS u32x4*)(Qs + (32 + row) * 272 + cc * 16) = R.q1; }
    { const int dk = tid >> 3, cp = tid & 7; LAS unsigned char* Kts = F.lds + P4_KT;
      *(LAS u32x4*)(Kts + dk * 144 + cp * 16) = R.k0; *(LAS u32x4*)(Kts + (64 + dk) * 144 + cp * 16) = R.k1; }
    { const int c = tid >> 3, s0 = (tid & 7) * 8;
      const unsigned m0 = d ? mk[1][0] : mk[0][0], m1 = d ? mk[1][1] : mk[0][1], m2 = d ? mk[1][2] : mk[0][2], m3 = d ? mk[1][3] : mk[0][3];
      *(LAS u32x4*)(TIs + c * 144 + s0 * 2) = (u32x4){R.ti.x & m0, R.ti.y & m1, R.ti.z & m2, R.ti.w & m3};
      *(LAS u32x4*)(ATs + c * 144 + s0 * 2) = (u32x4){R.at.x & m0, R.at.y & m1, R.at.z & m2, R.at.w & m3}; }
    { const int c = tid >> 3, e0 = (tid & 7) * 4; float o[4] = {0.f, 0.f, 0.f, 0.f};
      if (D.s == 0) {
#pragma unroll
          for (int j = 0; j < 4; ++j) cw[j] = cwn[j]; }
#pragma unroll
      for (int j = 0; j < 4; ++j) { const u32x2 v = R.v[j];
          o[0] += cw[j][0] * __uint_as_float(v.x << 16); o[1] += cw[j][1] * __uint_as_float(v.x & 0xffff0000u);
          o[2] += cw[j][2] * __uint_as_float(v.y << 16); o[3] += cw[j][3] * __uint_as_float(v.y & 0xffff0000u); }
#pragma unroll
      for (int i = 0; i < 4; ++i) ((LAS bf16_t*)Vbt)[(e0 + i) * 72 + c] = f2bf(siluf_(o[i]) * R.bc); }
    if (tid < 64) {
        const float glast = __shfl(R.g, d == 0 ? 63 : 0), eg = __expf(R.g);
        gv[tid] = eg; gv[64 + tid] = R.b * eg; gv[128 + tid] = __expf(glast - R.g); if (tid == 0) gv[192] = __expf(glast);
    }
}
__device__ __forceinline__ void phase4_chains(CParams& p, Frame& F) {
    const int tid = F.tid, lane = F.lane, wave = F.wave, q4 = lane >> 4, l15 = lane & 15;
    LAS unsigned char* Ks = F.lds + P4_KS; LAS unsigned char* TIs = F.lds + P4_TI; LAS unsigned char* Vbt = F.lds + P4_VBT; LAS unsigned char* Wl = F.lds + P4_WL;
    LAS unsigned char* Sb = F.lds + P4_SB; LAS unsigned char* Vt1 = F.lds + P4_VT1; LAS unsigned char* Vt2 = F.lds + P4_VT2;
    const int ct = wave & 3, et = wave >> 2;
    P4D Dc = p4_desc(F, 0, 0);
    if (!Dc.valid) return;
    P4Pre RA, RB;
    f32x4 S[2], U; bf16x8 KT[2];
    unsigned mk[2][4]; f32x4 cw[4], cwn[4];
    { const int c = tid >> 3, s0 = (tid & 7) * 8;
#pragma unroll
      for (int i = 0; i < 4; ++i) { const int slo = s0 + 2 * i, shi = slo + 1;
          mk[0][i] = (c >= slo ? 0x0000FFFFu : 0u) | (c >= shi ? 0xFFFF0000u : 0u); mk[1][i] = (c <= slo ? 0x0000FFFFu : 0u) | (c <= shi ? 0xFFFF0000u : 0u); } }
#define P4_INIT_S(D) do { _Pragma("unroll") for (int nt = 0; nt < 2; ++nt) _Pragma("unroll") for (int r = 0; r < 4; ++r) \
        S[nt][r] = (D).samp ? p.state_delta[(size_t)(((D).seq * 2 + (D).d) * 8 + (D).h) * 16384 + (size_t)(wave * 16 + q4 * 4 + r) * 128 + (D).sl * 32 + nt * 16 + l15] : 0.f; } while (0)
#define P4_WRITE_SB() do { _Pragma("unroll") for (int nt = 0; nt < 2; ++nt) { u32x2 o_; o_.x = pk2(S[nt][0], S[nt][1]); o_.y = pk2(S[nt][2], S[nt][3]); \
        *(LAS u32x2*)(Sb + (nt * 16 + l15) * 272 + (wave * 16 + q4 * 4) * 2) = o_; } } while (0)
#define P4_PRECOMP(buf_) do { const LAS float* gv_ = (const LAS float*)(F.lds + P4_GV + (buf_) * 1280); \
        f32x4 WT[4]; _Pragma("unroll") for (int c_ = 0; c_ < 4; ++c_) WT[c_] = (f32x4){0.f, 0.f, 0.f, 0.f}; \
        _Pragma("unroll") for (int ks = 0; ks < 2; ++ks) { \
            const u32x4 kraw = *(const LAS u32x4*)(F.lds + P4_KT + (wave * 16 + l15) * 144 + ks * 64 + q4 * 16); KT[ks] = __builtin_bit_cast(bf16x8, kraw); \
            const f32x4 sa = *(const LAS f32x4*)(gv_ + 64 + ks * 32 + q4 * 8), sb_ = *(const LAS f32x4*)(gv_ + 64 + ks * 32 + q4 * 8 + 4); \
            float kf[8]; unpack8(kraw, kf); u32x4 kg; \
            kg.x = pk2(kf[0] * sa[0], kf[1] * sa[1]); kg.y = pk2(kf[2] * sa[2], kf[3] * sa[3]); kg.z = pk2(kf[4] * sb_[0], kf[5] * sb_[1]); kg.w = pk2(kf[6] * sb_[2], kf[7] * sb_[3]); \
            const bf16x8 akg = __builtin_bit_cast(bf16x8, kg); \
            _Pragma("unroll") for (int c_ = 0; c_ < 4; ++c_) { const bf16x8 bt = ldfrag(TIs, 144, c_ * 16 + l15, ks * 64 + q4 * 16); WT[c_] = MFMA16(akg, bt, WT[c_]); } } \
        _Pragma("unroll") for (int c_ = 0; c_ < 4; ++c_) { u32x2 o_; o_.x = pk2(WT[c_][0], WT[c_][1]); o_.y = pk2(WT[c_][2], WT[c_][3]); \
            *(LAS u32x2*)(Wl + (c_ * 16 + l15) * 272 + (wave * 16 + q4 * 4) * 2) = o_; } \
        U = (f32x4){0.f, 0.f, 0.f, 0.f}; \
        _Pragma("unroll") for (int ks = 0; ks < 2; ++ks) { const bf16x8 a_ = ldfrag(TIs, 144, ct * 16 + l15, ks * 64 + q4 * 16), b_ = ldfrag(Vbt, 144, et * 16 + l15, ks * 64 + q4 * 16); U = MFMA16(a_, b_, U); } } while (0)

    const P4T T = p4_thread_consts(tid);
    p4_prefetch(p, F, RA, Dc, T);
    P4_INIT_S(Dc);
    { const int e0 = (tid & 7) * 4;
#pragma unroll
      for (int j = 0; j < 4; ++j) cwn[j] = *(const f32x4*)(p.dn_conv_w + j * 3072 + 2048 + Dc.h * 128 + Dc.sl * 32 + e0); }
    p4_stage(p, F, RA, Dc, 0, mk, cw, cwn);
    P4_WRITE_SB();
    P4D Dn = p4_next(F, Dc);
    if (Dn.valid) p4_prefetch(p, F, RA, Dn, T);
    P4D Dnn = Dn; if (Dn.valid) { Dnn = p4_next(F, Dn); if (Dnn.valid) p4_prefetch(p, F, RB, Dnn, T); }
    lds_barrier();
    P4_PRECOMP(0);
    lds_barrier();
    int buf = 0;
#define P4_BODY(RX) { \
        const LAS float* gv = (const LAS float*)(F.lds + P4_GV + buf * 1280); \
        const LAS unsigned char* Qs = F.lds + P4_QS + buf * 17408; const LAS unsigned char* ATs = F.lds + P4_AT + buf * 9216; \
        const int c0 = ct * 16 + q4 * 4, e = et * 16 + l15; \
         \
        f32x4 p1 = {0.f, 0.f, 0.f, 0.f}, oacc = {0.f, 0.f, 0.f, 0.f}; \
_Pragma("unroll") \
        for (int ks = 0; ks < 4; ++ks) { const bf16x8 bs = ldfrag(Sb, 272, et * 16 + l15, ks * 64 + q4 * 16); \
            const bf16x8 aw = ldfrag(Wl, 272, ct * 16 + l15, ks * 64 + q4 * 16), aq = ldfrag(Qs, 272, ct * 16 + l15, ks * 64 + q4 * 16); \
            p1 = MFMA16(aw, bs, p1); oacc = MFMA16(aq, bs, oacc); } \
        { float vn[4]; \
_Pragma("unroll") \
          for (int r = 0; r < 4; ++r) vn[r] = U[r] - p1[r]; \
          u32x2 o1, o2; o1.x = pk2(vn[0], vn[1]); o1.y = pk2(vn[2], vn[3]); \
          o2.x = pk2(vn[0] * gv[128 + c0], vn[1] * gv[128 + c0 + 1]); o2.y = pk2(vn[2] * gv[128 + c0 + 2], vn[3] * gv[128 + c0 + 3]); \
          *(LAS u32x2*)(Vt1 + e * 144 + c0 * 2) = o1; *(LAS u32x2*)(Vt2 + e * 144 + c0 * 2) = o2; } \
_Pragma("unroll") \
        for (int r = 0; r < 4; ++r) oacc[r] *= gv[c0 + r]; \
        P4D D3 = Dnn; \
        if (Dn.valid) { p4_stage(p, F, RX, Dn, buf ^ 1, mk, cw, cwn); \
            if (Dn.last && Dnn.valid) { const int e0_ = (tid & 7) * 4; _Pragma("unroll") for (int j = 0; j < 4; ++j) cwn[j] = *(const f32x4*)(p.dn_conv_w + j * 3072 + 2048 + Dnn.h * 128 + Dnn.sl * 32 + e0_); } if (Dnn.valid) { D3 = p4_next(F, Dnn); if (D3.valid) p4_prefetch(p, F, RX, D3, T); } } \
        lds_barrier(); \
         \
        { const float gl = gv[192]; \
_Pragma("unroll") \
          for (int nt = 0; nt < 2; ++nt) S[nt] *= gl; \
_Pragma("unroll") \
          for (int ks = 0; ks < 2; ++ks) \
_Pragma("unroll") \
              for (int nt = 0; nt < 2; ++nt) { const bf16x8 b_ = ldfrag(Vt2, 144, nt * 16 + l15, ks * 64 + q4 * 16); S[nt] = MFMA16(KT[ks], b_, S[nt]); } } \
_Pragma("unroll") \
        for (int ks = 0; ks < 2; ++ks) { const bf16x8 a_ = ldfrag(ATs, 144, ct * 16 + l15, ks * 64 + q4 * 16), b_ = ldfrag(Vt1, 144, et * 16 + l15, ks * 64 + q4 * 16); oacc = MFMA16(a_, b_, oacc); } \
_Pragma("unroll") \
        for (int r = 0; r < 4; ++r) *(bf16_t*)((char*)F.PROJ() + ((size_t)Dc.ci * 64 * NPROJ + Dc.d * 1024 + Dc.h * 128 + Dc.sl * 32) * 2 + (unsigned)(((c0 + r) * NPROJ + e) * 2)) = f2bf(oacc[r]); \
        if (Dc.last) { \
            if (!Dc.samp) { \
_Pragma("unroll") \
                for (int nt = 0; nt < 2; ++nt) \
_Pragma("unroll") \
                    for (int r = 0; r < 4; ++r) \
                        F.out[OUT_SD + (size_t)((Dc.seq * 2 + Dc.d) * 8 + Dc.h) * 16384 + (size_t)(wave * 16 + q4 * 4 + r) * 128 + Dc.sl * 32 + nt * 16 + l15] = S[nt][r]; \
            } \
            if (Dn.valid) P4_INIT_S(Dn); \
        } \
        P4_WRITE_SB(); \
        if (Dn.valid) P4_PRECOMP(buf ^ 1); \
        lds_barrier(); \
        if (!Dn.valid) break; \
        Dc = Dn; Dn = Dnn; Dnn = D3; buf ^= 1; \
    }
#pragma unroll 1
    for (;;) { P4_BODY(RA) P4_BODY(RB) }
#undef P4_BODY
#undef P4_INIT_S
#undef P4_WRITE_SB
#undef P4_PRECOMP
}
__device__ __forceinline__ void phase4(CParams& p, Frame& F) {
    if (F.G == 256) rg_carry_scan(p, F);
    else if (F.b == 0) {
        for (int g = F.tid; g < 69632; g += 512) { int samp = g >= 65536, gg = samp ? g - 65536 : g, seq = gg >> 11, d = (gg >> 10) & 1, ch = gg & 1023;
            const int nch = samp ? 64 : 4, c_lo = samp ? 128 + seq * 64 : seq * 4; float h = samp ? p.state_rglru[(size_t)(seq * 2 + d) * 1024 + ch] : 0.f;
            for (int i = 0; i < nch; ++i) { const int cc = d == 0 ? c_lo + i : c_lo + nch - 1 - i; const float* ag = F.RGAGG() + (size_t)(cc * 2 + d) * 2048; F.CARRY()[(size_t)(cc * 2 + d) * 1024 + ch] = h; h = ag[ch] * h + ag[1024 + ch]; } } }
    __syncthreads();
    phase4_chains(p, F);
}

__device__ __forceinline__ void phase5(CParams& p, Frame& F) {
    const int lane = F.lane;
    float nw[16];
#pragma unroll
    for (int q = 0; q < 4; ++q) { const f32x4 a = *(const f32x4*)(p.dn_norm_w + (lane & 7) * 16 + q * 4); nw[q * 4] = a[0]; nw[q * 4 + 1] = a[1]; nw[q * 4 + 2] = a[2]; nw[q * 4 + 3] = a[3]; }
#pragma unroll 4
    for (int tok = F.b * 8 + F.wave; tok < NTOK; tok += F.G * 8) {
        const bf16_t* pr = F.PROJ() + (size_t)tok * NPROJ + lane * 16;
        float o[16], z[16]; float ss = 0.f;
#pragma unroll
        for (int hf = 0; hf < 2; ++hf) { const u32x4 a = __builtin_nontemporal_load((const u32x4*)(pr + hf * 8)), b = __builtin_nontemporal_load((const u32x4*)(pr + 1024 + hf * 8)), zz = __builtin_nontemporal_load((const u32x4*)(pr + 3072 + hf * 8));
            float fa[8], fb[8], fz[8]; unpack8(a, fa); unpack8(b, fb); unpack8(zz, fz);
#pragma unroll
            for (int e = 0; e < 8; ++e) { o[hf * 8 + e] = fa[e] + fb[e]; z[hf * 8 + e] = fz[e]; ss += o[hf * 8 + e] * o[hf * 8 + e]; } }
        ss += __shfl_xor(ss, 1); ss += __shfl_xor(ss, 2); ss += __shfl_xor(ss, 4);
        const float rs = rsqrtf(ss * (1.f / 128.f) + 1e-6f);
#pragma unroll
        for (int hf = 0; hf < 2; ++hf) { float w[8];
#pragma unroll
            for (int e = 0; e < 8; ++e) w[e] = o[hf * 8 + e] * rs * nw[hf * 8 + e] * siluf_(z[hf * 8 + e]);
            *(u32x4*)(F.MIX() + (size_t)tok * 2048 + lane * 16 + hf * 8) = pack8(w); }
    }
    __syncthreads();
    for (int it = F.b; it < 1024; it += F.G) { u32x4 rows[5]; rg_load_rows(F, 128 + (it >> 3), it & 7, rows); rg_item<3>(p, F, 128 + (it >> 3), it & 7, rows, it + F.G); }
    for (int it = F.b; it < 256; it += F.G) { rg_prompt_dir<0>(p, F, it >> 3, it & 7); rg_prompt_dir<1>(p, F, it >> 3, it & 7); }

}

__device__ __forceinline__ void phase6(CParams& p, Frame& F) {
    pg8::Gemm g{F.MIX(), F.WoutT(), NTOK, 1024, 2048}; pg8::StaticOrder S; S.init(NTOK, 1024, F.G, F.b); pg8::EpiBf16 E{F.PROJ(), NPROJ};
    pg8::gemm_phase<pg8::EpiBf16, pg8::StaticOrder>(F.lds, g, S, E);
}

__device__ __forceinline__ void phase7(CParams& p, Frame& F) {
    LAS float* gt = (LAS float*)F.lds;
    for (int tb = F.b; tb < 256; tb += F.G) {
        const int grp = grp_of_block(tb);
        for (int j = F.tid; j < 1024; j += 512) gt[j] = mod_val(p, F, grp, 2048 + j) * p.post_w[j];
        __syncthreads();
#pragma unroll 2
        for (int i = 0; i < 8; ++i) {
            const int tok = tb * 64 + F.wave * 8 + i;
            const float* xr = tok < 8192 ? p.x_prompt + (size_t)tok * 1024 : p.x_sample + (size_t)(tok - 8192) * 1024;
            const bf16_t* yr = F.PROJ() + (size_t)tok * NPROJ;
            f32x4 y[4], xv[4]; float ss = 0.f;
#pragma unroll
            for (int q = 0; q < 4; ++q) xv[q] = __builtin_nontemporal_load((const f32x4*)(xr + F.lane * 4 + 256 * q));
#pragma unroll
            for (int q = 0; q < 4; ++q) { const u32x2 yb = __builtin_nontemporal_load((const u32x2*)(yr + F.lane * 4 + 256 * q));
                y[q] = (f32x4){__uint_as_float(yb.x << 16), __uint_as_float(yb.x & 0xffff0000u), __uint_as_float(yb.y << 16), __uint_as_float(yb.y & 0xffff0000u)}; ss += (y[q][0] * y[q][0] + y[q][1] * y[q][1]) + (y[q][2] * y[q][2] + y[q][3] * y[q][3]); }
            const float rstd = rsqrtf(wave_sum(ss) * (1.f / 1024.f) + 1e-6f);
#pragma unroll
            for (int q = 0; q < 4; ++q) { const int j = F.lane * 4 + 256 * q; f32x4 v = xv[q];
                if (tok >= 8192) { const int pp = (tok - 8192) & 4095; const int vv = (q < 2) ? (pp >> 6) : (pp & 63);
                    v += *(const f32x4*)(F.pe() + ((q & 1) ? 16384 : 0) + vv * 256 + F.lane * 4); }
                const f32x4 g4 = *(const LAS f32x4*)(gt + j);
                f32x4 ov = v + g4 * (y[q] * rstd); ov[0] = fin(ov[0]); ov[1] = fin(ov[1]); ov[2] = fin(ov[2]); ov[3] = fin(ov[3]); if (!(LIVE_MASK & 1)) ov = (f32x4){0.f, 0.f, 0.f, 0.f}; __builtin_nontemporal_store(ov, (f32x4*)(F.out + (size_t)tok * 1024 + j)); }
        }
        __syncthreads();
    }
}

__device__ __forceinline__ void phase8(CParams& p, Frame& F) {
    if (F.b == 0 && F.tid == 0) { int code = 0; for (int k = 31; k >= 1; --k) if (DG(F)[k]) code = k; F.out[OUT_SR] = 1000.f * (float)code + 500.f; }
}
extern __shared__ __attribute__((aligned(16))) unsigned char smem_raw[];
__global__ void __launch_bounds__(512) fwd_megakernel(Params p_unused) {
    CParams& p = *(CParams*)__builtin_amdgcn_kernarg_segment_ptr();
    Frame F;
    F.lds = (LAS unsigned char*)smem_raw;
    F.tid = threadIdx.x; F.lane = F.tid & 63; F.wave = __builtin_amdgcn_readfirstlane(F.tid >> 6); F.G = gridDim.x; F.b = blockIdx.x;
    F.out = p.out; F.ws = p.ws;
    volatile LAS unsigned* xbw = (volatile LAS unsigned*)(F.lds + LDS_BYTES - 16);
    const bool multi = (p.ph_hi - p.ph_lo) > 1;
    XcdBarrier xb; xb.bar = (unsigned*)(p.ws + WS_CTL); xb.x = 0; xb.st = xbw;
    if (multi) {
        if (F.tid == 0) { xbw[0] = 0u; xbw[1] = 0u; xbw[2] = 0u; xbw[3] = 0u; }
        __syncthreads();
        xb = xcd_barrier_post((unsigned*)(p.ws + WS_CTL), xbw);
    }
#ifndef PHMASK
#define PHMASK 511
#endif
    const int lo = p.ph_lo, hi = p.ph_hi;
#ifndef REP_PHASE
#define REP_PHASE -1
#endif
#define RUN_PHASE(k, fn) do { if (lo <= (k) && (k) < hi) { if (PHMASK & (1 << (k))) fn(p, F); if ((k) == REP_PHASE) { __syncthreads(); fn(p, F); } if ((k) + 1 < hi) xcd_barrier(xb); } } while (0)
    RUN_PHASE(0, phase0); RUN_PHASE(1, phase1); RUN_PHASE(2, phase2); RUN_PHASE(3, phase3);
    RUN_PHASE(4, phase4); RUN_PHASE(5, phase5); RUN_PHASE(6, phase6); RUN_PHASE(7, phase7); RUN_PHASE(8, phase8);
}

extern "C" void kernel_launch(void* const* d_in, const int* in_sizes, int n_in, void* d_out, int out_size, void* d_ws, size_t ws_size, hipStream_t stream) {
    static int grid = 0;
    if (grid == 0) {
        int dev = 0, cus = 0;
        if (hipGetDevice(&dev) != hipSuccess || hipDeviceGetAttribute(&cus, hipDeviceAttributeMultiprocessorCount, dev) != hipSuccess) { fprintf(stderr, "kernel_launch: device query failed\n"); grid = -1; return; }
        if (hipFuncSetAttribute((const void*)fwd_megakernel, hipFuncAttributeMaxDynamicSharedMemorySize, LDS_BYTES) != hipSuccess) { fprintf(stderr, "kernel_launch: hipFuncSetAttribute failed\n"); grid = -1; return; }
        int per_cu = 0;
        if (hipOccupancyMaxActiveBlocksPerMultiprocessor(&per_cu, (const void*)fwd_megakernel, 512, LDS_BYTES) != hipSuccess || per_cu < 1) { fprintf(stderr, "kernel_launch: occupancy query says %d blocks per CU\n", per_cu); (void)hipGetLastError(); }
        grid = cus;
    }
    if (grid < 0) return;
    Params p{};
    const float** pp = (const float**)&p;
    for (int i = 0; i < 23; ++i) pp[i] = (const float*)d_in[i];
    p.out = (float*)d_out; p.ws = (unsigned char*)d_ws;
    (void)hipMemsetAsync((char*)d_ws + WS_CTL, 0, 16384, stream);
#if MK_SINGLE
    p.ph_lo = 0; p.ph_hi = NPH;
    void* args[] = {&p};
    hipError_t e = hipLaunchCooperativeKernel((const void*)fwd_megakernel, dim3(grid), dim3(512), args, LDS_BYTES, stream);
    if (e != hipSuccess) fprintf(stderr, "cooperative launch failed: %s (grid %d)\n", hipGetErrorString(e), grid);
#else
    for (int ph = 0; ph < NPH; ++ph) {
        p.ph_lo = ph; p.ph_hi = ph + 1;
        hipLaunchKernelGGL(fwd_megakernel, dim3(grid), dim3(512), LDS_BYTES, stream, p);
    }
#endif
}
```
